# Optimizing an MI355X kernel written in HIP

```python
import jax, jax.numpy as jnp
from jax import lax
import numpy as np

D_MODEL = 2048
BATCH = 8
SEQ = 4096
DEPTH = 4

CHUNK = 64
Q_BLOCK = 128
N_MIXERS = 3
D_FF = 5632
FFN_RESIDUAL_WEIGHT = 0.5
RMS_EPS = 1e-6

A_HEADS = 8
A_QK_DIM = D_MODEL // (2 * A_HEADS)
A_V_DIM = D_MODEL // A_HEADS
A_IN = 2 * A_HEADS * A_QK_DIM + 2 * A_HEADS * A_V_DIM + 2 * A_HEADS
B_HEADS = 16
B_HEAD_DIM = D_MODEL // B_HEADS
B_IN = 3 * B_HEADS * B_HEAD_DIM + B_HEADS
C_HEADS = 4
C_K_DIM = D_MODEL // (2 * C_HEADS)
C_V_DIM = D_MODEL // C_HEADS
C_GATE_RANK = 16
C_GATE_TEMP = 16.0
C_IN = 2 * C_HEADS * C_K_DIM + 2 * C_HEADS * C_V_DIM + C_GATE_RANK

N_LAYERS_A = len(range(0, DEPTH, N_MIXERS))
N_LAYERS_B = len(range(1, DEPTH, N_MIXERS))
N_LAYERS_C = len(range(2, DEPTH, N_MIXERS))

kernel_name = "hybrid_mlstm_fox_gla_macaron_trunk"


def rmsnorm(x, g):
    xf = x.astype(jnp.float32)
    y = xf * lax.rsqrt(jnp.mean(xf * xf, axis=-1, keepdims=True) + RMS_EPS)
    return (y * g.astype(jnp.float32)).astype(x.dtype)


def head_rmsnorm(h, g):
    y = h * lax.rsqrt(jnp.mean(h * h, axis=-1, keepdims=True) + RMS_EPS)
    return y.reshape(h.shape[0], h.shape[1], -1) * g.astype(jnp.float32)


def swiglu_ffn(x, g, w_in, w_out):
    a, b = jnp.split(rmsnorm(x, g) @ w_in, 2, axis=-1)
    return (jax.nn.silu(a) * b) @ w_out


def to_chunks(t):
    b, s, h = t.shape[:3]
    t = t.reshape(b, s // CHUNK, CHUNK, h, *t.shape[3:])
    return jnp.moveaxis(t, (1, 3), (0, 2))


def from_chunks(t):
    t = jnp.moveaxis(t, (0, 2), (1, 3))
    return t.reshape(t.shape[0], t.shape[1] * t.shape[2], t.shape[3], t.shape[4])


def mlstm_chunk_step(carry, inp):
    c_prev, n_prev, m_prev = carry
    q, k, v, i_pre, log_f = inp
    tri = jnp.tril(jnp.ones((CHUNK, CHUNK), dtype=bool))
    b = jnp.cumsum(log_f, axis=-1)
    d_log = jnp.where(tri, b[..., :, None] - b[..., None, :] + i_pre[..., None, :], -jnp.inf)
    inter_log = b + m_prev[..., None]
    m_t = jnp.maximum(inter_log, jnp.max(d_log, axis=-1))
    d_w = jnp.exp(d_log - m_t[..., None])
    inter_w = jnp.exp(inter_log - m_t)
    s = jnp.einsum('bhtd,bhsd->bhts', q, k) * d_w
    num = jnp.einsum('bhts,bhse->bhte', s, v) + inter_w[..., None] * jnp.einsum('bhtd,bhde->bhte', q, c_prev)
    den = jnp.sum(s, axis=-1) + inter_w * jnp.einsum('bhtd,bhd->bht', q, n_prev)
    h = num / jnp.maximum(jnp.abs(den), jnp.exp(-m_t))[..., None]
    b_last = b[..., -1]
    g = b_last[..., None] - b + i_pre
    m_new = jnp.maximum(b_last + m_prev, jnp.max(g, axis=-1))
    w_c = jnp.exp(b_last + m_prev - m_new)
    w_s = jnp.exp(g - m_new[..., None])
    c_new = w_c[..., None, None] * c_prev + jnp.einsum('bhs,bhsd,bhse->bhde', w_s, k, v)
    n_new = w_c[..., None] * n_prev + jnp.einsum('bhs,bhsd->bhd', w_s, k)
    return (c_new, n_new, m_new), h


def mlstm_mixer(u, w_in, b_if, head_norm_g, w_out):
    bsz, s, _ = u.shape
    nq, nv = A_HEADS * A_QK_DIM, A_HEADS * A_V_DIM
    p = (u @ w_in).astype(jnp.float32)
    q, k, v, o, gi, gf = jnp.split(p, [nq, 2 * nq, 2 * nq + nv, 2 * nq + 2 * nv, 2 * nq + 2 * nv + A_HEADS], axis=-1)
    b_if = b_if.astype(jnp.float32)
    i_pre = gi + b_if[:A_HEADS]
    log_f = jax.nn.log_sigmoid(gf + b_if[A_HEADS:])
    q = q.reshape(bsz, s, A_HEADS, A_QK_DIM)
    k = k.reshape(bsz, s, A_HEADS, A_QK_DIM) * (A_QK_DIM ** -0.5)
    v = v.reshape(bsz, s, A_HEADS, A_V_DIM)
    init = (jnp.zeros((bsz, A_HEADS, A_QK_DIM, A_V_DIM), jnp.float32),
            jnp.zeros((bsz, A_HEADS, A_QK_DIM), jnp.float32),
            jnp.zeros((bsz, A_HEADS), jnp.float32))
    _, h = lax.scan(mlstm_chunk_step, init,
                    (to_chunks(q), to_chunks(k), to_chunks(v), to_chunks(i_pre), to_chunks(log_f)))
    h = head_rmsnorm(from_chunks(h), head_norm_g) * jax.nn.sigmoid(o)
    return h.astype(u.dtype) @ w_out


def fox_mixer(u, w_in, b_f, w_out):
    bsz, s, _ = u.shape
    nd = B_HEADS * B_HEAD_DIM
    q, k, v, gf = jnp.split(u @ w_in, [nd, 2 * nd, 3 * nd], axis=-1)
    q = q.reshape(bsz, s, B_HEADS, B_HEAD_DIM).transpose(0, 2, 1, 3)
    k = k.reshape(bsz, s, B_HEADS, B_HEAD_DIM).transpose(0, 2, 1, 3)
    v = v.reshape(bsz, s, B_HEADS, B_HEAD_DIM).transpose(0, 2, 1, 3)
    log_f = jax.nn.log_sigmoid(gf.astype(jnp.float32) + b_f.astype(jnp.float32))
    cum_f = jnp.cumsum(log_f, axis=1).transpose(0, 2, 1)
    scale = B_HEAD_DIM ** -0.5
    outs = []
    for blk in range(s // Q_BLOCK):
        lo, hi = blk * Q_BLOCK, (blk + 1) * Q_BLOCK
        logits = jnp.einsum('bhtd,bhsd->bhts', q[:, :, lo:hi], k[:, :, :hi],
                            preferred_element_type=jnp.float32) * scale
        logits = logits + cum_f[:, :, lo:hi, None] - cum_f[:, :, None, :hi]
        mask = (lo + jnp.arange(Q_BLOCK))[:, None] >= jnp.arange(hi)[None, :]
        probs = jax.nn.softmax(jnp.where(mask, logits, -jnp.inf), axis=-1)
        outs.append(jnp.einsum('bhts,bhsd->bhtd', probs.astype(v.dtype), v[:, :, :hi]))
    o = jnp.concatenate(outs, axis=2).transpose(0, 2, 1, 3).reshape(bsz, s, nd)
    return o @ w_out


def gla_chunk_step(state, inp):
    q, k, v, la = inp
    tri = jnp.tril(jnp.ones((CHUNK, CHUNK), dtype=bool))
    b = jnp.cumsum(la, axis=2)
    diff = b[:, :, :, None, :] - b[:, :, None, :, :]
    decay = jnp.exp(jnp.where(tri[:, :, None], diff, -jnp.inf))
    a = jnp.einsum('bhtd,bhsd,bhtsd->bhts', q, k, decay)
    o = jnp.einsum('bhts,bhse->bhte', a, v) + jnp.einsum('bhtd,bhde->bhte', q * jnp.exp(b), state)
    b_last = b[:, :, -1]
    state = jnp.exp(b_last)[..., None] * state + jnp.einsum(
        'bhsd,bhse->bhde', k * jnp.exp(b_last[:, :, None] - b), v)
    return state, o


def gla_mixer(u, w_in, w_alpha, b_alpha, head_norm_g, w_out):
    bsz, s, _ = u.shape
    nk, nv = C_HEADS * C_K_DIM, C_HEADS * C_V_DIM
    p = (u @ w_in).astype(jnp.float32)
    q, k, v, r, a_low = jnp.split(p, [nk, 2 * nk, 2 * nk + nv, 2 * nk + 2 * nv], axis=-1)
    log_alpha = jax.nn.log_sigmoid(a_low @ w_alpha.astype(jnp.float32) + b_alpha.astype(jnp.float32)) / C_GATE_TEMP
    q = q.reshape(bsz, s, C_HEADS, C_K_DIM) * (C_K_DIM ** -0.5)
    k = k.reshape(bsz, s, C_HEADS, C_K_DIM)
    v = v.reshape(bsz, s, C_HEADS, C_V_DIM)
    log_alpha = log_alpha.reshape(bsz, s, C_HEADS, C_K_DIM)
    init = jnp.zeros((bsz, C_HEADS, C_K_DIM, C_V_DIM), jnp.float32)
    _, o = lax.scan(gla_chunk_step, init,
                    (to_chunks(q), to_chunks(k), to_chunks(v), to_chunks(log_alpha)))
    h = head_rmsnorm(from_chunks(o), head_norm_g) * jax.nn.silu(r)
    return h.astype(u.dtype) @ w_out


def setup_inputs(seed: int = 0) -> dict:
    key = jax.random.key(seed)
    ks = jax.random.split(key, 24)
    f32 = jnp.float32
    nrm = lambda k, shape, fan_in: jax.random.normal(k, shape, f32) * (fan_in ** -0.5)
    gain = lambda k, shape: 1.0 + 0.02 * jax.random.normal(k, shape, f32)
    x = jax.random.normal(ks[0], (BATCH, SEQ, D_MODEL), f32)
    ffn_norm = gain(ks[1], (DEPTH, 2, D_MODEL))
    ffn_w_in = nrm(ks[2], (DEPTH, 2, D_MODEL, 2 * D_FF), D_MODEL)
    ffn_w_out = nrm(ks[3], (DEPTH, 2, D_FF, D_MODEL), D_FF)
    mix_norm = gain(ks[4], (DEPTH, D_MODEL))
    a_w_in = nrm(ks[5], (N_LAYERS_A, D_MODEL, A_IN), D_MODEL)
    a_b_if = jnp.concatenate([
        -2.0 + 0.1 * jax.random.normal(ks[6], (N_LAYERS_A, A_HEADS), f32),
        3.0 + 0.1 * jax.random.normal(ks[7], (N_LAYERS_A, A_HEADS), f32)], axis=-1)
    a_head_norm = gain(ks[8], (N_LAYERS_A, A_HEADS * A_V_DIM))
    a_w_out = nrm(ks[9], (N_LAYERS_A, A_HEADS * A_V_DIM, D_MODEL), A_HEADS * A_V_DIM)
    b_w_in = nrm(ks[10], (N_LAYERS_B, D_MODEL, B_IN), D_MODEL)
    b_b_f = 2.0 + 0.1 * jax.random.normal(ks[11], (N_LAYERS_B, B_HEADS), f32)
    b_w_out = nrm(ks[12], (N_LAYERS_B, B_HEADS * B_HEAD_DIM, D_MODEL), B_HEADS * B_HEAD_DIM)
    c_w_in = nrm(ks[13], (N_LAYERS_C, D_MODEL, C_IN), D_MODEL)
    c_w_alpha = nrm(ks[14], (N_LAYERS_C, C_GATE_RANK, C_HEADS * C_K_DIM), C_GATE_RANK)
    c_b_alpha = 0.1 * jax.random.normal(ks[15], (N_LAYERS_C, C_HEADS * C_K_DIM), f32)
    c_head_norm = gain(ks[16], (N_LAYERS_C, C_HEADS * C_V_DIM))
    c_w_out = nrm(ks[17], (N_LAYERS_C, C_HEADS * C_V_DIM, D_MODEL), C_HEADS * C_V_DIM)
    final_norm = gain(ks[18], (D_MODEL,))
    return {"x": x, "ffn_norm": ffn_norm, "ffn_w_in": ffn_w_in, "ffn_w_out": ffn_w_out,
            "mix_norm": mix_norm, "a_w_in": a_w_in, "a_b_if": a_b_if, "a_head_norm": a_head_norm,
            "a_w_out": a_w_out, "b_w_in": b_w_in, "b_b_f": b_b_f, "b_w_out": b_w_out,
            "c_w_in": c_w_in, "c_w_alpha": c_w_alpha, "c_b_alpha": c_b_alpha,
            "c_head_norm": c_head_norm, "c_w_out": c_w_out, "final_norm": final_norm}


def reference(x, ffn_norm, ffn_w_in, ffn_w_out, mix_norm, a_w_in, a_b_if, a_head_norm, a_w_out,
              b_w_in, b_b_f, b_w_out, c_w_in, c_w_alpha, c_b_alpha, c_head_norm, c_w_out, final_norm):
    h = x
    for i in range(DEPTH):
        h = h + FFN_RESIDUAL_WEIGHT * swiglu_ffn(h, ffn_norm[i, 0], ffn_w_in[i, 0], ffn_w_out[i, 0])
        u = rmsnorm(h, mix_norm[i])
        kind, j = i % N_MIXERS, i // N_MIXERS
        if kind == 0:
            y = mlstm_mixer(u, a_w_in[j], a_b_if[j], a_head_norm[j], a_w_out[j])
        elif kind == 1:
            y = fox_mixer(u, b_w_in[j], b_b_f[j], b_w_out[j])
        else:
            y = gla_mixer(u, c_w_in[j], c_w_alpha[j], c_b_alpha[j], c_head_norm[j], c_w_out[j])
        h = h + y
        h = h + FFN_RESIDUAL_WEIGHT * swiglu_ffn(h, ffn_norm[i, 1], ffn_w_in[i, 1], ffn_w_out[i, 1])
    return rmsnorm(h, final_norm)
```

```cpp
#include <hip/hip_runtime.h>
#include <cstdio>
#include <cstdint>
namespace pg8 {
#define PG8_LAS __attribute__((address_space(3)))
typedef unsigned short bf16_t;
typedef short bf16x8 __attribute__((ext_vector_type(8)));
typedef float f32x4 __attribute__((ext_vector_type(4)));
typedef unsigned u32x4 __attribute__((ext_vector_type(4)));
constexpr int BM = 256, BK = 64, HALF = 128, HTB = HALF * BK * 2  , STAGE_BYTES = 8 * HTB, NXCD = 8, WGM = 8;

__host__ __device__ __forceinline__ int lds_byte(int r, int c) { const int st = (r >> 4) * 2 + (c >> 5), rr = r & 15, cc = c & 31, ob = rr * 64 + cc * 2; return st * 1024 + (ob ^ (((ob >> 9) & 1) << 5)); }
__host__ __device__ __forceinline__ void stage_rc(int b, int& R, int& C) { const int st = b / 1024, sb = b % 1024, swz = sb ^ (((sb >> 9) & 1) << 5); R = (st >> 1) * 16 + swz / 64; C = (st & 1) * 32 + (swz % 64) / 2; }
__host__ __device__ __forceinline__ int perm32(int rho) { const int n = rho >> 4, i = rho & 15; return 8 * (i >> 2) + 4 * n + (i & 3); }

struct Unit { int pm, pn; };
struct Gemm { const bf16_t* A; const bf16_t* Bt; int M, N, K; };

struct StaticOrder {
    int nM, nN, nwg, G, c;
    __host__ __device__ void init(int M, int N, int G_, int c_) { nM = M / BM; nN = N / BM; nwg = nM * nN; G = G_; c = c_; }
    __host__ __device__ bool next(int i, Unit& u) const {
        const long L = (long)i * G + c; if (L >= nwg) return false;
        int wgid = (int)L; { const int q = nwg / NXCD, r = nwg % NXCD, xcd = wgid % NXCD, off = wgid / NXCD; wgid = (xcd < r ? xcd * (q + 1) : r * (q + 1) + (xcd - r) * q) + off; }
        const int nig = WGM * nN, gid = wgid / nig, fm = gid * WGM, gsz = (nM - fm) < WGM ? (nM - fm) : WGM;
        u.pm = fm + ((wgid % nig) % gsz); u.pn = (wgid % nig) / gsz; return true;
    }
    __device__ __forceinline__ void a_ready(const Unit&) const {}
    __device__ __forceinline__ void done(const Unit&) const {}
};

__device__ __forceinline__ unsigned cvt_pk_bf16(float lo, float hi) { unsigned r; asm volatile("v_cvt_pk_bf16_f32 %0, %1, %2" : "=v"(r) : "v"(lo), "v"(hi)); return r; }
constexpr float RMS_EPS_F = 1e-6f, SS_FIX = 1048576.0f, SS_UNFIX_D = 1.0f / (1048576.0f * 2048.0f);
typedef long long ss_t;
__device__ __forceinline__ float rstd_of(const ss_t* ss, int row) { return rsqrtf((float)ss[row] * SS_UNFIX_D + RMS_EPS_F); }
struct EpiSwiGLU {
    static constexpr bool PERM = true, AFTER_DRAIN = false;
    bf16_t* O; const ss_t* ss; int ldo;
    __device__ __forceinline__ void operator()(const f32x4 (&acc)[2][2][4][2], const Unit& u, int wr, int wc, int fr, int fq) const {
        const int row0 = u.pm * BM + wr * 64 + fr, col0 = u.pn * HALF + wc * 32 + 8 * fq;
#pragma unroll
        for (int ai = 0; ai < 2; ++ai)
#pragma unroll
            for (int m = 0; m < 4; ++m) {
                const int row = row0 + ai * HALF + m * 16;
                const float rs = rstd_of(ss, row);
                float o[8];
#pragma unroll
                for (int n = 0; n < 2; ++n)
#pragma unroll
                    for (int j = 0; j < 4; ++j) { const float a = acc[ai][0][m][n][j] * rs, b = acc[ai][1][m][n][j] * rs;
                        o[4 * n + j] = a * b * __builtin_amdgcn_rcpf(1.0f + __expf(-a)); }
                u32x4 w; w.x = cvt_pk_bf16(o[0], o[1]); w.y = cvt_pk_bf16(o[2], o[3]); w.z = cvt_pk_bf16(o[4], o[5]); w.w = cvt_pk_bf16(o[6], o[7]);
                *(u32x4*)(O + (size_t)row * ldo + col0) = w;
            }
    }
};
struct EpiMixIn {
    static constexpr bool PERM = true, AFTER_DRAIN = false;
    bf16_t* O; float* G; const ss_t* ss;
    __device__ __forceinline__ void operator()(const f32x4 (&acc)[2][2][4][2], const Unit& u, int wr, int wc, int fr, int fq) const {
        const int row0 = u.pm * BM + wr * 64 + fr;
        if (u.pn < 24) {
            const int col0 = u.pn * BM + wc * 32 + 8 * fq;
#pragma unroll
            for (int ai = 0; ai < 2; ++ai)
#pragma unroll
                for (int m = 0; m < 4; ++m) {
                    const int row = row0 + ai * HALF + m * 16;
                    const float rs = rstd_of(ss, row);
#pragma unroll
                    for (int bj = 0; bj < 2; ++bj) { const f32x4 v0 = acc[ai][bj][m][0] * rs, v1 = acc[ai][bj][m][1] * rs;
                        u32x4 w; w.x = cvt_pk_bf16(v0[0], v0[1]); w.y = cvt_pk_bf16(v0[2], v0[3]); w.z = cvt_pk_bf16(v1[0], v1[1]); w.w = cvt_pk_bf16(v1[2], v1[3]);
                        *(u32x4*)(O + (size_t)row * 6144 + col0 + bj * HALF) = w; }
                }
        } else if (wc == 0 && fq < 2) {
#pragma unroll
            for (int ai = 0; ai < 2; ++ai)
#pragma unroll
                for (int m = 0; m < 4; ++m) {
                    const int row = row0 + ai * HALF + m * 16;
                    const float rs = rstd_of(ss, row);
#pragma unroll
                    for (int n = 0; n < 2; ++n) *(f32x4*)(G + (size_t)row * 16 + 8 * fq + 4 * n) = acc[ai][0][m][n] * rs;
                }
        }
    }
};
struct EpiResid {
    static constexpr bool PERM = false, AFTER_DRAIN = false;
    const float* res; float* hout; bf16_t* hb; ss_t* ssn; float scale;
    __device__ __forceinline__ void operator()(const f32x4 (&acc)[2][2][4][2], const Unit& u, int wr, int wc, int fr, int fq) const {
        typedef unsigned u32x2v __attribute__((ext_vector_type(2)));
        const int row0 = u.pm * BM + wr * 64 + fr, col0 = u.pn * BM + wc * 32 + 4 * fq;
#pragma unroll
        for (int ai = 0; ai < 2; ++ai)
#pragma unroll
            for (int m = 0; m < 4; ++m) {
                const int row = row0 + ai * HALF + m * 16; const size_t off = (size_t)row * 2048 + col0; float sq = 0.f;
#pragma unroll
                for (int bj = 0; bj < 2; ++bj)
#pragma unroll
                    for (int n = 0; n < 2; ++n) { const size_t o2 = off + bj * HALF + n * 16;
                        const f32x4 r = *(const f32x4*)(res + o2); const f32x4 hn = r + acc[ai][bj][m][n] * scale;
                        *(f32x4*)(hout + o2) = hn; u32x2v w; w.x = cvt_pk_bf16(hn[0], hn[1]); w.y = cvt_pk_bf16(hn[2], hn[3]); *(u32x2v*)(hb + o2) = w;
                        sq += (hn[0] * hn[0] + hn[1] * hn[1]) + (hn[2] * hn[2] + hn[3] * hn[3]); }
                sq += __shfl_xor(sq, 16); sq += __shfl_xor(sq, 32);
                if (fq == 0) atomicAdd((unsigned long long*)(ssn + row), (unsigned long long)__float2ll_rn(sq * SS_FIX));
            }
    }
};

template <class Epi, class Sched, bool ALIGN_EPI = false, bool SP2 = false>
__device__ __forceinline__ void gemm_phase(PG8_LAS unsigned char* lds, const Gemm g, const Sched& S, const Epi& E) {
    int tid_ = threadIdx.x; asm volatile("" : "+v"(tid_));
    const int tid = tid_, wid = __builtin_amdgcn_readfirstlane(tid >> 6), lane = tid & 63, wr = wid >> 2, wc = wid & 3, fr = lane & 15, fq = lane >> 4;
    const int K = g.K, nt = K / BK;
    unsigned voffA[2], voffB[2];
#pragma unroll
    for (int i = 0; i < 2; ++i) { int R, C; stage_rc(tid * 16 + i * 8192, R, C); const int Rb = Epi::PERM ? ((R & ~31) + perm32(R & 31)) : R;
        voffA[i] = (unsigned)(R * K + C) * 2u; voffB[i] = (unsigned)(Rb * K + C) * 2u; }
    const size_t kstep = (size_t)(BK * 2);
    const size_t hstep = (size_t)HALF * K * 2;
    const size_t tstep = 2 * hstep;
    const unsigned ldsw = (unsigned)wid * 1024u;
    const int aoff = lds_byte(wr * 64 + fr, fq * 8), boff = lds_byte(wc * 32 + fr, fq * 8);
#define PG8_SA(b, h) (((b) * 2 + (h)) * HTB)
#define PG8_SB(b, h) ((4 + (b) * 2 + (h)) * HTB)
#define PG8_STAGE(bufoff, gbase, voff) do { _Pragma("unroll") for (int _i = 0; _i < 2; ++_i) \
        __builtin_amdgcn_global_load_lds((const unsigned*)((const char*)(gbase) + (voff)[_i]), (PG8_LAS unsigned*)(lds + (bufoff) + ldsw + _i * 8192), 16, 0, 0); } while (0)
#define PG8_LDA(dst, b, h) do { _Pragma("unroll") for (int m = 0; m < 4; ++m) _Pragma("unroll") for (int k = 0; k < 2; ++k) dst[m][k] = *(const PG8_LAS bf16x8*)(lds + PG8_SA(b, h) + aoff + m * 2048 + k * 1024); } while (0)
#define PG8_LDB(dst, b, h) do { _Pragma("unroll") for (int n = 0; n < 2; ++n) _Pragma("unroll") for (int k = 0; k < 2; ++k) dst[n][k] = *(const PG8_LAS bf16x8*)(lds + PG8_SB(b, h) + boff + n * 2048 + k * 1024); } while (0)
#define PG8_MMA(ai, bj, At, Bt) do { __builtin_amdgcn_s_setprio(1); _Pragma("unroll") for (int m = 0; m < 4; ++m) _Pragma("unroll") for (int n = 0; n < 2; ++n) _Pragma("unroll") for (int k = 0; k < 2; ++k) \
        acc[ai][bj][m][n] = __builtin_amdgcn_mfma_f32_16x16x32_bf16(Bt[n][k], At[m][k], acc[ai][bj][m][n], 0, 0, 0); __builtin_amdgcn_s_setprio(0); } while (0)
#define PG8_WAIT_V(n) asm volatile("s_waitcnt vmcnt(" #n ")" ::: "memory")
#define PG8_WAIT_L(n) asm volatile("s_waitcnt lgkmcnt(" #n ")" ::: "memory")
#define PG8_BAR __builtin_amdgcn_s_barrier()
#define PG8_SCHED __builtin_amdgcn_sched_barrier(0)
    Unit cur, nxt; int ui = 0;
    if (!S.next(0, cur)) return;
    f32x4 acc[2][2][4][2];
#pragma unroll
    for (int a = 0; a < 2; ++a)
#pragma unroll
        for (int b = 0; b < 2; ++b)
#pragma unroll
            for (int m = 0; m < 4; ++m)
#pragma unroll
                for (int n = 0; n < 2; ++n) acc[a][b][m][n] = (f32x4){0.f, 0.f, 0.f, 0.f};
    bf16x8 At[4][2], B0[2][2], B1[2][2];
    const char* cA = (const char*)g.A + (size_t)cur.pm * tstep; const char* cB = (const char*)g.Bt + (size_t)cur.pn * tstep;
    S.a_ready(cur);
    if constexpr (SP2) {
        PG8_STAGE(PG8_SB(0, 0), cB, voffB); PG8_STAGE(PG8_SB(0, 1), cB + hstep, voffB); PG8_STAGE(PG8_SA(0, 0), cA, voffA); PG8_STAGE(PG8_SA(0, 1), cA + hstep, voffA);
        if (wr == 1) PG8_BAR;
        PG8_WAIT_V(2); PG8_BAR;
        PG8_STAGE(PG8_SB(1, 0), cB + kstep, voffB); PG8_STAGE(PG8_SA(1, 0), cA + kstep, voffA); PG8_STAGE(PG8_SB(1, 1), cB + hstep + kstep, voffB);
        PG8_WAIT_V(6); PG8_BAR;
    } else {
        PG8_STAGE(PG8_SB(0, 0), cB, voffB); PG8_STAGE(PG8_SA(0, 0), cA, voffA); PG8_STAGE(PG8_SB(0, 1), cB + hstep, voffB); PG8_STAGE(PG8_SA(0, 1), cA + hstep, voffA);
        if (wr == 1) PG8_BAR;
        PG8_WAIT_V(4); PG8_BAR;
        PG8_STAGE(PG8_SB(1, 0), cB + kstep, voffB); PG8_STAGE(PG8_SA(1, 0), cA + kstep, voffA); PG8_STAGE(PG8_SB(1, 1), cB + hstep + kstep, voffB);
        PG8_WAIT_V(6); PG8_BAR;
    }
    for (;;) {
        const bool has_next = S.next(ui + 1, nxt);
        const char* nA = has_next ? (const char*)g.A + (size_t)nxt.pm * tstep : cA; const char* nB = has_next ? (const char*)g.Bt + (size_t)nxt.pn * tstep : cB;
        for (int t = 0; t < nt; t += 2) {
            const bool last = (t == nt - 2);
            const char* a1 = cA + (size_t)(t + 1) * kstep;
            const char* a2 = last ? nA : cA + (size_t)(t + 2) * kstep; const char* b2 = last ? nB : cB + (size_t)(t + 2) * kstep;
            const char* a3 = a2 + kstep; const char* b3 = b2 + kstep;
            if (last && has_next) S.a_ready(nxt);
            if constexpr (SP2) {
            PG8_LDB(B0, 0, 0); PG8_LDB(B1, 0, 1); PG8_SCHED; PG8_LDA(At, 0, 0); PG8_STAGE(PG8_SA(1, 1), a1 + hstep, voffA);
            PG8_WAIT_V(8); PG8_WAIT_L(0); PG8_BAR; PG8_MMA(0, 0, At, B0); PG8_MMA(0, 1, At, B1); PG8_BAR; PG8_SCHED;
            PG8_LDA(At, 0, 1); PG8_STAGE(PG8_SB(0, 0), b2, voffB); PG8_STAGE(PG8_SB(0, 1), b2 + hstep, voffB); PG8_STAGE(PG8_SA(0, 0), a2, voffA);
            PG8_WAIT_V(8); PG8_WAIT_L(0); PG8_BAR; PG8_MMA(1, 0, At, B0); PG8_MMA(1, 1, At, B1); PG8_BAR; PG8_SCHED;
            PG8_LDB(B0, 1, 0); PG8_LDB(B1, 1, 1); PG8_SCHED; PG8_LDA(At, 1, 0); PG8_STAGE(PG8_SA(0, 1), a2 + hstep, voffA);
            PG8_WAIT_V(8); PG8_WAIT_L(0); PG8_BAR; PG8_MMA(0, 0, At, B0); PG8_MMA(0, 1, At, B1); PG8_BAR; PG8_SCHED;
            PG8_LDA(At, 1, 1); PG8_STAGE(PG8_SB(1, 0), b3, voffB); PG8_STAGE(PG8_SB(1, 1), b3 + hstep, voffB); PG8_STAGE(PG8_SA(1, 0), a3, voffA);
            PG8_WAIT_V(8); PG8_WAIT_L(0); PG8_BAR; PG8_MMA(1, 0, At, B0); PG8_MMA(1, 1, At, B1); PG8_BAR; PG8_SCHED;
            } else {
            PG8_LDB(B0, 0, 0); PG8_SCHED; PG8_LDA(At, 0, 0); PG8_STAGE(PG8_SA(1, 1), a1 + hstep, voffA);
            PG8_WAIT_L(8); PG8_BAR; PG8_WAIT_L(0); PG8_MMA(0, 0, At, B0); PG8_BAR; PG8_SCHED;
            PG8_LDB(B1, 0, 1); PG8_STAGE(PG8_SB(0, 0), b2, voffB);
            PG8_BAR; PG8_WAIT_L(0); PG8_MMA(0, 1, At, B1); PG8_BAR;
            PG8_LDA(At, 0, 1); PG8_STAGE(PG8_SA(0, 0), a2, voffA);
            PG8_BAR; PG8_WAIT_L(0); PG8_MMA(1, 0, At, B0); PG8_BAR; PG8_SCHED;
            PG8_STAGE(PG8_SB(0, 1), b2 + hstep, voffB);
            PG8_WAIT_V(6); PG8_BAR; PG8_MMA(1, 1, At, B1); PG8_BAR;
            PG8_LDB(B0, 1, 0); PG8_SCHED; PG8_LDA(At, 1, 0); PG8_STAGE(PG8_SA(0, 1), a2 + hstep, voffA);
            PG8_WAIT_L(8); PG8_BAR; PG8_WAIT_L(0); PG8_MMA(0, 0, At, B0); PG8_BAR; PG8_SCHED;
            PG8_LDB(B1, 1, 1); PG8_STAGE(PG8_SB(1, 0), b3, voffB);
            PG8_BAR; PG8_WAIT_L(0); PG8_MMA(0, 1, At, B1); PG8_BAR;
            PG8_LDA(At, 1, 1); PG8_STAGE(PG8_SA(1, 0), a3, voffA);
            PG8_BAR; PG8_WAIT_L(0); PG8_MMA(1, 0, At, B0); PG8_BAR; PG8_SCHED;
            PG8_STAGE(PG8_SB(1, 1), b3 + hstep, voffB);
            PG8_WAIT_V(6); PG8_BAR; PG8_MMA(1, 1, At, B1); PG8_BAR;
            }
        }
        if constexpr (ALIGN_EPI) { if (wr == 0) PG8_BAR; }
        if constexpr (!Epi::AFTER_DRAIN) { E(acc, cur, wr, wc, fr, fq); S.done(cur); }
        if (!has_next) break;
#pragma unroll
        for (int a = 0; a < 2; ++a)
#pragma unroll
            for (int b = 0; b < 2; ++b)
#pragma unroll
                for (int m = 0; m < 4; ++m)
#pragma unroll
                    for (int n = 0; n < 2; ++n) acc[a][b][m][n] = (f32x4){0.f, 0.f, 0.f, 0.f};
        cur = nxt; cA = nA; cB = nB; ++ui;
        if constexpr (ALIGN_EPI) { if (wr == 1) PG8_BAR; }
    }
    PG8_WAIT_V(0);
    if constexpr (!ALIGN_EPI) { if (wr == 0) PG8_BAR; }
    PG8_BAR;
    if constexpr (Epi::AFTER_DRAIN) { E.fused(acc, cur, wr, wc, fr, fq, lds, wid, lane); S.done(cur); }
#undef PG8_SA
#undef PG8_SB
#undef PG8_STAGE
#undef PG8_LDA
#undef PG8_LDB
#undef PG8_MMA
#undef PG8_WAIT_V
#undef PG8_WAIT_L
#undef PG8_BAR
#undef PG8_SCHED
}
}

#ifndef PG8_SP2
#define PG8_SP2 true
#endif
#ifndef PG8_ALIGN
#define PG8_ALIGN true
#endif
#ifndef MK_PER_PHASE
#define MK_PER_PHASE 1
#endif

constexpr int DM = 2048, BATCH = 8, SEQ = 4096, MTOK = BATCH * SEQ, DEPTH = 4, DFF = 5632, NUP = 2 * DFF, NIN = 6160, NINP = 6400, NQKV = 6144;
constexpr int NWAVES = 8;
constexpr int NSUB = 3 * DEPTH;
constexpr int NPHASE = 2 + 5 * NSUB;

constexpr size_t MiB = 1u << 20;
constexpr size_t WS_CTL = 0, CTL_ZERO_BYTES = 5 * MiB;
constexpr size_t WS_SS = 1 * MiB;
constexpr size_t WS_WUP = 8 * MiB;
constexpr size_t WS_WDN = WS_WUP + 352 * MiB;
constexpr size_t WS_WIN = WS_WDN + 176 * MiB;
constexpr size_t WS_WOUT = WS_WIN + 100 * MiB;
constexpr size_t WS_HB = WS_WOUT + 32 * MiB;
constexpr size_t WS_ACT = WS_HB + 128 * MiB;
constexpr size_t WS_P1 = WS_ACT + 352 * MiB;
constexpr size_t WS_G = WS_P1 + 384 * MiB;
constexpr size_t WS_HRAW = WS_G + 2 * MiB;
constexpr size_t WS_HM = WS_HRAW + 256 * MiB;
constexpr size_t WS_CF = WS_HM + 128 * MiB;
constexpr size_t WS_END = WS_CF + 2 * MiB;
static_assert((size_t)8 * NUP * DM * 2 == 352 * MiB && (size_t)8 * DM * DFF * 2 == 176 * MiB && (size_t)4 * NINP * DM * 2 == 100 * MiB, "weight regions");
static_assert((size_t)MTOK * DFF * 2 == 352 * MiB && (size_t)MTOK * NQKV * 2 == 384 * MiB && WS_SS + 13 * (size_t)MTOK * 8 <= CTL_ZERO_BYTES, "activation regions");
constexpr int CW_BAR = 4096;

constexpr int LDS_BYTES = 153600, MISC_OFF = 152576;

#define GAS __attribute__((address_space(1)))
#define LAS __attribute__((address_space(3)))
#define DI __device__ __forceinline__
typedef unsigned short bf16;
typedef unsigned v4u __attribute__((ext_vector_type(4)));
typedef unsigned v2u __attribute__((ext_vector_type(2)));
typedef float f32x4 __attribute__((ext_vector_type(4)));
typedef short bf16x8 __attribute__((ext_vector_type(8)));
typedef GAS unsigned gu32;
#define RLX_AGENT __ATOMIC_RELAXED, __HIP_MEMORY_SCOPE_AGENT
#define LDS_WAIT() asm volatile("s_waitcnt lgkmcnt(0)" ::: "memory")
DI unsigned f2bf(float f) { unsigned u = __builtin_bit_cast(unsigned, f); return (u + 0x7fffu + ((u >> 16) & 1u)) >> 16; }
DI unsigned pk2(float lo, float hi) { return f2bf(lo) | (f2bf(hi) << 16); }
DI float bf2f(unsigned short v) { return __builtin_bit_cast(float, (unsigned)v << 16); }
DI float bflo(unsigned w) { return __builtin_bit_cast(float, w << 16); }
DI float bfhi(unsigned w) { return __builtin_bit_cast(float, w & 0xffff0000u); }
DI float logsig(float x) { return fminf(x, 0.f) - log1pf(expf(-fabsf(x))); }

#define XB_TMO      128
#define XB_XCNT(j)  (256  + 64 * (j))
#define XB_XSUB(j)  (1280 + 64 * (j))
#define XB_XGEN(j)  (2304 + 64 * (j))
#define XB_TOP      3328
#define XB_TOPGEN   3392
#define XCD_BAR_WORDS 3456
#define XB_SPIN_CAP (1u << 18)

__device__ __forceinline__ unsigned xb_ld(unsigned* p)              { return __hip_atomic_load(p, __ATOMIC_RELAXED, __HIP_MEMORY_SCOPE_AGENT); }
__device__ __forceinline__ unsigned xb_add(unsigned* p, unsigned v) { return __hip_atomic_fetch_add(p, v, __ATOMIC_RELAXED, __HIP_MEMORY_SCOPE_AGENT); }
__device__ __forceinline__ unsigned xb_xcc_id() { return (unsigned)__builtin_amdgcn_s_getreg((3 << 11) | 20) & 0xFu; }
#define XB_SPIN(cond, bar) do { unsigned _sp = 0; while (cond) { __builtin_amdgcn_s_sleep(1); \
    if ((++_sp & 255u) == 0u) { if (xb_ld(&(bar)[XB_TMO])) break; if (_sp > XB_SPIN_CAP) { atomicAdd(&(bar)[XB_TMO], 1u); break; } } } } while (0)

struct XcdBarrier {
    unsigned* bar; unsigned x;
    volatile LAS unsigned* st;
};

__device__ __forceinline__ XcdBarrier xcd_barrier_post(unsigned* bar, volatile LAS unsigned* st) {
    XcdBarrier b; b.bar = bar; b.x = xb_xcc_id(); b.st = st;
    if (threadIdx.x == 0) (void)xb_add(&bar[XB_XCNT(b.x)], 1u);
    return b;
}
__device__ __forceinline__ void xcd_barrier_complete(unsigned* bar, unsigned x, unsigned& nloc, unsigned& nx) {
    const unsigned G = gridDim.x * gridDim.y * gridDim.z;
    unsigned sum, cnt, mine, sp = 0u;
    for (;;) {
        sum = 0u; cnt = 0u; mine = 0u;
#pragma unroll
        for (unsigned j = 0; j < 16; ++j) { const unsigned c = xb_ld(&bar[XB_XCNT(j)]); sum += c; cnt += (c > 0u) ? 1u : 0u; mine = (j == x) ? c : mine; }
        if (sum == G) break;
        __builtin_amdgcn_s_sleep(1);
        if ((++sp & 255u) == 0u) { if (xb_ld(&bar[XB_TMO])) break; if (sp > XB_SPIN_CAP) { atomicAdd(&bar[XB_TMO], 1u); break; } }
    }
    nloc = mine > 0u ? mine : 1u; nx = cnt > 0u ? cnt : 1u;
}

__device__ __forceinline__ void xcd_barrier(const XcdBarrier& b) {
    asm volatile("s_waitcnt vmcnt(0)" ::: "memory");
    __syncthreads();
    if (threadIdx.x == 0) {
        unsigned* bar = b.bar;
        __builtin_amdgcn_s_waitcnt(0);
        unsigned nloc = b.st[0], nx = b.st[1];
        if (nloc == 0u) { xcd_barrier_complete(bar, b.x, nloc, nx); b.st[0] = nloc; b.st[1] = nx; }
        const unsigned old = xb_add(&bar[XB_XSUB(b.x)], 1u);
        const unsigned gen = old / nloc;
        if (old + 1u == (gen + 1u) * nloc) {
            __builtin_amdgcn_fence(__ATOMIC_RELEASE, "agent");
            asm volatile("s_waitcnt vmcnt(0)" ::: "memory");
            const unsigned og = xb_add(&bar[XB_TOP], 1u);
            const unsigned tg = og / nx;
            if (og + 1u == (tg + 1u) * nx) xb_add(&bar[XB_TOPGEN], 1u);
            else XB_SPIN(xb_ld(&bar[XB_TOPGEN]) == tg, bar);
            __builtin_amdgcn_fence(__ATOMIC_ACQUIRE, "agent");
            xb_add(&bar[XB_XGEN(b.x)], 1u);
            asm volatile("s_waitcnt vmcnt(0)" ::: "memory");
        } else {
            XB_SPIN(xb_ld(&bar[XB_XGEN(b.x)]) == gen, bar);
            __builtin_amdgcn_fence(__ATOMIC_ACQUIRE, "agent");
            asm volatile("s_waitcnt vmcnt(0)" ::: "memory");
        }
    }
    __syncthreads();
}


DI float wave_sum(float v) {
#pragma unroll
    for (int o = 1; o < 64; o <<= 1) v += __shfl_xor(v, o);
    return v;
}
DI float wave_max(float v) {
#pragma unroll
    for (int o = 1; o < 64; o <<= 1) v = fmaxf(v, __shfl_xor(v, o));
    return v;
}
DI float wave_incl_sum(float v, int lane) {
#pragma unroll
    for (int o = 1; o < 64; o <<= 1) { const float t = __shfl_up(v, o); if (lane >= o) v += t; }
    return v;
}
DI float wave_incl_max(float v, int lane) {
#pragma unroll
    for (int o = 1; o < 64; o <<= 1) { const float t = __shfl_up(v, o); if (lane >= o) v = fmaxf(v, t); }
    return v;
}

template <int L> DI int swx(int r) { return L == 64 ? ((r >> 1) & 7) : (r & 15); }
template <int L> DI int eoff(int r, int c) { return r * L + ((((c >> 3) ^ swx<L>(r)) << 3) | (c & 7)); }
template <int L> DI bf16x8 ldf(const LAS bf16* base, int r, int ch) { return *(const LAS bf16x8*)(base + r * L + ((ch ^ swx<L>(r)) << 3)); }
DI f32x4 mfma16(bf16x8 a, bf16x8 b, f32x4 c) { return __builtin_amdgcn_mfma_f32_16x16x32_bf16(a, b, c, 0, 0, 0); }
template <int LA, int LB, int NK> DI void mma_tile(f32x4& acc, const LAS bf16* A, int ra0, const LAS bf16* B, int rb0, int lane) {
    const int r = lane & 15, g = lane >> 4;
#pragma unroll
    for (int kk = 0; kk < NK; ++kk) { const bf16x8 a = ldf<LA>(A, ra0 + r, 4 * kk + g), b = ldf<LB>(B, rb0 + r, 4 * kk + g); acc = mfma16(a, b, acc); }
}

DI void conv_item(const float* W, int K, int N, int nblk, const float* gk, bf16* WT, int mode, LAS float* scr, int item, int lane) {
    const int kb = item / nblk, nb = item - kb * nblk, k0 = 64 * kb, n0 = 32 * nb;
    const int n = n0 + (lane & 31); const bool ok = n < N;
#pragma unroll 8
    for (int i = 0; i < 32; ++i) { const int kk = 2 * i + (lane >> 5); float v = ok ? W[(size_t)(k0 + kk) * N + n] : 0.f; if (gk) v *= gk[k0 + kk]; scr[kk * 33 + (lane & 31)] = v; }
    LDS_WAIT(); asm volatile("" ::: "memory");
    int row_off = n0;
    if (mode == 1) { const int j = n0 < DFF ? n0 : n0 - DFF; row_off = 256 * (j >> 7) + (j & 127) + (n0 < DFF ? 0 : 128); }
    const int c = lane & 7;
#pragma unroll
    for (int j = 0; j < 4; ++j) { const int nn = (lane >> 3) + 8 * j; const LAS float* s = scr + (8 * c) * 33 + nn;
        v4u o; o.x = pk2(s[0 * 33], s[1 * 33]); o.y = pk2(s[2 * 33], s[3 * 33]); o.z = pk2(s[4 * 33], s[5 * 33]); o.w = pk2(s[6 * 33], s[7 * 33]);
        *(v4u*)(WT + (size_t)(row_off + nn) * K + k0 + 8 * c) = o; }
    LDS_WAIT(); asm volatile("" ::: "memory");
}

struct Args { const float* in[18]; float* out; unsigned char* ws; int ph_lo, ph_hi; };

typedef const __attribute__((address_space(4))) Args* KArgs;
DI KArgs kargs() { KArgs p = (KArgs)__builtin_amdgcn_kernarg_segment_ptr(); asm volatile("" : "+s"(p)); return p; }
DI void prologue(LAS unsigned char* lds, int lane, int wave, int bx) {
    KArgs AP = kargs();
    LAS float* scr = (LAS float*)(lds + wave * 16384);
    const int gw = bx * NWAVES + wave, NGW = gridDim.x * NWAVES;
    unsigned char* ws = AP->ws;
    constexpr int I_UP = (DM / 64) * (NUP / 32), I_DN = (DFF / 64) * (DM / 32), I_IN = (DM / 64) * (NINP / 32), I_OUT = (DM / 64) * (DM / 32);
    constexpr int NITEMS = 8 * I_UP + 8 * I_DN + 4 * I_IN + 4 * I_OUT;
    for (int it = gw; it < NITEMS; it += NGW) {
        int r = it; const float* W; const float* gk = nullptr; bf16* WT; int K = DM, N, nblk, mode = 0;
        if (r < 8 * I_UP) { const int mi = r / I_UP; r -= mi * I_UP; W = AP->in[2] + (size_t)mi * DM * NUP; gk = AP->in[1] + (size_t)mi * DM; WT = (bf16*)(ws + WS_WUP) + (size_t)mi * NUP * DM; N = NUP; nblk = NUP / 32; mode = 1; }
        else if (r < 8 * I_UP + 8 * I_DN) { r -= 8 * I_UP; const int mi = r / I_DN; r -= mi * I_DN; W = AP->in[3] + (size_t)mi * DFF * DM; WT = (bf16*)(ws + WS_WDN) + (size_t)mi * DM * DFF; K = DFF; N = DM; nblk = DM / 32; }
        else if (r < 8 * I_UP + 8 * I_DN + 4 * I_IN) { r -= 8 * I_UP + 8 * I_DN; const int l = r / I_IN; r -= l * I_IN; const int kind = l % 3, ji = l / 3;
            W = AP->in[kind == 0 ? 5 : kind == 1 ? 9 : 12] + (size_t)ji * DM * NIN; gk = AP->in[4] + (size_t)l * DM; WT = (bf16*)(ws + WS_WIN) + (size_t)l * NINP * DM; N = NIN; nblk = NINP / 32; }
        else { r -= 8 * I_UP + 8 * I_DN + 4 * I_IN; const int l = r / I_OUT; r -= l * I_OUT; const int kind = l % 3, ji = l / 3;
            W = AP->in[kind == 0 ? 8 : kind == 1 ? 11 : 16] + (size_t)ji * DM * DM; WT = (bf16*)(ws + WS_WOUT) + (size_t)l * DM * DM; N = DM; nblk = DM / 32; }
        conv_item(W, K, N, nblk, gk, WT, mode, scr, r, lane);
    }
    const float* x = AP->in[0]; bf16* hb = (bf16*)(ws + WS_HB); long long* ss0 = (long long*)(ws + WS_SS);
    for (int m = gw; m < MTOK; m += NGW) {
        const f32x4* xr = (const f32x4*)(x + (size_t)m * DM) + lane; f32x4 v[8]; float s = 0.f;
#pragma unroll
        for (int j = 0; j < 8; ++j) { v[j] = xr[64 * j]; s += (v[j].x * v[j].x + v[j].y * v[j].y) + (v[j].z * v[j].z + v[j].w * v[j].w); }
        s = wave_sum(s);
        v2u* o8 = (v2u*)(hb + (size_t)m * DM) + lane;
#pragma unroll
        for (int j = 0; j < 8; ++j) { v2u w; w.x = pk2(v[j].x, v[j].y); w.y = pk2(v[j].z, v[j].w); o8[64 * j] = w; }
        if (lane == 0) ss0[m] = __float2ll_rn(s * 1048576.0f);
    }
}

DI void mlstm_scan(LAS unsigned char* lds, const bf16* P1, const float* G, const float* b_if, float* hraw, int tid, int lane, int wave, int bx) {
    LAS bf16* Qs = (LAS bf16*)lds;
    LAS bf16* Ks = Qs + 64 * 128;
    LAS bf16* KTs = Ks + 64 * 128;
    LAS bf16* VTs = KTs + 128 * 64;
    LAS bf16* Ps = VTs + 64 * 64;
    LAS bf16* CTs = Ps + 64 * 64;
    LAS float* fa = (LAS float*)(CTs + 64 * 128);
    LAS float *bcum = fa, *ipre = fa + 64, *mrow = fa + 128, *interw = fa + 192, *wsv = fa + 256, *dinv = fa + 320, *nvec = fa + 384, *scal = fa + 512;
    const float KSCALE = 0.08838834764831845f;
    const int g = lane >> 4, r16 = lane & 15;
    for (int item = bx; item < 256; item += gridDim.x) {
        const int b = item >> 5, h = (item >> 2) & 7, sl = item & 3;
        f32x4 Cacc[4];
#pragma unroll
        for (int e = 0; e < 4; ++e) Cacc[e] = (f32x4){0.f, 0.f, 0.f, 0.f};
        __syncthreads();
        ((LAS v4u*)CTs)[tid] = (v4u){0u, 0u, 0u, 0u}; ((LAS v4u*)CTs)[tid + 512] = (v4u){0u, 0u, 0u, 0u};
        if (tid < 128) nvec[tid] = 0.f;
        float m_prev = 0.f;
        for (int c = 0; c < 64; ++c) {
            const int row0 = b * SEQ + c * 64;
            __syncthreads();
            if (tid < 64) { const float* gp = G + (size_t)(row0 + tid) * 16; ipre[tid] = gp[h] + b_if[h]; bcum[tid] = logsig(gp[8 + h] + b_if[8 + h]); }
#pragma unroll
            for (int p = 0; p < 2; ++p) { const int idx = tid + 512 * p, r = idx >> 4, c8 = idx & 15; const bf16* src = P1 + (size_t)(row0 + r) * NQKV + h * 128 + c8 * 8;
                const v4u vq = *(const v4u*)src, vk = *(const v4u*)(src + 1024);
                *(LAS v4u*)(Qs + eoff<128>(r, c8 * 8)) = vq; *(LAS v4u*)(Ks + eoff<128>(r, c8 * 8)) = vk; }
            { const int r = tid >> 3, c8 = tid & 7; const v4u vv = *(const v4u*)(P1 + (size_t)(row0 + r) * NQKV + 2048 + h * 256 + sl * 64 + c8 * 8);
#pragma unroll
              for (int j = 0; j < 4; ++j) { VTs[eoff<64>(c8 * 8 + 2 * j, r)] = (bf16)(vv[j] & 0xffffu); VTs[eoff<64>(c8 * 8 + 2 * j + 1, r)] = (bf16)(vv[j] >> 16); } }
            __syncthreads();
            if (wave == 0) {
                const float bt = wave_incl_sum(bcum[lane], lane), ip = ipre[lane];
                const float am = wave_incl_max(ip - bt, lane);
                const float mt = fmaxf(bt + m_prev, bt + am);
                const float blast = __shfl(bt, 63);
                const float gg = blast - bt + ip;
                const float m_new = fmaxf(blast + m_prev, wave_max(gg));
                bcum[lane] = bt; mrow[lane] = mt; interw[lane] = expf(bt + m_prev - mt); wsv[lane] = expf(gg - m_new);
                if (lane == 0) scal[0] = expf(blast + m_prev - m_new);
                m_prev = m_new;
            }
            __syncthreads();
#pragma unroll
            for (int p = 0; p < 2; ++p) { const int idx = tid + 512 * p, s = idx >> 4, c8 = idx & 15; const v4u kv = *(const LAS v4u*)(Ks + eoff<128>(s, c8 * 8)); const float w = wsv[s] * KSCALE;
#pragma unroll
                for (int j = 0; j < 4; ++j) { KTs[eoff<64>(c8 * 8 + 2 * j, s)] = (bf16)f2bf(bflo(kv[j]) * w); KTs[eoff<64>(c8 * 8 + 2 * j + 1, s)] = (bf16)f2bf(bfhi(kv[j]) * w); } }
            const int tt = wave >> 1;
#pragma unroll
            for (int q2 = 0; q2 < 2; ++q2) { const int st = 2 * (wave & 1) + q2; f32x4 acc = (f32x4){0.f, 0.f, 0.f, 0.f};
                if (st <= tt) mma_tile<128, 128, 4>(acc, Qs, 16 * tt, Ks, 16 * st, lane);
                const int s = 16 * st + r16; const float cs = ipre[s] - bcum[s];
#pragma unroll
                for (int i = 0; i < 4; ++i) { const int t = 16 * tt + 4 * g + i; const float p = (s <= t) ? acc[i] * KSCALE * expf(bcum[t] + cs - mrow[t]) : 0.f; Ps[eoff<64>(t, s)] = (bf16)f2bf(p); } }
            __syncthreads();
#pragma unroll
            for (int rr = 0; rr < 8; ++rr) { const int t = wave * 8 + rr;
                float ps = bf2f(Ps[eoff<64>(t, lane)]);
                float qn = bf2f(Qs[eoff<128>(t, lane)]) * nvec[lane] + bf2f(Qs[eoff<128>(t, lane + 64)]) * nvec[lane + 64];
                ps = wave_sum(ps); qn = wave_sum(qn);
                if (lane == 0) { const float den = ps + interw[t] * qn; dinv[t] = 1.0f / fmaxf(fabsf(den), expf(-mrow[t])); } }
            f32x4 a1[2], a2[2];
#pragma unroll
            for (int q2 = 0; q2 < 2; ++q2) { const int et = 2 * (wave & 1) + q2; a1[q2] = (f32x4){0.f, 0.f, 0.f, 0.f}; a2[q2] = (f32x4){0.f, 0.f, 0.f, 0.f};
                mma_tile<64, 64, 2>(a1[q2], Ps, 16 * tt, VTs, 16 * et, lane); mma_tile<128, 128, 4>(a2[q2], Qs, 16 * tt, CTs, 16 * et, lane); }
            __syncthreads();
#pragma unroll
            for (int q2 = 0; q2 < 2; ++q2) { const int et = 2 * (wave & 1) + q2, e = 16 * et + r16;
#pragma unroll
                for (int i = 0; i < 4; ++i) { const int t = 16 * tt + 4 * g + i; hraw[(size_t)(row0 + t) * DM + h * 256 + sl * 64 + e] = (a1[q2][i] + interw[t] * a2[q2][i]) * dinv[t]; } }
            const float wcs = scal[0];
#pragma unroll
            for (int et = 0; et < 4; ++et) { Cacc[et] = Cacc[et] * wcs; mma_tile<64, 64, 2>(Cacc[et], KTs, 16 * wave, VTs, 16 * et, lane);
                v2u w; w.x = pk2(Cacc[et][0], Cacc[et][1]); w.y = pk2(Cacc[et][2], Cacc[et][3]);
                *(LAS v2u*)(CTs + eoff<128>(16 * et + r16, 16 * wave + 4 * g)) = w; }
            if (tid < 128) { float a = wcs * nvec[tid];
#pragma unroll 8
                for (int s = 0; s < 64; ++s) a += wsv[s] * KSCALE * bf2f(Ks[eoff<128>(s, tid)]);
                nvec[tid] = a; }
        }
    }
}

DI void gla_scan(LAS unsigned char* lds, const bf16* P1, const float* G, const float* w_alpha, const float* b_alpha, float* hraw, int tid, int lane, int wave, int bx) {
    LAS bf16* QTs = (LAS bf16*)lds;
    LAS bf16* KTl = QTs + 64 * 256;
    LAS bf16* KTT = KTl + 64 * 256;
    LAS bf16* STs = KTT + 256 * 64;
    LAS bf16* VTs = STs + 64 * 256;
    LAS bf16* Ps = VTs + 64 * 64;
    LAS float* alow = (LAS float*)(Ps + 64 * 64);
    LAS float* eb = alow + 1024;
    const int g = lane >> 4, r16 = lane & 15;
    for (int item = bx; item < 256; item += gridDim.x) {
        const int b = item >> 5, h = (item >> 3) & 3, sl = item & 7;
        f32x4 Sacc[2][4];
#pragma unroll
        for (int a = 0; a < 2; ++a)
#pragma unroll
            for (int e = 0; e < 4; ++e) Sacc[a][e] = (f32x4){0.f, 0.f, 0.f, 0.f};
        __syncthreads();
#pragma unroll
        for (int i = 0; i < 4; ++i) ((LAS v4u*)STs)[tid + 512 * i] = (v4u){0u, 0u, 0u, 0u};
        float wa[16]; float ba = 0.f;
        if (tid < 256) {
#pragma unroll
            for (int i = 0; i < 16; ++i) wa[i] = w_alpha[i * 1024 + h * 256 + tid];
            ba = b_alpha[h * 256 + tid]; }
        else {
#pragma unroll
            for (int i = 0; i < 16; ++i) wa[i] = 0.f; }
        for (int c = 0; c < 64; ++c) {
            const int row0 = b * SEQ + c * 64;
            __syncthreads();
            if (tid < 256) { *(LAS f32x4*)(alow + tid * 4) = *(const f32x4*)(G + (size_t)(row0 + (tid >> 2)) * 16 + (tid & 3) * 4); }
            else { const int u = tid - 256, r = u >> 2, c16 = u & 3; const bf16* src = P1 + (size_t)(row0 + r) * NQKV + 2048 + h * 512 + sl * 64 + c16 * 16;
                const v4u v0 = *(const v4u*)src, v1 = *(const v4u*)(src + 8);
#pragma unroll
                for (int j = 0; j < 4; ++j) { VTs[eoff<64>(c16 * 16 + 2 * j, r)] = (bf16)(v0[j] & 0xffffu); VTs[eoff<64>(c16 * 16 + 2 * j + 1, r)] = (bf16)(v0[j] >> 16);
                                              VTs[eoff<64>(c16 * 16 + 8 + 2 * j, r)] = (bf16)(v1[j] & 0xffffu); VTs[eoff<64>(c16 * 16 + 8 + 2 * j + 1, r)] = (bf16)(v1[j] >> 16); } }
            __syncthreads();
            if (tid < 256) { const int d = tid; float bsum = 0.f;
                const bf16* qsrc = P1 + (size_t)row0 * NQKV + h * 256 + d;
                for (int s8 = 0; s8 < 8; ++s8) {
                    unsigned short qraw[8], kraw[8];
#pragma unroll
                    for (int j = 0; j < 8; ++j) { qraw[j] = qsrc[(size_t)(8 * s8 + j) * NQKV]; kraw[j] = qsrc[(size_t)(8 * s8 + j) * NQKV + 1024]; }
                    unsigned kk[8];
#pragma unroll
                    for (int j = 0; j < 8; ++j) { const int s = 8 * s8 + j; float z = ba;
#pragma unroll
                        for (int i = 0; i < 16; ++i) z += alow[s * 16 + i] * wa[i];
                        bsum += logsig(z) * (1.0f / 16.0f);
                        const float e = expf(bsum), ei = expf(-bsum);
                        QTs[eoff<256>(s, d)] = (bf16)f2bf(bf2f(qraw[j]) * 0.0625f * e);
                        kk[j] = f2bf(bf2f(kraw[j]) * ei); KTl[eoff<256>(s, d)] = (bf16)kk[j]; }
                    v4u w; w.x = kk[0] | (kk[1] << 16); w.y = kk[2] | (kk[3] << 16); w.z = kk[4] | (kk[5] << 16); w.w = kk[6] | (kk[7] << 16);
                    *(LAS v4u*)(KTT + eoff<64>(d, 8 * s8)) = w;
                }
                eb[d] = expf(bsum);
            }
            __syncthreads();
            const int tt = wave >> 1;
#pragma unroll
            for (int q2 = 0; q2 < 2; ++q2) { const int st = 2 * (wave & 1) + q2; f32x4 acc = (f32x4){0.f, 0.f, 0.f, 0.f};
                if (st <= tt) mma_tile<256, 256, 8>(acc, QTs, 16 * tt, KTl, 16 * st, lane);
                const int s = 16 * st + r16;
#pragma unroll
                for (int i = 0; i < 4; ++i) { const int t = 16 * tt + 4 * g + i; Ps[eoff<64>(t, s)] = (bf16)f2bf((s <= t) ? acc[i] : 0.f); } }
            __syncthreads();
#pragma unroll
            for (int q2 = 0; q2 < 2; ++q2) { const int et = 2 * (wave & 1) + q2, e = 16 * et + r16; f32x4 acc = (f32x4){0.f, 0.f, 0.f, 0.f};
                mma_tile<64, 64, 2>(acc, Ps, 16 * tt, VTs, 16 * et, lane); mma_tile<256, 256, 8>(acc, QTs, 16 * tt, STs, 16 * et, lane);
#pragma unroll
                for (int i = 0; i < 4; ++i) { const int t = 16 * tt + 4 * g + i; hraw[(size_t)(row0 + t) * DM + h * 512 + sl * 64 + e] = acc[i]; } }
            __syncthreads();
#pragma unroll
            for (int a = 0; a < 2; ++a) { const int dt = 2 * wave + a;
                const f32x4 ev = *(const LAS f32x4*)(eb + 16 * dt + 4 * g);
#pragma unroll
                for (int et = 0; et < 4; ++et) { mma_tile<64, 64, 2>(Sacc[a][et], KTT, 16 * dt, VTs, 16 * et, lane); Sacc[a][et] = Sacc[a][et] * ev;
                    v2u w; w.x = pk2(Sacc[a][et][0], Sacc[a][et][1]); w.y = pk2(Sacc[a][et][2], Sacc[a][et][3]);
                    *(LAS v2u*)(STs + eoff<256>(16 * et + r16, 16 * dt + 4 * g)) = w; } }
        }
    }
}

template <int HS, int ACT> DI void headnorm_gate(const float* hraw, const bf16* P1, const float* gnorm, bf16* hm, int lane, int wave, int bx) {
    constexpr int NH = DM / HS, EPL = HS / 64;
    const int gw = bx * NWAVES + wave, NGW = gridDim.x * NWAVES;
    for (int row = gw; row < MTOK; row += NGW) {
#pragma unroll
        for (int hh = 0; hh < NH; ++hh) { const int col = hh * HS + lane * EPL;
            float x[EPL]; float s = 0.f;
#pragma unroll
            for (int j = 0; j < EPL; j += 4) { const f32x4 v = *(const f32x4*)(hraw + (size_t)row * DM + col + j); x[j] = v.x; x[j + 1] = v.y; x[j + 2] = v.z; x[j + 3] = v.w; s += (v.x * v.x + v.y * v.y) + (v.z * v.z + v.w * v.w); }
            s = wave_sum(s); const float rs = rsqrtf(s * (1.0f / HS) + 1e-6f);
            unsigned outw[EPL / 2];
#pragma unroll
            for (int j = 0; j < EPL; j += 2) { const unsigned gw2 = *(const unsigned*)(P1 + (size_t)row * NQKV + 4096 + col + j); const float g0 = bflo(gw2), g1 = bfhi(gw2);
                const float a0 = ACT == 0 ? 1.0f / (1.0f + expf(-g0)) : g0 / (1.0f + expf(-g0)), a1 = ACT == 0 ? 1.0f / (1.0f + expf(-g1)) : g1 / (1.0f + expf(-g1));
                outw[j / 2] = pk2(x[j] * rs * gnorm[col + j] * a0, x[j + 1] * rs * gnorm[col + j + 1] * a1); }
            if constexpr (EPL == 4) { v2u w; w.x = outw[0]; w.y = outw[1]; *(v2u*)(hm + (size_t)row * DM + col) = w; }
            else { v4u w; w.x = outw[0]; w.y = outw[1]; w.z = outw[2]; w.w = outw[3]; *(v4u*)(hm + (size_t)row * DM + col) = w; }
        }
    }
}

DI void fox_cf(const float* G, const float* b_f, float* cf, int lane, int wave, int bx) {
    const int gw = bx * NWAVES + wave, NGW = gridDim.x * NWAVES;
    for (int seq = gw; seq < 128; seq += NGW) { const int b = seq >> 4, h = seq & 15; const float bias = b_f[h];
        const float* gp = G + ((size_t)b * SEQ + lane * 64) * 16 + h; float s = 0.f;
        for (int p = 0; p < 64; ++p) s += logsig(gp[p * 16] + bias);
        float run = wave_incl_sum(s, lane) - s;
        float* o = cf + (size_t)seq * SEQ + lane * 64;
        for (int p = 0; p < 64; ++p) { run += logsig(gp[p * 16] + bias); o[p] = run; }
    }
}

DI void fox_attn(LAS unsigned char* lds, const bf16* P1, const float* cf, bf16* hm, int tid, int lane, int wave, int bx) {
    LAS bf16* Ks = (LAS bf16*)lds;
    LAS bf16* VTs = Ks + 64 * 128;
    LAS float* cfs = (LAS float*)(VTs + 128 * 64);
    const float LOG2E = 1.4426950408889634f, QS = 0.08838834764831845f * 1.4426950408889634f;
    const int g = lane >> 4, r16 = lane & 15;
    const int G_ = gridDim.x;
    const int nit = (2048 + G_ - 1) / G_;
    for (int it = 0; it < nit; ++it) {
        const int u = (it & 1) ? it * G_ + (G_ - 1 - bx) : it * G_ + bx;
        if (u >= 2048) continue;
        const int qb = 15 - (u >> 7), bh = u & 127, b = bh >> 4, h = bh & 15;
        const size_t rowb = (size_t)b * SEQ; const int q0 = qb * 256 + 32 * wave;
        bf16x8 qf[2][4]; float cft[2];
#pragma unroll
        for (int tt = 0; tt < 2; ++tt) { const int t = q0 + 16 * tt + r16; cft[tt] = cf[(size_t)bh * SEQ + t] * LOG2E;
#pragma unroll
            for (int kk = 0; kk < 4; ++kk) { const v4u raw = *(const v4u*)(P1 + (rowb + t) * NQKV + h * 128 + 32 * kk + 8 * g); v4u sc;
#pragma unroll
                for (int j = 0; j < 4; ++j) sc[j] = pk2(bflo(raw[j]) * QS, bfhi(raw[j]) * QS);
                qf[tt][kk] = __builtin_bit_cast(bf16x8, sc); } }
        f32x4 oacc[8][2];
#pragma unroll
        for (int et = 0; et < 8; ++et) { oacc[et][0] = (f32x4){0.f, 0.f, 0.f, 0.f}; oacc[et][1] = (f32x4){0.f, 0.f, 0.f, 0.f}; }
        float mrun[2] = {-1e30f, -1e30f}, lrun[2] = {0.f, 0.f};
        const int ntiles = 4 * (qb + 1);
        v4u kreg[2], vreg[2]; float cfreg = 0.f;
        const bf16* kvbase = P1 + rowb * NQKV + 2048 + h * 128;
#define FOX_PREFETCH(j) do { _Pragma("unroll") for (int p = 0; p < 2; ++p) { const int idx = tid + 512 * p, r = idx >> 4, c8 = idx & 15; const bf16* src = kvbase + (size_t)(64 * (j) + r) * NQKV + c8 * 8; \
            kreg[p] = *(const v4u*)src; vreg[p] = *(const v4u*)(src + 2048); } if (tid < 64) cfreg = cf[(size_t)bh * SEQ + 64 * (j) + tid] * LOG2E; } while (0)
        FOX_PREFETCH(0);
        for (int j = 0; j < ntiles; ++j) {
            __syncthreads();
#pragma unroll
            for (int p = 0; p < 2; ++p) { const int idx = tid + 512 * p, r = idx >> 4, c8 = idx & 15; *(LAS v4u*)(Ks + eoff<128>(r, c8 * 8)) = kreg[p];
#pragma unroll
                for (int jj = 0; jj < 4; ++jj) { VTs[eoff<64>(c8 * 8 + 2 * jj, r)] = (bf16)(vreg[p][jj] & 0xffffu); VTs[eoff<64>(c8 * 8 + 2 * jj + 1, r)] = (bf16)(vreg[p][jj] >> 16); } }
            if (tid < 64) cfs[tid] = cfreg;
            __syncthreads();
            if (j + 1 < ntiles) FOX_PREFETCH(j + 1);
            if (64 * j <= q0 + 31) {
                f32x4 sacc[2][4];
#pragma unroll
                for (int st = 0; st < 4; ++st) { const f32x4 cv = *(const LAS f32x4*)(cfs + 16 * st + 4 * g);
#pragma unroll
                    for (int tt = 0; tt < 2; ++tt) sacc[tt][st] = (f32x4){cft[tt] - cv[0], cft[tt] - cv[1], cft[tt] - cv[2], cft[tt] - cv[3]}; }
#pragma unroll
                for (int st = 0; st < 4; ++st)
#pragma unroll
                    for (int kk = 0; kk < 4; ++kk) { const bf16x8 kf = ldf<128>(Ks, 16 * st + r16, 4 * kk + g);
                        sacc[0][st] = mfma16(kf, qf[0][kk], sacc[0][st]); sacc[1][st] = mfma16(kf, qf[1][kk], sacc[1][st]); if (kk == 3) asm volatile("" ::: "memory"); }
                if (64 * j + 63 > q0) {
#pragma unroll
                    for (int tt = 0; tt < 2; ++tt) { const int t = q0 + 16 * tt + r16;
#pragma unroll
                        for (int st = 0; st < 4; ++st)
#pragma unroll
                            for (int i = 0; i < 4; ++i) { const int s = 64 * j + 16 * st + 4 * g + i; if (s > t) sacc[tt][st][i] = -__builtin_inff(); } }
                }
#pragma unroll
                for (int tt = 0; tt < 2; ++tt) { float mx = -__builtin_inff();
#pragma unroll
                    for (int st = 0; st < 4; ++st) mx = fmaxf(mx, fmaxf(fmaxf(sacc[tt][st][0], sacc[tt][st][1]), fmaxf(sacc[tt][st][2], sacc[tt][st][3])));
                    mx = fmaxf(mx, __shfl_xor(mx, 16)); mx = fmaxf(mx, __shfl_xor(mx, 32));
                    const float mnew = fmaxf(mrun[tt], mx), alpha = __builtin_amdgcn_exp2f(mrun[tt] - mnew); mrun[tt] = mnew; float ls = 0.f;
#pragma unroll
                    for (int st = 0; st < 4; ++st)
#pragma unroll
                        for (int i = 0; i < 4; ++i) { const float p = __builtin_amdgcn_exp2f(sacc[tt][st][i] - mnew); sacc[tt][st][i] = p; ls += p; }
                    lrun[tt] = lrun[tt] * alpha + ls;
#pragma unroll
                    for (int et = 0; et < 8; ++et) oacc[et][tt] = oacc[et][tt] * alpha; }
#pragma unroll
                for (int ks = 0; ks < 2; ++ks) { bf16x8 pb[2];
#pragma unroll
                    for (int tt = 0; tt < 2; ++tt) { v4u w; w.x = pk2(sacc[tt][2 * ks][0], sacc[tt][2 * ks][1]); w.y = pk2(sacc[tt][2 * ks][2], sacc[tt][2 * ks][3]);
                        w.z = pk2(sacc[tt][2 * ks + 1][0], sacc[tt][2 * ks + 1][1]); w.w = pk2(sacc[tt][2 * ks + 1][2], sacc[tt][2 * ks + 1][3]); pb[tt] = __builtin_bit_cast(bf16x8, w); }
#pragma unroll
                    for (int et = 0; et < 8; ++et) { const int e = 16 * et + r16;
                        const v2u lo = *(const LAS v2u*)(VTs + eoff<64>(e, 32 * ks + 4 * g)), hi = *(const LAS v2u*)(VTs + eoff<64>(e, 32 * ks + 16 + 4 * g));
                        v4u aw; aw.x = lo.x; aw.y = lo.y; aw.z = hi.x; aw.w = hi.y; const bf16x8 va = __builtin_bit_cast(bf16x8, aw);
                        oacc[et][0] = mfma16(va, pb[0], oacc[et][0]); oacc[et][1] = mfma16(va, pb[1], oacc[et][1]); if (et & 1) asm volatile("" ::: "memory"); } }
            }
        }
#undef FOX_PREFETCH
#pragma unroll
        for (int tt = 0; tt < 2; ++tt) { float l = lrun[tt]; l += __shfl_xor(l, 16); l += __shfl_xor(l, 32); const float inv = 1.0f / l;
            bf16* orow = hm + (rowb + q0 + 16 * tt + r16) * DM + h * 128 + 4 * g;
#pragma unroll
            for (int et = 0; et < 8; ++et) { v2u w; w.x = pk2(oacc[et][tt][0] * inv, oacc[et][tt][1] * inv); w.y = pk2(oacc[et][tt][2] * inv, oacc[et][tt][3] * inv); *(v2u*)(orow + 16 * et) = w; } }
    }
}

DI void final_norm(float* out, const long long* ss, const float* gfin, int lane, int wave, int bx) {
    const int gw = bx * NWAVES + wave, NGW = gridDim.x * NWAVES;
    for (int m = gw; m < MTOK; m += NGW) { const float rs = pg8::rstd_of(ss, m);
        f32x4* xr = (f32x4*)(out + (size_t)m * DM) + lane; const f32x4* gr = (const f32x4*)gfin + lane;
#pragma unroll
        for (int j = 0; j < 8; ++j) { const f32x4 v = xr[64 * j], gg = gr[64 * j]; xr[64 * j] = v * rs * gg; } }
}

#define PH(p) if (lo <= (p) && (p) < hi && (ran ? (xcd_barrier(bar), true) : (ran = true)))
#define TID() int tid = threadIdx.x; asm volatile("" : "+v"(tid)); const int lane = tid & 63, wave = __builtin_amdgcn_readfirstlane(tid >> 6); int bx = blockIdx.x; asm volatile("" : "+s"(bx)); (void)lane; (void)wave; (void)bx
#define WSP(T, off) ((T*)(ka->ws + (off)))
template <int j> DI void subblock(LAS unsigned char* lds, const XcdBarrier& bar, const int lo, const int hi, bool& ran) {
    {
        constexpr int layer = j / 3, typ = j - 3 * layer, base = 1 + 5 * j;
        if constexpr (typ != 1) {
            PH(base) { TID(); KArgs ka = kargs(); const int mi = layer * 2 + (typ >> 1);
                pg8::Gemm gm{WSP(bf16, WS_HB), WSP(bf16, WS_WUP) + (size_t)mi * NUP * DM, MTOK, NUP, DM}; pg8::StaticOrder S; S.init(MTOK, NUP, gridDim.x, bx);
                pg8::EpiSwiGLU E{WSP(bf16, WS_ACT), WSP(long long, WS_SS) + (size_t)j * MTOK, DFF};
                pg8::gemm_phase<pg8::EpiSwiGLU, pg8::StaticOrder, PG8_ALIGN, PG8_SP2>(lds, gm, S, E); }
        } else {
            constexpr int kind = layer % 3, ji = layer / 3;
            PH(base) { TID(); KArgs ka = kargs();
                pg8::Gemm gm{WSP(bf16, WS_HB), WSP(bf16, WS_WIN) + (size_t)layer * NINP * DM, MTOK, NINP, DM}; pg8::StaticOrder S; S.init(MTOK, NINP, gridDim.x, bx);
                pg8::EpiMixIn E{WSP(bf16, WS_P1), WSP(float, WS_G), WSP(long long, WS_SS) + (size_t)j * MTOK};
                pg8::gemm_phase<pg8::EpiMixIn, pg8::StaticOrder, PG8_ALIGN, PG8_SP2>(lds, gm, S, E); }
            PH(base + 1) { TID(); KArgs ka = kargs();
                if constexpr (kind == 0) mlstm_scan(lds, WSP(bf16, WS_P1), WSP(float, WS_G), ka->in[6] + ji * 16, WSP(float, WS_HRAW), tid, lane, wave, bx);
                else if constexpr (kind == 1) fox_cf(WSP(float, WS_G), ka->in[10] + ji * 16, WSP(float, WS_CF), lane, wave, bx);
                else gla_scan(lds, WSP(bf16, WS_P1), WSP(float, WS_G), ka->in[13] + (size_t)ji * 16 * 1024, ka->in[14] + ji * 1024, WSP(float, WS_HRAW), tid, lane, wave, bx);
            }
            PH(base + 2) { TID(); KArgs ka = kargs();
                if constexpr (kind == 0) headnorm_gate<256, 0>(WSP(float, WS_HRAW), WSP(bf16, WS_P1), ka->in[7] + ji * DM, WSP(bf16, WS_HM), lane, wave, bx);
                else if constexpr (kind == 1) fox_attn(lds, WSP(bf16, WS_P1), WSP(float, WS_CF), WSP(bf16, WS_HM), tid, lane, wave, bx);
                else headnorm_gate<512, 1>(WSP(float, WS_HRAW), WSP(bf16, WS_P1), ka->in[15] + ji * DM, WSP(bf16, WS_HM), lane, wave, bx);
            }
        }
        PH(base + 3) { TID(); KArgs ka = kargs();
            pg8::Gemm gm; float scale;
            if constexpr (typ != 1) { const int mi = layer * 2 + (typ >> 1); gm = pg8::Gemm{WSP(bf16, WS_ACT), WSP(bf16, WS_WDN) + (size_t)mi * DM * DFF, MTOK, DM, DFF}; scale = 0.5f; }
            else { gm = pg8::Gemm{WSP(bf16, WS_HM), WSP(bf16, WS_WOUT) + (size_t)layer * DM * DM, MTOK, DM, DM}; scale = 1.0f; }
            pg8::StaticOrder S; S.init(MTOK, DM, gridDim.x, bx);
            pg8::EpiResid E{(j == 0) ? ka->in[0] : (const float*)ka->out, ka->out, WSP(bf16, WS_HB), WSP(long long, WS_SS) + (size_t)(j + 1) * MTOK, scale};
            pg8::gemm_phase<pg8::EpiResid, pg8::StaticOrder, PG8_ALIGN, PG8_SP2>(lds, gm, S, E);
        }
    }
}

__global__ void __launch_bounds__(NWAVES * 64, 2) trunk_fwd(Args args) {
    extern __shared__ __attribute__((aligned(16))) unsigned char lds_raw[];
    LAS unsigned char* lds = (LAS unsigned char*)lds_raw;
    volatile LAS unsigned* MISC = (volatile LAS unsigned*)(lds + MISC_OFF);
    for (int u = threadIdx.x; u < (LDS_BYTES - MISC_OFF) / 4; u += NWAVES * 64) ((LAS unsigned*)(lds + MISC_OFF))[u] = 0u;
    __syncthreads();
    XcdBarrier bar = xcd_barrier_post((unsigned*)(args.ws + WS_CTL) + CW_BAR, MISC + 8);
    const int lo = args.ph_lo, hi = args.ph_hi; bool ran = false;

    PH(0) { TID(); prologue(lds, lane, wave, bx); }

    subblock<0>(lds, bar, lo, hi, ran); subblock<1>(lds, bar, lo, hi, ran); subblock<2>(lds, bar, lo, hi, ran); subblock<3>(lds, bar, lo, hi, ran);
    subblock<4>(lds, bar, lo, hi, ran); subblock<5>(lds, bar, lo, hi, ran); subblock<6>(lds, bar, lo, hi, ran); subblock<7>(lds, bar, lo, hi, ran);
    subblock<8>(lds, bar, lo, hi, ran); subblock<9>(lds, bar, lo, hi, ran); subblock<10>(lds, bar, lo, hi, ran); subblock<11>(lds, bar, lo, hi, ran);
    PH(NPHASE - 1) { TID(); KArgs ka = kargs(); final_norm(ka->out, WSP(long long, WS_SS) + (size_t)NSUB * MTOK, ka->in[17], lane, wave, bx); }
#undef WSP
#undef PH
}

static bool phase_exists(int p) {
    if (p == 0 || p == NPHASE - 1) return true;
    const int j = (p - 1) / 5, k = (p - 1) % 5, typ = j % 3;
    if (k == 0 || k == 3) return true;
    if (k == 4) return false;
    return typ == 1;
}
extern "C" void kernel_launch(void* const* d_in, const int* in_sizes, int n_in, void* d_out, int out_size, void* d_ws, size_t ws_size, hipStream_t stream) {
    static int grid = 0;
    if (grid == 0) {
        if (n_in != 18 || in_sizes[0] != MTOK * DM || out_size != MTOK * DM || ws_size < WS_END) { fprintf(stderr, "kernel_launch: unexpected shapes (n_in %d, in0 %d, out %d, ws %zu < %zu)\n", n_in, n_in > 0 ? in_sizes[0] : -1, out_size, ws_size, (size_t)WS_END); grid = -1; return; }
        int dev = 0, cus = 0, per_cu = 0;
        if (hipGetDevice(&dev) != hipSuccess || hipDeviceGetAttribute(&cus, hipDeviceAttributeMultiprocessorCount, dev) != hipSuccess) { grid = -1; return; }
        if (hipFuncSetAttribute((const void*)trunk_fwd, hipFuncAttributeMaxDynamicSharedMemorySize, LDS_BYTES) != hipSuccess) { fprintf(stderr, "kernel_launch: hipFuncSetAttribute failed\n"); grid = -1; return; }
        if (hipOccupancyMaxActiveBlocksPerMultiprocessor(&per_cu, (const void*)trunk_fwd, NWAVES * 64, LDS_BYTES) != hipSuccess || per_cu < 1) fprintf(stderr, "kernel_launch: occupancy query says %d\n", per_cu);
        (void)hipGetLastError();
        grid = cus;
    }
    if (grid < 0) return;
    if (hipMemsetAsync((char*)d_ws + WS_CTL, 0, CTL_ZERO_BYTES, stream) != hipSuccess) return;
    Args a{};
    for (int i = 0; i < 18; ++i) a.in[i] = (const float*)d_in[i];
    a.out = (float*)d_out; a.ws = (unsigned char*)d_ws;
#if MK_PER_PHASE
    for (int p = 0; p < NPHASE; ++p) { if (!phase_exists(p)) continue; a.ph_lo = p; a.ph_hi = p + 1; hipLaunchKernelGGL(trunk_fwd, dim3(grid), dim3(NWAVES * 64), LDS_BYTES, stream, a); }
#else
    a.ph_lo = 0; a.ph_hi = NPHASE; hipLaunchKernelGGL(trunk_fwd, dim3(grid), dim3(NWAVES * 64), LDS_BYTES, stream, a);
#endif
    (void)phase_exists;
}
```

```cpp
#include <hip/hip_runtime.h>
#include <cstdio>
#include <cstdint>
namespace pg8 {
#define PG8_LAS __attribute__((address_space(3)))
typedef unsigned short bf16_t;
typedef short bf16x8 __attribute__((ext_vector_type(8)));
typedef float f32x4 __attribute__((ext_vector_type(4)));
typedef unsigned u32x4 __attribute__((ext_vector_type(4)));
constexpr int BM = 256, BK = 64, HALF = 128, HTB = HALF * BK * 2  , STAGE_BYTES = 8 * HTB, NXCD = 8, WGM = 8;

__host__ __device__ __forceinline__ int lds_byte(int r, int c) { const int st = (r >> 4) * 2 + (c >> 5), rr = r & 15, cc = c & 31, ob = rr * 64 + cc * 2; return st * 1024 + (ob ^ (((ob >> 9) & 1) << 5)); }
__host__ __device__ __forceinline__ void stage_rc(int b, int& R, int& C) { const int st = b / 1024, sb = b % 1024, swz = sb ^ (((sb >> 9) & 1) << 5); R = (st >> 1) * 16 + swz / 64; C = (st & 1) * 32 + (swz % 64) / 2; }
__host__ __device__ __forceinline__ int perm32(int rho) { const int n = rho >> 4, i = rho & 15; return 8 * (i >> 2) + 4 * n + (i & 3); }

struct Unit { int pm, pn; };
struct Gemm { const bf16_t* A; const bf16_t* Bt; int M, N, K; };

struct StaticOrder {
    int nM, nN, nwg, G, c;
    __host__ __device__ void init(int M, int N, int G_, int c_) { nM = M / BM; nN = N / BM; nwg = nM * nN; G = G_; c = c_; }
    __host__ __device__ bool next(int i, Unit& u) const {
        const long L = (long)i * G + c; if (L >= nwg) return false;
        int wgid = (int)L; { const int q = nwg / NXCD, r = nwg % NXCD, xcd = wgid % NXCD, off = wgid / NXCD; wgid = (xcd < r ? xcd * (q + 1) : r * (q + 1) + (xcd - r) * q) + off; }
        const int nig = WGM * nN, gid = wgid / nig, fm = gid * WGM, gsz = (nM - fm) < WGM ? (nM - fm) : WGM;
        u.pm = fm + ((wgid % nig) % gsz); u.pn = (wgid % nig) / gsz; return true;
    }
    __device__ __forceinline__ void a_ready(const Unit&) const {}
    __device__ __forceinline__ void done(const Unit&) const {}
};

__device__ __forceinline__ unsigned cvt_pk_bf16(float lo, float hi) { unsigned r; asm volatile("v_cvt_pk_bf16_f32 %0, %1, %2" : "=v"(r) : "v"(lo), "v"(hi)); return r; }
constexpr float RMS_EPS_F = 1e-6f, SS_FIX = 1048576.0f, SS_UNFIX_D = 1.0f / (1048576.0f * 2048.0f);
typedef long long ss_t;
__device__ __forceinline__ float rstd_of(const ss_t* ss, int row) { return rsqrtf((float)ss[row] * SS_UNFIX_D + RMS_EPS_F); }
struct EpiSwiGLU {
    static constexpr bool PERM = true, AFTER_DRAIN = false;
    bf16_t* O; const ss_t* ss; int ldo;
    __device__ __forceinline__ void operator()(const f32x4 (&acc)[2][2][4][2], const Unit& u, int wr, int wc, int fr, int fq) const {
        const int row0 = u.pm * BM + wr * 64 + fr, col0 = u.pn * HALF + wc * 32 + 8 * fq;
#pragma unroll
        for (int ai = 0; ai < 2; ++ai)
#pragma unroll
            for (int m = 0; m < 4; ++m) {
                const int row = row0 + ai * HALF + m * 16;
                const float rs = rstd_of(ss, row);
                float o[8];
#pragma unroll
                for (int n = 0; n < 2; ++n)
#pragma unroll
                    for (int j = 0; j < 4; ++j) { const float a = acc[ai][0][m][n][j] * rs, b = acc[ai][1][m][n][j] * rs;
                        o[4 * n + j] = a * b * __builtin_amdgcn_rcpf(1.0f + __expf(-a)); }
                u32x4 w; w.x = cvt_pk_bf16(o[0], o[1]); w.y = cvt_pk_bf16(o[2], o[3]); w.z = cvt_pk_bf16(o[4], o[5]); w.w = cvt_pk_bf16(o[6], o[7]);
                *(u32x4*)(O + (size_t)row * ldo + col0) = w;
            }
    }
};
struct EpiMixIn {
    static constexpr bool PERM = true, AFTER_DRAIN = false;
    bf16_t* O; float* G; const ss_t* ss;
    __device__ __forceinline__ void operator()(const f32x4 (&acc)[2][2][4][2], const Unit& u, int wr, int wc, int fr, int fq) const {
        const int row0 = u.pm * BM + wr * 64 + fr;
        if (u.pn < 24) {
            const int col0 = u.pn * BM + wc * 32 + 8 * fq;
#pragma unroll
            for (int ai = 0; ai < 2; ++ai)
#pragma unroll
                for (int m = 0; m < 4; ++m) {
                    const int row = row0 + ai * HALF + m * 16;
                    const float rs = rstd_of(ss, row);
#pragma unroll
                    for (int bj = 0; bj < 2; ++bj) { const f32x4 v0 = acc[ai][bj][m][0] * rs, v1 = acc[ai][bj][m][1] * rs;
                        u32x4 w; w.x = cvt_pk_bf16(v0[0], v0[1]); w.y = cvt_pk_bf16(v0[2], v0[3]); w.z = cvt_pk_bf16(v1[0], v1[1]); w.w = cvt_pk_bf16(v1[2], v1[3]);
                        *(u32x4*)(O + (size_t)row * 6144 + col0 + bj * HALF) = w; }
                }
        } else if (wc == 0 && fq < 2) {
#pragma unroll
            for (int ai = 0; ai < 2; ++ai)
#pragma unroll
                for (int m = 0; m < 4; ++m) {
                    const int row = row0 + ai * HALF + m * 16;
                    const float rs = rstd_of(ss, row);
#pragma unroll
                    for (int n = 0; n < 2; ++n) *(f32x4*)(G + (size_t)row * 16 + 8 * fq + 4 * n) = acc[ai][0][m][n] * rs;
                }
        }
    }
};
struct EpiResid {
    static constexpr bool PERM = false, AFTER_DRAIN = false;
    const float* res; float* hout; bf16_t* hb; ss_t* ssn; float scale;
    __device__ __forceinline__ void operator()(const f32x4 (&acc)[2][2][4][2], const Unit& u, int wr, int wc, int fr, int fq) const {
        typedef unsigned u32x2v __attribute__((ext_vector_type(2)));
        const int row0 = u.pm * BM + wr * 64 + fr, col0 = u.pn * BM + wc * 32 + 4 * fq;
#pragma unroll
        for (int ai = 0; ai < 2; ++ai)
#pragma unroll
            for (int m = 0; m < 4; ++m) {
                const int row = row0 + ai * HALF + m * 16; const size_t off = (size_t)row * 2048 + col0; float sq = 0.f;
#pragma unroll
                for (int bj = 0; bj < 2; ++bj)
#pragma unroll
                    for (int n = 0; n < 2; ++n) { const size_t o2 = off + bj * HALF + n * 16;
                        const f32x4 r = *(const f32x4*)(res + o2); const f32x4 hn = r + acc[ai][bj][m][n] * scale;
                        *(f32x4*)(hout + o2) = hn; u32x2v w; w.x = cvt_pk_bf16(hn[0], hn[1]); w.y = cvt_pk_bf16(hn[2], hn[3]); *(u32x2v*)(hb + o2) = w;
                        sq += (hn[0] * hn[0] + hn[1] * hn[1]) + (hn[2] * hn[2] + hn[3] * hn[3]); }
                sq += __shfl_xor(sq, 16); sq += __shfl_xor(sq, 32);
                if (fq == 0) atomicAdd((unsigned long long*)(ssn + row), (unsigned long long)__float2ll_rn(sq * SS_FIX));
            }
    }
};

template <class Epi, class Sched, bool ALIGN_EPI = false, bool SP2 = false>
__device__ __forceinline__ void gemm_phase(PG8_LAS unsigned char* lds, const Gemm g, const Sched& S, const Epi& E) {
    int tid_ = threadIdx.x; asm volatile("" : "+v"(tid_));
    const int tid = tid_, wid = __builtin_amdgcn_readfirstlane(tid >> 6), lane = tid & 63, wr = wid >> 2, wc = wid & 3, fr = lane & 15, fq = lane >> 4;
    const int K = g.K, nt = K / BK;
    unsigned voffA[2], voffB[2];
#pragma unroll
    for (int i = 0; i < 2; ++i) { int R, C; stage_rc(tid * 16 + i * 8192, R, C); const int Rb = Epi::PERM ? ((R & ~31) + perm32(R & 31)) : R;
        voffA[i] = (unsigned)(R * K + C) * 2u; voffB[i] = (unsigned)(Rb * K + C) * 2u; }
    const size_t kstep = (size_t)(BK * 2);
    const size_t hstep = (size_t)HALF * K * 2;
    const size_t tstep = 2 * hstep;
    const unsigned ldsw = (unsigned)wid * 1024u;
    const int aoff = lds_byte(wr * 64 + fr, fq * 8), boff = lds_byte(wc * 32 + fr, fq * 8);
#define PG8_SA(b, h) (((b) * 2 + (h)) * HTB)
#define PG8_SB(b, h) ((4 + (b) * 2 + (h)) * HTB)
#define PG8_STAGE(bufoff, gbase, voff) do { _Pragma("unroll") for (int _i = 0; _i < 2; ++_i) \
        __builtin_amdgcn_global_load_lds((const unsigned*)((const char*)(gbase) + (voff)[_i]), (PG8_LAS unsigned*)(lds + (bufoff) + ldsw + _i * 8192), 16, 0, 0); } while (0)
#define PG8_LDA(dst, b, h) do { _Pragma("unroll") for (int m = 0; m < 4; ++m) _Pragma("unroll") for (int k = 0; k < 2; ++k) dst[m][k] = *(const PG8_LAS bf16x8*)(lds + PG8_SA(b, h) + aoff + m * 2048 + k * 1024); } while (0)
#define PG8_LDB(dst, b, h) do { _Pragma("unroll") for (int n = 0; n < 2; ++n) _Pragma("unroll") for (int k = 0; k < 2; ++k) dst[n][k] = *(const PG8_LAS bf16x8*)(lds + PG8_SB(b, h) + boff + n * 2048 + k * 1024); } while (0)
#define PG8_MMA(ai, bj, At, Bt) do { __builtin_amdgcn_s_setprio(1); _Pragma("unroll") for (int m = 0; m < 4; ++m) _Pragma("unroll") for (int n = 0; n < 2; ++n) _Pragma("unroll") for (int k = 0; k < 2; ++k) \
        acc[ai][bj][m][n] = __builtin_amdgcn_mfma_f32_16x16x32_bf16(Bt[n][k], At[m][k], acc[ai][bj][m][n], 0, 0, 0); __builtin_amdgcn_s_setprio(0); } while (0)
#define PG8_WAIT_V(n) asm volatile("s_waitcnt vmcnt(" #n ")" ::: "memory")
#define PG8_WAIT_L(n) asm volatile("s_waitcnt lgkmcnt(" #n ")" ::: "memory")
#define PG8_BAR __builtin_amdgcn_s_barrier()
#define PG8_SCHED __builtin_amdgcn_sched_barrier(0)
    Unit cur, nxt; int ui = 0;
    if (!S.next(0, cur)) return;
    f32x4 acc[2][2][4][2];
#pragma unroll
    for (int a = 0; a < 2; ++a)
#pragma unroll
        for (int b = 0; b < 2; ++b)
#pragma unroll
            for (int m = 0; m < 4; ++m)
#pragma unroll
                for (int n = 0; n < 2; ++n) acc[a][b][m][n] = (f32x4){0.f, 0.f, 0.f, 0.f};
    bf16x8 At[4][2], B0[2][2], B1[2][2];
    const char* cA = (const char*)g.A + (size_t)cur.pm * tstep; const char* cB = (const char*)g.Bt + (size_t)cur.pn * tstep;
    S.a_ready(cur);
    if constexpr (SP2) {
        PG8_STAGE(PG8_SB(0, 0), cB, voffB); PG8_STAGE(PG8_SB(0, 1), cB + hstep, voffB); PG8_STAGE(PG8_SA(0, 0), cA, voffA); PG8_STAGE(PG8_SA(0, 1), cA + hstep, voffA);
        if (wr == 1) PG8_BAR;
        PG8_WAIT_V(2); PG8_BAR;
        PG8_STAGE(PG8_SB(1, 0), cB + kstep, voffB); PG8_STAGE(PG8_SA(1, 0), cA + kstep, voffA); PG8_STAGE(PG8_SB(1, 1), cB + hstep + kstep, voffB);
        PG8_WAIT_V(6); PG8_BAR;
    } else {
        PG8_STAGE(PG8_SB(0, 0), cB, voffB); PG8_STAGE(PG8_SA(0, 0), cA, voffA); PG8_STAGE(PG8_SB(0, 1), cB + hstep, voffB); PG8_STAGE(PG8_SA(0, 1), cA + hstep, voffA);
        if (wr == 1) PG8_BAR;
        PG8_WAIT_V(4); PG8_BAR;
        PG8_STAGE(PG8_SB(1, 0), cB + kstep, voffB); PG8_STAGE(PG8_SA(1, 0), cA + kstep, voffA); PG8_STAGE(PG8_SB(1, 1), cB + hstep + kstep, voffB);
        PG8_WAIT_V(6); PG8_BAR;
    }
    for (;;) {
        const bool has_next = S.next(ui + 1, nxt);
        const char* nA = has_next ? (const char*)g.A + (size_t)nxt.pm * tstep : cA; const char* nB = has_next ? (const char*)g.Bt + (size_t)nxt.pn * tstep : cB;
        for (int t = 0; t < nt; t += 2) {
            const bool last = (t == nt - 2);
            const char* a1 = cA + (size_t)(t + 1) * kstep;
            const char* a2 = last ? nA : cA + (size_t)(t + 2) * kstep; const char* b2 = last ? nB : cB + (size_t)(t + 2) * kstep;
            const char* a3 = a2 + kstep; const char* b3 = b2 + kstep;
            if (last && has_next) S.a_ready(nxt);
            if constexpr (SP2) {
            PG8_LDB(B0, 0, 0); PG8_LDB(B1, 0, 1); PG8_SCHED; PG8_LDA(At, 0, 0); PG8_STAGE(PG8_SA(1, 1), a1 + hstep, voffA);
            PG8_WAIT_V(8); PG8_WAIT_L(0); PG8_BAR; PG8_MMA(0, 0, At, B0); PG8_MMA(0, 1, At, B1); PG8_BAR; PG8_SCHED;
            PG8_LDA(At, 0, 1); PG8_STAGE(PG8_SB(0, 0), b2, voffB); PG8_STAGE(PG8_SB(0, 1), b2 + hstep, voffB); PG8_STAGE(PG8_SA(0, 0), a2, voffA);
            PG8_WAIT_V(8); PG8_WAIT_L(0); PG8_BAR; PG8_MMA(1, 0, At, B0); PG8_MMA(1, 1, At, B1); PG8_BAR; PG8_SCHED;
            PG8_LDB(B0, 1, 0); PG8_LDB(B1, 1, 1); PG8_SCHED; PG8_LDA(At, 1, 0); PG8_STAGE(PG8_SA(0, 1), a2 + hstep, voffA);
            PG8_WAIT_V(8); PG8_WAIT_L(0); PG8_BAR; PG8_MMA(0, 0, At, B0); PG8_MMA(0, 1, At, B1); PG8_BAR; PG8_SCHED;
            PG8_LDA(At, 1, 1); PG8_STAGE(PG8_SB(1, 0), b3, voffB); PG8_STAGE(PG8_SB(1, 1), b3 + hstep, voffB); PG8_STAGE(PG8_SA(1, 0), a3, voffA);
            PG8_WAIT_V(8); PG8_WAIT_L(0); PG8_BAR; PG8_MMA(1, 0, At, B0); PG8_MMA(1, 1, At, B1); PG8_BAR; PG8_SCHED;
            } else {
            PG8_LDB(B0, 0, 0); PG8_SCHED; PG8_LDA(At, 0, 0); PG8_STAGE(PG8_SA(1, 1), a1 + hstep, voffA);
            PG8_WAIT_L(8); PG8_BAR; PG8_WAIT_L(0); PG8_MMA(0, 0, At, B0); PG8_BAR; PG8_SCHED;
            PG8_LDB(B1, 0, 1); PG8_STAGE(PG8_SB(0, 0), b2, voffB);
            PG8_BAR; PG8_WAIT_L(0); PG8_MMA(0, 1, At, B1); PG8_BAR;
            PG8_LDA(At, 0, 1); PG8_STAGE(PG8_SA(0, 0), a2, voffA);
            PG8_BAR; PG8_WAIT_L(0); PG8_MMA(1, 0, At, B0); PG8_BAR; PG8_SCHED;
            PG8_STAGE(PG8_SB(0, 1), b2 + hstep, voffB);
            PG8_WAIT_V(6); PG8_BAR; PG8_MMA(1, 1, At, B1); PG8_BAR;
            PG8_LDB(B0, 1, 0); PG8_SCHED; PG8_LDA(At, 1, 0); PG8_STAGE(PG8_SA(0, 1), a2 + hstep, voffA);
            PG8_WAIT_L(8); PG8_BAR; PG8_WAIT_L(0); PG8_MMA(0, 0, At, B0); PG8_BAR; PG8_SCHED;
            PG8_LDB(B1, 1, 1); PG8_STAGE(PG8_SB(1, 0), b3, voffB);
            PG8_BAR; PG8_WAIT_L(0); PG8_MMA(0, 1, At, B1); PG8_BAR;
            PG8_LDA(At, 1, 1); PG8_STAGE(PG8_SA(1, 0), a3, voffA);
            PG8_BAR; PG8_WAIT_L(0); PG8_MMA(1, 0, At, B0); PG8_BAR; PG8_SCHED;
            PG8_STAGE(PG8_SB(1, 1), b3 + hstep, voffB);
            PG8_WAIT_V(6); PG8_BAR; PG8_MMA(1, 1, At, B1); PG8_BAR;
            }
        }
        if constexpr (ALIGN_EPI) { if (wr == 0) PG8_BAR; }
        if constexpr (!Epi::AFTER_DRAIN) { E(acc, cur, wr, wc, fr, fq); S.done(cur); }
        if (!has_next) break;
#pragma unroll
        for (int a = 0; a < 2; ++a)
#pragma unroll
            for (int b = 0; b < 2; ++b)
#pragma unroll
                for (int m = 0; m < 4; ++m)
#pragma unroll
                    for (int n = 0; n < 2; ++n) acc[a][b][m][n] = (f32x4){0.f, 0.f, 0.f, 0.f};
        cur = nxt; cA = nA; cB = nB; ++ui;
        if constexpr (ALIGN_EPI) { if (wr == 1) PG8_BAR; }
    }
    PG8_WAIT_V(0);
    if constexpr (!ALIGN_EPI) { if (wr == 0) PG8_BAR; }
    PG8_BAR;
    if constexpr (Epi::AFTER_DRAIN) { E.fused(acc, cur, wr, wc, fr, fq, lds, wid, lane); S.done(cur); }
#undef PG8_SA
#undef PG8_SB
#undef PG8_STAGE
#undef PG8_LDA
#undef PG8_LDB
#undef PG8_MMA
#undef PG8_WAIT_V
#undef PG8_WAIT_L
#undef PG8_BAR
#undef PG8_SCHED
}
}

#ifndef PG8_SP2
#define PG8_SP2 true
#endif
#ifndef PG8_ALIGN
#define PG8_ALIGN true
#endif
#ifndef MK_PER_PHASE
#define MK_PER_PHASE 0
#endif

constexpr int DM = 2048, BATCH = 8, SEQ = 4096, MTOK = BATCH * SEQ, DEPTH = 4, DFF = 5632, NUP = 2 * DFF, NIN = 6160, NINP = 6400, NQKV = 6144;
constexpr int NWAVES = 8;
constexpr int NSUB = 3 * DEPTH;
constexpr int NPHASE = 2 + 5 * NSUB;

constexpr size_t MiB = 1u << 20;
constexpr size_t WS_CTL = 0, CTL_ZERO_BYTES = 5 * MiB;
constexpr size_t WS_SS = 1 * MiB;
constexpr size_t WS_WUP = 8 * MiB;
constexpr size_t WS_WDN = WS_WUP + 352 * MiB;
constexpr size_t WS_WIN = WS_WDN + 176 * MiB;
constexpr size_t WS_WOUT = WS_WIN + 100 * MiB;
constexpr size_t WS_HB = WS_WOUT + 32 * MiB;
constexpr size_t WS_ACT = WS_HB + 128 * MiB;
constexpr size_t WS_P1 = WS_ACT + 352 * MiB;
constexpr size_t WS_G = WS_P1 + 384 * MiB;
constexpr size_t WS_HRAW = WS_G + 2 * MiB;
constexpr size_t WS_HM = WS_HRAW + 256 * MiB;
constexpr size_t WS_CF = WS_HM + 128 * MiB;
constexpr size_t WS_END = WS_CF + 2 * MiB;
static_assert((size_t)8 * NUP * DM * 2 == 352 * MiB && (size_t)8 * DM * DFF * 2 == 176 * MiB && (size_t)4 * NINP * DM * 2 == 100 * MiB, "weight regions");
static_assert((size_t)MTOK * DFF * 2 == 352 * MiB && (size_t)MTOK * NQKV * 2 == 384 * MiB && WS_SS + 13 * (size_t)MTOK * 8 <= CTL_ZERO_BYTES, "activation regions");
constexpr int CW_BAR = 4096;

constexpr int LDS_BYTES = 153600, MISC_OFF = 152576;

#define GAS __attribute__((address_space(1)))
#define LAS __attribute__((address_space(3)))
#define DI __device__ __forceinline__
typedef unsigned short bf16;
typedef unsigned v4u __attribute__((ext_vector_type(4)));
typedef unsigned v2u __attribute__((ext_vector_type(2)));
typedef float f32x4 __attribute__((ext_vector_type(4)));
typedef short bf16x8 __attribute__((ext_vector_type(8)));
typedef GAS unsigned gu32;
#define RLX_AGENT __ATOMIC_RELAXED, __HIP_MEMORY_SCOPE_AGENT
#define LDS_WAIT() asm volatile("s_waitcnt lgkmcnt(0)" ::: "memory")
DI unsigned f2bf(float f) { unsigned u = __builtin_bit_cast(unsigned, f); return (u + 0x7fffu + ((u >> 16) & 1u)) >> 16; }
DI unsigned pk2(float lo, float hi) { return f2bf(lo) | (f2bf(hi) << 16); }
DI float bf2f(unsigned short v) { return __builtin_bit_cast(float, (unsigned)v << 16); }
DI float bflo(unsigned w) { return __builtin_bit_cast(float, w << 16); }
DI float bfhi(unsigned w) { return __builtin_bit_cast(float, w & 0xffff0000u); }
DI float logsig(float x) { return fminf(x, 0.f) - log1pf(expf(-fabsf(x))); }

#define XB_TMO      128
#define XB_XCNT(j)  (256  + 64 * (j))
#define XB_XSUB(j)  (1280 + 64 * (j))
#define XB_XGEN(j)  (2304 + 64 * (j))
#define XB_TOP      3328
#define XB_TOPGEN   3392
#define XCD_BAR_WORDS 3456
#define XB_SPIN_CAP (1u << 18)

__device__ __forceinline__ unsigned xb_ld(unsigned* p)              { return __hip_atomic_load(p, __ATOMIC_RELAXED, __HIP_MEMORY_SCOPE_AGENT); }
__device__ __forceinline__ unsigned xb_add(unsigned* p, unsigned v) { return __hip_atomic_fetch_add(p, v, __ATOMIC_RELAXED, __HIP_MEMORY_SCOPE_AGENT); }
__device__ __forceinline__ unsigned xb_xcc_id() { return (unsigned)__builtin_amdgcn_s_getreg((3 << 11) | 20) & 0xFu; }
#define XB_SPIN(cond, bar) do { unsigned _sp = 0; while (cond) { __builtin_amdgcn_s_sleep(1); \
    if ((++_sp & 255u) == 0u) { if (xb_ld(&(bar)[XB_TMO])) break; if (_sp > XB_SPIN_CAP) { atomicAdd(&(bar)[XB_TMO], 1u); break; } } } } while (0)

struct XcdBarrier {
    unsigned* bar; unsigned x;
    volatile LAS unsigned* st;
};

__device__ __forceinline__ XcdBarrier xcd_barrier_post(unsigned* bar, volatile LAS unsigned* st) {
    XcdBarrier b; b.bar = bar; b.x = xb_xcc_id(); b.st = st;
    if (threadIdx.x == 0) (void)xb_add(&bar[XB_XCNT(b.x)], 1u);
    return b;
}
__device__ __forceinline__ void xcd_barrier_complete(unsigned* bar, unsigned x, unsigned& nloc, unsigned& nx) {
    const unsigned G = gridDim.x * gridDim.y * gridDim.z;
    unsigned sum, cnt, mine, sp = 0u;
    for (;;) {
        sum = 0u; cnt = 0u; mine = 0u;
#pragma unroll
        for (unsigned j = 0; j < 16; ++j) { const unsigned c = xb_ld(&bar[XB_XCNT(j)]); sum += c; cnt += (c > 0u) ? 1u : 0u; mine = (j == x) ? c : mine; }
        if (sum == G) break;
        __builtin_amdgcn_s_sleep(1);
        if ((++sp & 255u) == 0u) { if (xb_ld(&bar[XB_TMO])) break; if (sp > XB_SPIN_CAP) { atomicAdd(&bar[XB_TMO], 1u); break; } }
    }
    nloc = mine > 0u ? mine : 1u; nx = cnt > 0u ? cnt : 1u;
}

__device__ __forceinline__ void xcd_barrier(const XcdBarrier& b) {
    asm volatile("s_waitcnt vmcnt(0)" ::: "memory");
    __syncthreads();
    if (threadIdx.x == 0) {
        unsigned* bar = b.bar;
        __builtin_amdgcn_s_waitcnt(0);
        unsigned nloc = b.st[0], nx = b.st[1];
        if (nloc == 0u) { xcd_barrier_complete(bar, b.x, nloc, nx); b.st[0] = nloc; b.st[1] = nx; }
        const unsigned old = xb_add(&bar[XB_XSUB(b.x)], 1u);
        const unsigned gen = old / nloc;
        if (old + 1u == (gen + 1u) * nloc) {
            __builtin_amdgcn_fence(__ATOMIC_RELEASE, "agent");
            asm volatile("s_waitcnt vmcnt(0)" ::: "memory");
            const unsigned og = xb_add(&bar[XB_TOP], 1u);
            const unsigned tg = og / nx;
            if (og + 1u == (tg + 1u) * nx) xb_add(&bar[XB_TOPGEN], 1u);
            else XB_SPIN(xb_ld(&bar[XB_TOPGEN]) == tg, bar);
            __builtin_amdgcn_fence(__ATOMIC_ACQUIRE, "agent");
            xb_add(&bar[XB_XGEN(b.x)], 1u);
            asm volatile("s_waitcnt vmcnt(0)" ::: "memory");
        } else {
            XB_SPIN(xb_ld(&bar[XB_XGEN(b.x)]) == gen, bar);
            __builtin_amdgcn_fence(__ATOMIC_ACQUIRE, "agent");
            asm volatile("s_waitcnt vmcnt(0)" ::: "memory");
        }
    }
    __syncthreads();
}


DI float wave_sum(float v) {
#pragma unroll
    for (int o = 1; o < 64; o <<= 1) v += __shfl_xor(v, o);
    return v;
}
DI float wave_max(float v) {
#pragma unroll
    for (int o = 1; o < 64; o <<= 1) v = fmaxf(v, __shfl_xor(v, o));
    return v;
}
DI float wave_incl_sum(float v, int lane) {
#pragma unroll
    for (int o = 1; o < 64; o <<= 1) { const float t = __shfl_up(v, o); if (lane >= o) v += t; }
    return v;
}
DI float wave_incl_max(float v, int lane) {
#pragma unroll
    for (int o = 1; o < 64; o <<= 1) { const float t = __shfl_up(v, o); if (lane >= o) v = fmaxf(v, t); }
    return v;
}

template <int L> DI int swx(int r) { return L == 64 ? ((r >> 1) & 7) : (r & 15); }
template <int L> DI int eoff(int r, int c) { return r * L + ((((c >> 3) ^ swx<L>(r)) << 3) | (c & 7)); }
template <int L> DI bf16x8 ldf(const LAS bf16* base, int r, int ch) { return *(const LAS bf16x8*)(base + r * L + ((ch ^ swx<L>(r)) << 3)); }
DI f32x4 mfma16(bf16x8 a, bf16x8 b, f32x4 c) { return __builtin_amdgcn_mfma_f32_16x16x32_bf16(a, b, c, 0, 0, 0); }
template <int LA, int LB, int NK> DI void mma_tile(f32x4& acc, const LAS bf16* A, int ra0, const LAS bf16* B, int rb0, int lane) {
    const int r = lane & 15, g = lane >> 4;
#pragma unroll
    for (int kk = 0; kk < NK; ++kk) { const bf16x8 a = ldf<LA>(A, ra0 + r, 4 * kk + g), b = ldf<LB>(B, rb0 + r, 4 * kk + g); acc = mfma16(a, b, acc); }
}

DI void conv_item(const float* W, int K, int N, int nblk, const float* gk, bf16* WT, int mode, LAS float* scr, int item, int lane) {
    const int kb = item / nblk, nb = item - kb * nblk, k0 = 64 * kb, n0 = 32 * nb;
    const int n = n0 + (lane & 31); const bool ok = n < N;
#pragma unroll 8
    for (int i = 0; i < 32; ++i) { const int kk = 2 * i + (lane >> 5); float v = ok ? W[(size_t)(k0 + kk) * N + n] : 0.f; if (gk) v *= gk[k0 + kk]; scr[kk * 33 + (lane & 31)] = v; }
    LDS_WAIT(); asm volatile("" ::: "memory");
    int row_off = n0;
    if (mode == 1) { const int j = n0 < DFF ? n0 : n0 - DFF; row_off = 256 * (j >> 7) + (j & 127) + (n0 < DFF ? 0 : 128); }
    const int c = lane & 7;
#pragma unroll
    for (int j = 0; j < 4; ++j) { const int nn = (lane >> 3) + 8 * j; const LAS float* s = scr + (8 * c) * 33 + nn;
        v4u o; o.x = pk2(s[0 * 33], s[1 * 33]); o.y = pk2(s[2 * 33], s[3 * 33]); o.z = pk2(s[4 * 33], s[5 * 33]); o.w = pk2(s[6 * 33], s[7 * 33]);
        *(v4u*)(WT + (size_t)(row_off + nn) * K + k0 + 8 * c) = o; }
    LDS_WAIT(); asm volatile("" ::: "memory");
}

struct Args { const float* in[18]; float* out; unsigned char* ws; int ph_lo, ph_hi; };

typedef const __attribute__((address_space(4))) Args* KArgs;
DI KArgs kargs() { KArgs p = (KArgs)__builtin_amdgcn_kernarg_segment_ptr(); asm volatile("" : "+s"(p)); return p; }
DI void prologue(LAS unsigned char* lds, int lane, int wave, int bx) {
    KArgs AP = kargs();
    LAS float* scr = (LAS float*)(lds + wave * 16384);
    const int gw = bx * NWAVES + wave, NGW = gridDim.x * NWAVES;
    unsigned char* ws = AP->ws;
    constexpr int I_UP = (DM / 64) * (NUP / 32), I_DN = (DFF / 64) * (DM / 32), I_IN = (DM / 64) * (NINP / 32), I_OUT = (DM / 64) * (DM / 32);
    constexpr int NITEMS = 8 * I_UP + 8 * I_DN + 4 * I_IN + 4 * I_OUT;
    for (int it = gw; it < NITEMS; it += NGW) {
        int r = it; const float* W; const float* gk = nullptr; bf16* WT; int K = DM, N, nblk, mode = 0;
        if (r < 8 * I_UP) { const int mi = r / I_UP; r -= mi * I_UP; W = AP->in[2] + (size_t)mi * DM * NUP; gk = AP->in[1] + (size_t)mi * DM; WT = (bf16*)(ws + WS_WUP) + (size_t)mi * NUP * DM; N = NUP; nblk = NUP / 32; mode = 1; }
        else if (r < 8 * I_UP + 8 * I_DN) { r -= 8 * I_UP; const int mi = r / I_DN; r -= mi * I_DN; W = AP->in[3] + (size_t)mi * DFF * DM; WT = (bf16*)(ws + WS_WDN) + (size_t)mi * DM * DFF; K = DFF; N = DM; nblk = DM / 32; }
        else if (r < 8 * I_UP + 8 * I_DN + 4 * I_IN) { r -= 8 * I_UP + 8 * I_DN; const int l = r / I_IN; r -= l * I_IN; const int kind = l % 3, ji = l / 3;
            W = AP->in[kind == 0 ? 5 : kind == 1 ? 9 : 12] + (size_t)ji * DM * NIN; gk = AP->in[4] + (size_t)l * DM; WT = (bf16*)(ws + WS_WIN) + (size_t)l * NINP * DM; N = NIN; nblk = NINP / 32; }
        else { r -= 8 * I_UP + 8 * I_DN + 4 * I_IN; const int l = r / I_OUT; r -= l * I_OUT; const int kind = l % 3, ji = l / 3;
            W = AP->in[kind == 0 ? 8 : kind == 1 ? 11 : 16] + (size_t)ji * DM * DM; WT = (bf16*)(ws + WS_WOUT) + (size_t)l * DM * DM; N = DM; nblk = DM / 32; }
        conv_item(W, K, N, nblk, gk, WT, mode, scr, r, lane);
    }
    const float* x = AP->in[0]; bf16* hb = (bf16*)(ws + WS_HB); long long* ss0 = (long long*)(ws + WS_SS);
    for (int m = gw; m < MTOK; m += NGW) {
        const f32x4* xr = (const f32x4*)(x + (size_t)m * DM) + lane; f32x4 v[8]; float s = 0.f;
#pragma unroll
        for (int j = 0; j < 8; ++j) { v[j] = xr[64 * j]; s += (v[j].x * v[j].x + v[j].y * v[j].y) + (v[j].z * v[j].z + v[j].w * v[j].w); }
        s = wave_sum(s);
        v2u* o8 = (v2u*)(hb + (size_t)m * DM) + lane;
#pragma unroll
        for (int j = 0; j < 8; ++j) { v2u w; w.x = pk2(v[j].x, v[j].y); w.y = pk2(v[j].z, v[j].w); o8[64 * j] = w; }
        if (lane == 0) ss0[m] = __float2ll_rn(s * 1048576.0f);
    }
}

DI void mlstm_scan(LAS unsigned char* lds, const bf16* P1, const float* G, const float* b_if, float* hraw, int tid, int lane, int wave, int bx) {
    LAS bf16* Qs = (LAS bf16*)lds;
    LAS bf16* Ks = Qs + 64 * 128;
    LAS bf16* KTs = Ks + 64 * 128;
    LAS bf16* VTs = KTs + 128 * 64;
    LAS bf16* Ps = VTs + 64 * 64;
    LAS bf16* CTs = Ps + 64 * 64;
    LAS float* fa = (LAS float*)(CTs + 64 * 128);
    LAS float *bcum = fa, *ipre = fa + 64, *mrow = fa + 128, *interw = fa + 192, *wsv = fa + 256, *dinv = fa + 320, *nvec = fa + 384, *scal = fa + 512;
    const float KSCALE = 0.08838834764831845f;
    const int g = lane >> 4, r16 = lane & 15;
    for (int item = bx; item < 256; item += gridDim.x) {
        const int b = item >> 5, h = (item >> 2) & 7, sl = item & 3;
        f32x4 Cacc[4];
#pragma unroll
        for (int e = 0; e < 4; ++e) Cacc[e] = (f32x4){0.f, 0.f, 0.f, 0.f};
        __syncthreads();
        ((LAS v4u*)CTs)[tid] = (v4u){0u, 0u, 0u, 0u}; ((LAS v4u*)CTs)[tid + 512] = (v4u){0u, 0u, 0u, 0u};
        if (tid < 128) nvec[tid] = 0.f;
        float m_prev = 0.f;
        for (int c = 0; c < 64; ++c) {
            const int row0 = b * SEQ + c * 64;
            __syncthreads();
            if (tid < 64) { const float* gp = G + (size_t)(row0 + tid) * 16; ipre[tid] = gp[h] + b_if[h]; bcum[tid] = logsig(gp[8 + h] + b_if[8 + h]); }
#pragma unroll
            for (int p = 0; p < 2; ++p) { const int idx = tid + 512 * p, r = idx >> 4, c8 = idx & 15; const bf16* src = P1 + (size_t)(row0 + r) * NQKV + h * 128 + c8 * 8;
                const v4u vq = *(const v4u*)src, vk = *(const v4u*)(src + 1024);
                *(LAS v4u*)(Qs + eoff<128>(r, c8 * 8)) = vq; *(LAS v4u*)(Ks + eoff<128>(r, c8 * 8)) = vk; }
            { const int r = tid >> 3, c8 = tid & 7; const v4u vv = *(const v4u*)(P1 + (size_t)(row0 + r) * NQKV + 2048 + h * 256 + sl * 64 + c8 * 8);
#pragma unroll
              for (int j = 0; j < 4; ++j) { VTs[eoff<64>(c8 * 8 + 2 * j, r)] = (bf16)(vv[j] & 0xffffu); VTs[eoff<64>(c8 * 8 + 2 * j + 1, r)] = (bf16)(vv[j] >> 16); } }
            __syncthreads();
            if (wave == 0) {
                const float bt = wave_incl_sum(bcum[lane], lane), ip = ipre[lane];
                const float am = wave_incl_max(ip - bt, lane);
                const float mt = fmaxf(bt + m_prev, bt + am);
                const float blast = __shfl(bt, 63);
                const float gg = blast - bt + ip;
                const float m_new = fmaxf(blast + m_prev, wave_max(gg));
                bcum[lane] = bt; mrow[lane] = mt; interw[lane] = expf(bt + m_prev - mt); wsv[lane] = expf(gg - m_new);
                if (lane == 0) scal[0] = expf(blast + m_prev - m_new);
                m_prev = m_new;
            }
            __syncthreads();
#pragma unroll
            for (int p = 0; p < 2; ++p) { const int idx = tid + 512 * p, s = idx >> 4, c8 = idx & 15; const v4u kv = *(const LAS v4u*)(Ks + eoff<128>(s, c8 * 8)); const float w = wsv[s] * KSCALE;
#pragma unroll
                for (int j = 0; j < 4; ++j) { KTs[eoff<64>(c8 * 8 + 2 * j, s)] = (bf16)f2bf(bflo(kv[j]) * w); KTs[eoff<64>(c8 * 8 + 2 * j + 1, s)] = (bf16)f2bf(bfhi(kv[j]) * w); } }
            const int tt = wave >> 1;
#pragma unroll
            for (int q2 = 0; q2 < 2; ++q2) { const int st = 2 * (wave & 1) + q2; f32x4 acc = (f32x4){0.f, 0.f, 0.f, 0.f};
                if (st <= tt) mma_tile<128, 128, 4>(acc, Qs, 16 * tt, Ks, 16 * st, lane);
                const int s = 16 * st + r16; const float cs = ipre[s] - bcum[s];
#pragma unroll
                for (int i = 0; i < 4; ++i) { const int t = 16 * tt + 4 * g + i; const float p = (s <= t) ? acc[i] * KSCALE * expf(bcum[t] + cs - mrow[t]) : 0.f; Ps[eoff<64>(t, s)] = (bf16)f2bf(p); } }
            __syncthreads();
#pragma unroll
            for (int rr = 0; rr < 8; ++rr) { const int t = wave * 8 + rr;
                float ps = bf2f(Ps[eoff<64>(t, lane)]);
                float qn = bf2f(Qs[eoff<128>(t, lane)]) * nvec[lane] + bf2f(Qs[eoff<128>(t, lane + 64)]) * nvec[lane + 64];
                ps = wave_sum(ps); qn = wave_sum(qn);
                if (lane == 0) { const float den = ps + interw[t] * qn; dinv[t] = 1.0f / fmaxf(fabsf(den), expf(-mrow[t])); } }
            f32x4 a1[2], a2[2];
#pragma unroll
            for (int q2 = 0; q2 < 2; ++q2) { const int et = 2 * (wave & 1) + q2; a1[q2] = (f32x4){0.f, 0.f, 0.f, 0.f}; a2[q2] = (f32x4){0.f, 0.f, 0.f, 0.f};
                mma_tile<64, 64, 2>(a1[q2], Ps, 16 * tt, VTs, 16 * et, lane); mma_tile<128, 128, 4>(a2[q2], Qs, 16 * tt, CTs, 16 * et, lane); }
            __syncthreads();
#pragma unroll
            for (int q2 = 0; q2 < 2; ++q2) { const int et = 2 * (wave & 1) + q2, e = 16 * et + r16;
#pragma unroll
                for (int i = 0; i < 4; ++i) { const int t = 16 * tt + 4 * g + i; hraw[(size_t)(row0 + t) * DM + h * 256 + sl * 64 + e] = (a1[q2][i] + interw[t] * a2[q2][i]) * dinv[t]; } }
            const float wcs = scal[0];
#pragma unroll
            for (int et = 0; et < 4; ++et) { Cacc[et] = Cacc[et] * wcs; mma_tile<64, 64, 2>(Cacc[et], KTs, 16 * wave, VTs, 16 * et, lane);
                v2u w; w.x = pk2(Cacc[et][0], Cacc[et][1]); w.y = pk2(Cacc[et][2], Cacc[et][3]);
                *(LAS v2u*)(CTs + eoff<128>(16 * et + r16, 16 * wave + 4 * g)) = w; }
            if (tid < 128) { float a = wcs * nvec[tid];
#pragma unroll 8
                for (int s = 0; s < 64; ++s) a += wsv[s] * KSCALE * bf2f(Ks[eoff<128>(s, tid)]);
                nvec[tid] = a; }
        }
    }
}

DI void gla_scan(LAS unsigned char* lds, const bf16* P1, const float* G, const float* w_alpha, const float* b_alpha, float* hraw, int tid, int lane, int wave, int bx) {
    LAS bf16* QTs = (LAS bf16*)lds;
    LAS bf16* KTl = QTs + 64 * 256;
    LAS bf16* KTT = KTl + 64 * 256;
    LAS bf16* STs = KTT + 256 * 64;
    LAS bf16* VTs = STs + 64 * 256;
    LAS bf16* Ps = VTs + 64 * 64;
    LAS float* alow = (LAS float*)(Ps + 64 * 64);
    LAS float* eb = alow + 1024;
    const int g = lane >> 4, r16 = lane & 15;
    for (int item = bx; item < 256; item += gridDim.x) {
        const int b = item >> 5, h = (item >> 3) & 3, sl = item & 7;
        f32x4 Sacc[2][4];
#pragma unroll
        for (int a = 0; a < 2; ++a)
#pragma unroll
            for (int e = 0; e < 4; ++e) Sacc[a][e] = (f32x4){0.f, 0.f, 0.f, 0.f};
        __syncthreads();
#pragma unroll
        for (int i = 0; i < 4; ++i) ((LAS v4u*)STs)[tid + 512 * i] = (v4u){0u, 0u, 0u, 0u};
        float wa[16]; float ba = 0.f;
        if (tid < 256) {
#pragma unroll
            for (int i = 0; i < 16; ++i) wa[i] = w_alpha[i * 1024 + h * 256 + tid];
            ba = b_alpha[h * 256 + tid]; }
        else {
#pragma unroll
            for (int i = 0; i < 16; ++i) wa[i] = 0.f; }
        for (int c = 0; c < 64; ++c) {
            const int row0 = b * SEQ + c * 64;
            __syncthreads();
            if (tid < 256) { *(LAS f32x4*)(alow + tid * 4) = *(const f32x4*)(G + (size_t)(row0 + (tid >> 2)) * 16 + (tid & 3) * 4); }
            else { const int u = tid - 256, r = u >> 2, c16 = u & 3; const bf16* src = P1 + (size_t)(row0 + r) * NQKV + 2048 + h * 512 + sl * 64 + c16 * 16;
                const v4u v0 = *(const v4u*)src, v1 = *(const v4u*)(src + 8);
#pragma unroll
                for (int j = 0; j < 4; ++j) { VTs[eoff<64>(c16 * 16 + 2 * j, r)] = (bf16)(v0[j] & 0xffffu); VTs[eoff<64>(c16 * 16 + 2 * j + 1, r)] = (bf16)(v0[j] >> 16);
                                              VTs[eoff<64>(c16 * 16 + 8 + 2 * j, r)] = (bf16)(v1[j] & 0xffffu); VTs[eoff<64>(c16 * 16 + 8 + 2 * j + 1, r)] = (bf16)(v1[j] >> 16); } }
            __syncthreads();
            if (tid < 256) { const int d = tid; float bsum = 0.f;
                const bf16* qsrc = P1 + (size_t)row0 * NQKV + h * 256 + d;
                for (int s8 = 0; s8 < 8; ++s8) {
                    unsigned short qraw[8], kraw[8];
#pragma unroll
                    for (int j = 0; j < 8; ++j) { qraw[j] = qsrc[(size_t)(8 * s8 + j) * NQKV]; kraw[j] = qsrc[(size_t)(8 * s8 + j) * NQKV + 1024]; }
                    unsigned kk[8];
#pragma unroll
                    for (int j = 0; j < 8; ++j) { const int s = 8 * s8 + j; float z = ba;
#pragma unroll
                        for (int i = 0; i < 16; ++i) z += alow[s * 16 + i] * wa[i];
                        bsum += logsig(z) * (1.0f / 16.0f);
                        const float e = expf(bsum), ei = expf(-bsum);
                        QTs[eoff<256>(s, d)] = (bf16)f2bf(bf2f(qraw[j]) * 0.0625f * e);
                        kk[j] = f2bf(bf2f(kraw[j]) * ei); KTl[eoff<256>(s, d)] = (bf16)kk[j]; }
                    v4u w; w.x = kk[0] | (kk[1] << 16); w.y = kk[2] | (kk[3] << 16); w.z = kk[4] | (kk[5] << 16); w.w = kk[6] | (kk[7] << 16);
                    *(LAS v4u*)(KTT + eoff<64>(d, 8 * s8)) = w;
                }
                eb[d] = expf(bsum);
            }
            __syncthreads();
            const int tt = wave >> 1;
#pragma unroll
            for (int q2 = 0; q2 < 2; ++q2) { const int st = 2 * (wave & 1) + q2; f32x4 acc = (f32x4){0.f, 0.f, 0.f, 0.f};
                if (st <= tt) mma_tile<256, 256, 8>(acc, QTs, 16 * tt, KTl, 16 * st, lane);
                const int s = 16 * st + r16;
#pragma unroll
                for (int i = 0; i < 4; ++i) { const int t = 16 * tt + 4 * g + i; Ps[eoff<64>(t, s)] = (bf16)f2bf((s <= t) ? acc[i] : 0.f); } }
            __syncthreads();
#pragma unroll
            for (int q2 = 0; q2 < 2; ++q2) { const int et = 2 * (wave & 1) + q2, e = 16 * et + r16; f32x4 acc = (f32x4){0.f, 0.f, 0.f, 0.f};
                mma_tile<64, 64, 2>(acc, Ps, 16 * tt, VTs, 16 * et, lane); mma_tile<256, 256, 8>(acc, QTs, 16 * tt, STs, 16 * et, lane);
#pragma unroll
                for (int i = 0; i < 4; ++i) { const int t = 16 * tt + 4 * g + i; hraw[(size_t)(row0 + t) * DM + h * 512 + sl * 64 + e] = acc[i]; } }
            __syncthreads();
#pragma unroll
            for (int a = 0; a < 2; ++a) { const int dt = 2 * wave + a;
                const f32x4 ev = *(const LAS f32x4*)(eb + 16 * dt + 4 * g);
#pragma unroll
                for (int et = 0; et < 4; ++et) { mma_tile<64, 64, 2>(Sacc[a][et], KTT, 16 * dt, VTs, 16 * et, lane); Sacc[a][et] = Sacc[a][et] * ev;
                    v2u w; w.x = pk2(Sacc[a][et][0], Sacc[a][et][1]); w.y = pk2(Sacc[a][et][2], Sacc[a][et][3]);
                    *(LAS v2u*)(STs + eoff<256>(16 * et + r16, 16 * dt + 4 * g)) = w; } }
        }
    }
}

template <int HS, int ACT> DI void headnorm_gate(const float* hraw, const bf16* P1, const float* gnorm, bf16* hm, int lane, int wave, int bx) {
    constexpr int NH = DM / HS, EPL = HS / 64;
    const int gw = bx * NWAVES + wave, NGW = gridDim.x * NWAVES;
    for (int row = gw; row < MTOK; row += NGW) {
#pragma unroll
        for (int hh = 0; hh < NH; ++hh) { const int col = hh * HS + lane * EPL;
            float x[EPL]; float s = 0.f;
#pragma unroll
            for (int j = 0; j < EPL; j += 4) { const f32x4 v = *(const f32x4*)(hraw + (size_t)row * DM + col + j); x[j] = v.x; x[j + 1] = v.y; x[j + 2] = v.z; x[j + 3] = v.w; s += (v.x * v.x + v.y * v.y) + (v.z * v.z + v.w * v.w); }
            s = wave_sum(s); const float rs = rsqrtf(s * (1.0f / HS) + 1e-6f);
            unsigned outw[EPL / 2];
#pragma unroll
            for (int j = 0; j < EPL; j += 2) { const unsigned gw2 = *(const unsigned*)(P1 + (size_t)row * NQKV + 4096 + col + j); const float g0 = bflo(gw2), g1 = bfhi(gw2);
                const float a0 = ACT == 0 ? 1.0f / (1.0f + expf(-g0)) : g0 / (1.0f + expf(-g0)), a1 = ACT == 0 ? 1.0f / (1.0f + expf(-g1)) : g1 / (1.0f + expf(-g1));
                outw[j / 2] = pk2(x[j] * rs * gnorm[col + j] * a0, x[j + 1] * rs * gnorm[col + j + 1] * a1); }
            if constexpr (EPL == 4) { v2u w; w.x = outw[0]; w.y = outw[1]; *(v2u*)(hm + (size_t)row * DM + col) = w; }
            else { v4u w; w.x = outw[0]; w.y = outw[1]; w.z = outw[2]; w.w = outw[3]; *(v4u*)(hm + (size_t)row * DM + col) = w; }
        }
    }
}

DI void fox_cf(const float* G, const float* b_f, float* cf, int lane, int wave, int bx) {
    const int gw = bx * NWAVES + wave, NGW = gridDim.x * NWAVES;
    for (int seq = gw; seq < 128; seq += NGW) { const int b = seq >> 4, h = seq & 15; const float bias = b_f[h];
        const float* gp = G + ((size_t)b * SEQ + lane * 64) * 16 + h; float s = 0.f;
        for (int p = 0; p < 64; ++p) s += logsig(gp[p * 16] + bias);
        float run = wave_incl_sum(s, lane) - s;
        float* o = cf + (size_t)seq * SEQ + lane * 64;
        for (int p = 0; p < 64; ++p) { run += logsig(gp[p * 16] + bias); o[p] = run; }
    }
}

DI void fox_attn(LAS unsigned char* lds, const bf16* P1, const float* cf, bf16* hm, int tid, int lane, int wave, int bx) {
    LAS bf16* Ks = (LAS bf16*)lds;
    LAS bf16* VTs = Ks + 64 * 128;
    LAS float* cfs = (LAS float*)(VTs + 128 * 64);
    const float LOG2E = 1.4426950408889634f, QS = 0.08838834764831845f * 1.4426950408889634f;
    const int g = lane >> 4, r16 = lane & 15;
    const int G_ = gridDim.x;
    const int nit = (2048 + G_ - 1) / G_;
    for (int it = 0; it < nit; ++it) {
        const int u = (it & 1) ? it * G_ + (G_ - 1 - bx) : it * G_ + bx;
        if (u >= 2048) continue;
        const int qb = 15 - (u >> 7), bh = u & 127, b = bh >> 4, h = bh & 15;
        const size_t rowb = (size_t)b * SEQ; const int q0 = qb * 256 + 32 * wave;
        bf16x8 qf[2][4]; float cft[2];
#pragma unroll
        for (int tt = 0; tt < 2; ++tt) { const int t = q0 + 16 * tt + r16; cft[tt] = cf[(size_t)bh * SEQ + t] * LOG2E;
#pragma unroll
            for (int kk = 0; kk < 4; ++kk) { const v4u raw = *(const v4u*)(P1 + (rowb + t) * NQKV + h * 128 + 32 * kk + 8 * g); v4u sc;
#pragma unroll
                for (int j = 0; j < 4; ++j) sc[j] = pk2(bflo(raw[j]) * QS, bfhi(raw[j]) * QS);
                qf[tt][kk] = __builtin_bit_cast(bf16x8, sc); } }
        f32x4 oacc[8][2];
#pragma unroll
        for (int et = 0; et < 8; ++et) { oacc[et][0] = (f32x4){0.f, 0.f, 0.f, 0.f}; oacc[et][1] = (f32x4){0.f, 0.f, 0.f, 0.f}; }
        float mrun[2] = {-1e30f, -1e30f}, lrun[2] = {0.f, 0.f};
        const int ntiles = 4 * (qb + 1);
        v4u kreg[2], vreg[2]; float cfreg = 0.f;
        const bf16* kvbase = P1 + rowb * NQKV + 2048 + h * 128;
#define FOX_PREFETCH(j) do { _Pragma("unroll") for (int p = 0; p < 2; ++p) { const int idx = tid + 512 * p, r = idx >> 4, c8 = idx & 15; const bf16* src = kvbase + (size_t)(64 * (j) + r) * NQKV + c8 * 8; \
            kreg[p] = *(const v4u*)src; vreg[p] = *(const v4u*)(src + 2048); } if (tid < 64) cfreg = cf[(size_t)bh * SEQ + 64 * (j) + tid] * LOG2E; } while (0)
        FOX_PREFETCH(0);
        for (int j = 0; j < ntiles; ++j) {
            __syncthreads();
#pragma unroll
            for (int p = 0; p < 2; ++p) { const int idx = tid + 512 * p, r = idx >> 4, c8 = idx & 15; *(LAS v4u*)(Ks + eoff<128>(r, c8 * 8)) = kreg[p];
#pragma unroll
                for (int jj = 0; jj < 4; ++jj) { VTs[eoff<64>(c8 * 8 + 2 * jj, r)] = (bf16)(vreg[p][jj] & 0xffffu); VTs[eoff<64>(c8 * 8 + 2 * jj + 1, r)] = (bf16)(vreg[p][jj] >> 16); } }
            if (tid < 64) cfs[tid] = cfreg;
            __syncthreads();
            if (j + 1 < ntiles) FOX_PREFETCH(j + 1);
            if (64 * j <= q0 + 31) {
                f32x4 sacc[2][4];
#pragma unroll
                for (int st = 0; st < 4; ++st) { const f32x4 cv = *(const LAS f32x4*)(cfs + 16 * st + 4 * g);
#pragma unroll
                    for (int tt = 0; tt < 2; ++tt) sacc[tt][st] = (f32x4){cft[tt] - cv[0], cft[tt] - cv[1], cft[tt] - cv[2], cft[tt] - cv[3]}; }
#pragma unroll
                for (int st = 0; st < 4; ++st)
#pragma unroll
                    for (int kk = 0; kk < 4; ++kk) { const bf16x8 kf = ldf<128>(Ks, 16 * st + r16, 4 * kk + g);
                        sacc[0][st] = mfma16(kf, qf[0][kk], sacc[0][st]); sacc[1][st] = mfma16(kf, qf[1][kk], sacc[1][st]); if (kk == 3) asm volatile("" ::: "memory"); }
                if (64 * j + 63 > q0) {
#pragma unroll
                    for (int tt = 0; tt < 2; ++tt) { const int t = q0 + 16 * tt + r16;
#pragma unroll
                        for (int st = 0; st < 4; ++st)
#pragma unroll
                            for (int i = 0; i < 4; ++i) { const int s = 64 * j + 16 * st + 4 * g + i; if (s > t) sacc[tt][st][i] = -__builtin_inff(); } }
                }
#pragma unroll
                for (int tt = 0; tt < 2; ++tt) { float mx = -__builtin_inff();
#pragma unroll
                    for (int st = 0; st < 4; ++st) mx = fmaxf(mx, fmaxf(fmaxf(sacc[tt][st][0], sacc[tt][st][1]), fmaxf(sacc[tt][st][2], sacc[tt][st][3])));
                    mx = fmaxf(mx, __shfl_xor(mx, 16)); mx = fmaxf(mx, __shfl_xor(mx, 32));
                    const float mnew = fmaxf(mrun[tt], mx), alpha = __builtin_amdgcn_exp2f(mrun[tt] - mnew); mrun[tt] = mnew; float ls = 0.f;
#pragma unroll
                    for (int st = 0; st < 4; ++st)
#pragma unroll
                        for (int i = 0; i < 4; ++i) { const float p = __builtin_amdgcn_exp2f(sacc[tt][st][i] - mnew); sacc[tt][st][i] = p; ls += p; }
                    lrun[tt] = lrun[tt] * alpha + ls;
#pragma unroll
                    for (int et = 0; et < 8; ++et) oacc[et][tt] = oacc[et][tt] * alpha; }
#pragma unroll
                for (int ks = 0; ks < 2; ++ks) { bf16x8 pb[2];
#pragma unroll
                    for (int tt = 0; tt < 2; ++tt) { v4u w; w.x = pk2(sacc[tt][2 * ks][0], sacc[tt][2 * ks][1]); w.y = pk2(sacc[tt][2 * ks][2], sacc[tt][2 * ks][3]);
                        w.z = pk2(sacc[tt][2 * ks + 1][0], sacc[tt][2 * ks + 1][1]); w.w = pk2(sacc[tt][2 * ks + 1][2], sacc[tt][2 * ks + 1][3]); pb[tt] = __builtin_bit_cast(bf16x8, w); }
#pragma unroll
                    for (int et = 0; et < 8; ++et) { const int e = 16 * et + r16;
                        const v2u lo = *(const LAS v2u*)(VTs + eoff<64>(e, 32 * ks + 4 * g)), hi = *(const LAS v2u*)(VTs + eoff<64>(e, 32 * ks + 16 + 4 * g));
                        v4u aw; aw.x = lo.x; aw.y = lo.y; aw.z = hi.x; aw.w = hi.y; const bf16x8 va = __builtin_bit_cast(bf16x8, aw);
                        oacc[et][0] = mfma16(va, pb[0], oacc[et][0]); oacc[et][1] = mfma16(va, pb[1], oacc[et][1]); if (et & 1) asm volatile("" ::: "memory"); } }
            }
        }
#undef FOX_PREFETCH
#pragma unroll
        for (int tt = 0; tt < 2; ++tt) { float l = lrun[tt]; l += __shfl_xor(l, 16); l += __shfl_xor(l, 32); const float inv = 1.0f / l;
            bf16* orow = hm + (rowb + q0 + 16 * tt + r16) * DM + h * 128 + 4 * g;
#pragma unroll
            for (int et = 0; et < 8; ++et) { v2u w; w.x = pk2(oacc[et][tt][0] * inv, oacc[et][tt][1] * inv); w.y = pk2(oacc[et][tt][2] * inv, oacc[et][tt][3] * inv); *(v2u*)(orow + 16 * et) = w; } }
    }
}

DI void final_norm(float* out, const long long* ss, const float* gfin, int lane, int wave, int bx) {
    const int gw = bx * NWAVES + wave, NGW = gridDim.x * NWAVES;
    for (int m = gw; m < MTOK; m += NGW) { const float rs = pg8::rstd_of(ss, m);
        f32x4* xr = (f32x4*)(out + (size_t)m * DM) + lane; const f32x4* gr = (const f32x4*)gfin + lane;
#pragma unroll
        for (int j = 0; j < 8; ++j) { const f32x4 v = xr[64 * j], gg = gr[64 * j]; xr[64 * j] = v * rs * gg; } }
}

#define PH(p) if (lo <= (p) && (p) < hi && (ran ? (xcd_barrier(bar), true) : (ran = true)))
#define TID() int tid = threadIdx.x; asm volatile("" : "+v"(tid)); const int lane = tid & 63, wave = __builtin_amdgcn_readfirstlane(tid >> 6); int bx = blockIdx.x; asm volatile("" : "+s"(bx)); (void)lane; (void)wave; (void)bx
#define WSP(T, off) ((T*)(ka->ws + (off)))
template <int j> DI void subblock(LAS unsigned char* lds, const XcdBarrier& bar, const int lo, const int hi, bool& ran) {
    {
        constexpr int layer = j / 3, typ = j - 3 * layer, base = 1 + 5 * j;
        if constexpr (typ != 1) {
            PH(base) { TID(); KArgs ka = kargs(); const int mi = layer * 2 + (typ >> 1);
                pg8::Gemm gm{WSP(bf16, WS_HB), WSP(bf16, WS_WUP) + (size_t)mi * NUP * DM, MTOK, NUP, DM}; pg8::StaticOrder S; S.init(MTOK, NUP, gridDim.x, bx);
                pg8::EpiSwiGLU E{WSP(bf16, WS_ACT), WSP(long long, WS_SS) + (size_t)j * MTOK, DFF};
                pg8::gemm_phase<pg8::EpiSwiGLU, pg8::StaticOrder, PG8_ALIGN, PG8_SP2>(lds, gm, S, E); }
        } else {
            constexpr int kind = layer % 3, ji = layer / 3;
            PH(base) { TID(); KArgs ka = kargs();
                pg8::Gemm gm{WSP(bf16, WS_HB), WSP(bf16, WS_WIN) + (size_t)layer * NINP * DM, MTOK, NINP, DM}; pg8::StaticOrder S; S.init(MTOK, NINP, gridDim.x, bx);
                pg8::EpiMixIn E{WSP(bf16, WS_P1), WSP(float, WS_G), WSP(long long, WS_SS) + (size_t)j * MTOK};
                pg8::gemm_phase<pg8::EpiMixIn, pg8::StaticOrder, PG8_ALIGN, PG8_SP2>(lds, gm, S, E); }
            PH(base + 1) { TID(); KArgs ka = kargs();
                if constexpr (kind == 0) mlstm_scan(lds, WSP(bf16, WS_P1), WSP(float, WS_G), ka->in[6] + ji * 16, WSP(float, WS_HRAW), tid, lane, wave, bx);
                else if constexpr (kind == 1) fox_cf(WSP(float, WS_G), ka->in[10] + ji * 16, WSP(float, WS_CF), lane, wave, bx);
                else gla_scan(lds, WSP(bf16, WS_P1), WSP(float, WS_G), ka->in[13] + (size_t)ji * 16 * 1024, ka->in[14] + ji * 1024, WSP(float, WS_HRAW), tid, lane, wave, bx);
            }
            PH(base + 2) { TID(); KArgs ka = kargs();
                if constexpr (kind == 0) headnorm_gate<256, 0>(WSP(float, WS_HRAW), WSP(bf16, WS_P1), ka->in[7] + ji * DM, WSP(bf16, WS_HM), lane, wave, bx);
                else if constexpr (kind == 1) fox_attn(lds, WSP(bf16, WS_P1), WSP(float, WS_CF), WSP(bf16, WS_HM), tid, lane, wave, bx);
                else headnorm_gate<512, 1>(WSP(float, WS_HRAW), WSP(bf16, WS_P1), ka->in[15] + ji * DM, WSP(bf16, WS_HM), lane, wave, bx);
            }
        }
        PH(base + 3) { TID(); KArgs ka = kargs();
            pg8::Gemm gm; float scale;
            if constexpr (typ != 1) { const int mi = layer * 2 + (typ >> 1); gm = pg8::Gemm{WSP(bf16, WS_ACT), WSP(bf16, WS_WDN) + (size_t)mi * DM * DFF, MTOK, DM, DFF}; scale = 0.5f; }
            else { gm = pg8::Gemm{WSP(bf16, WS_HM), WSP(bf16, WS_WOUT) + (size_t)layer * DM * DM, MTOK, DM, DM}; scale = 1.0f; }
            pg8::StaticOrder S; S.init(MTOK, DM, gridDim.x, bx);
            pg8::EpiResid E{(j == 0) ? ka->in[0] : (const float*)ka->out, ka->out, WSP(bf16, WS_HB), WSP(long long, WS_SS) + (size_t)(j + 1) * MTOK, scale};
            pg8::gemm_phase<pg8::EpiResid, pg8::StaticOrder, PG8_ALIGN, PG8_SP2>(lds, gm, S, E);
        }
    }
}

__global__ void __launch_bounds__(NWAVES * 64, 2) trunk_fwd(Args args) {
    extern __shared__ __attribute__((aligned(16))) unsigned char lds_raw[];
    LAS unsigned char* lds = (LAS unsigned char*)lds_raw;
    volatile LAS unsigned* MISC = (volatile LAS unsigned*)(lds + MISC_OFF);
    for (int u = threadIdx.x; u < (LDS_BYTES - MISC_OFF) / 4; u += NWAVES * 64) ((LAS unsigned*)(lds + MISC_OFF))[u] = 0u;
    __syncthreads();
    XcdBarrier bar = xcd_barrier_post((unsigned*)(args.ws + WS_CTL) + CW_BAR, MISC + 8);
    const int lo = args.ph_lo, hi = args.ph_hi; bool ran = false;

    PH(0) { TID(); prologue(lds, lane, wave, bx); }

    subblock<0>(lds, bar, lo, hi, ran); subblock<1>(lds, bar, lo, hi, ran); subblock<2>(lds, bar, lo, hi, ran); subblock<3>(lds, bar, lo, hi, ran);
    subblock<4>(lds, bar, lo, hi, ran); subblock<5>(lds, bar, lo, hi, ran); subblock<6>(lds, bar, lo, hi, ran); subblock<7>(lds, bar, lo, hi, ran);
    subblock<8>(lds, bar, lo, hi, ran); subblock<9>(lds, bar, lo, hi, ran); subblock<10>(lds, bar, lo, hi, ran); subblock<11>(lds, bar, lo, hi, ran);
    PH(NPHASE - 1) { TID(); KArgs ka = kargs(); final_norm(ka->out, WSP(long long, WS_SS) + (size_t)NSUB * MTOK, ka->in[17], lane, wave, bx); }
#undef WSP
#undef PH
}

static bool phase_exists(int p) {
    if (p == 0 || p == NPHASE - 1) return true;
    const int j = (p - 1) / 5, k = (p - 1) % 5, typ = j % 3;
    if (k == 0 || k == 3) return true;
    if (k == 4) return false;
    return typ == 1;
}
extern "C" void kernel_launch(void* const* d_in, const int* in_sizes, int n_in, void* d_out, int out_size, void* d_ws, size_t ws_size, hipStream_t stream) {
    static int grid = 0;
    if (grid == 0) {
        if (n_in != 18 || in_sizes[0] != MTOK * DM || out_size != MTOK * DM || ws_size < WS_END) { fprintf(stderr, "kernel_launch: unexpected shapes (n_in %d, in0 %d, out %d, ws %zu < %zu)\n", n_in, n_in > 0 ? in_sizes[0] : -1, out_size, ws_size, (size_t)WS_END); grid = -1; return; }
        int dev = 0, cus = 0, per_cu = 0;
        if (hipGetDevice(&dev) != hipSuccess || hipDeviceGetAttribute(&cus, hipDeviceAttributeMultiprocessorCount, dev) != hipSuccess) { grid = -1; return; }
        if (hipFuncSetAttribute((const void*)trunk_fwd, hipFuncAttributeMaxDynamicSharedMemorySize, LDS_BYTES) != hipSuccess) { fprintf(stderr, "kernel_launch: hipFuncSetAttribute failed\n"); grid = -1; return; }
        if (hipOccupancyMaxActiveBlocksPerMultiprocessor(&per_cu, (const void*)trunk_fwd, NWAVES * 64, LDS_BYTES) != hipSuccess || per_cu < 1) fprintf(stderr, "kernel_launch: occupancy query says %d\n", per_cu);
        (void)hipGetLastError();
        grid = cus;
    }
    if (grid < 0) return;
    if (hipMemsetAsync((char*)d_ws + WS_CTL, 0, CTL_ZERO_BYTES, stream) != hipSuccess) return;
    Args a{};
    for (int i = 0; i < 18; ++i) a.in[i] = (const float*)d_in[i];
    a.out = (float*)d_out; a.ws = (unsigned char*)d_ws;
#if MK_PER_PHASE
    for (int p = 0; p < NPHASE; ++p) { if (!phase_exists(p)) continue; a.ph_lo = p; a.ph_hi = p + 1; hipLaunchKernelGGL(trunk_fwd, dim3(grid), dim3(NWAVES * 64), LDS_BYTES, stream, a); }
#else
    a.ph_lo = 0; a.ph_hi = NPHASE; hipLaunchKernelGGL(trunk_fwd, dim3(grid), dim3(NWAVES * 64), LDS_BYTES, stream, a);
#endif
    (void)phase_exists;
}
```

```cpp
#include <hip/hip_runtime.h>
#include <cstdio>
#include <cstdint>
namespace pg8 {
#define PG8_LAS __attribute__((address_space(3)))
typedef unsigned short bf16_t;
typedef short bf16x8 __attribute__((ext_vector_type(8)));
typedef float f32x4 __attribute__((ext_vector_type(4)));
typedef unsigned u32x4 __attribute__((ext_vector_type(4)));
constexpr int BM = 256, BK = 64, HALF = 128, HTB = HALF * BK * 2  , STAGE_BYTES = 8 * HTB, NXCD = 8, WGM = 8;

__host__ __device__ __forceinline__ int lds_byte(int r, int c) { const int st = (r >> 4) * 2 + (c >> 5), rr = r & 15, cc = c & 31, ob = rr * 64 + cc * 2; return st * 1024 + (ob ^ (((ob >> 9) & 1) << 5)); }
__host__ __device__ __forceinline__ void stage_rc(int b, int& R, int& C) { const int st = b / 1024, sb = b % 1024, swz = sb ^ (((sb >> 9) & 1) << 5); R = (st >> 1) * 16 + swz / 64; C = (st & 1) * 32 + (swz % 64) / 2; }
__host__ __device__ __forceinline__ int perm32(int rho) { const int n = rho >> 4, i = rho & 15; return 8 * (i >> 2) + 4 * n + (i & 3); }

struct Unit { int pm, pn; };
struct Gemm { const bf16_t* A; const bf16_t* Bt; int M, N, K; };

struct StaticOrder {
    int nM, nN, nwg, G, c;
    __host__ __device__ void init(int M, int N, int G_, int c_) { nM = M / BM; nN = N / BM; nwg = nM * nN; G = G_; c = c_; }
    __host__ __device__ bool next(int i, Unit& u) const {
        const long L = (long)i * G + c; if (L >= nwg) return false;
        int wgid = (int)L; { const int q = nwg / NXCD, r = nwg % NXCD, xcd = wgid % NXCD, off = wgid / NXCD; wgid = (xcd < r ? xcd * (q + 1) : r * (q + 1) + (xcd - r) * q) + off; }
        const int nig = WGM * nN, gid = wgid / nig, fm = gid * WGM, gsz = (nM - fm) < WGM ? (nM - fm) : WGM;
        u.pm = fm + ((wgid % nig) % gsz); u.pn = (wgid % nig) / gsz; return true;
    }
    __device__ __forceinline__ void a_ready(const Unit&) const {}
    __device__ __forceinline__ void done(const Unit&) const {}
};

__device__ __forceinline__ unsigned cvt_pk_bf16(float lo, float hi) { unsigned r; asm volatile("v_cvt_pk_bf16_f32 %0, %1, %2" : "=v"(r) : "v"(lo), "v"(hi)); return r; }
constexpr float RMS_EPS_F = 1e-6f, SS_FIX = 1048576.0f, SS_UNFIX_D = 1.0f / (1048576.0f * 2048.0f);
typedef long long ss_t;
__device__ __forceinline__ float rstd_of(const ss_t* ss, int row) { return rsqrtf((float)ss[row] * SS_UNFIX_D + RMS_EPS_F); }
struct EpiSwiGLU {
    static constexpr bool PERM = true, AFTER_DRAIN = false;
    bf16_t* O; const ss_t* ss; int ldo;
    __device__ __forceinline__ void operator()(const f32x4 (&acc)[2][2][4][2], const Unit& u, int wr, int wc, int fr, int fq) const {
        const int row0 = u.pm * BM + wr * 64 + fr, col0 = u.pn * HALF + wc * 32 + 8 * fq;
#pragma unroll
        for (int ai = 0; ai < 2; ++ai)
#pragma unroll
            for (int m = 0; m < 4; ++m) {
                const int row = row0 + ai * HALF + m * 16;
                const float rs = rstd_of(ss, row);
                float o[8];
#pragma unroll
                for (int n = 0; n < 2; ++n)
#pragma unroll
                    for (int j = 0; j < 4; ++j) { const float a = acc[ai][0][m][n][j] * rs, b = acc[ai][1][m][n][j] * rs;
                        o[4 * n + j] = a * b * __builtin_amdgcn_rcpf(1.0f + __expf(-a)); }
                u32x4 w; w.x = cvt_pk_bf16(o[0], o[1]); w.y = cvt_pk_bf16(o[2], o[3]); w.z = cvt_pk_bf16(o[4], o[5]); w.w = cvt_pk_bf16(o[6], o[7]);
                *(u32x4*)(O + (size_t)row * ldo + col0) = w;
            }
    }
};
struct EpiMixIn {
    static constexpr bool PERM = true, AFTER_DRAIN = false;
    bf16_t* O; float* G; const ss_t* ss;
    __device__ __forceinline__ void operator()(const f32x4 (&acc)[2][2][4][2], const Unit& u, int wr, int wc, int fr, int fq) const {
        const int row0 = u.pm * BM + wr * 64 + fr;
        if (u.pn < 24) {
            const int col0 = u.pn * BM + wc * 32 + 8 * fq;
#pragma unroll
            for (int ai = 0; ai < 2; ++ai)
#pragma unroll
                for (int m = 0; m < 4; ++m) {
                    const int row = row0 + ai * HALF + m * 16;
                    const float rs = rstd_of(ss, row);
#pragma unroll
                    for (int bj = 0; bj < 2; ++bj) { const f32x4 v0 = acc[ai][bj][m][0] * rs, v1 = acc[ai][bj][m][1] * rs;
                        u32x4 w; w.x = cvt_pk_bf16(v0[0], v0[1]); w.y = cvt_pk_bf16(v0[2], v0[3]); w.z = cvt_pk_bf16(v1[0], v1[1]); w.w = cvt_pk_bf16(v1[2], v1[3]);
                        *(u32x4*)(O + (size_t)row * 6144 + col0 + bj * HALF) = w; }
                }
        } else if (wc == 0 && fq < 2) {
#pragma unroll
            for (int ai = 0; ai < 2; ++ai)
#pragma unroll
                for (int m = 0; m < 4; ++m) {
                    const int row = row0 + ai * HALF + m * 16;
                    const float rs = rstd_of(ss, row);
#pragma unroll
                    for (int n = 0; n < 2; ++n) *(f32x4*)(G + (size_t)row * 16 + 8 * fq + 4 * n) = acc[ai][0][m][n] * rs;
                }
        }
    }
};
struct EpiResid {
    static constexpr bool PERM = false, AFTER_DRAIN = false;
    const float* res; float* hout; bf16_t* hb; ss_t* ssn; float scale;
    __device__ __forceinline__ void operator()(const f32x4 (&acc)[2][2][4][2], const Unit& u, int wr, int wc, int fr, int fq) const {
        typedef unsigned u32x2v __attribute__((ext_vector_type(2)));
        const int row0 = u.pm * BM + wr * 64 + fr, col0 = u.pn * BM + wc * 32 + 4 * fq;
#pragma unroll
        for (int ai = 0; ai < 2; ++ai)
#pragma unroll
            for (int m = 0; m < 4; ++m) {
                const int row = row0 + ai * HALF + m * 16; const size_t off = (size_t)row * 2048 + col0; float sq = 0.f;
#pragma unroll
                for (int bj = 0; bj < 2; ++bj)
#pragma unroll
                    for (int n = 0; n < 2; ++n) { const size_t o2 = off + bj * HALF + n * 16;
                        const f32x4 r = *(const f32x4*)(res + o2); const f32x4 hn = r + acc[ai][bj][m][n] * scale;
                        *(f32x4*)(hout + o2) = hn; u32x2v w; w.x = cvt_pk_bf16(hn[0], hn[1]); w.y = cvt_pk_bf16(hn[2], hn[3]); *(u32x2v*)(hb + o2) = w;
                        sq += (hn[0] * hn[0] + hn[1] * hn[1]) + (hn[2] * hn[2] + hn[3] * hn[3]); }
                sq += __shfl_xor(sq, 16); sq += __shfl_xor(sq, 32);
                if (fq == 0) atomicAdd((unsigned long long*)(ssn + row), (unsigned long long)__float2ll_rn(sq * SS_FIX));
            }
    }
};

template <class Epi, class Sched, bool ALIGN_EPI = false, bool SP2 = false>
__device__ __forceinline__ void gemm_phase(PG8_LAS unsigned char* lds, const Gemm g, const Sched& S, const Epi& E) {
    int tid_ = threadIdx.x; asm volatile("" : "+v"(tid_));
    const int tid = tid_, wid = __builtin_amdgcn_readfirstlane(tid >> 6), lane = tid & 63, wr = wid >> 2, wc = wid & 3, fr = lane & 15, fq = lane >> 4;
    const int K = g.K, nt = K / BK;
    unsigned voffA[2], voffB[2];
#pragma unroll
    for (int i = 0; i < 2; ++i) { int R, C; stage_rc(tid * 16 + i * 8192, R, C); const int Rb = Epi::PERM ? ((R & ~31) + perm32(R & 31)) : R;
        voffA[i] = (unsigned)(R * K + C) * 2u; voffB[i] = (unsigned)(Rb * K + C) * 2u; }
    const size_t kstep = (size_t)(BK * 2);
    const size_t hstep = (size_t)HALF * K * 2;
    const size_t tstep = 2 * hstep;
    const unsigned ldsw = (unsigned)wid * 1024u;
    const int aoff = lds_byte(wr * 64 + fr, fq * 8), boff = lds_byte(wc * 32 + fr, fq * 8);
#define PG8_SA(b, h) (((b) * 2 + (h)) * HTB)
#define PG8_SB(b, h) ((4 + (b) * 2 + (h)) * HTB)
#define PG8_STAGE(bufoff, gbase, voff) do { _Pragma("unroll") for (int _i = 0; _i < 2; ++_i) \
        __builtin_amdgcn_global_load_lds((const unsigned*)((const char*)(gbase) + (voff)[_i]), (PG8_LAS unsigned*)(lds + (bufoff) + ldsw + _i * 8192), 16, 0, 0); } while (0)
#define PG8_LDA(dst, b, h) do { _Pragma("unroll") for (int m = 0; m < 4; ++m) _Pragma("unroll") for (int k = 0; k < 2; ++k) dst[m][k] = *(const PG8_LAS bf16x8*)(lds + PG8_SA(b, h) + aoff + m * 2048 + k * 1024); } while (0)
#define PG8_LDB(dst, b, h) do { _Pragma("unroll") for (int n = 0; n < 2; ++n) _Pragma("unroll") for (int k = 0; k < 2; ++k) dst[n][k] = *(const PG8_LAS bf16x8*)(lds + PG8_SB(b, h) + boff + n * 2048 + k * 1024); } while (0)
#define PG8_MMA(ai, bj, At, Bt) do { __builtin_amdgcn_s_setprio(1); _Pragma("unroll") for (int m = 0; m < 4; ++m) _Pragma("unroll") for (int n = 0; n < 2; ++n) _Pragma("unroll") for (int k = 0; k < 2; ++k) \
        acc[ai][bj][m][n] = __builtin_amdgcn_mfma_f32_16x16x32_bf16(Bt[n][k], At[m][k], acc[ai][bj][m][n], 0, 0, 0); __builtin_amdgcn_s_setprio(0); } while (0)
#define PG8_WAIT_V(n) asm volatile("s_waitcnt vmcnt(" #n ")" ::: "memory")
#define PG8_WAIT_L(n) asm volatile("s_waitcnt lgkmcnt(" #n ")" ::: "memory")
#define PG8_BAR __builtin_amdgcn_s_barrier()
#define PG8_SCHED __builtin_amdgcn_sched_barrier(0)
    Unit cur, nxt; int ui = 0;
    if (!S.next(0, cur)) return;
    f32x4 acc[2][2][4][2];
#pragma unroll
    for (int a = 0; a < 2; ++a)
#pragma unroll
        for (int b = 0; b < 2; ++b)
#pragma unroll
            for (int m = 0; m < 4; ++m)
#pragma unroll
                for (int n = 0; n < 2; ++n) acc[a][b][m][n] = (f32x4){0.f, 0.f, 0.f, 0.f};
    bf16x8 At[4][2], B0[2][2], B1[2][2];
    const char* cA = (const char*)g.A + (size_t)cur.pm * tstep; const char* cB = (const char*)g.Bt + (size_t)cur.pn * tstep;
    S.a_ready(cur);
    if constexpr (SP2) {
        PG8_STAGE(PG8_SB(0, 0), cB, voffB); PG8_STAGE(PG8_SB(0, 1), cB + hstep, voffB); PG8_STAGE(PG8_SA(0, 0), cA, voffA); PG8_STAGE(PG8_SA(0, 1), cA + hstep, voffA);
        if (wr == 1) PG8_BAR;
        PG8_WAIT_V(2); PG8_BAR;
        PG8_STAGE(PG8_SB(1, 0), cB + kstep, voffB); PG8_STAGE(PG8_SA(1, 0), cA + kstep, voffA); PG8_STAGE(PG8_SB(1, 1), cB + hstep + kstep, voffB);
        PG8_WAIT_V(6); PG8_BAR;
    } else {
        PG8_STAGE(PG8_SB(0, 0), cB, voffB); PG8_STAGE(PG8_SA(0, 0), cA, voffA); PG8_STAGE(PG8_SB(0, 1), cB + hstep, voffB); PG8_STAGE(PG8_SA(0, 1), cA + hstep, voffA);
        if (wr == 1) PG8_BAR;
        PG8_WAIT_V(4); PG8_BAR;
        PG8_STAGE(PG8_SB(1, 0), cB + kstep, voffB); PG8_STAGE(PG8_SA(1, 0), cA + kstep, voffA); PG8_STAGE(PG8_SB(1, 1), cB + hstep + kstep, voffB);
        PG8_WAIT_V(6); PG8_BAR;
    }
    for (;;) {
        const bool has_next = S.next(ui + 1, nxt);
        const char* nA = has_next ? (const char*)g.A + (size_t)nxt.pm * tstep : cA; const char* nB = has_next ? (const char*)g.Bt + (size_t)nxt.pn * tstep : cB;
        for (int t = 0; t < nt; t += 2) {
            const bool last = (t == nt - 2);
            const char* a1 = cA + (size_t)(t + 1) * kstep;
            const char* a2 = last ? nA : cA + (size_t)(t + 2) * kstep; const char* b2 = last ? nB : cB + (size_t)(t + 2) * kstep;
            const char* a3 = a2 + kstep; const char* b3 = b2 + kstep;
            if (last && has_next) S.a_ready(nxt);
            if constexpr (SP2) {
            PG8_LDB(B0, 0, 0); PG8_LDB(B1, 0, 1); PG8_SCHED; PG8_LDA(At, 0, 0); PG8_STAGE(PG8_SA(1, 1), a1 + hstep, voffA);
            PG8_WAIT_V(8); PG8_WAIT_L(0); PG8_BAR; PG8_MMA(0, 0, At, B0); PG8_MMA(0, 1, At, B1); PG8_BAR; PG8_SCHED;
            PG8_LDA(At, 0, 1); PG8_STAGE(PG8_SB(0, 0), b2, voffB); PG8_STAGE(PG8_SB(0, 1), b2 + hstep, voffB); PG8_STAGE(PG8_SA(0, 0), a2, voffA);
            PG8_WAIT_V(8); PG8_WAIT_L(0); PG8_BAR; PG8_MMA(1, 0, At, B0); PG8_MMA(1, 1, At, B1); PG8_BAR; PG8_SCHED;
            PG8_LDB(B0, 1, 0); PG8_LDB(B1, 1, 1); PG8_SCHED; PG8_LDA(At, 1, 0); PG8_STAGE(PG8_SA(0, 1), a2 + hstep, voffA);
            PG8_WAIT_V(8); PG8_WAIT_L(0); PG8_BAR; PG8_MMA(0, 0, At, B0); PG8_MMA(0, 1, At, B1); PG8_BAR; PG8_SCHED;
            PG8_LDA(At, 1, 1); PG8_STAGE(PG8_SB(1, 0), b3, voffB); PG8_STAGE(PG8_SB(1, 1), b3 + hstep, voffB); PG8_STAGE(PG8_SA(1, 0), a3, voffA);
            PG8_WAIT_V(8); PG8_WAIT_L(0); PG8_BAR; PG8_MMA(1, 0, At, B0); PG8_MMA(1, 1, At, B1); PG8_BAR; PG8_SCHED;
            } else {
            PG8_LDB(B0, 0, 0); PG8_SCHED; PG8_LDA(At, 0, 0); PG8_STAGE(PG8_SA(1, 1), a1 + hstep, voffA);
            PG8_WAIT_L(8); PG8_BAR; PG8_WAIT_L(0); PG8_MMA(0, 0, At, B0); PG8_BAR; PG8_SCHED;
            PG8_LDB(B1, 0, 1); PG8_STAGE(PG8_SB(0, 0), b2, voffB);
            PG8_BAR; PG8_WAIT_L(0); PG8_MMA(0, 1, At, B1); PG8_BAR;
            PG8_LDA(At, 0, 1); PG8_STAGE(PG8_SA(0, 0), a2, voffA);
            PG8_BAR; PG8_WAIT_L(0); PG8_MMA(1, 0, At, B0); PG8_BAR; PG8_SCHED;
            PG8_STAGE(PG8_SB(0, 1), b2 + hstep, voffB);
            PG8_WAIT_V(6); PG8_BAR; PG8_MMA(1, 1, At, B1); PG8_BAR;
            PG8_LDB(B0, 1, 0); PG8_SCHED; PG8_LDA(At, 1, 0); PG8_STAGE(PG8_SA(0, 1), a2 + hstep, voffA);
            PG8_WAIT_L(8); PG8_BAR; PG8_WAIT_L(0); PG8_MMA(0, 0, At, B0); PG8_BAR; PG8_SCHED;
            PG8_LDB(B1, 1, 1); PG8_STAGE(PG8_SB(1, 0), b3, voffB);
            PG8_BAR; PG8_WAIT_L(0); PG8_MMA(0, 1, At, B1); PG8_BAR;
            PG8_LDA(At, 1, 1); PG8_STAGE(PG8_SA(1, 0), a3, voffA);
            PG8_BAR; PG8_WAIT_L(0); PG8_MMA(1, 0, At, B0); PG8_BAR; PG8_SCHED;
            PG8_STAGE(PG8_SB(1, 1), b3 + hstep, voffB);
            PG8_WAIT_V(6); PG8_BAR; PG8_MMA(1, 1, At, B1); PG8_BAR;
            }
        }
        if constexpr (ALIGN_EPI) { if (wr == 0) PG8_BAR; }
        if constexpr (!Epi::AFTER_DRAIN) { E(acc, cur, wr, wc, fr, fq); S.done(cur); }
        if (!has_next) break;
#pragma unroll
        for (int a = 0; a < 2; ++a)
#pragma unroll
            for (int b = 0; b < 2; ++b)
#pragma unroll
                for (int m = 0; m < 4; ++m)
#pragma unroll
                    for (int n = 0; n < 2; ++n) acc[a][b][m][n] = (f32x4){0.f, 0.f, 0.f, 0.f};
        cur = nxt; cA = nA; cB = nB; ++ui;
        if constexpr (ALIGN_EPI) { if (wr == 1) PG8_BAR; }
    }
    PG8_WAIT_V(0);
    if constexpr (!ALIGN_EPI) { if (wr == 0) PG8_BAR; }
    PG8_BAR;
    if constexpr (Epi::AFTER_DRAIN) { E.fused(acc, cur, wr, wc, fr, fq, lds, wid, lane); S.done(cur); }
#undef PG8_SA
#undef PG8_SB
#undef PG8_STAGE
#undef PG8_LDA
#undef PG8_LDB
#undef PG8_MMA
#undef PG8_WAIT_V
#undef PG8_WAIT_L
#undef PG8_BAR
#undef PG8_SCHED
}
}

#ifndef PG8_SP2
#define PG8_SP2 true
#endif
#ifndef PG8_ALIGN
#define PG8_ALIGN true
#endif
#ifndef REP_PRO
#define REP_PRO 1
#endif
#ifndef REP_MLSTM
#define REP_MLSTM 1
#endif
#ifndef REP_FOX
#define REP_FOX 1
#endif
#ifndef REP_GLA
#define REP_GLA 1
#endif
#ifndef MK_PER_PHASE
#define MK_PER_PHASE 0
#endif

constexpr int DM = 2048, BATCH = 8, SEQ = 4096, MTOK = BATCH * SEQ, DEPTH = 4, DFF = 5632, NUP = 2 * DFF, NIN = 6160, NINP = 6400, NQKV = 6144;
constexpr int NWAVES = 8;
constexpr int NSUB = 3 * DEPTH;
constexpr int NPHASE = 2 + 5 * NSUB;

constexpr size_t MiB = 1u << 20;
constexpr size_t WS_CTL = 0, CTL_ZERO_BYTES = 5 * MiB;
constexpr size_t WS_SS = 1 * MiB;
constexpr size_t WS_WUP = 8 * MiB;
constexpr size_t WS_WDN = WS_WUP + 352 * MiB;
constexpr size_t WS_WIN = WS_WDN + 176 * MiB;
constexpr size_t WS_WOUT = WS_WIN + 100 * MiB;
constexpr size_t WS_HB = WS_WOUT + 32 * MiB;
constexpr size_t WS_ACT = WS_HB + 128 * MiB;
constexpr size_t WS_P1 = WS_ACT + 352 * MiB;
constexpr size_t WS_G = WS_P1 + 384 * MiB;
constexpr size_t WS_HRAW = WS_G + 2 * MiB;
constexpr size_t WS_HM = WS_HRAW + 256 * MiB;
constexpr size_t WS_CF = WS_HM + 128 * MiB;
constexpr size_t WS_END = WS_CF + 2 * MiB;
static_assert((size_t)8 * NUP * DM * 2 == 352 * MiB && (size_t)8 * DM * DFF * 2 == 176 * MiB && (size_t)4 * NINP * DM * 2 == 100 * MiB, "weight regions");
static_assert((size_t)MTOK * DFF * 2 == 352 * MiB && (size_t)MTOK * NQKV * 2 == 384 * MiB && WS_SS + 13 * (size_t)MTOK * 8 <= CTL_ZERO_BYTES, "activation regions");
constexpr int CW_BAR = 4096;

constexpr int LDS_BYTES = 153600, MISC_OFF = 152576;

#define GAS __attribute__((address_space(1)))
#define LAS __attribute__((address_space(3)))
#define DI __device__ __forceinline__
typedef unsigned short bf16;
typedef unsigned v4u __attribute__((ext_vector_type(4)));
typedef unsigned v2u __attribute__((ext_vector_type(2)));
typedef float f32x4 __attribute__((ext_vector_type(4)));
typedef short bf16x8 __attribute__((ext_vector_type(8)));
typedef GAS unsigned gu32;
#define RLX_AGENT __ATOMIC_RELAXED, __HIP_MEMORY_SCOPE_AGENT
#define LDS_WAIT() asm volatile("s_waitcnt lgkmcnt(0)" ::: "memory")
DI unsigned f2bf(float f) { unsigned u = __builtin_bit_cast(unsigned, f); return (u + 0x7fffu + ((u >> 16) & 1u)) >> 16; }
DI unsigned pk2(float lo, float hi) { return f2bf(lo) | (f2bf(hi) << 16); }
DI float bf2f(unsigned short v) { return __builtin_bit_cast(float, (unsigned)v << 16); }
DI float bflo(unsigned w) { return __builtin_bit_cast(float, w << 16); }
DI float bfhi(unsigned w) { return __builtin_bit_cast(float, w & 0xffff0000u); }
DI float logsig(float x) { return fminf(x, 0.f) - log1pf(expf(-fabsf(x))); }

#define XB_TMO      128
#define XB_XCNT(j)  (256  + 64 * (j))
#define XB_XSUB(j)  (1280 + 64 * (j))
#define XB_XGEN(j)  (2304 + 64 * (j))
#define XB_TOP      3328
#define XB_TOPGEN   3392
#define XCD_BAR_WORDS 3456
#define XB_SPIN_CAP (1u << 18)

__device__ __forceinline__ unsigned xb_ld(unsigned* p)              { return __hip_atomic_load(p, __ATOMIC_RELAXED, __HIP_MEMORY_SCOPE_AGENT); }
__device__ __forceinline__ unsigned xb_add(unsigned* p, unsigned v) { return __hip_atomic_fetch_add(p, v, __ATOMIC_RELAXED, __HIP_MEMORY_SCOPE_AGENT); }
__device__ __forceinline__ unsigned xb_xcc_id() { return (unsigned)__builtin_amdgcn_s_getreg((3 << 11) | 20) & 0xFu; }
#define XB_SPIN(cond, bar) do { unsigned _sp = 0; while (cond) { __builtin_amdgcn_s_sleep(1); \
    if ((++_sp & 255u) == 0u) { if (xb_ld(&(bar)[XB_TMO])) break; if (_sp > XB_SPIN_CAP) { atomicAdd(&(bar)[XB_TMO], 1u); break; } } } } while (0)

struct XcdBarrier {
    unsigned* bar; unsigned x;
    volatile LAS unsigned* st;
};

__device__ __forceinline__ XcdBarrier xcd_barrier_post(unsigned* bar, volatile LAS unsigned* st) {
    XcdBarrier b; b.bar = bar; b.x = xb_xcc_id(); b.st = st;
    if (threadIdx.x == 0) (void)xb_add(&bar[XB_XCNT(b.x)], 1u);
    return b;
}
__device__ __forceinline__ void xcd_barrier_complete(unsigned* bar, unsigned x, unsigned& nloc, unsigned& nx) {
    const unsigned G = gridDim.x * gridDim.y * gridDim.z;
    unsigned sum, cnt, mine, sp = 0u;
    for (;;) {
        sum = 0u; cnt = 0u; mine = 0u;
#pragma unroll
        for (unsigned j = 0; j < 16; ++j) { const unsigned c = xb_ld(&bar[XB_XCNT(j)]); sum += c; cnt += (c > 0u) ? 1u : 0u; mine = (j == x) ? c : mine; }
        if (sum == G) break;
        __builtin_amdgcn_s_sleep(1);
        if ((++sp & 255u) == 0u) { if (xb_ld(&bar[XB_TMO])) break; if (sp > XB_SPIN_CAP) { atomicAdd(&bar[XB_TMO], 1u); break; } }
    }
    nloc = mine > 0u ? mine : 1u; nx = cnt > 0u ? cnt : 1u;
}

__device__ __forceinline__ void xcd_barrier(const XcdBarrier& b) {
    asm volatile("s_waitcnt vmcnt(0)" ::: "memory");
    __syncthreads();
    if (threadIdx.x == 0) {
        unsigned* bar = b.bar;
        __builtin_amdgcn_s_waitcnt(0);
        unsigned nloc = b.st[0], nx = b.st[1];
        if (nloc == 0u) { xcd_barrier_complete(bar, b.x, nloc, nx); b.st[0] = nloc; b.st[1] = nx; }
        const unsigned old = xb_add(&bar[XB_XSUB(b.x)], 1u);
        const unsigned gen = old / nloc;
        if (old + 1u == (gen + 1u) * nloc) {
            __builtin_amdgcn_fence(__ATOMIC_RELEASE, "agent");
            asm volatile("s_waitcnt vmcnt(0)" ::: "memory");
            const unsigned og = xb_add(&bar[XB_TOP], 1u);
            const unsigned tg = og / nx;
            if (og + 1u == (tg + 1u) * nx) xb_add(&bar[XB_TOPGEN], 1u);
            else XB_SPIN(xb_ld(&bar[XB_TOPGEN]) == tg, bar);
            __builtin_amdgcn_fence(__ATOMIC_ACQUIRE, "agent");
            xb_add(&bar[XB_XGEN(b.x)], 1u);
            asm volatile("s_waitcnt vmcnt(0)" ::: "memory");
        } else {
            XB_SPIN(xb_ld(&bar[XB_XGEN(b.x)]) == gen, bar);
            __builtin_amdgcn_fence(__ATOMIC_ACQUIRE, "agent");
            asm volatile("s_waitcnt vmcnt(0)" ::: "memory");
        }
    }
    __syncthreads();
}


DI float wave_sum(float v) {
#pragma unroll
    for (int o = 1; o < 64; o <<= 1) v += __shfl_xor(v, o);
    return v;
}
DI float wave_max(float v) {
#pragma unroll
    for (int o = 1; o < 64; o <<= 1) v = fmaxf(v, __shfl_xor(v, o));
    return v;
}
DI float wave_incl_sum(float v, int lane) {
#pragma unroll
    for (int o = 1; o < 64; o <<= 1) { const float t = __shfl_up(v, o); if (lane >= o) v += t; }
    return v;
}
DI float wave_incl_max(float v, int lane) {
#pragma unroll
    for (int o = 1; o < 64; o <<= 1) { const float t = __shfl_up(v, o); if (lane >= o) v = fmaxf(v, t); }
    return v;
}

template <int L> DI int swx(int r) { return L == 64 ? ((r >> 1) & 7) : (r & 15); }
template <int L> DI int eoff(int r, int c) { return r * L + ((((c >> 3) ^ swx<L>(r)) << 3) | (c & 7)); }
template <int L> DI bf16x8 ldf(const LAS bf16* base, int r, int ch) { return *(const LAS bf16x8*)(base + r * L + ((ch ^ swx<L>(r)) << 3)); }
DI f32x4 mfma16(bf16x8 a, bf16x8 b, f32x4 c) { return __builtin_amdgcn_mfma_f32_16x16x32_bf16(a, b, c, 0, 0, 0); }
template <int LA, int LB, int NK> DI void mma_tile(f32x4& acc, const LAS bf16* A, int ra0, const LAS bf16* B, int rb0, int lane) {
    const int r = lane & 15, g = lane >> 4;
#pragma unroll
    for (int kk = 0; kk < NK; ++kk) { const bf16x8 a = ldf<LA>(A, ra0 + r, 4 * kk + g), b = ldf<LB>(B, rb0 + r, 4 * kk + g); acc = mfma16(a, b, acc); }
}

DI void conv_item(const float* W, int K, int N, int nblk, const float* gk, bf16* WT, int mode, LAS float* scr, int item, int lane) {
    const int kb = item / nblk, nb = item - kb * nblk, k0 = 64 * kb, n0 = 32 * nb;
    const int n = n0 + (lane & 31); const bool ok = n < N;
#pragma unroll 8
    for (int i = 0; i < 32; ++i) { const int kk = 2 * i + (lane >> 5); float v = ok ? W[(size_t)(k0 + kk) * N + n] : 0.f; if (gk) v *= gk[k0 + kk]; scr[kk * 33 + (lane & 31)] = v; }
    LDS_WAIT(); asm volatile("" ::: "memory");
    int row_off = n0;
    if (mode == 1) { const int j = n0 < DFF ? n0 : n0 - DFF; row_off = 256 * (j >> 7) + (j & 127) + (n0 < DFF ? 0 : 128); }
    const int c = lane & 7;
#pragma unroll
    for (int j = 0; j < 4; ++j) { const int nn = (lane >> 3) + 8 * j; const LAS float* s = scr + (8 * c) * 33 + nn;
        v4u o; o.x = pk2(s[0 * 33], s[1 * 33]); o.y = pk2(s[2 * 33], s[3 * 33]); o.z = pk2(s[4 * 33], s[5 * 33]); o.w = pk2(s[6 * 33], s[7 * 33]);
        *(v4u*)(WT + (size_t)(row_off + nn) * K + k0 + 8 * c) = o; }
    LDS_WAIT(); asm volatile("" ::: "memory");
}

struct Args { const float* in[18]; float* out; unsigned char* ws; int ph_lo, ph_hi; };

typedef const __attribute__((address_space(4))) Args* KArgs;
DI KArgs kargs() { KArgs p = (KArgs)__builtin_amdgcn_kernarg_segment_ptr(); asm volatile("" : "+s"(p)); return p; }
DI void prologue(LAS unsigned char* lds, int lane, int wave, int bx) {
    KArgs AP = kargs();
    LAS float* scr = (LAS float*)(lds + wave * 16384);
    const int gw = bx * NWAVES + wave, NGW = gridDim.x * NWAVES;
    unsigned char* ws = AP->ws;
    constexpr int I_UP = (DM / 64) * (NUP / 32), I_DN = (DFF / 64) * (DM / 32), I_IN = (DM / 64) * (NINP / 32), I_OUT = (DM / 64) * (DM / 32);
    constexpr int NITEMS = 8 * I_UP + 8 * I_DN + 4 * I_IN + 4 * I_OUT;
    for (int it = gw; it < NITEMS; it += NGW) {
        int r = it; const float* W; const float* gk = nullptr; bf16* WT; int K = DM, N, nblk, mode = 0;
        if (r < 8 * I_UP) { const int mi = r / I_UP; r -= mi * I_UP; W = AP->in[2] + (size_t)mi * DM * NUP; gk = AP->in[1] + (size_t)mi * DM; WT = (bf16*)(ws + WS_WUP) + (size_t)mi * NUP * DM; N = NUP; nblk = NUP / 32; mode = 1; }
        else if (r < 8 * I_UP + 8 * I_DN) { r -= 8 * I_UP; const int mi = r / I_DN; r -= mi * I_DN; W = AP->in[3] + (size_t)mi * DFF * DM; WT = (bf16*)(ws + WS_WDN) + (size_t)mi * DM * DFF; K = DFF; N = DM; nblk = DM / 32; }
        else if (r < 8 * I_UP + 8 * I_DN + 4 * I_IN) { r -= 8 * I_UP + 8 * I_DN; const int l = r / I_IN; r -= l * I_IN; const int kind = l % 3, ji = l / 3;
            W = AP->in[kind == 0 ? 5 : kind == 1 ? 9 : 12] + (size_t)ji * DM * NIN; gk = AP->in[4] + (size_t)l * DM; WT = (bf16*)(ws + WS_WIN) + (size_t)l * NINP * DM; N = NIN; nblk = NINP / 32; }
        else { r -= 8 * I_UP + 8 * I_DN + 4 * I_IN; const int l = r / I_OUT; r -= l * I_OUT; const int kind = l % 3, ji = l / 3;
            W = AP->in[kind == 0 ? 8 : kind == 1 ? 11 : 16] + (size_t)ji * DM * DM; WT = (bf16*)(ws + WS_WOUT) + (size_t)l * DM * DM; N = DM; nblk = DM / 32; }
        conv_item(W, K, N, nblk, gk, WT, mode, scr, r, lane);
    }
    const float* x = AP->in[0]; bf16* hb = (bf16*)(ws + WS_HB); long long* ss0 = (long long*)(ws + WS_SS);
    for (int m = gw; m < MTOK; m += NGW) {
        const f32x4* xr = (const f32x4*)(x + (size_t)m * DM) + lane; f32x4 v[8]; float s = 0.f;
#pragma unroll
        for (int j = 0; j < 8; ++j) { v[j] = xr[64 * j]; s += (v[j].x * v[j].x + v[j].y * v[j].y) + (v[j].z * v[j].z + v[j].w * v[j].w); }
        s = wave_sum(s);
        v2u* o8 = (v2u*)(hb + (size_t)m * DM) + lane;
#pragma unroll
        for (int j = 0; j < 8; ++j) { v2u w; w.x = pk2(v[j].x, v[j].y); w.y = pk2(v[j].z, v[j].w); o8[64 * j] = w; }
        if (lane == 0) ss0[m] = __float2ll_rn(s * 1048576.0f);
    }
}

constexpr int IMGM_P = 0, IMGM_KT = 8192, IMGM_VT = IMGM_KT + 16384, IMGM_GS = IMGM_VT + 4 * 8192, IMGM_BYTES = IMGM_GS + 1024;
constexpr int IMGG_Q = 0, IMGG_KT = 32768, IMGG_P = 65536, IMGG_VT = IMGG_P + 8192, IMGG_EB = IMGG_VT + 8 * 8192, IMGG_BYTES = IMGG_EB + 1024;
static_assert((size_t)IMGM_BYTES * 4096 <= 352 * MiB && (size_t)IMGG_BYTES * 2048 <= 352 * MiB, "images overlay the (idle) FFN activation buffer");
DI float logsig_fast(float x) { return fminf(x, 0.f) - __logf(1.0f + __expf(-fabsf(x))); }

DI void mlstm_pre(LAS unsigned char* lds, const bf16* P1, const float* G, const float* b_if, unsigned char* img, int tid, int lane, int wave, int bx) {
    LAS bf16* Qs = (LAS bf16*)lds;
    LAS bf16* Ks = Qs + 64 * 128;
    LAS bf16* KTs = Ks + 64 * 128;
    LAS bf16* Ps = KTs + 128 * 64;
    LAS bf16* VT = Ps + 64 * 64;
    LAS float* fa = (LAS float*)(VT + 256 * 64);
    LAS float *bcum = fa, *ipre = fa + 64, *aloc = fa + 128, *wloc = fa + 192, *scal = fa + 256;
    const float KSCALE = 0.08838834764831845f;
    const int g = lane >> 4, r16 = lane & 15;
    for (int item = bx; item < 4096; item += gridDim.x) {
        const int b = item >> 9, c = (item >> 3) & 63, h = item & 7;
        const int row0 = b * SEQ + c * 64;
        unsigned char* im = img + (size_t)item * IMGM_BYTES;
        __syncthreads();
        if (tid < 64) { const float* gp = G + (size_t)(row0 + tid) * 16; ipre[tid] = gp[h] + b_if[h]; bcum[tid] = logsig(gp[8 + h] + b_if[8 + h]); }
#pragma unroll
        for (int p = 0; p < 2; ++p) { const int idx = tid + 512 * p, r = idx >> 4, c8 = idx & 15; const bf16* src = P1 + (size_t)(row0 + r) * NQKV + h * 128 + c8 * 8;
            const v4u vq = *(const v4u*)src, vk = *(const v4u*)(src + 1024);
            *(LAS v4u*)(Qs + eoff<128>(r, c8 * 8)) = vq; *(LAS v4u*)(Ks + eoff<128>(r, c8 * 8)) = vk; }
#pragma unroll
        for (int p = 0; p < 4; ++p) { const int idx = tid + 512 * p, r = idx >> 5, c8 = idx & 31; const v4u vv = *(const v4u*)(P1 + (size_t)(row0 + r) * NQKV + 2048 + h * 256 + c8 * 8);
#pragma unroll
            for (int j = 0; j < 4; ++j) { VT[eoff<64>(c8 * 8 + 2 * j, r)] = (bf16)(vv[j] & 0xffffu); VT[eoff<64>(c8 * 8 + 2 * j + 1, r)] = (bf16)(vv[j] >> 16); } }
        __syncthreads();
        if (wave == 0) {
            const float bt = wave_incl_sum(bcum[lane], lane), ip = ipre[lane];
            const float al = bt + wave_incl_max(ip - bt, lane);
            const float blast = __shfl(bt, 63);
            const float gg = blast - bt + ip;
            const float gmax = wave_max(gg);
            bcum[lane] = bt; aloc[lane] = al; wloc[lane] = expf(gg - gmax);
            if (lane == 0) { scal[0] = blast; scal[1] = gmax; }
        }
        __syncthreads();
#pragma unroll
        for (int p = 0; p < 2; ++p) { const int idx = tid + 512 * p, s = idx >> 4, c8 = idx & 15; const v4u kv = *(const LAS v4u*)(Ks + eoff<128>(s, c8 * 8)); const float w = wloc[s] * KSCALE;
#pragma unroll
            for (int j = 0; j < 4; ++j) { KTs[eoff<64>(c8 * 8 + 2 * j, s)] = (bf16)f2bf(bflo(kv[j]) * w); KTs[eoff<64>(c8 * 8 + 2 * j + 1, s)] = (bf16)f2bf(bfhi(kv[j]) * w); } }
        { const int tt = wave >> 1;
#pragma unroll
          for (int q2 = 0; q2 < 2; ++q2) { const int st = 2 * (wave & 1) + q2; f32x4 acc = (f32x4){0.f, 0.f, 0.f, 0.f};
            if (st <= tt) mma_tile<128, 128, 4>(acc, Qs, 16 * tt, Ks, 16 * st, lane);
            const int s = 16 * st + r16; const float cs = ipre[s] - bcum[s];
#pragma unroll
            for (int i = 0; i < 4; ++i) { const int t = 16 * tt + 4 * g + i; const float p = (s <= t) ? acc[i] * KSCALE * expf(bcum[t] + cs - aloc[t]) : 0.f; Ps[eoff<64>(t, s)] = (bf16)f2bf(p); } } }
        __syncthreads();
        *(v4u*)(im + IMGM_P + tid * 16) = *(const LAS v4u*)((LAS unsigned char*)Ps + tid * 16);
#pragma unroll
        for (int p = 0; p < 2; ++p) *(v4u*)(im + IMGM_KT + (tid + 512 * p) * 16) = *(const LAS v4u*)((LAS unsigned char*)KTs + (tid + 512 * p) * 16);
#pragma unroll
        for (int p = 0; p < 4; ++p) *(v4u*)(im + IMGM_VT + (tid + 512 * p) * 16) = *(const LAS v4u*)((LAS unsigned char*)VT + (tid + 512 * p) * 16);
        if (tid < 64) { float* gs = (float*)(im + IMGM_GS); gs[tid] = bcum[tid]; gs[64 + tid] = aloc[tid]; if (tid < 2) gs[128 + tid] = scal[tid]; }
    }
}

DI void mlstm_scan2(LAS unsigned char* lds, const bf16* P1, const unsigned char* img, float* hraw, int tid, int lane, int wave, int bx) {
    LAS bf16* Ps = (LAS bf16*)lds;
    LAS bf16* Qs = Ps + 64 * 64;
    LAS bf16* KTs = Qs + 64 * 128;
    LAS bf16* VTs = KTs + 128 * 64;
    LAS float* gsl = (LAS float*)(VTs + 80 * 64);
    LAS bf16* CT0 = (LAS bf16*)(gsl + 256);
    const int g = lane >> 4, r16 = lane & 15, tt = wave >> 1, eh = wave & 1;
    for (int item = bx; item < 256; item += gridDim.x) {
        const int b = item >> 5, h = (item >> 2) & 7, sl = item & 3;
        f32x4 Cacc[5];
#pragma unroll
        for (int e = 0; e < 5; ++e) Cacc[e] = (f32x4){0.f, 0.f, 0.f, 0.f};
        __syncthreads();
        for (int i = tid; i < 2 * 80 * 128 / 8; i += 512) ((LAS v4u*)CT0)[i] = (v4u){0u, 0u, 0u, 0u};
        for (int i = tid; i < 16 * 64 / 8; i += 512) ((LAS v4u*)(VTs + 64 * 64))[i] = (i < 8) ? (v4u){0x3f803f80u, 0x3f803f80u, 0x3f803f80u, 0x3f803f80u} : (v4u){0u, 0u, 0u, 0u};
        float m_prev = 0.f;
        v4u rp, rq[2], rk[2], rv; float rg0 = 0.f, rbl, rgm;
#define MLS_PREFETCH(cc) do { const int item2 = (b * 64 + (cc)) * 8 + h; const unsigned char* im = img + (size_t)item2 * IMGM_BYTES; const int row0 = b * SEQ + (cc) * 64; \
            rp = *(const v4u*)(im + IMGM_P + tid * 16); rk[0] = *(const v4u*)(im + IMGM_KT + tid * 16); rk[1] = *(const v4u*)(im + IMGM_KT + (tid + 512) * 16); \
            rv = *(const v4u*)(im + IMGM_VT + sl * 8192 + tid * 16); \
            _Pragma("unroll") for (int p = 0; p < 2; ++p) { const int idx = tid + 512 * p, r = idx >> 4, c8 = idx & 15; rq[p] = *(const v4u*)(P1 + (size_t)(row0 + r) * NQKV + h * 128 + c8 * 8); } \
            const float* gs = (const float*)(im + IMGM_GS); if (tid < 128) rg0 = gs[tid]; rbl = gs[128]; rgm = gs[129]; } while (0)
        MLS_PREFETCH(0);
        for (int c = 0; c < 64; ++c) {
            const int row0 = b * SEQ + c * 64;
            LAS bf16* CTc = CT0 + (c & 1) * 80 * 128; LAS bf16* CTn = CT0 + ((c + 1) & 1) * 80 * 128;
            __syncthreads();
            *(LAS v4u*)((LAS unsigned char*)Ps + tid * 16) = rp;
            *(LAS v4u*)((LAS unsigned char*)KTs + tid * 16) = rk[0]; *(LAS v4u*)((LAS unsigned char*)KTs + (tid + 512) * 16) = rk[1];
            *(LAS v4u*)((LAS unsigned char*)VTs + tid * 16) = rv;
#pragma unroll
            for (int p = 0; p < 2; ++p) { const int idx = tid + 512 * p, r = idx >> 4, c8 = idx & 15; *(LAS v4u*)(Qs + eoff<128>(r, c8 * 8)) = rq[p]; }
            if (tid < 128) gsl[tid] = rg0;
            const float blast = rbl, gmax = rgm;
            __syncthreads();
            if (c + 1 < 64) MLS_PREFETCH(c + 1);
            const f32x4 btv = *(const LAS f32x4*)(gsl + 16 * tt + 4 * g), alv = *(const LAS f32x4*)(gsl + 64 + 16 * tt + 4 * g);
            float al[4], be[4], em[4];
#pragma unroll
            for (int i = 0; i < 4; ++i) { const float mt = fmaxf(btv[i] + m_prev, alv[i]); al[i] = expf(alv[i] - mt); be[i] = expf(btv[i] + m_prev - mt); em[i] = expf(-mt); }
            const float m_new = fmaxf(blast + m_prev, gmax), wcs = expf(blast + m_prev - m_new), gam = expf(gmax - m_new);
            m_prev = m_new;
            f32x4 d1 = (f32x4){0.f, 0.f, 0.f, 0.f}, d2 = (f32x4){0.f, 0.f, 0.f, 0.f};
            mma_tile<64, 64, 2>(d1, Ps, 16 * tt, VTs, 64, lane); mma_tile<128, 128, 4>(d2, Qs, 16 * tt, CTc, 64, lane);
            float dinv[4];
#pragma unroll
            for (int i = 0; i < 4; ++i) { const float den = __shfl(al[i] * d1[i] + be[i] * d2[i], lane & 48); dinv[i] = 1.0f / fmaxf(fabsf(den), em[i]); }
#pragma unroll
            for (int q2 = 0; q2 < 2; ++q2) { const int et = 2 * eh + q2, e = 16 * et + r16; f32x4 a1 = (f32x4){0.f, 0.f, 0.f, 0.f}, a2 = (f32x4){0.f, 0.f, 0.f, 0.f};
                mma_tile<64, 64, 2>(a1, Ps, 16 * tt, VTs, 16 * et, lane); mma_tile<128, 128, 4>(a2, Qs, 16 * tt, CTc, 16 * et, lane);
#pragma unroll
                for (int i = 0; i < 4; ++i) { const int t = 16 * tt + 4 * g + i; hraw[(size_t)(row0 + t) * DM + h * 256 + sl * 64 + e] = (al[i] * a1[i] + be[i] * a2[i]) * dinv[i]; } }
#pragma unroll
            for (int et = 0; et < 5; ++et) { f32x4 tmp = (f32x4){0.f, 0.f, 0.f, 0.f}; mma_tile<64, 64, 2>(tmp, KTs, 16 * wave, VTs, 16 * et, lane);
                Cacc[et] = Cacc[et] * wcs + tmp * gam;
                v2u w; w.x = pk2(Cacc[et][0], Cacc[et][1]); w.y = pk2(Cacc[et][2], Cacc[et][3]);
                *(LAS v2u*)(CTn + eoff<128>(16 * et + r16, 16 * wave + 4 * g)) = w; }
        }
#undef MLS_PREFETCH
    }
}

DI void gla_pre(LAS unsigned char* lds, const bf16* P1, const float* G, const float* w_alpha, const float* b_alpha, unsigned char* img, int tid, int lane, int wave, int bx) {
    LAS bf16* VT = (LAS bf16*)lds;
    LAS bf16* QTs = (LAS bf16*)lds;
    LAS bf16* KTl = QTs + 64 * 256;
    LAS bf16* KTT = KTl + 64 * 256;
    LAS bf16* Ps = KTT + 256 * 64;
    LAS float* alow = (LAS float*)(Ps + 64 * 64);
    LAS float* T0 = alow + 1024;
    const int g = lane >> 4, r16 = lane & 15, d = tid & 255, sh = tid >> 8;
    for (int item = bx; item < 2048; item += gridDim.x) {
        const int b = item >> 8, c = (item >> 2) & 63, h = item & 3;
        const int row0 = b * SEQ + c * 64;
        unsigned char* im = img + (size_t)item * IMGG_BYTES;
        __syncthreads();
#pragma unroll
        for (int p = 0; p < 8; ++p) { const int idx = tid + 512 * p, r = idx >> 6, c8 = idx & 63; const v4u vv = *(const v4u*)(P1 + (size_t)(row0 + r) * NQKV + 2048 + h * 512 + c8 * 8);
#pragma unroll
            for (int j = 0; j < 4; ++j) { VT[eoff<64>(c8 * 8 + 2 * j, r)] = (bf16)(vv[j] & 0xffffu); VT[eoff<64>(c8 * 8 + 2 * j + 1, r)] = (bf16)(vv[j] >> 16); } }
        float wa[16];
#pragma unroll
        for (int i = 0; i < 16; ++i) wa[i] = w_alpha[i * 1024 + h * 256 + d];
        const float ba = b_alpha[h * 256 + d];
        f32x4 al4 = (f32x4){0.f, 0.f, 0.f, 0.f};
        if (tid < 256) al4 = *(const f32x4*)(G + (size_t)(row0 + (tid >> 2)) * 16 + (tid & 3) * 4);
        __syncthreads();
#pragma unroll
        for (int p = 0; p < 8; ++p) *(v4u*)(im + IMGG_VT + (tid + 512 * p) * 16) = *(const LAS v4u*)((LAS unsigned char*)VT + (tid + 512 * p) * 16);
        __syncthreads();
        if (tid < 256) *(LAS f32x4*)(alow + tid * 4) = al4;
        __syncthreads();
        const bf16* qsrc = P1 + (size_t)(row0 + 32 * sh) * NQKV + h * 256 + d;
        float bs[32]; float run = 0.f;
#pragma unroll
        for (int j = 0; j < 32; ++j) { const int s = 32 * sh + j; float z = ba;
#pragma unroll
            for (int i = 0; i < 16; ++i) z += alow[s * 16 + i] * wa[i];
            run += logsig_fast(z) * (1.0f / 16.0f); bs[j] = run; }
        if (sh == 0) T0[d] = run;
        __syncthreads();
        const float add = sh ? T0[d] : 0.f;
        if (sh) ((float*)(im + IMGG_EB))[d] = __expf(run + add);
#pragma unroll
        for (int q8 = 0; q8 < 4; ++q8) { unsigned kk[8];
#pragma unroll
            for (int j = 0; j < 8; ++j) { const int jj = 8 * q8 + j, s = 32 * sh + jj; const float bsum = bs[jj] + add;
                const float qv = bf2f(qsrc[(size_t)jj * NQKV]) * 0.0625f * __expf(bsum), kv = bf2f(qsrc[(size_t)jj * NQKV + 1024]) * __expf(-bsum);
                QTs[eoff<256>(s, d)] = (bf16)f2bf(qv); kk[j] = f2bf(kv); KTl[eoff<256>(s, d)] = (bf16)kk[j]; }
            v4u w; w.x = kk[0] | (kk[1] << 16); w.y = kk[2] | (kk[3] << 16); w.z = kk[4] | (kk[5] << 16); w.w = kk[6] | (kk[7] << 16);
            *(LAS v4u*)(KTT + eoff<64>(d, 32 * sh + 8 * q8)) = w; }
        __syncthreads();
        { const int tt = wave >> 1;
#pragma unroll
          for (int q2 = 0; q2 < 2; ++q2) { const int st = 2 * (wave & 1) + q2; f32x4 acc = (f32x4){0.f, 0.f, 0.f, 0.f};
            if (st <= tt) mma_tile<256, 256, 8>(acc, QTs, 16 * tt, KTl, 16 * st, lane);
            const int s = 16 * st + r16;
#pragma unroll
            for (int i = 0; i < 4; ++i) { const int t = 16 * tt + 4 * g + i; Ps[eoff<64>(t, s)] = (bf16)f2bf((s <= t) ? acc[i] : 0.f); } } }
        __syncthreads();
#pragma unroll
        for (int p = 0; p < 4; ++p) { *(v4u*)(im + IMGG_Q + (tid + 512 * p) * 16) = *(const LAS v4u*)((LAS unsigned char*)QTs + (tid + 512 * p) * 16);
                                      *(v4u*)(im + IMGG_KT + (tid + 512 * p) * 16) = *(const LAS v4u*)((LAS unsigned char*)KTT + (tid + 512 * p) * 16); }
        *(v4u*)(im + IMGG_P + tid * 16) = *(const LAS v4u*)((LAS unsigned char*)Ps + tid * 16);
    }
}

DI void gla_scan2(LAS unsigned char* lds, const unsigned char* img, float* hraw, int tid, int lane, int wave, int bx) {
    LAS bf16* QTs = (LAS bf16*)lds;
    LAS bf16* KTT = QTs + 64 * 256;
    LAS bf16* Ps = KTT + 256 * 64;
    LAS bf16* VTs = Ps + 64 * 64;
    LAS float* eb = (LAS float*)(VTs + 64 * 64);
    LAS bf16* ST0 = (LAS bf16*)(eb + 256);
    const int g = lane >> 4, r16 = lane & 15, tt = wave >> 1, eh = wave & 1;
    for (int item = bx; item < 256; item += gridDim.x) {
        const int b = item >> 5, h = (item >> 3) & 3, sl = item & 7;
        f32x4 Sacc[2][4];
#pragma unroll
        for (int a = 0; a < 2; ++a)
#pragma unroll
            for (int e = 0; e < 4; ++e) Sacc[a][e] = (f32x4){0.f, 0.f, 0.f, 0.f};
        __syncthreads();
        for (int i = tid; i < 2 * 64 * 256 / 8; i += 512) ((LAS v4u*)ST0)[i] = (v4u){0u, 0u, 0u, 0u};
        v4u rq[4], rk[4], rp, rv; float re = 0.f;
#define GLS_PREFETCH(cc) do { const int item2 = (b * 64 + (cc)) * 4 + h; const unsigned char* im = img + (size_t)item2 * IMGG_BYTES; \
            _Pragma("unroll") for (int p = 0; p < 4; ++p) { rq[p] = *(const v4u*)(im + IMGG_Q + (tid + 512 * p) * 16); rk[p] = *(const v4u*)(im + IMGG_KT + (tid + 512 * p) * 16); } \
            rp = *(const v4u*)(im + IMGG_P + tid * 16); rv = *(const v4u*)(im + IMGG_VT + sl * 8192 + tid * 16); if (tid < 256) re = ((const float*)(im + IMGG_EB))[tid]; } while (0)
        GLS_PREFETCH(0);
        for (int c = 0; c < 64; ++c) {
            const int row0 = b * SEQ + c * 64;
            LAS bf16* STc = ST0 + (c & 1) * 64 * 256; LAS bf16* STn = ST0 + ((c + 1) & 1) * 64 * 256;
            __syncthreads();
#pragma unroll
            for (int p = 0; p < 4; ++p) { *(LAS v4u*)((LAS unsigned char*)QTs + (tid + 512 * p) * 16) = rq[p]; *(LAS v4u*)((LAS unsigned char*)KTT + (tid + 512 * p) * 16) = rk[p]; }
            *(LAS v4u*)((LAS unsigned char*)Ps + tid * 16) = rp; *(LAS v4u*)((LAS unsigned char*)VTs + tid * 16) = rv;
            if (tid < 256) eb[tid] = re;
            __syncthreads();
            if (c + 1 < 64) GLS_PREFETCH(c + 1);
#pragma unroll
            for (int q2 = 0; q2 < 2; ++q2) { const int et = 2 * eh + q2, e = 16 * et + r16; f32x4 acc = (f32x4){0.f, 0.f, 0.f, 0.f};
                mma_tile<64, 64, 2>(acc, Ps, 16 * tt, VTs, 16 * et, lane); mma_tile<256, 256, 8>(acc, QTs, 16 * tt, STc, 16 * et, lane);
#pragma unroll
                for (int i = 0; i < 4; ++i) { const int t = 16 * tt + 4 * g + i; hraw[(size_t)(row0 + t) * DM + h * 512 + sl * 64 + e] = acc[i]; } }
#pragma unroll
            for (int a = 0; a < 2; ++a) { const int dt = 2 * wave + a;
                const f32x4 ev = *(const LAS f32x4*)(eb + 16 * dt + 4 * g);
#pragma unroll
                for (int et = 0; et < 4; ++et) { mma_tile<64, 64, 2>(Sacc[a][et], KTT, 16 * dt, VTs, 16 * et, lane); Sacc[a][et] = Sacc[a][et] * ev;
                    v2u w; w.x = pk2(Sacc[a][et][0], Sacc[a][et][1]); w.y = pk2(Sacc[a][et][2], Sacc[a][et][3]);
                    *(LAS v2u*)(STn + eoff<256>(16 * et + r16, 16 * dt + 4 * g)) = w; } }
        }
#undef GLS_PREFETCH
    }
}


template <int HS, int ACT> DI void headnorm_gate(const float* hraw, const bf16* P1, const float* gnorm, bf16* hm, int lane, int wave, int bx) {
    constexpr int NH = DM / HS, EPL = HS / 64;
    const int gw = bx * NWAVES + wave, NGW = gridDim.x * NWAVES;
    for (int row = gw; row < MTOK; row += NGW) {
#pragma unroll
        for (int hh = 0; hh < NH; ++hh) { const int col = hh * HS + lane * EPL;
            float x[EPL]; float s = 0.f;
#pragma unroll
            for (int j = 0; j < EPL; j += 4) { const f32x4 v = *(const f32x4*)(hraw + (size_t)row * DM + col + j); x[j] = v.x; x[j + 1] = v.y; x[j + 2] = v.z; x[j + 3] = v.w; s += (v.x * v.x + v.y * v.y) + (v.z * v.z + v.w * v.w); }
            s = wave_sum(s); const float rs = rsqrtf(s * (1.0f / HS) + 1e-6f);
            unsigned outw[EPL / 2];
#pragma unroll
            for (int j = 0; j < EPL; j += 2) { const unsigned gw2 = *(const unsigned*)(P1 + (size_t)row * NQKV + 4096 + col + j); const float g0 = bflo(gw2), g1 = bfhi(gw2);
                const float a0 = ACT == 0 ? 1.0f / (1.0f + expf(-g0)) : g0 / (1.0f + expf(-g0)), a1 = ACT == 0 ? 1.0f / (1.0f + expf(-g1)) : g1 / (1.0f + expf(-g1));
                outw[j / 2] = pk2(x[j] * rs * gnorm[col + j] * a0, x[j + 1] * rs * gnorm[col + j + 1] * a1); }
            if constexpr (EPL == 4) { v2u w; w.x = outw[0]; w.y = outw[1]; *(v2u*)(hm + (size_t)row * DM + col) = w; }
            else { v4u w; w.x = outw[0]; w.y = outw[1]; w.z = outw[2]; w.w = outw[3]; *(v4u*)(hm + (size_t)row * DM + col) = w; }
        }
    }
}

DI void fox_cf(const float* G, const float* b_f, float* cf, int lane, int wave, int bx) {
    const int gw = bx * NWAVES + wave, NGW = gridDim.x * NWAVES;
    for (int seq = gw; seq < 128; seq += NGW) { const int b = seq >> 4, h = seq & 15; const float bias = b_f[h];
        const float* gp = G + ((size_t)b * SEQ + lane * 64) * 16 + h; float s = 0.f;
        for (int p = 0; p < 64; ++p) s += logsig(gp[p * 16] + bias);
        float run = wave_incl_sum(s, lane) - s;
        float* o = cf + (size_t)seq * SEQ + lane * 64;
        for (int p = 0; p < 64; ++p) { run += logsig(gp[p * 16] + bias); o[p] = run; }
    }
}

DI void fox_attn(LAS unsigned char* lds, const bf16* P1, const float* cf, bf16* hm, int tid, int lane, int wave, int bx) {
    LAS bf16* Ks = (LAS bf16*)lds;
    LAS bf16* VTs = Ks + 64 * 128;
    LAS float* cfs = (LAS float*)(VTs + 128 * 64);
    const float LOG2E = 1.4426950408889634f, QS = 0.08838834764831845f * 1.4426950408889634f;
    const int g = lane >> 4, r16 = lane & 15;
    const int G_ = gridDim.x;
    const int nit = (2048 + G_ - 1) / G_;
    for (int it = 0; it < nit; ++it) {
        const int u = (it & 1) ? it * G_ + (G_ - 1 - bx) : it * G_ + bx;
        if (u >= 2048) continue;
        const int qb = 15 - (u >> 7), bh = u & 127, b = bh >> 4, h = bh & 15;
        const size_t rowb = (size_t)b * SEQ; const int q0 = qb * 256 + 32 * wave;
        bf16x8 qf[2][4]; float cft[2];
#pragma unroll
        for (int tt = 0; tt < 2; ++tt) { const int t = q0 + 16 * tt + r16; cft[tt] = cf[(size_t)bh * SEQ + t] * LOG2E;
#pragma unroll
            for (int kk = 0; kk < 4; ++kk) { const v4u raw = *(const v4u*)(P1 + (rowb + t) * NQKV + h * 128 + 32 * kk + 8 * g); v4u sc;
#pragma unroll
                for (int j = 0; j < 4; ++j) sc[j] = pk2(bflo(raw[j]) * QS, bfhi(raw[j]) * QS);
                qf[tt][kk] = __builtin_bit_cast(bf16x8, sc); } }
        f32x4 oacc[8][2];
#pragma unroll
        for (int et = 0; et < 8; ++et) { oacc[et][0] = (f32x4){0.f, 0.f, 0.f, 0.f}; oacc[et][1] = (f32x4){0.f, 0.f, 0.f, 0.f}; }
        float mrun[2] = {-1e30f, -1e30f}, lrun[2] = {0.f, 0.f};
        const int ntiles = 4 * (qb + 1);
        v4u kreg[2], vreg[2]; float cfreg = 0.f;
        const bf16* kvbase = P1 + rowb * NQKV + 2048 + h * 128;
#define FOX_PREFETCH(j) do { _Pragma("unroll") for (int p = 0; p < 2; ++p) { const int idx = tid + 512 * p, r = idx >> 4, c8 = idx & 15; const bf16* src = kvbase + (size_t)(64 * (j) + r) * NQKV + c8 * 8; \
            kreg[p] = *(const v4u*)src; vreg[p] = *(const v4u*)(src + 2048); } if (tid < 64) cfreg = cf[(size_t)bh * SEQ + 64 * (j) + tid] * LOG2E; } while (0)
        FOX_PREFETCH(0);
        for (int j = 0; j < ntiles; ++j) {
            __syncthreads();
#pragma unroll
            for (int p = 0; p < 2; ++p) { const int idx = tid + 512 * p, r = idx >> 4, c8 = idx & 15; *(LAS v4u*)(Ks + eoff<128>(r, c8 * 8)) = kreg[p];
#pragma unroll
                for (int jj = 0; jj < 4; ++jj) { VTs[eoff<64>(c8 * 8 + 2 * jj, r)] = (bf16)(vreg[p][jj] & 0xffffu); VTs[eoff<64>(c8 * 8 + 2 * jj + 1, r)] = (bf16)(vreg[p][jj] >> 16); } }
            if (tid < 64) cfs[tid] = cfreg;
            __syncthreads();
            if (j + 1 < ntiles) FOX_PREFETCH(j + 1);
            if (64 * j <= q0 + 31) {
                f32x4 sacc[2][4];
#pragma unroll
                for (int st = 0; st < 4; ++st) { const f32x4 cv = *(const LAS f32x4*)(cfs + 16 * st + 4 * g);
#pragma unroll
                    for (int tt = 0; tt < 2; ++tt) sacc[tt][st] = (f32x4){cft[tt] - cv[0], cft[tt] - cv[1], cft[tt] - cv[2], cft[tt] - cv[3]}; }
#pragma unroll
                for (int st = 0; st < 4; ++st)
#pragma unroll
                    for (int kk = 0; kk < 4; ++kk) { const bf16x8 kf = ldf<128>(Ks, 16 * st + r16, 4 * kk + g);
                        sacc[0][st] = mfma16(kf, qf[0][kk], sacc[0][st]); sacc[1][st] = mfma16(kf, qf[1][kk], sacc[1][st]); if (kk == 3) asm volatile("" ::: "memory"); }
                if (64 * j + 63 > q0) {
#pragma unroll
                    for (int tt = 0; tt < 2; ++tt) { const int t = q0 + 16 * tt + r16;
#pragma unroll
                        for (int st = 0; st < 4; ++st)
#pragma unroll
                            for (int i = 0; i < 4; ++i) { const int s = 64 * j + 16 * st + 4 * g + i; if (s > t) sacc[tt][st][i] = -__builtin_inff(); } }
                }
#pragma unroll
                for (int tt = 0; tt < 2; ++tt) { float mx = -__builtin_inff();
#pragma unroll
                    for (int st = 0; st < 4; ++st) mx = fmaxf(mx, fmaxf(fmaxf(sacc[tt][st][0], sacc[tt][st][1]), fmaxf(sacc[tt][st][2], sacc[tt][st][3])));
                    mx = fmaxf(mx, __shfl_xor(mx, 16)); mx = fmaxf(mx, __shfl_xor(mx, 32));
                    const float mnew = fmaxf(mrun[tt], mx), alpha = __builtin_amdgcn_exp2f(mrun[tt] - mnew); mrun[tt] = mnew; float ls = 0.f;
#pragma unroll
                    for (int st = 0; st < 4; ++st)
#pragma unroll
                        for (int i = 0; i < 4; ++i) { const float p = __builtin_amdgcn_exp2f(sacc[tt][st][i] - mnew); sacc[tt][st][i] = p; ls += p; }
                    lrun[tt] = lrun[tt] * alpha + ls;
#pragma unroll
                    for (int et = 0; et < 8; ++et) oacc[et][tt] = oacc[et][tt] * alpha; }
#pragma unroll
                for (int ks = 0; ks < 2; ++ks) { bf16x8 pb[2];
#pragma unroll
                    for (int tt = 0; tt < 2; ++tt) { v4u w; w.x = pk2(sacc[tt][2 * ks][0], sacc[tt][2 * ks][1]); w.y = pk2(sacc[tt][2 * ks][2], sacc[tt][2 * ks][3]);
                        w.z = pk2(sacc[tt][2 * ks + 1][0], sacc[tt][2 * ks + 1][1]); w.w = pk2(sacc[tt][2 * ks + 1][2], sacc[tt][2 * ks + 1][3]); pb[tt] = __builtin_bit_cast(bf16x8, w); }
#pragma unroll
                    for (int et = 0; et < 8; ++et) { const int e = 16 * et + r16;
                        const v2u lo = *(const LAS v2u*)(VTs + eoff<64>(e, 32 * ks + 4 * g)), hi = *(const LAS v2u*)(VTs + eoff<64>(e, 32 * ks + 16 + 4 * g));
                        v4u aw; aw.x = lo.x; aw.y = lo.y; aw.z = hi.x; aw.w = hi.y; const bf16x8 va = __builtin_bit_cast(bf16x8, aw);
                        oacc[et][0] = mfma16(va, pb[0], oacc[et][0]); oacc[et][1] = mfma16(va, pb[1], oacc[et][1]); if (et & 1) asm volatile("" ::: "memory"); } }
            }
        }
#undef FOX_PREFETCH
#pragma unroll
        for (int tt = 0; tt < 2; ++tt) { float l = lrun[tt]; l += __shfl_xor(l, 16); l += __shfl_xor(l, 32); const float inv = 1.0f / l;
            bf16* orow = hm + (rowb + q0 + 16 * tt + r16) * DM + h * 128 + 4 * g;
#pragma unroll
            for (int et = 0; et < 8; ++et) { v2u w; w.x = pk2(oacc[et][tt][0] * inv, oacc[et][tt][1] * inv); w.y = pk2(oacc[et][tt][2] * inv, oacc[et][tt][3] * inv); *(v2u*)(orow + 16 * et) = w; } }
    }
}

DI void final_norm(float* out, const long long* ss, const float* gfin, int lane, int wave, int bx) {
    const int gw = bx * NWAVES + wave, NGW = gridDim.x * NWAVES;
    for (int m = gw; m < MTOK; m += NGW) { const float rs = pg8::rstd_of(ss, m);
        f32x4* xr = (f32x4*)(out + (size_t)m * DM) + lane; const f32x4* gr = (const f32x4*)gfin + lane;
#pragma unroll
        for (int j = 0; j < 8; ++j) { const f32x4 v = xr[64 * j], gg = gr[64 * j]; xr[64 * j] = v * rs * gg; } }
}

#define PH(p) if (lo <= (p) && (p) < hi && (ran ? (xcd_barrier(bar), true) : (ran = true)))
#define TID() int tid = threadIdx.x; asm volatile("" : "+v"(tid)); const int lane = tid & 63, wave = __builtin_amdgcn_readfirstlane(tid >> 6); int bx = blockIdx.x; asm volatile("" : "+s"(bx)); (void)lane; (void)wave; (void)bx
#define WSP(T, off) ((T*)(ka->ws + (off)))
template <int j> DI void subblock(LAS unsigned char* lds, const XcdBarrier& bar, const int lo, const int hi, bool& ran) {
    {
        constexpr int layer = j / 3, typ = j - 3 * layer, base = 1 + 5 * j;
        if constexpr (typ != 1) {
            PH(base) { TID(); KArgs ka = kargs(); const int mi = layer * 2 + (typ >> 1);
                pg8::Gemm gm{WSP(bf16, WS_HB), WSP(bf16, WS_WUP) + (size_t)mi * NUP * DM, MTOK, NUP, DM}; pg8::StaticOrder S; S.init(MTOK, NUP, gridDim.x, bx);
                pg8::EpiSwiGLU E{WSP(bf16, WS_ACT), WSP(long long, WS_SS) + (size_t)j * MTOK, DFF};
                pg8::gemm_phase<pg8::EpiSwiGLU, pg8::StaticOrder, PG8_ALIGN, PG8_SP2>(lds, gm, S, E); }
        } else {
            constexpr int kind = layer % 3, ji = layer / 3;
            PH(base) { TID(); KArgs ka = kargs();
                pg8::Gemm gm{WSP(bf16, WS_HB), WSP(bf16, WS_WIN) + (size_t)layer * NINP * DM, MTOK, NINP, DM}; pg8::StaticOrder S; S.init(MTOK, NINP, gridDim.x, bx);
                pg8::EpiMixIn E{WSP(bf16, WS_P1), WSP(float, WS_G), WSP(long long, WS_SS) + (size_t)j * MTOK};
                pg8::gemm_phase<pg8::EpiMixIn, pg8::StaticOrder, PG8_ALIGN, PG8_SP2>(lds, gm, S, E); }
            PH(base + 1) { TID(); KArgs ka = kargs();
                if constexpr (kind == 0) for (int rep = 0; rep < REP_MLSTM; ++rep) mlstm_pre(lds, WSP(bf16, WS_P1), WSP(float, WS_G), ka->in[6] + ji * 16, WSP(unsigned char, WS_ACT), tid, lane, wave, bx);
                else if constexpr (kind == 1) fox_cf(WSP(float, WS_G), ka->in[10] + ji * 16, WSP(float, WS_CF), lane, wave, bx);
                else for (int rep = 0; rep < REP_GLA; ++rep) gla_pre(lds, WSP(bf16, WS_P1), WSP(float, WS_G), ka->in[13] + (size_t)ji * 16 * 1024, ka->in[14] + ji * 1024, WSP(unsigned char, WS_ACT), tid, lane, wave, bx);
            }
            PH(base + 2) { TID(); KArgs ka = kargs();
                if constexpr (kind == 0) for (int rep = 0; rep < REP_MLSTM; ++rep) mlstm_scan2(lds, WSP(bf16, WS_P1), WSP(unsigned char, WS_ACT), WSP(float, WS_HRAW), tid, lane, wave, bx);
                else if constexpr (kind == 1) for (int rep = 0; rep < REP_FOX; ++rep) fox_attn(lds, WSP(bf16, WS_P1), WSP(float, WS_CF), WSP(bf16, WS_HM), tid, lane, wave, bx);
                else for (int rep = 0; rep < REP_GLA; ++rep) gla_scan2(lds, WSP(unsigned char, WS_ACT), WSP(float, WS_HRAW), tid, lane, wave, bx);
            }
            if constexpr (kind != 1) { PH(base + 3) { TID(); KArgs ka = kargs();
                if constexpr (kind == 0) headnorm_gate<256, 0>(WSP(float, WS_HRAW), WSP(bf16, WS_P1), ka->in[7] + ji * DM, WSP(bf16, WS_HM), lane, wave, bx);
                else headnorm_gate<512, 1>(WSP(float, WS_HRAW), WSP(bf16, WS_P1), ka->in[15] + ji * DM, WSP(bf16, WS_HM), lane, wave, bx);
            } }
        }
        PH(base + 4) { TID(); KArgs ka = kargs();
            pg8::Gemm gm; float scale;
            if constexpr (typ != 1) { const int mi = layer * 2 + (typ >> 1); gm = pg8::Gemm{WSP(bf16, WS_ACT), WSP(bf16, WS_WDN) + (size_t)mi * DM * DFF, MTOK, DM, DFF}; scale = 0.5f; }
            else { gm = pg8::Gemm{WSP(bf16, WS_HM), WSP(bf16, WS_WOUT) + (size_t)layer * DM * DM, MTOK, DM, DM}; scale = 1.0f; }
            pg8::StaticOrder S; S.init(MTOK, DM, gridDim.x, bx);
            pg8::EpiResid E{(j == 0) ? ka->in[0] : (const float*)ka->out, ka->out, WSP(bf16, WS_HB), WSP(long long, WS_SS) + (size_t)(j + 1) * MTOK, scale};
            pg8::gemm_phase<pg8::EpiResid, pg8::StaticOrder, PG8_ALIGN, PG8_SP2>(lds, gm, S, E);
        }
    }
}

__global__ void __launch_bounds__(NWAVES * 64, 2) trunk_fwd(Args args) {
    extern __shared__ __attribute__((aligned(16))) unsigned char lds_raw[];
    LAS unsigned char* lds = (LAS unsigned char*)lds_raw;
    volatile LAS unsigned* MISC = (volatile LAS unsigned*)(lds + MISC_OFF);
    for (int u = threadIdx.x; u < (LDS_BYTES - MISC_OFF) / 4; u += NWAVES * 64) ((LAS unsigned*)(lds + MISC_OFF))[u] = 0u;
    __syncthreads();
    XcdBarrier bar = xcd_barrier_post((unsigned*)(args.ws + WS_CTL) + CW_BAR, MISC + 8);
    const int lo = args.ph_lo, hi = args.ph_hi; bool ran = false;

    PH(0) { TID(); for (int rep = 0; rep < REP_PRO; ++rep) { prologue(lds, lane, wave, bx); __syncthreads(); } }

    subblock<0>(lds, bar, lo, hi, ran); subblock<1>(lds, bar, lo, hi, ran); subblock<2>(lds, bar, lo, hi, ran); subblock<3>(lds, bar, lo, hi, ran);
    subblock<4>(lds, bar, lo, hi, ran); subblock<5>(lds, bar, lo, hi, ran); subblock<6>(lds, bar, lo, hi, ran); subblock<7>(lds, bar, lo, hi, ran);
    subblock<8>(lds, bar, lo, hi, ran); subblock<9>(lds, bar, lo, hi, ran); subblock<10>(lds, bar, lo, hi, ran); subblock<11>(lds, bar, lo, hi, ran);
    PH(NPHASE - 1) { TID(); KArgs ka = kargs(); final_norm(ka->out, WSP(long long, WS_SS) + (size_t)NSUB * MTOK, ka->in[17], lane, wave, bx); }
#undef WSP
#undef PH
}

static bool phase_exists(int p) {
    if (p == 0 || p == NPHASE - 1) return true;
    const int j = (p - 1) / 5, k = (p - 1) % 5, typ = j % 3;
    if (k == 0 || k == 4) return true;
    if (typ != 1) return false;
    if (k == 3) return ((j / 3) % 3) != 1;
    return true;
}
extern "C" void kernel_launch(void* const* d_in, const int* in_sizes, int n_in, void* d_out, int out_size, void* d_ws, size_t ws_size, hipStream_t stream) {
    static int grid = 0;
    if (grid == 0) {
        if (n_in != 18 || in_sizes[0] != MTOK * DM || out_size != MTOK * DM || ws_size < WS_END) { fprintf(stderr, "kernel_launch: unexpected shapes (n_in %d, in0 %d, out %d, ws %zu < %zu)\n", n_in, n_in > 0 ? in_sizes[0] : -1, out_size, ws_size, (size_t)WS_END); grid = -1; return; }
        int dev = 0, cus = 0, per_cu = 0;
        if (hipGetDevice(&dev) != hipSuccess || hipDeviceGetAttribute(&cus, hipDeviceAttributeMultiprocessorCount, dev) != hipSuccess) { grid = -1; return; }
        if (hipFuncSetAttribute((const void*)trunk_fwd, hipFuncAttributeMaxDynamicSharedMemorySize, LDS_BYTES) != hipSuccess) { fprintf(stderr, "kernel_launch: hipFuncSetAttribute failed\n"); grid = -1; return; }
        if (hipOccupancyMaxActiveBlocksPerMultiprocessor(&per_cu, (const void*)trunk_fwd, NWAVES * 64, LDS_BYTES) != hipSuccess || per_cu < 1) fprintf(stderr, "kernel_launch: occupancy query says %d\n", per_cu);
        (void)hipGetLastError();
        grid = cus;
    }
    if (grid < 0) return;
    if (hipMemsetAsync((char*)d_ws + WS_CTL, 0, CTL_ZERO_BYTES, stream) != hipSuccess) return;
    Args a{};
    for (int i = 0; i < 18; ++i) a.in[i] = (const float*)d_in[i];
    a.out = (float*)d_out; a.ws = (unsigned char*)d_ws;
#if MK_PER_PHASE
    for (int p = 0; p < NPHASE; ++p) { if (!phase_exists(p)) continue; a.ph_lo = p; a.ph_hi = p + 1; hipLaunchKernelGGL(trunk_fwd, dim3(grid), dim3(NWAVES * 64), LDS_BYTES, stream, a); }
#else
    a.ph_lo = 0; a.ph_hi = NPHASE; hipLaunchKernelGGL(trunk_fwd, dim3(grid), dim3(NWAVES * 64), LDS_BYTES, stream, a);
#endif
    (void)phase_exists;
}
```

```cpp
#include <hip/hip_runtime.h>
#include <cstdio>
#include <cstdint>
namespace pg8 {
#define PG8_LAS __attribute__((address_space(3)))
typedef unsigned short bf16_t;
typedef short bf16x8 __attribute__((ext_vector_type(8)));
typedef float f32x4 __attribute__((ext_vector_type(4)));
typedef unsigned u32x4 __attribute__((ext_vector_type(4)));
constexpr int BM = 256, BK = 64, HALF = 128, HTB = HALF * BK * 2  , STAGE_BYTES = 8 * HTB, NXCD = 8, WGM = 8;

__host__ __device__ __forceinline__ int lds_byte(int r, int c) { const int st = (r >> 4) * 2 + (c >> 5), rr = r & 15, cc = c & 31, ob = rr * 64 + cc * 2; return st * 1024 + (ob ^ (((ob >> 9) & 1) << 5)); }
__host__ __device__ __forceinline__ void stage_rc(int b, int& R, int& C) { const int st = b / 1024, sb = b % 1024, swz = sb ^ (((sb >> 9) & 1) << 5); R = (st >> 1) * 16 + swz / 64; C = (st & 1) * 32 + (swz % 64) / 2; }
__host__ __device__ __forceinline__ int perm32(int rho) { const int n = rho >> 4, i = rho & 15; return 8 * (i >> 2) + 4 * n + (i & 3); }

struct Unit { int pm, pn; };
struct Gemm { const bf16_t* A; const bf16_t* Bt; int M, N, K; };

struct StaticOrder {
    int nM, nN, nwg, G, c;
    __host__ __device__ void init(int M, int N, int G_, int c_) { nM = M / BM; nN = N / BM; nwg = nM * nN; G = G_; c = c_; }
    __host__ __device__ bool next(int i, Unit& u) const {
        const long L = (long)i * G + c; if (L >= nwg) return false;
        int wgid = (int)L; { const int q = nwg / NXCD, r = nwg % NXCD, xcd = wgid % NXCD, off = wgid / NXCD; wgid = (xcd < r ? xcd * (q + 1) : r * (q + 1) + (xcd - r) * q) + off; }
        const int nig = WGM * nN, gid = wgid / nig, fm = gid * WGM, gsz = (nM - fm) < WGM ? (nM - fm) : WGM;
        u.pm = fm + ((wgid % nig) % gsz); u.pn = (wgid % nig) / gsz; return true;
    }
    __device__ __forceinline__ void a_ready(const Unit&) const {}
    __device__ __forceinline__ void done(const Unit&) const {}
};

__device__ __forceinline__ unsigned cvt_pk_bf16(float lo, float hi) { unsigned r; asm volatile("v_cvt_pk_bf16_f32 %0, %1, %2" : "=v"(r) : "v"(lo), "v"(hi)); return r; }
constexpr float RMS_EPS_F = 1e-6f, SS_FIX = 1048576.0f, SS_UNFIX_D = 1.0f / (1048576.0f * 2048.0f);
typedef long long ss_t;
__device__ __forceinline__ float rstd_of(const ss_t* ss, int row) { return rsqrtf((float)ss[row] * SS_UNFIX_D + RMS_EPS_F); }
struct EpiSwiGLU {
    static constexpr bool PERM = true, AFTER_DRAIN = false;
    bf16_t* O; const ss_t* ss; int ldo;
    __device__ __forceinline__ void operator()(const f32x4 (&acc)[2][2][4][2], const Unit& u, int wr, int wc, int fr, int fq) const {
        const int row0 = u.pm * BM + wr * 64 + fr, col0 = u.pn * HALF + wc * 32 + 8 * fq;
#pragma unroll
        for (int ai = 0; ai < 2; ++ai)
#pragma unroll
            for (int m = 0; m < 4; ++m) {
                const int row = row0 + ai * HALF + m * 16;
                const float rs = rstd_of(ss, row);
                float o[8];
#pragma unroll
                for (int n = 0; n < 2; ++n)
#pragma unroll
                    for (int j = 0; j < 4; ++j) { const float a = acc[ai][0][m][n][j] * rs, b = acc[ai][1][m][n][j] * rs;
                        o[4 * n + j] = a * b * __builtin_amdgcn_rcpf(1.0f + __expf(-a)); }
                u32x4 w; w.x = cvt_pk_bf16(o[0], o[1]); w.y = cvt_pk_bf16(o[2], o[3]); w.z = cvt_pk_bf16(o[4], o[5]); w.w = cvt_pk_bf16(o[6], o[7]);
                *(u32x4*)(O + (size_t)row * ldo + col0) = w;
            }
    }
};
struct EpiMixIn {
    static constexpr bool PERM = true, AFTER_DRAIN = false;
    bf16_t* O; float* G; const ss_t* ss;
    __device__ __forceinline__ void operator()(const f32x4 (&acc)[2][2][4][2], const Unit& u, int wr, int wc, int fr, int fq) const {
        const int row0 = u.pm * BM + wr * 64 + fr;
        if (u.pn < 24) {
            const int col0 = u.pn * BM + wc * 32 + 8 * fq;
#pragma unroll
            for (int ai = 0; ai < 2; ++ai)
#pragma unroll
                for (int m = 0; m < 4; ++m) {
                    const int row = row0 + ai * HALF + m * 16;
                    const float rs = rstd_of(ss, row);
#pragma unroll
                    for (int bj = 0; bj < 2; ++bj) { const f32x4 v0 = acc[ai][bj][m][0] * rs, v1 = acc[ai][bj][m][1] * rs;
                        u32x4 w; w.x = cvt_pk_bf16(v0[0], v0[1]); w.y = cvt_pk_bf16(v0[2], v0[3]); w.z = cvt_pk_bf16(v1[0], v1[1]); w.w = cvt_pk_bf16(v1[2], v1[3]);
                        *(u32x4*)(O + (size_t)row * 6144 + col0 + bj * HALF) = w; }
                }
        } else if (wc == 0 && fq < 2) {
#pragma unroll
            for (int ai = 0; ai < 2; ++ai)
#pragma unroll
                for (int m = 0; m < 4; ++m) {
                    const int row = row0 + ai * HALF + m * 16;
                    const float rs = rstd_of(ss, row);
#pragma unroll
                    for (int n = 0; n < 2; ++n) *(f32x4*)(G + (size_t)row * 16 + 8 * fq + 4 * n) = acc[ai][0][m][n] * rs;
                }
        }
    }
};
struct EpiResid {
    static constexpr bool PERM = false, AFTER_DRAIN = false;
    const float* res; float* hout; bf16_t* hb; ss_t* ssn; float scale;
    __device__ __forceinline__ void operator()(const f32x4 (&acc)[2][2][4][2], const Unit& u, int wr, int wc, int fr, int fq) const {
        typedef unsigned u32x2v __attribute__((ext_vector_type(2)));
        const int row0 = u.pm * BM + wr * 64 + fr, col0 = u.pn * BM + wc * 32 + 4 * fq;
#pragma unroll
        for (int ai = 0; ai < 2; ++ai)
#pragma unroll
            for (int m = 0; m < 4; ++m) {
                const int row = row0 + ai * HALF + m * 16; const size_t off = (size_t)row * 2048 + col0; float sq = 0.f;
#pragma unroll
                for (int bj = 0; bj < 2; ++bj)
#pragma unroll
                    for (int n = 0; n < 2; ++n) { const size_t o2 = off + bj * HALF + n * 16;
                        const f32x4 r = *(const f32x4*)(res + o2); const f32x4 hn = r + acc[ai][bj][m][n] * scale;
                        *(f32x4*)(hout + o2) = hn; u32x2v w; w.x = cvt_pk_bf16(hn[0], hn[1]); w.y = cvt_pk_bf16(hn[2], hn[3]); *(u32x2v*)(hb + o2) = w;
                        sq += (hn[0] * hn[0] + hn[1] * hn[1]) + (hn[2] * hn[2] + hn[3] * hn[3]); }
                sq += __shfl_xor(sq, 16); sq += __shfl_xor(sq, 32);
                if (fq == 0) atomicAdd((unsigned long long*)(ssn + row), (unsigned long long)__float2ll_rn(sq * SS_FIX));
            }
    }
};

template <class Epi, class Sched, bool ALIGN_EPI = false, bool SP2 = false>
__device__ __forceinline__ void gemm_phase(PG8_LAS unsigned char* lds, const Gemm g, const Sched& S, const Epi& E) {
    int tid_ = threadIdx.x; asm volatile("" : "+v"(tid_));
    const int tid = tid_, wid = __builtin_amdgcn_readfirstlane(tid >> 6), lane = tid & 63, wr = wid >> 2, wc = wid & 3, fr = lane & 15, fq = lane >> 4;
    const int K = g.K, nt = K / BK;
    unsigned voffA[2], voffB[2];
#pragma unroll
    for (int i = 0; i < 2; ++i) { int R, C; stage_rc(tid * 16 + i * 8192, R, C); const int Rb = Epi::PERM ? ((R & ~31) + perm32(R & 31)) : R;
        voffA[i] = (unsigned)(R * K + C) * 2u; voffB[i] = (unsigned)(Rb * K + C) * 2u; }
    const size_t kstep = (size_t)(BK * 2);
    const size_t hstep = (size_t)HALF * K * 2;
    const size_t tstep = 2 * hstep;
    const unsigned ldsw = (unsigned)wid * 1024u;
    const int aoff = lds_byte(wr * 64 + fr, fq * 8), boff = lds_byte(wc * 32 + fr, fq * 8);
#define PG8_SA(b, h) (((b) * 2 + (h)) * HTB)
#define PG8_SB(b, h) ((4 + (b) * 2 + (h)) * HTB)
#define PG8_STAGE(bufoff, gbase, voff) do { _Pragma("unroll") for (int _i = 0; _i < 2; ++_i) \
        __builtin_amdgcn_global_load_lds((const unsigned*)((const char*)(gbase) + (voff)[_i]), (PG8_LAS unsigned*)(lds + (bufoff) + ldsw + _i * 8192), 16, 0, 0); } while (0)
#define PG8_LDA(dst, b, h) do { _Pragma("unroll") for (int m = 0; m < 4; ++m) _Pragma("unroll") for (int k = 0; k < 2; ++k) dst[m][k] = *(const PG8_LAS bf16x8*)(lds + PG8_SA(b, h) + aoff + m * 2048 + k * 1024); } while (0)
#define PG8_LDB(dst, b, h) do { _Pragma("unroll") for (int n = 0; n < 2; ++n) _Pragma("unroll") for (int k = 0; k < 2; ++k) dst[n][k] = *(const PG8_LAS bf16x8*)(lds + PG8_SB(b, h) + boff + n * 2048 + k * 1024); } while (0)
#define PG8_MMA(ai, bj, At, Bt) do { __builtin_amdgcn_s_setprio(1); _Pragma("unroll") for (int m = 0; m < 4; ++m) _Pragma("unroll") for (int n = 0; n < 2; ++n) _Pragma("unroll") for (int k = 0; k < 2; ++k) \
        acc[ai][bj][m][n] = __builtin_amdgcn_mfma_f32_16x16x32_bf16(Bt[n][k], At[m][k], acc[ai][bj][m][n], 0, 0, 0); __builtin_amdgcn_s_setprio(0); } while (0)
#define PG8_WAIT_V(n) asm volatile("s_waitcnt vmcnt(" #n ")" ::: "memory")
#define PG8_WAIT_L(n) asm volatile("s_waitcnt lgkmcnt(" #n ")" ::: "memory")
#define PG8_BAR __builtin_amdgcn_s_barrier()
#define PG8_SCHED __builtin_amdgcn_sched_barrier(0)
    Unit cur, nxt; int ui = 0;
    if (!S.next(0, cur)) return;
    f32x4 acc[2][2][4][2];
#pragma unroll
    for (int a = 0; a < 2; ++a)
#pragma unroll
        for (int b = 0; b < 2; ++b)
#pragma unroll
            for (int m = 0; m < 4; ++m)
#pragma unroll
                for (int n = 0; n < 2; ++n) acc[a][b][m][n] = (f32x4){0.f, 0.f, 0.f, 0.f};
    bf16x8 At[4][2], B0[2][2], B1[2][2];
    const char* cA = (const char*)g.A + (size_t)cur.pm * tstep; const char* cB = (const char*)g.Bt + (size_t)cur.pn * tstep;
    S.a_ready(cur);
    if constexpr (SP2) {
        PG8_STAGE(PG8_SB(0, 0), cB, voffB); PG8_STAGE(PG8_SB(0, 1), cB + hstep, voffB); PG8_STAGE(PG8_SA(0, 0), cA, voffA); PG8_STAGE(PG8_SA(0, 1), cA + hstep, voffA);
        if (wr == 1) PG8_BAR;
        PG8_WAIT_V(2); PG8_BAR;
        PG8_STAGE(PG8_SB(1, 0), cB + kstep, voffB); PG8_STAGE(PG8_SA(1, 0), cA + kstep, voffA); PG8_STAGE(PG8_SB(1, 1), cB + hstep + kstep, voffB);
        PG8_WAIT_V(6); PG8_BAR;
    } else {
        PG8_STAGE(PG8_SB(0, 0), cB, voffB); PG8_STAGE(PG8_SA(0, 0), cA, voffA); PG8_STAGE(PG8_SB(0, 1), cB + hstep, voffB); PG8_STAGE(PG8_SA(0, 1), cA + hstep, voffA);
        if (wr == 1) PG8_BAR;
        PG8_WAIT_V(4); PG8_BAR;
        PG8_STAGE(PG8_SB(1, 0), cB + kstep, voffB); PG8_STAGE(PG8_SA(1, 0), cA + kstep, voffA); PG8_STAGE(PG8_SB(1, 1), cB + hstep + kstep, voffB);
        PG8_WAIT_V(6); PG8_BAR;
    }
    for (;;) {
        const bool has_next = S.next(ui + 1, nxt);
        const char* nA = has_next ? (const char*)g.A + (size_t)nxt.pm * tstep : cA; const char* nB = has_next ? (const char*)g.Bt + (size_t)nxt.pn * tstep : cB;
        for (int t = 0; t < nt; t += 2) {
            const bool last = (t == nt - 2);
            const char* a1 = cA + (size_t)(t + 1) * kstep;
            const char* a2 = last ? nA : cA + (size_t)(t + 2) * kstep; const char* b2 = last ? nB : cB + (size_t)(t + 2) * kstep;
            const char* a3 = a2 + kstep; const char* b3 = b2 + kstep;
            if (last && has_next) S.a_ready(nxt);
            if constexpr (SP2) {
            PG8_LDB(B0, 0, 0); PG8_LDB(B1, 0, 1); PG8_SCHED; PG8_LDA(At, 0, 0); PG8_STAGE(PG8_SA(1, 1), a1 + hstep, voffA);
            PG8_WAIT_V(8); PG8_WAIT_L(0); PG8_BAR; PG8_MMA(0, 0, At, B0); PG8_MMA(0, 1, At, B1); PG8_BAR; PG8_SCHED;
            PG8_LDA(At, 0, 1); PG8_STAGE(PG8_SB(0, 0), b2, voffB); PG8_STAGE(PG8_SB(0, 1), b2 + hstep, voffB); PG8_STAGE(PG8_SA(0, 0), a2, voffA);
            PG8_WAIT_V(8); PG8_WAIT_L(0); PG8_BAR; PG8_MMA(1, 0, At, B0); PG8_MMA(1, 1, At, B1); PG8_BAR; PG8_SCHED;
            PG8_LDB(B0, 1, 0); PG8_LDB(B1, 1, 1); PG8_SCHED; PG8_LDA(At, 1, 0); PG8_STAGE(PG8_SA(0, 1), a2 + hstep, voffA);
            PG8_WAIT_V(8); PG8_WAIT_L(0); PG8_BAR; PG8_MMA(0, 0, At, B0); PG8_MMA(0, 1, At, B1); PG8_BAR; PG8_SCHED;
            PG8_LDA(At, 1, 1); PG8_STAGE(PG8_SB(1, 0), b3, voffB); PG8_STAGE(PG8_SB(1, 1), b3 + hstep, voffB); PG8_STAGE(PG8_SA(1, 0), a3, voffA);
            PG8_WAIT_V(8); PG8_WAIT_L(0); PG8_BAR; PG8_MMA(1, 0, At, B0); PG8_MMA(1, 1, At, B1); PG8_BAR; PG8_SCHED;
            } else {
            PG8_LDB(B0, 0, 0); PG8_SCHED; PG8_LDA(At, 0, 0); PG8_STAGE(PG8_SA(1, 1), a1 + hstep, voffA);
            PG8_WAIT_L(8); PG8_BAR; PG8_WAIT_L(0); PG8_MMA(0, 0, At, B0); PG8_BAR; PG8_SCHED;
            PG8_LDB(B1, 0, 1); PG8_STAGE(PG8_SB(0, 0), b2, voffB);
            PG8_BAR; PG8_WAIT_L(0); PG8_MMA(0, 1, At, B1); PG8_BAR;
            PG8_LDA(At, 0, 1); PG8_STAGE(PG8_SA(0, 0), a2, voffA);
            PG8_BAR; PG8_WAIT_L(0); PG8_MMA(1, 0, At, B0); PG8_BAR; PG8_SCHED;
            PG8_STAGE(PG8_SB(0, 1), b2 + hstep, voffB);
            PG8_WAIT_V(6); PG8_BAR; PG8_MMA(1, 1, At, B1); PG8_BAR;
            PG8_LDB(B0, 1, 0); PG8_SCHED; PG8_LDA(At, 1, 0); PG8_STAGE(PG8_SA(0, 1), a2 + hstep, voffA);
            PG8_WAIT_L(8); PG8_BAR; PG8_WAIT_L(0); PG8_MMA(0, 0, At, B0); PG8_BAR; PG8_SCHED;
            PG8_LDB(B1, 1, 1); PG8_STAGE(PG8_SB(1, 0), b3, voffB);
            PG8_BAR; PG8_WAIT_L(0); PG8_MMA(0, 1, At, B1); PG8_BAR;
            PG8_LDA(At, 1, 1); PG8_STAGE(PG8_SA(1, 0), a3, voffA);
            PG8_BAR; PG8_WAIT_L(0); PG8_MMA(1, 0, At, B0); PG8_BAR; PG8_SCHED;
            PG8_STAGE(PG8_SB(1, 1), b3 + hstep, voffB);
            PG8_WAIT_V(6); PG8_BAR; PG8_MMA(1, 1, At, B1); PG8_BAR;
            }
        }
        if constexpr (ALIGN_EPI) { if (wr == 0) PG8_BAR; }
        if constexpr (!Epi::AFTER_DRAIN) { E(acc, cur, wr, wc, fr, fq); S.done(cur); }
        if (!has_next) break;
#pragma unroll
        for (int a = 0; a < 2; ++a)
#pragma unroll
            for (int b = 0; b < 2; ++b)
#pragma unroll
                for (int m = 0; m < 4; ++m)
#pragma unroll
                    for (int n = 0; n < 2; ++n) acc[a][b][m][n] = (f32x4){0.f, 0.f, 0.f, 0.f};
        cur = nxt; cA = nA; cB = nB; ++ui;
        if constexpr (ALIGN_EPI) { if (wr == 1) PG8_BAR; }
    }
    PG8_WAIT_V(0);
    if constexpr (!ALIGN_EPI) { if (wr == 0) PG8_BAR; }
    PG8_BAR;
    if constexpr (Epi::AFTER_DRAIN) { E.fused(acc, cur, wr, wc, fr, fq, lds, wid, lane); S.done(cur); }
#undef PG8_SA
#undef PG8_SB
#undef PG8_STAGE
#undef PG8_LDA
#undef PG8_LDB
#undef PG8_MMA
#undef PG8_WAIT_V
#undef PG8_WAIT_L
#undef PG8_BAR
#undef PG8_SCHED
}
}

#ifndef PG8_SP2
#define PG8_SP2 true
#endif
#ifndef PG8_ALIGN
#define PG8_ALIGN true
#endif
#ifndef REP_PRO
#define REP_PRO 1
#endif
#ifndef REP_MLSTM
#define REP_MLSTM 1
#endif
#ifndef REP_FOX
#define REP_FOX 1
#endif
#ifndef REP_GLA
#define REP_GLA 1
#endif
#ifndef MK_PER_PHASE
#define MK_PER_PHASE 0
#endif

constexpr int DM = 2048, BATCH = 8, SEQ = 4096, MTOK = BATCH * SEQ, DEPTH = 4, DFF = 5632, NUP = 2 * DFF, NIN = 6160, NINP = 6400, NQKV = 6144;
constexpr int NWAVES = 8;
constexpr int NSUB = 3 * DEPTH;
constexpr int NPHASE = 2 + 5 * NSUB;

constexpr size_t MiB = 1u << 20;
constexpr size_t WS_CTL = 0, CTL_ZERO_BYTES = 5 * MiB;
constexpr size_t WS_SS = 1 * MiB;
constexpr size_t WS_WUP = 8 * MiB;
constexpr size_t WS_WDN = WS_WUP + 352 * MiB;
constexpr size_t WS_WIN = WS_WDN + 176 * MiB;
constexpr size_t WS_WOUT = WS_WIN + 100 * MiB;
constexpr size_t WS_HB = WS_WOUT + 32 * MiB;
constexpr size_t WS_ACT = WS_HB + 128 * MiB;
constexpr size_t WS_P1 = WS_ACT + 352 * MiB;
constexpr size_t WS_G = WS_P1 + 384 * MiB;
constexpr size_t WS_HRAW = WS_G + 2 * MiB;
constexpr size_t WS_HM = WS_HRAW + 256 * MiB;
constexpr size_t WS_CF = WS_HM + 128 * MiB;
constexpr size_t WS_END = WS_CF + 2 * MiB;
static_assert((size_t)8 * NUP * DM * 2 == 352 * MiB && (size_t)8 * DM * DFF * 2 == 176 * MiB && (size_t)4 * NINP * DM * 2 == 100 * MiB, "weight regions");
static_assert((size_t)MTOK * DFF * 2 == 352 * MiB && (size_t)MTOK * NQKV * 2 == 384 * MiB && WS_SS + 13 * (size_t)MTOK * 8 <= CTL_ZERO_BYTES, "activation regions");
constexpr int CW_BAR = 4096;

constexpr int LDS_BYTES = 153600, MISC_OFF = 152576;

#define GAS __attribute__((address_space(1)))
#define LAS __attribute__((address_space(3)))
#define DI __device__ __forceinline__
typedef unsigned short bf16;
typedef unsigned v4u __attribute__((ext_vector_type(4)));
typedef unsigned v2u __attribute__((ext_vector_type(2)));
typedef float f32x4 __attribute__((ext_vector_type(4)));
typedef short bf16x8 __attribute__((ext_vector_type(8)));
typedef GAS unsigned gu32;
#define RLX_AGENT __ATOMIC_RELAXED, __HIP_MEMORY_SCOPE_AGENT
#define LDS_WAIT() asm volatile("s_waitcnt lgkmcnt(0)" ::: "memory")
DI unsigned f2bf(float f) { unsigned u = __builtin_bit_cast(unsigned, f); return (u + 0x7fffu + ((u >> 16) & 1u)) >> 16; }
DI unsigned pk2(float lo, float hi) { return f2bf(lo) | (f2bf(hi) << 16); }
DI float bf2f(unsigned short v) { return __builtin_bit_cast(float, (unsigned)v << 16); }
DI float bflo(unsigned w) { return __builtin_bit_cast(float, w << 16); }
DI float bfhi(unsigned w) { return __builtin_bit_cast(float, w & 0xffff0000u); }
DI float logsig(float x) { return fminf(x, 0.f) - log1pf(expf(-fabsf(x))); }

#define XB_TMO      128
#define XB_XCNT(j)  (256  + 64 * (j))
#define XB_XSUB(j)  (1280 + 64 * (j))
#define XB_XGEN(j)  (2304 + 64 * (j))
#define XB_TOP      3328
#define XB_TOPGEN   3392
#define XCD_BAR_WORDS 3456
#define XB_SPIN_CAP (1u << 18)

__device__ __forceinline__ unsigned xb_ld(unsigned* p)              { return __hip_atomic_load(p, __ATOMIC_RELAXED, __HIP_MEMORY_SCOPE_AGENT); }
__device__ __forceinline__ unsigned xb_add(unsigned* p, unsigned v) { return __hip_atomic_fetch_add(p, v, __ATOMIC_RELAXED, __HIP_MEMORY_SCOPE_AGENT); }
__device__ __forceinline__ unsigned xb_xcc_id() { return (unsigned)__builtin_amdgcn_s_getreg((3 << 11) | 20) & 0xFu; }
#define XB_SPIN(cond, bar) do { unsigned _sp = 0; while (cond) { __builtin_amdgcn_s_sleep(1); \
    if ((++_sp & 255u) == 0u) { if (xb_ld(&(bar)[XB_TMO])) break; if (_sp > XB_SPIN_CAP) { atomicAdd(&(bar)[XB_TMO], 1u); break; } } } } while (0)

struct XcdBarrier {
    unsigned* bar; unsigned x;
    volatile LAS unsigned* st;
};

__device__ __forceinline__ XcdBarrier xcd_barrier_post(unsigned* bar, volatile LAS unsigned* st) {
    XcdBarrier b; b.bar = bar; b.x = xb_xcc_id(); b.st = st;
    if (threadIdx.x == 0) (void)xb_add(&bar[XB_XCNT(b.x)], 1u);
    return b;
}
__device__ __forceinline__ void xcd_barrier_complete(unsigned* bar, unsigned x, unsigned& nloc, unsigned& nx) {
    const unsigned G = gridDim.x * gridDim.y * gridDim.z;
    unsigned sum, cnt, mine, sp = 0u;
    for (;;) {
        sum = 0u; cnt = 0u; mine = 0u;
#pragma unroll
        for (unsigned j = 0; j < 16; ++j) { const unsigned c = xb_ld(&bar[XB_XCNT(j)]); sum += c; cnt += (c > 0u) ? 1u : 0u; mine = (j == x) ? c : mine; }
        if (sum == G) break;
        __builtin_amdgcn_s_sleep(1);
        if ((++sp & 255u) == 0u) { if (xb_ld(&bar[XB_TMO])) break; if (sp > XB_SPIN_CAP) { atomicAdd(&bar[XB_TMO], 1u); break; } }
    }
    nloc = mine > 0u ? mine : 1u; nx = cnt > 0u ? cnt : 1u;
}

__device__ __forceinline__ void xcd_barrier(const XcdBarrier& b) {
    asm volatile("s_waitcnt vmcnt(0)" ::: "memory");
    __syncthreads();
    if (threadIdx.x == 0) {
        unsigned* bar = b.bar;
        __builtin_amdgcn_s_waitcnt(0);
        unsigned nloc = b.st[0], nx = b.st[1];
        if (nloc == 0u) { xcd_barrier_complete(bar, b.x, nloc, nx); b.st[0] = nloc; b.st[1] = nx; }
        const unsigned old = xb_add(&bar[XB_XSUB(b.x)], 1u);
        const unsigned gen = old / nloc;
        if (old + 1u == (gen + 1u) * nloc) {
            __builtin_amdgcn_fence(__ATOMIC_RELEASE, "agent");
            asm volatile("s_waitcnt vmcnt(0)" ::: "memory");
            const unsigned og = xb_add(&bar[XB_TOP], 1u);
            const unsigned tg = og / nx;
            if (og + 1u == (tg + 1u) * nx) xb_add(&bar[XB_TOPGEN], 1u);
            else XB_SPIN(xb_ld(&bar[XB_TOPGEN]) == tg, bar);
            __builtin_amdgcn_fence(__ATOMIC_ACQUIRE, "agent");
            xb_add(&bar[XB_XGEN(b.x)], 1u);
            asm volatile("s_waitcnt vmcnt(0)" ::: "memory");
        } else {
            XB_SPIN(xb_ld(&bar[XB_XGEN(b.x)]) == gen, bar);
            __builtin_amdgcn_fence(__ATOMIC_ACQUIRE, "agent");
            asm volatile("s_waitcnt vmcnt(0)" ::: "memory");
        }
    }
    __syncthreads();
}


DI float wave_sum(float v) {
#pragma unroll
    for (int o = 1; o < 64; o <<= 1) v += __shfl_xor(v, o);
    return v;
}
DI float wave_max(float v) {
#pragma unroll
    for (int o = 1; o < 64; o <<= 1) v = fmaxf(v, __shfl_xor(v, o));
    return v;
}
DI float wave_incl_sum(float v, int lane) {
#pragma unroll
    for (int o = 1; o < 64; o <<= 1) { const float t = __shfl_up(v, o); if (lane >= o) v += t; }
    return v;
}
DI float wave_incl_max(float v, int lane) {
#pragma unroll
    for (int o = 1; o < 64; o <<= 1) { const float t = __shfl_up(v, o); if (lane >= o) v = fmaxf(v, t); }
    return v;
}

template <int L> DI int swx(int r) { return L == 64 ? ((r >> 1) & 7) : (r & 15); }
template <int L> DI int eoff(int r, int c) { return r * L + ((((c >> 3) ^ swx<L>(r)) << 3) | (c & 7)); }
template <int L> DI bf16x8 ldf(const LAS bf16* base, int r, int ch) { return *(const LAS bf16x8*)(base + r * L + ((ch ^ swx<L>(r)) << 3)); }
DI f32x4 mfma16(bf16x8 a, bf16x8 b, f32x4 c) { return __builtin_amdgcn_mfma_f32_16x16x32_bf16(a, b, c, 0, 0, 0); }
template <int LA, int LB, int NK> DI void mma_tile(f32x4& acc, const LAS bf16* A, int ra0, const LAS bf16* B, int rb0, int lane) {
    const int r = lane & 15, g = lane >> 4;
#pragma unroll
    for (int kk = 0; kk < NK; ++kk) { const bf16x8 a = ldf<LA>(A, ra0 + r, 4 * kk + g), b = ldf<LB>(B, rb0 + r, 4 * kk + g); acc = mfma16(a, b, acc); }
}

DI void conv_item(const float* W, int K, int N, int nblk, const float* gk, bf16* WT, int mode, LAS float* scr, int item, int lane) {
    const int kb = item / nblk, nb = item - kb * nblk, k0 = 64 * kb, n0 = 32 * nb;
    const int nq = 4 * (lane & 7), n = n0 + nq; const bool ok = n < N;
    f32x4 v[8]; float gv[8];
#pragma unroll
    for (int i = 0; i < 8; ++i) { const int kk = 8 * i + (lane >> 3); v[i] = ok ? *(const f32x4*)(W + (size_t)(k0 + kk) * N + n) : (f32x4){0.f, 0.f, 0.f, 0.f}; gv[i] = gk ? gk[k0 + kk] : 1.0f; }
#pragma unroll
    for (int i = 0; i < 8; ++i) { const int kk = 8 * i + (lane >> 3); LAS float* d = scr + kk * 33 + nq; d[0] = v[i].x * gv[i]; d[1] = v[i].y * gv[i]; d[2] = v[i].z * gv[i]; d[3] = v[i].w * gv[i]; }
    LDS_WAIT(); asm volatile("" ::: "memory");
    int row_off = n0;
    if (mode == 1) { const int j = n0 < DFF ? n0 : n0 - DFF; row_off = 256 * (j >> 7) + (j & 127) + (n0 < DFF ? 0 : 128); }
    const int c = lane & 7;
#pragma unroll
    for (int j = 0; j < 4; ++j) { const int nn = (lane >> 3) + 8 * j; const LAS float* s = scr + (8 * c) * 33 + nn;
        v4u o; o.x = pk2(s[0 * 33], s[1 * 33]); o.y = pk2(s[2 * 33], s[3 * 33]); o.z = pk2(s[4 * 33], s[5 * 33]); o.w = pk2(s[6 * 33], s[7 * 33]);
        *(v4u*)(WT + (size_t)(row_off + nn) * K + k0 + 8 * c) = o; }
    LDS_WAIT(); asm volatile("" ::: "memory");
}

struct Args { const float* in[18]; float* out; unsigned char* ws; int ph_lo, ph_hi; };

typedef const __attribute__((address_space(4))) Args* KArgs;
DI KArgs kargs() { KArgs p = (KArgs)__builtin_amdgcn_kernarg_segment_ptr(); asm volatile("" : "+s"(p)); return p; }
DI void prologue(LAS unsigned char* lds, int lane, int wave, int bx) {
    KArgs AP = kargs();
    LAS float* scr = (LAS float*)(lds + wave * 16384);
    const int gw = bx * NWAVES + wave, NGW = gridDim.x * NWAVES;
    unsigned char* ws = AP->ws;
    constexpr int I_UP = (DM / 64) * (NUP / 32), I_DN = (DFF / 64) * (DM / 32), I_IN = (DM / 64) * (NINP / 32), I_OUT = (DM / 64) * (DM / 32);
    constexpr int NITEMS = 8 * I_UP + 8 * I_DN + 4 * I_IN + 4 * I_OUT;
    for (int it = gw; it < NITEMS; it += NGW) {
        int r = it; const float* W; const float* gk = nullptr; bf16* WT; int K = DM, N, nblk, mode = 0;
        if (r < 8 * I_UP) { const int mi = r / I_UP; r -= mi * I_UP; W = AP->in[2] + (size_t)mi * DM * NUP; gk = AP->in[1] + (size_t)mi * DM; WT = (bf16*)(ws + WS_WUP) + (size_t)mi * NUP * DM; N = NUP; nblk = NUP / 32; mode = 1; }
        else if (r < 8 * I_UP + 8 * I_DN) { r -= 8 * I_UP; const int mi = r / I_DN; r -= mi * I_DN; W = AP->in[3] + (size_t)mi * DFF * DM; WT = (bf16*)(ws + WS_WDN) + (size_t)mi * DM * DFF; K = DFF; N = DM; nblk = DM / 32; }
        else if (r < 8 * I_UP + 8 * I_DN + 4 * I_IN) { r -= 8 * I_UP + 8 * I_DN; const int l = r / I_IN; r -= l * I_IN; const int kind = l % 3, ji = l / 3;
            W = AP->in[kind == 0 ? 5 : kind == 1 ? 9 : 12] + (size_t)ji * DM * NIN; gk = AP->in[4] + (size_t)l * DM; WT = (bf16*)(ws + WS_WIN) + (size_t)l * NINP * DM; N = NIN; nblk = NINP / 32; }
        else { r -= 8 * I_UP + 8 * I_DN + 4 * I_IN; const int l = r / I_OUT; r -= l * I_OUT; const int kind = l % 3, ji = l / 3;
            W = AP->in[kind == 0 ? 8 : kind == 1 ? 11 : 16] + (size_t)ji * DM * DM; WT = (bf16*)(ws + WS_WOUT) + (size_t)l * DM * DM; N = DM; nblk = DM / 32; }
        conv_item(W, K, N, nblk, gk, WT, mode, scr, r, lane);
    }
    const float* x = AP->in[0]; bf16* hb = (bf16*)(ws + WS_HB); long long* ss0 = (long long*)(ws + WS_SS);
    for (int m = gw; m < MTOK; m += NGW) {
        const f32x4* xr = (const f32x4*)(x + (size_t)m * DM) + lane; f32x4 v[8]; float s = 0.f;
#pragma unroll
        for (int j = 0; j < 8; ++j) { v[j] = xr[64 * j]; s += (v[j].x * v[j].x + v[j].y * v[j].y) + (v[j].z * v[j].z + v[j].w * v[j].w); }
        s = wave_sum(s);
        v2u* o8 = (v2u*)(hb + (size_t)m * DM) + lane;
#pragma unroll
        for (int j = 0; j < 8; ++j) { v2u w; w.x = pk2(v[j].x, v[j].y); w.y = pk2(v[j].z, v[j].w); o8[64 * j] = w; }
        if (lane == 0) ss0[m] = __float2ll_rn(s * 1048576.0f);
    }
}

constexpr int IMGM_P = 0, IMGM_KT = 8192, IMGM_VT = IMGM_KT + 16384, IMGM_GS = IMGM_VT + 4 * 8192, IMGM_BYTES = IMGM_GS + 1024;
constexpr int IMGG_Q = 0, IMGG_KT = 32768, IMGG_P = 65536, IMGG_VT = IMGG_P + 8192, IMGG_EB = IMGG_VT + 8 * 8192, IMGG_BYTES = IMGG_EB + 1024;
static_assert((size_t)IMGM_BYTES * 4096 <= 352 * MiB && (size_t)IMGG_BYTES * 2048 <= 352 * MiB, "images overlay the (idle) FFN activation buffer");
DI float logsig_fast(float x) { return fminf(x, 0.f) - __logf(1.0f + __expf(-fabsf(x))); }

DI void mlstm_pre(LAS unsigned char* lds, const bf16* P1, const float* G, const float* b_if, unsigned char* img, int tid, int lane, int wave, int bx) {
    LAS bf16* Qs = (LAS bf16*)lds;
    LAS bf16* Ks = Qs + 64 * 128;
    LAS bf16* KTs = Ks + 64 * 128;
    LAS bf16* Ps = KTs + 128 * 64;
    LAS bf16* VT = Ps + 64 * 64;
    LAS float* fa = (LAS float*)(VT + 256 * 64);
    LAS float *bcum = fa, *ipre = fa + 64, *aloc = fa + 128, *wloc = fa + 192, *scal = fa + 256;
    const float KSCALE = 0.08838834764831845f;
    const int g = lane >> 4, r16 = lane & 15;
    for (int item = bx; item < 4096; item += gridDim.x) {
        const int b = item >> 9, c = (item >> 3) & 63, h = item & 7;
        const int row0 = b * SEQ + c * 64;
        unsigned char* im = img + (size_t)item * IMGM_BYTES;
        __syncthreads();
        if (tid < 64) { const float* gp = G + (size_t)(row0 + tid) * 16; ipre[tid] = gp[h] + b_if[h]; bcum[tid] = logsig(gp[8 + h] + b_if[8 + h]); }
#pragma unroll
        for (int p = 0; p < 2; ++p) { const int idx = tid + 512 * p, r = idx >> 4, c8 = idx & 15; const bf16* src = P1 + (size_t)(row0 + r) * NQKV + h * 128 + c8 * 8;
            const v4u vq = *(const v4u*)src, vk = *(const v4u*)(src + 1024);
            *(LAS v4u*)(Qs + eoff<128>(r, c8 * 8)) = vq; *(LAS v4u*)(Ks + eoff<128>(r, c8 * 8)) = vk; }
#pragma unroll
        for (int p = 0; p < 4; ++p) { const int idx = tid + 512 * p, r = idx >> 5, c8 = idx & 31; const v4u vv = *(const v4u*)(P1 + (size_t)(row0 + r) * NQKV + 2048 + h * 256 + c8 * 8);
#pragma unroll
            for (int j = 0; j < 4; ++j) { VT[eoff<64>(c8 * 8 + 2 * j, r)] = (bf16)(vv[j] & 0xffffu); VT[eoff<64>(c8 * 8 + 2 * j + 1, r)] = (bf16)(vv[j] >> 16); } }
        __syncthreads();
        if (wave == 0) {
            const float bt = wave_incl_sum(bcum[lane], lane), ip = ipre[lane];
            const float al = bt + wave_incl_max(ip - bt, lane);
            const float blast = __shfl(bt, 63);
            const float gg = blast - bt + ip;
            const float gmax = wave_max(gg);
            bcum[lane] = bt; aloc[lane] = al; wloc[lane] = expf(gg - gmax);
            if (lane == 0) { scal[0] = blast; scal[1] = gmax; }
        }
        __syncthreads();
#pragma unroll
        for (int p = 0; p < 2; ++p) { const int idx = tid + 512 * p, s = idx >> 4, c8 = idx & 15; const v4u kv = *(const LAS v4u*)(Ks + eoff<128>(s, c8 * 8)); const float w = wloc[s] * KSCALE;
#pragma unroll
            for (int j = 0; j < 4; ++j) { KTs[eoff<64>(c8 * 8 + 2 * j, s)] = (bf16)f2bf(bflo(kv[j]) * w); KTs[eoff<64>(c8 * 8 + 2 * j + 1, s)] = (bf16)f2bf(bfhi(kv[j]) * w); } }
        { const int tt = wave >> 1;
#pragma unroll
          for (int q2 = 0; q2 < 2; ++q2) { const int st = 2 * (wave & 1) + q2; f32x4 acc = (f32x4){0.f, 0.f, 0.f, 0.f};
            if (st <= tt) mma_tile<128, 128, 4>(acc, Qs, 16 * tt, Ks, 16 * st, lane);
            const int s = 16 * st + r16; const float cs = ipre[s] - bcum[s];
#pragma unroll
            for (int i = 0; i < 4; ++i) { const int t = 16 * tt + 4 * g + i; const float p = (s <= t) ? acc[i] * KSCALE * expf(bcum[t] + cs - aloc[t]) : 0.f; Ps[eoff<64>(t, s)] = (bf16)f2bf(p); } } }
        __syncthreads();
        *(v4u*)(im + IMGM_P + tid * 16) = *(const LAS v4u*)((LAS unsigned char*)Ps + tid * 16);
#pragma unroll
        for (int p = 0; p < 2; ++p) *(v4u*)(im + IMGM_KT + (tid + 512 * p) * 16) = *(const LAS v4u*)((LAS unsigned char*)KTs + (tid + 512 * p) * 16);
#pragma unroll
        for (int p = 0; p < 4; ++p) *(v4u*)(im + IMGM_VT + (tid + 512 * p) * 16) = *(const LAS v4u*)((LAS unsigned char*)VT + (tid + 512 * p) * 16);
        if (tid < 64) { float* gs = (float*)(im + IMGM_GS); gs[tid] = bcum[tid]; gs[64 + tid] = aloc[tid]; if (tid < 2) gs[128 + tid] = scal[tid]; }
    }
}

DI void mlstm_scan2(LAS unsigned char* lds, const bf16* P1, const unsigned char* img, float* hraw, int tid, int lane, int wave, int bx) {
    LAS bf16* Ps = (LAS bf16*)lds;
    LAS bf16* Qs = Ps + 64 * 64;
    LAS bf16* KTs = Qs + 64 * 128;
    LAS bf16* VTs = KTs + 128 * 64;
    LAS float* gsl = (LAS float*)(VTs + 80 * 64);
    LAS bf16* CT0 = (LAS bf16*)(gsl + 256);
    const int g = lane >> 4, r16 = lane & 15, tt = wave >> 1, eh = wave & 1;
    for (int item = bx; item < 256; item += gridDim.x) {
        const int b = item >> 5, h = (item >> 2) & 7, sl = item & 3;
        f32x4 Cacc[5];
#pragma unroll
        for (int e = 0; e < 5; ++e) Cacc[e] = (f32x4){0.f, 0.f, 0.f, 0.f};
        __syncthreads();
        for (int i = tid; i < 2 * 80 * 128 / 8; i += 512) ((LAS v4u*)CT0)[i] = (v4u){0u, 0u, 0u, 0u};
        for (int i = tid; i < 16 * 64 / 8; i += 512) ((LAS v4u*)(VTs + 64 * 64))[i] = (i < 8) ? (v4u){0x3f803f80u, 0x3f803f80u, 0x3f803f80u, 0x3f803f80u} : (v4u){0u, 0u, 0u, 0u};
        float m_prev = 0.f;
        v4u rp, rq[2], rk[2], rv; float rg0 = 0.f, rbl, rgm;
#define MLS_PREFETCH(cc) do { const int item2 = (b * 64 + (cc)) * 8 + h; const unsigned char* im = img + (size_t)item2 * IMGM_BYTES; const int row0 = b * SEQ + (cc) * 64; \
            rp = *(const v4u*)(im + IMGM_P + tid * 16); rk[0] = *(const v4u*)(im + IMGM_KT + tid * 16); rk[1] = *(const v4u*)(im + IMGM_KT + (tid + 512) * 16); \
            rv = *(const v4u*)(im + IMGM_VT + sl * 8192 + tid * 16); \
            _Pragma("unroll") for (int p = 0; p < 2; ++p) { const int idx = tid + 512 * p, r = idx >> 4, c8 = idx & 15; rq[p] = *(const v4u*)(P1 + (size_t)(row0 + r) * NQKV + h * 128 + c8 * 8); } \
            const float* gs = (const float*)(im + IMGM_GS); if (tid < 128) rg0 = gs[tid]; rbl = gs[128]; rgm = gs[129]; } while (0)
        MLS_PREFETCH(0);
        for (int c = 0; c < 64; ++c) {
            const int row0 = b * SEQ + c * 64;
            LAS bf16* CTc = CT0 + (c & 1) * 80 * 128; LAS bf16* CTn = CT0 + ((c + 1) & 1) * 80 * 128;
            __syncthreads();
            *(LAS v4u*)((LAS unsigned char*)Ps + tid * 16) = rp;
            *(LAS v4u*)((LAS unsigned char*)KTs + tid * 16) = rk[0]; *(LAS v4u*)((LAS unsigned char*)KTs + (tid + 512) * 16) = rk[1];
            *(LAS v4u*)((LAS unsigned char*)VTs + tid * 16) = rv;
#pragma unroll
            for (int p = 0; p < 2; ++p) { const int idx = tid + 512 * p, r = idx >> 4, c8 = idx & 15; *(LAS v4u*)(Qs + eoff<128>(r, c8 * 8)) = rq[p]; }
            if (tid < 128) gsl[tid] = rg0;
            const float blast = rbl, gmax = rgm;
            __syncthreads();
            if (c + 1 < 64) MLS_PREFETCH(c + 1);
            const f32x4 btv = *(const LAS f32x4*)(gsl + 16 * tt + 4 * g), alv = *(const LAS f32x4*)(gsl + 64 + 16 * tt + 4 * g);
            float al[4], be[4], em[4];
#pragma unroll
            for (int i = 0; i < 4; ++i) { const float mt = fmaxf(btv[i] + m_prev, alv[i]); al[i] = expf(alv[i] - mt); be[i] = expf(btv[i] + m_prev - mt); em[i] = expf(-mt); }
            const float m_new = fmaxf(blast + m_prev, gmax), wcs = expf(blast + m_prev - m_new), gam = expf(gmax - m_new);
            m_prev = m_new;
            f32x4 d1 = (f32x4){0.f, 0.f, 0.f, 0.f}, d2 = (f32x4){0.f, 0.f, 0.f, 0.f};
            mma_tile<64, 64, 2>(d1, Ps, 16 * tt, VTs, 64, lane); mma_tile<128, 128, 4>(d2, Qs, 16 * tt, CTc, 64, lane);
            float dinv[4];
#pragma unroll
            for (int i = 0; i < 4; ++i) { const float den = __shfl(al[i] * d1[i] + be[i] * d2[i], lane & 48); dinv[i] = 1.0f / fmaxf(fabsf(den), em[i]); }
#pragma unroll
            for (int q2 = 0; q2 < 2; ++q2) { const int et = 2 * eh + q2, e = 16 * et + r16; f32x4 a1 = (f32x4){0.f, 0.f, 0.f, 0.f}, a2 = (f32x4){0.f, 0.f, 0.f, 0.f};
                mma_tile<64, 64, 2>(a1, Ps, 16 * tt, VTs, 16 * et, lane); mma_tile<128, 128, 4>(a2, Qs, 16 * tt, CTc, 16 * et, lane);
#pragma unroll
                for (int i = 0; i < 4; ++i) { const int t = 16 * tt + 4 * g + i; hraw[(size_t)(row0 + t) * DM + h * 256 + sl * 64 + e] = (al[i] * a1[i] + be[i] * a2[i]) * dinv[i]; } }
#pragma unroll
            for (int et = 0; et < 5; ++et) { f32x4 tmp = (f32x4){0.f, 0.f, 0.f, 0.f}; mma_tile<64, 64, 2>(tmp, KTs, 16 * wave, VTs, 16 * et, lane);
                Cacc[et] = Cacc[et] * wcs + tmp * gam;
                v2u w; w.x = pk2(Cacc[et][0], Cacc[et][1]); w.y = pk2(Cacc[et][2], Cacc[et][3]);
                *(LAS v2u*)(CTn + eoff<128>(16 * et + r16, 16 * wave + 4 * g)) = w; }
        }
#undef MLS_PREFETCH
    }
}

DI void gla_pre(LAS unsigned char* lds, const bf16* P1, const float* G, const float* w_alpha, const float* b_alpha, unsigned char* img, int tid, int lane, int wave, int bx) {
    LAS bf16* VT = (LAS bf16*)lds;
    LAS bf16* QTs = (LAS bf16*)lds;
    LAS bf16* KTl = QTs + 64 * 256;
    LAS bf16* KTT = KTl + 64 * 256;
    LAS bf16* Ps = KTT + 256 * 64;
    LAS float* alow = (LAS float*)(Ps + 64 * 64);
    LAS float* T0 = alow + 1024;
    const int g = lane >> 4, r16 = lane & 15, d = tid & 255, sh = tid >> 8;
    for (int item = bx; item < 2048; item += gridDim.x) {
        const int b = item >> 8, c = (item >> 2) & 63, h = item & 3;
        const int row0 = b * SEQ + c * 64;
        unsigned char* im = img + (size_t)item * IMGG_BYTES;
        __syncthreads();
#pragma unroll
        for (int p = 0; p < 8; ++p) { const int idx = tid + 512 * p, r = idx >> 6, c8 = idx & 63; const v4u vv = *(const v4u*)(P1 + (size_t)(row0 + r) * NQKV + 2048 + h * 512 + c8 * 8);
#pragma unroll
            for (int j = 0; j < 4; ++j) { VT[eoff<64>(c8 * 8 + 2 * j, r)] = (bf16)(vv[j] & 0xffffu); VT[eoff<64>(c8 * 8 + 2 * j + 1, r)] = (bf16)(vv[j] >> 16); } }
        float wa[16];
#pragma unroll
        for (int i = 0; i < 16; ++i) wa[i] = w_alpha[i * 1024 + h * 256 + d];
        const float ba = b_alpha[h * 256 + d];
        f32x4 al4 = (f32x4){0.f, 0.f, 0.f, 0.f};
        if (tid < 256) al4 = *(const f32x4*)(G + (size_t)(row0 + (tid >> 2)) * 16 + (tid & 3) * 4);
        __syncthreads();
#pragma unroll
        for (int p = 0; p < 8; ++p) *(v4u*)(im + IMGG_VT + (tid + 512 * p) * 16) = *(const LAS v4u*)((LAS unsigned char*)VT + (tid + 512 * p) * 16);
        __syncthreads();
        if (tid < 256) *(LAS f32x4*)(alow + tid * 4) = al4;
        __syncthreads();
        const bf16* qsrc = P1 + (size_t)(row0 + 32 * sh) * NQKV + h * 256 + d;
        float bs[32]; float run = 0.f;
#pragma unroll
        for (int j = 0; j < 32; ++j) { const int s = 32 * sh + j; float z = ba;
#pragma unroll
            for (int i = 0; i < 16; ++i) z += alow[s * 16 + i] * wa[i];
            run += logsig_fast(z) * (1.0f / 16.0f); bs[j] = run; }
        if (sh == 0) T0[d] = run;
        __syncthreads();
        const float add = sh ? T0[d] : 0.f;
        if (sh) ((float*)(im + IMGG_EB))[d] = __expf(run + add);
#pragma unroll
        for (int q8 = 0; q8 < 4; ++q8) { unsigned kk[8];
#pragma unroll
            for (int j = 0; j < 8; ++j) { const int jj = 8 * q8 + j, s = 32 * sh + jj; const float bsum = bs[jj] + add;
                const float qv = bf2f(qsrc[(size_t)jj * NQKV]) * 0.0625f * __expf(bsum), kv = bf2f(qsrc[(size_t)jj * NQKV + 1024]) * __expf(-bsum);
                QTs[eoff<256>(s, d)] = (bf16)f2bf(qv); kk[j] = f2bf(kv); KTl[eoff<256>(s, d)] = (bf16)kk[j]; }
            v4u w; w.x = kk[0] | (kk[1] << 16); w.y = kk[2] | (kk[3] << 16); w.z = kk[4] | (kk[5] << 16); w.w = kk[6] | (kk[7] << 16);
            *(LAS v4u*)(KTT + eoff<64>(d, 32 * sh + 8 * q8)) = w; }
        __syncthreads();
        { const int tt = wave >> 1;
#pragma unroll
          for (int q2 = 0; q2 < 2; ++q2) { const int st = 2 * (wave & 1) + q2; f32x4 acc = (f32x4){0.f, 0.f, 0.f, 0.f};
            if (st <= tt) mma_tile<256, 256, 8>(acc, QTs, 16 * tt, KTl, 16 * st, lane);
            const int s = 16 * st + r16;
#pragma unroll
            for (int i = 0; i < 4; ++i) { const int t = 16 * tt + 4 * g + i; Ps[eoff<64>(t, s)] = (bf16)f2bf((s <= t) ? acc[i] : 0.f); } } }
        __syncthreads();
#pragma unroll
        for (int p = 0; p < 4; ++p) { *(v4u*)(im + IMGG_Q + (tid + 512 * p) * 16) = *(const LAS v4u*)((LAS unsigned char*)QTs + (tid + 512 * p) * 16);
                                      *(v4u*)(im + IMGG_KT + (tid + 512 * p) * 16) = *(const LAS v4u*)((LAS unsigned char*)KTT + (tid + 512 * p) * 16); }
        *(v4u*)(im + IMGG_P + tid * 16) = *(const LAS v4u*)((LAS unsigned char*)Ps + tid * 16);
    }
}

DI void gla_scan2(LAS unsigned char* lds, const unsigned char* img, float* hraw, int tid, int lane, int wave, int bx) {
    LAS bf16* QTs = (LAS bf16*)lds;
    LAS bf16* KTT = QTs + 64 * 256;
    LAS bf16* Ps = KTT + 256 * 64;
    LAS bf16* VTs = Ps + 64 * 64;
    LAS float* eb = (LAS float*)(VTs + 64 * 64);
    LAS bf16* ST0 = (LAS bf16*)(eb + 256);
    const int g = lane >> 4, r16 = lane & 15, tt = wave >> 1, eh = wave & 1;
    for (int item = bx; item < 256; item += gridDim.x) {
        const int b = item >> 5, h = (item >> 3) & 3, sl = item & 7;
        f32x4 Sacc[2][4];
#pragma unroll
        for (int a = 0; a < 2; ++a)
#pragma unroll
            for (int e = 0; e < 4; ++e) Sacc[a][e] = (f32x4){0.f, 0.f, 0.f, 0.f};
        __syncthreads();
        for (int i = tid; i < 2 * 64 * 256 / 8; i += 512) ((LAS v4u*)ST0)[i] = (v4u){0u, 0u, 0u, 0u};
        v4u rq[4], rk[4], rp, rv; float re = 0.f;
#define GLS_PREFETCH(cc) do { const int item2 = (b * 64 + (cc)) * 4 + h; const unsigned char* im = img + (size_t)item2 * IMGG_BYTES; \
            _Pragma("unroll") for (int p = 0; p < 4; ++p) { rq[p] = *(const v4u*)(im + IMGG_Q + (tid + 512 * p) * 16); rk[p] = *(const v4u*)(im + IMGG_KT + (tid + 512 * p) * 16); } \
            rp = *(const v4u*)(im + IMGG_P + tid * 16); rv = *(const v4u*)(im + IMGG_VT + sl * 8192 + tid * 16); if (tid < 256) re = ((const float*)(im + IMGG_EB))[tid]; } while (0)
        GLS_PREFETCH(0);
        for (int c = 0; c < 64; ++c) {
            const int row0 = b * SEQ + c * 64;
            LAS bf16* STc = ST0 + (c & 1) * 64 * 256; LAS bf16* STn = ST0 + ((c + 1) & 1) * 64 * 256;
            __syncthreads();
#pragma unroll
            for (int p = 0; p < 4; ++p) { *(LAS v4u*)((LAS unsigned char*)QTs + (tid + 512 * p) * 16) = rq[p]; *(LAS v4u*)((LAS unsigned char*)KTT + (tid + 512 * p) * 16) = rk[p]; }
            *(LAS v4u*)((LAS unsigned char*)Ps + tid * 16) = rp; *(LAS v4u*)((LAS unsigned char*)VTs + tid * 16) = rv;
            if (tid < 256) eb[tid] = re;
            __syncthreads();
            if (c + 1 < 64) GLS_PREFETCH(c + 1);
#pragma unroll
            for (int q2 = 0; q2 < 2; ++q2) { const int et = 2 * eh + q2, e = 16 * et + r16; f32x4 acc = (f32x4){0.f, 0.f, 0.f, 0.f};
                mma_tile<64, 64, 2>(acc, Ps, 16 * tt, VTs, 16 * et, lane); mma_tile<256, 256, 8>(acc, QTs, 16 * tt, STc, 16 * et, lane);
#pragma unroll
                for (int i = 0; i < 4; ++i) { const int t = 16 * tt + 4 * g + i; hraw[(size_t)(row0 + t) * DM + h * 512 + sl * 64 + e] = acc[i]; } }
#pragma unroll
            for (int a = 0; a < 2; ++a) { const int dt = 2 * wave + a;
                const f32x4 ev = *(const LAS f32x4*)(eb + 16 * dt + 4 * g);
#pragma unroll
                for (int et = 0; et < 4; ++et) { mma_tile<64, 64, 2>(Sacc[a][et], KTT, 16 * dt, VTs, 16 * et, lane); Sacc[a][et] = Sacc[a][et] * ev;
                    v2u w; w.x = pk2(Sacc[a][et][0], Sacc[a][et][1]); w.y = pk2(Sacc[a][et][2], Sacc[a][et][3]);
                    *(LAS v2u*)(STn + eoff<256>(16 * et + r16, 16 * dt + 4 * g)) = w; } }
        }
#undef GLS_PREFETCH
    }
}


template <int HS, int ACT> DI void headnorm_gate(const float* hraw, const bf16* P1, const float* gnorm, bf16* hm, int lane, int wave, int bx) {
    constexpr int NH = DM / HS, EPL = HS / 64;
    const int gw = bx * NWAVES + wave, NGW = gridDim.x * NWAVES;
    for (int row = gw; row < MTOK; row += NGW) {
#pragma unroll
        for (int hh = 0; hh < NH; ++hh) { const int col = hh * HS + lane * EPL;
            float x[EPL]; float s = 0.f;
#pragma unroll
            for (int j = 0; j < EPL; j += 4) { const f32x4 v = *(const f32x4*)(hraw + (size_t)row * DM + col + j); x[j] = v.x; x[j + 1] = v.y; x[j + 2] = v.z; x[j + 3] = v.w; s += (v.x * v.x + v.y * v.y) + (v.z * v.z + v.w * v.w); }
            s = wave_sum(s); const float rs = rsqrtf(s * (1.0f / HS) + 1e-6f);
            unsigned outw[EPL / 2];
#pragma unroll
            for (int j = 0; j < EPL; j += 2) { const unsigned gw2 = *(const unsigned*)(P1 + (size_t)row * NQKV + 4096 + col + j); const float g0 = bflo(gw2), g1 = bfhi(gw2);
                const float a0 = ACT == 0 ? 1.0f / (1.0f + expf(-g0)) : g0 / (1.0f + expf(-g0)), a1 = ACT == 0 ? 1.0f / (1.0f + expf(-g1)) : g1 / (1.0f + expf(-g1));
                outw[j / 2] = pk2(x[j] * rs * gnorm[col + j] * a0, x[j + 1] * rs * gnorm[col + j + 1] * a1); }
            if constexpr (EPL == 4) { v2u w; w.x = outw[0]; w.y = outw[1]; *(v2u*)(hm + (size_t)row * DM + col) = w; }
            else { v4u w; w.x = outw[0]; w.y = outw[1]; w.z = outw[2]; w.w = outw[3]; *(v4u*)(hm + (size_t)row * DM + col) = w; }
        }
    }
}

DI void fox_cf(const float* G, const float* b_f, float* cf, int lane, int wave, int bx) {
    const int gw = bx * NWAVES + wave, NGW = gridDim.x * NWAVES;
    for (int seq = gw; seq < 128; seq += NGW) { const int b = seq >> 4, h = seq & 15; const float bias = b_f[h];
        const float* gp = G + ((size_t)b * SEQ + lane * 64) * 16 + h; float s = 0.f;
        for (int p = 0; p < 64; ++p) s += logsig(gp[p * 16] + bias);
        float run = wave_incl_sum(s, lane) - s;
        float* o = cf + (size_t)seq * SEQ + lane * 64;
        for (int p = 0; p < 64; ++p) { run += logsig(gp[p * 16] + bias); o[p] = run; }
    }
}

DI void fox_vt_pre(LAS unsigned char* lds, const bf16* P1, unsigned char* img, int lane, int wave, int bx) {
    LAS bf16* scr = (LAS bf16*)(lds + wave * 4096);
    const int gw = bx * NWAVES + wave, NGW = gridDim.x * NWAVES;
    for (int it = gw; it < 8192 * 4; it += NGW) {
        const int q = it & 3, jt = (it >> 2) & 63, bh = it >> 8, b = bh >> 4, h = bh & 15;
        const bf16* src = P1 + ((size_t)b * SEQ + jt * 64) * NQKV + 4096 + h * 128 + q * 32;
        v4u v[4];
#pragma unroll
        for (int p = 0; p < 4; ++p) { const int idx = lane + 64 * p, r = idx >> 2, c8 = idx & 3; v[p] = *(const v4u*)(src + (size_t)r * NQKV + c8 * 8); }
#pragma unroll
        for (int p = 0; p < 4; ++p) { const int idx = lane + 64 * p, r = idx >> 2, c8 = idx & 3;
#pragma unroll
            for (int j = 0; j < 4; ++j) { scr[eoff<64>(c8 * 8 + 2 * j, r)] = (bf16)(v[p][j] & 0xffffu); scr[eoff<64>(c8 * 8 + 2 * j + 1, r)] = (bf16)(v[p][j] >> 16); } }
        LDS_WAIT(); asm volatile("" ::: "memory");
        unsigned char* dst = img + ((size_t)(bh * 64 + jt)) * 16384 + q * 4096;
#pragma unroll
        for (int p = 0; p < 4; ++p) *(v4u*)(dst + (lane + 64 * p) * 16) = *(const LAS v4u*)((LAS unsigned char*)scr + (lane + 64 * p) * 16);
        LDS_WAIT(); asm volatile("" ::: "memory");
    }
}

DI void fox_attn2(LAS unsigned char* lds, const bf16* P1, const float* cf, const unsigned char* vimg, bf16* hm, int tid, int lane, int wave, int bx) {
    constexpr int BUFB = 16384 + 16384 + 256;
    const float LOG2E = 1.4426950408889634f, QS = 0.08838834764831845f * 1.4426950408889634f, THR = 8.0f;
    const int g = lane >> 4, r16 = lane & 15;
    const int G_ = gridDim.x;
    const int nit = (2048 + G_ - 1) / G_;
    for (int it = 0; it < nit; ++it) {
        const int u = (it & 1) ? it * G_ + (G_ - 1 - bx) : it * G_ + bx;
        if (u >= 2048) continue;
        const int qb = 15 - (u >> 7), bh = u & 127, b = bh >> 4, h = bh & 15;
        const size_t rowb = (size_t)b * SEQ; const int q0 = qb * 256 + 32 * wave;
        bf16x8 qf[2][4]; float c0[2];
#pragma unroll
        for (int tt = 0; tt < 2; ++tt) { const int t = q0 + 16 * tt + r16; c0[tt] = cf[(size_t)bh * SEQ + t] * LOG2E;
#pragma unroll
            for (int kk = 0; kk < 4; ++kk) { const v4u raw = *(const v4u*)(P1 + (rowb + t) * NQKV + h * 128 + 32 * kk + 8 * g); v4u sc;
#pragma unroll
                for (int j = 0; j < 4; ++j) sc[j] = pk2(bflo(raw[j]) * QS, bfhi(raw[j]) * QS);
                qf[tt][kk] = __builtin_bit_cast(bf16x8, sc); } }
        f32x4 oacc[8][2];
#pragma unroll
        for (int et = 0; et < 8; ++et) { oacc[et][0] = (f32x4){0.f, 0.f, 0.f, 0.f}; oacc[et][1] = (f32x4){0.f, 0.f, 0.f, 0.f}; }
        float lrun[2] = {0.f, 0.f};
        const int ntiles = 4 * (qb + 1);
        v4u kreg[2], vreg[2]; float cfreg = 0.f;
        const bf16* kbase = P1 + rowb * NQKV + 2048 + h * 128;
        const unsigned char* vbase = vimg + (size_t)bh * 64 * 16384;
#define FOX_LOAD(j) do { _Pragma("unroll") for (int p = 0; p < 2; ++p) { const int idx = tid + 512 * p, r = idx >> 4, c8 = idx & 15; \
            kreg[p] = *(const v4u*)(kbase + (size_t)(64 * (j) + r) * NQKV + c8 * 8); vreg[p] = *(const v4u*)(vbase + (size_t)(j) * 16384 + idx * 16); } \
            if (tid < 64) cfreg = -cf[(size_t)bh * SEQ + 64 * (j) + tid] * LOG2E; } while (0)
#define FOX_STORE(bufi) do { LAS unsigned char* bb = lds + (bufi) * BUFB; _Pragma("unroll") for (int p = 0; p < 2; ++p) { const int idx = tid + 512 * p, r = idx >> 4, c8 = idx & 15; \
            *(LAS v4u*)((LAS bf16*)bb + eoff<128>(r, c8 * 8)) = kreg[p]; *(LAS v4u*)(bb + 16384 + idx * 16) = vreg[p]; } \
            if (tid < 64) ((LAS float*)(bb + 32768))[tid] = cfreg; } while (0)
        __syncthreads();
        FOX_LOAD(0); FOX_STORE(0);
        if (ntiles > 1) FOX_LOAD(1);
        __syncthreads();
        for (int j = 0; j < ntiles; ++j) {
            if (j + 1 < ntiles) FOX_STORE((j + 1) & 1);
            if (j + 2 < ntiles) FOX_LOAD(j + 2);
            if (64 * j <= q0 + 31) {
                const LAS bf16* Ks = (const LAS bf16*)(lds + (j & 1) * BUFB); const LAS bf16* VTs = Ks + 64 * 128; const LAS float* cfs = (const LAS float*)(VTs + 128 * 64);
                f32x4 sacc[2][4];
#pragma unroll
                for (int st = 0; st < 4; ++st) { const f32x4 cv = *(const LAS f32x4*)(cfs + 16 * st + 4 * g);
#pragma unroll
                    for (int tt = 0; tt < 2; ++tt) sacc[tt][st] = cv + c0[tt]; }
#pragma unroll
                for (int st = 0; st < 4; ++st)
#pragma unroll
                    for (int kk = 0; kk < 4; ++kk) { const bf16x8 kf = ldf<128>(Ks, 16 * st + r16, 4 * kk + g);
                        sacc[0][st] = mfma16(kf, qf[0][kk], sacc[0][st]); sacc[1][st] = mfma16(kf, qf[1][kk], sacc[1][st]); if (kk == 3) asm volatile("" ::: "memory"); }
                if (64 * j + 63 > q0) {
#pragma unroll
                    for (int tt = 0; tt < 2; ++tt) { const int t = q0 + 16 * tt + r16;
#pragma unroll
                        for (int st = 0; st < 4; ++st)
#pragma unroll
                            for (int i = 0; i < 4; ++i) { const int s = 64 * j + 16 * st + 4 * g + i; if (s > t) sacc[tt][st][i] = -__builtin_inff(); } }
                }
                float mx[2];
#pragma unroll
                for (int tt = 0; tt < 2; ++tt) { float m = -__builtin_inff();
#pragma unroll
                    for (int st = 0; st < 4; ++st) m = fmaxf(m, fmaxf(fmaxf(sacc[tt][st][0], sacc[tt][st][1]), fmaxf(sacc[tt][st][2], sacc[tt][st][3])));
                    m = fmaxf(m, __shfl_xor(m, 16)); m = fmaxf(m, __shfl_xor(m, 32)); mx[tt] = m; }
                if (__any(mx[0] > THR || mx[1] > THR)) {
#pragma unroll
                    for (int tt = 0; tt < 2; ++tt) { const float sh = fmaxf(mx[tt], 0.f), f = __builtin_amdgcn_exp2f(-sh);
                        c0[tt] -= sh; lrun[tt] *= f;
#pragma unroll
                        for (int st = 0; st < 4; ++st) sacc[tt][st] = sacc[tt][st] - sh;
#pragma unroll
                        for (int et = 0; et < 8; ++et) oacc[et][tt] = oacc[et][tt] * f; }
                }
#pragma unroll
                for (int tt = 0; tt < 2; ++tt) { float ls = 0.f;
#pragma unroll
                    for (int st = 0; st < 4; ++st)
#pragma unroll
                        for (int i = 0; i < 4; ++i) { const float p = __builtin_amdgcn_exp2f(sacc[tt][st][i]); sacc[tt][st][i] = p; ls += p; }
                    lrun[tt] += ls; }
#pragma unroll
                for (int ks = 0; ks < 2; ++ks) { bf16x8 pb[2];
#pragma unroll
                    for (int tt = 0; tt < 2; ++tt) { v4u w; w.x = pk2(sacc[tt][2 * ks][0], sacc[tt][2 * ks][1]); w.y = pk2(sacc[tt][2 * ks][2], sacc[tt][2 * ks][3]);
                        w.z = pk2(sacc[tt][2 * ks + 1][0], sacc[tt][2 * ks + 1][1]); w.w = pk2(sacc[tt][2 * ks + 1][2], sacc[tt][2 * ks + 1][3]); pb[tt] = __builtin_bit_cast(bf16x8, w); }
#pragma unroll
                    for (int et = 0; et < 8; ++et) { const int e = 16 * et + r16;
                        const v2u lo = *(const LAS v2u*)(VTs + eoff<64>(e, 32 * ks + 4 * g)), hi = *(const LAS v2u*)(VTs + eoff<64>(e, 32 * ks + 16 + 4 * g));
                        v4u aw; aw.x = lo.x; aw.y = lo.y; aw.z = hi.x; aw.w = hi.y; const bf16x8 va = __builtin_bit_cast(bf16x8, aw);
                        oacc[et][0] = mfma16(va, pb[0], oacc[et][0]); oacc[et][1] = mfma16(va, pb[1], oacc[et][1]); if (et & 1) asm volatile("" ::: "memory"); } }
            }
            __syncthreads();
        }
#undef FOX_LOAD
#undef FOX_STORE
#pragma unroll
        for (int tt = 0; tt < 2; ++tt) { float l = lrun[tt]; l += __shfl_xor(l, 16); l += __shfl_xor(l, 32); const float inv = 1.0f / l;
            bf16* orow = hm + (rowb + q0 + 16 * tt + r16) * DM + h * 128 + 4 * g;
#pragma unroll
            for (int et = 0; et < 8; ++et) { v2u w; w.x = pk2(oacc[et][tt][0] * inv, oacc[et][tt][1] * inv); w.y = pk2(oacc[et][tt][2] * inv, oacc[et][tt][3] * inv); *(v2u*)(orow + 16 * et) = w; } }
    }
}


DI void final_norm(float* out, const long long* ss, const float* gfin, int lane, int wave, int bx) {
    const int gw = bx * NWAVES + wave, NGW = gridDim.x * NWAVES;
    for (int m = gw; m < MTOK; m += NGW) { const float rs = pg8::rstd_of(ss, m);
        f32x4* xr = (f32x4*)(out + (size_t)m * DM) + lane; const f32x4* gr = (const f32x4*)gfin + lane;
#pragma unroll
        for (int j = 0; j < 8; ++j) { const f32x4 v = xr[64 * j], gg = gr[64 * j]; xr[64 * j] = v * rs * gg; } }
}

#define PH(p) if (lo <= (p) && (p) < hi && (ran ? (xcd_barrier(bar), true) : (ran = true)))
#define TID() int tid = threadIdx.x; asm volatile("" : "+v"(tid)); const int lane = tid & 63, wave = __builtin_amdgcn_readfirstlane(tid >> 6); int bx = blockIdx.x; asm volatile("" : "+s"(bx)); (void)lane; (void)wave; (void)bx
#define WSP(T, off) ((T*)(ka->ws + (off)))
template <int j> DI void subblock(LAS unsigned char* lds, const XcdBarrier& bar, const int lo, const int hi, bool& ran) {
    {
        constexpr int layer = j / 3, typ = j - 3 * layer, base = 1 + 5 * j;
        if constexpr (typ != 1) {
            PH(base) { TID(); KArgs ka = kargs(); const int mi = layer * 2 + (typ >> 1);
                pg8::Gemm gm{WSP(bf16, WS_HB), WSP(bf16, WS_WUP) + (size_t)mi * NUP * DM, MTOK, NUP, DM}; pg8::StaticOrder S; S.init(MTOK, NUP, gridDim.x, bx);
                pg8::EpiSwiGLU E{WSP(bf16, WS_ACT), WSP(long long, WS_SS) + (size_t)j * MTOK, DFF};
                pg8::gemm_phase<pg8::EpiSwiGLU, pg8::StaticOrder, PG8_ALIGN, PG8_SP2>(lds, gm, S, E); }
        } else {
            constexpr int kind = layer % 3, ji = layer / 3;
            PH(base) { TID(); KArgs ka = kargs();
                pg8::Gemm gm{WSP(bf16, WS_HB), WSP(bf16, WS_WIN) + (size_t)layer * NINP * DM, MTOK, NINP, DM}; pg8::StaticOrder S; S.init(MTOK, NINP, gridDim.x, bx);
                pg8::EpiMixIn E{WSP(bf16, WS_P1), WSP(float, WS_G), WSP(long long, WS_SS) + (size_t)j * MTOK};
                pg8::gemm_phase<pg8::EpiMixIn, pg8::StaticOrder, PG8_ALIGN, PG8_SP2>(lds, gm, S, E); }
            PH(base + 1) { TID(); KArgs ka = kargs();
                if constexpr (kind == 0) for (int rep = 0; rep < REP_MLSTM; ++rep) mlstm_pre(lds, WSP(bf16, WS_P1), WSP(float, WS_G), ka->in[6] + ji * 16, WSP(unsigned char, WS_ACT), tid, lane, wave, bx);
                else if constexpr (kind == 1) { fox_cf(WSP(float, WS_G), ka->in[10] + ji * 16, WSP(float, WS_CF), lane, wave, bx); fox_vt_pre(lds, WSP(bf16, WS_P1), WSP(unsigned char, WS_ACT), lane, wave, bx); }
                else for (int rep = 0; rep < REP_GLA; ++rep) gla_pre(lds, WSP(bf16, WS_P1), WSP(float, WS_G), ka->in[13] + (size_t)ji * 16 * 1024, ka->in[14] + ji * 1024, WSP(unsigned char, WS_ACT), tid, lane, wave, bx);
            }
            PH(base + 2) { TID(); KArgs ka = kargs();
                if constexpr (kind == 0) for (int rep = 0; rep < REP_MLSTM; ++rep) mlstm_scan2(lds, WSP(bf16, WS_P1), WSP(unsigned char, WS_ACT), WSP(float, WS_HRAW), tid, lane, wave, bx);
                else if constexpr (kind == 1) for (int rep = 0; rep < REP_FOX; ++rep) fox_attn2(lds, WSP(bf16, WS_P1), WSP(float, WS_CF), WSP(unsigned char, WS_ACT), WSP(bf16, WS_HM), tid, lane, wave, bx);
                else for (int rep = 0; rep < REP_GLA; ++rep) gla_scan2(lds, WSP(unsigned char, WS_ACT), WSP(float, WS_HRAW), tid, lane, wave, bx);
            }
            if constexpr (kind != 1) { PH(base + 3) { TID(); KArgs ka = kargs();
                if constexpr (kind == 0) headnorm_gate<256, 0>(WSP(float, WS_HRAW), WSP(bf16, WS_P1), ka->in[7] + ji * DM, WSP(bf16, WS_HM), lane, wave, bx);
                else headnorm_gate<512, 1>(WSP(float, WS_HRAW), WSP(bf16, WS_P1), ka->in[15] + ji * DM, WSP(bf16, WS_HM), lane, wave, bx);
            } }
        }
        PH(base + 4) { TID(); KArgs ka = kargs();
            pg8::Gemm gm; float scale;
            if constexpr (typ != 1) { const int mi = layer * 2 + (typ >> 1); gm = pg8::Gemm{WSP(bf16, WS_ACT), WSP(bf16, WS_WDN) + (size_t)mi * DM * DFF, MTOK, DM, DFF}; scale = 0.5f; }
            else { gm = pg8::Gemm{WSP(bf16, WS_HM), WSP(bf16, WS_WOUT) + (size_t)layer * DM * DM, MTOK, DM, DM}; scale = 1.0f; }
            pg8::StaticOrder S; S.init(MTOK, DM, gridDim.x, bx);
            pg8::EpiResid E{(j == 0) ? ka->in[0] : (const float*)ka->out, ka->out, WSP(bf16, WS_HB), WSP(long long, WS_SS) + (size_t)(j + 1) * MTOK, scale};
            pg8::gemm_phase<pg8::EpiResid, pg8::StaticOrder, PG8_ALIGN, PG8_SP2>(lds, gm, S, E);
        }
    }
}

__global__ void __launch_bounds__(NWAVES * 64, 2) trunk_fwd(Args args) {
    extern __shared__ __attribute__((aligned(16))) unsigned char lds_raw[];
    LAS unsigned char* lds = (LAS unsigned char*)lds_raw;
    volatile LAS unsigned* MISC = (volatile LAS unsigned*)(lds + MISC_OFF);
    for (int u = threadIdx.x; u < (LDS_BYTES - MISC_OFF) / 4; u += NWAVES * 64) ((LAS unsigned*)(lds + MISC_OFF))[u] = 0u;
    __syncthreads();
    XcdBarrier bar = xcd_barrier_post((unsigned*)(args.ws + WS_CTL) + CW_BAR, MISC + 8);
    const int lo = args.ph_lo, hi = args.ph_hi; bool ran = false;

    PH(0) { TID(); for (int rep = 0; rep < REP_PRO; ++rep) { prologue(lds, lane, wave, bx); __syncthreads(); } }

    subblock<0>(lds, bar, lo, hi, ran); subblock<1>(lds, bar, lo, hi, ran); subblock<2>(lds, bar, lo, hi, ran); subblock<3>(lds, bar, lo, hi, ran);
    subblock<4>(lds, bar, lo, hi, ran); subblock<5>(lds, bar, lo, hi, ran); subblock<6>(lds, bar, lo, hi, ran); subblock<7>(lds, bar, lo, hi, ran);
    subblock<8>(lds, bar, lo, hi, ran); subblock<9>(lds, bar, lo, hi, ran); subblock<10>(lds, bar, lo, hi, ran); subblock<11>(lds, bar, lo, hi, ran);
    PH(NPHASE - 1) { TID(); KArgs ka = kargs(); final_norm(ka->out, WSP(long long, WS_SS) + (size_t)NSUB * MTOK, ka->in[17], lane, wave, bx); }
#undef WSP
#undef PH
}

static bool phase_exists(int p) {
    if (p == 0 || p == NPHASE - 1) return true;
    const int j = (p - 1) / 5, k = (p - 1) % 5, typ = j % 3;
    if (k == 0 || k == 4) return true;
    if (typ != 1) return false;
    if (k == 3) return ((j / 3) % 3) != 1;
    return true;
}
extern "C" void kernel_launch(void* const* d_in, const int* in_sizes, int n_in, void* d_out, int out_size, void* d_ws, size_t ws_size, hipStream_t stream) {
    static int grid = 0;
    if (grid == 0) {
        if (n_in != 18 || in_sizes[0] != MTOK * DM || out_size != MTOK * DM || ws_size < WS_END) { fprintf(stderr, "kernel_launch: unexpected shapes (n_in %d, in0 %d, out %d, ws %zu < %zu)\n", n_in, n_in > 0 ? in_sizes[0] : -1, out_size, ws_size, (size_t)WS_END); grid = -1; return; }
        int dev = 0, cus = 0, per_cu = 0;
        if (hipGetDevice(&dev) != hipSuccess || hipDeviceGetAttribute(&cus, hipDeviceAttributeMultiprocessorCount, dev) != hipSuccess) { grid = -1; return; }
        if (hipFuncSetAttribute((const void*)trunk_fwd, hipFuncAttributeMaxDynamicSharedMemorySize, LDS_BYTES) != hipSuccess) { fprintf(stderr, "kernel_launch: hipFuncSetAttribute failed\n"); grid = -1; return; }
        if (hipOccupancyMaxActiveBlocksPerMultiprocessor(&per_cu, (const void*)trunk_fwd, NWAVES * 64, LDS_BYTES) != hipSuccess || per_cu < 1) fprintf(stderr, "kernel_launch: occupancy query says %d\n", per_cu);
        (void)hipGetLastError();
        grid = cus;
    }
    if (grid < 0) return;
    if (hipMemsetAsync((char*)d_ws + WS_CTL, 0, CTL_ZERO_BYTES, stream) != hipSuccess) return;
    Args a{};
    for (int i = 0; i < 18; ++i) a.in[i] = (const float*)d_in[i];
    a.out = (float*)d_out; a.ws = (unsigned char*)d_ws;
#if MK_PER_PHASE
    for (int p = 0; p < NPHASE; ++p) { if (!phase_exists(p)) continue; a.ph_lo = p; a.ph_hi = p + 1; hipLaunchKernelGGL(trunk_fwd, dim3(grid), dim3(NWAVES * 64), LDS_BYTES, stream, a); }
#else
    a.ph_lo = 0; a.ph_hi = NPHASE; hipLaunchKernelGGL(trunk_fwd, dim3(grid), dim3(NWAVES * 64), LDS_BYTES, stream, a);
#endif
    (void)phase_exists;
}
```

```cpp
#include <hip/hip_runtime.h>
#include <cstdio>
#include <cstdint>
namespace pg8 {
#define PG8_LAS __attribute__((address_space(3)))
typedef unsigned short bf16_t;
typedef short bf16x8 __attribute__((ext_vector_type(8)));
typedef float f32x4 __attribute__((ext_vector_type(4)));
typedef unsigned u32x4 __attribute__((ext_vector_type(4)));
constexpr int BM = 256, BK = 64, HALF = 128, HTB = HALF * BK * 2  , STAGE_BYTES = 8 * HTB, NXCD = 8, WGM = 8;

__host__ __device__ __forceinline__ int lds_byte(int r, int c) { const int st = (r >> 4) * 2 + (c >> 5), rr = r & 15, cc = c & 31, ob = rr * 64 + cc * 2; return st * 1024 + (ob ^ (((ob >> 9) & 1) << 5)); }
__host__ __device__ __forceinline__ void stage_rc(int b, int& R, int& C) { const int st = b / 1024, sb = b % 1024, swz = sb ^ (((sb >> 9) & 1) << 5); R = (st >> 1) * 16 + swz / 64; C = (st & 1) * 32 + (swz % 64) / 2; }
__host__ __device__ __forceinline__ int perm32(int rho) { const int n = rho >> 4, i = rho & 15; return 8 * (i >> 2) + 4 * n + (i & 3); }

struct Unit { int pm, pn; };
struct Gemm { const bf16_t* A; const bf16_t* Bt; int M, N, K; };

struct StaticOrder {
    int nM, nN, nwg, G, c;
    __host__ __device__ void init(int M, int N, int G_, int c_) { nM = M / BM; nN = N / BM; nwg = nM * nN; G = G_; c = c_; }
    __host__ __device__ bool next(int i, Unit& u) const {
        const long L = (long)i * G + c; if (L >= nwg) return false;
        int wgid = (int)L; { const int q = nwg / NXCD, r = nwg % NXCD, xcd = wgid % NXCD, off = wgid / NXCD; wgid = (xcd < r ? xcd * (q + 1) : r * (q + 1) + (xcd - r) * q) + off; }
        const int nig = WGM * nN, gid = wgid / nig, fm = gid * WGM, gsz = (nM - fm) < WGM ? (nM - fm) : WGM;
        u.pm = fm + ((wgid % nig) % gsz); u.pn = (wgid % nig) / gsz; return true;
    }
    __device__ __forceinline__ void a_ready(const Unit&) const {}
    __device__ __forceinline__ void done(const Unit&) const {}
};

__device__ __forceinline__ unsigned cvt_pk_bf16(float lo, float hi) { unsigned r; asm volatile("v_cvt_pk_bf16_f32 %0, %1, %2" : "=v"(r) : "v"(lo), "v"(hi)); return r; }
constexpr float RMS_EPS_F = 1e-6f, SS_FIX = 1048576.0f, SS_UNFIX_D = 1.0f / (1048576.0f * 2048.0f);
typedef long long ss_t;
__device__ __forceinline__ float rstd_of(const ss_t* ss, int row) { return rsqrtf((float)ss[row] * SS_UNFIX_D + RMS_EPS_F); }
template <class Sched> __device__ __forceinline__ int rstd_table_fill(const Sched& S, const ss_t* ss, PG8_LAS unsigned char* ext, int tid) {
    PG8_LAS float* tab = (PG8_LAS float*)ext; int key0 = -1, key1 = -1, bad = 0; Unit u;
    for (int i = 0; S.next(i, u); ++i) { const int slot = (u.pm >> 3) & 1; const int key = slot ? key1 : key0;
        if (key == u.pm) continue;
        if (key >= 0) { bad = 1; continue; }
        if (slot) key1 = u.pm; else key0 = u.pm;
        if (tid < 256) tab[slot * 256 + tid] = rstd_of(ss, u.pm * BM + tid); }
    asm volatile("s_waitcnt lgkmcnt(0)" ::: "memory"); __builtin_amdgcn_s_barrier(); asm volatile("" ::: "memory");
    return bad;
}
__device__ __forceinline__ float rstd_get(const ss_t* ss, const Unit& u, int row, int pf, const PG8_LAS unsigned char* ext) {
    return pf ? rstd_of(ss, row) : ((const PG8_LAS float*)ext)[((u.pm >> 3) & 1) * 256 + (row - u.pm * BM)];
}
struct EpiSwiGLU {
    static constexpr bool PERM = true, AFTER_DRAIN = false;
    bf16_t* O; const ss_t* ss; int ldo;
    template <class Sched> __device__ __forceinline__ int prepare(const Sched& S, PG8_LAS unsigned char* ext, int tid) const { return rstd_table_fill(S, ss, ext, tid); }
    __device__ __forceinline__ void operator()(const f32x4 (&acc)[2][2][4][2], const Unit& u, int wr, int wc, int fr, int fq, int pf, const PG8_LAS unsigned char* ext) const {
        const int row0 = u.pm * BM + wr * 64 + fr, col0 = u.pn * HALF + wc * 32 + 8 * fq;
#pragma unroll
        for (int ai = 0; ai < 2; ++ai)
#pragma unroll
            for (int m = 0; m < 4; ++m) {
                const int row = row0 + ai * HALF + m * 16;
                const float rs = rstd_get(ss, u, row, pf, ext);
                float o[8];
#pragma unroll
                for (int n = 0; n < 2; ++n)
#pragma unroll
                    for (int j = 0; j < 4; ++j) { const float a = acc[ai][0][m][n][j] * rs, b = acc[ai][1][m][n][j] * rs;
                        o[4 * n + j] = a * b * __builtin_amdgcn_rcpf(1.0f + __expf(-a)); }
                u32x4 w; w.x = cvt_pk_bf16(o[0], o[1]); w.y = cvt_pk_bf16(o[2], o[3]); w.z = cvt_pk_bf16(o[4], o[5]); w.w = cvt_pk_bf16(o[6], o[7]);
                *(u32x4*)(O + (size_t)row * ldo + col0) = w;
            }
    }
};
struct EpiMixIn {
    static constexpr bool PERM = true, AFTER_DRAIN = false;
    bf16_t* O; const ss_t* ss;
    template <class Sched> __device__ __forceinline__ int prepare(const Sched& S, PG8_LAS unsigned char* ext, int tid) const { return rstd_table_fill(S, ss, ext, tid); }
    __device__ __forceinline__ void operator()(const f32x4 (&acc)[2][2][4][2], const Unit& u, int wr, int wc, int fr, int fq, int pf, const PG8_LAS unsigned char* ext) const {
        const int row0 = u.pm * BM + wr * 64 + fr, col0 = u.pn * BM + wc * 32 + 8 * fq;
#pragma unroll
        for (int ai = 0; ai < 2; ++ai)
#pragma unroll
            for (int m = 0; m < 4; ++m) {
                const int row = row0 + ai * HALF + m * 16;
                const float rs = rstd_get(ss, u, row, pf, ext);
#pragma unroll
                for (int bj = 0; bj < 2; ++bj) { const f32x4 v0 = acc[ai][bj][m][0] * rs, v1 = acc[ai][bj][m][1] * rs;
                    u32x4 w; w.x = cvt_pk_bf16(v0[0], v0[1]); w.y = cvt_pk_bf16(v0[2], v0[3]); w.z = cvt_pk_bf16(v1[0], v1[1]); w.w = cvt_pk_bf16(v1[2], v1[3]);
                    *(u32x4*)(O + (size_t)row * 6144 + col0 + bj * HALF) = w; }
            }
    }
};
struct EpiResid {
    static constexpr bool PERM = false, AFTER_DRAIN = false;
    const float* res; float* hout; bf16_t* hb; ss_t* ssn; float scale;
    template <class Sched> __device__ __forceinline__ int prepare(const Sched&, PG8_LAS unsigned char*, int) const { return 0; }
    __device__ __forceinline__ void operator()(const f32x4 (&acc)[2][2][4][2], const Unit& u, int wr, int wc, int fr, int fq, int pf, const PG8_LAS unsigned char* ext) const {
        typedef unsigned u32x2v __attribute__((ext_vector_type(2)));
        const int row0 = u.pm * BM + wr * 64 + fr, col0 = u.pn * BM + wc * 32 + 4 * fq;
        f32x4 rb[3][4];
#define PG8_LDG(gi, buf) do { const size_t off_ = (size_t)(row0 + ((gi) >> 2) * HALF + ((gi) & 3) * 16) * 2048 + col0; \
            _Pragma("unroll") for (int q_ = 0; q_ < 4; ++q_) buf[q_] = *(const f32x4*)(res + off_ + (q_ >> 1) * HALF + (q_ & 1) * 16); } while (0)
        PG8_LDG(0, rb[0]); PG8_LDG(1, rb[1]);
#pragma unroll
        for (int gi = 0; gi < 8; ++gi) {
            if (gi + 2 < 8) PG8_LDG(gi + 2, rb[(gi + 2) % 3]);
            const int ai = gi >> 2, m = gi & 3;
            const int row = row0 + ai * HALF + m * 16; const size_t off = (size_t)row * 2048 + col0; float sq = 0.f;
#pragma unroll
            for (int q = 0; q < 4; ++q) { const int bj = q >> 1, n = q & 1; const size_t o2 = off + bj * HALF + n * 16;
                const f32x4 hn = rb[gi % 3][q] + acc[ai][bj][m][n] * scale;
                *(f32x4*)(hout + o2) = hn; u32x2v w; w.x = cvt_pk_bf16(hn[0], hn[1]); w.y = cvt_pk_bf16(hn[2], hn[3]); *(u32x2v*)(hb + o2) = w;
                sq += (hn[0] * hn[0] + hn[1] * hn[1]) + (hn[2] * hn[2] + hn[3] * hn[3]); }
            sq += __shfl_xor(sq, 16); sq += __shfl_xor(sq, 32);
            if (fq == 0) atomicAdd((unsigned long long*)(ssn + row), (unsigned long long)__float2ll_rn(sq * SS_FIX));
        }
#undef PG8_LDG
    }
};

template <class Epi, class Sched, bool ALIGN_EPI = false, bool SP2 = false>
__device__ __forceinline__ void gemm_phase(PG8_LAS unsigned char* lds, const Gemm g, const Sched& S, const Epi& E) {
    int tid_ = threadIdx.x; asm volatile("" : "+v"(tid_));
    const int tid = tid_, wid = __builtin_amdgcn_readfirstlane(tid >> 6), lane = tid & 63, wr = wid >> 2, wc = wid & 3, fr = lane & 15, fq = lane >> 4;
    const int K = g.K, nt = K / BK;
    unsigned voffA[2], voffB[2];
#pragma unroll
    for (int i = 0; i < 2; ++i) { int R, C; stage_rc(tid * 16 + i * 8192, R, C); const int Rb = Epi::PERM ? ((R & ~31) + perm32(R & 31)) : R;
        voffA[i] = (unsigned)(R * K + C) * 2u; voffB[i] = (unsigned)(Rb * K + C) * 2u; }
    const size_t kstep = (size_t)(BK * 2);
    const size_t hstep = (size_t)HALF * K * 2;
    const size_t tstep = 2 * hstep;
    const unsigned ldsw = (unsigned)wid * 1024u;
    const int aoff = lds_byte(wr * 64 + fr, fq * 8), boff = lds_byte(wc * 32 + fr, fq * 8);
#define PG8_SA(b, h) (((b) * 2 + (h)) * HTB)
#define PG8_SB(b, h) ((4 + (b) * 2 + (h)) * HTB)
#define PG8_STAGE(bufoff, gbase, voff) do { _Pragma("unroll") for (int _i = 0; _i < 2; ++_i) \
        __builtin_amdgcn_global_load_lds((const unsigned*)((const char*)(gbase) + (voff)[_i]), (PG8_LAS unsigned*)(lds + (bufoff) + ldsw + _i * 8192), 16, 0, 0); } while (0)
#define PG8_LDA(dst, b, h) do { _Pragma("unroll") for (int m = 0; m < 4; ++m) _Pragma("unroll") for (int k = 0; k < 2; ++k) dst[m][k] = *(const PG8_LAS bf16x8*)(lds + PG8_SA(b, h) + aoff + m * 2048 + k * 1024); } while (0)
#define PG8_LDB(dst, b, h) do { _Pragma("unroll") for (int n = 0; n < 2; ++n) _Pragma("unroll") for (int k = 0; k < 2; ++k) dst[n][k] = *(const PG8_LAS bf16x8*)(lds + PG8_SB(b, h) + boff + n * 2048 + k * 1024); } while (0)
#define PG8_MMA(ai, bj, At, Bt) do { __builtin_amdgcn_s_setprio(1); _Pragma("unroll") for (int m = 0; m < 4; ++m) _Pragma("unroll") for (int n = 0; n < 2; ++n) _Pragma("unroll") for (int k = 0; k < 2; ++k) \
        acc[ai][bj][m][n] = __builtin_amdgcn_mfma_f32_16x16x32_bf16(Bt[n][k], At[m][k], acc[ai][bj][m][n], 0, 0, 0); __builtin_amdgcn_s_setprio(0); } while (0)
#define PG8_WAIT_V(n) asm volatile("s_waitcnt vmcnt(" #n ")" ::: "memory")
#define PG8_WAIT_L(n) asm volatile("s_waitcnt lgkmcnt(" #n ")" ::: "memory")
#define PG8_BAR __builtin_amdgcn_s_barrier()
#define PG8_SCHED __builtin_amdgcn_sched_barrier(0)
    const int pf = E.prepare(S, lds + STAGE_BYTES, tid);
    Unit cur, nxt; int ui = 0;
    if (!S.next(0, cur)) return;
    f32x4 acc[2][2][4][2];
#pragma unroll
    for (int a = 0; a < 2; ++a)
#pragma unroll
        for (int b = 0; b < 2; ++b)
#pragma unroll
            for (int m = 0; m < 4; ++m)
#pragma unroll
                for (int n = 0; n < 2; ++n) acc[a][b][m][n] = (f32x4){0.f, 0.f, 0.f, 0.f};
    bf16x8 At[4][2], B0[2][2], B1[2][2];
    const char* cA = (const char*)g.A + (size_t)cur.pm * tstep; const char* cB = (const char*)g.Bt + (size_t)cur.pn * tstep;
    S.a_ready(cur);
    if constexpr (SP2) {
        PG8_STAGE(PG8_SB(0, 0), cB, voffB); PG8_STAGE(PG8_SB(0, 1), cB + hstep, voffB); PG8_STAGE(PG8_SA(0, 0), cA, voffA); PG8_STAGE(PG8_SA(0, 1), cA + hstep, voffA);
        if (wr == 1) PG8_BAR;
        PG8_WAIT_V(2); PG8_BAR;
        PG8_STAGE(PG8_SB(1, 0), cB + kstep, voffB); PG8_STAGE(PG8_SA(1, 0), cA + kstep, voffA); PG8_STAGE(PG8_SB(1, 1), cB + hstep + kstep, voffB);
        PG8_WAIT_V(6); PG8_BAR;
    } else {
        PG8_STAGE(PG8_SB(0, 0), cB, voffB); PG8_STAGE(PG8_SA(0, 0), cA, voffA); PG8_STAGE(PG8_SB(0, 1), cB + hstep, voffB); PG8_STAGE(PG8_SA(0, 1), cA + hstep, voffA);
        if (wr == 1) PG8_BAR;
        PG8_WAIT_V(4); PG8_BAR;
        PG8_STAGE(PG8_SB(1, 0), cB + kstep, voffB); PG8_STAGE(PG8_SA(1, 0), cA + kstep, voffA); PG8_STAGE(PG8_SB(1, 1), cB + hstep + kstep, voffB);
        PG8_WAIT_V(6); PG8_BAR;
    }
    for (;;) {
        const bool has_next = S.next(ui + 1, nxt);
        const char* nA = has_next ? (const char*)g.A + (size_t)nxt.pm * tstep : cA; const char* nB = has_next ? (const char*)g.Bt + (size_t)nxt.pn * tstep : cB;
        for (int t = 0; t < nt; t += 2) {
            const bool last = (t == nt - 2);
            const char* a1 = cA + (size_t)(t + 1) * kstep;
            const char* a2 = last ? nA : cA + (size_t)(t + 2) * kstep; const char* b2 = last ? nB : cB + (size_t)(t + 2) * kstep;
            const char* a3 = a2 + kstep; const char* b3 = b2 + kstep;
            if (last && has_next) S.a_ready(nxt);
            if constexpr (SP2) {
            PG8_LDB(B0, 0, 0); PG8_LDB(B1, 0, 1); PG8_SCHED; PG8_LDA(At, 0, 0); PG8_STAGE(PG8_SA(1, 1), a1 + hstep, voffA);
            PG8_WAIT_V(8); PG8_WAIT_L(0); PG8_BAR; PG8_MMA(0, 0, At, B0); PG8_MMA(0, 1, At, B1); PG8_BAR; PG8_SCHED;
            PG8_LDA(At, 0, 1); PG8_STAGE(PG8_SB(0, 0), b2, voffB); PG8_STAGE(PG8_SB(0, 1), b2 + hstep, voffB); PG8_STAGE(PG8_SA(0, 0), a2, voffA);
            PG8_WAIT_V(8); PG8_WAIT_L(0); PG8_BAR; PG8_MMA(1, 0, At, B0); PG8_MMA(1, 1, At, B1); PG8_BAR; PG8_SCHED;
            PG8_LDB(B0, 1, 0); PG8_LDB(B1, 1, 1); PG8_SCHED; PG8_LDA(At, 1, 0); PG8_STAGE(PG8_SA(0, 1), a2 + hstep, voffA);
            PG8_WAIT_V(8); PG8_WAIT_L(0); PG8_BAR; PG8_MMA(0, 0, At, B0); PG8_MMA(0, 1, At, B1); PG8_BAR; PG8_SCHED;
            PG8_LDA(At, 1, 1); PG8_STAGE(PG8_SB(1, 0), b3, voffB); PG8_STAGE(PG8_SB(1, 1), b3 + hstep, voffB); PG8_STAGE(PG8_SA(1, 0), a3, voffA);
            PG8_WAIT_V(8); PG8_WAIT_L(0); PG8_BAR; PG8_MMA(1, 0, At, B0); PG8_MMA(1, 1, At, B1); PG8_BAR; PG8_SCHED;
            } else {
            PG8_LDB(B0, 0, 0); PG8_SCHED; PG8_LDA(At, 0, 0); PG8_STAGE(PG8_SA(1, 1), a1 + hstep, voffA);
            PG8_WAIT_L(8); PG8_BAR; PG8_WAIT_L(0); PG8_MMA(0, 0, At, B0); PG8_BAR; PG8_SCHED;
            PG8_LDB(B1, 0, 1); PG8_STAGE(PG8_SB(0, 0), b2, voffB);
            PG8_BAR; PG8_WAIT_L(0); PG8_MMA(0, 1, At, B1); PG8_BAR;
            PG8_LDA(At, 0, 1); PG8_STAGE(PG8_SA(0, 0), a2, voffA);
            PG8_BAR; PG8_WAIT_L(0); PG8_MMA(1, 0, At, B0); PG8_BAR; PG8_SCHED;
            PG8_STAGE(PG8_SB(0, 1), b2 + hstep, voffB);
            PG8_WAIT_V(6); PG8_BAR; PG8_MMA(1, 1, At, B1); PG8_BAR;
            PG8_LDB(B0, 1, 0); PG8_SCHED; PG8_LDA(At, 1, 0); PG8_STAGE(PG8_SA(0, 1), a2 + hstep, voffA);
            PG8_WAIT_L(8); PG8_BAR; PG8_WAIT_L(0); PG8_MMA(0, 0, At, B0); PG8_BAR; PG8_SCHED;
            PG8_LDB(B1, 1, 1); PG8_STAGE(PG8_SB(1, 0), b3, voffB);
            PG8_BAR; PG8_WAIT_L(0); PG8_MMA(0, 1, At, B1); PG8_BAR;
            PG8_LDA(At, 1, 1); PG8_STAGE(PG8_SA(1, 0), a3, voffA);
            PG8_BAR; PG8_WAIT_L(0); PG8_MMA(1, 0, At, B0); PG8_BAR; PG8_SCHED;
            PG8_STAGE(PG8_SB(1, 1), b3 + hstep, voffB);
            PG8_WAIT_V(6); PG8_BAR; PG8_MMA(1, 1, At, B1); PG8_BAR;
            }
        }
        if constexpr (ALIGN_EPI) { if (wr == 0) PG8_BAR; }
        if constexpr (!Epi::AFTER_DRAIN) { E(acc, cur, wr, wc, fr, fq, pf, lds + STAGE_BYTES); S.done(cur); }
        if (!has_next) break;
#pragma unroll
        for (int a = 0; a < 2; ++a)
#pragma unroll
            for (int b = 0; b < 2; ++b)
#pragma unroll
                for (int m = 0; m < 4; ++m)
#pragma unroll
                    for (int n = 0; n < 2; ++n) acc[a][b][m][n] = (f32x4){0.f, 0.f, 0.f, 0.f};
        cur = nxt; cA = nA; cB = nB; ++ui;
        if constexpr (ALIGN_EPI) { if (wr == 1) PG8_BAR; }
    }
    PG8_WAIT_V(0);
    if constexpr (!ALIGN_EPI) { if (wr == 0) PG8_BAR; }
    PG8_BAR;
    if constexpr (Epi::AFTER_DRAIN) { E.fused(acc, cur, wr, wc, fr, fq, lds, wid, lane); S.done(cur); }
#undef PG8_SA
#undef PG8_SB
#undef PG8_STAGE
#undef PG8_LDA
#undef PG8_LDB
#undef PG8_MMA
#undef PG8_WAIT_V
#undef PG8_WAIT_L
#undef PG8_BAR
#undef PG8_SCHED
}
}

#ifndef PG8_SP2
#define PG8_SP2 true
#endif
#ifndef PG8_ALIGN
#define PG8_ALIGN true
#endif
#ifndef REP_PRO
#define REP_PRO 1
#endif
#ifndef REP_MLSTM
#define REP_MLSTM 1
#endif
#ifndef REP_FOX
#define REP_FOX 1
#endif
#ifndef REP_GLA
#define REP_GLA 1
#endif
#ifndef MK_PER_PHASE
#define MK_PER_PHASE 0
#endif

constexpr int DM = 2048, BATCH = 8, SEQ = 4096, MTOK = BATCH * SEQ, DEPTH = 4, DFF = 5632, NUP = 2 * DFF, NIN = 6160, NINP = 6400, NQKV = 6144;
constexpr int NWAVES = 8;
constexpr int NSUB = 3 * DEPTH;
constexpr int NPHASE = 2 + 5 * NSUB;

constexpr size_t MiB = 1u << 20;
constexpr size_t WS_CTL = 0, CTL_ZERO_BYTES = 5 * MiB;
constexpr size_t WS_SS = 1 * MiB;
constexpr size_t WS_WUP = 8 * MiB;
constexpr size_t WS_WDN = WS_WUP + 352 * MiB;
constexpr size_t WS_WIN = WS_WDN + 176 * MiB;
constexpr size_t WS_WOUT = WS_WIN + 100 * MiB;
constexpr size_t WS_HB = WS_WOUT + 32 * MiB;
constexpr size_t WS_ACT = WS_HB + 128 * MiB;
constexpr size_t WS_P1 = WS_ACT + 352 * MiB;
constexpr size_t WS_G = WS_P1 + 384 * MiB;
constexpr size_t WS_HRAW = WS_G + 2 * MiB;
constexpr size_t WS_HM = WS_HRAW + 256 * MiB;
constexpr size_t WS_CF = WS_HM + 128 * MiB;
constexpr size_t WS_END = WS_CF + 2 * MiB;
static_assert((size_t)8 * NUP * DM * 2 == 352 * MiB && (size_t)8 * DM * DFF * 2 == 176 * MiB && (size_t)4 * NINP * DM * 2 == 100 * MiB, "weight regions");
static_assert((size_t)MTOK * DFF * 2 == 352 * MiB && (size_t)MTOK * NQKV * 2 == 384 * MiB && WS_SS + 13 * (size_t)MTOK * 8 <= CTL_ZERO_BYTES, "activation regions");
constexpr int CW_BAR = 4096;

constexpr int LDS_BYTES = 153600, MISC_OFF = 152576;

#define GAS __attribute__((address_space(1)))
#define LAS __attribute__((address_space(3)))
#define DI __device__ __forceinline__
typedef unsigned short bf16;
typedef unsigned v4u __attribute__((ext_vector_type(4)));
typedef unsigned v2u __attribute__((ext_vector_type(2)));
typedef float f32x4 __attribute__((ext_vector_type(4)));
typedef short bf16x8 __attribute__((ext_vector_type(8)));
typedef GAS unsigned gu32;
#define RLX_AGENT __ATOMIC_RELAXED, __HIP_MEMORY_SCOPE_AGENT
#define LDS_WAIT() asm volatile("s_waitcnt lgkmcnt(0)" ::: "memory")
DI unsigned f2bf(float f) { unsigned u = __builtin_bit_cast(unsigned, f); return (u + 0x7fffu + ((u >> 16) & 1u)) >> 16; }
DI unsigned pk2(float lo, float hi) { return f2bf(lo) | (f2bf(hi) << 16); }
DI float bf2f(unsigned short v) { return __builtin_bit_cast(float, (unsigned)v << 16); }
DI float bflo(unsigned w) { return __builtin_bit_cast(float, w << 16); }
DI float bfhi(unsigned w) { return __builtin_bit_cast(float, w & 0xffff0000u); }
DI float logsig(float x) { return fminf(x, 0.f) - log1pf(expf(-fabsf(x))); }

#define XB_TMO      128
#define XB_XCNT(j)  (256  + 64 * (j))
#define XB_XSUB(j)  (1280 + 64 * (j))
#define XB_XGEN(j)  (2304 + 64 * (j))
#define XB_TOP      3328
#define XB_TOPGEN   3392
#define XCD_BAR_WORDS 3456
#define XB_SPIN_CAP (1u << 18)

__device__ __forceinline__ unsigned xb_ld(unsigned* p)              { return __hip_atomic_load(p, __ATOMIC_RELAXED, __HIP_MEMORY_SCOPE_AGENT); }
__device__ __forceinline__ unsigned xb_add(unsigned* p, unsigned v) { return __hip_atomic_fetch_add(p, v, __ATOMIC_RELAXED, __HIP_MEMORY_SCOPE_AGENT); }
__device__ __forceinline__ unsigned xb_xcc_id() { return (unsigned)__builtin_amdgcn_s_getreg((3 << 11) | 20) & 0xFu; }
#define XB_SPIN(cond, bar) do { unsigned _sp = 0; while (cond) { __builtin_amdgcn_s_sleep(1); \
    if ((++_sp & 255u) == 0u) { if (xb_ld(&(bar)[XB_TMO])) break; if (_sp > XB_SPIN_CAP) { atomicAdd(&(bar)[XB_TMO], 1u); break; } } } } while (0)

struct XcdBarrier {
    unsigned* bar; unsigned x;
    volatile LAS unsigned* st;
};

__device__ __forceinline__ XcdBarrier xcd_barrier_post(unsigned* bar, volatile LAS unsigned* st) {
    XcdBarrier b; b.bar = bar; b.x = xb_xcc_id(); b.st = st;
    if (threadIdx.x == 0) (void)xb_add(&bar[XB_XCNT(b.x)], 1u);
    return b;
}
__device__ __forceinline__ void xcd_barrier_complete(unsigned* bar, unsigned x, unsigned& nloc, unsigned& nx) {
    const unsigned G = gridDim.x * gridDim.y * gridDim.z;
    unsigned sum, cnt, mine, sp = 0u;
    for (;;) {
        sum = 0u; cnt = 0u; mine = 0u;
#pragma unroll
        for (unsigned j = 0; j < 16; ++j) { const unsigned c = xb_ld(&bar[XB_XCNT(j)]); sum += c; cnt += (c > 0u) ? 1u : 0u; mine = (j == x) ? c : mine; }
        if (sum == G) break;
        __builtin_amdgcn_s_sleep(1);
        if ((++sp & 255u) == 0u) { if (xb_ld(&bar[XB_TMO])) break; if (sp > XB_SPIN_CAP) { atomicAdd(&bar[XB_TMO], 1u); break; } }
    }
    nloc = mine > 0u ? mine : 1u; nx = cnt > 0u ? cnt : 1u;
}

__device__ __forceinline__ void xcd_barrier(const XcdBarrier& b) {
    asm volatile("s_waitcnt vmcnt(0)" ::: "memory");
    __syncthreads();
    if (threadIdx.x == 0) {
        unsigned* bar = b.bar;
        __builtin_amdgcn_s_waitcnt(0);
        unsigned nloc = b.st[0], nx = b.st[1];
        if (nloc == 0u) { xcd_barrier_complete(bar, b.x, nloc, nx); b.st[0] = nloc; b.st[1] = nx; }
        const unsigned old = xb_add(&bar[XB_XSUB(b.x)], 1u);
        const unsigned gen = old / nloc;
        if (old + 1u == (gen + 1u) * nloc) {
            __builtin_amdgcn_fence(__ATOMIC_RELEASE, "agent");
            asm volatile("s_waitcnt vmcnt(0)" ::: "memory");
            const unsigned og = xb_add(&bar[XB_TOP], 1u);
            const unsigned tg = og / nx;
            if (og + 1u == (tg + 1u) * nx) xb_add(&bar[XB_TOPGEN], 1u);
            else XB_SPIN(xb_ld(&bar[XB_TOPGEN]) == tg, bar);
            __builtin_amdgcn_fence(__ATOMIC_ACQUIRE, "agent");
            xb_add(&bar[XB_XGEN(b.x)], 1u);
            asm volatile("s_waitcnt vmcnt(0)" ::: "memory");
        } else {
            XB_SPIN(xb_ld(&bar[XB_XGEN(b.x)]) == gen, bar);
            __builtin_amdgcn_fence(__ATOMIC_ACQUIRE, "agent");
            asm volatile("s_waitcnt vmcnt(0)" ::: "memory");
        }
    }
    __syncthreads();
}


DI float wave_sum(float v) {
#pragma unroll
    for (int o = 1; o < 64; o <<= 1) v += __shfl_xor(v, o);
    return v;
}
DI float wave_max(float v) {
#pragma unroll
    for (int o = 1; o < 64; o <<= 1) v = fmaxf(v, __shfl_xor(v, o));
    return v;
}
DI float wave_incl_sum(float v, int lane) {
#pragma unroll
    for (int o = 1; o < 64; o <<= 1) { const float t = __shfl_up(v, o); if (lane >= o) v += t; }
    return v;
}
DI float wave_incl_max(float v, int lane) {
#pragma unroll
    for (int o = 1; o < 64; o <<= 1) { const float t = __shfl_up(v, o); if (lane >= o) v = fmaxf(v, t); }
    return v;
}

template <int L> DI int swx(int r) { return L == 64 ? ((r >> 1) & 7) : (r & 15); }
template <int L> DI int eoff(int r, int c) { return r * L + ((((c >> 3) ^ swx<L>(r)) << 3) | (c & 7)); }
template <int L> DI bf16x8 ldf(const LAS bf16* base, int r, int ch) { return *(const LAS bf16x8*)(base + r * L + ((ch ^ swx<L>(r)) << 3)); }
DI f32x4 mfma16(bf16x8 a, bf16x8 b, f32x4 c) { return __builtin_amdgcn_mfma_f32_16x16x32_bf16(a, b, c, 0, 0, 0); }
template <int LA, int LB, int NK> DI void mma_tile(f32x4& acc, const LAS bf16* A, int ra0, const LAS bf16* B, int rb0, int lane) {
    const int r = lane & 15, g = lane >> 4;
#pragma unroll
    for (int kk = 0; kk < NK; ++kk) { const bf16x8 a = ldf<LA>(A, ra0 + r, 4 * kk + g), b = ldf<LB>(B, rb0 + r, 4 * kk + g); acc = mfma16(a, b, acc); }
}

DI void conv_item(const float* W, int K, int N, int nblk, const float* gk, bf16* WT, int mode, LAS float* scr, int item, int lane) {
    const int kb = item / nblk, nb = item - kb * nblk, k0 = 64 * kb, n0 = 32 * nb;
    const int nq = 4 * (lane & 7), n = n0 + nq; const bool ok = n < N;
    f32x4 v[8]; float gv[8];
#pragma unroll
    for (int i = 0; i < 8; ++i) { const int kk = 8 * i + (lane >> 3); v[i] = ok ? *(const f32x4*)(W + (size_t)(k0 + kk) * N + n) : (f32x4){0.f, 0.f, 0.f, 0.f}; gv[i] = gk ? gk[k0 + kk] : 1.0f; }
#pragma unroll
    for (int i = 0; i < 8; ++i) { const int kk = 8 * i + (lane >> 3); LAS float* d = scr + kk * 33 + nq; d[0] = v[i].x * gv[i]; d[1] = v[i].y * gv[i]; d[2] = v[i].z * gv[i]; d[3] = v[i].w * gv[i]; }
    LDS_WAIT(); asm volatile("" ::: "memory");
    int row_off = n0;
    if (mode == 1) { const int j = n0 < DFF ? n0 : n0 - DFF; row_off = 256 * (j >> 7) + (j & 127) + (n0 < DFF ? 0 : 128); }
    const int c = lane & 7;
#pragma unroll
    for (int j = 0; j < 4; ++j) { const int nn = (lane >> 3) + 8 * j; const LAS float* s = scr + (8 * c) * 33 + nn;
        v4u o; o.x = pk2(s[0 * 33], s[1 * 33]); o.y = pk2(s[2 * 33], s[3 * 33]); o.z = pk2(s[4 * 33], s[5 * 33]); o.w = pk2(s[6 * 33], s[7 * 33]);
        *(v4u*)(WT + (size_t)(row_off + nn) * K + k0 + 8 * c) = o; }
    LDS_WAIT(); asm volatile("" ::: "memory");
}

struct Args { const float* in[18]; float* out; unsigned char* ws; int ph_lo, ph_hi; };

typedef const __attribute__((address_space(4))) Args* KArgs;
DI KArgs kargs() { KArgs p = (KArgs)__builtin_amdgcn_kernarg_segment_ptr(); asm volatile("" : "+s"(p)); return p; }
DI void prologue(LAS unsigned char* lds, int lane, int wave, int bx) {
    KArgs AP = kargs();
    LAS float* scr = (LAS float*)(lds + wave * 16384);
    const int gw = bx * NWAVES + wave, NGW = gridDim.x * NWAVES;
    unsigned char* ws = AP->ws;
    constexpr int I_UP = (DM / 64) * (NUP / 32), I_DN = (DFF / 64) * (DM / 32), I_IN = (DM / 64) * (NINP / 32), I_OUT = (DM / 64) * (DM / 32);
    constexpr int NITEMS = 8 * I_UP + 8 * I_DN + 4 * I_IN + 4 * I_OUT;
    for (int it = gw; it < NITEMS; it += NGW) {
        int r = it; const float* W; const float* gk = nullptr; bf16* WT; int K = DM, N, nblk, mode = 0;
        if (r < 8 * I_UP) { const int mi = r / I_UP; r -= mi * I_UP; W = AP->in[2] + (size_t)mi * DM * NUP; gk = AP->in[1] + (size_t)mi * DM; WT = (bf16*)(ws + WS_WUP) + (size_t)mi * NUP * DM; N = NUP; nblk = NUP / 32; mode = 1; }
        else if (r < 8 * I_UP + 8 * I_DN) { r -= 8 * I_UP; const int mi = r / I_DN; r -= mi * I_DN; W = AP->in[3] + (size_t)mi * DFF * DM; WT = (bf16*)(ws + WS_WDN) + (size_t)mi * DM * DFF; K = DFF; N = DM; nblk = DM / 32; }
        else if (r < 8 * I_UP + 8 * I_DN + 4 * I_IN) { r -= 8 * I_UP + 8 * I_DN; const int l = r / I_IN; r -= l * I_IN; const int kind = l % 3, ji = l / 3;
            W = AP->in[kind == 0 ? 5 : kind == 1 ? 9 : 12] + (size_t)ji * DM * NIN; gk = AP->in[4] + (size_t)l * DM; WT = (bf16*)(ws + WS_WIN) + (size_t)l * NINP * DM; N = NIN; nblk = NINP / 32; }
        else { r -= 8 * I_UP + 8 * I_DN + 4 * I_IN; const int l = r / I_OUT; r -= l * I_OUT; const int kind = l % 3, ji = l / 3;
            W = AP->in[kind == 0 ? 8 : kind == 1 ? 11 : 16] + (size_t)ji * DM * DM; WT = (bf16*)(ws + WS_WOUT) + (size_t)l * DM * DM; N = DM; nblk = DM / 32; }
        conv_item(W, K, N, nblk, gk, WT, mode, scr, r, lane);
    }
    const float* x = AP->in[0]; bf16* hb = (bf16*)(ws + WS_HB); long long* ss0 = (long long*)(ws + WS_SS);
    for (int m = gw; m < MTOK; m += NGW) {
        const f32x4* xr = (const f32x4*)(x + (size_t)m * DM) + lane; f32x4 v[8]; float s = 0.f;
#pragma unroll
        for (int j = 0; j < 8; ++j) { v[j] = xr[64 * j]; s += (v[j].x * v[j].x + v[j].y * v[j].y) + (v[j].z * v[j].z + v[j].w * v[j].w); }
        s = wave_sum(s);
        v2u* o8 = (v2u*)(hb + (size_t)m * DM) + lane;
#pragma unroll
        for (int j = 0; j < 8; ++j) { v2u w; w.x = pk2(v[j].x, v[j].y); w.y = pk2(v[j].z, v[j].w); o8[64 * j] = w; }
        if (lane == 0) ss0[m] = __float2ll_rn(s * 1048576.0f);
    }
}

constexpr int IMGM_P = 0, IMGM_KT = 8192, IMGM_VT = IMGM_KT + 16384, IMGM_GS = IMGM_VT + 4 * 8192, IMGM_BYTES = IMGM_GS + 1024;
constexpr int IMGG_Q = 0, IMGG_KT = 32768, IMGG_P = 65536, IMGG_VT = IMGG_P + 8192, IMGG_EB = IMGG_VT + 8 * 8192, IMGG_BYTES = IMGG_EB + 1024;
static_assert((size_t)IMGM_BYTES * 4096 <= 352 * MiB && (size_t)IMGG_BYTES * 2048 <= 352 * MiB, "images overlay the (idle) FFN activation buffer");
DI float logsig_fast(float x) { return fminf(x, 0.f) - __logf(1.0f + __expf(-fabsf(x))); }

DI void mlstm_pre(LAS unsigned char* lds, const bf16* P1, const float* G, const float* b_if, unsigned char* img, int tid, int lane, int wave, int bx) {
    LAS bf16* Qs = (LAS bf16*)lds;
    LAS bf16* Ks = Qs + 64 * 128;
    LAS bf16* KTs = Ks + 64 * 128;
    LAS bf16* Ps = KTs + 128 * 64;
    LAS bf16* VT = Ps + 64 * 64;
    LAS float* fa = (LAS float*)(VT + 256 * 64);
    LAS float *bcum = fa, *ipre = fa + 64, *aloc = fa + 128, *wloc = fa + 192, *scal = fa + 256;
    const float KSCALE = 0.08838834764831845f;
    const int g = lane >> 4, r16 = lane & 15;
    for (int item = bx; item < 4096; item += gridDim.x) {
        const int b = item >> 9, c = (item >> 3) & 63, h = item & 7;
        const int row0 = b * SEQ + c * 64;
        unsigned char* im = img + (size_t)item * IMGM_BYTES;
        __syncthreads();
        if (tid < 64) { const float* gp = G + (size_t)(row0 + tid) * 16; ipre[tid] = gp[h] + b_if[h]; bcum[tid] = logsig(gp[8 + h] + b_if[8 + h]); }
#pragma unroll
        for (int p = 0; p < 2; ++p) { const int idx = tid + 512 * p, r = idx >> 4, c8 = idx & 15; const bf16* src = P1 + (size_t)(row0 + r) * NQKV + h * 128 + c8 * 8;
            const v4u vq = *(const v4u*)src, vk = *(const v4u*)(src + 1024);
            *(LAS v4u*)(Qs + eoff<128>(r, c8 * 8)) = vq; *(LAS v4u*)(Ks + eoff<128>(r, c8 * 8)) = vk; }
#pragma unroll
        for (int p = 0; p < 4; ++p) { const int idx = tid + 512 * p, r = idx >> 5, c8 = idx & 31; const v4u vv = *(const v4u*)(P1 + (size_t)(row0 + r) * NQKV + 2048 + h * 256 + c8 * 8);
#pragma unroll
            for (int j = 0; j < 4; ++j) { VT[eoff<64>(c8 * 8 + 2 * j, r)] = (bf16)(vv[j] & 0xffffu); VT[eoff<64>(c8 * 8 + 2 * j + 1, r)] = (bf16)(vv[j] >> 16); } }
        __syncthreads();
        if (wave == 0) {
            const float bt = wave_incl_sum(bcum[lane], lane), ip = ipre[lane];
            const float al = bt + wave_incl_max(ip - bt, lane);
            const float blast = __shfl(bt, 63);
            const float gg = blast - bt + ip;
            const float gmax = wave_max(gg);
            bcum[lane] = bt; aloc[lane] = al; wloc[lane] = expf(gg - gmax);
            if (lane == 0) { scal[0] = blast; scal[1] = gmax; }
        }
        __syncthreads();
#pragma unroll
        for (int p = 0; p < 2; ++p) { const int idx = tid + 512 * p, s = idx >> 4, c8 = idx & 15; const v4u kv = *(const LAS v4u*)(Ks + eoff<128>(s, c8 * 8)); const float w = wloc[s] * KSCALE;
#pragma unroll
            for (int j = 0; j < 4; ++j) { KTs[eoff<64>(c8 * 8 + 2 * j, s)] = (bf16)f2bf(bflo(kv[j]) * w); KTs[eoff<64>(c8 * 8 + 2 * j + 1, s)] = (bf16)f2bf(bfhi(kv[j]) * w); } }
        { const int tt = wave >> 1;
#pragma unroll
          for (int q2 = 0; q2 < 2; ++q2) { const int st = 2 * (wave & 1) + q2; f32x4 acc = (f32x4){0.f, 0.f, 0.f, 0.f};
            if (st <= tt) mma_tile<128, 128, 4>(acc, Qs, 16 * tt, Ks, 16 * st, lane);
            const int s = 16 * st + r16; const float cs = ipre[s] - bcum[s];
#pragma unroll
            for (int i = 0; i < 4; ++i) { const int t = 16 * tt + 4 * g + i; const float p = (s <= t) ? acc[i] * KSCALE * expf(bcum[t] + cs - aloc[t]) : 0.f; Ps[eoff<64>(t, s)] = (bf16)f2bf(p); } } }
        __syncthreads();
        *(v4u*)(im + IMGM_P + tid * 16) = *(const LAS v4u*)((LAS unsigned char*)Ps + tid * 16);
#pragma unroll
        for (int p = 0; p < 2; ++p) *(v4u*)(im + IMGM_KT + (tid + 512 * p) * 16) = *(const LAS v4u*)((LAS unsigned char*)KTs + (tid + 512 * p) * 16);
#pragma unroll
        for (int p = 0; p < 4; ++p) *(v4u*)(im + IMGM_VT + (tid + 512 * p) * 16) = *(const LAS v4u*)((LAS unsigned char*)VT + (tid + 512 * p) * 16);
        if (tid < 64) { float* gs = (float*)(im + IMGM_GS); gs[tid] = bcum[tid]; gs[64 + tid] = aloc[tid]; if (tid < 2) gs[128 + tid] = scal[tid]; }
    }
}

DI void mlstm_scan2(LAS unsigned char* lds, const bf16* P1, const unsigned char* img, float* hraw, int tid, int lane, int wave, int bx) {
    LAS bf16* Ps = (LAS bf16*)lds;
    LAS bf16* Qs = Ps + 64 * 64;
    LAS bf16* KTs = Qs + 64 * 128;
    LAS bf16* VTs = KTs + 128 * 64;
    LAS float* gsl = (LAS float*)(VTs + 80 * 64);
    LAS bf16* CT0 = (LAS bf16*)(gsl + 256);
    const int g = lane >> 4, r16 = lane & 15, tt = wave >> 1, eh = wave & 1;
    for (int item = bx; item < 256; item += gridDim.x) {
        const int b = item >> 5, h = (item >> 2) & 7, sl = item & 3;
        f32x4 Cacc[5];
#pragma unroll
        for (int e = 0; e < 5; ++e) Cacc[e] = (f32x4){0.f, 0.f, 0.f, 0.f};
        __syncthreads();
        for (int i = tid; i < 2 * 80 * 128 / 8; i += 512) ((LAS v4u*)CT0)[i] = (v4u){0u, 0u, 0u, 0u};
        for (int i = tid; i < 16 * 64 / 8; i += 512) ((LAS v4u*)(VTs + 64 * 64))[i] = (i < 8) ? (v4u){0x3f803f80u, 0x3f803f80u, 0x3f803f80u, 0x3f803f80u} : (v4u){0u, 0u, 0u, 0u};
        float m_prev = 0.f;
        v4u rp, rq[2], rk[2], rv; float rg0 = 0.f, rbl, rgm;
#define MLS_PREFETCH(cc) do { const int item2 = (b * 64 + (cc)) * 8 + h; const unsigned char* im = img + (size_t)item2 * IMGM_BYTES; const int row0 = b * SEQ + (cc) * 64; \
            rp = *(const v4u*)(im + IMGM_P + tid * 16); rk[0] = *(const v4u*)(im + IMGM_KT + tid * 16); rk[1] = *(const v4u*)(im + IMGM_KT + (tid + 512) * 16); \
            rv = *(const v4u*)(im + IMGM_VT + sl * 8192 + tid * 16); \
            _Pragma("unroll") for (int p = 0; p < 2; ++p) { const int idx = tid + 512 * p, r = idx >> 4, c8 = idx & 15; rq[p] = *(const v4u*)(P1 + (size_t)(row0 + r) * NQKV + h * 128 + c8 * 8); } \
            const float* gs = (const float*)(im + IMGM_GS); if (tid < 128) rg0 = gs[tid]; rbl = gs[128]; rgm = gs[129]; } while (0)
        MLS_PREFETCH(0);
        for (int c = 0; c < 64; ++c) {
            const int row0 = b * SEQ + c * 64;
            LAS bf16* CTc = CT0 + (c & 1) * 80 * 128; LAS bf16* CTn = CT0 + ((c + 1) & 1) * 80 * 128;
            __syncthreads();
            *(LAS v4u*)((LAS unsigned char*)Ps + tid * 16) = rp;
            *(LAS v4u*)((LAS unsigned char*)KTs + tid * 16) = rk[0]; *(LAS v4u*)((LAS unsigned char*)KTs + (tid + 512) * 16) = rk[1];
            *(LAS v4u*)((LAS unsigned char*)VTs + tid * 16) = rv;
#pragma unroll
            for (int p = 0; p < 2; ++p) { const int idx = tid + 512 * p, r = idx >> 4, c8 = idx & 15; *(LAS v4u*)(Qs + eoff<128>(r, c8 * 8)) = rq[p]; }
            if (tid < 128) gsl[tid] = rg0;
            const float blast = rbl, gmax = rgm;
            __syncthreads();
            if (c + 1 < 64) MLS_PREFETCH(c + 1);
            const f32x4 btv = *(const LAS f32x4*)(gsl + 16 * tt + 4 * g), alv = *(const LAS f32x4*)(gsl + 64 + 16 * tt + 4 * g);
            float al[4], be[4], em[4];
#pragma unroll
            for (int i = 0; i < 4; ++i) { const float mt = fmaxf(btv[i] + m_prev, alv[i]); al[i] = expf(alv[i] - mt); be[i] = expf(btv[i] + m_prev - mt); em[i] = expf(-mt); }
            const float m_new = fmaxf(blast + m_prev, gmax), wcs = expf(blast + m_prev - m_new), gam = expf(gmax - m_new);
            m_prev = m_new;
            f32x4 d1 = (f32x4){0.f, 0.f, 0.f, 0.f}, d2 = (f32x4){0.f, 0.f, 0.f, 0.f};
            mma_tile<64, 64, 2>(d1, Ps, 16 * tt, VTs, 64, lane); mma_tile<128, 128, 4>(d2, Qs, 16 * tt, CTc, 64, lane);
            float dinv[4];
#pragma unroll
            for (int i = 0; i < 4; ++i) { const float den = __shfl(al[i] * d1[i] + be[i] * d2[i], lane & 48); dinv[i] = 1.0f / fmaxf(fabsf(den), em[i]); }
#pragma unroll
            for (int q2 = 0; q2 < 2; ++q2) { const int et = 2 * eh + q2, e = 16 * et + r16; f32x4 a1 = (f32x4){0.f, 0.f, 0.f, 0.f}, a2 = (f32x4){0.f, 0.f, 0.f, 0.f};
                mma_tile<64, 64, 2>(a1, Ps, 16 * tt, VTs, 16 * et, lane); mma_tile<128, 128, 4>(a2, Qs, 16 * tt, CTc, 16 * et, lane);
#pragma unroll
                for (int i = 0; i < 4; ++i) { const int t = 16 * tt + 4 * g + i; hraw[(size_t)(row0 + t) * DM + h * 256 + sl * 64 + e] = (al[i] * a1[i] + be[i] * a2[i]) * dinv[i]; } }
#pragma unroll
            for (int et = 0; et < 5; ++et) { f32x4 tmp = (f32x4){0.f, 0.f, 0.f, 0.f}; mma_tile<64, 64, 2>(tmp, KTs, 16 * wave, VTs, 16 * et, lane);
                Cacc[et] = Cacc[et] * wcs + tmp * gam;
                v2u w; w.x = pk2(Cacc[et][0], Cacc[et][1]); w.y = pk2(Cacc[et][2], Cacc[et][3]);
                *(LAS v2u*)(CTn + eoff<128>(16 * et + r16, 16 * wave + 4 * g)) = w; }
        }
#undef MLS_PREFETCH
    }
}

DI void gla_pre(LAS unsigned char* lds, const bf16* P1, const float* G, const float* w_alpha, const float* b_alpha, unsigned char* img, int tid, int lane, int wave, int bx) {
    LAS bf16* VT = (LAS bf16*)lds;
    LAS bf16* QTs = (LAS bf16*)lds;
    LAS bf16* KTl = QTs + 64 * 256;
    LAS bf16* KTT = KTl + 64 * 256;
    LAS bf16* Ps = KTT + 256 * 64;
    LAS float* alow = (LAS float*)(Ps + 64 * 64);
    LAS float* T0 = alow + 1024;
    const int g = lane >> 4, r16 = lane & 15, d = tid & 255, sh = tid >> 8;
    for (int item = bx; item < 2048; item += gridDim.x) {
        const int b = item >> 8, c = (item >> 2) & 63, h = item & 3;
        const int row0 = b * SEQ + c * 64;
        unsigned char* im = img + (size_t)item * IMGG_BYTES;
        __syncthreads();
#pragma unroll
        for (int p = 0; p < 8; ++p) { const int idx = tid + 512 * p, r = idx >> 6, c8 = idx & 63; const v4u vv = *(const v4u*)(P1 + (size_t)(row0 + r) * NQKV + 2048 + h * 512 + c8 * 8);
#pragma unroll
            for (int j = 0; j < 4; ++j) { VT[eoff<64>(c8 * 8 + 2 * j, r)] = (bf16)(vv[j] & 0xffffu); VT[eoff<64>(c8 * 8 + 2 * j + 1, r)] = (bf16)(vv[j] >> 16); } }
        float wa[16];
#pragma unroll
        for (int i = 0; i < 16; ++i) wa[i] = w_alpha[i * 1024 + h * 256 + d];
        const float ba = b_alpha[h * 256 + d];
        f32x4 al4 = (f32x4){0.f, 0.f, 0.f, 0.f};
        if (tid < 256) al4 = *(const f32x4*)(G + (size_t)(row0 + (tid >> 2)) * 16 + (tid & 3) * 4);
        __syncthreads();
#pragma unroll
        for (int p = 0; p < 8; ++p) *(v4u*)(im + IMGG_VT + (tid + 512 * p) * 16) = *(const LAS v4u*)((LAS unsigned char*)VT + (tid + 512 * p) * 16);
        __syncthreads();
        if (tid < 256) *(LAS f32x4*)(alow + tid * 4) = al4;
        __syncthreads();
        const bf16* qsrc = P1 + (size_t)(row0 + 32 * sh) * NQKV + h * 256 + d;
        float bs[32]; float run = 0.f;
#pragma unroll
        for (int j = 0; j < 32; ++j) { const int s = 32 * sh + j; float z = ba;
#pragma unroll
            for (int i = 0; i < 16; ++i) z += alow[s * 16 + i] * wa[i];
            run += logsig_fast(z) * (1.0f / 16.0f); bs[j] = run; }
        if (sh == 0) T0[d] = run;
        __syncthreads();
        const float add = sh ? T0[d] : 0.f;
        if (sh) ((float*)(im + IMGG_EB))[d] = __expf(run + add);
#pragma unroll
        for (int q8 = 0; q8 < 4; ++q8) { unsigned kk[8];
#pragma unroll
            for (int j = 0; j < 8; ++j) { const int jj = 8 * q8 + j, s = 32 * sh + jj; const float bsum = bs[jj] + add;
                const float qv = bf2f(qsrc[(size_t)jj * NQKV]) * 0.0625f * __expf(bsum), kv = bf2f(qsrc[(size_t)jj * NQKV + 1024]) * __expf(-bsum);
                QTs[eoff<256>(s, d)] = (bf16)f2bf(qv); kk[j] = f2bf(kv); KTl[eoff<256>(s, d)] = (bf16)kk[j]; }
            v4u w; w.x = kk[0] | (kk[1] << 16); w.y = kk[2] | (kk[3] << 16); w.z = kk[4] | (kk[5] << 16); w.w = kk[6] | (kk[7] << 16);
            *(LAS v4u*)(KTT + eoff<64>(d, 32 * sh + 8 * q8)) = w; }
        __syncthreads();
        { const int tt = wave >> 1;
#pragma unroll
          for (int q2 = 0; q2 < 2; ++q2) { const int st = 2 * (wave & 1) + q2; f32x4 acc = (f32x4){0.f, 0.f, 0.f, 0.f};
            if (st <= tt) mma_tile<256, 256, 8>(acc, QTs, 16 * tt, KTl, 16 * st, lane);
            const int s = 16 * st + r16;
#pragma unroll
            for (int i = 0; i < 4; ++i) { const int t = 16 * tt + 4 * g + i; Ps[eoff<64>(t, s)] = (bf16)f2bf((s <= t) ? acc[i] : 0.f); } } }
        __syncthreads();
#pragma unroll
        for (int p = 0; p < 4; ++p) { *(v4u*)(im + IMGG_Q + (tid + 512 * p) * 16) = *(const LAS v4u*)((LAS unsigned char*)QTs + (tid + 512 * p) * 16);
                                      *(v4u*)(im + IMGG_KT + (tid + 512 * p) * 16) = *(const LAS v4u*)((LAS unsigned char*)KTT + (tid + 512 * p) * 16); }
        *(v4u*)(im + IMGG_P + tid * 16) = *(const LAS v4u*)((LAS unsigned char*)Ps + tid * 16);
    }
}

DI void gla_scan2(LAS unsigned char* lds, const unsigned char* img, float* hraw, int tid, int lane, int wave, int bx) {
    LAS bf16* QTs = (LAS bf16*)lds;
    LAS bf16* KTT = QTs + 64 * 256;
    LAS bf16* Ps = KTT + 256 * 64;
    LAS bf16* VTs = Ps + 64 * 64;
    LAS float* eb = (LAS float*)(VTs + 64 * 64);
    LAS bf16* ST0 = (LAS bf16*)(eb + 256);
    const int g = lane >> 4, r16 = lane & 15, tt = wave >> 1, eh = wave & 1;
    for (int item = bx; item < 256; item += gridDim.x) {
        const int b = item >> 5, h = (item >> 3) & 3, sl = item & 7;
        f32x4 Sacc[2][4];
#pragma unroll
        for (int a = 0; a < 2; ++a)
#pragma unroll
            for (int e = 0; e < 4; ++e) Sacc[a][e] = (f32x4){0.f, 0.f, 0.f, 0.f};
        __syncthreads();
        for (int i = tid; i < 2 * 64 * 256 / 8; i += 512) ((LAS v4u*)ST0)[i] = (v4u){0u, 0u, 0u, 0u};
        v4u rq[4], rk[4], rp, rv; float re = 0.f;
#define GLS_PREFETCH(cc) do { const int item2 = (b * 64 + (cc)) * 4 + h; const unsigned char* im = img + (size_t)item2 * IMGG_BYTES; \
            _Pragma("unroll") for (int p = 0; p < 4; ++p) { rq[p] = *(const v4u*)(im + IMGG_Q + (tid + 512 * p) * 16); rk[p] = *(const v4u*)(im + IMGG_KT + (tid + 512 * p) * 16); } \
            rp = *(const v4u*)(im + IMGG_P + tid * 16); rv = *(const v4u*)(im + IMGG_VT + sl * 8192 + tid * 16); if (tid < 256) re = ((const float*)(im + IMGG_EB))[tid]; } while (0)
        GLS_PREFETCH(0);
        for (int c = 0; c < 64; ++c) {
            const int row0 = b * SEQ + c * 64;
            LAS bf16* STc = ST0 + (c & 1) * 64 * 256; LAS bf16* STn = ST0 + ((c + 1) & 1) * 64 * 256;
            __syncthreads();
#pragma unroll
            for (int p = 0; p < 4; ++p) { *(LAS v4u*)((LAS unsigned char*)QTs + (tid + 512 * p) * 16) = rq[p]; *(LAS v4u*)((LAS unsigned char*)KTT + (tid + 512 * p) * 16) = rk[p]; }
            *(LAS v4u*)((LAS unsigned char*)Ps + tid * 16) = rp; *(LAS v4u*)((LAS unsigned char*)VTs + tid * 16) = rv;
            if (tid < 256) eb[tid] = re;
            __syncthreads();
            if (c + 1 < 64) GLS_PREFETCH(c + 1);
#pragma unroll
            for (int q2 = 0; q2 < 2; ++q2) { const int et = 2 * eh + q2, e = 16 * et + r16; f32x4 acc = (f32x4){0.f, 0.f, 0.f, 0.f};
                mma_tile<64, 64, 2>(acc, Ps, 16 * tt, VTs, 16 * et, lane); mma_tile<256, 256, 8>(acc, QTs, 16 * tt, STc, 16 * et, lane);
#pragma unroll
                for (int i = 0; i < 4; ++i) { const int t = 16 * tt + 4 * g + i; hraw[(size_t)(row0 + t) * DM + h * 512 + sl * 64 + e] = acc[i]; } }
#pragma unroll
            for (int a = 0; a < 2; ++a) { const int dt = 2 * wave + a;
                const f32x4 ev = *(const LAS f32x4*)(eb + 16 * dt + 4 * g);
#pragma unroll
                for (int et = 0; et < 4; ++et) { mma_tile<64, 64, 2>(Sacc[a][et], KTT, 16 * dt, VTs, 16 * et, lane); Sacc[a][et] = Sacc[a][et] * ev;
                    v2u w; w.x = pk2(Sacc[a][et][0], Sacc[a][et][1]); w.y = pk2(Sacc[a][et][2], Sacc[a][et][3]);
                    *(LAS v2u*)(STn + eoff<256>(16 * et + r16, 16 * dt + 4 * g)) = w; } }
        }
#undef GLS_PREFETCH
    }
}


DI void mixer_gates(const bf16* hb, const bf16* wg, const long long* ss, float* G, int lane, int wave, int bx) {
    const int g = lane >> 4, r16 = lane & 15;
    for (int t = bx * NWAVES + wave; t < MTOK / 16; t += gridDim.x * NWAVES) {
        const bf16* ap = hb + (size_t)(16 * t + r16) * DM + 8 * g; const bf16* bp = wg + (size_t)r16 * DM + 8 * g;
        f32x4 acc = (f32x4){0.f, 0.f, 0.f, 0.f};
#pragma unroll 8
        for (int kk = 0; kk < DM / 32; ++kk) { const bf16x8 a = *(const bf16x8*)(ap + 32 * kk), b = *(const bf16x8*)(bp + 32 * kk); acc = mfma16(a, b, acc); }
#pragma unroll
        for (int i = 0; i < 4; ++i) { const int row = 16 * t + 4 * g + i; G[(size_t)row * 16 + r16] = acc[i] * pg8::rstd_of(ss, row); }
    }
}

template <int HS, int ACT> DI void headnorm_gate(const float* hraw, const bf16* P1, const float* gnorm, bf16* hm, int lane, int wave, int bx) {
    constexpr int NH = DM / HS, EPL = HS / 64;
    const int gw = bx * NWAVES + wave, NGW = gridDim.x * NWAVES;
    for (int row = gw; row < MTOK; row += NGW) {
#pragma unroll
        for (int hh = 0; hh < NH; ++hh) { const int col = hh * HS + lane * EPL;
            float x[EPL]; float s = 0.f;
#pragma unroll
            for (int j = 0; j < EPL; j += 4) { const f32x4 v = *(const f32x4*)(hraw + (size_t)row * DM + col + j); x[j] = v.x; x[j + 1] = v.y; x[j + 2] = v.z; x[j + 3] = v.w; s += (v.x * v.x + v.y * v.y) + (v.z * v.z + v.w * v.w); }
            s = wave_sum(s); const float rs = rsqrtf(s * (1.0f / HS) + 1e-6f);
            unsigned outw[EPL / 2];
#pragma unroll
            for (int j = 0; j < EPL; j += 2) { const unsigned gw2 = *(const unsigned*)(P1 + (size_t)row * NQKV + 4096 + col + j); const float g0 = bflo(gw2), g1 = bfhi(gw2);
                const float a0 = ACT == 0 ? 1.0f / (1.0f + expf(-g0)) : g0 / (1.0f + expf(-g0)), a1 = ACT == 0 ? 1.0f / (1.0f + expf(-g1)) : g1 / (1.0f + expf(-g1));
                outw[j / 2] = pk2(x[j] * rs * gnorm[col + j] * a0, x[j + 1] * rs * gnorm[col + j + 1] * a1); }
            if constexpr (EPL == 4) { v2u w; w.x = outw[0]; w.y = outw[1]; *(v2u*)(hm + (size_t)row * DM + col) = w; }
            else { v4u w; w.x = outw[0]; w.y = outw[1]; w.z = outw[2]; w.w = outw[3]; *(v4u*)(hm + (size_t)row * DM + col) = w; }
        }
    }
}

DI void fox_cf(const float* G, const float* b_f, float* cf, int lane, int wave, int bx) {
    const int gw = bx * NWAVES + wave, NGW = gridDim.x * NWAVES;
    for (int seq = gw; seq < 128; seq += NGW) { const int b = seq >> 4, h = seq & 15; const float bias = b_f[h];
        const float* gp = G + ((size_t)b * SEQ + lane * 64) * 16 + h; float s = 0.f;
        for (int p = 0; p < 64; ++p) s += logsig(gp[p * 16] + bias);
        float run = wave_incl_sum(s, lane) - s;
        float* o = cf + (size_t)seq * SEQ + lane * 64;
        for (int p = 0; p < 64; ++p) { run += logsig(gp[p * 16] + bias); o[p] = run; }
    }
}

DI void fox_vt_pre(LAS unsigned char* lds, const bf16* P1, unsigned char* img, int lane, int wave, int bx) {
    LAS bf16* scr = (LAS bf16*)(lds + wave * 4096);
    const int gw = bx * NWAVES + wave, NGW = gridDim.x * NWAVES;
    for (int it = gw; it < 8192 * 4; it += NGW) {
        const int q = it & 3, jt = (it >> 2) & 63, bh = it >> 8, b = bh >> 4, h = bh & 15;
        const bf16* src = P1 + ((size_t)b * SEQ + jt * 64) * NQKV + 4096 + h * 128 + q * 32;
        v4u v[4];
#pragma unroll
        for (int p = 0; p < 4; ++p) { const int idx = lane + 64 * p, r = idx >> 2, c8 = idx & 3; v[p] = *(const v4u*)(src + (size_t)r * NQKV + c8 * 8); }
#pragma unroll
        for (int p = 0; p < 4; ++p) { const int idx = lane + 64 * p, r = idx >> 2, c8 = idx & 3;
#pragma unroll
            for (int j = 0; j < 4; ++j) { scr[eoff<64>(c8 * 8 + 2 * j, r)] = (bf16)(v[p][j] & 0xffffu); scr[eoff<64>(c8 * 8 + 2 * j + 1, r)] = (bf16)(v[p][j] >> 16); } }
        LDS_WAIT(); asm volatile("" ::: "memory");
        unsigned char* dst = img + ((size_t)(bh * 64 + jt)) * 16384 + q * 4096;
#pragma unroll
        for (int p = 0; p < 4; ++p) *(v4u*)(dst + (lane + 64 * p) * 16) = *(const LAS v4u*)((LAS unsigned char*)scr + (lane + 64 * p) * 16);
        LDS_WAIT(); asm volatile("" ::: "memory");
    }
}

DI void fox_attn2(LAS unsigned char* lds, const bf16* P1, const float* cf, const unsigned char* vimg, bf16* hm, int tid, int lane, int wave, int bx) {
    constexpr int BUFB = 16384 + 16384 + 256;
    const float LOG2E = 1.4426950408889634f, QS = 0.08838834764831845f * 1.4426950408889634f, THR = 8.0f;
    const int g = lane >> 4, r16 = lane & 15;
    const int G_ = gridDim.x;
    const int nit = (2048 + G_ - 1) / G_;
    for (int it = 0; it < nit; ++it) {
        const int u = (it & 1) ? it * G_ + (G_ - 1 - bx) : it * G_ + bx;
        if (u >= 2048) continue;
        const int qb = 15 - (u >> 7), bh = u & 127, b = bh >> 4, h = bh & 15;
        const size_t rowb = (size_t)b * SEQ; const int q0 = qb * 256 + 32 * wave;
        bf16x8 qf[2][4]; float c0[2];
#pragma unroll
        for (int tt = 0; tt < 2; ++tt) { const int t = q0 + 16 * tt + r16; c0[tt] = cf[(size_t)bh * SEQ + t] * LOG2E;
#pragma unroll
            for (int kk = 0; kk < 4; ++kk) { const v4u raw = *(const v4u*)(P1 + (rowb + t) * NQKV + h * 128 + 32 * kk + 8 * g); v4u sc;
#pragma unroll
                for (int j = 0; j < 4; ++j) sc[j] = pk2(bflo(raw[j]) * QS, bfhi(raw[j]) * QS);
                qf[tt][kk] = __builtin_bit_cast(bf16x8, sc); } }
        f32x4 oacc[8][2];
#pragma unroll
        for (int et = 0; et < 8; ++et) { oacc[et][0] = (f32x4){0.f, 0.f, 0.f, 0.f}; oacc[et][1] = (f32x4){0.f, 0.f, 0.f, 0.f}; }
        float lrun[2] = {0.f, 0.f};
        const int ntiles = 4 * (qb + 1);
        v4u kreg[2], vreg[2]; float cfreg = 0.f;
        const bf16* kbase = P1 + rowb * NQKV + 2048 + h * 128;
        const unsigned char* vbase = vimg + (size_t)bh * 64 * 16384;
#define FOX_LOAD(j) do { _Pragma("unroll") for (int p = 0; p < 2; ++p) { const int idx = tid + 512 * p, r = idx >> 4, c8 = idx & 15; \
            kreg[p] = *(const v4u*)(kbase + (size_t)(64 * (j) + r) * NQKV + c8 * 8); vreg[p] = *(const v4u*)(vbase + (size_t)(j) * 16384 + idx * 16); } \
            if (tid < 64) cfreg = -cf[(size_t)bh * SEQ + 64 * (j) + tid] * LOG2E; } while (0)
#define FOX_STORE(bufi) do { LAS unsigned char* bb = lds + (bufi) * BUFB; _Pragma("unroll") for (int p = 0; p < 2; ++p) { const int idx = tid + 512 * p, r = idx >> 4, c8 = idx & 15; \
            *(LAS v4u*)((LAS bf16*)bb + eoff<128>(r, c8 * 8)) = kreg[p]; *(LAS v4u*)(bb + 16384 + idx * 16) = vreg[p]; } \
            if (tid < 64) ((LAS float*)(bb + 32768))[tid] = cfreg; } while (0)
        __syncthreads();
        FOX_LOAD(0); FOX_STORE(0);
        if (ntiles > 1) FOX_LOAD(1);
        __syncthreads();
        for (int j = 0; j < ntiles; ++j) {
            if (j + 1 < ntiles) FOX_STORE((j + 1) & 1);
            if (j + 2 < ntiles) FOX_LOAD(j + 2);
            if (64 * j <= q0 + 31) {
                const LAS bf16* Ks = (const LAS bf16*)(lds + (j & 1) * BUFB); const LAS bf16* VTs = Ks + 64 * 128; const LAS float* cfs = (const LAS float*)(VTs + 128 * 64);
                f32x4 sacc[2][4];
#pragma unroll
                for (int st = 0; st < 4; ++st) { const f32x4 cv = *(const LAS f32x4*)(cfs + 16 * st + 4 * g);
#pragma unroll
                    for (int tt = 0; tt < 2; ++tt) sacc[tt][st] = cv + c0[tt]; }
#pragma unroll
                for (int st = 0; st < 4; ++st)
#pragma unroll
                    for (int kk = 0; kk < 4; ++kk) { const bf16x8 kf = ldf<128>(Ks, 16 * st + r16, 4 * kk + g);
                        sacc[0][st] = mfma16(kf, qf[0][kk], sacc[0][st]); sacc[1][st] = mfma16(kf, qf[1][kk], sacc[1][st]); if (kk == 3) asm volatile("" ::: "memory"); }
                if (64 * j + 63 > q0) {
#pragma unroll
                    for (int tt = 0; tt < 2; ++tt) { const int t = q0 + 16 * tt + r16;
#pragma unroll
                        for (int st = 0; st < 4; ++st)
#pragma unroll
                            for (int i = 0; i < 4; ++i) { const int s = 64 * j + 16 * st + 4 * g + i; if (s > t) sacc[tt][st][i] = -__builtin_inff(); } }
                }
                float mx[2];
#pragma unroll
                for (int tt = 0; tt < 2; ++tt) { float m = -__builtin_inff();
#pragma unroll
                    for (int st = 0; st < 4; ++st) m = fmaxf(m, fmaxf(fmaxf(sacc[tt][st][0], sacc[tt][st][1]), fmaxf(sacc[tt][st][2], sacc[tt][st][3])));
                    m = fmaxf(m, __shfl_xor(m, 16)); m = fmaxf(m, __shfl_xor(m, 32)); mx[tt] = m; }
                if (__any(mx[0] > THR || mx[1] > THR)) {
#pragma unroll
                    for (int tt = 0; tt < 2; ++tt) { const float sh = fmaxf(mx[tt], 0.f), f = __builtin_amdgcn_exp2f(-sh);
                        c0[tt] -= sh; lrun[tt] *= f;
#pragma unroll
                        for (int st = 0; st < 4; ++st) sacc[tt][st] = sacc[tt][st] - sh;
#pragma unroll
                        for (int et = 0; et < 8; ++et) oacc[et][tt] = oacc[et][tt] * f; }
                }
#pragma unroll
                for (int tt = 0; tt < 2; ++tt) { float ls = 0.f;
#pragma unroll
                    for (int st = 0; st < 4; ++st)
#pragma unroll
                        for (int i = 0; i < 4; ++i) { const float p = __builtin_amdgcn_exp2f(sacc[tt][st][i]); sacc[tt][st][i] = p; ls += p; }
                    lrun[tt] += ls; }
#pragma unroll
                for (int ks = 0; ks < 2; ++ks) { bf16x8 pb[2];
#pragma unroll
                    for (int tt = 0; tt < 2; ++tt) { v4u w; w.x = pk2(sacc[tt][2 * ks][0], sacc[tt][2 * ks][1]); w.y = pk2(sacc[tt][2 * ks][2], sacc[tt][2 * ks][3]);
                        w.z = pk2(sacc[tt][2 * ks + 1][0], sacc[tt][2 * ks + 1][1]); w.w = pk2(sacc[tt][2 * ks + 1][2], sacc[tt][2 * ks + 1][3]); pb[tt] = __builtin_bit_cast(bf16x8, w); }
#pragma unroll
                    for (int et = 0; et < 8; ++et) { const int e = 16 * et + r16;
                        const v2u lo = *(const LAS v2u*)(VTs + eoff<64>(e, 32 * ks + 4 * g)), hi = *(const LAS v2u*)(VTs + eoff<64>(e, 32 * ks + 16 + 4 * g));
                        v4u aw; aw.x = lo.x; aw.y = lo.y; aw.z = hi.x; aw.w = hi.y; const bf16x8 va = __builtin_bit_cast(bf16x8, aw);
                        oacc[et][0] = mfma16(va, pb[0], oacc[et][0]); oacc[et][1] = mfma16(va, pb[1], oacc[et][1]); if (et & 1) asm volatile("" ::: "memory"); } }
            }
            __syncthreads();
        }
#undef FOX_LOAD
#undef FOX_STORE
#pragma unroll
        for (int tt = 0; tt < 2; ++tt) { float l = lrun[tt]; l += __shfl_xor(l, 16); l += __shfl_xor(l, 32); const float inv = 1.0f / l;
            bf16* orow = hm + (rowb + q0 + 16 * tt + r16) * DM + h * 128 + 4 * g;
#pragma unroll
            for (int et = 0; et < 8; ++et) { v2u w; w.x = pk2(oacc[et][tt][0] * inv, oacc[et][tt][1] * inv); w.y = pk2(oacc[et][tt][2] * inv, oacc[et][tt][3] * inv); *(v2u*)(orow + 16 * et) = w; } }
    }
}


DI void final_norm(float* out, const long long* ss, const float* gfin, int lane, int wave, int bx) {
    const int gw = bx * NWAVES + wave, NGW = gridDim.x * NWAVES;
    for (int m = gw; m < MTOK; m += NGW) { const float rs = pg8::rstd_of(ss, m);
        f32x4* xr = (f32x4*)(out + (size_t)m * DM) + lane; const f32x4* gr = (const f32x4*)gfin + lane;
#pragma unroll
        for (int j = 0; j < 8; ++j) { const f32x4 v = xr[64 * j], gg = gr[64 * j]; xr[64 * j] = v * rs * gg; } }
}

#define PH(p) if (lo <= (p) && (p) < hi && (ran ? (xcd_barrier(bar), true) : (ran = true)))
#define TID() int tid = threadIdx.x; asm volatile("" : "+v"(tid)); const int lane = tid & 63, wave = __builtin_amdgcn_readfirstlane(tid >> 6); int bx = blockIdx.x; asm volatile("" : "+s"(bx)); (void)lane; (void)wave; (void)bx
#define WSP(T, off) ((T*)(ka->ws + (off)))
template <int j> DI void subblock(LAS unsigned char* lds, const XcdBarrier& bar, const int lo, const int hi, bool& ran) {
    {
        constexpr int layer = j / 3, typ = j - 3 * layer, base = 1 + 5 * j;
        if constexpr (typ != 1) {
            PH(base) { TID(); KArgs ka = kargs(); const int mi = layer * 2 + (typ >> 1);
                pg8::Gemm gm{WSP(bf16, WS_HB), WSP(bf16, WS_WUP) + (size_t)mi * NUP * DM, MTOK, NUP, DM}; pg8::StaticOrder S; S.init(MTOK, NUP, gridDim.x, bx);
                pg8::EpiSwiGLU E{WSP(bf16, WS_ACT), WSP(long long, WS_SS) + (size_t)j * MTOK, DFF};
                pg8::gemm_phase<pg8::EpiSwiGLU, pg8::StaticOrder, PG8_ALIGN, PG8_SP2>(lds, gm, S, E); }
        } else {
            constexpr int kind = layer % 3, ji = layer / 3;
            PH(base) { TID(); KArgs ka = kargs();
                mixer_gates(WSP(bf16, WS_HB), WSP(bf16, WS_WIN) + ((size_t)layer * NINP + NQKV) * DM, WSP(long long, WS_SS) + (size_t)j * MTOK, WSP(float, WS_G), lane, wave, bx);
                pg8::Gemm gm{WSP(bf16, WS_HB), WSP(bf16, WS_WIN) + (size_t)layer * NINP * DM, MTOK, NQKV, DM}; pg8::StaticOrder S; S.init(MTOK, NQKV, gridDim.x, bx);
                pg8::EpiMixIn E{WSP(bf16, WS_P1), WSP(long long, WS_SS) + (size_t)j * MTOK};
                pg8::gemm_phase<pg8::EpiMixIn, pg8::StaticOrder, PG8_ALIGN, PG8_SP2>(lds, gm, S, E); }
            PH(base + 1) { TID(); KArgs ka = kargs();
                if constexpr (kind == 0) for (int rep = 0; rep < REP_MLSTM; ++rep) mlstm_pre(lds, WSP(bf16, WS_P1), WSP(float, WS_G), ka->in[6] + ji * 16, WSP(unsigned char, WS_ACT), tid, lane, wave, bx);
                else if constexpr (kind == 1) { fox_cf(WSP(float, WS_G), ka->in[10] + ji * 16, WSP(float, WS_CF), lane, wave, bx); fox_vt_pre(lds, WSP(bf16, WS_P1), WSP(unsigned char, WS_ACT), lane, wave, bx); }
                else for (int rep = 0; rep < REP_GLA; ++rep) gla_pre(lds, WSP(bf16, WS_P1), WSP(float, WS_G), ka->in[13] + (size_t)ji * 16 * 1024, ka->in[14] + ji * 1024, WSP(unsigned char, WS_ACT), tid, lane, wave, bx);
            }
            PH(base + 2) { TID(); KArgs ka = kargs();
                if constexpr (kind == 0) for (int rep = 0; rep < REP_MLSTM; ++rep) mlstm_scan2(lds, WSP(bf16, WS_P1), WSP(unsigned char, WS_ACT), WSP(float, WS_HRAW), tid, lane, wave, bx);
                else if constexpr (kind == 1) for (int rep = 0; rep < REP_FOX; ++rep) fox_attn2(lds, WSP(bf16, WS_P1), WSP(float, WS_CF), WSP(unsigned char, WS_ACT), WSP(bf16, WS_HM), tid, lane, wave, bx);
                else for (int rep = 0; rep < REP_GLA; ++rep) gla_scan2(lds, WSP(unsigned char, WS_ACT), WSP(float, WS_HRAW), tid, lane, wave, bx);
            }
            if constexpr (kind != 1) { PH(base + 3) { TID(); KArgs ka = kargs();
                if constexpr (kind == 0) headnorm_gate<256, 0>(WSP(float, WS_HRAW), WSP(bf16, WS_P1), ka->in[7] + ji * DM, WSP(bf16, WS_HM), lane, wave, bx);
                else headnorm_gate<512, 1>(WSP(float, WS_HRAW), WSP(bf16, WS_P1), ka->in[15] + ji * DM, WSP(bf16, WS_HM), lane, wave, bx);
            } }
        }
        PH(base + 4) { TID(); KArgs ka = kargs();
            pg8::Gemm gm; float scale;
            if constexpr (typ != 1) { const int mi = layer * 2 + (typ >> 1); gm = pg8::Gemm{WSP(bf16, WS_ACT), WSP(bf16, WS_WDN) + (size_t)mi * DM * DFF, MTOK, DM, DFF}; scale = 0.5f; }
            else { gm = pg8::Gemm{WSP(bf16, WS_HM), WSP(bf16, WS_WOUT) + (size_t)layer * DM * DM, MTOK, DM, DM}; scale = 1.0f; }
            pg8::StaticOrder S; S.init(MTOK, DM, gridDim.x, bx);
            pg8::EpiResid E{(j == 0) ? ka->in[0] : (const float*)ka->out, ka->out, WSP(bf16, WS_HB), WSP(long long, WS_SS) + (size_t)(j + 1) * MTOK, scale};
            pg8::gemm_phase<pg8::EpiResid, pg8::StaticOrder, PG8_ALIGN, PG8_SP2>(lds, gm, S, E);
        }
    }
}

__global__ void __launch_bounds__(NWAVES * 64, 2) trunk_fwd(Args args) {
    extern __shared__ __attribute__((aligned(16))) unsigned char lds_raw[];
    LAS unsigned char* lds = (LAS unsigned char*)lds_raw;
    volatile LAS unsigned* MISC = (volatile LAS unsigned*)(lds + MISC_OFF);
    for (int u = threadIdx.x; u < (LDS_BYTES - MISC_OFF) / 4; u += NWAVES * 64) ((LAS unsigned*)(lds + MISC_OFF))[u] = 0u;
    __syncthreads();
    XcdBarrier bar = xcd_barrier_post((unsigned*)(args.ws + WS_CTL) + CW_BAR, MISC + 8);
    const int lo = args.ph_lo, hi = args.ph_hi; bool ran = false;

    PH(0) { TID(); for (int rep = 0; rep < REP_PRO; ++rep) { prologue(lds, lane, wave, bx); __syncthreads(); } }

    subblock<0>(lds, bar, lo, hi, ran); subblock<1>(lds, bar, lo, hi, ran); subblock<2>(lds, bar, lo, hi, ran); subblock<3>(lds, bar, lo, hi, ran);
    subblock<4>(lds, bar, lo, hi, ran); subblock<5>(lds, bar, lo, hi, ran); subblock<6>(lds, bar, lo, hi, ran); subblock<7>(lds, bar, lo, hi, ran);
    subblock<8>(lds, bar, lo, hi, ran); subblock<9>(lds, bar, lo, hi, ran); subblock<10>(lds, bar, lo, hi, ran); subblock<11>(lds, bar, lo, hi, ran);
    PH(NPHASE - 1) { TID(); KArgs ka = kargs(); final_norm(ka->out, WSP(long long, WS_SS) + (size_t)NSUB * MTOK, ka->in[17], lane, wave, bx); }
#undef WSP
#undef PH
}

static bool phase_exists(int p) {
    if (p == 0 || p == NPHASE - 1) return true;
    const int j = (p - 1) / 5, k = (p - 1) % 5, typ = j % 3;
    if (k == 0 || k == 4) return true;
    if (typ != 1) return false;
    if (k == 3) return ((j / 3) % 3) != 1;
    return true;
}
extern "C" void kernel_launch(void* const* d_in, const int* in_sizes, int n_in, void* d_out, int out_size, void* d_ws, size_t ws_size, hipStream_t stream) {
    static int grid = 0;
    if (grid == 0) {
        if (n_in != 18 || in_sizes[0] != MTOK * DM || out_size != MTOK * DM || ws_size < WS_END) { fprintf(stderr, "kernel_launch: unexpected shapes (n_in %d, in0 %d, out %d, ws %zu < %zu)\n", n_in, n_in > 0 ? in_sizes[0] : -1, out_size, ws_size, (size_t)WS_END); grid = -1; return; }
        int dev = 0, cus = 0, per_cu = 0;
        if (hipGetDevice(&dev) != hipSuccess || hipDeviceGetAttribute(&cus, hipDeviceAttributeMultiprocessorCount, dev) != hipSuccess) { grid = -1; return; }
        if (hipFuncSetAttribute((const void*)trunk_fwd, hipFuncAttributeMaxDynamicSharedMemorySize, LDS_BYTES) != hipSuccess) { fprintf(stderr, "kernel_launch: hipFuncSetAttribute failed\n"); grid = -1; return; }
        if (hipOccupancyMaxActiveBlocksPerMultiprocessor(&per_cu, (const void*)trunk_fwd, NWAVES * 64, LDS_BYTES) != hipSuccess || per_cu < 1) fprintf(stderr, "kernel_launch: occupancy query says %d\n", per_cu);
        (void)hipGetLastError();
        grid = cus;
    }
    if (grid < 0) return;
    if (hipMemsetAsync((char*)d_ws + WS_CTL, 0, CTL_ZERO_BYTES, stream) != hipSuccess) return;
    Args a{};
    for (int i = 0; i < 18; ++i) a.in[i] = (const float*)d_in[i];
    a.out = (float*)d_out; a.ws = (unsigned char*)d_ws;
#if MK_PER_PHASE
    for (int p = 0; p < NPHASE; ++p) { if (!phase_exists(p)) continue; a.ph_lo = p; a.ph_hi = p + 1; hipLaunchKernelGGL(trunk_fwd, dim3(grid), dim3(NWAVES * 64), LDS_BYTES, stream, a); }
#else
    a.ph_lo = 0; a.ph_hi = NPHASE; hipLaunchKernelGGL(trunk_fwd, dim3(grid), dim3(NWAVES * 64), LDS_BYTES, stream, a);
#endif
    (void)phase_exists;
}
```

```cpp
#include <hip/hip_runtime.h>
#include <cstdio>
#include <cstdint>
namespace pg8 {
#define PG8_LAS __attribute__((address_space(3)))
typedef unsigned short bf16_t;
typedef short bf16x8 __attribute__((ext_vector_type(8)));
typedef float f32x4 __attribute__((ext_vector_type(4)));
typedef unsigned u32x4 __attribute__((ext_vector_type(4)));
constexpr int BM = 256, BK = 64, HALF = 128, HTB = HALF * BK * 2  , STAGE_BYTES = 8 * HTB, NXCD = 8, WGM = 8;

__host__ __device__ __forceinline__ int lds_byte(int r, int c) { const int st = (r >> 4) * 2 + (c >> 5), rr = r & 15, cc = c & 31, ob = rr * 64 + cc * 2; return st * 1024 + (ob ^ (((ob >> 9) & 1) << 5)); }
__host__ __device__ __forceinline__ void stage_rc(int b, int& R, int& C) { const int st = b / 1024, sb = b % 1024, swz = sb ^ (((sb >> 9) & 1) << 5); R = (st >> 1) * 16 + swz / 64; C = (st & 1) * 32 + (swz % 64) / 2; }
__host__ __device__ __forceinline__ int perm32(int rho) { const int n = rho >> 4, i = rho & 15; return 8 * (i >> 2) + 4 * n + (i & 3); }

struct Unit { int pm, pn; };
struct Gemm { const bf16_t* A; const bf16_t* Bt; int M, N, K; };

struct StaticOrder {
    int nM, nN, nwg, G, c;
    __host__ __device__ void init(int M, int N, int G_, int c_) { nM = M / BM; nN = N / BM; nwg = nM * nN; G = G_; c = c_; }
    __host__ __device__ bool next(int i, Unit& u) const {
        const long L = (long)i * G + c; if (L >= nwg) return false;
        int wgid = (int)L; { const int q = nwg / NXCD, r = nwg % NXCD, xcd = wgid % NXCD, off = wgid / NXCD; wgid = (xcd < r ? xcd * (q + 1) : r * (q + 1) + (xcd - r) * q) + off; }
        const int nig = WGM * nN, gid = wgid / nig, fm = gid * WGM, gsz = (nM - fm) < WGM ? (nM - fm) : WGM;
        u.pm = fm + ((wgid % nig) % gsz); u.pn = (wgid % nig) / gsz; return true;
    }
    __device__ __forceinline__ void a_ready(const Unit&) const {}
    __device__ __forceinline__ void done(const Unit&) const {}
};

__device__ __forceinline__ unsigned cvt_pk_bf16(float lo, float hi) { unsigned r; asm volatile("v_cvt_pk_bf16_f32 %0, %1, %2" : "=v"(r) : "v"(lo), "v"(hi)); return r; }
constexpr float RMS_EPS_F = 1e-6f, SS_FIX = 1048576.0f, SS_UNFIX_D = 1.0f / (1048576.0f * 2048.0f);
typedef long long ss_t;
__device__ __forceinline__ float rstd_of(const ss_t* ss, int row) { return rsqrtf((float)ss[row] * SS_UNFIX_D + RMS_EPS_F); }
template <class Sched> __device__ __forceinline__ int rstd_table_fill(const Sched& S, const ss_t* ss, PG8_LAS unsigned char* ext, int tid) {
    PG8_LAS float* tab = (PG8_LAS float*)ext; int key0 = -1, key1 = -1, bad = 0; Unit u;
    for (int i = 0; S.next(i, u); ++i) { const int slot = (u.pm >> 3) & 1; const int key = slot ? key1 : key0;
        if (key == u.pm) continue;
        if (key >= 0) { bad = 1; continue; }
        if (slot) key1 = u.pm; else key0 = u.pm;
        if (tid < 256) tab[slot * 256 + tid] = rstd_of(ss, u.pm * BM + tid); }
    asm volatile("s_waitcnt lgkmcnt(0)" ::: "memory"); __builtin_amdgcn_s_barrier(); asm volatile("" ::: "memory");
    return bad;
}
__device__ __forceinline__ float rstd_get(const ss_t* ss, const Unit& u, int row, int pf, const PG8_LAS unsigned char* ext) {
    return pf ? rstd_of(ss, row) : ((const PG8_LAS float*)ext)[((u.pm >> 3) & 1) * 256 + (row - u.pm * BM)];
}
struct EpiSwiGLU {
    static constexpr bool PERM = true, AFTER_DRAIN = false;
    bf16_t* O; const ss_t* ss; int ldo;
    template <class Sched> __device__ __forceinline__ int prepare(const Sched& S, PG8_LAS unsigned char* ext, int tid) const { return rstd_table_fill(S, ss, ext, tid); }
    __device__ __forceinline__ void operator()(const f32x4 (&acc)[2][2][4][2], const Unit& u, int wr, int wc, int fr, int fq, int pf, const PG8_LAS unsigned char* ext) const {
        const int row0 = u.pm * BM + wr * 64 + fr, col0 = u.pn * HALF + wc * 32 + 8 * fq;
#pragma unroll
        for (int ai = 0; ai < 2; ++ai)
#pragma unroll
            for (int m = 0; m < 4; ++m) {
                const int row = row0 + ai * HALF + m * 16;
                const float rs = rstd_get(ss, u, row, pf, ext);
                float o[8];
#pragma unroll
                for (int n = 0; n < 2; ++n)
#pragma unroll
                    for (int j = 0; j < 4; ++j) { const float a = acc[ai][0][m][n][j] * rs, b = acc[ai][1][m][n][j] * rs;
                        o[4 * n + j] = a * b * __builtin_amdgcn_rcpf(1.0f + __expf(-a)); }
                u32x4 w; w.x = cvt_pk_bf16(o[0], o[1]); w.y = cvt_pk_bf16(o[2], o[3]); w.z = cvt_pk_bf16(o[4], o[5]); w.w = cvt_pk_bf16(o[6], o[7]);
                *(u32x4*)(O + (size_t)row * ldo + col0) = w;
            }
    }
};
struct EpiMixIn {
    static constexpr bool PERM = true, AFTER_DRAIN = false;
    bf16_t* O; const ss_t* ss;
    template <class Sched> __device__ __forceinline__ int prepare(const Sched& S, PG8_LAS unsigned char* ext, int tid) const { return rstd_table_fill(S, ss, ext, tid); }
    __device__ __forceinline__ void operator()(const f32x4 (&acc)[2][2][4][2], const Unit& u, int wr, int wc, int fr, int fq, int pf, const PG8_LAS unsigned char* ext) const {
        const int row0 = u.pm * BM + wr * 64 + fr, col0 = u.pn * BM + wc * 32 + 8 * fq;
#pragma unroll
        for (int ai = 0; ai < 2; ++ai)
#pragma unroll
            for (int m = 0; m < 4; ++m) {
                const int row = row0 + ai * HALF + m * 16;
                const float rs = rstd_get(ss, u, row, pf, ext);
#pragma unroll
                for (int bj = 0; bj < 2; ++bj) { const f32x4 v0 = acc[ai][bj][m][0] * rs, v1 = acc[ai][bj][m][1] * rs;
                    u32x4 w; w.x = cvt_pk_bf16(v0[0], v0[1]); w.y = cvt_pk_bf16(v0[2], v0[3]); w.z = cvt_pk_bf16(v1[0], v1[1]); w.w = cvt_pk_bf16(v1[2], v1[3]);
                    *(u32x4*)(O + (size_t)row * 6144 + col0 + bj * HALF) = w; }
            }
    }
};
struct EpiResid {
    static constexpr bool PERM = false, AFTER_DRAIN = false;
    const float* res; float* hout; bf16_t* hb; ss_t* ssn; float scale;
    template <class Sched> __device__ __forceinline__ int prepare(const Sched&, PG8_LAS unsigned char*, int) const { return 0; }
    __device__ __forceinline__ void operator()(const f32x4 (&acc)[2][2][4][2], const Unit& u, int wr, int wc, int fr, int fq, int pf, const PG8_LAS unsigned char* ext) const {
        typedef unsigned u32x2v __attribute__((ext_vector_type(2)));
        const int row0 = u.pm * BM + wr * 64 + fr, col0 = u.pn * BM + wc * 32 + 4 * fq;
        f32x4 rb[3][4];
#define PG8_LDG(gi, buf) do { const size_t off_ = (size_t)(row0 + ((gi) >> 2) * HALF + ((gi) & 3) * 16) * 2048 + col0; \
            _Pragma("unroll") for (int q_ = 0; q_ < 4; ++q_) buf[q_] = *(const f32x4*)(res + off_ + (q_ >> 1) * HALF + (q_ & 1) * 16); } while (0)
        PG8_LDG(0, rb[0]); PG8_LDG(1, rb[1]);
#pragma unroll
        for (int gi = 0; gi < 8; ++gi) {
            if (gi + 2 < 8) PG8_LDG(gi + 2, rb[(gi + 2) % 3]);
            const int ai = gi >> 2, m = gi & 3;
            const int row = row0 + ai * HALF + m * 16; const size_t off = (size_t)row * 2048 + col0; float sq = 0.f;
#pragma unroll
            for (int q = 0; q < 4; ++q) { const int bj = q >> 1, n = q & 1; const size_t o2 = off + bj * HALF + n * 16;
                const f32x4 hn = rb[gi % 3][q] + acc[ai][bj][m][n] * scale;
                *(f32x4*)(hout + o2) = hn; u32x2v w; w.x = cvt_pk_bf16(hn[0], hn[1]); w.y = cvt_pk_bf16(hn[2], hn[3]); *(u32x2v*)(hb + o2) = w;
                sq += (hn[0] * hn[0] + hn[1] * hn[1]) + (hn[2] * hn[2] + hn[3] * hn[3]); }
            sq += __shfl_xor(sq, 16); sq += __shfl_xor(sq, 32);
            if (fq == 0) atomicAdd((unsigned long long*)(ssn + row), (unsigned long long)__float2ll_rn(sq * SS_FIX));
        }
#undef PG8_LDG
    }
};

template <class Epi, class Sched, bool ALIGN_EPI = false, bool SP2 = false>
__device__ __forceinline__ void gemm_phase(PG8_LAS unsigned char* lds, const Gemm g, const Sched& S, const Epi& E) {
    int tid_ = threadIdx.x; asm volatile("" : "+v"(tid_));
    const int tid = tid_, wid = __builtin_amdgcn_readfirstlane(tid >> 6), lane = tid & 63, wr = wid >> 2, wc = wid & 3, fr = lane & 15, fq = lane >> 4;
    const int K = g.K, nt = K / BK;
    unsigned voffA[2], voffB[2];
#pragma unroll
    for (int i = 0; i < 2; ++i) { int R, C; stage_rc(tid * 16 + i * 8192, R, C); const int Rb = Epi::PERM ? ((R & ~31) + perm32(R & 31)) : R;
        voffA[i] = (unsigned)(R * K + C) * 2u; voffB[i] = (unsigned)(Rb * K + C) * 2u; }
    const size_t kstep = (size_t)(BK * 2);
    const size_t hstep = (size_t)HALF * K * 2;
    const size_t tstep = 2 * hstep;
    const unsigned ldsw = (unsigned)wid * 1024u;
    const int aoff = lds_byte(wr * 64 + fr, fq * 8), boff = lds_byte(wc * 32 + fr, fq * 8);
#define PG8_SA(b, h) (((b) * 2 + (h)) * HTB)
#define PG8_SB(b, h) ((4 + (b) * 2 + (h)) * HTB)
#define PG8_STAGE(bufoff, gbase, voff) do { _Pragma("unroll") for (int _i = 0; _i < 2; ++_i) \
        __builtin_amdgcn_global_load_lds((const unsigned*)((const char*)(gbase) + (voff)[_i]), (PG8_LAS unsigned*)(lds + (bufoff) + ldsw + _i * 8192), 16, 0, 0); } while (0)
#define PG8_LDA(dst, b, h) do { _Pragma("unroll") for (int m = 0; m < 4; ++m) _Pragma("unroll") for (int k = 0; k < 2; ++k) dst[m][k] = *(const PG8_LAS bf16x8*)(lds + PG8_SA(b, h) + aoff + m * 2048 + k * 1024); } while (0)
#define PG8_LDB(dst, b, h) do { _Pragma("unroll") for (int n = 0; n < 2; ++n) _Pragma("unroll") for (int k = 0; k < 2; ++k) dst[n][k] = *(const PG8_LAS bf16x8*)(lds + PG8_SB(b, h) + boff + n * 2048 + k * 1024); } while (0)
#define PG8_MMA(ai, bj, At, Bt) do { __builtin_amdgcn_s_setprio(1); _Pragma("unroll") for (int m = 0; m < 4; ++m) _Pragma("unroll") for (int n = 0; n < 2; ++n) _Pragma("unroll") for (int k = 0; k < 2; ++k) \
        acc[ai][bj][m][n] = __builtin_amdgcn_mfma_f32_16x16x32_bf16(Bt[n][k], At[m][k], acc[ai][bj][m][n], 0, 0, 0); __builtin_amdgcn_s_setprio(0); } while (0)
#define PG8_WAIT_V(n) asm volatile("s_waitcnt vmcnt(" #n ")" ::: "memory")
#define PG8_WAIT_L(n) asm volatile("s_waitcnt lgkmcnt(" #n ")" ::: "memory")
#define PG8_BAR __builtin_amdgcn_s_barrier()
#define PG8_SCHED __builtin_amdgcn_sched_barrier(0)
    const int pf = E.prepare(S, lds + STAGE_BYTES, tid);
    Unit cur, nxt; int ui = 0;
    if (!S.next(0, cur)) return;
    f32x4 acc[2][2][4][2];
#pragma unroll
    for (int a = 0; a < 2; ++a)
#pragma unroll
        for (int b = 0; b < 2; ++b)
#pragma unroll
            for (int m = 0; m < 4; ++m)
#pragma unroll
                for (int n = 0; n < 2; ++n) acc[a][b][m][n] = (f32x4){0.f, 0.f, 0.f, 0.f};
    bf16x8 At[4][2], B0[2][2], B1[2][2];
    const char* cA = (const char*)g.A + (size_t)cur.pm * tstep; const char* cB = (const char*)g.Bt + (size_t)cur.pn * tstep;
    S.a_ready(cur);
    if constexpr (SP2) {
        PG8_STAGE(PG8_SB(0, 0), cB, voffB); PG8_STAGE(PG8_SB(0, 1), cB + hstep, voffB); PG8_STAGE(PG8_SA(0, 0), cA, voffA); PG8_STAGE(PG8_SA(0, 1), cA + hstep, voffA);
        if (wr == 1) PG8_BAR;
        PG8_WAIT_V(2); PG8_BAR;
        PG8_STAGE(PG8_SB(1, 0), cB + kstep, voffB); PG8_STAGE(PG8_SA(1, 0), cA + kstep, voffA); PG8_STAGE(PG8_SB(1, 1), cB + hstep + kstep, voffB);
        PG8_WAIT_V(6); PG8_BAR;
    } else {
        PG8_STAGE(PG8_SB(0, 0), cB, voffB); PG8_STAGE(PG8_SA(0, 0), cA, voffA); PG8_STAGE(PG8_SB(0, 1), cB + hstep, voffB); PG8_STAGE(PG8_SA(0, 1), cA + hstep, voffA);
        if (wr == 1) PG8_BAR;
        PG8_WAIT_V(4); PG8_BAR;
        PG8_STAGE(PG8_SB(1, 0), cB + kstep, voffB); PG8_STAGE(PG8_SA(1, 0), cA + kstep, voffA); PG8_STAGE(PG8_SB(1, 1), cB + hstep + kstep, voffB);
        PG8_WAIT_V(6); PG8_BAR;
    }
    for (;;) {
        const bool has_next = S.next(ui + 1, nxt);
        const char* nA = has_next ? (const char*)g.A + (size_t)nxt.pm * tstep : cA; const char* nB = has_next ? (const char*)g.Bt + (size_t)nxt.pn * tstep : cB;
        for (int t = 0; t < nt; t += 2) {
            const bool last = (t == nt - 2);
            const char* a1 = cA + (size_t)(t + 1) * kstep;
            const char* a2 = last ? nA : cA + (size_t)(t + 2) * kstep; const char* b2 = last ? nB : cB + (size_t)(t + 2) * kstep;
            const char* a3 = a2 + kstep; const char* b3 = b2 + kstep;
            if (last && has_next) S.a_ready(nxt);
            if constexpr (SP2) {
            PG8_LDB(B0, 0, 0); PG8_LDB(B1, 0, 1); PG8_SCHED; PG8_LDA(At, 0, 0); PG8_STAGE(PG8_SA(1, 1), a1 + hstep, voffA);
            PG8_WAIT_V(8); PG8_WAIT_L(0); PG8_BAR; PG8_MMA(0, 0, At, B0); PG8_MMA(0, 1, At, B1); PG8_BAR; PG8_SCHED;
            PG8_LDA(At, 0, 1); PG8_STAGE(PG8_SB(0, 0), b2, voffB); PG8_STAGE(PG8_SB(0, 1), b2 + hstep, voffB); PG8_STAGE(PG8_SA(0, 0), a2, voffA);
            PG8_WAIT_V(8); PG8_WAIT_L(0); PG8_BAR; PG8_MMA(1, 0, At, B0); PG8_MMA(1, 1, At, B1); PG8_BAR; PG8_SCHED;
            PG8_LDB(B0, 1, 0); PG8_LDB(B1, 1, 1); PG8_SCHED; PG8_LDA(At, 1, 0); PG8_STAGE(PG8_SA(0, 1), a2 + hstep, voffA);
            PG8_WAIT_V(8); PG8_WAIT_L(0); PG8_BAR; PG8_MMA(0, 0, At, B0); PG8_MMA(0, 1, At, B1); PG8_BAR; PG8_SCHED;
            PG8_LDA(At, 1, 1); PG8_STAGE(PG8_SB(1, 0), b3, voffB); PG8_STAGE(PG8_SB(1, 1), b3 + hstep, voffB); PG8_STAGE(PG8_SA(1, 0), a3, voffA);
            PG8_WAIT_V(8); PG8_WAIT_L(0); PG8_BAR; PG8_MMA(1, 0, At, B0); PG8_MMA(1, 1, At, B1); PG8_BAR; PG8_SCHED;
            } else {
            PG8_LDB(B0, 0, 0); PG8_SCHED; PG8_LDA(At, 0, 0); PG8_STAGE(PG8_SA(1, 1), a1 + hstep, voffA);
            PG8_WAIT_L(8); PG8_BAR; PG8_WAIT_L(0); PG8_MMA(0, 0, At, B0); PG8_BAR; PG8_SCHED;
            PG8_LDB(B1, 0, 1); PG8_STAGE(PG8_SB(0, 0), b2, voffB);
            PG8_BAR; PG8_WAIT_L(0); PG8_MMA(0, 1, At, B1); PG8_BAR;
            PG8_LDA(At, 0, 1); PG8_STAGE(PG8_SA(0, 0), a2, voffA);
            PG8_BAR; PG8_WAIT_L(0); PG8_MMA(1, 0, At, B0); PG8_BAR; PG8_SCHED;
            PG8_STAGE(PG8_SB(0, 1), b2 + hstep, voffB);
            PG8_WAIT_V(6); PG8_BAR; PG8_MMA(1, 1, At, B1); PG8_BAR;
            PG8_LDB(B0, 1, 0); PG8_SCHED; PG8_LDA(At, 1, 0); PG8_STAGE(PG8_SA(0, 1), a2 + hstep, voffA);
            PG8_WAIT_L(8); PG8_BAR; PG8_WAIT_L(0); PG8_MMA(0, 0, At, B0); PG8_BAR; PG8_SCHED;
            PG8_LDB(B1, 1, 1); PG8_STAGE(PG8_SB(1, 0), b3, voffB);
            PG8_BAR; PG8_WAIT_L(0); PG8_MMA(0, 1, At, B1); PG8_BAR;
            PG8_LDA(At, 1, 1); PG8_STAGE(PG8_SA(1, 0), a3, voffA);
            PG8_BAR; PG8_WAIT_L(0); PG8_MMA(1, 0, At, B0); PG8_BAR; PG8_SCHED;
            PG8_STAGE(PG8_SB(1, 1), b3 + hstep, voffB);
            PG8_WAIT_V(6); PG8_BAR; PG8_MMA(1, 1, At, B1); PG8_BAR;
            }
        }
        if constexpr (ALIGN_EPI) { if (wr == 0) PG8_BAR; }
        if constexpr (!Epi::AFTER_DRAIN) { E(acc, cur, wr, wc, fr, fq, pf, lds + STAGE_BYTES); S.done(cur); }
        if (!has_next) break;
#pragma unroll
        for (int a = 0; a < 2; ++a)
#pragma unroll
            for (int b = 0; b < 2; ++b)
#pragma unroll
                for (int m = 0; m < 4; ++m)
#pragma unroll
                    for (int n = 0; n < 2; ++n) acc[a][b][m][n] = (f32x4){0.f, 0.f, 0.f, 0.f};
        cur = nxt; cA = nA; cB = nB; ++ui;
        if constexpr (ALIGN_EPI) { if (wr == 1) PG8_BAR; }
    }
    PG8_WAIT_V(0);
    if constexpr (!ALIGN_EPI) { if (wr == 0) PG8_BAR; }
    PG8_BAR;
    if constexpr (Epi::AFTER_DRAIN) { E.fused(acc, cur, wr, wc, fr, fq, lds, wid, lane); S.done(cur); }
#undef PG8_SA
#undef PG8_SB
#undef PG8_STAGE
#undef PG8_LDA
#undef PG8_LDB
#undef PG8_MMA
#undef PG8_WAIT_V
#undef PG8_WAIT_L
#undef PG8_BAR
#undef PG8_SCHED
}
}

#ifndef PG8_SP2
#define PG8_SP2 true
#endif
#ifndef PG8_ALIGN
#define PG8_ALIGN true
#endif
#ifndef REP_PRO
#define REP_PRO 1
#endif
#ifndef REP_MLSTM
#define REP_MLSTM 1
#endif
#ifndef REP_FOX
#define REP_FOX 1
#endif
#ifndef REP_GLA
#define REP_GLA 1
#endif
#ifndef MK_PER_PHASE
#define MK_PER_PHASE 0
#endif

constexpr int DM = 2048, BATCH = 8, SEQ = 4096, MTOK = BATCH * SEQ, DEPTH = 4, DFF = 5632, NUP = 2 * DFF, NIN = 6160, NINP = 6400, NQKV = 6144;
constexpr int NWAVES = 8;
constexpr int NSUB = 3 * DEPTH;
constexpr int NPHASE = 2 + 5 * NSUB;

constexpr size_t MiB = 1u << 20;
constexpr size_t WS_CTL = 0, CTL_ZERO_BYTES = 5 * MiB;
constexpr size_t WS_SS = 1 * MiB;
constexpr size_t WS_WUP = 8 * MiB;
constexpr size_t WS_WDN = WS_WUP + 352 * MiB;
constexpr size_t WS_WIN = WS_WDN + 176 * MiB;
constexpr size_t WS_WOUT = WS_WIN + 100 * MiB;
constexpr size_t WS_HB = WS_WOUT + 32 * MiB;
constexpr size_t WS_ACT = WS_HB + 128 * MiB;
constexpr size_t WS_P1 = WS_ACT + 352 * MiB;
constexpr size_t WS_G = WS_P1 + 384 * MiB;
constexpr size_t WS_HRAW = WS_G + 2 * MiB;
constexpr size_t WS_HM = WS_HRAW + 256 * MiB;
constexpr size_t WS_CF = WS_HM + 128 * MiB;
constexpr size_t WS_END = WS_CF + 2 * MiB;
static_assert((size_t)8 * NUP * DM * 2 == 352 * MiB && (size_t)8 * DM * DFF * 2 == 176 * MiB && (size_t)4 * NINP * DM * 2 == 100 * MiB, "weight regions");
static_assert((size_t)MTOK * DFF * 2 == 352 * MiB && (size_t)MTOK * NQKV * 2 == 384 * MiB && WS_SS + 13 * (size_t)MTOK * 8 <= CTL_ZERO_BYTES, "activation regions");
constexpr int CW_BAR = 4096;

constexpr int LDS_BYTES = 153600, MISC_OFF = 152576;

#define GAS __attribute__((address_space(1)))
#define LAS __attribute__((address_space(3)))
#define DI __device__ __forceinline__
typedef unsigned short bf16;
typedef unsigned v4u __attribute__((ext_vector_type(4)));
typedef unsigned v2u __attribute__((ext_vector_type(2)));
typedef float f32x4 __attribute__((ext_vector_type(4)));
typedef short bf16x8 __attribute__((ext_vector_type(8)));
typedef GAS unsigned gu32;
#define RLX_AGENT __ATOMIC_RELAXED, __HIP_MEMORY_SCOPE_AGENT
#define LDS_WAIT() asm volatile("s_waitcnt lgkmcnt(0)" ::: "memory")
DI unsigned f2bf(float f) { unsigned u = __builtin_bit_cast(unsigned, f); return (u + 0x7fffu + ((u >> 16) & 1u)) >> 16; }
DI unsigned pk2(float lo, float hi) { unsigned r; asm("v_cvt_pk_bf16_f32 %0, %1, %2" : "=v"(r) : "v"(lo), "v"(hi)); return r; }
DI float bf2f(unsigned short v) { return __builtin_bit_cast(float, (unsigned)v << 16); }
DI float bflo(unsigned w) { return __builtin_bit_cast(float, w << 16); }
DI float bfhi(unsigned w) { return __builtin_bit_cast(float, w & 0xffff0000u); }
DI float logsig(float x) { return fminf(x, 0.f) - log1pf(expf(-fabsf(x))); }

#define XB_TMO      128
#define XB_XCNT(j)  (256  + 64 * (j))
#define XB_XSUB(j)  (1280 + 64 * (j))
#define XB_XGEN(j)  (2304 + 64 * (j))
#define XB_TOP      3328
#define XB_TOPGEN   3392
#define XCD_BAR_WORDS 3456
#define XB_SPIN_CAP (1u << 18)

__device__ __forceinline__ unsigned xb_ld(unsigned* p)              { return __hip_atomic_load(p, __ATOMIC_RELAXED, __HIP_MEMORY_SCOPE_AGENT); }
__device__ __forceinline__ unsigned xb_add(unsigned* p, unsigned v) { return __hip_atomic_fetch_add(p, v, __ATOMIC_RELAXED, __HIP_MEMORY_SCOPE_AGENT); }
__device__ __forceinline__ unsigned xb_xcc_id() { return (unsigned)__builtin_amdgcn_s_getreg((3 << 11) | 20) & 0xFu; }
#define XB_SPIN(cond, bar) do { unsigned _sp = 0; while (cond) { __builtin_amdgcn_s_sleep(1); \
    if ((++_sp & 255u) == 0u) { if (xb_ld(&(bar)[XB_TMO])) break; if (_sp > XB_SPIN_CAP) { atomicAdd(&(bar)[XB_TMO], 1u); break; } } } } while (0)

struct XcdBarrier {
    unsigned* bar; unsigned x;
    volatile LAS unsigned* st;
};

__device__ __forceinline__ XcdBarrier xcd_barrier_post(unsigned* bar, volatile LAS unsigned* st) {
    XcdBarrier b; b.bar = bar; b.x = xb_xcc_id(); b.st = st;
    if (threadIdx.x == 0) (void)xb_add(&bar[XB_XCNT(b.x)], 1u);
    return b;
}
__device__ __forceinline__ void xcd_barrier_complete(unsigned* bar, unsigned x, unsigned& nloc, unsigned& nx) {
    const unsigned G = gridDim.x * gridDim.y * gridDim.z;
    unsigned sum, cnt, mine, sp = 0u;
    for (;;) {
        sum = 0u; cnt = 0u; mine = 0u;
#pragma unroll
        for (unsigned j = 0; j < 16; ++j) { const unsigned c = xb_ld(&bar[XB_XCNT(j)]); sum += c; cnt += (c > 0u) ? 1u : 0u; mine = (j == x) ? c : mine; }
        if (sum == G) break;
        __builtin_amdgcn_s_sleep(1);
        if ((++sp & 255u) == 0u) { if (xb_ld(&bar[XB_TMO])) break; if (sp > XB_SPIN_CAP) { atomicAdd(&bar[XB_TMO], 1u); break; } }
    }
    nloc = mine > 0u ? mine : 1u; nx = cnt > 0u ? cnt : 1u;
}

__device__ __forceinline__ void xcd_barrier(const XcdBarrier& b) {
    asm volatile("s_waitcnt vmcnt(0)" ::: "memory");
    __syncthreads();
    if (threadIdx.x == 0) {
        unsigned* bar = b.bar;
        __builtin_amdgcn_s_waitcnt(0);
        unsigned nloc = b.st[0], nx = b.st[1];
        if (nloc == 0u) { xcd_barrier_complete(bar, b.x, nloc, nx); b.st[0] = nloc; b.st[1] = nx; }
        const unsigned old = xb_add(&bar[XB_XSUB(b.x)], 1u);
        const unsigned gen = old / nloc;
        if (old + 1u == (gen + 1u) * nloc) {
            __builtin_amdgcn_fence(__ATOMIC_RELEASE, "agent");
            asm volatile("s_waitcnt vmcnt(0)" ::: "memory");
            const unsigned og = xb_add(&bar[XB_TOP], 1u);
            const unsigned tg = og / nx;
            if (og + 1u == (tg + 1u) * nx) xb_add(&bar[XB_TOPGEN], 1u);
            else XB_SPIN(xb_ld(&bar[XB_TOPGEN]) == tg, bar);
            __builtin_amdgcn_fence(__ATOMIC_ACQUIRE, "agent");
            xb_add(&bar[XB_XGEN(b.x)], 1u);
            asm volatile("s_waitcnt vmcnt(0)" ::: "memory");
        } else {
            XB_SPIN(xb_ld(&bar[XB_XGEN(b.x)]) == gen, bar);
            __builtin_amdgcn_fence(__ATOMIC_ACQUIRE, "agent");
            asm volatile("s_waitcnt vmcnt(0)" ::: "memory");
        }
    }
    __syncthreads();
}


DI float wave_sum(float v) {
#pragma unroll
    for (int o = 1; o < 64; o <<= 1) v += __shfl_xor(v, o);
    return v;
}
DI float wave_max(float v) {
#pragma unroll
    for (int o = 1; o < 64; o <<= 1) v = fmaxf(v, __shfl_xor(v, o));
    return v;
}
DI float wave_incl_sum(float v, int lane) {
#pragma unroll
    for (int o = 1; o < 64; o <<= 1) { const float t = __shfl_up(v, o); if (lane >= o) v += t; }
    return v;
}
DI float wave_incl_max(float v, int lane) {
#pragma unroll
    for (int o = 1; o < 64; o <<= 1) { const float t = __shfl_up(v, o); if (lane >= o) v = fmaxf(v, t); }
    return v;
}

template <int L> DI int swx(int r) { return L == 64 ? ((r >> 1) & 7) : (r & 15); }
template <int L> DI int eoff(int r, int c) { return r * L + ((((c >> 3) ^ swx<L>(r)) << 3) | (c & 7)); }
template <int L> DI bf16x8 ldf(const LAS bf16* base, int r, int ch) { return *(const LAS bf16x8*)(base + r * L + ((ch ^ swx<L>(r)) << 3)); }
DI f32x4 mfma16(bf16x8 a, bf16x8 b, f32x4 c) { return __builtin_amdgcn_mfma_f32_16x16x32_bf16(a, b, c, 0, 0, 0); }
template <int LA, int LB, int NK> DI void mma_tile(f32x4& acc, const LAS bf16* A, int ra0, const LAS bf16* B, int rb0, int lane) {
    const int r = lane & 15, g = lane >> 4;
#pragma unroll
    for (int kk = 0; kk < NK; ++kk) { const bf16x8 a = ldf<LA>(A, ra0 + r, 4 * kk + g), b = ldf<LB>(B, rb0 + r, 4 * kk + g); acc = mfma16(a, b, acc); }
}

DI void conv_item(const float* W, int K, int N, int nblk, const float* gk, bf16* WT, int mode, LAS float* scr, int item, int lane) {
    const int kb = item / nblk, nb = item - kb * nblk, k0 = 64 * kb, n0 = 32 * nb;
    const int nq = 4 * (lane & 7), n = n0 + nq; const bool ok = n < N;
    f32x4 v[8]; float gv[8];
#pragma unroll
    for (int i = 0; i < 8; ++i) { const int kk = 8 * i + (lane >> 3); v[i] = ok ? *(const f32x4*)(W + (size_t)(k0 + kk) * N + n) : (f32x4){0.f, 0.f, 0.f, 0.f}; gv[i] = gk ? gk[k0 + kk] : 1.0f; }
#pragma unroll
    for (int i = 0; i < 8; ++i) { const int kk = 8 * i + (lane >> 3); LAS float* d = scr + kk * 33 + nq; d[0] = v[i].x * gv[i]; d[1] = v[i].y * gv[i]; d[2] = v[i].z * gv[i]; d[3] = v[i].w * gv[i]; }
    LDS_WAIT(); asm volatile("" ::: "memory");
    int row_off = n0;
    if (mode == 1) { const int j = n0 < DFF ? n0 : n0 - DFF; row_off = 256 * (j >> 7) + (j & 127) + (n0 < DFF ? 0 : 128); }
    const int c = lane & 7;
#pragma unroll
    for (int j = 0; j < 4; ++j) { const int nn = (lane >> 3) + 8 * j; const LAS float* s = scr + (8 * c) * 33 + nn;
        v4u o; o.x = pk2(s[0 * 33], s[1 * 33]); o.y = pk2(s[2 * 33], s[3 * 33]); o.z = pk2(s[4 * 33], s[5 * 33]); o.w = pk2(s[6 * 33], s[7 * 33]);
        *(v4u*)(WT + (size_t)(row_off + nn) * K + k0 + 8 * c) = o; }
    LDS_WAIT(); asm volatile("" ::: "memory");
}

struct Args { const float* in[18]; float* out; unsigned char* ws; int ph_lo, ph_hi; };

typedef const __attribute__((address_space(4))) Args* KArgs;
DI KArgs kargs() { KArgs p = (KArgs)__builtin_amdgcn_kernarg_segment_ptr(); asm volatile("" : "+s"(p)); return p; }
DI void prologue(LAS unsigned char* lds, int lane, int wave, int bx) {
    KArgs AP = kargs();
    LAS float* scr = (LAS float*)(lds + wave * 16384);
    const int gw = bx * NWAVES + wave, NGW = gridDim.x * NWAVES;
    unsigned char* ws = AP->ws;
    constexpr int I_UP = (DM / 64) * (NUP / 32), I_DN = (DFF / 64) * (DM / 32), I_IN = (DM / 64) * (NINP / 32), I_OUT = (DM / 64) * (DM / 32);
    constexpr int NITEMS = 8 * I_UP + 8 * I_DN + 4 * I_IN + 4 * I_OUT;
    for (int it = gw; it < NITEMS; it += NGW) {
        int r = it; const float* W; const float* gk = nullptr; bf16* WT; int K = DM, N, nblk, mode = 0;
        if (r < 8 * I_UP) { const int mi = r / I_UP; r -= mi * I_UP; W = AP->in[2] + (size_t)mi * DM * NUP; gk = AP->in[1] + (size_t)mi * DM; WT = (bf16*)(ws + WS_WUP) + (size_t)mi * NUP * DM; N = NUP; nblk = NUP / 32; mode = 1; }
        else if (r < 8 * I_UP + 8 * I_DN) { r -= 8 * I_UP; const int mi = r / I_DN; r -= mi * I_DN; W = AP->in[3] + (size_t)mi * DFF * DM; WT = (bf16*)(ws + WS_WDN) + (size_t)mi * DM * DFF; K = DFF; N = DM; nblk = DM / 32; }
        else if (r < 8 * I_UP + 8 * I_DN + 4 * I_IN) { r -= 8 * I_UP + 8 * I_DN; const int l = r / I_IN; r -= l * I_IN; const int kind = l % 3, ji = l / 3;
            W = AP->in[kind == 0 ? 5 : kind == 1 ? 9 : 12] + (size_t)ji * DM * NIN; gk = AP->in[4] + (size_t)l * DM; WT = (bf16*)(ws + WS_WIN) + (size_t)l * NINP * DM; N = NIN; nblk = NINP / 32; }
        else { r -= 8 * I_UP + 8 * I_DN + 4 * I_IN; const int l = r / I_OUT; r -= l * I_OUT; const int kind = l % 3, ji = l / 3;
            W = AP->in[kind == 0 ? 8 : kind == 1 ? 11 : 16] + (size_t)ji * DM * DM; WT = (bf16*)(ws + WS_WOUT) + (size_t)l * DM * DM; N = DM; nblk = DM / 32; }
        conv_item(W, K, N, nblk, gk, WT, mode, scr, r, lane);
    }
    const float* x = AP->in[0]; bf16* hb = (bf16*)(ws + WS_HB); long long* ss0 = (long long*)(ws + WS_SS);
    for (int m = gw; m < MTOK; m += NGW) {
        const f32x4* xr = (const f32x4*)(x + (size_t)m * DM) + lane; f32x4 v[8]; float s = 0.f;
#pragma unroll
        for (int j = 0; j < 8; ++j) { v[j] = xr[64 * j]; s += (v[j].x * v[j].x + v[j].y * v[j].y) + (v[j].z * v[j].z + v[j].w * v[j].w); }
        s = wave_sum(s);
        v2u* o8 = (v2u*)(hb + (size_t)m * DM) + lane;
#pragma unroll
        for (int j = 0; j < 8; ++j) { v2u w; w.x = pk2(v[j].x, v[j].y); w.y = pk2(v[j].z, v[j].w); o8[64 * j] = w; }
        if (lane == 0) ss0[m] = __float2ll_rn(s * 1048576.0f);
    }
}

constexpr int IMGM_P = 0, IMGM_KT = 8192, IMGM_VT = IMGM_KT + 16384, IMGM_GS = IMGM_VT + 4 * 8192, IMGM_BYTES = IMGM_GS + 1024;
constexpr int IMGG_Q = 0, IMGG_KT = 32768, IMGG_P = 65536, IMGG_VT = IMGG_P + 8192, IMGG_EB = IMGG_VT + 8 * 8192, IMGG_BYTES = IMGG_EB + 1024;
static_assert((size_t)IMGM_BYTES * 4096 <= 352 * MiB && (size_t)IMGG_BYTES * 2048 <= 352 * MiB, "images overlay the (idle) FFN activation buffer");
DI float logsig_fast(float x) { return fminf(x, 0.f) - __logf(1.0f + __expf(-fabsf(x))); }

DI void mlstm_pre(LAS unsigned char* lds, const bf16* P1, const float* G, const float* b_if, unsigned char* img, int tid, int lane, int wave, int bx) {
    LAS bf16* Qs = (LAS bf16*)lds;
    LAS bf16* Ks = Qs + 64 * 128;
    LAS bf16* KTs = Ks + 64 * 128;
    LAS bf16* Ps = KTs + 128 * 64;
    LAS bf16* VT = Ps + 64 * 64;
    LAS float* fa = (LAS float*)(VT + 256 * 64);
    LAS float *bcum = fa, *ipre = fa + 64, *aloc = fa + 128, *wloc = fa + 192, *scal = fa + 256;
    const float KSCALE = 0.08838834764831845f;
    const int g = lane >> 4, r16 = lane & 15;
    v4u pq[2], pk[2], pv[4]; float pgi = 0.f, pgf = 0.f;
#define MLP_LOAD(it_) do { const int b_ = (it_) >> 9, c_ = ((it_) >> 3) & 63, h_ = (it_) & 7; const int row0_ = b_ * SEQ + c_ * 64; \
        _Pragma("unroll") for (int p = 0; p < 2; ++p) { const int idx = tid + 512 * p, r = idx >> 4, c8 = idx & 15; const bf16* src = P1 + (size_t)(row0_ + r) * NQKV + h_ * 128 + c8 * 8; pq[p] = *(const v4u*)src; pk[p] = *(const v4u*)(src + 1024); } \
        _Pragma("unroll") for (int p = 0; p < 4; ++p) { const int idx = tid + 512 * p, r = idx >> 5, c8 = idx & 31; pv[p] = *(const v4u*)(P1 + (size_t)(row0_ + r) * NQKV + 2048 + h_ * 256 + c8 * 8); } \
        if (tid < 64) { const float* gp = G + (size_t)(row0_ + tid) * 16; pgi = gp[h_]; pgf = gp[8 + h_]; } } while (0)
    if (bx < 4096) MLP_LOAD(bx);
    for (int item = bx; item < 4096; item += gridDim.x) {
        const int h = item & 7;
        unsigned char* im = img + (size_t)item * IMGM_BYTES;
        __syncthreads();
        if (tid < 64) { ipre[tid] = pgi + b_if[h]; bcum[tid] = logsig(pgf + b_if[8 + h]); }
#pragma unroll
        for (int p = 0; p < 2; ++p) { const int idx = tid + 512 * p, r = idx >> 4, c8 = idx & 15; *(LAS v4u*)(Qs + eoff<128>(r, c8 * 8)) = pq[p]; *(LAS v4u*)(Ks + eoff<128>(r, c8 * 8)) = pk[p]; }
        __syncthreads();
        if (wave == 0) {
            const float bt = wave_incl_sum(bcum[lane], lane), ip = ipre[lane];
            const float al = bt + wave_incl_max(ip - bt, lane);
            const float blast = __shfl(bt, 63);
            const float gg = blast - bt + ip;
            const float gmax = wave_max(gg);
            bcum[lane] = bt; aloc[lane] = al; wloc[lane] = __expf(gg - gmax);
            if (lane == 0) { scal[0] = blast; scal[1] = gmax; }
        }
#pragma unroll
        for (int p = 0; p < 4; ++p) { const int idx = tid + 512 * p, r = idx >> 5, c8 = idx & 31;
#pragma unroll
            for (int j = 0; j < 4; ++j) { VT[eoff<64>(c8 * 8 + 2 * j, r)] = (bf16)(pv[p][j] & 0xffffu); VT[eoff<64>(c8 * 8 + 2 * j + 1, r)] = (bf16)(pv[p][j] >> 16); } }
        if (item + (int)gridDim.x < 4096) MLP_LOAD(item + (int)gridDim.x);
        __syncthreads();
#pragma unroll
        for (int p = 0; p < 2; ++p) { const int idx = tid + 512 * p, s = idx >> 4, c8 = idx & 15; const v4u kv = *(const LAS v4u*)(Ks + eoff<128>(s, c8 * 8)); const float w = wloc[s] * KSCALE;
#pragma unroll
            for (int j = 0; j < 4; ++j) { KTs[eoff<64>(c8 * 8 + 2 * j, s)] = (bf16)f2bf(bflo(kv[j]) * w); KTs[eoff<64>(c8 * 8 + 2 * j + 1, s)] = (bf16)f2bf(bfhi(kv[j]) * w); } }
        { const int tt = wave >> 1;
#pragma unroll
          for (int q2 = 0; q2 < 2; ++q2) { const int st = 2 * (wave & 1) + q2; f32x4 acc = (f32x4){0.f, 0.f, 0.f, 0.f};
            if (st <= tt) mma_tile<128, 128, 4>(acc, Qs, 16 * tt, Ks, 16 * st, lane);
            const int s = 16 * st + r16; const float cs = ipre[s] - bcum[s];
#pragma unroll
            for (int i = 0; i < 4; ++i) { const int t = 16 * tt + 4 * g + i; const float p = (s <= t) ? acc[i] * KSCALE * __expf(bcum[t] + cs - aloc[t]) : 0.f; Ps[eoff<64>(t, s)] = (bf16)f2bf(p); } } }
        __syncthreads();
        *(v4u*)(im + IMGM_P + tid * 16) = *(const LAS v4u*)((LAS unsigned char*)Ps + tid * 16);
#pragma unroll
        for (int p = 0; p < 2; ++p) *(v4u*)(im + IMGM_KT + (tid + 512 * p) * 16) = *(const LAS v4u*)((LAS unsigned char*)KTs + (tid + 512 * p) * 16);
#pragma unroll
        for (int p = 0; p < 4; ++p) *(v4u*)(im + IMGM_VT + (tid + 512 * p) * 16) = *(const LAS v4u*)((LAS unsigned char*)VT + (tid + 512 * p) * 16);
        if (tid < 64) { float* gs = (float*)(im + IMGM_GS); gs[tid] = bcum[tid]; gs[64 + tid] = aloc[tid]; if (tid < 2) gs[128 + tid] = scal[tid]; }
    }
#undef MLP_LOAD
}

DI void mlstm_scan2(LAS unsigned char* lds, const bf16* P1, const unsigned char* img, float* hraw, int tid, int lane, int wave, int bx) {
    constexpr int IB = 8192 + 16384 + 16384 + 10240 + 1024;
    LAS bf16* CT0 = (LAS bf16*)(lds + 2 * IB);
    const int g = lane >> 4, r16 = lane & 15, tt = wave >> 1, eh = wave & 1;
    for (int item = bx; item < 256; item += gridDim.x) {
        const int b = item >> 5, h = (item >> 2) & 7, sl = item & 3;
        f32x4 Cacc[5];
#pragma unroll
        for (int e = 0; e < 5; ++e) Cacc[e] = (f32x4){0.f, 0.f, 0.f, 0.f};
        __syncthreads();
        for (int i = tid; i < 2 * 80 * 128 / 8; i += 512) ((LAS v4u*)CT0)[i] = (v4u){0u, 0u, 0u, 0u};
        for (int i = tid; i < 2 * 128; i += 512) { const int bi = i >> 7, k = i & 127; ((LAS v4u*)(lds + bi * IB + 8192 + 16384 + 16384 + 8192))[k] = (k < 8) ? (v4u){0x3f803f80u, 0x3f803f80u, 0x3f803f80u, 0x3f803f80u} : (v4u){0u, 0u, 0u, 0u}; }
        float m_prev = 0.f;
        v4u rp, rq[2], rk[2], rv; float rg0 = 0.f, rbl, rgm;
#define MLS_PREFETCH(cc) do { const int item2 = (b * 64 + (cc)) * 8 + h; const unsigned char* im = img + (size_t)item2 * IMGM_BYTES; const int row0_ = b * SEQ + (cc) * 64; \
            rp = *(const v4u*)(im + IMGM_P + tid * 16); rk[0] = *(const v4u*)(im + IMGM_KT + tid * 16); rk[1] = *(const v4u*)(im + IMGM_KT + (tid + 512) * 16); \
            rv = *(const v4u*)(im + IMGM_VT + sl * 8192 + tid * 16); \
            _Pragma("unroll") for (int p = 0; p < 2; ++p) { const int idx = tid + 512 * p, r = idx >> 4, c8 = idx & 15; rq[p] = *(const v4u*)(P1 + (size_t)(row0_ + r) * NQKV + h * 128 + c8 * 8); } \
            const float* gs = (const float*)(im + IMGM_GS); if (tid < 128) rg0 = gs[tid]; rbl = gs[128]; rgm = gs[129]; } while (0)
#define MLS_STORE(bi) do { LAS unsigned char* bb = lds + (bi) * IB; \
            *(LAS v4u*)(bb + tid * 16) = rp; *(LAS v4u*)(bb + 8192 + 16384 + tid * 16) = rk[0]; *(LAS v4u*)(bb + 8192 + 16384 + (tid + 512) * 16) = rk[1]; \
            *(LAS v4u*)(bb + 8192 + 16384 + 16384 + tid * 16) = rv; \
            _Pragma("unroll") for (int p = 0; p < 2; ++p) { const int idx = tid + 512 * p, r = idx >> 4, c8 = idx & 15; *(LAS v4u*)((LAS bf16*)(bb + 8192) + eoff<128>(r, c8 * 8)) = rq[p]; } \
            if (tid < 128) ((LAS float*)(bb + 8192 + 16384 + 16384 + 10240))[tid] = rg0; } while (0)
        MLS_PREFETCH(0); MLS_STORE(0);
        float blast = rbl, gmax = rgm;
        MLS_PREFETCH(1);
        __syncthreads();
        for (int c = 0; c < 64; ++c) {
            const int row0 = b * SEQ + c * 64;
            const LAS unsigned char* bb = lds + (c & 1) * IB;
            const LAS bf16* Ps = (const LAS bf16*)bb; const LAS bf16* Qs = (const LAS bf16*)(bb + 8192); const LAS bf16* KTs = (const LAS bf16*)(bb + 8192 + 16384);
            const LAS bf16* VTs = (const LAS bf16*)(bb + 8192 + 16384 + 16384); const LAS float* gsl = (const LAS float*)(bb + 8192 + 16384 + 16384 + 10240);
            LAS bf16* CTc = CT0 + (c & 1) * 80 * 128; LAS bf16* CTn = CT0 + ((c + 1) & 1) * 80 * 128;
            const f32x4 btv = *(const LAS f32x4*)(gsl + 16 * tt + 4 * g), alv = *(const LAS f32x4*)(gsl + 64 + 16 * tt + 4 * g);
            float al[4], be[4], em[4];
#pragma unroll
            for (int i = 0; i < 4; ++i) { const float mt = fmaxf(btv[i] + m_prev, alv[i]); al[i] = __expf(alv[i] - mt); be[i] = __expf(btv[i] + m_prev - mt); em[i] = __expf(-mt); }
            const float m_new = fmaxf(blast + m_prev, gmax), wcs = __expf(blast + m_prev - m_new), gam = __expf(gmax - m_new);
            m_prev = m_new;
            f32x4 d1 = (f32x4){0.f, 0.f, 0.f, 0.f}, d2 = (f32x4){0.f, 0.f, 0.f, 0.f};
            mma_tile<64, 64, 2>(d1, Ps, 16 * tt, VTs, 64, lane); mma_tile<128, 128, 4>(d2, Qs, 16 * tt, CTc, 64, lane);
            float dinv[4];
#pragma unroll
            for (int i = 0; i < 4; ++i) { const float den = __shfl(al[i] * d1[i] + be[i] * d2[i], lane & 48); dinv[i] = __builtin_amdgcn_rcpf(fmaxf(fabsf(den), em[i])); }
#pragma unroll
            for (int q2 = 0; q2 < 2; ++q2) { const int et = 2 * eh + q2, e = 16 * et + r16; f32x4 a1 = (f32x4){0.f, 0.f, 0.f, 0.f}, a2 = (f32x4){0.f, 0.f, 0.f, 0.f};
                mma_tile<64, 64, 2>(a1, Ps, 16 * tt, VTs, 16 * et, lane); mma_tile<128, 128, 4>(a2, Qs, 16 * tt, CTc, 16 * et, lane);
#pragma unroll
                for (int i = 0; i < 4; ++i) { const int t = 16 * tt + 4 * g + i; hraw[(size_t)(row0 + t) * DM + h * 256 + sl * 64 + e] = (al[i] * a1[i] + be[i] * a2[i]) * dinv[i]; } }
#pragma unroll
            for (int et = 0; et < 5; ++et) { f32x4 tmp = (f32x4){0.f, 0.f, 0.f, 0.f}; mma_tile<64, 64, 2>(tmp, KTs, 16 * wave, VTs, 16 * et, lane);
                Cacc[et] = Cacc[et] * wcs + tmp * gam;
                v2u w; w.x = pk2(Cacc[et][0], Cacc[et][1]); w.y = pk2(Cacc[et][2], Cacc[et][3]);
                *(LAS v2u*)(CTn + eoff<128>(16 * et + r16, 16 * wave + 4 * g)) = w; }
            if (c + 1 < 64) { MLS_STORE((c + 1) & 1); blast = rbl; gmax = rgm; }
            if (c + 2 < 64) MLS_PREFETCH(c + 2);
            __syncthreads();
        }
#undef MLS_PREFETCH
#undef MLS_STORE
    }
}

DI void gla_pre(LAS unsigned char* lds, const bf16* P1, const float* G, const float* w_alpha, const float* b_alpha, unsigned char* img, int tid, int lane, int wave, int bx) {
    LAS bf16* VT = (LAS bf16*)lds;
    LAS bf16* QTs = (LAS bf16*)lds;
    LAS bf16* KTl = QTs + 64 * 256;
    LAS bf16* KTT = KTl + 64 * 256;
    LAS bf16* Ps = KTT + 256 * 64;
    LAS float* alow = (LAS float*)(Ps + 64 * 64);
    LAS float* T0 = alow + 1024;
    const int g = lane >> 4, r16 = lane & 15, d = tid & 255, sh = tid >> 8;
    for (int item = bx; item < 2048; item += gridDim.x) {
        const int b = item >> 8, c = (item >> 2) & 63, h = item & 3;
        const int row0 = b * SEQ + c * 64;
        unsigned char* im = img + (size_t)item * IMGG_BYTES;
        __syncthreads();
#pragma unroll
        for (int p = 0; p < 8; ++p) { const int idx = tid + 512 * p, r = idx >> 6, c8 = idx & 63; const v4u vv = *(const v4u*)(P1 + (size_t)(row0 + r) * NQKV + 2048 + h * 512 + c8 * 8);
#pragma unroll
            for (int j = 0; j < 4; ++j) { VT[eoff<64>(c8 * 8 + 2 * j, r)] = (bf16)(vv[j] & 0xffffu); VT[eoff<64>(c8 * 8 + 2 * j + 1, r)] = (bf16)(vv[j] >> 16); } }
        float wa[16];
#pragma unroll
        for (int i = 0; i < 16; ++i) wa[i] = w_alpha[i * 1024 + h * 256 + d];
        const float ba = b_alpha[h * 256 + d];
        f32x4 al4 = (f32x4){0.f, 0.f, 0.f, 0.f};
        if (tid < 256) al4 = *(const f32x4*)(G + (size_t)(row0 + (tid >> 2)) * 16 + (tid & 3) * 4);
        __syncthreads();
#pragma unroll
        for (int p = 0; p < 8; ++p) *(v4u*)(im + IMGG_VT + (tid + 512 * p) * 16) = *(const LAS v4u*)((LAS unsigned char*)VT + (tid + 512 * p) * 16);
        __syncthreads();
        if (tid < 256) *(LAS f32x4*)(alow + tid * 4) = al4;
        __syncthreads();
        const bf16* qsrc = P1 + (size_t)(row0 + 32 * sh) * NQKV + h * 256 + d;
        float bs[32]; float run = 0.f;
#pragma unroll
        for (int j = 0; j < 32; ++j) { const int s = 32 * sh + j; float z = ba;
#pragma unroll
            for (int i = 0; i < 16; ++i) z += alow[s * 16 + i] * wa[i];
            run += logsig_fast(z) * (1.0f / 16.0f); bs[j] = run; }
        if (sh == 0) T0[d] = run;
        __syncthreads();
        const float add = sh ? T0[d] : 0.f;
        if (sh) ((float*)(im + IMGG_EB))[d] = __expf(run + add);
#pragma unroll
        for (int q8 = 0; q8 < 4; ++q8) { unsigned kk[8];
#pragma unroll
            for (int j = 0; j < 8; ++j) { const int jj = 8 * q8 + j, s = 32 * sh + jj; const float bsum = bs[jj] + add;
                const float qv = bf2f(qsrc[(size_t)jj * NQKV]) * 0.0625f * __expf(bsum), kv = bf2f(qsrc[(size_t)jj * NQKV + 1024]) * __expf(-bsum);
                QTs[eoff<256>(s, d)] = (bf16)f2bf(qv); kk[j] = f2bf(kv); KTl[eoff<256>(s, d)] = (bf16)kk[j]; }
            v4u w; w.x = kk[0] | (kk[1] << 16); w.y = kk[2] | (kk[3] << 16); w.z = kk[4] | (kk[5] << 16); w.w = kk[6] | (kk[7] << 16);
            *(LAS v4u*)(KTT + eoff<64>(d, 32 * sh + 8 * q8)) = w; }
        __syncthreads();
        { const int tt = wave >> 1;
#pragma unroll
          for (int q2 = 0; q2 < 2; ++q2) { const int st = 2 * (wave & 1) + q2; f32x4 acc = (f32x4){0.f, 0.f, 0.f, 0.f};
            if (st <= tt) mma_tile<256, 256, 8>(acc, QTs, 16 * tt, KTl, 16 * st, lane);
            const int s = 16 * st + r16;
#pragma unroll
            for (int i = 0; i < 4; ++i) { const int t = 16 * tt + 4 * g + i; Ps[eoff<64>(t, s)] = (bf16)f2bf((s <= t) ? acc[i] : 0.f); } } }
        __syncthreads();
#pragma unroll
        for (int p = 0; p < 4; ++p) { *(v4u*)(im + IMGG_Q + (tid + 512 * p) * 16) = *(const LAS v4u*)((LAS unsigned char*)QTs + (tid + 512 * p) * 16);
                                      *(v4u*)(im + IMGG_KT + (tid + 512 * p) * 16) = *(const LAS v4u*)((LAS unsigned char*)KTT + (tid + 512 * p) * 16); }
        *(v4u*)(im + IMGG_P + tid * 16) = *(const LAS v4u*)((LAS unsigned char*)Ps + tid * 16);
    }
}

DI void gla_scan2(LAS unsigned char* lds, const unsigned char* img, float* hraw, int tid, int lane, int wave, int bx) {
    LAS bf16* QTs = (LAS bf16*)lds;
    LAS bf16* KTT = QTs + 64 * 256;
    LAS bf16* Ps = KTT + 256 * 64;
    LAS bf16* VTs = Ps + 64 * 64;
    LAS float* eb = (LAS float*)(VTs + 64 * 64);
    LAS bf16* ST0 = (LAS bf16*)(eb + 256);
    const int g = lane >> 4, r16 = lane & 15, tt = wave >> 1, eh = wave & 1;
    for (int item = bx; item < 256; item += gridDim.x) {
        const int b = item >> 5, h = (item >> 3) & 3, sl = item & 7;
        f32x4 Sacc[2][4];
#pragma unroll
        for (int a = 0; a < 2; ++a)
#pragma unroll
            for (int e = 0; e < 4; ++e) Sacc[a][e] = (f32x4){0.f, 0.f, 0.f, 0.f};
        __syncthreads();
        for (int i = tid; i < 2 * 64 * 256 / 8; i += 512) ((LAS v4u*)ST0)[i] = (v4u){0u, 0u, 0u, 0u};
        v4u rq[4], rk[4], rp, rv; float re = 0.f;
#define GLS_PREFETCH(cc) do { const int item2 = (b * 64 + (cc)) * 4 + h; const unsigned char* im = img + (size_t)item2 * IMGG_BYTES; \
            _Pragma("unroll") for (int p = 0; p < 4; ++p) { rq[p] = *(const v4u*)(im + IMGG_Q + (tid + 512 * p) * 16); rk[p] = *(const v4u*)(im + IMGG_KT + (tid + 512 * p) * 16); } \
            rp = *(const v4u*)(im + IMGG_P + tid * 16); rv = *(const v4u*)(im + IMGG_VT + sl * 8192 + tid * 16); if (tid < 256) re = ((const float*)(im + IMGG_EB))[tid]; } while (0)
        GLS_PREFETCH(0);
        for (int c = 0; c < 64; ++c) {
            const int row0 = b * SEQ + c * 64;
            LAS bf16* STc = ST0 + (c & 1) * 64 * 256; LAS bf16* STn = ST0 + ((c + 1) & 1) * 64 * 256;
            __syncthreads();
#pragma unroll
            for (int p = 0; p < 4; ++p) { *(LAS v4u*)((LAS unsigned char*)QTs + (tid + 512 * p) * 16) = rq[p]; *(LAS v4u*)((LAS unsigned char*)KTT + (tid + 512 * p) * 16) = rk[p]; }
            *(LAS v4u*)((LAS unsigned char*)Ps + tid * 16) = rp; *(LAS v4u*)((LAS unsigned char*)VTs + tid * 16) = rv;
            if (tid < 256) eb[tid] = re;
            __syncthreads();
            if (c + 1 < 64) GLS_PREFETCH(c + 1);
#pragma unroll
            for (int q2 = 0; q2 < 2; ++q2) { const int et = 2 * eh + q2, e = 16 * et + r16; f32x4 acc = (f32x4){0.f, 0.f, 0.f, 0.f};
                mma_tile<64, 64, 2>(acc, Ps, 16 * tt, VTs, 16 * et, lane); mma_tile<256, 256, 8>(acc, QTs, 16 * tt, STc, 16 * et, lane);
#pragma unroll
                for (int i = 0; i < 4; ++i) { const int t = 16 * tt + 4 * g + i; hraw[(size_t)(row0 + t) * DM + h * 512 + sl * 64 + e] = acc[i]; } }
#pragma unroll
            for (int a = 0; a < 2; ++a) { const int dt = 2 * wave + a;
                const f32x4 ev = *(const LAS f32x4*)(eb + 16 * dt + 4 * g);
#pragma unroll
                for (int et = 0; et < 4; ++et) { mma_tile<64, 64, 2>(Sacc[a][et], KTT, 16 * dt, VTs, 16 * et, lane); Sacc[a][et] = Sacc[a][et] * ev;
                    v2u w; w.x = pk2(Sacc[a][et][0], Sacc[a][et][1]); w.y = pk2(Sacc[a][et][2], Sacc[a][et][3]);
                    *(LAS v2u*)(STn + eoff<256>(16 * et + r16, 16 * dt + 4 * g)) = w; } }
        }
#undef GLS_PREFETCH
    }
}


DI void mixer_gates(const bf16* hb, const bf16* wg, const long long* ss, float* G, int lane, int wave, int bx) {
    const int g = lane >> 4, r16 = lane & 15;
    for (int t = bx * NWAVES + wave; t < MTOK / 16; t += gridDim.x * NWAVES) {
        const bf16* ap = hb + (size_t)(16 * t + r16) * DM + 8 * g; const bf16* bp = wg + (size_t)r16 * DM + 8 * g;
        f32x4 acc = (f32x4){0.f, 0.f, 0.f, 0.f};
#pragma unroll 8
        for (int kk = 0; kk < DM / 32; ++kk) { const bf16x8 a = *(const bf16x8*)(ap + 32 * kk), b = *(const bf16x8*)(bp + 32 * kk); acc = mfma16(a, b, acc); }
#pragma unroll
        for (int i = 0; i < 4; ++i) { const int row = 16 * t + 4 * g + i; G[(size_t)row * 16 + r16] = acc[i] * pg8::rstd_of(ss, row); }
    }
}

template <int HS, int ACT> DI void headnorm_gate(const float* hraw, const bf16* P1, const float* gnorm, bf16* hm, int lane, int wave, int bx) {
    constexpr int NH = DM / HS, EPL = HS / 64;
    const int gw = bx * NWAVES + wave, NGW = gridDim.x * NWAVES;
    for (int row = gw; row < MTOK; row += NGW) {
#pragma unroll
        for (int hh = 0; hh < NH; ++hh) { const int col = hh * HS + lane * EPL;
            float x[EPL]; float s = 0.f;
#pragma unroll
            for (int j = 0; j < EPL; j += 4) { const f32x4 v = *(const f32x4*)(hraw + (size_t)row * DM + col + j); x[j] = v.x; x[j + 1] = v.y; x[j + 2] = v.z; x[j + 3] = v.w; s += (v.x * v.x + v.y * v.y) + (v.z * v.z + v.w * v.w); }
            s = wave_sum(s); const float rs = rsqrtf(s * (1.0f / HS) + 1e-6f);
            unsigned outw[EPL / 2];
#pragma unroll
            for (int j = 0; j < EPL; j += 2) { const unsigned gw2 = *(const unsigned*)(P1 + (size_t)row * NQKV + 4096 + col + j); const float g0 = bflo(gw2), g1 = bfhi(gw2);
                const float a0 = ACT == 0 ? 1.0f / (1.0f + expf(-g0)) : g0 / (1.0f + expf(-g0)), a1 = ACT == 0 ? 1.0f / (1.0f + expf(-g1)) : g1 / (1.0f + expf(-g1));
                outw[j / 2] = pk2(x[j] * rs * gnorm[col + j] * a0, x[j + 1] * rs * gnorm[col + j + 1] * a1); }
            if constexpr (EPL == 4) { v2u w; w.x = outw[0]; w.y = outw[1]; *(v2u*)(hm + (size_t)row * DM + col) = w; }
            else { v4u w; w.x = outw[0]; w.y = outw[1]; w.z = outw[2]; w.w = outw[3]; *(v4u*)(hm + (size_t)row * DM + col) = w; }
        }
    }
}

DI void fox_cf(const float* G, const float* b_f, float* cf, int lane, int wave, int bx) {
    const int gw = bx * NWAVES + wave, NGW = gridDim.x * NWAVES;
    for (int seq = gw; seq < 128; seq += NGW) { const int b = seq >> 4, h = seq & 15; const float bias = b_f[h];
        const float* gp = G + ((size_t)b * SEQ + lane * 64) * 16 + h; float s = 0.f;
        for (int p = 0; p < 64; ++p) s += logsig(gp[p * 16] + bias);
        float run = wave_incl_sum(s, lane) - s;
        float* o = cf + (size_t)seq * SEQ + lane * 64;
        for (int p = 0; p < 64; ++p) { run += logsig(gp[p * 16] + bias); o[p] = run; }
    }
}

DI void fox_vt_pre(LAS unsigned char* lds, const bf16* P1, unsigned char* img, int lane, int wave, int bx) {
    LAS bf16* scr = (LAS bf16*)(lds + wave * 4096);
    const int gw = bx * NWAVES + wave, NGW = gridDim.x * NWAVES;
    for (int it = gw; it < 8192 * 4; it += NGW) {
        const int q = it & 3, jt = (it >> 2) & 63, bh = it >> 8, b = bh >> 4, h = bh & 15;
        const bf16* src = P1 + ((size_t)b * SEQ + jt * 64) * NQKV + 4096 + h * 128 + q * 32;
        v4u v[4];
#pragma unroll
        for (int p = 0; p < 4; ++p) { const int idx = lane + 64 * p, r = idx >> 2, c8 = idx & 3; v[p] = *(const v4u*)(src + (size_t)r * NQKV + c8 * 8); }
#pragma unroll
        for (int p = 0; p < 4; ++p) { const int idx = lane + 64 * p, r = idx >> 2, c8 = idx & 3;
#pragma unroll
            for (int j = 0; j < 4; ++j) { scr[eoff<64>(c8 * 8 + 2 * j, r)] = (bf16)(v[p][j] & 0xffffu); scr[eoff<64>(c8 * 8 + 2 * j + 1, r)] = (bf16)(v[p][j] >> 16); } }
        LDS_WAIT(); asm volatile("" ::: "memory");
        unsigned char* dst = img + ((size_t)(bh * 64 + jt)) * 16384 + q * 4096;
#pragma unroll
        for (int p = 0; p < 4; ++p) *(v4u*)(dst + (lane + 64 * p) * 16) = *(const LAS v4u*)((LAS unsigned char*)scr + (lane + 64 * p) * 16);
        LDS_WAIT(); asm volatile("" ::: "memory");
    }
}

DI void fox_attn2(LAS unsigned char* lds, const bf16* P1, const float* cf, const unsigned char* vimg, bf16* hm, int tid, int lane, int wave, int bx) {
    constexpr int BUFB = 16384 + 16384 + 256;
    const float LOG2E = 1.4426950408889634f, QS = 0.08838834764831845f * 1.4426950408889634f, THR = 8.0f;
    const int g = lane >> 4, r16 = lane & 15;
    const int G_ = gridDim.x;
    const int nit = (2048 + G_ - 1) / G_;
    for (int it = 0; it < nit; ++it) {
        const int u = (it & 1) ? it * G_ + (G_ - 1 - bx) : it * G_ + bx;
        if (u >= 2048) continue;
        const int qb = 15 - (u >> 7), bh = u & 127, b = bh >> 4, h = bh & 15;
        const size_t rowb = (size_t)b * SEQ; const int q0 = qb * 256 + 32 * wave;
        bf16x8 qf[2][4]; float c0[2];
#pragma unroll
        for (int tt = 0; tt < 2; ++tt) { const int t = q0 + 16 * tt + r16; c0[tt] = cf[(size_t)bh * SEQ + t] * LOG2E;
#pragma unroll
            for (int kk = 0; kk < 4; ++kk) { const v4u raw = *(const v4u*)(P1 + (rowb + t) * NQKV + h * 128 + 32 * kk + 8 * g); v4u sc;
#pragma unroll
                for (int j = 0; j < 4; ++j) sc[j] = pk2(bflo(raw[j]) * QS, bfhi(raw[j]) * QS);
                qf[tt][kk] = __builtin_bit_cast(bf16x8, sc); } }
        f32x4 oacc[8][2];
#pragma unroll
        for (int et = 0; et < 8; ++et) { oacc[et][0] = (f32x4){0.f, 0.f, 0.f, 0.f}; oacc[et][1] = (f32x4){0.f, 0.f, 0.f, 0.f}; }
        float lrun[2] = {0.f, 0.f};
        const int ntiles = 4 * (qb + 1);
        v4u kreg[2], vreg[2]; float cfreg = 0.f;
        const bf16* kbase = P1 + rowb * NQKV + 2048 + h * 128;
        const unsigned char* vbase = vimg + (size_t)bh * 64 * 16384;
#define FOX_LOAD(j) do { _Pragma("unroll") for (int p = 0; p < 2; ++p) { const int idx = tid + 512 * p, r = idx >> 4, c8 = idx & 15; \
            kreg[p] = *(const v4u*)(kbase + (size_t)(64 * (j) + r) * NQKV + c8 * 8); vreg[p] = *(const v4u*)(vbase + (size_t)(j) * 16384 + idx * 16); } \
            if (tid < 64) cfreg = -cf[(size_t)bh * SEQ + 64 * (j) + tid] * LOG2E; } while (0)
#define FOX_STORE(bufi) do { LAS unsigned char* bb = lds + (bufi) * BUFB; _Pragma("unroll") for (int p = 0; p < 2; ++p) { const int idx = tid + 512 * p, r = idx >> 4, c8 = idx & 15; \
            *(LAS v4u*)((LAS bf16*)bb + eoff<128>(r, c8 * 8)) = kreg[p]; *(LAS v4u*)(bb + 16384 + idx * 16) = vreg[p]; } \
            if (tid < 64) ((LAS float*)(bb + 32768))[tid] = cfreg; } while (0)
        __syncthreads();
        FOX_LOAD(0); FOX_STORE(0);
        if (ntiles > 1) FOX_LOAD(1);
        __syncthreads();
        for (int j = 0; j < ntiles; ++j) {
            if (j + 1 < ntiles) FOX_STORE((j + 1) & 1);
            if (j + 2 < ntiles) FOX_LOAD(j + 2);
            if (64 * j <= q0 + 31) {
                const LAS bf16* Ks = (const LAS bf16*)(lds + (j & 1) * BUFB); const LAS bf16* VTs = Ks + 64 * 128; const LAS float* cfs = (const LAS float*)(VTs + 128 * 64);
                f32x4 sacc[2][4];
#pragma unroll
                for (int st = 0; st < 4; ++st) { const f32x4 cv = *(const LAS f32x4*)(cfs + 16 * st + 4 * g);
#pragma unroll
                    for (int tt = 0; tt < 2; ++tt) sacc[tt][st] = cv + c0[tt]; }
#pragma unroll
                for (int st = 0; st < 4; ++st)
#pragma unroll
                    for (int kk = 0; kk < 4; ++kk) { const bf16x8 kf = ldf<128>(Ks, 16 * st + r16, 4 * kk + g);
                        sacc[0][st] = mfma16(kf, qf[0][kk], sacc[0][st]); sacc[1][st] = mfma16(kf, qf[1][kk], sacc[1][st]); if (kk == 3) asm volatile("" ::: "memory"); }
                if (64 * j + 63 > q0) {
#pragma unroll
                    for (int tt = 0; tt < 2; ++tt) { const int t = q0 + 16 * tt + r16;
#pragma unroll
                        for (int st = 0; st < 4; ++st)
#pragma unroll
                            for (int i = 0; i < 4; ++i) { const int s = 64 * j + 16 * st + 4 * g + i; if (s > t) sacc[tt][st][i] = -__builtin_inff(); } }
                }
                float mx[2];
#pragma unroll
                for (int tt = 0; tt < 2; ++tt) { float m = -__builtin_inff();
#pragma unroll
                    for (int st = 0; st < 4; ++st) m = fmaxf(m, fmaxf(fmaxf(sacc[tt][st][0], sacc[tt][st][1]), fmaxf(sacc[tt][st][2], sacc[tt][st][3])));
                    m = fmaxf(m, __shfl_xor(m, 16)); m = fmaxf(m, __shfl_xor(m, 32)); mx[tt] = m; }
                if (__any(mx[0] > THR || mx[1] > THR)) {
#pragma unroll
                    for (int tt = 0; tt < 2; ++tt) { const float sh = fmaxf(mx[tt], 0.f), f = __builtin_amdgcn_exp2f(-sh);
                        c0[tt] -= sh; lrun[tt] *= f;
#pragma unroll
                        for (int st = 0; st < 4; ++st) sacc[tt][st] = sacc[tt][st] - sh;
#pragma unroll
                        for (int et = 0; et < 8; ++et) oacc[et][tt] = oacc[et][tt] * f; }
                }
#pragma unroll
                for (int tt = 0; tt < 2; ++tt) { float ls = 0.f;
#pragma unroll
                    for (int st = 0; st < 4; ++st)
#pragma unroll
                        for (int i = 0; i < 4; ++i) { const float p = __builtin_amdgcn_exp2f(sacc[tt][st][i]); sacc[tt][st][i] = p; ls += p; }
                    lrun[tt] += ls; }
#pragma unroll
                for (int ks = 0; ks < 2; ++ks) { bf16x8 pb[2];
#pragma unroll
                    for (int tt = 0; tt < 2; ++tt) { v4u w; w.x = pk2(sacc[tt][2 * ks][0], sacc[tt][2 * ks][1]); w.y = pk2(sacc[tt][2 * ks][2], sacc[tt][2 * ks][3]);
                        w.z = pk2(sacc[tt][2 * ks + 1][0], sacc[tt][2 * ks + 1][1]); w.w = pk2(sacc[tt][2 * ks + 1][2], sacc[tt][2 * ks + 1][3]); pb[tt] = __builtin_bit_cast(bf16x8, w); }
#pragma unroll
                    for (int et = 0; et < 8; ++et) { const int e = 16 * et + r16;
                        const v2u lo = *(const LAS v2u*)(VTs + eoff<64>(e, 32 * ks + 4 * g)), hi = *(const LAS v2u*)(VTs + eoff<64>(e, 32 * ks + 16 + 4 * g));
                        v4u aw; aw.x = lo.x; aw.y = lo.y; aw.z = hi.x; aw.w = hi.y; const bf16x8 va = __builtin_bit_cast(bf16x8, aw);
                        oacc[et][0] = mfma16(va, pb[0], oacc[et][0]); oacc[et][1] = mfma16(va, pb[1], oacc[et][1]); if (et & 1) asm volatile("" ::: "memory"); } }
            }
            __syncthreads();
        }
#undef FOX_LOAD
#undef FOX_STORE
#pragma unroll
        for (int tt = 0; tt < 2; ++tt) { float l = lrun[tt]; l += __shfl_xor(l, 16); l += __shfl_xor(l, 32); const float inv = 1.0f / l;
            bf16* orow = hm + (rowb + q0 + 16 * tt + r16) * DM + h * 128 + 4 * g;
#pragma unroll
            for (int et = 0; et < 8; ++et) { v2u w; w.x = pk2(oacc[et][tt][0] * inv, oacc[et][tt][1] * inv); w.y = pk2(oacc[et][tt][2] * inv, oacc[et][tt][3] * inv); *(v2u*)(orow + 16 * et) = w; } }
    }
}


DI void final_norm(float* out, const long long* ss, const float* gfin, int lane, int wave, int bx) {
    const int gw = bx * NWAVES + wave, NGW = gridDim.x * NWAVES;
    for (int m = gw; m < MTOK; m += NGW) { const float rs = pg8::rstd_of(ss, m);
        f32x4* xr = (f32x4*)(out + (size_t)m * DM) + lane; const f32x4* gr = (const f32x4*)gfin + lane;
#pragma unroll
        for (int j = 0; j < 8; ++j) { const f32x4 v = xr[64 * j], gg = gr[64 * j]; xr[64 * j] = v * rs * gg; } }
}

#define PH(p) if (lo <= (p) && (p) < hi && (ran ? (xcd_barrier(bar), true) : (ran = true)))
#define TID() int tid = threadIdx.x; asm volatile("" : "+v"(tid)); const int lane = tid & 63, wave = __builtin_amdgcn_readfirstlane(tid >> 6); int bx = blockIdx.x; asm volatile("" : "+s"(bx)); (void)lane; (void)wave; (void)bx
#define WSP(T, off) ((T*)(ka->ws + (off)))
template <int j> DI void subblock(LAS unsigned char* lds, const XcdBarrier& bar, const int lo, const int hi, bool& ran) {
    {
        constexpr int layer = j / 3, typ = j - 3 * layer, base = 1 + 5 * j;
        if constexpr (typ != 1) {
            PH(base) { TID(); KArgs ka = kargs(); const int mi = layer * 2 + (typ >> 1);
                pg8::Gemm gm{WSP(bf16, WS_HB), WSP(bf16, WS_WUP) + (size_t)mi * NUP * DM, MTOK, NUP, DM}; pg8::StaticOrder S; S.init(MTOK, NUP, gridDim.x, bx);
                pg8::EpiSwiGLU E{WSP(bf16, WS_ACT), WSP(long long, WS_SS) + (size_t)j * MTOK, DFF};
                pg8::gemm_phase<pg8::EpiSwiGLU, pg8::StaticOrder, PG8_ALIGN, PG8_SP2>(lds, gm, S, E); }
        } else {
            constexpr int kind = layer % 3, ji = layer / 3;
            PH(base) { TID(); KArgs ka = kargs();
                mixer_gates(WSP(bf16, WS_HB), WSP(bf16, WS_WIN) + ((size_t)layer * NINP + NQKV) * DM, WSP(long long, WS_SS) + (size_t)j * MTOK, WSP(float, WS_G), lane, wave, bx);
                pg8::Gemm gm{WSP(bf16, WS_HB), WSP(bf16, WS_WIN) + (size_t)layer * NINP * DM, MTOK, NQKV, DM}; pg8::StaticOrder S; S.init(MTOK, NQKV, gridDim.x, bx);
                pg8::EpiMixIn E{WSP(bf16, WS_P1), WSP(long long, WS_SS) + (size_t)j * MTOK};
                pg8::gemm_phase<pg8::EpiMixIn, pg8::StaticOrder, PG8_ALIGN, PG8_SP2>(lds, gm, S, E); }
            PH(base + 1) { TID(); KArgs ka = kargs();
                if constexpr (kind == 0) for (int rep = 0; rep < REP_MLSTM; ++rep) mlstm_pre(lds, WSP(bf16, WS_P1), WSP(float, WS_G), ka->in[6] + ji * 16, WSP(unsigned char, WS_ACT), tid, lane, wave, bx);
                else if constexpr (kind == 1) { fox_cf(WSP(float, WS_G), ka->in[10] + ji * 16, WSP(float, WS_CF), lane, wave, bx); fox_vt_pre(lds, WSP(bf16, WS_P1), WSP(unsigned char, WS_ACT), lane, wave, bx); }
                else for (int rep = 0; rep < REP_GLA; ++rep) gla_pre(lds, WSP(bf16, WS_P1), WSP(float, WS_G), ka->in[13] + (size_t)ji * 16 * 1024, ka->in[14] + ji * 1024, WSP(unsigned char, WS_ACT), tid, lane, wave, bx);
            }
            PH(base + 2) { TID(); KArgs ka = kargs();
                if constexpr (kind == 0) for (int rep = 0; rep < REP_MLSTM; ++rep) mlstm_scan2(lds, WSP(bf16, WS_P1), WSP(unsigned char, WS_ACT), WSP(float, WS_HRAW), tid, lane, wave, bx);
                else if constexpr (kind == 1) for (int rep = 0; rep < REP_FOX; ++rep) fox_attn2(lds, WSP(bf16, WS_P1), WSP(float, WS_CF), WSP(unsigned char, WS_ACT), WSP(bf16, WS_HM), tid, lane, wave, bx);
                else for (int rep = 0; rep < REP_GLA; ++rep) gla_scan2(lds, WSP(unsigned char, WS_ACT), WSP(float, WS_HRAW), tid, lane, wave, bx);
            }
            if constexpr (kind != 1) { PH(base + 3) { TID(); KArgs ka = kargs();
                if constexpr (kind == 0) headnorm_gate<256, 0>(WSP(float, WS_HRAW), WSP(bf16, WS_P1), ka->in[7] + ji * DM, WSP(bf16, WS_HM), lane, wave, bx);
                else headnorm_gate<512, 1>(WSP(float, WS_HRAW), WSP(bf16, WS_P1), ka->in[15] + ji * DM, WSP(bf16, WS_HM), lane, wave, bx);
            } }
        }
        PH(base + 4) { TID(); KArgs ka = kargs();
            pg8::Gemm gm; float scale;
            if constexpr (typ != 1) { const int mi = layer * 2 + (typ >> 1); gm = pg8::Gemm{WSP(bf16, WS_ACT), WSP(bf16, WS_WDN) + (size_t)mi * DM * DFF, MTOK, DM, DFF}; scale = 0.5f; }
            else { gm = pg8::Gemm{WSP(bf16, WS_HM), WSP(bf16, WS_WOUT) + (size_t)layer * DM * DM, MTOK, DM, DM}; scale = 1.0f; }
            pg8::StaticOrder S; S.init(MTOK, DM, gridDim.x, bx);
            pg8::EpiResid E{(j == 0) ? ka->in[0] : (const float*)ka->out, ka->out, WSP(bf16, WS_HB), WSP(long long, WS_SS) + (size_t)(j + 1) * MTOK, scale};
            pg8::gemm_phase<pg8::EpiResid, pg8::StaticOrder, PG8_ALIGN, PG8_SP2>(lds, gm, S, E);
        }
    }
}

__global__ void __launch_bounds__(NWAVES * 64, 2) trunk_fwd(Args args) {
    extern __shared__ __attribute__((aligned(16))) unsigned char lds_raw[];
    LAS unsigned char* lds = (LAS unsigned char*)lds_raw;
    volatile LAS unsigned* MISC = (volatile LAS unsigned*)(lds + MISC_OFF);
    for (int u = threadIdx.x; u < (LDS_BYTES - MISC_OFF) / 4; u += NWAVES * 64) ((LAS unsigned*)(lds + MISC_OFF))[u] = 0u;
    __syncthreads();
    XcdBarrier bar = xcd_barrier_post((unsigned*)(args.ws + WS_CTL) + CW_BAR, MISC + 8);
    const int lo = args.ph_lo, hi = args.ph_hi; bool ran = false;

    PH(0) { TID(); for (int rep = 0; rep < REP_PRO; ++rep) { prologue(lds, lane, wave, bx); __syncthreads(); } }

    subblock<0>(lds, bar, lo, hi, ran); subblock<1>(lds, bar, lo, hi, ran); subblock<2>(lds, bar, lo, hi, ran); subblock<3>(lds, bar, lo, hi, ran);
    subblock<4>(lds, bar, lo, hi, ran); subblock<5>(lds, bar, lo, hi, ran); subblock<6>(lds, bar, lo, hi, ran); subblock<7>(lds, bar, lo, hi, ran);
    subblock<8>(lds, bar, lo, hi, ran); subblock<9>(lds, bar, lo, hi, ran); subblock<10>(lds, bar, lo, hi, ran); subblock<11>(lds, bar, lo, hi, ran);
    PH(NPHASE - 1) { TID(); KArgs ka = kargs(); final_norm(ka->out, WSP(long long, WS_SS) + (size_t)NSUB * MTOK, ka->in[17], lane, wave, bx); }
#undef WSP
#undef PH
}

static bool phase_exists(int p) {
    if (p == 0 || p == NPHASE - 1) return true;
    const int j = (p - 1) / 5, k = (p - 1) % 5, typ = j % 3;
    if (k == 0 || k == 4) return true;
    if (typ != 1) return false;
    if (k == 3) return ((j / 3) % 3) != 1;
    return true;
}
extern "C" void kernel_launch(void* const* d_in, const int* in_sizes, int n_in, void* d_out, int out_size, void* d_ws, size_t ws_size, hipStream_t stream) {
    static int grid = 0;
    if (grid == 0) {
        if (n_in != 18 || in_sizes[0] != MTOK * DM || out_size != MTOK * DM || ws_size < WS_END) { fprintf(stderr, "kernel_launch: unexpected shapes (n_in %d, in0 %d, out %d, ws %zu < %zu)\n", n_in, n_in > 0 ? in_sizes[0] : -1, out_size, ws_size, (size_t)WS_END); grid = -1; return; }
        int dev = 0, cus = 0, per_cu = 0;
        if (hipGetDevice(&dev) != hipSuccess || hipDeviceGetAttribute(&cus, hipDeviceAttributeMultiprocessorCount, dev) != hipSuccess) { grid = -1; return; }
        if (hipFuncSetAttribute((const void*)trunk_fwd, hipFuncAttributeMaxDynamicSharedMemorySize, LDS_BYTES) != hipSuccess) { fprintf(stderr, "kernel_launch: hipFuncSetAttribute failed\n"); grid = -1; return; }
        if (hipOccupancyMaxActiveBlocksPerMultiprocessor(&per_cu, (const void*)trunk_fwd, NWAVES * 64, LDS_BYTES) != hipSuccess || per_cu < 1) fprintf(stderr, "kernel_launch: occupancy query says %d\n", per_cu);
        (void)hipGetLastError();
        grid = cus;
    }
    if (grid < 0) return;
    if (hipMemsetAsync((char*)d_ws + WS_CTL, 0, CTL_ZERO_BYTES, stream) != hipSuccess) return;
    Args a{};
    for (int i = 0; i < 18; ++i) a.in[i] = (const float*)d_in[i];
    a.out = (float*)d_out; a.ws = (unsigned char*)d_ws;
#if MK_PER_PHASE
    for (int p = 0; p < NPHASE; ++p) { if (!phase_exists(p)) continue; a.ph_lo = p; a.ph_hi = p + 1; hipLaunchKernelGGL(trunk_fwd, dim3(grid), dim3(NWAVES * 64), LDS_BYTES, stream, a); }
#else
    a.ph_lo = 0; a.ph_hi = NPHASE; hipLaunchKernelGGL(trunk_fwd, dim3(grid), dim3(NWAVES * 64), LDS_BYTES, stream, a);
#endif
    (void)phase_exists;
}
```

```cpp
#include <hip/hip_runtime.h>
#include <cstdio>
#include <cstdint>
namespace pg8 {
#define PG8_LAS __attribute__((address_space(3)))
typedef unsigned short bf16_t;
typedef short bf16x8 __attribute__((ext_vector_type(8)));
typedef float f32x4 __attribute__((ext_vector_type(4)));
typedef unsigned u32x4 __attribute__((ext_vector_type(4)));
constexpr int BM = 256, BK = 64, HALF = 128, HTB = HALF * BK * 2  , STAGE_BYTES = 8 * HTB, NXCD = 8, WGM = 8;

__host__ __device__ __forceinline__ int lds_byte(int r, int c) { const int st = (r >> 4) * 2 + (c >> 5), rr = r & 15, cc = c & 31, ob = rr * 64 + cc * 2; return st * 1024 + (ob ^ (((ob >> 9) & 1) << 5)); }
__host__ __device__ __forceinline__ void stage_rc(int b, int& R, int& C) { const int st = b / 1024, sb = b % 1024, swz = sb ^ (((sb >> 9) & 1) << 5); R = (st >> 1) * 16 + swz / 64; C = (st & 1) * 32 + (swz % 64) / 2; }
__host__ __device__ __forceinline__ int perm32(int rho) { const int n = rho >> 4, i = rho & 15; return 8 * (i >> 2) + 4 * n + (i & 3); }

struct Unit { int pm, pn; };
struct Gemm { const bf16_t* A; const bf16_t* Bt; int M, N, K; };

struct StaticOrder {
    int nM, nN, nwg, G, c;
    __host__ __device__ void init(int M, int N, int G_, int c_) { nM = M / BM; nN = N / BM; nwg = nM * nN; G = G_; c = c_; }
    __host__ __device__ bool next(int i, Unit& u) const {
        const long L = (long)i * G + c; if (L >= nwg) return false;
        int wgid = (int)L; { const int q = nwg / NXCD, r = nwg % NXCD, xcd = wgid % NXCD, off = wgid / NXCD; wgid = (xcd < r ? xcd * (q + 1) : r * (q + 1) + (xcd - r) * q) + off; }
        const int nig = WGM * nN, gid = wgid / nig, fm = gid * WGM, gsz = (nM - fm) < WGM ? (nM - fm) : WGM;
        u.pm = fm + ((wgid % nig) % gsz); u.pn = (wgid % nig) / gsz; return true;
    }
    __device__ __forceinline__ void a_ready(const Unit&) const {}
    __device__ __forceinline__ void done(const Unit&) const {}
};

__device__ __forceinline__ unsigned cvt_pk_bf16(float lo, float hi) { unsigned r; asm volatile("v_cvt_pk_bf16_f32 %0, %1, %2" : "=v"(r) : "v"(lo), "v"(hi)); return r; }
constexpr float RMS_EPS_F = 1e-6f, SS_FIX = 1048576.0f, SS_UNFIX_D = 1.0f / (1048576.0f * 2048.0f);
typedef long long ss_t;
__device__ __forceinline__ float rstd_of(const ss_t* ss, int row) { return rsqrtf((float)ss[row] * SS_UNFIX_D + RMS_EPS_F); }
template <class Sched> __device__ __forceinline__ int rstd_table_fill(const Sched& S, const ss_t* ss, PG8_LAS unsigned char* ext, int tid) {
    PG8_LAS float* tab = (PG8_LAS float*)ext; int key0 = -1, key1 = -1, bad = 0; Unit u;
    for (int i = 0; S.next(i, u); ++i) { const int slot = (u.pm >> 3) & 1; const int key = slot ? key1 : key0;
        if (key == u.pm) continue;
        if (key >= 0) { bad = 1; continue; }
        if (slot) key1 = u.pm; else key0 = u.pm;
        if (tid < 256) tab[slot * 256 + tid] = rstd_of(ss, u.pm * BM + tid); }
    asm volatile("s_waitcnt lgkmcnt(0)" ::: "memory"); __builtin_amdgcn_s_barrier(); asm volatile("" ::: "memory");
    return bad;
}
__device__ __forceinline__ float rstd_get(const ss_t* ss, const Unit& u, int row, int pf, const PG8_LAS unsigned char* ext) {
    return pf ? rstd_of(ss, row) : ((const PG8_LAS float*)ext)[((u.pm >> 3) & 1) * 256 + (row - u.pm * BM)];
}
struct EpiSwiGLU {
    static constexpr bool PERM = true, AFTER_DRAIN = false;
    bf16_t* O; const ss_t* ss; int ldo;
    template <class Sched> __device__ __forceinline__ int prepare(const Sched& S, PG8_LAS unsigned char* ext, int tid) const { return rstd_table_fill(S, ss, ext, tid); }
    __device__ __forceinline__ void operator()(const f32x4 (&acc)[2][2][4][2], const Unit& u, int wr, int wc, int fr, int fq, int pf, const PG8_LAS unsigned char* ext) const {
        const int row0 = u.pm * BM + wr * 64 + fr, col0 = u.pn * HALF + wc * 32 + 8 * fq;
#pragma unroll
        for (int ai = 0; ai < 2; ++ai)
#pragma unroll
            for (int m = 0; m < 4; ++m) {
                const int row = row0 + ai * HALF + m * 16;
                const float rs = rstd_get(ss, u, row, pf, ext);
                float o[8];
#pragma unroll
                for (int n = 0; n < 2; ++n)
#pragma unroll
                    for (int j = 0; j < 4; ++j) { const float a = acc[ai][0][m][n][j] * rs, b = acc[ai][1][m][n][j] * rs;
                        o[4 * n + j] = a * b * __builtin_amdgcn_rcpf(1.0f + __expf(-a)); }
                u32x4 w; w.x = cvt_pk_bf16(o[0], o[1]); w.y = cvt_pk_bf16(o[2], o[3]); w.z = cvt_pk_bf16(o[4], o[5]); w.w = cvt_pk_bf16(o[6], o[7]);
                *(u32x4*)(O + (size_t)row * ldo + col0) = w;
            }
    }
};
struct EpiMixIn {
    static constexpr bool PERM = true, AFTER_DRAIN = false;
    bf16_t* O; const ss_t* ss;
    template <class Sched> __device__ __forceinline__ int prepare(const Sched& S, PG8_LAS unsigned char* ext, int tid) const { return rstd_table_fill(S, ss, ext, tid); }
    __device__ __forceinline__ void operator()(const f32x4 (&acc)[2][2][4][2], const Unit& u, int wr, int wc, int fr, int fq, int pf, const PG8_LAS unsigned char* ext) const {
        const int row0 = u.pm * BM + wr * 64 + fr, col0 = u.pn * BM + wc * 32 + 8 * fq;
#pragma unroll
        for (int ai = 0; ai < 2; ++ai)
#pragma unroll
            for (int m = 0; m < 4; ++m) {
                const int row = row0 + ai * HALF + m * 16;
                const float rs = rstd_get(ss, u, row, pf, ext);
#pragma unroll
                for (int bj = 0; bj < 2; ++bj) { const f32x4 v0 = acc[ai][bj][m][0] * rs, v1 = acc[ai][bj][m][1] * rs;
                    u32x4 w; w.x = cvt_pk_bf16(v0[0], v0[1]); w.y = cvt_pk_bf16(v0[2], v0[3]); w.z = cvt_pk_bf16(v1[0], v1[1]); w.w = cvt_pk_bf16(v1[2], v1[3]);
                    *(u32x4*)(O + (size_t)row * 6144 + col0 + bj * HALF) = w; }
            }
    }
};
struct EpiResid {
    static constexpr bool PERM = false, AFTER_DRAIN = false;
    const float* res; float* hout; bf16_t* hb; ss_t* ssn; float scale;
    template <class Sched> __device__ __forceinline__ int prepare(const Sched&, PG8_LAS unsigned char*, int) const { return 0; }
    __device__ __forceinline__ void operator()(const f32x4 (&acc)[2][2][4][2], const Unit& u, int wr, int wc, int fr, int fq, int pf, const PG8_LAS unsigned char* ext) const {
        typedef unsigned u32x2v __attribute__((ext_vector_type(2)));
        const int row0 = u.pm * BM + wr * 64 + fr, col0 = u.pn * BM + wc * 32 + 4 * fq;
        f32x4 rb[3][4];
#define PG8_LDG(gi, buf) do { const size_t off_ = (size_t)(row0 + ((gi) >> 2) * HALF + ((gi) & 3) * 16) * 2048 + col0; \
            _Pragma("unroll") for (int q_ = 0; q_ < 4; ++q_) buf[q_] = *(const f32x4*)(res + off_ + (q_ >> 1) * HALF + (q_ & 1) * 16); } while (0)
        PG8_LDG(0, rb[0]); PG8_LDG(1, rb[1]);
#pragma unroll
        for (int gi = 0; gi < 8; ++gi) {
            if (gi + 2 < 8) PG8_LDG(gi + 2, rb[(gi + 2) % 3]);
            const int ai = gi >> 2, m = gi & 3;
            const int row = row0 + ai * HALF + m * 16; const size_t off = (size_t)row * 2048 + col0; float sq = 0.f;
#pragma unroll
            for (int q = 0; q < 4; ++q) { const int bj = q >> 1, n = q & 1; const size_t o2 = off + bj * HALF + n * 16;
                const f32x4 hn = rb[gi % 3][q] + acc[ai][bj][m][n] * scale;
                *(f32x4*)(hout + o2) = hn; u32x2v w; w.x = cvt_pk_bf16(hn[0], hn[1]); w.y = cvt_pk_bf16(hn[2], hn[3]); *(u32x2v*)(hb + o2) = w;
                sq += (hn[0] * hn[0] + hn[1] * hn[1]) + (hn[2] * hn[2] + hn[3] * hn[3]); }
            sq += __shfl_xor(sq, 16); sq += __shfl_xor(sq, 32);
            if (fq == 0) atomicAdd((unsigned long long*)(ssn + row), (unsigned long long)__float2ll_rn(sq * SS_FIX));
        }
#undef PG8_LDG
    }
};

template <class Epi, class Sched, bool ALIGN_EPI = false, bool SP2 = false>
__device__ __forceinline__ void gemm_phase(PG8_LAS unsigned char* lds, const Gemm g, const Sched& S, const Epi& E) {
    int tid_ = threadIdx.x; asm volatile("" : "+v"(tid_));
    const int tid = tid_, wid = __builtin_amdgcn_readfirstlane(tid >> 6), lane = tid & 63, wr = wid >> 2, wc = wid & 3, fr = lane & 15, fq = lane >> 4;
    const int K = g.K, nt = K / BK;
    unsigned voffA[2], voffB[2];
#pragma unroll
    for (int i = 0; i < 2; ++i) { int R, C; stage_rc(tid * 16 + i * 8192, R, C); const int Rb = Epi::PERM ? ((R & ~31) + perm32(R & 31)) : R;
        voffA[i] = (unsigned)(R * K + C) * 2u; voffB[i] = (unsigned)(Rb * K + C) * 2u; }
    const size_t kstep = (size_t)(BK * 2);
    const size_t hstep = (size_t)HALF * K * 2;
    const size_t tstep = 2 * hstep;
    const unsigned ldsw = (unsigned)wid * 1024u;
    const int aoff = lds_byte(wr * 64 + fr, fq * 8), boff = lds_byte(wc * 32 + fr, fq * 8);
#define PG8_SA(b, h) (((b) * 2 + (h)) * HTB)
#define PG8_SB(b, h) ((4 + (b) * 2 + (h)) * HTB)
#define PG8_STAGE(bufoff, gbase, voff) do { _Pragma("unroll") for (int _i = 0; _i < 2; ++_i) \
        __builtin_amdgcn_global_load_lds((const unsigned*)((const char*)(gbase) + (voff)[_i]), (PG8_LAS unsigned*)(lds + (bufoff) + ldsw + _i * 8192), 16, 0, 0); } while (0)
#define PG8_LDA(dst, b, h) do { _Pragma("unroll") for (int m = 0; m < 4; ++m) _Pragma("unroll") for (int k = 0; k < 2; ++k) dst[m][k] = *(const PG8_LAS bf16x8*)(lds + PG8_SA(b, h) + aoff + m * 2048 + k * 1024); } while (0)
#define PG8_LDB(dst, b, h) do { _Pragma("unroll") for (int n = 0; n < 2; ++n) _Pragma("unroll") for (int k = 0; k < 2; ++k) dst[n][k] = *(const PG8_LAS bf16x8*)(lds + PG8_SB(b, h) + boff + n * 2048 + k * 1024); } while (0)
#define PG8_MMA(ai, bj, At, Bt) do { __builtin_amdgcn_s_setprio(1); _Pragma("unroll") for (int m = 0; m < 4; ++m) _Pragma("unroll") for (int n = 0; n < 2; ++n) _Pragma("unroll") for (int k = 0; k < 2; ++k) \
        acc[ai][bj][m][n] = __builtin_amdgcn_mfma_f32_16x16x32_bf16(Bt[n][k], At[m][k], acc[ai][bj][m][n], 0, 0, 0); __builtin_amdgcn_s_setprio(0); } while (0)
#define PG8_WAIT_V(n) asm volatile("s_waitcnt vmcnt(" #n ")" ::: "memory")
#define PG8_WAIT_L(n) asm volatile("s_waitcnt lgkmcnt(" #n ")" ::: "memory")
#define PG8_BAR __builtin_amdgcn_s_barrier()
#define PG8_SCHED __builtin_amdgcn_sched_barrier(0)
    const int pf = E.prepare(S, lds + STAGE_BYTES, tid);
    Unit cur, nxt; int ui = 0;
    if (!S.next(0, cur)) return;
    f32x4 acc[2][2][4][2];
#pragma unroll
    for (int a = 0; a < 2; ++a)
#pragma unroll
        for (int b = 0; b < 2; ++b)
#pragma unroll
            for (int m = 0; m < 4; ++m)
#pragma unroll
                for (int n = 0; n < 2; ++n) acc[a][b][m][n] = (f32x4){0.f, 0.f, 0.f, 0.f};
    bf16x8 At[4][2], B0[2][2], B1[2][2];
    const char* cA = (const char*)g.A + (size_t)cur.pm * tstep; const char* cB = (const char*)g.Bt + (size_t)cur.pn * tstep;
    S.a_ready(cur);
    if constexpr (SP2) {
        PG8_STAGE(PG8_SB(0, 0), cB, voffB); PG8_STAGE(PG8_SB(0, 1), cB + hstep, voffB); PG8_STAGE(PG8_SA(0, 0), cA, voffA); PG8_STAGE(PG8_SA(0, 1), cA + hstep, voffA);
        if (wr == 1) PG8_BAR;
        PG8_WAIT_V(2); PG8_BAR;
        PG8_STAGE(PG8_SB(1, 0), cB + kstep, voffB); PG8_STAGE(PG8_SA(1, 0), cA + kstep, voffA); PG8_STAGE(PG8_SB(1, 1), cB + hstep + kstep, voffB);
        PG8_WAIT_V(6); PG8_BAR;
    } else {
        PG8_STAGE(PG8_SB(0, 0), cB, voffB); PG8_STAGE(PG8_SA(0, 0), cA, voffA); PG8_STAGE(PG8_SB(0, 1), cB + hstep, voffB); PG8_STAGE(PG8_SA(0, 1), cA + hstep, voffA);
        if (wr == 1) PG8_BAR;
        PG8_WAIT_V(4); PG8_BAR;
        PG8_STAGE(PG8_SB(1, 0), cB + kstep, voffB); PG8_STAGE(PG8_SA(1, 0), cA + kstep, voffA); PG8_STAGE(PG8_SB(1, 1), cB + hstep + kstep, voffB);
        PG8_WAIT_V(6); PG8_BAR;
    }
    for (;;) {
        const bool has_next = S.next(ui + 1, nxt);
        const char* nA = has_next ? (const char*)g.A + (size_t)nxt.pm * tstep : cA; const char* nB = has_next ? (const char*)g.Bt + (size_t)nxt.pn * tstep : cB;
        for (int t = 0; t < nt; t += 2) {
            const bool last = (t == nt - 2);
            const char* a1 = cA + (size_t)(t + 1) * kstep;
            const char* a2 = last ? nA : cA + (size_t)(t + 2) * kstep; const char* b2 = last ? nB : cB + (size_t)(t + 2) * kstep;
            const char* a3 = a2 + kstep; const char* b3 = b2 + kstep;
            if (last && has_next) S.a_ready(nxt);
            if constexpr (SP2) {
            PG8_LDB(B0, 0, 0); PG8_LDB(B1, 0, 1); PG8_SCHED; PG8_LDA(At, 0, 0); PG8_STAGE(PG8_SA(1, 1), a1 + hstep, voffA);
            PG8_WAIT_V(8); PG8_WAIT_L(0); PG8_BAR; PG8_MMA(0, 0, At, B0); PG8_MMA(0, 1, At, B1); PG8_BAR; PG8_SCHED;
            PG8_LDA(At, 0, 1); PG8_STAGE(PG8_SB(0, 0), b2, voffB); PG8_STAGE(PG8_SB(0, 1), b2 + hstep, voffB); PG8_STAGE(PG8_SA(0, 0), a2, voffA);
            PG8_WAIT_V(8); PG8_WAIT_L(0); PG8_BAR; PG8_MMA(1, 0, At, B0); PG8_MMA(1, 1, At, B1); PG8_BAR; PG8_SCHED;
            PG8_LDB(B0, 1, 0); PG8_LDB(B1, 1, 1); PG8_SCHED; PG8_LDA(At, 1, 0); PG8_STAGE(PG8_SA(0, 1), a2 + hstep, voffA);
            PG8_WAIT_V(8); PG8_WAIT_L(0); PG8_BAR; PG8_MMA(0, 0, At, B0); PG8_MMA(0, 1, At, B1); PG8_BAR; PG8_SCHED;
            PG8_LDA(At, 1, 1); PG8_STAGE(PG8_SB(1, 0), b3, voffB); PG8_STAGE(PG8_SB(1, 1), b3 + hstep, voffB); PG8_STAGE(PG8_SA(1, 0), a3, voffA);
            PG8_WAIT_V(8); PG8_WAIT_L(0); PG8_BAR; PG8_MMA(1, 0, At, B0); PG8_MMA(1, 1, At, B1); PG8_BAR; PG8_SCHED;
            } else {
            PG8_LDB(B0, 0, 0); PG8_SCHED; PG8_LDA(At, 0, 0); PG8_STAGE(PG8_SA(1, 1), a1 + hstep, voffA);
            PG8_WAIT_L(8); PG8_BAR; PG8_WAIT_L(0); PG8_MMA(0, 0, At, B0); PG8_BAR; PG8_SCHED;
            PG8_LDB(B1, 0, 1); PG8_STAGE(PG8_SB(0, 0), b2, voffB);
            PG8_BAR; PG8_WAIT_L(0); PG8_MMA(0, 1, At, B1); PG8_BAR;
            PG8_LDA(At, 0, 1); PG8_STAGE(PG8_SA(0, 0), a2, voffA);
            PG8_BAR; PG8_WAIT_L(0); PG8_MMA(1, 0, At, B0); PG8_BAR; PG8_SCHED;
            PG8_STAGE(PG8_SB(0, 1), b2 + hstep, voffB);
            PG8_WAIT_V(6); PG8_BAR; PG8_MMA(1, 1, At, B1); PG8_BAR;
            PG8_LDB(B0, 1, 0); PG8_SCHED; PG8_LDA(At, 1, 0); PG8_STAGE(PG8_SA(0, 1), a2 + hstep, voffA);
            PG8_WAIT_L(8); PG8_BAR; PG8_WAIT_L(0); PG8_MMA(0, 0, At, B0); PG8_BAR; PG8_SCHED;
            PG8_LDB(B1, 1, 1); PG8_STAGE(PG8_SB(1, 0), b3, voffB);
            PG8_BAR; PG8_WAIT_L(0); PG8_MMA(0, 1, At, B1); PG8_BAR;
            PG8_LDA(At, 1, 1); PG8_STAGE(PG8_SA(1, 0), a3, voffA);
            PG8_BAR; PG8_WAIT_L(0); PG8_MMA(1, 0, At, B0); PG8_BAR; PG8_SCHED;
            PG8_STAGE(PG8_SB(1, 1), b3 + hstep, voffB);
            PG8_WAIT_V(6); PG8_BAR; PG8_MMA(1, 1, At, B1); PG8_BAR;
            }
        }
        if constexpr (ALIGN_EPI) { if (wr == 0) PG8_BAR; }
        if constexpr (!Epi::AFTER_DRAIN) { E(acc, cur, wr, wc, fr, fq, pf, lds + STAGE_BYTES); S.done(cur); }
        if (!has_next) break;
#pragma unroll
        for (int a = 0; a < 2; ++a)
#pragma unroll
            for (int b = 0; b < 2; ++b)
#pragma unroll
                for (int m = 0; m < 4; ++m)
#pragma unroll
                    for (int n = 0; n < 2; ++n) acc[a][b][m][n] = (f32x4){0.f, 0.f, 0.f, 0.f};
        cur = nxt; cA = nA; cB = nB; ++ui;
        if constexpr (ALIGN_EPI) { if (wr == 1) PG8_BAR; }
    }
    PG8_WAIT_V(0);
    if constexpr (!ALIGN_EPI) { if (wr == 0) PG8_BAR; }
    PG8_BAR;
    if constexpr (Epi::AFTER_DRAIN) { E.fused(acc, cur, wr, wc, fr, fq, lds, wid, lane); S.done(cur); }
#undef PG8_SA
#undef PG8_SB
#undef PG8_STAGE
#undef PG8_LDA
#undef PG8_LDB
#undef PG8_MMA
#undef PG8_WAIT_V
#undef PG8_WAIT_L
#undef PG8_BAR
#undef PG8_SCHED
}
}

#ifndef PG8_SP2
#define PG8_SP2 true
#endif
#ifndef PG8_ALIGN
#define PG8_ALIGN true
#endif
#ifndef REP_PRO
#define REP_PRO 1
#endif
#ifndef REP_MLSTM
#define REP_MLSTM 1
#endif
#ifndef REP_FOX
#define REP_FOX 1
#endif
#ifndef REP_GLA
#define REP_GLA 1
#endif
#ifndef MK_PER_PHASE
#define MK_PER_PHASE 0
#endif

constexpr int DM = 2048, BATCH = 8, SEQ = 4096, MTOK = BATCH * SEQ, DEPTH = 4, DFF = 5632, NUP = 2 * DFF, NIN = 6160, NINP = 6400, NQKV = 6144;
constexpr int NWAVES = 8;
constexpr int NSUB = 3 * DEPTH;
constexpr int NPHASE = 2 + 5 * NSUB;

constexpr size_t MiB = 1u << 20;
constexpr size_t WS_CTL = 0, CTL_ZERO_BYTES = 5 * MiB;
constexpr size_t WS_SS = 1 * MiB;
constexpr size_t WS_WUP = 8 * MiB;
constexpr size_t WS_WDN = WS_WUP + 352 * MiB;
constexpr size_t WS_WIN = WS_WDN + 176 * MiB;
constexpr size_t WS_WOUT = WS_WIN + 100 * MiB;
constexpr size_t WS_HB = WS_WOUT + 32 * MiB;
constexpr size_t WS_ACT = WS_HB + 128 * MiB;
constexpr size_t WS_P1 = WS_ACT + 352 * MiB;
constexpr size_t WS_G = WS_P1 + 384 * MiB;
constexpr size_t WS_HRAW = WS_G + 2 * MiB;
constexpr size_t WS_HM = WS_HRAW + 256 * MiB;
constexpr size_t WS_CF = WS_HM + 128 * MiB;
constexpr size_t WS_END = WS_CF + 2 * MiB;
static_assert((size_t)8 * NUP * DM * 2 == 352 * MiB && (size_t)8 * DM * DFF * 2 == 176 * MiB && (size_t)4 * NINP * DM * 2 == 100 * MiB, "weight regions");
static_assert((size_t)MTOK * DFF * 2 == 352 * MiB && (size_t)MTOK * NQKV * 2 == 384 * MiB && WS_SS + 13 * (size_t)MTOK * 8 <= CTL_ZERO_BYTES, "activation regions");
constexpr int CW_BAR = 4096;

constexpr int LDS_BYTES = 153600, MISC_OFF = 152576;

#define GAS __attribute__((address_space(1)))
#define LAS __attribute__((address_space(3)))
#define DI __device__ __forceinline__
typedef unsigned short bf16;
typedef unsigned v4u __attribute__((ext_vector_type(4)));
typedef unsigned v2u __attribute__((ext_vector_type(2)));
typedef float f32x4 __attribute__((ext_vector_type(4)));
typedef short bf16x8 __attribute__((ext_vector_type(8)));
typedef GAS unsigned gu32;
#define RLX_AGENT __ATOMIC_RELAXED, __HIP_MEMORY_SCOPE_AGENT
#define LDS_WAIT() asm volatile("s_waitcnt lgkmcnt(0)" ::: "memory")
DI unsigned f2bf(float f) { unsigned r; asm("v_cvt_pk_bf16_f32 %0, %1, %1" : "=v"(r) : "v"(f)); return r & 0xffffu; }
DI unsigned pk2(float lo, float hi) { unsigned r; asm("v_cvt_pk_bf16_f32 %0, %1, %2" : "=v"(r) : "v"(lo), "v"(hi)); return r; }
DI float bf2f(unsigned short v) { return __builtin_bit_cast(float, (unsigned)v << 16); }
DI float bflo(unsigned w) { return __builtin_bit_cast(float, w << 16); }
DI float bfhi(unsigned w) { return __builtin_bit_cast(float, w & 0xffff0000u); }
DI float logsig(float x) { return fminf(x, 0.f) - log1pf(expf(-fabsf(x))); }

#define XB_TMO      128
#define XB_XCNT(j)  (256  + 64 * (j))
#define XB_XSUB(j)  (1280 + 64 * (j))
#define XB_XGEN(j)  (2304 + 64 * (j))
#define XB_TOP      3328
#define XB_TOPGEN   3392
#define XCD_BAR_WORDS 3456
#define XB_SPIN_CAP (1u << 18)

__device__ __forceinline__ unsigned xb_ld(unsigned* p)              { return __hip_atomic_load(p, __ATOMIC_RELAXED, __HIP_MEMORY_SCOPE_AGENT); }
__device__ __forceinline__ unsigned xb_add(unsigned* p, unsigned v) { return __hip_atomic_fetch_add(p, v, __ATOMIC_RELAXED, __HIP_MEMORY_SCOPE_AGENT); }
__device__ __forceinline__ unsigned xb_xcc_id() { return (unsigned)__builtin_amdgcn_s_getreg((3 << 11) | 20) & 0xFu; }
#define XB_SPIN(cond, bar) do { unsigned _sp = 0; while (cond) { __builtin_amdgcn_s_sleep(1); \
    if ((++_sp & 255u) == 0u) { if (xb_ld(&(bar)[XB_TMO])) break; if (_sp > XB_SPIN_CAP) { atomicAdd(&(bar)[XB_TMO], 1u); break; } } } } while (0)

struct XcdBarrier {
    unsigned* bar; unsigned x;
    volatile LAS unsigned* st;
};

__device__ __forceinline__ XcdBarrier xcd_barrier_post(unsigned* bar, volatile LAS unsigned* st) {
    XcdBarrier b; b.bar = bar; b.x = xb_xcc_id(); b.st = st;
    if (threadIdx.x == 0) (void)xb_add(&bar[XB_XCNT(b.x)], 1u);
    return b;
}
__device__ __forceinline__ void xcd_barrier_complete(unsigned* bar, unsigned x, unsigned& nloc, unsigned& nx) {
    const unsigned G = gridDim.x * gridDim.y * gridDim.z;
    unsigned sum, cnt, mine, sp = 0u;
    for (;;) {
        sum = 0u; cnt = 0u; mine = 0u;
#pragma unroll
        for (unsigned j = 0; j < 16; ++j) { const unsigned c = xb_ld(&bar[XB_XCNT(j)]); sum += c; cnt += (c > 0u) ? 1u : 0u; mine = (j == x) ? c : mine; }
        if (sum == G) break;
        __builtin_amdgcn_s_sleep(1);
        if ((++sp & 255u) == 0u) { if (xb_ld(&bar[XB_TMO])) break; if (sp > XB_SPIN_CAP) { atomicAdd(&bar[XB_TMO], 1u); break; } }
    }
    nloc = mine > 0u ? mine : 1u; nx = cnt > 0u ? cnt : 1u;
}

__device__ __forceinline__ void xcd_barrier(const XcdBarrier& b) {
    asm volatile("s_waitcnt vmcnt(0)" ::: "memory");
    __syncthreads();
    if (threadIdx.x == 0) {
        unsigned* bar = b.bar;
        __builtin_amdgcn_s_waitcnt(0);
        unsigned nloc = b.st[0], nx = b.st[1];
        if (nloc == 0u) { xcd_barrier_complete(bar, b.x, nloc, nx); b.st[0] = nloc; b.st[1] = nx; }
        const unsigned old = xb_add(&bar[XB_XSUB(b.x)], 1u);
        const unsigned gen = old / nloc;
        if (old + 1u == (gen + 1u) * nloc) {
            __builtin_amdgcn_fence(__ATOMIC_RELEASE, "agent");
            asm volatile("s_waitcnt vmcnt(0)" ::: "memory");
            const unsigned og = xb_add(&bar[XB_TOP], 1u);
            const unsigned tg = og / nx;
            if (og + 1u == (tg + 1u) * nx) xb_add(&bar[XB_TOPGEN], 1u);
            else XB_SPIN(xb_ld(&bar[XB_TOPGEN]) == tg, bar);
            __builtin_amdgcn_fence(__ATOMIC_ACQUIRE, "agent");
            xb_add(&bar[XB_XGEN(b.x)], 1u);
            asm volatile("s_waitcnt vmcnt(0)" ::: "memory");
        } else {
            XB_SPIN(xb_ld(&bar[XB_XGEN(b.x)]) == gen, bar);
            __builtin_amdgcn_fence(__ATOMIC_ACQUIRE, "agent");
            asm volatile("s_waitcnt vmcnt(0)" ::: "memory");
        }
    }
    __syncthreads();
}


DI float wave_sum(float v) {
#pragma unroll
    for (int o = 1; o < 64; o <<= 1) v += __shfl_xor(v, o);
    return v;
}
DI float wave_max(float v) {
#pragma unroll
    for (int o = 1; o < 64; o <<= 1) v = fmaxf(v, __shfl_xor(v, o));
    return v;
}
DI float wave_incl_sum(float v, int lane) {
#pragma unroll
    for (int o = 1; o < 64; o <<= 1) { const float t = __shfl_up(v, o); if (lane >= o) v += t; }
    return v;
}
DI float wave_incl_max(float v, int lane) {
#pragma unroll
    for (int o = 1; o < 64; o <<= 1) { const float t = __shfl_up(v, o); if (lane >= o) v = fmaxf(v, t); }
    return v;
}

template <int L> DI int swx(int r) { return L == 64 ? ((r >> 1) & 7) : (r & 15); }
template <int L> DI int eoff(int r, int c) { return r * L + ((((c >> 3) ^ swx<L>(r)) << 3) | (c & 7)); }
template <int L> DI bf16x8 ldf(const LAS bf16* base, int r, int ch) { return *(const LAS bf16x8*)(base + r * L + ((ch ^ swx<L>(r)) << 3)); }
DI f32x4 mfma16(bf16x8 a, bf16x8 b, f32x4 c) { return __builtin_amdgcn_mfma_f32_16x16x32_bf16(a, b, c, 0, 0, 0); }
template <int LA, int LB, int NK> DI void mma_tile(f32x4& acc, const LAS bf16* A, int ra0, const LAS bf16* B, int rb0, int lane) {
    const int r = lane & 15, g = lane >> 4;
#pragma unroll
    for (int kk = 0; kk < NK; ++kk) { const bf16x8 a = ldf<LA>(A, ra0 + r, 4 * kk + g), b = ldf<LB>(B, rb0 + r, 4 * kk + g); acc = mfma16(a, b, acc); }
}

DI void conv_item(const float* W, int K, int N, int nblk, const float* gk, bf16* WT, int mode, LAS float* scr, int item, int lane) {
    const int nkb = K / 64, nb = item / nkb, kb = item - nb * nkb, k0 = 64 * kb, n0 = 32 * nb;
    const int nq = 4 * (lane & 7), n = n0 + nq; const bool ok = n < N;
    f32x4 v[8]; float gv[8];
#pragma unroll
    for (int i = 0; i < 8; ++i) { const int kk = 8 * i + (lane >> 3); v[i] = ok ? *(const f32x4*)(W + (size_t)(k0 + kk) * N + n) : (f32x4){0.f, 0.f, 0.f, 0.f}; gv[i] = gk ? gk[k0 + kk] : 1.0f; }
#pragma unroll
    for (int i = 0; i < 8; ++i) { const int kk = 8 * i + (lane >> 3); LAS float* d = scr + kk * 33 + nq; d[0] = v[i].x * gv[i]; d[1] = v[i].y * gv[i]; d[2] = v[i].z * gv[i]; d[3] = v[i].w * gv[i]; }
    LDS_WAIT(); asm volatile("" ::: "memory");
    int row_off = n0;
    if (mode == 1) { const int j = n0 < DFF ? n0 : n0 - DFF; row_off = 256 * (j >> 7) + (j & 127) + (n0 < DFF ? 0 : 128); }
    const int c = lane & 7;
#pragma unroll
    for (int j = 0; j < 4; ++j) { const int nn = (lane >> 3) + 8 * j; const LAS float* s = scr + (8 * c) * 33 + nn;
        v4u o; o.x = pk2(s[0 * 33], s[1 * 33]); o.y = pk2(s[2 * 33], s[3 * 33]); o.z = pk2(s[4 * 33], s[5 * 33]); o.w = pk2(s[6 * 33], s[7 * 33]);
        *(v4u*)(WT + (size_t)(row_off + nn) * K + k0 + 8 * c) = o; }
    LDS_WAIT(); asm volatile("" ::: "memory");
}

struct Args { const float* in[18]; float* out; unsigned char* ws; int ph_lo, ph_hi; };

typedef const __attribute__((address_space(4))) Args* KArgs;
DI KArgs kargs() { KArgs p = (KArgs)__builtin_amdgcn_kernarg_segment_ptr(); asm volatile("" : "+s"(p)); return p; }
DI void prologue(LAS unsigned char* lds, int lane, int wave, int bx) {
    KArgs AP = kargs();
    LAS float* scr = (LAS float*)(lds + wave * 16384);
    const int gw = bx * NWAVES + wave, NGW = gridDim.x * NWAVES;
    unsigned char* ws = AP->ws;
    constexpr int I_UP = (DM / 64) * (NUP / 32), I_DN = (DFF / 64) * (DM / 32), I_IN = (DM / 64) * (NINP / 32), I_OUT = (DM / 64) * (DM / 32);
    constexpr int NITEMS = 8 * I_UP + 8 * I_DN + 4 * I_IN + 4 * I_OUT;
    for (int it = gw; it < NITEMS; it += NGW) {
        int r = it; const float* W; const float* gk = nullptr; bf16* WT; int K = DM, N, nblk, mode = 0;
        if (r < 8 * I_UP) { const int mi = r / I_UP; r -= mi * I_UP; W = AP->in[2] + (size_t)mi * DM * NUP; gk = AP->in[1] + (size_t)mi * DM; WT = (bf16*)(ws + WS_WUP) + (size_t)mi * NUP * DM; N = NUP; nblk = NUP / 32; mode = 1; }
        else if (r < 8 * I_UP + 8 * I_DN) { r -= 8 * I_UP; const int mi = r / I_DN; r -= mi * I_DN; W = AP->in[3] + (size_t)mi * DFF * DM; WT = (bf16*)(ws + WS_WDN) + (size_t)mi * DM * DFF; K = DFF; N = DM; nblk = DM / 32; }
        else if (r < 8 * I_UP + 8 * I_DN + 4 * I_IN) { r -= 8 * I_UP + 8 * I_DN; const int l = r / I_IN; r -= l * I_IN; const int kind = l % 3, ji = l / 3;
            W = AP->in[kind == 0 ? 5 : kind == 1 ? 9 : 12] + (size_t)ji * DM * NIN; gk = AP->in[4] + (size_t)l * DM; WT = (bf16*)(ws + WS_WIN) + (size_t)l * NINP * DM; N = NIN; nblk = NINP / 32; }
        else { r -= 8 * I_UP + 8 * I_DN + 4 * I_IN; const int l = r / I_OUT; r -= l * I_OUT; const int kind = l % 3, ji = l / 3;
            W = AP->in[kind == 0 ? 8 : kind == 1 ? 11 : 16] + (size_t)ji * DM * DM; WT = (bf16*)(ws + WS_WOUT) + (size_t)l * DM * DM; N = DM; nblk = DM / 32; }
        conv_item(W, K, N, nblk, gk, WT, mode, scr, r, lane);
    }
    const float* x = AP->in[0]; bf16* hb = (bf16*)(ws + WS_HB); long long* ss0 = (long long*)(ws + WS_SS);
    for (int m = gw; m < MTOK; m += NGW) {
        const f32x4* xr = (const f32x4*)(x + (size_t)m * DM) + lane; f32x4 v[8]; float s = 0.f;
#pragma unroll
        for (int j = 0; j < 8; ++j) { v[j] = xr[64 * j]; s += (v[j].x * v[j].x + v[j].y * v[j].y) + (v[j].z * v[j].z + v[j].w * v[j].w); }
        s = wave_sum(s);
        v2u* o8 = (v2u*)(hb + (size_t)m * DM) + lane;
#pragma unroll
        for (int j = 0; j < 8; ++j) { v2u w; w.x = pk2(v[j].x, v[j].y); w.y = pk2(v[j].z, v[j].w); o8[64 * j] = w; }
        if (lane == 0) ss0[m] = __float2ll_rn(s * 1048576.0f);
    }
}

constexpr int IMGM_P = 0, IMGM_KT = 8192, IMGM_VT = IMGM_KT + 16384, IMGM_GS = IMGM_VT + 4 * 8192, IMGM_BYTES = IMGM_GS + 1024;
constexpr int IMGG_Q = 0, IMGG_KT = 32768, IMGG_P = 65536, IMGG_VT = IMGG_P + 8192, IMGG_EB = IMGG_VT + 8 * 8192, IMGG_BYTES = IMGG_EB + 1024;
static_assert((size_t)IMGM_BYTES * 4096 <= 352 * MiB && (size_t)IMGG_BYTES * 2048 <= 352 * MiB, "images overlay the (idle) FFN activation buffer");
DI float logsig_fast(float x) { return fminf(x, 0.f) - __logf(1.0f + __expf(-fabsf(x))); }

DI void mlstm_pre(LAS unsigned char* lds, const bf16* P1, const float* G, const float* b_if, unsigned char* img, int tid, int lane, int wave, int bx) {
    LAS bf16* Qs = (LAS bf16*)lds;
    LAS bf16* Ks = Qs + 64 * 128;
    LAS bf16* KTs = Ks + 64 * 128;
    LAS bf16* Ps = KTs + 128 * 64;
    LAS bf16* VT = Ps + 64 * 64;
    LAS float* fa = (LAS float*)(VT + 256 * 64);
    LAS float *bcum = fa, *ipre = fa + 64, *aloc = fa + 128, *wloc = fa + 192, *scal = fa + 256;
    const float KSCALE = 0.08838834764831845f;
    const int g = lane >> 4, r16 = lane & 15;
    v4u pq[2], pk[2], pv[4]; float pgi = 0.f, pgf = 0.f;
#define MLP_LOAD(it_) do { const int b_ = (it_) >> 9, c_ = ((it_) >> 3) & 63, h_ = (it_) & 7; const int row0_ = b_ * SEQ + c_ * 64; \
        _Pragma("unroll") for (int p = 0; p < 2; ++p) { const int idx = tid + 512 * p, r = idx >> 4, c8 = idx & 15; const bf16* src = P1 + (size_t)(row0_ + r) * NQKV + h_ * 128 + c8 * 8; pq[p] = *(const v4u*)src; pk[p] = *(const v4u*)(src + 1024); } \
        _Pragma("unroll") for (int p = 0; p < 4; ++p) { const int idx = tid + 512 * p, r = idx >> 5, c8 = idx & 31; pv[p] = *(const v4u*)(P1 + (size_t)(row0_ + r) * NQKV + 2048 + h_ * 256 + c8 * 8); } \
        if (tid < 64) { const float* gp = G + (size_t)(row0_ + tid) * 16; pgi = gp[h_]; pgf = gp[8 + h_]; } } while (0)
    if (bx < 4096) MLP_LOAD(bx);
    for (int item = bx; item < 4096; item += gridDim.x) {
        const int h = item & 7;
        unsigned char* im = img + (size_t)item * IMGM_BYTES;
        __syncthreads();
        if (tid < 64) { ipre[tid] = pgi + b_if[h]; bcum[tid] = logsig(pgf + b_if[8 + h]); }
#pragma unroll
        for (int p = 0; p < 2; ++p) { const int idx = tid + 512 * p, r = idx >> 4, c8 = idx & 15; *(LAS v4u*)(Qs + eoff<128>(r, c8 * 8)) = pq[p]; *(LAS v4u*)(Ks + eoff<128>(r, c8 * 8)) = pk[p]; }
        __syncthreads();
        if (wave == 0) {
            const float bt = wave_incl_sum(bcum[lane], lane), ip = ipre[lane];
            const float al = bt + wave_incl_max(ip - bt, lane);
            const float blast = __shfl(bt, 63);
            const float gg = blast - bt + ip;
            const float gmax = wave_max(gg);
            bcum[lane] = bt; aloc[lane] = al; wloc[lane] = __expf(gg - gmax);
            if (lane == 0) { scal[0] = blast; scal[1] = gmax; }
        }
#pragma unroll
        for (int p = 0; p < 4; ++p) { const int idx = tid + 512 * p, r = idx >> 5, c8 = idx & 31;
#pragma unroll
            for (int j = 0; j < 4; ++j) { VT[eoff<64>(c8 * 8 + 2 * j, r)] = (bf16)(pv[p][j] & 0xffffu); VT[eoff<64>(c8 * 8 + 2 * j + 1, r)] = (bf16)(pv[p][j] >> 16); } }
        if (item + (int)gridDim.x < 4096) MLP_LOAD(item + (int)gridDim.x);
        __syncthreads();
#pragma unroll
        for (int p = 0; p < 2; ++p) { const int idx = tid + 512 * p, s = idx >> 4, c8 = idx & 15; const v4u kv = *(const LAS v4u*)(Ks + eoff<128>(s, c8 * 8)); const float w = wloc[s] * KSCALE;
#pragma unroll
            for (int j = 0; j < 4; ++j) { KTs[eoff<64>(c8 * 8 + 2 * j, s)] = (bf16)f2bf(bflo(kv[j]) * w); KTs[eoff<64>(c8 * 8 + 2 * j + 1, s)] = (bf16)f2bf(bfhi(kv[j]) * w); } }
        { const int tt = wave >> 1;
#pragma unroll
          for (int q2 = 0; q2 < 2; ++q2) { const int st = 2 * (wave & 1) + q2; f32x4 acc = (f32x4){0.f, 0.f, 0.f, 0.f};
            if (st <= tt) mma_tile<128, 128, 4>(acc, Qs, 16 * tt, Ks, 16 * st, lane);
            const int s = 16 * st + r16; const float cs = ipre[s] - bcum[s];
#pragma unroll
            for (int i = 0; i < 4; ++i) { const int t = 16 * tt + 4 * g + i; const float p = (s <= t) ? acc[i] * KSCALE * __expf(bcum[t] + cs - aloc[t]) : 0.f; Ps[eoff<64>(t, s)] = (bf16)f2bf(p); } } }
        __syncthreads();
        *(v4u*)(im + IMGM_P + tid * 16) = *(const LAS v4u*)((LAS unsigned char*)Ps + tid * 16);
#pragma unroll
        for (int p = 0; p < 2; ++p) *(v4u*)(im + IMGM_KT + (tid + 512 * p) * 16) = *(const LAS v4u*)((LAS unsigned char*)KTs + (tid + 512 * p) * 16);
#pragma unroll
        for (int p = 0; p < 4; ++p) *(v4u*)(im + IMGM_VT + (tid + 512 * p) * 16) = *(const LAS v4u*)((LAS unsigned char*)VT + (tid + 512 * p) * 16);
        if (tid < 64) { float* gs = (float*)(im + IMGM_GS); gs[tid] = bcum[tid]; gs[64 + tid] = aloc[tid]; if (tid < 2) gs[128 + tid] = scal[tid]; }
    }
#undef MLP_LOAD
}

DI void mlstm_scan2(LAS unsigned char* lds, const bf16* P1, const unsigned char* img, float* hraw, int tid, int lane, int wave, int bx) {
    constexpr int IB = 8192 + 16384 + 16384 + 10240 + 1024;
    LAS bf16* CT0 = (LAS bf16*)(lds + 2 * IB);
    const int g = lane >> 4, r16 = lane & 15, tt = wave >> 1, eh = wave & 1;
    for (int item0 = bx; item0 < 256; item0 += gridDim.x) {
        const int item = (gridDim.x == 256) ? (item0 & 7) * 32 + (item0 >> 3) : item0;
        const int b = item >> 5, h = (item >> 2) & 7, sl = item & 3;
        f32x4 Cacc[5];
#pragma unroll
        for (int e = 0; e < 5; ++e) Cacc[e] = (f32x4){0.f, 0.f, 0.f, 0.f};
        __syncthreads();
        for (int i = tid; i < 2 * 80 * 128 / 8; i += 512) ((LAS v4u*)CT0)[i] = (v4u){0u, 0u, 0u, 0u};
        for (int i = tid; i < 2 * 128; i += 512) { const int bi = i >> 7, k = i & 127; ((LAS v4u*)(lds + bi * IB + 8192 + 16384 + 16384 + 8192))[k] = (k < 8) ? (v4u){0x3f803f80u, 0x3f803f80u, 0x3f803f80u, 0x3f803f80u} : (v4u){0u, 0u, 0u, 0u}; }
        float m_prev = 0.f;
        v4u rp, rq[2], rk[2], rv; float rg0 = 0.f, rbl, rgm;
#define MLS_PREFETCH(cc) do { const int item2 = (b * 64 + (cc)) * 8 + h; const unsigned char* im = img + (size_t)item2 * IMGM_BYTES; const int row0_ = b * SEQ + (cc) * 64; \
            rp = *(const v4u*)(im + IMGM_P + tid * 16); rk[0] = *(const v4u*)(im + IMGM_KT + tid * 16); rk[1] = *(const v4u*)(im + IMGM_KT + (tid + 512) * 16); \
            rv = *(const v4u*)(im + IMGM_VT + sl * 8192 + tid * 16); \
            _Pragma("unroll") for (int p = 0; p < 2; ++p) { const int idx = tid + 512 * p, r = idx >> 4, c8 = idx & 15; rq[p] = *(const v4u*)(P1 + (size_t)(row0_ + r) * NQKV + h * 128 + c8 * 8); } \
            const float* gs = (const float*)(im + IMGM_GS); if (tid < 128) rg0 = gs[tid]; rbl = gs[128]; rgm = gs[129]; } while (0)
#define MLS_STORE(bi) do { LAS unsigned char* bb = lds + (bi) * IB; \
            *(LAS v4u*)(bb + tid * 16) = rp; *(LAS v4u*)(bb + 8192 + 16384 + tid * 16) = rk[0]; *(LAS v4u*)(bb + 8192 + 16384 + (tid + 512) * 16) = rk[1]; \
            *(LAS v4u*)(bb + 8192 + 16384 + 16384 + tid * 16) = rv; \
            _Pragma("unroll") for (int p = 0; p < 2; ++p) { const int idx = tid + 512 * p, r = idx >> 4, c8 = idx & 15; *(LAS v4u*)((LAS bf16*)(bb + 8192) + eoff<128>(r, c8 * 8)) = rq[p]; } \
            if (tid < 128) ((LAS float*)(bb + 8192 + 16384 + 16384 + 10240))[tid] = rg0; } while (0)
        MLS_PREFETCH(0); MLS_STORE(0);
        float blast = rbl, gmax = rgm;
        MLS_PREFETCH(1);
        __syncthreads();
        for (int c = 0; c < 64; ++c) {
            const int row0 = b * SEQ + c * 64;
            const LAS unsigned char* bb = lds + (c & 1) * IB;
            const LAS bf16* Ps = (const LAS bf16*)bb; const LAS bf16* Qs = (const LAS bf16*)(bb + 8192); const LAS bf16* KTs = (const LAS bf16*)(bb + 8192 + 16384);
            const LAS bf16* VTs = (const LAS bf16*)(bb + 8192 + 16384 + 16384); const LAS float* gsl = (const LAS float*)(bb + 8192 + 16384 + 16384 + 10240);
            LAS bf16* CTc = CT0 + (c & 1) * 80 * 128; LAS bf16* CTn = CT0 + ((c + 1) & 1) * 80 * 128;
            const f32x4 btv = *(const LAS f32x4*)(gsl + 16 * tt + 4 * g), alv = *(const LAS f32x4*)(gsl + 64 + 16 * tt + 4 * g);
            float al[4], be[4], em[4];
#pragma unroll
            for (int i = 0; i < 4; ++i) { const float mt = fmaxf(btv[i] + m_prev, alv[i]); al[i] = __expf(alv[i] - mt); be[i] = __expf(btv[i] + m_prev - mt); em[i] = __expf(-mt); }
            const float m_new = fmaxf(blast + m_prev, gmax), wcs = __expf(blast + m_prev - m_new), gam = __expf(gmax - m_new);
            m_prev = m_new;
            f32x4 d1 = (f32x4){0.f, 0.f, 0.f, 0.f}, d2 = (f32x4){0.f, 0.f, 0.f, 0.f};
            mma_tile<64, 64, 2>(d1, Ps, 16 * tt, VTs, 64, lane); mma_tile<128, 128, 4>(d2, Qs, 16 * tt, CTc, 64, lane);
            float dinv[4];
#pragma unroll
            for (int i = 0; i < 4; ++i) { const float den = __shfl(al[i] * d1[i] + be[i] * d2[i], lane & 48); dinv[i] = __builtin_amdgcn_rcpf(fmaxf(fabsf(den), em[i])); }
#pragma unroll
            for (int q2 = 0; q2 < 2; ++q2) { const int et = 2 * eh + q2, e = 16 * et + r16; f32x4 a1 = (f32x4){0.f, 0.f, 0.f, 0.f}, a2 = (f32x4){0.f, 0.f, 0.f, 0.f};
                mma_tile<64, 64, 2>(a1, Ps, 16 * tt, VTs, 16 * et, lane); mma_tile<128, 128, 4>(a2, Qs, 16 * tt, CTc, 16 * et, lane);
#pragma unroll
                for (int i = 0; i < 4; ++i) { const int t = 16 * tt + 4 * g + i; hraw[(size_t)(row0 + t) * DM + h * 256 + sl * 64 + e] = (al[i] * a1[i] + be[i] * a2[i]) * dinv[i]; } }
#pragma unroll
            for (int et = 0; et < 5; ++et) { f32x4 tmp = (f32x4){0.f, 0.f, 0.f, 0.f}; mma_tile<64, 64, 2>(tmp, KTs, 16 * wave, VTs, 16 * et, lane);
                Cacc[et] = Cacc[et] * wcs + tmp * gam;
                v2u w; w.x = pk2(Cacc[et][0], Cacc[et][1]); w.y = pk2(Cacc[et][2], Cacc[et][3]);
                *(LAS v2u*)(CTn + eoff<128>(16 * et + r16, 16 * wave + 4 * g)) = w; }
            if (c + 1 < 64) { MLS_STORE((c + 1) & 1); blast = rbl; gmax = rgm; }
            if (c + 2 < 64) MLS_PREFETCH(c + 2);
            __syncthreads();
        }
#undef MLS_PREFETCH
#undef MLS_STORE
    }
}

DI void gla_pre(LAS unsigned char* lds, const bf16* P1, const float* G, const float* w_alpha, const float* b_alpha, unsigned char* img, int tid, int lane, int wave, int bx) {
    LAS bf16* VT = (LAS bf16*)lds;
    LAS bf16* QTs = (LAS bf16*)lds;
    LAS bf16* KTl = QTs + 64 * 256;
    LAS bf16* KTT = KTl + 64 * 256;
    LAS bf16* Ps = KTT + 256 * 64;
    LAS float* alow = (LAS float*)(Ps + 64 * 64);
    LAS float* T0 = alow + 1024;
    const int g = lane >> 4, r16 = lane & 15, d = tid & 255, sh = tid >> 8;
    for (int item = bx; item < 2048; item += gridDim.x) {
        const int b = item >> 8, c = (item >> 2) & 63, h = item & 3;
        const int row0 = b * SEQ + c * 64;
        unsigned char* im = img + (size_t)item * IMGG_BYTES;
        __syncthreads();
#pragma unroll
        for (int p = 0; p < 8; ++p) { const int idx = tid + 512 * p, r = idx >> 6, c8 = idx & 63; const v4u vv = *(const v4u*)(P1 + (size_t)(row0 + r) * NQKV + 2048 + h * 512 + c8 * 8);
#pragma unroll
            for (int j = 0; j < 4; ++j) { VT[eoff<64>(c8 * 8 + 2 * j, r)] = (bf16)(vv[j] & 0xffffu); VT[eoff<64>(c8 * 8 + 2 * j + 1, r)] = (bf16)(vv[j] >> 16); } }
        float wa[16];
#pragma unroll
        for (int i = 0; i < 16; ++i) wa[i] = w_alpha[i * 1024 + h * 256 + d];
        const float ba = b_alpha[h * 256 + d];
        f32x4 al4 = (f32x4){0.f, 0.f, 0.f, 0.f};
        if (tid < 256) al4 = *(const f32x4*)(G + (size_t)(row0 + (tid >> 2)) * 16 + (tid & 3) * 4);
        __syncthreads();
#pragma unroll
        for (int p = 0; p < 8; ++p) *(v4u*)(im + IMGG_VT + (tid + 512 * p) * 16) = *(const LAS v4u*)((LAS unsigned char*)VT + (tid + 512 * p) * 16);
        __syncthreads();
        if (tid < 256) *(LAS f32x4*)(alow + tid * 4) = al4;
        __syncthreads();
        const bf16* qsrc = P1 + (size_t)(row0 + 32 * sh) * NQKV + h * 256 + d;
        float bs[32]; float run = 0.f;
#pragma unroll
        for (int j = 0; j < 32; ++j) { const int s = 32 * sh + j; float z = ba;
#pragma unroll
            for (int i = 0; i < 16; ++i) z += alow[s * 16 + i] * wa[i];
            run += logsig_fast(z) * (1.0f / 16.0f); bs[j] = run; }
        if (sh == 0) T0[d] = run;
        __syncthreads();
        const float add = sh ? T0[d] : 0.f;
        if (sh) ((float*)(im + IMGG_EB))[d] = __expf(run + add);
#pragma unroll
        for (int q8 = 0; q8 < 4; ++q8) { unsigned kk[8];
#pragma unroll
            for (int j = 0; j < 8; ++j) { const int jj = 8 * q8 + j, s = 32 * sh + jj; const float bsum = bs[jj] + add;
                const float qv = bf2f(qsrc[(size_t)jj * NQKV]) * 0.0625f * __expf(bsum), kv = bf2f(qsrc[(size_t)jj * NQKV + 1024]) * __expf(-bsum);
                QTs[eoff<256>(s, d)] = (bf16)f2bf(qv); kk[j] = f2bf(kv); KTl[eoff<256>(s, d)] = (bf16)kk[j]; }
            v4u w; w.x = kk[0] | (kk[1] << 16); w.y = kk[2] | (kk[3] << 16); w.z = kk[4] | (kk[5] << 16); w.w = kk[6] | (kk[7] << 16);
            *(LAS v4u*)(KTT + eoff<64>(d, 32 * sh + 8 * q8)) = w; }
        __syncthreads();
        { const int tt = wave >> 1;
#pragma unroll
          for (int q2 = 0; q2 < 2; ++q2) { const int st = 2 * (wave & 1) + q2; f32x4 acc = (f32x4){0.f, 0.f, 0.f, 0.f};
            if (st <= tt) mma_tile<256, 256, 8>(acc, QTs, 16 * tt, KTl, 16 * st, lane);
            const int s = 16 * st + r16;
#pragma unroll
            for (int i = 0; i < 4; ++i) { const int t = 16 * tt + 4 * g + i; Ps[eoff<64>(t, s)] = (bf16)f2bf((s <= t) ? acc[i] : 0.f); } } }
        __syncthreads();
#pragma unroll
        for (int p = 0; p < 4; ++p) { *(v4u*)(im + IMGG_Q + (tid + 512 * p) * 16) = *(const LAS v4u*)((LAS unsigned char*)QTs + (tid + 512 * p) * 16);
                                      *(v4u*)(im + IMGG_KT + (tid + 512 * p) * 16) = *(const LAS v4u*)((LAS unsigned char*)KTT + (tid + 512 * p) * 16); }
        *(v4u*)(im + IMGG_P + tid * 16) = *(const LAS v4u*)((LAS unsigned char*)Ps + tid * 16);
    }
}

DI void gla_scan2(LAS unsigned char* lds, const unsigned char* img, float* hraw, int tid, int lane, int wave, int bx) {
    LAS bf16* QTs = (LAS bf16*)lds;
    LAS bf16* KTT = QTs + 64 * 256;
    LAS bf16* Ps = KTT + 256 * 64;
    LAS bf16* VTs = Ps + 64 * 64;
    LAS float* eb = (LAS float*)(VTs + 64 * 64);
    LAS bf16* ST0 = (LAS bf16*)(eb + 256);
    const int g = lane >> 4, r16 = lane & 15, tt = wave >> 1, eh = wave & 1;
    for (int item0 = bx; item0 < 256; item0 += gridDim.x) {
        const int item = (gridDim.x == 256) ? (item0 & 7) * 32 + (item0 >> 3) : item0;
        const int b = item >> 5, h = (item >> 3) & 3, sl = item & 7;
        f32x4 Sacc[2][4];
#pragma unroll
        for (int a = 0; a < 2; ++a)
#pragma unroll
            for (int e = 0; e < 4; ++e) Sacc[a][e] = (f32x4){0.f, 0.f, 0.f, 0.f};
        __syncthreads();
        for (int i = tid; i < 2 * 64 * 256 / 8; i += 512) ((LAS v4u*)ST0)[i] = (v4u){0u, 0u, 0u, 0u};
        v4u rq[4], rk[4], rp, rv; float re = 0.f;
#define GLS_PREFETCH(cc) do { const int item2 = (b * 64 + (cc)) * 4 + h; const unsigned char* im = img + (size_t)item2 * IMGG_BYTES; \
            _Pragma("unroll") for (int p = 0; p < 4; ++p) { rq[p] = *(const v4u*)(im + IMGG_Q + (tid + 512 * p) * 16); rk[p] = *(const v4u*)(im + IMGG_KT + (tid + 512 * p) * 16); } \
            rp = *(const v4u*)(im + IMGG_P + tid * 16); rv = *(const v4u*)(im + IMGG_VT + sl * 8192 + tid * 16); if (tid < 256) re = ((const float*)(im + IMGG_EB))[tid]; } while (0)
        GLS_PREFETCH(0);
        for (int c = 0; c < 64; ++c) {
            const int row0 = b * SEQ + c * 64;
            LAS bf16* STc = ST0 + (c & 1) * 64 * 256; LAS bf16* STn = ST0 + ((c + 1) & 1) * 64 * 256;
            __syncthreads();
#pragma unroll
            for (int p = 0; p < 4; ++p) { *(LAS v4u*)((LAS unsigned char*)QTs + (tid + 512 * p) * 16) = rq[p]; *(LAS v4u*)((LAS unsigned char*)KTT + (tid + 512 * p) * 16) = rk[p]; }
            *(LAS v4u*)((LAS unsigned char*)Ps + tid * 16) = rp; *(LAS v4u*)((LAS unsigned char*)VTs + tid * 16) = rv;
            if (tid < 256) eb[tid] = re;
            __syncthreads();
            if (c + 1 < 64) GLS_PREFETCH(c + 1);
#pragma unroll
            for (int q2 = 0; q2 < 2; ++q2) { const int et = 2 * eh + q2, e = 16 * et + r16; f32x4 acc = (f32x4){0.f, 0.f, 0.f, 0.f};
                mma_tile<64, 64, 2>(acc, Ps, 16 * tt, VTs, 16 * et, lane); mma_tile<256, 256, 8>(acc, QTs, 16 * tt, STc, 16 * et, lane);
#pragma unroll
                for (int i = 0; i < 4; ++i) { const int t = 16 * tt + 4 * g + i; hraw[(size_t)(row0 + t) * DM + h * 512 + sl * 64 + e] = acc[i]; } }
#pragma unroll
            for (int a = 0; a < 2; ++a) { const int dt = 2 * wave + a;
                const f32x4 ev = *(const LAS f32x4*)(eb + 16 * dt + 4 * g);
#pragma unroll
                for (int et = 0; et < 4; ++et) { mma_tile<64, 64, 2>(Sacc[a][et], KTT, 16 * dt, VTs, 16 * et, lane); Sacc[a][et] = Sacc[a][et] * ev;
                    v2u w; w.x = pk2(Sacc[a][et][0], Sacc[a][et][1]); w.y = pk2(Sacc[a][et][2], Sacc[a][et][3]);
                    *(LAS v2u*)(STn + eoff<256>(16 * et + r16, 16 * dt + 4 * g)) = w; } }
        }
#undef GLS_PREFETCH
    }
}


DI void mixer_gates(const bf16* hb, const bf16* wg, const long long* ss, float* G, int lane, int wave, int bx) {
    const int g = lane >> 4, r16 = lane & 15;
    for (int t = bx * NWAVES + wave; t < MTOK / 16; t += gridDim.x * NWAVES) {
        const bf16* ap = hb + (size_t)(16 * t + r16) * DM + 8 * g; const bf16* bp = wg + (size_t)r16 * DM + 8 * g;
        f32x4 acc = (f32x4){0.f, 0.f, 0.f, 0.f};
#pragma unroll 8
        for (int kk = 0; kk < DM / 32; ++kk) { const bf16x8 a = *(const bf16x8*)(ap + 32 * kk), b = *(const bf16x8*)(bp + 32 * kk); acc = mfma16(a, b, acc); }
#pragma unroll
        for (int i = 0; i < 4; ++i) { const int row = 16 * t + 4 * g + i; G[(size_t)row * 16 + r16] = acc[i] * pg8::rstd_of(ss, row); }
    }
}

template <int HS, int ACT> DI void headnorm_gate(const float* hraw, const bf16* P1, const float* gnorm, bf16* hm, int lane, int wave, int bx) {
    constexpr int NH = DM / HS, EPL = HS / 64;
    const int gw = bx * NWAVES + wave, NGW = gridDim.x * NWAVES;
    for (int row = gw; row < MTOK; row += NGW) {
#pragma unroll
        for (int hh = 0; hh < NH; ++hh) { const int col = hh * HS + lane * EPL;
            float x[EPL]; float s = 0.f;
#pragma unroll
            for (int j = 0; j < EPL; j += 4) { const f32x4 v = *(const f32x4*)(hraw + (size_t)row * DM + col + j); x[j] = v.x; x[j + 1] = v.y; x[j + 2] = v.z; x[j + 3] = v.w; s += (v.x * v.x + v.y * v.y) + (v.z * v.z + v.w * v.w); }
            s = wave_sum(s); const float rs = rsqrtf(s * (1.0f / HS) + 1e-6f);
            unsigned outw[EPL / 2];
#pragma unroll
            for (int j = 0; j < EPL; j += 2) { const unsigned gw2 = *(const unsigned*)(P1 + (size_t)row * NQKV + 4096 + col + j); const float g0 = bflo(gw2), g1 = bfhi(gw2);
                const float a0 = ACT == 0 ? 1.0f / (1.0f + expf(-g0)) : g0 / (1.0f + expf(-g0)), a1 = ACT == 0 ? 1.0f / (1.0f + expf(-g1)) : g1 / (1.0f + expf(-g1));
                outw[j / 2] = pk2(x[j] * rs * gnorm[col + j] * a0, x[j + 1] * rs * gnorm[col + j + 1] * a1); }
            if constexpr (EPL == 4) { v2u w; w.x = outw[0]; w.y = outw[1]; *(v2u*)(hm + (size_t)row * DM + col) = w; }
            else { v4u w; w.x = outw[0]; w.y = outw[1]; w.z = outw[2]; w.w = outw[3]; *(v4u*)(hm + (size_t)row * DM + col) = w; }
        }
    }
}

DI void fox_cf(LAS unsigned char* lds, const float* G, const float* b_f, float* cf, int tid, int lane, int wave, int bx) {
    LAS float* wt = (LAS float*)lds;
    for (int item = bx; item < 256; item += gridDim.x) { const int seq = item >> 1, hf = item & 1, b = seq >> 4, h = seq & 15; const float bias = b_f[h];
        const float* gp = G + ((size_t)b * SEQ + hf * 2048 + tid * 4) * 16 + h;
        float ls[4]; float s = 0.f, s0 = 0.f;
#pragma unroll
        for (int p = 0; p < 4; ++p) { ls[p] = logsig(gp[p * 16] + bias); s += ls[p]; }
        if (hf) { const float* g0 = gp - (size_t)2048 * 16;
#pragma unroll
            for (int p = 0; p < 4; ++p) s0 += logsig(g0[p * 16] + bias); }
        const float incl = wave_incl_sum(s, lane), tot0 = wave_sum(s0);
        __syncthreads();
        if (lane == 63) wt[wave] = incl; if (lane == 0) wt[8 + wave] = tot0;
        __syncthreads();
        float base = 0.f;
#pragma unroll
        for (int w = 0; w < 8; ++w) { base += (w < wave) ? wt[w] : 0.f; base += wt[8 + w]; }
        float run = base + incl - s;
        float* o = cf + (size_t)seq * SEQ + hf * 2048 + tid * 4; f32x4 ov;
        run += ls[0]; ov.x = run; run += ls[1]; ov.y = run; run += ls[2]; ov.z = run; run += ls[3]; ov.w = run;
        *(f32x4*)o = ov;
    }
}

DI void fox_vt_pre(LAS unsigned char* lds, const bf16* P1, unsigned char* img, int lane, int wave, int bx) {
    LAS bf16* scr = (LAS bf16*)(lds + wave * 4096);
    const int gw = bx * NWAVES + wave, NGW = gridDim.x * NWAVES;
    for (int it = gw; it < 8192 * 4; it += NGW) {
        const int q = it & 3, jt = (it >> 2) & 63, bh = it >> 8, b = bh >> 4, h = bh & 15;
        const bf16* src = P1 + ((size_t)b * SEQ + jt * 64) * NQKV + 4096 + h * 128 + q * 32;
        v4u v[4];
#pragma unroll
        for (int p = 0; p < 4; ++p) { const int idx = lane + 64 * p, r = idx >> 2, c8 = idx & 3; v[p] = *(const v4u*)(src + (size_t)r * NQKV + c8 * 8); }
#pragma unroll
        for (int p = 0; p < 4; ++p) { const int idx = lane + 64 * p, r = idx >> 2, c8 = idx & 3;
#pragma unroll
            for (int j = 0; j < 4; ++j) { scr[eoff<64>(c8 * 8 + 2 * j, r)] = (bf16)(v[p][j] & 0xffffu); scr[eoff<64>(c8 * 8 + 2 * j + 1, r)] = (bf16)(v[p][j] >> 16); } }
        LDS_WAIT(); asm volatile("" ::: "memory");
        unsigned char* dst = img + ((size_t)(bh * 64 + jt)) * 16384 + q * 4096;
#pragma unroll
        for (int p = 0; p < 4; ++p) *(v4u*)(dst + (lane + 64 * p) * 16) = *(const LAS v4u*)((LAS unsigned char*)scr + (lane + 64 * p) * 16);
        LDS_WAIT(); asm volatile("" ::: "memory");
    }
}

DI void fox_attn2(LAS unsigned char* lds, const bf16* P1, const float* cf, const unsigned char* vimg, bf16* hm, int tid, int lane, int wave, int bx) {
    constexpr int BUFB = 16384 + 16384 + 256;
    const float LOG2E = 1.4426950408889634f, QS = 0.08838834764831845f * 1.4426950408889634f, THR = 8.0f;
    const int g = lane >> 4, r16 = lane & 15;
    const int G_ = gridDim.x;
    const int nit = (2048 + G_ - 1) / G_;
    for (int it = 0; it < nit; ++it) {
        const int u = (it & 1) ? it * G_ + (G_ - 1 - bx) : it * G_ + bx;
        if (u >= 2048) continue;
        const int qb = 15 - (u >> 7), bh = u & 127, b = bh >> 4, h = bh & 15;
        const size_t rowb = (size_t)b * SEQ; const int q0 = qb * 256 + 32 * wave;
        bf16x8 qf[2][4]; float c0[2];
#pragma unroll
        for (int tt = 0; tt < 2; ++tt) { const int t = q0 + 16 * tt + r16; c0[tt] = cf[(size_t)bh * SEQ + t] * LOG2E;
#pragma unroll
            for (int kk = 0; kk < 4; ++kk) { const v4u raw = *(const v4u*)(P1 + (rowb + t) * NQKV + h * 128 + 32 * kk + 8 * g); v4u sc;
#pragma unroll
                for (int j = 0; j < 4; ++j) sc[j] = pk2(bflo(raw[j]) * QS, bfhi(raw[j]) * QS);
                qf[tt][kk] = __builtin_bit_cast(bf16x8, sc); } }
        f32x4 oacc[8][2];
#pragma unroll
        for (int et = 0; et < 8; ++et) { oacc[et][0] = (f32x4){0.f, 0.f, 0.f, 0.f}; oacc[et][1] = (f32x4){0.f, 0.f, 0.f, 0.f}; }
        float lrun[2] = {0.f, 0.f};
        const int ntiles = 4 * (qb + 1);
        v4u kreg[2], vreg[2]; float cfreg = 0.f;
        const bf16* kbase = P1 + rowb * NQKV + 2048 + h * 128;
        const unsigned char* vbase = vimg + (size_t)bh * 64 * 16384;
#define FOX_LOAD(j) do { _Pragma("unroll") for (int p = 0; p < 2; ++p) { const int idx = tid + 512 * p, r = idx >> 4, c8 = idx & 15; \
            kreg[p] = *(const v4u*)(kbase + (size_t)(64 * (j) + r) * NQKV + c8 * 8); vreg[p] = *(const v4u*)(vbase + (size_t)(j) * 16384 + idx * 16); } \
            if (tid < 64) cfreg = -cf[(size_t)bh * SEQ + 64 * (j) + tid] * LOG2E; } while (0)
#define FOX_STORE(bufi) do { LAS unsigned char* bb = lds + (bufi) * BUFB; _Pragma("unroll") for (int p = 0; p < 2; ++p) { const int idx = tid + 512 * p, r = idx >> 4, c8 = idx & 15; \
            *(LAS v4u*)((LAS bf16*)bb + eoff<128>(r, c8 * 8)) = kreg[p]; *(LAS v4u*)(bb + 16384 + idx * 16) = vreg[p]; } \
            if (tid < 64) ((LAS float*)(bb + 32768))[tid] = cfreg; } while (0)
        __syncthreads();
        FOX_LOAD(0); FOX_STORE(0);
        if (ntiles > 1) FOX_LOAD(1);
        __syncthreads();
        for (int j = 0; j < ntiles; ++j) {
            if (j + 1 < ntiles) FOX_STORE((j + 1) & 1);
            if (j + 2 < ntiles) FOX_LOAD(j + 2);
            if (64 * j <= q0 + 31) {
                const LAS bf16* Ks = (const LAS bf16*)(lds + (j & 1) * BUFB); const LAS bf16* VTs = Ks + 64 * 128; const LAS float* cfs = (const LAS float*)(VTs + 128 * 64);
                f32x4 sacc[2][4];
#pragma unroll
                for (int st = 0; st < 4; ++st) { const f32x4 cv = *(const LAS f32x4*)(cfs + 16 * st + 4 * g);
#pragma unroll
                    for (int tt = 0; tt < 2; ++tt) sacc[tt][st] = cv + c0[tt]; }
#pragma unroll
                for (int st = 0; st < 4; ++st)
#pragma unroll
                    for (int kk = 0; kk < 4; ++kk) { const bf16x8 kf = ldf<128>(Ks, 16 * st + r16, 4 * kk + g);
                        sacc[0][st] = mfma16(kf, qf[0][kk], sacc[0][st]); sacc[1][st] = mfma16(kf, qf[1][kk], sacc[1][st]); if (kk == 3) asm volatile("" ::: "memory"); }
                if (64 * j + 63 > q0) {
#pragma unroll
                    for (int tt = 0; tt < 2; ++tt) { const int t = q0 + 16 * tt + r16;
#pragma unroll
                        for (int st = 0; st < 4; ++st)
#pragma unroll
                            for (int i = 0; i < 4; ++i) { const int s = 64 * j + 16 * st + 4 * g + i; if (s > t) sacc[tt][st][i] = -__builtin_inff(); } }
                }
                float mx[2];
#pragma unroll
                for (int tt = 0; tt < 2; ++tt) { float m = -__builtin_inff();
#pragma unroll
                    for (int st = 0; st < 4; ++st) m = fmaxf(m, fmaxf(fmaxf(sacc[tt][st][0], sacc[tt][st][1]), fmaxf(sacc[tt][st][2], sacc[tt][st][3])));
                    m = fmaxf(m, __shfl_xor(m, 16)); m = fmaxf(m, __shfl_xor(m, 32)); mx[tt] = m; }
                if (__any(mx[0] > THR || mx[1] > THR)) {
#pragma unroll
                    for (int tt = 0; tt < 2; ++tt) { const float sh = fmaxf(mx[tt], 0.f), f = __builtin_amdgcn_exp2f(-sh);
                        c0[tt] -= sh; lrun[tt] *= f;
#pragma unroll
                        for (int st = 0; st < 4; ++st) sacc[tt][st] = sacc[tt][st] - sh;
#pragma unroll
                        for (int et = 0; et < 8; ++et) oacc[et][tt] = oacc[et][tt] * f; }
                }
#pragma unroll
                for (int tt = 0; tt < 2; ++tt) { float ls = 0.f;
#pragma unroll
                    for (int st = 0; st < 4; ++st)
#pragma unroll
                        for (int i = 0; i < 4; ++i) { const float p = __builtin_amdgcn_exp2f(sacc[tt][st][i]); sacc[tt][st][i] = p; ls += p; }
                    lrun[tt] += ls; }
#pragma unroll
                for (int ks = 0; ks < 2; ++ks) { bf16x8 pb[2];
#pragma unroll
                    for (int tt = 0; tt < 2; ++tt) { v4u w; w.x = pk2(sacc[tt][2 * ks][0], sacc[tt][2 * ks][1]); w.y = pk2(sacc[tt][2 * ks][2], sacc[tt][2 * ks][3]);
                        w.z = pk2(sacc[tt][2 * ks + 1][0], sacc[tt][2 * ks + 1][1]); w.w = pk2(sacc[tt][2 * ks + 1][2], sacc[tt][2 * ks + 1][3]); pb[tt] = __builtin_bit_cast(bf16x8, w); }
#pragma unroll
                    for (int et = 0; et < 8; ++et) { const int e = 16 * et + r16;
                        const v2u lo = *(const LAS v2u*)(VTs + eoff<64>(e, 32 * ks + 4 * g)), hi = *(const LAS v2u*)(VTs + eoff<64>(e, 32 * ks + 16 + 4 * g));
                        v4u aw; aw.x = lo.x; aw.y = lo.y; aw.z = hi.x; aw.w = hi.y; const bf16x8 va = __builtin_bit_cast(bf16x8, aw);
                        oacc[et][0] = mfma16(va, pb[0], oacc[et][0]); oacc[et][1] = mfma16(va, pb[1], oacc[et][1]); if (et & 1) asm volatile("" ::: "memory"); } }
            }
            __syncthreads();
        }
#undef FOX_LOAD
#undef FOX_STORE
#pragma unroll
        for (int tt = 0; tt < 2; ++tt) { float l = lrun[tt]; l += __shfl_xor(l, 16); l += __shfl_xor(l, 32); const float inv = 1.0f / l;
            bf16* orow = hm + (rowb + q0 + 16 * tt + r16) * DM + h * 128 + 4 * g;
#pragma unroll
            for (int et = 0; et < 8; ++et) { v2u w; w.x = pk2(oacc[et][tt][0] * inv, oacc[et][tt][1] * inv); w.y = pk2(oacc[et][tt][2] * inv, oacc[et][tt][3] * inv); *(v2u*)(orow + 16 * et) = w; } }
    }
}


DI void final_norm(float* out, const long long* ss, const float* gfin, int lane, int wave, int bx) {
    const int gw = bx * NWAVES + wave, NGW = gridDim.x * NWAVES;
    for (int m = gw; m < MTOK; m += NGW) { const float rs = pg8::rstd_of(ss, m);
        f32x4* xr = (f32x4*)(out + (size_t)m * DM) + lane; const f32x4* gr = (const f32x4*)gfin + lane;
#pragma unroll
        for (int j = 0; j < 8; ++j) { const f32x4 v = xr[64 * j], gg = gr[64 * j]; xr[64 * j] = v * rs * gg; } }
}

#define PH(p) if (lo <= (p) && (p) < hi && (ran ? (xcd_barrier(bar), true) : (ran = true)))
#define TID() int tid = threadIdx.x; asm volatile("" : "+v"(tid)); const int lane = tid & 63, wave = __builtin_amdgcn_readfirstlane(tid >> 6); int bx = blockIdx.x; asm volatile("" : "+s"(bx)); (void)lane; (void)wave; (void)bx
#define WSP(T, off) ((T*)(ka->ws + (off)))
template <int j> DI void subblock(LAS unsigned char* lds, const XcdBarrier& bar, const int lo, const int hi, bool& ran) {
    {
        constexpr int layer = j / 3, typ = j - 3 * layer, base = 1 + 5 * j;
        if constexpr (typ != 1) {
            PH(base) { TID(); KArgs ka = kargs(); const int mi = layer * 2 + (typ >> 1);
                pg8::Gemm gm{WSP(bf16, WS_HB), WSP(bf16, WS_WUP) + (size_t)mi * NUP * DM, MTOK, NUP, DM}; pg8::StaticOrder S; S.init(MTOK, NUP, gridDim.x, bx);
                pg8::EpiSwiGLU E{WSP(bf16, WS_ACT), WSP(long long, WS_SS) + (size_t)j * MTOK, DFF};
                pg8::gemm_phase<pg8::EpiSwiGLU, pg8::StaticOrder, PG8_ALIGN, PG8_SP2>(lds, gm, S, E); }
        } else {
            constexpr int kind = layer % 3, ji = layer / 3;
            PH(base) { TID(); KArgs ka = kargs();
                mixer_gates(WSP(bf16, WS_HB), WSP(bf16, WS_WIN) + ((size_t)layer * NINP + NQKV) * DM, WSP(long long, WS_SS) + (size_t)j * MTOK, WSP(float, WS_G), lane, wave, bx);
                pg8::Gemm gm{WSP(bf16, WS_HB), WSP(bf16, WS_WIN) + (size_t)layer * NINP * DM, MTOK, NQKV, DM}; pg8::StaticOrder S; S.init(MTOK, NQKV, gridDim.x, bx);
                pg8::EpiMixIn E{WSP(bf16, WS_P1), WSP(long long, WS_SS) + (size_t)j * MTOK};
                pg8::gemm_phase<pg8::EpiMixIn, pg8::StaticOrder, PG8_ALIGN, PG8_SP2>(lds, gm, S, E); }
            PH(base + 1) { TID(); KArgs ka = kargs();
                if constexpr (kind == 0) for (int rep = 0; rep < REP_MLSTM; ++rep) mlstm_pre(lds, WSP(bf16, WS_P1), WSP(float, WS_G), ka->in[6] + ji * 16, WSP(unsigned char, WS_ACT), tid, lane, wave, bx);
                else if constexpr (kind == 1) { fox_cf(lds, WSP(float, WS_G), ka->in[10] + ji * 16, WSP(float, WS_CF), tid, lane, wave, bx); __syncthreads(); fox_vt_pre(lds, WSP(bf16, WS_P1), WSP(unsigned char, WS_ACT), lane, wave, bx); }
                else for (int rep = 0; rep < REP_GLA; ++rep) gla_pre(lds, WSP(bf16, WS_P1), WSP(float, WS_G), ka->in[13] + (size_t)ji * 16 * 1024, ka->in[14] + ji * 1024, WSP(unsigned char, WS_ACT), tid, lane, wave, bx);
            }
            PH(base + 2) { TID(); KArgs ka = kargs();
                if constexpr (kind == 0) for (int rep = 0; rep < REP_MLSTM; ++rep) mlstm_scan2(lds, WSP(bf16, WS_P1), WSP(unsigned char, WS_ACT), WSP(float, WS_HRAW), tid, lane, wave, bx);
                else if constexpr (kind == 1) for (int rep = 0; rep < REP_FOX; ++rep) fox_attn2(lds, WSP(bf16, WS_P1), WSP(float, WS_CF), WSP(unsigned char, WS_ACT), WSP(bf16, WS_HM), tid, lane, wave, bx);
                else for (int rep = 0; rep < REP_GLA; ++rep) gla_scan2(lds, WSP(unsigned char, WS_ACT), WSP(float, WS_HRAW), tid, lane, wave, bx);
            }
            if constexpr (kind != 1) { PH(base + 3) { TID(); KArgs ka = kargs();
                if constexpr (kind == 0) headnorm_gate<256, 0>(WSP(float, WS_HRAW), WSP(bf16, WS_P1), ka->in[7] + ji * DM, WSP(bf16, WS_HM), lane, wave, bx);
                else headnorm_gate<512, 1>(WSP(float, WS_HRAW), WSP(bf16, WS_P1), ka->in[15] + ji * DM, WSP(bf16, WS_HM), lane, wave, bx);
            } }
        }
        PH(base + 4) { TID(); KArgs ka = kargs();
            pg8::Gemm gm; float scale;
            if constexpr (typ != 1) { const int mi = layer * 2 + (typ >> 1); gm = pg8::Gemm{WSP(bf16, WS_ACT), WSP(bf16, WS_WDN) + (size_t)mi * DM * DFF, MTOK, DM, DFF}; scale = 0.5f; }
            else { gm = pg8::Gemm{WSP(bf16, WS_HM), WSP(bf16, WS_WOUT) + (size_t)layer * DM * DM, MTOK, DM, DM}; scale = 1.0f; }
            pg8::StaticOrder S; S.init(MTOK, DM, gridDim.x, bx);
            pg8::EpiResid E{(j == 0) ? ka->in[0] : (const float*)ka->out, ka->out, WSP(bf16, WS_HB), WSP(long long, WS_SS) + (size_t)(j + 1) * MTOK, scale};
            pg8::gemm_phase<pg8::EpiResid, pg8::StaticOrder, PG8_ALIGN, PG8_SP2>(lds, gm, S, E);
        }
    }
}

__global__ void __launch_bounds__(NWAVES * 64, 2) trunk_fwd(Args args) {
    extern __shared__ __attribute__((aligned(16))) unsigned char lds_raw[];
    LAS unsigned char* lds = (LAS unsigned char*)lds_raw;
    volatile LAS unsigned* MISC = (volatile LAS unsigned*)(lds + MISC_OFF);
    for (int u = threadIdx.x; u < (LDS_BYTES - MISC_OFF) / 4; u += NWAVES * 64) ((LAS unsigned*)(lds + MISC_OFF))[u] = 0u;
    __syncthreads();
    XcdBarrier bar = xcd_barrier_post((unsigned*)(args.ws + WS_CTL) + CW_BAR, MISC + 8);
    const int lo = args.ph_lo, hi = args.ph_hi; bool ran = false;

    PH(0) { TID(); for (int rep = 0; rep < REP_PRO; ++rep) { prologue(lds, lane, wave, bx); __syncthreads(); } }

    subblock<0>(lds, bar, lo, hi, ran); subblock<1>(lds, bar, lo, hi, ran); subblock<2>(lds, bar, lo, hi, ran); subblock<3>(lds, bar, lo, hi, ran);
    subblock<4>(lds, bar, lo, hi, ran); subblock<5>(lds, bar, lo, hi, ran); subblock<6>(lds, bar, lo, hi, ran); subblock<7>(lds, bar, lo, hi, ran);
    subblock<8>(lds, bar, lo, hi, ran); subblock<9>(lds, bar, lo, hi, ran); subblock<10>(lds, bar, lo, hi, ran); subblock<11>(lds, bar, lo, hi, ran);
    PH(NPHASE - 1) { TID(); KArgs ka = kargs(); final_norm(ka->out, WSP(long long, WS_SS) + (size_t)NSUB * MTOK, ka->in[17], lane, wave, bx); }
#undef WSP
#undef PH
}

static bool phase_exists(int p) {
    if (p == 0 || p == NPHASE - 1) return true;
    const int j = (p - 1) / 5, k = (p - 1) % 5, typ = j % 3;
    if (k == 0 || k == 4) return true;
    if (typ != 1) return false;
    if (k == 3) return ((j / 3) % 3) != 1;
    return true;
}
extern "C" void kernel_launch(void* const* d_in, const int* in_sizes, int n_in, void* d_out, int out_size, void* d_ws, size_t ws_size, hipStream_t stream) {
    static int grid = 0;
    if (grid == 0) {
        if (n_in != 18 || in_sizes[0] != MTOK * DM || out_size != MTOK * DM || ws_size < WS_END) { fprintf(stderr, "kernel_launch: unexpected shapes (n_in %d, in0 %d, out %d, ws %zu < %zu)\n", n_in, n_in > 0 ? in_sizes[0] : -1, out_size, ws_size, (size_t)WS_END); grid = -1; return; }
        int dev = 0, cus = 0, per_cu = 0;
        if (hipGetDevice(&dev) != hipSuccess || hipDeviceGetAttribute(&cus, hipDeviceAttributeMultiprocessorCount, dev) != hipSuccess) { grid = -1; return; }
        if (hipFuncSetAttribute((const void*)trunk_fwd, hipFuncAttributeMaxDynamicSharedMemorySize, LDS_BYTES) != hipSuccess) { fprintf(stderr, "kernel_launch: hipFuncSetAttribute failed\n"); grid = -1; return; }
        if (hipOccupancyMaxActiveBlocksPerMultiprocessor(&per_cu, (const void*)trunk_fwd, NWAVES * 64, LDS_BYTES) != hipSuccess || per_cu < 1) fprintf(stderr, "kernel_launch: occupancy query says %d\n", per_cu);
        (void)hipGetLastError();
        grid = cus;
    }
    if (grid < 0) return;
    if (hipMemsetAsync((char*)d_ws + WS_CTL, 0, CTL_ZERO_BYTES, stream) != hipSuccess) return;
    Args a{};
    for (int i = 0; i < 18; ++i) a.in[i] = (const float*)d_in[i];
    a.out = (float*)d_out; a.ws = (unsigned char*)d_ws;
#if MK_PER_PHASE
    for (int p = 0; p < NPHASE; ++p) { if (!phase_exists(p)) continue; a.ph_lo = p; a.ph_hi = p + 1; hipLaunchKernelGGL(trunk_fwd, dim3(grid), dim3(NWAVES * 64), LDS_BYTES, stream, a); }
#else
    a.ph_lo = 0; a.ph_hi = NPHASE; hipLaunchKernelGGL(trunk_fwd, dim3(grid), dim3(NWAVES * 64), LDS_BYTES, stream, a);
#endif
    (void)phase_exists;
}
```

```cpp
#include <hip/hip_runtime.h>
#include <cstdio>
#include <cstdint>
namespace pg8 {
#define PG8_LAS __attribute__((address_space(3)))
typedef unsigned short bf16_t;
typedef short bf16x8 __attribute__((ext_vector_type(8)));
typedef float f32x4 __attribute__((ext_vector_type(4)));
typedef unsigned u32x4 __attribute__((ext_vector_type(4)));
constexpr int BM = 256, BK = 64, HALF = 128, HTB = HALF * BK * 2  , STAGE_BYTES = 8 * HTB, NXCD = 8, WGM = 8;

__host__ __device__ __forceinline__ int lds_byte(int r, int c) { const int st = (r >> 4) * 2 + (c >> 5), rr = r & 15, cc = c & 31, ob = rr * 64 + cc * 2; return st * 1024 + (ob ^ (((ob >> 9) & 1) << 5)); }
__host__ __device__ __forceinline__ void stage_rc(int b, int& R, int& C) { const int st = b / 1024, sb = b % 1024, swz = sb ^ (((sb >> 9) & 1) << 5); R = (st >> 1) * 16 + swz / 64; C = (st & 1) * 32 + (swz % 64) / 2; }
__host__ __device__ __forceinline__ int perm32(int rho) { const int n = rho >> 4, i = rho & 15; return 8 * (i >> 2) + 4 * n + (i & 3); }

struct Unit { int pm, pn; };
struct Gemm { const bf16_t* A; const bf16_t* Bt; int M, N, K; };

struct StaticOrder {
    int nM, nN, nwg, G, c;
    __host__ __device__ void init(int M, int N, int G_, int c_) { nM = M / BM; nN = N / BM; nwg = nM * nN; G = G_; c = c_; }
    __host__ __device__ bool next(int i, Unit& u) const {
        const long L = (long)i * G + c; if (L >= nwg) return false;
        int wgid = (int)L; { const int q = nwg / NXCD, r = nwg % NXCD, xcd = wgid % NXCD, off = wgid / NXCD; wgid = (xcd < r ? xcd * (q + 1) : r * (q + 1) + (xcd - r) * q) + off; }
        const int nig = WGM * nN, gid = wgid / nig, fm = gid * WGM, gsz = (nM - fm) < WGM ? (nM - fm) : WGM;
        u.pm = fm + ((wgid % nig) % gsz); u.pn = (wgid % nig) / gsz; return true;
    }
    __device__ __forceinline__ void a_ready(const Unit&) const {}
    __device__ __forceinline__ void done(const Unit&) const {}
};

__device__ __forceinline__ unsigned cvt_pk_bf16(float lo, float hi) { unsigned r; asm volatile("v_cvt_pk_bf16_f32 %0, %1, %2" : "=v"(r) : "v"(lo), "v"(hi)); return r; }
constexpr float RMS_EPS_F = 1e-6f, SS_FIX = 1048576.0f, SS_UNFIX_D = 1.0f / (1048576.0f * 2048.0f);
typedef long long ss_t;
__device__ __forceinline__ float rstd_of(const ss_t* ss, int row) { return rsqrtf((float)ss[row] * SS_UNFIX_D + RMS_EPS_F); }
template <class Sched> __device__ __forceinline__ int rstd_table_fill(const Sched& S, const ss_t* ss, PG8_LAS unsigned char* ext, int tid) {
    PG8_LAS float* tab = (PG8_LAS float*)ext; int key0 = -1, key1 = -1, bad = 0; Unit u;
    for (int i = 0; S.next(i, u); ++i) { const int slot = (u.pm >> 3) & 1; const int key = slot ? key1 : key0;
        if (key == u.pm) continue;
        if (key >= 0) { bad = 1; continue; }
        if (slot) key1 = u.pm; else key0 = u.pm;
        if (tid < 256) tab[slot * 256 + tid] = rstd_of(ss, u.pm * BM + tid); }
    asm volatile("s_waitcnt lgkmcnt(0)" ::: "memory"); __builtin_amdgcn_s_barrier(); asm volatile("" ::: "memory");
    return bad;
}
__device__ __forceinline__ float rstd_get(const ss_t* ss, const Unit& u, int row, int pf, const PG8_LAS unsigned char* ext) {
    return pf ? rstd_of(ss, row) : ((const PG8_LAS float*)ext)[((u.pm >> 3) & 1) * 256 + (row - u.pm * BM)];
}
struct EpiSwiGLU {
    static constexpr bool PERM = true, AFTER_DRAIN = false;
    bf16_t* O; const ss_t* ss; int ldo;
    template <class Sched> __device__ __forceinline__ int prepare(const Sched& S, PG8_LAS unsigned char* ext, int tid) const { return rstd_table_fill(S, ss, ext, tid); }
    __device__ __forceinline__ void operator()(const f32x4 (&acc)[2][2][4][2], const Unit& u, int wr, int wc, int fr, int fq, int pf, const PG8_LAS unsigned char* ext) const {
        const int row0 = u.pm * BM + wr * 64 + fr, col0 = u.pn * HALF + wc * 32 + 8 * fq;
#pragma unroll
        for (int ai = 0; ai < 2; ++ai)
#pragma unroll
            for (int m = 0; m < 4; ++m) {
                const int row = row0 + ai * HALF + m * 16;
                const float rs = rstd_get(ss, u, row, pf, ext);
                float o[8];
#pragma unroll
                for (int n = 0; n < 2; ++n)
#pragma unroll
                    for (int j = 0; j < 4; ++j) { const float a = acc[ai][0][m][n][j] * rs, b = acc[ai][1][m][n][j] * rs;
                        o[4 * n + j] = a * b * __builtin_amdgcn_rcpf(1.0f + __expf(-a)); }
                u32x4 w; w.x = cvt_pk_bf16(o[0], o[1]); w.y = cvt_pk_bf16(o[2], o[3]); w.z = cvt_pk_bf16(o[4], o[5]); w.w = cvt_pk_bf16(o[6], o[7]);
                *(u32x4*)(O + (size_t)row * ldo + col0) = w;
            }
    }
};
struct EpiMixIn {
    static constexpr bool PERM = true, AFTER_DRAIN = false;
    bf16_t* O; const ss_t* ss;
    template <class Sched> __device__ __forceinline__ int prepare(const Sched& S, PG8_LAS unsigned char* ext, int tid) const { return rstd_table_fill(S, ss, ext, tid); }
    __device__ __forceinline__ void operator()(const f32x4 (&acc)[2][2][4][2], const Unit& u, int wr, int wc, int fr, int fq, int pf, const PG8_LAS unsigned char* ext) const {
        const int row0 = u.pm * BM + wr * 64 + fr, col0 = u.pn * BM + wc * 32 + 8 * fq;
#pragma unroll
        for (int ai = 0; ai < 2; ++ai)
#pragma unroll
            for (int m = 0; m < 4; ++m) {
                const int row = row0 + ai * HALF + m * 16;
                const float rs = rstd_get(ss, u, row, pf, ext);
#pragma unroll
                for (int bj = 0; bj < 2; ++bj) { const f32x4 v0 = acc[ai][bj][m][0] * rs, v1 = acc[ai][bj][m][1] * rs;
                    u32x4 w; w.x = cvt_pk_bf16(v0[0], v0[1]); w.y = cvt_pk_bf16(v0[2], v0[3]); w.z = cvt_pk_bf16(v1[0], v1[1]); w.w = cvt_pk_bf16(v1[2], v1[3]);
                    *(u32x4*)(O + (size_t)row * 6144 + col0 + bj * HALF) = w; }
            }
    }
};
struct EpiResid {
    static constexpr bool PERM = false, AFTER_DRAIN = false;
    const float* res; float* hout; bf16_t* hb; ss_t* ssn; float scale;
    template <class Sched> __device__ __forceinline__ int prepare(const Sched&, PG8_LAS unsigned char*, int) const { return 0; }
    __device__ __forceinline__ void operator()(const f32x4 (&acc)[2][2][4][2], const Unit& u, int wr, int wc, int fr, int fq, int pf, const PG8_LAS unsigned char* ext) const {
        typedef unsigned u32x2v __attribute__((ext_vector_type(2)));
        const int row0 = u.pm * BM + wr * 64 + fr, col0 = u.pn * BM + wc * 32 + 4 * fq;
        f32x4 rb[3][4];
#define PG8_LDG(gi, buf) do { const size_t off_ = (size_t)(row0 + ((gi) >> 2) * HALF + ((gi) & 3) * 16) * 2048 + col0; \
            _Pragma("unroll") for (int q_ = 0; q_ < 4; ++q_) buf[q_] = *(const f32x4*)(res + off_ + (q_ >> 1) * HALF + (q_ & 1) * 16); } while (0)
        PG8_LDG(0, rb[0]); PG8_LDG(1, rb[1]);
#pragma unroll
        for (int gi = 0; gi < 8; ++gi) {
            if (gi + 2 < 8) PG8_LDG(gi + 2, rb[(gi + 2) % 3]);
            const int ai = gi >> 2, m = gi & 3;
            const int row = row0 + ai * HALF + m * 16; const size_t off = (size_t)row * 2048 + col0; float sq = 0.f;
#pragma unroll
            for (int q = 0; q < 4; ++q) { const int bj = q >> 1, n = q & 1; const size_t o2 = off + bj * HALF + n * 16;
                const f32x4 hn = rb[gi % 3][q] + acc[ai][bj][m][n] * scale;
                *(f32x4*)(hout + o2) = hn; u32x2v w; w.x = cvt_pk_bf16(hn[0], hn[1]); w.y = cvt_pk_bf16(hn[2], hn[3]); *(u32x2v*)(hb + o2) = w;
                sq += (hn[0] * hn[0] + hn[1] * hn[1]) + (hn[2] * hn[2] + hn[3] * hn[3]); }
            sq += __shfl_xor(sq, 16); sq += __shfl_xor(sq, 32);
            if (fq == 0) atomicAdd((unsigned long long*)(ssn + row), (unsigned long long)__float2ll_rn(sq * SS_FIX));
        }
#undef PG8_LDG
    }
};

template <class Epi, class Sched, bool ALIGN_EPI = false, bool SP2 = false>
__device__ __forceinline__ void gemm_phase(PG8_LAS unsigned char* lds, const Gemm g, const Sched& S, const Epi& E) {
    int tid_ = threadIdx.x; asm volatile("" : "+v"(tid_));
    const int tid = tid_, wid = __builtin_amdgcn_readfirstlane(tid >> 6), lane = tid & 63, wr = wid >> 2, wc = wid & 3, fr = lane & 15, fq = lane >> 4;
    const int K = g.K, nt = K / BK;
    unsigned voffA[2], voffB[2];
#pragma unroll
    for (int i = 0; i < 2; ++i) { int R, C; stage_rc(tid * 16 + i * 8192, R, C); const int Rb = Epi::PERM ? ((R & ~31) + perm32(R & 31)) : R;
        voffA[i] = (unsigned)(R * K + C) * 2u; voffB[i] = (unsigned)(Rb * K + C) * 2u; }
    const size_t kstep = (size_t)(BK * 2);
    const size_t hstep = (size_t)HALF * K * 2;
    const size_t tstep = 2 * hstep;
    const unsigned ldsw = (unsigned)wid * 1024u;
    const int aoff = lds_byte(wr * 64 + fr, fq * 8), boff = lds_byte(wc * 32 + fr, fq * 8);
#define PG8_SA(b, h) (((b) * 2 + (h)) * HTB)
#define PG8_SB(b, h) ((4 + (b) * 2 + (h)) * HTB)
#define PG8_STAGE(bufoff, gbase, voff) do { _Pragma("unroll") for (int _i = 0; _i < 2; ++_i) \
        __builtin_amdgcn_global_load_lds((const unsigned*)((const char*)(gbase) + (voff)[_i]), (PG8_LAS unsigned*)(lds + (bufoff) + ldsw + _i * 8192), 16, 0, 0); } while (0)
#define PG8_LDA(dst, b, h) do { _Pragma("unroll") for (int m = 0; m < 4; ++m) _Pragma("unroll") for (int k = 0; k < 2; ++k) dst[m][k] = *(const PG8_LAS bf16x8*)(lds + PG8_SA(b, h) + aoff + m * 2048 + k * 1024); } while (0)
#define PG8_LDB(dst, b, h) do { _Pragma("unroll") for (int n = 0; n < 2; ++n) _Pragma("unroll") for (int k = 0; k < 2; ++k) dst[n][k] = *(const PG8_LAS bf16x8*)(lds + PG8_SB(b, h) + boff + n * 2048 + k * 1024); } while (0)
#define PG8_MMA(ai, bj, At, Bt) do { __builtin_amdgcn_s_setprio(1); _Pragma("unroll") for (int m = 0; m < 4; ++m) _Pragma("unroll") for (int n = 0; n < 2; ++n) _Pragma("unroll") for (int k = 0; k < 2; ++k) \
        acc[ai][bj][m][n] = __builtin_amdgcn_mfma_f32_16x16x32_bf16(Bt[n][k], At[m][k], acc[ai][bj][m][n], 0, 0, 0); __builtin_amdgcn_s_setprio(0); } while (0)
#define PG8_WAIT_V(n) asm volatile("s_waitcnt vmcnt(" #n ")" ::: "memory")
#define PG8_WAIT_L(n) asm volatile("s_waitcnt lgkmcnt(" #n ")" ::: "memory")
#define PG8_BAR __builtin_amdgcn_s_barrier()
#define PG8_SCHED __builtin_amdgcn_sched_barrier(0)
    const int pf = E.prepare(S, lds + STAGE_BYTES, tid);
    Unit cur, nxt; int ui = 0;
    if (!S.next(0, cur)) return;
    f32x4 acc[2][2][4][2];
#pragma unroll
    for (int a = 0; a < 2; ++a)
#pragma unroll
        for (int b = 0; b < 2; ++b)
#pragma unroll
            for (int m = 0; m < 4; ++m)
#pragma unroll
                for (int n = 0; n < 2; ++n) acc[a][b][m][n] = (f32x4){0.f, 0.f, 0.f, 0.f};
    bf16x8 At[4][2], B0[2][2], B1[2][2];
    const char* cA = (const char*)g.A + (size_t)cur.pm * tstep; const char* cB = (const char*)g.Bt + (size_t)cur.pn * tstep;
    S.a_ready(cur);
    if constexpr (SP2) {
        PG8_STAGE(PG8_SB(0, 0), cB, voffB); PG8_STAGE(PG8_SB(0, 1), cB + hstep, voffB); PG8_STAGE(PG8_SA(0, 0), cA, voffA); PG8_STAGE(PG8_SA(0, 1), cA + hstep, voffA);
        if (wr == 1) PG8_BAR;
        PG8_WAIT_V(2); PG8_BAR;
        PG8_STAGE(PG8_SB(1, 0), cB + kstep, voffB); PG8_STAGE(PG8_SA(1, 0), cA + kstep, voffA); PG8_STAGE(PG8_SB(1, 1), cB + hstep + kstep, voffB);
        PG8_WAIT_V(6); PG8_BAR;
    } else {
        PG8_STAGE(PG8_SB(0, 0), cB, voffB); PG8_STAGE(PG8_SA(0, 0), cA, voffA); PG8_STAGE(PG8_SB(0, 1), cB + hstep, voffB); PG8_STAGE(PG8_SA(0, 1), cA + hstep, voffA);
        if (wr == 1) PG8_BAR;
        PG8_WAIT_V(4); PG8_BAR;
        PG8_STAGE(PG8_SB(1, 0), cB + kstep, voffB); PG8_STAGE(PG8_SA(1, 0), cA + kstep, voffA); PG8_STAGE(PG8_SB(1, 1), cB + hstep + kstep, voffB);
        PG8_WAIT_V(6); PG8_BAR;
    }
    for (;;) {
        const bool has_next = S.next(ui + 1, nxt);
        const char* nA = has_next ? (const char*)g.A + (size_t)nxt.pm * tstep : cA; const char* nB = has_next ? (const char*)g.Bt + (size_t)nxt.pn * tstep : cB;
        for (int t = 0; t < nt; t += 2) {
            const bool last = (t == nt - 2);
            const char* a1 = cA + (size_t)(t + 1) * kstep;
            const char* a2 = last ? nA : cA + (size_t)(t + 2) * kstep; const char* b2 = last ? nB : cB + (size_t)(t + 2) * kstep;
            const char* a3 = a2 + kstep; const char* b3 = b2 + kstep;
            if (last && has_next) S.a_ready(nxt);
            if constexpr (SP2) {
            PG8_LDB(B0, 0, 0); PG8_LDB(B1, 0, 1); PG8_SCHED; PG8_LDA(At, 0, 0); PG8_STAGE(PG8_SA(1, 1), a1 + hstep, voffA);
            PG8_WAIT_V(8); PG8_WAIT_L(0); PG8_BAR; PG8_MMA(0, 0, At, B0); PG8_MMA(0, 1, At, B1); PG8_BAR; PG8_SCHED;
            PG8_LDA(At, 0, 1); PG8_STAGE(PG8_SB(0, 0), b2, voffB); PG8_STAGE(PG8_SB(0, 1), b2 + hstep, voffB); PG8_STAGE(PG8_SA(0, 0), a2, voffA);
            PG8_WAIT_V(8); PG8_WAIT_L(0); PG8_BAR; PG8_MMA(1, 0, At, B0); PG8_MMA(1, 1, At, B1); PG8_BAR; PG8_SCHED;
            PG8_LDB(B0, 1, 0); PG8_LDB(B1, 1, 1); PG8_SCHED; PG8_LDA(At, 1, 0); PG8_STAGE(PG8_SA(0, 1), a2 + hstep, voffA);
            PG8_WAIT_V(8); PG8_WAIT_L(0); PG8_BAR; PG8_MMA(0, 0, At, B0); PG8_MMA(0, 1, At, B1); PG8_BAR; PG8_SCHED;
            PG8_LDA(At, 1, 1); PG8_STAGE(PG8_SB(1, 0), b3, voffB); PG8_STAGE(PG8_SB(1, 1), b3 + hstep, voffB); PG8_STAGE(PG8_SA(1, 0), a3, voffA);
            PG8_WAIT_V(8); PG8_WAIT_L(0); PG8_BAR; PG8_MMA(1, 0, At, B0); PG8_MMA(1, 1, At, B1); PG8_BAR; PG8_SCHED;
            } else {
            PG8_LDB(B0, 0, 0); PG8_SCHED; PG8_LDA(At, 0, 0); PG8_STAGE(PG8_SA(1, 1), a1 + hstep, voffA);
            PG8_WAIT_L(8); PG8_BAR; PG8_WAIT_L(0); PG8_MMA(0, 0, At, B0); PG8_BAR; PG8_SCHED;
            PG8_LDB(B1, 0, 1); PG8_STAGE(PG8_SB(0, 0), b2, voffB);
            PG8_BAR; PG8_WAIT_L(0); PG8_MMA(0, 1, At, B1); PG8_BAR;
            PG8_LDA(At, 0, 1); PG8_STAGE(PG8_SA(0, 0), a2, voffA);
            PG8_BAR; PG8_WAIT_L(0); PG8_MMA(1, 0, At, B0); PG8_BAR; PG8_SCHED;
            PG8_STAGE(PG8_SB(0, 1), b2 + hstep, voffB);
            PG8_WAIT_V(6); PG8_BAR; PG8_MMA(1, 1, At, B1); PG8_BAR;
            PG8_LDB(B0, 1, 0); PG8_SCHED; PG8_LDA(At, 1, 0); PG8_STAGE(PG8_SA(0, 1), a2 + hstep, voffA);
            PG8_WAIT_L(8); PG8_BAR; PG8_WAIT_L(0); PG8_MMA(0, 0, At, B0); PG8_BAR; PG8_SCHED;
            PG8_LDB(B1, 1, 1); PG8_STAGE(PG8_SB(1, 0), b3, voffB);
            PG8_BAR; PG8_WAIT_L(0); PG8_MMA(0, 1, At, B1); PG8_BAR;
            PG8_LDA(At, 1, 1); PG8_STAGE(PG8_SA(1, 0), a3, voffA);
            PG8_BAR; PG8_WAIT_L(0); PG8_MMA(1, 0, At, B0); PG8_BAR; PG8_SCHED;
            PG8_STAGE(PG8_SB(1, 1), b3 + hstep, voffB);
            PG8_WAIT_V(6); PG8_BAR; PG8_MMA(1, 1, At, B1); PG8_BAR;
            }
        }
        if constexpr (ALIGN_EPI) { if (wr == 0) PG8_BAR; }
        if constexpr (!Epi::AFTER_DRAIN) { E(acc, cur, wr, wc, fr, fq, pf, lds + STAGE_BYTES); S.done(cur); }
        if (!has_next) break;
#pragma unroll
        for (int a = 0; a < 2; ++a)
#pragma unroll
            for (int b = 0; b < 2; ++b)
#pragma unroll
                for (int m = 0; m < 4; ++m)
#pragma unroll
                    for (int n = 0; n < 2; ++n) acc[a][b][m][n] = (f32x4){0.f, 0.f, 0.f, 0.f};
        cur = nxt; cA = nA; cB = nB; ++ui;
        if constexpr (ALIGN_EPI) { if (wr == 1) PG8_BAR; }
    }
    PG8_WAIT_V(0);
    if constexpr (!ALIGN_EPI) { if (wr == 0) PG8_BAR; }
    PG8_BAR;
    if constexpr (Epi::AFTER_DRAIN) { E.fused(acc, cur, wr, wc, fr, fq, lds, wid, lane); S.done(cur); }
#undef PG8_SA
#undef PG8_SB
#undef PG8_STAGE
#undef PG8_LDA
#undef PG8_LDB
#undef PG8_MMA
#undef PG8_WAIT_V
#undef PG8_WAIT_L
#undef PG8_BAR
#undef PG8_SCHED
}
}

#ifndef PG8_SP2
#define PG8_SP2 true
#endif
#ifndef PG8_ALIGN
#define PG8_ALIGN true
#endif
#ifndef REP_PRO
#define REP_PRO 1
#endif
#ifndef REP_MLSTM
#define REP_MLSTM 1
#endif
#ifndef REP_FOX
#define REP_FOX 1
#endif
#ifndef REP_GLA
#define REP_GLA 1
#endif
#ifndef MK_PER_PHASE
#define MK_PER_PHASE 0
#endif

constexpr int DM = 2048, BATCH = 8, SEQ = 4096, MTOK = BATCH * SEQ, DEPTH = 4, DFF = 5632, NUP = 2 * DFF, NIN = 6160, NINP = 6400, NQKV = 6144;
constexpr int NWAVES = 8;
constexpr int NSUB = 3 * DEPTH;
constexpr int NPHASE = 2 + 5 * NSUB;

constexpr size_t MiB = 1u << 20;
constexpr size_t WS_CTL = 0, CTL_ZERO_BYTES = 5 * MiB;
constexpr size_t WS_SS = 1 * MiB;
constexpr size_t WS_WUP = 8 * MiB;
constexpr size_t WS_WDN = WS_WUP + 352 * MiB;
constexpr size_t WS_WIN = WS_WDN + 176 * MiB;
constexpr size_t WS_WOUT = WS_WIN + 100 * MiB;
constexpr size_t WS_HB = WS_WOUT + 32 * MiB;
constexpr size_t WS_ACT = WS_HB + 128 * MiB;
constexpr size_t WS_P1 = WS_ACT + 352 * MiB;
constexpr size_t WS_G = WS_P1 + 384 * MiB;
constexpr size_t WS_HRAW = WS_G + 2 * MiB;
constexpr size_t WS_HM = WS_HRAW + 256 * MiB;
constexpr size_t WS_CF = WS_HM + 128 * MiB;
constexpr size_t WS_END = WS_CF + 2 * MiB;
static_assert((size_t)8 * NUP * DM * 2 == 352 * MiB && (size_t)8 * DM * DFF * 2 == 176 * MiB && (size_t)4 * NINP * DM * 2 == 100 * MiB, "weight regions");
static_assert((size_t)MTOK * DFF * 2 == 352 * MiB && (size_t)MTOK * NQKV * 2 == 384 * MiB && WS_SS + 13 * (size_t)MTOK * 8 <= CTL_ZERO_BYTES, "activation regions");
constexpr int CW_BAR = 4096;

constexpr int LDS_BYTES = 153600, MISC_OFF = 152576;

#define GAS __attribute__((address_space(1)))
#define LAS __attribute__((address_space(3)))
#define DI __device__ __forceinline__
typedef unsigned short bf16;
typedef unsigned v4u __attribute__((ext_vector_type(4)));
typedef unsigned v2u __attribute__((ext_vector_type(2)));
typedef float f32x4 __attribute__((ext_vector_type(4)));
typedef short bf16x8 __attribute__((ext_vector_type(8)));
typedef GAS unsigned gu32;
#define RLX_AGENT __ATOMIC_RELAXED, __HIP_MEMORY_SCOPE_AGENT
#define LDS_WAIT() asm volatile("s_waitcnt lgkmcnt(0)" ::: "memory")
DI unsigned f2bf(float f) { unsigned r; asm("v_cvt_pk_bf16_f32 %0, %1, %1" : "=v"(r) : "v"(f)); return r & 0xffffu; }
DI unsigned pk2(float lo, float hi) { unsigned r; asm("v_cvt_pk_bf16_f32 %0, %1, %2" : "=v"(r) : "v"(lo), "v"(hi)); return r; }
DI float bf2f(unsigned short v) { return __builtin_bit_cast(float, (unsigned)v << 16); }
DI float bflo(unsigned w) { return __builtin_bit_cast(float, w << 16); }
DI float bfhi(unsigned w) { return __builtin_bit_cast(float, w & 0xffff0000u); }
DI float logsig(float x) { return fminf(x, 0.f) - log1pf(expf(-fabsf(x))); }

#define XB_TMO      128
#define XB_XCNT(j)  (256  + 64 * (j))
#define XB_XSUB(j)  (1280 + 64 * (j))
#define XB_XGEN(j)  (2304 + 64 * (j))
#define XB_TOP      3328
#define XB_TOPGEN   3392
#define XCD_BAR_WORDS 3456
#define XB_SPIN_CAP (1u << 18)

__device__ __forceinline__ unsigned xb_ld(unsigned* p)              { return __hip_atomic_load(p, __ATOMIC_RELAXED, __HIP_MEMORY_SCOPE_AGENT); }
__device__ __forceinline__ unsigned xb_add(unsigned* p, unsigned v) { return __hip_atomic_fetch_add(p, v, __ATOMIC_RELAXED, __HIP_MEMORY_SCOPE_AGENT); }
__device__ __forceinline__ unsigned xb_xcc_id() { return (unsigned)__builtin_amdgcn_s_getreg((3 << 11) | 20) & 0xFu; }
#define XB_SPIN(cond, bar) do { unsigned _sp = 0; while (cond) { __builtin_amdgcn_s_sleep(1); \
    if ((++_sp & 255u) == 0u) { if (xb_ld(&(bar)[XB_TMO])) break; if (_sp > XB_SPIN_CAP) { atomicAdd(&(bar)[XB_TMO], 1u); break; } } } } while (0)

struct XcdBarrier {
    unsigned* bar; unsigned x;
    volatile LAS unsigned* st;
};

__device__ __forceinline__ XcdBarrier xcd_barrier_post(unsigned* bar, volatile LAS unsigned* st) {
    XcdBarrier b; b.bar = bar; b.x = xb_xcc_id(); b.st = st;
    if (threadIdx.x == 0) (void)xb_add(&bar[XB_XCNT(b.x)], 1u);
    return b;
}
__device__ __forceinline__ void xcd_barrier_complete(unsigned* bar, unsigned x, unsigned& nloc, unsigned& nx) {
    const unsigned G = gridDim.x * gridDim.y * gridDim.z;
    unsigned sum, cnt, mine, sp = 0u;
    for (;;) {
        sum = 0u; cnt = 0u; mine = 0u;
#pragma unroll
        for (unsigned j = 0; j < 16; ++j) { const unsigned c = xb_ld(&bar[XB_XCNT(j)]); sum += c; cnt += (c > 0u) ? 1u : 0u; mine = (j == x) ? c : mine; }
        if (sum == G) break;
        __builtin_amdgcn_s_sleep(1);
        if ((++sp & 255u) == 0u) { if (xb_ld(&bar[XB_TMO])) break; if (sp > XB_SPIN_CAP) { atomicAdd(&bar[XB_TMO], 1u); break; } }
    }
    nloc = mine > 0u ? mine : 1u; nx = cnt > 0u ? cnt : 1u;
}

__device__ __forceinline__ void xcd_barrier(const XcdBarrier& b) {
    asm volatile("s_waitcnt vmcnt(0)" ::: "memory");
    __syncthreads();
    if (threadIdx.x == 0) {
        unsigned* bar = b.bar;
        __builtin_amdgcn_s_waitcnt(0);
        unsigned nloc = b.st[0], nx = b.st[1];
        if (nloc == 0u) { xcd_barrier_complete(bar, b.x, nloc, nx); b.st[0] = nloc; b.st[1] = nx; }
        const unsigned old = xb_add(&bar[XB_XSUB(b.x)], 1u);
        const unsigned gen = old / nloc;
        if (old + 1u == (gen + 1u) * nloc) {
            __builtin_amdgcn_fence(__ATOMIC_RELEASE, "agent");
            asm volatile("s_waitcnt vmcnt(0)" ::: "memory");
            const unsigned og = xb_add(&bar[XB_TOP], 1u);
            const unsigned tg = og / nx;
            if (og + 1u == (tg + 1u) * nx) xb_add(&bar[XB_TOPGEN], 1u);
            else XB_SPIN(xb_ld(&bar[XB_TOPGEN]) == tg, bar);
            __builtin_amdgcn_fence(__ATOMIC_ACQUIRE, "agent");
            xb_add(&bar[XB_XGEN(b.x)], 1u);
            asm volatile("s_waitcnt vmcnt(0)" ::: "memory");
        } else {
            XB_SPIN(xb_ld(&bar[XB_XGEN(b.x)]) == gen, bar);
            __builtin_amdgcn_fence(__ATOMIC_ACQUIRE, "agent");
            asm volatile("s_waitcnt vmcnt(0)" ::: "memory");
        }
    }
    __syncthreads();
}


DI float wave_sum(float v) {
#pragma unroll
    for (int o = 1; o < 64; o <<= 1) v += __shfl_xor(v, o);
    return v;
}
DI float wave_max(float v) {
#pragma unroll
    for (int o = 1; o < 64; o <<= 1) v = fmaxf(v, __shfl_xor(v, o));
    return v;
}
DI float wave_incl_sum(float v, int lane) {
#pragma unroll
    for (int o = 1; o < 64; o <<= 1) { const float t = __shfl_up(v, o); if (lane >= o) v += t; }
    return v;
}
DI float wave_incl_max(float v, int lane) {
#pragma unroll
    for (int o = 1; o < 64; o <<= 1) { const float t = __shfl_up(v, o); if (lane >= o) v = fmaxf(v, t); }
    return v;
}

template <int L> DI int swx(int r) { return L == 64 ? ((r >> 1) & 7) : (r & 15); }
template <int L> DI int eoff(int r, int c) { return r * L + ((((c >> 3) ^ swx<L>(r)) << 3) | (c & 7)); }
template <int L> DI bf16x8 ldf(const LAS bf16* base, int r, int ch) { return *(const LAS bf16x8*)(base + r * L + ((ch ^ swx<L>(r)) << 3)); }
DI f32x4 mfma16(bf16x8 a, bf16x8 b, f32x4 c) { return __builtin_amdgcn_mfma_f32_16x16x32_bf16(a, b, c, 0, 0, 0); }
template <int LA, int LB, int NK> DI void mma_tile(f32x4& acc, const LAS bf16* A, int ra0, const LAS bf16* B, int rb0, int lane) {
    const int r = lane & 15, g = lane >> 4;
#pragma unroll
    for (int kk = 0; kk < NK; ++kk) { const bf16x8 a = ldf<LA>(A, ra0 + r, 4 * kk + g), b = ldf<LB>(B, rb0 + r, 4 * kk + g); acc = mfma16(a, b, acc); }
}

struct ConvItem { const float* W; const float* gk; bf16* WT; int K, N, mode, r; };
DI void conv_load(const ConvItem& c, int lane, f32x4 (&v)[8], float (&gv)[8]) {
    const int nkb = c.K / 64, nb = c.r / nkb, kb = c.r - nb * nkb, k0 = 64 * kb, n0 = 32 * nb;
    const int n = n0 + 4 * (lane & 7); const bool ok = n < c.N;
#pragma unroll
    for (int i = 0; i < 8; ++i) { const int kk = 8 * i + (lane >> 3); v[i] = ok ? *(const f32x4*)(c.W + (size_t)(k0 + kk) * c.N + n) : (f32x4){0.f, 0.f, 0.f, 0.f}; gv[i] = c.gk ? c.gk[k0 + kk] : 1.0f; }
}
DI void conv_store(const ConvItem& c, int lane, const f32x4 (&v)[8], const float (&gv)[8], LAS float* scr) {
    const int nkb = c.K / 64, nb = c.r / nkb, kb = c.r - nb * nkb, k0 = 64 * kb, n0 = 32 * nb, nq = 4 * (lane & 7);
#pragma unroll
    for (int i = 0; i < 8; ++i) { const int kk = 8 * i + (lane >> 3); LAS float* d = scr + kk * 33 + nq; d[0] = v[i].x * gv[i]; d[1] = v[i].y * gv[i]; d[2] = v[i].z * gv[i]; d[3] = v[i].w * gv[i]; }
    LDS_WAIT(); asm volatile("" ::: "memory");
    int row_off = n0;
    if (c.mode == 1) { const int j = n0 < DFF ? n0 : n0 - DFF; row_off = 256 * (j >> 7) + (j & 127) + (n0 < DFF ? 0 : 128); }
    const int cc = lane & 7;
#pragma unroll
    for (int j = 0; j < 4; ++j) { const int nn = (lane >> 3) + 8 * j; const LAS float* s = scr + (8 * cc) * 33 + nn;
        v4u o; o.x = pk2(s[0 * 33], s[1 * 33]); o.y = pk2(s[2 * 33], s[3 * 33]); o.z = pk2(s[4 * 33], s[5 * 33]); o.w = pk2(s[6 * 33], s[7 * 33]);
        *(v4u*)(c.WT + (size_t)(row_off + nn) * c.K + k0 + 8 * cc) = o; }
    LDS_WAIT(); asm volatile("" ::: "memory");
}

struct Args { const float* in[18]; float* out; unsigned char* ws; int ph_lo, ph_hi; };

typedef const __attribute__((address_space(4))) Args* KArgs;
DI KArgs kargs() { KArgs p = (KArgs)__builtin_amdgcn_kernarg_segment_ptr(); asm volatile("" : "+s"(p)); return p; }
DI void prologue(LAS unsigned char* lds, int lane, int wave, int bx) {
    KArgs AP = kargs();
    LAS float* scr = (LAS float*)(lds + wave * 16384);
    const int gw = bx * NWAVES + wave, NGW = gridDim.x * NWAVES;
    unsigned char* ws = AP->ws;
    constexpr int I_UP = (DM / 64) * (NUP / 32), I_DN = (DFF / 64) * (DM / 32), I_IN = (DM / 64) * (NINP / 32), I_OUT = (DM / 64) * (DM / 32);
    constexpr int NITEMS = 8 * I_UP + 8 * I_DN + 4 * I_IN + 4 * I_OUT;
#define CONV_DECODE(it_, c_) do { int r = (it_); (c_).gk = nullptr; (c_).K = DM; (c_).mode = 0; \
        if (r < 8 * I_UP) { const int mi = r / I_UP; r -= mi * I_UP; (c_).W = AP->in[2] + (size_t)mi * DM * NUP; (c_).gk = AP->in[1] + (size_t)mi * DM; (c_).WT = (bf16*)(ws + WS_WUP) + (size_t)mi * NUP * DM; (c_).N = NUP; (c_).mode = 1; } \
        else if (r < 8 * I_UP + 8 * I_DN) { r -= 8 * I_UP; const int mi = r / I_DN; r -= mi * I_DN; (c_).W = AP->in[3] + (size_t)mi * DFF * DM; (c_).WT = (bf16*)(ws + WS_WDN) + (size_t)mi * DM * DFF; (c_).K = DFF; (c_).N = DM; } \
        else if (r < 8 * I_UP + 8 * I_DN + 4 * I_IN) { r -= 8 * I_UP + 8 * I_DN; const int l = r / I_IN; r -= l * I_IN; const int kind = l % 3, ji = l / 3; \
            (c_).W = AP->in[kind == 0 ? 5 : kind == 1 ? 9 : 12] + (size_t)ji * DM * NIN; (c_).gk = AP->in[4] + (size_t)l * DM; (c_).WT = (bf16*)(ws + WS_WIN) + (size_t)l * NINP * DM; (c_).N = NIN; } \
        else { r -= 8 * I_UP + 8 * I_DN + 4 * I_IN; const int l = r / I_OUT; r -= l * I_OUT; const int kind = l % 3, ji = l / 3; \
            (c_).W = AP->in[kind == 0 ? 8 : kind == 1 ? 11 : 16] + (size_t)ji * DM * DM; (c_).WT = (bf16*)(ws + WS_WOUT) + (size_t)l * DM * DM; (c_).N = DM; } \
        (c_).r = r; } while (0)
    f32x4 va[8]; float ga[8]; ConvItem ca{}, cb{};
    if (gw < NITEMS) { CONV_DECODE(gw, ca); conv_load(ca, lane, va, ga); }
    for (int it = gw; it < NITEMS; it += NGW) {
        f32x4 vb[8]; float gb[8]; const int nx = it + NGW;
        if (nx < NITEMS) { CONV_DECODE(nx, cb); conv_load(cb, lane, vb, gb); }
        conv_store(ca, lane, va, ga, scr);
        ca = cb;
#pragma unroll
        for (int i = 0; i < 8; ++i) { va[i] = vb[i]; ga[i] = gb[i]; }
    }
#undef CONV_DECODE
    const float* x = AP->in[0]; bf16* hb = (bf16*)(ws + WS_HB); long long* ss0 = (long long*)(ws + WS_SS);
    for (int m = gw; m < MTOK; m += NGW) {
        const f32x4* xr = (const f32x4*)(x + (size_t)m * DM) + lane; f32x4 v[8]; float s = 0.f;
#pragma unroll
        for (int j = 0; j < 8; ++j) { v[j] = xr[64 * j]; s += (v[j].x * v[j].x + v[j].y * v[j].y) + (v[j].z * v[j].z + v[j].w * v[j].w); }
        s = wave_sum(s);
        v2u* o8 = (v2u*)(hb + (size_t)m * DM) + lane;
#pragma unroll
        for (int j = 0; j < 8; ++j) { v2u w; w.x = pk2(v[j].x, v[j].y); w.y = pk2(v[j].z, v[j].w); o8[64 * j] = w; }
        if (lane == 0) ss0[m] = __float2ll_rn(s * 1048576.0f);
    }
}

constexpr int IMGM_P = 0, IMGM_KT = 8192, IMGM_VT = IMGM_KT + 16384, IMGM_GS = IMGM_VT + 4 * 8192, IMGM_BYTES = IMGM_GS + 1024;
constexpr int IMGG_Q = 0, IMGG_KT = 32768, IMGG_P = 65536, IMGG_VT = IMGG_P + 8192, IMGG_EB = IMGG_VT + 8 * 8192, IMGG_BYTES = IMGG_EB + 1024;
static_assert((size_t)IMGM_BYTES * 4096 <= 352 * MiB && (size_t)IMGG_BYTES * 2048 <= 352 * MiB, "images overlay the (idle) FFN activation buffer");
DI float logsig_fast(float x) { return fminf(x, 0.f) - __logf(1.0f + __expf(-fabsf(x))); }

DI void mlstm_pre(LAS unsigned char* lds, const bf16* P1, const float* G, const float* b_if, unsigned char* img, int tid, int lane, int wave, int bx) {
    LAS bf16* Qs = (LAS bf16*)lds;
    LAS bf16* Ks = Qs + 64 * 128;
    LAS bf16* KTs = Ks + 64 * 128;
    LAS bf16* Ps = KTs + 128 * 64;
    LAS bf16* VT = Ps + 64 * 64;
    LAS float* fa = (LAS float*)(VT + 256 * 64);
    LAS float *bcum = fa, *ipre = fa + 64, *aloc = fa + 128, *wloc = fa + 192, *scal = fa + 256;
    const float KSCALE = 0.08838834764831845f;
    const int g = lane >> 4, r16 = lane & 15;
    v4u pq[2], pk[2], pv[4]; float pgi = 0.f, pgf = 0.f;
#define MLP_LOAD(it_) do { const int b_ = (it_) >> 9, c_ = ((it_) >> 3) & 63, h_ = (it_) & 7; const int row0_ = b_ * SEQ + c_ * 64; \
        _Pragma("unroll") for (int p = 0; p < 2; ++p) { const int idx = tid + 512 * p, r = idx >> 4, c8 = idx & 15; const bf16* src = P1 + (size_t)(row0_ + r) * NQKV + h_ * 128 + c8 * 8; pq[p] = *(const v4u*)src; pk[p] = *(const v4u*)(src + 1024); } \
        _Pragma("unroll") for (int p = 0; p < 4; ++p) { const int idx = tid + 512 * p, r = idx >> 5, c8 = idx & 31; pv[p] = *(const v4u*)(P1 + (size_t)(row0_ + r) * NQKV + 2048 + h_ * 256 + c8 * 8); } \
        if (tid < 64) { const float* gp = G + (size_t)(row0_ + tid) * 16; pgi = gp[h_]; pgf = gp[8 + h_]; } } while (0)
    if (bx < 4096) MLP_LOAD(bx);
    for (int item = bx; item < 4096; item += gridDim.x) {
        const int h = item & 7;
        unsigned char* im = img + (size_t)item * IMGM_BYTES;
        __syncthreads();
        if (tid < 64) { ipre[tid] = pgi + b_if[h]; bcum[tid] = logsig(pgf + b_if[8 + h]); }
#pragma unroll
        for (int p = 0; p < 2; ++p) { const int idx = tid + 512 * p, r = idx >> 4, c8 = idx & 15; *(LAS v4u*)(Qs + eoff<128>(r, c8 * 8)) = pq[p]; *(LAS v4u*)(Ks + eoff<128>(r, c8 * 8)) = pk[p]; }
        __syncthreads();
        if (wave == 0) {
            const float bt = wave_incl_sum(bcum[lane], lane), ip = ipre[lane];
            const float al = bt + wave_incl_max(ip - bt, lane);
            const float blast = __shfl(bt, 63);
            const float gg = blast - bt + ip;
            const float gmax = wave_max(gg);
            bcum[lane] = bt; aloc[lane] = al; wloc[lane] = __expf(gg - gmax);
            if (lane == 0) { scal[0] = blast; scal[1] = gmax; }
        }
#pragma unroll
        for (int p = 0; p < 4; ++p) { const int idx = tid + 512 * p, r = idx >> 5, c8 = idx & 31;
#pragma unroll
            for (int j = 0; j < 4; ++j) { VT[eoff<64>(c8 * 8 + 2 * j, r)] = (bf16)(pv[p][j] & 0xffffu); VT[eoff<64>(c8 * 8 + 2 * j + 1, r)] = (bf16)(pv[p][j] >> 16); } }
        if (item + (int)gridDim.x < 4096) MLP_LOAD(item + (int)gridDim.x);
        __syncthreads();
#pragma unroll
        for (int p = 0; p < 2; ++p) { const int idx = tid + 512 * p, s = idx >> 4, c8 = idx & 15; const v4u kv = *(const LAS v4u*)(Ks + eoff<128>(s, c8 * 8)); const float w = wloc[s] * KSCALE;
#pragma unroll
            for (int j = 0; j < 4; ++j) { KTs[eoff<64>(c8 * 8 + 2 * j, s)] = (bf16)f2bf(bflo(kv[j]) * w); KTs[eoff<64>(c8 * 8 + 2 * j + 1, s)] = (bf16)f2bf(bfhi(kv[j]) * w); } }
        { const int tt = wave >> 1;
#pragma unroll
          for (int q2 = 0; q2 < 2; ++q2) { const int st = 2 * (wave & 1) + q2; f32x4 acc = (f32x4){0.f, 0.f, 0.f, 0.f};
            if (st <= tt) mma_tile<128, 128, 4>(acc, Qs, 16 * tt, Ks, 16 * st, lane);
            const int s = 16 * st + r16; const float cs = ipre[s] - bcum[s];
#pragma unroll
            for (int i = 0; i < 4; ++i) { const int t = 16 * tt + 4 * g + i; const float p = (s <= t) ? acc[i] * KSCALE * __expf(bcum[t] + cs - aloc[t]) : 0.f; Ps[eoff<64>(t, s)] = (bf16)f2bf(p); } } }
        __syncthreads();
        *(v4u*)(im + IMGM_P + tid * 16) = *(const LAS v4u*)((LAS unsigned char*)Ps + tid * 16);
#pragma unroll
        for (int p = 0; p < 2; ++p) *(v4u*)(im + IMGM_KT + (tid + 512 * p) * 16) = *(const LAS v4u*)((LAS unsigned char*)KTs + (tid + 512 * p) * 16);
#pragma unroll
        for (int p = 0; p < 4; ++p) *(v4u*)(im + IMGM_VT + (tid + 512 * p) * 16) = *(const LAS v4u*)((LAS unsigned char*)VT + (tid + 512 * p) * 16);
        if (tid < 64) { float* gs = (float*)(im + IMGM_GS); gs[tid] = bcum[tid]; gs[64 + tid] = aloc[tid]; if (tid < 2) gs[128 + tid] = scal[tid]; }
    }
#undef MLP_LOAD
}

DI void mlstm_scan2(LAS unsigned char* lds, const bf16* P1, const unsigned char* img, float* hraw, int tid, int lane, int wave, int bx) {
    constexpr int IB = 8192 + 16384 + 16384 + 10240 + 1024;
    LAS bf16* CT0 = (LAS bf16*)(lds + 2 * IB);
    const int g = lane >> 4, r16 = lane & 15, tt = wave >> 1, eh = wave & 1;
    for (int item0 = bx; item0 < 256; item0 += gridDim.x) {
        const int item = (gridDim.x == 256) ? (item0 & 7) * 32 + (item0 >> 3) : item0;
        const int b = item >> 5, h = (item >> 2) & 7, sl = item & 3;
        f32x4 Cacc[5];
#pragma unroll
        for (int e = 0; e < 5; ++e) Cacc[e] = (f32x4){0.f, 0.f, 0.f, 0.f};
        __syncthreads();
        for (int i = tid; i < 2 * 80 * 128 / 8; i += 512) ((LAS v4u*)CT0)[i] = (v4u){0u, 0u, 0u, 0u};
        for (int i = tid; i < 2 * 128; i += 512) { const int bi = i >> 7, k = i & 127; ((LAS v4u*)(lds + bi * IB + 8192 + 16384 + 16384 + 8192))[k] = (k < 8) ? (v4u){0x3f803f80u, 0x3f803f80u, 0x3f803f80u, 0x3f803f80u} : (v4u){0u, 0u, 0u, 0u}; }
        float m_prev = 0.f;
        v4u rp, rq[2], rk[2], rv; float rg0 = 0.f, rbl, rgm;
#define MLS_PREFETCH(cc) do { const int item2 = (b * 64 + (cc)) * 8 + h; const unsigned char* im = img + (size_t)item2 * IMGM_BYTES; const int row0_ = b * SEQ + (cc) * 64; \
            rp = *(const v4u*)(im + IMGM_P + tid * 16); rk[0] = *(const v4u*)(im + IMGM_KT + tid * 16); rk[1] = *(const v4u*)(im + IMGM_KT + (tid + 512) * 16); \
            rv = *(const v4u*)(im + IMGM_VT + sl * 8192 + tid * 16); \
            _Pragma("unroll") for (int p = 0; p < 2; ++p) { const int idx = tid + 512 * p, r = idx >> 4, c8 = idx & 15; rq[p] = *(const v4u*)(P1 + (size_t)(row0_ + r) * NQKV + h * 128 + c8 * 8); } \
            const float* gs = (const float*)(im + IMGM_GS); if (tid < 128) rg0 = gs[tid]; rbl = gs[128]; rgm = gs[129]; } while (0)
#define MLS_STORE(bi) do { LAS unsigned char* bb = lds + (bi) * IB; \
            *(LAS v4u*)(bb + tid * 16) = rp; *(LAS v4u*)(bb + 8192 + 16384 + tid * 16) = rk[0]; *(LAS v4u*)(bb + 8192 + 16384 + (tid + 512) * 16) = rk[1]; \
            *(LAS v4u*)(bb + 8192 + 16384 + 16384 + tid * 16) = rv; \
            _Pragma("unroll") for (int p = 0; p < 2; ++p) { const int idx = tid + 512 * p, r = idx >> 4, c8 = idx & 15; *(LAS v4u*)((LAS bf16*)(bb + 8192) + eoff<128>(r, c8 * 8)) = rq[p]; } \
            if (tid < 128) ((LAS float*)(bb + 8192 + 16384 + 16384 + 10240))[tid] = rg0; } while (0)
        MLS_PREFETCH(0); MLS_STORE(0);
        float blast = rbl, gmax = rgm;
        MLS_PREFETCH(1);
        __syncthreads();
        for (int c = 0; c < 64; ++c) {
            const int row0 = b * SEQ + c * 64;
            const LAS unsigned char* bb = lds + (c & 1) * IB;
            const LAS bf16* Ps = (const LAS bf16*)bb; const LAS bf16* Qs = (const LAS bf16*)(bb + 8192); const LAS bf16* KTs = (const LAS bf16*)(bb + 8192 + 16384);
            const LAS bf16* VTs = (const LAS bf16*)(bb + 8192 + 16384 + 16384); const LAS float* gsl = (const LAS float*)(bb + 8192 + 16384 + 16384 + 10240);
            LAS bf16* CTc = CT0 + (c & 1) * 80 * 128; LAS bf16* CTn = CT0 + ((c + 1) & 1) * 80 * 128;
            const f32x4 btv = *(const LAS f32x4*)(gsl + 16 * tt + 4 * g), alv = *(const LAS f32x4*)(gsl + 64 + 16 * tt + 4 * g);
            float al[4], be[4], em[4];
#pragma unroll
            for (int i = 0; i < 4; ++i) { const float mt = fmaxf(btv[i] + m_prev, alv[i]); al[i] = __expf(alv[i] - mt); be[i] = __expf(btv[i] + m_prev - mt); em[i] = __expf(-mt); }
            const float m_new = fmaxf(blast + m_prev, gmax), wcs = __expf(blast + m_prev - m_new), gam = __expf(gmax - m_new);
            m_prev = m_new;
            f32x4 d1 = (f32x4){0.f, 0.f, 0.f, 0.f}, d2 = (f32x4){0.f, 0.f, 0.f, 0.f};
            mma_tile<64, 64, 2>(d1, Ps, 16 * tt, VTs, 64, lane); mma_tile<128, 128, 4>(d2, Qs, 16 * tt, CTc, 64, lane);
            float dinv[4];
#pragma unroll
            for (int i = 0; i < 4; ++i) { const float den = __shfl(al[i] * d1[i] + be[i] * d2[i], lane & 48); dinv[i] = __builtin_amdgcn_rcpf(fmaxf(fabsf(den), em[i])); }
#pragma unroll
            for (int q2 = 0; q2 < 2; ++q2) { const int et = 2 * eh + q2, e = 16 * et + r16; f32x4 a1 = (f32x4){0.f, 0.f, 0.f, 0.f}, a2 = (f32x4){0.f, 0.f, 0.f, 0.f};
                mma_tile<64, 64, 2>(a1, Ps, 16 * tt, VTs, 16 * et, lane); mma_tile<128, 128, 4>(a2, Qs, 16 * tt, CTc, 16 * et, lane);
#pragma unroll
                for (int i = 0; i < 4; ++i) { const int t = 16 * tt + 4 * g + i; hraw[(size_t)(row0 + t) * DM + h * 256 + sl * 64 + e] = (al[i] * a1[i] + be[i] * a2[i]) * dinv[i]; } }
#pragma unroll
            for (int et = 0; et < 5; ++et) { f32x4 tmp = (f32x4){0.f, 0.f, 0.f, 0.f}; mma_tile<64, 64, 2>(tmp, KTs, 16 * wave, VTs, 16 * et, lane);
                Cacc[et] = Cacc[et] * wcs + tmp * gam;
                v2u w; w.x = pk2(Cacc[et][0], Cacc[et][1]); w.y = pk2(Cacc[et][2], Cacc[et][3]);
                *(LAS v2u*)(CTn + eoff<128>(16 * et + r16, 16 * wave + 4 * g)) = w; }
            if (c + 1 < 64) { MLS_STORE((c + 1) & 1); blast = rbl; gmax = rgm; }
            if (c + 2 < 64) MLS_PREFETCH(c + 2);
            __syncthreads();
        }
#undef MLS_PREFETCH
#undef MLS_STORE
    }
}

DI void gla_pre(LAS unsigned char* lds, const bf16* P1, const float* G, const float* w_alpha, const float* b_alpha, unsigned char* img, int tid, int lane, int wave, int bx) {
    LAS bf16* VT = (LAS bf16*)lds;
    LAS bf16* QTs = (LAS bf16*)lds;
    LAS bf16* KTl = QTs + 64 * 256;
    LAS bf16* KTT = KTl + 64 * 256;
    LAS bf16* Ps = KTT + 256 * 64;
    LAS float* alow = (LAS float*)(Ps + 64 * 64);
    LAS float* T0 = alow + 1024;
    const int g = lane >> 4, r16 = lane & 15, d = tid & 255, sh = tid >> 8;
    for (int item = bx; item < 2048; item += gridDim.x) {
        const int b = item >> 8, c = (item >> 2) & 63, h = item & 3;
        const int row0 = b * SEQ + c * 64;
        unsigned char* im = img + (size_t)item * IMGG_BYTES;
        __syncthreads();
#pragma unroll
        for (int p = 0; p < 8; ++p) { const int idx = tid + 512 * p, r = idx >> 6, c8 = idx & 63; const v4u vv = *(const v4u*)(P1 + (size_t)(row0 + r) * NQKV + 2048 + h * 512 + c8 * 8);
#pragma unroll
            for (int j = 0; j < 4; ++j) { VT[eoff<64>(c8 * 8 + 2 * j, r)] = (bf16)(vv[j] & 0xffffu); VT[eoff<64>(c8 * 8 + 2 * j + 1, r)] = (bf16)(vv[j] >> 16); } }
        float wa[16];
#pragma unroll
        for (int i = 0; i < 16; ++i) wa[i] = w_alpha[i * 1024 + h * 256 + d];
        const float ba = b_alpha[h * 256 + d];
        f32x4 al4 = (f32x4){0.f, 0.f, 0.f, 0.f};
        if (tid < 256) al4 = *(const f32x4*)(G + (size_t)(row0 + (tid >> 2)) * 16 + (tid & 3) * 4);
        __syncthreads();
#pragma unroll
        for (int p = 0; p < 8; ++p) *(v4u*)(im + IMGG_VT + (tid + 512 * p) * 16) = *(const LAS v4u*)((LAS unsigned char*)VT + (tid + 512 * p) * 16);
        __syncthreads();
        if (tid < 256) *(LAS f32x4*)(alow + tid * 4) = al4;
        __syncthreads();
        const bf16* qsrc = P1 + (size_t)(row0 + 32 * sh) * NQKV + h * 256 + d;
        float bs[32]; float run = 0.f;
#pragma unroll
        for (int j = 0; j < 32; ++j) { const int s = 32 * sh + j; float z = ba;
#pragma unroll
            for (int i = 0; i < 16; ++i) z += alow[s * 16 + i] * wa[i];
            run += logsig_fast(z) * (1.0f / 16.0f); bs[j] = run; }
        if (sh == 0) T0[d] = run;
        __syncthreads();
        const float add = sh ? T0[d] : 0.f;
        if (sh) ((float*)(im + IMGG_EB))[d] = __expf(run + add);
#pragma unroll
        for (int q8 = 0; q8 < 4; ++q8) { unsigned kk[8];
#pragma unroll
            for (int j = 0; j < 8; ++j) { const int jj = 8 * q8 + j, s = 32 * sh + jj; const float bsum = bs[jj] + add;
                const float qv = bf2f(qsrc[(size_t)jj * NQKV]) * 0.0625f * __expf(bsum), kv = bf2f(qsrc[(size_t)jj * NQKV + 1024]) * __expf(-bsum);
                QTs[eoff<256>(s, d)] = (bf16)f2bf(qv); kk[j] = f2bf(kv); KTl[eoff<256>(s, d)] = (bf16)kk[j]; }
            v4u w; w.x = kk[0] | (kk[1] << 16); w.y = kk[2] | (kk[3] << 16); w.z = kk[4] | (kk[5] << 16); w.w = kk[6] | (kk[7] << 16);
            *(LAS v4u*)(KTT + eoff<64>(d, 32 * sh + 8 * q8)) = w; }
        __syncthreads();
        { const int tt = wave >> 1;
#pragma unroll
          for (int q2 = 0; q2 < 2; ++q2) { const int st = 2 * (wave & 1) + q2; f32x4 acc = (f32x4){0.f, 0.f, 0.f, 0.f};
            if (st <= tt) mma_tile<256, 256, 8>(acc, QTs, 16 * tt, KTl, 16 * st, lane);
            const int s = 16 * st + r16;
#pragma unroll
            for (int i = 0; i < 4; ++i) { const int t = 16 * tt + 4 * g + i; Ps[eoff<64>(t, s)] = (bf16)f2bf((s <= t) ? acc[i] : 0.f); } } }
        __syncthreads();
#pragma unroll
        for (int p = 0; p < 4; ++p) { *(v4u*)(im + IMGG_Q + (tid + 512 * p) * 16) = *(const LAS v4u*)((LAS unsigned char*)QTs + (tid + 512 * p) * 16);
                                      *(v4u*)(im + IMGG_KT + (tid + 512 * p) * 16) = *(const LAS v4u*)((LAS unsigned char*)KTT + (tid + 512 * p) * 16); }
        *(v4u*)(im + IMGG_P + tid * 16) = *(const LAS v4u*)((LAS unsigned char*)Ps + tid * 16);
    }
}

DI void gla_scan2(LAS unsigned char* lds, const unsigned char* img, float* hraw, int tid, int lane, int wave, int bx) {
    LAS bf16* QTs = (LAS bf16*)lds;
    LAS bf16* KTT = QTs + 64 * 256;
    LAS bf16* Ps = KTT + 256 * 64;
    LAS bf16* VTs = Ps + 64 * 64;
    LAS float* eb = (LAS float*)(VTs + 64 * 64);
    LAS bf16* ST0 = (LAS bf16*)(eb + 256);
    const int g = lane >> 4, r16 = lane & 15, tt = wave >> 1, eh = wave & 1;
    for (int item0 = bx; item0 < 256; item0 += gridDim.x) {
        const int item = (gridDim.x == 256) ? (item0 & 7) * 32 + (item0 >> 3) : item0;
        const int b = item >> 5, h = (item >> 3) & 3, sl = item & 7;
        f32x4 Sacc[2][4];
#pragma unroll
        for (int a = 0; a < 2; ++a)
#pragma unroll
            for (int e = 0; e < 4; ++e) Sacc[a][e] = (f32x4){0.f, 0.f, 0.f, 0.f};
        __syncthreads();
        for (int i = tid; i < 2 * 64 * 256 / 8; i += 512) ((LAS v4u*)ST0)[i] = (v4u){0u, 0u, 0u, 0u};
        v4u rq[4], rk[4], rp, rv; float re = 0.f;
#define GLS_PREFETCH(cc) do { const int item2 = (b * 64 + (cc)) * 4 + h; const unsigned char* im = img + (size_t)item2 * IMGG_BYTES; \
            _Pragma("unroll") for (int p = 0; p < 4; ++p) { rq[p] = *(const v4u*)(im + IMGG_Q + (tid + 512 * p) * 16); rk[p] = *(const v4u*)(im + IMGG_KT + (tid + 512 * p) * 16); } \
            rp = *(const v4u*)(im + IMGG_P + tid * 16); rv = *(const v4u*)(im + IMGG_VT + sl * 8192 + tid * 16); if (tid < 256) re = ((const float*)(im + IMGG_EB))[tid]; } while (0)
        GLS_PREFETCH(0);
        for (int c = 0; c < 64; ++c) {
            const int row0 = b * SEQ + c * 64;
            LAS bf16* STc = ST0 + (c & 1) * 64 * 256; LAS bf16* STn = ST0 + ((c + 1) & 1) * 64 * 256;
            __syncthreads();
#pragma unroll
            for (int p = 0; p < 4; ++p) { *(LAS v4u*)((LAS unsigned char*)QTs + (tid + 512 * p) * 16) = rq[p]; *(LAS v4u*)((LAS unsigned char*)KTT + (tid + 512 * p) * 16) = rk[p]; }
            *(LAS v4u*)((LAS unsigned char*)Ps + tid * 16) = rp; *(LAS v4u*)((LAS unsigned char*)VTs + tid * 16) = rv;
            if (tid < 256) eb[tid] = re;
            __syncthreads();
            if (c + 1 < 64) GLS_PREFETCH(c + 1);
#pragma unroll
            for (int q2 = 0; q2 < 2; ++q2) { const int et = 2 * eh + q2, e = 16 * et + r16; f32x4 acc = (f32x4){0.f, 0.f, 0.f, 0.f};
                mma_tile<64, 64, 2>(acc, Ps, 16 * tt, VTs, 16 * et, lane); mma_tile<256, 256, 8>(acc, QTs, 16 * tt, STc, 16 * et, lane);
#pragma unroll
                for (int i = 0; i < 4; ++i) { const int t = 16 * tt + 4 * g + i; hraw[(size_t)(row0 + t) * DM + h * 512 + sl * 64 + e] = acc[i]; } }
#pragma unroll
            for (int a = 0; a < 2; ++a) { const int dt = 2 * wave + a;
                const f32x4 ev = *(const LAS f32x4*)(eb + 16 * dt + 4 * g);
#pragma unroll
                for (int et = 0; et < 4; ++et) { mma_tile<64, 64, 2>(Sacc[a][et], KTT, 16 * dt, VTs, 16 * et, lane); Sacc[a][et] = Sacc[a][et] * ev;
                    v2u w; w.x = pk2(Sacc[a][et][0], Sacc[a][et][1]); w.y = pk2(Sacc[a][et][2], Sacc[a][et][3]);
                    *(LAS v2u*)(STn + eoff<256>(16 * et + r16, 16 * dt + 4 * g)) = w; } }
        }
#undef GLS_PREFETCH
    }
}


DI void mixer_gates(const bf16* hb, const bf16* wg, const long long* ss, float* G, int lane, int wave, int bx) {
    const int g = lane >> 4, r16 = lane & 15;
    for (int t = bx * NWAVES + wave; t < MTOK / 16; t += gridDim.x * NWAVES) {
        const bf16* ap = hb + (size_t)(16 * t + r16) * DM + 8 * g; const bf16* bp = wg + (size_t)r16 * DM + 8 * g;
        f32x4 acc = (f32x4){0.f, 0.f, 0.f, 0.f};
#pragma unroll 8
        for (int kk = 0; kk < DM / 32; ++kk) { const bf16x8 a = *(const bf16x8*)(ap + 32 * kk), b = *(const bf16x8*)(bp + 32 * kk); acc = mfma16(a, b, acc); }
#pragma unroll
        for (int i = 0; i < 4; ++i) { const int row = 16 * t + 4 * g + i; G[(size_t)row * 16 + r16] = acc[i] * pg8::rstd_of(ss, row); }
    }
}

template <int HS, int ACT> DI void headnorm_gate(const float* hraw, const bf16* P1, const float* gnorm, bf16* hm, int lane, int wave, int bx) {
    constexpr int NH = DM / HS, EPL = HS / 64;
    const int gw = bx * NWAVES + wave, NGW = gridDim.x * NWAVES;
    for (int row = gw; row < MTOK; row += NGW) {
#pragma unroll
        for (int hh = 0; hh < NH; ++hh) { const int col = hh * HS + lane * EPL;
            float x[EPL]; float s = 0.f;
#pragma unroll
            for (int j = 0; j < EPL; j += 4) { const f32x4 v = *(const f32x4*)(hraw + (size_t)row * DM + col + j); x[j] = v.x; x[j + 1] = v.y; x[j + 2] = v.z; x[j + 3] = v.w; s += (v.x * v.x + v.y * v.y) + (v.z * v.z + v.w * v.w); }
            s = wave_sum(s); const float rs = rsqrtf(s * (1.0f / HS) + 1e-6f);
            unsigned outw[EPL / 2];
#pragma unroll
            for (int j = 0; j < EPL; j += 2) { const unsigned gw2 = *(const unsigned*)(P1 + (size_t)row * NQKV + 4096 + col + j); const float g0 = bflo(gw2), g1 = bfhi(gw2);
                const float a0 = ACT == 0 ? 1.0f / (1.0f + expf(-g0)) : g0 / (1.0f + expf(-g0)), a1 = ACT == 0 ? 1.0f / (1.0f + expf(-g1)) : g1 / (1.0f + expf(-g1));
                outw[j / 2] = pk2(x[j] * rs * gnorm[col + j] * a0, x[j + 1] * rs * gnorm[col + j + 1] * a1); }
            if constexpr (EPL == 4) { v2u w; w.x = outw[0]; w.y = outw[1]; *(v2u*)(hm + (size_t)row * DM + col) = w; }
            else { v4u w; w.x = outw[0]; w.y = outw[1]; w.z = outw[2]; w.w = outw[3]; *(v4u*)(hm + (size_t)row * DM + col) = w; }
        }
    }
}

DI void fox_cf(LAS unsigned char* lds, const float* G, const float* b_f, float* cf, int tid, int lane, int wave, int bx) {
    LAS float* wt = (LAS float*)lds;
    for (int item = bx; item < 256; item += gridDim.x) { const int seq = item >> 1, hf = item & 1, b = seq >> 4, h = seq & 15; const float bias = b_f[h];
        const float* gp = G + ((size_t)b * SEQ + hf * 2048 + tid * 4) * 16 + h;
        float ls[4]; float s = 0.f, s0 = 0.f;
#pragma unroll
        for (int p = 0; p < 4; ++p) { ls[p] = logsig(gp[p * 16] + bias); s += ls[p]; }
        if (hf) { const float* g0 = gp - (size_t)2048 * 16;
#pragma unroll
            for (int p = 0; p < 4; ++p) s0 += logsig(g0[p * 16] + bias); }
        const float incl = wave_incl_sum(s, lane), tot0 = wave_sum(s0);
        __syncthreads();
        if (lane == 63) wt[wave] = incl; if (lane == 0) wt[8 + wave] = tot0;
        __syncthreads();
        float base = 0.f;
#pragma unroll
        for (int w = 0; w < 8; ++w) { base += (w < wave) ? wt[w] : 0.f; base += wt[8 + w]; }
        float run = base + incl - s;
        float* o = cf + (size_t)seq * SEQ + hf * 2048 + tid * 4; f32x4 ov;
        run += ls[0]; ov.x = run; run += ls[1]; ov.y = run; run += ls[2]; ov.z = run; run += ls[3]; ov.w = run;
        *(f32x4*)o = ov;
    }
}

DI void fox_vt_pre(LAS unsigned char* lds, const bf16* P1, unsigned char* img, int lane, int wave, int bx) {
    LAS bf16* scr = (LAS bf16*)(lds + wave * 4096);
    const int gw = bx * NWAVES + wave, NGW = gridDim.x * NWAVES;
    for (int it = gw; it < 8192 * 4; it += NGW) {
        const int q = it & 3, jt = (it >> 2) & 63, bh = it >> 8, b = bh >> 4, h = bh & 15;
        const bf16* src = P1 + ((size_t)b * SEQ + jt * 64) * NQKV + 4096 + h * 128 + q * 32;
        v4u v[4];
#pragma unroll
        for (int p = 0; p < 4; ++p) { const int idx = lane + 64 * p, r = idx >> 2, c8 = idx & 3; v[p] = *(const v4u*)(src + (size_t)r * NQKV + c8 * 8); }
#pragma unroll
        for (int p = 0; p < 4; ++p) { const int idx = lane + 64 * p, r = idx >> 2, c8 = idx & 3;
#pragma unroll
            for (int j = 0; j < 4; ++j) { scr[eoff<64>(c8 * 8 + 2 * j, r)] = (bf16)(v[p][j] & 0xffffu); scr[eoff<64>(c8 * 8 + 2 * j + 1, r)] = (bf16)(v[p][j] >> 16); } }
        LDS_WAIT(); asm volatile("" ::: "memory");
        unsigned char* dst = img + ((size_t)(bh * 64 + jt)) * 16384 + q * 4096;
#pragma unroll
        for (int p = 0; p < 4; ++p) *(v4u*)(dst + (lane + 64 * p) * 16) = *(const LAS v4u*)((LAS unsigned char*)scr + (lane + 64 * p) * 16);
        LDS_WAIT(); asm volatile("" ::: "memory");
    }
}

DI void fox_attn2(LAS unsigned char* lds, const bf16* P1, const float* cf, const unsigned char* vimg, bf16* hm, int tid, int lane, int wave, int bx) {
    constexpr int BUFB = 16384 + 16384 + 256;
    const float LOG2E = 1.4426950408889634f, QS = 0.08838834764831845f * 1.4426950408889634f, THR = 8.0f;
    const int g = lane >> 4, r16 = lane & 15;
    const int G_ = gridDim.x;
    const int nit = (2048 + G_ - 1) / G_;
    for (int it = 0; it < nit; ++it) {
        const int u = (it & 1) ? it * G_ + (G_ - 1 - bx) : it * G_ + bx;
        if (u >= 2048) continue;
        const int qb = 15 - (u >> 7), bh = u & 127, b = bh >> 4, h = bh & 15;
        const size_t rowb = (size_t)b * SEQ; const int q0 = qb * 256 + 32 * wave;
        bf16x8 qf[2][4]; float c0[2];
#pragma unroll
        for (int tt = 0; tt < 2; ++tt) { const int t = q0 + 16 * tt + r16; c0[tt] = cf[(size_t)bh * SEQ + t] * LOG2E;
#pragma unroll
            for (int kk = 0; kk < 4; ++kk) { const v4u raw = *(const v4u*)(P1 + (rowb + t) * NQKV + h * 128 + 32 * kk + 8 * g); v4u sc;
#pragma unroll
                for (int j = 0; j < 4; ++j) sc[j] = pk2(bflo(raw[j]) * QS, bfhi(raw[j]) * QS);
                qf[tt][kk] = __builtin_bit_cast(bf16x8, sc); } }
        f32x4 oacc[8][2];
#pragma unroll
        for (int et = 0; et < 8; ++et) { oacc[et][0] = (f32x4){0.f, 0.f, 0.f, 0.f}; oacc[et][1] = (f32x4){0.f, 0.f, 0.f, 0.f}; }
        float lrun[2] = {0.f, 0.f};
        const int ntiles = 4 * (qb + 1);
        v4u kreg[2], vreg[2]; float cfreg = 0.f;
        const bf16* kbase = P1 + rowb * NQKV + 2048 + h * 128;
        const unsigned char* vbase = vimg + (size_t)bh * 64 * 16384;
#define FOX_LOAD(j) do { _Pragma("unroll") for (int p = 0; p < 2; ++p) { const int idx = tid + 512 * p, r = idx >> 4, c8 = idx & 15; \
            kreg[p] = *(const v4u*)(kbase + (size_t)(64 * (j) + r) * NQKV + c8 * 8); vreg[p] = *(const v4u*)(vbase + (size_t)(j) * 16384 + idx * 16); } \
            if (tid < 64) cfreg = -cf[(size_t)bh * SEQ + 64 * (j) + tid] * LOG2E; } while (0)
#define FOX_STORE(bufi) do { LAS unsigned char* bb = lds + (bufi) * BUFB; _Pragma("unroll") for (int p = 0; p < 2; ++p) { const int idx = tid + 512 * p, r = idx >> 4, c8 = idx & 15; \
            *(LAS v4u*)((LAS bf16*)bb + eoff<128>(r, c8 * 8)) = kreg[p]; *(LAS v4u*)(bb + 16384 + idx * 16) = vreg[p]; } \
            if (tid < 64) ((LAS float*)(bb + 32768))[tid] = cfreg; } while (0)
        __syncthreads();
        FOX_LOAD(0); FOX_STORE(0);
        if (ntiles > 1) FOX_LOAD(1);
        __syncthreads();
        for (int j = 0; j < ntiles; ++j) {
            if (j + 1 < ntiles) FOX_STORE((j + 1) & 1);
            if (j + 2 < ntiles) FOX_LOAD(j + 2);
            if (64 * j <= q0 + 31) {
                const LAS bf16* Ks = (const LAS bf16*)(lds + (j & 1) * BUFB); const LAS bf16* VTs = Ks + 64 * 128; const LAS float* cfs = (const LAS float*)(VTs + 128 * 64);
                f32x4 sacc[2][4];
#pragma unroll
                for (int st = 0; st < 4; ++st) { const f32x4 cv = *(const LAS f32x4*)(cfs + 16 * st + 4 * g);
#pragma unroll
                    for (int tt = 0; tt < 2; ++tt) sacc[tt][st] = cv + c0[tt]; }
#pragma unroll
                for (int st = 0; st < 4; ++st)
#pragma unroll
                    for (int kk = 0; kk < 4; ++kk) { const bf16x8 kf = ldf<128>(Ks, 16 * st + r16, 4 * kk + g);
                        sacc[0][st] = mfma16(kf, qf[0][kk], sacc[0][st]); sacc[1][st] = mfma16(kf, qf[1][kk], sacc[1][st]); if (kk == 3) asm volatile("" ::: "memory"); }
                if (64 * j + 63 > q0) {
#pragma unroll
                    for (int tt = 0; tt < 2; ++tt) { const int t = q0 + 16 * tt + r16;
#pragma unroll
                        for (int st = 0; st < 4; ++st)
#pragma unroll
                            for (int i = 0; i < 4; ++i) { const int s = 64 * j + 16 * st + 4 * g + i; if (s > t) sacc[tt][st][i] = -__builtin_inff(); } }
                }
                float mx[2];
#pragma unroll
                for (int tt = 0; tt < 2; ++tt) { float m = -__builtin_inff();
#pragma unroll
                    for (int st = 0; st < 4; ++st) m = fmaxf(m, fmaxf(fmaxf(sacc[tt][st][0], sacc[tt][st][1]), fmaxf(sacc[tt][st][2], sacc[tt][st][3])));
                    m = fmaxf(m, __shfl_xor(m, 16)); m = fmaxf(m, __shfl_xor(m, 32)); mx[tt] = m; }
                if (__any(mx[0] > THR || mx[1] > THR)) {
#pragma unroll
                    for (int tt = 0; tt < 2; ++tt) { const float sh = fmaxf(mx[tt], 0.f), f = __builtin_amdgcn_exp2f(-sh);
                        c0[tt] -= sh; lrun[tt] *= f;
#pragma unroll
                        for (int st = 0; st < 4; ++st) sacc[tt][st] = sacc[tt][st] - sh;
#pragma unroll
                        for (int et = 0; et < 8; ++et) oacc[et][tt] = oacc[et][tt] * f; }
                }
#pragma unroll
                for (int tt = 0; tt < 2; ++tt) { float ls = 0.f;
#pragma unroll
                    for (int st = 0; st < 4; ++st)
#pragma unroll
                        for (int i = 0; i < 4; ++i) { const float p = __builtin_amdgcn_exp2f(sacc[tt][st][i]); sacc[tt][st][i] = p; ls += p; }
                    lrun[tt] += ls; }
#pragma unroll
                for (int ks = 0; ks < 2; ++ks) { bf16x8 pb[2];
#pragma unroll
                    for (int tt = 0; tt < 2; ++tt) { v4u w; w.x = pk2(sacc[tt][2 * ks][0], sacc[tt][2 * ks][1]); w.y = pk2(sacc[tt][2 * ks][2], sacc[tt][2 * ks][3]);
                        w.z = pk2(sacc[tt][2 * ks + 1][0], sacc[tt][2 * ks + 1][1]); w.w = pk2(sacc[tt][2 * ks + 1][2], sacc[tt][2 * ks + 1][3]); pb[tt] = __builtin_bit_cast(bf16x8, w); }
#pragma unroll
                    for (int et = 0; et < 8; ++et) { const int e = 16 * et + r16;
                        const v2u lo = *(const LAS v2u*)(VTs + eoff<64>(e, 32 * ks + 4 * g)), hi = *(const LAS v2u*)(VTs + eoff<64>(e, 32 * ks + 16 + 4 * g));
                        v4u aw; aw.x = lo.x; aw.y = lo.y; aw.z = hi.x; aw.w = hi.y; const bf16x8 va = __builtin_bit_cast(bf16x8, aw);
                        oacc[et][0] = mfma16(va, pb[0], oacc[et][0]); oacc[et][1] = mfma16(va, pb[1], oacc[et][1]); if (et & 1) asm volatile("" ::: "memory"); } }
            }
            __syncthreads();
        }
#undef FOX_LOAD
#undef FOX_STORE
#pragma unroll
        for (int tt = 0; tt < 2; ++tt) { float l = lrun[tt]; l += __shfl_xor(l, 16); l += __shfl_xor(l, 32); const float inv = 1.0f / l;
            bf16* orow = hm + (rowb + q0 + 16 * tt + r16) * DM + h * 128 + 4 * g;
#pragma unroll
            for (int et = 0; et < 8; ++et) { v2u w; w.x = pk2(oacc[et][tt][0] * inv, oacc[et][tt][1] * inv); w.y = pk2(oacc[et][tt][2] * inv, oacc[et][tt][3] * inv); *(v2u*)(orow + 16 * et) = w; } }
    }
}


DI void final_norm(float* out, const long long* ss, const float* gfin, int lane, int wave, int bx) {
    const int gw = bx * NWAVES + wave, NGW = gridDim.x * NWAVES;
    for (int m = gw; m < MTOK; m += NGW) { const float rs = pg8::rstd_of(ss, m);
        f32x4* xr = (f32x4*)(out + (size_t)m * DM) + lane; const f32x4* gr = (const f32x4*)gfin + lane;
#pragma unroll
        for (int j = 0; j < 8; ++j) { const f32x4 v = xr[64 * j], gg = gr[64 * j]; xr[64 * j] = v * rs * gg; } }
}

#define PH(p) if (lo <= (p) && (p) < hi && (ran ? (xcd_barrier(bar), true) : (ran = true)))
#define TID() int tid = threadIdx.x; asm volatile("" : "+v"(tid)); const int lane = tid & 63, wave = __builtin_amdgcn_readfirstlane(tid >> 6); int bx = blockIdx.x; asm volatile("" : "+s"(bx)); (void)lane; (void)wave; (void)bx
#define WSP(T, off) ((T*)(ka->ws + (off)))
template <int j> DI void subblock(LAS unsigned char* lds, const XcdBarrier& bar, const int lo, const int hi, bool& ran) {
    {
        constexpr int layer = j / 3, typ = j - 3 * layer, base = 1 + 5 * j;
        if constexpr (typ != 1) {
            PH(base) { TID(); KArgs ka = kargs(); const int mi = layer * 2 + (typ >> 1);
                pg8::Gemm gm{WSP(bf16, WS_HB), WSP(bf16, WS_WUP) + (size_t)mi * NUP * DM, MTOK, NUP, DM}; pg8::StaticOrder S; S.init(MTOK, NUP, gridDim.x, bx);
                pg8::EpiSwiGLU E{WSP(bf16, WS_ACT), WSP(long long, WS_SS) + (size_t)j * MTOK, DFF};
                pg8::gemm_phase<pg8::EpiSwiGLU, pg8::StaticOrder, PG8_ALIGN, PG8_SP2>(lds, gm, S, E); }
        } else {
            constexpr int kind = layer % 3, ji = layer / 3;
            PH(base) { TID(); KArgs ka = kargs();
                mixer_gates(WSP(bf16, WS_HB), WSP(bf16, WS_WIN) + ((size_t)layer * NINP + NQKV) * DM, WSP(long long, WS_SS) + (size_t)j * MTOK, WSP(float, WS_G), lane, wave, bx);
                pg8::Gemm gm{WSP(bf16, WS_HB), WSP(bf16, WS_WIN) + (size_t)layer * NINP * DM, MTOK, NQKV, DM}; pg8::StaticOrder S; S.init(MTOK, NQKV, gridDim.x, bx);
                pg8::EpiMixIn E{WSP(bf16, WS_P1), WSP(long long, WS_SS) + (size_t)j * MTOK};
                pg8::gemm_phase<pg8::EpiMixIn, pg8::StaticOrder, PG8_ALIGN, PG8_SP2>(lds, gm, S, E); }
            PH(base + 1) { TID(); KArgs ka = kargs();
                if constexpr (kind == 0) for (int rep = 0; rep < REP_MLSTM; ++rep) mlstm_pre(lds, WSP(bf16, WS_P1), WSP(float, WS_G), ka->in[6] + ji * 16, WSP(unsigned char, WS_ACT), tid, lane, wave, bx);
                else if constexpr (kind == 1) { fox_cf(lds, WSP(float, WS_G), ka->in[10] + ji * 16, WSP(float, WS_CF), tid, lane, wave, bx); __syncthreads(); fox_vt_pre(lds, WSP(bf16, WS_P1), WSP(unsigned char, WS_ACT), lane, wave, bx); }
                else for (int rep = 0; rep < REP_GLA; ++rep) gla_pre(lds, WSP(bf16, WS_P1), WSP(float, WS_G), ka->in[13] + (size_t)ji * 16 * 1024, ka->in[14] + ji * 1024, WSP(unsigned char, WS_ACT), tid, lane, wave, bx);
            }
            PH(base + 2) { TID(); KArgs ka = kargs();
                if constexpr (kind == 0) for (int rep = 0; rep < REP_MLSTM; ++rep) mlstm_scan2(lds, WSP(bf16, WS_P1), WSP(unsigned char, WS_ACT), WSP(float, WS_HRAW), tid, lane, wave, bx);
                else if constexpr (kind == 1) for (int rep = 0; rep < REP_FOX; ++rep) fox_attn2(lds, WSP(bf16, WS_P1), WSP(float, WS_CF), WSP(unsigned char, WS_ACT), WSP(bf16, WS_HM), tid, lane, wave, bx);
                else for (int rep = 0; rep < REP_GLA; ++rep) gla_scan2(lds, WSP(unsigned char, WS_ACT), WSP(float, WS_HRAW), tid, lane, wave, bx);
            }
            if constexpr (kind != 1) { PH(base + 3) { TID(); KArgs ka = kargs();
                if constexpr (kind == 0) headnorm_gate<256, 0>(WSP(float, WS_HRAW), WSP(bf16, WS_P1), ka->in[7] + ji * DM, WSP(bf16, WS_HM), lane, wave, bx);
                else headnorm_gate<512, 1>(WSP(float, WS_HRAW), WSP(bf16, WS_P1), ka->in[15] + ji * DM, WSP(bf16, WS_HM), lane, wave, bx);
            } }
        }
        PH(base + 4) { TID(); KArgs ka = kargs();
            pg8::Gemm gm; float scale;
            if constexpr (typ != 1) { const int mi = layer * 2 + (typ >> 1); gm = pg8::Gemm{WSP(bf16, WS_ACT), WSP(bf16, WS_WDN) + (size_t)mi * DM * DFF, MTOK, DM, DFF}; scale = 0.5f; }
            else { gm = pg8::Gemm{WSP(bf16, WS_HM), WSP(bf16, WS_WOUT) + (size_t)layer * DM * DM, MTOK, DM, DM}; scale = 1.0f; }
            pg8::StaticOrder S; S.init(MTOK, DM, gridDim.x, bx);
            pg8::EpiResid E{(j == 0) ? ka->in[0] : (const float*)ka->out, ka->out, WSP(bf16, WS_HB), WSP(long long, WS_SS) + (size_t)(j + 1) * MTOK, scale};
            pg8::gemm_phase<pg8::EpiResid, pg8::StaticOrder, PG8_ALIGN, PG8_SP2>(lds, gm, S, E);
        }
    }
}

__global__ void __launch_bounds__(NWAVES * 64, 2) trunk_fwd(Args args) {
    extern __shared__ __attribute__((aligned(16))) unsigned char lds_raw[];
    LAS unsigned char* lds = (LAS unsigned char*)lds_raw;
    volatile LAS unsigned* MISC = (volatile LAS unsigned*)(lds + MISC_OFF);
    for (int u = threadIdx.x; u < (LDS_BYTES - MISC_OFF) / 4; u += NWAVES * 64) ((LAS unsigned*)(lds + MISC_OFF))[u] = 0u;
    __syncthreads();
    XcdBarrier bar = xcd_barrier_post((unsigned*)(args.ws + WS_CTL) + CW_BAR, MISC + 8);
    const int lo = args.ph_lo, hi = args.ph_hi; bool ran = false;

    PH(0) { TID(); for (int rep = 0; rep < REP_PRO; ++rep) { prologue(lds, lane, wave, bx); __syncthreads(); } }

    subblock<0>(lds, bar, lo, hi, ran); subblock<1>(lds, bar, lo, hi, ran); subblock<2>(lds, bar, lo, hi, ran); subblock<3>(lds, bar, lo, hi, ran);
    subblock<4>(lds, bar, lo, hi, ran); subblock<5>(lds, bar, lo, hi, ran); subblock<6>(lds, bar, lo, hi, ran); subblock<7>(lds, bar, lo, hi, ran);
    subblock<8>(lds, bar, lo, hi, ran); subblock<9>(lds, bar, lo, hi, ran); subblock<10>(lds, bar, lo, hi, ran); subblock<11>(lds, bar, lo, hi, ran);
    PH(NPHASE - 1) { TID(); KArgs ka = kargs(); final_norm(ka->out, WSP(long long, WS_SS) + (size_t)NSUB * MTOK, ka->in[17], lane, wave, bx); }
#undef WSP
#undef PH
}

static bool phase_exists(int p) {
    if (p == 0 || p == NPHASE - 1) return true;
    const int j = (p - 1) / 5, k = (p - 1) % 5, typ = j % 3;
    if (k == 0 || k == 4) return true;
    if (typ != 1) return false;
    if (k == 3) return ((j / 3) % 3) != 1;
    return true;
}
extern "C" void kernel_launch(void* const* d_in, const int* in_sizes, int n_in, void* d_out, int out_size, void* d_ws, size_t ws_size, hipStream_t stream) {
    static int grid = 0;
    if (grid == 0) {
        if (n_in != 18 || in_sizes[0] != MTOK * DM || out_size != MTOK * DM || ws_size < WS_END) { fprintf(stderr, "kernel_launch: unexpected shapes (n_in %d, in0 %d, out %d, ws %zu < %zu)\n", n_in, n_in > 0 ? in_sizes[0] : -1, out_size, ws_size, (size_t)WS_END); grid = -1; return; }
        int dev = 0, cus = 0, per_cu = 0;
        if (hipGetDevice(&dev) != hipSuccess || hipDeviceGetAttribute(&cus, hipDeviceAttributeMultiprocessorCount, dev) != hipSuccess) { grid = -1; return; }
        if (hipFuncSetAttribute((const void*)trunk_fwd, hipFuncAttributeMaxDynamicSharedMemorySize, LDS_BYTES) != hipSuccess) { fprintf(stderr, "kernel_launch: hipFuncSetAttribute failed\n"); grid = -1; return; }
        if (hipOccupancyMaxActiveBlocksPerMultiprocessor(&per_cu, (const void*)trunk_fwd, NWAVES * 64, LDS_BYTES) != hipSuccess || per_cu < 1) fprintf(stderr, "kernel_launch: occupancy query says %d\n", per_cu);
        (void)hipGetLastError();
        grid = cus;
    }
    if (grid < 0) return;
    if (hipMemsetAsync((char*)d_ws + WS_CTL, 0, CTL_ZERO_BYTES, stream) != hipSuccess) return;
    Args a{};
    for (int i = 0; i < 18; ++i) a.in[i] = (const float*)d_in[i];
    a.out = (float*)d_out; a.ws = (unsigned char*)d_ws;
#if MK_PER_PHASE
    for (int p = 0; p < NPHASE; ++p) { if (!phase_exists(p)) continue; a.ph_lo = p; a.ph_hi = p + 1; hipLaunchKernelGGL(trunk_fwd, dim3(grid), dim3(NWAVES * 64), LDS_BYTES, stream, a); }
#else
    a.ph_lo = 0; a.ph_hi = NPHASE; hipLaunchKernelGGL(trunk_fwd, dim3(grid), dim3(NWAVES * 64), LDS_BYTES, stream, a);
#endif
    (void)phase_exists;
}
```

```cpp
#include <hip/hip_runtime.h>
#include <cstdio>
#include <cstdint>
namespace pg8 {
#define PG8_LAS __attribute__((address_space(3)))
typedef unsigned short bf16_t;
typedef short bf16x8 __attribute__((ext_vector_type(8)));
typedef float f32x4 __attribute__((ext_vector_type(4)));
typedef unsigned u32x4 __attribute__((ext_vector_type(4)));
constexpr int BM = 256, BK = 64, HALF = 128, HTB = HALF * BK * 2  , STAGE_BYTES = 8 * HTB, NXCD = 8, WGM = 8;

__host__ __device__ __forceinline__ int lds_byte(int r, int c) { const int st = (r >> 4) * 2 + (c >> 5), rr = r & 15, cc = c & 31, ob = rr * 64 + cc * 2; return st * 1024 + (ob ^ (((ob >> 9) & 1) << 5)); }
__host__ __device__ __forceinline__ void stage_rc(int b, int& R, int& C) { const int st = b / 1024, sb = b % 1024, swz = sb ^ (((sb >> 9) & 1) << 5); R = (st >> 1) * 16 + swz / 64; C = (st & 1) * 32 + (swz % 64) / 2; }
__host__ __device__ __forceinline__ int perm32(int rho) { const int n = rho >> 4, i = rho & 15; return 8 * (i >> 2) + 4 * n + (i & 3); }

struct Unit { int pm, pn; };
struct Gemm { const bf16_t* A; const bf16_t* Bt; int M, N, K; };

struct StaticOrder {
    int nM, nN, nwg, G, c;
    __host__ __device__ void init(int M, int N, int G_, int c_) { nM = M / BM; nN = N / BM; nwg = nM * nN; G = G_; c = c_; }
    __host__ __device__ bool next(int i, Unit& u) const {
        const long L = (long)i * G + c; if (L >= nwg) return false;
        int wgid = (int)L; { const int q = nwg / NXCD, r = nwg % NXCD, xcd = wgid % NXCD, off = wgid / NXCD; wgid = (xcd < r ? xcd * (q + 1) : r * (q + 1) + (xcd - r) * q) + off; }
        const int nig = WGM * nN, gid = wgid / nig, fm = gid * WGM, gsz = (nM - fm) < WGM ? (nM - fm) : WGM;
        u.pm = fm + ((wgid % nig) % gsz); u.pn = (wgid % nig) / gsz; return true;
    }
    __device__ __forceinline__ void a_ready(const Unit&) const {}
    __device__ __forceinline__ void done(const Unit&) const {}
};

__device__ __forceinline__ unsigned cvt_pk_bf16(float lo, float hi) { unsigned r; asm volatile("v_cvt_pk_bf16_f32 %0, %1, %2" : "=v"(r) : "v"(lo), "v"(hi)); return r; }
constexpr float RMS_EPS_F = 1e-6f, SS_FIX = 1048576.0f, SS_UNFIX_D = 1.0f / (1048576.0f * 2048.0f);
typedef long long ss_t;
__device__ __forceinline__ float rstd_of(const ss_t* ss, int row) { return rsqrtf((float)ss[row] * SS_UNFIX_D + RMS_EPS_F); }
template <class Sched> __device__ __forceinline__ int rstd_table_fill(const Sched& S, const ss_t* ss, PG8_LAS unsigned char* ext, int tid) {
    PG8_LAS float* tab = (PG8_LAS float*)ext; int key0 = -1, key1 = -1, bad = 0; Unit u;
    for (int i = 0; S.next(i, u); ++i) { const int slot = (u.pm >> 3) & 1; const int key = slot ? key1 : key0;
        if (key == u.pm) continue;
        if (key >= 0) { bad = 1; continue; }
        if (slot) key1 = u.pm; else key0 = u.pm;
        if (tid < 256) tab[slot * 256 + tid] = rstd_of(ss, u.pm * BM + tid); }
    asm volatile("s_waitcnt lgkmcnt(0)" ::: "memory"); __builtin_amdgcn_s_barrier(); asm volatile("" ::: "memory");
    return bad;
}
__device__ __forceinline__ float rstd_get(const ss_t* ss, const Unit& u, int row, int pf, const PG8_LAS unsigned char* ext) {
    return pf ? rstd_of(ss, row) : ((const PG8_LAS float*)ext)[((u.pm >> 3) & 1) * 256 + (row - u.pm * BM)];
}
struct EpiSwiGLU {
    static constexpr bool PERM = true, AFTER_DRAIN = false;
    bf16_t* O; const ss_t* ss; int ldo;
    template <class Sched> __device__ __forceinline__ int prepare(const Sched& S, PG8_LAS unsigned char* ext, int tid) const { return rstd_table_fill(S, ss, ext, tid); }
    __device__ __forceinline__ void operator()(const f32x4 (&acc)[2][2][4][2], const Unit& u, int wr, int wc, int fr, int fq, int pf, const PG8_LAS unsigned char* ext) const {
        const int row0 = u.pm * BM + wr * 64 + fr, col0 = u.pn * HALF + wc * 32 + 8 * fq;
#pragma unroll
        for (int ai = 0; ai < 2; ++ai)
#pragma unroll
            for (int m = 0; m < 4; ++m) {
                const int row = row0 + ai * HALF + m * 16;
                const float rs = rstd_get(ss, u, row, pf, ext);
                float o[8];
#pragma unroll
                for (int n = 0; n < 2; ++n)
#pragma unroll
                    for (int j = 0; j < 4; ++j) { const float a = acc[ai][0][m][n][j] * rs, b = acc[ai][1][m][n][j] * rs;
                        o[4 * n + j] = a * b * __builtin_amdgcn_rcpf(1.0f + __expf(-a)); }
                u32x4 w; w.x = cvt_pk_bf16(o[0], o[1]); w.y = cvt_pk_bf16(o[2], o[3]); w.z = cvt_pk_bf16(o[4], o[5]); w.w = cvt_pk_bf16(o[6], o[7]);
                *(u32x4*)(O + (size_t)row * ldo + col0) = w;
            }
    }
};
struct EpiMixIn {
    static constexpr bool PERM = true, AFTER_DRAIN = false;
    bf16_t* O; const ss_t* ss;
    template <class Sched> __device__ __forceinline__ int prepare(const Sched& S, PG8_LAS unsigned char* ext, int tid) const { return rstd_table_fill(S, ss, ext, tid); }
    __device__ __forceinline__ void operator()(const f32x4 (&acc)[2][2][4][2], const Unit& u, int wr, int wc, int fr, int fq, int pf, const PG8_LAS unsigned char* ext) const {
        const int row0 = u.pm * BM + wr * 64 + fr, col0 = u.pn * BM + wc * 32 + 8 * fq;
#pragma unroll
        for (int ai = 0; ai < 2; ++ai)
#pragma unroll
            for (int m = 0; m < 4; ++m) {
                const int row = row0 + ai * HALF + m * 16;
                const float rs = rstd_get(ss, u, row, pf, ext);
#pragma unroll
                for (int bj = 0; bj < 2; ++bj) { const f32x4 v0 = acc[ai][bj][m][0] * rs, v1 = acc[ai][bj][m][1] * rs;
                    u32x4 w; w.x = cvt_pk_bf16(v0[0], v0[1]); w.y = cvt_pk_bf16(v0[2], v0[3]); w.z = cvt_pk_bf16(v1[0], v1[1]); w.w = cvt_pk_bf16(v1[2], v1[3]);
                    *(u32x4*)(O + (size_t)row * 6144 + col0 + bj * HALF) = w; }
            }
    }
};
struct EpiResid {
    static constexpr bool PERM = false, AFTER_DRAIN = false;
    const float* res; float* hout; bf16_t* hb; ss_t* ssn; float scale;
    template <class Sched> __device__ __forceinline__ int prepare(const Sched&, PG8_LAS unsigned char*, int) const { return 0; }
    __device__ __forceinline__ void operator()(const f32x4 (&acc)[2][2][4][2], const Unit& u, int wr, int wc, int fr, int fq, int pf, const PG8_LAS unsigned char* ext) const {
        typedef unsigned u32x2v __attribute__((ext_vector_type(2)));
        const int row0 = u.pm * BM + wr * 64 + fr, col0 = u.pn * BM + wc * 32 + 4 * fq;
        f32x4 rb[3][4];
#define PG8_LDG(gi, buf) do { const size_t off_ = (size_t)(row0 + ((gi) >> 2) * HALF + ((gi) & 3) * 16) * 2048 + col0; \
            _Pragma("unroll") for (int q_ = 0; q_ < 4; ++q_) buf[q_] = *(const f32x4*)(res + off_ + (q_ >> 1) * HALF + (q_ & 1) * 16); } while (0)
        PG8_LDG(0, rb[0]); PG8_LDG(1, rb[1]);
#pragma unroll
        for (int gi = 0; gi < 8; ++gi) {
            if (gi + 2 < 8) PG8_LDG(gi + 2, rb[(gi + 2) % 3]);
            const int ai = gi >> 2, m = gi & 3;
            const int row = row0 + ai * HALF + m * 16; const size_t off = (size_t)row * 2048 + col0; float sq = 0.f;
#pragma unroll
            for (int q = 0; q < 4; ++q) { const int bj = q >> 1, n = q & 1; const size_t o2 = off + bj * HALF + n * 16;
                const f32x4 hn = rb[gi % 3][q] + acc[ai][bj][m][n] * scale;
                *(f32x4*)(hout + o2) = hn; u32x2v w; w.x = cvt_pk_bf16(hn[0], hn[1]); w.y = cvt_pk_bf16(hn[2], hn[3]); *(u32x2v*)(hb + o2) = w;
                sq += (hn[0] * hn[0] + hn[1] * hn[1]) + (hn[2] * hn[2] + hn[3] * hn[3]); }
            sq += __shfl_xor(sq, 16); sq += __shfl_xor(sq, 32);
            if (fq == 0) atomicAdd((unsigned long long*)(ssn + row), (unsigned long long)__float2ll_rn(sq * SS_FIX));
        }
#undef PG8_LDG
    }
};

template <class Epi, class Sched, bool ALIGN_EPI = false, bool SP2 = false>
__device__ __forceinline__ void gemm_phase(PG8_LAS unsigned char* lds, const Gemm g, const Sched& S, const Epi& E) {
    int tid_ = threadIdx.x; asm volatile("" : "+v"(tid_));
    const int tid = tid_, wid = __builtin_amdgcn_readfirstlane(tid >> 6), lane = tid & 63, wr = wid >> 2, wc = wid & 3, fr = lane & 15, fq = lane >> 4;
    const int K = g.K, nt = K / BK;
    unsigned voffA[2], voffB[2];
#pragma unroll
    for (int i = 0; i < 2; ++i) { int R, C; stage_rc(tid * 16 + i * 8192, R, C); const int Rb = Epi::PERM ? ((R & ~31) + perm32(R & 31)) : R;
        voffA[i] = (unsigned)(R * K + C) * 2u; voffB[i] = (unsigned)(Rb * K + C) * 2u; }
    const size_t kstep = (size_t)(BK * 2);
    const size_t hstep = (size_t)HALF * K * 2;
    const size_t tstep = 2 * hstep;
    const unsigned ldsw = (unsigned)wid * 1024u;
    const int aoff = lds_byte(wr * 64 + fr, fq * 8), boff = lds_byte(wc * 32 + fr, fq * 8);
#define PG8_SA(b, h) (((b) * 2 + (h)) * HTB)
#define PG8_SB(b, h) ((4 + (b) * 2 + (h)) * HTB)
#define PG8_STAGE(bufoff, gbase, voff) do { _Pragma("unroll") for (int _i = 0; _i < 2; ++_i) \
        __builtin_amdgcn_global_load_lds((const unsigned*)((const char*)(gbase) + (voff)[_i]), (PG8_LAS unsigned*)(lds + (bufoff) + ldsw + _i * 8192), 16, 0, 0); } while (0)
#define PG8_LDA(dst, b, h) do { _Pragma("unroll") for (int m = 0; m < 4; ++m) _Pragma("unroll") for (int k = 0; k < 2; ++k) dst[m][k] = *(const PG8_LAS bf16x8*)(lds + PG8_SA(b, h) + aoff + m * 2048 + k * 1024); } while (0)
#define PG8_LDB(dst, b, h) do { _Pragma("unroll") for (int n = 0; n < 2; ++n) _Pragma("unroll") for (int k = 0; k < 2; ++k) dst[n][k] = *(const PG8_LAS bf16x8*)(lds + PG8_SB(b, h) + boff + n * 2048 + k * 1024); } while (0)
#define PG8_MMA(ai, bj, At, Bt) do { __builtin_amdgcn_s_setprio(1); _Pragma("unroll") for (int m = 0; m < 4; ++m) _Pragma("unroll") for (int n = 0; n < 2; ++n) _Pragma("unroll") for (int k = 0; k < 2; ++k) \
        acc[ai][bj][m][n] = __builtin_amdgcn_mfma_f32_16x16x32_bf16(Bt[n][k], At[m][k], acc[ai][bj][m][n], 0, 0, 0); __builtin_amdgcn_s_setprio(0); } while (0)
#define PG8_WAIT_V(n) asm volatile("s_waitcnt vmcnt(" #n ")" ::: "memory")
#define PG8_WAIT_L(n) asm volatile("s_waitcnt lgkmcnt(" #n ")" ::: "memory")
#define PG8_BAR __builtin_amdgcn_s_barrier()
#define PG8_SCHED __builtin_amdgcn_sched_barrier(0)
    const int pf = E.prepare(S, lds + STAGE_BYTES, tid);
    Unit cur, nxt; int ui = 0;
    if (!S.next(0, cur)) return;
    f32x4 acc[2][2][4][2];
#pragma unroll
    for (int a = 0; a < 2; ++a)
#pragma unroll
        for (int b = 0; b < 2; ++b)
#pragma unroll
            for (int m = 0; m < 4; ++m)
#pragma unroll
                for (int n = 0; n < 2; ++n) acc[a][b][m][n] = (f32x4){0.f, 0.f, 0.f, 0.f};
    bf16x8 At[4][2], B0[2][2], B1[2][2];
    const char* cA = (const char*)g.A + (size_t)cur.pm * tstep; const char* cB = (const char*)g.Bt + (size_t)cur.pn * tstep;
    S.a_ready(cur);
    if constexpr (SP2) {
        PG8_STAGE(PG8_SB(0, 0), cB, voffB); PG8_STAGE(PG8_SB(0, 1), cB + hstep, voffB); PG8_STAGE(PG8_SA(0, 0), cA, voffA); PG8_STAGE(PG8_SA(0, 1), cA + hstep, voffA);
        if (wr == 1) PG8_BAR;
        PG8_WAIT_V(2); PG8_BAR;
        PG8_STAGE(PG8_SB(1, 0), cB + kstep, voffB); PG8_STAGE(PG8_SA(1, 0), cA + kstep, voffA); PG8_STAGE(PG8_SB(1, 1), cB + hstep + kstep, voffB);
        PG8_WAIT_V(6); PG8_BAR;
    } else {
        PG8_STAGE(PG8_SB(0, 0), cB, voffB); PG8_STAGE(PG8_SA(0, 0), cA, voffA); PG8_STAGE(PG8_SB(0, 1), cB + hstep, voffB); PG8_STAGE(PG8_SA(0, 1), cA + hstep, voffA);
        if (wr == 1) PG8_BAR;
        PG8_WAIT_V(4); PG8_BAR;
        PG8_STAGE(PG8_SB(1, 0), cB + kstep, voffB); PG8_STAGE(PG8_SA(1, 0), cA + kstep, voffA); PG8_STAGE(PG8_SB(1, 1), cB + hstep + kstep, voffB);
        PG8_WAIT_V(6); PG8_BAR;
    }
    for (;;) {
        const bool has_next = S.next(ui + 1, nxt);
        const char* nA = has_next ? (const char*)g.A + (size_t)nxt.pm * tstep : cA; const char* nB = has_next ? (const char*)g.Bt + (size_t)nxt.pn * tstep : cB;
        for (int t = 0; t < nt; t += 2) {
            const bool last = (t == nt - 2);
            const char* a1 = cA + (size_t)(t + 1) * kstep;
            const char* a2 = last ? nA : cA + (size_t)(t + 2) * kstep; const char* b2 = last ? nB : cB + (size_t)(t + 2) * kstep;
            const char* a3 = a2 + kstep; const char* b3 = b2 + kstep;
            if (last && has_next) S.a_ready(nxt);
            if constexpr (SP2) {
            PG8_LDB(B0, 0, 0); PG8_LDB(B1, 0, 1); PG8_SCHED; PG8_LDA(At, 0, 0); PG8_STAGE(PG8_SA(1, 1), a1 + hstep, voffA);
            PG8_WAIT_V(8); PG8_WAIT_L(0); PG8_BAR; PG8_MMA(0, 0, At, B0); PG8_MMA(0, 1, At, B1); PG8_BAR; PG8_SCHED;
            PG8_LDA(At, 0, 1); PG8_STAGE(PG8_SB(0, 0), b2, voffB); PG8_STAGE(PG8_SB(0, 1), b2 + hstep, voffB); PG8_STAGE(PG8_SA(0, 0), a2, voffA);
            PG8_WAIT_V(8); PG8_WAIT_L(0); PG8_BAR; PG8_MMA(1, 0, At, B0); PG8_MMA(1, 1, At, B1); PG8_BAR; PG8_SCHED;
            PG8_LDB(B0, 1, 0); PG8_LDB(B1, 1, 1); PG8_SCHED; PG8_LDA(At, 1, 0); PG8_STAGE(PG8_SA(0, 1), a2 + hstep, voffA);
            PG8_WAIT_V(8); PG8_WAIT_L(0); PG8_BAR; PG8_MMA(0, 0, At, B0); PG8_MMA(0, 1, At, B1); PG8_BAR; PG8_SCHED;
            PG8_LDA(At, 1, 1); PG8_STAGE(PG8_SB(1, 0), b3, voffB); PG8_STAGE(PG8_SB(1, 1), b3 + hstep, voffB); PG8_STAGE(PG8_SA(1, 0), a3, voffA);
            PG8_WAIT_V(8); PG8_WAIT_L(0); PG8_BAR; PG8_MMA(1, 0, At, B0); PG8_MMA(1, 1, At, B1); PG8_BAR; PG8_SCHED;
            } else {
            PG8_LDB(B0, 0, 0); PG8_SCHED; PG8_LDA(At, 0, 0); PG8_STAGE(PG8_SA(1, 1), a1 + hstep, voffA);
            PG8_WAIT_L(8); PG8_BAR; PG8_WAIT_L(0); PG8_MMA(0, 0, At, B0); PG8_BAR; PG8_SCHED;
            PG8_LDB(B1, 0, 1); PG8_STAGE(PG8_SB(0, 0), b2, voffB);
            PG8_BAR; PG8_WAIT_L(0); PG8_MMA(0, 1, At, B1); PG8_BAR;
            PG8_LDA(At, 0, 1); PG8_STAGE(PG8_SA(0, 0), a2, voffA);
            PG8_BAR; PG8_WAIT_L(0); PG8_MMA(1, 0, At, B0); PG8_BAR; PG8_SCHED;
            PG8_STAGE(PG8_SB(0, 1), b2 + hstep, voffB);
            PG8_WAIT_V(6); PG8_BAR; PG8_MMA(1, 1, At, B1); PG8_BAR;
            PG8_LDB(B0, 1, 0); PG8_SCHED; PG8_LDA(At, 1, 0); PG8_STAGE(PG8_SA(0, 1), a2 + hstep, voffA);
            PG8_WAIT_L(8); PG8_BAR; PG8_WAIT_L(0); PG8_MMA(0, 0, At, B0); PG8_BAR; PG8_SCHED;
            PG8_LDB(B1, 1, 1); PG8_STAGE(PG8_SB(1, 0), b3, voffB);
            PG8_BAR; PG8_WAIT_L(0); PG8_MMA(0, 1, At, B1); PG8_BAR;
            PG8_LDA(At, 1, 1); PG8_STAGE(PG8_SA(1, 0), a3, voffA);
            PG8_BAR; PG8_WAIT_L(0); PG8_MMA(1, 0, At, B0); PG8_BAR; PG8_SCHED;
            PG8_STAGE(PG8_SB(1, 1), b3 + hstep, voffB);
            PG8_WAIT_V(6); PG8_BAR; PG8_MMA(1, 1, At, B1); PG8_BAR;
            }
        }
        if constexpr (ALIGN_EPI) { if (wr == 0) PG8_BAR; }
        if constexpr (!Epi::AFTER_DRAIN) { E(acc, cur, wr, wc, fr, fq, pf, lds + STAGE_BYTES); S.done(cur); }
        if (!has_next) break;
#pragma unroll
        for (int a = 0; a < 2; ++a)
#pragma unroll
            for (int b = 0; b < 2; ++b)
#pragma unroll
                for (int m = 0; m < 4; ++m)
#pragma unroll
                    for (int n = 0; n < 2; ++n) acc[a][b][m][n] = (f32x4){0.f, 0.f, 0.f, 0.f};
        cur = nxt; cA = nA; cB = nB; ++ui;
        if constexpr (ALIGN_EPI) { if (wr == 1) PG8_BAR; }
    }
    PG8_WAIT_V(0);
    if constexpr (!ALIGN_EPI) { if (wr == 0) PG8_BAR; }
    PG8_BAR;
    if constexpr (Epi::AFTER_DRAIN) { E.fused(acc, cur, wr, wc, fr, fq, lds, wid, lane); S.done(cur); }
#undef PG8_SA
#undef PG8_SB
#undef PG8_STAGE
#undef PG8_LDA
#undef PG8_LDB
#undef PG8_MMA
#undef PG8_WAIT_V
#undef PG8_WAIT_L
#undef PG8_BAR
#undef PG8_SCHED
}
}

#ifndef PG8_SP2
#define PG8_SP2 true
#endif
#ifndef PG8_ALIGN
#define PG8_ALIGN true
#endif
#ifndef REP_PRO
#define REP_PRO 1
#endif
#ifndef REP_MLSTM
#define REP_MLSTM 1
#endif
#ifndef REP_FOX
#define REP_FOX 1
#endif
#ifndef REP_GLA
#define REP_GLA 1
#endif
#ifndef MK_PER_PHASE
#define MK_PER_PHASE 0
#endif

constexpr int DM = 2048, BATCH = 8, SEQ = 4096, MTOK = BATCH * SEQ, DEPTH = 4, DFF = 5632, NUP = 2 * DFF, NIN = 6160, NINP = 6400, NQKV = 6144;
constexpr int NWAVES = 8;
constexpr int NSUB = 3 * DEPTH;
constexpr int NPHASE = 2 + 5 * NSUB;

constexpr size_t MiB = 1u << 20;
constexpr size_t WS_CTL = 0, CTL_ZERO_BYTES = 5 * MiB;
constexpr size_t WS_SS = 1 * MiB;
constexpr size_t WS_WUP = 8 * MiB;
constexpr size_t WS_WDN = WS_WUP + 352 * MiB;
constexpr size_t WS_WIN = WS_WDN + 176 * MiB;
constexpr size_t WS_WOUT = WS_WIN + 100 * MiB;
constexpr size_t WS_HB = WS_WOUT + 32 * MiB;
constexpr size_t WS_ACT = WS_HB + 128 * MiB;
constexpr size_t WS_P1 = WS_ACT + 352 * MiB;
constexpr size_t WS_G = WS_P1 + 384 * MiB;
constexpr size_t WS_HRAW = WS_G + 2 * MiB;
constexpr size_t WS_HM = WS_HRAW + 256 * MiB;
constexpr size_t WS_CF = WS_HM + 128 * MiB;
constexpr size_t WS_END = WS_CF + 2 * MiB;
static_assert((size_t)8 * NUP * DM * 2 == 352 * MiB && (size_t)8 * DM * DFF * 2 == 176 * MiB && (size_t)4 * NINP * DM * 2 == 100 * MiB, "weight regions");
static_assert((size_t)MTOK * DFF * 2 == 352 * MiB && (size_t)MTOK * NQKV * 2 == 384 * MiB && WS_SS + 13 * (size_t)MTOK * 8 <= CTL_ZERO_BYTES, "activation regions");
constexpr int CW_BAR = 4096;

constexpr int LDS_BYTES = 153600, MISC_OFF = 152576;

#define GAS __attribute__((address_space(1)))
#define LAS __attribute__((address_space(3)))
#define DI __device__ __forceinline__
typedef unsigned short bf16;
typedef unsigned v4u __attribute__((ext_vector_type(4)));
typedef unsigned v2u __attribute__((ext_vector_type(2)));
typedef float f32x4 __attribute__((ext_vector_type(4)));
typedef short bf16x8 __attribute__((ext_vector_type(8)));
typedef GAS unsigned gu32;
#define RLX_AGENT __ATOMIC_RELAXED, __HIP_MEMORY_SCOPE_AGENT
#define LDS_WAIT() asm volatile("s_waitcnt lgkmcnt(0)" ::: "memory")
DI unsigned f2bf(float f) { unsigned r; asm("v_cvt_pk_bf16_f32 %0, %1, %1" : "=v"(r) : "v"(f)); return r & 0xffffu; }
DI unsigned pk2(float lo, float hi) { unsigned r; asm("v_cvt_pk_bf16_f32 %0, %1, %2" : "=v"(r) : "v"(lo), "v"(hi)); return r; }
DI float bf2f(unsigned short v) { return __builtin_bit_cast(float, (unsigned)v << 16); }
DI float bflo(unsigned w) { return __builtin_bit_cast(float, w << 16); }
DI float bfhi(unsigned w) { return __builtin_bit_cast(float, w & 0xffff0000u); }
DI float logsig(float x) { return fminf(x, 0.f) - log1pf(expf(-fabsf(x))); }

#define XB_TMO      128
#define XB_XCNT(j)  (256  + 64 * (j))
#define XB_XSUB(j)  (1280 + 64 * (j))
#define XB_XGEN(j)  (2304 + 64 * (j))
#define XB_TOP      3328
#define XB_TOPGEN   3392
#define XCD_BAR_WORDS 3456
#define XB_SPIN_CAP (1u << 18)

__device__ __forceinline__ unsigned xb_ld(unsigned* p)              { return __hip_atomic_load(p, __ATOMIC_RELAXED, __HIP_MEMORY_SCOPE_AGENT); }
__device__ __forceinline__ unsigned xb_add(unsigned* p, unsigned v) { return __hip_atomic_fetch_add(p, v, __ATOMIC_RELAXED, __HIP_MEMORY_SCOPE_AGENT); }
__device__ __forceinline__ unsigned xb_xcc_id() { return (unsigned)__builtin_amdgcn_s_getreg((3 << 11) | 20) & 0xFu; }
#define XB_SPIN(cond, bar) do { unsigned _sp = 0; while (cond) { __builtin_amdgcn_s_sleep(1); \
    if ((++_sp & 255u) == 0u) { if (xb_ld(&(bar)[XB_TMO])) break; if (_sp > XB_SPIN_CAP) { atomicAdd(&(bar)[XB_TMO], 1u); break; } } } } while (0)

struct XcdBarrier {
    unsigned* bar; unsigned x;
    volatile LAS unsigned* st;
};

__device__ __forceinline__ XcdBarrier xcd_barrier_post(unsigned* bar, volatile LAS unsigned* st) {
    XcdBarrier b; b.bar = bar; b.x = xb_xcc_id(); b.st = st;
    if (threadIdx.x == 0) (void)xb_add(&bar[XB_XCNT(b.x)], 1u);
    return b;
}
__device__ __forceinline__ void xcd_barrier_complete(unsigned* bar, unsigned x, unsigned& nloc, unsigned& nx) {
    const unsigned G = gridDim.x * gridDim.y * gridDim.z;
    unsigned sum, cnt, mine, sp = 0u;
    for (;;) {
        sum = 0u; cnt = 0u; mine = 0u;
#pragma unroll
        for (unsigned j = 0; j < 16; ++j) { const unsigned c = xb_ld(&bar[XB_XCNT(j)]); sum += c; cnt += (c > 0u) ? 1u : 0u; mine = (j == x) ? c : mine; }
        if (sum == G) break;
        __builtin_amdgcn_s_sleep(1);
        if ((++sp & 255u) == 0u) { if (xb_ld(&bar[XB_TMO])) break; if (sp > XB_SPIN_CAP) { atomicAdd(&bar[XB_TMO], 1u); break; } }
    }
    nloc = mine > 0u ? mine : 1u; nx = cnt > 0u ? cnt : 1u;
}

__device__ __forceinline__ void xcd_barrier(const XcdBarrier& b) {
    asm volatile("s_waitcnt vmcnt(0)" ::: "memory");
    __syncthreads();
    if (threadIdx.x == 0) {
        unsigned* bar = b.bar;
        __builtin_amdgcn_s_waitcnt(0);
        unsigned nloc = b.st[0], nx = b.st[1];
        if (nloc == 0u) { xcd_barrier_complete(bar, b.x, nloc, nx); b.st[0] = nloc; b.st[1] = nx; }
        const unsigned old = xb_add(&bar[XB_XSUB(b.x)], 1u);
        const unsigned gen = old / nloc;
        if (old + 1u == (gen + 1u) * nloc) {
            __builtin_amdgcn_fence(__ATOMIC_RELEASE, "agent");
            asm volatile("s_waitcnt vmcnt(0)" ::: "memory");
            const unsigned og = xb_add(&bar[XB_TOP], 1u);
            const unsigned tg = og / nx;
            if (og + 1u == (tg + 1u) * nx) xb_add(&bar[XB_TOPGEN], 1u);
            else XB_SPIN(xb_ld(&bar[XB_TOPGEN]) == tg, bar);
            __builtin_amdgcn_fence(__ATOMIC_ACQUIRE, "agent");
            xb_add(&bar[XB_XGEN(b.x)], 1u);
            asm volatile("s_waitcnt vmcnt(0)" ::: "memory");
        } else {
            XB_SPIN(xb_ld(&bar[XB_XGEN(b.x)]) == gen, bar);
            __builtin_amdgcn_fence(__ATOMIC_ACQUIRE, "agent");
            asm volatile("s_waitcnt vmcnt(0)" ::: "memory");
        }
    }
    __syncthreads();
}


DI float wave_sum(float v) {
#pragma unroll
    for (int o = 1; o < 64; o <<= 1) v += __shfl_xor(v, o);
    return v;
}
DI float wave_max(float v) {
#pragma unroll
    for (int o = 1; o < 64; o <<= 1) v = fmaxf(v, __shfl_xor(v, o));
    return v;
}
DI float wave_incl_sum(float v, int lane) {
#pragma unroll
    for (int o = 1; o < 64; o <<= 1) { const float t = __shfl_up(v, o); if (lane >= o) v += t; }
    return v;
}
DI float wave_incl_max(float v, int lane) {
#pragma unroll
    for (int o = 1; o < 64; o <<= 1) { const float t = __shfl_up(v, o); if (lane >= o) v = fmaxf(v, t); }
    return v;
}

template <int L> DI int swx(int r) { return L == 64 ? ((r >> 1) & 7) : (r & 15); }
template <int L> DI int eoff(int r, int c) { return r * L + ((((c >> 3) ^ swx<L>(r)) << 3) | (c & 7)); }
template <int L> DI bf16x8 ldf(const LAS bf16* base, int r, int ch) { return *(const LAS bf16x8*)(base + r * L + ((ch ^ swx<L>(r)) << 3)); }
DI f32x4 mfma16(bf16x8 a, bf16x8 b, f32x4 c) { return __builtin_amdgcn_mfma_f32_16x16x32_bf16(a, b, c, 0, 0, 0); }
typedef short v4i16_t __attribute__((ext_vector_type(4)));
DI v4i16_t tr_read(const LAS unsigned char* p) { return __builtin_amdgcn_ds_read_tr16_b64_v4i16((LAS v4i16_t*)p); }
DI bf16x8 cat4(v4i16_t lo, v4i16_t hi) { bf16x8 r; r[0] = lo[0]; r[1] = lo[1]; r[2] = lo[2]; r[3] = lo[3]; r[4] = hi[0]; r[5] = hi[1]; r[6] = hi[2]; r[7] = hi[3]; return r; }
DI unsigned off_v64(unsigned row, unsigned ch) { return 128u * row + 16u * (ch ^ ((((row >> 1) & 1u) << 1) | (((row >> 3) & 1u) << 2))); }
DI bf16x8 vfrag64(const LAS unsigned char* vb, int c, int ks, int lane) { const unsigned g = lane >> 4, q = (lane & 15) >> 2, p = lane & 3;
    return cat4(tr_read(vb + off_v64(32 * ks + 8 * g + q, 2 * c + (p >> 1)) + 8 * (p & 1)), tr_read(vb + off_v64(32 * ks + 8 * g + 4 + q, 2 * c + (p >> 1)) + 8 * (p & 1))); }
template <int LA, int LB, int NK> DI void mma_tile(f32x4& acc, const LAS bf16* A, int ra0, const LAS bf16* B, int rb0, int lane) {
    const int r = lane & 15, g = lane >> 4;
#pragma unroll
    for (int kk = 0; kk < NK; ++kk) { const bf16x8 a = ldf<LA>(A, ra0 + r, 4 * kk + g), b = ldf<LB>(B, rb0 + r, 4 * kk + g); acc = mfma16(a, b, acc); }
}

struct ConvItem { const float* W; const float* gk; bf16* WT; int K, N, mode, r; };
DI void conv_load(const ConvItem& c, int lane, f32x4 (&v)[8], float (&gv)[8]) {
    const int nkb = c.K / 64, nb = c.r / nkb, kb = c.r - nb * nkb, k0 = 64 * kb, n0 = 32 * nb;
    const int n = n0 + 4 * (lane & 7); const bool ok = n < c.N;
#pragma unroll
    for (int i = 0; i < 8; ++i) { const int kk = 8 * i + (lane >> 3); v[i] = ok ? *(const f32x4*)(c.W + (size_t)(k0 + kk) * c.N + n) : (f32x4){0.f, 0.f, 0.f, 0.f}; gv[i] = c.gk ? c.gk[k0 + kk] : 1.0f; }
}
DI void conv_store(const ConvItem& c, int lane, const f32x4 (&v)[8], const float (&gv)[8], LAS float* scr) {
    const int nkb = c.K / 64, nb = c.r / nkb, kb = c.r - nb * nkb, k0 = 64 * kb, n0 = 32 * nb, nq = 4 * (lane & 7);
#pragma unroll
    for (int i = 0; i < 8; ++i) { const int kk = 8 * i + (lane >> 3); LAS float* d = scr + kk * 33 + nq; d[0] = v[i].x * gv[i]; d[1] = v[i].y * gv[i]; d[2] = v[i].z * gv[i]; d[3] = v[i].w * gv[i]; }
    LDS_WAIT(); asm volatile("" ::: "memory");
    int row_off = n0;
    if (c.mode == 1) { const int j = n0 < DFF ? n0 : n0 - DFF; row_off = 256 * (j >> 7) + (j & 127) + (n0 < DFF ? 0 : 128); }
    const int cc = lane & 7;
#pragma unroll
    for (int j = 0; j < 4; ++j) { const int nn = (lane >> 3) + 8 * j; const LAS float* s = scr + (8 * cc) * 33 + nn;
        v4u o; o.x = pk2(s[0 * 33], s[1 * 33]); o.y = pk2(s[2 * 33], s[3 * 33]); o.z = pk2(s[4 * 33], s[5 * 33]); o.w = pk2(s[6 * 33], s[7 * 33]);
        *(v4u*)(c.WT + (size_t)(row_off + nn) * c.K + k0 + 8 * cc) = o; }
    LDS_WAIT(); asm volatile("" ::: "memory");
}

struct Args { const float* in[18]; float* out; unsigned char* ws; int ph_lo, ph_hi; };

typedef const __attribute__((address_space(4))) Args* KArgs;
DI KArgs kargs() { KArgs p = (KArgs)__builtin_amdgcn_kernarg_segment_ptr(); asm volatile("" : "+s"(p)); return p; }
DI void prologue(LAS unsigned char* lds, int lane, int wave, int bx) {
    KArgs AP = kargs();
    LAS float* scr = (LAS float*)(lds + wave * 16384);
    const int gw = bx * NWAVES + wave, NGW = gridDim.x * NWAVES;
    unsigned char* ws = AP->ws;
    constexpr int I_UP = (DM / 64) * (NUP / 32), I_DN = (DFF / 64) * (DM / 32), I_IN = (DM / 64) * (NINP / 32), I_OUT = (DM / 64) * (DM / 32);
    constexpr int NITEMS = 8 * I_UP + 8 * I_DN + 4 * I_IN + 4 * I_OUT;
#define CONV_DECODE(it_, c_) do { int r = (it_); (c_).gk = nullptr; (c_).K = DM; (c_).mode = 0; \
        if (r < 8 * I_UP) { const int mi = r / I_UP; r -= mi * I_UP; (c_).W = AP->in[2] + (size_t)mi * DM * NUP; (c_).gk = AP->in[1] + (size_t)mi * DM; (c_).WT = (bf16*)(ws + WS_WUP) + (size_t)mi * NUP * DM; (c_).N = NUP; (c_).mode = 1; } \
        else if (r < 8 * I_UP + 8 * I_DN) { r -= 8 * I_UP; const int mi = r / I_DN; r -= mi * I_DN; (c_).W = AP->in[3] + (size_t)mi * DFF * DM; (c_).WT = (bf16*)(ws + WS_WDN) + (size_t)mi * DM * DFF; (c_).K = DFF; (c_).N = DM; } \
        else if (r < 8 * I_UP + 8 * I_DN + 4 * I_IN) { r -= 8 * I_UP + 8 * I_DN; const int l = r / I_IN; r -= l * I_IN; const int kind = l % 3, ji = l / 3; \
            (c_).W = AP->in[kind == 0 ? 5 : kind == 1 ? 9 : 12] + (size_t)ji * DM * NIN; (c_).gk = AP->in[4] + (size_t)l * DM; (c_).WT = (bf16*)(ws + WS_WIN) + (size_t)l * NINP * DM; (c_).N = NIN; } \
        else { r -= 8 * I_UP + 8 * I_DN + 4 * I_IN; const int l = r / I_OUT; r -= l * I_OUT; const int kind = l % 3, ji = l / 3; \
            (c_).W = AP->in[kind == 0 ? 8 : kind == 1 ? 11 : 16] + (size_t)ji * DM * DM; (c_).WT = (bf16*)(ws + WS_WOUT) + (size_t)l * DM * DM; (c_).N = DM; } \
        (c_).r = r; } while (0)
    f32x4 va[8]; float ga[8]; ConvItem ca{}, cb{};
    if (gw < NITEMS) { CONV_DECODE(gw, ca); conv_load(ca, lane, va, ga); }
    for (int it = gw; it < NITEMS; it += NGW) {
        f32x4 vb[8]; float gb[8]; const int nx = it + NGW;
        if (nx < NITEMS) { CONV_DECODE(nx, cb); conv_load(cb, lane, vb, gb); }
        conv_store(ca, lane, va, ga, scr);
        ca = cb;
#pragma unroll
        for (int i = 0; i < 8; ++i) { va[i] = vb[i]; ga[i] = gb[i]; }
    }
#undef CONV_DECODE
    const float* x = AP->in[0]; bf16* hb = (bf16*)(ws + WS_HB); long long* ss0 = (long long*)(ws + WS_SS);
    for (int m = gw; m < MTOK; m += NGW) {
        const f32x4* xr = (const f32x4*)(x + (size_t)m * DM) + lane; f32x4 v[8]; float s = 0.f;
#pragma unroll
        for (int j = 0; j < 8; ++j) { v[j] = xr[64 * j]; s += (v[j].x * v[j].x + v[j].y * v[j].y) + (v[j].z * v[j].z + v[j].w * v[j].w); }
        s = wave_sum(s);
        v2u* o8 = (v2u*)(hb + (size_t)m * DM) + lane;
#pragma unroll
        for (int j = 0; j < 8; ++j) { v2u w; w.x = pk2(v[j].x, v[j].y); w.y = pk2(v[j].z, v[j].w); o8[64 * j] = w; }
        if (lane == 0) ss0[m] = __float2ll_rn(s * 1048576.0f);
    }
}

constexpr int IMGM_P = 0, IMGM_KT = 8192, IMGM_VT = IMGM_KT + 16384, IMGM_GS = IMGM_VT + 4 * 8192, IMGM_BYTES = IMGM_GS + 1024;
constexpr int IMGG_Q = 0, IMGG_KT = 32768, IMGG_P = 65536, IMGG_VT = IMGG_P + 8192, IMGG_EB = IMGG_VT + 8 * 8192, IMGG_BYTES = IMGG_EB + 1024;
static_assert((size_t)IMGM_BYTES * 4096 <= 352 * MiB && (size_t)IMGG_BYTES * 2048 <= 352 * MiB, "images overlay the (idle) FFN activation buffer");
DI float logsig_fast(float x) { return fminf(x, 0.f) - __logf(1.0f + __expf(-fabsf(x))); }

DI void mlstm_pre(LAS unsigned char* lds, const bf16* P1, const float* G, const float* b_if, unsigned char* img, int tid, int lane, int wave, int bx) {
    LAS bf16* Qs = (LAS bf16*)lds;
    LAS bf16* Ks = Qs + 64 * 128;
    LAS bf16* KTs = Ks + 64 * 128;
    LAS bf16* Ps = KTs + 128 * 64;
    LAS bf16* VT = Ps + 64 * 64;
    LAS float* fa = (LAS float*)(VT + 256 * 64);
    LAS float *bcum = fa, *ipre = fa + 64, *aloc = fa + 128, *wloc = fa + 192, *scal = fa + 256;
    const float KSCALE = 0.08838834764831845f;
    const int g = lane >> 4, r16 = lane & 15;
    v4u pq[2], pk[2]; float pgi = 0.f, pgf = 0.f;
#define MLP_LOAD(it_) do { const int b_ = (it_) >> 9, c_ = ((it_) >> 3) & 63, h_ = (it_) & 7; const int row0_ = b_ * SEQ + c_ * 64; \
        _Pragma("unroll") for (int p = 0; p < 2; ++p) { const int idx = tid + 512 * p, r = idx >> 4, c8 = idx & 15; const bf16* src = P1 + (size_t)(row0_ + r) * NQKV + h_ * 128 + c8 * 8; pq[p] = *(const v4u*)src; pk[p] = *(const v4u*)(src + 1024); } \
        if (tid < 64) { const float* gp = G + (size_t)(row0_ + tid) * 16; pgi = gp[h_]; pgf = gp[8 + h_]; } } while (0)
    if (bx < 4096) MLP_LOAD(bx);
    for (int item = bx; item < 4096; item += gridDim.x) {
        const int h = item & 7;
        unsigned char* im = img + (size_t)item * IMGM_BYTES;
        __syncthreads();
        if (tid < 64) { ipre[tid] = pgi + b_if[h]; bcum[tid] = logsig(pgf + b_if[8 + h]); }
#pragma unroll
        for (int p = 0; p < 2; ++p) { const int idx = tid + 512 * p, r = idx >> 4, c8 = idx & 15; *(LAS v4u*)(Qs + eoff<128>(r, c8 * 8)) = pq[p]; *(LAS v4u*)(Ks + eoff<128>(r, c8 * 8)) = pk[p]; }
        __syncthreads();
        if (wave == 0) {
            const float bt = wave_incl_sum(bcum[lane], lane), ip = ipre[lane];
            const float al = bt + wave_incl_max(ip - bt, lane);
            const float blast = __shfl(bt, 63);
            const float gg = blast - bt + ip;
            const float gmax = wave_max(gg);
            bcum[lane] = bt; aloc[lane] = al; wloc[lane] = __expf(gg - gmax);
            if (lane == 0) { scal[0] = blast; scal[1] = gmax; }
        }
        if (item + (int)gridDim.x < 4096) MLP_LOAD(item + (int)gridDim.x);
        __syncthreads();
#pragma unroll
        for (int p = 0; p < 2; ++p) { const int idx = tid + 512 * p, s = idx >> 4, c8 = idx & 15; const v4u kv = *(const LAS v4u*)(Ks + eoff<128>(s, c8 * 8)); const float w = wloc[s] * KSCALE;
#pragma unroll
            for (int j = 0; j < 4; ++j) { KTs[eoff<64>(c8 * 8 + 2 * j, s)] = (bf16)f2bf(bflo(kv[j]) * w); KTs[eoff<64>(c8 * 8 + 2 * j + 1, s)] = (bf16)f2bf(bfhi(kv[j]) * w); } }
        { const int tt = wave >> 1;
#pragma unroll
          for (int q2 = 0; q2 < 2; ++q2) { const int st = 2 * (wave & 1) + q2; f32x4 acc = (f32x4){0.f, 0.f, 0.f, 0.f};
            if (st <= tt) mma_tile<128, 128, 4>(acc, Qs, 16 * tt, Ks, 16 * st, lane);
            const int s = 16 * st + r16; const float cs = ipre[s] - bcum[s];
#pragma unroll
            for (int i = 0; i < 4; ++i) { const int t = 16 * tt + 4 * g + i; const float p = (s <= t) ? acc[i] * KSCALE * __expf(bcum[t] + cs - aloc[t]) : 0.f; Ps[eoff<64>(t, s)] = (bf16)f2bf(p); } } }
        __syncthreads();
        *(v4u*)(im + IMGM_P + tid * 16) = *(const LAS v4u*)((LAS unsigned char*)Ps + tid * 16);
#pragma unroll
        for (int p = 0; p < 2; ++p) *(v4u*)(im + IMGM_KT + (tid + 512 * p) * 16) = *(const LAS v4u*)((LAS unsigned char*)KTs + (tid + 512 * p) * 16);
        if (tid < 64) { float* gs = (float*)(im + IMGM_GS); gs[tid] = bcum[tid]; gs[64 + tid] = aloc[tid]; if (tid < 2) gs[128 + tid] = scal[tid]; }
    }
#undef MLP_LOAD
}

DI void mlstm_scan2(LAS unsigned char* lds, const bf16* P1, const unsigned char* img, float* hraw, int tid, int lane, int wave, int bx) {
    constexpr int IB = 8192 + 16384 + 16384 + 10240 + 1024;
    LAS bf16* CT0 = (LAS bf16*)(lds + 2 * IB);
    const int g = lane >> 4, r16 = lane & 15, tt = wave >> 1, eh = wave & 1;
    for (int item0 = bx; item0 < 256; item0 += gridDim.x) {
        const int item = (gridDim.x == 256) ? (item0 & 7) * 32 + (item0 >> 3) : item0;
        const int b = item >> 5, h = (item >> 2) & 7, sl = item & 3;
        f32x4 Cacc[5];
#pragma unroll
        for (int e = 0; e < 5; ++e) Cacc[e] = (f32x4){0.f, 0.f, 0.f, 0.f};
        __syncthreads();
        for (int i = tid; i < 2 * 80 * 128 / 8; i += 512) ((LAS v4u*)CT0)[i] = (v4u){0u, 0u, 0u, 0u};
        float m_prev = 0.f;
        v4u rp, rq[2], rk[2], rv; float rg0 = 0.f, rbl, rgm;
#define MLS_PREFETCH(cc) do { const int item2 = (b * 64 + (cc)) * 8 + h; const unsigned char* im = img + (size_t)item2 * IMGM_BYTES; const int row0_ = b * SEQ + (cc) * 64; \
            rp = *(const v4u*)(im + IMGM_P + tid * 16); rk[0] = *(const v4u*)(im + IMGM_KT + tid * 16); rk[1] = *(const v4u*)(im + IMGM_KT + (tid + 512) * 16); \
            rv = *(const v4u*)(P1 + (size_t)(row0_ + (tid >> 3)) * NQKV + 2048 + h * 256 + sl * 64 + (tid & 7) * 8); \
            _Pragma("unroll") for (int p = 0; p < 2; ++p) { const int idx = tid + 512 * p, r = idx >> 4, c8 = idx & 15; rq[p] = *(const v4u*)(P1 + (size_t)(row0_ + r) * NQKV + h * 128 + c8 * 8); } \
            const float* gs = (const float*)(im + IMGM_GS); if (tid < 128) rg0 = gs[tid]; rbl = gs[128]; rgm = gs[129]; } while (0)
#define MLS_STORE(bi) do { LAS unsigned char* bb = lds + (bi) * IB; \
            *(LAS v4u*)(bb + tid * 16) = rp; *(LAS v4u*)(bb + 8192 + 16384 + tid * 16) = rk[0]; *(LAS v4u*)(bb + 8192 + 16384 + (tid + 512) * 16) = rk[1]; \
            *(LAS v4u*)(bb + 8192 + 16384 + 16384 + off_v64(tid >> 3, tid & 7)) = rv; \
            _Pragma("unroll") for (int p = 0; p < 2; ++p) { const int idx = tid + 512 * p, r = idx >> 4, c8 = idx & 15; *(LAS v4u*)((LAS bf16*)(bb + 8192) + eoff<128>(r, c8 * 8)) = rq[p]; } \
            if (tid < 128) ((LAS float*)(bb + 8192 + 16384 + 16384 + 10240))[tid] = rg0; } while (0)
        MLS_PREFETCH(0); MLS_STORE(0);
        float blast = rbl, gmax = rgm;
        MLS_PREFETCH(1);
        __syncthreads();
        for (int c = 0; c < 64; ++c) {
            const int row0 = b * SEQ + c * 64;
            const LAS unsigned char* bb = lds + (c & 1) * IB;
            const LAS bf16* Ps = (const LAS bf16*)bb; const LAS bf16* Qs = (const LAS bf16*)(bb + 8192); const LAS bf16* KTs = (const LAS bf16*)(bb + 8192 + 16384);
            const LAS bf16* VTs = (const LAS bf16*)(bb + 8192 + 16384 + 16384); const LAS float* gsl = (const LAS float*)(bb + 8192 + 16384 + 16384 + 10240);
            LAS bf16* CTc = CT0 + (c & 1) * 80 * 128; LAS bf16* CTn = CT0 + ((c + 1) & 1) * 80 * 128;
            const f32x4 btv = *(const LAS f32x4*)(gsl + 16 * tt + 4 * g), alv = *(const LAS f32x4*)(gsl + 64 + 16 * tt + 4 * g);
            float al[4], be[4], em[4];
#pragma unroll
            for (int i = 0; i < 4; ++i) { const float mt = fmaxf(btv[i] + m_prev, alv[i]); al[i] = __expf(alv[i] - mt); be[i] = __expf(btv[i] + m_prev - mt); em[i] = __expf(-mt); }
            const float m_new = fmaxf(blast + m_prev, gmax), wcs = __expf(blast + m_prev - m_new), gam = __expf(gmax - m_new);
            m_prev = m_new;
            const LAS unsigned char* vb = (const LAS unsigned char*)VTs;
            bf16x8 onesf;
#pragma unroll
            for (int j = 0; j < 8; ++j) onesf[j] = (r16 == 0) ? (short)0x3f80 : (short)0;
            const bf16x8 pa0 = ldf<64>(Ps, 16 * tt + r16, g), pa1 = ldf<64>(Ps, 16 * tt + r16, 4 + g);
            f32x4 d1 = (f32x4){0.f, 0.f, 0.f, 0.f}, d2 = (f32x4){0.f, 0.f, 0.f, 0.f};
            d1 = mfma16(pa0, onesf, d1); d1 = mfma16(pa1, onesf, d1); mma_tile<128, 128, 4>(d2, Qs, 16 * tt, CTc, 64, lane);
            float dinv[4];
#pragma unroll
            for (int i = 0; i < 4; ++i) { const float den = __shfl(al[i] * d1[i] + be[i] * d2[i], lane & 48); dinv[i] = __builtin_amdgcn_rcpf(fmaxf(fabsf(den), em[i])); }
#pragma unroll
            for (int q2 = 0; q2 < 2; ++q2) { const int et = 2 * eh + q2, e = 16 * et + r16; f32x4 a1 = (f32x4){0.f, 0.f, 0.f, 0.f}, a2 = (f32x4){0.f, 0.f, 0.f, 0.f};
                a1 = mfma16(pa0, vfrag64(vb, et, 0, lane), a1); a1 = mfma16(pa1, vfrag64(vb, et, 1, lane), a1); mma_tile<128, 128, 4>(a2, Qs, 16 * tt, CTc, 16 * et, lane);
#pragma unroll
                for (int i = 0; i < 4; ++i) { const int t = 16 * tt + 4 * g + i; hraw[(size_t)(row0 + t) * DM + h * 256 + sl * 64 + e] = (al[i] * a1[i] + be[i] * a2[i]) * dinv[i]; } }
            const bf16x8 ka0 = ldf<64>(KTs, 16 * wave + r16, g), ka1 = ldf<64>(KTs, 16 * wave + r16, 4 + g);
#pragma unroll
            for (int et = 0; et < 5; ++et) { f32x4 tmp = (f32x4){0.f, 0.f, 0.f, 0.f};
                tmp = mfma16(ka0, et < 4 ? vfrag64(vb, et & 3, 0, lane) : onesf, tmp); tmp = mfma16(ka1, et < 4 ? vfrag64(vb, et & 3, 1, lane) : onesf, tmp);
                Cacc[et] = Cacc[et] * wcs + tmp * gam;
                v2u w; w.x = pk2(Cacc[et][0], Cacc[et][1]); w.y = pk2(Cacc[et][2], Cacc[et][3]);
                *(LAS v2u*)(CTn + eoff<128>(16 * et + r16, 16 * wave + 4 * g)) = w; }
            if (c + 1 < 64) { MLS_STORE((c + 1) & 1); blast = rbl; gmax = rgm; }
            if (c + 2 < 64) MLS_PREFETCH(c + 2);
            __syncthreads();
        }
#undef MLS_PREFETCH
#undef MLS_STORE
    }
}

DI void gla_pre(LAS unsigned char* lds, const bf16* P1, const float* G, const float* w_alpha, const float* b_alpha, unsigned char* img, int tid, int lane, int wave, int bx) {
    LAS bf16* VT = (LAS bf16*)lds;
    LAS bf16* QTs = (LAS bf16*)lds;
    LAS bf16* KTl = QTs + 64 * 256;
    LAS bf16* KTT = KTl + 64 * 256;
    LAS bf16* Ps = KTT + 256 * 64;
    LAS float* alow = (LAS float*)(Ps + 64 * 64);
    LAS float* T0 = alow + 1024;
    const int g = lane >> 4, r16 = lane & 15, d = tid & 255, sh = tid >> 8;
    for (int item = bx; item < 2048; item += gridDim.x) {
        const int b = item >> 8, c = (item >> 2) & 63, h = item & 3;
        const int row0 = b * SEQ + c * 64;
        unsigned char* im = img + (size_t)item * IMGG_BYTES;
        __syncthreads();
        float wa[16];
#pragma unroll
        for (int i = 0; i < 16; ++i) wa[i] = w_alpha[i * 1024 + h * 256 + d];
        const float ba = b_alpha[h * 256 + d];
        f32x4 al4 = (f32x4){0.f, 0.f, 0.f, 0.f};
        if (tid < 256) al4 = *(const f32x4*)(G + (size_t)(row0 + (tid >> 2)) * 16 + (tid & 3) * 4);
        if (tid < 256) *(LAS f32x4*)(alow + tid * 4) = al4;
        __syncthreads();
        const bf16* qsrc = P1 + (size_t)(row0 + 32 * sh) * NQKV + h * 256 + d;
        float bs[32]; float run = 0.f;
#pragma unroll
        for (int j = 0; j < 32; ++j) { const int s = 32 * sh + j; float z = ba;
#pragma unroll
            for (int i = 0; i < 16; ++i) z += alow[s * 16 + i] * wa[i];
            run += logsig_fast(z) * (1.0f / 16.0f); bs[j] = run; }
        if (sh == 0) T0[d] = run;
        __syncthreads();
        const float add = sh ? T0[d] : 0.f;
        if (sh) ((float*)(im + IMGG_EB))[d] = __expf(run + add);
#pragma unroll
        for (int q8 = 0; q8 < 4; ++q8) { unsigned kk[8];
#pragma unroll
            for (int j = 0; j < 8; ++j) { const int jj = 8 * q8 + j, s = 32 * sh + jj; const float bsum = bs[jj] + add;
                const float qv = bf2f(qsrc[(size_t)jj * NQKV]) * 0.0625f * __expf(bsum), kv = bf2f(qsrc[(size_t)jj * NQKV + 1024]) * __expf(-bsum);
                QTs[eoff<256>(s, d)] = (bf16)f2bf(qv); kk[j] = f2bf(kv); KTl[eoff<256>(s, d)] = (bf16)kk[j]; }
            v4u w; w.x = kk[0] | (kk[1] << 16); w.y = kk[2] | (kk[3] << 16); w.z = kk[4] | (kk[5] << 16); w.w = kk[6] | (kk[7] << 16);
            *(LAS v4u*)(KTT + eoff<64>(d, 32 * sh + 8 * q8)) = w; }
        __syncthreads();
        { const int tt = wave >> 1;
#pragma unroll
          for (int q2 = 0; q2 < 2; ++q2) { const int st = 2 * (wave & 1) + q2; f32x4 acc = (f32x4){0.f, 0.f, 0.f, 0.f};
            if (st <= tt) mma_tile<256, 256, 8>(acc, QTs, 16 * tt, KTl, 16 * st, lane);
            const int s = 16 * st + r16;
#pragma unroll
            for (int i = 0; i < 4; ++i) { const int t = 16 * tt + 4 * g + i; Ps[eoff<64>(t, s)] = (bf16)f2bf((s <= t) ? acc[i] : 0.f); } } }
        __syncthreads();
#pragma unroll
        for (int p = 0; p < 4; ++p) { *(v4u*)(im + IMGG_Q + (tid + 512 * p) * 16) = *(const LAS v4u*)((LAS unsigned char*)QTs + (tid + 512 * p) * 16);
                                      *(v4u*)(im + IMGG_KT + (tid + 512 * p) * 16) = *(const LAS v4u*)((LAS unsigned char*)KTT + (tid + 512 * p) * 16); }
        *(v4u*)(im + IMGG_P + tid * 16) = *(const LAS v4u*)((LAS unsigned char*)Ps + tid * 16);
    }
}

DI void gla_scan2(LAS unsigned char* lds, const bf16* P1, const unsigned char* img, float* hraw, int tid, int lane, int wave, int bx) {
    LAS bf16* QTs = (LAS bf16*)lds;
    LAS bf16* KTT = QTs + 64 * 256;
    LAS bf16* Ps = KTT + 256 * 64;
    LAS bf16* VTs = Ps + 64 * 64;
    LAS float* eb = (LAS float*)(VTs + 64 * 64);
    LAS bf16* ST0 = (LAS bf16*)(eb + 256);
    const int g = lane >> 4, r16 = lane & 15, tt = wave >> 1, eh = wave & 1;
    for (int item0 = bx; item0 < 256; item0 += gridDim.x) {
        const int item = (gridDim.x == 256) ? (item0 & 7) * 32 + (item0 >> 3) : item0;
        const int b = item >> 5, h = (item >> 3) & 3, sl = item & 7;
        f32x4 Sacc[2][4];
#pragma unroll
        for (int a = 0; a < 2; ++a)
#pragma unroll
            for (int e = 0; e < 4; ++e) Sacc[a][e] = (f32x4){0.f, 0.f, 0.f, 0.f};
        __syncthreads();
        for (int i = tid; i < 2 * 64 * 256 / 8; i += 512) ((LAS v4u*)ST0)[i] = (v4u){0u, 0u, 0u, 0u};
        v4u rq[4], rk[4], rp, rv; float re = 0.f;
#define GLS_PREFETCH(cc) do { const int item2 = (b * 64 + (cc)) * 4 + h; const unsigned char* im = img + (size_t)item2 * IMGG_BYTES; \
            _Pragma("unroll") for (int p = 0; p < 4; ++p) { rq[p] = *(const v4u*)(im + IMGG_Q + (tid + 512 * p) * 16); rk[p] = *(const v4u*)(im + IMGG_KT + (tid + 512 * p) * 16); } \
            rp = *(const v4u*)(im + IMGG_P + tid * 16); rv = *(const v4u*)(P1 + ((size_t)b * SEQ + (cc) * 64 + (tid >> 3)) * NQKV + 2048 + h * 512 + sl * 64 + (tid & 7) * 8); if (tid < 256) re = ((const float*)(im + IMGG_EB))[tid]; } while (0)
        GLS_PREFETCH(0);
        for (int c = 0; c < 64; ++c) {
            const int row0 = b * SEQ + c * 64;
            LAS bf16* STc = ST0 + (c & 1) * 64 * 256; LAS bf16* STn = ST0 + ((c + 1) & 1) * 64 * 256;
            __syncthreads();
#pragma unroll
            for (int p = 0; p < 4; ++p) { *(LAS v4u*)((LAS unsigned char*)QTs + (tid + 512 * p) * 16) = rq[p]; *(LAS v4u*)((LAS unsigned char*)KTT + (tid + 512 * p) * 16) = rk[p]; }
            *(LAS v4u*)((LAS unsigned char*)Ps + tid * 16) = rp; *(LAS v4u*)((LAS unsigned char*)VTs + off_v64(tid >> 3, tid & 7)) = rv;
            if (tid < 256) eb[tid] = re;
            __syncthreads();
            if (c + 1 < 64) GLS_PREFETCH(c + 1);
            const LAS unsigned char* vb = (const LAS unsigned char*)VTs;
            const bf16x8 pa0 = ldf<64>(Ps, 16 * tt + r16, g), pa1 = ldf<64>(Ps, 16 * tt + r16, 4 + g);
#pragma unroll
            for (int q2 = 0; q2 < 2; ++q2) { const int et = 2 * eh + q2, e = 16 * et + r16; f32x4 acc = (f32x4){0.f, 0.f, 0.f, 0.f};
                acc = mfma16(pa0, vfrag64(vb, et, 0, lane), acc); acc = mfma16(pa1, vfrag64(vb, et, 1, lane), acc); mma_tile<256, 256, 8>(acc, QTs, 16 * tt, STc, 16 * et, lane);
#pragma unroll
                for (int i = 0; i < 4; ++i) { const int t = 16 * tt + 4 * g + i; hraw[(size_t)(row0 + t) * DM + h * 512 + sl * 64 + e] = acc[i]; } }
#pragma unroll
            for (int a = 0; a < 2; ++a) { const int dt = 2 * wave + a;
                const f32x4 ev = *(const LAS f32x4*)(eb + 16 * dt + 4 * g);
                const bf16x8 ka0 = ldf<64>(KTT, 16 * dt + r16, g), ka1 = ldf<64>(KTT, 16 * dt + r16, 4 + g);
#pragma unroll
                for (int et = 0; et < 4; ++et) { Sacc[a][et] = mfma16(ka0, vfrag64(vb, et, 0, lane), Sacc[a][et]); Sacc[a][et] = mfma16(ka1, vfrag64(vb, et, 1, lane), Sacc[a][et]); Sacc[a][et] = Sacc[a][et] * ev;
                    v2u w; w.x = pk2(Sacc[a][et][0], Sacc[a][et][1]); w.y = pk2(Sacc[a][et][2], Sacc[a][et][3]);
                    *(LAS v2u*)(STn + eoff<256>(16 * et + r16, 16 * dt + 4 * g)) = w; } }
        }
#undef GLS_PREFETCH
    }
}


DI void mixer_gates(const bf16* hb, const bf16* wg, const long long* ss, float* G, int lane, int wave, int bx) {
    const int g = lane >> 4, r16 = lane & 15;
    for (int t = bx * NWAVES + wave; t < MTOK / 16; t += gridDim.x * NWAVES) {
        const bf16* ap = hb + (size_t)(16 * t + r16) * DM + 8 * g; const bf16* bp = wg + (size_t)r16 * DM + 8 * g;
        f32x4 acc = (f32x4){0.f, 0.f, 0.f, 0.f};
#pragma unroll 8
        for (int kk = 0; kk < DM / 32; ++kk) { const bf16x8 a = *(const bf16x8*)(ap + 32 * kk), b = *(const bf16x8*)(bp + 32 * kk); acc = mfma16(a, b, acc); }
#pragma unroll
        for (int i = 0; i < 4; ++i) { const int row = 16 * t + 4 * g + i; G[(size_t)row * 16 + r16] = acc[i] * pg8::rstd_of(ss, row); }
    }
}

template <int HS, int ACT> DI void headnorm_gate(const float* hraw, const bf16* P1, const float* gnorm, bf16* hm, int lane, int wave, int bx) {
    constexpr int NH = DM / HS, EPL = HS / 64;
    const int gw = bx * NWAVES + wave, NGW = gridDim.x * NWAVES;
    for (int row = gw; row < MTOK; row += NGW) {
#pragma unroll
        for (int hh = 0; hh < NH; ++hh) { const int col = hh * HS + lane * EPL;
            float x[EPL]; float s = 0.f;
#pragma unroll
            for (int j = 0; j < EPL; j += 4) { const f32x4 v = *(const f32x4*)(hraw + (size_t)row * DM + col + j); x[j] = v.x; x[j + 1] = v.y; x[j + 2] = v.z; x[j + 3] = v.w; s += (v.x * v.x + v.y * v.y) + (v.z * v.z + v.w * v.w); }
            s = wave_sum(s); const float rs = rsqrtf(s * (1.0f / HS) + 1e-6f);
            unsigned outw[EPL / 2];
#pragma unroll
            for (int j = 0; j < EPL; j += 2) { const unsigned gw2 = *(const unsigned*)(P1 + (size_t)row * NQKV + 4096 + col + j); const float g0 = bflo(gw2), g1 = bfhi(gw2);
                const float a0 = ACT == 0 ? 1.0f / (1.0f + expf(-g0)) : g0 / (1.0f + expf(-g0)), a1 = ACT == 0 ? 1.0f / (1.0f + expf(-g1)) : g1 / (1.0f + expf(-g1));
                outw[j / 2] = pk2(x[j] * rs * gnorm[col + j] * a0, x[j + 1] * rs * gnorm[col + j + 1] * a1); }
            if constexpr (EPL == 4) { v2u w; w.x = outw[0]; w.y = outw[1]; *(v2u*)(hm + (size_t)row * DM + col) = w; }
            else { v4u w; w.x = outw[0]; w.y = outw[1]; w.z = outw[2]; w.w = outw[3]; *(v4u*)(hm + (size_t)row * DM + col) = w; }
        }
    }
}

DI void fox_cf(LAS unsigned char* lds, const float* G, const float* b_f, float* cf, int tid, int lane, int wave, int bx) {
    LAS float* wt = (LAS float*)lds;
    for (int item = bx; item < 256; item += gridDim.x) { const int seq = item >> 1, hf = item & 1, b = seq >> 4, h = seq & 15; const float bias = b_f[h];
        const float* gp = G + ((size_t)b * SEQ + hf * 2048 + tid * 4) * 16 + h;
        float ls[4]; float s = 0.f, s0 = 0.f;
#pragma unroll
        for (int p = 0; p < 4; ++p) { ls[p] = logsig(gp[p * 16] + bias); s += ls[p]; }
        if (hf) { const float* g0 = gp - (size_t)2048 * 16;
#pragma unroll
            for (int p = 0; p < 4; ++p) s0 += logsig(g0[p * 16] + bias); }
        const float incl = wave_incl_sum(s, lane), tot0 = wave_sum(s0);
        __syncthreads();
        if (lane == 63) wt[wave] = incl; if (lane == 0) wt[8 + wave] = tot0;
        __syncthreads();
        float base = 0.f;
#pragma unroll
        for (int w = 0; w < 8; ++w) { base += (w < wave) ? wt[w] : 0.f; base += wt[8 + w]; }
        float run = base + incl - s;
        float* o = cf + (size_t)seq * SEQ + hf * 2048 + tid * 4; f32x4 ov;
        run += ls[0]; ov.x = run; run += ls[1]; ov.y = run; run += ls[2]; ov.z = run; run += ls[3]; ov.w = run;
        *(f32x4*)o = ov;
    }
}

DI unsigned off_v(unsigned row, unsigned ch) { return 256u * row + 16u * (ch ^ (((row & 3u) << 2) | (((row >> 2) & 1u) << 1))); }

DI void fox_attn2(LAS unsigned char* lds, const bf16* P1, const float* cf, bf16* hm, int tid, int lane, int wave, int bx) {
    constexpr int BUFB = 16384 + 16384 + 256;
    const float LOG2E = 1.4426950408889634f, QS = 0.08838834764831845f * 1.4426950408889634f, THR = 8.0f;
    const int g = lane >> 4, r16 = lane & 15;
    const int G_ = gridDim.x;
    const int nit = (2048 + G_ - 1) / G_;
    for (int it = 0; it < nit; ++it) {
        const int u = (it & 1) ? it * G_ + (G_ - 1 - bx) : it * G_ + bx;
        if (u >= 2048) continue;
        const int qb = 15 - (u >> 7), bh = u & 127, b = bh >> 4, h = bh & 15;
        const size_t rowb = (size_t)b * SEQ; const int q0 = qb * 256 + 32 * wave;
        bf16x8 qf[2][4]; float c0[2];
#pragma unroll
        for (int tt = 0; tt < 2; ++tt) { const int t = q0 + 16 * tt + r16; c0[tt] = cf[(size_t)bh * SEQ + t] * LOG2E;
#pragma unroll
            for (int kk = 0; kk < 4; ++kk) { const v4u raw = *(const v4u*)(P1 + (rowb + t) * NQKV + h * 128 + 32 * kk + 8 * g); v4u sc;
#pragma unroll
                for (int j = 0; j < 4; ++j) sc[j] = pk2(bflo(raw[j]) * QS, bfhi(raw[j]) * QS);
                qf[tt][kk] = __builtin_bit_cast(bf16x8, sc); } }
        f32x4 oacc[8][2];
#pragma unroll
        for (int et = 0; et < 8; ++et) { oacc[et][0] = (f32x4){0.f, 0.f, 0.f, 0.f}; oacc[et][1] = (f32x4){0.f, 0.f, 0.f, 0.f}; }
        float lrun[2] = {0.f, 0.f};
        const int ntiles = 4 * (qb + 1);
        v4u kreg[2], vreg[2]; float cfreg = 0.f;
        const bf16* kbase = P1 + rowb * NQKV + 2048 + h * 128;
#define FOX_LOAD(j) do { _Pragma("unroll") for (int p = 0; p < 2; ++p) { const int idx = tid + 512 * p, r = idx >> 4, c8 = idx & 15; \
            kreg[p] = *(const v4u*)(kbase + (size_t)(64 * (j) + r) * NQKV + c8 * 8); vreg[p] = *(const v4u*)(kbase + (size_t)(64 * (j) + r) * NQKV + 2048 + c8 * 8); } \
            if (tid < 64) cfreg = -cf[(size_t)bh * SEQ + 64 * (j) + tid] * LOG2E; } while (0)
#define FOX_STORE(bufi) do { LAS unsigned char* bb = lds + (bufi) * BUFB; _Pragma("unroll") for (int p = 0; p < 2; ++p) { const int idx = tid + 512 * p, r = idx >> 4, c8 = idx & 15; \
            *(LAS v4u*)((LAS bf16*)bb + eoff<128>(r, c8 * 8)) = kreg[p]; *(LAS v4u*)(bb + 16384 + off_v(r, c8)) = vreg[p]; } \
            if (tid < 64) ((LAS float*)(bb + 32768))[tid] = cfreg; } while (0)
        __syncthreads();
        FOX_LOAD(0); FOX_STORE(0);
        if (ntiles > 1) FOX_LOAD(1);
        __syncthreads();
        for (int j = 0; j < ntiles; ++j) {
            if (j + 1 < ntiles) FOX_STORE((j + 1) & 1);
            if (j + 2 < ntiles) FOX_LOAD(j + 2);
            if (64 * j <= q0 + 31) {
                const LAS bf16* Ks = (const LAS bf16*)(lds + (j & 1) * BUFB); const LAS bf16* VTs = Ks + 64 * 128; const LAS float* cfs = (const LAS float*)(VTs + 128 * 64);
                f32x4 sacc[2][4];
#pragma unroll
                for (int st = 0; st < 4; ++st) { const f32x4 cv = *(const LAS f32x4*)(cfs + 16 * st + 4 * g);
#pragma unroll
                    for (int tt = 0; tt < 2; ++tt) sacc[tt][st] = cv + c0[tt]; }
#pragma unroll
                for (int st = 0; st < 4; ++st)
#pragma unroll
                    for (int kk = 0; kk < 4; ++kk) { const bf16x8 kf = ldf<128>(Ks, 16 * st + r16, 4 * kk + g);
                        sacc[0][st] = mfma16(kf, qf[0][kk], sacc[0][st]); sacc[1][st] = mfma16(kf, qf[1][kk], sacc[1][st]); if (kk == 3) asm volatile("" ::: "memory"); }
                if (64 * j + 63 > q0) {
#pragma unroll
                    for (int tt = 0; tt < 2; ++tt) { const int t = q0 + 16 * tt + r16;
#pragma unroll
                        for (int st = 0; st < 4; ++st)
#pragma unroll
                            for (int i = 0; i < 4; ++i) { const int s = 64 * j + 16 * st + 4 * g + i; if (s > t) sacc[tt][st][i] = -__builtin_inff(); } }
                }
                float mx[2];
#pragma unroll
                for (int tt = 0; tt < 2; ++tt) { float m = -__builtin_inff();
#pragma unroll
                    for (int st = 0; st < 4; ++st) m = fmaxf(m, fmaxf(fmaxf(sacc[tt][st][0], sacc[tt][st][1]), fmaxf(sacc[tt][st][2], sacc[tt][st][3])));
                    m = fmaxf(m, __shfl_xor(m, 16)); m = fmaxf(m, __shfl_xor(m, 32)); mx[tt] = m; }
                if (__any(mx[0] > THR || mx[1] > THR)) {
#pragma unroll
                    for (int tt = 0; tt < 2; ++tt) { const float sh = fmaxf(mx[tt], 0.f), f = __builtin_amdgcn_exp2f(-sh);
                        c0[tt] -= sh; lrun[tt] *= f;
#pragma unroll
                        for (int st = 0; st < 4; ++st) sacc[tt][st] = sacc[tt][st] - sh;
#pragma unroll
                        for (int et = 0; et < 8; ++et) oacc[et][tt] = oacc[et][tt] * f; }
                }
#pragma unroll
                for (int tt = 0; tt < 2; ++tt) { float ls = 0.f;
#pragma unroll
                    for (int st = 0; st < 4; ++st)
#pragma unroll
                        for (int i = 0; i < 4; ++i) { const float p = __builtin_amdgcn_exp2f(sacc[tt][st][i]); sacc[tt][st][i] = p; ls += p; }
                    lrun[tt] += ls; }
#pragma unroll
                for (int ks = 0; ks < 2; ++ks) { bf16x8 pb[2];
#pragma unroll
                    for (int tt = 0; tt < 2; ++tt) { v4u w; w.x = pk2(sacc[tt][2 * ks][0], sacc[tt][2 * ks][1]); w.y = pk2(sacc[tt][2 * ks][2], sacc[tt][2 * ks][3]);
                        w.z = pk2(sacc[tt][2 * ks + 1][0], sacc[tt][2 * ks + 1][1]); w.w = pk2(sacc[tt][2 * ks + 1][2], sacc[tt][2 * ks + 1][3]); pb[tt] = __builtin_bit_cast(bf16x8, w); }
#pragma unroll
                    for (int et = 0; et < 8; ++et) {
                        const LAS unsigned char* vb = (const LAS unsigned char*)VTs;
                        const v4i16_t lo = tr_read(vb + off_v(32 * ks + 4 * g + (r16 >> 2), 2 * et + ((lane & 3) >> 1)) + 8 * (lane & 1));
                        const v4i16_t hi = tr_read(vb + off_v(32 * ks + 16 + 4 * g + (r16 >> 2), 2 * et + ((lane & 3) >> 1)) + 8 * (lane & 1));
                        bf16x8 va; va[0] = lo[0]; va[1] = lo[1]; va[2] = lo[2]; va[3] = lo[3]; va[4] = hi[0]; va[5] = hi[1]; va[6] = hi[2]; va[7] = hi[3];
                        oacc[et][0] = mfma16(va, pb[0], oacc[et][0]); oacc[et][1] = mfma16(va, pb[1], oacc[et][1]); if (et & 1) asm volatile("" ::: "memory"); } }
            }
            __syncthreads();
        }
#undef FOX_LOAD
#undef FOX_STORE
#pragma unroll
        for (int tt = 0; tt < 2; ++tt) { float l = lrun[tt]; l += __shfl_xor(l, 16); l += __shfl_xor(l, 32); const float inv = 1.0f / l;
            bf16* orow = hm + (rowb + q0 + 16 * tt + r16) * DM + h * 128 + 4 * g;
#pragma unroll
            for (int et = 0; et < 8; ++et) { v2u w; w.x = pk2(oacc[et][tt][0] * inv, oacc[et][tt][1] * inv); w.y = pk2(oacc[et][tt][2] * inv, oacc[et][tt][3] * inv); *(v2u*)(orow + 16 * et) = w; } }
    }
}


DI void final_norm(float* out, const long long* ss, const float* gfin, int lane, int wave, int bx) {
    const int gw = bx * NWAVES + wave, NGW = gridDim.x * NWAVES;
    for (int m = gw; m < MTOK; m += NGW) { const float rs = pg8::rstd_of(ss, m);
        f32x4* xr = (f32x4*)(out + (size_t)m * DM) + lane; const f32x4* gr = (const f32x4*)gfin + lane;
#pragma unroll
        for (int j = 0; j < 8; ++j) { const f32x4 v = xr[64 * j], gg = gr[64 * j]; xr[64 * j] = v * rs * gg; } }
}

#define PH(p) if (lo <= (p) && (p) < hi && (ran ? (xcd_barrier(bar), true) : (ran = true)))
#define TID() int tid = threadIdx.x; asm volatile("" : "+v"(tid)); const int lane = tid & 63, wave = __builtin_amdgcn_readfirstlane(tid >> 6); int bx = blockIdx.x; asm volatile("" : "+s"(bx)); (void)lane; (void)wave; (void)bx
#define WSP(T, off) ((T*)(ka->ws + (off)))
template <int j> DI void subblock(LAS unsigned char* lds, const XcdBarrier& bar, const int lo, const int hi, bool& ran) {
    {
        constexpr int layer = j / 3, typ = j - 3 * layer, base = 1 + 5 * j;
        if constexpr (typ != 1) {
            PH(base) { TID(); KArgs ka = kargs(); const int mi = layer * 2 + (typ >> 1);
                pg8::Gemm gm{WSP(bf16, WS_HB), WSP(bf16, WS_WUP) + (size_t)mi * NUP * DM, MTOK, NUP, DM}; pg8::StaticOrder S; S.init(MTOK, NUP, gridDim.x, bx);
                pg8::EpiSwiGLU E{WSP(bf16, WS_ACT), WSP(long long, WS_SS) + (size_t)j * MTOK, DFF};
                pg8::gemm_phase<pg8::EpiSwiGLU, pg8::StaticOrder, PG8_ALIGN, PG8_SP2>(lds, gm, S, E); }
        } else {
            constexpr int kind = layer % 3, ji = layer / 3;
            PH(base) { TID(); KArgs ka = kargs();
                mixer_gates(WSP(bf16, WS_HB), WSP(bf16, WS_WIN) + ((size_t)layer * NINP + NQKV) * DM, WSP(long long, WS_SS) + (size_t)j * MTOK, WSP(float, WS_G), lane, wave, bx);
                pg8::Gemm gm{WSP(bf16, WS_HB), WSP(bf16, WS_WIN) + (size_t)layer * NINP * DM, MTOK, NQKV, DM}; pg8::StaticOrder S; S.init(MTOK, NQKV, gridDim.x, bx);
                pg8::EpiMixIn E{WSP(bf16, WS_P1), WSP(long long, WS_SS) + (size_t)j * MTOK};
                pg8::gemm_phase<pg8::EpiMixIn, pg8::StaticOrder, PG8_ALIGN, PG8_SP2>(lds, gm, S, E); }
            PH(base + 1) { TID(); KArgs ka = kargs();
                if constexpr (kind == 0) for (int rep = 0; rep < REP_MLSTM; ++rep) mlstm_pre(lds, WSP(bf16, WS_P1), WSP(float, WS_G), ka->in[6] + ji * 16, WSP(unsigned char, WS_ACT), tid, lane, wave, bx);
                else if constexpr (kind == 1) { fox_cf(lds, WSP(float, WS_G), ka->in[10] + ji * 16, WSP(float, WS_CF), tid, lane, wave, bx); }
                else for (int rep = 0; rep < REP_GLA; ++rep) gla_pre(lds, WSP(bf16, WS_P1), WSP(float, WS_G), ka->in[13] + (size_t)ji * 16 * 1024, ka->in[14] + ji * 1024, WSP(unsigned char, WS_ACT), tid, lane, wave, bx);
            }
            PH(base + 2) { TID(); KArgs ka = kargs();
                if constexpr (kind == 0) for (int rep = 0; rep < REP_MLSTM; ++rep) mlstm_scan2(lds, WSP(bf16, WS_P1), WSP(unsigned char, WS_ACT), WSP(float, WS_HRAW), tid, lane, wave, bx);
                else if constexpr (kind == 1) for (int rep = 0; rep < REP_FOX; ++rep) fox_attn2(lds, WSP(bf16, WS_P1), WSP(float, WS_CF), WSP(bf16, WS_HM), tid, lane, wave, bx);
                else for (int rep = 0; rep < REP_GLA; ++rep) gla_scan2(lds, WSP(bf16, WS_P1), WSP(unsigned char, WS_ACT), WSP(float, WS_HRAW), tid, lane, wave, bx);
            }
            if constexpr (kind != 1) { PH(base + 3) { TID(); KArgs ka = kargs();
                if constexpr (kind == 0) headnorm_gate<256, 0>(WSP(float, WS_HRAW), WSP(bf16, WS_P1), ka->in[7] + ji * DM, WSP(bf16, WS_HM), lane, wave, bx);
                else headnorm_gate<512, 1>(WSP(float, WS_HRAW), WSP(bf16, WS_P1), ka->in[15] + ji * DM, WSP(bf16, WS_HM), lane, wave, bx);
            } }
        }
        PH(base + 4) { TID(); KArgs ka = kargs();
            pg8::Gemm gm; float scale;
            if constexpr (typ != 1) { const int mi = layer * 2 + (typ >> 1); gm = pg8::Gemm{WSP(bf16, WS_ACT), WSP(bf16, WS_WDN) + (size_t)mi * DM * DFF, MTOK, DM, DFF}; scale = 0.5f; }
            else { gm = pg8::Gemm{WSP(bf16, WS_HM), WSP(bf16, WS_WOUT) + (size_t)layer * DM * DM, MTOK, DM, DM}; scale = 1.0f; }
            pg8::StaticOrder S; S.init(MTOK, DM, gridDim.x, bx);
            pg8::EpiResid E{(j == 0) ? ka->in[0] : (const float*)ka->out, ka->out, WSP(bf16, WS_HB), WSP(long long, WS_SS) + (size_t)(j + 1) * MTOK, scale};
            pg8::gemm_phase<pg8::EpiResid, pg8::StaticOrder, PG8_ALIGN, PG8_SP2>(lds, gm, S, E);
        }
    }
}

__global__ void __launch_bounds__(NWAVES * 64, 2) trunk_fwd(Args args) {
    extern __shared__ __attribute__((aligned(16))) unsigned char lds_raw[];
    LAS unsigned char* lds = (LAS unsigned char*)lds_raw;
    volatile LAS unsigned* MISC = (volatile LAS unsigned*)(lds + MISC_OFF);
    for (int u = threadIdx.x; u < (LDS_BYTES - MISC_OFF) / 4; u += NWAVES * 64) ((LAS unsigned*)(lds + MISC_OFF))[u] = 0u;
    __syncthreads();
    XcdBarrier bar = xcd_barrier_post((unsigned*)(args.ws + WS_CTL) + CW_BAR, MISC + 8);
    const int lo = args.ph_lo, hi = args.ph_hi; bool ran = false;

    PH(0) { TID(); for (int rep = 0; rep < REP_PRO; ++rep) { prologue(lds, lane, wave, bx); __syncthreads(); } }

    subblock<0>(lds, bar, lo, hi, ran); subblock<1>(lds, bar, lo, hi, ran); subblock<2>(lds, bar, lo, hi, ran); subblock<3>(lds, bar, lo, hi, ran);
    subblock<4>(lds, bar, lo, hi, ran); subblock<5>(lds, bar, lo, hi, ran); subblock<6>(lds, bar, lo, hi, ran); subblock<7>(lds, bar, lo, hi, ran);
    subblock<8>(lds, bar, lo, hi, ran); subblock<9>(lds, bar, lo, hi, ran); subblock<10>(lds, bar, lo, hi, ran); subblock<11>(lds, bar, lo, hi, ran);
    PH(NPHASE - 1) { TID(); KArgs ka = kargs(); final_norm(ka->out, WSP(long long, WS_SS) + (size_t)NSUB * MTOK, ka->in[17], lane, wave, bx); }
#undef WSP
#undef PH
}

static bool phase_exists(int p) {
    if (p == 0 || p == NPHASE - 1) return true;
    const int j = (p - 1) / 5, k = (p - 1) % 5, typ = j % 3;
    if (k == 0 || k == 4) return true;
    if (typ != 1) return false;
    if (k == 3) return ((j / 3) % 3) != 1;
    return true;
}
extern "C" void kernel_launch(void* const* d_in, const int* in_sizes, int n_in, void* d_out, int out_size, void* d_ws, size_t ws_size, hipStream_t stream) {
    static int grid = 0;
    if (grid == 0) {
        if (n_in != 18 || in_sizes[0] != MTOK * DM || out_size != MTOK * DM || ws_size < WS_END) { fprintf(stderr, "kernel_launch: unexpected shapes (n_in %d, in0 %d, out %d, ws %zu < %zu)\n", n_in, n_in > 0 ? in_sizes[0] : -1, out_size, ws_size, (size_t)WS_END); grid = -1; return; }
        int dev = 0, cus = 0, per_cu = 0;
        if (hipGetDevice(&dev) != hipSuccess || hipDeviceGetAttribute(&cus, hipDeviceAttributeMultiprocessorCount, dev) != hipSuccess) { grid = -1; return; }
        if (hipFuncSetAttribute((const void*)trunk_fwd, hipFuncAttributeMaxDynamicSharedMemorySize, LDS_BYTES) != hipSuccess) { fprintf(stderr, "kernel_launch: hipFuncSetAttribute failed\n"); grid = -1; return; }
        if (hipOccupancyMaxActiveBlocksPerMultiprocessor(&per_cu, (const void*)trunk_fwd, NWAVES * 64, LDS_BYTES) != hipSuccess || per_cu < 1) fprintf(stderr, "kernel_launch: occupancy query says %d\n", per_cu);
        (void)hipGetLastError();
        grid = cus;
    }
    if (grid < 0) return;
    if (hipMemsetAsync((char*)d_ws + WS_CTL, 0, CTL_ZERO_BYTES, stream) != hipSuccess) return;
    Args a{};
    for (int i = 0; i < 18; ++i) a.in[i] = (const float*)d_in[i];
    a.out = (float*)d_out; a.ws = (unsigned char*)d_ws;
#if MK_PER_PHASE
    for (int p = 0; p < NPHASE; ++p) { if (!phase_exists(p)) continue; a.ph_lo = p; a.ph_hi = p + 1; hipLaunchKernelGGL(trunk_fwd, dim3(grid), dim3(NWAVES * 64), LDS_BYTES, stream, a); }
#else
    a.ph_lo = 0; a.ph_hi = NPHASE; hipLaunchKernelGGL(trunk_fwd, dim3(grid), dim3(NWAVES * 64), LDS_BYTES, stream, a);
#endif
    (void)phase_exists;
}
```

```cpp
#include <hip/hip_runtime.h>
#include <cstdio>
#include <cstdint>
namespace pg8 {
#define PG8_LAS __attribute__((address_space(3)))
typedef unsigned short bf16_t;
typedef short bf16x8 __attribute__((ext_vector_type(8)));
typedef float f32x4 __attribute__((ext_vector_type(4)));
typedef unsigned u32x4 __attribute__((ext_vector_type(4)));
constexpr int BM = 256, BK = 64, HALF = 128, HTB = HALF * BK * 2  , STAGE_BYTES = 8 * HTB, NXCD = 8, WGM = 8;

__host__ __device__ __forceinline__ int lds_byte(int r, int c) { const int st = (r >> 4) * 2 + (c >> 5), rr = r & 15, cc = c & 31, ob = rr * 64 + cc * 2; return st * 1024 + (ob ^ (((ob >> 9) & 1) << 5)); }
__host__ __device__ __forceinline__ void stage_rc(int b, int& R, int& C) { const int st = b / 1024, sb = b % 1024, swz = sb ^ (((sb >> 9) & 1) << 5); R = (st >> 1) * 16 + swz / 64; C = (st & 1) * 32 + (swz % 64) / 2; }
__host__ __device__ __forceinline__ int perm32(int rho) { const int n = rho >> 4, i = rho & 15; return 8 * (i >> 2) + 4 * n + (i & 3); }

struct Unit { int pm, pn; };
struct Gemm { const bf16_t* A; const bf16_t* Bt; int M, N, K; };

struct StaticOrder {
    int nM, nN, nwg, G, c;
    __host__ __device__ void init(int M, int N, int G_, int c_) { nM = M / BM; nN = N / BM; nwg = nM * nN; G = G_; c = c_; }
    __host__ __device__ bool next(int i, Unit& u) const {
        const long L = (long)i * G + c; if (L >= nwg) return false;
        int wgid = (int)L; { const int q = nwg / NXCD, r = nwg % NXCD, xcd = wgid % NXCD, off = wgid / NXCD; wgid = (xcd < r ? xcd * (q + 1) : r * (q + 1) + (xcd - r) * q) + off; }
        const int nig = WGM * nN, gid = wgid / nig, fm = gid * WGM, gsz = (nM - fm) < WGM ? (nM - fm) : WGM;
        u.pm = fm + ((wgid % nig) % gsz); u.pn = (wgid % nig) / gsz; return true;
    }
    __device__ __forceinline__ void a_ready(const Unit&) const {}
    __device__ __forceinline__ void done(const Unit&) const {}
};

__device__ __forceinline__ unsigned cvt_pk_bf16(float lo, float hi) { unsigned r; asm volatile("v_cvt_pk_bf16_f32 %0, %1, %2" : "=v"(r) : "v"(lo), "v"(hi)); return r; }
constexpr float RMS_EPS_F = 1e-6f, SS_FIX = 1048576.0f, SS_UNFIX_D = 1.0f / (1048576.0f * 2048.0f);
typedef long long ss_t;
__device__ __forceinline__ float rstd_of(const ss_t* ss, int row) { return rsqrtf((float)ss[row] * SS_UNFIX_D + RMS_EPS_F); }
template <class Sched> __device__ __forceinline__ int rstd_table_fill(const Sched& S, const ss_t* ss, PG8_LAS unsigned char* ext, int tid) {
    PG8_LAS float* tab = (PG8_LAS float*)ext; int key0 = -1, key1 = -1, bad = 0; Unit u;
    for (int i = 0; S.next(i, u); ++i) { const int slot = (u.pm >> 3) & 1; const int key = slot ? key1 : key0;
        if (key == u.pm) continue;
        if (key >= 0) { bad = 1; continue; }
        if (slot) key1 = u.pm; else key0 = u.pm;
        if (tid < 256) tab[slot * 256 + tid] = rstd_of(ss, u.pm * BM + tid); }
    asm volatile("s_waitcnt lgkmcnt(0)" ::: "memory"); __builtin_amdgcn_s_barrier(); asm volatile("" ::: "memory");
    return bad;
}
__device__ __forceinline__ float rstd_get(const ss_t* ss, const Unit& u, int row, int pf, const PG8_LAS unsigned char* ext) {
    return pf ? rstd_of(ss, row) : ((const PG8_LAS float*)ext)[((u.pm >> 3) & 1) * 256 + (row - u.pm * BM)];
}
struct EpiSwiGLU {
    static constexpr bool PERM = true, AFTER_DRAIN = false;
    bf16_t* O; const ss_t* ss; int ldo;
    template <class Sched> __device__ __forceinline__ int prepare(const Sched& S, PG8_LAS unsigned char* ext, int tid) const { return rstd_table_fill(S, ss, ext, tid); }
    __device__ __forceinline__ void operator()(const f32x4 (&acc)[2][2][4][2], const Unit& u, int wr, int wc, int fr, int fq, int pf, const PG8_LAS unsigned char* ext) const {
        const int row0 = u.pm * BM + wr * 64 + fr, col0 = u.pn * HALF + wc * 32 + 8 * fq;
#pragma unroll
        for (int ai = 0; ai < 2; ++ai)
#pragma unroll
            for (int m = 0; m < 4; ++m) {
                const int row = row0 + ai * HALF + m * 16;
                const float rs = rstd_get(ss, u, row, pf, ext);
                float o[8];
#pragma unroll
                for (int n = 0; n < 2; ++n)
#pragma unroll
                    for (int j = 0; j < 4; ++j) { const float a = acc[ai][0][m][n][j] * rs, b = acc[ai][1][m][n][j] * rs;
                        o[4 * n + j] = a * b * __builtin_amdgcn_rcpf(1.0f + __expf(-a)); }
                u32x4 w; w.x = cvt_pk_bf16(o[0], o[1]); w.y = cvt_pk_bf16(o[2], o[3]); w.z = cvt_pk_bf16(o[4], o[5]); w.w = cvt_pk_bf16(o[6], o[7]);
                *(u32x4*)(O + (size_t)row * ldo + col0) = w;
            }
    }
};
struct EpiMixIn {
    static constexpr bool PERM = true, AFTER_DRAIN = false;
    bf16_t* O; const ss_t* ss;
    template <class Sched> __device__ __forceinline__ int prepare(const Sched& S, PG8_LAS unsigned char* ext, int tid) const { return rstd_table_fill(S, ss, ext, tid); }
    __device__ __forceinline__ void operator()(const f32x4 (&acc)[2][2][4][2], const Unit& u, int wr, int wc, int fr, int fq, int pf, const PG8_LAS unsigned char* ext) const {
        const int row0 = u.pm * BM + wr * 64 + fr, col0 = u.pn * BM + wc * 32 + 8 * fq;
#pragma unroll
        for (int ai = 0; ai < 2; ++ai)
#pragma unroll
            for (int m = 0; m < 4; ++m) {
                const int row = row0 + ai * HALF + m * 16;
                const float rs = rstd_get(ss, u, row, pf, ext);
#pragma unroll
                for (int bj = 0; bj < 2; ++bj) { const f32x4 v0 = acc[ai][bj][m][0] * rs, v1 = acc[ai][bj][m][1] * rs;
                    u32x4 w; w.x = cvt_pk_bf16(v0[0], v0[1]); w.y = cvt_pk_bf16(v0[2], v0[3]); w.z = cvt_pk_bf16(v1[0], v1[1]); w.w = cvt_pk_bf16(v1[2], v1[3]);
                    *(u32x4*)(O + (size_t)row * 6144 + col0 + bj * HALF) = w; }
            }
    }
};
struct EpiResid {
    static constexpr bool PERM = false, AFTER_DRAIN = false;
    const float* res; float* hout; bf16_t* hb; ss_t* ssn; float scale;
    template <class Sched> __device__ __forceinline__ int prepare(const Sched&, PG8_LAS unsigned char*, int) const { return 0; }
    __device__ __forceinline__ void operator()(const f32x4 (&acc)[2][2][4][2], const Unit& u, int wr, int wc, int fr, int fq, int pf, const PG8_LAS unsigned char* ext) const {
        typedef unsigned u32x2v __attribute__((ext_vector_type(2)));
        const int row0 = u.pm * BM + wr * 64 + fr, col0 = u.pn * BM + wc * 32 + 4 * fq;
        f32x4 rb[3][4];
#define PG8_LDG(gi, buf) do { const size_t off_ = (size_t)(row0 + ((gi) >> 2) * HALF + ((gi) & 3) * 16) * 2048 + col0; \
            _Pragma("unroll") for (int q_ = 0; q_ < 4; ++q_) buf[q_] = *(const f32x4*)(res + off_ + (q_ >> 1) * HALF + (q_ & 1) * 16); } while (0)
        PG8_LDG(0, rb[0]); PG8_LDG(1, rb[1]);
#pragma unroll
        for (int gi = 0; gi < 8; ++gi) {
            if (gi + 2 < 8) PG8_LDG(gi + 2, rb[(gi + 2) % 3]);
            const int ai = gi >> 2, m = gi & 3;
            const int row = row0 + ai * HALF + m * 16; const size_t off = (size_t)row * 2048 + col0; float sq = 0.f;
#pragma unroll
            for (int q = 0; q < 4; ++q) { const int bj = q >> 1, n = q & 1; const size_t o2 = off + bj * HALF + n * 16;
                const f32x4 hn = rb[gi % 3][q] + acc[ai][bj][m][n] * scale;
                *(f32x4*)(hout + o2) = hn; u32x2v w; w.x = cvt_pk_bf16(hn[0], hn[1]); w.y = cvt_pk_bf16(hn[2], hn[3]); *(u32x2v*)(hb + o2) = w;
                sq += (hn[0] * hn[0] + hn[1] * hn[1]) + (hn[2] * hn[2] + hn[3] * hn[3]); }
            sq += __shfl_xor(sq, 16); sq += __shfl_xor(sq, 32);
            if (fq == 0) atomicAdd((unsigned long long*)(ssn + row), (unsigned long long)__float2ll_rn(sq * SS_FIX));
        }
#undef PG8_LDG
    }
};

template <class Epi, class Sched, bool ALIGN_EPI = false, bool SP2 = false>
__device__ __forceinline__ void gemm_phase(PG8_LAS unsigned char* lds, const Gemm g, const Sched& S, const Epi& E) {
    int tid_ = threadIdx.x; asm volatile("" : "+v"(tid_));
    const int tid = tid_, wid = __builtin_amdgcn_readfirstlane(tid >> 6), lane = tid & 63, wr = wid >> 2, wc = wid & 3, fr = lane & 15, fq = lane >> 4;
    const int K = g.K, nt = K / BK;
    unsigned voffA[2], voffB[2];
#pragma unroll
    for (int i = 0; i < 2; ++i) { int R, C; stage_rc(tid * 16 + i * 8192, R, C); const int Rb = Epi::PERM ? ((R & ~31) + perm32(R & 31)) : R;
        voffA[i] = (unsigned)(R * K + C) * 2u; voffB[i] = (unsigned)(Rb * K + C) * 2u; }
    const size_t kstep = (size_t)(BK * 2);
    const size_t hstep = (size_t)HALF * K * 2;
    const size_t tstep = 2 * hstep;
    const unsigned ldsw = (unsigned)wid * 1024u;
    const int aoff = lds_byte(wr * 64 + fr, fq * 8), boff = lds_byte(wc * 32 + fr, fq * 8);
#define PG8_SA(b, h) (((b) * 2 + (h)) * HTB)
#define PG8_SB(b, h) ((4 + (b) * 2 + (h)) * HTB)
#define PG8_STAGE(bufoff, gbase, voff) do { _Pragma("unroll") for (int _i = 0; _i < 2; ++_i) \
        __builtin_amdgcn_global_load_lds((const unsigned*)((const char*)(gbase) + (voff)[_i]), (PG8_LAS unsigned*)(lds + (bufoff) + ldsw + _i * 8192), 16, 0, 0); } while (0)
#define PG8_LDA(dst, b, h) do { _Pragma("unroll") for (int m = 0; m < 4; ++m) _Pragma("unroll") for (int k = 0; k < 2; ++k) dst[m][k] = *(const PG8_LAS bf16x8*)(lds + PG8_SA(b, h) + aoff + m * 2048 + k * 1024); } while (0)
#define PG8_LDB(dst, b, h) do { _Pragma("unroll") for (int n = 0; n < 2; ++n) _Pragma("unroll") for (int k = 0; k < 2; ++k) dst[n][k] = *(const PG8_LAS bf16x8*)(lds + PG8_SB(b, h) + boff + n * 2048 + k * 1024); } while (0)
#define PG8_MMA(ai, bj, At, Bt) do { __builtin_amdgcn_s_setprio(1); _Pragma("unroll") for (int m = 0; m < 4; ++m) _Pragma("unroll") for (int n = 0; n < 2; ++n) _Pragma("unroll") for (int k = 0; k < 2; ++k) \
        acc[ai][bj][m][n] = __builtin_amdgcn_mfma_f32_16x16x32_bf16(Bt[n][k], At[m][k], acc[ai][bj][m][n], 0, 0, 0); __builtin_amdgcn_s_setprio(0); } while (0)
#define PG8_WAIT_V(n) asm volatile("s_waitcnt vmcnt(" #n ")" ::: "memory")
#define PG8_WAIT_L(n) asm volatile("s_waitcnt lgkmcnt(" #n ")" ::: "memory")
#define PG8_BAR __builtin_amdgcn_s_barrier()
#define PG8_SCHED __builtin_amdgcn_sched_barrier(0)
    const int pf = E.prepare(S, lds + STAGE_BYTES, tid);
    Unit cur, nxt; int ui = 0;
    if (!S.next(0, cur)) return;
    f32x4 acc[2][2][4][2];
#pragma unroll
    for (int a = 0; a < 2; ++a)
#pragma unroll
        for (int b = 0; b < 2; ++b)
#pragma unroll
            for (int m = 0; m < 4; ++m)
#pragma unroll
                for (int n = 0; n < 2; ++n) acc[a][b][m][n] = (f32x4){0.f, 0.f, 0.f, 0.f};
    bf16x8 At[4][2], B0[2][2], B1[2][2];
    const char* cA = (const char*)g.A + (size_t)cur.pm * tstep; const char* cB = (const char*)g.Bt + (size_t)cur.pn * tstep;
    S.a_ready(cur);
    if constexpr (SP2) {
        PG8_STAGE(PG8_SB(0, 0), cB, voffB); PG8_STAGE(PG8_SB(0, 1), cB + hstep, voffB); PG8_STAGE(PG8_SA(0, 0), cA, voffA); PG8_STAGE(PG8_SA(0, 1), cA + hstep, voffA);
        if (wr == 1) PG8_BAR;
        PG8_WAIT_V(2); PG8_BAR;
        PG8_STAGE(PG8_SB(1, 0), cB + kstep, voffB); PG8_STAGE(PG8_SA(1, 0), cA + kstep, voffA); PG8_STAGE(PG8_SB(1, 1), cB + hstep + kstep, voffB);
        PG8_WAIT_V(6); PG8_BAR;
    } else {
        PG8_STAGE(PG8_SB(0, 0), cB, voffB); PG8_STAGE(PG8_SA(0, 0), cA, voffA); PG8_STAGE(PG8_SB(0, 1), cB + hstep, voffB); PG8_STAGE(PG8_SA(0, 1), cA + hstep, voffA);
        if (wr == 1) PG8_BAR;
        PG8_WAIT_V(4); PG8_BAR;
        PG8_STAGE(PG8_SB(1, 0), cB + kstep, voffB); PG8_STAGE(PG8_SA(1, 0), cA + kstep, voffA); PG8_STAGE(PG8_SB(1, 1), cB + hstep + kstep, voffB);
        PG8_WAIT_V(6); PG8_BAR;
    }
    for (;;) {
        const bool has_next = S.next(ui + 1, nxt);
        const char* nA = has_next ? (const char*)g.A + (size_t)nxt.pm * tstep : cA; const char* nB = has_next ? (const char*)g.Bt + (size_t)nxt.pn * tstep : cB;
        for (int t = 0; t < nt; t += 2) {
            const bool last = (t == nt - 2);
            const char* a1 = cA + (size_t)(t + 1) * kstep;
            const char* a2 = last ? nA : cA + (size_t)(t + 2) * kstep; const char* b2 = last ? nB : cB + (size_t)(t + 2) * kstep;
            const char* a3 = a2 + kstep; const char* b3 = b2 + kstep;
            if (last && has_next) S.a_ready(nxt);
            if constexpr (SP2) {
            PG8_LDB(B0, 0, 0); PG8_LDB(B1, 0, 1); PG8_SCHED; PG8_LDA(At, 0, 0); PG8_STAGE(PG8_SA(1, 1), a1 + hstep, voffA);
            PG8_WAIT_V(8); PG8_WAIT_L(0); PG8_BAR; PG8_MMA(0, 0, At, B0); PG8_MMA(0, 1, At, B1); PG8_BAR; PG8_SCHED;
            PG8_LDA(At, 0, 1); PG8_STAGE(PG8_SB(0, 0), b2, voffB); PG8_STAGE(PG8_SB(0, 1), b2 + hstep, voffB); PG8_STAGE(PG8_SA(0, 0), a2, voffA);
            PG8_WAIT_V(8); PG8_WAIT_L(0); PG8_BAR; PG8_MMA(1, 0, At, B0); PG8_MMA(1, 1, At, B1); PG8_BAR; PG8_SCHED;
            PG8_LDB(B0, 1, 0); PG8_LDB(B1, 1, 1); PG8_SCHED; PG8_LDA(At, 1, 0); PG8_STAGE(PG8_SA(0, 1), a2 + hstep, voffA);
            PG8_WAIT_V(8); PG8_WAIT_L(0); PG8_BAR; PG8_MMA(0, 0, At, B0); PG8_MMA(0, 1, At, B1); PG8_BAR; PG8_SCHED;
            PG8_LDA(At, 1, 1); PG8_STAGE(PG8_SB(1, 0), b3, voffB); PG8_STAGE(PG8_SB(1, 1), b3 + hstep, voffB); PG8_STAGE(PG8_SA(1, 0), a3, voffA);
            PG8_WAIT_V(8); PG8_WAIT_L(0); PG8_BAR; PG8_MMA(1, 0, At, B0); PG8_MMA(1, 1, At, B1); PG8_BAR; PG8_SCHED;
            } else {
            PG8_LDB(B0, 0, 0); PG8_SCHED; PG8_LDA(At, 0, 0); PG8_STAGE(PG8_SA(1, 1), a1 + hstep, voffA);
            PG8_WAIT_L(8); PG8_BAR; PG8_WAIT_L(0); PG8_MMA(0, 0, At, B0); PG8_BAR; PG8_SCHED;
            PG8_LDB(B1, 0, 1); PG8_STAGE(PG8_SB(0, 0), b2, voffB);
            PG8_BAR; PG8_WAIT_L(0); PG8_MMA(0, 1, At, B1); PG8_BAR;
            PG8_LDA(At, 0, 1); PG8_STAGE(PG8_SA(0, 0), a2, voffA);
            PG8_BAR; PG8_WAIT_L(0); PG8_MMA(1, 0, At, B0); PG8_BAR; PG8_SCHED;
            PG8_STAGE(PG8_SB(0, 1), b2 + hstep, voffB);
            PG8_WAIT_V(6); PG8_BAR; PG8_MMA(1, 1, At, B1); PG8_BAR;
            PG8_LDB(B0, 1, 0); PG8_SCHED; PG8_LDA(At, 1, 0); PG8_STAGE(PG8_SA(0, 1), a2 + hstep, voffA);
            PG8_WAIT_L(8); PG8_BAR; PG8_WAIT_L(0); PG8_MMA(0, 0, At, B0); PG8_BAR; PG8_SCHED;
            PG8_LDB(B1, 1, 1); PG8_STAGE(PG8_SB(1, 0), b3, voffB);
            PG8_BAR; PG8_WAIT_L(0); PG8_MMA(0, 1, At, B1); PG8_BAR;
            PG8_LDA(At, 1, 1); PG8_STAGE(PG8_SA(1, 0), a3, voffA);
            PG8_BAR; PG8_WAIT_L(0); PG8_MMA(1, 0, At, B0); PG8_BAR; PG8_SCHED;
            PG8_STAGE(PG8_SB(1, 1), b3 + hstep, voffB);
            PG8_WAIT_V(6); PG8_BAR; PG8_MMA(1, 1, At, B1); PG8_BAR;
            }
        }
        if constexpr (ALIGN_EPI) { if (wr == 0) PG8_BAR; }
        if constexpr (!Epi::AFTER_DRAIN) { E(acc, cur, wr, wc, fr, fq, pf, lds + STAGE_BYTES); S.done(cur); }
        if (!has_next) break;
#pragma unroll
        for (int a = 0; a < 2; ++a)
#pragma unroll
            for (int b = 0; b < 2; ++b)
#pragma unroll
                for (int m = 0; m < 4; ++m)
#pragma unroll
                    for (int n = 0; n < 2; ++n) acc[a][b][m][n] = (f32x4){0.f, 0.f, 0.f, 0.f};
        cur = nxt; cA = nA; cB = nB; ++ui;
        if constexpr (ALIGN_EPI) { if (wr == 1) PG8_BAR; }
    }
    PG8_WAIT_V(0);
    if constexpr (!ALIGN_EPI) { if (wr == 0) PG8_BAR; }
    PG8_BAR;
    if constexpr (Epi::AFTER_DRAIN) { E.fused(acc, cur, wr, wc, fr, fq, lds, wid, lane); S.done(cur); }
#undef PG8_SA
#undef PG8_SB
#undef PG8_STAGE
#undef PG8_LDA
#undef PG8_LDB
#undef PG8_MMA
#undef PG8_WAIT_V
#undef PG8_WAIT_L
#undef PG8_BAR
#undef PG8_SCHED
}
}

#ifndef PG8_SP2
#define PG8_SP2 true
#endif
#ifndef PG8_ALIGN
#define PG8_ALIGN true
#endif
#ifndef REP_PRO
#define REP_PRO 1
#endif
#ifndef REP_MLSTM
#define REP_MLSTM 1
#endif
#ifndef REP_FOX
#define REP_FOX 1
#endif
#ifndef REP_GLA
#define REP_GLA 1
#endif
#ifndef MK_PER_PHASE
#define MK_PER_PHASE 0
#endif

constexpr int DM = 2048, BATCH = 8, SEQ = 4096, MTOK = BATCH * SEQ, DEPTH = 4, DFF = 5632, NUP = 2 * DFF, NIN = 6160, NINP = 6400, NQKV = 6144;
constexpr int NWAVES = 8;
constexpr int NSUB = 3 * DEPTH;
constexpr int NPHASE = 2 + 5 * NSUB;

constexpr size_t MiB = 1u << 20;
constexpr size_t WS_CTL = 0, CTL_ZERO_BYTES = 5 * MiB;
constexpr size_t WS_SS = 1 * MiB;
constexpr size_t WS_WUP = 8 * MiB;
constexpr size_t WS_WDN = WS_WUP + 352 * MiB;
constexpr size_t WS_WIN = WS_WDN + 176 * MiB;
constexpr size_t WS_WOUT = WS_WIN + 100 * MiB;
constexpr size_t WS_HB = WS_WOUT + 32 * MiB;
constexpr size_t WS_ACT = WS_HB + 128 * MiB;
constexpr size_t WS_P1 = WS_ACT + 352 * MiB;
constexpr size_t WS_G = WS_P1 + 384 * MiB;
constexpr size_t WS_HRAW = WS_G + 2 * MiB;
constexpr size_t WS_HM = WS_HRAW + 256 * MiB;
constexpr size_t WS_CF = WS_HM + 128 * MiB;
constexpr size_t WS_END = WS_CF + 2 * MiB;
static_assert((size_t)8 * NUP * DM * 2 == 352 * MiB && (size_t)8 * DM * DFF * 2 == 176 * MiB && (size_t)4 * NINP * DM * 2 == 100 * MiB, "weight regions");
static_assert((size_t)MTOK * DFF * 2 == 352 * MiB && (size_t)MTOK * NQKV * 2 == 384 * MiB && WS_SS + 13 * (size_t)MTOK * 8 <= CTL_ZERO_BYTES, "activation regions");
constexpr int CW_BAR = 4096;

constexpr int LDS_BYTES = 153600, MISC_OFF = 152576;

#define GAS __attribute__((address_space(1)))
#define LAS __attribute__((address_space(3)))
#define DI __device__ __forceinline__
typedef unsigned short bf16;
typedef unsigned v4u __attribute__((ext_vector_type(4)));
typedef unsigned v2u __attribute__((ext_vector_type(2)));
typedef float f32x4 __attribute__((ext_vector_type(4)));
typedef short bf16x8 __attribute__((ext_vector_type(8)));
typedef GAS unsigned gu32;
#define RLX_AGENT __ATOMIC_RELAXED, __HIP_MEMORY_SCOPE_AGENT
#define LDS_WAIT() asm volatile("s_waitcnt lgkmcnt(0)" ::: "memory")
DI unsigned f2bf(float f) { unsigned r; asm("v_cvt_pk_bf16_f32 %0, %1, %1" : "=v"(r) : "v"(f)); return r & 0xffffu; }
DI unsigned pk2(float lo, float hi) { unsigned r; asm("v_cvt_pk_bf16_f32 %0, %1, %2" : "=v"(r) : "v"(lo), "v"(hi)); return r; }
DI float bf2f(unsigned short v) { return __builtin_bit_cast(float, (unsigned)v << 16); }
DI float bflo(unsigned w) { return __builtin_bit_cast(float, w << 16); }
DI float bfhi(unsigned w) { return __builtin_bit_cast(float, w & 0xffff0000u); }
DI float logsig(float x) { return fminf(x, 0.f) - log1pf(expf(-fabsf(x))); }

#define XB_TMO      128
#define XB_XCNT(j)  (256  + 64 * (j))
#define XB_XSUB(j)  (1280 + 64 * (j))
#define XB_XGEN(j)  (2304 + 64 * (j))
#define XB_TOP      3328
#define XB_TOPGEN   3392
#define XCD_BAR_WORDS 3456
#define XB_SPIN_CAP (1u << 18)

__device__ __forceinline__ unsigned xb_ld(unsigned* p)              { return __hip_atomic_load(p, __ATOMIC_RELAXED, __HIP_MEMORY_SCOPE_AGENT); }
__device__ __forceinline__ unsigned xb_add(unsigned* p, unsigned v) { return __hip_atomic_fetch_add(p, v, __ATOMIC_RELAXED, __HIP_MEMORY_SCOPE_AGENT); }
__device__ __forceinline__ unsigned xb_xcc_id() { return (unsigned)__builtin_amdgcn_s_getreg((3 << 11) | 20) & 0xFu; }
#define XB_SPIN(cond, bar) do { unsigned _sp = 0; while (cond) { __builtin_amdgcn_s_sleep(1); \
    if ((++_sp & 255u) == 0u) { if (xb_ld(&(bar)[XB_TMO])) break; if (_sp > XB_SPIN_CAP) { atomicAdd(&(bar)[XB_TMO], 1u); break; } } } } while (0)

struct XcdBarrier {
    unsigned* bar; unsigned x;
    volatile LAS unsigned* st;
};

__device__ __forceinline__ XcdBarrier xcd_barrier_post(unsigned* bar, volatile LAS unsigned* st) {
    XcdBarrier b; b.bar = bar; b.x = xb_xcc_id(); b.st = st;
    if (threadIdx.x == 0) (void)xb_add(&bar[XB_XCNT(b.x)], 1u);
    return b;
}
__device__ __forceinline__ void xcd_barrier_complete(unsigned* bar, unsigned x, unsigned& nloc, unsigned& nx) {
    const unsigned G = gridDim.x * gridDim.y * gridDim.z;
    unsigned sum, cnt, mine, sp = 0u;
    for (;;) {
        sum = 0u; cnt = 0u; mine = 0u;
#pragma unroll
        for (unsigned j = 0; j < 16; ++j) { const unsigned c = xb_ld(&bar[XB_XCNT(j)]); sum += c; cnt += (c > 0u) ? 1u : 0u; mine = (j == x) ? c : mine; }
        if (sum == G) break;
        __builtin_amdgcn_s_sleep(1);
        if ((++sp & 255u) == 0u) { if (xb_ld(&bar[XB_TMO])) break; if (sp > XB_SPIN_CAP) { atomicAdd(&bar[XB_TMO], 1u); break; } }
    }
    nloc = mine > 0u ? mine : 1u; nx = cnt > 0u ? cnt : 1u;
}

__device__ __forceinline__ void xcd_barrier(const XcdBarrier& b) {
    asm volatile("s_waitcnt vmcnt(0)" ::: "memory");
    __syncthreads();
    if (threadIdx.x == 0) {
        unsigned* bar = b.bar;
        __builtin_amdgcn_s_waitcnt(0);
        unsigned nloc = b.st[0], nx = b.st[1];
        if (nloc == 0u) { xcd_barrier_complete(bar, b.x, nloc, nx); b.st[0] = nloc; b.st[1] = nx; }
        const unsigned old = xb_add(&bar[XB_XSUB(b.x)], 1u);
        const unsigned gen = old / nloc;
        if (old + 1u == (gen + 1u) * nloc) {
            __builtin_amdgcn_fence(__ATOMIC_RELEASE, "agent");
            asm volatile("s_waitcnt vmcnt(0)" ::: "memory");
            const unsigned og = xb_add(&bar[XB_TOP], 1u);
            const unsigned tg = og / nx;
            if (og + 1u == (tg + 1u) * nx) xb_add(&bar[XB_TOPGEN], 1u);
            else XB_SPIN(xb_ld(&bar[XB_TOPGEN]) == tg, bar);
            __builtin_amdgcn_fence(__ATOMIC_ACQUIRE, "agent");
            xb_add(&bar[XB_XGEN(b.x)], 1u);
            asm volatile("s_waitcnt vmcnt(0)" ::: "memory");
        } else {
            XB_SPIN(xb_ld(&bar[XB_XGEN(b.x)]) == gen, bar);
            __builtin_amdgcn_fence(__ATOMIC_ACQUIRE, "agent");
            asm volatile("s_waitcnt vmcnt(0)" ::: "memory");
        }
    }
    __syncthreads();
}


DI float wave_sum(float v) {
#pragma unroll
    for (int o = 1; o < 64; o <<= 1) v += __shfl_xor(v, o);
    return v;
}
DI float wave_max(float v) {
#pragma unroll
    for (int o = 1; o < 64; o <<= 1) v = fmaxf(v, __shfl_xor(v, o));
    return v;
}
DI float wave_incl_sum(float v, int lane) {
#pragma unroll
    for (int o = 1; o < 64; o <<= 1) { const float t = __shfl_up(v, o); if (lane >= o) v += t; }
    return v;
}
DI float wave_incl_max(float v, int lane) {
#pragma unroll
    for (int o = 1; o < 64; o <<= 1) { const float t = __shfl_up(v, o); if (lane >= o) v = fmaxf(v, t); }
    return v;
}

template <int L> DI int swx(int r) { return L == 64 ? ((r >> 1) & 7) : (r & 15); }
template <int L> DI int eoff(int r, int c) { return r * L + ((((c >> 3) ^ swx<L>(r)) << 3) | (c & 7)); }
template <int L> DI bf16x8 ldf(const LAS bf16* base, int r, int ch) { return *(const LAS bf16x8*)(base + r * L + ((ch ^ swx<L>(r)) << 3)); }
DI f32x4 mfma16(bf16x8 a, bf16x8 b, f32x4 c) { return __builtin_amdgcn_mfma_f32_16x16x32_bf16(a, b, c, 0, 0, 0); }
typedef short v4i16_t __attribute__((ext_vector_type(4)));
DI v4i16_t tr_read(const LAS unsigned char* p) { return __builtin_amdgcn_ds_read_tr16_b64_v4i16((LAS v4i16_t*)p); }
DI bf16x8 cat4(v4i16_t lo, v4i16_t hi) { bf16x8 r; r[0] = lo[0]; r[1] = lo[1]; r[2] = lo[2]; r[3] = lo[3]; r[4] = hi[0]; r[5] = hi[1]; r[6] = hi[2]; r[7] = hi[3]; return r; }
DI unsigned off_v64(unsigned row, unsigned ch) { return 128u * row + 16u * (ch ^ ((((row >> 1) & 1u) << 1) | (((row >> 3) & 1u) << 2))); }
DI bf16x8 vfrag64(const LAS unsigned char* vb, int c, int ks, int lane) { const unsigned g = lane >> 4, q = (lane & 15) >> 2, p = lane & 3;
    return cat4(tr_read(vb + off_v64(32 * ks + 8 * g + q, 2 * c + (p >> 1)) + 8 * (p & 1)), tr_read(vb + off_v64(32 * ks + 8 * g + 4 + q, 2 * c + (p >> 1)) + 8 * (p & 1))); }
template <int LA, int LB, int NK> DI void mma_tile(f32x4& acc, const LAS bf16* A, int ra0, const LAS bf16* B, int rb0, int lane) {
    const int r = lane & 15, g = lane >> 4;
#pragma unroll
    for (int kk = 0; kk < NK; ++kk) { const bf16x8 a = ldf<LA>(A, ra0 + r, 4 * kk + g), b = ldf<LB>(B, rb0 + r, 4 * kk + g); acc = mfma16(a, b, acc); }
}

struct ConvItem { const float* W; const float* gk; bf16* WT; int K, N, mode, r; };
DI void conv_load(const ConvItem& c, int lane, f32x4 (&v)[8], float (&gv)[8]) {
    const int nkb = c.K / 64, nb = c.r / nkb, kb = c.r - nb * nkb, k0 = 64 * kb, n0 = 32 * nb;
    const int n = n0 + 4 * (lane & 7); const bool ok = n < c.N;
#pragma unroll
    for (int i = 0; i < 8; ++i) { const int kk = 8 * i + (lane >> 3); v[i] = ok ? *(const f32x4*)(c.W + (size_t)(k0 + kk) * c.N + n) : (f32x4){0.f, 0.f, 0.f, 0.f}; gv[i] = c.gk ? c.gk[k0 + kk] : 1.0f; }
}
DI void conv_store(const ConvItem& c, int lane, const f32x4 (&v)[8], const float (&gv)[8], LAS float* scr) {
    const int nkb = c.K / 64, nb = c.r / nkb, kb = c.r - nb * nkb, k0 = 64 * kb, n0 = 32 * nb, nq = 4 * (lane & 7);
#pragma unroll
    for (int i = 0; i < 8; ++i) { const int kk = 8 * i + (lane >> 3); LAS float* d = scr + kk * 33 + nq; d[0] = v[i].x * gv[i]; d[1] = v[i].y * gv[i]; d[2] = v[i].z * gv[i]; d[3] = v[i].w * gv[i]; }
    LDS_WAIT(); asm volatile("" ::: "memory");
    int row_off = n0;
    if (c.mode == 1) { const int j = n0 < DFF ? n0 : n0 - DFF; row_off = 256 * (j >> 7) + (j & 127) + (n0 < DFF ? 0 : 128); }
    const int cc = lane & 7;
#pragma unroll
    for (int j = 0; j < 4; ++j) { const int nn = (lane >> 3) + 8 * j; const LAS float* s = scr + (8 * cc) * 33 + nn;
        v4u o; o.x = pk2(s[0 * 33], s[1 * 33]); o.y = pk2(s[2 * 33], s[3 * 33]); o.z = pk2(s[4 * 33], s[5 * 33]); o.w = pk2(s[6 * 33], s[7 * 33]);
        *(v4u*)(c.WT + (size_t)(row_off + nn) * c.K + k0 + 8 * cc) = o; }
    LDS_WAIT(); asm volatile("" ::: "memory");
}

struct Args { const float* in[18]; float* out; unsigned char* ws; int ph_lo, ph_hi; };

typedef const __attribute__((address_space(4))) Args* KArgs;
DI KArgs kargs() { KArgs p = (KArgs)__builtin_amdgcn_kernarg_segment_ptr(); asm volatile("" : "+s"(p)); return p; }
DI void prologue(LAS unsigned char* lds, int lane, int wave, int bx) {
    KArgs AP = kargs();
    LAS float* scr = (LAS float*)(lds + wave * 16384);
    const int gw = bx * NWAVES + wave, NGW = gridDim.x * NWAVES;
    unsigned char* ws = AP->ws;
    constexpr int I_UP = (DM / 64) * (NUP / 32), I_DN = (DFF / 64) * (DM / 32), I_IN = (DM / 64) * (NINP / 32), I_OUT = (DM / 64) * (DM / 32);
    constexpr int NITEMS = 8 * I_UP + 8 * I_DN + 4 * I_IN + 4 * I_OUT;
#define CONV_DECODE(it_, c_) do { int r = (it_); (c_).gk = nullptr; (c_).K = DM; (c_).mode = 0; \
        if (r < 8 * I_UP) { const int mi = r / I_UP; r -= mi * I_UP; (c_).W = AP->in[2] + (size_t)mi * DM * NUP; (c_).gk = AP->in[1] + (size_t)mi * DM; (c_).WT = (bf16*)(ws + WS_WUP) + (size_t)mi * NUP * DM; (c_).N = NUP; (c_).mode = 1; } \
        else if (r < 8 * I_UP + 8 * I_DN) { r -= 8 * I_UP; const int mi = r / I_DN; r -= mi * I_DN; (c_).W = AP->in[3] + (size_t)mi * DFF * DM; (c_).WT = (bf16*)(ws + WS_WDN) + (size_t)mi * DM * DFF; (c_).K = DFF; (c_).N = DM; } \
        else if (r < 8 * I_UP + 8 * I_DN + 4 * I_IN) { r -= 8 * I_UP + 8 * I_DN; const int l = r / I_IN; r -= l * I_IN; const int kind = l % 3, ji = l / 3; \
            (c_).W = AP->in[kind == 0 ? 5 : kind == 1 ? 9 : 12] + (size_t)ji * DM * NIN; (c_).gk = AP->in[4] + (size_t)l * DM; (c_).WT = (bf16*)(ws + WS_WIN) + (size_t)l * NINP * DM; (c_).N = NIN; } \
        else { r -= 8 * I_UP + 8 * I_DN + 4 * I_IN; const int l = r / I_OUT; r -= l * I_OUT; const int kind = l % 3, ji = l / 3; \
            (c_).W = AP->in[kind == 0 ? 8 : kind == 1 ? 11 : 16] + (size_t)ji * DM * DM; (c_).WT = (bf16*)(ws + WS_WOUT) + (size_t)l * DM * DM; (c_).N = DM; } \
        (c_).r = r; } while (0)
    f32x4 va[8]; float ga[8]; ConvItem ca{}, cb{};
    if (gw < NITEMS) { CONV_DECODE(gw, ca); conv_load(ca, lane, va, ga); }
    for (int it = gw; it < NITEMS; it += NGW) {
        f32x4 vb[8]; float gb[8]; const int nx = it + NGW;
        if (nx < NITEMS) { CONV_DECODE(nx, cb); conv_load(cb, lane, vb, gb); }
        conv_store(ca, lane, va, ga, scr);
        ca = cb;
#pragma unroll
        for (int i = 0; i < 8; ++i) { va[i] = vb[i]; ga[i] = gb[i]; }
    }
#undef CONV_DECODE
    const float* x = AP->in[0]; bf16* hb = (bf16*)(ws + WS_HB); long long* ss0 = (long long*)(ws + WS_SS);
    for (int m = gw; m < MTOK; m += NGW) {
        const f32x4* xr = (const f32x4*)(x + (size_t)m * DM) + lane; f32x4 v[8]; float s = 0.f;
#pragma unroll
        for (int j = 0; j < 8; ++j) { v[j] = xr[64 * j]; s += (v[j].x * v[j].x + v[j].y * v[j].y) + (v[j].z * v[j].z + v[j].w * v[j].w); }
        s = wave_sum(s);
        v2u* o8 = (v2u*)(hb + (size_t)m * DM) + lane;
#pragma unroll
        for (int j = 0; j < 8; ++j) { v2u w; w.x = pk2(v[j].x, v[j].y); w.y = pk2(v[j].z, v[j].w); o8[64 * j] = w; }
        if (lane == 0) ss0[m] = __float2ll_rn(s * 1048576.0f);
    }
}

constexpr int IMGM_P = 0, IMGM_KT = 8192, IMGM_VT = IMGM_KT + 16384, IMGM_GS = IMGM_VT + 4 * 8192, IMGM_BYTES = IMGM_GS + 1024;
constexpr int IMGG_Q = 0, IMGG_KT = 32768, IMGG_P = 65536, IMGG_VT = IMGG_P + 8192, IMGG_EB = IMGG_VT + 8 * 8192, IMGG_BYTES = IMGG_EB + 1024;
static_assert((size_t)IMGM_BYTES * 4096 <= 352 * MiB && (size_t)IMGG_BYTES * 2048 <= 352 * MiB, "images overlay the (idle) FFN activation buffer");
DI unsigned pk2_sw(float lo, float hi) { unsigned a = __builtin_bit_cast(unsigned, lo), b = __builtin_bit_cast(unsigned, hi); a = (a + 0x7fffu + ((a >> 16) & 1u)) >> 16; b = (b + 0x7fffu + ((b >> 16) & 1u)) & 0xffff0000u; return a | b; }
DI float logsig_fast(float x) { return fminf(x, 0.f) - __logf(1.0f + __expf(-fabsf(x))); }

DI void mlstm_pre(LAS unsigned char* lds, const bf16* P1, const float* G, const float* b_if, unsigned char* img, int tid, int lane, int wave, int bx) {
    LAS bf16* Qs = (LAS bf16*)lds;
    LAS bf16* Ks = Qs + 64 * 128;
    LAS bf16* KTs = Ks + 64 * 128;
    LAS bf16* Ps = KTs + 128 * 64;
    LAS bf16* VT = Ps + 64 * 64;
    LAS float* fa = (LAS float*)(VT + 256 * 64);
    LAS float *bcum = fa, *ipre = fa + 64, *aloc = fa + 128, *wloc = fa + 192, *scal = fa + 256;
    const float KSCALE = 0.08838834764831845f;
    const int g = lane >> 4, r16 = lane & 15;
    v4u pq[2], pk[2]; float pgi = 0.f, pgf = 0.f;
#define MLP_LOAD(it_) do { const int b_ = (it_) >> 9, c_ = ((it_) >> 3) & 63, h_ = (it_) & 7; const int row0_ = b_ * SEQ + c_ * 64; \
        _Pragma("unroll") for (int p = 0; p < 2; ++p) { const int idx = tid + 512 * p, r = idx >> 4, c8 = idx & 15; const bf16* src = P1 + (size_t)(row0_ + r) * NQKV + h_ * 128 + c8 * 8; pq[p] = *(const v4u*)src; pk[p] = *(const v4u*)(src + 1024); } \
        if (tid < 64) { const float* gp = G + (size_t)(row0_ + tid) * 16; pgi = gp[h_]; pgf = gp[8 + h_]; } } while (0)
    if (bx < 4096) MLP_LOAD(bx);
    for (int item = bx; item < 4096; item += gridDim.x) {
        const int h = item & 7;
        unsigned char* im = img + (size_t)item * IMGM_BYTES;
        __syncthreads();
        if (tid < 64) { ipre[tid] = pgi + b_if[h]; bcum[tid] = logsig(pgf + b_if[8 + h]); }
#pragma unroll
        for (int p = 0; p < 2; ++p) { const int idx = tid + 512 * p, r = idx >> 4, c8 = idx & 15; *(LAS v4u*)(Qs + eoff<128>(r, c8 * 8)) = pq[p]; *(LAS v4u*)(Ks + eoff<128>(r, c8 * 8)) = pk[p]; }
        __syncthreads();
        if (wave == 0) {
            const float bt = wave_incl_sum(bcum[lane], lane), ip = ipre[lane];
            const float al = bt + wave_incl_max(ip - bt, lane);
            const float blast = __shfl(bt, 63);
            const float gg = blast - bt + ip;
            const float gmax = wave_max(gg);
            bcum[lane] = bt; aloc[lane] = al; wloc[lane] = __expf(gg - gmax);
            if (lane == 0) { scal[0] = blast; scal[1] = gmax; }
        }
        if (item + (int)gridDim.x < 4096) MLP_LOAD(item + (int)gridDim.x);
        __syncthreads();
#pragma unroll
        for (int p = 0; p < 2; ++p) { const int idx = tid + 512 * p, s = idx >> 4, c8 = idx & 15; const v4u kv = *(const LAS v4u*)(Ks + eoff<128>(s, c8 * 8)); const float w = wloc[s] * KSCALE;
#pragma unroll
            for (int j = 0; j < 4; ++j) { KTs[eoff<64>(c8 * 8 + 2 * j, s)] = (bf16)f2bf(bflo(kv[j]) * w); KTs[eoff<64>(c8 * 8 + 2 * j + 1, s)] = (bf16)f2bf(bfhi(kv[j]) * w); } }
        { const int tt = wave >> 1;
#pragma unroll
          for (int q2 = 0; q2 < 2; ++q2) { const int st = 2 * (wave & 1) + q2; f32x4 acc = (f32x4){0.f, 0.f, 0.f, 0.f};
            if (st <= tt) mma_tile<128, 128, 4>(acc, Qs, 16 * tt, Ks, 16 * st, lane);
            const int s = 16 * st + r16; const float cs = ipre[s] - bcum[s];
#pragma unroll
            for (int i = 0; i < 4; ++i) { const int t = 16 * tt + 4 * g + i; const float p = (s <= t) ? acc[i] * KSCALE * __expf(bcum[t] + cs - aloc[t]) : 0.f; Ps[eoff<64>(t, s)] = (bf16)f2bf(p); } } }
        __syncthreads();
        *(v4u*)(im + IMGM_P + tid * 16) = *(const LAS v4u*)((LAS unsigned char*)Ps + tid * 16);
#pragma unroll
        for (int p = 0; p < 2; ++p) *(v4u*)(im + IMGM_KT + (tid + 512 * p) * 16) = *(const LAS v4u*)((LAS unsigned char*)KTs + (tid + 512 * p) * 16);
        if (tid < 64) { float* gs = (float*)(im + IMGM_GS); gs[tid] = bcum[tid]; gs[64 + tid] = aloc[tid]; if (tid < 2) gs[128 + tid] = scal[tid]; }
    }
#undef MLP_LOAD
}

DI void mlstm_scan2(LAS unsigned char* lds, const bf16* P1, const unsigned char* img, bf16* hraw, int tid, int lane, int wave, int bx) {
    constexpr int IB = 8192 + 16384 + 16384 + 10240 + 1024;
    LAS bf16* CT0 = (LAS bf16*)(lds + 2 * IB);
    const int g = lane >> 4, r16 = lane & 15, tt = wave >> 1, eh = wave & 1;
    for (int item0 = bx; item0 < 256; item0 += gridDim.x) {
        const int item = (gridDim.x == 256) ? (item0 & 7) * 32 + (item0 >> 3) : item0;
        const int b = item >> 5, h = (item >> 2) & 7, sl = item & 3;
        f32x4 Cacc[5];
#pragma unroll
        for (int e = 0; e < 5; ++e) Cacc[e] = (f32x4){0.f, 0.f, 0.f, 0.f};
        __syncthreads();
        for (int i = tid; i < 2 * 80 * 128 / 8; i += 512) ((LAS v4u*)CT0)[i] = (v4u){0u, 0u, 0u, 0u};
        float m_prev = 0.f;
        v4u rp, rq[2], rk[2], rv; float rg0 = 0.f, rbl, rgm;
#define MLS_PREFETCH(cc) do { const int item2 = (b * 64 + (cc)) * 8 + h; const unsigned char* im = img + (size_t)item2 * IMGM_BYTES; const int row0_ = b * SEQ + (cc) * 64; \
            rp = *(const v4u*)(im + IMGM_P + tid * 16); rk[0] = *(const v4u*)(im + IMGM_KT + tid * 16); rk[1] = *(const v4u*)(im + IMGM_KT + (tid + 512) * 16); \
            rv = *(const v4u*)(P1 + (size_t)(row0_ + (tid >> 3)) * NQKV + 2048 + h * 256 + sl * 64 + (tid & 7) * 8); \
            _Pragma("unroll") for (int p = 0; p < 2; ++p) { const int idx = tid + 512 * p, r = idx >> 4, c8 = idx & 15; rq[p] = *(const v4u*)(P1 + (size_t)(row0_ + r) * NQKV + h * 128 + c8 * 8); } \
            const float* gs = (const float*)(im + IMGM_GS); if (tid < 128) rg0 = gs[tid]; rbl = gs[128]; rgm = gs[129]; } while (0)
#define MLS_STORE(bi) do { LAS unsigned char* bb = lds + (bi) * IB; \
            *(LAS v4u*)(bb + tid * 16) = rp; *(LAS v4u*)(bb + 8192 + 16384 + tid * 16) = rk[0]; *(LAS v4u*)(bb + 8192 + 16384 + (tid + 512) * 16) = rk[1]; \
            *(LAS v4u*)(bb + 8192 + 16384 + 16384 + off_v64(tid >> 3, tid & 7)) = rv; \
            _Pragma("unroll") for (int p = 0; p < 2; ++p) { const int idx = tid + 512 * p, r = idx >> 4, c8 = idx & 15; *(LAS v4u*)((LAS bf16*)(bb + 8192) + eoff<128>(r, c8 * 8)) = rq[p]; } \
            if (tid < 128) ((LAS float*)(bb + 8192 + 16384 + 16384 + 10240))[tid] = rg0; } while (0)
        MLS_PREFETCH(0); MLS_STORE(0);
        float blast = rbl, gmax = rgm;
        MLS_PREFETCH(1);
        __syncthreads();
        for (int c = 0; c < 64; ++c) {
            const int row0 = b * SEQ + c * 64;
            const LAS unsigned char* bb = lds + (c & 1) * IB;
            const LAS bf16* Ps = (const LAS bf16*)bb; const LAS bf16* Qs = (const LAS bf16*)(bb + 8192); const LAS bf16* KTs = (const LAS bf16*)(bb + 8192 + 16384);
            const LAS bf16* VTs = (const LAS bf16*)(bb + 8192 + 16384 + 16384); const LAS float* gsl = (const LAS float*)(bb + 8192 + 16384 + 16384 + 10240);
            LAS bf16* CTc = CT0 + (c & 1) * 80 * 128; LAS bf16* CTn = CT0 + ((c + 1) & 1) * 80 * 128;
            const int t = 16 * tt + r16;
            const float btv = gsl[t], alv = gsl[64 + t];
            const float mt = fmaxf(btv + m_prev, alv), al = __expf(alv - mt), be = __expf(btv + m_prev - mt), em = __expf(-mt);
            const float m_new = fmaxf(blast + m_prev, gmax), wcs = __expf(blast + m_prev - m_new), gam = __expf(gmax - m_new);
            m_prev = m_new;
            const LAS unsigned char* vb = (const LAS unsigned char*)VTs;
            bf16x8 onesf;
#pragma unroll
            for (int j = 0; j < 8; ++j) onesf[j] = (r16 == 0) ? (short)0x3f80 : (short)0;
            const bf16x8 pa0 = ldf<64>(Ps, 16 * tt + r16, g), pa1 = ldf<64>(Ps, 16 * tt + r16, 4 + g);
            f32x4 d1 = (f32x4){0.f, 0.f, 0.f, 0.f}, d2 = (f32x4){0.f, 0.f, 0.f, 0.f};
            d1 = mfma16(onesf, pa0, d1); d1 = mfma16(onesf, pa1, d1); mma_tile<128, 128, 4>(d2, CTc, 64, Qs, 16 * tt, lane);
            const float den = __shfl(al * d1[0] + be * d2[0], r16);
            const float dinv = __builtin_amdgcn_rcpf(fmaxf(fabsf(den), em));
#pragma unroll
            for (int q2 = 0; q2 < 2; ++q2) { const int et = 2 * eh + q2; f32x4 a1 = (f32x4){0.f, 0.f, 0.f, 0.f}, a2 = (f32x4){0.f, 0.f, 0.f, 0.f};
                a1 = mfma16(vfrag64(vb, et, 0, lane), pa0, a1); a1 = mfma16(vfrag64(vb, et, 1, lane), pa1, a1); mma_tile<128, 128, 4>(a2, CTc, 16 * et, Qs, 16 * tt, lane);
                const f32x4 o4 = (a1 * al + a2 * be) * dinv; v2u w; w.x = pk2(o4[0], o4[1]); w.y = pk2(o4[2], o4[3]);
                *(v2u*)(hraw + (size_t)(row0 + t) * DM + h * 256 + sl * 64 + 16 * et + 4 * g) = w; }
            const bf16x8 ka0 = ldf<64>(KTs, 16 * wave + r16, g), ka1 = ldf<64>(KTs, 16 * wave + r16, 4 + g);
#pragma unroll
            for (int et = 0; et < 5; ++et) { f32x4 tmp = (f32x4){0.f, 0.f, 0.f, 0.f};
                tmp = mfma16(ka0, et < 4 ? vfrag64(vb, et & 3, 0, lane) : onesf, tmp); tmp = mfma16(ka1, et < 4 ? vfrag64(vb, et & 3, 1, lane) : onesf, tmp);
                Cacc[et] = Cacc[et] * wcs + tmp * gam;
                v2u w; w.x = pk2(Cacc[et][0], Cacc[et][1]); w.y = pk2(Cacc[et][2], Cacc[et][3]);
                *(LAS v2u*)(CTn + eoff<128>(16 * et + r16, 16 * wave + 4 * g)) = w; }
            if (c + 1 < 64) { MLS_STORE((c + 1) & 1); blast = rbl; gmax = rgm; }
            if (c + 2 < 64) MLS_PREFETCH(c + 2);
            __syncthreads();
        }
#undef MLS_PREFETCH
#undef MLS_STORE
    }
}

DI void gla_pre(LAS unsigned char* lds, const bf16* P1, const float* G, const float* w_alpha, const float* b_alpha, unsigned char* img, int tid, int lane, int wave, int bx) {
    LAS bf16* VT = (LAS bf16*)lds;
    LAS bf16* QTs = (LAS bf16*)lds;
    LAS bf16* KTl = QTs + 64 * 256;
    LAS bf16* KTT = KTl + 64 * 256;
    LAS bf16* Ps = KTT + 256 * 64;
    LAS float* alow = (LAS float*)(Ps + 64 * 64);
    LAS float* T0 = alow + 1024;
    const int g = lane >> 4, r16 = lane & 15, d = tid & 255, sh = tid >> 8;
    for (int item = bx; item < 2048; item += gridDim.x) {
        const int b = item >> 8, c = (item >> 2) & 63, h = item & 3;
        const int row0 = b * SEQ + c * 64;
        unsigned char* im = img + (size_t)item * IMGG_BYTES;
        __syncthreads();
        float wa[16];
#pragma unroll
        for (int i = 0; i < 16; ++i) wa[i] = w_alpha[i * 1024 + h * 256 + d];
        const float ba = b_alpha[h * 256 + d];
        f32x4 al4 = (f32x4){0.f, 0.f, 0.f, 0.f};
        if (tid < 256) al4 = *(const f32x4*)(G + (size_t)(row0 + (tid >> 2)) * 16 + (tid & 3) * 4);
        if (tid < 256) *(LAS f32x4*)(alow + tid * 4) = al4;
        __syncthreads();
        const bf16* qsrc = P1 + (size_t)(row0 + 32 * sh) * NQKV + h * 256 + d;
        float bs[32]; float run = 0.f;
#pragma unroll
        for (int j = 0; j < 32; ++j) { const int s = 32 * sh + j; float z = ba;
#pragma unroll
            for (int i = 0; i < 16; ++i) z += alow[s * 16 + i] * wa[i];
            run += logsig_fast(z) * (1.0f / 16.0f); bs[j] = run; }
        if (sh == 0) T0[d] = run;
        __syncthreads();
        const float add = sh ? T0[d] : 0.f;
        if (sh) ((float*)(im + IMGG_EB))[d] = __expf(run + add);
#pragma unroll
        for (int q8 = 0; q8 < 4; ++q8) { unsigned kk[8];
#pragma unroll
            for (int j = 0; j < 8; ++j) { const int jj = 8 * q8 + j, s = 32 * sh + jj; const float bsum = bs[jj] + add;
                const float qv = bf2f(qsrc[(size_t)jj * NQKV]) * 0.0625f * __expf(bsum), kv = bf2f(qsrc[(size_t)jj * NQKV + 1024]) * __expf(-bsum);
                QTs[eoff<256>(s, d)] = (bf16)f2bf(qv); kk[j] = f2bf(kv); KTl[eoff<256>(s, d)] = (bf16)kk[j]; }
            v4u w; w.x = kk[0] | (kk[1] << 16); w.y = kk[2] | (kk[3] << 16); w.z = kk[4] | (kk[5] << 16); w.w = kk[6] | (kk[7] << 16);
            *(LAS v4u*)(KTT + eoff<64>(d, 32 * sh + 8 * q8)) = w; }
        __syncthreads();
        { const int tt = wave >> 1;
#pragma unroll
          for (int q2 = 0; q2 < 2; ++q2) { const int st = 2 * (wave & 1) + q2; f32x4 acc = (f32x4){0.f, 0.f, 0.f, 0.f};
            if (st <= tt) mma_tile<256, 256, 8>(acc, QTs, 16 * tt, KTl, 16 * st, lane);
            const int s = 16 * st + r16;
#pragma unroll
            for (int i = 0; i < 4; ++i) { const int t = 16 * tt + 4 * g + i; Ps[eoff<64>(t, s)] = (bf16)f2bf((s <= t) ? acc[i] : 0.f); } } }
        __syncthreads();
#pragma unroll
        for (int p = 0; p < 4; ++p) { *(v4u*)(im + IMGG_Q + (tid + 512 * p) * 16) = *(const LAS v4u*)((LAS unsigned char*)QTs + (tid + 512 * p) * 16);
                                      *(v4u*)(im + IMGG_KT + (tid + 512 * p) * 16) = *(const LAS v4u*)((LAS unsigned char*)KTT + (tid + 512 * p) * 16); }
        *(v4u*)(im + IMGG_P + tid * 16) = *(const LAS v4u*)((LAS unsigned char*)Ps + tid * 16);
    }
}

DI void gla_scan2(LAS unsigned char* lds, const bf16* P1, const unsigned char* img, bf16* hraw, int tid, int lane, int wave, int bx) {
    LAS bf16* QTs = (LAS bf16*)lds;
    LAS bf16* KTT = QTs + 64 * 256;
    LAS bf16* Ps = KTT + 256 * 64;
    LAS bf16* VTs = Ps + 64 * 64;
    LAS float* eb = (LAS float*)(VTs + 64 * 64);
    LAS bf16* ST0 = (LAS bf16*)(eb + 256);
    const int g = lane >> 4, r16 = lane & 15, tt = wave >> 1, eh = wave & 1;
    for (int item0 = bx; item0 < 256; item0 += gridDim.x) {
        const int item = (gridDim.x == 256) ? (item0 & 7) * 32 + (item0 >> 3) : item0;
        const int b = item >> 5, h = (item >> 3) & 3, sl = item & 7;
        f32x4 Sacc[2][4];
#pragma unroll
        for (int a = 0; a < 2; ++a)
#pragma unroll
            for (int e = 0; e < 4; ++e) Sacc[a][e] = (f32x4){0.f, 0.f, 0.f, 0.f};
        __syncthreads();
        for (int i = tid; i < 2 * 64 * 256 / 8; i += 512) ((LAS v4u*)ST0)[i] = (v4u){0u, 0u, 0u, 0u};
        v4u rq[4], rk[4], rp, rv; float re = 0.f;
#define GLS_PREFETCH(cc) do { const int item2 = (b * 64 + (cc)) * 4 + h; const unsigned char* im = img + (size_t)item2 * IMGG_BYTES; \
            _Pragma("unroll") for (int p = 0; p < 4; ++p) { rq[p] = *(const v4u*)(im + IMGG_Q + (tid + 512 * p) * 16); rk[p] = *(const v4u*)(im + IMGG_KT + (tid + 512 * p) * 16); } \
            rp = *(const v4u*)(im + IMGG_P + tid * 16); rv = *(const v4u*)(P1 + ((size_t)b * SEQ + (cc) * 64 + (tid >> 3)) * NQKV + 2048 + h * 512 + sl * 64 + (tid & 7) * 8); if (tid < 256) re = ((const float*)(im + IMGG_EB))[tid]; } while (0)
        GLS_PREFETCH(0);
        for (int c = 0; c < 64; ++c) {
            const int row0 = b * SEQ + c * 64;
            LAS bf16* STc = ST0 + (c & 1) * 64 * 256; LAS bf16* STn = ST0 + ((c + 1) & 1) * 64 * 256;
            __syncthreads();
#pragma unroll
            for (int p = 0; p < 4; ++p) { *(LAS v4u*)((LAS unsigned char*)QTs + (tid + 512 * p) * 16) = rq[p]; *(LAS v4u*)((LAS unsigned char*)KTT + (tid + 512 * p) * 16) = rk[p]; }
            *(LAS v4u*)((LAS unsigned char*)Ps + tid * 16) = rp; *(LAS v4u*)((LAS unsigned char*)VTs + off_v64(tid >> 3, tid & 7)) = rv;
            if (tid < 256) eb[tid] = re;
            __syncthreads();
            if (c + 1 < 64) GLS_PREFETCH(c + 1);
            const LAS unsigned char* vb = (const LAS unsigned char*)VTs;
            const bf16x8 pa0 = ldf<64>(Ps, 16 * tt + r16, g), pa1 = ldf<64>(Ps, 16 * tt + r16, 4 + g);
#pragma unroll
            for (int q2 = 0; q2 < 2; ++q2) { const int et = 2 * eh + q2; f32x4 acc = (f32x4){0.f, 0.f, 0.f, 0.f};
                acc = mfma16(vfrag64(vb, et, 0, lane), pa0, acc); acc = mfma16(vfrag64(vb, et, 1, lane), pa1, acc); mma_tile<256, 256, 8>(acc, STc, 16 * et, QTs, 16 * tt, lane);
                v2u w; w.x = pk2_sw(acc[0], acc[1]); w.y = pk2_sw(acc[2], acc[3]);
                *(v2u*)(hraw + (size_t)(row0 + 16 * tt + r16) * DM + h * 512 + sl * 64 + 16 * et + 4 * g) = w; }
#pragma unroll
            for (int a = 0; a < 2; ++a) { const int dt = 2 * wave + a;
                const f32x4 ev = *(const LAS f32x4*)(eb + 16 * dt + 4 * g);
                const bf16x8 ka0 = ldf<64>(KTT, 16 * dt + r16, g), ka1 = ldf<64>(KTT, 16 * dt + r16, 4 + g);
#pragma unroll
                for (int et = 0; et < 4; ++et) { Sacc[a][et] = mfma16(ka0, vfrag64(vb, et, 0, lane), Sacc[a][et]); Sacc[a][et] = mfma16(ka1, vfrag64(vb, et, 1, lane), Sacc[a][et]); Sacc[a][et] = Sacc[a][et] * ev;
                    v2u w; w.x = pk2(Sacc[a][et][0], Sacc[a][et][1]); w.y = pk2(Sacc[a][et][2], Sacc[a][et][3]);
                    *(LAS v2u*)(STn + eoff<256>(16 * et + r16, 16 * dt + 4 * g)) = w; } }
        }
#undef GLS_PREFETCH
    }
}


DI void mixer_gates(const bf16* hb, const bf16* wg, const long long* ss, float* G, int lane, int wave, int bx) {
    const int g = lane >> 4, r16 = lane & 15;
    for (int t = bx * NWAVES + wave; t < MTOK / 16; t += gridDim.x * NWAVES) {
        const bf16* ap = hb + (size_t)(16 * t + r16) * DM + 8 * g; const bf16* bp = wg + (size_t)r16 * DM + 8 * g;
        f32x4 acc = (f32x4){0.f, 0.f, 0.f, 0.f};
#pragma unroll 8
        for (int kk = 0; kk < DM / 32; ++kk) { const bf16x8 a = *(const bf16x8*)(ap + 32 * kk), b = *(const bf16x8*)(bp + 32 * kk); acc = mfma16(a, b, acc); }
#pragma unroll
        for (int i = 0; i < 4; ++i) { const int row = 16 * t + 4 * g + i; G[(size_t)row * 16 + r16] = acc[i] * pg8::rstd_of(ss, row); }
    }
}

template <int HS, int ACT> DI void headnorm_gate(const bf16* hraw, const bf16* P1, const float* gnorm, bf16* hm, int lane, int wave, int bx) {
    constexpr int NH = DM / HS, EPL = HS / 64;
    const int gw = bx * NWAVES + wave, NGW = gridDim.x * NWAVES;
    for (int row = gw; row < MTOK; row += NGW) {
#pragma unroll
        for (int hh = 0; hh < NH; ++hh) { const int col = hh * HS + lane * EPL;
            unsigned xw[EPL / 2], gwd[EPL / 2];
            if constexpr (EPL == 4) { const v2u a = *(const v2u*)(hraw + (size_t)row * DM + col), b2 = *(const v2u*)(P1 + (size_t)row * NQKV + 4096 + col); xw[0] = a.x; xw[1] = a.y; gwd[0] = b2.x; gwd[1] = b2.y; }
            else { const v4u a = *(const v4u*)(hraw + (size_t)row * DM + col), b2 = *(const v4u*)(P1 + (size_t)row * NQKV + 4096 + col); xw[0] = a.x; xw[1] = a.y; xw[2] = a.z; xw[3] = a.w; gwd[0] = b2.x; gwd[1] = b2.y; gwd[2] = b2.z; gwd[3] = b2.w; }
            float s = 0.f;
#pragma unroll
            for (int j = 0; j < EPL / 2; ++j) { const float x0 = bflo(xw[j]), x1 = bfhi(xw[j]); s += x0 * x0 + x1 * x1; }
            s = wave_sum(s); const float rs = rsqrtf(s * (1.0f / HS) + 1e-6f);
            unsigned outw[EPL / 2];
#pragma unroll
            for (int j = 0; j < EPL / 2; ++j) { const float g0 = bflo(gwd[j]), g1 = bfhi(gwd[j]);
                const float a0 = ACT == 0 ? __builtin_amdgcn_rcpf(1.0f + __expf(-g0)) : g0 * __builtin_amdgcn_rcpf(1.0f + __expf(-g0)), a1 = ACT == 0 ? __builtin_amdgcn_rcpf(1.0f + __expf(-g1)) : g1 * __builtin_amdgcn_rcpf(1.0f + __expf(-g1));
                outw[j] = pk2(bflo(xw[j]) * rs * gnorm[col + 2 * j] * a0, bfhi(xw[j]) * rs * gnorm[col + 2 * j + 1] * a1); }
            if constexpr (EPL == 4) { v2u w; w.x = outw[0]; w.y = outw[1]; *(v2u*)(hm + (size_t)row * DM + col) = w; }
            else { v4u w; w.x = outw[0]; w.y = outw[1]; w.z = outw[2]; w.w = outw[3]; *(v4u*)(hm + (size_t)row * DM + col) = w; }
        }
    }
}

DI void fox_cf(LAS unsigned char* lds, const float* G, const float* b_f, float* cf, int tid, int lane, int wave, int bx) {
    LAS float* wt = (LAS float*)lds;
    for (int item = bx; item < 256; item += gridDim.x) { const int seq = item >> 1, hf = item & 1, b = seq >> 4, h = seq & 15; const float bias = b_f[h];
        const float* gp = G + ((size_t)b * SEQ + hf * 2048 + tid * 4) * 16 + h;
        float ls[4]; float s = 0.f, s0 = 0.f;
#pragma unroll
        for (int p = 0; p < 4; ++p) { ls[p] = logsig(gp[p * 16] + bias); s += ls[p]; }
        if (hf) { const float* g0 = gp - (size_t)2048 * 16;
#pragma unroll
            for (int p = 0; p < 4; ++p) s0 += logsig(g0[p * 16] + bias); }
        const float incl = wave_incl_sum(s, lane), tot0 = wave_sum(s0);
        __syncthreads();
        if (lane == 63) wt[wave] = incl; if (lane == 0) wt[8 + wave] = tot0;
        __syncthreads();
        float base = 0.f;
#pragma unroll
        for (int w = 0; w < 8; ++w) { base += (w < wave) ? wt[w] : 0.f; base += wt[8 + w]; }
        float run = base + incl - s;
        float* o = cf + (size_t)seq * SEQ + hf * 2048 + tid * 4; f32x4 ov;
        run += ls[0]; ov.x = run; run += ls[1]; ov.y = run; run += ls[2]; ov.z = run; run += ls[3]; ov.w = run;
        *(f32x4*)o = ov;
    }
}

DI unsigned off_v(unsigned row, unsigned ch) { return 256u * row + 16u * (ch ^ (((row & 3u) << 2) | (((row >> 2) & 1u) << 1))); }

DI void fox_attn2(LAS unsigned char* lds, const bf16* P1, const float* cf, bf16* hm, int tid, int lane, int wave, int bx) {
    constexpr int BUFB = 16384 + 16384 + 256;
    const float LOG2E = 1.4426950408889634f, QS = 0.08838834764831845f * 1.4426950408889634f, THR = 8.0f;
    const int g = lane >> 4, r16 = lane & 15;
    const int G_ = gridDim.x;
    const int nit = (2048 + G_ - 1) / G_;
    for (int it = 0; it < nit; ++it) {
        const int u = (it & 1) ? it * G_ + (G_ - 1 - bx) : it * G_ + bx;
        if (u >= 2048) continue;
        const int qb = 15 - (u >> 7), bh = u & 127, b = bh >> 4, h = bh & 15;
        const size_t rowb = (size_t)b * SEQ; const int q0 = qb * 256 + 32 * wave;
        bf16x8 qf[2][4]; float c0[2];
#pragma unroll
        for (int tt = 0; tt < 2; ++tt) { const int t = q0 + 16 * tt + r16; c0[tt] = cf[(size_t)bh * SEQ + t] * LOG2E;
#pragma unroll
            for (int kk = 0; kk < 4; ++kk) { const v4u raw = *(const v4u*)(P1 + (rowb + t) * NQKV + h * 128 + 32 * kk + 8 * g); v4u sc;
#pragma unroll
                for (int j = 0; j < 4; ++j) sc[j] = pk2(bflo(raw[j]) * QS, bfhi(raw[j]) * QS);
                qf[tt][kk] = __builtin_bit_cast(bf16x8, sc); } }
        f32x4 oacc[8][2];
#pragma unroll
        for (int et = 0; et < 8; ++et) { oacc[et][0] = (f32x4){0.f, 0.f, 0.f, 0.f}; oacc[et][1] = (f32x4){0.f, 0.f, 0.f, 0.f}; }
        float lrun[2] = {0.f, 0.f};
        const int ntiles = 4 * (qb + 1);
        v4u kreg[2], vreg[2]; float cfreg = 0.f;
        const bf16* kbase = P1 + rowb * NQKV + 2048 + h * 128;
#define FOX_LOAD(j) do { _Pragma("unroll") for (int p = 0; p < 2; ++p) { const int idx = tid + 512 * p, r = idx >> 4, c8 = idx & 15; \
            kreg[p] = *(const v4u*)(kbase + (size_t)(64 * (j) + r) * NQKV + c8 * 8); vreg[p] = *(const v4u*)(kbase + (size_t)(64 * (j) + r) * NQKV + 2048 + c8 * 8); } \
            if (tid < 64) cfreg = -cf[(size_t)bh * SEQ + 64 * (j) + tid] * LOG2E; } while (0)
#define FOX_STORE(bufi) do { LAS unsigned char* bb = lds + (bufi) * BUFB; _Pragma("unroll") for (int p = 0; p < 2; ++p) { const int idx = tid + 512 * p, r = idx >> 4, c8 = idx & 15; \
            *(LAS v4u*)((LAS bf16*)bb + eoff<128>(r, c8 * 8)) = kreg[p]; *(LAS v4u*)(bb + 16384 + off_v(r, c8)) = vreg[p]; } \
            if (tid < 64) ((LAS float*)(bb + 32768))[tid] = cfreg; } while (0)
        __syncthreads();
        FOX_LOAD(0); FOX_STORE(0);
        if (ntiles > 1) FOX_LOAD(1);
        __syncthreads();
        for (int j = 0; j < ntiles; ++j) {
            if (j + 1 < ntiles) FOX_STORE((j + 1) & 1);
            if (j + 2 < ntiles) FOX_LOAD(j + 2);
            if (64 * j <= q0 + 31) {
                const LAS bf16* Ks = (const LAS bf16*)(lds + (j & 1) * BUFB); const LAS bf16* VTs = Ks + 64 * 128; const LAS float* cfs = (const LAS float*)(VTs + 128 * 64);
                f32x4 sacc[2][4];
#pragma unroll
                for (int st = 0; st < 4; ++st) { const f32x4 cv = *(const LAS f32x4*)(cfs + 16 * st + 4 * g);
#pragma unroll
                    for (int tt = 0; tt < 2; ++tt) sacc[tt][st] = cv + c0[tt]; }
#pragma unroll
                for (int st = 0; st < 4; ++st)
#pragma unroll
                    for (int kk = 0; kk < 4; ++kk) { const bf16x8 kf = ldf<128>(Ks, 16 * st + r16, 4 * kk + g);
                        sacc[0][st] = mfma16(kf, qf[0][kk], sacc[0][st]); sacc[1][st] = mfma16(kf, qf[1][kk], sacc[1][st]); if (kk == 3) asm volatile("" ::: "memory"); }
                if (64 * j + 63 > q0) {
#pragma unroll
                    for (int tt = 0; tt < 2; ++tt) { const int t = q0 + 16 * tt + r16;
#pragma unroll
                        for (int st = 0; st < 4; ++st)
#pragma unroll
                            for (int i = 0; i < 4; ++i) { const int s = 64 * j + 16 * st + 4 * g + i; if (s > t) sacc[tt][st][i] = -__builtin_inff(); } }
                }
                float mx[2];
#pragma unroll
                for (int tt = 0; tt < 2; ++tt) { float m = -__builtin_inff();
#pragma unroll
                    for (int st = 0; st < 4; ++st) m = fmaxf(m, fmaxf(fmaxf(sacc[tt][st][0], sacc[tt][st][1]), fmaxf(sacc[tt][st][2], sacc[tt][st][3])));
                    m = fmaxf(m, __shfl_xor(m, 16)); m = fmaxf(m, __shfl_xor(m, 32)); mx[tt] = m; }
                if (__any(mx[0] > THR || mx[1] > THR)) {
#pragma unroll
                    for (int tt = 0; tt < 2; ++tt) { const float sh = fmaxf(mx[tt], 0.f), f = __builtin_amdgcn_exp2f(-sh);
                        c0[tt] -= sh; lrun[tt] *= f;
#pragma unroll
                        for (int st = 0; st < 4; ++st) sacc[tt][st] = sacc[tt][st] - sh;
#pragma unroll
                        for (int et = 0; et < 8; ++et) oacc[et][tt] = oacc[et][tt] * f; }
                }
#pragma unroll
                for (int tt = 0; tt < 2; ++tt) { float ls = 0.f;
#pragma unroll
                    for (int st = 0; st < 4; ++st)
#pragma unroll
                        for (int i = 0; i < 4; ++i) { const float p = __builtin_amdgcn_exp2f(sacc[tt][st][i]); sacc[tt][st][i] = p; ls += p; }
                    lrun[tt] += ls; }
#pragma unroll
                for (int ks = 0; ks < 2; ++ks) { bf16x8 pb[2];
#pragma unroll
                    for (int tt = 0; tt < 2; ++tt) { v4u w; w.x = pk2(sacc[tt][2 * ks][0], sacc[tt][2 * ks][1]); w.y = pk2(sacc[tt][2 * ks][2], sacc[tt][2 * ks][3]);
                        w.z = pk2(sacc[tt][2 * ks + 1][0], sacc[tt][2 * ks + 1][1]); w.w = pk2(sacc[tt][2 * ks + 1][2], sacc[tt][2 * ks + 1][3]); pb[tt] = __builtin_bit_cast(bf16x8, w); }
#pragma unroll
                    for (int et = 0; et < 8; ++et) {
                        const LAS unsigned char* vb = (const LAS unsigned char*)VTs;
                        const v4i16_t lo = tr_read(vb + off_v(32 * ks + 4 * g + (r16 >> 2), 2 * et + ((lane & 3) >> 1)) + 8 * (lane & 1));
                        const v4i16_t hi = tr_read(vb + off_v(32 * ks + 16 + 4 * g + (r16 >> 2), 2 * et + ((lane & 3) >> 1)) + 8 * (lane & 1));
                        bf16x8 va; va[0] = lo[0]; va[1] = lo[1]; va[2] = lo[2]; va[3] = lo[3]; va[4] = hi[0]; va[5] = hi[1]; va[6] = hi[2]; va[7] = hi[3];
                        oacc[et][0] = mfma16(va, pb[0], oacc[et][0]); oacc[et][1] = mfma16(va, pb[1], oacc[et][1]); if (et & 1) asm volatile("" ::: "memory"); } }
            }
            __syncthreads();
        }
#undef FOX_LOAD
#undef FOX_STORE
#pragma unroll
        for (int tt = 0; tt < 2; ++tt) { float l = lrun[tt]; l += __shfl_xor(l, 16); l += __shfl_xor(l, 32); const float inv = 1.0f / l;
            bf16* orow = hm + (rowb + q0 + 16 * tt + r16) * DM + h * 128 + 4 * g;
#pragma unroll
            for (int et = 0; et < 8; ++et) { v2u w; w.x = pk2(oacc[et][tt][0] * inv, oacc[et][tt][1] * inv); w.y = pk2(oacc[et][tt][2] * inv, oacc[et][tt][3] * inv); *(v2u*)(orow + 16 * et) = w; } }
    }
}


DI void final_norm(float* out, const long long* ss, const float* gfin, int lane, int wave, int bx) {
    const int gw = bx * NWAVES + wave, NGW = gridDim.x * NWAVES;
    for (int m = gw; m < MTOK; m += NGW) { const float rs = pg8::rstd_of(ss, m);
        f32x4* xr = (f32x4*)(out + (size_t)m * DM) + lane; const f32x4* gr = (const f32x4*)gfin + lane;
#pragma unroll
        for (int j = 0; j < 8; ++j) { const f32x4 v = xr[64 * j], gg = gr[64 * j]; xr[64 * j] = v * rs * gg; } }
}

#define PH(p) if (lo <= (p) && (p) < hi && (ran ? (xcd_barrier(bar), true) : (ran = true)))
#define TID() int tid = threadIdx.x; asm volatile("" : "+v"(tid)); const int lane = tid & 63, wave = __builtin_amdgcn_readfirstlane(tid >> 6); int bx = blockIdx.x; asm volatile("" : "+s"(bx)); (void)lane; (void)wave; (void)bx
#define WSP(T, off) ((T*)(ka->ws + (off)))
template <int j> DI void subblock(LAS unsigned char* lds, const XcdBarrier& bar, const int lo, const int hi, bool& ran) {
    {
        constexpr int layer = j / 3, typ = j - 3 * layer, base = 1 + 5 * j;
        if constexpr (typ != 1) {
            PH(base) { TID(); KArgs ka = kargs(); const int mi = layer * 2 + (typ >> 1);
                pg8::Gemm gm{WSP(bf16, WS_HB), WSP(bf16, WS_WUP) + (size_t)mi * NUP * DM, MTOK, NUP, DM}; pg8::StaticOrder S; S.init(MTOK, NUP, gridDim.x, bx);
                pg8::EpiSwiGLU E{WSP(bf16, WS_ACT), WSP(long long, WS_SS) + (size_t)j * MTOK, DFF};
                pg8::gemm_phase<pg8::EpiSwiGLU, pg8::StaticOrder, PG8_ALIGN, PG8_SP2>(lds, gm, S, E); }
        } else {
            constexpr int kind = layer % 3, ji = layer / 3;
            PH(base) { TID(); KArgs ka = kargs();
                mixer_gates(WSP(bf16, WS_HB), WSP(bf16, WS_WIN) + ((size_t)layer * NINP + NQKV) * DM, WSP(long long, WS_SS) + (size_t)j * MTOK, WSP(float, WS_G), lane, wave, bx);
                pg8::Gemm gm{WSP(bf16, WS_HB), WSP(bf16, WS_WIN) + (size_t)layer * NINP * DM, MTOK, NQKV, DM}; pg8::StaticOrder S; S.init(MTOK, NQKV, gridDim.x, bx);
                pg8::EpiMixIn E{WSP(bf16, WS_P1), WSP(long long, WS_SS) + (size_t)j * MTOK};
                pg8::gemm_phase<pg8::EpiMixIn, pg8::StaticOrder, PG8_ALIGN, PG8_SP2>(lds, gm, S, E); }
            PH(base + 1) { TID(); KArgs ka = kargs();
                if constexpr (kind == 0) for (int rep = 0; rep < REP_MLSTM; ++rep) mlstm_pre(lds, WSP(bf16, WS_P1), WSP(float, WS_G), ka->in[6] + ji * 16, WSP(unsigned char, WS_ACT), tid, lane, wave, bx);
                else if constexpr (kind == 1) { fox_cf(lds, WSP(float, WS_G), ka->in[10] + ji * 16, WSP(float, WS_CF), tid, lane, wave, bx); }
                else for (int rep = 0; rep < REP_GLA; ++rep) gla_pre(lds, WSP(bf16, WS_P1), WSP(float, WS_G), ka->in[13] + (size_t)ji * 16 * 1024, ka->in[14] + ji * 1024, WSP(unsigned char, WS_ACT), tid, lane, wave, bx);
            }
            PH(base + 2) { TID(); KArgs ka = kargs();
                if constexpr (kind == 0) for (int rep = 0; rep < REP_MLSTM; ++rep) mlstm_scan2(lds, WSP(bf16, WS_P1), WSP(unsigned char, WS_ACT), WSP(bf16, WS_HRAW), tid, lane, wave, bx);
                else if constexpr (kind == 1) for (int rep = 0; rep < REP_FOX; ++rep) fox_attn2(lds, WSP(bf16, WS_P1), WSP(float, WS_CF), WSP(bf16, WS_HM), tid, lane, wave, bx);
                else for (int rep = 0; rep < REP_GLA; ++rep) gla_scan2(lds, WSP(bf16, WS_P1), WSP(unsigned char, WS_ACT), WSP(bf16, WS_HRAW), tid, lane, wave, bx);
            }
            if constexpr (kind != 1) { PH(base + 3) { TID(); KArgs ka = kargs();
                if constexpr (kind == 0) headnorm_gate<256, 0>(WSP(bf16, WS_HRAW), WSP(bf16, WS_P1), ka->in[7] + ji * DM, WSP(bf16, WS_HM), lane, wave, bx);
                else headnorm_gate<512, 1>(WSP(bf16, WS_HRAW), WSP(bf16, WS_P1), ka->in[15] + ji * DM, WSP(bf16, WS_HM), lane, wave, bx);
            } }
        }
        PH(base + 4) { TID(); KArgs ka = kargs();
            pg8::Gemm gm; float scale;
            if constexpr (typ != 1) { const int mi = layer * 2 + (typ >> 1); gm = pg8::Gemm{WSP(bf16, WS_ACT), WSP(bf16, WS_WDN) + (size_t)mi * DM * DFF, MTOK, DM, DFF}; scale = 0.5f; }
            else { gm = pg8::Gemm{WSP(bf16, WS_HM), WSP(bf16, WS_WOUT) + (size_t)layer * DM * DM, MTOK, DM, DM}; scale = 1.0f; }
            pg8::StaticOrder S; S.init(MTOK, DM, gridDim.x, bx);
            pg8::EpiResid E{(j == 0) ? ka->in[0] : (const float*)ka->out, ka->out, WSP(bf16, WS_HB), WSP(long long, WS_SS) + (size_t)(j + 1) * MTOK, scale};
            pg8::gemm_phase<pg8::EpiResid, pg8::StaticOrder, PG8_ALIGN, PG8_SP2>(lds, gm, S, E);
        }
    }
}

__global__ void __launch_bounds__(NWAVES * 64, 2) trunk_fwd(Args args) {
    extern __shared__ __attribute__((aligned(16))) unsigned char lds_raw[];
    LAS unsigned char* lds = (LAS unsigned char*)lds_raw;
    volatile LAS unsigned* MISC = (volatile LAS unsigned*)(lds + MISC_OFF);
    for (int u = threadIdx.x; u < (LDS_BYTES - MISC_OFF) / 4; u += NWAVES * 64) ((LAS unsigned*)(lds + MISC_OFF))[u] = 0u;
    __syncthreads();
    XcdBarrier bar = xcd_barrier_post((unsigned*)(args.ws + WS_CTL) + CW_BAR, MISC + 8);
    const int lo = args.ph_lo, hi = args.ph_hi; bool ran = false;

    PH(0) { TID(); for (int rep = 0; rep < REP_PRO; ++rep) { prologue(lds, lane, wave, bx); __syncthreads(); } }

    subblock<0>(lds, bar, lo, hi, ran); subblock<1>(lds, bar, lo, hi, ran); subblock<2>(lds, bar, lo, hi, ran); subblock<3>(lds, bar, lo, hi, ran);
    subblock<4>(lds, bar, lo, hi, ran); subblock<5>(lds, bar, lo, hi, ran); subblock<6>(lds, bar, lo, hi, ran); subblock<7>(lds, bar, lo, hi, ran);
    subblock<8>(lds, bar, lo, hi, ran); subblock<9>(lds, bar, lo, hi, ran); subblock<10>(lds, bar, lo, hi, ran); subblock<11>(lds, bar, lo, hi, ran);
    PH(NPHASE - 1) { TID(); KArgs ka = kargs(); final_norm(ka->out, WSP(long long, WS_SS) + (size_t)NSUB * MTOK, ka->in[17], lane, wave, bx); }
#undef WSP
#undef PH
}

static bool phase_exists(int p) {
    if (p == 0 || p == NPHASE - 1) return true;
    const int j = (p - 1) / 5, k = (p - 1) % 5, typ = j % 3;
    if (k == 0 || k == 4) return true;
    if (typ != 1) return false;
    if (k == 3) return ((j / 3) % 3) != 1;
    return true;
}
extern "C" void kernel_launch(void* const* d_in, const int* in_sizes, int n_in, void* d_out, int out_size, void* d_ws, size_t ws_size, hipStream_t stream) {
    static int grid = 0;
    if (grid == 0) {
        if (n_in != 18 || in_sizes[0] != MTOK * DM || out_size != MTOK * DM || ws_size < WS_END) { fprintf(stderr, "kernel_launch: unexpected shapes (n_in %d, in0 %d, out %d, ws %zu < %zu)\n", n_in, n_in > 0 ? in_sizes[0] : -1, out_size, ws_size, (size_t)WS_END); grid = -1; return; }
        int dev = 0, cus = 0, per_cu = 0;
        if (hipGetDevice(&dev) != hipSuccess || hipDeviceGetAttribute(&cus, hipDeviceAttributeMultiprocessorCount, dev) != hipSuccess) { grid = -1; return; }
        if (hipFuncSetAttribute((const void*)trunk_fwd, hipFuncAttributeMaxDynamicSharedMemorySize, LDS_BYTES) != hipSuccess) { fprintf(stderr, "kernel_launch: hipFuncSetAttribute failed\n"); grid = -1; return; }
        if (hipOccupancyMaxActiveBlocksPerMultiprocessor(&per_cu, (const void*)trunk_fwd, NWAVES * 64, LDS_BYTES) != hipSuccess || per_cu < 1) fprintf(stderr, "kernel_launch: occupancy query says %d\n", per_cu);
        (void)hipGetLastError();
        grid = cus;
    }
    if (grid < 0) return;
    if (hipMemsetAsync((char*)d_ws + WS_CTL, 0, CTL_ZERO_BYTES, stream) != hipSuccess) return;
    Args a{};
    for (int i = 0; i < 18; ++i) a.in[i] = (const float*)d_in[i];
    a.out = (float*)d_out; a.ws = (unsigned char*)d_ws;
#if MK_PER_PHASE
    for (int p = 0; p < NPHASE; ++p) { if (!phase_exists(p)) continue; a.ph_lo = p; a.ph_hi = p + 1; hipLaunchKernelGGL(trunk_fwd, dim3(grid), dim3(NWAVES * 64), LDS_BYTES, stream, a); }
#else
    a.ph_lo = 0; a.ph_hi = NPHASE; hipLaunchKernelGGL(trunk_fwd, dim3(grid), dim3(NWAVES * 64), LDS_BYTES, stream, a);
#endif
    (void)phase_exists;
}
```

```cpp
#include <hip/hip_runtime.h>
#include <cstdio>
#include <cstdint>
namespace pg8 {
#define PG8_LAS __attribute__((address_space(3)))
typedef unsigned short bf16_t;
typedef short bf16x8 __attribute__((ext_vector_type(8)));
typedef float f32x4 __attribute__((ext_vector_type(4)));
typedef unsigned u32x4 __attribute__((ext_vector_type(4)));
constexpr int BM = 256, BK = 64, HALF = 128, HTB = HALF * BK * 2  , STAGE_BYTES = 8 * HTB, NXCD = 8, WGM = 8;

__host__ __device__ __forceinline__ int lds_byte(int r, int c) { const int st = (r >> 4) * 2 + (c >> 5), rr = r & 15, cc = c & 31, ob = rr * 64 + cc * 2; return st * 1024 + (ob ^ (((ob >> 9) & 1) << 5)); }
__host__ __device__ __forceinline__ void stage_rc(int b, int& R, int& C) { const int st = b / 1024, sb = b % 1024, swz = sb ^ (((sb >> 9) & 1) << 5); R = (st >> 1) * 16 + swz / 64; C = (st & 1) * 32 + (swz % 64) / 2; }
__host__ __device__ __forceinline__ int perm32(int rho) { const int n = rho >> 4, i = rho & 15; return 8 * (i >> 2) + 4 * n + (i & 3); }

struct Unit { int pm, pn; };
struct Gemm { const bf16_t* A; const bf16_t* Bt; int M, N, K; };

struct StaticOrder {
    int nM, nN, nwg, G, c;
    __host__ __device__ void init(int M, int N, int G_, int c_) { nM = M / BM; nN = N / BM; nwg = nM * nN; G = G_; c = c_; }
    __host__ __device__ bool next(int i, Unit& u) const {
        const long L = (long)i * G + c; if (L >= nwg) return false;
        int wgid = (int)L; { const int q = nwg / NXCD, r = nwg % NXCD, xcd = wgid % NXCD, off = wgid / NXCD; wgid = (xcd < r ? xcd * (q + 1) : r * (q + 1) + (xcd - r) * q) + off; }
        const int nig = WGM * nN, gid = wgid / nig, fm = gid * WGM, gsz = (nM - fm) < WGM ? (nM - fm) : WGM;
        u.pm = fm + ((wgid % nig) % gsz); u.pn = (wgid % nig) / gsz; return true;
    }
    __device__ __forceinline__ void a_ready(const Unit&) const {}
    __device__ __forceinline__ void done(const Unit&) const {}
};

__device__ __forceinline__ unsigned cvt_pk_bf16(float lo, float hi) { unsigned r; asm volatile("v_cvt_pk_bf16_f32 %0, %1, %2" : "=v"(r) : "v"(lo), "v"(hi)); return r; }
constexpr float RMS_EPS_F = 1e-6f, SS_FIX = 1048576.0f, SS_UNFIX_D = 1.0f / (1048576.0f * 2048.0f);
typedef long long ss_t;
__device__ __forceinline__ float rstd_of(const ss_t* ss, int row) { return rsqrtf((float)ss[row] * SS_UNFIX_D + RMS_EPS_F); }
template <class Sched> __device__ __forceinline__ int rstd_table_fill(const Sched& S, const ss_t* ss, PG8_LAS unsigned char* ext, int tid) {
    PG8_LAS float* tab = (PG8_LAS float*)ext; int key0 = -1, key1 = -1, bad = 0; Unit u;
    for (int i = 0; S.next(i, u); ++i) { const int slot = (u.pm >> 3) & 1; const int key = slot ? key1 : key0;
        if (key == u.pm) continue;
        if (key >= 0) { bad = 1; continue; }
        if (slot) key1 = u.pm; else key0 = u.pm;
        if (tid < 256) tab[slot * 256 + tid] = rstd_of(ss, u.pm * BM + tid); }
    asm volatile("s_waitcnt lgkmcnt(0)" ::: "memory"); __builtin_amdgcn_s_barrier(); asm volatile("" ::: "memory");
    return bad;
}
__device__ __forceinline__ float rstd_get(const ss_t* ss, const Unit& u, int row, int pf, const PG8_LAS unsigned char* ext) {
    return pf ? rstd_of(ss, row) : ((const PG8_LAS float*)ext)[((u.pm >> 3) & 1) * 256 + (row - u.pm * BM)];
}
struct EpiSwiGLU {
    static constexpr bool PERM = true, AFTER_DRAIN = false;
    bf16_t* O; const ss_t* ss; int ldo;
    template <class Sched> __device__ __forceinline__ int prepare(const Sched& S, PG8_LAS unsigned char* ext, int tid) const { return rstd_table_fill(S, ss, ext, tid); }
    __device__ __forceinline__ void operator()(const f32x4 (&acc)[2][2][4][2], const Unit& u, int wr, int wc, int fr, int fq, int pf, const PG8_LAS unsigned char* ext) const {
        const int row0 = u.pm * BM + wr * 64 + fr, col0 = u.pn * HALF + wc * 32 + 8 * fq;
#pragma unroll
        for (int ai = 0; ai < 2; ++ai)
#pragma unroll
            for (int m = 0; m < 4; ++m) {
                const int row = row0 + ai * HALF + m * 16;
                const float rs = rstd_get(ss, u, row, pf, ext);
                float o[8];
#pragma unroll
                for (int n = 0; n < 2; ++n)
#pragma unroll
                    for (int j = 0; j < 4; ++j) { const float a = acc[ai][0][m][n][j] * rs, b = acc[ai][1][m][n][j] * rs;
                        o[4 * n + j] = a * b * __builtin_amdgcn_rcpf(1.0f + __expf(-a)); }
                u32x4 w; w.x = cvt_pk_bf16(o[0], o[1]); w.y = cvt_pk_bf16(o[2], o[3]); w.z = cvt_pk_bf16(o[4], o[5]); w.w = cvt_pk_bf16(o[6], o[7]);
                *(u32x4*)(O + (size_t)row * ldo + col0) = w;
            }
    }
};
struct EpiMixIn {
    static constexpr bool PERM = true, AFTER_DRAIN = false;
    bf16_t* O; const ss_t* ss;
    template <class Sched> __device__ __forceinline__ int prepare(const Sched& S, PG8_LAS unsigned char* ext, int tid) const { return rstd_table_fill(S, ss, ext, tid); }
    __device__ __forceinline__ void operator()(const f32x4 (&acc)[2][2][4][2], const Unit& u, int wr, int wc, int fr, int fq, int pf, const PG8_LAS unsigned char* ext) const {
        const int row0 = u.pm * BM + wr * 64 + fr, col0 = u.pn * BM + wc * 32 + 8 * fq;
#pragma unroll
        for (int ai = 0; ai < 2; ++ai)
#pragma unroll
            for (int m = 0; m < 4; ++m) {
                const int row = row0 + ai * HALF + m * 16;
                const float rs = rstd_get(ss, u, row, pf, ext);
#pragma unroll
                for (int bj = 0; bj < 2; ++bj) { const f32x4 v0 = acc[ai][bj][m][0] * rs, v1 = acc[ai][bj][m][1] * rs;
                    u32x4 w; w.x = cvt_pk_bf16(v0[0], v0[1]); w.y = cvt_pk_bf16(v0[2], v0[3]); w.z = cvt_pk_bf16(v1[0], v1[1]); w.w = cvt_pk_bf16(v1[2], v1[3]);
                    *(u32x4*)(O + (size_t)row * 6144 + col0 + bj * HALF) = w; }
            }
    }
};
struct EpiResid {
    static constexpr bool PERM = false, AFTER_DRAIN = false;
    const float* x0; bf16_t* hb; ss_t* ssn; float scale;
    template <class Sched> __device__ __forceinline__ int prepare(const Sched&, PG8_LAS unsigned char*, int) const { return 0; }
    __device__ __forceinline__ void operator()(const f32x4 (&acc)[2][2][4][2], const Unit& u, int wr, int wc, int fr, int fq, int pf, const PG8_LAS unsigned char* ext) const {
        typedef unsigned u32x2v __attribute__((ext_vector_type(2)));
        const int row0 = u.pm * BM + wr * 64 + fr, col0 = u.pn * BM + wc * 32 + 4 * fq;
        if (x0) {
#pragma unroll
            for (int gi = 0; gi < 8; ++gi) { const int ai = gi >> 2, m = gi & 3; const int row = row0 + ai * HALF + m * 16; const size_t off = (size_t)row * 2048 + col0; float sq = 0.f;
#pragma unroll
                for (int q = 0; q < 4; ++q) { const int bj = q >> 1, n = q & 1; const size_t o2 = off + bj * HALF + n * 16;
                    const f32x4 hn = *(const f32x4*)(x0 + o2) + acc[ai][bj][m][n] * scale;
                    u32x2v w; w.x = cvt_pk_bf16(hn[0], hn[1]); w.y = cvt_pk_bf16(hn[2], hn[3]); *(u32x2v*)(hb + o2) = w;
                    const float r0 = __uint_as_float(w.x << 16), r1 = __uint_as_float(w.x & 0xffff0000u), r2 = __uint_as_float(w.y << 16), r3 = __uint_as_float(w.y & 0xffff0000u);
                    sq += (r0 * r0 + r1 * r1) + (r2 * r2 + r3 * r3); }
                sq += __shfl_xor(sq, 16); sq += __shfl_xor(sq, 32);
                if (fq == 0) atomicAdd((unsigned long long*)(ssn + row), (unsigned long long)__float2ll_rn(sq * SS_FIX)); }
            return; }
        u32x2v rb[3][4];
#define PG8_LDG(gi, buf) do { const size_t off_ = (size_t)(row0 + ((gi) >> 2) * HALF + ((gi) & 3) * 16) * 2048 + col0; \
            _Pragma("unroll") for (int q_ = 0; q_ < 4; ++q_) buf[q_] = *(const u32x2v*)(hb + off_ + (q_ >> 1) * HALF + (q_ & 1) * 16); } while (0)
        PG8_LDG(0, rb[0]); PG8_LDG(1, rb[1]);
#pragma unroll
        for (int gi = 0; gi < 8; ++gi) {
            if (gi + 2 < 8) PG8_LDG(gi + 2, rb[(gi + 2) % 3]);
            const int ai = gi >> 2, m = gi & 3;
            const int row = row0 + ai * HALF + m * 16; const size_t off = (size_t)row * 2048 + col0; float sq = 0.f;
#pragma unroll
            for (int q = 0; q < 4; ++q) { const int bj = q >> 1, n = q & 1; const size_t o2 = off + bj * HALF + n * 16; const u32x2v hw = rb[gi % 3][q];
                const f32x4 ho = (f32x4){__uint_as_float(hw.x << 16), __uint_as_float(hw.x & 0xffff0000u), __uint_as_float(hw.y << 16), __uint_as_float(hw.y & 0xffff0000u)};
                const f32x4 hn = ho + acc[ai][bj][m][n] * scale;
                u32x2v w; w.x = cvt_pk_bf16(hn[0], hn[1]); w.y = cvt_pk_bf16(hn[2], hn[3]); *(u32x2v*)(hb + o2) = w;
                const float r0 = __uint_as_float(w.x << 16), r1 = __uint_as_float(w.x & 0xffff0000u), r2 = __uint_as_float(w.y << 16), r3 = __uint_as_float(w.y & 0xffff0000u);
                sq += (r0 * r0 + r1 * r1) + (r2 * r2 + r3 * r3); }
            sq += __shfl_xor(sq, 16); sq += __shfl_xor(sq, 32);
            if (fq == 0) atomicAdd((unsigned long long*)(ssn + row), (unsigned long long)__float2ll_rn(sq * SS_FIX));
        }
#undef PG8_LDG
    }
};

template <class Epi, class Sched, bool ALIGN_EPI = false, bool SP2 = false>
__device__ __forceinline__ void gemm_phase(PG8_LAS unsigned char* lds, const Gemm g, const Sched& S, const Epi& E) {
    int tid_ = threadIdx.x; asm volatile("" : "+v"(tid_));
    const int tid = tid_, wid = __builtin_amdgcn_readfirstlane(tid >> 6), lane = tid & 63, wr = wid >> 2, wc = wid & 3, fr = lane & 15, fq = lane >> 4;
    const int K = g.K, nt = K / BK;
    unsigned voffA[2], voffB[2];
#pragma unroll
    for (int i = 0; i < 2; ++i) { int R, C; stage_rc(tid * 16 + i * 8192, R, C); const int Rb = Epi::PERM ? ((R & ~31) + perm32(R & 31)) : R;
        voffA[i] = (unsigned)(R * K + C) * 2u; voffB[i] = (unsigned)(Rb * K + C) * 2u; }
    const size_t kstep = (size_t)(BK * 2);
    const size_t hstep = (size_t)HALF * K * 2;
    const size_t tstep = 2 * hstep;
    const unsigned ldsw = (unsigned)wid * 1024u;
    const int aoff = lds_byte(wr * 64 + fr, fq * 8), boff = lds_byte(wc * 32 + fr, fq * 8);
#define PG8_SA(b, h) (((b) * 2 + (h)) * HTB)
#define PG8_SB(b, h) ((4 + (b) * 2 + (h)) * HTB)
#define PG8_STAGE(bufoff, gbase, voff) do { _Pragma("unroll") for (int _i = 0; _i < 2; ++_i) \
        __builtin_amdgcn_global_load_lds((const unsigned*)((const char*)(gbase) + (voff)[_i]), (PG8_LAS unsigned*)(lds + (bufoff) + ldsw + _i * 8192), 16, 0, 0); } while (0)
#define PG8_LDA(dst, b, h) do { _Pragma("unroll") for (int m = 0; m < 4; ++m) _Pragma("unroll") for (int k = 0; k < 2; ++k) dst[m][k] = *(const PG8_LAS bf16x8*)(lds + PG8_SA(b, h) + aoff + m * 2048 + k * 1024); } while (0)
#define PG8_LDB(dst, b, h) do { _Pragma("unroll") for (int n = 0; n < 2; ++n) _Pragma("unroll") for (int k = 0; k < 2; ++k) dst[n][k] = *(const PG8_LAS bf16x8*)(lds + PG8_SB(b, h) + boff + n * 2048 + k * 1024); } while (0)
#define PG8_MMA(ai, bj, At, Bt) do { __builtin_amdgcn_s_setprio(1); _Pragma("unroll") for (int m = 0; m < 4; ++m) _Pragma("unroll") for (int n = 0; n < 2; ++n) _Pragma("unroll") for (int k = 0; k < 2; ++k) \
        acc[ai][bj][m][n] = __builtin_amdgcn_mfma_f32_16x16x32_bf16(Bt[n][k], At[m][k], acc[ai][bj][m][n], 0, 0, 0); __builtin_amdgcn_s_setprio(0); } while (0)
#define PG8_WAIT_V(n) asm volatile("s_waitcnt vmcnt(" #n ")" ::: "memory")
#define PG8_WAIT_L(n) asm volatile("s_waitcnt lgkmcnt(" #n ")" ::: "memory")
#define PG8_BAR __builtin_amdgcn_s_barrier()
#define PG8_SCHED __builtin_amdgcn_sched_barrier(0)
    const int pf = E.prepare(S, lds + STAGE_BYTES, tid);
    Unit cur, nxt; int ui = 0;
    if (!S.next(0, cur)) return;
    f32x4 acc[2][2][4][2];
#pragma unroll
    for (int a = 0; a < 2; ++a)
#pragma unroll
        for (int b = 0; b < 2; ++b)
#pragma unroll
            for (int m = 0; m < 4; ++m)
#pragma unroll
                for (int n = 0; n < 2; ++n) acc[a][b][m][n] = (f32x4){0.f, 0.f, 0.f, 0.f};
    bf16x8 At[4][2], B0[2][2], B1[2][2];
    const char* cA = (const char*)g.A + (size_t)cur.pm * tstep; const char* cB = (const char*)g.Bt + (size_t)cur.pn * tstep;
    S.a_ready(cur);
    if constexpr (SP2) {
        PG8_STAGE(PG8_SB(0, 0), cB, voffB); PG8_STAGE(PG8_SB(0, 1), cB + hstep, voffB); PG8_STAGE(PG8_SA(0, 0), cA, voffA); PG8_STAGE(PG8_SA(0, 1), cA + hstep, voffA);
        if (wr == 1) PG8_BAR;
        PG8_WAIT_V(2); PG8_BAR;
        PG8_STAGE(PG8_SB(1, 0), cB + kstep, voffB); PG8_STAGE(PG8_SA(1, 0), cA + kstep, voffA); PG8_STAGE(PG8_SB(1, 1), cB + hstep + kstep, voffB);
        PG8_WAIT_V(6); PG8_BAR;
    } else {
        PG8_STAGE(PG8_SB(0, 0), cB, voffB); PG8_STAGE(PG8_SA(0, 0), cA, voffA); PG8_STAGE(PG8_SB(0, 1), cB + hstep, voffB); PG8_STAGE(PG8_SA(0, 1), cA + hstep, voffA);
        if (wr == 1) PG8_BAR;
        PG8_WAIT_V(4); PG8_BAR;
        PG8_STAGE(PG8_SB(1, 0), cB + kstep, voffB); PG8_STAGE(PG8_SA(1, 0), cA + kstep, voffA); PG8_STAGE(PG8_SB(1, 1), cB + hstep + kstep, voffB);
        PG8_WAIT_V(6); PG8_BAR;
    }
    for (;;) {
        const bool has_next = S.next(ui + 1, nxt);
        const char* nA = has_next ? (const char*)g.A + (size_t)nxt.pm * tstep : cA; const char* nB = has_next ? (const char*)g.Bt + (size_t)nxt.pn * tstep : cB;
        for (int t = 0; t < nt; t += 2) {
            const bool last = (t == nt - 2);
            const char* a1 = cA + (size_t)(t + 1) * kstep;
            const char* a2 = last ? nA : cA + (size_t)(t + 2) * kstep; const char* b2 = last ? nB : cB + (size_t)(t + 2) * kstep;
            const char* a3 = a2 + kstep; const char* b3 = b2 + kstep;
            if (last && has_next) S.a_ready(nxt);
            if constexpr (SP2) {
            PG8_LDB(B0, 0, 0); PG8_LDB(B1, 0, 1); PG8_SCHED; PG8_LDA(At, 0, 0); PG8_STAGE(PG8_SA(1, 1), a1 + hstep, voffA);
            PG8_WAIT_V(8); PG8_WAIT_L(0); PG8_BAR; PG8_MMA(0, 0, At, B0); PG8_MMA(0, 1, At, B1); PG8_BAR; PG8_SCHED;
            PG8_LDA(At, 0, 1); PG8_STAGE(PG8_SB(0, 0), b2, voffB); PG8_STAGE(PG8_SB(0, 1), b2 + hstep, voffB); PG8_STAGE(PG8_SA(0, 0), a2, voffA);
            PG8_WAIT_V(8); PG8_WAIT_L(0); PG8_BAR; PG8_MMA(1, 0, At, B0); PG8_MMA(1, 1, At, B1); PG8_BAR; PG8_SCHED;
            PG8_LDB(B0, 1, 0); PG8_LDB(B1, 1, 1); PG8_SCHED; PG8_LDA(At, 1, 0); PG8_STAGE(PG8_SA(0, 1), a2 + hstep, voffA);
            PG8_WAIT_V(8); PG8_WAIT_L(0); PG8_BAR; PG8_MMA(0, 0, At, B0); PG8_MMA(0, 1, At, B1); PG8_BAR; PG8_SCHED;
            PG8_LDA(At, 1, 1); PG8_STAGE(PG8_SB(1, 0), b3, voffB); PG8_STAGE(PG8_SB(1, 1), b3 + hstep, voffB); PG8_STAGE(PG8_SA(1, 0), a3, voffA);
            PG8_WAIT_V(8); PG8_WAIT_L(0); PG8_BAR; PG8_MMA(1, 0, At, B0); PG8_MMA(1, 1, At, B1); PG8_BAR; PG8_SCHED;
            } else {
            PG8_LDB(B0, 0, 0); PG8_SCHED; PG8_LDA(At, 0, 0); PG8_STAGE(PG8_SA(1, 1), a1 + hstep, voffA);
            PG8_WAIT_L(8); PG8_BAR; PG8_WAIT_L(0); PG8_MMA(0, 0, At, B0); PG8_BAR; PG8_SCHED;
            PG8_LDB(B1, 0, 1); PG8_STAGE(PG8_SB(0, 0), b2, voffB);
            PG8_BAR; PG8_WAIT_L(0); PG8_MMA(0, 1, At, B1); PG8_BAR;
            PG8_LDA(At, 0, 1); PG8_STAGE(PG8_SA(0, 0), a2, voffA);
            PG8_BAR; PG8_WAIT_L(0); PG8_MMA(1, 0, At, B0); PG8_BAR; PG8_SCHED;
            PG8_STAGE(PG8_SB(0, 1), b2 + hstep, voffB);
            PG8_WAIT_V(6); PG8_BAR; PG8_MMA(1, 1, At, B1); PG8_BAR;
            PG8_LDB(B0, 1, 0); PG8_SCHED; PG8_LDA(At, 1, 0); PG8_STAGE(PG8_SA(0, 1), a2 + hstep, voffA);
            PG8_WAIT_L(8); PG8_BAR; PG8_WAIT_L(0); PG8_MMA(0, 0, At, B0); PG8_BAR; PG8_SCHED;
            PG8_LDB(B1, 1, 1); PG8_STAGE(PG8_SB(1, 0), b3, voffB);
            PG8_BAR; PG8_WAIT_L(0); PG8_MMA(0, 1, At, B1); PG8_BAR;
            PG8_LDA(At, 1, 1); PG8_STAGE(PG8_SA(1, 0), a3, voffA);
            PG8_BAR; PG8_WAIT_L(0); PG8_MMA(1, 0, At, B0); PG8_BAR; PG8_SCHED;
            PG8_STAGE(PG8_SB(1, 1), b3 + hstep, voffB);
            PG8_WAIT_V(6); PG8_BAR; PG8_MMA(1, 1, At, B1); PG8_BAR;
            }
        }
        if constexpr (ALIGN_EPI) { if (wr == 0) PG8_BAR; }
        if constexpr (!Epi::AFTER_DRAIN) { E(acc, cur, wr, wc, fr, fq, pf, lds + STAGE_BYTES); S.done(cur); }
        if (!has_next) break;
#pragma unroll
        for (int a = 0; a < 2; ++a)
#pragma unroll
            for (int b = 0; b < 2; ++b)
#pragma unroll
                for (int m = 0; m < 4; ++m)
#pragma unroll
                    for (int n = 0; n < 2; ++n) acc[a][b][m][n] = (f32x4){0.f, 0.f, 0.f, 0.f};
        cur = nxt; cA = nA; cB = nB; ++ui;
        if constexpr (ALIGN_EPI) { if (wr == 1) PG8_BAR; }
    }
    PG8_WAIT_V(0);
    if constexpr (!ALIGN_EPI) { if (wr == 0) PG8_BAR; }
    PG8_BAR;
    if constexpr (Epi::AFTER_DRAIN) { E.fused(acc, cur, wr, wc, fr, fq, lds, wid, lane); S.done(cur); }
#undef PG8_SA
#undef PG8_SB
#undef PG8_STAGE
#undef PG8_LDA
#undef PG8_LDB
#undef PG8_MMA
#undef PG8_WAIT_V
#undef PG8_WAIT_L
#undef PG8_BAR
#undef PG8_SCHED
}
}

#ifndef PG8_SP2
#define PG8_SP2 true
#endif
#ifndef PG8_ALIGN
#define PG8_ALIGN true
#endif
#ifndef REP_PRO
#define REP_PRO 1
#endif
#ifndef REP_MLSTM
#define REP_MLSTM 1
#endif
#ifndef REP_FOX
#define REP_FOX 1
#endif
#ifndef REP_GLA
#define REP_GLA 1
#endif
#ifndef MK_PER_PHASE
#define MK_PER_PHASE 0
#endif

constexpr int DM = 2048, BATCH = 8, SEQ = 4096, MTOK = BATCH * SEQ, DEPTH = 4, DFF = 5632, NUP = 2 * DFF, NIN = 6160, NINP = 6400, NQKV = 6144;
constexpr int NWAVES = 8;
constexpr int NSUB = 3 * DEPTH;
constexpr int NPHASE = 2 + 5 * NSUB;

constexpr size_t MiB = 1u << 20;
constexpr size_t WS_CTL = 0, CTL_ZERO_BYTES = 5 * MiB;
constexpr size_t WS_SS = 1 * MiB;
constexpr size_t WS_WUP = 8 * MiB;
constexpr size_t WS_WDN = WS_WUP + 352 * MiB;
constexpr size_t WS_WIN = WS_WDN + 176 * MiB;
constexpr size_t WS_WOUT = WS_WIN + 100 * MiB;
constexpr size_t WS_HB = WS_WOUT + 32 * MiB;
constexpr size_t WS_ACT = WS_HB + 128 * MiB;
constexpr size_t WS_P1 = WS_ACT + 352 * MiB;
constexpr size_t WS_G = WS_P1 + 384 * MiB;
constexpr size_t WS_HRAW = WS_G + 2 * MiB;
constexpr size_t WS_HM = WS_HRAW + 256 * MiB;
constexpr size_t WS_CF = WS_HM + 128 * MiB;
constexpr size_t WS_END = WS_CF + 2 * MiB;
static_assert((size_t)8 * NUP * DM * 2 == 352 * MiB && (size_t)8 * DM * DFF * 2 == 176 * MiB && (size_t)4 * NINP * DM * 2 == 100 * MiB, "weight regions");
static_assert((size_t)MTOK * DFF * 2 == 352 * MiB && (size_t)MTOK * NQKV * 2 == 384 * MiB && WS_SS + 13 * (size_t)MTOK * 8 <= CTL_ZERO_BYTES, "activation regions");
constexpr int CW_BAR = 4096;

constexpr int LDS_BYTES = 153600, MISC_OFF = 152576;

#define GAS __attribute__((address_space(1)))
#define LAS __attribute__((address_space(3)))
#define DI __device__ __forceinline__
typedef unsigned short bf16;
typedef unsigned v4u __attribute__((ext_vector_type(4)));
typedef unsigned v2u __attribute__((ext_vector_type(2)));
typedef float f32x4 __attribute__((ext_vector_type(4)));
typedef short bf16x8 __attribute__((ext_vector_type(8)));
typedef GAS unsigned gu32;
#define RLX_AGENT __ATOMIC_RELAXED, __HIP_MEMORY_SCOPE_AGENT
#define LDS_WAIT() asm volatile("s_waitcnt lgkmcnt(0)" ::: "memory")
DI unsigned f2bf(float f) { unsigned r; asm("v_cvt_pk_bf16_f32 %0, %1, %1" : "=v"(r) : "v"(f)); return r & 0xffffu; }
DI unsigned pk2(float lo, float hi) { unsigned r; asm("v_cvt_pk_bf16_f32 %0, %1, %2" : "=v"(r) : "v"(lo), "v"(hi)); return r; }
DI float bf2f(unsigned short v) { return __builtin_bit_cast(float, (unsigned)v << 16); }
DI float bflo(unsigned w) { return __builtin_bit_cast(float, w << 16); }
DI float bfhi(unsigned w) { return __builtin_bit_cast(float, w & 0xffff0000u); }
DI float logsig(float x) { return fminf(x, 0.f) - log1pf(expf(-fabsf(x))); }

#define XB_TMO      128
#define XB_XCNT(j)  (256  + 64 * (j))
#define XB_XSUB(j)  (1280 + 64 * (j))
#define XB_XGEN(j)  (2304 + 64 * (j))
#define XB_TOP      3328
#define XB_TOPGEN   3392
#define XCD_BAR_WORDS 3456
#define XB_SPIN_CAP (1u << 18)

__device__ __forceinline__ unsigned xb_ld(unsigned* p)              { return __hip_atomic_load(p, __ATOMIC_RELAXED, __HIP_MEMORY_SCOPE_AGENT); }
__device__ __forceinline__ unsigned xb_add(unsigned* p, unsigned v) { return __hip_atomic_fetch_add(p, v, __ATOMIC_RELAXED, __HIP_MEMORY_SCOPE_AGENT); }
__device__ __forceinline__ unsigned xb_xcc_id() { return (unsigned)__builtin_amdgcn_s_getreg((3 << 11) | 20) & 0xFu; }
#define XB_SPIN(cond, bar) do { unsigned _sp = 0; while (cond) { __builtin_amdgcn_s_sleep(1); \
    if ((++_sp & 255u) == 0u) { if (xb_ld(&(bar)[XB_TMO])) break; if (_sp > XB_SPIN_CAP) { atomicAdd(&(bar)[XB_TMO], 1u); break; } } } } while (0)

struct XcdBarrier {
    unsigned* bar; unsigned x;
    volatile LAS unsigned* st;
};

__device__ __forceinline__ XcdBarrier xcd_barrier_post(unsigned* bar, volatile LAS unsigned* st) {
    XcdBarrier b; b.bar = bar; b.x = xb_xcc_id(); b.st = st;
    if (threadIdx.x == 0) (void)xb_add(&bar[XB_XCNT(b.x)], 1u);
    return b;
}
__device__ __forceinline__ void xcd_barrier_complete(unsigned* bar, unsigned x, unsigned& nloc, unsigned& nx) {
    const unsigned G = gridDim.x * gridDim.y * gridDim.z;
    unsigned sum, cnt, mine, sp = 0u;
    for (;;) {
        sum = 0u; cnt = 0u; mine = 0u;
#pragma unroll
        for (unsigned j = 0; j < 16; ++j) { const unsigned c = xb_ld(&bar[XB_XCNT(j)]); sum += c; cnt += (c > 0u) ? 1u : 0u; mine = (j == x) ? c : mine; }
        if (sum == G) break;
        __builtin_amdgcn_s_sleep(1);
        if ((++sp & 255u) == 0u) { if (xb_ld(&bar[XB_TMO])) break; if (sp > XB_SPIN_CAP) { atomicAdd(&bar[XB_TMO], 1u); break; } }
    }
    nloc = mine > 0u ? mine : 1u; nx = cnt > 0u ? cnt : 1u;
}

__device__ __forceinline__ void xcd_barrier(const XcdBarrier& b) {
    asm volatile("s_waitcnt vmcnt(0)" ::: "memory");
    __syncthreads();
    if (threadIdx.x == 0) {
        unsigned* bar = b.bar;
        __builtin_amdgcn_s_waitcnt(0);
        unsigned nloc = b.st[0], nx = b.st[1];
        if (nloc == 0u) { xcd_barrier_complete(bar, b.x, nloc, nx); b.st[0] = nloc; b.st[1] = nx; }
        const unsigned old = xb_add(&bar[XB_XSUB(b.x)], 1u);
        const unsigned gen = old / nloc;
        if (old + 1u == (gen + 1u) * nloc) {
            __builtin_amdgcn_fence(__ATOMIC_RELEASE, "agent");
            asm volatile("s_waitcnt vmcnt(0)" ::: "memory");
            const unsigned og = xb_add(&bar[XB_TOP], 1u);
            const unsigned tg = og / nx;
            if (og + 1u == (tg + 1u) * nx) xb_add(&bar[XB_TOPGEN], 1u);
            else XB_SPIN(xb_ld(&bar[XB_TOPGEN]) == tg, bar);
            __builtin_amdgcn_fence(__ATOMIC_ACQUIRE, "agent");
            xb_add(&bar[XB_XGEN(b.x)], 1u);
            asm volatile("s_waitcnt vmcnt(0)" ::: "memory");
        } else {
            XB_SPIN(xb_ld(&bar[XB_XGEN(b.x)]) == gen, bar);
            __builtin_amdgcn_fence(__ATOMIC_ACQUIRE, "agent");
            asm volatile("s_waitcnt vmcnt(0)" ::: "memory");
        }
    }
    __syncthreads();
}


DI float wave_sum(float v) {
#pragma unroll
    for (int o = 1; o < 64; o <<= 1) v += __shfl_xor(v, o);
    return v;
}
DI float wave_max(float v) {
#pragma unroll
    for (int o = 1; o < 64; o <<= 1) v = fmaxf(v, __shfl_xor(v, o));
    return v;
}
DI float wave_incl_sum(float v, int lane) {
#pragma unroll
    for (int o = 1; o < 64; o <<= 1) { const float t = __shfl_up(v, o); if (lane >= o) v += t; }
    return v;
}
DI float wave_incl_max(float v, int lane) {
#pragma unroll
    for (int o = 1; o < 64; o <<= 1) { const float t = __shfl_up(v, o); if (lane >= o) v = fmaxf(v, t); }
    return v;
}

template <int L> DI int swx(int r) { return L == 64 ? ((r >> 1) & 7) : (r & 15); }
template <int L> DI int eoff(int r, int c) { return r * L + ((((c >> 3) ^ swx<L>(r)) << 3) | (c & 7)); }
template <int L> DI bf16x8 ldf(const LAS bf16* base, int r, int ch) { return *(const LAS bf16x8*)(base + r * L + ((ch ^ swx<L>(r)) << 3)); }
DI f32x4 mfma16(bf16x8 a, bf16x8 b, f32x4 c) { return __builtin_amdgcn_mfma_f32_16x16x32_bf16(a, b, c, 0, 0, 0); }
typedef short v4i16_t __attribute__((ext_vector_type(4)));
DI v4i16_t tr_read(const LAS unsigned char* p) { return __builtin_amdgcn_ds_read_tr16_b64_v4i16((LAS v4i16_t*)p); }
DI bf16x8 cat4(v4i16_t lo, v4i16_t hi) { bf16x8 r; r[0] = lo[0]; r[1] = lo[1]; r[2] = lo[2]; r[3] = lo[3]; r[4] = hi[0]; r[5] = hi[1]; r[6] = hi[2]; r[7] = hi[3]; return r; }
DI unsigned off_v64(unsigned row, unsigned ch) { return 128u * row + 16u * (ch ^ ((((row >> 1) & 1u) << 1) | (((row >> 3) & 1u) << 2))); }
DI bf16x8 vfrag64(const LAS unsigned char* vb, int c, int ks, int lane) { const unsigned g = lane >> 4, q = (lane & 15) >> 2, p = lane & 3;
    return cat4(tr_read(vb + off_v64(32 * ks + 8 * g + q, 2 * c + (p >> 1)) + 8 * (p & 1)), tr_read(vb + off_v64(32 * ks + 8 * g + 4 + q, 2 * c + (p >> 1)) + 8 * (p & 1))); }
template <int LA, int LB, int NK> DI void mma_tile(f32x4& acc, const LAS bf16* A, int ra0, const LAS bf16* B, int rb0, int lane) {
    const int r = lane & 15, g = lane >> 4;
#pragma unroll
    for (int kk = 0; kk < NK; ++kk) { const bf16x8 a = ldf<LA>(A, ra0 + r, 4 * kk + g), b = ldf<LB>(B, rb0 + r, 4 * kk + g); acc = mfma16(a, b, acc); }
}

struct ConvItem { const float* W; const float* gk; bf16* WT; int K, N, mode, r; };
DI void conv_load(const ConvItem& c, int lane, f32x4 (&v)[8], float (&gv)[8]) {
    const int nkb = c.K / 64, nb = c.r / nkb, kb = c.r - nb * nkb, k0 = 64 * kb, n0 = 32 * nb;
    const int n = n0 + 4 * (lane & 7); const bool ok = n < c.N;
#pragma unroll
    for (int i = 0; i < 8; ++i) { const int kk = 8 * i + (lane >> 3); v[i] = ok ? *(const f32x4*)(c.W + (size_t)(k0 + kk) * c.N + n) : (f32x4){0.f, 0.f, 0.f, 0.f}; gv[i] = c.gk ? c.gk[k0 + kk] : 1.0f; }
}
DI void conv_store(const ConvItem& c, int lane, const f32x4 (&v)[8], const float (&gv)[8], LAS float* scr) {
    const int nkb = c.K / 64, nb = c.r / nkb, kb = c.r - nb * nkb, k0 = 64 * kb, n0 = 32 * nb, nq = 4 * (lane & 7);
#pragma unroll
    for (int i = 0; i < 8; ++i) { const int kk = 8 * i + (lane >> 3); LAS float* d = scr + kk * 33 + nq; d[0] = v[i].x * gv[i]; d[1] = v[i].y * gv[i]; d[2] = v[i].z * gv[i]; d[3] = v[i].w * gv[i]; }
    LDS_WAIT(); asm volatile("" ::: "memory");
    int row_off = n0;
    if (c.mode == 1) { const int j = n0 < DFF ? n0 : n0 - DFF; row_off = 256 * (j >> 7) + (j & 127) + (n0 < DFF ? 0 : 128); }
    const int cc = lane & 7;
#pragma unroll
    for (int j = 0; j < 4; ++j) { const int nn = (lane >> 3) + 8 * j; const LAS float* s = scr + (8 * cc) * 33 + nn;
        v4u o; o.x = pk2(s[0 * 33], s[1 * 33]); o.y = pk2(s[2 * 33], s[3 * 33]); o.z = pk2(s[4 * 33], s[5 * 33]); o.w = pk2(s[6 * 33], s[7 * 33]);
        *(v4u*)(c.WT + (size_t)(row_off + nn) * c.K + k0 + 8 * cc) = o; }
    LDS_WAIT(); asm volatile("" ::: "memory");
}

struct Args { const float* in[18]; float* out; unsigned char* ws; int ph_lo, ph_hi; };

typedef const __attribute__((address_space(4))) Args* KArgs;
DI KArgs kargs() { KArgs p = (KArgs)__builtin_amdgcn_kernarg_segment_ptr(); asm volatile("" : "+s"(p)); return p; }
DI void prologue(LAS unsigned char* lds, int lane, int wave, int bx) {
    KArgs AP = kargs();
    LAS float* scr = (LAS float*)(lds + wave * 16384);
    const int gw = bx * NWAVES + wave, NGW = gridDim.x * NWAVES;
    unsigned char* ws = AP->ws;
    constexpr int I_UP = (DM / 64) * (NUP / 32), I_DN = (DFF / 64) * (DM / 32), I_IN = (DM / 64) * (NINP / 32), I_OUT = (DM / 64) * (DM / 32);
    constexpr int NITEMS = 8 * I_UP + 8 * I_DN + 4 * I_IN + 4 * I_OUT;
#define CONV_DECODE(it_, c_) do { int r = (it_); (c_).gk = nullptr; (c_).K = DM; (c_).mode = 0; \
        if (r < 8 * I_UP) { const int mi = r / I_UP; r -= mi * I_UP; (c_).W = AP->in[2] + (size_t)mi * DM * NUP; (c_).gk = AP->in[1] + (size_t)mi * DM; (c_).WT = (bf16*)(ws + WS_WUP) + (size_t)mi * NUP * DM; (c_).N = NUP; (c_).mode = 1; } \
        else if (r < 8 * I_UP + 8 * I_DN) { r -= 8 * I_UP; const int mi = r / I_DN; r -= mi * I_DN; (c_).W = AP->in[3] + (size_t)mi * DFF * DM; (c_).WT = (bf16*)(ws + WS_WDN) + (size_t)mi * DM * DFF; (c_).K = DFF; (c_).N = DM; } \
        else if (r < 8 * I_UP + 8 * I_DN + 4 * I_IN) { r -= 8 * I_UP + 8 * I_DN; const int l = r / I_IN; r -= l * I_IN; const int kind = l % 3, ji = l / 3; \
            (c_).W = AP->in[kind == 0 ? 5 : kind == 1 ? 9 : 12] + (size_t)ji * DM * NIN; (c_).gk = AP->in[4] + (size_t)l * DM; (c_).WT = (bf16*)(ws + WS_WIN) + (size_t)l * NINP * DM; (c_).N = NIN; } \
        else { r -= 8 * I_UP + 8 * I_DN + 4 * I_IN; const int l = r / I_OUT; r -= l * I_OUT; const int kind = l % 3, ji = l / 3; \
            (c_).W = AP->in[kind == 0 ? 8 : kind == 1 ? 11 : 16] + (size_t)ji * DM * DM; (c_).WT = (bf16*)(ws + WS_WOUT) + (size_t)l * DM * DM; (c_).N = DM; } \
        (c_).r = r; } while (0)
    f32x4 va[8]; float ga[8]; ConvItem ca{}, cb{};
    if (gw < NITEMS) { CONV_DECODE(gw, ca); conv_load(ca, lane, va, ga); }
    for (int it = gw; it < NITEMS; it += NGW) {
        f32x4 vb[8]; float gb[8]; const int nx = it + NGW;
        if (nx < NITEMS) { CONV_DECODE(nx, cb); conv_load(cb, lane, vb, gb); }
        conv_store(ca, lane, va, ga, scr);
        ca = cb;
#pragma unroll
        for (int i = 0; i < 8; ++i) { va[i] = vb[i]; ga[i] = gb[i]; }
    }
#undef CONV_DECODE
    const float* x = AP->in[0]; bf16* hb = (bf16*)(ws + WS_HB); long long* ss0 = (long long*)(ws + WS_SS);
    for (int m = gw; m < MTOK; m += NGW) {
        const f32x4* xr = (const f32x4*)(x + (size_t)m * DM) + lane; f32x4 v[8]; float s = 0.f;
#pragma unroll
        for (int j = 0; j < 8; ++j) { v[j] = xr[64 * j]; s += (v[j].x * v[j].x + v[j].y * v[j].y) + (v[j].z * v[j].z + v[j].w * v[j].w); }
        s = wave_sum(s);
        v2u* o8 = (v2u*)(hb + (size_t)m * DM) + lane;
#pragma unroll
        for (int j = 0; j < 8; ++j) { v2u w; w.x = pk2(v[j].x, v[j].y); w.y = pk2(v[j].z, v[j].w); o8[64 * j] = w; }
        if (lane == 0) ss0[m] = __float2ll_rn(s * 1048576.0f);
    }
}

constexpr int IMGM_P = 0, IMGM_KT = 8192, IMGM_VT = IMGM_KT + 16384, IMGM_GS = IMGM_VT + 4 * 8192, IMGM_BYTES = IMGM_GS + 1024;
constexpr int IMGG_Q = 0, IMGG_KT = 32768, IMGG_P = 65536, IMGG_VT = IMGG_P + 8192, IMGG_EB = IMGG_VT + 8 * 8192, IMGG_BYTES = IMGG_EB + 1024;
static_assert((size_t)IMGM_BYTES * 4096 <= 352 * MiB && (size_t)IMGG_BYTES * 2048 <= 352 * MiB, "images overlay the (idle) FFN activation buffer");
DI unsigned pk2_sw(float lo, float hi) { unsigned a = __builtin_bit_cast(unsigned, lo), b = __builtin_bit_cast(unsigned, hi); a = (a + 0x7fffu + ((a >> 16) & 1u)) >> 16; b = (b + 0x7fffu + ((b >> 16) & 1u)) & 0xffff0000u; return a | b; }
DI float logsig_fast(float x) { return fminf(x, 0.f) - __logf(1.0f + __expf(-fabsf(x))); }

DI void mlstm_pre(LAS unsigned char* lds, const bf16* P1, const float* G, const float* b_if, unsigned char* img, int tid, int lane, int wave, int bx) {
    LAS bf16* Qs = (LAS bf16*)lds;
    LAS bf16* Ks = Qs + 64 * 128;
    LAS bf16* KTs = Ks + 64 * 128;
    LAS bf16* Ps = KTs + 128 * 64;
    LAS bf16* VT = Ps + 64 * 64;
    LAS float* fa = (LAS float*)(VT + 256 * 64);
    LAS float *bcum = fa, *ipre = fa + 64, *aloc = fa + 128, *wloc = fa + 192, *scal = fa + 256;
    const float KSCALE = 0.08838834764831845f;
    const int g = lane >> 4, r16 = lane & 15;
    v4u pq[2], pk[2]; float pgi = 0.f, pgf = 0.f;
#define MLP_LOAD(it_) do { const int b_ = (it_) >> 9, c_ = ((it_) >> 3) & 63, h_ = (it_) & 7; const int row0_ = b_ * SEQ + c_ * 64; \
        _Pragma("unroll") for (int p = 0; p < 2; ++p) { const int idx = tid + 512 * p, r = idx >> 4, c8 = idx & 15; const bf16* src = P1 + (size_t)(row0_ + r) * NQKV + h_ * 128 + c8 * 8; pq[p] = *(const v4u*)src; pk[p] = *(const v4u*)(src + 1024); } \
        if (tid < 64) { const float* gp = G + (size_t)(row0_ + tid) * 16; pgi = gp[h_]; pgf = gp[8 + h_]; } } while (0)
    if (bx < 4096) MLP_LOAD(bx);
    for (int item = bx; item < 4096; item += gridDim.x) {
        const int h = item & 7;
        unsigned char* im = img + (size_t)item * IMGM_BYTES;
        __syncthreads();
        if (tid < 64) { ipre[tid] = pgi + b_if[h]; bcum[tid] = logsig(pgf + b_if[8 + h]); }
#pragma unroll
        for (int p = 0; p < 2; ++p) { const int idx = tid + 512 * p, r = idx >> 4, c8 = idx & 15; *(LAS v4u*)(Qs + eoff<128>(r, c8 * 8)) = pq[p]; *(LAS v4u*)(Ks + eoff<128>(r, c8 * 8)) = pk[p]; }
        __syncthreads();
        if (wave == 0) {
            const float bt = wave_incl_sum(bcum[lane], lane), ip = ipre[lane];
            const float al = bt + wave_incl_max(ip - bt, lane);
            const float blast = __shfl(bt, 63);
            const float gg = blast - bt + ip;
            const float gmax = wave_max(gg);
            bcum[lane] = bt; aloc[lane] = al; wloc[lane] = __expf(gg - gmax);
            if (lane == 0) { scal[0] = blast; scal[1] = gmax; }
        }
        if (item + (int)gridDim.x < 4096) MLP_LOAD(item + (int)gridDim.x);
        __syncthreads();
#pragma unroll
        for (int p = 0; p < 2; ++p) { const int idx = tid + 512 * p, s = idx >> 4, c8 = idx & 15; const v4u kv = *(const LAS v4u*)(Ks + eoff<128>(s, c8 * 8)); const float w = wloc[s] * KSCALE;
#pragma unroll
            for (int j = 0; j < 4; ++j) { KTs[eoff<64>(c8 * 8 + 2 * j, s)] = (bf16)f2bf(bflo(kv[j]) * w); KTs[eoff<64>(c8 * 8 + 2 * j + 1, s)] = (bf16)f2bf(bfhi(kv[j]) * w); } }
        { const int tt = wave >> 1;
#pragma unroll
          for (int q2 = 0; q2 < 2; ++q2) { const int st = 2 * (wave & 1) + q2; f32x4 acc = (f32x4){0.f, 0.f, 0.f, 0.f};
            if (st <= tt) mma_tile<128, 128, 4>(acc, Qs, 16 * tt, Ks, 16 * st, lane);
            const int s = 16 * st + r16; const float cs = ipre[s] - bcum[s];
#pragma unroll
            for (int i = 0; i < 4; ++i) { const int t = 16 * tt + 4 * g + i; const float p = (s <= t) ? acc[i] * KSCALE * __expf(bcum[t] + cs - aloc[t]) : 0.f; Ps[eoff<64>(t, s)] = (bf16)f2bf(p); } } }
        __syncthreads();
        *(v4u*)(im + IMGM_P + tid * 16) = *(const LAS v4u*)((LAS unsigned char*)Ps + tid * 16);
#pragma unroll
        for (int p = 0; p < 2; ++p) *(v4u*)(im + IMGM_KT + (tid + 512 * p) * 16) = *(const LAS v4u*)((LAS unsigned char*)KTs + (tid + 512 * p) * 16);
        if (tid < 64) { float* gs = (float*)(im + IMGM_GS); gs[tid] = bcum[tid]; gs[64 + tid] = aloc[tid]; if (tid < 2) gs[128 + tid] = scal[tid]; }
    }
#undef MLP_LOAD
}

DI void mlstm_scan2(LAS unsigned char* lds, const bf16* P1, const unsigned char* img, bf16* hraw, int tid, int lane, int wave, int bx) {
    constexpr int IB = 8192 + 16384 + 16384 + 10240 + 1024;
    LAS bf16* CT0 = (LAS bf16*)(lds + 2 * IB);
    const int g = lane >> 4, r16 = lane & 15, tt = wave >> 1, eh = wave & 1;
    for (int item0 = bx; item0 < 256; item0 += gridDim.x) {
        const int item = (gridDim.x == 256) ? (item0 & 7) * 32 + (item0 >> 3) : item0;
        const int b = item >> 5, h = (item >> 2) & 7, sl = item & 3;
        f32x4 Cacc[5];
#pragma unroll
        for (int e = 0; e < 5; ++e) Cacc[e] = (f32x4){0.f, 0.f, 0.f, 0.f};
        __syncthreads();
        for (int i = tid; i < 2 * 80 * 128 / 8; i += 512) ((LAS v4u*)CT0)[i] = (v4u){0u, 0u, 0u, 0u};
        float m_prev = 0.f;
        v4u rp, rq[2], rk[2], rv; float rg0 = 0.f, rbl, rgm;
#define MLS_PREFETCH(cc) do { const int item2 = (b * 64 + (cc)) * 8 + h; const unsigned char* im = img + (size_t)item2 * IMGM_BYTES; const int row0_ = b * SEQ + (cc) * 64; \
            rp = *(const v4u*)(im + IMGM_P + tid * 16); rk[0] = *(const v4u*)(im + IMGM_KT + tid * 16); rk[1] = *(const v4u*)(im + IMGM_KT + (tid + 512) * 16); \
            rv = *(const v4u*)(P1 + (size_t)(row0_ + (tid >> 3)) * NQKV + 2048 + h * 256 + sl * 64 + (tid & 7) * 8); \
            _Pragma("unroll") for (int p = 0; p < 2; ++p) { const int idx = tid + 512 * p, r = idx >> 4, c8 = idx & 15; rq[p] = *(const v4u*)(P1 + (size_t)(row0_ + r) * NQKV + h * 128 + c8 * 8); } \
            const float* gs = (const float*)(im + IMGM_GS); if (tid < 128) rg0 = gs[tid]; rbl = gs[128]; rgm = gs[129]; } while (0)
#define MLS_STORE(bi) do { LAS unsigned char* bb = lds + (bi) * IB; \
            *(LAS v4u*)(bb + tid * 16) = rp; *(LAS v4u*)(bb + 8192 + 16384 + tid * 16) = rk[0]; *(LAS v4u*)(bb + 8192 + 16384 + (tid + 512) * 16) = rk[1]; \
            *(LAS v4u*)(bb + 8192 + 16384 + 16384 + off_v64(tid >> 3, tid & 7)) = rv; \
            _Pragma("unroll") for (int p = 0; p < 2; ++p) { const int idx = tid + 512 * p, r = idx >> 4, c8 = idx & 15; *(LAS v4u*)((LAS bf16*)(bb + 8192) + eoff<128>(r, c8 * 8)) = rq[p]; } \
            if (tid < 128) ((LAS float*)(bb + 8192 + 16384 + 16384 + 10240))[tid] = rg0; } while (0)
        MLS_PREFETCH(0); MLS_STORE(0);
        float blast = rbl, gmax = rgm;
        MLS_PREFETCH(1);
        __syncthreads();
        for (int c = 0; c < 64; ++c) {
            const int row0 = b * SEQ + c * 64;
            const LAS unsigned char* bb = lds + (c & 1) * IB;
            const LAS bf16* Ps = (const LAS bf16*)bb; const LAS bf16* Qs = (const LAS bf16*)(bb + 8192); const LAS bf16* KTs = (const LAS bf16*)(bb + 8192 + 16384);
            const LAS bf16* VTs = (const LAS bf16*)(bb + 8192 + 16384 + 16384); const LAS float* gsl = (const LAS float*)(bb + 8192 + 16384 + 16384 + 10240);
            LAS bf16* CTc = CT0 + (c & 1) * 80 * 128; LAS bf16* CTn = CT0 + ((c + 1) & 1) * 80 * 128;
            const int t = 16 * tt + r16;
            const float btv = gsl[t], alv = gsl[64 + t];
            const float mt = fmaxf(btv + m_prev, alv), al = __expf(alv - mt), be = __expf(btv + m_prev - mt), em = __expf(-mt);
            const float m_new = fmaxf(blast + m_prev, gmax), wcs = __expf(blast + m_prev - m_new), gam = __expf(gmax - m_new);
            m_prev = m_new;
            const LAS unsigned char* vb = (const LAS unsigned char*)VTs;
            bf16x8 onesf;
#pragma unroll
            for (int j = 0; j < 8; ++j) onesf[j] = (r16 == 0) ? (short)0x3f80 : (short)0;
            const bf16x8 pa0 = ldf<64>(Ps, 16 * tt + r16, g), pa1 = ldf<64>(Ps, 16 * tt + r16, 4 + g);
            f32x4 d1 = (f32x4){0.f, 0.f, 0.f, 0.f}, d2 = (f32x4){0.f, 0.f, 0.f, 0.f};
            d1 = mfma16(onesf, pa0, d1); d1 = mfma16(onesf, pa1, d1); mma_tile<128, 128, 4>(d2, CTc, 64, Qs, 16 * tt, lane);
            const float den = __shfl(al * d1[0] + be * d2[0], r16);
            const float dinv = __builtin_amdgcn_rcpf(fmaxf(fabsf(den), em));
#pragma unroll
            for (int q2 = 0; q2 < 2; ++q2) { const int et = 2 * eh + q2; f32x4 a1 = (f32x4){0.f, 0.f, 0.f, 0.f}, a2 = (f32x4){0.f, 0.f, 0.f, 0.f};
                a1 = mfma16(vfrag64(vb, et, 0, lane), pa0, a1); a1 = mfma16(vfrag64(vb, et, 1, lane), pa1, a1); mma_tile<128, 128, 4>(a2, CTc, 16 * et, Qs, 16 * tt, lane);
                const f32x4 o4 = (a1 * al + a2 * be) * dinv; v2u w; w.x = pk2(o4[0], o4[1]); w.y = pk2(o4[2], o4[3]);
                *(v2u*)(hraw + (size_t)(row0 + t) * DM + h * 256 + sl * 64 + 16 * et + 4 * g) = w; }
            const bf16x8 ka0 = ldf<64>(KTs, 16 * wave + r16, g), ka1 = ldf<64>(KTs, 16 * wave + r16, 4 + g);
#pragma unroll
            for (int et = 0; et < 5; ++et) { f32x4 tmp = (f32x4){0.f, 0.f, 0.f, 0.f};
                tmp = mfma16(ka0, et < 4 ? vfrag64(vb, et & 3, 0, lane) : onesf, tmp); tmp = mfma16(ka1, et < 4 ? vfrag64(vb, et & 3, 1, lane) : onesf, tmp);
                Cacc[et] = Cacc[et] * wcs + tmp * gam;
                v2u w; w.x = pk2(Cacc[et][0], Cacc[et][1]); w.y = pk2(Cacc[et][2], Cacc[et][3]);
                *(LAS v2u*)(CTn + eoff<128>(16 * et + r16, 16 * wave + 4 * g)) = w; }
            if (c + 1 < 64) { MLS_STORE((c + 1) & 1); blast = rbl; gmax = rgm; }
            if (c + 2 < 64) MLS_PREFETCH(c + 2);
            __syncthreads();
        }
#undef MLS_PREFETCH
#undef MLS_STORE
    }
}

DI void gla_pre(LAS unsigned char* lds, const bf16* P1, const float* G, const float* w_alpha, const float* b_alpha, unsigned char* img, int tid, int lane, int wave, int bx) {
    LAS bf16* VT = (LAS bf16*)lds;
    LAS bf16* QTs = (LAS bf16*)lds;
    LAS bf16* KTl = QTs + 64 * 256;
    LAS bf16* KTT = KTl + 64 * 256;
    LAS bf16* Ps = KTT + 256 * 64;
    LAS float* alow = (LAS float*)(Ps + 64 * 64);
    LAS float* T0 = alow + 1024;
    const int g = lane >> 4, r16 = lane & 15, d = tid & 255, sh = tid >> 8;
    for (int item = bx; item < 2048; item += gridDim.x) {
        const int b = item >> 8, c = (item >> 2) & 63, h = item & 3;
        const int row0 = b * SEQ + c * 64;
        unsigned char* im = img + (size_t)item * IMGG_BYTES;
        __syncthreads();
        float wa[16];
#pragma unroll
        for (int i = 0; i < 16; ++i) wa[i] = w_alpha[i * 1024 + h * 256 + d];
        const float ba = b_alpha[h * 256 + d];
        f32x4 al4 = (f32x4){0.f, 0.f, 0.f, 0.f};
        if (tid < 256) al4 = *(const f32x4*)(G + (size_t)(row0 + (tid >> 2)) * 16 + (tid & 3) * 4);
        if (tid < 256) *(LAS f32x4*)(alow + tid * 4) = al4;
        __syncthreads();
        const bf16* qsrc = P1 + (size_t)(row0 + 32 * sh) * NQKV + h * 256 + d;
        float bs[32]; float run = 0.f;
#pragma unroll
        for (int j = 0; j < 32; ++j) { const int s = 32 * sh + j; float z = ba;
#pragma unroll
            for (int i = 0; i < 16; ++i) z += alow[s * 16 + i] * wa[i];
            run += logsig_fast(z) * (1.0f / 16.0f); bs[j] = run; }
        if (sh == 0) T0[d] = run;
        __syncthreads();
        const float add = sh ? T0[d] : 0.f;
        if (sh) ((float*)(im + IMGG_EB))[d] = __expf(run + add);
#pragma unroll
        for (int q8 = 0; q8 < 4; ++q8) { unsigned kk[8];
#pragma unroll
            for (int j = 0; j < 8; ++j) { const int jj = 8 * q8 + j, s = 32 * sh + jj; const float bsum = bs[jj] + add;
                const float qv = bf2f(qsrc[(size_t)jj * NQKV]) * 0.0625f * __expf(bsum), kv = bf2f(qsrc[(size_t)jj * NQKV + 1024]) * __expf(-bsum);
                QTs[eoff<256>(s, d)] = (bf16)f2bf(qv); kk[j] = f2bf(kv); KTl[eoff<256>(s, d)] = (bf16)kk[j]; }
            v4u w; w.x = kk[0] | (kk[1] << 16); w.y = kk[2] | (kk[3] << 16); w.z = kk[4] | (kk[5] << 16); w.w = kk[6] | (kk[7] << 16);
            *(LAS v4u*)(KTT + eoff<64>(d, 32 * sh + 8 * q8)) = w; }
        __syncthreads();
        { const int tt = wave >> 1;
#pragma unroll
          for (int q2 = 0; q2 < 2; ++q2) { const int st = 2 * (wave & 1) + q2; f32x4 acc = (f32x4){0.f, 0.f, 0.f, 0.f};
            if (st <= tt) mma_tile<256, 256, 8>(acc, QTs, 16 * tt, KTl, 16 * st, lane);
            const int s = 16 * st + r16;
#pragma unroll
            for (int i = 0; i < 4; ++i) { const int t = 16 * tt + 4 * g + i; Ps[eoff<64>(t, s)] = (bf16)f2bf((s <= t) ? acc[i] : 0.f); } } }
        __syncthreads();
#pragma unroll
        for (int p = 0; p < 4; ++p) { *(v4u*)(im + IMGG_Q + (tid + 512 * p) * 16) = *(const LAS v4u*)((LAS unsigned char*)QTs + (tid + 512 * p) * 16);
                                      *(v4u*)(im + IMGG_KT + (tid + 512 * p) * 16) = *(const LAS v4u*)((LAS unsigned char*)KTT + (tid + 512 * p) * 16); }
        *(v4u*)(im + IMGG_P + tid * 16) = *(const LAS v4u*)((LAS unsigned char*)Ps + tid * 16);
    }
}

DI void gla_scan2(LAS unsigned char* lds, const bf16* P1, const unsigned char* img, bf16* hraw, int tid, int lane, int wave, int bx) {
    LAS bf16* QTs = (LAS bf16*)lds;
    LAS bf16* KTT = QTs + 64 * 256;
    LAS bf16* Ps = KTT + 256 * 64;
    LAS bf16* VTs = Ps + 64 * 64;
    LAS float* eb = (LAS float*)(VTs + 64 * 64);
    LAS bf16* ST0 = (LAS bf16*)(eb + 256);
    const int g = lane >> 4, r16 = lane & 15, tt = wave >> 1, eh = wave & 1;
    for (int item0 = bx; item0 < 256; item0 += gridDim.x) {
        const int item = (gridDim.x == 256) ? (item0 & 7) * 32 + (item0 >> 3) : item0;
        const int b = item >> 5, h = (item >> 3) & 3, sl = item & 7;
        f32x4 Sacc[2][4];
#pragma unroll
        for (int a = 0; a < 2; ++a)
#pragma unroll
            for (int e = 0; e < 4; ++e) Sacc[a][e] = (f32x4){0.f, 0.f, 0.f, 0.f};
        __syncthreads();
        for (int i = tid; i < 2 * 64 * 256 / 8; i += 512) ((LAS v4u*)ST0)[i] = (v4u){0u, 0u, 0u, 0u};
        v4u rq[4], rk[4], rp, rv; float re = 0.f;
#define GLS_PREFETCH(cc) do { const int item2 = (b * 64 + (cc)) * 4 + h; const unsigned char* im = img + (size_t)item2 * IMGG_BYTES; \
            _Pragma("unroll") for (int p = 0; p < 4; ++p) { rq[p] = *(const v4u*)(im + IMGG_Q + (tid + 512 * p) * 16); rk[p] = *(const v4u*)(im + IMGG_KT + (tid + 512 * p) * 16); } \
            rp = *(const v4u*)(im + IMGG_P + tid * 16); rv = *(const v4u*)(P1 + ((size_t)b * SEQ + (cc) * 64 + (tid >> 3)) * NQKV + 2048 + h * 512 + sl * 64 + (tid & 7) * 8); if (tid < 256) re = ((const float*)(im + IMGG_EB))[tid]; } while (0)
        GLS_PREFETCH(0);
        for (int c = 0; c < 64; ++c) {
            const int row0 = b * SEQ + c * 64;
            LAS bf16* STc = ST0 + (c & 1) * 64 * 256; LAS bf16* STn = ST0 + ((c + 1) & 1) * 64 * 256;
            __syncthreads();
#pragma unroll
            for (int p = 0; p < 4; ++p) { *(LAS v4u*)((LAS unsigned char*)QTs + (tid + 512 * p) * 16) = rq[p]; *(LAS v4u*)((LAS unsigned char*)KTT + (tid + 512 * p) * 16) = rk[p]; }
            *(LAS v4u*)((LAS unsigned char*)Ps + tid * 16) = rp; *(LAS v4u*)((LAS unsigned char*)VTs + off_v64(tid >> 3, tid & 7)) = rv;
            if (tid < 256) eb[tid] = re;
            __syncthreads();
            if (c + 1 < 64) GLS_PREFETCH(c + 1);
            const LAS unsigned char* vb = (const LAS unsigned char*)VTs;
            const bf16x8 pa0 = ldf<64>(Ps, 16 * tt + r16, g), pa1 = ldf<64>(Ps, 16 * tt + r16, 4 + g);
#pragma unroll
            for (int q2 = 0; q2 < 2; ++q2) { const int et = 2 * eh + q2; f32x4 acc = (f32x4){0.f, 0.f, 0.f, 0.f};
                acc = mfma16(vfrag64(vb, et, 0, lane), pa0, acc); acc = mfma16(vfrag64(vb, et, 1, lane), pa1, acc); mma_tile<256, 256, 8>(acc, STc, 16 * et, QTs, 16 * tt, lane);
                v2u w; w.x = pk2_sw(acc[0], acc[1]); w.y = pk2_sw(acc[2], acc[3]);
                *(v2u*)(hraw + (size_t)(row0 + 16 * tt + r16) * DM + h * 512 + sl * 64 + 16 * et + 4 * g) = w; }
#pragma unroll
            for (int a = 0; a < 2; ++a) { const int dt = 2 * wave + a;
                const f32x4 ev = *(const LAS f32x4*)(eb + 16 * dt + 4 * g);
                const bf16x8 ka0 = ldf<64>(KTT, 16 * dt + r16, g), ka1 = ldf<64>(KTT, 16 * dt + r16, 4 + g);
#pragma unroll
                for (int et = 0; et < 4; ++et) { Sacc[a][et] = mfma16(ka0, vfrag64(vb, et, 0, lane), Sacc[a][et]); Sacc[a][et] = mfma16(ka1, vfrag64(vb, et, 1, lane), Sacc[a][et]); Sacc[a][et] = Sacc[a][et] * ev;
                    v2u w; w.x = pk2(Sacc[a][et][0], Sacc[a][et][1]); w.y = pk2(Sacc[a][et][2], Sacc[a][et][3]);
                    *(LAS v2u*)(STn + eoff<256>(16 * et + r16, 16 * dt + 4 * g)) = w; } }
        }
#undef GLS_PREFETCH
    }
}


DI void mixer_gates(const bf16* hb, const bf16* wg, const long long* ss, float* G, int lane, int wave, int bx) {
    const int g = lane >> 4, r16 = lane & 15;
    for (int t = bx * NWAVES + wave; t < MTOK / 16; t += gridDim.x * NWAVES) {
        const bf16* ap = hb + (size_t)(16 * t + r16) * DM + 8 * g; const bf16* bp = wg + (size_t)r16 * DM + 8 * g;
        f32x4 acc = (f32x4){0.f, 0.f, 0.f, 0.f};
#pragma unroll 8
        for (int kk = 0; kk < DM / 32; ++kk) { const bf16x8 a = *(const bf16x8*)(ap + 32 * kk), b = *(const bf16x8*)(bp + 32 * kk); acc = mfma16(a, b, acc); }
#pragma unroll
        for (int i = 0; i < 4; ++i) { const int row = 16 * t + 4 * g + i; G[(size_t)row * 16 + r16] = acc[i] * pg8::rstd_of(ss, row); }
    }
}

template <int HS, int ACT> DI void headnorm_gate(const bf16* hraw, const bf16* P1, const float* gnorm, bf16* hm, int lane, int wave, int bx) {
    constexpr int NH = DM / HS, EPL = HS / 64;
    const int gw = bx * NWAVES + wave, NGW = gridDim.x * NWAVES;
    for (int row = gw; row < MTOK; row += NGW) {
#pragma unroll
        for (int hh = 0; hh < NH; ++hh) { const int col = hh * HS + lane * EPL;
            unsigned xw[EPL / 2], gwd[EPL / 2];
            if constexpr (EPL == 4) { const v2u a = *(const v2u*)(hraw + (size_t)row * DM + col), b2 = *(const v2u*)(P1 + (size_t)row * NQKV + 4096 + col); xw[0] = a.x; xw[1] = a.y; gwd[0] = b2.x; gwd[1] = b2.y; }
            else { const v4u a = *(const v4u*)(hraw + (size_t)row * DM + col), b2 = *(const v4u*)(P1 + (size_t)row * NQKV + 4096 + col); xw[0] = a.x; xw[1] = a.y; xw[2] = a.z; xw[3] = a.w; gwd[0] = b2.x; gwd[1] = b2.y; gwd[2] = b2.z; gwd[3] = b2.w; }
            float s = 0.f;
#pragma unroll
            for (int j = 0; j < EPL / 2; ++j) { const float x0 = bflo(xw[j]), x1 = bfhi(xw[j]); s += x0 * x0 + x1 * x1; }
            s = wave_sum(s); const float rs = rsqrtf(s * (1.0f / HS) + 1e-6f);
            unsigned outw[EPL / 2];
#pragma unroll
            for (int j = 0; j < EPL / 2; ++j) { const float g0 = bflo(gwd[j]), g1 = bfhi(gwd[j]);
                const float a0 = ACT == 0 ? __builtin_amdgcn_rcpf(1.0f + __expf(-g0)) : g0 * __builtin_amdgcn_rcpf(1.0f + __expf(-g0)), a1 = ACT == 0 ? __builtin_amdgcn_rcpf(1.0f + __expf(-g1)) : g1 * __builtin_amdgcn_rcpf(1.0f + __expf(-g1));
                outw[j] = pk2(bflo(xw[j]) * rs * gnorm[col + 2 * j] * a0, bfhi(xw[j]) * rs * gnorm[col + 2 * j + 1] * a1); }
            if constexpr (EPL == 4) { v2u w; w.x = outw[0]; w.y = outw[1]; *(v2u*)(hm + (size_t)row * DM + col) = w; }
            else { v4u w; w.x = outw[0]; w.y = outw[1]; w.z = outw[2]; w.w = outw[3]; *(v4u*)(hm + (size_t)row * DM + col) = w; }
        }
    }
}

DI void fox_cf(LAS unsigned char* lds, const float* G, const float* b_f, float* cf, int tid, int lane, int wave, int bx) {
    LAS float* wt = (LAS float*)lds;
    for (int item = bx; item < 256; item += gridDim.x) { const int seq = item >> 1, hf = item & 1, b = seq >> 4, h = seq & 15; const float bias = b_f[h];
        const float* gp = G + ((size_t)b * SEQ + hf * 2048 + tid * 4) * 16 + h;
        float ls[4]; float s = 0.f, s0 = 0.f;
#pragma unroll
        for (int p = 0; p < 4; ++p) { ls[p] = logsig(gp[p * 16] + bias); s += ls[p]; }
        if (hf) { const float* g0 = gp - (size_t)2048 * 16;
#pragma unroll
            for (int p = 0; p < 4; ++p) s0 += logsig(g0[p * 16] + bias); }
        const float incl = wave_incl_sum(s, lane), tot0 = wave_sum(s0);
        __syncthreads();
        if (lane == 63) wt[wave] = incl; if (lane == 0) wt[8 + wave] = tot0;
        __syncthreads();
        float base = 0.f;
#pragma unroll
        for (int w = 0; w < 8; ++w) { base += (w < wave) ? wt[w] : 0.f; base += wt[8 + w]; }
        float run = base + incl - s;
        float* o = cf + (size_t)seq * SEQ + hf * 2048 + tid * 4; f32x4 ov;
        run += ls[0]; ov.x = run; run += ls[1]; ov.y = run; run += ls[2]; ov.z = run; run += ls[3]; ov.w = run;
        *(f32x4*)o = ov;
    }
}

DI unsigned off_v(unsigned row, unsigned ch) { return 256u * row + 16u * (ch ^ (((row & 3u) << 2) | (((row >> 2) & 1u) << 1))); }

DI void fox_attn2(LAS unsigned char* lds, const bf16* P1, const float* cf, bf16* hm, int tid, int lane, int wave, int bx) {
    constexpr int BUFB = 16384 + 16384 + 256;
    const float LOG2E = 1.4426950408889634f, QS = 0.08838834764831845f * 1.4426950408889634f, THR = 8.0f;
    const int g = lane >> 4, r16 = lane & 15;
    const int G_ = gridDim.x;
    const int nit = (2048 + G_ - 1) / G_;
    for (int it = 0; it < nit; ++it) {
        const int u = (it & 1) ? it * G_ + (G_ - 1 - bx) : it * G_ + bx;
        if (u >= 2048) continue;
        const int qb = 15 - (u >> 7), bh = u & 127, b = bh >> 4, h = bh & 15;
        const size_t rowb = (size_t)b * SEQ; const int q0 = qb * 256 + 32 * wave;
        bf16x8 qf[2][4]; float c0[2];
#pragma unroll
        for (int tt = 0; tt < 2; ++tt) { const int t = q0 + 16 * tt + r16; c0[tt] = cf[(size_t)bh * SEQ + t] * LOG2E;
#pragma unroll
            for (int kk = 0; kk < 4; ++kk) { const v4u raw = *(const v4u*)(P1 + (rowb + t) * NQKV + h * 128 + 32 * kk + 8 * g); v4u sc;
#pragma unroll
                for (int j = 0; j < 4; ++j) sc[j] = pk2(bflo(raw[j]) * QS, bfhi(raw[j]) * QS);
                qf[tt][kk] = __builtin_bit_cast(bf16x8, sc); } }
        f32x4 oacc[8][2];
#pragma unroll
        for (int et = 0; et < 8; ++et) { oacc[et][0] = (f32x4){0.f, 0.f, 0.f, 0.f}; oacc[et][1] = (f32x4){0.f, 0.f, 0.f, 0.f}; }
        float lrun[2] = {0.f, 0.f};
        const int ntiles = 4 * (qb + 1);
        v4u kreg[2], vreg[2]; float cfreg = 0.f;
        const bf16* kbase = P1 + rowb * NQKV + 2048 + h * 128;
#define FOX_LOAD(j) do { _Pragma("unroll") for (int p = 0; p < 2; ++p) { const int idx = tid + 512 * p, r = idx >> 4, c8 = idx & 15; \
            kreg[p] = *(const v4u*)(kbase + (size_t)(64 * (j) + r) * NQKV + c8 * 8); vreg[p] = *(const v4u*)(kbase + (size_t)(64 * (j) + r) * NQKV + 2048 + c8 * 8); } \
            if (tid < 64) cfreg = -cf[(size_t)bh * SEQ + 64 * (j) + tid] * LOG2E; } while (0)
#define FOX_STORE(bufi) do { LAS unsigned char* bb = lds + (bufi) * BUFB; _Pragma("unroll") for (int p = 0; p < 2; ++p) { const int idx = tid + 512 * p, r = idx >> 4, c8 = idx & 15; \
            *(LAS v4u*)((LAS bf16*)bb + eoff<128>(r, c8 * 8)) = kreg[p]; *(LAS v4u*)(bb + 16384 + off_v(r, c8)) = vreg[p]; } \
            if (tid < 64) ((LAS float*)(bb + 32768))[tid] = cfreg; } while (0)
        __syncthreads();
        FOX_LOAD(0); FOX_STORE(0);
        if (ntiles > 1) FOX_LOAD(1);
        __syncthreads();
        for (int j = 0; j < ntiles; ++j) {
            if (j + 1 < ntiles) FOX_STORE((j + 1) & 1);
            if (j + 2 < ntiles) FOX_LOAD(j + 2);
            if (64 * j <= q0 + 31) {
                const LAS bf16* Ks = (const LAS bf16*)(lds + (j & 1) * BUFB); const LAS bf16* VTs = Ks + 64 * 128; const LAS float* cfs = (const LAS float*)(VTs + 128 * 64);
                f32x4 sacc[2][4];
#pragma unroll
                for (int st = 0; st < 4; ++st) { const f32x4 cv = *(const LAS f32x4*)(cfs + 16 * st + 4 * g);
#pragma unroll
                    for (int tt = 0; tt < 2; ++tt) sacc[tt][st] = cv + c0[tt]; }
#pragma unroll
                for (int st = 0; st < 4; ++st)
#pragma unroll
                    for (int kk = 0; kk < 4; ++kk) { const bf16x8 kf = ldf<128>(Ks, 16 * st + r16, 4 * kk + g);
                        sacc[0][st] = mfma16(kf, qf[0][kk], sacc[0][st]); sacc[1][st] = mfma16(kf, qf[1][kk], sacc[1][st]); if (kk == 3) asm volatile("" ::: "memory"); }
                if (64 * j + 63 > q0) {
#pragma unroll
                    for (int tt = 0; tt < 2; ++tt) { const int t = q0 + 16 * tt + r16;
#pragma unroll
                        for (int st = 0; st < 4; ++st)
#pragma unroll
                            for (int i = 0; i < 4; ++i) { const int s = 64 * j + 16 * st + 4 * g + i; if (s > t) sacc[tt][st][i] = -__builtin_inff(); } }
                }
                float mx[2];
#pragma unroll
                for (int tt = 0; tt < 2; ++tt) { float m = -__builtin_inff();
#pragma unroll
                    for (int st = 0; st < 4; ++st) m = fmaxf(m, fmaxf(fmaxf(sacc[tt][st][0], sacc[tt][st][1]), fmaxf(sacc[tt][st][2], sacc[tt][st][3])));
                    m = fmaxf(m, __shfl_xor(m, 16)); m = fmaxf(m, __shfl_xor(m, 32)); mx[tt] = m; }
                if (__any(mx[0] > THR || mx[1] > THR)) {
#pragma unroll
                    for (int tt = 0; tt < 2; ++tt) { const float sh = fmaxf(mx[tt], 0.f), f = __builtin_amdgcn_exp2f(-sh);
                        c0[tt] -= sh; lrun[tt] *= f;
#pragma unroll
                        for (int st = 0; st < 4; ++st) sacc[tt][st] = sacc[tt][st] - sh;
#pragma unroll
                        for (int et = 0; et < 8; ++et) oacc[et][tt] = oacc[et][tt] * f; }
                }
#pragma unroll
                for (int tt = 0; tt < 2; ++tt) { float ls = 0.f;
#pragma unroll
                    for (int st = 0; st < 4; ++st)
#pragma unroll
                        for (int i = 0; i < 4; ++i) { const float p = __builtin_amdgcn_exp2f(sacc[tt][st][i]); sacc[tt][st][i] = p; ls += p; }
                    lrun[tt] += ls; }
#pragma unroll
                for (int ks = 0; ks < 2; ++ks) { bf16x8 pb[2];
#pragma unroll
                    for (int tt = 0; tt < 2; ++tt) { v4u w; w.x = pk2(sacc[tt][2 * ks][0], sacc[tt][2 * ks][1]); w.y = pk2(sacc[tt][2 * ks][2], sacc[tt][2 * ks][3]);
                        w.z = pk2(sacc[tt][2 * ks + 1][0], sacc[tt][2 * ks + 1][1]); w.w = pk2(sacc[tt][2 * ks + 1][2], sacc[tt][2 * ks + 1][3]); pb[tt] = __builtin_bit_cast(bf16x8, w); }
#pragma unroll
                    for (int et = 0; et < 8; ++et) {
                        const LAS unsigned char* vb = (const LAS unsigned char*)VTs;
                        const v4i16_t lo = tr_read(vb + off_v(32 * ks + 4 * g + (r16 >> 2), 2 * et + ((lane & 3) >> 1)) + 8 * (lane & 1));
                        const v4i16_t hi = tr_read(vb + off_v(32 * ks + 16 + 4 * g + (r16 >> 2), 2 * et + ((lane & 3) >> 1)) + 8 * (lane & 1));
                        bf16x8 va; va[0] = lo[0]; va[1] = lo[1]; va[2] = lo[2]; va[3] = lo[3]; va[4] = hi[0]; va[5] = hi[1]; va[6] = hi[2]; va[7] = hi[3];
                        oacc[et][0] = mfma16(va, pb[0], oacc[et][0]); oacc[et][1] = mfma16(va, pb[1], oacc[et][1]); if (et & 1) asm volatile("" ::: "memory"); } }
            }
            __syncthreads();
        }
#undef FOX_LOAD
#undef FOX_STORE
#pragma unroll
        for (int tt = 0; tt < 2; ++tt) { float l = lrun[tt]; l += __shfl_xor(l, 16); l += __shfl_xor(l, 32); const float inv = 1.0f / l;
            bf16* orow = hm + (rowb + q0 + 16 * tt + r16) * DM + h * 128 + 4 * g;
#pragma unroll
            for (int et = 0; et < 8; ++et) { v2u w; w.x = pk2(oacc[et][tt][0] * inv, oacc[et][tt][1] * inv); w.y = pk2(oacc[et][tt][2] * inv, oacc[et][tt][3] * inv); *(v2u*)(orow + 16 * et) = w; } }
    }
}


DI void final_norm(float* out, const bf16* hb, const long long* ss, const float* gfin, int lane, int wave, int bx) {
    const int gw = bx * NWAVES + wave, NGW = gridDim.x * NWAVES;
    for (int m = gw; m < MTOK; m += NGW) { const float rs = pg8::rstd_of(ss, m);
        const v4u* hr = (const v4u*)(hb + (size_t)m * DM); f32x4* xr = (f32x4*)(out + (size_t)m * DM); const f32x4* gr = (const f32x4*)gfin;
#pragma unroll
        for (int j = 0; j < 4; ++j) { const v4u w = hr[lane + 64 * j]; const int c4 = 2 * (lane + 64 * j);
            const f32x4 g0 = gr[c4], g1 = gr[c4 + 1];
            xr[c4] = (f32x4){bflo(w.x) * rs * g0.x, bfhi(w.x) * rs * g0.y, bflo(w.y) * rs * g0.z, bfhi(w.y) * rs * g0.w};
            xr[c4 + 1] = (f32x4){bflo(w.z) * rs * g1.x, bfhi(w.z) * rs * g1.y, bflo(w.w) * rs * g1.z, bfhi(w.w) * rs * g1.w}; } }
}

#define PH(p) if (lo <= (p) && (p) < hi && (ran ? (xcd_barrier(bar), true) : (ran = true)))
#define TID() int tid = threadIdx.x; asm volatile("" : "+v"(tid)); const int lane = tid & 63, wave = __builtin_amdgcn_readfirstlane(tid >> 6); int bx = blockIdx.x; asm volatile("" : "+s"(bx)); (void)lane; (void)wave; (void)bx
#define WSP(T, off) ((T*)(ka->ws + (off)))
template <int j> DI void subblock(LAS unsigned char* lds, const XcdBarrier& bar, const int lo, const int hi, bool& ran) {
    {
        constexpr int layer = j / 3, typ = j - 3 * layer, base = 1 + 5 * j;
        if constexpr (typ != 1) {
            PH(base) { TID(); KArgs ka = kargs(); const int mi = layer * 2 + (typ >> 1);
                pg8::Gemm gm{WSP(bf16, WS_HB), WSP(bf16, WS_WUP) + (size_t)mi * NUP * DM, MTOK, NUP, DM}; pg8::StaticOrder S; S.init(MTOK, NUP, gridDim.x, bx);
                pg8::EpiSwiGLU E{WSP(bf16, WS_ACT), WSP(long long, WS_SS) + (size_t)j * MTOK, DFF};
                pg8::gemm_phase<pg8::EpiSwiGLU, pg8::StaticOrder, PG8_ALIGN, PG8_SP2>(lds, gm, S, E); }
        } else {
            constexpr int kind = layer % 3, ji = layer / 3;
            PH(base) { TID(); KArgs ka = kargs();
                mixer_gates(WSP(bf16, WS_HB), WSP(bf16, WS_WIN) + ((size_t)layer * NINP + NQKV) * DM, WSP(long long, WS_SS) + (size_t)j * MTOK, WSP(float, WS_G), lane, wave, bx);
                pg8::Gemm gm{WSP(bf16, WS_HB), WSP(bf16, WS_WIN) + (size_t)layer * NINP * DM, MTOK, NQKV, DM}; pg8::StaticOrder S; S.init(MTOK, NQKV, gridDim.x, bx);
                pg8::EpiMixIn E{WSP(bf16, WS_P1), WSP(long long, WS_SS) + (size_t)j * MTOK};
                pg8::gemm_phase<pg8::EpiMixIn, pg8::StaticOrder, PG8_ALIGN, PG8_SP2>(lds, gm, S, E); }
            PH(base + 1) { TID(); KArgs ka = kargs();
                if constexpr (kind == 0) for (int rep = 0; rep < REP_MLSTM; ++rep) mlstm_pre(lds, WSP(bf16, WS_P1), WSP(float, WS_G), ka->in[6] + ji * 16, WSP(unsigned char, WS_ACT), tid, lane, wave, bx);
                else if constexpr (kind == 1) { fox_cf(lds, WSP(float, WS_G), ka->in[10] + ji * 16, WSP(float, WS_CF), tid, lane, wave, bx); }
                else for (int rep = 0; rep < REP_GLA; ++rep) gla_pre(lds, WSP(bf16, WS_P1), WSP(float, WS_G), ka->in[13] + (size_t)ji * 16 * 1024, ka->in[14] + ji * 1024, WSP(unsigned char, WS_ACT), tid, lane, wave, bx);
            }
            PH(base + 2) { TID(); KArgs ka = kargs();
                if constexpr (kind == 0) for (int rep = 0; rep < REP_MLSTM; ++rep) mlstm_scan2(lds, WSP(bf16, WS_P1), WSP(unsigned char, WS_ACT), WSP(bf16, WS_HRAW), tid, lane, wave, bx);
                else if constexpr (kind == 1) for (int rep = 0; rep < REP_FOX; ++rep) fox_attn2(lds, WSP(bf16, WS_P1), WSP(float, WS_CF), WSP(bf16, WS_HM), tid, lane, wave, bx);
                else for (int rep = 0; rep < REP_GLA; ++rep) gla_scan2(lds, WSP(bf16, WS_P1), WSP(unsigned char, WS_ACT), WSP(bf16, WS_HRAW), tid, lane, wave, bx);
            }
            if constexpr (kind != 1) { PH(base + 3) { TID(); KArgs ka = kargs();
                if constexpr (kind == 0) headnorm_gate<256, 0>(WSP(bf16, WS_HRAW), WSP(bf16, WS_P1), ka->in[7] + ji * DM, WSP(bf16, WS_HM), lane, wave, bx);
                else headnorm_gate<512, 1>(WSP(bf16, WS_HRAW), WSP(bf16, WS_P1), ka->in[15] + ji * DM, WSP(bf16, WS_HM), lane, wave, bx);
            } }
        }
        PH(base + 4) { TID(); KArgs ka = kargs();
            pg8::Gemm gm; float scale;
            if constexpr (typ != 1) { const int mi = layer * 2 + (typ >> 1); gm = pg8::Gemm{WSP(bf16, WS_ACT), WSP(bf16, WS_WDN) + (size_t)mi * DM * DFF, MTOK, DM, DFF}; scale = 0.5f; }
            else { gm = pg8::Gemm{WSP(bf16, WS_HM), WSP(bf16, WS_WOUT) + (size_t)layer * DM * DM, MTOK, DM, DM}; scale = 1.0f; }
            pg8::StaticOrder S; S.init(MTOK, DM, gridDim.x, bx);
            pg8::EpiResid E{(j == 0) ? ka->in[0] : (const float*)nullptr, WSP(bf16, WS_HB), WSP(long long, WS_SS) + (size_t)(j + 1) * MTOK, scale};
            pg8::gemm_phase<pg8::EpiResid, pg8::StaticOrder, PG8_ALIGN, PG8_SP2>(lds, gm, S, E);
        }
    }
}

__global__ void __launch_bounds__(NWAVES * 64, 2) trunk_fwd(Args args) {
    extern __shared__ __attribute__((aligned(16))) unsigned char lds_raw[];
    LAS unsigned char* lds = (LAS unsigned char*)lds_raw;
    volatile LAS unsigned* MISC = (volatile LAS unsigned*)(lds + MISC_OFF);
    for (int u = threadIdx.x; u < (LDS_BYTES - MISC_OFF) / 4; u += NWAVES * 64) ((LAS unsigned*)(lds + MISC_OFF))[u] = 0u;
    __syncthreads();
    XcdBarrier bar = xcd_barrier_post((unsigned*)(args.ws + WS_CTL) + CW_BAR, MISC + 8);
    const int lo = args.ph_lo, hi = args.ph_hi; bool ran = false;

    PH(0) { TID(); for (int rep = 0; rep < REP_PRO; ++rep) { prologue(lds, lane, wave, bx); __syncthreads(); } }

    subblock<0>(lds, bar, lo, hi, ran); subblock<1>(lds, bar, lo, hi, ran); subblock<2>(lds, bar, lo, hi, ran); subblock<3>(lds, bar, lo, hi, ran);
    subblock<4>(lds, bar, lo, hi, ran); subblock<5>(lds, bar, lo, hi, ran); subblock<6>(lds, bar, lo, hi, ran); subblock<7>(lds, bar, lo, hi, ran);
    subblock<8>(lds, bar, lo, hi, ran); subblock<9>(lds, bar, lo, hi, ran); subblock<10>(lds, bar, lo, hi, ran); subblock<11>(lds, bar, lo, hi, ran);
    PH(NPHASE - 1) { TID(); KArgs ka = kargs(); final_norm(ka->out, WSP(bf16, WS_HB), WSP(long long, WS_SS) + (size_t)NSUB * MTOK, ka->in[17], lane, wave, bx); }
#undef WSP
#undef PH
}

static bool phase_exists(int p) {
    if (p == 0 || p == NPHASE - 1) return true;
    const int j = (p - 1) / 5, k = (p - 1) % 5, typ = j % 3;
    if (k == 0 || k == 4) return true;
    if (typ != 1) return false;
    if (k == 3) return ((j / 3) % 3) != 1;
    return true;
}
extern "C" void kernel_launch(void* const* d_in, const int* in_sizes, int n_in, void* d_out, int out_size, void* d_ws, size_t ws_size, hipStream_t stream) {
    static int grid = 0;
    if (grid == 0) {
        if (n_in != 18 || in_sizes[0] != MTOK * DM || out_size != MTOK * DM || ws_size < WS_END) { fprintf(stderr, "kernel_launch: unexpected shapes (n_in %d, in0 %d, out %d, ws %zu < %zu)\n", n_in, n_in > 0 ? in_sizes[0] : -1, out_size, ws_size, (size_t)WS_END); grid = -1; return; }
        int dev = 0, cus = 0, per_cu = 0;
        if (hipGetDevice(&dev) != hipSuccess || hipDeviceGetAttribute(&cus, hipDeviceAttributeMultiprocessorCount, dev) != hipSuccess) { grid = -1; return; }
        if (hipFuncSetAttribute((const void*)trunk_fwd, hipFuncAttributeMaxDynamicSharedMemorySize, LDS_BYTES) != hipSuccess) { fprintf(stderr, "kernel_launch: hipFuncSetAttribute failed\n"); grid = -1; return; }
        if (hipOccupancyMaxActiveBlocksPerMultiprocessor(&per_cu, (const void*)trunk_fwd, NWAVES * 64, LDS_BYTES) != hipSuccess || per_cu < 1) fprintf(stderr, "kernel_launch: occupancy query says %d\n", per_cu);
        (void)hipGetLastError();
        grid = cus;
    }
    if (grid < 0) return;
    if (hipMemsetAsync((char*)d_ws + WS_CTL, 0, CTL_ZERO_BYTES, stream) != hipSuccess) return;
    Args a{};
    for (int i = 0; i < 18; ++i) a.in[i] = (const float*)d_in[i];
    a.out = (float*)d_out; a.ws = (unsigned char*)d_ws;
#if MK_PER_PHASE
    for (int p = 0; p < NPHASE; ++p) { if (!phase_exists(p)) continue; a.ph_lo = p; a.ph_hi = p + 1; hipLaunchKernelGGL(trunk_fwd, dim3(grid), dim3(NWAVES * 64), LDS_BYTES, stream, a); }
#else
    a.ph_lo = 0; a.ph_hi = NPHASE; hipLaunchKernelGGL(trunk_fwd, dim3(grid), dim3(NWAVES * 64), LDS_BYTES, stream, a);
#endif
    (void)phase_exists;
}
```

```cpp
#include <hip/hip_runtime.h>
#include <cstdio>
#include <cstdint>
namespace pg8 {
#define PG8_LAS __attribute__((address_space(3)))
typedef unsigned short bf16_t;
typedef short bf16x8 __attribute__((ext_vector_type(8)));
typedef float f32x4 __attribute__((ext_vector_type(4)));
typedef unsigned u32x4 __attribute__((ext_vector_type(4)));
constexpr int BM = 256, BK = 64, HALF = 128, HTB = HALF * BK * 2  , STAGE_BYTES = 8 * HTB, NXCD = 8, WGM = 8;

__host__ __device__ __forceinline__ int lds_byte(int r, int c) { const int st = (r >> 4) * 2 + (c >> 5), rr = r & 15, cc = c & 31, ob = rr * 64 + cc * 2; return st * 1024 + (ob ^ (((ob >> 9) & 1) << 5)); }
__host__ __device__ __forceinline__ void stage_rc(int b, int& R, int& C) { const int st = b / 1024, sb = b % 1024, swz = sb ^ (((sb >> 9) & 1) << 5); R = (st >> 1) * 16 + swz / 64; C = (st & 1) * 32 + (swz % 64) / 2; }
__host__ __device__ __forceinline__ int perm32(int rho) { const int n = rho >> 4, i = rho & 15; return 8 * (i >> 2) + 4 * n + (i & 3); }

struct Unit { int pm, pn; };
struct Gemm { const bf16_t* A; const bf16_t* Bt; int M, N, K; };

struct StaticOrder {
    int nM, nN, nwg, G, c;
    __host__ __device__ void init(int M, int N, int G_, int c_) { nM = M / BM; nN = N / BM; nwg = nM * nN; G = G_; c = c_; }
    __host__ __device__ bool next(int i, Unit& u) const {
        const long L = (long)i * G + c; if (L >= nwg) return false;
        int wgid = (int)L; { const int q = nwg / NXCD, r = nwg % NXCD, xcd = wgid % NXCD, off = wgid / NXCD; wgid = (xcd < r ? xcd * (q + 1) : r * (q + 1) + (xcd - r) * q) + off; }
        const int nig = WGM * nN, gid = wgid / nig, fm = gid * WGM, gsz = (nM - fm) < WGM ? (nM - fm) : WGM;
        u.pm = fm + ((wgid % nig) % gsz); u.pn = (wgid % nig) / gsz; return true;
    }
    __device__ __forceinline__ void a_ready(const Unit&) const {}
    __device__ __forceinline__ void done(const Unit&) const {}
};

__device__ __forceinline__ unsigned cvt_pk_bf16(float lo, float hi) { unsigned r; asm volatile("v_cvt_pk_bf16_f32 %0, %1, %2" : "=v"(r) : "v"(lo), "v"(hi)); return r; }
constexpr float RMS_EPS_F = 1e-6f, SS_FIX = 1048576.0f, SS_UNFIX_D = 1.0f / (1048576.0f * 2048.0f);
typedef long long ss_t;
__device__ __forceinline__ float rstd_of(const ss_t* ss, int row) { return rsqrtf((float)ss[row] * SS_UNFIX_D + RMS_EPS_F); }
template <class Sched> __device__ __forceinline__ int rstd_table_fill(const Sched& S, const ss_t* ss, PG8_LAS unsigned char* ext, int tid) {
    PG8_LAS float* tab = (PG8_LAS float*)ext; int key0 = -1, key1 = -1, bad = 0; Unit u;
    for (int i = 0; S.next(i, u); ++i) { const int slot = (u.pm >> 3) & 1; const int key = slot ? key1 : key0;
        if (key == u.pm) continue;
        if (key >= 0) { bad = 1; continue; }
        if (slot) key1 = u.pm; else key0 = u.pm;
        if (tid < 256) tab[slot * 256 + tid] = rstd_of(ss, u.pm * BM + tid); }
    asm volatile("s_waitcnt lgkmcnt(0)" ::: "memory"); __builtin_amdgcn_s_barrier(); asm volatile("" ::: "memory");
    return bad;
}
__device__ __forceinline__ float rstd_get(const ss_t* ss, const Unit& u, int row, int pf, const PG8_LAS unsigned char* ext) {
    return pf ? rstd_of(ss, row) : ((const PG8_LAS float*)ext)[((u.pm >> 3) & 1) * 256 + (row - u.pm * BM)];
}
struct EpiSwiGLU {
    static constexpr bool PERM = true, AFTER_DRAIN = false;
    bf16_t* O; const ss_t* ss; int ldo;
    template <class Sched> __device__ __forceinline__ int prepare(const Sched& S, PG8_LAS unsigned char* ext, int tid) const { return rstd_table_fill(S, ss, ext, tid); }
    __device__ __forceinline__ void operator()(const f32x4 (&acc)[2][2][4][2], const Unit& u, int wr, int wc, int fr, int fq, int pf, const PG8_LAS unsigned char* ext) const {
        const int row0 = u.pm * BM + wr * 64 + fr, col0 = u.pn * HALF + wc * 32 + 8 * fq;
#pragma unroll
        for (int ai = 0; ai < 2; ++ai)
#pragma unroll
            for (int m = 0; m < 4; ++m) {
                const int row = row0 + ai * HALF + m * 16;
                const float rs = rstd_get(ss, u, row, pf, ext);
                float o[8];
#pragma unroll
                for (int n = 0; n < 2; ++n)
#pragma unroll
                    for (int j = 0; j < 4; ++j) { const float a = acc[ai][0][m][n][j] * rs, b = acc[ai][1][m][n][j] * rs;
                        o[4 * n + j] = a * b * __builtin_amdgcn_rcpf(1.0f + __expf(-a)); }
                u32x4 w; w.x = cvt_pk_bf16(o[0], o[1]); w.y = cvt_pk_bf16(o[2], o[3]); w.z = cvt_pk_bf16(o[4], o[5]); w.w = cvt_pk_bf16(o[6], o[7]);
                *(u32x4*)(O + (size_t)row * ldo + col0) = w;
            }
    }
};
struct EpiMixIn {
    static constexpr bool PERM = true, AFTER_DRAIN = false;
    bf16_t* O; const ss_t* ss;
    template <class Sched> __device__ __forceinline__ int prepare(const Sched& S, PG8_LAS unsigned char* ext, int tid) const { return rstd_table_fill(S, ss, ext, tid); }
    __device__ __forceinline__ void operator()(const f32x4 (&acc)[2][2][4][2], const Unit& u, int wr, int wc, int fr, int fq, int pf, const PG8_LAS unsigned char* ext) const {
        const int row0 = u.pm * BM + wr * 64 + fr, col0 = u.pn * BM + wc * 32 + 8 * fq;
#pragma unroll
        for (int ai = 0; ai < 2; ++ai)
#pragma unroll
            for (int m = 0; m < 4; ++m) {
                const int row = row0 + ai * HALF + m * 16;
                const float rs = rstd_get(ss, u, row, pf, ext);
#pragma unroll
                for (int bj = 0; bj < 2; ++bj) { const f32x4 v0 = acc[ai][bj][m][0] * rs, v1 = acc[ai][bj][m][1] * rs;
                    u32x4 w; w.x = cvt_pk_bf16(v0[0], v0[1]); w.y = cvt_pk_bf16(v0[2], v0[3]); w.z = cvt_pk_bf16(v1[0], v1[1]); w.w = cvt_pk_bf16(v1[2], v1[3]);
                    *(u32x4*)(O + (size_t)row * 6144 + col0 + bj * HALF) = w; }
            }
    }
};
struct EpiResid {
    static constexpr bool PERM = true, AFTER_DRAIN = false;
    const float* x0; bf16_t* hb; ss_t* ssn; float scale;
    template <class Sched> __device__ __forceinline__ int prepare(const Sched&, PG8_LAS unsigned char*, int) const { return 0; }
    __device__ __forceinline__ void operator()(const f32x4 (&acc)[2][2][4][2], const Unit& u, int wr, int wc, int fr, int fq, int pf, const PG8_LAS unsigned char* ext) const {
        const int row0 = u.pm * BM + wr * 64 + fr, col0 = u.pn * BM + wc * 32 + 8 * fq;
        u32x4 rb[3][2];
#define PG8_LDG(gi, buf) do { const size_t off_ = (size_t)(row0 + ((gi) >> 2) * HALF + ((gi) & 3) * 16) * 2048 + col0; \
            if (x0) { _Pragma("unroll") for (int q_ = 0; q_ < 2; ++q_) { const f32x4 a_ = *(const f32x4*)(x0 + off_ + q_ * HALF), b_ = *(const f32x4*)(x0 + off_ + q_ * HALF + 4); \
                buf[q_].x = cvt_pk_bf16(a_[0], a_[1]); buf[q_].y = cvt_pk_bf16(a_[2], a_[3]); buf[q_].z = cvt_pk_bf16(b_[0], b_[1]); buf[q_].w = cvt_pk_bf16(b_[2], b_[3]); } } \
            else { _Pragma("unroll") for (int q_ = 0; q_ < 2; ++q_) buf[q_] = *(const u32x4*)(hb + off_ + q_ * HALF); } } while (0)
        PG8_LDG(0, rb[0]); PG8_LDG(1, rb[1]);
#pragma unroll
        for (int gi = 0; gi < 8; ++gi) {
            if (gi + 2 < 8) PG8_LDG(gi + 2, rb[(gi + 2) % 3]);
            const int ai = gi >> 2, m = gi & 3;
            const int row = row0 + ai * HALF + m * 16; const size_t off = (size_t)row * 2048 + col0; float sq = 0.f;
#pragma unroll
            for (int bj = 0; bj < 2; ++bj) { const u32x4 hw = rb[gi % 3][bj];
                const f32x4 h0 = (f32x4){__uint_as_float(hw.x << 16), __uint_as_float(hw.x & 0xffff0000u), __uint_as_float(hw.y << 16), __uint_as_float(hw.y & 0xffff0000u)};
                const f32x4 h1 = (f32x4){__uint_as_float(hw.z << 16), __uint_as_float(hw.z & 0xffff0000u), __uint_as_float(hw.w << 16), __uint_as_float(hw.w & 0xffff0000u)};
                const f32x4 n0 = h0 + acc[ai][bj][m][0] * scale, n1 = h1 + acc[ai][bj][m][1] * scale;
                u32x4 w; w.x = cvt_pk_bf16(n0[0], n0[1]); w.y = cvt_pk_bf16(n0[2], n0[3]); w.z = cvt_pk_bf16(n1[0], n1[1]); w.w = cvt_pk_bf16(n1[2], n1[3]);
                *(u32x4*)(hb + off + bj * HALF) = w;
                const float r0 = __uint_as_float(w.x << 16), r1 = __uint_as_float(w.x & 0xffff0000u), r2 = __uint_as_float(w.y << 16), r3 = __uint_as_float(w.y & 0xffff0000u);
                const float r4 = __uint_as_float(w.z << 16), r5 = __uint_as_float(w.z & 0xffff0000u), r6 = __uint_as_float(w.w << 16), r7 = __uint_as_float(w.w & 0xffff0000u);
                sq += ((r0 * r0 + r1 * r1) + (r2 * r2 + r3 * r3)) + ((r4 * r4 + r5 * r5) + (r6 * r6 + r7 * r7)); }
            sq += __shfl_xor(sq, 16); sq += __shfl_xor(sq, 32);
            if (fq == 0) atomicAdd((unsigned long long*)(ssn + row), (unsigned long long)__float2ll_rn(sq * SS_FIX));
        }
#undef PG8_LDG
    }
};

template <class Epi, class Sched, bool ALIGN_EPI = false, bool SP2 = false>
__device__ __forceinline__ void gemm_phase(PG8_LAS unsigned char* lds, const Gemm g, const Sched& S, const Epi& E) {
    int tid_ = threadIdx.x; asm volatile("" : "+v"(tid_));
    const int tid = tid_, wid = __builtin_amdgcn_readfirstlane(tid >> 6), lane = tid & 63, wr = wid >> 2, wc = wid & 3, fr = lane & 15, fq = lane >> 4;
    const int K = g.K, nt = K / BK;
    unsigned voffA[2], voffB[2];
#pragma unroll
    for (int i = 0; i < 2; ++i) { int R, C; stage_rc(tid * 16 + i * 8192, R, C); const int Rb = Epi::PERM ? ((R & ~31) + perm32(R & 31)) : R;
        voffA[i] = (unsigned)(R * K + C) * 2u; voffB[i] = (unsigned)(Rb * K + C) * 2u; }
    const size_t kstep = (size_t)(BK * 2);
    const size_t hstep = (size_t)HALF * K * 2;
    const size_t tstep = 2 * hstep;
    const unsigned ldsw = (unsigned)wid * 1024u;
    const int aoff = lds_byte(wr * 64 + fr, fq * 8), boff = lds_byte(wc * 32 + fr, fq * 8);
#define PG8_SA(b, h) (((b) * 2 + (h)) * HTB)
#define PG8_SB(b, h) ((4 + (b) * 2 + (h)) * HTB)
#define PG8_STAGE(bufoff, gbase, voff) do { _Pragma("unroll") for (int _i = 0; _i < 2; ++_i) \
        __builtin_amdgcn_global_load_lds((const unsigned*)((const char*)(gbase) + (voff)[_i]), (PG8_LAS unsigned*)(lds + (bufoff) + ldsw + _i * 8192), 16, 0, 0); } while (0)
#define PG8_LDA(dst, b, h) do { _Pragma("unroll") for (int m = 0; m < 4; ++m) _Pragma("unroll") for (int k = 0; k < 2; ++k) dst[m][k] = *(const PG8_LAS bf16x8*)(lds + PG8_SA(b, h) + aoff + m * 2048 + k * 1024); } while (0)
#define PG8_LDB(dst, b, h) do { _Pragma("unroll") for (int n = 0; n < 2; ++n) _Pragma("unroll") for (int k = 0; k < 2; ++k) dst[n][k] = *(const PG8_LAS bf16x8*)(lds + PG8_SB(b, h) + boff + n * 2048 + k * 1024); } while (0)
#define PG8_MMA(ai, bj, At, Bt) do { __builtin_amdgcn_s_setprio(1); _Pragma("unroll") for (int m = 0; m < 4; ++m) _Pragma("unroll") for (int n = 0; n < 2; ++n) _Pragma("unroll") for (int k = 0; k < 2; ++k) \
        acc[ai][bj][m][n] = __builtin_amdgcn_mfma_f32_16x16x32_bf16(Bt[n][k], At[m][k], acc[ai][bj][m][n], 0, 0, 0); __builtin_amdgcn_s_setprio(0); } while (0)
#define PG8_WAIT_V(n) asm volatile("s_waitcnt vmcnt(" #n ")" ::: "memory")
#define PG8_WAIT_L(n) asm volatile("s_waitcnt lgkmcnt(" #n ")" ::: "memory")
#define PG8_BAR __builtin_amdgcn_s_barrier()
#define PG8_SCHED __builtin_amdgcn_sched_barrier(0)
    const int pf = E.prepare(S, lds + STAGE_BYTES, tid);
    Unit cur, nxt; int ui = 0;
    if (!S.next(0, cur)) return;
    f32x4 acc[2][2][4][2];
#pragma unroll
    for (int a = 0; a < 2; ++a)
#pragma unroll
        for (int b = 0; b < 2; ++b)
#pragma unroll
            for (int m = 0; m < 4; ++m)
#pragma unroll
                for (int n = 0; n < 2; ++n) acc[a][b][m][n] = (f32x4){0.f, 0.f, 0.f, 0.f};
    bf16x8 At[4][2], B0[2][2], B1[2][2];
    const char* cA = (const char*)g.A + (size_t)cur.pm * tstep; const char* cB = (const char*)g.Bt + (size_t)cur.pn * tstep;
    S.a_ready(cur);
    if constexpr (SP2) {
        PG8_STAGE(PG8_SB(0, 0), cB, voffB); PG8_STAGE(PG8_SB(0, 1), cB + hstep, voffB); PG8_STAGE(PG8_SA(0, 0), cA, voffA); PG8_STAGE(PG8_SA(0, 1), cA + hstep, voffA);
        if (wr == 1) PG8_BAR;
        PG8_WAIT_V(2); PG8_BAR;
        PG8_STAGE(PG8_SB(1, 0), cB + kstep, voffB); PG8_STAGE(PG8_SA(1, 0), cA + kstep, voffA); PG8_STAGE(PG8_SB(1, 1), cB + hstep + kstep, voffB);
        PG8_WAIT_V(6); PG8_BAR;
    } else {
        PG8_STAGE(PG8_SB(0, 0), cB, voffB); PG8_STAGE(PG8_SA(0, 0), cA, voffA); PG8_STAGE(PG8_SB(0, 1), cB + hstep, voffB); PG8_STAGE(PG8_SA(0, 1), cA + hstep, voffA);
        if (wr == 1) PG8_BAR;
        PG8_WAIT_V(4); PG8_BAR;
        PG8_STAGE(PG8_SB(1, 0), cB + kstep, voffB); PG8_STAGE(PG8_SA(1, 0), cA + kstep, voffA); PG8_STAGE(PG8_SB(1, 1), cB + hstep + kstep, voffB);
        PG8_WAIT_V(6); PG8_BAR;
    }
    for (;;) {
        const bool has_next = S.next(ui + 1, nxt);
        const char* nA = has_next ? (const char*)g.A + (size_t)nxt.pm * tstep : cA; const char* nB = has_next ? (const char*)g.Bt + (size_t)nxt.pn * tstep : cB;
        for (int t = 0; t < nt; t += 2) {
            const bool last = (t == nt - 2);
            const char* a1 = cA + (size_t)(t + 1) * kstep;
            const char* a2 = last ? nA : cA + (size_t)(t + 2) * kstep; const char* b2 = last ? nB : cB + (size_t)(t + 2) * kstep;
            const char* a3 = a2 + kstep; const char* b3 = b2 + kstep;
            if (last && has_next) S.a_ready(nxt);
            if constexpr (SP2) {
            PG8_LDB(B0, 0, 0); PG8_LDB(B1, 0, 1); PG8_SCHED; PG8_LDA(At, 0, 0); PG8_STAGE(PG8_SA(1, 1), a1 + hstep, voffA);
            PG8_WAIT_V(8); PG8_WAIT_L(0); PG8_BAR; PG8_MMA(0, 0, At, B0); PG8_MMA(0, 1, At, B1); PG8_BAR; PG8_SCHED;
            PG8_LDA(At, 0, 1); PG8_STAGE(PG8_SB(0, 0), b2, voffB); PG8_STAGE(PG8_SB(0, 1), b2 + hstep, voffB); PG8_STAGE(PG8_SA(0, 0), a2, voffA);
            PG8_WAIT_V(8); PG8_WAIT_L(0); PG8_BAR; PG8_MMA(1, 0, At, B0); PG8_MMA(1, 1, At, B1); PG8_BAR; PG8_SCHED;
            PG8_LDB(B0, 1, 0); PG8_LDB(B1, 1, 1); PG8_SCHED; PG8_LDA(At, 1, 0); PG8_STAGE(PG8_SA(0, 1), a2 + hstep, voffA);
            PG8_WAIT_V(8); PG8_WAIT_L(0); PG8_BAR; PG8_MMA(0, 0, At, B0); PG8_MMA(0, 1, At, B1); PG8_BAR; PG8_SCHED;
            PG8_LDA(At, 1, 1); PG8_STAGE(PG8_SB(1, 0), b3, voffB); PG8_STAGE(PG8_SB(1, 1), b3 + hstep, voffB); PG8_STAGE(PG8_SA(1, 0), a3, voffA);
            PG8_WAIT_V(8); PG8_WAIT_L(0); PG8_BAR; PG8_MMA(1, 0, At, B0); PG8_MMA(1, 1, At, B1); PG8_BAR; PG8_SCHED;
            } else {
            PG8_LDB(B0, 0, 0); PG8_SCHED; PG8_LDA(At, 0, 0); PG8_STAGE(PG8_SA(1, 1), a1 + hstep, voffA);
            PG8_WAIT_L(8); PG8_BAR; PG8_WAIT_L(0); PG8_MMA(0, 0, At, B0); PG8_BAR; PG8_SCHED;
            PG8_LDB(B1, 0, 1); PG8_STAGE(PG8_SB(0, 0), b2, voffB);
            PG8_BAR; PG8_WAIT_L(0); PG8_MMA(0, 1, At, B1); PG8_BAR;
            PG8_LDA(At, 0, 1); PG8_STAGE(PG8_SA(0, 0), a2, voffA);
            PG8_BAR; PG8_WAIT_L(0); PG8_MMA(1, 0, At, B0); PG8_BAR; PG8_SCHED;
            PG8_STAGE(PG8_SB(0, 1), b2 + hstep, voffB);
            PG8_WAIT_V(6); PG8_BAR; PG8_MMA(1, 1, At, B1); PG8_BAR;
            PG8_LDB(B0, 1, 0); PG8_SCHED; PG8_LDA(At, 1, 0); PG8_STAGE(PG8_SA(0, 1), a2 + hstep, voffA);
            PG8_WAIT_L(8); PG8_BAR; PG8_WAIT_L(0); PG8_MMA(0, 0, At, B0); PG8_BAR; PG8_SCHED;
            PG8_LDB(B1, 1, 1); PG8_STAGE(PG8_SB(1, 0), b3, voffB);
            PG8_BAR; PG8_WAIT_L(0); PG8_MMA(0, 1, At, B1); PG8_BAR;
            PG8_LDA(At, 1, 1); PG8_STAGE(PG8_SA(1, 0), a3, voffA);
            PG8_BAR; PG8_WAIT_L(0); PG8_MMA(1, 0, At, B0); PG8_BAR; PG8_SCHED;
            PG8_STAGE(PG8_SB(1, 1), b3 + hstep, voffB);
            PG8_WAIT_V(6); PG8_BAR; PG8_MMA(1, 1, At, B1); PG8_BAR;
            }
        }
        if constexpr (ALIGN_EPI) { if (wr == 0) PG8_BAR; }
        if constexpr (!Epi::AFTER_DRAIN) { E(acc, cur, wr, wc, fr, fq, pf, lds + STAGE_BYTES); S.done(cur); }
        if (!has_next) break;
#pragma unroll
        for (int a = 0; a < 2; ++a)
#pragma unroll
            for (int b = 0; b < 2; ++b)
#pragma unroll
                for (int m = 0; m < 4; ++m)
#pragma unroll
                    for (int n = 0; n < 2; ++n) acc[a][b][m][n] = (f32x4){0.f, 0.f, 0.f, 0.f};
        cur = nxt; cA = nA; cB = nB; ++ui;
        if constexpr (ALIGN_EPI) { if (wr == 1) PG8_BAR; }
    }
    PG8_WAIT_V(0);
    if constexpr (!ALIGN_EPI) { if (wr == 0) PG8_BAR; }
    PG8_BAR;
    if constexpr (Epi::AFTER_DRAIN) { E.fused(acc, cur, wr, wc, fr, fq, lds, wid, lane); S.done(cur); }
#undef PG8_SA
#undef PG8_SB
#undef PG8_STAGE
#undef PG8_LDA
#undef PG8_LDB
#undef PG8_MMA
#undef PG8_WAIT_V
#undef PG8_WAIT_L
#undef PG8_BAR
#undef PG8_SCHED
}
}

#ifndef PG8_SP2
#define PG8_SP2 true
#endif
#ifndef PG8_ALIGN
#define PG8_ALIGN true
#endif
#ifndef REP_PRO
#define REP_PRO 1
#endif
#ifndef REP_MLSTM
#define REP_MLSTM 1
#endif
#ifndef REP_FOX
#define REP_FOX 1
#endif
#ifndef REP_GLA
#define REP_GLA 1
#endif
#ifndef MK_PER_PHASE
#define MK_PER_PHASE 0
#endif

constexpr int DM = 2048, BATCH = 8, SEQ = 4096, MTOK = BATCH * SEQ, DEPTH = 4, DFF = 5632, NUP = 2 * DFF, NIN = 6160, NINP = 6400, NQKV = 6144;
constexpr int NWAVES = 8;
constexpr int NSUB = 3 * DEPTH;
constexpr int NPHASE = 2 + 5 * NSUB;

constexpr size_t MiB = 1u << 20;
constexpr size_t WS_CTL = 0, CTL_ZERO_BYTES = 5 * MiB;
constexpr size_t WS_SS = 1 * MiB;
constexpr size_t WS_WUP = 8 * MiB;
constexpr size_t WS_WDN = WS_WUP + 352 * MiB;
constexpr size_t WS_WIN = WS_WDN + 176 * MiB;
constexpr size_t WS_WOUT = WS_WIN + 100 * MiB;
constexpr size_t WS_HB = WS_WOUT + 32 * MiB;
constexpr size_t WS_ACT = WS_HB + 128 * MiB;
constexpr size_t WS_P1 = WS_ACT + 352 * MiB;
constexpr size_t WS_G = WS_P1 + 384 * MiB;
constexpr size_t WS_HRAW = WS_G + 2 * MiB;
constexpr size_t WS_HM = WS_HRAW + 256 * MiB;
constexpr size_t WS_CF = WS_HM + 128 * MiB;
constexpr size_t WS_END = WS_CF + 2 * MiB;
static_assert((size_t)8 * NUP * DM * 2 == 352 * MiB && (size_t)8 * DM * DFF * 2 == 176 * MiB && (size_t)4 * NINP * DM * 2 == 100 * MiB, "weight regions");
static_assert((size_t)MTOK * DFF * 2 == 352 * MiB && (size_t)MTOK * NQKV * 2 == 384 * MiB && WS_SS + 13 * (size_t)MTOK * 8 <= CTL_ZERO_BYTES, "activation regions");
constexpr int CW_BAR = 4096;

constexpr int LDS_BYTES = 153600, MISC_OFF = 152576;

#define GAS __attribute__((address_space(1)))
#define LAS __attribute__((address_space(3)))
#define DI __device__ __forceinline__
typedef unsigned short bf16;
typedef unsigned v4u __attribute__((ext_vector_type(4)));
typedef unsigned v2u __attribute__((ext_vector_type(2)));
typedef float f32x4 __attribute__((ext_vector_type(4)));
typedef short bf16x8 __attribute__((ext_vector_type(8)));
typedef GAS unsigned gu32;
#define RLX_AGENT __ATOMIC_RELAXED, __HIP_MEMORY_SCOPE_AGENT
#define LDS_WAIT() asm volatile("s_waitcnt lgkmcnt(0)" ::: "memory")
DI unsigned f2bf(float f) { unsigned r; asm("v_cvt_pk_bf16_f32 %0, %1, %1" : "=v"(r) : "v"(f)); return r & 0xffffu; }
DI unsigned pk2(float lo, float hi) { unsigned r; asm("v_cvt_pk_bf16_f32 %0, %1, %2" : "=v"(r) : "v"(lo), "v"(hi)); return r; }
DI float bf2f(unsigned short v) { return __builtin_bit_cast(float, (unsigned)v << 16); }
DI float bflo(unsigned w) { return __builtin_bit_cast(float, w << 16); }
DI float bfhi(unsigned w) { return __builtin_bit_cast(float, w & 0xffff0000u); }
DI float logsig(float x) { return fminf(x, 0.f) - log1pf(expf(-fabsf(x))); }

#define XB_TMO      128
#define XB_XCNT(j)  (256  + 64 * (j))
#define XB_XSUB(j)  (1280 + 64 * (j))
#define XB_XGEN(j)  (2304 + 64 * (j))
#define XB_TOP      3328
#define XB_TOPGEN   3392
#define XCD_BAR_WORDS 3456
#define XB_SPIN_CAP (1u << 18)

__device__ __forceinline__ unsigned xb_ld(unsigned* p)              { return __hip_atomic_load(p, __ATOMIC_RELAXED, __HIP_MEMORY_SCOPE_AGENT); }
__device__ __forceinline__ unsigned xb_add(unsigned* p, unsigned v) { return __hip_atomic_fetch_add(p, v, __ATOMIC_RELAXED, __HIP_MEMORY_SCOPE_AGENT); }
__device__ __forceinline__ unsigned xb_xcc_id() { return (unsigned)__builtin_amdgcn_s_getreg((3 << 11) | 20) & 0xFu; }
#define XB_SPIN(cond, bar) do { unsigned _sp = 0; while (cond) { __builtin_amdgcn_s_sleep(1); \
    if ((++_sp & 255u) == 0u) { if (xb_ld(&(bar)[XB_TMO])) break; if (_sp > XB_SPIN_CAP) { atomicAdd(&(bar)[XB_TMO], 1u); break; } } } } while (0)

struct XcdBarrier {
    unsigned* bar; unsigned x;
    volatile LAS unsigned* st;
};

__device__ __forceinline__ XcdBarrier xcd_barrier_post(unsigned* bar, volatile LAS unsigned* st) {
    XcdBarrier b; b.bar = bar; b.x = xb_xcc_id(); b.st = st;
    if (threadIdx.x == 0) (void)xb_add(&bar[XB_XCNT(b.x)], 1u);
    return b;
}
__device__ __forceinline__ void xcd_barrier_complete(unsigned* bar, unsigned x, unsigned& nloc, unsigned& nx) {
    const unsigned G = gridDim.x * gridDim.y * gridDim.z;
    unsigned sum, cnt, mine, sp = 0u;
    for (;;) {
        sum = 0u; cnt = 0u; mine = 0u;
#pragma unroll
        for (unsigned j = 0; j < 16; ++j) { const unsigned c = xb_ld(&bar[XB_XCNT(j)]); sum += c; cnt += (c > 0u) ? 1u : 0u; mine = (j == x) ? c : mine; }
        if (sum == G) break;
        __builtin_amdgcn_s_sleep(1);
        if ((++sp & 255u) == 0u) { if (xb_ld(&bar[XB_TMO])) break; if (sp > XB_SPIN_CAP) { atomicAdd(&bar[XB_TMO], 1u); break; } }
    }
    nloc = mine > 0u ? mine : 1u; nx = cnt > 0u ? cnt : 1u;
}

__device__ __forceinline__ void xcd_barrier(const XcdBarrier& b) {
    asm volatile("s_waitcnt vmcnt(0)" ::: "memory");
    __syncthreads();
    if (threadIdx.x == 0) {
        unsigned* bar = b.bar;
        __builtin_amdgcn_s_waitcnt(0);
        unsigned nloc = b.st[0], nx = b.st[1];
        if (nloc == 0u) { xcd_barrier_complete(bar, b.x, nloc, nx); b.st[0] = nloc; b.st[1] = nx; }
        const unsigned old = xb_add(&bar[XB_XSUB(b.x)], 1u);
        const unsigned gen = old / nloc;
        if (old + 1u == (gen + 1u) * nloc) {
            __builtin_amdgcn_fence(__ATOMIC_RELEASE, "agent");
            asm volatile("s_waitcnt vmcnt(0)" ::: "memory");
            const unsigned og = xb_add(&bar[XB_TOP], 1u);
            const unsigned tg = og / nx;
            if (og + 1u == (tg + 1u) * nx) xb_add(&bar[XB_TOPGEN], 1u);
            else XB_SPIN(xb_ld(&bar[XB_TOPGEN]) == tg, bar);
            __builtin_amdgcn_fence(__ATOMIC_ACQUIRE, "agent");
            xb_add(&bar[XB_XGEN(b.x)], 1u);
            asm volatile("s_waitcnt vmcnt(0)" ::: "memory");
        } else {
            XB_SPIN(xb_ld(&bar[XB_XGEN(b.x)]) == gen, bar);
            __builtin_amdgcn_fence(__ATOMIC_ACQUIRE, "agent");
            asm volatile("s_waitcnt vmcnt(0)" ::: "memory");
        }
    }
    __syncthreads();
}


DI float wave_sum(float v) {
#pragma unroll
    for (int o = 1; o < 64; o <<= 1) v += __shfl_xor(v, o);
    return v;
}
DI float wave_max(float v) {
#pragma unroll
    for (int o = 1; o < 64; o <<= 1) v = fmaxf(v, __shfl_xor(v, o));
    return v;
}
DI float wave_incl_sum(float v, int lane) {
#pragma unroll
    for (int o = 1; o < 64; o <<= 1) { const float t = __shfl_up(v, o); if (lane >= o) v += t; }
    return v;
}
DI float wave_incl_max(float v, int lane) {
#pragma unroll
    for (int o = 1; o < 64; o <<= 1) { const float t = __shfl_up(v, o); if (lane >= o) v = fmaxf(v, t); }
    return v;
}

template <int L> DI int swx(int r) { return L == 64 ? ((r >> 1) & 7) : (r & 15); }
template <int L> DI int eoff(int r, int c) { return r * L + ((((c >> 3) ^ swx<L>(r)) << 3) | (c & 7)); }
template <int L> DI bf16x8 ldf(const LAS bf16* base, int r, int ch) { return *(const LAS bf16x8*)(base + r * L + ((ch ^ swx<L>(r)) << 3)); }
DI f32x4 mfma16(bf16x8 a, bf16x8 b, f32x4 c) { return __builtin_amdgcn_mfma_f32_16x16x32_bf16(a, b, c, 0, 0, 0); }
typedef short v4i16_t __attribute__((ext_vector_type(4)));
DI v4i16_t tr_read(const LAS unsigned char* p) { return __builtin_amdgcn_ds_read_tr16_b64_v4i16((LAS v4i16_t*)p); }
DI bf16x8 cat4(v4i16_t lo, v4i16_t hi) { bf16x8 r; r[0] = lo[0]; r[1] = lo[1]; r[2] = lo[2]; r[3] = lo[3]; r[4] = hi[0]; r[5] = hi[1]; r[6] = hi[2]; r[7] = hi[3]; return r; }
DI unsigned off_v64(unsigned row, unsigned ch) { return 128u * row + 16u * (ch ^ ((((row >> 1) & 1u) << 1) | (((row >> 3) & 1u) << 2))); }
DI bf16x8 vfrag64(const LAS unsigned char* vb, int c, int ks, int lane) { const unsigned g = lane >> 4, q = (lane & 15) >> 2, p = lane & 3;
    return cat4(tr_read(vb + off_v64(32 * ks + 8 * g + q, 2 * c + (p >> 1)) + 8 * (p & 1)), tr_read(vb + off_v64(32 * ks + 8 * g + 4 + q, 2 * c + (p >> 1)) + 8 * (p & 1))); }
template <int LA, int LB, int NK> DI void mma_tile(f32x4& acc, const LAS bf16* A, int ra0, const LAS bf16* B, int rb0, int lane) {
    const int r = lane & 15, g = lane >> 4;
#pragma unroll
    for (int kk = 0; kk < NK; ++kk) { const bf16x8 a = ldf<LA>(A, ra0 + r, 4 * kk + g), b = ldf<LB>(B, rb0 + r, 4 * kk + g); acc = mfma16(a, b, acc); }
}

struct ConvItem { const float* W; const float* gk; bf16* WT; int K, N, mode, r; };
DI void conv_load(const ConvItem& c, int lane, f32x4 (&v)[8], float (&gv)[8]) {
    const int nkb = c.K / 64, nb = c.r / nkb, kb = c.r - nb * nkb, k0 = 64 * kb, n0 = 32 * nb;
    const int n = n0 + 4 * (lane & 7); const bool ok = n < c.N;
#pragma unroll
    for (int i = 0; i < 8; ++i) { const int kk = 8 * i + (lane >> 3); v[i] = ok ? *(const f32x4*)(c.W + (size_t)(k0 + kk) * c.N + n) : (f32x4){0.f, 0.f, 0.f, 0.f}; gv[i] = c.gk ? c.gk[k0 + kk] : 1.0f; }
}
DI void conv_store(const ConvItem& c, int lane, const f32x4 (&v)[8], const float (&gv)[8], LAS float* scr) {
    const int nkb = c.K / 64, nb = c.r / nkb, kb = c.r - nb * nkb, k0 = 64 * kb, n0 = 32 * nb, nq = 4 * (lane & 7);
#pragma unroll
    for (int i = 0; i < 8; ++i) { const int kk = 8 * i + (lane >> 3); LAS float* d = scr + kk * 33 + nq; d[0] = v[i].x * gv[i]; d[1] = v[i].y * gv[i]; d[2] = v[i].z * gv[i]; d[3] = v[i].w * gv[i]; }
    LDS_WAIT(); asm volatile("" ::: "memory");
    int row_off = n0;
    if (c.mode == 1) { const int j = n0 < DFF ? n0 : n0 - DFF; row_off = 256 * (j >> 7) + (j & 127) + (n0 < DFF ? 0 : 128); }
    const int cc = lane & 7;
#pragma unroll
    for (int j = 0; j < 4; ++j) { const int nn = (lane >> 3) + 8 * j; const LAS float* s = scr + (8 * cc) * 33 + nn;
        v4u o; o.x = pk2(s[0 * 33], s[1 * 33]); o.y = pk2(s[2 * 33], s[3 * 33]); o.z = pk2(s[4 * 33], s[5 * 33]); o.w = pk2(s[6 * 33], s[7 * 33]);
        *(v4u*)(c.WT + (size_t)(row_off + nn) * c.K + k0 + 8 * cc) = o; }
    LDS_WAIT(); asm volatile("" ::: "memory");
}

struct Args { const float* in[18]; float* out; unsigned char* ws; int ph_lo, ph_hi; };

typedef const __attribute__((address_space(4))) Args* KArgs;
DI KArgs kargs() { KArgs p = (KArgs)__builtin_amdgcn_kernarg_segment_ptr(); asm volatile("" : "+s"(p)); return p; }
DI void prologue(LAS unsigned char* lds, int lane, int wave, int bx) {
    KArgs AP = kargs();
    LAS float* scr = (LAS float*)(lds + wave * 16384);
    const int gw = bx * NWAVES + wave, NGW = gridDim.x * NWAVES;
    unsigned char* ws = AP->ws;
    constexpr int I_UP = (DM / 64) * (NUP / 32), I_DN = (DFF / 64) * (DM / 32), I_IN = (DM / 64) * (NINP / 32), I_OUT = (DM / 64) * (DM / 32);
    constexpr int NITEMS = 8 * I_UP + 8 * I_DN + 4 * I_IN + 4 * I_OUT;
#define CONV_DECODE(it_, c_) do { int r = (it_); (c_).gk = nullptr; (c_).K = DM; (c_).mode = 0; \
        if (r < 8 * I_UP) { const int mi = r / I_UP; r -= mi * I_UP; (c_).W = AP->in[2] + (size_t)mi * DM * NUP; (c_).gk = AP->in[1] + (size_t)mi * DM; (c_).WT = (bf16*)(ws + WS_WUP) + (size_t)mi * NUP * DM; (c_).N = NUP; (c_).mode = 1; } \
        else if (r < 8 * I_UP + 8 * I_DN) { r -= 8 * I_UP; const int mi = r / I_DN; r -= mi * I_DN; (c_).W = AP->in[3] + (size_t)mi * DFF * DM; (c_).WT = (bf16*)(ws + WS_WDN) + (size_t)mi * DM * DFF; (c_).K = DFF; (c_).N = DM; } \
        else if (r < 8 * I_UP + 8 * I_DN + 4 * I_IN) { r -= 8 * I_UP + 8 * I_DN; const int l = r / I_IN; r -= l * I_IN; const int kind = l % 3, ji = l / 3; \
            (c_).W = AP->in[kind == 0 ? 5 : kind == 1 ? 9 : 12] + (size_t)ji * DM * NIN; (c_).gk = AP->in[4] + (size_t)l * DM; (c_).WT = (bf16*)(ws + WS_WIN) + (size_t)l * NINP * DM; (c_).N = NIN; } \
        else { r -= 8 * I_UP + 8 * I_DN + 4 * I_IN; const int l = r / I_OUT; r -= l * I_OUT; const int kind = l % 3, ji = l / 3; \
            (c_).W = AP->in[kind == 0 ? 8 : kind == 1 ? 11 : 16] + (size_t)ji * DM * DM; (c_).WT = (bf16*)(ws + WS_WOUT) + (size_t)l * DM * DM; (c_).N = DM; } \
        (c_).r = r; } while (0)
    f32x4 va[8]; float ga[8]; ConvItem ca{}, cb{};
    if (gw < NITEMS) { CONV_DECODE(gw, ca); conv_load(ca, lane, va, ga); }
    for (int it = gw; it < NITEMS; it += NGW) {
        f32x4 vb[8]; float gb[8]; const int nx = it + NGW;
        if (nx < NITEMS) { CONV_DECODE(nx, cb); conv_load(cb, lane, vb, gb); }
        conv_store(ca, lane, va, ga, scr);
        ca = cb;
#pragma unroll
        for (int i = 0; i < 8; ++i) { va[i] = vb[i]; ga[i] = gb[i]; }
    }
#undef CONV_DECODE
    const float* x = AP->in[0]; bf16* hb = (bf16*)(ws + WS_HB); long long* ss0 = (long long*)(ws + WS_SS);
    for (int m = gw; m < MTOK; m += NGW) {
        const f32x4* xr = (const f32x4*)(x + (size_t)m * DM) + lane; f32x4 v[8]; float s = 0.f;
#pragma unroll
        for (int j = 0; j < 8; ++j) { v[j] = xr[64 * j]; s += (v[j].x * v[j].x + v[j].y * v[j].y) + (v[j].z * v[j].z + v[j].w * v[j].w); }
        s = wave_sum(s);
        v2u* o8 = (v2u*)(hb + (size_t)m * DM) + lane;
#pragma unroll
        for (int j = 0; j < 8; ++j) { v2u w; w.x = pk2(v[j].x, v[j].y); w.y = pk2(v[j].z, v[j].w); o8[64 * j] = w; }
        if (lane == 0) ss0[m] = __float2ll_rn(s * 1048576.0f);
    }
}

constexpr int IMGM_P = 0, IMGM_KT = 8192, IMGM_VT = IMGM_KT + 16384, IMGM_GS = IMGM_VT + 4 * 8192, IMGM_BYTES = IMGM_GS + 1024;
constexpr int IMGG_Q = 0, IMGG_KT = 32768, IMGG_P = 65536, IMGG_VT = IMGG_P + 8192, IMGG_EB = IMGG_VT + 8 * 8192, IMGG_BYTES = IMGG_EB + 1024;
static_assert((size_t)IMGM_BYTES * 4096 <= 352 * MiB && (size_t)IMGG_BYTES * 2048 <= 352 * MiB, "images overlay the (idle) FFN activation buffer");
DI unsigned pk2_sw(float lo, float hi) { unsigned a = __builtin_bit_cast(unsigned, lo), b = __builtin_bit_cast(unsigned, hi); a = (a + 0x7fffu + ((a >> 16) & 1u)) >> 16; b = (b + 0x7fffu + ((b >> 16) & 1u)) & 0xffff0000u; return a | b; }
DI float logsig_fast(float x) { return fminf(x, 0.f) - __logf(1.0f + __expf(-fabsf(x))); }

DI void mlstm_pre(LAS unsigned char* lds, const bf16* P1, const float* G, const float* b_if, unsigned char* img, int tid, int lane, int wave, int bx) {
    LAS bf16* Qs = (LAS bf16*)lds;
    LAS bf16* Ks = Qs + 64 * 128;
    LAS bf16* KTs = Ks + 64 * 128;
    LAS bf16* Ps = KTs + 128 * 64;
    LAS bf16* VT = Ps + 64 * 64;
    LAS float* fa = (LAS float*)(VT + 256 * 64);
    LAS float *bcum = fa, *ipre = fa + 64, *aloc = fa + 128, *wloc = fa + 192, *scal = fa + 256;
    const float KSCALE = 0.08838834764831845f;
    const int g = lane >> 4, r16 = lane & 15;
    v4u pq[2], pk[2]; float pgi = 0.f, pgf = 0.f;
#define MLP_LOAD(it_) do { const int b_ = (it_) >> 9, c_ = ((it_) >> 3) & 63, h_ = (it_) & 7; const int row0_ = b_ * SEQ + c_ * 64; \
        _Pragma("unroll") for (int p = 0; p < 2; ++p) { const int idx = tid + 512 * p, r = idx >> 4, c8 = idx & 15; const bf16* src = P1 + (size_t)(row0_ + r) * NQKV + h_ * 128 + c8 * 8; pq[p] = *(const v4u*)src; pk[p] = *(const v4u*)(src + 1024); } \
        if (tid < 64) { const float* gp = G + (size_t)(row0_ + tid) * 16; pgi = gp[h_]; pgf = gp[8 + h_]; } } while (0)
    if (bx < 4096) MLP_LOAD(bx);
    for (int item = bx; item < 4096; item += gridDim.x) {
        const int h = item & 7;
        unsigned char* im = img + (size_t)item * IMGM_BYTES;
        __syncthreads();
        if (tid < 64) { ipre[tid] = pgi + b_if[h]; bcum[tid] = logsig(pgf + b_if[8 + h]); }
#pragma unroll
        for (int p = 0; p < 2; ++p) { const int idx = tid + 512 * p, r = idx >> 4, c8 = idx & 15; *(LAS v4u*)(Qs + eoff<128>(r, c8 * 8)) = pq[p]; *(LAS v4u*)(Ks + eoff<128>(r, c8 * 8)) = pk[p]; }
        __syncthreads();
        if (wave == 0) {
            const float bt = wave_incl_sum(bcum[lane], lane), ip = ipre[lane];
            const float al = bt + wave_incl_max(ip - bt, lane);
            const float blast = __shfl(bt, 63);
            const float gg = blast - bt + ip;
            const float gmax = wave_max(gg);
            bcum[lane] = bt; aloc[lane] = al; wloc[lane] = __expf(gg - gmax);
            if (lane == 0) { scal[0] = blast; scal[1] = gmax; }
        }
        if (item + (int)gridDim.x < 4096) MLP_LOAD(item + (int)gridDim.x);
        __syncthreads();
#pragma unroll
        for (int p = 0; p < 2; ++p) { const int idx = tid + 512 * p, s = idx >> 4, c8 = idx & 15; const v4u kv = *(const LAS v4u*)(Ks + eoff<128>(s, c8 * 8)); const float w = wloc[s] * KSCALE;
#pragma unroll
            for (int j = 0; j < 4; ++j) { KTs[eoff<64>(c8 * 8 + 2 * j, s)] = (bf16)f2bf(bflo(kv[j]) * w); KTs[eoff<64>(c8 * 8 + 2 * j + 1, s)] = (bf16)f2bf(bfhi(kv[j]) * w); } }
        { const int tt = wave >> 1;
#pragma unroll
          for (int q2 = 0; q2 < 2; ++q2) { const int st = 2 * (wave & 1) + q2; f32x4 acc = (f32x4){0.f, 0.f, 0.f, 0.f};
            if (st <= tt) mma_tile<128, 128, 4>(acc, Qs, 16 * tt, Ks, 16 * st, lane);
            const int s = 16 * st + r16; const float cs = ipre[s] - bcum[s];
#pragma unroll
            for (int i = 0; i < 4; ++i) { const int t = 16 * tt + 4 * g + i; const float p = (s <= t) ? acc[i] * KSCALE * __expf(bcum[t] + cs - aloc[t]) : 0.f; Ps[eoff<64>(t, s)] = (bf16)f2bf(p); } } }
        __syncthreads();
        *(v4u*)(im + IMGM_P + tid * 16) = *(const LAS v4u*)((LAS unsigned char*)Ps + tid * 16);
#pragma unroll
        for (int p = 0; p < 2; ++p) *(v4u*)(im + IMGM_KT + (tid + 512 * p) * 16) = *(const LAS v4u*)((LAS unsigned char*)KTs + (tid + 512 * p) * 16);
        if (tid < 64) { float* gs = (float*)(im + IMGM_GS); gs[tid] = bcum[tid]; gs[64 + tid] = aloc[tid]; if (tid < 2) gs[128 + tid] = scal[tid]; }
    }
#undef MLP_LOAD
}

DI void mlstm_scan2(LAS unsigned char* lds, const bf16* P1, const unsigned char* img, bf16* hraw, int tid, int lane, int wave, int bx) {
    constexpr int IB = 8192 + 16384 + 16384 + 10240 + 1024;
    LAS bf16* CT0 = (LAS bf16*)(lds + 2 * IB);
    const int g = lane >> 4, r16 = lane & 15, tt = wave >> 1, eh = wave & 1;
    for (int item0 = bx; item0 < 256; item0 += gridDim.x) {
        const int item = (gridDim.x == 256) ? (item0 & 7) * 32 + (item0 >> 3) : item0;
        const int b = item >> 5, h = (item >> 2) & 7, sl = item & 3;
        f32x4 Cacc[5];
#pragma unroll
        for (int e = 0; e < 5; ++e) Cacc[e] = (f32x4){0.f, 0.f, 0.f, 0.f};
        __syncthreads();
        for (int i = tid; i < 2 * 80 * 128 / 8; i += 512) ((LAS v4u*)CT0)[i] = (v4u){0u, 0u, 0u, 0u};
        float m_prev = 0.f;
        v4u rp, rq[2], rk[2], rv; float rg0 = 0.f, rbl, rgm;
#define MLS_PREFETCH(cc) do { const int item2 = (b * 64 + (cc)) * 8 + h; const unsigned char* im = img + (size_t)item2 * IMGM_BYTES; const int row0_ = b * SEQ + (cc) * 64; \
            rp = *(const v4u*)(im + IMGM_P + tid * 16); rk[0] = *(const v4u*)(im + IMGM_KT + tid * 16); rk[1] = *(const v4u*)(im + IMGM_KT + (tid + 512) * 16); \
            rv = *(const v4u*)(P1 + (size_t)(row0_ + (tid >> 3)) * NQKV + 2048 + h * 256 + sl * 64 + (tid & 7) * 8); \
            _Pragma("unroll") for (int p = 0; p < 2; ++p) { const int idx = tid + 512 * p, r = idx >> 4, c8 = idx & 15; rq[p] = *(const v4u*)(P1 + (size_t)(row0_ + r) * NQKV + h * 128 + c8 * 8); } \
            const float* gs = (const float*)(im + IMGM_GS); if (tid < 128) rg0 = gs[tid]; rbl = gs[128]; rgm = gs[129]; } while (0)
#define MLS_STORE(bi) do { LAS unsigned char* bb = lds + (bi) * IB; \
            *(LAS v4u*)(bb + tid * 16) = rp; *(LAS v4u*)(bb + 8192 + 16384 + tid * 16) = rk[0]; *(LAS v4u*)(bb + 8192 + 16384 + (tid + 512) * 16) = rk[1]; \
            *(LAS v4u*)(bb + 8192 + 16384 + 16384 + off_v64(tid >> 3, tid & 7)) = rv; \
            _Pragma("unroll") for (int p = 0; p < 2; ++p) { const int idx = tid + 512 * p, r = idx >> 4, c8 = idx & 15; *(LAS v4u*)((LAS bf16*)(bb + 8192) + eoff<128>(r, c8 * 8)) = rq[p]; } \
            if (tid < 128) ((LAS float*)(bb + 8192 + 16384 + 16384 + 10240))[tid] = rg0; } while (0)
        MLS_PREFETCH(0); MLS_STORE(0);
        float blast = rbl, gmax = rgm;
        MLS_PREFETCH(1);
        __syncthreads();
        for (int c = 0; c < 64; ++c) {
            const int row0 = b * SEQ + c * 64;
            const LAS unsigned char* bb = lds + (c & 1) * IB;
            const LAS bf16* Ps = (const LAS bf16*)bb; const LAS bf16* Qs = (const LAS bf16*)(bb + 8192); const LAS bf16* KTs = (const LAS bf16*)(bb + 8192 + 16384);
            const LAS bf16* VTs = (const LAS bf16*)(bb + 8192 + 16384 + 16384); const LAS float* gsl = (const LAS float*)(bb + 8192 + 16384 + 16384 + 10240);
            LAS bf16* CTc = CT0 + (c & 1) * 80 * 128; LAS bf16* CTn = CT0 + ((c + 1) & 1) * 80 * 128;
            const int t = 16 * tt + r16;
            const float btv = gsl[t], alv = gsl[64 + t];
            const float mt = fmaxf(btv + m_prev, alv), al = __expf(alv - mt), be = __expf(btv + m_prev - mt), em = __expf(-mt);
            const float m_new = fmaxf(blast + m_prev, gmax), wcs = __expf(blast + m_prev - m_new), gam = __expf(gmax - m_new);
            m_prev = m_new;
            const LAS unsigned char* vb = (const LAS unsigned char*)VTs;
            bf16x8 onesf;
#pragma unroll
            for (int j = 0; j < 8; ++j) onesf[j] = (r16 == 0) ? (short)0x3f80 : (short)0;
            const bf16x8 pa0 = ldf<64>(Ps, 16 * tt + r16, g), pa1 = ldf<64>(Ps, 16 * tt + r16, 4 + g);
            f32x4 d1 = (f32x4){0.f, 0.f, 0.f, 0.f}, d2 = (f32x4){0.f, 0.f, 0.f, 0.f};
            d1 = mfma16(onesf, pa0, d1); d1 = mfma16(onesf, pa1, d1); mma_tile<128, 128, 4>(d2, CTc, 64, Qs, 16 * tt, lane);
            const float den = __shfl(al * d1[0] + be * d2[0], r16);
            const float dinv = __builtin_amdgcn_rcpf(fmaxf(fabsf(den), em));
#pragma unroll
            for (int q2 = 0; q2 < 2; ++q2) { const int et = 2 * eh + q2; f32x4 a1 = (f32x4){0.f, 0.f, 0.f, 0.f}, a2 = (f32x4){0.f, 0.f, 0.f, 0.f};
                a1 = mfma16(vfrag64(vb, et, 0, lane), pa0, a1); a1 = mfma16(vfrag64(vb, et, 1, lane), pa1, a1); mma_tile<128, 128, 4>(a2, CTc, 16 * et, Qs, 16 * tt, lane);
                const f32x4 o4 = (a1 * al + a2 * be) * dinv; v2u w; w.x = pk2(o4[0], o4[1]); w.y = pk2(o4[2], o4[3]);
                *(v2u*)(hraw + (size_t)(row0 + t) * DM + h * 256 + sl * 64 + 16 * et + 4 * g) = w; }
            const bf16x8 ka0 = ldf<64>(KTs, 16 * wave + r16, g), ka1 = ldf<64>(KTs, 16 * wave + r16, 4 + g);
#pragma unroll
            for (int et = 0; et < 5; ++et) { f32x4 tmp = (f32x4){0.f, 0.f, 0.f, 0.f};
                tmp = mfma16(ka0, et < 4 ? vfrag64(vb, et & 3, 0, lane) : onesf, tmp); tmp = mfma16(ka1, et < 4 ? vfrag64(vb, et & 3, 1, lane) : onesf, tmp);
                Cacc[et] = Cacc[et] * wcs + tmp * gam;
                v2u w; w.x = pk2(Cacc[et][0], Cacc[et][1]); w.y = pk2(Cacc[et][2], Cacc[et][3]);
                *(LAS v2u*)(CTn + eoff<128>(16 * et + r16, 16 * wave + 4 * g)) = w; }
            if (c + 1 < 64) { MLS_STORE((c + 1) & 1); blast = rbl; gmax = rgm; }
            if (c + 2 < 64) MLS_PREFETCH(c + 2);
            __syncthreads();
        }
#undef MLS_PREFETCH
#undef MLS_STORE
    }
}

DI void gla_pre(LAS unsigned char* lds, const bf16* P1, const float* G, const float* w_alpha, const float* b_alpha, unsigned char* img, int tid, int lane, int wave, int bx) {
    LAS bf16* VT = (LAS bf16*)lds;
    LAS bf16* QTs = (LAS bf16*)lds;
    LAS bf16* KTl = QTs + 64 * 256;
    LAS bf16* KTT = KTl + 64 * 256;
    LAS bf16* Ps = KTT + 256 * 64;
    LAS float* alow = (LAS float*)(Ps + 64 * 64);
    LAS float* T0 = alow + 1024;
    const int g = lane >> 4, r16 = lane & 15, d = tid & 255, sh = tid >> 8;
    for (int item = bx; item < 2048; item += gridDim.x) {
        const int b = item >> 8, c = (item >> 2) & 63, h = item & 3;
        const int row0 = b * SEQ + c * 64;
        unsigned char* im = img + (size_t)item * IMGG_BYTES;
        __syncthreads();
        float wa[16];
#pragma unroll
        for (int i = 0; i < 16; ++i) wa[i] = w_alpha[i * 1024 + h * 256 + d];
        const float ba = b_alpha[h * 256 + d];
        f32x4 al4 = (f32x4){0.f, 0.f, 0.f, 0.f};
        if (tid < 256) al4 = *(const f32x4*)(G + (size_t)(row0 + (tid >> 2)) * 16 + (tid & 3) * 4);
        if (tid < 256) *(LAS f32x4*)(alow + tid * 4) = al4;
        __syncthreads();
        const bf16* qsrc = P1 + (size_t)(row0 + 32 * sh) * NQKV + h * 256 + d;
        float bs[32]; float run = 0.f;
#pragma unroll
        for (int j = 0; j < 32; ++j) { const int s = 32 * sh + j; float z = ba;
#pragma unroll
            for (int i = 0; i < 16; ++i) z += alow[s * 16 + i] * wa[i];
            run += logsig_fast(z) * (1.0f / 16.0f); bs[j] = run; }
        if (sh == 0) T0[d] = run;
        __syncthreads();
        const float add = sh ? T0[d] : 0.f;
        if (sh) ((float*)(im + IMGG_EB))[d] = __expf(run + add);
#pragma unroll
        for (int q8 = 0; q8 < 4; ++q8) { unsigned kk[8];
#pragma unroll
            for (int j = 0; j < 8; ++j) { const int jj = 8 * q8 + j, s = 32 * sh + jj; const float bsum = bs[jj] + add;
                const float qv = bf2f(qsrc[(size_t)jj * NQKV]) * 0.0625f * __expf(bsum), kv = bf2f(qsrc[(size_t)jj * NQKV + 1024]) * __expf(-bsum);
                QTs[eoff<256>(s, d)] = (bf16)f2bf(qv); kk[j] = f2bf(kv); KTl[eoff<256>(s, d)] = (bf16)kk[j]; }
            v4u w; w.x = kk[0] | (kk[1] << 16); w.y = kk[2] | (kk[3] << 16); w.z = kk[4] | (kk[5] << 16); w.w = kk[6] | (kk[7] << 16);
            *(LAS v4u*)(KTT + eoff<64>(d, 32 * sh + 8 * q8)) = w; }
        __syncthreads();
        { const int tt = wave >> 1;
#pragma unroll
          for (int q2 = 0; q2 < 2; ++q2) { const int st = 2 * (wave & 1) + q2; f32x4 acc = (f32x4){0.f, 0.f, 0.f, 0.f};
            if (st <= tt) mma_tile<256, 256, 8>(acc, QTs, 16 * tt, KTl, 16 * st, lane);
            const int s = 16 * st + r16;
#pragma unroll
            for (int i = 0; i < 4; ++i) { const int t = 16 * tt + 4 * g + i; Ps[eoff<64>(t, s)] = (bf16)f2bf((s <= t) ? acc[i] : 0.f); } } }
        __syncthreads();
#pragma unroll
        for (int p = 0; p < 4; ++p) { *(v4u*)(im + IMGG_Q + (tid + 512 * p) * 16) = *(const LAS v4u*)((LAS unsigned char*)QTs + (tid + 512 * p) * 16);
                                      *(v4u*)(im + IMGG_KT + (tid + 512 * p) * 16) = *(const LAS v4u*)((LAS unsigned char*)KTT + (tid + 512 * p) * 16); }
        *(v4u*)(im + IMGG_P + tid * 16) = *(const LAS v4u*)((LAS unsigned char*)Ps + tid * 16);
    }
}

DI void gla_scan2(LAS unsigned char* lds, const bf16* P1, const unsigned char* img, bf16* hraw, int tid, int lane, int wave, int bx) {
    LAS bf16* QTs = (LAS bf16*)lds;
    LAS bf16* KTT = QTs + 64 * 256;
    LAS bf16* Ps = KTT + 256 * 64;
    LAS bf16* VTs = Ps + 64 * 64;
    LAS float* eb = (LAS float*)(VTs + 64 * 64);
    LAS bf16* ST0 = (LAS bf16*)(eb + 256);
    const int g = lane >> 4, r16 = lane & 15, tt = wave >> 1, eh = wave & 1;
    for (int item0 = bx; item0 < 256; item0 += gridDim.x) {
        const int item = (gridDim.x == 256) ? (item0 & 7) * 32 + (item0 >> 3) : item0;
        const int b = item >> 5, h = (item >> 3) & 3, sl = item & 7;
        f32x4 Sacc[2][4];
#pragma unroll
        for (int a = 0; a < 2; ++a)
#pragma unroll
            for (int e = 0; e < 4; ++e) Sacc[a][e] = (f32x4){0.f, 0.f, 0.f, 0.f};
        __syncthreads();
        for (int i = tid; i < 2 * 64 * 256 / 8; i += 512) ((LAS v4u*)ST0)[i] = (v4u){0u, 0u, 0u, 0u};
        v4u rq[4], rk[4], rp, rv; float re = 0.f;
#define GLS_PREFETCH(cc) do { const int item2 = (b * 64 + (cc)) * 4 + h; const unsigned char* im = img + (size_t)item2 * IMGG_BYTES; \
            _Pragma("unroll") for (int p = 0; p < 4; ++p) { rq[p] = *(const v4u*)(im + IMGG_Q + (tid + 512 * p) * 16); rk[p] = *(const v4u*)(im + IMGG_KT + (tid + 512 * p) * 16); } \
            rp = *(const v4u*)(im + IMGG_P + tid * 16); rv = *(const v4u*)(P1 + ((size_t)b * SEQ + (cc) * 64 + (tid >> 3)) * NQKV + 2048 + h * 512 + sl * 64 + (tid & 7) * 8); if (tid < 256) re = ((const float*)(im + IMGG_EB))[tid]; } while (0)
        GLS_PREFETCH(0);
        for (int c = 0; c < 64; ++c) {
            const int row0 = b * SEQ + c * 64;
            LAS bf16* STc = ST0 + (c & 1) * 64 * 256; LAS bf16* STn = ST0 + ((c + 1) & 1) * 64 * 256;
            __syncthreads();
#pragma unroll
            for (int p = 0; p < 4; ++p) { *(LAS v4u*)((LAS unsigned char*)QTs + (tid + 512 * p) * 16) = rq[p]; *(LAS v4u*)((LAS unsigned char*)KTT + (tid + 512 * p) * 16) = rk[p]; }
            *(LAS v4u*)((LAS unsigned char*)Ps + tid * 16) = rp; *(LAS v4u*)((LAS unsigned char*)VTs + off_v64(tid >> 3, tid & 7)) = rv;
            if (tid < 256) eb[tid] = re;
            __syncthreads();
            if (c + 1 < 64) GLS_PREFETCH(c + 1);
            const LAS unsigned char* vb = (const LAS unsigned char*)VTs;
            const bf16x8 pa0 = ldf<64>(Ps, 16 * tt + r16, g), pa1 = ldf<64>(Ps, 16 * tt + r16, 4 + g);
#pragma unroll
            for (int q2 = 0; q2 < 2; ++q2) { const int et = 2 * eh + q2; f32x4 acc = (f32x4){0.f, 0.f, 0.f, 0.f};
                acc = mfma16(vfrag64(vb, et, 0, lane), pa0, acc); acc = mfma16(vfrag64(vb, et, 1, lane), pa1, acc); mma_tile<256, 256, 8>(acc, STc, 16 * et, QTs, 16 * tt, lane);
                v2u w; w.x = pk2_sw(acc[0], acc[1]); w.y = pk2_sw(acc[2], acc[3]);
                *(v2u*)(hraw + (size_t)(row0 + 16 * tt + r16) * DM + h * 512 + sl * 64 + 16 * et + 4 * g) = w; }
#pragma unroll
            for (int a = 0; a < 2; ++a) { const int dt = 2 * wave + a;
                const f32x4 ev = *(const LAS f32x4*)(eb + 16 * dt + 4 * g);
                const bf16x8 ka0 = ldf<64>(KTT, 16 * dt + r16, g), ka1 = ldf<64>(KTT, 16 * dt + r16, 4 + g);
#pragma unroll
                for (int et = 0; et < 4; ++et) { Sacc[a][et] = mfma16(ka0, vfrag64(vb, et, 0, lane), Sacc[a][et]); Sacc[a][et] = mfma16(ka1, vfrag64(vb, et, 1, lane), Sacc[a][et]); Sacc[a][et] = Sacc[a][et] * ev;
                    v2u w; w.x = pk2(Sacc[a][et][0], Sacc[a][et][1]); w.y = pk2(Sacc[a][et][2], Sacc[a][et][3]);
                    *(LAS v2u*)(STn + eoff<256>(16 * et + r16, 16 * dt + 4 * g)) = w; } }
        }
#undef GLS_PREFETCH
    }
}


DI void mixer_gates(const bf16* hb, const bf16* wg, const long long* ss, float* G, int lane, int wave, int bx) {
    const int g = lane >> 4, r16 = lane & 15;
    for (int t = bx * NWAVES + wave; t < MTOK / 16; t += gridDim.x * NWAVES) {
        const bf16* ap = hb + (size_t)(16 * t + r16) * DM + 8 * g; const bf16* bp = wg + (size_t)r16 * DM + 8 * g;
        f32x4 acc = (f32x4){0.f, 0.f, 0.f, 0.f};
#pragma unroll 8
        for (int kk = 0; kk < DM / 32; ++kk) { const bf16x8 a = *(const bf16x8*)(ap + 32 * kk), b = *(const bf16x8*)(bp + 32 * kk); acc = mfma16(a, b, acc); }
#pragma unroll
        for (int i = 0; i < 4; ++i) { const int row = 16 * t + 4 * g + i; G[(size_t)row * 16 + r16] = acc[i] * pg8::rstd_of(ss, row); }
    }
}

template <int HS, int ACT> DI void headnorm_gate(const bf16* hraw, const bf16* P1, const float* gnorm, bf16* hm, int lane, int wave, int bx) {
    constexpr int NH = DM / HS, EPL = HS / 64;
    const int gw = bx * NWAVES + wave, NGW = gridDim.x * NWAVES;
    for (int row = gw; row < MTOK; row += NGW) {
#pragma unroll
        for (int hh = 0; hh < NH; ++hh) { const int col = hh * HS + lane * EPL;
            unsigned xw[EPL / 2], gwd[EPL / 2];
            if constexpr (EPL == 4) { const v2u a = *(const v2u*)(hraw + (size_t)row * DM + col), b2 = *(const v2u*)(P1 + (size_t)row * NQKV + 4096 + col); xw[0] = a.x; xw[1] = a.y; gwd[0] = b2.x; gwd[1] = b2.y; }
            else { const v4u a = *(const v4u*)(hraw + (size_t)row * DM + col), b2 = *(const v4u*)(P1 + (size_t)row * NQKV + 4096 + col); xw[0] = a.x; xw[1] = a.y; xw[2] = a.z; xw[3] = a.w; gwd[0] = b2.x; gwd[1] = b2.y; gwd[2] = b2.z; gwd[3] = b2.w; }
            float s = 0.f;
#pragma unroll
            for (int j = 0; j < EPL / 2; ++j) { const float x0 = bflo(xw[j]), x1 = bfhi(xw[j]); s += x0 * x0 + x1 * x1; }
            s = wave_sum(s); const float rs = rsqrtf(s * (1.0f / HS) + 1e-6f);
            unsigned outw[EPL / 2];
#pragma unroll
            for (int j = 0; j < EPL / 2; ++j) { const float g0 = bflo(gwd[j]), g1 = bfhi(gwd[j]);
                const float a0 = ACT == 0 ? __builtin_amdgcn_rcpf(1.0f + __expf(-g0)) : g0 * __builtin_amdgcn_rcpf(1.0f + __expf(-g0)), a1 = ACT == 0 ? __builtin_amdgcn_rcpf(1.0f + __expf(-g1)) : g1 * __builtin_amdgcn_rcpf(1.0f + __expf(-g1));
                outw[j] = pk2(bflo(xw[j]) * rs * gnorm[col + 2 * j] * a0, bfhi(xw[j]) * rs * gnorm[col + 2 * j + 1] * a1); }
            if constexpr (EPL == 4) { v2u w; w.x = outw[0]; w.y = outw[1]; *(v2u*)(hm + (size_t)row * DM + col) = w; }
            else { v4u w; w.x = outw[0]; w.y = outw[1]; w.z = outw[2]; w.w = outw[3]; *(v4u*)(hm + (size_t)row * DM + col) = w; }
        }
    }
}

DI void fox_cf(LAS unsigned char* lds, const float* G, const float* b_f, float* cf, int tid, int lane, int wave, int bx) {
    LAS float* wt = (LAS float*)lds;
    for (int item = bx; item < 256; item += gridDim.x) { const int seq = item >> 1, hf = item & 1, b = seq >> 4, h = seq & 15; const float bias = b_f[h];
        const float* gp = G + ((size_t)b * SEQ + hf * 2048 + tid * 4) * 16 + h;
        float ls[4]; float s = 0.f, s0 = 0.f;
#pragma unroll
        for (int p = 0; p < 4; ++p) { ls[p] = logsig(gp[p * 16] + bias); s += ls[p]; }
        if (hf) { const float* g0 = gp - (size_t)2048 * 16;
#pragma unroll
            for (int p = 0; p < 4; ++p) s0 += logsig(g0[p * 16] + bias); }
        const float incl = wave_incl_sum(s, lane), tot0 = wave_sum(s0);
        __syncthreads();
        if (lane == 63) wt[wave] = incl; if (lane == 0) wt[8 + wave] = tot0;
        __syncthreads();
        float base = 0.f;
#pragma unroll
        for (int w = 0; w < 8; ++w) { base += (w < wave) ? wt[w] : 0.f; base += wt[8 + w]; }
        float run = base + incl - s;
        float* o = cf + (size_t)seq * SEQ + hf * 2048 + tid * 4; f32x4 ov;
        run += ls[0]; ov.x = run; run += ls[1]; ov.y = run; run += ls[2]; ov.z = run; run += ls[3]; ov.w = run;
        *(f32x4*)o = ov;
    }
}

DI unsigned off_v(unsigned row, unsigned ch) { return 256u * row + 16u * (ch ^ (((row & 3u) << 2) | (((row >> 2) & 1u) << 1))); }

DI void fox_attn2(LAS unsigned char* lds, const bf16* P1, const float* cf, bf16* hm, int tid, int lane, int wave, int bx) {
    constexpr int BUFB = 16384 + 16384 + 256;
    const float LOG2E = 1.4426950408889634f, QS = 0.08838834764831845f * 1.4426950408889634f, THR = 8.0f;
    const int g = lane >> 4, r16 = lane & 15;
    const int G_ = gridDim.x;
    const int nit = (2048 + G_ - 1) / G_;
    for (int it = 0; it < nit; ++it) {
        const int u = (it & 1) ? it * G_ + (G_ - 1 - bx) : it * G_ + bx;
        if (u >= 2048) continue;
        const int qb = 15 - (u >> 7), bh = u & 127, b = bh >> 4, h = bh & 15;
        const size_t rowb = (size_t)b * SEQ; const int q0 = qb * 256 + 32 * wave;
        bf16x8 qf[2][4]; float c0[2];
#pragma unroll
        for (int tt = 0; tt < 2; ++tt) { const int t = q0 + 16 * tt + r16; c0[tt] = cf[(size_t)bh * SEQ + t] * LOG2E;
#pragma unroll
            for (int kk = 0; kk < 4; ++kk) { const v4u raw = *(const v4u*)(P1 + (rowb + t) * NQKV + h * 128 + 32 * kk + 8 * g); v4u sc;
#pragma unroll
                for (int j = 0; j < 4; ++j) sc[j] = pk2(bflo(raw[j]) * QS, bfhi(raw[j]) * QS);
                qf[tt][kk] = __builtin_bit_cast(bf16x8, sc); } }
        f32x4 oacc[8][2];
#pragma unroll
        for (int et = 0; et < 8; ++et) { oacc[et][0] = (f32x4){0.f, 0.f, 0.f, 0.f}; oacc[et][1] = (f32x4){0.f, 0.f, 0.f, 0.f}; }
        float lrun[2] = {0.f, 0.f};
        const int ntiles = 4 * (qb + 1);
        v4u kreg[2], vreg[2]; float cfreg = 0.f;
        const bf16* kbase = P1 + rowb * NQKV + 2048 + h * 128;
#define FOX_LOAD(j) do { _Pragma("unroll") for (int p = 0; p < 2; ++p) { const int idx = tid + 512 * p, r = idx >> 4, c8 = idx & 15; \
            kreg[p] = *(const v4u*)(kbase + (size_t)(64 * (j) + r) * NQKV + c8 * 8); vreg[p] = *(const v4u*)(kbase + (size_t)(64 * (j) + r) * NQKV + 2048 + c8 * 8); } \
            if (tid < 64) cfreg = -cf[(size_t)bh * SEQ + 64 * (j) + tid] * LOG2E; } while (0)
#define FOX_STORE(bufi) do { LAS unsigned char* bb = lds + (bufi) * BUFB; _Pragma("unroll") for (int p = 0; p < 2; ++p) { const int idx = tid + 512 * p, r = idx >> 4, c8 = idx & 15; \
            *(LAS v4u*)((LAS bf16*)bb + eoff<128>(r, c8 * 8)) = kreg[p]; *(LAS v4u*)(bb + 16384 + off_v(r, c8)) = vreg[p]; } \
            if (tid < 64) ((LAS float*)(bb + 32768))[tid] = cfreg; } while (0)
        __syncthreads();
        FOX_LOAD(0); FOX_STORE(0);
        if (ntiles > 1) FOX_LOAD(1);
        __syncthreads();
        for (int j = 0; j < ntiles; ++j) {
            if (j + 1 < ntiles) FOX_STORE((j + 1) & 1);
            if (j + 2 < ntiles) FOX_LOAD(j + 2);
            if (64 * j <= q0 + 31) {
                const LAS bf16* Ks = (const LAS bf16*)(lds + (j & 1) * BUFB); const LAS bf16* VTs = Ks + 64 * 128; const LAS float* cfs = (const LAS float*)(VTs + 128 * 64);
                f32x4 sacc[2][4];
#pragma unroll
                for (int st = 0; st < 4; ++st) { const f32x4 cv = *(const LAS f32x4*)(cfs + 16 * st + 4 * g);
#pragma unroll
                    for (int tt = 0; tt < 2; ++tt) sacc[tt][st] = cv + c0[tt]; }
#pragma unroll
                for (int st = 0; st < 4; ++st)
#pragma unroll
                    for (int kk = 0; kk < 4; ++kk) { const bf16x8 kf = ldf<128>(Ks, 16 * st + r16, 4 * kk + g);
                        sacc[0][st] = mfma16(kf, qf[0][kk], sacc[0][st]); sacc[1][st] = mfma16(kf, qf[1][kk], sacc[1][st]); if (kk == 3) asm volatile("" ::: "memory"); }
                if (64 * j + 63 > q0) {
#pragma unroll
                    for (int tt = 0; tt < 2; ++tt) { const int t = q0 + 16 * tt + r16;
#pragma unroll
                        for (int st = 0; st < 4; ++st)
#pragma unroll
                            for (int i = 0; i < 4; ++i) { const int s = 64 * j + 16 * st + 4 * g + i; if (s > t) sacc[tt][st][i] = -__builtin_inff(); } }
                }
                float mx[2];
#pragma unroll
                for (int tt = 0; tt < 2; ++tt) { float m = -__builtin_inff();
#pragma unroll
                    for (int st = 0; st < 4; ++st) m = fmaxf(m, fmaxf(fmaxf(sacc[tt][st][0], sacc[tt][st][1]), fmaxf(sacc[tt][st][2], sacc[tt][st][3])));
                    m = fmaxf(m, __shfl_xor(m, 16)); m = fmaxf(m, __shfl_xor(m, 32)); mx[tt] = m; }
                if (__any(mx[0] > THR || mx[1] > THR)) {
#pragma unroll
                    for (int tt = 0; tt < 2; ++tt) { const float sh = fmaxf(mx[tt], 0.f), f = __builtin_amdgcn_exp2f(-sh);
                        c0[tt] -= sh; lrun[tt] *= f;
#pragma unroll
                        for (int st = 0; st < 4; ++st) sacc[tt][st] = sacc[tt][st] - sh;
#pragma unroll
                        for (int et = 0; et < 8; ++et) oacc[et][tt] = oacc[et][tt] * f; }
                }
#pragma unroll
                for (int tt = 0; tt < 2; ++tt) { float ls = 0.f;
#pragma unroll
                    for (int st = 0; st < 4; ++st)
#pragma unroll
                        for (int i = 0; i < 4; ++i) { const float p = __builtin_amdgcn_exp2f(sacc[tt][st][i]); sacc[tt][st][i] = p; ls += p; }
                    lrun[tt] += ls; }
#pragma unroll
                for (int ks = 0; ks < 2; ++ks) { bf16x8 pb[2];
#pragma unroll
                    for (int tt = 0; tt < 2; ++tt) { v4u w; w.x = pk2(sacc[tt][2 * ks][0], sacc[tt][2 * ks][1]); w.y = pk2(sacc[tt][2 * ks][2], sacc[tt][2 * ks][3]);
                        w.z = pk2(sacc[tt][2 * ks + 1][0], sacc[tt][2 * ks + 1][1]); w.w = pk2(sacc[tt][2 * ks + 1][2], sacc[tt][2 * ks + 1][3]); pb[tt] = __builtin_bit_cast(bf16x8, w); }
#pragma unroll
                    for (int et = 0; et < 8; ++et) {
                        const LAS unsigned char* vb = (const LAS unsigned char*)VTs;
                        const v4i16_t lo = tr_read(vb + off_v(32 * ks + 4 * g + (r16 >> 2), 2 * et + ((lane & 3) >> 1)) + 8 * (lane & 1));
                        const v4i16_t hi = tr_read(vb + off_v(32 * ks + 16 + 4 * g + (r16 >> 2), 2 * et + ((lane & 3) >> 1)) + 8 * (lane & 1));
                        bf16x8 va; va[0] = lo[0]; va[1] = lo[1]; va[2] = lo[2]; va[3] = lo[3]; va[4] = hi[0]; va[5] = hi[1]; va[6] = hi[2]; va[7] = hi[3];
                        oacc[et][0] = mfma16(va, pb[0], oacc[et][0]); oacc[et][1] = mfma16(va, pb[1], oacc[et][1]); if (et & 1) asm volatile("" ::: "memory"); } }
            }
            __syncthreads();
        }
#undef FOX_LOAD
#undef FOX_STORE
#pragma unroll
        for (int tt = 0; tt < 2; ++tt) { float l = lrun[tt]; l += __shfl_xor(l, 16); l += __shfl_xor(l, 32); const float inv = 1.0f / l;
            bf16* orow = hm + (rowb + q0 + 16 * tt + r16) * DM + h * 128 + 4 * g;
#pragma unroll
            for (int et = 0; et < 8; ++et) { v2u w; w.x = pk2(oacc[et][tt][0] * inv, oacc[et][tt][1] * inv); w.y = pk2(oacc[et][tt][2] * inv, oacc[et][tt][3] * inv); *(v2u*)(orow + 16 * et) = w; } }
    }
}


DI void final_norm(float* out, const bf16* hb, const long long* ss, const float* gfin, int lane, int wave, int bx) {
    const int gw = bx * NWAVES + wave, NGW = gridDim.x * NWAVES;
    for (int m = gw; m < MTOK; m += NGW) { const float rs = pg8::rstd_of(ss, m);
        const v4u* hr = (const v4u*)(hb + (size_t)m * DM); f32x4* xr = (f32x4*)(out + (size_t)m * DM); const f32x4* gr = (const f32x4*)gfin;
#pragma unroll
        for (int j = 0; j < 4; ++j) { const v4u w = hr[lane + 64 * j]; const int c4 = 2 * (lane + 64 * j);
            const f32x4 g0 = gr[c4], g1 = gr[c4 + 1];
            xr[c4] = (f32x4){bflo(w.x) * rs * g0.x, bfhi(w.x) * rs * g0.y, bflo(w.y) * rs * g0.z, bfhi(w.y) * rs * g0.w};
            xr[c4 + 1] = (f32x4){bflo(w.z) * rs * g1.x, bfhi(w.z) * rs * g1.y, bflo(w.w) * rs * g1.z, bfhi(w.w) * rs * g1.w}; } }
}

#define PH(p) if (lo <= (p) && (p) < hi && (ran ? (xcd_barrier(bar), true) : (ran = true)))
#define TID() int tid = threadIdx.x; asm volatile("" : "+v"(tid)); const int lane = tid & 63, wave = __builtin_amdgcn_readfirstlane(tid >> 6); int bx = blockIdx.x; asm volatile("" : "+s"(bx)); (void)lane; (void)wave; (void)bx
#define WSP(T, off) ((T*)(ka->ws + (off)))
template <int j> DI void subblock(LAS unsigned char* lds, const XcdBarrier& bar, const int lo, const int hi, bool& ran) {
    {
        constexpr int layer = j / 3, typ = j - 3 * layer, base = 1 + 5 * j;
        if constexpr (typ != 1) {
            PH(base) { TID(); KArgs ka = kargs(); const int mi = layer * 2 + (typ >> 1);
                pg8::Gemm gm{WSP(bf16, WS_HB), WSP(bf16, WS_WUP) + (size_t)mi * NUP * DM, MTOK, NUP, DM}; pg8::StaticOrder S; S.init(MTOK, NUP, gridDim.x, bx);
                pg8::EpiSwiGLU E{WSP(bf16, WS_ACT), WSP(long long, WS_SS) + (size_t)j * MTOK, DFF};
                pg8::gemm_phase<pg8::EpiSwiGLU, pg8::StaticOrder, PG8_ALIGN, PG8_SP2>(lds, gm, S, E); }
        } else {
            constexpr int kind = layer % 3, ji = layer / 3;
            PH(base) { TID(); KArgs ka = kargs();
                mixer_gates(WSP(bf16, WS_HB), WSP(bf16, WS_WIN) + ((size_t)layer * NINP + NQKV) * DM, WSP(long long, WS_SS) + (size_t)j * MTOK, WSP(float, WS_G), lane, wave, bx);
                pg8::Gemm gm{WSP(bf16, WS_HB), WSP(bf16, WS_WIN) + (size_t)layer * NINP * DM, MTOK, NQKV, DM}; pg8::StaticOrder S; S.init(MTOK, NQKV, gridDim.x, bx);
                pg8::EpiMixIn E{WSP(bf16, WS_P1), WSP(long long, WS_SS) + (size_t)j * MTOK};
                pg8::gemm_phase<pg8::EpiMixIn, pg8::StaticOrder, PG8_ALIGN, PG8_SP2>(lds, gm, S, E); }
            PH(base + 1) { TID(); KArgs ka = kargs();
                if constexpr (kind == 0) for (int rep = 0; rep < REP_MLSTM; ++rep) mlstm_pre(lds, WSP(bf16, WS_P1), WSP(float, WS_G), ka->in[6] + ji * 16, WSP(unsigned char, WS_ACT), tid, lane, wave, bx);
                else if constexpr (kind == 1) { fox_cf(lds, WSP(float, WS_G), ka->in[10] + ji * 16, WSP(float, WS_CF), tid, lane, wave, bx); }
                else for (int rep = 0; rep < REP_GLA; ++rep) gla_pre(lds, WSP(bf16, WS_P1), WSP(float, WS_G), ka->in[13] + (size_t)ji * 16 * 1024, ka->in[14] + ji * 1024, WSP(unsigned char, WS_ACT), tid, lane, wave, bx);
            }
            PH(base + 2) { TID(); KArgs ka = kargs();
                if constexpr (kind == 0) for (int rep = 0; rep < REP_MLSTM; ++rep) mlstm_scan2(lds, WSP(bf16, WS_P1), WSP(unsigned char, WS_ACT), WSP(bf16, WS_HRAW), tid, lane, wave, bx);
                else if constexpr (kind == 1) for (int rep = 0; rep < REP_FOX; ++rep) fox_attn2(lds, WSP(bf16, WS_P1), WSP(float, WS_CF), WSP(bf16, WS_HM), tid, lane, wave, bx);
                else for (int rep = 0; rep < REP_GLA; ++rep) gla_scan2(lds, WSP(bf16, WS_P1), WSP(unsigned char, WS_ACT), WSP(bf16, WS_HRAW), tid, lane, wave, bx);
            }
            if constexpr (kind != 1) { PH(base + 3) { TID(); KArgs ka = kargs();
                if constexpr (kind == 0) headnorm_gate<256, 0>(WSP(bf16, WS_HRAW), WSP(bf16, WS_P1), ka->in[7] + ji * DM, WSP(bf16, WS_HM), lane, wave, bx);
                else headnorm_gate<512, 1>(WSP(bf16, WS_HRAW), WSP(bf16, WS_P1), ka->in[15] + ji * DM, WSP(bf16, WS_HM), lane, wave, bx);
            } }
        }
        PH(base + 4) { TID(); KArgs ka = kargs();
            pg8::Gemm gm; float scale;
            if constexpr (typ != 1) { const int mi = layer * 2 + (typ >> 1); gm = pg8::Gemm{WSP(bf16, WS_ACT), WSP(bf16, WS_WDN) + (size_t)mi * DM * DFF, MTOK, DM, DFF}; scale = 0.5f; }
            else { gm = pg8::Gemm{WSP(bf16, WS_HM), WSP(bf16, WS_WOUT) + (size_t)layer * DM * DM, MTOK, DM, DM}; scale = 1.0f; }
            pg8::StaticOrder S; S.init(MTOK, DM, gridDim.x, bx);
            pg8::EpiResid E{(j == 0) ? ka->in[0] : (const float*)nullptr, WSP(bf16, WS_HB), WSP(long long, WS_SS) + (size_t)(j + 1) * MTOK, scale};
            pg8::gemm_phase<pg8::EpiResid, pg8::StaticOrder, PG8_ALIGN, PG8_SP2>(lds, gm, S, E);
        }
    }
}

__global__ void __launch_bounds__(NWAVES * 64, 2) trunk_fwd(Args args) {
    extern __shared__ __attribute__((aligned(16))) unsigned char lds_raw[];
    LAS unsigned char* lds = (LAS unsigned char*)lds_raw;
    volatile LAS unsigned* MISC = (volatile LAS unsigned*)(lds + MISC_OFF);
    for (int u = threadIdx.x; u < (LDS_BYTES - MISC_OFF) / 4; u += NWAVES * 64) ((LAS unsigned*)(lds + MISC_OFF))[u] = 0u;
    __syncthreads();
    XcdBarrier bar = xcd_barrier_post((unsigned*)(args.ws + WS_CTL) + CW_BAR, MISC + 8);
    const int lo = args.ph_lo, hi = args.ph_hi; bool ran = false;

    PH(0) { TID(); for (int rep = 0; rep < REP_PRO; ++rep) { prologue(lds, lane, wave, bx); __syncthreads(); } }

    subblock<0>(lds, bar, lo, hi, ran); subblock<1>(lds, bar, lo, hi, ran); subblock<2>(lds, bar, lo, hi, ran); subblock<3>(lds, bar, lo, hi, ran);
    subblock<4>(lds, bar, lo, hi, ran); subblock<5>(lds, bar, lo, hi, ran); subblock<6>(lds, bar, lo, hi, ran); subblock<7>(lds, bar, lo, hi, ran);
    subblock<8>(lds, bar, lo, hi, ran); subblock<9>(lds, bar, lo, hi, ran); subblock<10>(lds, bar, lo, hi, ran); subblock<11>(lds, bar, lo, hi, ran);
    PH(NPHASE - 1) { TID(); KArgs ka = kargs(); final_norm(ka->out, WSP(bf16, WS_HB), WSP(long long, WS_SS) + (size_t)NSUB * MTOK, ka->in[17], lane, wave, bx); }
#undef WSP
#undef PH
}

static bool phase_exists(int p) {
    if (p == 0 || p == NPHASE - 1) return true;
    const int j = (p - 1) / 5, k = (p - 1) % 5, typ = j % 3;
    if (k == 0 || k == 4) return true;
    if (typ != 1) return false;
    if (k == 3) return ((j / 3) % 3) != 1;
    return true;
}
extern "C" void kernel_launch(void* const* d_in, const int* in_sizes, int n_in, void* d_out, int out_size, void* d_ws, size_t ws_size, hipStream_t stream) {
    static int grid = 0;
    if (grid == 0) {
        if (n_in != 18 || in_sizes[0] != MTOK * DM || out_size != MTOK * DM || ws_size < WS_END) { fprintf(stderr, "kernel_launch: unexpected shapes (n_in %d, in0 %d, out %d, ws %zu < %zu)\n", n_in, n_in > 0 ? in_sizes[0] : -1, out_size, ws_size, (size_t)WS_END); grid = -1; return; }
        int dev = 0, cus = 0, per_cu = 0;
        if (hipGetDevice(&dev) != hipSuccess || hipDeviceGetAttribute(&cus, hipDeviceAttributeMultiprocessorCount, dev) != hipSuccess) { grid = -1; return; }
        if (hipFuncSetAttribute((const void*)trunk_fwd, hipFuncAttributeMaxDynamicSharedMemorySize, LDS_BYTES) != hipSuccess) { fprintf(stderr, "kernel_launch: hipFuncSetAttribute failed\n"); grid = -1; return; }
        if (hipOccupancyMaxActiveBlocksPerMultiprocessor(&per_cu, (const void*)trunk_fwd, NWAVES * 64, LDS_BYTES) != hipSuccess || per_cu < 1) fprintf(stderr, "kernel_launch: occupancy query says %d\n", per_cu);
        (void)hipGetLastError();
        grid = cus;
    }
    if (grid < 0) return;
    if (hipMemsetAsync((char*)d_ws + WS_CTL, 0, CTL_ZERO_BYTES, stream) != hipSuccess) return;
    Args a{};
    for (int i = 0; i < 18; ++i) a.in[i] = (const float*)d_in[i];
    a.out = (float*)d_out; a.ws = (unsigned char*)d_ws;
#if MK_PER_PHASE
    for (int p = 0; p < NPHASE; ++p) { if (!phase_exists(p)) continue; a.ph_lo = p; a.ph_hi = p + 1; hipLaunchKernelGGL(trunk_fwd, dim3(grid), dim3(NWAVES * 64), LDS_BYTES, stream, a); }
#else
    a.ph_lo = 0; a.ph_hi = NPHASE; hipLaunchKernelGGL(trunk_fwd, dim3(grid), dim3(NWAVES * 64), LDS_BYTES, stream, a);
#endif
    (void)phase_exists;
}
```

```cpp
#include <hip/hip_runtime.h>
#include <cstdio>
#include <cstdint>
namespace pg8 {
#define PG8_LAS __attribute__((address_space(3)))
typedef unsigned short bf16_t;
typedef short bf16x8 __attribute__((ext_vector_type(8)));
typedef float f32x4 __attribute__((ext_vector_type(4)));
typedef unsigned u32x4 __attribute__((ext_vector_type(4)));
constexpr int BM = 256, BK = 64, HALF = 128, HTB = HALF * BK * 2  , STAGE_BYTES = 8 * HTB, NXCD = 8, WGM = 8;

__host__ __device__ __forceinline__ int lds_byte(int r, int c) { const int st = (r >> 4) * 2 + (c >> 5), rr = r & 15, cc = c & 31, ob = rr * 64 + cc * 2; return st * 1024 + (ob ^ (((ob >> 9) & 1) << 5)); }
__host__ __device__ __forceinline__ void stage_rc(int b, int& R, int& C) { const int st = b / 1024, sb = b % 1024, swz = sb ^ (((sb >> 9) & 1) << 5); R = (st >> 1) * 16 + swz / 64; C = (st & 1) * 32 + (swz % 64) / 2; }
__host__ __device__ __forceinline__ int perm32(int rho) { const int n = rho >> 4, i = rho & 15; return 8 * (i >> 2) + 4 * n + (i & 3); }

struct Unit { int pm, pn; };
struct Gemm { const bf16_t* A; const bf16_t* Bt; int M, N, K; };

struct StaticOrder {
    int nM, nN, nwg, G, c;
    __host__ __device__ void init(int M, int N, int G_, int c_) { nM = M / BM; nN = N / BM; nwg = nM * nN; G = G_; c = c_; }
    __host__ __device__ bool next(int i, Unit& u) const {
        const long L = (long)i * G + c; if (L >= nwg) return false;
        int wgid = (int)L; { const int q = nwg / NXCD, r = nwg % NXCD, xcd = wgid % NXCD, off = wgid / NXCD; wgid = (xcd < r ? xcd * (q + 1) : r * (q + 1) + (xcd - r) * q) + off; }
        const int nig = WGM * nN, gid = wgid / nig, fm = gid * WGM, gsz = (nM - fm) < WGM ? (nM - fm) : WGM;
        u.pm = fm + ((wgid % nig) % gsz); u.pn = (wgid % nig) / gsz; return true;
    }
    __device__ __forceinline__ void a_ready(const Unit&) const {}
    __device__ __forceinline__ void done(const Unit&) const {}
};

__device__ __forceinline__ unsigned cvt_pk_bf16(float lo, float hi) { unsigned r; asm volatile("v_cvt_pk_bf16_f32 %0, %1, %2" : "=v"(r) : "v"(lo), "v"(hi)); return r; }
constexpr float RMS_EPS_F = 1e-6f, SS_FIX = 1048576.0f, SS_UNFIX_D = 1.0f / (1048576.0f * 2048.0f);
typedef long long ss_t;
__device__ __forceinline__ float rstd_of(const ss_t* ss, int row) { return rsqrtf((float)ss[row] * SS_UNFIX_D + RMS_EPS_F); }
template <class Sched> __device__ __forceinline__ int rstd_table_fill(const Sched& S, const ss_t* ss, PG8_LAS unsigned char* ext, int tid) {
    PG8_LAS float* tab = (PG8_LAS float*)ext; int key0 = -1, key1 = -1, bad = 0; Unit u;
    for (int i = 0; S.next(i, u); ++i) { const int slot = (u.pm >> 3) & 1; const int key = slot ? key1 : key0;
        if (key == u.pm) continue;
        if (key >= 0) { bad = 1; continue; }
        if (slot) key1 = u.pm; else key0 = u.pm;
        if (tid < 256) tab[slot * 256 + tid] = rstd_of(ss, u.pm * BM + tid); }
    asm volatile("s_waitcnt lgkmcnt(0)" ::: "memory"); __builtin_amdgcn_s_barrier(); asm volatile("" ::: "memory");
    return bad;
}
__device__ __forceinline__ float rstd_get(const ss_t* ss, const Unit& u, int row, int pf, const PG8_LAS unsigned char* ext) {
    return pf ? rstd_of(ss, row) : ((const PG8_LAS float*)ext)[((u.pm >> 3) & 1) * 256 + (row - u.pm * BM)];
}
struct EpiSwiGLU {
    static constexpr bool PERM = true, AFTER_DRAIN = false;
    bf16_t* O; const ss_t* ss; int ldo;
    template <class Sched> __device__ __forceinline__ int prepare(const Sched& S, PG8_LAS unsigned char* ext, int tid) const { return rstd_table_fill(S, ss, ext, tid); }
    __device__ __forceinline__ void operator()(const f32x4 (&acc)[2][2][4][2], const Unit& u, int wr, int wc, int fr, int fq, int pf, const PG8_LAS unsigned char* ext) const {
        const int row0 = u.pm * BM + wr * 64 + fr, col0 = u.pn * HALF + wc * 32 + 8 * fq;
#pragma unroll
        for (int ai = 0; ai < 2; ++ai)
#pragma unroll
            for (int m = 0; m < 4; ++m) {
                const int row = row0 + ai * HALF + m * 16;
                const float rs = rstd_get(ss, u, row, pf, ext);
                float o[8];
#pragma unroll
                for (int n = 0; n < 2; ++n)
#pragma unroll
                    for (int j = 0; j < 4; ++j) { const float a = acc[ai][0][m][n][j] * rs, b = acc[ai][1][m][n][j] * rs;
                        o[4 * n + j] = a * b * __builtin_amdgcn_rcpf(1.0f + __expf(-a)); }
                u32x4 w; w.x = cvt_pk_bf16(o[0], o[1]); w.y = cvt_pk_bf16(o[2], o[3]); w.z = cvt_pk_bf16(o[4], o[5]); w.w = cvt_pk_bf16(o[6], o[7]);
                *(u32x4*)(O + (size_t)row * ldo + col0) = w;
            }
    }
};
struct EpiMixIn {
    static constexpr bool PERM = true, AFTER_DRAIN = false;
    bf16_t* O; const ss_t* ss;
    template <class Sched> __device__ __forceinline__ int prepare(const Sched& S, PG8_LAS unsigned char* ext, int tid) const { return rstd_table_fill(S, ss, ext, tid); }
    __device__ __forceinline__ void operator()(const f32x4 (&acc)[2][2][4][2], const Unit& u, int wr, int wc, int fr, int fq, int pf, const PG8_LAS unsigned char* ext) const {
        const int row0 = u.pm * BM + wr * 64 + fr, col0 = u.pn * BM + wc * 32 + 8 * fq;
#pragma unroll
        for (int ai = 0; ai < 2; ++ai)
#pragma unroll
            for (int m = 0; m < 4; ++m) {
                const int row = row0 + ai * HALF + m * 16;
                const float rs = rstd_get(ss, u, row, pf, ext);
#pragma unroll
                for (int bj = 0; bj < 2; ++bj) { const f32x4 v0 = acc[ai][bj][m][0] * rs, v1 = acc[ai][bj][m][1] * rs;
                    u32x4 w; w.x = cvt_pk_bf16(v0[0], v0[1]); w.y = cvt_pk_bf16(v0[2], v0[3]); w.z = cvt_pk_bf16(v1[0], v1[1]); w.w = cvt_pk_bf16(v1[2], v1[3]);
                    *(u32x4*)(O + (size_t)row * 6144 + col0 + bj * HALF) = w; }
            }
    }
};
struct EpiResid {
    static constexpr bool PERM = true, AFTER_DRAIN = false;
    bf16_t* hb; ss_t* ssn; float scale;
    template <class Sched> __device__ __forceinline__ int prepare(const Sched&, PG8_LAS unsigned char*, int) const { return 0; }
    __device__ __forceinline__ void operator()(const f32x4 (&acc)[2][2][4][2], const Unit& u, int wr, int wc, int fr, int fq, int pf, const PG8_LAS unsigned char* ext) const {
        const int row0 = u.pm * BM + wr * 64 + fr, col0 = u.pn * BM + wc * 32 + 8 * fq;
        u32x4 rb[3][2];
#define PG8_LDG(gi, buf) do { const size_t off_ = (size_t)(row0 + ((gi) >> 2) * HALF + ((gi) & 3) * 16) * 2048 + col0; \
            _Pragma("unroll") for (int q_ = 0; q_ < 2; ++q_) buf[q_] = *(const u32x4*)(hb + off_ + q_ * HALF); } while (0)
        PG8_LDG(0, rb[0]); PG8_LDG(1, rb[1]);
#pragma unroll
        for (int gi = 0; gi < 8; ++gi) {
            if (gi + 2 < 8) PG8_LDG(gi + 2, rb[(gi + 2) % 3]);
            const int ai = gi >> 2, m = gi & 3;
            const int row = row0 + ai * HALF + m * 16; const size_t off = (size_t)row * 2048 + col0; float sq = 0.f;
#pragma unroll
            for (int bj = 0; bj < 2; ++bj) { const u32x4 hw = rb[gi % 3][bj];
                const f32x4 h0 = (f32x4){__uint_as_float(hw.x << 16), __uint_as_float(hw.x & 0xffff0000u), __uint_as_float(hw.y << 16), __uint_as_float(hw.y & 0xffff0000u)};
                const f32x4 h1 = (f32x4){__uint_as_float(hw.z << 16), __uint_as_float(hw.z & 0xffff0000u), __uint_as_float(hw.w << 16), __uint_as_float(hw.w & 0xffff0000u)};
                const f32x4 n0 = h0 + acc[ai][bj][m][0] * scale, n1 = h1 + acc[ai][bj][m][1] * scale;
                u32x4 w; w.x = cvt_pk_bf16(n0[0], n0[1]); w.y = cvt_pk_bf16(n0[2], n0[3]); w.z = cvt_pk_bf16(n1[0], n1[1]); w.w = cvt_pk_bf16(n1[2], n1[3]);
                *(u32x4*)(hb + off + bj * HALF) = w;
                const float r0 = __uint_as_float(w.x << 16), r1 = __uint_as_float(w.x & 0xffff0000u), r2 = __uint_as_float(w.y << 16), r3 = __uint_as_float(w.y & 0xffff0000u);
                const float r4 = __uint_as_float(w.z << 16), r5 = __uint_as_float(w.z & 0xffff0000u), r6 = __uint_as_float(w.w << 16), r7 = __uint_as_float(w.w & 0xffff0000u);
                sq += ((r0 * r0 + r1 * r1) + (r2 * r2 + r3 * r3)) + ((r4 * r4 + r5 * r5) + (r6 * r6 + r7 * r7)); }
            sq += __shfl_xor(sq, 16); sq += __shfl_xor(sq, 32);
            if (fq == 0) atomicAdd((unsigned long long*)(ssn + row), (unsigned long long)__float2ll_rn(sq * SS_FIX));
        }
#undef PG8_LDG
    }
};

template <class Epi, class Sched, bool ALIGN_EPI = false, bool SP2 = false>
__device__ __forceinline__ void gemm_phase(PG8_LAS unsigned char* lds, const Gemm g, const Sched& S, const Epi& E) {
    int tid_ = threadIdx.x; asm volatile("" : "+v"(tid_));
    const int tid = tid_, wid = __builtin_amdgcn_readfirstlane(tid >> 6), lane = tid & 63, wr = wid >> 2, wc = wid & 3, fr = lane & 15, fq = lane >> 4;
    const int K = g.K, nt = K / BK;
    unsigned voffA[2], voffB[2];
#pragma unroll
    for (int i = 0; i < 2; ++i) { int R, C; stage_rc(tid * 16 + i * 8192, R, C); const int Rb = Epi::PERM ? ((R & ~31) + perm32(R & 31)) : R;
        voffA[i] = (unsigned)(R * K + C) * 2u; voffB[i] = (unsigned)(Rb * K + C) * 2u; }
    const size_t kstep = (size_t)(BK * 2);
    const size_t hstep = (size_t)HALF * K * 2;
    const size_t tstep = 2 * hstep;
    const unsigned ldsw = (unsigned)wid * 1024u;
    const int aoff = lds_byte(wr * 64 + fr, fq * 8), boff = lds_byte(wc * 32 + fr, fq * 8);
#define PG8_SA(b, h) (((b) * 2 + (h)) * HTB)
#define PG8_SB(b, h) ((4 + (b) * 2 + (h)) * HTB)
#define PG8_STAGE(bufoff, gbase, voff) do { _Pragma("unroll") for (int _i = 0; _i < 2; ++_i) \
        __builtin_amdgcn_global_load_lds((const unsigned*)((const char*)(gbase) + (voff)[_i]), (PG8_LAS unsigned*)(lds + (bufoff) + ldsw + _i * 8192), 16, 0, 0); } while (0)
#define PG8_LDA(dst, b, h) do { _Pragma("unroll") for (int m = 0; m < 4; ++m) _Pragma("unroll") for (int k = 0; k < 2; ++k) dst[m][k] = *(const PG8_LAS bf16x8*)(lds + PG8_SA(b, h) + aoff + m * 2048 + k * 1024); } while (0)
#define PG8_LDB(dst, b, h) do { _Pragma("unroll") for (int n = 0; n < 2; ++n) _Pragma("unroll") for (int k = 0; k < 2; ++k) dst[n][k] = *(const PG8_LAS bf16x8*)(lds + PG8_SB(b, h) + boff + n * 2048 + k * 1024); } while (0)
#define PG8_MMA(ai, bj, At, Bt) do { __builtin_amdgcn_s_setprio(1); _Pragma("unroll") for (int m = 0; m < 4; ++m) _Pragma("unroll") for (int n = 0; n < 2; ++n) _Pragma("unroll") for (int k = 0; k < 2; ++k) \
        acc[ai][bj][m][n] = __builtin_amdgcn_mfma_f32_16x16x32_bf16(Bt[n][k], At[m][k], acc[ai][bj][m][n], 0, 0, 0); __builtin_amdgcn_s_setprio(0); } while (0)
#define PG8_WAIT_V(n) asm volatile("s_waitcnt vmcnt(" #n ")" ::: "memory")
#define PG8_WAIT_L(n) asm volatile("s_waitcnt lgkmcnt(" #n ")" ::: "memory")
#define PG8_BAR __builtin_amdgcn_s_barrier()
#define PG8_SCHED __builtin_amdgcn_sched_barrier(0)
    const int pf = E.prepare(S, lds + STAGE_BYTES, tid);
    Unit cur, nxt; int ui = 0;
    if (!S.next(0, cur)) return;
    f32x4 acc[2][2][4][2];
#pragma unroll
    for (int a = 0; a < 2; ++a)
#pragma unroll
        for (int b = 0; b < 2; ++b)
#pragma unroll
            for (int m = 0; m < 4; ++m)
#pragma unroll
                for (int n = 0; n < 2; ++n) acc[a][b][m][n] = (f32x4){0.f, 0.f, 0.f, 0.f};
    bf16x8 At[4][2], B0[2][2], B1[2][2];
    const char* cA = (const char*)g.A + (size_t)cur.pm * tstep; const char* cB = (const char*)g.Bt + (size_t)cur.pn * tstep;
    S.a_ready(cur);
    if constexpr (SP2) {
        PG8_STAGE(PG8_SB(0, 0), cB, voffB); PG8_STAGE(PG8_SB(0, 1), cB + hstep, voffB); PG8_STAGE(PG8_SA(0, 0), cA, voffA); PG8_STAGE(PG8_SA(0, 1), cA + hstep, voffA);
        if (wr == 1) PG8_BAR;
        PG8_WAIT_V(2); PG8_BAR;
        PG8_STAGE(PG8_SB(1, 0), cB + kstep, voffB); PG8_STAGE(PG8_SA(1, 0), cA + kstep, voffA); PG8_STAGE(PG8_SB(1, 1), cB + hstep + kstep, voffB);
        PG8_WAIT_V(6); PG8_BAR;
    } else {
        PG8_STAGE(PG8_SB(0, 0), cB, voffB); PG8_STAGE(PG8_SA(0, 0), cA, voffA); PG8_STAGE(PG8_SB(0, 1), cB + hstep, voffB); PG8_STAGE(PG8_SA(0, 1), cA + hstep, voffA);
        if (wr == 1) PG8_BAR;
        PG8_WAIT_V(4); PG8_BAR;
        PG8_STAGE(PG8_SB(1, 0), cB + kstep, voffB); PG8_STAGE(PG8_SA(1, 0), cA + kstep, voffA); PG8_STAGE(PG8_SB(1, 1), cB + hstep + kstep, voffB);
        PG8_WAIT_V(6); PG8_BAR;
    }
    for (;;) {
        const bool has_next = S.next(ui + 1, nxt);
        const char* nA = has_next ? (const char*)g.A + (size_t)nxt.pm * tstep : cA; const char* nB = has_next ? (const char*)g.Bt + (size_t)nxt.pn * tstep : cB;
        for (int t = 0; t < nt; t += 2) {
            const bool last = (t == nt - 2);
            const char* a1 = cA + (size_t)(t + 1) * kstep;
            const char* a2 = last ? nA : cA + (size_t)(t + 2) * kstep; const char* b2 = last ? nB : cB + (size_t)(t + 2) * kstep;
            const char* a3 = a2 + kstep; const char* b3 = b2 + kstep;
            if (last && has_next) S.a_ready(nxt);
            if constexpr (SP2) {
            PG8_LDB(B0, 0, 0); PG8_LDB(B1, 0, 1); PG8_SCHED; PG8_LDA(At, 0, 0); PG8_STAGE(PG8_SA(1, 1), a1 + hstep, voffA);
            PG8_WAIT_V(8); PG8_WAIT_L(0); PG8_BAR; PG8_MMA(0, 0, At, B0); PG8_MMA(0, 1, At, B1); PG8_BAR; PG8_SCHED;
            PG8_LDA(At, 0, 1); PG8_STAGE(PG8_SB(0, 0), b2, voffB); PG8_STAGE(PG8_SB(0, 1), b2 + hstep, voffB); PG8_STAGE(PG8_SA(0, 0), a2, voffA);
            PG8_WAIT_V(8); PG8_WAIT_L(0); PG8_BAR; PG8_MMA(1, 0, At, B0); PG8_MMA(1, 1, At, B1); PG8_BAR; PG8_SCHED;
            PG8_LDB(B0, 1, 0); PG8_LDB(B1, 1, 1); PG8_SCHED; PG8_LDA(At, 1, 0); PG8_STAGE(PG8_SA(0, 1), a2 + hstep, voffA);
            PG8_WAIT_V(8); PG8_WAIT_L(0); PG8_BAR; PG8_MMA(0, 0, At, B0); PG8_MMA(0, 1, At, B1); PG8_BAR; PG8_SCHED;
            PG8_LDA(At, 1, 1); PG8_STAGE(PG8_SB(1, 0), b3, voffB); PG8_STAGE(PG8_SB(1, 1), b3 + hstep, voffB); PG8_STAGE(PG8_SA(1, 0), a3, voffA);
            PG8_WAIT_V(8); PG8_WAIT_L(0); PG8_BAR; PG8_MMA(1, 0, At, B0); PG8_MMA(1, 1, At, B1); PG8_BAR; PG8_SCHED;
            } else {
            PG8_LDB(B0, 0, 0); PG8_SCHED; PG8_LDA(At, 0, 0); PG8_STAGE(PG8_SA(1, 1), a1 + hstep, voffA);
            PG8_WAIT_L(8); PG8_BAR; PG8_WAIT_L(0); PG8_MMA(0, 0, At, B0); PG8_BAR; PG8_SCHED;
            PG8_LDB(B1, 0, 1); PG8_STAGE(PG8_SB(0, 0), b2, voffB);
            PG8_BAR; PG8_WAIT_L(0); PG8_MMA(0, 1, At, B1); PG8_BAR;
            PG8_LDA(At, 0, 1); PG8_STAGE(PG8_SA(0, 0), a2, voffA);
            PG8_BAR; PG8_WAIT_L(0); PG8_MMA(1, 0, At, B0); PG8_BAR; PG8_SCHED;
            PG8_STAGE(PG8_SB(0, 1), b2 + hstep, voffB);
            PG8_WAIT_V(6); PG8_BAR; PG8_MMA(1, 1, At, B1); PG8_BAR;
            PG8_LDB(B0, 1, 0); PG8_SCHED; PG8_LDA(At, 1, 0); PG8_STAGE(PG8_SA(0, 1), a2 + hstep, voffA);
            PG8_WAIT_L(8); PG8_BAR; PG8_WAIT_L(0); PG8_MMA(0, 0, At, B0); PG8_BAR; PG8_SCHED;
            PG8_LDB(B1, 1, 1); PG8_STAGE(PG8_SB(1, 0), b3, voffB);
            PG8_BAR; PG8_WAIT_L(0); PG8_MMA(0, 1, At, B1); PG8_BAR;
            PG8_LDA(At, 1, 1); PG8_STAGE(PG8_SA(1, 0), a3, voffA);
            PG8_BAR; PG8_WAIT_L(0); PG8_MMA(1, 0, At, B0); PG8_BAR; PG8_SCHED;
            PG8_STAGE(PG8_SB(1, 1), b3 + hstep, voffB);
            PG8_WAIT_V(6); PG8_BAR; PG8_MMA(1, 1, At, B1); PG8_BAR;
            }
        }
        if constexpr (ALIGN_EPI) { if (wr == 0) PG8_BAR; }
        if constexpr (!Epi::AFTER_DRAIN) { E(acc, cur, wr, wc, fr, fq, pf, lds + STAGE_BYTES); S.done(cur); }
        if (!has_next) break;
#pragma unroll
        for (int a = 0; a < 2; ++a)
#pragma unroll
            for (int b = 0; b < 2; ++b)
#pragma unroll
                for (int m = 0; m < 4; ++m)
#pragma unroll
                    for (int n = 0; n < 2; ++n) acc[a][b][m][n] = (f32x4){0.f, 0.f, 0.f, 0.f};
        cur = nxt; cA = nA; cB = nB; ++ui;
        if constexpr (ALIGN_EPI) { if (wr == 1) PG8_BAR; }
    }
    PG8_WAIT_V(0);
    if constexpr (!ALIGN_EPI) { if (wr == 0) PG8_BAR; }
    PG8_BAR;
    if constexpr (Epi::AFTER_DRAIN) { E.fused(acc, cur, wr, wc, fr, fq, lds, wid, lane); S.done(cur); }
#undef PG8_SA
#undef PG8_SB
#undef PG8_STAGE
#undef PG8_LDA
#undef PG8_LDB
#undef PG8_MMA
#undef PG8_WAIT_V
#undef PG8_WAIT_L
#undef PG8_BAR
#undef PG8_SCHED
}
}

#ifndef PG8_SP2
#define PG8_SP2 true
#endif
#ifndef PG8_ALIGN
#define PG8_ALIGN true
#endif
#ifndef REP_PRO
#define REP_PRO 1
#endif
#ifndef REP_MLSTM
#define REP_MLSTM 1
#endif
#ifndef REP_FOX
#define REP_FOX 1
#endif
#ifndef REP_GLA
#define REP_GLA 1
#endif
#ifndef MK_PER_PHASE
#define MK_PER_PHASE 0
#endif

constexpr int DM = 2048, BATCH = 8, SEQ = 4096, MTOK = BATCH * SEQ, DEPTH = 4, DFF = 5632, NUP = 2 * DFF, NIN = 6160, NINP = 6400, NQKV = 6144;
constexpr int NWAVES = 8;
constexpr int NSUB = 3 * DEPTH;
constexpr int NPHASE = 2 + 5 * NSUB;

constexpr size_t MiB = 1u << 20;
constexpr size_t WS_CTL = 0, CTL_ZERO_BYTES = 5 * MiB;
constexpr size_t WS_SS = 1 * MiB;
constexpr size_t WS_WUP = 8 * MiB;
constexpr size_t WS_WDN = WS_WUP + 352 * MiB;
constexpr size_t WS_WIN = WS_WDN + 176 * MiB;
constexpr size_t WS_WOUT = WS_WIN + 100 * MiB;
constexpr size_t WS_HB = WS_WOUT + 32 * MiB;
constexpr size_t WS_ACT = WS_HB + 128 * MiB;
constexpr size_t WS_P1 = WS_ACT + 352 * MiB;
constexpr size_t WS_G = WS_P1 + 384 * MiB;
constexpr size_t WS_HRAW = WS_G + 2 * MiB;
constexpr size_t WS_HM = WS_HRAW + 256 * MiB;
constexpr size_t WS_CF = WS_HM + 128 * MiB;
constexpr size_t WS_END = WS_CF + 2 * MiB;
static_assert((size_t)8 * NUP * DM * 2 == 352 * MiB && (size_t)8 * DM * DFF * 2 == 176 * MiB && (size_t)4 * NINP * DM * 2 == 100 * MiB, "weight regions");
static_assert((size_t)MTOK * DFF * 2 == 352 * MiB && (size_t)MTOK * NQKV * 2 == 384 * MiB && WS_SS + 13 * (size_t)MTOK * 8 <= CTL_ZERO_BYTES, "activation regions");
constexpr int CW_BAR = 4096;

constexpr int LDS_BYTES = 153600, MISC_OFF = 152576;

#define GAS __attribute__((address_space(1)))
#define LAS __attribute__((address_space(3)))
#define DI __device__ __forceinline__
typedef unsigned short bf16;
typedef unsigned v4u __attribute__((ext_vector_type(4)));
typedef unsigned v2u __attribute__((ext_vector_type(2)));
typedef float f32x4 __attribute__((ext_vector_type(4)));
typedef short bf16x8 __attribute__((ext_vector_type(8)));
typedef GAS unsigned gu32;
#define RLX_AGENT __ATOMIC_RELAXED, __HIP_MEMORY_SCOPE_AGENT
#define LDS_WAIT() asm volatile("s_waitcnt lgkmcnt(0)" ::: "memory")
DI unsigned f2bf(float f) { unsigned r; asm("v_cvt_pk_bf16_f32 %0, %1, %1" : "=v"(r) : "v"(f)); return r & 0xffffu; }
DI unsigned pk2(float lo, float hi) { unsigned r; asm("v_cvt_pk_bf16_f32 %0, %1, %2" : "=v"(r) : "v"(lo), "v"(hi)); return r; }
DI float bf2f(unsigned short v) { return __builtin_bit_cast(float, (unsigned)v << 16); }
DI float bflo(unsigned w) { return __builtin_bit_cast(float, w << 16); }
DI float bfhi(unsigned w) { return __builtin_bit_cast(float, w & 0xffff0000u); }
DI float logsig(float x) { return fminf(x, 0.f) - log1pf(expf(-fabsf(x))); }

#define XB_TMO      128
#define XB_XCNT(j)  (256  + 64 * (j))
#define XB_XSUB(j)  (1280 + 64 * (j))
#define XB_XGEN(j)  (2304 + 64 * (j))
#define XB_TOP      3328
#define XB_TOPGEN   3392
#define XCD_BAR_WORDS 3456
#define XB_SPIN_CAP (1u << 18)

__device__ __forceinline__ unsigned xb_ld(unsigned* p)              { return __hip_atomic_load(p, __ATOMIC_RELAXED, __HIP_MEMORY_SCOPE_AGENT); }
__device__ __forceinline__ unsigned xb_add(unsigned* p, unsigned v) { return __hip_atomic_fetch_add(p, v, __ATOMIC_RELAXED, __HIP_MEMORY_SCOPE_AGENT); }
__device__ __forceinline__ unsigned xb_xcc_id() { return (unsigned)__builtin_amdgcn_s_getreg((3 << 11) | 20) & 0xFu; }
#define XB_SPIN(cond, bar) do { unsigned _sp = 0; while (cond) { __builtin_amdgcn_s_sleep(1); \
    if ((++_sp & 255u) == 0u) { if (xb_ld(&(bar)[XB_TMO])) break; if (_sp > XB_SPIN_CAP) { atomicAdd(&(bar)[XB_TMO], 1u); break; } } } } while (0)

struct XcdBarrier {
    unsigned* bar; unsigned x;
    volatile LAS unsigned* st;
};

__device__ __forceinline__ XcdBarrier xcd_barrier_post(unsigned* bar, volatile LAS unsigned* st) {
    XcdBarrier b; b.bar = bar; b.x = xb_xcc_id(); b.st = st;
    if (threadIdx.x == 0) (void)xb_add(&bar[XB_XCNT(b.x)], 1u);
    return b;
}
__device__ __forceinline__ void xcd_barrier_complete(unsigned* bar, unsigned x, unsigned& nloc, unsigned& nx) {
    const unsigned G = gridDim.x * gridDim.y * gridDim.z;
    unsigned sum, cnt, mine, sp = 0u;
    for (;;) {
        sum = 0u; cnt = 0u; mine = 0u;
#pragma unroll
        for (unsigned j = 0; j < 16; ++j) { const unsigned c = xb_ld(&bar[XB_XCNT(j)]); sum += c; cnt += (c > 0u) ? 1u : 0u; mine = (j == x) ? c : mine; }
        if (sum == G) break;
        __builtin_amdgcn_s_sleep(1);
        if ((++sp & 255u) == 0u) { if (xb_ld(&bar[XB_TMO])) break; if (sp > XB_SPIN_CAP) { atomicAdd(&bar[XB_TMO], 1u); break; } }
    }
    nloc = mine > 0u ? mine : 1u; nx = cnt > 0u ? cnt : 1u;
}

__device__ __forceinline__ void xcd_barrier(const XcdBarrier& b) {
    asm volatile("s_waitcnt vmcnt(0)" ::: "memory");
    __syncthreads();
    if (threadIdx.x == 0) {
        unsigned* bar = b.bar;
        __builtin_amdgcn_s_waitcnt(0);
        unsigned nloc = b.st[0], nx = b.st[1];
        if (nloc == 0u) { xcd_barrier_complete(bar, b.x, nloc, nx); b.st[0] = nloc; b.st[1] = nx; }
        const unsigned old = xb_add(&bar[XB_XSUB(b.x)], 1u);
        const unsigned gen = old / nloc;
        if (old + 1u == (gen + 1u) * nloc) {
            __builtin_amdgcn_fence(__ATOMIC_RELEASE, "agent");
            asm volatile("s_waitcnt vmcnt(0)" ::: "memory");
            const unsigned og = xb_add(&bar[XB_TOP], 1u);
            const unsigned tg = og / nx;
            if (og + 1u == (tg + 1u) * nx) xb_add(&bar[XB_TOPGEN], 1u);
            else XB_SPIN(xb_ld(&bar[XB_TOPGEN]) == tg, bar);
            __builtin_amdgcn_fence(__ATOMIC_ACQUIRE, "agent");
            xb_add(&bar[XB_XGEN(b.x)], 1u);
            asm volatile("s_waitcnt vmcnt(0)" ::: "memory");
        } else {
            XB_SPIN(xb_ld(&bar[XB_XGEN(b.x)]) == gen, bar);
            __builtin_amdgcn_fence(__ATOMIC_ACQUIRE, "agent");
            asm volatile("s_waitcnt vmcnt(0)" ::: "memory");
        }
    }
    __syncthreads();
}


DI float wave_sum(float v) {
#pragma unroll
    for (int o = 1; o < 64; o <<= 1) v += __shfl_xor(v, o);
    return v;
}
DI float wave_max(float v) {
#pragma unroll
    for (int o = 1; o < 64; o <<= 1) v = fmaxf(v, __shfl_xor(v, o));
    return v;
}
DI float wave_incl_sum(float v, int lane) {
#pragma unroll
    for (int o = 1; o < 64; o <<= 1) { const float t = __shfl_up(v, o); if (lane >= o) v += t; }
    return v;
}
DI float wave_incl_max(float v, int lane) {
#pragma unroll
    for (int o = 1; o < 64; o <<= 1) { const float t = __shfl_up(v, o); if (lane >= o) v = fmaxf(v, t); }
    return v;
}

template <int L> DI int swx(int r) { return L == 64 ? ((r >> 1) & 7) : (r & 15); }
template <int L> DI int eoff(int r, int c) { return r * L + ((((c >> 3) ^ swx<L>(r)) << 3) | (c & 7)); }
template <int L> DI bf16x8 ldf(const LAS bf16* base, int r, int ch) { return *(const LAS bf16x8*)(base + r * L + ((ch ^ swx<L>(r)) << 3)); }
DI f32x4 mfma16(bf16x8 a, bf16x8 b, f32x4 c) { return __builtin_amdgcn_mfma_f32_16x16x32_bf16(a, b, c, 0, 0, 0); }
typedef short v4i16_t __attribute__((ext_vector_type(4)));
DI v4i16_t tr_read(const LAS unsigned char* p) { return __builtin_amdgcn_ds_read_tr16_b64_v4i16((LAS v4i16_t*)p); }
DI bf16x8 cat4(v4i16_t lo, v4i16_t hi) { bf16x8 r; r[0] = lo[0]; r[1] = lo[1]; r[2] = lo[2]; r[3] = lo[3]; r[4] = hi[0]; r[5] = hi[1]; r[6] = hi[2]; r[7] = hi[3]; return r; }
DI unsigned off_v64(unsigned row, unsigned ch) { return 128u * row + 16u * (ch ^ ((((row >> 1) & 1u) << 1) | (((row >> 3) & 1u) << 2))); }
DI bf16x8 vfrag64(const LAS unsigned char* vb, int c, int ks, int lane) { const unsigned g = lane >> 4, q = (lane & 15) >> 2, p = lane & 3;
    return cat4(tr_read(vb + off_v64(32 * ks + 8 * g + q, 2 * c + (p >> 1)) + 8 * (p & 1)), tr_read(vb + off_v64(32 * ks + 8 * g + 4 + q, 2 * c + (p >> 1)) + 8 * (p & 1))); }
template <int LA, int LB, int NK> DI void mma_tile(f32x4& acc, const LAS bf16* A, int ra0, const LAS bf16* B, int rb0, int lane) {
    const int r = lane & 15, g = lane >> 4;
#pragma unroll
    for (int kk = 0; kk < NK; ++kk) { const bf16x8 a = ldf<LA>(A, ra0 + r, 4 * kk + g), b = ldf<LB>(B, rb0 + r, 4 * kk + g); acc = mfma16(a, b, acc); }
}

struct ConvItem { const float* W; const float* gk; bf16* WT; int K, N, mode, r; };
DI void conv_load(const ConvItem& c, int lane, f32x4 (&v)[8], float (&gv)[8]) {
    const int nkb = c.K / 64, nb = c.r / nkb, kb = c.r - nb * nkb, k0 = 64 * kb, n0 = 32 * nb;
    const int n = n0 + 4 * (lane & 7); const bool ok = n < c.N;
#pragma unroll
    for (int i = 0; i < 8; ++i) { const int kk = 8 * i + (lane >> 3); v[i] = ok ? *(const f32x4*)(c.W + (size_t)(k0 + kk) * c.N + n) : (f32x4){0.f, 0.f, 0.f, 0.f}; gv[i] = c.gk ? c.gk[k0 + kk] : 1.0f; }
}
DI void conv_store(const ConvItem& c, int lane, const f32x4 (&v)[8], const float (&gv)[8], LAS float* scr) {
    const int nkb = c.K / 64, nb = c.r / nkb, kb = c.r - nb * nkb, k0 = 64 * kb, n0 = 32 * nb, nq = 4 * (lane & 7);
#pragma unroll
    for (int i = 0; i < 8; ++i) { const int kk = 8 * i + (lane >> 3); LAS float* d = scr + kk * 33 + nq; d[0] = v[i].x * gv[i]; d[1] = v[i].y * gv[i]; d[2] = v[i].z * gv[i]; d[3] = v[i].w * gv[i]; }
    LDS_WAIT(); asm volatile("" ::: "memory");
    int row_off = n0;
    if (c.mode == 1) { const int j = n0 < DFF ? n0 : n0 - DFF; row_off = 256 * (j >> 7) + (j & 127) + (n0 < DFF ? 0 : 128); }
    const int cc = lane & 7;
#pragma unroll
    for (int j = 0; j < 4; ++j) { const int nn = (lane >> 3) + 8 * j; const LAS float* s = scr + (8 * cc) * 33 + nn;
        v4u o; o.x = pk2(s[0 * 33], s[1 * 33]); o.y = pk2(s[2 * 33], s[3 * 33]); o.z = pk2(s[4 * 33], s[5 * 33]); o.w = pk2(s[6 * 33], s[7 * 33]);
        *(v4u*)(c.WT + (size_t)(row_off + nn) * c.K + k0 + 8 * cc) = o; }
    LDS_WAIT(); asm volatile("" ::: "memory");
}

struct Args { const float* in[18]; float* out; unsigned char* ws; int ph_lo, ph_hi; };

typedef const __attribute__((address_space(4))) Args* KArgs;
DI KArgs kargs() { KArgs p = (KArgs)__builtin_amdgcn_kernarg_segment_ptr(); asm volatile("" : "+s"(p)); return p; }
DI void prologue(LAS unsigned char* lds, int lane, int wave, int bx) {
    KArgs AP = kargs();
    LAS float* scr = (LAS float*)(lds + wave * 16384);
    const int gw = bx * NWAVES + wave, NGW = gridDim.x * NWAVES;
    unsigned char* ws = AP->ws;
    constexpr int I_UP = (DM / 64) * (NUP / 32), I_DN = (DFF / 64) * (DM / 32), I_IN = (DM / 64) * (NINP / 32), I_OUT = (DM / 64) * (DM / 32);
    constexpr int NITEMS = 8 * I_UP + 8 * I_DN + 4 * I_IN + 4 * I_OUT;
#define CONV_DECODE(it_, c_) do { int r = (it_); (c_).gk = nullptr; (c_).K = DM; (c_).mode = 0; \
        if (r < 8 * I_UP) { const int mi = r / I_UP; r -= mi * I_UP; (c_).W = AP->in[2] + (size_t)mi * DM * NUP; (c_).gk = AP->in[1] + (size_t)mi * DM; (c_).WT = (bf16*)(ws + WS_WUP) + (size_t)mi * NUP * DM; (c_).N = NUP; (c_).mode = 1; } \
        else if (r < 8 * I_UP + 8 * I_DN) { r -= 8 * I_UP; const int mi = r / I_DN; r -= mi * I_DN; (c_).W = AP->in[3] + (size_t)mi * DFF * DM; (c_).WT = (bf16*)(ws + WS_WDN) + (size_t)mi * DM * DFF; (c_).K = DFF; (c_).N = DM; } \
        else if (r < 8 * I_UP + 8 * I_DN + 4 * I_IN) { r -= 8 * I_UP + 8 * I_DN; const int l = r / I_IN; r -= l * I_IN; const int kind = l % 3, ji = l / 3; \
            (c_).W = AP->in[kind == 0 ? 5 : kind == 1 ? 9 : 12] + (size_t)ji * DM * NIN; (c_).gk = AP->in[4] + (size_t)l * DM; (c_).WT = (bf16*)(ws + WS_WIN) + (size_t)l * NINP * DM; (c_).N = NIN; } \
        else { r -= 8 * I_UP + 8 * I_DN + 4 * I_IN; const int l = r / I_OUT; r -= l * I_OUT; const int kind = l % 3, ji = l / 3; \
            (c_).W = AP->in[kind == 0 ? 8 : kind == 1 ? 11 : 16] + (size_t)ji * DM * DM; (c_).WT = (bf16*)(ws + WS_WOUT) + (size_t)l * DM * DM; (c_).N = DM; } \
        (c_).r = r; } while (0)
    f32x4 va[8]; float ga[8]; ConvItem ca{}, cb{};
    if (gw < NITEMS) { CONV_DECODE(gw, ca); conv_load(ca, lane, va, ga); }
    for (int it = gw; it < NITEMS; it += NGW) {
        f32x4 vb[8]; float gb[8]; const int nx = it + NGW;
        if (nx < NITEMS) { CONV_DECODE(nx, cb); conv_load(cb, lane, vb, gb); }
        conv_store(ca, lane, va, ga, scr);
        ca = cb;
#pragma unroll
        for (int i = 0; i < 8; ++i) { va[i] = vb[i]; ga[i] = gb[i]; }
    }
#undef CONV_DECODE
    const float* x = AP->in[0]; bf16* hb = (bf16*)(ws + WS_HB); long long* ss0 = (long long*)(ws + WS_SS);
    for (int m = gw; m < MTOK; m += NGW) {
        const f32x4* xr = (const f32x4*)(x + (size_t)m * DM) + lane; f32x4 v[8]; float s = 0.f;
#pragma unroll
        for (int j = 0; j < 8; ++j) { v[j] = xr[64 * j]; s += (v[j].x * v[j].x + v[j].y * v[j].y) + (v[j].z * v[j].z + v[j].w * v[j].w); }
        s = wave_sum(s);
        v2u* o8 = (v2u*)(hb + (size_t)m * DM) + lane;
#pragma unroll
        for (int j = 0; j < 8; ++j) { v2u w; w.x = pk2(v[j].x, v[j].y); w.y = pk2(v[j].z, v[j].w); o8[64 * j] = w; }
        if (lane == 0) ss0[m] = __float2ll_rn(s * 1048576.0f);
    }
}

constexpr int IMGM_P = 0, IMGM_KT = 8192, IMGM_VT = IMGM_KT + 16384, IMGM_GS = IMGM_VT + 4 * 8192, IMGM_BYTES = IMGM_GS + 1024;
constexpr int IMGG_Q = 0, IMGG_KT = 32768, IMGG_P = 65536, IMGG_VT = IMGG_P + 8192, IMGG_EB = IMGG_VT + 8 * 8192, IMGG_BYTES = IMGG_EB + 1024;
static_assert((size_t)IMGM_BYTES * 4096 <= 352 * MiB && (size_t)IMGG_BYTES * 2048 <= 352 * MiB, "images overlay the (idle) FFN activation buffer");
DI unsigned pk2_sw(float lo, float hi) { unsigned a = __builtin_bit_cast(unsigned, lo), b = __builtin_bit_cast(unsigned, hi); a = (a + 0x7fffu + ((a >> 16) & 1u)) >> 16; b = (b + 0x7fffu + ((b >> 16) & 1u)) & 0xffff0000u; return a | b; }
DI float logsig_fast(float x) { return fminf(x, 0.f) - __logf(1.0f + __expf(-fabsf(x))); }

DI void mlstm_pre(LAS unsigned char* lds, const bf16* P1, const float* G, const float* b_if, unsigned char* img, int tid, int lane, int wave, int bx) {
    LAS bf16* Qs = (LAS bf16*)lds;
    LAS bf16* Ks = Qs + 64 * 128;
    LAS bf16* KTs = Ks + 64 * 128;
    LAS bf16* Ps = KTs + 128 * 64;
    LAS bf16* VT = Ps + 64 * 64;
    LAS float* fa = (LAS float*)(VT + 256 * 64);
    LAS float *bcum = fa, *ipre = fa + 64, *aloc = fa + 128, *wloc = fa + 192, *scal = fa + 256;
    const float KSCALE = 0.08838834764831845f;
    const int g = lane >> 4, r16 = lane & 15;
    v4u pq[2], pk[2]; float pgi = 0.f, pgf = 0.f;
#define MLP_LOAD(it_) do { const int b_ = (it_) >> 9, c_ = ((it_) >> 3) & 63, h_ = (it_) & 7; const int row0_ = b_ * SEQ + c_ * 64; \
        _Pragma("unroll") for (int p = 0; p < 2; ++p) { const int idx = tid + 512 * p, r = idx >> 4, c8 = idx & 15; const bf16* src = P1 + (size_t)(row0_ + r) * NQKV + h_ * 128 + c8 * 8; pq[p] = *(const v4u*)src; pk[p] = *(const v4u*)(src + 1024); } \
        if (tid < 64) { const float* gp = G + (size_t)(row0_ + tid) * 16; pgi = gp[h_]; pgf = gp[8 + h_]; } } while (0)
    if (bx < 4096) MLP_LOAD(bx);
    for (int item = bx; item < 4096; item += gridDim.x) {
        const int h = item & 7;
        unsigned char* im = img + (size_t)item * IMGM_BYTES;
        __syncthreads();
        if (tid < 64) { ipre[tid] = pgi + b_if[h]; bcum[tid] = logsig(pgf + b_if[8 + h]); }
#pragma unroll
        for (int p = 0; p < 2; ++p) { const int idx = tid + 512 * p, r = idx >> 4, c8 = idx & 15; *(LAS v4u*)(Qs + eoff<128>(r, c8 * 8)) = pq[p]; *(LAS v4u*)(Ks + eoff<128>(r, c8 * 8)) = pk[p]; }
        __syncthreads();
        if (wave == 0) {
            const float bt = wave_incl_sum(bcum[lane], lane), ip = ipre[lane];
            const float al = bt + wave_incl_max(ip - bt, lane);
            const float blast = __shfl(bt, 63);
            const float gg = blast - bt + ip;
            const float gmax = wave_max(gg);
            bcum[lane] = bt; aloc[lane] = al; wloc[lane] = __expf(gg - gmax);
            if (lane == 0) { scal[0] = blast; scal[1] = gmax; }
        }
        if (item + (int)gridDim.x < 4096) MLP_LOAD(item + (int)gridDim.x);
        __syncthreads();
#pragma unroll
        for (int p = 0; p < 2; ++p) { const int idx = tid + 512 * p, s = idx >> 4, c8 = idx & 15; const v4u kv = *(const LAS v4u*)(Ks + eoff<128>(s, c8 * 8)); const float w = wloc[s] * KSCALE;
#pragma unroll
            for (int j = 0; j < 4; ++j) { KTs[eoff<64>(c8 * 8 + 2 * j, s)] = (bf16)f2bf(bflo(kv[j]) * w); KTs[eoff<64>(c8 * 8 + 2 * j + 1, s)] = (bf16)f2bf(bfhi(kv[j]) * w); } }
        { const int tt = wave >> 1;
#pragma unroll
          for (int q2 = 0; q2 < 2; ++q2) { const int st = 2 * (wave & 1) + q2; f32x4 acc = (f32x4){0.f, 0.f, 0.f, 0.f};
            if (st <= tt) mma_tile<128, 128, 4>(acc, Qs, 16 * tt, Ks, 16 * st, lane);
            const int s = 16 * st + r16; const float cs = ipre[s] - bcum[s];
#pragma unroll
            for (int i = 0; i < 4; ++i) { const int t = 16 * tt + 4 * g + i; const float p = (s <= t) ? acc[i] * KSCALE * __expf(bcum[t] + cs - aloc[t]) : 0.f; Ps[eoff<64>(t, s)] = (bf16)f2bf(p); } } }
        __syncthreads();
        *(v4u*)(im + IMGM_P + tid * 16) = *(const LAS v4u*)((LAS unsigned char*)Ps + tid * 16);
#pragma unroll
        for (int p = 0; p < 2; ++p) *(v4u*)(im + IMGM_KT + (tid + 512 * p) * 16) = *(const LAS v4u*)((LAS unsigned char*)KTs + (tid + 512 * p) * 16);
        if (tid < 64) { float* gs = (float*)(im + IMGM_GS); gs[tid] = bcum[tid]; gs[64 + tid] = aloc[tid]; if (tid < 2) gs[128 + tid] = scal[tid]; }
    }
#undef MLP_LOAD
}

DI void mlstm_scan2(LAS unsigned char* lds, const bf16* P1, const unsigned char* img, bf16* hraw, int tid, int lane, int wave, int bx) {
    constexpr int IB = 8192 + 16384 + 16384 + 10240 + 1024;
    LAS bf16* CT0 = (LAS bf16*)(lds + 2 * IB);
    const int g = lane >> 4, r16 = lane & 15, tt = wave >> 1, eh = wave & 1;
    for (int item0 = bx; item0 < 256; item0 += gridDim.x) {
        const int item = (gridDim.x == 256) ? (item0 & 7) * 32 + (item0 >> 3) : item0;
        const int b = item >> 5, h = (item >> 2) & 7, sl = item & 3;
        f32x4 Cacc[5];
#pragma unroll
        for (int e = 0; e < 5; ++e) Cacc[e] = (f32x4){0.f, 0.f, 0.f, 0.f};
        __syncthreads();
        for (int i = tid; i < 2 * 80 * 128 / 8; i += 512) ((LAS v4u*)CT0)[i] = (v4u){0u, 0u, 0u, 0u};
        float m_prev = 0.f;
        v4u rp, rq[2], rk[2], rv; float rg0 = 0.f, rbl, rgm;
#define MLS_PREFETCH(cc) do { const int item2 = (b * 64 + (cc)) * 8 + h; const unsigned char* im = img + (size_t)item2 * IMGM_BYTES; const int row0_ = b * SEQ + (cc) * 64; \
            rp = *(const v4u*)(im + IMGM_P + tid * 16); rk[0] = *(const v4u*)(im + IMGM_KT + tid * 16); rk[1] = *(const v4u*)(im + IMGM_KT + (tid + 512) * 16); \
            rv = *(const v4u*)(P1 + (size_t)(row0_ + (tid >> 3)) * NQKV + 2048 + h * 256 + sl * 64 + (tid & 7) * 8); \
            _Pragma("unroll") for (int p = 0; p < 2; ++p) { const int idx = tid + 512 * p, r = idx >> 4, c8 = idx & 15; rq[p] = *(const v4u*)(P1 + (size_t)(row0_ + r) * NQKV + h * 128 + c8 * 8); } \
            const float* gs = (const float*)(im + IMGM_GS); if (tid < 128) rg0 = gs[tid]; rbl = gs[128]; rgm = gs[129]; } while (0)
#define MLS_STORE(bi) do { LAS unsigned char* bb = lds + (bi) * IB; \
            *(LAS v4u*)(bb + tid * 16) = rp; *(LAS v4u*)(bb + 8192 + 16384 + tid * 16) = rk[0]; *(LAS v4u*)(bb + 8192 + 16384 + (tid + 512) * 16) = rk[1]; \
            *(LAS v4u*)(bb + 8192 + 16384 + 16384 + off_v64(tid >> 3, tid & 7)) = rv; \
            _Pragma("unroll") for (int p = 0; p < 2; ++p) { const int idx = tid + 512 * p, r = idx >> 4, c8 = idx & 15; *(LAS v4u*)((LAS bf16*)(bb + 8192) + eoff<128>(r, c8 * 8)) = rq[p]; } \
            if (tid < 128) ((LAS float*)(bb + 8192 + 16384 + 16384 + 10240))[tid] = rg0; } while (0)
        MLS_PREFETCH(0); MLS_STORE(0);
        float blast = rbl, gmax = rgm;
        MLS_PREFETCH(1);
        __syncthreads();
        for (int c = 0; c < 64; ++c) {
            const int row0 = b * SEQ + c * 64;
            const LAS unsigned char* bb = lds + (c & 1) * IB;
            const LAS bf16* Ps = (const LAS bf16*)bb; const LAS bf16* Qs = (const LAS bf16*)(bb + 8192); const LAS bf16* KTs = (const LAS bf16*)(bb + 8192 + 16384);
            const LAS bf16* VTs = (const LAS bf16*)(bb + 8192 + 16384 + 16384); const LAS float* gsl = (const LAS float*)(bb + 8192 + 16384 + 16384 + 10240);
            LAS bf16* CTc = CT0 + (c & 1) * 80 * 128; LAS bf16* CTn = CT0 + ((c + 1) & 1) * 80 * 128;
            const int t = 16 * tt + r16;
            const float btv = gsl[t], alv = gsl[64 + t];
            const float mt = fmaxf(btv + m_prev, alv), al = __expf(alv - mt), be = __expf(btv + m_prev - mt), em = __expf(-mt);
            const float m_new = fmaxf(blast + m_prev, gmax), wcs = __expf(blast + m_prev - m_new), gam = __expf(gmax - m_new);
            m_prev = m_new;
            const LAS unsigned char* vb = (const LAS unsigned char*)VTs;
            bf16x8 onesf;
#pragma unroll
            for (int j = 0; j < 8; ++j) onesf[j] = (r16 == 0) ? (short)0x3f80 : (short)0;
            const bf16x8 pa0 = ldf<64>(Ps, 16 * tt + r16, g), pa1 = ldf<64>(Ps, 16 * tt + r16, 4 + g);
            f32x4 d1 = (f32x4){0.f, 0.f, 0.f, 0.f}, d2 = (f32x4){0.f, 0.f, 0.f, 0.f};
            d1 = mfma16(onesf, pa0, d1); d1 = mfma16(onesf, pa1, d1); mma_tile<128, 128, 4>(d2, CTc, 64, Qs, 16 * tt, lane);
            const float den = __shfl(al * d1[0] + be * d2[0], r16);
            const float dinv = __builtin_amdgcn_rcpf(fmaxf(fabsf(den), em));
#pragma unroll
            for (int q2 = 0; q2 < 2; ++q2) { const int et = 2 * eh + q2; f32x4 a1 = (f32x4){0.f, 0.f, 0.f, 0.f}, a2 = (f32x4){0.f, 0.f, 0.f, 0.f};
                a1 = mfma16(vfrag64(vb, et, 0, lane), pa0, a1); a1 = mfma16(vfrag64(vb, et, 1, lane), pa1, a1); mma_tile<128, 128, 4>(a2, CTc, 16 * et, Qs, 16 * tt, lane);
                const f32x4 o4 = (a1 * al + a2 * be) * dinv; v2u w; w.x = pk2(o4[0], o4[1]); w.y = pk2(o4[2], o4[3]);
                *(v2u*)(hraw + (size_t)(row0 + t) * DM + h * 256 + sl * 64 + 16 * et + 4 * g) = w; }
            const bf16x8 ka0 = ldf<64>(KTs, 16 * wave + r16, g), ka1 = ldf<64>(KTs, 16 * wave + r16, 4 + g);
#pragma unroll
            for (int et = 0; et < 5; ++et) { f32x4 tmp = (f32x4){0.f, 0.f, 0.f, 0.f};
                tmp = mfma16(ka0, et < 4 ? vfrag64(vb, et & 3, 0, lane) : onesf, tmp); tmp = mfma16(ka1, et < 4 ? vfrag64(vb, et & 3, 1, lane) : onesf, tmp);
                Cacc[et] = Cacc[et] * wcs + tmp * gam;
                v2u w; w.x = pk2(Cacc[et][0], Cacc[et][1]); w.y = pk2(Cacc[et][2], Cacc[et][3]);
                *(LAS v2u*)(CTn + eoff<128>(16 * et + r16, 16 * wave + 4 * g)) = w; }
            if (c + 1 < 64) { MLS_STORE((c + 1) & 1); blast = rbl; gmax = rgm; }
            if (c + 2 < 64) MLS_PREFETCH(c + 2);
            __syncthreads();
        }
#undef MLS_PREFETCH
#undef MLS_STORE
    }
}

DI void gla_pre(LAS unsigned char* lds, const bf16* P1, const float* G, const float* w_alpha, const float* b_alpha, unsigned char* img, int tid, int lane, int wave, int bx) {
    LAS bf16* VT = (LAS bf16*)lds;
    LAS bf16* QTs = (LAS bf16*)lds;
    LAS bf16* KTl = QTs + 64 * 256;
    LAS bf16* KTT = KTl + 64 * 256;
    LAS bf16* Ps = KTT + 256 * 64;
    LAS float* alow = (LAS float*)(Ps + 64 * 64);
    LAS float* T0 = alow + 1024;
    const int g = lane >> 4, r16 = lane & 15, d = tid & 255, sh = tid >> 8;
    for (int item = bx; item < 2048; item += gridDim.x) {
        const int b = item >> 8, c = (item >> 2) & 63, h = item & 3;
        const int row0 = b * SEQ + c * 64;
        unsigned char* im = img + (size_t)item * IMGG_BYTES;
        __syncthreads();
        float wa[16];
#pragma unroll
        for (int i = 0; i < 16; ++i) wa[i] = w_alpha[i * 1024 + h * 256 + d];
        const float ba = b_alpha[h * 256 + d];
        f32x4 al4 = (f32x4){0.f, 0.f, 0.f, 0.f};
        if (tid < 256) al4 = *(const f32x4*)(G + (size_t)(row0 + (tid >> 2)) * 16 + (tid & 3) * 4);
        if (tid < 256) *(LAS f32x4*)(alow + tid * 4) = al4;
        __syncthreads();
        const bf16* qsrc = P1 + (size_t)(row0 + 32 * sh) * NQKV + h * 256 + d;
        float bs[32]; float run = 0.f;
#pragma unroll
        for (int j = 0; j < 32; ++j) { const int s = 32 * sh + j; float z = ba;
#pragma unroll
            for (int i = 0; i < 16; ++i) z += alow[s * 16 + i] * wa[i];
            run += logsig_fast(z) * (1.0f / 16.0f); bs[j] = run; }
        if (sh == 0) T0[d] = run;
        __syncthreads();
        const float add = sh ? T0[d] : 0.f;
        if (sh) ((float*)(im + IMGG_EB))[d] = __expf(run + add);
#pragma unroll
        for (int q8 = 0; q8 < 4; ++q8) { unsigned kk[8];
#pragma unroll
            for (int j = 0; j < 8; ++j) { const int jj = 8 * q8 + j, s = 32 * sh + jj; const float bsum = bs[jj] + add;
                const float qv = bf2f(qsrc[(size_t)jj * NQKV]) * 0.0625f * __expf(bsum), kv = bf2f(qsrc[(size_t)jj * NQKV + 1024]) * __expf(-bsum);
                QTs[eoff<256>(s, d)] = (bf16)f2bf(qv); kk[j] = f2bf(kv); KTl[eoff<256>(s, d)] = (bf16)kk[j]; }
            v4u w; w.x = kk[0] | (kk[1] << 16); w.y = kk[2] | (kk[3] << 16); w.z = kk[4] | (kk[5] << 16); w.w = kk[6] | (kk[7] << 16);
            *(LAS v4u*)(KTT + eoff<64>(d, 32 * sh + 8 * q8)) = w; }
        __syncthreads();
        { const int tt = wave >> 1;
#pragma unroll
          for (int q2 = 0; q2 < 2; ++q2) { const int st = 2 * (wave & 1) + q2; f32x4 acc = (f32x4){0.f, 0.f, 0.f, 0.f};
            if (st <= tt) mma_tile<256, 256, 8>(acc, QTs, 16 * tt, KTl, 16 * st, lane);
            const int s = 16 * st + r16;
#pragma unroll
            for (int i = 0; i < 4; ++i) { const int t = 16 * tt + 4 * g + i; Ps[eoff<64>(t, s)] = (bf16)f2bf((s <= t) ? acc[i] : 0.f); } } }
        __syncthreads();
#pragma unroll
        for (int p = 0; p < 4; ++p) { *(v4u*)(im + IMGG_Q + (tid + 512 * p) * 16) = *(const LAS v4u*)((LAS unsigned char*)QTs + (tid + 512 * p) * 16);
                                      *(v4u*)(im + IMGG_KT + (tid + 512 * p) * 16) = *(const LAS v4u*)((LAS unsigned char*)KTT + (tid + 512 * p) * 16); }
        *(v4u*)(im + IMGG_P + tid * 16) = *(const LAS v4u*)((LAS unsigned char*)Ps + tid * 16);
    }
}

DI void gla_scan2(LAS unsigned char* lds, const bf16* P1, const unsigned char* img, bf16* hraw, int tid, int lane, int wave, int bx) {
    LAS bf16* QTs = (LAS bf16*)lds;
    LAS bf16* KTT = QTs + 64 * 256;
    LAS bf16* Ps = KTT + 256 * 64;
    LAS bf16* VTs = Ps + 64 * 64;
    LAS float* eb = (LAS float*)(VTs + 64 * 64);
    LAS bf16* ST0 = (LAS bf16*)(eb + 256);
    const int g = lane >> 4, r16 = lane & 15, tt = wave >> 1, eh = wave & 1;
    for (int item0 = bx; item0 < 256; item0 += gridDim.x) {
        const int item = (gridDim.x == 256) ? (item0 & 7) * 32 + (item0 >> 3) : item0;
        const int b = item >> 5, h = (item >> 3) & 3, sl = item & 7;
        f32x4 Sacc[2][4];
#pragma unroll
        for (int a = 0; a < 2; ++a)
#pragma unroll
            for (int e = 0; e < 4; ++e) Sacc[a][e] = (f32x4){0.f, 0.f, 0.f, 0.f};
        __syncthreads();
        for (int i = tid; i < 2 * 64 * 256 / 8; i += 512) ((LAS v4u*)ST0)[i] = (v4u){0u, 0u, 0u, 0u};
        v4u rq[4], rk[4], rp, rv; float re = 0.f;
#define GLS_PREFETCH(cc) do { const int item2 = (b * 64 + (cc)) * 4 + h; const unsigned char* im = img + (size_t)item2 * IMGG_BYTES; \
            _Pragma("unroll") for (int p = 0; p < 4; ++p) { rq[p] = *(const v4u*)(im + IMGG_Q + (tid + 512 * p) * 16); rk[p] = *(const v4u*)(im + IMGG_KT + (tid + 512 * p) * 16); } \
            rp = *(const v4u*)(im + IMGG_P + tid * 16); rv = *(const v4u*)(P1 + ((size_t)b * SEQ + (cc) * 64 + (tid >> 3)) * NQKV + 2048 + h * 512 + sl * 64 + (tid & 7) * 8); if (tid < 256) re = ((const float*)(im + IMGG_EB))[tid]; } while (0)
        GLS_PREFETCH(0);
        for (int c = 0; c < 64; ++c) {
            const int row0 = b * SEQ + c * 64;
            LAS bf16* STc = ST0 + (c & 1) * 64 * 256; LAS bf16* STn = ST0 + ((c + 1) & 1) * 64 * 256;
            __syncthreads();
#pragma unroll
            for (int p = 0; p < 4; ++p) { *(LAS v4u*)((LAS unsigned char*)QTs + (tid + 512 * p) * 16) = rq[p]; *(LAS v4u*)((LAS unsigned char*)KTT + (tid + 512 * p) * 16) = rk[p]; }
            *(LAS v4u*)((LAS unsigned char*)Ps + tid * 16) = rp; *(LAS v4u*)((LAS unsigned char*)VTs + off_v64(tid >> 3, tid & 7)) = rv;
            if (tid < 256) eb[tid] = re;
            __syncthreads();
            if (c + 1 < 64) GLS_PREFETCH(c + 1);
            const LAS unsigned char* vb = (const LAS unsigned char*)VTs;
            const bf16x8 pa0 = ldf<64>(Ps, 16 * tt + r16, g), pa1 = ldf<64>(Ps, 16 * tt + r16, 4 + g);
#pragma unroll
            for (int q2 = 0; q2 < 2; ++q2) { const int et = 2 * eh + q2; f32x4 acc = (f32x4){0.f, 0.f, 0.f, 0.f};
                acc = mfma16(vfrag64(vb, et, 0, lane), pa0, acc); acc = mfma16(vfrag64(vb, et, 1, lane), pa1, acc); mma_tile<256, 256, 8>(acc, STc, 16 * et, QTs, 16 * tt, lane);
                v2u w; w.x = pk2_sw(acc[0], acc[1]); w.y = pk2_sw(acc[2], acc[3]);
                *(v2u*)(hraw + (size_t)(row0 + 16 * tt + r16) * DM + h * 512 + sl * 64 + 16 * et + 4 * g) = w; }
#pragma unroll
            for (int a = 0; a < 2; ++a) { const int dt = 2 * wave + a;
                const f32x4 ev = *(const LAS f32x4*)(eb + 16 * dt + 4 * g);
                const bf16x8 ka0 = ldf<64>(KTT, 16 * dt + r16, g), ka1 = ldf<64>(KTT, 16 * dt + r16, 4 + g);
#pragma unroll
                for (int et = 0; et < 4; ++et) { Sacc[a][et] = mfma16(ka0, vfrag64(vb, et, 0, lane), Sacc[a][et]); Sacc[a][et] = mfma16(ka1, vfrag64(vb, et, 1, lane), Sacc[a][et]); Sacc[a][et] = Sacc[a][et] * ev;
                    v2u w; w.x = pk2(Sacc[a][et][0], Sacc[a][et][1]); w.y = pk2(Sacc[a][et][2], Sacc[a][et][3]);
                    *(LAS v2u*)(STn + eoff<256>(16 * et + r16, 16 * dt + 4 * g)) = w; } }
        }
#undef GLS_PREFETCH
    }
}


DI void mixer_gates(const bf16* hb, const bf16* wg, const long long* ss, float* G, int lane, int wave, int bx) {
    const int g = lane >> 4, r16 = lane & 15;
    for (int t = bx * NWAVES + wave; t < MTOK / 16; t += gridDim.x * NWAVES) {
        const bf16* ap = hb + (size_t)(16 * t + r16) * DM + 8 * g; const bf16* bp = wg + (size_t)r16 * DM + 8 * g;
        f32x4 acc = (f32x4){0.f, 0.f, 0.f, 0.f};
#pragma unroll 8
        for (int kk = 0; kk < DM / 32; ++kk) { const bf16x8 a = *(const bf16x8*)(ap + 32 * kk), b = *(const bf16x8*)(bp + 32 * kk); acc = mfma16(a, b, acc); }
#pragma unroll
        for (int i = 0; i < 4; ++i) { const int row = 16 * t + 4 * g + i; G[(size_t)row * 16 + r16] = acc[i] * pg8::rstd_of(ss, row); }
    }
}

template <int HS, int ACT> DI void headnorm_gate(const bf16* hraw, const bf16* P1, const float* gnorm, bf16* hm, int lane, int wave, int bx) {
    constexpr int NH = DM / HS, EPL = HS / 64;
    const int gw = bx * NWAVES + wave, NGW = gridDim.x * NWAVES;
    for (int row = gw; row < MTOK; row += NGW) {
#pragma unroll
        for (int hh = 0; hh < NH; ++hh) { const int col = hh * HS + lane * EPL;
            unsigned xw[EPL / 2], gwd[EPL / 2];
            if constexpr (EPL == 4) { const v2u a = *(const v2u*)(hraw + (size_t)row * DM + col), b2 = *(const v2u*)(P1 + (size_t)row * NQKV + 4096 + col); xw[0] = a.x; xw[1] = a.y; gwd[0] = b2.x; gwd[1] = b2.y; }
            else { const v4u a = *(const v4u*)(hraw + (size_t)row * DM + col), b2 = *(const v4u*)(P1 + (size_t)row * NQKV + 4096 + col); xw[0] = a.x; xw[1] = a.y; xw[2] = a.z; xw[3] = a.w; gwd[0] = b2.x; gwd[1] = b2.y; gwd[2] = b2.z; gwd[3] = b2.w; }
            float s = 0.f;
#pragma unroll
            for (int j = 0; j < EPL / 2; ++j) { const float x0 = bflo(xw[j]), x1 = bfhi(xw[j]); s += x0 * x0 + x1 * x1; }
            s = wave_sum(s); const float rs = rsqrtf(s * (1.0f / HS) + 1e-6f);
            unsigned outw[EPL / 2];
#pragma unroll
            for (int j = 0; j < EPL / 2; ++j) { const float g0 = bflo(gwd[j]), g1 = bfhi(gwd[j]);
                const float a0 = ACT == 0 ? __builtin_amdgcn_rcpf(1.0f + __expf(-g0)) : g0 * __builtin_amdgcn_rcpf(1.0f + __expf(-g0)), a1 = ACT == 0 ? __builtin_amdgcn_rcpf(1.0f + __expf(-g1)) : g1 * __builtin_amdgcn_rcpf(1.0f + __expf(-g1));
                outw[j] = pk2(bflo(xw[j]) * rs * gnorm[col + 2 * j] * a0, bfhi(xw[j]) * rs * gnorm[col + 2 * j + 1] * a1); }
            if constexpr (EPL == 4) { v2u w; w.x = outw[0]; w.y = outw[1]; *(v2u*)(hm + (size_t)row * DM + col) = w; }
            else { v4u w; w.x = outw[0]; w.y = outw[1]; w.z = outw[2]; w.w = outw[3]; *(v4u*)(hm + (size_t)row * DM + col) = w; }
        }
    }
}

DI void fox_cf(LAS unsigned char* lds, const float* G, const float* b_f, float* cf, int tid, int lane, int wave, int bx) {
    LAS float* wt = (LAS float*)lds;
    for (int item = bx; item < 256; item += gridDim.x) { const int seq = item >> 1, hf = item & 1, b = seq >> 4, h = seq & 15; const float bias = b_f[h];
        const float* gp = G + ((size_t)b * SEQ + hf * 2048 + tid * 4) * 16 + h;
        float ls[4]; float s = 0.f, s0 = 0.f;
#pragma unroll
        for (int p = 0; p < 4; ++p) { ls[p] = logsig(gp[p * 16] + bias); s += ls[p]; }
        if (hf) { const float* g0 = gp - (size_t)2048 * 16;
#pragma unroll
            for (int p = 0; p < 4; ++p) s0 += logsig(g0[p * 16] + bias); }
        const float incl = wave_incl_sum(s, lane), tot0 = wave_sum(s0);
        __syncthreads();
        if (lane == 63) wt[wave] = incl; if (lane == 0) wt[8 + wave] = tot0;
        __syncthreads();
        float base = 0.f;
#pragma unroll
        for (int w = 0; w < 8; ++w) { base += (w < wave) ? wt[w] : 0.f; base += wt[8 + w]; }
        float run = base + incl - s;
        float* o = cf + (size_t)seq * SEQ + hf * 2048 + tid * 4; f32x4 ov;
        run += ls[0]; ov.x = run; run += ls[1]; ov.y = run; run += ls[2]; ov.z = run; run += ls[3]; ov.w = run;
        *(f32x4*)o = ov;
    }
}

DI unsigned off_v(unsigned row, unsigned ch) { return 256u * row + 16u * (ch ^ (((row & 3u) << 2) | (((row >> 2) & 1u) << 1))); }

DI void fox_attn2(LAS unsigned char* lds, const bf16* P1, const float* cf, bf16* hm, int tid, int lane, int wave, int bx) {
    constexpr int BUFB = 16384 + 16384 + 256;
    const float LOG2E = 1.4426950408889634f, QS = 0.08838834764831845f * 1.4426950408889634f, THR = 8.0f;
    const int g = lane >> 4, r16 = lane & 15;
    const int G_ = gridDim.x;
    const int nit = (2048 + G_ - 1) / G_;
    for (int it = 0; it < nit; ++it) {
        const int u = (it & 1) ? it * G_ + (G_ - 1 - bx) : it * G_ + bx;
        if (u >= 2048) continue;
        const int qb = 15 - (u >> 7), bh = u & 127, b = bh >> 4, h = bh & 15;
        const size_t rowb = (size_t)b * SEQ; const int q0 = qb * 256 + 32 * wave;
        bf16x8 qf[2][4]; float c0[2];
#pragma unroll
        for (int tt = 0; tt < 2; ++tt) { const int t = q0 + 16 * tt + r16; c0[tt] = cf[(size_t)bh * SEQ + t] * LOG2E;
#pragma unroll
            for (int kk = 0; kk < 4; ++kk) { const v4u raw = *(const v4u*)(P1 + (rowb + t) * NQKV + h * 128 + 32 * kk + 8 * g); v4u sc;
#pragma unroll
                for (int j = 0; j < 4; ++j) sc[j] = pk2(bflo(raw[j]) * QS, bfhi(raw[j]) * QS);
                qf[tt][kk] = __builtin_bit_cast(bf16x8, sc); } }
        f32x4 oacc[8][2];
#pragma unroll
        for (int et = 0; et < 8; ++et) { oacc[et][0] = (f32x4){0.f, 0.f, 0.f, 0.f}; oacc[et][1] = (f32x4){0.f, 0.f, 0.f, 0.f}; }
        float lrun[2] = {0.f, 0.f};
        const int ntiles = 4 * (qb + 1);
        v4u kreg[2], vreg[2]; float cfreg = 0.f;
        const bf16* kbase = P1 + rowb * NQKV + 2048 + h * 128;
#define FOX_LOAD(j) do { _Pragma("unroll") for (int p = 0; p < 2; ++p) { const int idx = tid + 512 * p, r = idx >> 4, c8 = idx & 15; \
            kreg[p] = *(const v4u*)(kbase + (size_t)(64 * (j) + r) * NQKV + c8 * 8); vreg[p] = *(const v4u*)(kbase + (size_t)(64 * (j) + r) * NQKV + 2048 + c8 * 8); } \
            if (tid < 64) cfreg = -cf[(size_t)bh * SEQ + 64 * (j) + tid] * LOG2E; } while (0)
#define FOX_STORE(bufi) do { LAS unsigned char* bb = lds + (bufi) * BUFB; _Pragma("unroll") for (int p = 0; p < 2; ++p) { const int idx = tid + 512 * p, r = idx >> 4, c8 = idx & 15; \
            *(LAS v4u*)((LAS bf16*)bb + eoff<128>(r, c8 * 8)) = kreg[p]; *(LAS v4u*)(bb + 16384 + off_v(r, c8)) = vreg[p]; } \
            if (tid < 64) ((LAS float*)(bb + 32768))[tid] = cfreg; } while (0)
        __syncthreads();
        FOX_LOAD(0); FOX_STORE(0);
        if (ntiles > 1) FOX_LOAD(1);
        __syncthreads();
        for (int j = 0; j < ntiles; ++j) {
            if (j + 1 < ntiles) FOX_STORE((j + 1) & 1);
            if (j + 2 < ntiles) FOX_LOAD(j + 2);
            if (64 * j <= q0 + 31) {
                const LAS bf16* Ks = (const LAS bf16*)(lds + (j & 1) * BUFB); const LAS bf16* VTs = Ks + 64 * 128; const LAS float* cfs = (const LAS float*)(VTs + 128 * 64);
                f32x4 sacc[2][4];
#pragma unroll
                for (int st = 0; st < 4; ++st) { const f32x4 cv = *(const LAS f32x4*)(cfs + 16 * st + 4 * g);
#pragma unroll
                    for (int tt = 0; tt < 2; ++tt) sacc[tt][st] = cv + c0[tt]; }
#pragma unroll
                for (int st = 0; st < 4; ++st)
#pragma unroll
                    for (int kk = 0; kk < 4; ++kk) { const bf16x8 kf = ldf<128>(Ks, 16 * st + r16, 4 * kk + g);
                        sacc[0][st] = mfma16(kf, qf[0][kk], sacc[0][st]); sacc[1][st] = mfma16(kf, qf[1][kk], sacc[1][st]); if (kk == 3) asm volatile("" ::: "memory"); }
                if (64 * j + 63 > q0) {
#pragma unroll
                    for (int tt = 0; tt < 2; ++tt) { const int t = q0 + 16 * tt + r16;
#pragma unroll
                        for (int st = 0; st < 4; ++st)
#pragma unroll
                            for (int i = 0; i < 4; ++i) { const int s = 64 * j + 16 * st + 4 * g + i; if (s > t) sacc[tt][st][i] = -__builtin_inff(); } }
                }
                float mx[2];
#pragma unroll
                for (int tt = 0; tt < 2; ++tt) { float m = -__builtin_inff();
#pragma unroll
                    for (int st = 0; st < 4; ++st) m = fmaxf(m, fmaxf(fmaxf(sacc[tt][st][0], sacc[tt][st][1]), fmaxf(sacc[tt][st][2], sacc[tt][st][3])));
                    m = fmaxf(m, __shfl_xor(m, 16)); m = fmaxf(m, __shfl_xor(m, 32)); mx[tt] = m; }
                if (__any(mx[0] > THR || mx[1] > THR)) {
#pragma unroll
                    for (int tt = 0; tt < 2; ++tt) { const float sh = fmaxf(mx[tt], 0.f), f = __builtin_amdgcn_exp2f(-sh);
                        c0[tt] -= sh; lrun[tt] *= f;
#pragma unroll
                        for (int st = 0; st < 4; ++st) sacc[tt][st] = sacc[tt][st] - sh;
#pragma unroll
                        for (int et = 0; et < 8; ++et) oacc[et][tt] = oacc[et][tt] * f; }
                }
#pragma unroll
                for (int tt = 0; tt < 2; ++tt) { float ls = 0.f;
#pragma unroll
                    for (int st = 0; st < 4; ++st)
#pragma unroll
                        for (int i = 0; i < 4; ++i) { const float p = __builtin_amdgcn_exp2f(sacc[tt][st][i]); sacc[tt][st][i] = p; ls += p; }
                    lrun[tt] += ls; }
#pragma unroll
                for (int ks = 0; ks < 2; ++ks) { bf16x8 pb[2];
#pragma unroll
                    for (int tt = 0; tt < 2; ++tt) { v4u w; w.x = pk2(sacc[tt][2 * ks][0], sacc[tt][2 * ks][1]); w.y = pk2(sacc[tt][2 * ks][2], sacc[tt][2 * ks][3]);
                        w.z = pk2(sacc[tt][2 * ks + 1][0], sacc[tt][2 * ks + 1][1]); w.w = pk2(sacc[tt][2 * ks + 1][2], sacc[tt][2 * ks + 1][3]); pb[tt] = __builtin_bit_cast(bf16x8, w); }
#pragma unroll
                    for (int et = 0; et < 8; ++et) {
                        const LAS unsigned char* vb = (const LAS unsigned char*)VTs;
                        const v4i16_t lo = tr_read(vb + off_v(32 * ks + 4 * g + (r16 >> 2), 2 * et + ((lane & 3) >> 1)) + 8 * (lane & 1));
                        const v4i16_t hi = tr_read(vb + off_v(32 * ks + 16 + 4 * g + (r16 >> 2), 2 * et + ((lane & 3) >> 1)) + 8 * (lane & 1));
                        bf16x8 va; va[0] = lo[0]; va[1] = lo[1]; va[2] = lo[2]; va[3] = lo[3]; va[4] = hi[0]; va[5] = hi[1]; va[6] = hi[2]; va[7] = hi[3];
                        oacc[et][0] = mfma16(va, pb[0], oacc[et][0]); oacc[et][1] = mfma16(va, pb[1], oacc[et][1]); if (et & 1) asm volatile("" ::: "memory"); } }
            }
            __syncthreads();
        }
#undef FOX_LOAD
#undef FOX_STORE
#pragma unroll
        for (int tt = 0; tt < 2; ++tt) { float l = lrun[tt]; l += __shfl_xor(l, 16); l += __shfl_xor(l, 32); const float inv = 1.0f / l;
            bf16* orow = hm + (rowb + q0 + 16 * tt + r16) * DM + h * 128 + 4 * g;
#pragma unroll
            for (int et = 0; et < 8; ++et) { v2u w; w.x = pk2(oacc[et][tt][0] * inv, oacc[et][tt][1] * inv); w.y = pk2(oacc[et][tt][2] * inv, oacc[et][tt][3] * inv); *(v2u*)(orow + 16 * et) = w; } }
    }
}


DI void final_norm(float* out, const bf16* hb, const long long* ss, const float* gfin, int lane, int wave, int bx) {
    const int gw = bx * NWAVES + wave, NGW = gridDim.x * NWAVES;
    for (int m = gw; m < MTOK; m += NGW) { const float rs = pg8::rstd_of(ss, m);
        const v4u* hr = (const v4u*)(hb + (size_t)m * DM); f32x4* xr = (f32x4*)(out + (size_t)m * DM); const f32x4* gr = (const f32x4*)gfin;
#pragma unroll
        for (int j = 0; j < 4; ++j) { const v4u w = hr[lane + 64 * j]; const int c4 = 2 * (lane + 64 * j);
            const f32x4 g0 = gr[c4], g1 = gr[c4 + 1];
            xr[c4] = (f32x4){bflo(w.x) * rs * g0.x, bfhi(w.x) * rs * g0.y, bflo(w.y) * rs * g0.z, bfhi(w.y) * rs * g0.w};
            xr[c4 + 1] = (f32x4){bflo(w.z) * rs * g1.x, bfhi(w.z) * rs * g1.y, bflo(w.w) * rs * g1.z, bfhi(w.w) * rs * g1.w}; } }
}

#define PH(p) if (lo <= (p) && (p) < hi && (ran ? (xcd_barrier(bar), true) : (ran = true)))
#define TID() int tid = threadIdx.x; asm volatile("" : "+v"(tid)); const int lane = tid & 63, wave = __builtin_amdgcn_readfirstlane(tid >> 6); int bx = blockIdx.x; asm volatile("" : "+s"(bx)); (void)lane; (void)wave; (void)bx
#define WSP(T, off) ((T*)(ka->ws + (off)))
template <int j> DI void subblock(LAS unsigned char* lds, const XcdBarrier& bar, const int lo, const int hi, bool& ran) {
    {
        constexpr int layer = j / 3, typ = j - 3 * layer, base = 1 + 5 * j;
        if constexpr (typ != 1) {
            PH(base) { TID(); KArgs ka = kargs(); const int mi = layer * 2 + (typ >> 1);
                pg8::Gemm gm{WSP(bf16, WS_HB), WSP(bf16, WS_WUP) + (size_t)mi * NUP * DM, MTOK, NUP, DM}; pg8::StaticOrder S; S.init(MTOK, NUP, gridDim.x, bx);
                pg8::EpiSwiGLU E{WSP(bf16, WS_ACT), WSP(long long, WS_SS) + (size_t)j * MTOK, DFF};
                pg8::gemm_phase<pg8::EpiSwiGLU, pg8::StaticOrder, PG8_ALIGN, PG8_SP2>(lds, gm, S, E); }
        } else {
            constexpr int kind = layer % 3, ji = layer / 3;
            PH(base) { TID(); KArgs ka = kargs();
                mixer_gates(WSP(bf16, WS_HB), WSP(bf16, WS_WIN) + ((size_t)layer * NINP + NQKV) * DM, WSP(long long, WS_SS) + (size_t)j * MTOK, WSP(float, WS_G), lane, wave, bx);
                pg8::Gemm gm{WSP(bf16, WS_HB), WSP(bf16, WS_WIN) + (size_t)layer * NINP * DM, MTOK, NQKV, DM}; pg8::StaticOrder S; S.init(MTOK, NQKV, gridDim.x, bx);
                pg8::EpiMixIn E{WSP(bf16, WS_P1), WSP(long long, WS_SS) + (size_t)j * MTOK};
                pg8::gemm_phase<pg8::EpiMixIn, pg8::StaticOrder, PG8_ALIGN, PG8_SP2>(lds, gm, S, E); }
            PH(base + 1) { TID(); KArgs ka = kargs();
                if constexpr (kind == 0) for (int rep = 0; rep < REP_MLSTM; ++rep) mlstm_pre(lds, WSP(bf16, WS_P1), WSP(float, WS_G), ka->in[6] + ji * 16, WSP(unsigned char, WS_ACT), tid, lane, wave, bx);
                else if constexpr (kind == 1) { fox_cf(lds, WSP(float, WS_G), ka->in[10] + ji * 16, WSP(float, WS_CF), tid, lane, wave, bx); }
                else for (int rep = 0; rep < REP_GLA; ++rep) gla_pre(lds, WSP(bf16, WS_P1), WSP(float, WS_G), ka->in[13] + (size_t)ji * 16 * 1024, ka->in[14] + ji * 1024, WSP(unsigned char, WS_ACT), tid, lane, wave, bx);
            }
            PH(base + 2) { TID(); KArgs ka = kargs();
                if constexpr (kind == 0) for (int rep = 0; rep < REP_MLSTM; ++rep) mlstm_scan2(lds, WSP(bf16, WS_P1), WSP(unsigned char, WS_ACT), WSP(bf16, WS_HRAW), tid, lane, wave, bx);
                else if constexpr (kind == 1) for (int rep = 0; rep < REP_FOX; ++rep) fox_attn2(lds, WSP(bf16, WS_P1), WSP(float, WS_CF), WSP(bf16, WS_HM), tid, lane, wave, bx);
                else for (int rep = 0; rep < REP_GLA; ++rep) gla_scan2(lds, WSP(bf16, WS_P1), WSP(unsigned char, WS_ACT), WSP(bf16, WS_HRAW), tid, lane, wave, bx);
            }
            if constexpr (kind != 1) { PH(base + 3) { TID(); KArgs ka = kargs();
                if constexpr (kind == 0) headnorm_gate<256, 0>(WSP(bf16, WS_HRAW), WSP(bf16, WS_P1), ka->in[7] + ji * DM, WSP(bf16, WS_HM), lane, wave, bx);
                else headnorm_gate<512, 1>(WSP(bf16, WS_HRAW), WSP(bf16, WS_P1), ka->in[15] + ji * DM, WSP(bf16, WS_HM), lane, wave, bx);
            } }
        }
        PH(base + 4) { TID(); KArgs ka = kargs();
            pg8::Gemm gm; float scale;
            if constexpr (typ != 1) { const int mi = layer * 2 + (typ >> 1); gm = pg8::Gemm{WSP(bf16, WS_ACT), WSP(bf16, WS_WDN) + (size_t)mi * DM * DFF, MTOK, DM, DFF}; scale = 0.5f; }
            else { gm = pg8::Gemm{WSP(bf16, WS_HM), WSP(bf16, WS_WOUT) + (size_t)layer * DM * DM, MTOK, DM, DM}; scale = 1.0f; }
            pg8::StaticOrder S; S.init(MTOK, DM, gridDim.x, bx);
            pg8::EpiResid E{WSP(bf16, WS_HB), WSP(long long, WS_SS) + (size_t)(j + 1) * MTOK, scale};
            pg8::gemm_phase<pg8::EpiResid, pg8::StaticOrder, PG8_ALIGN, PG8_SP2>(lds, gm, S, E);
        }
    }
}

__global__ void __launch_bounds__(NWAVES * 64, 2) trunk_fwd(Args args) {
    extern __shared__ __attribute__((aligned(16))) unsigned char lds_raw[];
    LAS unsigned char* lds = (LAS unsigned char*)lds_raw;
    volatile LAS unsigned* MISC = (volatile LAS unsigned*)(lds + MISC_OFF);
    for (int u = threadIdx.x; u < (LDS_BYTES - MISC_OFF) / 4; u += NWAVES * 64) ((LAS unsigned*)(lds + MISC_OFF))[u] = 0u;
    __syncthreads();
    XcdBarrier bar = xcd_barrier_post((unsigned*)(args.ws + WS_CTL) + CW_BAR, MISC + 8);
    const int lo = args.ph_lo, hi = args.ph_hi; bool ran = false;

    PH(0) { TID(); for (int rep = 0; rep < REP_PRO; ++rep) { prologue(lds, lane, wave, bx); __syncthreads(); } }

    subblock<0>(lds, bar, lo, hi, ran); subblock<1>(lds, bar, lo, hi, ran); subblock<2>(lds, bar, lo, hi, ran); subblock<3>(lds, bar, lo, hi, ran);
    subblock<4>(lds, bar, lo, hi, ran); subblock<5>(lds, bar, lo, hi, ran); subblock<6>(lds, bar, lo, hi, ran); subblock<7>(lds, bar, lo, hi, ran);
    subblock<8>(lds, bar, lo, hi, ran); subblock<9>(lds, bar, lo, hi, ran); subblock<10>(lds, bar, lo, hi, ran); subblock<11>(lds, bar, lo, hi, ran);
    PH(NPHASE - 1) { TID(); KArgs ka = kargs(); final_norm(ka->out, WSP(bf16, WS_HB), WSP(long long, WS_SS) + (size_t)NSUB * MTOK, ka->in[17], lane, wave, bx); }
#undef WSP
#undef PH
}

static bool phase_exists(int p) {
    if (p == 0 || p == NPHASE - 1) return true;
    const int j = (p - 1) / 5, k = (p - 1) % 5, typ = j % 3;
    if (k == 0 || k == 4) return true;
    if (typ != 1) return false;
    if (k == 3) return ((j / 3) % 3) != 1;
    return true;
}
extern "C" void kernel_launch(void* const* d_in, const int* in_sizes, int n_in, void* d_out, int out_size, void* d_ws, size_t ws_size, hipStream_t stream) {
    static int grid = 0;
    if (grid == 0) {
        if (n_in != 18 || in_sizes[0] != MTOK * DM || out_size != MTOK * DM || ws_size < WS_END) { fprintf(stderr, "kernel_launch: unexpected shapes (n_in %d, in0 %d, out %d, ws %zu < %zu)\n", n_in, n_in > 0 ? in_sizes[0] : -1, out_size, ws_size, (size_t)WS_END); grid = -1; return; }
        int dev = 0, cus = 0, per_cu = 0;
        if (hipGetDevice(&dev) != hipSuccess || hipDeviceGetAttribute(&cus, hipDeviceAttributeMultiprocessorCount, dev) != hipSuccess) { grid = -1; return; }
        if (hipFuncSetAttribute((const void*)trunk_fwd, hipFuncAttributeMaxDynamicSharedMemorySize, LDS_BYTES) != hipSuccess) { fprintf(stderr, "kernel_launch: hipFuncSetAttribute failed\n"); grid = -1; return; }
        if (hipOccupancyMaxActiveBlocksPerMultiprocessor(&per_cu, (const void*)trunk_fwd, NWAVES * 64, LDS_BYTES) != hipSuccess || per_cu < 1) fprintf(stderr, "kernel_launch: occupancy query says %d\n", per_cu);
        (void)hipGetLastError();
        grid = cus;
    }
    if (grid < 0) return;
    if (hipMemsetAsync((char*)d_ws + WS_CTL, 0, CTL_ZERO_BYTES, stream) != hipSuccess) return;
    Args a{};
    for (int i = 0; i < 18; ++i) a.in[i] = (const float*)d_in[i];
    a.out = (float*)d_out; a.ws = (unsigned char*)d_ws;
#if MK_PER_PHASE
    for (int p = 0; p < NPHASE; ++p) { if (!phase_exists(p)) continue; a.ph_lo = p; a.ph_hi = p + 1; hipLaunchKernelGGL(trunk_fwd, dim3(grid), dim3(NWAVES * 64), LDS_BYTES, stream, a); }
#else
    a.ph_lo = 0; a.ph_hi = NPHASE; hipLaunchKernelGGL(trunk_fwd, dim3(grid), dim3(NWAVES * 64), LDS_BYTES, stream, a);
#endif
    (void)phase_exists;
}
```

```cpp
#include <hip/hip_runtime.h>
#include <cstdio>
#include <cstdint>
namespace pg8 {
#define PG8_LAS __attribute__((address_space(3)))
typedef unsigned short bf16_t;
typedef short bf16x8 __attribute__((ext_vector_type(8)));
typedef float f32x4 __attribute__((ext_vector_type(4)));
typedef unsigned u32x4 __attribute__((ext_vector_type(4)));
constexpr int BM = 256, BK = 64, HALF = 128, HTB = HALF * BK * 2  , STAGE_BYTES = 8 * HTB, NXCD = 8, WGM = 8;

__host__ __device__ __forceinline__ int lds_byte(int r, int c) { const int st = (r >> 4) * 2 + (c >> 5), rr = r & 15, cc = c & 31, ob = rr * 64 + cc * 2; return st * 1024 + (ob ^ (((ob >> 9) & 1) << 5)); }
__host__ __device__ __forceinline__ void stage_rc(int b, int& R, int& C) { const int st = b / 1024, sb = b % 1024, swz = sb ^ (((sb >> 9) & 1) << 5); R = (st >> 1) * 16 + swz / 64; C = (st & 1) * 32 + (swz % 64) / 2; }
__host__ __device__ __forceinline__ int perm32(int rho) { const int n = rho >> 4, i = rho & 15; return 8 * (i >> 2) + 4 * n + (i & 3); }

struct Unit { int pm, pn; };
struct Gemm { const bf16_t* A; const bf16_t* Bt; int M, N, K; };

struct StaticOrder {
    int nM, nN, nwg, G, c;
    __host__ __device__ void init(int M, int N, int G_, int c_) { nM = M / BM; nN = N / BM; nwg = nM * nN; G = G_; c = c_; }
    __host__ __device__ bool next(int i, Unit& u) const {
        const long L = (long)i * G + c; if (L >= nwg) return false;
        int wgid = (int)L; { const int q = nwg / NXCD, r = nwg % NXCD, xcd = wgid % NXCD, off = wgid / NXCD; wgid = (xcd < r ? xcd * (q + 1) : r * (q + 1) + (xcd - r) * q) + off; }
        const int nig = WGM * nN, gid = wgid / nig, fm = gid * WGM, gsz = (nM - fm) < WGM ? (nM - fm) : WGM;
        u.pm = fm + ((wgid % nig) % gsz); u.pn = (wgid % nig) / gsz; return true;
    }
    __device__ __forceinline__ void a_ready(const Unit&) const {}
    __device__ __forceinline__ void done(const Unit&) const {}
};

__device__ __forceinline__ unsigned cvt_pk_bf16(float lo, float hi) { unsigned r; asm volatile("v_cvt_pk_bf16_f32 %0, %1, %2" : "=v"(r) : "v"(lo), "v"(hi)); return r; }
constexpr float RMS_EPS_F = 1e-6f, SS_FIX = 1048576.0f, SS_UNFIX_D = 1.0f / (1048576.0f * 2048.0f);
typedef long long ss_t;
__device__ __forceinline__ float rstd_of(const ss_t* ss, int row) { return rsqrtf((float)ss[row] * SS_UNFIX_D + RMS_EPS_F); }
template <class Sched> __device__ __forceinline__ int rstd_table_fill(const Sched& S, const ss_t* ss, PG8_LAS unsigned char* ext, int tid) {
    PG8_LAS float* tab = (PG8_LAS float*)ext; int key0 = -1, key1 = -1, bad = 0; Unit u;
    for (int i = 0; S.next(i, u); ++i) { const int slot = (u.pm >> 3) & 1; const int key = slot ? key1 : key0;
        if (key == u.pm) continue;
        if (key >= 0) { bad = 1; continue; }
        if (slot) key1 = u.pm; else key0 = u.pm;
        if (tid < 256) tab[slot * 256 + tid] = rstd_of(ss, u.pm * BM + tid); }
    asm volatile("s_waitcnt lgkmcnt(0)" ::: "memory"); __builtin_amdgcn_s_barrier(); asm volatile("" ::: "memory");
    return bad;
}
__device__ __forceinline__ float rstd_get(const ss_t* ss, const Unit& u, int row, int pf, const PG8_LAS unsigned char* ext) {
    return pf ? rstd_of(ss, row) : ((const PG8_LAS float*)ext)[((u.pm >> 3) & 1) * 256 + (row - u.pm * BM)];
}
struct EpiSwiGLU {
    static constexpr bool PERM = true, AFTER_DRAIN = false;
    bf16_t* O; const ss_t* ss; int ldo;
    template <class Sched> __device__ __forceinline__ int prepare(const Sched& S, PG8_LAS unsigned char* ext, int tid) const { return rstd_table_fill(S, ss, ext, tid); }
    __device__ __forceinline__ void operator()(const f32x4 (&acc)[2][2][4][2], const Unit& u, int wr, int wc, int fr, int fq, int pf, const PG8_LAS unsigned char* ext) const {
        const int row0 = u.pm * BM + wr * 64 + fr, col0 = u.pn * HALF + wc * 32 + 8 * fq;
#pragma unroll
        for (int ai = 0; ai < 2; ++ai)
#pragma unroll
            for (int m = 0; m < 4; ++m) {
                const int row = row0 + ai * HALF + m * 16;
                const float rs = rstd_get(ss, u, row, pf, ext), c1 = -1.4426950408889634f * rs, rs2 = rs * rs;
                float o[8];
#pragma unroll
                for (int n = 0; n < 2; ++n) { const f32x4 p4 = acc[ai][0][m][n] * acc[ai][1][m][n] * rs2;
#pragma unroll
                    for (int j = 0; j < 4; ++j) o[4 * n + j] = p4[j] * __builtin_amdgcn_rcpf(1.0f + __builtin_amdgcn_exp2f(acc[ai][0][m][n][j] * c1)); }
                u32x4 w; w.x = cvt_pk_bf16(o[0], o[1]); w.y = cvt_pk_bf16(o[2], o[3]); w.z = cvt_pk_bf16(o[4], o[5]); w.w = cvt_pk_bf16(o[6], o[7]);
                *(u32x4*)(O + (size_t)row * ldo + col0) = w;
            }
    }
};
struct EpiMixIn {
    static constexpr bool PERM = true, AFTER_DRAIN = false;
    bf16_t* O; const ss_t* ss;
    template <class Sched> __device__ __forceinline__ int prepare(const Sched& S, PG8_LAS unsigned char* ext, int tid) const { return rstd_table_fill(S, ss, ext, tid); }
    __device__ __forceinline__ void operator()(const f32x4 (&acc)[2][2][4][2], const Unit& u, int wr, int wc, int fr, int fq, int pf, const PG8_LAS unsigned char* ext) const {
        const int row0 = u.pm * BM + wr * 64 + fr, col0 = u.pn * BM + wc * 32 + 8 * fq;
#pragma unroll
        for (int ai = 0; ai < 2; ++ai)
#pragma unroll
            for (int m = 0; m < 4; ++m) {
                const int row = row0 + ai * HALF + m * 16;
                const float rs = rstd_get(ss, u, row, pf, ext);
#pragma unroll
                for (int bj = 0; bj < 2; ++bj) { const f32x4 v0 = acc[ai][bj][m][0] * rs, v1 = acc[ai][bj][m][1] * rs;
                    u32x4 w; w.x = cvt_pk_bf16(v0[0], v0[1]); w.y = cvt_pk_bf16(v0[2], v0[3]); w.z = cvt_pk_bf16(v1[0], v1[1]); w.w = cvt_pk_bf16(v1[2], v1[3]);
                    *(u32x4*)(O + (size_t)row * 6144 + col0 + bj * HALF) = w; }
            }
    }
};
struct EpiResid {
    static constexpr bool PERM = true, AFTER_DRAIN = false;
    bf16_t* hb; ss_t* ssn; float scale;
    template <class Sched> __device__ __forceinline__ int prepare(const Sched&, PG8_LAS unsigned char*, int) const { return 0; }
    __device__ __forceinline__ void operator()(const f32x4 (&acc)[2][2][4][2], const Unit& u, int wr, int wc, int fr, int fq, int pf, const PG8_LAS unsigned char* ext) const {
        const int row0 = u.pm * BM + wr * 64 + fr, col0 = u.pn * BM + wc * 32 + 8 * fq;
        u32x4 rb[3][2];
#define PG8_LDG(gi, buf) do { const size_t off_ = (size_t)(row0 + ((gi) >> 2) * HALF + ((gi) & 3) * 16) * 2048 + col0; \
            _Pragma("unroll") for (int q_ = 0; q_ < 2; ++q_) buf[q_] = *(const u32x4*)(hb + off_ + q_ * HALF); } while (0)
        PG8_LDG(0, rb[0]); PG8_LDG(1, rb[1]);
#pragma unroll
        for (int gi = 0; gi < 8; ++gi) {
            if (gi + 2 < 8) PG8_LDG(gi + 2, rb[(gi + 2) % 3]);
            const int ai = gi >> 2, m = gi & 3;
            const int row = row0 + ai * HALF + m * 16; const size_t off = (size_t)row * 2048 + col0; float sq = 0.f;
#pragma unroll
            for (int bj = 0; bj < 2; ++bj) { const u32x4 hw = rb[gi % 3][bj];
                const f32x4 h0 = (f32x4){__uint_as_float(hw.x << 16), __uint_as_float(hw.x & 0xffff0000u), __uint_as_float(hw.y << 16), __uint_as_float(hw.y & 0xffff0000u)};
                const f32x4 h1 = (f32x4){__uint_as_float(hw.z << 16), __uint_as_float(hw.z & 0xffff0000u), __uint_as_float(hw.w << 16), __uint_as_float(hw.w & 0xffff0000u)};
                const f32x4 n0 = h0 + acc[ai][bj][m][0] * scale, n1 = h1 + acc[ai][bj][m][1] * scale;
                u32x4 w; w.x = cvt_pk_bf16(n0[0], n0[1]); w.y = cvt_pk_bf16(n0[2], n0[3]); w.z = cvt_pk_bf16(n1[0], n1[1]); w.w = cvt_pk_bf16(n1[2], n1[3]);
                *(u32x4*)(hb + off + bj * HALF) = w;
                const float r0 = __uint_as_float(w.x << 16), r1 = __uint_as_float(w.x & 0xffff0000u), r2 = __uint_as_float(w.y << 16), r3 = __uint_as_float(w.y & 0xffff0000u);
                const float r4 = __uint_as_float(w.z << 16), r5 = __uint_as_float(w.z & 0xffff0000u), r6 = __uint_as_float(w.w << 16), r7 = __uint_as_float(w.w & 0xffff0000u);
                sq += ((r0 * r0 + r1 * r1) + (r2 * r2 + r3 * r3)) + ((r4 * r4 + r5 * r5) + (r6 * r6 + r7 * r7)); }
            sq += __shfl_xor(sq, 16); sq += __shfl_xor(sq, 32);
            if (fq == 0) atomicAdd((unsigned long long*)(ssn + row), (unsigned long long)__float2ll_rn(sq * SS_FIX));
        }
#undef PG8_LDG
    }
};

template <class Epi, class Sched, bool ALIGN_EPI = false, bool SP2 = false>
__device__ __forceinline__ void gemm_phase(PG8_LAS unsigned char* lds, const Gemm g, const Sched& S, const Epi& E) {
    int tid_ = threadIdx.x; asm volatile("" : "+v"(tid_));
    const int tid = tid_, wid = __builtin_amdgcn_readfirstlane(tid >> 6), lane = tid & 63, wr = wid >> 2, wc = wid & 3, fr = lane & 15, fq = lane >> 4;
    const int K = g.K, nt = K / BK;
    unsigned voffA[2], voffB[2];
#pragma unroll
    for (int i = 0; i < 2; ++i) { int R, C; stage_rc(tid * 16 + i * 8192, R, C); const int Rb = Epi::PERM ? ((R & ~31) + perm32(R & 31)) : R;
        voffA[i] = (unsigned)(R * K + C) * 2u; voffB[i] = (unsigned)(Rb * K + C) * 2u; }
    const size_t kstep = (size_t)(BK * 2);
    const size_t hstep = (size_t)HALF * K * 2;
    const size_t tstep = 2 * hstep;
    const unsigned ldsw = (unsigned)wid * 1024u;
    const int aoff = lds_byte(wr * 64 + fr, fq * 8), boff = lds_byte(wc * 32 + fr, fq * 8);
#define PG8_SA(b, h) (((b) * 2 + (h)) * HTB)
#define PG8_SB(b, h) ((4 + (b) * 2 + (h)) * HTB)
#define PG8_STAGE(bufoff, gbase, voff) do { _Pragma("unroll") for (int _i = 0; _i < 2; ++_i) \
        __builtin_amdgcn_global_load_lds((const unsigned*)((const char*)(gbase) + (voff)[_i]), (PG8_LAS unsigned*)(lds + (bufoff) + ldsw + _i * 8192), 16, 0, 0); } while (0)
#define PG8_LDA(dst, b, h) do { _Pragma("unroll") for (int m = 0; m < 4; ++m) _Pragma("unroll") for (int k = 0; k < 2; ++k) dst[m][k] = *(const PG8_LAS bf16x8*)(lds + PG8_SA(b, h) + aoff + m * 2048 + k * 1024); } while (0)
#define PG8_LDB(dst, b, h) do { _Pragma("unroll") for (int n = 0; n < 2; ++n) _Pragma("unroll") for (int k = 0; k < 2; ++k) dst[n][k] = *(const PG8_LAS bf16x8*)(lds + PG8_SB(b, h) + boff + n * 2048 + k * 1024); } while (0)
#define PG8_MMA(ai, bj, At, Bt) do { __builtin_amdgcn_s_setprio(1); _Pragma("unroll") for (int m = 0; m < 4; ++m) _Pragma("unroll") for (int n = 0; n < 2; ++n) _Pragma("unroll") for (int k = 0; k < 2; ++k) \
        acc[ai][bj][m][n] = __builtin_amdgcn_mfma_f32_16x16x32_bf16(Bt[n][k], At[m][k], acc[ai][bj][m][n], 0, 0, 0); __builtin_amdgcn_s_setprio(0); } while (0)
#define PG8_WAIT_V(n) asm volatile("s_waitcnt vmcnt(" #n ")" ::: "memory")
#define PG8_WAIT_L(n) asm volatile("s_waitcnt lgkmcnt(" #n ")" ::: "memory")
#define PG8_BAR __builtin_amdgcn_s_barrier()
#define PG8_SCHED __builtin_amdgcn_sched_barrier(0)
    const int pf = E.prepare(S, lds + STAGE_BYTES, tid);
    Unit cur, nxt; int ui = 0;
    if (!S.next(0, cur)) return;
    f32x4 acc[2][2][4][2];
#pragma unroll
    for (int a = 0; a < 2; ++a)
#pragma unroll
        for (int b = 0; b < 2; ++b)
#pragma unroll
            for (int m = 0; m < 4; ++m)
#pragma unroll
                for (int n = 0; n < 2; ++n) acc[a][b][m][n] = (f32x4){0.f, 0.f, 0.f, 0.f};
    bf16x8 At[4][2], B0[2][2], B1[2][2];
    const char* cA = (const char*)g.A + (size_t)cur.pm * tstep; const char* cB = (const char*)g.Bt + (size_t)cur.pn * tstep;
    S.a_ready(cur);
    if constexpr (SP2) {
        PG8_STAGE(PG8_SB(0, 0), cB, voffB); PG8_STAGE(PG8_SB(0, 1), cB + hstep, voffB); PG8_STAGE(PG8_SA(0, 0), cA, voffA); PG8_STAGE(PG8_SA(0, 1), cA + hstep, voffA);
        if (wr == 1) PG8_BAR;
        PG8_WAIT_V(2); PG8_BAR;
        PG8_STAGE(PG8_SB(1, 0), cB + kstep, voffB); PG8_STAGE(PG8_SA(1, 0), cA + kstep, voffA); PG8_STAGE(PG8_SB(1, 1), cB + hstep + kstep, voffB);
        PG8_WAIT_V(6); PG8_BAR;
    } else {
        PG8_STAGE(PG8_SB(0, 0), cB, voffB); PG8_STAGE(PG8_SA(0, 0), cA, voffA); PG8_STAGE(PG8_SB(0, 1), cB + hstep, voffB); PG8_STAGE(PG8_SA(0, 1), cA + hstep, voffA);
        if (wr == 1) PG8_BAR;
        PG8_WAIT_V(4); PG8_BAR;
        PG8_STAGE(PG8_SB(1, 0), cB + kstep, voffB); PG8_STAGE(PG8_SA(1, 0), cA + kstep, voffA); PG8_STAGE(PG8_SB(1, 1), cB + hstep + kstep, voffB);
        PG8_WAIT_V(6); PG8_BAR;
    }
    for (;;) {
        const bool has_next = S.next(ui + 1, nxt);
        const char* nA = has_next ? (const char*)g.A + (size_t)nxt.pm * tstep : cA; const char* nB = has_next ? (const char*)g.Bt + (size_t)nxt.pn * tstep : cB;
        for (int t = 0; t < nt; t += 2) {
            const bool last = (t == nt - 2);
            const char* a1 = cA + (size_t)(t + 1) * kstep;
            const char* a2 = last ? nA : cA + (size_t)(t + 2) * kstep; const char* b2 = last ? nB : cB + (size_t)(t + 2) * kstep;
            const char* a3 = a2 + kstep; const char* b3 = b2 + kstep;
            if (last && has_next) S.a_ready(nxt);
            if constexpr (SP2) {
            PG8_LDB(B0, 0, 0); PG8_LDB(B1, 0, 1); PG8_SCHED; PG8_LDA(At, 0, 0); PG8_STAGE(PG8_SA(1, 1), a1 + hstep, voffA);
            PG8_WAIT_V(8); PG8_WAIT_L(0); PG8_BAR; PG8_MMA(0, 0, At, B0); PG8_MMA(0, 1, At, B1); PG8_BAR; PG8_SCHED;
            PG8_LDA(At, 0, 1); PG8_STAGE(PG8_SB(0, 0), b2, voffB); PG8_STAGE(PG8_SB(0, 1), b2 + hstep, voffB); PG8_STAGE(PG8_SA(0, 0), a2, voffA);
            PG8_WAIT_V(8); PG8_WAIT_L(0); PG8_BAR; PG8_MMA(1, 0, At, B0); PG8_MMA(1, 1, At, B1); PG8_BAR; PG8_SCHED;
            PG8_LDB(B0, 1, 0); PG8_LDB(B1, 1, 1); PG8_SCHED; PG8_LDA(At, 1, 0); PG8_STAGE(PG8_SA(0, 1), a2 + hstep, voffA);
            PG8_WAIT_V(8); PG8_WAIT_L(0); PG8_BAR; PG8_MMA(0, 0, At, B0); PG8_MMA(0, 1, At, B1); PG8_BAR; PG8_SCHED;
            PG8_LDA(At, 1, 1); PG8_STAGE(PG8_SB(1, 0), b3, voffB); PG8_STAGE(PG8_SB(1, 1), b3 + hstep, voffB); PG8_STAGE(PG8_SA(1, 0), a3, voffA);
            PG8_WAIT_V(8); PG8_WAIT_L(0); PG8_BAR; PG8_MMA(1, 0, At, B0); PG8_MMA(1, 1, At, B1); PG8_BAR; PG8_SCHED;
            } else {
            PG8_LDB(B0, 0, 0); PG8_SCHED; PG8_LDA(At, 0, 0); PG8_STAGE(PG8_SA(1, 1), a1 + hstep, voffA);
            PG8_WAIT_L(8); PG8_BAR; PG8_WAIT_L(0); PG8_MMA(0, 0, At, B0); PG8_BAR; PG8_SCHED;
            PG8_LDB(B1, 0, 1); PG8_STAGE(PG8_SB(0, 0), b2, voffB);
            PG8_BAR; PG8_WAIT_L(0); PG8_MMA(0, 1, At, B1); PG8_BAR;
            PG8_LDA(At, 0, 1); PG8_STAGE(PG8_SA(0, 0), a2, voffA);
            PG8_BAR; PG8_WAIT_L(0); PG8_MMA(1, 0, At, B0); PG8_BAR; PG8_SCHED;
            PG8_STAGE(PG8_SB(0, 1), b2 + hstep, voffB);
            PG8_WAIT_V(6); PG8_BAR; PG8_MMA(1, 1, At, B1); PG8_BAR;
            PG8_LDB(B0, 1, 0); PG8_SCHED; PG8_LDA(At, 1, 0); PG8_STAGE(PG8_SA(0, 1), a2 + hstep, voffA);
            PG8_WAIT_L(8); PG8_BAR; PG8_WAIT_L(0); PG8_MMA(0, 0, At, B0); PG8_BAR; PG8_SCHED;
            PG8_LDB(B1, 1, 1); PG8_STAGE(PG8_SB(1, 0), b3, voffB);
            PG8_BAR; PG8_WAIT_L(0); PG8_MMA(0, 1, At, B1); PG8_BAR;
            PG8_LDA(At, 1, 1); PG8_STAGE(PG8_SA(1, 0), a3, voffA);
            PG8_BAR; PG8_WAIT_L(0); PG8_MMA(1, 0, At, B0); PG8_BAR; PG8_SCHED;
            PG8_STAGE(PG8_SB(1, 1), b3 + hstep, voffB);
            PG8_WAIT_V(6); PG8_BAR; PG8_MMA(1, 1, At, B1); PG8_BAR;
            }
        }
        if constexpr (ALIGN_EPI) { if (wr == 0) PG8_BAR; }
        if constexpr (!Epi::AFTER_DRAIN) { E(acc, cur, wr, wc, fr, fq, pf, lds + STAGE_BYTES); S.done(cur); }
        if (!has_next) break;
#pragma unroll
        for (int a = 0; a < 2; ++a)
#pragma unroll
            for (int b = 0; b < 2; ++b)
#pragma unroll
                for (int m = 0; m < 4; ++m)
#pragma unroll
                    for (int n = 0; n < 2; ++n) acc[a][b][m][n] = (f32x4){0.f, 0.f, 0.f, 0.f};
        cur = nxt; cA = nA; cB = nB; ++ui;
        if constexpr (ALIGN_EPI) { if (wr == 1) PG8_BAR; }
    }
    PG8_WAIT_V(0);
    if constexpr (!ALIGN_EPI) { if (wr == 0) PG8_BAR; }
    PG8_BAR;
    if constexpr (Epi::AFTER_DRAIN) { E.fused(acc, cur, wr, wc, fr, fq, lds, wid, lane); S.done(cur); }
#undef PG8_SA
#undef PG8_SB
#undef PG8_STAGE
#undef PG8_LDA
#undef PG8_LDB
#undef PG8_MMA
#undef PG8_WAIT_V
#undef PG8_WAIT_L
#undef PG8_BAR
#undef PG8_SCHED
}
}

#ifndef PG8_SP2
#define PG8_SP2 true
#endif
#ifndef PG8_ALIGN
#define PG8_ALIGN true
#endif
#ifndef REP_PRO
#define REP_PRO 1
#endif
#ifndef REP_MLSTM
#define REP_MLSTM 1
#endif
#ifndef REP_FOX
#define REP_FOX 1
#endif
#ifndef REP_GLA
#define REP_GLA 1
#endif
#ifndef MK_PER_PHASE
#define MK_PER_PHASE 0
#endif

constexpr int DM = 2048, BATCH = 8, SEQ = 4096, MTOK = BATCH * SEQ, DEPTH = 4, DFF = 5632, NUP = 2 * DFF, NIN = 6160, NINP = 6400, NQKV = 6144;
constexpr int NWAVES = 8;
constexpr int NSUB = 3 * DEPTH;
constexpr int NPHASE = 2 + 5 * NSUB;

constexpr size_t MiB = 1u << 20;
constexpr size_t WS_CTL = 0, CTL_ZERO_BYTES = 5 * MiB;
constexpr size_t WS_SS = 1 * MiB;
constexpr size_t WS_WUP = 8 * MiB;
constexpr size_t WS_WDN = WS_WUP + 352 * MiB;
constexpr size_t WS_WIN = WS_WDN + 176 * MiB;
constexpr size_t WS_WOUT = WS_WIN + 100 * MiB;
constexpr size_t WS_HB = WS_WOUT + 32 * MiB;
constexpr size_t WS_ACT = WS_HB + 128 * MiB;
constexpr size_t WS_P1 = WS_ACT + 352 * MiB;
constexpr size_t WS_G = WS_P1 + 384 * MiB;
constexpr size_t WS_HRAW = WS_G + 2 * MiB;
constexpr size_t WS_HM = WS_HRAW + 256 * MiB;
constexpr size_t WS_CF = WS_HM + 128 * MiB;
constexpr size_t WS_END = WS_CF + 2 * MiB;
static_assert((size_t)8 * NUP * DM * 2 == 352 * MiB && (size_t)8 * DM * DFF * 2 == 176 * MiB && (size_t)4 * NINP * DM * 2 == 100 * MiB, "weight regions");
static_assert((size_t)MTOK * DFF * 2 == 352 * MiB && (size_t)MTOK * NQKV * 2 == 384 * MiB && WS_SS + 13 * (size_t)MTOK * 8 <= CTL_ZERO_BYTES, "activation regions");
constexpr int CW_BAR = 4096;

constexpr int LDS_BYTES = 153600, MISC_OFF = 152576;

#define GAS __attribute__((address_space(1)))
#define LAS __attribute__((address_space(3)))
#define DI __device__ __forceinline__
typedef unsigned short bf16;
typedef unsigned v4u __attribute__((ext_vector_type(4)));
typedef unsigned v2u __attribute__((ext_vector_type(2)));
typedef float f32x4 __attribute__((ext_vector_type(4)));
typedef short bf16x8 __attribute__((ext_vector_type(8)));
typedef GAS unsigned gu32;
#define RLX_AGENT __ATOMIC_RELAXED, __HIP_MEMORY_SCOPE_AGENT
#define LDS_WAIT() asm volatile("s_waitcnt lgkmcnt(0)" ::: "memory")
DI unsigned f2bf(float f) { unsigned r; asm("v_cvt_pk_bf16_f32 %0, %1, %1" : "=v"(r) : "v"(f)); return r & 0xffffu; }
DI unsigned pk2(float lo, float hi) { unsigned r; asm("v_cvt_pk_bf16_f32 %0, %1, %2" : "=v"(r) : "v"(lo), "v"(hi)); return r; }
DI float bf2f(unsigned short v) { return __builtin_bit_cast(float, (unsigned)v << 16); }
DI float bflo(unsigned w) { return __builtin_bit_cast(float, w << 16); }
DI float bfhi(unsigned w) { return __builtin_bit_cast(float, w & 0xffff0000u); }
DI float logsig(float x) { return fminf(x, 0.f) - log1pf(expf(-fabsf(x))); }

#define XB_TMO      128
#define XB_XCNT(j)  (256  + 64 * (j))
#define XB_XSUB(j)  (1280 + 64 * (j))
#define XB_XGEN(j)  (2304 + 64 * (j))
#define XB_TOP      3328
#define XB_TOPGEN   3392
#define XCD_BAR_WORDS 3456
#define XB_SPIN_CAP (1u << 18)

__device__ __forceinline__ unsigned xb_ld(unsigned* p)              { return __hip_atomic_load(p, __ATOMIC_RELAXED, __HIP_MEMORY_SCOPE_AGENT); }
__device__ __forceinline__ unsigned xb_add(unsigned* p, unsigned v) { return __hip_atomic_fetch_add(p, v, __ATOMIC_RELAXED, __HIP_MEMORY_SCOPE_AGENT); }
__device__ __forceinline__ unsigned xb_xcc_id() { return (unsigned)__builtin_amdgcn_s_getreg((3 << 11) | 20) & 0xFu; }
#define XB_SPIN(cond, bar) do { unsigned _sp = 0; while (cond) { __builtin_amdgcn_s_sleep(1); \
    if ((++_sp & 255u) == 0u) { if (xb_ld(&(bar)[XB_TMO])) break; if (_sp > XB_SPIN_CAP) { atomicAdd(&(bar)[XB_TMO], 1u); break; } } } } while (0)

struct XcdBarrier {
    unsigned* bar; unsigned x;
    volatile LAS unsigned* st;
};

__device__ __forceinline__ XcdBarrier xcd_barrier_post(unsigned* bar, volatile LAS unsigned* st) {
    XcdBarrier b; b.bar = bar; b.x = xb_xcc_id(); b.st = st;
    if (threadIdx.x == 0) (void)xb_add(&bar[XB_XCNT(b.x)], 1u);
    return b;
}
__device__ __forceinline__ void xcd_barrier_complete(unsigned* bar, unsigned x, unsigned& nloc, unsigned& nx) {
    const unsigned G = gridDim.x * gridDim.y * gridDim.z;
    unsigned sum, cnt, mine, sp = 0u;
    for (;;) {
        sum = 0u; cnt = 0u; mine = 0u;
#pragma unroll
        for (unsigned j = 0; j < 16; ++j) { const unsigned c = xb_ld(&bar[XB_XCNT(j)]); sum += c; cnt += (c > 0u) ? 1u : 0u; mine = (j == x) ? c : mine; }
        if (sum == G) break;
        __builtin_amdgcn_s_sleep(1);
        if ((++sp & 255u) == 0u) { if (xb_ld(&bar[XB_TMO])) break; if (sp > XB_SPIN_CAP) { atomicAdd(&bar[XB_TMO], 1u); break; } }
    }
    nloc = mine > 0u ? mine : 1u; nx = cnt > 0u ? cnt : 1u;
}

__device__ __forceinline__ void xcd_barrier(const XcdBarrier& b) {
    asm volatile("s_waitcnt vmcnt(0)" ::: "memory");
    __syncthreads();
    if (threadIdx.x == 0) {
        unsigned* bar = b.bar;
        __builtin_amdgcn_s_waitcnt(0);
        unsigned nloc = b.st[0], nx = b.st[1];
        if (nloc == 0u) { xcd_barrier_complete(bar, b.x, nloc, nx); b.st[0] = nloc; b.st[1] = nx; }
        const unsigned old = xb_add(&bar[XB_XSUB(b.x)], 1u);
        const unsigned gen = old / nloc;
        if (old + 1u == (gen + 1u) * nloc) {
            __builtin_amdgcn_fence(__ATOMIC_RELEASE, "agent");
            asm volatile("s_waitcnt vmcnt(0)" ::: "memory");
            const unsigned og = xb_add(&bar[XB_TOP], 1u);
            const unsigned tg = og / nx;
            if (og + 1u == (tg + 1u) * nx) xb_add(&bar[XB_TOPGEN], 1u);
            else XB_SPIN(xb_ld(&bar[XB_TOPGEN]) == tg, bar);
            __builtin_amdgcn_fence(__ATOMIC_ACQUIRE, "agent");
            xb_add(&bar[XB_XGEN(b.x)], 1u);
            asm volatile("s_waitcnt vmcnt(0)" ::: "memory");
        } else {
            XB_SPIN(xb_ld(&bar[XB_XGEN(b.x)]) == gen, bar);
            __builtin_amdgcn_fence(__ATOMIC_ACQUIRE, "agent");
            asm volatile("s_waitcnt vmcnt(0)" ::: "memory");
        }
    }
    __syncthreads();
}


DI float wave_sum(float v) {
#pragma unroll
    for (int o = 1; o < 64; o <<= 1) v += __shfl_xor(v, o);
    return v;
}
DI float wave_max(float v) {
#pragma unroll
    for (int o = 1; o < 64; o <<= 1) v = fmaxf(v, __shfl_xor(v, o));
    return v;
}
DI float wave_incl_sum(float v, int lane) {
#pragma unroll
    for (int o = 1; o < 64; o <<= 1) { const float t = __shfl_up(v, o); if (lane >= o) v += t; }
    return v;
}
DI float wave_incl_max(float v, int lane) {
#pragma unroll
    for (int o = 1; o < 64; o <<= 1) { const float t = __shfl_up(v, o); if (lane >= o) v = fmaxf(v, t); }
    return v;
}

template <int L> DI int swx(int r) { return L == 64 ? ((r >> 1) & 7) : (r & 15); }
template <int L> DI int eoff(int r, int c) { return r * L + ((((c >> 3) ^ swx<L>(r)) << 3) | (c & 7)); }
template <int L> DI bf16x8 ldf(const LAS bf16* base, int r, int ch) { return *(const LAS bf16x8*)(base + r * L + ((ch ^ swx<L>(r)) << 3)); }
DI f32x4 mfma16(bf16x8 a, bf16x8 b, f32x4 c) { return __builtin_amdgcn_mfma_f32_16x16x32_bf16(a, b, c, 0, 0, 0); }
typedef short v4i16_t __attribute__((ext_vector_type(4)));
DI v4i16_t tr_read(const LAS unsigned char* p) { return __builtin_amdgcn_ds_read_tr16_b64_v4i16((LAS v4i16_t*)p); }
DI bf16x8 cat4(v4i16_t lo, v4i16_t hi) { bf16x8 r; r[0] = lo[0]; r[1] = lo[1]; r[2] = lo[2]; r[3] = lo[3]; r[4] = hi[0]; r[5] = hi[1]; r[6] = hi[2]; r[7] = hi[3]; return r; }
DI unsigned off_v64(unsigned row, unsigned ch) { return 128u * row + 16u * (ch ^ ((((row >> 1) & 1u) << 1) | (((row >> 3) & 1u) << 2))); }
DI bf16x8 vfrag64(const LAS unsigned char* vb, int c, int ks, int lane) { const unsigned g = lane >> 4, q = (lane & 15) >> 2, p = lane & 3;
    return cat4(tr_read(vb + off_v64(32 * ks + 8 * g + q, 2 * c + (p >> 1)) + 8 * (p & 1)), tr_read(vb + off_v64(32 * ks + 8 * g + 4 + q, 2 * c + (p >> 1)) + 8 * (p & 1))); }
template <int LA, int LB, int NK> DI void mma_tile(f32x4& acc, const LAS bf16* A, int ra0, const LAS bf16* B, int rb0, int lane) {
    const int r = lane & 15, g = lane >> 4;
#pragma unroll
    for (int kk = 0; kk < NK; ++kk) { const bf16x8 a = ldf<LA>(A, ra0 + r, 4 * kk + g), b = ldf<LB>(B, rb0 + r, 4 * kk + g); acc = mfma16(a, b, acc); }
}

struct ConvItem { const float* W; const float* gk; bf16* WT; int K, N, mode, r; };
DI void conv_load(const ConvItem& c, int lane, f32x4 (&v)[8], float (&gv)[8]) {
    const int nkb = c.K / 64, nb = c.r / nkb, kb = c.r - nb * nkb, k0 = 64 * kb, n0 = 32 * nb;
    const int n = n0 + 4 * (lane & 7); const bool ok = n < c.N;
#pragma unroll
    for (int i = 0; i < 8; ++i) { const int kk = 8 * i + (lane >> 3); v[i] = ok ? *(const f32x4*)(c.W + (size_t)(k0 + kk) * c.N + n) : (f32x4){0.f, 0.f, 0.f, 0.f}; gv[i] = c.gk ? c.gk[k0 + kk] : 1.0f; }
}
DI void conv_store(const ConvItem& c, int lane, const f32x4 (&v)[8], const float (&gv)[8], LAS float* scr) {
    const int nkb = c.K / 64, nb = c.r / nkb, kb = c.r - nb * nkb, k0 = 64 * kb, n0 = 32 * nb, nq = 4 * (lane & 7);
#pragma unroll
    for (int i = 0; i < 8; ++i) { const int kk = 8 * i + (lane >> 3); LAS float* d = scr + kk * 33 + nq; d[0] = v[i].x * gv[i]; d[1] = v[i].y * gv[i]; d[2] = v[i].z * gv[i]; d[3] = v[i].w * gv[i]; }
    LDS_WAIT(); asm volatile("" ::: "memory");
    int row_off = n0;
    if (c.mode == 1) { const int j = n0 < DFF ? n0 : n0 - DFF; row_off = 256 * (j >> 7) + (j & 127) + (n0 < DFF ? 0 : 128); }
    const int cc = lane & 7;
#pragma unroll
    for (int j = 0; j < 4; ++j) { const int nn = (lane >> 3) + 8 * j; const LAS float* s = scr + (8 * cc) * 33 + nn;
        v4u o; o.x = pk2(s[0 * 33], s[1 * 33]); o.y = pk2(s[2 * 33], s[3 * 33]); o.z = pk2(s[4 * 33], s[5 * 33]); o.w = pk2(s[6 * 33], s[7 * 33]);
        *(v4u*)(c.WT + (size_t)(row_off + nn) * c.K + k0 + 8 * cc) = o; }
    LDS_WAIT(); asm volatile("" ::: "memory");
}

struct Args { const float* in[18]; float* out; unsigned char* ws; int ph_lo, ph_hi; };

typedef const __attribute__((address_space(4))) Args* KArgs;
DI KArgs kargs() { KArgs p = (KArgs)__builtin_amdgcn_kernarg_segment_ptr(); asm volatile("" : "+s"(p)); return p; }
DI void prologue(LAS unsigned char* lds, int lane, int wave, int bx) {
    KArgs AP = kargs();
    LAS float* scr = (LAS float*)(lds + wave * 16384);
    const int gw = bx * NWAVES + wave, NGW = gridDim.x * NWAVES;
    unsigned char* ws = AP->ws;
    constexpr int I_UP = (DM / 64) * (NUP / 32), I_DN = (DFF / 64) * (DM / 32), I_IN = (DM / 64) * (NINP / 32), I_OUT = (DM / 64) * (DM / 32);
    constexpr int NITEMS = 8 * I_UP + 8 * I_DN + 4 * I_IN + 4 * I_OUT;
#define CONV_DECODE(it_, c_) do { int r = (it_); (c_).gk = nullptr; (c_).K = DM; (c_).mode = 0; \
        if (r < 8 * I_UP) { const int mi = r / I_UP; r -= mi * I_UP; (c_).W = AP->in[2] + (size_t)mi * DM * NUP; (c_).gk = AP->in[1] + (size_t)mi * DM; (c_).WT = (bf16*)(ws + WS_WUP) + (size_t)mi * NUP * DM; (c_).N = NUP; (c_).mode = 1; } \
        else if (r < 8 * I_UP + 8 * I_DN) { r -= 8 * I_UP; const int mi = r / I_DN; r -= mi * I_DN; (c_).W = AP->in[3] + (size_t)mi * DFF * DM; (c_).WT = (bf16*)(ws + WS_WDN) + (size_t)mi * DM * DFF; (c_).K = DFF; (c_).N = DM; } \
        else if (r < 8 * I_UP + 8 * I_DN + 4 * I_IN) { r -= 8 * I_UP + 8 * I_DN; const int l = r / I_IN; r -= l * I_IN; const int kind = l % 3, ji = l / 3; \
            (c_).W = AP->in[kind == 0 ? 5 : kind == 1 ? 9 : 12] + (size_t)ji * DM * NIN; (c_).gk = AP->in[4] + (size_t)l * DM; (c_).WT = (bf16*)(ws + WS_WIN) + (size_t)l * NINP * DM; (c_).N = NIN; } \
        else { r -= 8 * I_UP + 8 * I_DN + 4 * I_IN; const int l = r / I_OUT; r -= l * I_OUT; const int kind = l % 3, ji = l / 3; \
            (c_).W = AP->in[kind == 0 ? 8 : kind == 1 ? 11 : 16] + (size_t)ji * DM * DM; (c_).WT = (bf16*)(ws + WS_WOUT) + (size_t)l * DM * DM; (c_).N = DM; } \
        (c_).r = r; } while (0)
    f32x4 va[8]; float ga[8]; ConvItem ca{}, cb{};
    if (gw < NITEMS) { CONV_DECODE(gw, ca); conv_load(ca, lane, va, ga); }
    for (int it = gw; it < NITEMS; it += NGW) {
        f32x4 vb[8]; float gb[8]; const int nx = it + NGW;
        if (nx < NITEMS) { CONV_DECODE(nx, cb); conv_load(cb, lane, vb, gb); }
        conv_store(ca, lane, va, ga, scr);
        ca = cb;
#pragma unroll
        for (int i = 0; i < 8; ++i) { va[i] = vb[i]; ga[i] = gb[i]; }
    }
#undef CONV_DECODE
    const float* x = AP->in[0]; bf16* hb = (bf16*)(ws + WS_HB); long long* ss0 = (long long*)(ws + WS_SS);
    for (int m = gw; m < MTOK; m += NGW) {
        const f32x4* xr = (const f32x4*)(x + (size_t)m * DM) + lane; f32x4 v[8]; float s = 0.f;
#pragma unroll
        for (int j = 0; j < 8; ++j) { v[j] = xr[64 * j]; s += (v[j].x * v[j].x + v[j].y * v[j].y) + (v[j].z * v[j].z + v[j].w * v[j].w); }
        s = wave_sum(s);
        v2u* o8 = (v2u*)(hb + (size_t)m * DM) + lane;
#pragma unroll
        for (int j = 0; j < 8; ++j) { v2u w; w.x = pk2(v[j].x, v[j].y); w.y = pk2(v[j].z, v[j].w); o8[64 * j] = w; }
        if (lane == 0) ss0[m] = __float2ll_rn(s * 1048576.0f);
    }
}

constexpr int IMGM_P = 0, IMGM_KT = 8192, IMGM_VT = IMGM_KT + 16384, IMGM_GS = IMGM_VT + 4 * 8192, IMGM_BYTES = IMGM_GS + 1024;
constexpr int IMGG_Q = 0, IMGG_KT = 32768, IMGG_P = 65536, IMGG_VT = IMGG_P + 8192, IMGG_EB = IMGG_VT + 8 * 8192, IMGG_BYTES = IMGG_EB + 1024;
static_assert((size_t)IMGM_BYTES * 4096 <= 352 * MiB && (size_t)IMGG_BYTES * 2048 <= 352 * MiB, "images overlay the (idle) FFN activation buffer");
DI unsigned pk2_sw(float lo, float hi) { unsigned a = __builtin_bit_cast(unsigned, lo), b = __builtin_bit_cast(unsigned, hi); a = (a + 0x7fffu + ((a >> 16) & 1u)) >> 16; b = (b + 0x7fffu + ((b >> 16) & 1u)) & 0xffff0000u; return a | b; }
DI float logsig_fast(float x) { return fminf(x, 0.f) - __logf(1.0f + __expf(-fabsf(x))); }

DI void mlstm_pre(LAS unsigned char* lds, const bf16* P1, const float* G, const float* b_if, unsigned char* img, int tid, int lane, int wave, int bx) {
    LAS bf16* Qs = (LAS bf16*)lds;
    LAS bf16* Ks = Qs + 64 * 128;
    LAS bf16* KTs = Ks + 64 * 128;
    LAS bf16* Ps = KTs + 128 * 64;
    LAS bf16* VT = Ps + 64 * 64;
    LAS float* fa = (LAS float*)(VT + 256 * 64);
    LAS float *bcum = fa, *ipre = fa + 64, *aloc = fa + 128, *wloc = fa + 192, *scal = fa + 256;
    const float KSCALE = 0.08838834764831845f;
    const int g = lane >> 4, r16 = lane & 15;
    v4u pq[2], pk[2]; float pgi = 0.f, pgf = 0.f;
#define MLP_LOAD(it_) do { const int b_ = (it_) >> 9, c_ = ((it_) >> 3) & 63, h_ = (it_) & 7; const int row0_ = b_ * SEQ + c_ * 64; \
        _Pragma("unroll") for (int p = 0; p < 2; ++p) { const int idx = tid + 512 * p, r = idx >> 4, c8 = idx & 15; const bf16* src = P1 + (size_t)(row0_ + r) * NQKV + h_ * 128 + c8 * 8; pq[p] = *(const v4u*)src; pk[p] = *(const v4u*)(src + 1024); } \
        if (tid < 64) { const float* gp = G + (size_t)(row0_ + tid) * 16; pgi = gp[h_]; pgf = gp[8 + h_]; } } while (0)
    if (bx < 4096) MLP_LOAD(bx);
    for (int item = bx; item < 4096; item += gridDim.x) {
        const int h = item & 7;
        unsigned char* im = img + (size_t)item * IMGM_BYTES;
        __syncthreads();
        if (tid < 64) { ipre[tid] = pgi + b_if[h]; bcum[tid] = logsig(pgf + b_if[8 + h]); }
#pragma unroll
        for (int p = 0; p < 2; ++p) { const int idx = tid + 512 * p, r = idx >> 4, c8 = idx & 15; *(LAS v4u*)(Qs + eoff<128>(r, c8 * 8)) = pq[p]; *(LAS v4u*)(Ks + eoff<128>(r, c8 * 8)) = pk[p]; }
        __syncthreads();
        if (wave == 0) {
            const float bt = wave_incl_sum(bcum[lane], lane), ip = ipre[lane];
            const float al = bt + wave_incl_max(ip - bt, lane);
            const float blast = __shfl(bt, 63);
            const float gg = blast - bt + ip;
            const float gmax = wave_max(gg);
            bcum[lane] = bt; aloc[lane] = al; wloc[lane] = __expf(gg - gmax);
            if (lane == 0) { scal[0] = blast; scal[1] = gmax; }
        }
        if (item + (int)gridDim.x < 4096) MLP_LOAD(item + (int)gridDim.x);
        __syncthreads();
#pragma unroll
        for (int p = 0; p < 2; ++p) { const int idx = tid + 512 * p, s = idx >> 4, c8 = idx & 15; const v4u kv = *(const LAS v4u*)(Ks + eoff<128>(s, c8 * 8)); const float w = wloc[s] * KSCALE;
#pragma unroll
            for (int j = 0; j < 4; ++j) { KTs[eoff<64>(c8 * 8 + 2 * j, s)] = (bf16)f2bf(bflo(kv[j]) * w); KTs[eoff<64>(c8 * 8 + 2 * j + 1, s)] = (bf16)f2bf(bfhi(kv[j]) * w); } }
        { const int tt = wave >> 1;
#pragma unroll
          for (int q2 = 0; q2 < 2; ++q2) { const int st = 2 * (wave & 1) + q2; f32x4 acc = (f32x4){0.f, 0.f, 0.f, 0.f};
            if (st <= tt) mma_tile<128, 128, 4>(acc, Qs, 16 * tt, Ks, 16 * st, lane);
            const int s = 16 * st + r16; const float cs = ipre[s] - bcum[s];
#pragma unroll
            for (int i = 0; i < 4; ++i) { const int t = 16 * tt + 4 * g + i; const float p = (s <= t) ? acc[i] * KSCALE * __expf(bcum[t] + cs - aloc[t]) : 0.f; Ps[eoff<64>(t, s)] = (bf16)f2bf(p); } } }
        __syncthreads();
        *(v4u*)(im + IMGM_P + tid * 16) = *(const LAS v4u*)((LAS unsigned char*)Ps + tid * 16);
#pragma unroll
        for (int p = 0; p < 2; ++p) *(v4u*)(im + IMGM_KT + (tid + 512 * p) * 16) = *(const LAS v4u*)((LAS unsigned char*)KTs + (tid + 512 * p) * 16);
        if (tid < 64) { float* gs = (float*)(im + IMGM_GS); gs[tid] = bcum[tid]; gs[64 + tid] = aloc[tid]; if (tid < 2) gs[128 + tid] = scal[tid]; }
    }
#undef MLP_LOAD
}

DI void mlstm_scan2(LAS unsigned char* lds, const bf16* P1, const unsigned char* img, bf16* hraw, int tid, int lane, int wave, int bx) {
    constexpr int IB = 8192 + 16384 + 16384 + 10240 + 1024;
    LAS bf16* CT0 = (LAS bf16*)(lds + 2 * IB);
    const int g = lane >> 4, r16 = lane & 15, tt = wave >> 1, eh = wave & 1;
    for (int item0 = bx; item0 < 256; item0 += gridDim.x) {
        const int item = (gridDim.x == 256) ? (item0 & 7) * 32 + (item0 >> 3) : item0;
        const int b = item >> 5, h = (item >> 2) & 7, sl = item & 3;
        f32x4 Cacc[5];
#pragma unroll
        for (int e = 0; e < 5; ++e) Cacc[e] = (f32x4){0.f, 0.f, 0.f, 0.f};
        __syncthreads();
        for (int i = tid; i < 2 * 80 * 128 / 8; i += 512) ((LAS v4u*)CT0)[i] = (v4u){0u, 0u, 0u, 0u};
        float m_prev = 0.f;
        v4u rp, rq[2], rk[2], rv; float rg0 = 0.f, rbl, rgm;
#define MLS_PREFETCH(cc) do { const int item2 = (b * 64 + (cc)) * 8 + h; const unsigned char* im = img + (size_t)item2 * IMGM_BYTES; const int row0_ = b * SEQ + (cc) * 64; \
            rp = *(const v4u*)(im + IMGM_P + tid * 16); rk[0] = *(const v4u*)(im + IMGM_KT + tid * 16); rk[1] = *(const v4u*)(im + IMGM_KT + (tid + 512) * 16); \
            rv = *(const v4u*)(P1 + (size_t)(row0_ + (tid >> 3)) * NQKV + 2048 + h * 256 + sl * 64 + (tid & 7) * 8); \
            _Pragma("unroll") for (int p = 0; p < 2; ++p) { const int idx = tid + 512 * p, r = idx >> 4, c8 = idx & 15; rq[p] = *(const v4u*)(P1 + (size_t)(row0_ + r) * NQKV + h * 128 + c8 * 8); } \
            const float* gs = (const float*)(im + IMGM_GS); if (tid < 128) rg0 = gs[tid]; rbl = gs[128]; rgm = gs[129]; } while (0)
#define MLS_STORE(bi) do { LAS unsigned char* bb = lds + (bi) * IB; \
            *(LAS v4u*)(bb + tid * 16) = rp; *(LAS v4u*)(bb + 8192 + 16384 + tid * 16) = rk[0]; *(LAS v4u*)(bb + 8192 + 16384 + (tid + 512) * 16) = rk[1]; \
            *(LAS v4u*)(bb + 8192 + 16384 + 16384 + off_v64(tid >> 3, tid & 7)) = rv; \
            _Pragma("unroll") for (int p = 0; p < 2; ++p) { const int idx = tid + 512 * p, r = idx >> 4, c8 = idx & 15; *(LAS v4u*)((LAS bf16*)(bb + 8192) + eoff<128>(r, c8 * 8)) = rq[p]; } \
            if (tid < 128) ((LAS float*)(bb + 8192 + 16384 + 16384 + 10240))[tid] = rg0; } while (0)
        MLS_PREFETCH(0); MLS_STORE(0);
        float blast = rbl, gmax = rgm;
        MLS_PREFETCH(1);
        __syncthreads();
        for (int c = 0; c < 64; ++c) {
            const int row0 = b * SEQ + c * 64;
            const LAS unsigned char* bb = lds + (c & 1) * IB;
            const LAS bf16* Ps = (const LAS bf16*)bb; const LAS bf16* Qs = (const LAS bf16*)(bb + 8192); const LAS bf16* KTs = (const LAS bf16*)(bb + 8192 + 16384);
            const LAS bf16* VTs = (const LAS bf16*)(bb + 8192 + 16384 + 16384); const LAS float* gsl = (const LAS float*)(bb + 8192 + 16384 + 16384 + 10240);
            LAS bf16* CTc = CT0 + (c & 1) * 80 * 128; LAS bf16* CTn = CT0 + ((c + 1) & 1) * 80 * 128;
            const int t = 16 * tt + r16;
            const float btv = gsl[t], alv = gsl[64 + t];
            const float mt = fmaxf(btv + m_prev, alv), al = __expf(alv - mt), be = __expf(btv + m_prev - mt), em = __expf(-mt);
            const float m_new = fmaxf(blast + m_prev, gmax), wcs = __expf(blast + m_prev - m_new), gam = __expf(gmax - m_new);
            m_prev = m_new;
            const LAS unsigned char* vb = (const LAS unsigned char*)VTs;
            bf16x8 onesf;
#pragma unroll
            for (int j = 0; j < 8; ++j) onesf[j] = (r16 == 0) ? (short)0x3f80 : (short)0;
            const bf16x8 pa0 = ldf<64>(Ps, 16 * tt + r16, g), pa1 = ldf<64>(Ps, 16 * tt + r16, 4 + g);
            f32x4 d1 = (f32x4){0.f, 0.f, 0.f, 0.f}, d2 = (f32x4){0.f, 0.f, 0.f, 0.f};
            d1 = mfma16(onesf, pa0, d1); d1 = mfma16(onesf, pa1, d1); mma_tile<128, 128, 4>(d2, CTc, 64, Qs, 16 * tt, lane);
            const float den = __shfl(al * d1[0] + be * d2[0], r16);
            const float dinv = __builtin_amdgcn_rcpf(fmaxf(fabsf(den), em));
#pragma unroll
            for (int q2 = 0; q2 < 2; ++q2) { const int et = 2 * eh + q2; f32x4 a1 = (f32x4){0.f, 0.f, 0.f, 0.f}, a2 = (f32x4){0.f, 0.f, 0.f, 0.f};
                a1 = mfma16(vfrag64(vb, et, 0, lane), pa0, a1); a1 = mfma16(vfrag64(vb, et, 1, lane), pa1, a1); mma_tile<128, 128, 4>(a2, CTc, 16 * et, Qs, 16 * tt, lane);
                const f32x4 o4 = (a1 * al + a2 * be) * dinv; v2u w; w.x = pk2(o4[0], o4[1]); w.y = pk2(o4[2], o4[3]);
                *(v2u*)(hraw + (size_t)(row0 + t) * DM + h * 256 + sl * 64 + 16 * et + 4 * g) = w; }
            const bf16x8 ka0 = ldf<64>(KTs, 16 * wave + r16, g), ka1 = ldf<64>(KTs, 16 * wave + r16, 4 + g);
#pragma unroll
            for (int et = 0; et < 5; ++et) { f32x4 tmp = (f32x4){0.f, 0.f, 0.f, 0.f};
                tmp = mfma16(ka0, et < 4 ? vfrag64(vb, et & 3, 0, lane) : onesf, tmp); tmp = mfma16(ka1, et < 4 ? vfrag64(vb, et & 3, 1, lane) : onesf, tmp);
                Cacc[et] = Cacc[et] * wcs + tmp * gam;
                v2u w; w.x = pk2(Cacc[et][0], Cacc[et][1]); w.y = pk2(Cacc[et][2], Cacc[et][3]);
                *(LAS v2u*)(CTn + eoff<128>(16 * et + r16, 16 * wave + 4 * g)) = w; }
            if (c + 1 < 64) { MLS_STORE((c + 1) & 1); blast = rbl; gmax = rgm; }
            if (c + 2 < 64) MLS_PREFETCH(c + 2);
            __syncthreads();
        }
#undef MLS_PREFETCH
#undef MLS_STORE
    }
}

DI void gla_pre(LAS unsigned char* lds, const bf16* P1, const float* G, const float* w_alpha, const float* b_alpha, unsigned char* img, int tid, int lane, int wave, int bx) {
    LAS bf16* VT = (LAS bf16*)lds;
    LAS bf16* QTs = (LAS bf16*)lds;
    LAS bf16* KTl = QTs + 64 * 256;
    LAS bf16* KTT = KTl + 64 * 256;
    LAS bf16* Ps = KTT + 256 * 64;
    LAS float* alow = (LAS float*)(Ps + 64 * 64);
    LAS float* T0 = alow + 1024;
    const int g = lane >> 4, r16 = lane & 15, d = tid & 255, sh = tid >> 8;
    for (int item = bx; item < 2048; item += gridDim.x) {
        const int b = item >> 8, c = (item >> 2) & 63, h = item & 3;
        const int row0 = b * SEQ + c * 64;
        unsigned char* im = img + (size_t)item * IMGG_BYTES;
        __syncthreads();
        float wa[16];
#pragma unroll
        for (int i = 0; i < 16; ++i) wa[i] = w_alpha[i * 1024 + h * 256 + d];
        const float ba = b_alpha[h * 256 + d];
        f32x4 al4 = (f32x4){0.f, 0.f, 0.f, 0.f};
        if (tid < 256) al4 = *(const f32x4*)(G + (size_t)(row0 + (tid >> 2)) * 16 + (tid & 3) * 4);
        if (tid < 256) *(LAS f32x4*)(alow + tid * 4) = al4;
        __syncthreads();
        const bf16* qsrc = P1 + (size_t)(row0 + 32 * sh) * NQKV + h * 256 + d;
        float bs[32]; float run = 0.f;
#pragma unroll
        for (int j = 0; j < 32; ++j) { const int s = 32 * sh + j; float z = ba;
#pragma unroll
            for (int i = 0; i < 16; ++i) z += alow[s * 16 + i] * wa[i];
            run += logsig_fast(z) * (1.0f / 16.0f); bs[j] = run; }
        if (sh == 0) T0[d] = run;
        __syncthreads();
        const float add = sh ? T0[d] : 0.f;
        if (sh) ((float*)(im + IMGG_EB))[d] = __expf(run + add);
#pragma unroll
        for (int q8 = 0; q8 < 4; ++q8) { unsigned kk[8];
#pragma unroll
            for (int j = 0; j < 8; ++j) { const int jj = 8 * q8 + j, s = 32 * sh + jj; const float bsum = bs[jj] + add;
                const float qv = bf2f(qsrc[(size_t)jj * NQKV]) * 0.0625f * __expf(bsum), kv = bf2f(qsrc[(size_t)jj * NQKV + 1024]) * __expf(-bsum);
                QTs[eoff<256>(s, d)] = (bf16)f2bf(qv); kk[j] = f2bf(kv); KTl[eoff<256>(s, d)] = (bf16)kk[j]; }
            v4u w; w.x = kk[0] | (kk[1] << 16); w.y = kk[2] | (kk[3] << 16); w.z = kk[4] | (kk[5] << 16); w.w = kk[6] | (kk[7] << 16);
            *(LAS v4u*)(KTT + eoff<64>(d, 32 * sh + 8 * q8)) = w; }
        __syncthreads();
        { const int tt = wave >> 1;
#pragma unroll
          for (int q2 = 0; q2 < 2; ++q2) { const int st = 2 * (wave & 1) + q2; f32x4 acc = (f32x4){0.f, 0.f, 0.f, 0.f};
            if (st <= tt) mma_tile<256, 256, 8>(acc, QTs, 16 * tt, KTl, 16 * st, lane);
            const int s = 16 * st + r16;
#pragma unroll
            for (int i = 0; i < 4; ++i) { const int t = 16 * tt + 4 * g + i; Ps[eoff<64>(t, s)] = (bf16)f2bf((s <= t) ? acc[i] : 0.f); } } }
        __syncthreads();
#pragma unroll
        for (int p = 0; p < 4; ++p) { *(v4u*)(im + IMGG_Q + (tid + 512 * p) * 16) = *(const LAS v4u*)((LAS unsigned char*)QTs + (tid + 512 * p) * 16);
                                      *(v4u*)(im + IMGG_KT + (tid + 512 * p) * 16) = *(const LAS v4u*)((LAS unsigned char*)KTT + (tid + 512 * p) * 16); }
        *(v4u*)(im + IMGG_P + tid * 16) = *(const LAS v4u*)((LAS unsigned char*)Ps + tid * 16);
    }
}

DI void gla_scan2(LAS unsigned char* lds, const bf16* P1, const unsigned char* img, bf16* hraw, int tid, int lane, int wave, int bx) {
    LAS bf16* QTs = (LAS bf16*)lds;
    LAS bf16* KTT = QTs + 64 * 256;
    LAS bf16* Ps = KTT + 256 * 64;
    LAS bf16* VTs = Ps + 64 * 64;
    LAS float* eb = (LAS float*)(VTs + 64 * 64);
    LAS bf16* ST0 = (LAS bf16*)(eb + 256);
    const int g = lane >> 4, r16 = lane & 15, tt = wave >> 1, eh = wave & 1;
    for (int item0 = bx; item0 < 256; item0 += gridDim.x) {
        const int item = (gridDim.x == 256) ? (item0 & 7) * 32 + (item0 >> 3) : item0;
        const int b = item >> 5, h = (item >> 3) & 3, sl = item & 7;
        f32x4 Sacc[2][4];
#pragma unroll
        for (int a = 0; a < 2; ++a)
#pragma unroll
            for (int e = 0; e < 4; ++e) Sacc[a][e] = (f32x4){0.f, 0.f, 0.f, 0.f};
        __syncthreads();
        for (int i = tid; i < 2 * 64 * 256 / 8; i += 512) ((LAS v4u*)ST0)[i] = (v4u){0u, 0u, 0u, 0u};
        v4u rq[4], rk[4], rp, rv; float re = 0.f;
#define GLS_PREFETCH(cc) do { const int item2 = (b * 64 + (cc)) * 4 + h; const unsigned char* im = img + (size_t)item2 * IMGG_BYTES; \
            _Pragma("unroll") for (int p = 0; p < 4; ++p) { rq[p] = *(const v4u*)(im + IMGG_Q + (tid + 512 * p) * 16); rk[p] = *(const v4u*)(im + IMGG_KT + (tid + 512 * p) * 16); } \
            rp = *(const v4u*)(im + IMGG_P + tid * 16); rv = *(const v4u*)(P1 + ((size_t)b * SEQ + (cc) * 64 + (tid >> 3)) * NQKV + 2048 + h * 512 + sl * 64 + (tid & 7) * 8); if (tid < 256) re = ((const float*)(im + IMGG_EB))[tid]; } while (0)
        GLS_PREFETCH(0);
        for (int c = 0; c < 64; ++c) {
            const int row0 = b * SEQ + c * 64;
            LAS bf16* STc = ST0 + (c & 1) * 64 * 256; LAS bf16* STn = ST0 + ((c + 1) & 1) * 64 * 256;
            __syncthreads();
#pragma unroll
            for (int p = 0; p < 4; ++p) { *(LAS v4u*)((LAS unsigned char*)QTs + (tid + 512 * p) * 16) = rq[p]; *(LAS v4u*)((LAS unsigned char*)KTT + (tid + 512 * p) * 16) = rk[p]; }
            *(LAS v4u*)((LAS unsigned char*)Ps + tid * 16) = rp; *(LAS v4u*)((LAS unsigned char*)VTs + off_v64(tid >> 3, tid & 7)) = rv;
            if (tid < 256) eb[tid] = re;
            __syncthreads();
            if (c + 1 < 64) GLS_PREFETCH(c + 1);
            const LAS unsigned char* vb = (const LAS unsigned char*)VTs;
            const bf16x8 pa0 = ldf<64>(Ps, 16 * tt + r16, g), pa1 = ldf<64>(Ps, 16 * tt + r16, 4 + g);
#pragma unroll
            for (int q2 = 0; q2 < 2; ++q2) { const int et = 2 * eh + q2; f32x4 acc = (f32x4){0.f, 0.f, 0.f, 0.f};
                acc = mfma16(vfrag64(vb, et, 0, lane), pa0, acc); acc = mfma16(vfrag64(vb, et, 1, lane), pa1, acc); mma_tile<256, 256, 8>(acc, STc, 16 * et, QTs, 16 * tt, lane);
                v2u w; w.x = pk2_sw(acc[0], acc[1]); w.y = pk2_sw(acc[2], acc[3]);
                *(v2u*)(hraw + (size_t)(row0 + 16 * tt + r16) * DM + h * 512 + sl * 64 + 16 * et + 4 * g) = w; }
#pragma unroll
            for (int a = 0; a < 2; ++a) { const int dt = 2 * wave + a;
                const f32x4 ev = *(const LAS f32x4*)(eb + 16 * dt + 4 * g);
                const bf16x8 ka0 = ldf<64>(KTT, 16 * dt + r16, g), ka1 = ldf<64>(KTT, 16 * dt + r16, 4 + g);
#pragma unroll
                for (int et = 0; et < 4; ++et) { Sacc[a][et] = mfma16(ka0, vfrag64(vb, et, 0, lane), Sacc[a][et]); Sacc[a][et] = mfma16(ka1, vfrag64(vb, et, 1, lane), Sacc[a][et]); Sacc[a][et] = Sacc[a][et] * ev;
                    v2u w; w.x = pk2(Sacc[a][et][0], Sacc[a][et][1]); w.y = pk2(Sacc[a][et][2], Sacc[a][et][3]);
                    *(LAS v2u*)(STn + eoff<256>(16 * et + r16, 16 * dt + 4 * g)) = w; } }
        }
#undef GLS_PREFETCH
    }
}


DI void mixer_gates(const bf16* hb, const bf16* wg, const long long* ss, float* G, int lane, int wave, int bx) {
    const int g = lane >> 4, r16 = lane & 15;
    for (int t = bx * NWAVES + wave; t < MTOK / 16; t += gridDim.x * NWAVES) {
        const bf16* ap = hb + (size_t)(16 * t + r16) * DM + 8 * g; const bf16* bp = wg + (size_t)r16 * DM + 8 * g;
        f32x4 acc = (f32x4){0.f, 0.f, 0.f, 0.f};
#pragma unroll 8
        for (int kk = 0; kk < DM / 32; ++kk) { const bf16x8 a = *(const bf16x8*)(ap + 32 * kk), b = *(const bf16x8*)(bp + 32 * kk); acc = mfma16(a, b, acc); }
#pragma unroll
        for (int i = 0; i < 4; ++i) { const int row = 16 * t + 4 * g + i; G[(size_t)row * 16 + r16] = acc[i] * pg8::rstd_of(ss, row); }
    }
}

template <int HS, int ACT> DI void headnorm_gate(const bf16* hraw, const bf16* P1, const float* gnorm, bf16* hm, int lane, int wave, int bx) {
    constexpr int NH = DM / HS, EPL = HS / 64;
    const int gw = bx * NWAVES + wave, NGW = gridDim.x * NWAVES;
    for (int row = gw; row < MTOK; row += NGW) {
#pragma unroll
        for (int hh = 0; hh < NH; ++hh) { const int col = hh * HS + lane * EPL;
            unsigned xw[EPL / 2], gwd[EPL / 2];
            if constexpr (EPL == 4) { const v2u a = *(const v2u*)(hraw + (size_t)row * DM + col), b2 = *(const v2u*)(P1 + (size_t)row * NQKV + 4096 + col); xw[0] = a.x; xw[1] = a.y; gwd[0] = b2.x; gwd[1] = b2.y; }
            else { const v4u a = *(const v4u*)(hraw + (size_t)row * DM + col), b2 = *(const v4u*)(P1 + (size_t)row * NQKV + 4096 + col); xw[0] = a.x; xw[1] = a.y; xw[2] = a.z; xw[3] = a.w; gwd[0] = b2.x; gwd[1] = b2.y; gwd[2] = b2.z; gwd[3] = b2.w; }
            float s = 0.f;
#pragma unroll
            for (int j = 0; j < EPL / 2; ++j) { const float x0 = bflo(xw[j]), x1 = bfhi(xw[j]); s += x0 * x0 + x1 * x1; }
            s = wave_sum(s); const float rs = rsqrtf(s * (1.0f / HS) + 1e-6f);
            unsigned outw[EPL / 2];
#pragma unroll
            for (int j = 0; j < EPL / 2; ++j) { const float g0 = bflo(gwd[j]), g1 = bfhi(gwd[j]);
                const float a0 = ACT == 0 ? __builtin_amdgcn_rcpf(1.0f + __expf(-g0)) : g0 * __builtin_amdgcn_rcpf(1.0f + __expf(-g0)), a1 = ACT == 0 ? __builtin_amdgcn_rcpf(1.0f + __expf(-g1)) : g1 * __builtin_amdgcn_rcpf(1.0f + __expf(-g1));
                outw[j] = pk2(bflo(xw[j]) * rs * gnorm[col + 2 * j] * a0, bfhi(xw[j]) * rs * gnorm[col + 2 * j + 1] * a1); }
            if constexpr (EPL == 4) { v2u w; w.x = outw[0]; w.y = outw[1]; *(v2u*)(hm + (size_t)row * DM + col) = w; }
            else { v4u w; w.x = outw[0]; w.y = outw[1]; w.z = outw[2]; w.w = outw[3]; *(v4u*)(hm + (size_t)row * DM + col) = w; }
        }
    }
}

DI void fox_cf(LAS unsigned char* lds, const float* G, const float* b_f, float* cf, int tid, int lane, int wave, int bx) {
    LAS float* wt = (LAS float*)lds;
    for (int item = bx; item < 256; item += gridDim.x) { const int seq = item >> 1, hf = item & 1, b = seq >> 4, h = seq & 15; const float bias = b_f[h];
        const float* gp = G + ((size_t)b * SEQ + hf * 2048 + tid * 4) * 16 + h;
        float ls[4]; float s = 0.f, s0 = 0.f;
#pragma unroll
        for (int p = 0; p < 4; ++p) { ls[p] = logsig(gp[p * 16] + bias); s += ls[p]; }
        if (hf) { const float* g0 = gp - (size_t)2048 * 16;
#pragma unroll
            for (int p = 0; p < 4; ++p) s0 += logsig(g0[p * 16] + bias); }
        const float incl = wave_incl_sum(s, lane), tot0 = wave_sum(s0);
        __syncthreads();
        if (lane == 63) wt[wave] = incl; if (lane == 0) wt[8 + wave] = tot0;
        __syncthreads();
        float base = 0.f;
#pragma unroll
        for (int w = 0; w < 8; ++w) { base += (w < wave) ? wt[w] : 0.f; base += wt[8 + w]; }
        float run = base + incl - s;
        float* o = cf + (size_t)seq * SEQ + hf * 2048 + tid * 4; f32x4 ov;
        run += ls[0]; ov.x = run; run += ls[1]; ov.y = run; run += ls[2]; ov.z = run; run += ls[3]; ov.w = run;
        *(f32x4*)o = ov;
    }
}

DI unsigned off_v(unsigned row, unsigned ch) { return 256u * row + 16u * (ch ^ (((row & 3u) << 2) | (((row >> 2) & 1u) << 1))); }

DI void fox_attn2(LAS unsigned char* lds, const bf16* P1, const float* cf, bf16* hm, int tid, int lane, int wave, int bx) {
    constexpr int BUFB = 16384 + 16384 + 256;
    const float LOG2E = 1.4426950408889634f, QS = 0.08838834764831845f * 1.4426950408889634f, THR = 8.0f;
    const int g = lane >> 4, r16 = lane & 15;
    const int G_ = gridDim.x;
    const int nit = (2048 + G_ - 1) / G_;
    for (int it = 0; it < nit; ++it) {
        const int u = (it & 1) ? it * G_ + (G_ - 1 - bx) : it * G_ + bx;
        if (u >= 2048) continue;
        const int qb = 15 - (u >> 7), bh = u & 127, b = bh >> 4, h = bh & 15;
        const size_t rowb = (size_t)b * SEQ; const int q0 = qb * 256 + 32 * wave;
        bf16x8 qf[2][4]; float c0[2];
#pragma unroll
        for (int tt = 0; tt < 2; ++tt) { const int t = q0 + 16 * tt + r16; c0[tt] = cf[(size_t)bh * SEQ + t] * LOG2E;
#pragma unroll
            for (int kk = 0; kk < 4; ++kk) { const v4u raw = *(const v4u*)(P1 + (rowb + t) * NQKV + h * 128 + 32 * kk + 8 * g); v4u sc;
#pragma unroll
                for (int j = 0; j < 4; ++j) sc[j] = pk2(bflo(raw[j]) * QS, bfhi(raw[j]) * QS);
                qf[tt][kk] = __builtin_bit_cast(bf16x8, sc); } }
        f32x4 oacc[8][2];
#pragma unroll
        for (int et = 0; et < 8; ++et) { oacc[et][0] = (f32x4){0.f, 0.f, 0.f, 0.f}; oacc[et][1] = (f32x4){0.f, 0.f, 0.f, 0.f}; }
        float lrun[2] = {0.f, 0.f};
        const int ntiles = 4 * (qb + 1);
        v4u kreg[2], vreg[2]; float cfreg = 0.f;
        const bf16* kbase = P1 + rowb * NQKV + 2048 + h * 128;
#define FOX_LOAD(j) do { _Pragma("unroll") for (int p = 0; p < 2; ++p) { const int idx = tid + 512 * p, r = idx >> 4, c8 = idx & 15; \
            kreg[p] = *(const v4u*)(kbase + (size_t)(64 * (j) + r) * NQKV + c8 * 8); vreg[p] = *(const v4u*)(kbase + (size_t)(64 * (j) + r) * NQKV + 2048 + c8 * 8); } \
            if (tid < 64) cfreg = -cf[(size_t)bh * SEQ + 64 * (j) + tid] * LOG2E; } while (0)
#define FOX_STORE(bufi) do { LAS unsigned char* bb = lds + (bufi) * BUFB; _Pragma("unroll") for (int p = 0; p < 2; ++p) { const int idx = tid + 512 * p, r = idx >> 4, c8 = idx & 15; \
            *(LAS v4u*)((LAS bf16*)bb + eoff<128>(r, c8 * 8)) = kreg[p]; *(LAS v4u*)(bb + 16384 + off_v(r, c8)) = vreg[p]; } \
            if (tid < 64) ((LAS float*)(bb + 32768))[tid] = cfreg; } while (0)
        __syncthreads();
        FOX_LOAD(0); FOX_STORE(0);
        if (ntiles > 1) FOX_LOAD(1);
        __syncthreads();
        for (int j = 0; j < ntiles; ++j) {
            if (j + 1 < ntiles) FOX_STORE((j + 1) & 1);
            if (j + 2 < ntiles) FOX_LOAD(j + 2);
            if (64 * j <= q0 + 31) {
                const LAS bf16* Ks = (const LAS bf16*)(lds + (j & 1) * BUFB); const LAS bf16* VTs = Ks + 64 * 128; const LAS float* cfs = (const LAS float*)(VTs + 128 * 64);
                f32x4 sacc[2][4];
#pragma unroll
                for (int st = 0; st < 4; ++st) { const f32x4 cv = *(const LAS f32x4*)(cfs + 16 * st + 4 * g);
#pragma unroll
                    for (int tt = 0; tt < 2; ++tt) sacc[tt][st] = cv + c0[tt]; }
#pragma unroll
                for (int st = 0; st < 4; ++st)
#pragma unroll
                    for (int kk = 0; kk < 4; ++kk) { const bf16x8 kf = ldf<128>(Ks, 16 * st + r16, 4 * kk + g);
                        sacc[0][st] = mfma16(kf, qf[0][kk], sacc[0][st]); sacc[1][st] = mfma16(kf, qf[1][kk], sacc[1][st]); if (kk == 3) asm volatile("" ::: "memory"); }
                if (64 * j + 63 > q0) {
#pragma unroll
                    for (int tt = 0; tt < 2; ++tt) { const int t = q0 + 16 * tt + r16;
#pragma unroll
                        for (int st = 0; st < 4; ++st)
#pragma unroll
                            for (int i = 0; i < 4; ++i) { const int s = 64 * j + 16 * st + 4 * g + i; if (s > t) sacc[tt][st][i] = -__builtin_inff(); } }
                }
                float mx[2];
#pragma unroll
                for (int tt = 0; tt < 2; ++tt) { float m = -__builtin_inff();
#pragma unroll
                    for (int st = 0; st < 4; ++st) m = fmaxf(m, fmaxf(fmaxf(sacc[tt][st][0], sacc[tt][st][1]), fmaxf(sacc[tt][st][2], sacc[tt][st][3])));
                    m = fmaxf(m, __shfl_xor(m, 16)); m = fmaxf(m, __shfl_xor(m, 32)); mx[tt] = m; }
                if (__any(mx[0] > THR || mx[1] > THR)) {
#pragma unroll
                    for (int tt = 0; tt < 2; ++tt) { const float sh = fmaxf(mx[tt], 0.f), f = __builtin_amdgcn_exp2f(-sh);
                        c0[tt] -= sh; lrun[tt] *= f;
#pragma unroll
                        for (int st = 0; st < 4; ++st) sacc[tt][st] = sacc[tt][st] - sh;
#pragma unroll
                        for (int et = 0; et < 8; ++et) oacc[et][tt] = oacc[et][tt] * f; }
                }
#pragma unroll
                for (int tt = 0; tt < 2; ++tt) { float ls = 0.f;
#pragma unroll
                    for (int st = 0; st < 4; ++st)
#pragma unroll
                        for (int i = 0; i < 4; ++i) { const float p = __builtin_amdgcn_exp2f(sacc[tt][st][i]); sacc[tt][st][i] = p; ls += p; }
                    lrun[tt] += ls; }
#pragma unroll
                for (int ks = 0; ks < 2; ++ks) { bf16x8 pb[2];
#pragma unroll
                    for (int tt = 0; tt < 2; ++tt) { v4u w; w.x = pk2(sacc[tt][2 * ks][0], sacc[tt][2 * ks][1]); w.y = pk2(sacc[tt][2 * ks][2], sacc[tt][2 * ks][3]);
                        w.z = pk2(sacc[tt][2 * ks + 1][0], sacc[tt][2 * ks + 1][1]); w.w = pk2(sacc[tt][2 * ks + 1][2], sacc[tt][2 * ks + 1][3]); pb[tt] = __builtin_bit_cast(bf16x8, w); }
#pragma unroll
                    for (int et = 0; et < 8; ++et) {
                        const LAS unsigned char* vb = (const LAS unsigned char*)VTs;
                        const v4i16_t lo = tr_read(vb + off_v(32 * ks + 4 * g + (r16 >> 2), 2 * et + ((lane & 3) >> 1)) + 8 * (lane & 1));
                        const v4i16_t hi = tr_read(vb + off_v(32 * ks + 16 + 4 * g + (r16 >> 2), 2 * et + ((lane & 3) >> 1)) + 8 * (lane & 1));
                        bf16x8 va; va[0] = lo[0]; va[1] = lo[1]; va[2] = lo[2]; va[3] = lo[3]; va[4] = hi[0]; va[5] = hi[1]; va[6] = hi[2]; va[7] = hi[3];
                        oacc[et][0] = mfma16(va, pb[0], oacc[et][0]); oacc[et][1] = mfma16(va, pb[1], oacc[et][1]); if (et & 1) asm volatile("" ::: "memory"); } }
            }
            __syncthreads();
        }
#undef FOX_LOAD
#undef FOX_STORE
#pragma unroll
        for (int tt = 0; tt < 2; ++tt) { float l = lrun[tt]; l += __shfl_xor(l, 16); l += __shfl_xor(l, 32); const float inv = 1.0f / l;
            bf16* orow = hm + (rowb + q0 + 16 * tt + r16) * DM + h * 128 + 4 * g;
#pragma unroll
            for (int et = 0; et < 8; ++et) { v2u w; w.x = pk2(oacc[et][tt][0] * inv, oacc[et][tt][1] * inv); w.y = pk2(oacc[et][tt][2] * inv, oacc[et][tt][3] * inv); *(v2u*)(orow + 16 * et) = w; } }
    }
}


DI void final_norm(float* out, const bf16* hb, const long long* ss, const float* gfin, int lane, int wave, int bx) {
    const int gw = bx * NWAVES + wave, NGW = gridDim.x * NWAVES;
    for (int m = gw; m < MTOK; m += NGW) { const float rs = pg8::rstd_of(ss, m);
        const v4u* hr = (const v4u*)(hb + (size_t)m * DM); f32x4* xr = (f32x4*)(out + (size_t)m * DM); const f32x4* gr = (const f32x4*)gfin;
#pragma unroll
        for (int j = 0; j < 4; ++j) { const v4u w = hr[lane + 64 * j]; const int c4 = 2 * (lane + 64 * j);
            const f32x4 g0 = gr[c4], g1 = gr[c4 + 1];
            xr[c4] = (f32x4){bflo(w.x) * rs * g0.x, bfhi(w.x) * rs * g0.y, bflo(w.y) * rs * g0.z, bfhi(w.y) * rs * g0.w};
            xr[c4 + 1] = (f32x4){bflo(w.z) * rs * g1.x, bfhi(w.z) * rs * g1.y, bflo(w.w) * rs * g1.z, bfhi(w.w) * rs * g1.w}; } }
}

#define PH(p) if (lo <= (p) && (p) < hi && (ran ? (xcd_barrier(bar), true) : (ran = true)))
#define TID() int tid = threadIdx.x; asm volatile("" : "+v"(tid)); const int lane = tid & 63, wave = __builtin_amdgcn_readfirstlane(tid >> 6); int bx = blockIdx.x; asm volatile("" : "+s"(bx)); (void)lane; (void)wave; (void)bx
#define WSP(T, off) ((T*)(ka->ws + (off)))
template <int j> DI void subblock(LAS unsigned char* lds, const XcdBarrier& bar, const int lo, const int hi, bool& ran) {
    {
        constexpr int layer = j / 3, typ = j - 3 * layer, base = 1 + 5 * j;
        if constexpr (typ != 1) {
            PH(base) { TID(); KArgs ka = kargs(); const int mi = layer * 2 + (typ >> 1);
                pg8::Gemm gm{WSP(bf16, WS_HB), WSP(bf16, WS_WUP) + (size_t)mi * NUP * DM, MTOK, NUP, DM}; pg8::StaticOrder S; S.init(MTOK, NUP, gridDim.x, bx);
                pg8::EpiSwiGLU E{WSP(bf16, WS_ACT), WSP(long long, WS_SS) + (size_t)j * MTOK, DFF};
                pg8::gemm_phase<pg8::EpiSwiGLU, pg8::StaticOrder, PG8_ALIGN, PG8_SP2>(lds, gm, S, E); }
        } else {
            constexpr int kind = layer % 3, ji = layer / 3;
            PH(base) { TID(); KArgs ka = kargs();
                mixer_gates(WSP(bf16, WS_HB), WSP(bf16, WS_WIN) + ((size_t)layer * NINP + NQKV) * DM, WSP(long long, WS_SS) + (size_t)j * MTOK, WSP(float, WS_G), lane, wave, bx);
                pg8::Gemm gm{WSP(bf16, WS_HB), WSP(bf16, WS_WIN) + (size_t)layer * NINP * DM, MTOK, NQKV, DM}; pg8::StaticOrder S; S.init(MTOK, NQKV, gridDim.x, bx);
                pg8::EpiMixIn E{WSP(bf16, WS_P1), WSP(long long, WS_SS) + (size_t)j * MTOK};
                pg8::gemm_phase<pg8::EpiMixIn, pg8::StaticOrder, PG8_ALIGN, PG8_SP2>(lds, gm, S, E); }
            PH(base + 1) { TID(); KArgs ka = kargs();
                if constexpr (kind == 0) for (int rep = 0; rep < REP_MLSTM; ++rep) mlstm_pre(lds, WSP(bf16, WS_P1), WSP(float, WS_G), ka->in[6] + ji * 16, WSP(unsigned char, WS_ACT), tid, lane, wave, bx);
                else if constexpr (kind == 1) { fox_cf(lds, WSP(float, WS_G), ka->in[10] + ji * 16, WSP(float, WS_CF), tid, lane, wave, bx); }
                else for (int rep = 0; rep < REP_GLA; ++rep) gla_pre(lds, WSP(bf16, WS_P1), WSP(float, WS_G), ka->in[13] + (size_t)ji * 16 * 1024, ka->in[14] + ji * 1024, WSP(unsigned char, WS_ACT), tid, lane, wave, bx);
            }
            PH(base + 2) { TID(); KArgs ka = kargs();
                if constexpr (kind == 0) for (int rep = 0; rep < REP_MLSTM; ++rep) mlstm_scan2(lds, WSP(bf16, WS_P1), WSP(unsigned char, WS_ACT), WSP(bf16, WS_HRAW), tid, lane, wave, bx);
                else if constexpr (kind == 1) for (int rep = 0; rep < REP_FOX; ++rep) fox_attn2(lds, WSP(bf16, WS_P1), WSP(float, WS_CF), WSP(bf16, WS_HM), tid, lane, wave, bx);
                else for (int rep = 0; rep < REP_GLA; ++rep) gla_scan2(lds, WSP(bf16, WS_P1), WSP(unsigned char, WS_ACT), WSP(bf16, WS_HRAW), tid, lane, wave, bx);
            }
            if constexpr (kind != 1) { PH(base + 3) { TID(); KArgs ka = kargs();
                if constexpr (kind == 0) headnorm_gate<256, 0>(WSP(bf16, WS_HRAW), WSP(bf16, WS_P1), ka->in[7] + ji * DM, WSP(bf16, WS_HM), lane, wave, bx);
                else headnorm_gate<512, 1>(WSP(bf16, WS_HRAW), WSP(bf16, WS_P1), ka->in[15] + ji * DM, WSP(bf16, WS_HM), lane, wave, bx);
            } }
        }
        PH(base + 4) { TID(); KArgs ka = kargs();
            pg8::Gemm gm; float scale;
            if constexpr (typ != 1) { const int mi = layer * 2 + (typ >> 1); gm = pg8::Gemm{WSP(bf16, WS_ACT), WSP(bf16, WS_WDN) + (size_t)mi * DM * DFF, MTOK, DM, DFF}; scale = 0.5f; }
            else { gm = pg8::Gemm{WSP(bf16, WS_HM), WSP(bf16, WS_WOUT) + (size_t)layer * DM * DM, MTOK, DM, DM}; scale = 1.0f; }
            pg8::StaticOrder S; S.init(MTOK, DM, gridDim.x, bx);
            pg8::EpiResid E{WSP(bf16, WS_HB), WSP(long long, WS_SS) + (size_t)(j + 1) * MTOK, scale};
            pg8::gemm_phase<pg8::EpiResid, pg8::StaticOrder, PG8_ALIGN, PG8_SP2>(lds, gm, S, E);
        }
    }
}

__global__ void __launch_bounds__(NWAVES * 64, 2) trunk_fwd(Args args) {
    extern __shared__ __attribute__((aligned(16))) unsigned char lds_raw[];
    LAS unsigned char* lds = (LAS unsigned char*)lds_raw;
    volatile LAS unsigned* MISC = (volatile LAS unsigned*)(lds + MISC_OFF);
    for (int u = threadIdx.x; u < (LDS_BYTES - MISC_OFF) / 4; u += NWAVES * 64) ((LAS unsigned*)(lds + MISC_OFF))[u] = 0u;
    __syncthreads();
    XcdBarrier bar = xcd_barrier_post((unsigned*)(args.ws + WS_CTL) + CW_BAR, MISC + 8);
    const int lo = args.ph_lo, hi = args.ph_hi; bool ran = false;

    PH(0) { TID(); for (int rep = 0; rep < REP_PRO; ++rep) { prologue(lds, lane, wave, bx); __syncthreads(); } }

    subblock<0>(lds, bar, lo, hi, ran); subblock<1>(lds, bar, lo, hi, ran); subblock<2>(lds, bar, lo, hi, ran); subblock<3>(lds, bar, lo, hi, ran);
    subblock<4>(lds, bar, lo, hi, ran); subblock<5>(lds, bar, lo, hi, ran); subblock<6>(lds, bar, lo, hi, ran); subblock<7>(lds, bar, lo, hi, ran);
    subblock<8>(lds, bar, lo, hi, ran); subblock<9>(lds, bar, lo, hi, ran); subblock<10>(lds, bar, lo, hi, ran); subblock<11>(lds, bar, lo, hi, ran);
    PH(NPHASE - 1) { TID(); KArgs ka = kargs(); final_norm(ka->out, WSP(bf16, WS_HB), WSP(long long, WS_SS) + (size_t)NSUB * MTOK, ka->in[17], lane, wave, bx); }
#undef WSP
#undef PH
}

static bool phase_exists(int p) {
    if (p == 0 || p == NPHASE - 1) return true;
    const int j = (p - 1) / 5, k = (p - 1) % 5, typ = j % 3;
    if (k == 0 || k == 4) return true;
    if (typ != 1) return false;
    if (k == 3) return ((j / 3) % 3) != 1;
    return true;
}
extern "C" void kernel_launch(void* const* d_in, const int* in_sizes, int n_in, void* d_out, int out_size, void* d_ws, size_t ws_size, hipStream_t stream) {
    static int grid = 0;
    if (grid == 0) {
        if (n_in != 18 || in_sizes[0] != MTOK * DM || out_size != MTOK * DM || ws_size < WS_END) { fprintf(stderr, "kernel_launch: unexpected shapes (n_in %d, in0 %d, out %d, ws %zu < %zu)\n", n_in, n_in > 0 ? in_sizes[0] : -1, out_size, ws_size, (size_t)WS_END); grid = -1; return; }
        int dev = 0, cus = 0, per_cu = 0;
        if (hipGetDevice(&dev) != hipSuccess || hipDeviceGetAttribute(&cus, hipDeviceAttributeMultiprocessorCount, dev) != hipSuccess) { grid = -1; return; }
        if (hipFuncSetAttribute((const void*)trunk_fwd, hipFuncAttributeMaxDynamicSharedMemorySize, LDS_BYTES) != hipSuccess) { fprintf(stderr, "kernel_launch: hipFuncSetAttribute failed\n"); grid = -1; return; }
        if (hipOccupancyMaxActiveBlocksPerMultiprocessor(&per_cu, (const void*)trunk_fwd, NWAVES * 64, LDS_BYTES) != hipSuccess || per_cu < 1) fprintf(stderr, "kernel_launch: occupancy query says %d\n", per_cu);
        (void)hipGetLastError();
        grid = cus;
    }
    if (grid < 0) return;
    if (hipMemsetAsync((char*)d_ws + WS_CTL, 0, CTL_ZERO_BYTES, stream) != hipSuccess) return;
    Args a{};
    for (int i = 0; i < 18; ++i) a.in[i] = (const float*)d_in[i];
    a.out = (float*)d_out; a.ws = (unsigned char*)d_ws;
#if MK_PER_PHASE
    for (int p = 0; p < NPHASE; ++p) { if (!phase_exists(p)) continue; a.ph_lo = p; a.ph_hi = p + 1; hipLaunchKernelGGL(trunk_fwd, dim3(grid), dim3(NWAVES * 64), LDS_BYTES, stream, a); }
#else
    a.ph_lo = 0; a.ph_hi = NPHASE; hipLaunchKernelGGL(trunk_fwd, dim3(grid), dim3(NWAVES * 64), LDS_BYTES, stream, a);
#endif
    (void)phase_exists;
}
```

```cpp
#include <hip/hip_runtime.h>
#include <cstdio>
#include <cstdint>
namespace pg8 {
#define PG8_LAS __attribute__((address_space(3)))
typedef unsigned short bf16_t;
typedef short bf16x8 __attribute__((ext_vector_type(8)));
typedef float f32x4 __attribute__((ext_vector_type(4)));
typedef unsigned u32x4 __attribute__((ext_vector_type(4)));
constexpr int BM = 256, BK = 64, HALF = 128, HTB = HALF * BK * 2  , STAGE_BYTES = 8 * HTB, NXCD = 8, WGM = 8;

__host__ __device__ __forceinline__ int lds_byte(int r, int c) { const int st = (r >> 4) * 2 + (c >> 5), rr = r & 15, cc = c & 31, ob = rr * 64 + cc * 2; return st * 1024 + (ob ^ (((ob >> 9) & 1) << 5)); }
__host__ __device__ __forceinline__ void stage_rc(int b, int& R, int& C) { const int st = b / 1024, sb = b % 1024, swz = sb ^ (((sb >> 9) & 1) << 5); R = (st >> 1) * 16 + swz / 64; C = (st & 1) * 32 + (swz % 64) / 2; }
__host__ __device__ __forceinline__ int perm32(int rho) { const int n = rho >> 4, i = rho & 15; return 8 * (i >> 2) + 4 * n + (i & 3); }

struct Unit { int pm, pn; };
struct Gemm { const bf16_t* A; const bf16_t* Bt; int M, N, K; };

struct StaticOrder {
    int nM, nN, nwg, G, c;
    __host__ __device__ void init(int M, int N, int G_, int c_) { nM = M / BM; nN = N / BM; nwg = nM * nN; G = G_; c = c_; }
    __host__ __device__ bool next(int i, Unit& u) const {
        const long L = (long)i * G + c; if (L >= nwg) return false;
        int wgid = (int)L; { const int q = nwg / NXCD, r = nwg % NXCD, xcd = wgid % NXCD, off = wgid / NXCD; wgid = (xcd < r ? xcd * (q + 1) : r * (q + 1) + (xcd - r) * q) + off; }
        const int nig = WGM * nN, gid = wgid / nig, fm = gid * WGM, gsz = (nM - fm) < WGM ? (nM - fm) : WGM;
        u.pm = fm + ((wgid % nig) % gsz); u.pn = (wgid % nig) / gsz; return true;
    }
    __device__ __forceinline__ void a_ready(const Unit&) const {}
    __device__ __forceinline__ void done(const Unit&) const {}
};

__device__ __forceinline__ unsigned cvt_pk_bf16(float lo, float hi) { unsigned r; asm volatile("v_cvt_pk_bf16_f32 %0, %1, %2" : "=v"(r) : "v"(lo), "v"(hi)); return r; }
constexpr float RMS_EPS_F = 1e-6f, SS_FIX = 1048576.0f, SS_UNFIX_D = 1.0f / (1048576.0f * 2048.0f);
typedef long long ss_t;
__device__ __forceinline__ float rstd_of(const ss_t* ss, int row) { return rsqrtf((float)ss[row] * SS_UNFIX_D + RMS_EPS_F); }
template <class Sched> __device__ __forceinline__ int rstd_table_fill(const Sched& S, const ss_t* ss, PG8_LAS unsigned char* ext, int tid) {
    PG8_LAS float* tab = (PG8_LAS float*)ext; int key0 = -1, key1 = -1, bad = 0; Unit u;
    for (int i = 0; S.next(i, u); ++i) { const int slot = (u.pm >> 3) & 1; const int key = slot ? key1 : key0;
        if (key == u.pm) continue;
        if (key >= 0) { bad = 1; continue; }
        if (slot) key1 = u.pm; else key0 = u.pm;
        if (tid < 256) tab[slot * 256 + tid] = rstd_of(ss, u.pm * BM + tid); }
    asm volatile("s_waitcnt lgkmcnt(0)" ::: "memory"); __builtin_amdgcn_s_barrier(); asm volatile("" ::: "memory");
    return bad;
}
__device__ __forceinline__ float rstd_get(const ss_t* ss, const Unit& u, int row, int pf, const PG8_LAS unsigned char* ext) {
    return pf ? rstd_of(ss, row) : ((const PG8_LAS float*)ext)[((u.pm >> 3) & 1) * 256 + (row - u.pm * BM)];
}
struct EpiSwiGLU {
    static constexpr bool PERM = true, AFTER_DRAIN = false;
    bf16_t* O; const ss_t* ss; int ldo;
    template <class Sched> __device__ __forceinline__ int prepare(const Sched& S, PG8_LAS unsigned char* ext, int tid) const { return rstd_table_fill(S, ss, ext, tid); }
    __device__ __forceinline__ void operator()(const f32x4 (&acc)[2][2][4][2], const Unit& u, int wr, int wc, int fr, int fq, int pf, const PG8_LAS unsigned char* ext) const {
        const int row0 = u.pm * BM + wr * 64 + fr, col0 = u.pn * HALF + wc * 32 + 8 * fq;
#pragma unroll
        for (int ai = 0; ai < 2; ++ai)
#pragma unroll
            for (int m = 0; m < 4; ++m) {
                const int row = row0 + ai * HALF + m * 16;
                const float rs = rstd_get(ss, u, row, pf, ext), c1 = -1.4426950408889634f * rs, rs2 = rs * rs;
                float o[8];
#pragma unroll
                for (int n = 0; n < 2; ++n) { const f32x4 p4 = acc[ai][0][m][n] * acc[ai][1][m][n] * rs2;
#pragma unroll
                    for (int j = 0; j < 4; ++j) o[4 * n + j] = p4[j] * __builtin_amdgcn_rcpf(1.0f + __builtin_amdgcn_exp2f(acc[ai][0][m][n][j] * c1)); }
                u32x4 w; w.x = cvt_pk_bf16(o[0], o[1]); w.y = cvt_pk_bf16(o[2], o[3]); w.z = cvt_pk_bf16(o[4], o[5]); w.w = cvt_pk_bf16(o[6], o[7]);
                *(u32x4*)(O + (size_t)row * ldo + col0) = w;
            }
    }
};
struct EpiMixIn {
    static constexpr bool PERM = true, AFTER_DRAIN = false;
    bf16_t* O; const ss_t* ss;
    template <class Sched> __device__ __forceinline__ int prepare(const Sched& S, PG8_LAS unsigned char* ext, int tid) const { return rstd_table_fill(S, ss, ext, tid); }
    __device__ __forceinline__ void operator()(const f32x4 (&acc)[2][2][4][2], const Unit& u, int wr, int wc, int fr, int fq, int pf, const PG8_LAS unsigned char* ext) const {
        const int row0 = u.pm * BM + wr * 64 + fr, col0 = u.pn * BM + wc * 32 + 8 * fq;
#pragma unroll
        for (int ai = 0; ai < 2; ++ai)
#pragma unroll
            for (int m = 0; m < 4; ++m) {
                const int row = row0 + ai * HALF + m * 16;
                const float rs = rstd_get(ss, u, row, pf, ext);
#pragma unroll
                for (int bj = 0; bj < 2; ++bj) { const f32x4 v0 = acc[ai][bj][m][0] * rs, v1 = acc[ai][bj][m][1] * rs;
                    u32x4 w; w.x = cvt_pk_bf16(v0[0], v0[1]); w.y = cvt_pk_bf16(v0[2], v0[3]); w.z = cvt_pk_bf16(v1[0], v1[1]); w.w = cvt_pk_bf16(v1[2], v1[3]);
                    *(u32x4*)(O + (size_t)row * 6144 + col0 + bj * HALF) = w; }
            }
    }
};
struct EpiResid {
    static constexpr bool PERM = true, AFTER_DRAIN = false;
    bf16_t* hb; ss_t* ssn; float scale;
    template <class Sched> __device__ __forceinline__ int prepare(const Sched&, PG8_LAS unsigned char*, int) const { return 0; }
    __device__ __forceinline__ void operator()(const f32x4 (&acc)[2][2][4][2], const Unit& u, int wr, int wc, int fr, int fq, int pf, const PG8_LAS unsigned char* ext) const {
        const int row0 = u.pm * BM + wr * 64 + fr, col0 = u.pn * BM + wc * 32 + 8 * fq;
        u32x4 rb[3][2];
#define PG8_LDG(gi, buf) do { const size_t off_ = (size_t)(row0 + ((gi) >> 2) * HALF + ((gi) & 3) * 16) * 2048 + col0; \
            _Pragma("unroll") for (int q_ = 0; q_ < 2; ++q_) buf[q_] = *(const u32x4*)(hb + off_ + q_ * HALF); } while (0)
        PG8_LDG(0, rb[0]); PG8_LDG(1, rb[1]);
#pragma unroll
        for (int gi = 0; gi < 8; ++gi) {
            if (gi + 2 < 8) PG8_LDG(gi + 2, rb[(gi + 2) % 3]);
            const int ai = gi >> 2, m = gi & 3;
            const int row = row0 + ai * HALF + m * 16; const size_t off = (size_t)row * 2048 + col0; float sq = 0.f;
#pragma unroll
            for (int bj = 0; bj < 2; ++bj) { const u32x4 hw = rb[gi % 3][bj];
                const f32x4 h0 = (f32x4){__uint_as_float(hw.x << 16), __uint_as_float(hw.x & 0xffff0000u), __uint_as_float(hw.y << 16), __uint_as_float(hw.y & 0xffff0000u)};
                const f32x4 h1 = (f32x4){__uint_as_float(hw.z << 16), __uint_as_float(hw.z & 0xffff0000u), __uint_as_float(hw.w << 16), __uint_as_float(hw.w & 0xffff0000u)};
                const f32x4 n0 = h0 + acc[ai][bj][m][0] * scale, n1 = h1 + acc[ai][bj][m][1] * scale;
                u32x4 w; w.x = cvt_pk_bf16(n0[0], n0[1]); w.y = cvt_pk_bf16(n0[2], n0[3]); w.z = cvt_pk_bf16(n1[0], n1[1]); w.w = cvt_pk_bf16(n1[2], n1[3]);
                *(u32x4*)(hb + off + bj * HALF) = w;
                const float r0 = __uint_as_float(w.x << 16), r1 = __uint_as_float(w.x & 0xffff0000u), r2 = __uint_as_float(w.y << 16), r3 = __uint_as_float(w.y & 0xffff0000u);
                const float r4 = __uint_as_float(w.z << 16), r5 = __uint_as_float(w.z & 0xffff0000u), r6 = __uint_as_float(w.w << 16), r7 = __uint_as_float(w.w & 0xffff0000u);
                sq += ((r0 * r0 + r1 * r1) + (r2 * r2 + r3 * r3)) + ((r4 * r4 + r5 * r5) + (r6 * r6 + r7 * r7)); }
            sq += __shfl_xor(sq, 16); sq += __shfl_xor(sq, 32);
            if (fq == 0) atomicAdd((unsigned long long*)(ssn + row), (unsigned long long)__float2ll_rn(sq * SS_FIX));
        }
#undef PG8_LDG
    }
};

template <class Epi, class Sched, bool ALIGN_EPI = false, bool SP2 = false>
__device__ __forceinline__ void gemm_phase(PG8_LAS unsigned char* lds, const Gemm g, const Sched& S, const Epi& E) {
    int tid_ = threadIdx.x; asm volatile("" : "+v"(tid_));
    const int tid = tid_, wid = __builtin_amdgcn_readfirstlane(tid >> 6), lane = tid & 63, wr = wid >> 2, wc = wid & 3, fr = lane & 15, fq = lane >> 4;
    const int K = g.K, nt = K / BK;
    unsigned voffA[2], voffB[2];
#pragma unroll
    for (int i = 0; i < 2; ++i) { int R, C; stage_rc(tid * 16 + i * 8192, R, C); const int Rb = Epi::PERM ? ((R & ~31) + perm32(R & 31)) : R;
        voffA[i] = (unsigned)(R * K + C) * 2u; voffB[i] = (unsigned)(Rb * K + C) * 2u; }
    const size_t kstep = (size_t)(BK * 2);
    const size_t hstep = (size_t)HALF * K * 2;
    const size_t tstep = 2 * hstep;
    const unsigned ldsw = (unsigned)wid * 1024u;
    const int aoff = lds_byte(wr * 64 + fr, fq * 8), boff = lds_byte(wc * 32 + fr, fq * 8);
#define PG8_SA(b, h) (((b) * 2 + (h)) * HTB)
#define PG8_SB(b, h) ((4 + (b) * 2 + (h)) * HTB)
#define PG8_STAGE(bufoff, gbase, voff) do { _Pragma("unroll") for (int _i = 0; _i < 2; ++_i) \
        __builtin_amdgcn_global_load_lds((const unsigned*)((const char*)(gbase) + (voff)[_i]), (PG8_LAS unsigned*)(lds + (bufoff) + ldsw + _i * 8192), 16, 0, 0); } while (0)
#define PG8_LDA(dst, b, h) do { _Pragma("unroll") for (int m = 0; m < 4; ++m) _Pragma("unroll") for (int k = 0; k < 2; ++k) dst[m][k] = *(const PG8_LAS bf16x8*)(lds + PG8_SA(b, h) + aoff + m * 2048 + k * 1024); } while (0)
#define PG8_LDB(dst, b, h) do { _Pragma("unroll") for (int n = 0; n < 2; ++n) _Pragma("unroll") for (int k = 0; k < 2; ++k) dst[n][k] = *(const PG8_LAS bf16x8*)(lds + PG8_SB(b, h) + boff + n * 2048 + k * 1024); } while (0)
#define PG8_MMA(ai, bj, At, Bt) do { __builtin_amdgcn_s_setprio(1); _Pragma("unroll") for (int m = 0; m < 4; ++m) _Pragma("unroll") for (int n = 0; n < 2; ++n) _Pragma("unroll") for (int k = 0; k < 2; ++k) \
        acc[ai][bj][m][n] = __builtin_amdgcn_mfma_f32_16x16x32_bf16(Bt[n][k], At[m][k], acc[ai][bj][m][n], 0, 0, 0); __builtin_amdgcn_s_setprio(0); } while (0)
#define PG8_WAIT_V(n) asm volatile("s_waitcnt vmcnt(" #n ")" ::: "memory")
#define PG8_WAIT_L(n) asm volatile("s_waitcnt lgkmcnt(" #n ")" ::: "memory")
#define PG8_BAR __builtin_amdgcn_s_barrier()
#define PG8_SCHED __builtin_amdgcn_sched_barrier(0)
    const int pf = E.prepare(S, lds + STAGE_BYTES, tid);
    Unit cur, nxt; int ui = 0;
    if (!S.next(0, cur)) return;
    f32x4 acc[2][2][4][2];
#pragma unroll
    for (int a = 0; a < 2; ++a)
#pragma unroll
        for (int b = 0; b < 2; ++b)
#pragma unroll
            for (int m = 0; m < 4; ++m)
#pragma unroll
                for (int n = 0; n < 2; ++n) acc[a][b][m][n] = (f32x4){0.f, 0.f, 0.f, 0.f};
    bf16x8 At[4][2], B0[2][2], B1[2][2];
    const char* cA = (const char*)g.A + (size_t)cur.pm * tstep; const char* cB = (const char*)g.Bt + (size_t)cur.pn * tstep;
    S.a_ready(cur);
    if constexpr (SP2) {
        PG8_STAGE(PG8_SB(0, 0), cB, voffB); PG8_STAGE(PG8_SB(0, 1), cB + hstep, voffB); PG8_STAGE(PG8_SA(0, 0), cA, voffA); PG8_STAGE(PG8_SA(0, 1), cA + hstep, voffA);
        if (wr == 1) PG8_BAR;
        PG8_WAIT_V(2); PG8_BAR;
        PG8_STAGE(PG8_SB(1, 0), cB + kstep, voffB); PG8_STAGE(PG8_SA(1, 0), cA + kstep, voffA); PG8_STAGE(PG8_SB(1, 1), cB + hstep + kstep, voffB);
        PG8_WAIT_V(6); PG8_BAR;
    } else {
        PG8_STAGE(PG8_SB(0, 0), cB, voffB); PG8_STAGE(PG8_SA(0, 0), cA, voffA); PG8_STAGE(PG8_SB(0, 1), cB + hstep, voffB); PG8_STAGE(PG8_SA(0, 1), cA + hstep, voffA);
        if (wr == 1) PG8_BAR;
        PG8_WAIT_V(4); PG8_BAR;
        PG8_STAGE(PG8_SB(1, 0), cB + kstep, voffB); PG8_STAGE(PG8_SA(1, 0), cA + kstep, voffA); PG8_STAGE(PG8_SB(1, 1), cB + hstep + kstep, voffB);
        PG8_WAIT_V(6); PG8_BAR;
    }
    for (;;) {
        const bool has_next = S.next(ui + 1, nxt);
        const char* nA = has_next ? (const char*)g.A + (size_t)nxt.pm * tstep : cA; const char* nB = has_next ? (const char*)g.Bt + (size_t)nxt.pn * tstep : cB;
        for (int t = 0; t < nt; t += 2) {
            const bool last = (t == nt - 2);
            const char* a1 = cA + (size_t)(t + 1) * kstep;
            const char* a2 = last ? nA : cA + (size_t)(t + 2) * kstep; const char* b2 = last ? nB : cB + (size_t)(t + 2) * kstep;
            const char* a3 = a2 + kstep; const char* b3 = b2 + kstep;
            if (last && has_next) S.a_ready(nxt);
            if constexpr (SP2) {
            PG8_LDB(B0, 0, 0); PG8_LDB(B1, 0, 1); PG8_SCHED; PG8_LDA(At, 0, 0); PG8_STAGE(PG8_SA(1, 1), a1 + hstep, voffA);
            PG8_WAIT_V(8); PG8_WAIT_L(0); PG8_BAR; PG8_MMA(0, 0, At, B0); PG8_MMA(0, 1, At, B1); PG8_BAR; PG8_SCHED;
            PG8_LDA(At, 0, 1); PG8_STAGE(PG8_SB(0, 0), b2, voffB); PG8_STAGE(PG8_SB(0, 1), b2 + hstep, voffB); PG8_STAGE(PG8_SA(0, 0), a2, voffA);
            PG8_WAIT_V(8); PG8_WAIT_L(0); PG8_BAR; PG8_MMA(1, 0, At, B0); PG8_MMA(1, 1, At, B1); PG8_BAR; PG8_SCHED;
            PG8_LDB(B0, 1, 0); PG8_LDB(B1, 1, 1); PG8_SCHED; PG8_LDA(At, 1, 0); PG8_STAGE(PG8_SA(0, 1), a2 + hstep, voffA);
            PG8_WAIT_V(8); PG8_WAIT_L(0); PG8_BAR; PG8_MMA(0, 0, At, B0); PG8_MMA(0, 1, At, B1); PG8_BAR; PG8_SCHED;
            PG8_LDA(At, 1, 1); PG8_STAGE(PG8_SB(1, 0), b3, voffB); PG8_STAGE(PG8_SB(1, 1), b3 + hstep, voffB); PG8_STAGE(PG8_SA(1, 0), a3, voffA);
            PG8_WAIT_V(8); PG8_WAIT_L(0); PG8_BAR; PG8_MMA(1, 0, At, B0); PG8_MMA(1, 1, At, B1); PG8_BAR; PG8_SCHED;
            } else {
            PG8_LDB(B0, 0, 0); PG8_SCHED; PG8_LDA(At, 0, 0); PG8_STAGE(PG8_SA(1, 1), a1 + hstep, voffA);
            PG8_WAIT_L(8); PG8_BAR; PG8_WAIT_L(0); PG8_MMA(0, 0, At, B0); PG8_BAR; PG8_SCHED;
            PG8_LDB(B1, 0, 1); PG8_STAGE(PG8_SB(0, 0), b2, voffB);
            PG8_BAR; PG8_WAIT_L(0); PG8_MMA(0, 1, At, B1); PG8_BAR;
            PG8_LDA(At, 0, 1); PG8_STAGE(PG8_SA(0, 0), a2, voffA);
            PG8_BAR; PG8_WAIT_L(0); PG8_MMA(1, 0, At, B0); PG8_BAR; PG8_SCHED;
            PG8_STAGE(PG8_SB(0, 1), b2 + hstep, voffB);
            PG8_WAIT_V(6); PG8_BAR; PG8_MMA(1, 1, At, B1); PG8_BAR;
            PG8_LDB(B0, 1, 0); PG8_SCHED; PG8_LDA(At, 1, 0); PG8_STAGE(PG8_SA(0, 1), a2 + hstep, voffA);
            PG8_WAIT_L(8); PG8_BAR; PG8_WAIT_L(0); PG8_MMA(0, 0, At, B0); PG8_BAR; PG8_SCHED;
            PG8_LDB(B1, 1, 1); PG8_STAGE(PG8_SB(1, 0), b3, voffB);
            PG8_BAR; PG8_WAIT_L(0); PG8_MMA(0, 1, At, B1); PG8_BAR;
            PG8_LDA(At, 1, 1); PG8_STAGE(PG8_SA(1, 0), a3, voffA);
            PG8_BAR; PG8_WAIT_L(0); PG8_MMA(1, 0, At, B0); PG8_BAR; PG8_SCHED;
            PG8_STAGE(PG8_SB(1, 1), b3 + hstep, voffB);
            PG8_WAIT_V(6); PG8_BAR; PG8_MMA(1, 1, At, B1); PG8_BAR;
            }
        }
        if constexpr (ALIGN_EPI) { if (wr == 0) PG8_BAR; }
        if constexpr (!Epi::AFTER_DRAIN) { E(acc, cur, wr, wc, fr, fq, pf, lds + STAGE_BYTES); S.done(cur); }
        if (!has_next) break;
#pragma unroll
        for (int a = 0; a < 2; ++a)
#pragma unroll
            for (int b = 0; b < 2; ++b)
#pragma unroll
                for (int m = 0; m < 4; ++m)
#pragma unroll
                    for (int n = 0; n < 2; ++n) acc[a][b][m][n] = (f32x4){0.f, 0.f, 0.f, 0.f};
        cur = nxt; cA = nA; cB = nB; ++ui;
        if constexpr (ALIGN_EPI) { if (wr == 1) PG8_BAR; }
    }
    PG8_WAIT_V(0);
    if constexpr (!ALIGN_EPI) { if (wr == 0) PG8_BAR; }
    PG8_BAR;
    if constexpr (Epi::AFTER_DRAIN) { E.fused(acc, cur, wr, wc, fr, fq, lds, wid, lane); S.done(cur); }
#undef PG8_SA
#undef PG8_SB
#undef PG8_STAGE
#undef PG8_LDA
#undef PG8_LDB
#undef PG8_MMA
#undef PG8_WAIT_V
#undef PG8_WAIT_L
#undef PG8_BAR
#undef PG8_SCHED
}
}

#ifndef PG8_SP2
#define PG8_SP2 true
#endif
#ifndef PG8_ALIGN
#define PG8_ALIGN true
#endif
#ifndef REP_PRO
#define REP_PRO 1
#endif
#ifndef REP_MLSTM
#define REP_MLSTM 1
#endif
#ifndef REP_FOX
#define REP_FOX 1
#endif
#ifndef REP_GLA
#define REP_GLA 1
#endif
#ifndef MK_PER_PHASE
#define MK_PER_PHASE 0
#endif

constexpr int DM = 2048, BATCH = 8, SEQ = 4096, MTOK = BATCH * SEQ, DEPTH = 4, DFF = 5632, NUP = 2 * DFF, NIN = 6160, NINP = 6400, NQKV = 6144;
constexpr int NWAVES = 8;
constexpr int NSUB = 3 * DEPTH;
constexpr int NPHASE = 2 + 5 * NSUB;

constexpr size_t MiB = 1u << 20;
constexpr size_t WS_CTL = 0, CTL_ZERO_BYTES = 5 * MiB;
constexpr size_t WS_SS = 1 * MiB;
constexpr size_t WS_WUP = 8 * MiB;
constexpr size_t WS_WDN = WS_WUP + 352 * MiB;
constexpr size_t WS_WIN = WS_WDN + 176 * MiB;
constexpr size_t WS_WOUT = WS_WIN + 100 * MiB;
constexpr size_t WS_HB = WS_WOUT + 32 * MiB;
constexpr size_t WS_ACT = WS_HB + 128 * MiB;
constexpr size_t WS_P1 = WS_ACT + 352 * MiB;
constexpr size_t WS_G = WS_P1 + 384 * MiB;
constexpr size_t WS_HRAW = WS_G + 2 * MiB;
constexpr size_t WS_HM = WS_HRAW + 256 * MiB;
constexpr size_t WS_CF = WS_HM + 128 * MiB;
constexpr size_t WS_END = WS_CF + 2 * MiB;
static_assert((size_t)8 * NUP * DM * 2 == 352 * MiB && (size_t)8 * DM * DFF * 2 == 176 * MiB && (size_t)4 * NINP * DM * 2 == 100 * MiB, "weight regions");
static_assert((size_t)MTOK * DFF * 2 == 352 * MiB && (size_t)MTOK * NQKV * 2 == 384 * MiB && WS_SS + 13 * (size_t)MTOK * 8 <= CTL_ZERO_BYTES, "activation regions");
constexpr int CW_KMAX = 16384;
constexpr int CW_BAR = 4096;

constexpr int LDS_BYTES = 153600, MISC_OFF = 152576;

#define GAS __attribute__((address_space(1)))
#define LAS __attribute__((address_space(3)))
#define DI __device__ __forceinline__
typedef unsigned short bf16;
typedef unsigned v4u __attribute__((ext_vector_type(4)));
typedef unsigned v2u __attribute__((ext_vector_type(2)));
typedef float f32x4 __attribute__((ext_vector_type(4)));
typedef short bf16x8 __attribute__((ext_vector_type(8)));
typedef GAS unsigned gu32;
#define RLX_AGENT __ATOMIC_RELAXED, __HIP_MEMORY_SCOPE_AGENT
#define LDS_WAIT() asm volatile("s_waitcnt lgkmcnt(0)" ::: "memory")
DI unsigned f2bf(float f) { unsigned r; asm("v_cvt_pk_bf16_f32 %0, %1, %1" : "=v"(r) : "v"(f)); return r & 0xffffu; }
DI unsigned pk2(float lo, float hi) { unsigned r; asm("v_cvt_pk_bf16_f32 %0, %1, %2" : "=v"(r) : "v"(lo), "v"(hi)); return r; }
DI float bf2f(unsigned short v) { return __builtin_bit_cast(float, (unsigned)v << 16); }
DI float bflo(unsigned w) { return __builtin_bit_cast(float, w << 16); }
DI float bfhi(unsigned w) { return __builtin_bit_cast(float, w & 0xffff0000u); }
DI float logsig(float x) { return fminf(x, 0.f) - log1pf(expf(-fabsf(x))); }

#define XB_TMO      128
#define XB_XCNT(j)  (256  + 64 * (j))
#define XB_XSUB(j)  (1280 + 64 * (j))
#define XB_XGEN(j)  (2304 + 64 * (j))
#define XB_TOP      3328
#define XB_TOPGEN   3392
#define XCD_BAR_WORDS 3456
#define XB_SPIN_CAP (1u << 18)

__device__ __forceinline__ unsigned xb_ld(unsigned* p)              { return __hip_atomic_load(p, __ATOMIC_RELAXED, __HIP_MEMORY_SCOPE_AGENT); }
__device__ __forceinline__ unsigned xb_add(unsigned* p, unsigned v) { return __hip_atomic_fetch_add(p, v, __ATOMIC_RELAXED, __HIP_MEMORY_SCOPE_AGENT); }
__device__ __forceinline__ unsigned xb_xcc_id() { return (unsigned)__builtin_amdgcn_s_getreg((3 << 11) | 20) & 0xFu; }
#define XB_SPIN(cond, bar) do { unsigned _sp = 0; while (cond) { __builtin_amdgcn_s_sleep(1); \
    if ((++_sp & 255u) == 0u) { if (xb_ld(&(bar)[XB_TMO])) break; if (_sp > XB_SPIN_CAP) { atomicAdd(&(bar)[XB_TMO], 1u); break; } } } } while (0)

struct XcdBarrier {
    unsigned* bar; unsigned x;
    volatile LAS unsigned* st;
};

__device__ __forceinline__ XcdBarrier xcd_barrier_post(unsigned* bar, volatile LAS unsigned* st) {
    XcdBarrier b; b.bar = bar; b.x = xb_xcc_id(); b.st = st;
    if (threadIdx.x == 0) (void)xb_add(&bar[XB_XCNT(b.x)], 1u);
    return b;
}
__device__ __forceinline__ void xcd_barrier_complete(unsigned* bar, unsigned x, unsigned& nloc, unsigned& nx) {
    const unsigned G = gridDim.x * gridDim.y * gridDim.z;
    unsigned sum, cnt, mine, sp = 0u;
    for (;;) {
        sum = 0u; cnt = 0u; mine = 0u;
#pragma unroll
        for (unsigned j = 0; j < 16; ++j) { const unsigned c = xb_ld(&bar[XB_XCNT(j)]); sum += c; cnt += (c > 0u) ? 1u : 0u; mine = (j == x) ? c : mine; }
        if (sum == G) break;
        __builtin_amdgcn_s_sleep(1);
        if ((++sp & 255u) == 0u) { if (xb_ld(&bar[XB_TMO])) break; if (sp > XB_SPIN_CAP) { atomicAdd(&bar[XB_TMO], 1u); break; } }
    }
    nloc = mine > 0u ? mine : 1u; nx = cnt > 0u ? cnt : 1u;
}

__device__ __forceinline__ void xcd_barrier(const XcdBarrier& b) {
    asm volatile("s_waitcnt vmcnt(0)" ::: "memory");
    __syncthreads();
    if (threadIdx.x == 0) {
        unsigned* bar = b.bar;
        __builtin_amdgcn_s_waitcnt(0);
        unsigned nloc = b.st[0], nx = b.st[1];
        if (nloc == 0u) { xcd_barrier_complete(bar, b.x, nloc, nx); b.st[0] = nloc; b.st[1] = nx; }
        const unsigned old = xb_add(&bar[XB_XSUB(b.x)], 1u);
        const unsigned gen = old / nloc;
        if (old + 1u == (gen + 1u) * nloc) {
            __builtin_amdgcn_fence(__ATOMIC_RELEASE, "agent");
            asm volatile("s_waitcnt vmcnt(0)" ::: "memory");
            const unsigned og = xb_add(&bar[XB_TOP], 1u);
            const unsigned tg = og / nx;
            if (og + 1u == (tg + 1u) * nx) xb_add(&bar[XB_TOPGEN], 1u);
            else XB_SPIN(xb_ld(&bar[XB_TOPGEN]) == tg, bar);
            __builtin_amdgcn_fence(__ATOMIC_ACQUIRE, "agent");
            xb_add(&bar[XB_XGEN(b.x)], 1u);
            asm volatile("s_waitcnt vmcnt(0)" ::: "memory");
        } else {
            XB_SPIN(xb_ld(&bar[XB_XGEN(b.x)]) == gen, bar);
            __builtin_amdgcn_fence(__ATOMIC_ACQUIRE, "agent");
            asm volatile("s_waitcnt vmcnt(0)" ::: "memory");
        }
    }
    __syncthreads();
}


DI float wave_sum(float v) {
#pragma unroll
    for (int o = 1; o < 64; o <<= 1) v += __shfl_xor(v, o);
    return v;
}
DI float wave_max(float v) {
#pragma unroll
    for (int o = 1; o < 64; o <<= 1) v = fmaxf(v, __shfl_xor(v, o));
    return v;
}
DI float wave_incl_sum(float v, int lane) {
#pragma unroll
    for (int o = 1; o < 64; o <<= 1) { const float t = __shfl_up(v, o); if (lane >= o) v += t; }
    return v;
}
DI float wave_incl_max(float v, int lane) {
#pragma unroll
    for (int o = 1; o < 64; o <<= 1) { const float t = __shfl_up(v, o); if (lane >= o) v = fmaxf(v, t); }
    return v;
}

template <int L> DI int swx(int r) { return L == 64 ? ((r >> 1) & 7) : (r & 15); }
template <int L> DI int eoff(int r, int c) { return r * L + ((((c >> 3) ^ swx<L>(r)) << 3) | (c & 7)); }
template <int L> DI bf16x8 ldf(const LAS bf16* base, int r, int ch) { return *(const LAS bf16x8*)(base + r * L + ((ch ^ swx<L>(r)) << 3)); }
DI f32x4 mfma16(bf16x8 a, bf16x8 b, f32x4 c) { return __builtin_amdgcn_mfma_f32_16x16x32_bf16(a, b, c, 0, 0, 0); }
typedef short v4i16_t __attribute__((ext_vector_type(4)));
DI v4i16_t tr_read(const LAS unsigned char* p) { return __builtin_amdgcn_ds_read_tr16_b64_v4i16((LAS v4i16_t*)p); }
DI bf16x8 cat4(v4i16_t lo, v4i16_t hi) { bf16x8 r; r[0] = lo[0]; r[1] = lo[1]; r[2] = lo[2]; r[3] = lo[3]; r[4] = hi[0]; r[5] = hi[1]; r[6] = hi[2]; r[7] = hi[3]; return r; }
DI unsigned off_v64(unsigned row, unsigned ch) { return 128u * row + 16u * (ch ^ ((((row >> 1) & 1u) << 1) | (((row >> 3) & 1u) << 2))); }
DI bf16x8 vfrag64(const LAS unsigned char* vb, int c, int ks, int lane) { const unsigned g = lane >> 4, q = (lane & 15) >> 2, p = lane & 3;
    return cat4(tr_read(vb + off_v64(32 * ks + 8 * g + q, 2 * c + (p >> 1)) + 8 * (p & 1)), tr_read(vb + off_v64(32 * ks + 8 * g + 4 + q, 2 * c + (p >> 1)) + 8 * (p & 1))); }
template <int LA, int LB, int NK> DI void mma_tile(f32x4& acc, const LAS bf16* A, int ra0, const LAS bf16* B, int rb0, int lane) {
    const int r = lane & 15, g = lane >> 4;
#pragma unroll
    for (int kk = 0; kk < NK; ++kk) { const bf16x8 a = ldf<LA>(A, ra0 + r, 4 * kk + g), b = ldf<LB>(B, rb0 + r, 4 * kk + g); acc = mfma16(a, b, acc); }
}

struct ConvItem { const float* W; const float* gk; bf16* WT; int K, N, mode, r; };
DI void conv_load(const ConvItem& c, int lane, f32x4 (&v)[8], float (&gv)[8]) {
    const int nkb = c.K / 64, nb = c.r / nkb, kb = c.r - nb * nkb, k0 = 64 * kb, n0 = 32 * nb;
    const int n = n0 + 4 * (lane & 7); const bool ok = n < c.N;
#pragma unroll
    for (int i = 0; i < 8; ++i) { const int kk = 8 * i + (lane >> 3); v[i] = ok ? *(const f32x4*)(c.W + (size_t)(k0 + kk) * c.N + n) : (f32x4){0.f, 0.f, 0.f, 0.f}; gv[i] = c.gk ? c.gk[k0 + kk] : 1.0f; }
}
DI void conv_store(const ConvItem& c, int lane, const f32x4 (&v)[8], const float (&gv)[8], LAS float* scr) {
    const int nkb = c.K / 64, nb = c.r / nkb, kb = c.r - nb * nkb, k0 = 64 * kb, n0 = 32 * nb, nq = 4 * (lane & 7);
#pragma unroll
    for (int i = 0; i < 8; ++i) { const int kk = 8 * i + (lane >> 3); LAS float* d = scr + kk * 33 + nq; d[0] = v[i].x * gv[i]; d[1] = v[i].y * gv[i]; d[2] = v[i].z * gv[i]; d[3] = v[i].w * gv[i]; }
    LDS_WAIT(); asm volatile("" ::: "memory");
    int row_off = n0;
    if (c.mode == 1) { const int j = n0 < DFF ? n0 : n0 - DFF; row_off = 256 * (j >> 7) + (j & 127) + (n0 < DFF ? 0 : 128); }
    const int cc = lane & 7;
#pragma unroll
    for (int j = 0; j < 4; ++j) { const int nn = (lane >> 3) + 8 * j; const LAS float* s = scr + (8 * cc) * 33 + nn;
        v4u o; o.x = pk2(s[0 * 33], s[1 * 33]); o.y = pk2(s[2 * 33], s[3 * 33]); o.z = pk2(s[4 * 33], s[5 * 33]); o.w = pk2(s[6 * 33], s[7 * 33]);
        *(v4u*)(c.WT + (size_t)(row_off + nn) * c.K + k0 + 8 * cc) = o; }
    LDS_WAIT(); asm volatile("" ::: "memory");
}

struct Args { const float* in[18]; float* out; unsigned char* ws; int ph_lo, ph_hi; };

typedef const __attribute__((address_space(4))) Args* KArgs;
DI KArgs kargs() { KArgs p = (KArgs)__builtin_amdgcn_kernarg_segment_ptr(); asm volatile("" : "+s"(p)); return p; }
DI void prologue(LAS unsigned char* lds, int lane, int wave, int bx) {
    KArgs AP = kargs();
    LAS float* scr = (LAS float*)(lds + wave * 16384);
    const int gw = bx * NWAVES + wave, NGW = gridDim.x * NWAVES;
    unsigned char* ws = AP->ws;
    constexpr int I_UP = (DM / 64) * (NUP / 32), I_DN = (DFF / 64) * (DM / 32), I_IN = (DM / 64) * (NINP / 32), I_OUT = (DM / 64) * (DM / 32);
    constexpr int NITEMS = 8 * I_UP + 8 * I_DN + 4 * I_IN + 4 * I_OUT;
#define CONV_DECODE(it_, c_) do { int r = (it_); (c_).gk = nullptr; (c_).K = DM; (c_).mode = 0; \
        if (r < 8 * I_UP) { const int mi = r / I_UP; r -= mi * I_UP; (c_).W = AP->in[2] + (size_t)mi * DM * NUP; (c_).gk = AP->in[1] + (size_t)mi * DM; (c_).WT = (bf16*)(ws + WS_WUP) + (size_t)mi * NUP * DM; (c_).N = NUP; (c_).mode = 1; } \
        else if (r < 8 * I_UP + 8 * I_DN) { r -= 8 * I_UP; const int mi = r / I_DN; r -= mi * I_DN; (c_).W = AP->in[3] + (size_t)mi * DFF * DM; (c_).WT = (bf16*)(ws + WS_WDN) + (size_t)mi * DM * DFF; (c_).K = DFF; (c_).N = DM; } \
        else if (r < 8 * I_UP + 8 * I_DN + 4 * I_IN) { r -= 8 * I_UP + 8 * I_DN; const int l = r / I_IN; r -= l * I_IN; const int kind = l % 3, ji = l / 3; \
            (c_).W = AP->in[kind == 0 ? 5 : kind == 1 ? 9 : 12] + (size_t)ji * DM * NIN; (c_).gk = AP->in[4] + (size_t)l * DM; (c_).WT = (bf16*)(ws + WS_WIN) + (size_t)l * NINP * DM; (c_).N = NIN; } \
        else { r -= 8 * I_UP + 8 * I_DN + 4 * I_IN; const int l = r / I_OUT; r -= l * I_OUT; const int kind = l % 3, ji = l / 3; \
            (c_).W = AP->in[kind == 0 ? 8 : kind == 1 ? 11 : 16] + (size_t)ji * DM * DM; (c_).WT = (bf16*)(ws + WS_WOUT) + (size_t)l * DM * DM; (c_).N = DM; } \
        (c_).r = r; } while (0)
    f32x4 va[8]; float ga[8]; ConvItem ca{}, cb{};
    if (gw < NITEMS) { CONV_DECODE(gw, ca); conv_load(ca, lane, va, ga); }
    for (int it = gw; it < NITEMS; it += NGW) {
        f32x4 vb[8]; float gb[8]; const int nx = it + NGW;
        if (nx < NITEMS) { CONV_DECODE(nx, cb); conv_load(cb, lane, vb, gb); }
        conv_store(ca, lane, va, ga, scr);
        ca = cb;
#pragma unroll
        for (int i = 0; i < 8; ++i) { va[i] = vb[i]; ga[i] = gb[i]; }
    }
#undef CONV_DECODE
    const float* x = AP->in[0]; bf16* hb = (bf16*)(ws + WS_HB); long long* ss0 = (long long*)(ws + WS_SS);
    for (int m = gw; m < MTOK; m += NGW) {
        const f32x4* xr = (const f32x4*)(x + (size_t)m * DM) + lane; f32x4 v[8]; float s = 0.f;
#pragma unroll
        for (int j = 0; j < 8; ++j) { v[j] = xr[64 * j]; s += (v[j].x * v[j].x + v[j].y * v[j].y) + (v[j].z * v[j].z + v[j].w * v[j].w); }
        s = wave_sum(s);
        v2u* o8 = (v2u*)(hb + (size_t)m * DM) + lane;
#pragma unroll
        for (int j = 0; j < 8; ++j) { v2u w; w.x = pk2(v[j].x, v[j].y); w.y = pk2(v[j].z, v[j].w); o8[64 * j] = w; }
        if (lane == 0) ss0[m] = __float2ll_rn(s * 1048576.0f);
    }
}

constexpr int IMGM_P = 0, IMGM_KT = 8192, IMGM_VT = IMGM_KT + 16384, IMGM_GS = IMGM_VT + 4 * 8192, IMGM_BYTES = IMGM_GS + 1024;
constexpr int IMGG_Q = 0, IMGG_KT = 32768, IMGG_P = 65536, IMGG_VT = IMGG_P + 8192, IMGG_EB = IMGG_VT + 8 * 8192, IMGG_BYTES = IMGG_EB + 1024;
static_assert((size_t)IMGM_BYTES * 4096 <= 352 * MiB && (size_t)IMGG_BYTES * 2048 <= 352 * MiB, "images overlay the (idle) FFN activation buffer");
DI unsigned pk2_sw(float lo, float hi) { unsigned a = __builtin_bit_cast(unsigned, lo), b = __builtin_bit_cast(unsigned, hi); a = (a + 0x7fffu + ((a >> 16) & 1u)) >> 16; b = (b + 0x7fffu + ((b >> 16) & 1u)) & 0xffff0000u; return a | b; }
DI float logsig_fast(float x) { return fminf(x, 0.f) - __logf(1.0f + __expf(-fabsf(x))); }

DI void mlstm_pre(LAS unsigned char* lds, const bf16* P1, const float* G, const float* b_if, unsigned char* img, int tid, int lane, int wave, int bx) {
    LAS bf16* Qs = (LAS bf16*)lds;
    LAS bf16* Ks = Qs + 64 * 128;
    LAS bf16* KTs = Ks + 64 * 128;
    LAS bf16* Ps = KTs + 128 * 64;
    LAS bf16* VT = Ps + 64 * 64;
    LAS float* fa = (LAS float*)(VT + 256 * 64);
    LAS float *bcum = fa, *ipre = fa + 64, *aloc = fa + 128, *wloc = fa + 192, *scal = fa + 256;
    const float KSCALE = 0.08838834764831845f;
    const int g = lane >> 4, r16 = lane & 15;
    v4u pq[2], pk[2]; float pgi = 0.f, pgf = 0.f;
#define MLP_LOAD(it_) do { const int b_ = (it_) >> 9, c_ = ((it_) >> 3) & 63, h_ = (it_) & 7; const int row0_ = b_ * SEQ + c_ * 64; \
        _Pragma("unroll") for (int p = 0; p < 2; ++p) { const int idx = tid + 512 * p, r = idx >> 4, c8 = idx & 15; const bf16* src = P1 + (size_t)(row0_ + r) * NQKV + h_ * 128 + c8 * 8; pq[p] = *(const v4u*)src; pk[p] = *(const v4u*)(src + 1024); } \
        if (tid < 64) { const float* gp = G + (size_t)(row0_ + tid) * 16; pgi = gp[h_]; pgf = gp[8 + h_]; } } while (0)
    if (bx < 4096) MLP_LOAD(bx);
    for (int item = bx; item < 4096; item += gridDim.x) {
        const int h = item & 7;
        unsigned char* im = img + (size_t)item * IMGM_BYTES;
        __syncthreads();
        if (tid < 64) { ipre[tid] = pgi + b_if[h]; bcum[tid] = logsig(pgf + b_if[8 + h]); }
#pragma unroll
        for (int p = 0; p < 2; ++p) { const int idx = tid + 512 * p, r = idx >> 4, c8 = idx & 15; *(LAS v4u*)(Qs + eoff<128>(r, c8 * 8)) = pq[p]; *(LAS v4u*)(Ks + eoff<128>(r, c8 * 8)) = pk[p]; }
        __syncthreads();
        if (wave == 0) {
            const float bt = wave_incl_sum(bcum[lane], lane), ip = ipre[lane];
            const float al = bt + wave_incl_max(ip - bt, lane);
            const float blast = __shfl(bt, 63);
            const float gg = blast - bt + ip;
            const float gmax = wave_max(gg);
            bcum[lane] = bt; aloc[lane] = al; wloc[lane] = __expf(gg - gmax);
            if (lane == 0) { scal[0] = blast; scal[1] = gmax; }
        }
        if (item + (int)gridDim.x < 4096) MLP_LOAD(item + (int)gridDim.x);
        __syncthreads();
#pragma unroll
        for (int p = 0; p < 2; ++p) { const int idx = tid + 512 * p, s = idx >> 4, c8 = idx & 15; const v4u kv = *(const LAS v4u*)(Ks + eoff<128>(s, c8 * 8)); const float w = wloc[s] * KSCALE;
#pragma unroll
            for (int j = 0; j < 4; ++j) { KTs[eoff<64>(c8 * 8 + 2 * j, s)] = (bf16)f2bf(bflo(kv[j]) * w); KTs[eoff<64>(c8 * 8 + 2 * j + 1, s)] = (bf16)f2bf(bfhi(kv[j]) * w); } }
        { const int tt = wave >> 1;
#pragma unroll
          for (int q2 = 0; q2 < 2; ++q2) { const int st = 2 * (wave & 1) + q2; f32x4 acc = (f32x4){0.f, 0.f, 0.f, 0.f};
            if (st <= tt) mma_tile<128, 128, 4>(acc, Qs, 16 * tt, Ks, 16 * st, lane);
            const int s = 16 * st + r16; const float cs = ipre[s] - bcum[s];
#pragma unroll
            for (int i = 0; i < 4; ++i) { const int t = 16 * tt + 4 * g + i; const float p = (s <= t) ? acc[i] * KSCALE * __expf(bcum[t] + cs - aloc[t]) : 0.f; Ps[eoff<64>(t, s)] = (bf16)f2bf(p); } } }
        __syncthreads();
        *(v4u*)(im + IMGM_P + tid * 16) = *(const LAS v4u*)((LAS unsigned char*)Ps + tid * 16);
#pragma unroll
        for (int p = 0; p < 2; ++p) *(v4u*)(im + IMGM_KT + (tid + 512 * p) * 16) = *(const LAS v4u*)((LAS unsigned char*)KTs + (tid + 512 * p) * 16);
        if (tid < 64) { float* gs = (float*)(im + IMGM_GS); gs[tid] = bcum[tid]; gs[64 + tid] = aloc[tid]; if (tid < 2) gs[128 + tid] = scal[tid]; }
    }
#undef MLP_LOAD
}

DI void mlstm_scan2(LAS unsigned char* lds, const bf16* P1, const unsigned char* img, bf16* hraw, int tid, int lane, int wave, int bx) {
    constexpr int IB = 8192 + 16384 + 16384 + 10240 + 1024;
    LAS bf16* CT0 = (LAS bf16*)(lds + 2 * IB);
    const int g = lane >> 4, r16 = lane & 15, tt = wave >> 1, eh = wave & 1;
    for (int item0 = bx; item0 < 256; item0 += gridDim.x) {
        const int item = (gridDim.x == 256) ? (item0 & 7) * 32 + (item0 >> 3) : item0;
        const int b = item >> 5, h = (item >> 2) & 7, sl = item & 3;
        f32x4 Cacc[5];
#pragma unroll
        for (int e = 0; e < 5; ++e) Cacc[e] = (f32x4){0.f, 0.f, 0.f, 0.f};
        __syncthreads();
        for (int i = tid; i < 2 * 80 * 128 / 8; i += 512) ((LAS v4u*)CT0)[i] = (v4u){0u, 0u, 0u, 0u};
        float m_prev = 0.f;
        v4u rp, rq[2], rk[2], rv; float rg0 = 0.f, rbl, rgm;
#define MLS_PREFETCH(cc) do { const int item2 = (b * 64 + (cc)) * 8 + h; const unsigned char* im = img + (size_t)item2 * IMGM_BYTES; const int row0_ = b * SEQ + (cc) * 64; \
            rp = *(const v4u*)(im + IMGM_P + tid * 16); rk[0] = *(const v4u*)(im + IMGM_KT + tid * 16); rk[1] = *(const v4u*)(im + IMGM_KT + (tid + 512) * 16); \
            rv = *(const v4u*)(P1 + (size_t)(row0_ + (tid >> 3)) * NQKV + 2048 + h * 256 + sl * 64 + (tid & 7) * 8); \
            _Pragma("unroll") for (int p = 0; p < 2; ++p) { const int idx = tid + 512 * p, r = idx >> 4, c8 = idx & 15; rq[p] = *(const v4u*)(P1 + (size_t)(row0_ + r) * NQKV + h * 128 + c8 * 8); } \
            const float* gs = (const float*)(im + IMGM_GS); if (tid < 128) rg0 = gs[tid]; rbl = gs[128]; rgm = gs[129]; } while (0)
#define MLS_STORE(bi) do { LAS unsigned char* bb = lds + (bi) * IB; \
            *(LAS v4u*)(bb + tid * 16) = rp; *(LAS v4u*)(bb + 8192 + 16384 + tid * 16) = rk[0]; *(LAS v4u*)(bb + 8192 + 16384 + (tid + 512) * 16) = rk[1]; \
            *(LAS v4u*)(bb + 8192 + 16384 + 16384 + off_v64(tid >> 3, tid & 7)) = rv; \
            _Pragma("unroll") for (int p = 0; p < 2; ++p) { const int idx = tid + 512 * p, r = idx >> 4, c8 = idx & 15; *(LAS v4u*)((LAS bf16*)(bb + 8192) + eoff<128>(r, c8 * 8)) = rq[p]; } \
            if (tid < 128) ((LAS float*)(bb + 8192 + 16384 + 16384 + 10240))[tid] = rg0; } while (0)
        MLS_PREFETCH(0); MLS_STORE(0);
        float blast = rbl, gmax = rgm;
        MLS_PREFETCH(1);
        __syncthreads();
        for (int c = 0; c < 64; ++c) {
            const int row0 = b * SEQ + c * 64;
            const LAS unsigned char* bb = lds + (c & 1) * IB;
            const LAS bf16* Ps = (const LAS bf16*)bb; const LAS bf16* Qs = (const LAS bf16*)(bb + 8192); const LAS bf16* KTs = (const LAS bf16*)(bb + 8192 + 16384);
            const LAS bf16* VTs = (const LAS bf16*)(bb + 8192 + 16384 + 16384); const LAS float* gsl = (const LAS float*)(bb + 8192 + 16384 + 16384 + 10240);
            LAS bf16* CTc = CT0 + (c & 1) * 80 * 128; LAS bf16* CTn = CT0 + ((c + 1) & 1) * 80 * 128;
            const int t = 16 * tt + r16;
            const float btv = gsl[t], alv = gsl[64 + t];
            const float mt = fmaxf(btv + m_prev, alv), al = __expf(alv - mt), be = __expf(btv + m_prev - mt), em = __expf(-mt);
            const float m_new = fmaxf(blast + m_prev, gmax), wcs = __expf(blast + m_prev - m_new), gam = __expf(gmax - m_new);
            m_prev = m_new;
            const LAS unsigned char* vb = (const LAS unsigned char*)VTs;
            bf16x8 onesf;
#pragma unroll
            for (int j = 0; j < 8; ++j) onesf[j] = (r16 == 0) ? (short)0x3f80 : (short)0;
            const bf16x8 pa0 = ldf<64>(Ps, 16 * tt + r16, g), pa1 = ldf<64>(Ps, 16 * tt + r16, 4 + g);
            f32x4 d1 = (f32x4){0.f, 0.f, 0.f, 0.f}, d2 = (f32x4){0.f, 0.f, 0.f, 0.f};
            d1 = mfma16(onesf, pa0, d1); d1 = mfma16(onesf, pa1, d1); mma_tile<128, 128, 4>(d2, CTc, 64, Qs, 16 * tt, lane);
            const float den = __shfl(al * d1[0] + be * d2[0], r16);
            const float dinv = __builtin_amdgcn_rcpf(fmaxf(fabsf(den), em));
#pragma unroll
            for (int q2 = 0; q2 < 2; ++q2) { const int et = 2 * eh + q2; f32x4 a1 = (f32x4){0.f, 0.f, 0.f, 0.f}, a2 = (f32x4){0.f, 0.f, 0.f, 0.f};
                a1 = mfma16(vfrag64(vb, et, 0, lane), pa0, a1); a1 = mfma16(vfrag64(vb, et, 1, lane), pa1, a1); mma_tile<128, 128, 4>(a2, CTc, 16 * et, Qs, 16 * tt, lane);
                const f32x4 o4 = (a1 * al + a2 * be) * dinv; v2u w; w.x = pk2(o4[0], o4[1]); w.y = pk2(o4[2], o4[3]);
                *(v2u*)(hraw + (size_t)(row0 + t) * DM + h * 256 + sl * 64 + 16 * et + 4 * g) = w; }
            const bf16x8 ka0 = ldf<64>(KTs, 16 * wave + r16, g), ka1 = ldf<64>(KTs, 16 * wave + r16, 4 + g);
#pragma unroll
            for (int et = 0; et < 5; ++et) { f32x4 tmp = (f32x4){0.f, 0.f, 0.f, 0.f};
                tmp = mfma16(ka0, et < 4 ? vfrag64(vb, et & 3, 0, lane) : onesf, tmp); tmp = mfma16(ka1, et < 4 ? vfrag64(vb, et & 3, 1, lane) : onesf, tmp);
                Cacc[et] = Cacc[et] * wcs + tmp * gam;
                v2u w; w.x = pk2(Cacc[et][0], Cacc[et][1]); w.y = pk2(Cacc[et][2], Cacc[et][3]);
                *(LAS v2u*)(CTn + eoff<128>(16 * et + r16, 16 * wave + 4 * g)) = w; }
            if (c + 1 < 64) { MLS_STORE((c + 1) & 1); blast = rbl; gmax = rgm; }
            if (c + 2 < 64) MLS_PREFETCH(c + 2);
            __syncthreads();
        }
#undef MLS_PREFETCH
#undef MLS_STORE
    }
}

DI void gla_pre(LAS unsigned char* lds, const bf16* P1, const float* G, const float* w_alpha, const float* b_alpha, unsigned char* img, int tid, int lane, int wave, int bx) {
    LAS bf16* VT = (LAS bf16*)lds;
    LAS bf16* QTs = (LAS bf16*)lds;
    LAS bf16* KTl = QTs + 64 * 256;
    LAS bf16* KTT = KTl + 64 * 256;
    LAS bf16* Ps = KTT + 256 * 64;
    LAS float* alow = (LAS float*)(Ps + 64 * 64);
    LAS float* T0 = alow + 1024;
    const int g = lane >> 4, r16 = lane & 15, d = tid & 255, sh = tid >> 8;
    for (int item = bx; item < 2048; item += gridDim.x) {
        const int b = item >> 8, c = (item >> 2) & 63, h = item & 3;
        const int row0 = b * SEQ + c * 64;
        unsigned char* im = img + (size_t)item * IMGG_BYTES;
        __syncthreads();
        float wa[16];
#pragma unroll
        for (int i = 0; i < 16; ++i) wa[i] = w_alpha[i * 1024 + h * 256 + d];
        const float ba = b_alpha[h * 256 + d];
        f32x4 al4 = (f32x4){0.f, 0.f, 0.f, 0.f};
        if (tid < 256) al4 = *(const f32x4*)(G + (size_t)(row0 + (tid >> 2)) * 16 + (tid & 3) * 4);
        if (tid < 256) *(LAS f32x4*)(alow + tid * 4) = al4;
        __syncthreads();
        const bf16* qsrc = P1 + (size_t)(row0 + 32 * sh) * NQKV + h * 256 + d;
        float bs[32]; float run = 0.f;
#pragma unroll
        for (int j = 0; j < 32; ++j) { const int s = 32 * sh + j; float z = ba;
#pragma unroll
            for (int i = 0; i < 16; ++i) z += alow[s * 16 + i] * wa[i];
            run += logsig_fast(z) * (1.0f / 16.0f); bs[j] = run; }
        if (sh == 0) T0[d] = run;
        __syncthreads();
        const float add = sh ? T0[d] : 0.f;
        if (sh) ((float*)(im + IMGG_EB))[d] = __expf(run + add);
#pragma unroll
        for (int q8 = 0; q8 < 4; ++q8) { unsigned kk[8];
#pragma unroll
            for (int j = 0; j < 8; ++j) { const int jj = 8 * q8 + j, s = 32 * sh + jj; const float bsum = bs[jj] + add;
                const float qv = bf2f(qsrc[(size_t)jj * NQKV]) * 0.0625f * __expf(bsum), kv = bf2f(qsrc[(size_t)jj * NQKV + 1024]) * __expf(-bsum);
                QTs[eoff<256>(s, d)] = (bf16)f2bf(qv); kk[j] = f2bf(kv); KTl[eoff<256>(s, d)] = (bf16)kk[j]; }
            v4u w; w.x = kk[0] | (kk[1] << 16); w.y = kk[2] | (kk[3] << 16); w.z = kk[4] | (kk[5] << 16); w.w = kk[6] | (kk[7] << 16);
            *(LAS v4u*)(KTT + eoff<64>(d, 32 * sh + 8 * q8)) = w; }
        __syncthreads();
        { const int tt = wave >> 1;
#pragma unroll
          for (int q2 = 0; q2 < 2; ++q2) { const int st = 2 * (wave & 1) + q2; f32x4 acc = (f32x4){0.f, 0.f, 0.f, 0.f};
            if (st <= tt) mma_tile<256, 256, 8>(acc, QTs, 16 * tt, KTl, 16 * st, lane);
            const int s = 16 * st + r16;
#pragma unroll
            for (int i = 0; i < 4; ++i) { const int t = 16 * tt + 4 * g + i; Ps[eoff<64>(t, s)] = (bf16)f2bf((s <= t) ? acc[i] : 0.f); } } }
        __syncthreads();
#pragma unroll
        for (int p = 0; p < 4; ++p) { *(v4u*)(im + IMGG_Q + (tid + 512 * p) * 16) = *(const LAS v4u*)((LAS unsigned char*)QTs + (tid + 512 * p) * 16);
                                      *(v4u*)(im + IMGG_KT + (tid + 512 * p) * 16) = *(const LAS v4u*)((LAS unsigned char*)KTT + (tid + 512 * p) * 16); }
        *(v4u*)(im + IMGG_P + tid * 16) = *(const LAS v4u*)((LAS unsigned char*)Ps + tid * 16);
    }
}

DI void gla_scan2(LAS unsigned char* lds, const bf16* P1, const unsigned char* img, bf16* hraw, int tid, int lane, int wave, int bx) {
    LAS bf16* QTs = (LAS bf16*)lds;
    LAS bf16* KTT = QTs + 64 * 256;
    LAS bf16* Ps = KTT + 256 * 64;
    LAS bf16* VTs = Ps + 64 * 64;
    LAS float* eb = (LAS float*)(VTs + 64 * 64);
    LAS bf16* ST0 = (LAS bf16*)(eb + 256);
    const int g = lane >> 4, r16 = lane & 15, tt = wave >> 1, eh = wave & 1;
    for (int item0 = bx; item0 < 256; item0 += gridDim.x) {
        const int item = (gridDim.x == 256) ? (item0 & 7) * 32 + (item0 >> 3) : item0;
        const int b = item >> 5, h = (item >> 3) & 3, sl = item & 7;
        f32x4 Sacc[2][4];
#pragma unroll
        for (int a = 0; a < 2; ++a)
#pragma unroll
            for (int e = 0; e < 4; ++e) Sacc[a][e] = (f32x4){0.f, 0.f, 0.f, 0.f};
        __syncthreads();
        for (int i = tid; i < 2 * 64 * 256 / 8; i += 512) ((LAS v4u*)ST0)[i] = (v4u){0u, 0u, 0u, 0u};
        v4u rq[4], rk[4], rp, rv; float re = 0.f;
#define GLS_PREFETCH(cc) do { const int item2 = (b * 64 + (cc)) * 4 + h; const unsigned char* im = img + (size_t)item2 * IMGG_BYTES; \
            _Pragma("unroll") for (int p = 0; p < 4; ++p) { rq[p] = *(const v4u*)(im + IMGG_Q + (tid + 512 * p) * 16); rk[p] = *(const v4u*)(im + IMGG_KT + (tid + 512 * p) * 16); } \
            rp = *(const v4u*)(im + IMGG_P + tid * 16); rv = *(const v4u*)(P1 + ((size_t)b * SEQ + (cc) * 64 + (tid >> 3)) * NQKV + 2048 + h * 512 + sl * 64 + (tid & 7) * 8); if (tid < 256) re = ((const float*)(im + IMGG_EB))[tid]; } while (0)
        GLS_PREFETCH(0);
        for (int c = 0; c < 64; ++c) {
            const int row0 = b * SEQ + c * 64;
            LAS bf16* STc = ST0 + (c & 1) * 64 * 256; LAS bf16* STn = ST0 + ((c + 1) & 1) * 64 * 256;
            __syncthreads();
#pragma unroll
            for (int p = 0; p < 4; ++p) { *(LAS v4u*)((LAS unsigned char*)QTs + (tid + 512 * p) * 16) = rq[p]; *(LAS v4u*)((LAS unsigned char*)KTT + (tid + 512 * p) * 16) = rk[p]; }
            *(LAS v4u*)((LAS unsigned char*)Ps + tid * 16) = rp; *(LAS v4u*)((LAS unsigned char*)VTs + off_v64(tid >> 3, tid & 7)) = rv;
            if (tid < 256) eb[tid] = re;
            __syncthreads();
            if (c + 1 < 64) GLS_PREFETCH(c + 1);
            const LAS unsigned char* vb = (const LAS unsigned char*)VTs;
            const bf16x8 pa0 = ldf<64>(Ps, 16 * tt + r16, g), pa1 = ldf<64>(Ps, 16 * tt + r16, 4 + g);
#pragma unroll
            for (int q2 = 0; q2 < 2; ++q2) { const int et = 2 * eh + q2; f32x4 acc = (f32x4){0.f, 0.f, 0.f, 0.f};
                acc = mfma16(vfrag64(vb, et, 0, lane), pa0, acc); acc = mfma16(vfrag64(vb, et, 1, lane), pa1, acc); mma_tile<256, 256, 8>(acc, STc, 16 * et, QTs, 16 * tt, lane);
                v2u w; w.x = pk2_sw(acc[0], acc[1]); w.y = pk2_sw(acc[2], acc[3]);
                *(v2u*)(hraw + (size_t)(row0 + 16 * tt + r16) * DM + h * 512 + sl * 64 + 16 * et + 4 * g) = w; }
#pragma unroll
            for (int a = 0; a < 2; ++a) { const int dt = 2 * wave + a;
                const f32x4 ev = *(const LAS f32x4*)(eb + 16 * dt + 4 * g);
                const bf16x8 ka0 = ldf<64>(KTT, 16 * dt + r16, g), ka1 = ldf<64>(KTT, 16 * dt + r16, 4 + g);
#pragma unroll
                for (int et = 0; et < 4; ++et) { Sacc[a][et] = mfma16(ka0, vfrag64(vb, et, 0, lane), Sacc[a][et]); Sacc[a][et] = mfma16(ka1, vfrag64(vb, et, 1, lane), Sacc[a][et]); Sacc[a][et] = Sacc[a][et] * ev;
                    v2u w; w.x = pk2(Sacc[a][et][0], Sacc[a][et][1]); w.y = pk2(Sacc[a][et][2], Sacc[a][et][3]);
                    *(LAS v2u*)(STn + eoff<256>(16 * et + r16, 16 * dt + 4 * g)) = w; } }
        }
#undef GLS_PREFETCH
    }
}


DI void mixer_gates(const bf16* hb, const bf16* wg, const long long* ss, float* G, int lane, int wave, int bx) {
    const int g = lane >> 4, r16 = lane & 15;
    for (int t = bx * NWAVES + wave; t < MTOK / 16; t += gridDim.x * NWAVES) {
        const bf16* ap = hb + (size_t)(16 * t + r16) * DM + 8 * g; const bf16* bp = wg + (size_t)r16 * DM + 8 * g;
        f32x4 acc = (f32x4){0.f, 0.f, 0.f, 0.f};
#pragma unroll 8
        for (int kk = 0; kk < DM / 32; ++kk) { const bf16x8 a = *(const bf16x8*)(ap + 32 * kk), b = *(const bf16x8*)(bp + 32 * kk); acc = mfma16(a, b, acc); }
#pragma unroll
        for (int i = 0; i < 4; ++i) { const int row = 16 * t + 4 * g + i; G[(size_t)row * 16 + r16] = acc[i] * pg8::rstd_of(ss, row); }
    }
}

template <int HS, int ACT> DI void headnorm_gate(const bf16* hraw, const bf16* P1, const float* gnorm, bf16* hm, int lane, int wave, int bx) {
    constexpr int NH = DM / HS, EPL = HS / 64;
    const int gw = bx * NWAVES + wave, NGW = gridDim.x * NWAVES;
    for (int row = gw; row < MTOK; row += NGW) {
#pragma unroll
        for (int hh = 0; hh < NH; ++hh) { const int col = hh * HS + lane * EPL;
            unsigned xw[EPL / 2], gwd[EPL / 2];
            if constexpr (EPL == 4) { const v2u a = *(const v2u*)(hraw + (size_t)row * DM + col), b2 = *(const v2u*)(P1 + (size_t)row * NQKV + 4096 + col); xw[0] = a.x; xw[1] = a.y; gwd[0] = b2.x; gwd[1] = b2.y; }
            else { const v4u a = *(const v4u*)(hraw + (size_t)row * DM + col), b2 = *(const v4u*)(P1 + (size_t)row * NQKV + 4096 + col); xw[0] = a.x; xw[1] = a.y; xw[2] = a.z; xw[3] = a.w; gwd[0] = b2.x; gwd[1] = b2.y; gwd[2] = b2.z; gwd[3] = b2.w; }
            float s = 0.f;
#pragma unroll
            for (int j = 0; j < EPL / 2; ++j) { const float x0 = bflo(xw[j]), x1 = bfhi(xw[j]); s += x0 * x0 + x1 * x1; }
            s = wave_sum(s); const float rs = rsqrtf(s * (1.0f / HS) + 1e-6f);
            unsigned outw[EPL / 2];
#pragma unroll
            for (int j = 0; j < EPL / 2; ++j) { const float g0 = bflo(gwd[j]), g1 = bfhi(gwd[j]);
                const float a0 = ACT == 0 ? __builtin_amdgcn_rcpf(1.0f + __expf(-g0)) : g0 * __builtin_amdgcn_rcpf(1.0f + __expf(-g0)), a1 = ACT == 0 ? __builtin_amdgcn_rcpf(1.0f + __expf(-g1)) : g1 * __builtin_amdgcn_rcpf(1.0f + __expf(-g1));
                outw[j] = pk2(bflo(xw[j]) * rs * gnorm[col + 2 * j] * a0, bfhi(xw[j]) * rs * gnorm[col + 2 * j + 1] * a1); }
            if constexpr (EPL == 4) { v2u w; w.x = outw[0]; w.y = outw[1]; *(v2u*)(hm + (size_t)row * DM + col) = w; }
            else { v4u w; w.x = outw[0]; w.y = outw[1]; w.z = outw[2]; w.w = outw[3]; *(v4u*)(hm + (size_t)row * DM + col) = w; }
        }
    }
}

DI void fox_cf(LAS unsigned char* lds, const float* G, const float* b_f, float* cf, const bf16* P1, unsigned* kmax2, int tid, int lane, int wave, int bx) {
    LAS float* wt = (LAS float*)lds;
    for (int item = bx; item < 256; item += gridDim.x) { const int seq = item >> 1, hf = item & 1, b = seq >> 4, h = seq & 15; const float bias = b_f[h];
        const float* gp = G + ((size_t)b * SEQ + hf * 2048 + tid * 4) * 16 + h;
        float ls[4]; float s = 0.f, s0 = 0.f;
#pragma unroll
        for (int p = 0; p < 4; ++p) { ls[p] = logsig(gp[p * 16] + bias); s += ls[p]; }
        if (hf) { const float* g0 = gp - (size_t)2048 * 16;
#pragma unroll
            for (int p = 0; p < 4; ++p) s0 += logsig(g0[p * 16] + bias); }
        const float incl = wave_incl_sum(s, lane), tot0 = wave_sum(s0);
        __syncthreads();
        if (lane == 63) wt[wave] = incl; if (lane == 0) wt[8 + wave] = tot0;
        __syncthreads();
        float base = 0.f;
#pragma unroll
        for (int w = 0; w < 8; ++w) { base += (w < wave) ? wt[w] : 0.f; base += wt[8 + w]; }
        float run = base + incl - s;
        float* o = cf + (size_t)seq * SEQ + hf * 2048 + tid * 4; f32x4 ov;
        run += ls[0]; ov.x = run; run += ls[1]; ov.y = run; run += ls[2]; ov.z = run; run += ls[3]; ov.w = run;
        *(f32x4*)o = ov;
        float km = 0.f; const bf16* kp = P1 + ((size_t)b * SEQ + hf * 2048) * NQKV + 2048 + h * 128;
#pragma unroll 8
        for (int i = 0; i < 64; ++i) { const int idx = tid + 512 * i, r = idx >> 4, c = idx & 15; const v4u kv = *(const v4u*)(kp + (size_t)r * NQKV + c * 8); float s2 = 0.f;
#pragma unroll
            for (int q = 0; q < 4; ++q) { const float x0 = bflo(kv[q]), x1 = bfhi(kv[q]); s2 += x0 * x0 + x1 * x1; }
            s2 += __shfl_xor(s2, 1); s2 += __shfl_xor(s2, 2); s2 += __shfl_xor(s2, 4); s2 += __shfl_xor(s2, 8); km = fmaxf(km, s2); }
        km = fmaxf(km, __shfl_xor(km, 16)); km = fmaxf(km, __shfl_xor(km, 32));
        if (lane == 0) atomicMax(kmax2 + seq, __float_as_uint(km));
    }
}

DI bf16x8 pack8_mfma(const f32x4& lo, const f32x4& hi) { v4u p;
    asm volatile("v_cvt_pk_bf16_f32 %0, %4, %5\n\tv_cvt_pk_bf16_f32 %1, %6, %7\n\tv_cvt_pk_bf16_f32 %2, %8, %9\n\tv_cvt_pk_bf16_f32 %3, %10, %11\n\ts_nop 1"
                 : "=&v"(p[0]), "=&v"(p[1]), "=&v"(p[2]), "=&v"(p[3]) : "v"(lo[0]), "v"(lo[1]), "v"(lo[2]), "v"(lo[3]), "v"(hi[0]), "v"(hi[1]), "v"(hi[2]), "v"(hi[3]));
    return __builtin_bit_cast(bf16x8, p); }
DI unsigned off_v(unsigned row, unsigned ch) { return 256u * row + 16u * (ch ^ (((row & 3u) << 2) | (((row >> 2) & 1u) << 1))); }

DI void fox_attn2(LAS unsigned char* lds, const bf16* P1, const float* cf, const unsigned* kmax2, bf16* hm, int tid, int lane, int wave, int bx) {
    constexpr int BUFB = 16384 + 16384 + 256;
    LAS float* xch = (LAS float*)(lds + 2 * BUFB);
    const float LOG2E = 1.4426950408889634f, QS = 0.08838834764831845f * 1.4426950408889634f, THR = 8.0f;
    const int g = lane >> 4, r16 = lane & 15;
    const int G_ = gridDim.x;
    const int nit = (2048 + G_ - 1) / G_;
    for (int it = 0; it < nit; ++it) {
        const int u = (it & 1) ? it * G_ + (G_ - 1 - bx) : it * G_ + bx;
        if (u >= 2048) continue;
        const int qb = 15 - (u >> 7), bh = u & 127, b = bh >> 4, h = bh & 15;
        const size_t rowb = (size_t)b * SEQ; const int q0 = qb * 256 + 32 * wave;
        bf16x8 qf[2][4]; float c0[2];
#pragma unroll
        for (int tt = 0; tt < 2; ++tt) { const int t = q0 + 16 * tt + r16; c0[tt] = cf[(size_t)bh * SEQ + t] * LOG2E;
#pragma unroll
            for (int kk = 0; kk < 4; ++kk) { const v4u raw = *(const v4u*)(P1 + (rowb + t) * NQKV + h * 128 + 32 * kk + 8 * g); v4u sc;
#pragma unroll
                for (int j = 0; j < 4; ++j) sc[j] = pk2(bflo(raw[j]) * QS, bfhi(raw[j]) * QS);
                qf[tt][kk] = __builtin_bit_cast(bf16x8, sc); } }
        f32x4 oacc[8][2];
#pragma unroll
        for (int et = 0; et < 8; ++et) { oacc[et][0] = (f32x4){0.f, 0.f, 0.f, 0.f}; oacc[et][1] = (f32x4){0.f, 0.f, 0.f, 0.f}; }
        float lrun[2] = {0.f, 0.f};
        const int ntiles = 4 * (qb + 1);
        v4u kreg[2], vreg[2]; float cfreg = 0.f;
        const bf16* kbase = P1 + rowb * NQKV + 2048 + h * 128;
#define FOX_LOAD(j) do { _Pragma("unroll") for (int p = 0; p < 2; ++p) { const int idx = tid + 512 * p, r = idx >> 4, c8 = idx & 15; \
            kreg[p] = *(const v4u*)(kbase + (size_t)(64 * (j) + r) * NQKV + c8 * 8); vreg[p] = *(const v4u*)(kbase + (size_t)(64 * (j) + r) * NQKV + 2048 + c8 * 8); } \
            if (tid < 64) cfreg = -cf[(size_t)bh * SEQ + 64 * (j) + tid] * LOG2E; } while (0)
#define FOX_STORE(bufi) do { LAS unsigned char* bb = lds + (bufi) * BUFB; _Pragma("unroll") for (int p = 0; p < 2; ++p) { const int idx = tid + 512 * p, r = idx >> 4, c8 = idx & 15; \
            *(LAS v4u*)((LAS bf16*)bb + eoff<128>(r, c8 * 8)) = kreg[p]; *(LAS v4u*)(bb + 16384 + off_v(r, c8)) = vreg[p]; } \
            if (tid < 64) ((LAS float*)(bb + 32768))[tid] = cfreg; } while (0)
        float qm = 0.f;
#pragma unroll
        for (int tt = 0; tt < 2; ++tt) { float s2 = 0.f;
#pragma unroll
            for (int kk = 0; kk < 4; ++kk)
#pragma unroll
                for (int jq = 0; jq < 8; ++jq) { const float v = bf2f((unsigned short)qf[tt][kk][jq]); s2 += v * v; }
            s2 += __shfl_xor(s2, 16); s2 += __shfl_xor(s2, 32); qm = fmaxf(qm, s2); }
        qm = fmaxf(qm, __shfl_xor(qm, 1)); qm = fmaxf(qm, __shfl_xor(qm, 2)); qm = fmaxf(qm, __shfl_xor(qm, 4)); qm = fmaxf(qm, __shfl_xor(qm, 8));
        __syncthreads();
        if (lane == 0) xch[16 + wave] = qm;
        FOX_LOAD(ntiles - 1); FOX_STORE(0);
        if (ntiles > 1) FOX_LOAD(ntiles - 2);
        __syncthreads();
        float q2 = xch[16];
#pragma unroll
        for (int w8 = 1; w8 < 8; ++w8) q2 = fmaxf(q2, xch[16 + w8]);
        const float QKB = sqrtf(q2 * __uint_as_float(kmax2[bh])) * 1.01f + 1e-3f;
        const float cfu0 = cf[(size_t)bh * SEQ + qb * 256] * LOG2E;
        float mref[2] = {0.f, 0.f}, rmaxlog[2] = {-__builtin_inff(), -__builtin_inff()};
        for (int k = 0; k < ntiles; ++k) { const int j = ntiles - 1 - k;
            if (k + 1 < ntiles) FOX_STORE((k + 1) & 1);
            if (k + 2 < ntiles) FOX_LOAD(ntiles - 3 - k);
            if (64 * j <= q0 + 31) {
                const LAS bf16* Ks = (const LAS bf16*)(lds + (k & 1) * BUFB); const LAS bf16* VTs = Ks + 64 * 128; const LAS float* cfs = (const LAS float*)(VTs + 128 * 64);
                f32x4 sacc[2][4];
#pragma unroll
                for (int st = 0; st < 4; ++st) { const f32x4 cv = *(const LAS f32x4*)(cfs + 16 * st + 4 * g);
#pragma unroll
                    for (int tt = 0; tt < 2; ++tt) sacc[tt][st] = cv + c0[tt]; }
#pragma unroll
                for (int st = 0; st < 4; ++st)
#pragma unroll
                    for (int kk = 0; kk < 4; ++kk) { const bf16x8 kf = ldf<128>(Ks, 16 * st + r16, 4 * kk + g);
                        sacc[0][st] = mfma16(kf, qf[0][kk], sacc[0][st]); sacc[1][st] = mfma16(kf, qf[1][kk], sacc[1][st]); if (kk == 3) asm volatile("" ::: "memory"); }
                if (64 * j + 63 > q0) {
#pragma unroll
                    for (int tt = 0; tt < 2; ++tt) { const int t = q0 + 16 * tt + r16;
#pragma unroll
                        for (int st = 0; st < 4; ++st)
#pragma unroll
                            for (int i = 0; i < 4; ++i) { const int s = 64 * j + 16 * st + 4 * g + i; if (s > t) sacc[tt][st][i] = -__builtin_inff(); } }
                }
                float mx[2];
#pragma unroll
                for (int tt = 0; tt < 2; ++tt) { float m = -__builtin_inff();
#pragma unroll
                    for (int st = 0; st < 4; ++st) m = fmaxf(m, fmaxf(fmaxf(sacc[tt][st][0], sacc[tt][st][1]), fmaxf(sacc[tt][st][2], sacc[tt][st][3])));
                    m = fmaxf(m, __shfl_xor(m, 16)); m = fmaxf(m, __shfl_xor(m, 32)); mx[tt] = m; }
                rmaxlog[0] = fmaxf(rmaxlog[0], mx[0] + mref[0]); rmaxlog[1] = fmaxf(rmaxlog[1], mx[1] + mref[1]);
                if (__any(mx[0] > THR || mx[1] > THR)) {
#pragma unroll
                    for (int tt = 0; tt < 2; ++tt) { const float sh = fmaxf(mx[tt], 0.f), f = __builtin_amdgcn_exp2f(-sh);
                        c0[tt] -= sh; mref[tt] += sh; lrun[tt] *= f;
#pragma unroll
                        for (int st = 0; st < 4; ++st) sacc[tt][st] = sacc[tt][st] - sh;
#pragma unroll
                        for (int et = 0; et < 8; ++et) oacc[et][tt] = oacc[et][tt] * f; }
                }
#pragma unroll
                for (int tt = 0; tt < 2; ++tt) { float ls = 0.f;
#pragma unroll
                    for (int st = 0; st < 4; ++st)
#pragma unroll
                        for (int i = 0; i < 4; ++i) { const float p = __builtin_amdgcn_exp2f(sacc[tt][st][i]); sacc[tt][st][i] = p; ls += p; }
                    lrun[tt] += ls; }
#pragma unroll
                for (int ks = 0; ks < 2; ++ks) { bf16x8 pb[2];
#pragma unroll
                    for (int tt = 0; tt < 2; ++tt) pb[tt] = pack8_mfma(sacc[tt][2 * ks], sacc[tt][2 * ks + 1]);
#pragma unroll
                    for (int et = 0; et < 8; ++et) {
                        const LAS unsigned char* vb = (const LAS unsigned char*)VTs;
                        const v4i16_t lo = tr_read(vb + off_v(32 * ks + 4 * g + (r16 >> 2), 2 * et + ((lane & 3) >> 1)) + 8 * (lane & 1));
                        const v4i16_t hi = tr_read(vb + off_v(32 * ks + 16 + 4 * g + (r16 >> 2), 2 * et + ((lane & 3) >> 1)) + 8 * (lane & 1));
                        bf16x8 va; va[0] = lo[0]; va[1] = lo[1]; va[2] = lo[2]; va[3] = lo[3]; va[4] = hi[0]; va[5] = hi[1]; va[6] = hi[2]; va[7] = hi[3];
                        oacc[et][0] = mfma16(va, pb[0], oacc[et][0]); oacc[et][1] = mfma16(va, pb[1], oacc[et][1]); if (et & 1) asm volatile("" ::: "memory"); } }
            }
            { float wm = fminf(rmaxlog[0], rmaxlog[1]);
              wm = fminf(wm, __shfl_xor(wm, 1)); wm = fminf(wm, __shfl_xor(wm, 2)); wm = fminf(wm, __shfl_xor(wm, 4)); wm = fminf(wm, __shfl_xor(wm, 8));
              if (lane == 0) xch[(k & 1) * 8 + wave] = wm; }
            __syncthreads();
            if (k + 1 < ntiles) { float mmin = xch[(k & 1) * 8];
#pragma unroll
                for (int w8 = 1; w8 < 8; ++w8) mmin = fminf(mmin, xch[(k & 1) * 8 + w8]);
                const float cfe = ((const LAS float*)(lds + ((k + 1) & 1) * BUFB + 32768))[63];
                if (QKB + cfu0 + cfe < mmin - 60.0f) break; }
        }
#undef FOX_LOAD
#undef FOX_STORE
#pragma unroll
        for (int tt = 0; tt < 2; ++tt) { float l = lrun[tt]; l += __shfl_xor(l, 16); l += __shfl_xor(l, 32); const float inv = 1.0f / l;
            bf16* orow = hm + (rowb + q0 + 16 * tt + r16) * DM + h * 128 + 4 * g;
#pragma unroll
            for (int et = 0; et < 8; ++et) { v2u w; w.x = pk2(oacc[et][tt][0] * inv, oacc[et][tt][1] * inv); w.y = pk2(oacc[et][tt][2] * inv, oacc[et][tt][3] * inv); *(v2u*)(orow + 16 * et) = w; } }
    }
}


DI void final_norm(float* out, const bf16* hb, const long long* ss, const float* gfin, int lane, int wave, int bx) {
    const int gw = bx * NWAVES + wave, NGW = gridDim.x * NWAVES;
    for (int m = gw; m < MTOK; m += NGW) { const float rs = pg8::rstd_of(ss, m);
        const v4u* hr = (const v4u*)(hb + (size_t)m * DM); f32x4* xr = (f32x4*)(out + (size_t)m * DM); const f32x4* gr = (const f32x4*)gfin;
#pragma unroll
        for (int j = 0; j < 4; ++j) { const v4u w = hr[lane + 64 * j]; const int c4 = 2 * (lane + 64 * j);
            const f32x4 g0 = gr[c4], g1 = gr[c4 + 1];
            xr[c4] = (f32x4){bflo(w.x) * rs * g0.x, bfhi(w.x) * rs * g0.y, bflo(w.y) * rs * g0.z, bfhi(w.y) * rs * g0.w};
            xr[c4 + 1] = (f32x4){bflo(w.z) * rs * g1.x, bfhi(w.z) * rs * g1.y, bflo(w.w) * rs * g1.z, bfhi(w.w) * rs * g1.w}; } }
}

#define PH(p) if (lo <= (p) && (p) < hi && (ran ? (xcd_barrier(bar), true) : (ran = true)))
#define TID() int tid = threadIdx.x; asm volatile("" : "+v"(tid)); const int lane = tid & 63, wave = __builtin_amdgcn_readfirstlane(tid >> 6); int bx = blockIdx.x; asm volatile("" : "+s"(bx)); (void)lane; (void)wave; (void)bx
#define WSP(T, off) ((T*)(ka->ws + (off)))
template <int j> DI void subblock(LAS unsigned char* lds, const XcdBarrier& bar, const int lo, const int hi, bool& ran) {
    {
        constexpr int layer = j / 3, typ = j - 3 * layer, base = 1 + 5 * j;
        if constexpr (typ != 1) {
            PH(base) { TID(); KArgs ka = kargs(); const int mi = layer * 2 + (typ >> 1);
                pg8::Gemm gm{WSP(bf16, WS_HB), WSP(bf16, WS_WUP) + (size_t)mi * NUP * DM, MTOK, NUP, DM}; pg8::StaticOrder S; S.init(MTOK, NUP, gridDim.x, bx);
                pg8::EpiSwiGLU E{WSP(bf16, WS_ACT), WSP(long long, WS_SS) + (size_t)j * MTOK, DFF};
                pg8::gemm_phase<pg8::EpiSwiGLU, pg8::StaticOrder, PG8_ALIGN, PG8_SP2>(lds, gm, S, E); }
        } else {
            constexpr int kind = layer % 3, ji = layer / 3;
            PH(base) { TID(); KArgs ka = kargs();
                mixer_gates(WSP(bf16, WS_HB), WSP(bf16, WS_WIN) + ((size_t)layer * NINP + NQKV) * DM, WSP(long long, WS_SS) + (size_t)j * MTOK, WSP(float, WS_G), lane, wave, bx);
                pg8::Gemm gm{WSP(bf16, WS_HB), WSP(bf16, WS_WIN) + (size_t)layer * NINP * DM, MTOK, NQKV, DM}; pg8::StaticOrder S; S.init(MTOK, NQKV, gridDim.x, bx);
                pg8::EpiMixIn E{WSP(bf16, WS_P1), WSP(long long, WS_SS) + (size_t)j * MTOK};
                pg8::gemm_phase<pg8::EpiMixIn, pg8::StaticOrder, PG8_ALIGN, PG8_SP2>(lds, gm, S, E); }
            PH(base + 1) { TID(); KArgs ka = kargs();
                if constexpr (kind == 0) for (int rep = 0; rep < REP_MLSTM; ++rep) mlstm_pre(lds, WSP(bf16, WS_P1), WSP(float, WS_G), ka->in[6] + ji * 16, WSP(unsigned char, WS_ACT), tid, lane, wave, bx);
                else if constexpr (kind == 1) { fox_cf(lds, WSP(float, WS_G), ka->in[10] + ji * 16, WSP(float, WS_CF), WSP(bf16, WS_P1), WSP(unsigned, WS_CTL) + CW_KMAX, tid, lane, wave, bx); }
                else for (int rep = 0; rep < REP_GLA; ++rep) gla_pre(lds, WSP(bf16, WS_P1), WSP(float, WS_G), ka->in[13] + (size_t)ji * 16 * 1024, ka->in[14] + ji * 1024, WSP(unsigned char, WS_ACT), tid, lane, wave, bx);
            }
            PH(base + 2) { TID(); KArgs ka = kargs();
                if constexpr (kind == 0) for (int rep = 0; rep < REP_MLSTM; ++rep) mlstm_scan2(lds, WSP(bf16, WS_P1), WSP(unsigned char, WS_ACT), WSP(bf16, WS_HRAW), tid, lane, wave, bx);
                else if constexpr (kind == 1) for (int rep = 0; rep < REP_FOX; ++rep) fox_attn2(lds, WSP(bf16, WS_P1), WSP(float, WS_CF), WSP(unsigned, WS_CTL) + CW_KMAX, WSP(bf16, WS_HM), tid, lane, wave, bx);
                else for (int rep = 0; rep < REP_GLA; ++rep) gla_scan2(lds, WSP(bf16, WS_P1), WSP(unsigned char, WS_ACT), WSP(bf16, WS_HRAW), tid, lane, wave, bx);
            }
            if constexpr (kind != 1) { PH(base + 3) { TID(); KArgs ka = kargs();
                if constexpr (kind == 0) headnorm_gate<256, 0>(WSP(bf16, WS_HRAW), WSP(bf16, WS_P1), ka->in[7] + ji * DM, WSP(bf16, WS_HM), lane, wave, bx);
                else headnorm_gate<512, 1>(WSP(bf16, WS_HRAW), WSP(bf16, WS_P1), ka->in[15] + ji * DM, WSP(bf16, WS_HM), lane, wave, bx);
            } }
        }
        PH(base + 4) { TID(); KArgs ka = kargs();
            pg8::Gemm gm; float scale;
            if constexpr (typ != 1) { const int mi = layer * 2 + (typ >> 1); gm = pg8::Gemm{WSP(bf16, WS_ACT), WSP(bf16, WS_WDN) + (size_t)mi * DM * DFF, MTOK, DM, DFF}; scale = 0.5f; }
            else { gm = pg8::Gemm{WSP(bf16, WS_HM), WSP(bf16, WS_WOUT) + (size_t)layer * DM * DM, MTOK, DM, DM}; scale = 1.0f; }
            pg8::StaticOrder S; S.init(MTOK, DM, gridDim.x, bx);
            pg8::EpiResid E{WSP(bf16, WS_HB), WSP(long long, WS_SS) + (size_t)(j + 1) * MTOK, scale};
            pg8::gemm_phase<pg8::EpiResid, pg8::StaticOrder, PG8_ALIGN, PG8_SP2>(lds, gm, S, E);
        }
    }
}

__global__ void __launch_bounds__(NWAVES * 64, 2) trunk_fwd(Args args) {
    extern __shared__ __attribute__((aligned(16))) unsigned char lds_raw[];
    LAS unsigned char* lds = (LAS unsigned char*)lds_raw;
    volatile LAS unsigned* MISC = (volatile LAS unsigned*)(lds + MISC_OFF);
    for (int u = threadIdx.x; u < (LDS_BYTES - MISC_OFF) / 4; u += NWAVES * 64) ((LAS unsigned*)(lds + MISC_OFF))[u] = 0u;
    __syncthreads();
    XcdBarrier bar = xcd_barrier_post((unsigned*)(args.ws + WS_CTL) + CW_BAR, MISC + 8);
    const int lo = args.ph_lo, hi = args.ph_hi; bool ran = false;

    PH(0) { TID(); for (int rep = 0; rep < REP_PRO; ++rep) { prologue(lds, lane, wave, bx); __syncthreads(); } }

    subblock<0>(lds, bar, lo, hi, ran); subblock<1>(lds, bar, lo, hi, ran); subblock<2>(lds, bar, lo, hi, ran); subblock<3>(lds, bar, lo, hi, ran);
    subblock<4>(lds, bar, lo, hi, ran); subblock<5>(lds, bar, lo, hi, ran); subblock<6>(lds, bar, lo, hi, ran); subblock<7>(lds, bar, lo, hi, ran);
    subblock<8>(lds, bar, lo, hi, ran); subblock<9>(lds, bar, lo, hi, ran); subblock<10>(lds, bar, lo, hi, ran); subblock<11>(lds, bar, lo, hi, ran);
    PH(NPHASE - 1) { TID(); KArgs ka = kargs(); final_norm(ka->out, WSP(bf16, WS_HB), WSP(long long, WS_SS) + (size_t)NSUB * MTOK, ka->in[17], lane, wave, bx); }
#undef WSP
#undef PH
}

static bool phase_exists(int p) {
    if (p == 0 || p == NPHASE - 1) return true;
    const int j = (p - 1) / 5, k = (p - 1) % 5, typ = j % 3;
    if (k == 0 || k == 4) return true;
    if (typ != 1) return false;
    if (k == 3) return ((j / 3) % 3) != 1;
    return true;
}
extern "C" void kernel_launch(void* const* d_in, const int* in_sizes, int n_in, void* d_out, int out_size, void* d_ws, size_t ws_size, hipStream_t stream) {
    static int grid = 0;
    if (grid == 0) {
        if (n_in != 18 || in_sizes[0] != MTOK * DM || out_size != MTOK * DM || ws_size < WS_END) { fprintf(stderr, "kernel_launch: unexpected shapes (n_in %d, in0 %d, out %d, ws %zu < %zu)\n", n_in, n_in > 0 ? in_sizes[0] : -1, out_size, ws_size, (size_t)WS_END); grid = -1; return; }
        int dev = 0, cus = 0, per_cu = 0;
        if (hipGetDevice(&dev) != hipSuccess || hipDeviceGetAttribute(&cus, hipDeviceAttributeMultiprocessorCount, dev) != hipSuccess) { grid = -1; return; }
        if (hipFuncSetAttribute((const void*)trunk_fwd, hipFuncAttributeMaxDynamicSharedMemorySize, LDS_BYTES) != hipSuccess) { fprintf(stderr, "kernel_launch: hipFuncSetAttribute failed\n"); grid = -1; return; }
        if (hipOccupancyMaxActiveBlocksPerMultiprocessor(&per_cu, (const void*)trunk_fwd, NWAVES * 64, LDS_BYTES) != hipSuccess || per_cu < 1) fprintf(stderr, "kernel_launch: occupancy query says %d\n", per_cu);
        (void)hipGetLastError();
        grid = cus;
    }
    if (grid < 0) return;
    if (hipMemsetAsync((char*)d_ws + WS_CTL, 0, CTL_ZERO_BYTES, stream) != hipSuccess) return;
    Args a{};
    for (int i = 0; i < 18; ++i) a.in[i] = (const float*)d_in[i];
    a.out = (float*)d_out; a.ws = (unsigned char*)d_ws;
#if MK_PER_PHASE
    for (int p = 0; p < NPHASE; ++p) { if (!phase_exists(p)) continue; a.ph_lo = p; a.ph_hi = p + 1; hipLaunchKernelGGL(trunk_fwd, dim3(grid), dim3(NWAVES * 64), LDS_BYTES, stream, a); }
#else
    a.ph_lo = 0; a.ph_hi = NPHASE; hipLaunchKernelGGL(trunk_fwd, dim3(grid), dim3(NWAVES * 64), LDS_BYTES, stream, a);
#endif
    (void)phase_exists;
}
```

```cpp
#include <hip/hip_runtime.h>
#include <cstdio>
#include <cstdint>
namespace pg8 {
#define PG8_LAS __attribute__((address_space(3)))
typedef unsigned short bf16_t;
typedef short bf16x8 __attribute__((ext_vector_type(8)));
typedef float f32x4 __attribute__((ext_vector_type(4)));
typedef unsigned u32x4 __attribute__((ext_vector_type(4)));
constexpr int BM = 256, BK = 64, HALF = 128, HTB = HALF * BK * 2  , STAGE_BYTES = 8 * HTB, NXCD = 8, WGM = 8;

__host__ __device__ __forceinline__ int lds_byte(int r, int c) { const int st = (r >> 4) * 2 + (c >> 5), rr = r & 15, cc = c & 31, ob = rr * 64 + cc * 2; return st * 1024 + (ob ^ (((ob >> 9) & 1) << 5)); }
__host__ __device__ __forceinline__ void stage_rc(int b, int& R, int& C) { const int st = b / 1024, sb = b % 1024, swz = sb ^ (((sb >> 9) & 1) << 5); R = (st >> 1) * 16 + swz / 64; C = (st & 1) * 32 + (swz % 64) / 2; }
__host__ __device__ __forceinline__ int perm32(int rho) { const int n = rho >> 4, i = rho & 15; return 8 * (i >> 2) + 4 * n + (i & 3); }

struct Unit { int pm, pn; };
struct Gemm { const bf16_t* A; const bf16_t* Bt; int M, N, K; };

struct StaticOrder {
    int nM, nN, nwg, G, c;
    __host__ __device__ void init(int M, int N, int G_, int c_) { nM = M / BM; nN = N / BM; nwg = nM * nN; G = G_; c = c_; }
    __host__ __device__ bool next(int i, Unit& u) const {
        const long L = (long)i * G + c; if (L >= nwg) return false;
        int wgid = (int)L; { const int q = nwg / NXCD, r = nwg % NXCD, xcd = wgid % NXCD, off = wgid / NXCD; wgid = (xcd < r ? xcd * (q + 1) : r * (q + 1) + (xcd - r) * q) + off; }
        const int nig = WGM * nN, gid = wgid / nig, fm = gid * WGM, gsz = (nM - fm) < WGM ? (nM - fm) : WGM;
        u.pm = fm + ((wgid % nig) % gsz); u.pn = (wgid % nig) / gsz; return true;
    }
    __device__ __forceinline__ void a_ready(const Unit&) const {}
    __device__ __forceinline__ void done(const Unit&) const {}
};

__device__ __forceinline__ unsigned cvt_pk_bf16(float lo, float hi) { unsigned r; asm volatile("v_cvt_pk_bf16_f32 %0, %1, %2" : "=v"(r) : "v"(lo), "v"(hi)); return r; }
constexpr float RMS_EPS_F = 1e-6f, SS_FIX = 1048576.0f, SS_UNFIX_D = 1.0f / (1048576.0f * 2048.0f);
typedef long long ss_t;
__device__ __forceinline__ float rstd_of(const ss_t* ss, int row) { return rsqrtf((float)ss[row] * SS_UNFIX_D + RMS_EPS_F); }
template <class Sched> __device__ __forceinline__ int rstd_table_fill(const Sched& S, const ss_t* ss, PG8_LAS unsigned char* ext, int tid) {
    PG8_LAS float* tab = (PG8_LAS float*)ext; int key0 = -1, key1 = -1, bad = 0; Unit u;
    for (int i = 0; S.next(i, u); ++i) { const int slot = (u.pm >> 3) & 1; const int key = slot ? key1 : key0;
        if (key == u.pm) continue;
        if (key >= 0) { bad = 1; continue; }
        if (slot) key1 = u.pm; else key0 = u.pm;
        if (tid < 256) tab[slot * 256 + tid] = rstd_of(ss, u.pm * BM + tid); }
    asm volatile("s_waitcnt lgkmcnt(0)" ::: "memory"); __builtin_amdgcn_s_barrier(); asm volatile("" ::: "memory");
    return bad;
}
__device__ __forceinline__ float rstd_get(const ss_t* ss, const Unit& u, int row, int pf, const PG8_LAS unsigned char* ext) {
    return pf ? rstd_of(ss, row) : ((const PG8_LAS float*)ext)[((u.pm >> 3) & 1) * 256 + (row - u.pm * BM)];
}
struct EpiSwiGLU {
    static constexpr bool PERM = true, AFTER_DRAIN = false, SEG = false;
    bf16_t* O; const ss_t* ss; int ldo;
    template <class Sched> __device__ __forceinline__ int prepare(const Sched& S, PG8_LAS unsigned char* ext, int tid) const { return rstd_table_fill(S, ss, ext, tid); }
    __device__ __forceinline__ void operator()(const f32x4 (&acc)[2][2][4][2], const Unit& u, int wr, int wc, int fr, int fq, int pf, const PG8_LAS unsigned char* ext) const {
        const int row0 = u.pm * BM + wr * 64 + fr, col0 = u.pn * HALF + wc * 32 + 8 * fq;
#pragma unroll
        for (int ai = 0; ai < 2; ++ai)
#pragma unroll
            for (int m = 0; m < 4; ++m) {
                const int row = row0 + ai * HALF + m * 16;
                const float rs = rstd_get(ss, u, row, pf, ext), c1 = -1.4426950408889634f * rs, rs2 = rs * rs;
                float o[8];
#pragma unroll
                for (int n = 0; n < 2; ++n) { const f32x4 p4 = acc[ai][0][m][n] * acc[ai][1][m][n] * rs2;
#pragma unroll
                    for (int j = 0; j < 4; ++j) o[4 * n + j] = p4[j] * __builtin_amdgcn_rcpf(1.0f + __builtin_amdgcn_exp2f(acc[ai][0][m][n][j] * c1)); }
                u32x4 w; w.x = cvt_pk_bf16(o[0], o[1]); w.y = cvt_pk_bf16(o[2], o[3]); w.z = cvt_pk_bf16(o[4], o[5]); w.w = cvt_pk_bf16(o[6], o[7]);
                *(u32x4*)(O + (size_t)row * ldo + col0) = w;
            }
    }
};
struct EpiMixIn {
    static constexpr bool PERM = true, AFTER_DRAIN = false, SEG = false;
    bf16_t* O; const ss_t* ss;
    template <class Sched> __device__ __forceinline__ int prepare(const Sched& S, PG8_LAS unsigned char* ext, int tid) const { return rstd_table_fill(S, ss, ext, tid); }
    __device__ __forceinline__ void operator()(const f32x4 (&acc)[2][2][4][2], const Unit& u, int wr, int wc, int fr, int fq, int pf, const PG8_LAS unsigned char* ext) const {
        const int row0 = u.pm * BM + wr * 64 + fr, col0 = u.pn * BM + wc * 32 + 8 * fq;
#pragma unroll
        for (int ai = 0; ai < 2; ++ai)
#pragma unroll
            for (int m = 0; m < 4; ++m) {
                const int row = row0 + ai * HALF + m * 16;
                const float rs = rstd_get(ss, u, row, pf, ext);
#pragma unroll
                for (int bj = 0; bj < 2; ++bj) { const f32x4 v0 = acc[ai][bj][m][0] * rs, v1 = acc[ai][bj][m][1] * rs;
                    u32x4 w; w.x = cvt_pk_bf16(v0[0], v0[1]); w.y = cvt_pk_bf16(v0[2], v0[3]); w.z = cvt_pk_bf16(v1[0], v1[1]); w.w = cvt_pk_bf16(v1[2], v1[3]);
                    *(u32x4*)(O + (size_t)row * 6144 + col0 + bj * HALF) = w; }
            }
    }
};
constexpr float HSS_FIX = 1073741824.0f;
template <int NH> struct EpiResidT {
    static constexpr bool PERM = true, AFTER_DRAIN = false, SEG = NH > 0; static constexpr int NHX = NH > 0 ? NH : 1, SEGT = (2048 / NHX) / BK;
    bf16_t* hb; ss_t* ssn; float scale; const ss_t* hss;
    __device__ __forceinline__ float hrstd(int row, int hh) const { return rsqrtf((float)hss[(size_t)row * NHX + hh] * (1.0f / (HSS_FIX * (2048 / NHX))) + RMS_EPS_F); }
    __device__ __forceinline__ static int slot_of(const Unit& u, int pf) { return pf ? (pf & 1) : ((u.pm >> 3) & 1); }
    __device__ __forceinline__ void fill(PG8_LAS float* tab, int slot, int pm, int tid) const {
        if (tid < 256) { const int row = pm * BM + tid; float prev = hrstd(row, 0);
#pragma unroll
            for (int hh = 1; hh < NHX; ++hh) { const float c = hrstd(row, hh); tab[(slot * NHX + hh) * 256 + tid] = prev / c; prev = c; }
            tab[(slot * NHX) * 256 + tid] = prev; }
    }
    __device__ __forceinline__ void fill_unit(const Unit& u, int ui, PG8_LAS unsigned char* ext, int tid) const { fill((PG8_LAS float*)ext, ui & 1, u.pm, tid); asm volatile("s_waitcnt lgkmcnt(0)" ::: "memory"); }
    template <class Sched> __device__ __forceinline__ int prepare(const Sched& S, PG8_LAS unsigned char* ext, int tid) const {
        if constexpr (NH == 0) return 0;
        else {
            PG8_LAS float* tab = (PG8_LAS float*)ext; int key0 = -1, key1 = -1, bad = 0; Unit u;
            for (int i = 0; S.next(i, u); ++i) { const int slot = (u.pm >> 3) & 1; const int key = slot ? key1 : key0;
                if (key == u.pm) continue;
                if (key >= 0) { bad = 1; continue; }
                if (slot) key1 = u.pm; else key0 = u.pm;
                fill(tab, slot, u.pm, tid); }
            if (bad) tab[((tid >> 8) & 1) * NH * 256 + (tid & 255)] = 1.0f;
            asm volatile("s_waitcnt lgkmcnt(0)" ::: "memory"); __builtin_amdgcn_s_barrier(); asm volatile("" ::: "memory");
            return bad;
        }
    }
    __device__ __forceinline__ void rescale(f32x4 (&acc)[2][2][4][2], const Unit& u, int hh, int wr, int fr, int pf, const PG8_LAS unsigned char* ext) const {
        int t_ = threadIdx.x; asm volatile("" : "+v"(t_));
        const PG8_LAS float* tab = (const PG8_LAS float*)ext + (slot_of(u, pf) * NHX + hh) * 256 + ((t_ >> 8) << 6) + (t_ & 15);
#pragma unroll
        for (int ai = 0; ai < 2; ++ai)
#pragma unroll
            for (int m = 0; m < 4; ++m) { const int lr = ai * HALF + m * 16; float r;
                r = tab[lr];
#pragma unroll
                for (int bj = 0; bj < 2; ++bj) { acc[ai][bj][m][0] = acc[ai][bj][m][0] * r; acc[ai][bj][m][1] = acc[ai][bj][m][1] * r; }
                __builtin_amdgcn_sched_barrier(0); }
    }
    __device__ __forceinline__ void operator()(const f32x4 (&acc)[2][2][4][2], const Unit& u, int wr, int wc, int fr, int fq, int pf, const PG8_LAS unsigned char* ext) const {
        const int row0 = u.pm * BM + wr * 64 + fr, col0 = u.pn * BM + wc * 32 + 8 * fq;
        u32x4 rb[3][2];
#define PG8_LDG(gi, buf) do { const size_t off_ = (size_t)(row0 + ((gi) >> 2) * HALF + ((gi) & 3) * 16) * 2048 + col0; \
            _Pragma("unroll") for (int q_ = 0; q_ < 2; ++q_) buf[q_] = *(const u32x4*)(hb + off_ + q_ * HALF); } while (0)
        PG8_LDG(0, rb[0]); PG8_LDG(1, rb[1]);
#pragma unroll
        for (int gi = 0; gi < 8; ++gi) {
            if (gi + 2 < 8) PG8_LDG(gi + 2, rb[(gi + 2) % 3]);
            const int ai = gi >> 2, m = gi & 3;
            const int row = row0 + ai * HALF + m * 16; const size_t off = (size_t)row * 2048 + col0; float sq = 0.f;
            float sc = scale;
            if constexpr (NH > 0) sc *= ((const PG8_LAS float*)ext)[(slot_of(u, pf) * NHX) * 256 + (row - u.pm * BM)];
#pragma unroll
            for (int bj = 0; bj < 2; ++bj) { const u32x4 hw = rb[gi % 3][bj];
                const f32x4 h0 = (f32x4){__uint_as_float(hw.x << 16), __uint_as_float(hw.x & 0xffff0000u), __uint_as_float(hw.y << 16), __uint_as_float(hw.y & 0xffff0000u)};
                const f32x4 h1 = (f32x4){__uint_as_float(hw.z << 16), __uint_as_float(hw.z & 0xffff0000u), __uint_as_float(hw.w << 16), __uint_as_float(hw.w & 0xffff0000u)};
                const f32x4 n0 = h0 + acc[ai][bj][m][0] * sc, n1 = h1 + acc[ai][bj][m][1] * sc;
                u32x4 w; w.x = cvt_pk_bf16(n0[0], n0[1]); w.y = cvt_pk_bf16(n0[2], n0[3]); w.z = cvt_pk_bf16(n1[0], n1[1]); w.w = cvt_pk_bf16(n1[2], n1[3]);
                *(u32x4*)(hb + off + bj * HALF) = w;
                const float r0 = __uint_as_float(w.x << 16), r1 = __uint_as_float(w.x & 0xffff0000u), r2 = __uint_as_float(w.y << 16), r3 = __uint_as_float(w.y & 0xffff0000u);
                const float r4 = __uint_as_float(w.z << 16), r5 = __uint_as_float(w.z & 0xffff0000u), r6 = __uint_as_float(w.w << 16), r7 = __uint_as_float(w.w & 0xffff0000u);
                sq += ((r0 * r0 + r1 * r1) + (r2 * r2 + r3 * r3)) + ((r4 * r4 + r5 * r5) + (r6 * r6 + r7 * r7)); }
            sq += __shfl_xor(sq, 16); sq += __shfl_xor(sq, 32);
            if (fq == 0) atomicAdd((unsigned long long*)(ssn + row), (unsigned long long)__float2ll_rn(sq * SS_FIX));
        }
#undef PG8_LDG
    }
};
typedef EpiResidT<0> EpiResid;

template <class Epi, class Sched, bool ALIGN_EPI = false, bool SP2 = false>
__device__ __forceinline__ void gemm_phase(PG8_LAS unsigned char* lds, const Gemm g, const Sched& S, const Epi& E) {
    int tid_ = threadIdx.x; asm volatile("" : "+v"(tid_));
    const int tid = tid_, wid = __builtin_amdgcn_readfirstlane(tid >> 6), lane = tid & 63, wr = wid >> 2, wc = wid & 3, fr = lane & 15, fq = lane >> 4;
    const int K = g.K, nt = K / BK;
    unsigned voffA[2], voffB[2];
#pragma unroll
    for (int i = 0; i < 2; ++i) { int R, C; stage_rc(tid * 16 + i * 8192, R, C); const int Rb = Epi::PERM ? ((R & ~31) + perm32(R & 31)) : R;
        voffA[i] = (unsigned)(R * K + C) * 2u; voffB[i] = (unsigned)(Rb * K + C) * 2u; }
    const size_t kstep = (size_t)(BK * 2);
    const size_t hstep = (size_t)HALF * K * 2;
    const size_t tstep = 2 * hstep;
    const unsigned ldsw = (unsigned)wid * 1024u;
    const int aoff = lds_byte(wr * 64 + fr, fq * 8), boff = lds_byte(wc * 32 + fr, fq * 8);
#define PG8_SA(b, h) (((b) * 2 + (h)) * HTB)
#define PG8_SB(b, h) ((4 + (b) * 2 + (h)) * HTB)
#define PG8_STAGE(bufoff, gbase, voff) do { _Pragma("unroll") for (int _i = 0; _i < 2; ++_i) \
        __builtin_amdgcn_global_load_lds((const unsigned*)((const char*)(gbase) + (voff)[_i]), (PG8_LAS unsigned*)(lds + (bufoff) + ldsw + _i * 8192), 16, 0, 0); } while (0)
#define PG8_LDA(dst, b, h) do { _Pragma("unroll") for (int m = 0; m < 4; ++m) _Pragma("unroll") for (int k = 0; k < 2; ++k) dst[m][k] = *(const PG8_LAS bf16x8*)(lds + PG8_SA(b, h) + aoff + m * 2048 + k * 1024); } while (0)
#define PG8_LDB(dst, b, h) do { _Pragma("unroll") for (int n = 0; n < 2; ++n) _Pragma("unroll") for (int k = 0; k < 2; ++k) dst[n][k] = *(const PG8_LAS bf16x8*)(lds + PG8_SB(b, h) + boff + n * 2048 + k * 1024); } while (0)
#define PG8_MMA(ai, bj, At, Bt) do { __builtin_amdgcn_s_setprio(1); _Pragma("unroll") for (int m = 0; m < 4; ++m) _Pragma("unroll") for (int n = 0; n < 2; ++n) _Pragma("unroll") for (int k = 0; k < 2; ++k) \
        acc[ai][bj][m][n] = __builtin_amdgcn_mfma_f32_16x16x32_bf16(Bt[n][k], At[m][k], acc[ai][bj][m][n], 0, 0, 0); __builtin_amdgcn_s_setprio(0); } while (0)
#define PG8_WAIT_V(n) asm volatile("s_waitcnt vmcnt(" #n ")" ::: "memory")
#define PG8_WAIT_L(n) asm volatile("s_waitcnt lgkmcnt(" #n ")" ::: "memory")
#define PG8_BAR __builtin_amdgcn_s_barrier()
#define PG8_SCHED __builtin_amdgcn_sched_barrier(0)
    const int pf0 = E.prepare(S, lds + STAGE_BYTES, tid); int pf = pf0;
    Unit cur, nxt; int ui = 0;
    if (!S.next(0, cur)) return;
    if constexpr (Epi::SEG) { if (pf0) { E.fill_unit(cur, 0, lds + STAGE_BYTES, tid); pf = 2; } }
    f32x4 acc[2][2][4][2];
#pragma unroll
    for (int a = 0; a < 2; ++a)
#pragma unroll
        for (int b = 0; b < 2; ++b)
#pragma unroll
            for (int m = 0; m < 4; ++m)
#pragma unroll
                for (int n = 0; n < 2; ++n) acc[a][b][m][n] = (f32x4){0.f, 0.f, 0.f, 0.f};
    bf16x8 At[4][2], B0[2][2], B1[2][2];
    const char* cA = (const char*)g.A + (size_t)cur.pm * tstep; const char* cB = (const char*)g.Bt + (size_t)cur.pn * tstep;
    S.a_ready(cur);
    if constexpr (SP2) {
        PG8_STAGE(PG8_SB(0, 0), cB, voffB); PG8_STAGE(PG8_SB(0, 1), cB + hstep, voffB); PG8_STAGE(PG8_SA(0, 0), cA, voffA); PG8_STAGE(PG8_SA(0, 1), cA + hstep, voffA);
        if (wr == 1) PG8_BAR;
        PG8_WAIT_V(2); PG8_BAR;
        PG8_STAGE(PG8_SB(1, 0), cB + kstep, voffB); PG8_STAGE(PG8_SA(1, 0), cA + kstep, voffA); PG8_STAGE(PG8_SB(1, 1), cB + hstep + kstep, voffB);
        PG8_WAIT_V(6); PG8_BAR;
    } else {
        PG8_STAGE(PG8_SB(0, 0), cB, voffB); PG8_STAGE(PG8_SA(0, 0), cA, voffA); PG8_STAGE(PG8_SB(0, 1), cB + hstep, voffB); PG8_STAGE(PG8_SA(0, 1), cA + hstep, voffA);
        if (wr == 1) PG8_BAR;
        PG8_WAIT_V(4); PG8_BAR;
        PG8_STAGE(PG8_SB(1, 0), cB + kstep, voffB); PG8_STAGE(PG8_SA(1, 0), cA + kstep, voffA); PG8_STAGE(PG8_SB(1, 1), cB + hstep + kstep, voffB);
        PG8_WAIT_V(6); PG8_BAR;
    }
    for (;;) {
        const bool has_next = S.next(ui + 1, nxt);
        const char* nA = has_next ? (const char*)g.A + (size_t)nxt.pm * tstep : cA; const char* nB = has_next ? (const char*)g.Bt + (size_t)nxt.pn * tstep : cB;
        for (int t = 0; t < nt; t += 2) {
            const bool last = (t == nt - 2);
            const char* a1 = cA + (size_t)(t + 1) * kstep;
            const char* a2 = last ? nA : cA + (size_t)(t + 2) * kstep; const char* b2 = last ? nB : cB + (size_t)(t + 2) * kstep;
            const char* a3 = a2 + kstep; const char* b3 = b2 + kstep;
            if (last && has_next) S.a_ready(nxt);
            if constexpr (Epi::SEG) { if ((t & (Epi::SEGT - 1)) == 0) E.rescale(acc, cur, t / Epi::SEGT, wr, fr, pf, lds + STAGE_BYTES); }
            if constexpr (SP2) {
            PG8_LDB(B0, 0, 0); PG8_LDB(B1, 0, 1); PG8_SCHED; PG8_LDA(At, 0, 0); PG8_STAGE(PG8_SA(1, 1), a1 + hstep, voffA);
            PG8_WAIT_V(8); PG8_WAIT_L(0); PG8_BAR; PG8_MMA(0, 0, At, B0); PG8_MMA(0, 1, At, B1); PG8_BAR; PG8_SCHED;
            PG8_LDA(At, 0, 1); PG8_STAGE(PG8_SB(0, 0), b2, voffB); PG8_STAGE(PG8_SB(0, 1), b2 + hstep, voffB); PG8_STAGE(PG8_SA(0, 0), a2, voffA);
            PG8_WAIT_V(8); PG8_WAIT_L(0); PG8_BAR; PG8_MMA(1, 0, At, B0); PG8_MMA(1, 1, At, B1); PG8_BAR; PG8_SCHED;
            PG8_LDB(B0, 1, 0); PG8_LDB(B1, 1, 1); PG8_SCHED; PG8_LDA(At, 1, 0); PG8_STAGE(PG8_SA(0, 1), a2 + hstep, voffA);
            PG8_WAIT_V(8); PG8_WAIT_L(0); PG8_BAR; PG8_MMA(0, 0, At, B0); PG8_MMA(0, 1, At, B1); PG8_BAR; PG8_SCHED;
            PG8_LDA(At, 1, 1); PG8_STAGE(PG8_SB(1, 0), b3, voffB); PG8_STAGE(PG8_SB(1, 1), b3 + hstep, voffB); PG8_STAGE(PG8_SA(1, 0), a3, voffA);
            PG8_WAIT_V(8); PG8_WAIT_L(0); PG8_BAR; PG8_MMA(1, 0, At, B0); PG8_MMA(1, 1, At, B1); PG8_BAR; PG8_SCHED;
            } else {
            PG8_LDB(B0, 0, 0); PG8_SCHED; PG8_LDA(At, 0, 0); PG8_STAGE(PG8_SA(1, 1), a1 + hstep, voffA);
            PG8_WAIT_L(8); PG8_BAR; PG8_WAIT_L(0); PG8_MMA(0, 0, At, B0); PG8_BAR; PG8_SCHED;
            PG8_LDB(B1, 0, 1); PG8_STAGE(PG8_SB(0, 0), b2, voffB);
            PG8_BAR; PG8_WAIT_L(0); PG8_MMA(0, 1, At, B1); PG8_BAR;
            PG8_LDA(At, 0, 1); PG8_STAGE(PG8_SA(0, 0), a2, voffA);
            PG8_BAR; PG8_WAIT_L(0); PG8_MMA(1, 0, At, B0); PG8_BAR; PG8_SCHED;
            PG8_STAGE(PG8_SB(0, 1), b2 + hstep, voffB);
            PG8_WAIT_V(6); PG8_BAR; PG8_MMA(1, 1, At, B1); PG8_BAR;
            PG8_LDB(B0, 1, 0); PG8_SCHED; PG8_LDA(At, 1, 0); PG8_STAGE(PG8_SA(0, 1), a2 + hstep, voffA);
            PG8_WAIT_L(8); PG8_BAR; PG8_WAIT_L(0); PG8_MMA(0, 0, At, B0); PG8_BAR; PG8_SCHED;
            PG8_LDB(B1, 1, 1); PG8_STAGE(PG8_SB(1, 0), b3, voffB);
            PG8_BAR; PG8_WAIT_L(0); PG8_MMA(0, 1, At, B1); PG8_BAR;
            PG8_LDA(At, 1, 1); PG8_STAGE(PG8_SA(1, 0), a3, voffA);
            PG8_BAR; PG8_WAIT_L(0); PG8_MMA(1, 0, At, B0); PG8_BAR; PG8_SCHED;
            PG8_STAGE(PG8_SB(1, 1), b3 + hstep, voffB);
            PG8_WAIT_V(6); PG8_BAR; PG8_MMA(1, 1, At, B1); PG8_BAR;
            }
        }
        if constexpr (ALIGN_EPI) { if (wr == 0) PG8_BAR; }
        if constexpr (!Epi::AFTER_DRAIN) { E(acc, cur, wr, wc, fr, fq, pf, lds + STAGE_BYTES); S.done(cur); }
        if (!has_next) break;
#pragma unroll
        for (int a = 0; a < 2; ++a)
#pragma unroll
            for (int b = 0; b < 2; ++b)
#pragma unroll
                for (int m = 0; m < 4; ++m)
#pragma unroll
                    for (int n = 0; n < 2; ++n) acc[a][b][m][n] = (f32x4){0.f, 0.f, 0.f, 0.f};
        cur = nxt; cA = nA; cB = nB; ++ui;
        if constexpr (Epi::SEG) { if (pf0) { E.fill_unit(cur, ui, lds + STAGE_BYTES, tid); pf = 2 + (ui & 1); } }
        if constexpr (ALIGN_EPI) { if (wr == 1) PG8_BAR; }
    }
    PG8_WAIT_V(0);
    if constexpr (!ALIGN_EPI) { if (wr == 0) PG8_BAR; }
    PG8_BAR;
    if constexpr (Epi::AFTER_DRAIN) { E.fused(acc, cur, wr, wc, fr, fq, lds, wid, lane); S.done(cur); }
#undef PG8_SA
#undef PG8_SB
#undef PG8_STAGE
#undef PG8_LDA
#undef PG8_LDB
#undef PG8_MMA
#undef PG8_WAIT_V
#undef PG8_WAIT_L
#undef PG8_BAR
#undef PG8_SCHED
}
}

#ifndef PG8_SP2
#define PG8_SP2 true
#endif
#ifndef PG8_ALIGN
#define PG8_ALIGN true
#endif
#ifndef REP_PRO
#define REP_PRO 1
#endif
#ifndef REP_MLSTM
#define REP_MLSTM 1
#endif
#ifndef REP_FOX
#define REP_FOX 1
#endif
#ifndef REP_GLA
#define REP_GLA 1
#endif
#ifndef MK_PER_PHASE
#define MK_PER_PHASE 0
#endif

constexpr int DM = 2048, BATCH = 8, SEQ = 4096, MTOK = BATCH * SEQ, DEPTH = 4, DFF = 5632, NUP = 2 * DFF, NIN = 6160, NINP = 6400, NQKV = 6144;
constexpr int NWAVES = 8;
constexpr int NSUB = 3 * DEPTH;
constexpr int NPHASE = 2 + 5 * NSUB;

constexpr size_t MiB = 1u << 20;
constexpr size_t WS_CTL = 0, CTL_ZERO_BYTES = 11 * MiB;
constexpr size_t WS_SS = 1 * MiB;
constexpr size_t WS_HSS = 5 * MiB;
constexpr size_t WS_WUP = 12 * MiB;
constexpr size_t WS_WDN = WS_WUP + 352 * MiB;
constexpr size_t WS_WIN = WS_WDN + 176 * MiB;
constexpr size_t WS_WOUT = WS_WIN + 100 * MiB;
constexpr size_t WS_HB = WS_WOUT + 32 * MiB;
constexpr size_t WS_ACT = WS_HB + 128 * MiB;
constexpr size_t WS_P1 = WS_ACT + 352 * MiB;
constexpr size_t WS_G = WS_P1 + 384 * MiB;
constexpr size_t WS_HRAW = WS_G + 2 * MiB;
constexpr size_t WS_HM = WS_HRAW + 256 * MiB;
constexpr size_t WS_CF = WS_HM + 128 * MiB;
constexpr size_t WS_END = WS_CF + 2 * MiB;
static_assert((size_t)8 * NUP * DM * 2 == 352 * MiB && (size_t)8 * DM * DFF * 2 == 176 * MiB && (size_t)4 * NINP * DM * 2 == 100 * MiB, "weight regions");
static_assert((size_t)MTOK * DFF * 2 == 352 * MiB && (size_t)MTOK * NQKV * 2 == 384 * MiB && WS_SS + 13 * (size_t)MTOK * 8 <= WS_HSS && WS_HSS + 3 * (size_t)MTOK * 64 <= CTL_ZERO_BYTES && CTL_ZERO_BYTES <= WS_WUP, "activation regions");
constexpr int CW_KMAX = 16384;
constexpr int CW_BAR = 4096;

constexpr int LDS_BYTES = 153600, MISC_OFF = 152576;

#define GAS __attribute__((address_space(1)))
#define LAS __attribute__((address_space(3)))
#define DI __device__ __forceinline__
typedef unsigned short bf16;
typedef unsigned v4u __attribute__((ext_vector_type(4)));
typedef unsigned v2u __attribute__((ext_vector_type(2)));
typedef float f32x4 __attribute__((ext_vector_type(4)));
typedef short bf16x8 __attribute__((ext_vector_type(8)));
typedef GAS unsigned gu32;
#define RLX_AGENT __ATOMIC_RELAXED, __HIP_MEMORY_SCOPE_AGENT
#define LDS_WAIT() asm volatile("s_waitcnt lgkmcnt(0)" ::: "memory")
DI unsigned f2bf(float f) { unsigned r; asm("v_cvt_pk_bf16_f32 %0, %1, %1" : "=v"(r) : "v"(f)); return r & 0xffffu; }
DI unsigned pk2(float lo, float hi) { unsigned r; asm("v_cvt_pk_bf16_f32 %0, %1, %2" : "=v"(r) : "v"(lo), "v"(hi)); return r; }
DI float bf2f(unsigned short v) { return __builtin_bit_cast(float, (unsigned)v << 16); }
DI float bflo(unsigned w) { return __builtin_bit_cast(float, w << 16); }
DI float bfhi(unsigned w) { return __builtin_bit_cast(float, w & 0xffff0000u); }
DI float logsig(float x) { return fminf(x, 0.f) - log1pf(expf(-fabsf(x))); }

#define XB_TMO      128
#define XB_XCNT(j)  (256  + 64 * (j))
#define XB_XSUB(j)  (1280 + 64 * (j))
#define XB_XGEN(j)  (2304 + 64 * (j))
#define XB_TOP      3328
#define XB_TOPGEN   3392
#define XCD_BAR_WORDS 3456
#define XB_SPIN_CAP (1u << 18)

__device__ __forceinline__ unsigned xb_ld(unsigned* p)              { return __hip_atomic_load(p, __ATOMIC_RELAXED, __HIP_MEMORY_SCOPE_AGENT); }
__device__ __forceinline__ unsigned xb_add(unsigned* p, unsigned v) { return __hip_atomic_fetch_add(p, v, __ATOMIC_RELAXED, __HIP_MEMORY_SCOPE_AGENT); }
__device__ __forceinline__ unsigned xb_xcc_id() { return (unsigned)__builtin_amdgcn_s_getreg((3 << 11) | 20) & 0xFu; }
#define XB_SPIN(cond, bar) do { unsigned _sp = 0; while (cond) { __builtin_amdgcn_s_sleep(1); \
    if ((++_sp & 255u) == 0u) { if (xb_ld(&(bar)[XB_TMO])) break; if (_sp > XB_SPIN_CAP) { atomicAdd(&(bar)[XB_TMO], 1u); break; } } } } while (0)

struct XcdBarrier {
    unsigned* bar; unsigned x;
    volatile LAS unsigned* st;
};

__device__ __forceinline__ XcdBarrier xcd_barrier_post(unsigned* bar, volatile LAS unsigned* st) {
    XcdBarrier b; b.bar = bar; b.x = xb_xcc_id(); b.st = st;
    if (threadIdx.x == 0) (void)xb_add(&bar[XB_XCNT(b.x)], 1u);
    return b;
}
__device__ __forceinline__ void xcd_barrier_complete(unsigned* bar, unsigned x, unsigned& nloc, unsigned& nx) {
    const unsigned G = gridDim.x * gridDim.y * gridDim.z;
    unsigned sum, cnt, mine, sp = 0u;
    for (;;) {
        sum = 0u; cnt = 0u; mine = 0u;
#pragma unroll
        for (unsigned j = 0; j < 16; ++j) { const unsigned c = xb_ld(&bar[XB_XCNT(j)]); sum += c; cnt += (c > 0u) ? 1u : 0u; mine = (j == x) ? c : mine; }
        if (sum == G) break;
        __builtin_amdgcn_s_sleep(1);
        if ((++sp & 255u) == 0u) { if (xb_ld(&bar[XB_TMO])) break; if (sp > XB_SPIN_CAP) { atomicAdd(&bar[XB_TMO], 1u); break; } }
    }
    nloc = mine > 0u ? mine : 1u; nx = cnt > 0u ? cnt : 1u;
}

__device__ __forceinline__ void xcd_barrier(const XcdBarrier& b) {
    asm volatile("s_waitcnt vmcnt(0)" ::: "memory");
    __syncthreads();
    if (threadIdx.x == 0) {
        unsigned* bar = b.bar;
        __builtin_amdgcn_s_waitcnt(0);
        unsigned nloc = b.st[0], nx = b.st[1];
        if (nloc == 0u) { xcd_barrier_complete(bar, b.x, nloc, nx); b.st[0] = nloc; b.st[1] = nx; }
        const unsigned old = xb_add(&bar[XB_XSUB(b.x)], 1u);
        const unsigned gen = old / nloc;
        if (old + 1u == (gen + 1u) * nloc) {
            __builtin_amdgcn_fence(__ATOMIC_RELEASE, "agent");
            asm volatile("s_waitcnt vmcnt(0)" ::: "memory");
            const unsigned og = xb_add(&bar[XB_TOP], 1u);
            const unsigned tg = og / nx;
            if (og + 1u == (tg + 1u) * nx) xb_add(&bar[XB_TOPGEN], 1u);
            else XB_SPIN(xb_ld(&bar[XB_TOPGEN]) == tg, bar);
            __builtin_amdgcn_fence(__ATOMIC_ACQUIRE, "agent");
            xb_add(&bar[XB_XGEN(b.x)], 1u);
            asm volatile("s_waitcnt vmcnt(0)" ::: "memory");
        } else {
            XB_SPIN(xb_ld(&bar[XB_XGEN(b.x)]) == gen, bar);
            __builtin_amdgcn_fence(__ATOMIC_ACQUIRE, "agent");
            asm volatile("s_waitcnt vmcnt(0)" ::: "memory");
        }
    }
    __syncthreads();
}


DI float wave_sum(float v) {
#pragma unroll
    for (int o = 1; o < 64; o <<= 1) v += __shfl_xor(v, o);
    return v;
}
DI float wave_max(float v) {
#pragma unroll
    for (int o = 1; o < 64; o <<= 1) v = fmaxf(v, __shfl_xor(v, o));
    return v;
}
DI float wave_incl_sum(float v, int lane) {
#pragma unroll
    for (int o = 1; o < 64; o <<= 1) { const float t = __shfl_up(v, o); if (lane >= o) v += t; }
    return v;
}
DI float wave_incl_max(float v, int lane) {
#pragma unroll
    for (int o = 1; o < 64; o <<= 1) { const float t = __shfl_up(v, o); if (lane >= o) v = fmaxf(v, t); }
    return v;
}

template <int L> DI int swx(int r) { return L == 64 ? ((r >> 1) & 7) : (r & 15); }
template <int L> DI int eoff(int r, int c) { return r * L + ((((c >> 3) ^ swx<L>(r)) << 3) | (c & 7)); }
template <int L> DI bf16x8 ldf(const LAS bf16* base, int r, int ch) { return *(const LAS bf16x8*)(base + r * L + ((ch ^ swx<L>(r)) << 3)); }
DI f32x4 mfma16(bf16x8 a, bf16x8 b, f32x4 c) { return __builtin_amdgcn_mfma_f32_16x16x32_bf16(a, b, c, 0, 0, 0); }
typedef short v4i16_t __attribute__((ext_vector_type(4)));
DI v4i16_t tr_read(const LAS unsigned char* p) { return __builtin_amdgcn_ds_read_tr16_b64_v4i16((LAS v4i16_t*)p); }
DI bf16x8 cat4(v4i16_t lo, v4i16_t hi) { bf16x8 r; r[0] = lo[0]; r[1] = lo[1]; r[2] = lo[2]; r[3] = lo[3]; r[4] = hi[0]; r[5] = hi[1]; r[6] = hi[2]; r[7] = hi[3]; return r; }
DI unsigned off_v64(unsigned row, unsigned ch) { return 128u * row + 16u * (ch ^ ((((row >> 1) & 1u) << 1) | (((row >> 3) & 1u) << 2))); }
DI bf16x8 vfrag64(const LAS unsigned char* vb, int c, int ks, int lane) { const unsigned g = lane >> 4, q = (lane & 15) >> 2, p = lane & 3;
    return cat4(tr_read(vb + off_v64(32 * ks + 8 * g + q, 2 * c + (p >> 1)) + 8 * (p & 1)), tr_read(vb + off_v64(32 * ks + 8 * g + 4 + q, 2 * c + (p >> 1)) + 8 * (p & 1))); }
template <int LA, int LB, int NK> DI void mma_tile(f32x4& acc, const LAS bf16* A, int ra0, const LAS bf16* B, int rb0, int lane) {
    const int r = lane & 15, g = lane >> 4;
#pragma unroll
    for (int kk = 0; kk < NK; ++kk) { const bf16x8 a = ldf<LA>(A, ra0 + r, 4 * kk + g), b = ldf<LB>(B, rb0 + r, 4 * kk + g); acc = mfma16(a, b, acc); }
}

struct ConvItem { const float* W; const float* gk; bf16* WT; int K, N, mode, r; };
DI void conv_load(const ConvItem& c, int lane, f32x4 (&v)[8], float (&gv)[8]) {
    const int nkb = c.K / 64, nb = c.r / nkb, kb = c.r - nb * nkb, k0 = 64 * kb, n0 = 32 * nb;
    const int n = n0 + 4 * (lane & 7); const bool ok = n < c.N;
#pragma unroll
    for (int i = 0; i < 8; ++i) { const int kk = 8 * i + (lane >> 3); v[i] = ok ? *(const f32x4*)(c.W + (size_t)(k0 + kk) * c.N + n) : (f32x4){0.f, 0.f, 0.f, 0.f}; gv[i] = c.gk ? c.gk[k0 + kk] : 1.0f; }
}
DI void conv_store(const ConvItem& c, int lane, const f32x4 (&v)[8], const float (&gv)[8], LAS float* scr) {
    const int nkb = c.K / 64, nb = c.r / nkb, kb = c.r - nb * nkb, k0 = 64 * kb, n0 = 32 * nb, nq = 4 * (lane & 7);
#pragma unroll
    for (int i = 0; i < 8; ++i) { const int kk = 8 * i + (lane >> 3); LAS float* d = scr + kk * 33 + nq; d[0] = v[i].x * gv[i]; d[1] = v[i].y * gv[i]; d[2] = v[i].z * gv[i]; d[3] = v[i].w * gv[i]; }
    LDS_WAIT(); asm volatile("" ::: "memory");
    int row_off = n0;
    if (c.mode == 1) { const int j = n0 < DFF ? n0 : n0 - DFF; row_off = 256 * (j >> 7) + (j & 127) + (n0 < DFF ? 0 : 128); }
    const int cc = lane & 7;
#pragma unroll
    for (int j = 0; j < 4; ++j) { const int nn = (lane >> 3) + 8 * j; const LAS float* s = scr + (8 * cc) * 33 + nn;
        v4u o; o.x = pk2(s[0 * 33], s[1 * 33]); o.y = pk2(s[2 * 33], s[3 * 33]); o.z = pk2(s[4 * 33], s[5 * 33]); o.w = pk2(s[6 * 33], s[7 * 33]);
        *(v4u*)(c.WT + (size_t)(row_off + nn) * c.K + k0 + 8 * cc) = o; }
    LDS_WAIT(); asm volatile("" ::: "memory");
}

struct Args { const float* in[18]; float* out; unsigned char* ws; int ph_lo, ph_hi; };

typedef const __attribute__((address_space(4))) Args* KArgs;
DI KArgs kargs() { KArgs p = (KArgs)__builtin_amdgcn_kernarg_segment_ptr(); asm volatile("" : "+s"(p)); return p; }
DI void prologue(LAS unsigned char* lds, int lane, int wave, int bx) {
    KArgs AP = kargs();
    LAS float* scr = (LAS float*)(lds + wave * 16384);
    const int gw = bx * NWAVES + wave, NGW = gridDim.x * NWAVES;
    unsigned char* ws = AP->ws;
    constexpr int I_UP = (DM / 64) * (NUP / 32), I_DN = (DFF / 64) * (DM / 32), I_IN = (DM / 64) * (NINP / 32), I_OUT = (DM / 64) * (DM / 32);
    constexpr int NITEMS = 8 * I_UP + 8 * I_DN + 4 * I_IN + 4 * I_OUT;
#define CONV_DECODE(it_, c_) do { int r = (it_); (c_).gk = nullptr; (c_).K = DM; (c_).mode = 0; \
        if (r < 8 * I_UP) { const int mi = r / I_UP; r -= mi * I_UP; (c_).W = AP->in[2] + (size_t)mi * DM * NUP; (c_).gk = AP->in[1] + (size_t)mi * DM; (c_).WT = (bf16*)(ws + WS_WUP) + (size_t)mi * NUP * DM; (c_).N = NUP; (c_).mode = 1; } \
        else if (r < 8 * I_UP + 8 * I_DN) { r -= 8 * I_UP; const int mi = r / I_DN; r -= mi * I_DN; (c_).W = AP->in[3] + (size_t)mi * DFF * DM; (c_).WT = (bf16*)(ws + WS_WDN) + (size_t)mi * DM * DFF; (c_).K = DFF; (c_).N = DM; } \
        else if (r < 8 * I_UP + 8 * I_DN + 4 * I_IN) { r -= 8 * I_UP + 8 * I_DN; const int l = r / I_IN; r -= l * I_IN; const int kind = l % 3, ji = l / 3; \
            (c_).W = AP->in[kind == 0 ? 5 : kind == 1 ? 9 : 12] + (size_t)ji * DM * NIN; (c_).gk = AP->in[4] + (size_t)l * DM; (c_).WT = (bf16*)(ws + WS_WIN) + (size_t)l * NINP * DM; (c_).N = NIN; } \
        else { r -= 8 * I_UP + 8 * I_DN + 4 * I_IN; const int l = r / I_OUT; r -= l * I_OUT; const int kind = l % 3, ji = l / 3; \
            (c_).W = AP->in[kind == 0 ? 8 : kind == 1 ? 11 : 16] + (size_t)ji * DM * DM; if (kind != 1) (c_).gk = AP->in[kind == 0 ? 7 : 15] + (size_t)ji * DM; (c_).WT = (bf16*)(ws + WS_WOUT) + (size_t)l * DM * DM; (c_).N = DM; } \
        (c_).r = r; } while (0)
    f32x4 va[8]; float ga[8]; ConvItem ca{}, cb{};
    if (gw < NITEMS) { CONV_DECODE(gw, ca); conv_load(ca, lane, va, ga); }
    for (int it = gw; it < NITEMS; it += NGW) {
        f32x4 vb[8]; float gb[8]; const int nx = it + NGW;
        if (nx < NITEMS) { CONV_DECODE(nx, cb); conv_load(cb, lane, vb, gb); }
        conv_store(ca, lane, va, ga, scr);
        ca = cb;
#pragma unroll
        for (int i = 0; i < 8; ++i) { va[i] = vb[i]; ga[i] = gb[i]; }
    }
#undef CONV_DECODE
    const float* x = AP->in[0]; bf16* hb = (bf16*)(ws + WS_HB); long long* ss0 = (long long*)(ws + WS_SS);
    for (int m = gw; m < MTOK; m += NGW) {
        const f32x4* xr = (const f32x4*)(x + (size_t)m * DM) + lane; f32x4 v[8]; float s = 0.f;
#pragma unroll
        for (int j = 0; j < 8; ++j) { v[j] = xr[64 * j]; s += (v[j].x * v[j].x + v[j].y * v[j].y) + (v[j].z * v[j].z + v[j].w * v[j].w); }
        s = wave_sum(s);
        v2u* o8 = (v2u*)(hb + (size_t)m * DM) + lane;
#pragma unroll
        for (int j = 0; j < 8; ++j) { v2u w; w.x = pk2(v[j].x, v[j].y); w.y = pk2(v[j].z, v[j].w); o8[64 * j] = w; }
        if (lane == 0) ss0[m] = __float2ll_rn(s * 1048576.0f);
    }
}

constexpr int IMGM_P = 0, IMGM_KT = 8192, IMGM_VT = IMGM_KT + 16384, IMGM_GS = IMGM_VT + 4 * 8192, IMGM_BYTES = IMGM_GS + 1024;
constexpr int IMGG_Q = 0, IMGG_KT = 32768, IMGG_P = 65536, IMGG_VT = IMGG_P + 8192, IMGG_EB = IMGG_VT + 8 * 8192, IMGG_BYTES = IMGG_EB + 1024;
static_assert((size_t)IMGM_BYTES * 4096 <= 352 * MiB && (size_t)IMGG_BYTES * 2048 <= 352 * MiB, "images overlay the (idle) FFN activation buffer");
DI unsigned pk2_sw(float lo, float hi) { unsigned a = __builtin_bit_cast(unsigned, lo), b = __builtin_bit_cast(unsigned, hi); a = (a + 0x7fffu + ((a >> 16) & 1u)) >> 16; b = (b + 0x7fffu + ((b >> 16) & 1u)) & 0xffff0000u; return a | b; }
DI float logsig_fast(float x) { return fminf(x, 0.f) - __logf(1.0f + __expf(-fabsf(x))); }

DI void mlstm_pre(LAS unsigned char* lds, const bf16* P1, const float* G, const float* b_if, unsigned char* img, int tid, int lane, int wave, int bx) {
    LAS bf16* Qs = (LAS bf16*)lds;
    LAS bf16* Ks = Qs + 64 * 128;
    LAS bf16* KTs = Ks + 64 * 128;
    LAS bf16* Ps = KTs + 128 * 64;
    LAS bf16* VT = Ps + 64 * 64;
    LAS float* fa = (LAS float*)(VT + 256 * 64);
    LAS float *bcum = fa, *ipre = fa + 64, *aloc = fa + 128, *wloc = fa + 192, *scal = fa + 256;
    const float KSCALE = 0.08838834764831845f;
    const int g = lane >> 4, r16 = lane & 15;
    v4u pq[2], pk[2]; float pgi = 0.f, pgf = 0.f;
#define MLP_LOAD(it_) do { const int b_ = (it_) >> 9, c_ = ((it_) >> 3) & 63, h_ = (it_) & 7; const int row0_ = b_ * SEQ + c_ * 64; \
        _Pragma("unroll") for (int p = 0; p < 2; ++p) { const int idx = tid + 512 * p, r = idx >> 4, c8 = idx & 15; const bf16* src = P1 + (size_t)(row0_ + r) * NQKV + h_ * 128 + c8 * 8; pq[p] = *(const v4u*)src; pk[p] = *(const v4u*)(src + 1024); } \
        if (tid < 64) { const float* gp = G + (size_t)(row0_ + tid) * 16; pgi = gp[h_]; pgf = gp[8 + h_]; } } while (0)
    if (bx < 4096) MLP_LOAD(bx);
    for (int item = bx; item < 4096; item += gridDim.x) {
        const int h = item & 7;
        unsigned char* im = img + (size_t)item * IMGM_BYTES;
        __syncthreads();
        if (tid < 64) { ipre[tid] = pgi + b_if[h]; bcum[tid] = logsig(pgf + b_if[8 + h]); }
#pragma unroll
        for (int p = 0; p < 2; ++p) { const int idx = tid + 512 * p, r = idx >> 4, c8 = idx & 15; *(LAS v4u*)(Qs + eoff<128>(r, c8 * 8)) = pq[p]; *(LAS v4u*)(Ks + eoff<128>(r, c8 * 8)) = pk[p]; }
        __syncthreads();
        if (wave == 0) {
            const float bt = wave_incl_sum(bcum[lane], lane), ip = ipre[lane];
            const float al = bt + wave_incl_max(ip - bt, lane);
            const float blast = __shfl(bt, 63);
            const float gg = blast - bt + ip;
            const float gmax = wave_max(gg);
            bcum[lane] = bt; aloc[lane] = al; wloc[lane] = __expf(gg - gmax);
            if (lane == 0) { scal[0] = blast; scal[1] = gmax; }
        }
        if (item + (int)gridDim.x < 4096) MLP_LOAD(item + (int)gridDim.x);
        __syncthreads();
#pragma unroll
        for (int p = 0; p < 2; ++p) { const int idx = tid + 512 * p, s = idx >> 4, c8 = idx & 15; const v4u kv = *(const LAS v4u*)(Ks + eoff<128>(s, c8 * 8)); const float w = wloc[s] * KSCALE;
#pragma unroll
            for (int j = 0; j < 4; ++j) { KTs[eoff<64>(c8 * 8 + 2 * j, s)] = (bf16)f2bf(bflo(kv[j]) * w); KTs[eoff<64>(c8 * 8 + 2 * j + 1, s)] = (bf16)f2bf(bfhi(kv[j]) * w); } }
        { const int tt = wave >> 1;
#pragma unroll
          for (int q2 = 0; q2 < 2; ++q2) { const int st = 2 * (wave & 1) + q2; f32x4 acc = (f32x4){0.f, 0.f, 0.f, 0.f};
            if (st <= tt) mma_tile<128, 128, 4>(acc, Qs, 16 * tt, Ks, 16 * st, lane);
            const int s = 16 * st + r16; const float cs = ipre[s] - bcum[s];
#pragma unroll
            for (int i = 0; i < 4; ++i) { const int t = 16 * tt + 4 * g + i; const float p = (s <= t) ? acc[i] * KSCALE * __expf(bcum[t] + cs - aloc[t]) : 0.f; Ps[eoff<64>(t, s)] = (bf16)f2bf(p); } } }
        __syncthreads();
        *(v4u*)(im + IMGM_P + tid * 16) = *(const LAS v4u*)((LAS unsigned char*)Ps + tid * 16);
#pragma unroll
        for (int p = 0; p < 2; ++p) *(v4u*)(im + IMGM_KT + (tid + 512 * p) * 16) = *(const LAS v4u*)((LAS unsigned char*)KTs + (tid + 512 * p) * 16);
        if (tid < 64) { float* gs = (float*)(im + IMGM_GS); gs[tid] = bcum[tid]; gs[64 + tid] = aloc[tid]; if (tid < 2) gs[128 + tid] = scal[tid]; }
    }
#undef MLP_LOAD
}

DI void mlstm_scan2(LAS unsigned char* lds, const bf16* P1, const unsigned char* img, bf16* hm, long long* hss, int tid, int lane, int wave, int bx) {
    constexpr int IB = 8192 + 16384 + 16384 + 10240 + 1024;
    LAS bf16* CT0 = (LAS bf16*)(lds + 2 * IB);
    const int g = lane >> 4, r16 = lane & 15, tt = wave >> 1, eh = wave & 1;
    for (int item0 = bx; item0 < 256; item0 += gridDim.x) {
        const int item = (gridDim.x == 256) ? (item0 & 7) * 32 + (item0 >> 3) : item0;
        const int b = item >> 5, h = (item >> 2) & 7, sl = item & 3;
        f32x4 Cacc[5];
#pragma unroll
        for (int e = 0; e < 5; ++e) Cacc[e] = (f32x4){0.f, 0.f, 0.f, 0.f};
        __syncthreads();
        for (int i = tid; i < 2 * 80 * 128 / 8; i += 512) ((LAS v4u*)CT0)[i] = (v4u){0u, 0u, 0u, 0u};
        float m_prev = 0.f;
        v4u rp, rq[2], rk[2], rv; float rg0 = 0.f, rbl, rgm;
#define MLS_PREFETCH(cc) do { const int item2 = (b * 64 + (cc)) * 8 + h; const unsigned char* im = img + (size_t)item2 * IMGM_BYTES; const int row0_ = b * SEQ + (cc) * 64; \
            rp = *(const v4u*)(im + IMGM_P + tid * 16); rk[0] = *(const v4u*)(im + IMGM_KT + tid * 16); rk[1] = *(const v4u*)(im + IMGM_KT + (tid + 512) * 16); \
            rv = *(const v4u*)(P1 + (size_t)(row0_ + (tid >> 3)) * NQKV + 2048 + h * 256 + sl * 64 + (tid & 7) * 8); \
            _Pragma("unroll") for (int p = 0; p < 2; ++p) { const int idx = tid + 512 * p, r = idx >> 4, c8 = idx & 15; rq[p] = *(const v4u*)(P1 + (size_t)(row0_ + r) * NQKV + h * 128 + c8 * 8); } \
            const float* gs = (const float*)(im + IMGM_GS); if (tid < 128) rg0 = gs[tid]; rbl = gs[128]; rgm = gs[129]; } while (0)
#define MLS_STORE(bi) do { LAS unsigned char* bb = lds + (bi) * IB; \
            *(LAS v4u*)(bb + tid * 16) = rp; *(LAS v4u*)(bb + 8192 + 16384 + tid * 16) = rk[0]; *(LAS v4u*)(bb + 8192 + 16384 + (tid + 512) * 16) = rk[1]; \
            *(LAS v4u*)(bb + 8192 + 16384 + 16384 + off_v64(tid >> 3, tid & 7)) = rv; \
            _Pragma("unroll") for (int p = 0; p < 2; ++p) { const int idx = tid + 512 * p, r = idx >> 4, c8 = idx & 15; *(LAS v4u*)((LAS bf16*)(bb + 8192) + eoff<128>(r, c8 * 8)) = rq[p]; } \
            if (tid < 128) ((LAS float*)(bb + 8192 + 16384 + 16384 + 10240))[tid] = rg0; } while (0)
        MLS_PREFETCH(0); MLS_STORE(0);
        float blast = rbl, gmax = rgm;
        MLS_PREFETCH(1);
        __syncthreads();
        for (int c = 0; c < 64; ++c) {
            const int row0 = b * SEQ + c * 64;
            const LAS unsigned char* bb = lds + (c & 1) * IB;
            const LAS bf16* Ps = (const LAS bf16*)bb; const LAS bf16* Qs = (const LAS bf16*)(bb + 8192); const LAS bf16* KTs = (const LAS bf16*)(bb + 8192 + 16384);
            const LAS bf16* VTs = (const LAS bf16*)(bb + 8192 + 16384 + 16384); const LAS float* gsl = (const LAS float*)(bb + 8192 + 16384 + 16384 + 10240);
            LAS bf16* CTc = CT0 + (c & 1) * 80 * 128; LAS bf16* CTn = CT0 + ((c + 1) & 1) * 80 * 128;
            const int t = 16 * tt + r16;
            v2u gt[2];
#pragma unroll
            for (int q2 = 0; q2 < 2; ++q2) gt[q2] = *(const v2u*)(P1 + (size_t)(row0 + t) * NQKV + 4096 + h * 256 + sl * 64 + 16 * (2 * eh + q2) + 4 * g);
            float sq = 0.f;
            const float btv = gsl[t], alv = gsl[64 + t];
            const float mt = fmaxf(btv + m_prev, alv), al = __expf(alv - mt), be = __expf(btv + m_prev - mt), em = __expf(-mt);
            const float m_new = fmaxf(blast + m_prev, gmax), wcs = __expf(blast + m_prev - m_new), gam = __expf(gmax - m_new);
            m_prev = m_new;
            const LAS unsigned char* vb = (const LAS unsigned char*)VTs;
            bf16x8 onesf;
#pragma unroll
            for (int j = 0; j < 8; ++j) onesf[j] = (r16 == 0) ? (short)0x3f80 : (short)0;
            const bf16x8 pa0 = ldf<64>(Ps, 16 * tt + r16, g), pa1 = ldf<64>(Ps, 16 * tt + r16, 4 + g);
            f32x4 d1 = (f32x4){0.f, 0.f, 0.f, 0.f}, d2 = (f32x4){0.f, 0.f, 0.f, 0.f};
            d1 = mfma16(onesf, pa0, d1); d1 = mfma16(onesf, pa1, d1); mma_tile<128, 128, 4>(d2, CTc, 64, Qs, 16 * tt, lane);
            const float den = __shfl(al * d1[0] + be * d2[0], r16);
            const float dinv = __builtin_amdgcn_rcpf(fmaxf(fabsf(den), em));
#pragma unroll
            for (int q2 = 0; q2 < 2; ++q2) { const int et = 2 * eh + q2; f32x4 a1 = (f32x4){0.f, 0.f, 0.f, 0.f}, a2 = (f32x4){0.f, 0.f, 0.f, 0.f};
                a1 = mfma16(vfrag64(vb, et, 0, lane), pa0, a1); a1 = mfma16(vfrag64(vb, et, 1, lane), pa1, a1); mma_tile<128, 128, 4>(a2, CTc, 16 * et, Qs, 16 * tt, lane);
                const f32x4 o4 = (a1 * al + a2 * be) * dinv; sq += (o4[0] * o4[0] + o4[1] * o4[1]) + (o4[2] * o4[2] + o4[3] * o4[3]);
                const float s0 = __builtin_amdgcn_rcpf(1.0f + __expf(-bflo(gt[q2].x))), s1 = __builtin_amdgcn_rcpf(1.0f + __expf(-bfhi(gt[q2].x)));
                const float s2 = __builtin_amdgcn_rcpf(1.0f + __expf(-bflo(gt[q2].y))), s3 = __builtin_amdgcn_rcpf(1.0f + __expf(-bfhi(gt[q2].y)));
                v2u w; w.x = pk2(o4[0] * s0, o4[1] * s1); w.y = pk2(o4[2] * s2, o4[3] * s3);
                *(v2u*)(hm + (size_t)(row0 + t) * DM + h * 256 + sl * 64 + 16 * et + 4 * g) = w; }
            sq += __shfl_xor(sq, 16); sq += __shfl_xor(sq, 32);
            if (g == 0) atomicAdd((unsigned long long*)(hss + (size_t)(row0 + t) * 8 + h), (unsigned long long)__float2ll_rn(sq * pg8::HSS_FIX));
            const bf16x8 ka0 = ldf<64>(KTs, 16 * wave + r16, g), ka1 = ldf<64>(KTs, 16 * wave + r16, 4 + g);
#pragma unroll
            for (int et = 0; et < 5; ++et) { f32x4 tmp = (f32x4){0.f, 0.f, 0.f, 0.f};
                tmp = mfma16(ka0, et < 4 ? vfrag64(vb, et & 3, 0, lane) : onesf, tmp); tmp = mfma16(ka1, et < 4 ? vfrag64(vb, et & 3, 1, lane) : onesf, tmp);
                Cacc[et] = Cacc[et] * wcs + tmp * gam;
                v2u w; w.x = pk2(Cacc[et][0], Cacc[et][1]); w.y = pk2(Cacc[et][2], Cacc[et][3]);
                *(LAS v2u*)(CTn + eoff<128>(16 * et + r16, 16 * wave + 4 * g)) = w; }
            if (c + 1 < 64) { MLS_STORE((c + 1) & 1); blast = rbl; gmax = rgm; }
            if (c + 2 < 64) MLS_PREFETCH(c + 2);
            __syncthreads();
        }
#undef MLS_PREFETCH
#undef MLS_STORE
    }
}

DI void gla_pre(LAS unsigned char* lds, const bf16* P1, const float* G, const float* w_alpha, const float* b_alpha, unsigned char* img, int tid, int lane, int wave, int bx) {
    LAS bf16* VT = (LAS bf16*)lds;
    LAS bf16* QTs = (LAS bf16*)lds;
    LAS bf16* KTl = QTs + 64 * 256;
    LAS bf16* KTT = KTl + 64 * 256;
    LAS bf16* Ps = KTT + 256 * 64;
    LAS float* alow = (LAS float*)(Ps + 64 * 64);
    LAS float* T0 = alow + 1024;
    const int g = lane >> 4, r16 = lane & 15, d = tid & 255, sh = tid >> 8;
    for (int item = bx; item < 2048; item += gridDim.x) {
        const int b = item >> 8, c = (item >> 2) & 63, h = item & 3;
        const int row0 = b * SEQ + c * 64;
        unsigned char* im = img + (size_t)item * IMGG_BYTES;
        __syncthreads();
        float wa[16];
#pragma unroll
        for (int i = 0; i < 16; ++i) wa[i] = w_alpha[i * 1024 + h * 256 + d];
        const float ba = b_alpha[h * 256 + d];
        f32x4 al4 = (f32x4){0.f, 0.f, 0.f, 0.f};
        if (tid < 256) al4 = *(const f32x4*)(G + (size_t)(row0 + (tid >> 2)) * 16 + (tid & 3) * 4);
        if (tid < 256) *(LAS f32x4*)(alow + tid * 4) = al4;
        __syncthreads();
        const bf16* qsrc = P1 + (size_t)(row0 + 32 * sh) * NQKV + h * 256 + d;
        float bs[32]; float run = 0.f;
#pragma unroll
        for (int j = 0; j < 32; ++j) { const int s = 32 * sh + j; float z = ba;
#pragma unroll
            for (int i = 0; i < 16; ++i) z += alow[s * 16 + i] * wa[i];
            run += logsig_fast(z) * (1.0f / 16.0f); bs[j] = run; }
        if (sh == 0) T0[d] = run;
        __syncthreads();
        const float add = sh ? T0[d] : 0.f;
        if (sh) ((float*)(im + IMGG_EB))[d] = __expf(run + add);
#pragma unroll
        for (int q8 = 0; q8 < 4; ++q8) { unsigned kk[8];
#pragma unroll
            for (int j = 0; j < 8; ++j) { const int jj = 8 * q8 + j, s = 32 * sh + jj; const float bsum = bs[jj] + add;
                const float qv = bf2f(qsrc[(size_t)jj * NQKV]) * 0.0625f * __expf(bsum), kv = bf2f(qsrc[(size_t)jj * NQKV + 1024]) * __expf(-bsum);
                QTs[eoff<256>(s, d)] = (bf16)f2bf(qv); kk[j] = f2bf(kv); KTl[eoff<256>(s, d)] = (bf16)kk[j]; }
            v4u w; w.x = kk[0] | (kk[1] << 16); w.y = kk[2] | (kk[3] << 16); w.z = kk[4] | (kk[5] << 16); w.w = kk[6] | (kk[7] << 16);
            *(LAS v4u*)(KTT + eoff<64>(d, 32 * sh + 8 * q8)) = w; }
        __syncthreads();
        { const int tt = wave >> 1;
#pragma unroll
          for (int q2 = 0; q2 < 2; ++q2) { const int st = 2 * (wave & 1) + q2; f32x4 acc = (f32x4){0.f, 0.f, 0.f, 0.f};
            if (st <= tt) mma_tile<256, 256, 8>(acc, QTs, 16 * tt, KTl, 16 * st, lane);
            const int s = 16 * st + r16;
#pragma unroll
            for (int i = 0; i < 4; ++i) { const int t = 16 * tt + 4 * g + i; Ps[eoff<64>(t, s)] = (bf16)f2bf((s <= t) ? acc[i] : 0.f); } } }
        __syncthreads();
#pragma unroll
        for (int p = 0; p < 4; ++p) { *(v4u*)(im + IMGG_Q + (tid + 512 * p) * 16) = *(const LAS v4u*)((LAS unsigned char*)QTs + (tid + 512 * p) * 16);
                                      *(v4u*)(im + IMGG_KT + (tid + 512 * p) * 16) = *(const LAS v4u*)((LAS unsigned char*)KTT + (tid + 512 * p) * 16); }
        *(v4u*)(im + IMGG_P + tid * 16) = *(const LAS v4u*)((LAS unsigned char*)Ps + tid * 16);
    }
}

DI void gla_scan2(LAS unsigned char* lds, const bf16* P1, const unsigned char* img, bf16* hm, long long* hss, int tid, int lane, int wave, int bx) {
    LAS bf16* QTs = (LAS bf16*)lds;
    LAS bf16* KTT = QTs + 64 * 256;
    LAS bf16* Ps = KTT + 256 * 64;
    LAS bf16* VTs = Ps + 64 * 64;
    LAS float* eb = (LAS float*)(VTs + 64 * 64);
    LAS bf16* ST0 = (LAS bf16*)(eb + 256);
    const int g = lane >> 4, r16 = lane & 15, tt = wave >> 1, eh = wave & 1;
    for (int item0 = bx; item0 < 256; item0 += gridDim.x) {
        const int item = (gridDim.x == 256) ? (item0 & 7) * 32 + (item0 >> 3) : item0;
        const int b = item >> 5, h = (item >> 3) & 3, sl = item & 7;
        f32x4 Sacc[2][4];
#pragma unroll
        for (int a = 0; a < 2; ++a)
#pragma unroll
            for (int e = 0; e < 4; ++e) Sacc[a][e] = (f32x4){0.f, 0.f, 0.f, 0.f};
        __syncthreads();
        for (int i = tid; i < 2 * 64 * 256 / 8; i += 512) ((LAS v4u*)ST0)[i] = (v4u){0u, 0u, 0u, 0u};
        v4u rq[4], rk[4], rp, rv; float re = 0.f;
#define GLS_PREFETCH(cc) do { const int item2 = (b * 64 + (cc)) * 4 + h; const unsigned char* im = img + (size_t)item2 * IMGG_BYTES; \
            _Pragma("unroll") for (int p = 0; p < 4; ++p) { rq[p] = *(const v4u*)(im + IMGG_Q + (tid + 512 * p) * 16); rk[p] = *(const v4u*)(im + IMGG_KT + (tid + 512 * p) * 16); } \
            rp = *(const v4u*)(im + IMGG_P + tid * 16); rv = *(const v4u*)(P1 + ((size_t)b * SEQ + (cc) * 64 + (tid >> 3)) * NQKV + 2048 + h * 512 + sl * 64 + (tid & 7) * 8); if (tid < 256) re = ((const float*)(im + IMGG_EB))[tid]; } while (0)
        GLS_PREFETCH(0);
        for (int c = 0; c < 64; ++c) {
            const int row0 = b * SEQ + c * 64;
            LAS bf16* STc = ST0 + (c & 1) * 64 * 256; LAS bf16* STn = ST0 + ((c + 1) & 1) * 64 * 256;
            __syncthreads();
#pragma unroll
            for (int p = 0; p < 4; ++p) { *(LAS v4u*)((LAS unsigned char*)QTs + (tid + 512 * p) * 16) = rq[p]; *(LAS v4u*)((LAS unsigned char*)KTT + (tid + 512 * p) * 16) = rk[p]; }
            *(LAS v4u*)((LAS unsigned char*)Ps + tid * 16) = rp; *(LAS v4u*)((LAS unsigned char*)VTs + off_v64(tid >> 3, tid & 7)) = rv;
            if (tid < 256) eb[tid] = re;
            __syncthreads();
            if (c + 1 < 64) GLS_PREFETCH(c + 1);
            v2u gt[2];
#pragma unroll
            for (int q2 = 0; q2 < 2; ++q2) gt[q2] = *(const v2u*)(P1 + (size_t)(row0 + 16 * tt + r16) * NQKV + 4096 + h * 512 + sl * 64 + 16 * (2 * eh + q2) + 4 * g);
            float sq = 0.f;
            const LAS unsigned char* vb = (const LAS unsigned char*)VTs;
            const bf16x8 pa0 = ldf<64>(Ps, 16 * tt + r16, g), pa1 = ldf<64>(Ps, 16 * tt + r16, 4 + g);
#pragma unroll
            for (int q2 = 0; q2 < 2; ++q2) { const int et = 2 * eh + q2; f32x4 acc = (f32x4){0.f, 0.f, 0.f, 0.f};
                acc = mfma16(vfrag64(vb, et, 0, lane), pa0, acc); acc = mfma16(vfrag64(vb, et, 1, lane), pa1, acc); mma_tile<256, 256, 8>(acc, STc, 16 * et, QTs, 16 * tt, lane);
                sq += (acc[0] * acc[0] + acc[1] * acc[1]) + (acc[2] * acc[2] + acc[3] * acc[3]);
                const float g0 = bflo(gt[q2].x), g1 = bfhi(gt[q2].x), g2 = bflo(gt[q2].y), g3 = bfhi(gt[q2].y);
                const float o0 = acc[0] * (g0 * __builtin_amdgcn_rcpf(1.0f + __expf(-g0))), o1 = acc[1] * (g1 * __builtin_amdgcn_rcpf(1.0f + __expf(-g1)));
                const float o2 = acc[2] * (g2 * __builtin_amdgcn_rcpf(1.0f + __expf(-g2))), o3 = acc[3] * (g3 * __builtin_amdgcn_rcpf(1.0f + __expf(-g3)));
                v2u w; w.x = pk2_sw(o0, o1); w.y = pk2_sw(o2, o3);
                *(v2u*)(hm + (size_t)(row0 + 16 * tt + r16) * DM + h * 512 + sl * 64 + 16 * et + 4 * g) = w; }
            sq += __shfl_xor(sq, 16); sq += __shfl_xor(sq, 32);
            if (g == 0) atomicAdd((unsigned long long*)(hss + (size_t)(row0 + 16 * tt + r16) * 4 + h), (unsigned long long)__float2ll_rn(sq * pg8::HSS_FIX));
#pragma unroll
            for (int a = 0; a < 2; ++a) { const int dt = 2 * wave + a;
                const f32x4 ev = *(const LAS f32x4*)(eb + 16 * dt + 4 * g);
                const bf16x8 ka0 = ldf<64>(KTT, 16 * dt + r16, g), ka1 = ldf<64>(KTT, 16 * dt + r16, 4 + g);
#pragma unroll
                for (int et = 0; et < 4; ++et) { Sacc[a][et] = mfma16(ka0, vfrag64(vb, et, 0, lane), Sacc[a][et]); Sacc[a][et] = mfma16(ka1, vfrag64(vb, et, 1, lane), Sacc[a][et]); Sacc[a][et] = Sacc[a][et] * ev;
                    v2u w; w.x = pk2(Sacc[a][et][0], Sacc[a][et][1]); w.y = pk2(Sacc[a][et][2], Sacc[a][et][3]);
                    *(LAS v2u*)(STn + eoff<256>(16 * et + r16, 16 * dt + 4 * g)) = w; } }
        }
#undef GLS_PREFETCH
    }
}


DI void mixer_gates(const bf16* hb, const bf16* wg, const long long* ss, float* G, int lane, int wave, int bx) {
    const int g = lane >> 4, r16 = lane & 15;
    for (int t = bx * NWAVES + wave; t < MTOK / 16; t += gridDim.x * NWAVES) {
        const bf16* ap = hb + (size_t)(16 * t + r16) * DM + 8 * g; const bf16* bp = wg + (size_t)r16 * DM + 8 * g;
        f32x4 acc = (f32x4){0.f, 0.f, 0.f, 0.f};
#pragma unroll 8
        for (int kk = 0; kk < DM / 32; ++kk) { const bf16x8 a = *(const bf16x8*)(ap + 32 * kk), b = *(const bf16x8*)(bp + 32 * kk); acc = mfma16(a, b, acc); }
#pragma unroll
        for (int i = 0; i < 4; ++i) { const int row = 16 * t + 4 * g + i; G[(size_t)row * 16 + r16] = acc[i] * pg8::rstd_of(ss, row); }
    }
}

template <int HS, int ACT> DI void headnorm_gate(const bf16* hraw, const bf16* P1, const float* gnorm, bf16* hm, int lane, int wave, int bx) {
    constexpr int NH = DM / HS, EPL = HS / 64;
    const int gw = bx * NWAVES + wave, NGW = gridDim.x * NWAVES;
    for (int row = gw; row < MTOK; row += NGW) {
#pragma unroll
        for (int hh = 0; hh < NH; ++hh) { const int col = hh * HS + lane * EPL;
            unsigned xw[EPL / 2], gwd[EPL / 2];
            if constexpr (EPL == 4) { const v2u a = *(const v2u*)(hraw + (size_t)row * DM + col), b2 = *(const v2u*)(P1 + (size_t)row * NQKV + 4096 + col); xw[0] = a.x; xw[1] = a.y; gwd[0] = b2.x; gwd[1] = b2.y; }
            else { const v4u a = *(const v4u*)(hraw + (size_t)row * DM + col), b2 = *(const v4u*)(P1 + (size_t)row * NQKV + 4096 + col); xw[0] = a.x; xw[1] = a.y; xw[2] = a.z; xw[3] = a.w; gwd[0] = b2.x; gwd[1] = b2.y; gwd[2] = b2.z; gwd[3] = b2.w; }
            float s = 0.f;
#pragma unroll
            for (int j = 0; j < EPL / 2; ++j) { const float x0 = bflo(xw[j]), x1 = bfhi(xw[j]); s += x0 * x0 + x1 * x1; }
            s = wave_sum(s); const float rs = rsqrtf(s * (1.0f / HS) + 1e-6f);
            unsigned outw[EPL / 2];
#pragma unroll
            for (int j = 0; j < EPL / 2; ++j) { const float g0 = bflo(gwd[j]), g1 = bfhi(gwd[j]);
                const float a0 = ACT == 0 ? __builtin_amdgcn_rcpf(1.0f + __expf(-g0)) : g0 * __builtin_amdgcn_rcpf(1.0f + __expf(-g0)), a1 = ACT == 0 ? __builtin_amdgcn_rcpf(1.0f + __expf(-g1)) : g1 * __builtin_amdgcn_rcpf(1.0f + __expf(-g1));
                outw[j] = pk2(bflo(xw[j]) * rs * gnorm[col + 2 * j] * a0, bfhi(xw[j]) * rs * gnorm[col + 2 * j + 1] * a1); }
            if constexpr (EPL == 4) { v2u w; w.x = outw[0]; w.y = outw[1]; *(v2u*)(hm + (size_t)row * DM + col) = w; }
            else { v4u w; w.x = outw[0]; w.y = outw[1]; w.z = outw[2]; w.w = outw[3]; *(v4u*)(hm + (size_t)row * DM + col) = w; }
        }
    }
}

DI void fox_cf(LAS unsigned char* lds, const float* G, const float* b_f, float* cf, const bf16* P1, unsigned* kmax2, int tid, int lane, int wave, int bx) {
    LAS float* wt = (LAS float*)lds;
    for (int item = bx; item < 256; item += gridDim.x) { const int seq = item >> 1, hf = item & 1, b = seq >> 4, h = seq & 15; const float bias = b_f[h];
        const float* gp = G + ((size_t)b * SEQ + hf * 2048 + tid * 4) * 16 + h;
        float ls[4]; float s = 0.f, s0 = 0.f;
#pragma unroll
        for (int p = 0; p < 4; ++p) { ls[p] = logsig(gp[p * 16] + bias); s += ls[p]; }
        if (hf) { const float* g0 = gp - (size_t)2048 * 16;
#pragma unroll
            for (int p = 0; p < 4; ++p) s0 += logsig(g0[p * 16] + bias); }
        const float incl = wave_incl_sum(s, lane), tot0 = wave_sum(s0);
        __syncthreads();
        if (lane == 63) wt[wave] = incl; if (lane == 0) wt[8 + wave] = tot0;
        __syncthreads();
        float base = 0.f;
#pragma unroll
        for (int w = 0; w < 8; ++w) { base += (w < wave) ? wt[w] : 0.f; base += wt[8 + w]; }
        float run = base + incl - s;
        float* o = cf + (size_t)seq * SEQ + hf * 2048 + tid * 4; f32x4 ov;
        run += ls[0]; ov.x = run; run += ls[1]; ov.y = run; run += ls[2]; ov.z = run; run += ls[3]; ov.w = run;
        *(f32x4*)o = ov;
        float km = 0.f; const bf16* kp = P1 + ((size_t)b * SEQ + hf * 2048) * NQKV + 2048 + h * 128;
#pragma unroll 8
        for (int i = 0; i < 64; ++i) { const int idx = tid + 512 * i, r = idx >> 4, c = idx & 15; const v4u kv = *(const v4u*)(kp + (size_t)r * NQKV + c * 8); float s2 = 0.f;
#pragma unroll
            for (int q = 0; q < 4; ++q) { const float x0 = bflo(kv[q]), x1 = bfhi(kv[q]); s2 += x0 * x0 + x1 * x1; }
            s2 += __shfl_xor(s2, 1); s2 += __shfl_xor(s2, 2); s2 += __shfl_xor(s2, 4); s2 += __shfl_xor(s2, 8); km = fmaxf(km, s2); }
        km = fmaxf(km, __shfl_xor(km, 16)); km = fmaxf(km, __shfl_xor(km, 32));
        if (lane == 0) atomicMax(kmax2 + seq, __float_as_uint(km));
    }
}

DI bf16x8 pack8_mfma(const f32x4& lo, const f32x4& hi) { v4u p;
    asm volatile("v_cvt_pk_bf16_f32 %0, %4, %5\n\tv_cvt_pk_bf16_f32 %1, %6, %7\n\tv_cvt_pk_bf16_f32 %2, %8, %9\n\tv_cvt_pk_bf16_f32 %3, %10, %11\n\ts_nop 1"
                 : "=&v"(p[0]), "=&v"(p[1]), "=&v"(p[2]), "=&v"(p[3]) : "v"(lo[0]), "v"(lo[1]), "v"(lo[2]), "v"(lo[3]), "v"(hi[0]), "v"(hi[1]), "v"(hi[2]), "v"(hi[3]));
    return __builtin_bit_cast(bf16x8, p); }
DI unsigned off_v(unsigned row, unsigned ch) { return 256u * row + 16u * (ch ^ (((row & 3u) << 2) | (((row >> 2) & 1u) << 1))); }

DI void fox_attn2(LAS unsigned char* lds, const bf16* P1, const float* cf, const unsigned* kmax2, bf16* hm, int tid, int lane, int wave, int bx) {
    constexpr int BUFB = 16384 + 16384 + 256;
    LAS float* xch = (LAS float*)(lds + 2 * BUFB);
    const float LOG2E = 1.4426950408889634f, QS = 0.08838834764831845f * 1.4426950408889634f, THR = 8.0f;
    const int g = lane >> 4, r16 = lane & 15;
    const int G_ = gridDim.x;
    const int nit = (2048 + G_ - 1) / G_;
    for (int it = 0; it < nit; ++it) {
        const int u = (it & 1) ? it * G_ + (G_ - 1 - bx) : it * G_ + bx;
        if (u >= 2048) continue;
        const int qb = 15 - (u >> 7), bh = u & 127, b = bh >> 4, h = bh & 15;
        const size_t rowb = (size_t)b * SEQ; const int q0 = qb * 256 + 32 * wave;
        bf16x8 qf[2][4]; float c0[2];
#pragma unroll
        for (int tt = 0; tt < 2; ++tt) { const int t = q0 + 16 * tt + r16; c0[tt] = cf[(size_t)bh * SEQ + t] * LOG2E;
#pragma unroll
            for (int kk = 0; kk < 4; ++kk) { const v4u raw = *(const v4u*)(P1 + (rowb + t) * NQKV + h * 128 + 32 * kk + 8 * g); v4u sc;
#pragma unroll
                for (int j = 0; j < 4; ++j) sc[j] = pk2(bflo(raw[j]) * QS, bfhi(raw[j]) * QS);
                qf[tt][kk] = __builtin_bit_cast(bf16x8, sc); } }
        f32x4 oacc[8][2];
#pragma unroll
        for (int et = 0; et < 8; ++et) { oacc[et][0] = (f32x4){0.f, 0.f, 0.f, 0.f}; oacc[et][1] = (f32x4){0.f, 0.f, 0.f, 0.f}; }
        float lrun[2] = {0.f, 0.f};
        const int ntiles = 4 * (qb + 1);
        v4u kreg[2], vreg[2]; float cfreg = 0.f;
        const bf16* kbase = P1 + rowb * NQKV + 2048 + h * 128;
#define FOX_LOAD(j) do { _Pragma("unroll") for (int p = 0; p < 2; ++p) { const int idx = tid + 512 * p, r = idx >> 4, c8 = idx & 15; \
            kreg[p] = *(const v4u*)(kbase + (size_t)(64 * (j) + r) * NQKV + c8 * 8); vreg[p] = *(const v4u*)(kbase + (size_t)(64 * (j) + r) * NQKV + 2048 + c8 * 8); } \
            if (tid < 64) cfreg = -cf[(size_t)bh * SEQ + 64 * (j) + tid] * LOG2E; } while (0)
#define FOX_STORE(bufi) do { LAS unsigned char* bb = lds + (bufi) * BUFB; _Pragma("unroll") for (int p = 0; p < 2; ++p) { const int idx = tid + 512 * p, r = idx >> 4, c8 = idx & 15; \
            *(LAS v4u*)((LAS bf16*)bb + eoff<128>(r, c8 * 8)) = kreg[p]; *(LAS v4u*)(bb + 16384 + off_v(r, c8)) = vreg[p]; } \
            if (tid < 64) ((LAS float*)(bb + 32768))[tid] = cfreg; } while (0)
        float qm = 0.f;
#pragma unroll
        for (int tt = 0; tt < 2; ++tt) { float s2 = 0.f;
#pragma unroll
            for (int kk = 0; kk < 4; ++kk)
#pragma unroll
                for (int jq = 0; jq < 8; ++jq) { const float v = bf2f((unsigned short)qf[tt][kk][jq]); s2 += v * v; }
            s2 += __shfl_xor(s2, 16); s2 += __shfl_xor(s2, 32); qm = fmaxf(qm, s2); }
        qm = fmaxf(qm, __shfl_xor(qm, 1)); qm = fmaxf(qm, __shfl_xor(qm, 2)); qm = fmaxf(qm, __shfl_xor(qm, 4)); qm = fmaxf(qm, __shfl_xor(qm, 8));
        __syncthreads();
        if (lane == 0) xch[16 + wave] = qm;
        FOX_LOAD(ntiles - 1); FOX_STORE(0);
        if (ntiles > 1) FOX_LOAD(ntiles - 2);
        __syncthreads();
        float q2 = xch[16];
#pragma unroll
        for (int w8 = 1; w8 < 8; ++w8) q2 = fmaxf(q2, xch[16 + w8]);
        const float QKB = sqrtf(q2 * __uint_as_float(kmax2[bh])) * 1.01f + 1e-3f;
        const float cfu0 = cf[(size_t)bh * SEQ + qb * 256] * LOG2E;
        float mref[2] = {0.f, 0.f}, rmaxlog[2] = {-__builtin_inff(), -__builtin_inff()};
        for (int k = 0; k < ntiles; ++k) { const int j = ntiles - 1 - k;
            if (k + 1 < ntiles) FOX_STORE((k + 1) & 1);
            if (k + 2 < ntiles) FOX_LOAD(ntiles - 3 - k);
            if (64 * j <= q0 + 31) {
                const LAS bf16* Ks = (const LAS bf16*)(lds + (k & 1) * BUFB); const LAS bf16* VTs = Ks + 64 * 128; const LAS float* cfs = (const LAS float*)(VTs + 128 * 64);
                f32x4 sacc[2][4];
#pragma unroll
                for (int st = 0; st < 4; ++st) { const f32x4 cv = *(const LAS f32x4*)(cfs + 16 * st + 4 * g);
#pragma unroll
                    for (int tt = 0; tt < 2; ++tt) sacc[tt][st] = cv + c0[tt]; }
#pragma unroll
                for (int st = 0; st < 4; ++st)
#pragma unroll
                    for (int kk = 0; kk < 4; ++kk) { const bf16x8 kf = ldf<128>(Ks, 16 * st + r16, 4 * kk + g);
                        sacc[0][st] = mfma16(kf, qf[0][kk], sacc[0][st]); sacc[1][st] = mfma16(kf, qf[1][kk], sacc[1][st]); if (kk == 3) asm volatile("" ::: "memory"); }
                if (64 * j + 63 > q0) {
#pragma unroll
                    for (int tt = 0; tt < 2; ++tt) { const int t = q0 + 16 * tt + r16;
#pragma unroll
                        for (int st = 0; st < 4; ++st)
#pragma unroll
                            for (int i = 0; i < 4; ++i) { const int s = 64 * j + 16 * st + 4 * g + i; if (s > t) sacc[tt][st][i] = -__builtin_inff(); } }
                }
                float mx[2];
#pragma unroll
                for (int tt = 0; tt < 2; ++tt) { float m = -__builtin_inff();
#pragma unroll
                    for (int st = 0; st < 4; ++st) m = fmaxf(m, fmaxf(fmaxf(sacc[tt][st][0], sacc[tt][st][1]), fmaxf(sacc[tt][st][2], sacc[tt][st][3])));
                    m = fmaxf(m, __shfl_xor(m, 16)); m = fmaxf(m, __shfl_xor(m, 32)); mx[tt] = m; }
                rmaxlog[0] = fmaxf(rmaxlog[0], mx[0] + mref[0]); rmaxlog[1] = fmaxf(rmaxlog[1], mx[1] + mref[1]);
                if (__any(mx[0] > THR || mx[1] > THR)) {
#pragma unroll
                    for (int tt = 0; tt < 2; ++tt) { const float sh = fmaxf(mx[tt], 0.f), f = __builtin_amdgcn_exp2f(-sh);
                        c0[tt] -= sh; mref[tt] += sh; lrun[tt] *= f;
#pragma unroll
                        for (int st = 0; st < 4; ++st) sacc[tt][st] = sacc[tt][st] - sh;
#pragma unroll
                        for (int et = 0; et < 8; ++et) oacc[et][tt] = oacc[et][tt] * f; }
                }
#pragma unroll
                for (int tt = 0; tt < 2; ++tt) { float ls = 0.f;
#pragma unroll
                    for (int st = 0; st < 4; ++st)
#pragma unroll
                        for (int i = 0; i < 4; ++i) { const float p = __builtin_amdgcn_exp2f(sacc[tt][st][i]); sacc[tt][st][i] = p; ls += p; }
                    lrun[tt] += ls; }
#pragma unroll
                for (int ks = 0; ks < 2; ++ks) { bf16x8 pb[2];
#pragma unroll
                    for (int tt = 0; tt < 2; ++tt) pb[tt] = pack8_mfma(sacc[tt][2 * ks], sacc[tt][2 * ks + 1]);
#pragma unroll
                    for (int et = 0; et < 8; ++et) {
                        const LAS unsigned char* vb = (const LAS unsigned char*)VTs;
                        const v4i16_t lo = tr_read(vb + off_v(32 * ks + 4 * g + (r16 >> 2), 2 * et + ((lane & 3) >> 1)) + 8 * (lane & 1));
                        const v4i16_t hi = tr_read(vb + off_v(32 * ks + 16 + 4 * g + (r16 >> 2), 2 * et + ((lane & 3) >> 1)) + 8 * (lane & 1));
                        bf16x8 va; va[0] = lo[0]; va[1] = lo[1]; va[2] = lo[2]; va[3] = lo[3]; va[4] = hi[0]; va[5] = hi[1]; va[6] = hi[2]; va[7] = hi[3];
                        oacc[et][0] = mfma16(va, pb[0], oacc[et][0]); oacc[et][1] = mfma16(va, pb[1], oacc[et][1]); if (et & 1) asm volatile("" ::: "memory"); } }
            }
            { float wm = fminf(rmaxlog[0], rmaxlog[1]);
              wm = fminf(wm, __shfl_xor(wm, 1)); wm = fminf(wm, __shfl_xor(wm, 2)); wm = fminf(wm, __shfl_xor(wm, 4)); wm = fminf(wm, __shfl_xor(wm, 8));
              if (lane == 0) xch[(k & 1) * 8 + wave] = wm; }
            __syncthreads();
            if (k + 1 < ntiles) { float mmin = xch[(k & 1) * 8];
#pragma unroll
                for (int w8 = 1; w8 < 8; ++w8) mmin = fminf(mmin, xch[(k & 1) * 8 + w8]);
                const float cfe = ((const LAS float*)(lds + ((k + 1) & 1) * BUFB + 32768))[63];
                if (QKB + cfu0 + cfe < mmin - 60.0f) break; }
        }
#undef FOX_LOAD
#undef FOX_STORE
#pragma unroll
        for (int tt = 0; tt < 2; ++tt) { float l = lrun[tt]; l += __shfl_xor(l, 16); l += __shfl_xor(l, 32); const float inv = 1.0f / l;
            bf16* orow = hm + (rowb + q0 + 16 * tt + r16) * DM + h * 128 + 4 * g;
#pragma unroll
            for (int et = 0; et < 8; ++et) { v2u w; w.x = pk2(oacc[et][tt][0] * inv, oacc[et][tt][1] * inv); w.y = pk2(oacc[et][tt][2] * inv, oacc[et][tt][3] * inv); *(v2u*)(orow + 16 * et) = w; } }
    }
}


DI void final_norm(float* out, const bf16* hb, const long long* ss, const float* gfin, int lane, int wave, int bx) {
    const int gw = bx * NWAVES + wave, NGW = gridDim.x * NWAVES;
    for (int m = gw; m < MTOK; m += NGW) { const float rs = pg8::rstd_of(ss, m);
        const v4u* hr = (const v4u*)(hb + (size_t)m * DM); f32x4* xr = (f32x4*)(out + (size_t)m * DM); const f32x4* gr = (const f32x4*)gfin;
#pragma unroll
        for (int j = 0; j < 4; ++j) { const v4u w = hr[lane + 64 * j]; const int c4 = 2 * (lane + 64 * j);
            const f32x4 g0 = gr[c4], g1 = gr[c4 + 1];
            xr[c4] = (f32x4){bflo(w.x) * rs * g0.x, bfhi(w.x) * rs * g0.y, bflo(w.y) * rs * g0.z, bfhi(w.y) * rs * g0.w};
            xr[c4 + 1] = (f32x4){bflo(w.z) * rs * g1.x, bfhi(w.z) * rs * g1.y, bflo(w.w) * rs * g1.z, bfhi(w.w) * rs * g1.w}; } }
}

#define PH(p) if (lo <= (p) && (p) < hi && (ran ? (xcd_barrier(bar), true) : (ran = true)))
#define TID() int tid = threadIdx.x; asm volatile("" : "+v"(tid)); const int lane = tid & 63, wave = __builtin_amdgcn_readfirstlane(tid >> 6); int bx = blockIdx.x; asm volatile("" : "+s"(bx)); (void)lane; (void)wave; (void)bx
#define WSP(T, off) ((T*)(ka->ws + (off)))
template <int j> DI void subblock(LAS unsigned char* lds, const XcdBarrier& bar, const int lo, const int hi, bool& ran) {
    {
        constexpr int layer = j / 3, typ = j - 3 * layer, base = 1 + 5 * j;
        if constexpr (typ != 1) {
            PH(base) { TID(); KArgs ka = kargs(); const int mi = layer * 2 + (typ >> 1);
                pg8::Gemm gm{WSP(bf16, WS_HB), WSP(bf16, WS_WUP) + (size_t)mi * NUP * DM, MTOK, NUP, DM}; pg8::StaticOrder S; S.init(MTOK, NUP, gridDim.x, bx);
                pg8::EpiSwiGLU E{WSP(bf16, WS_ACT), WSP(long long, WS_SS) + (size_t)j * MTOK, DFF};
                pg8::gemm_phase<pg8::EpiSwiGLU, pg8::StaticOrder, PG8_ALIGN, PG8_SP2>(lds, gm, S, E); }
        } else {
            constexpr int kind = layer % 3, ji = layer / 3, HSLOT = (layer * 2 + 1) / 3;
            (void)ji; (void)HSLOT;
            PH(base) { TID(); KArgs ka = kargs();
                mixer_gates(WSP(bf16, WS_HB), WSP(bf16, WS_WIN) + ((size_t)layer * NINP + NQKV) * DM, WSP(long long, WS_SS) + (size_t)j * MTOK, WSP(float, WS_G), lane, wave, bx);
                pg8::Gemm gm{WSP(bf16, WS_HB), WSP(bf16, WS_WIN) + (size_t)layer * NINP * DM, MTOK, NQKV, DM}; pg8::StaticOrder S; S.init(MTOK, NQKV, gridDim.x, bx);
                pg8::EpiMixIn E{WSP(bf16, WS_P1), WSP(long long, WS_SS) + (size_t)j * MTOK};
                pg8::gemm_phase<pg8::EpiMixIn, pg8::StaticOrder, PG8_ALIGN, PG8_SP2>(lds, gm, S, E); }
            PH(base + 1) { TID(); KArgs ka = kargs();
                if constexpr (kind == 0) for (int rep = 0; rep < REP_MLSTM; ++rep) mlstm_pre(lds, WSP(bf16, WS_P1), WSP(float, WS_G), ka->in[6] + ji * 16, WSP(unsigned char, WS_ACT), tid, lane, wave, bx);
                else if constexpr (kind == 1) { fox_cf(lds, WSP(float, WS_G), ka->in[10] + ji * 16, WSP(float, WS_CF), WSP(bf16, WS_P1), WSP(unsigned, WS_CTL) + CW_KMAX, tid, lane, wave, bx); }
                else for (int rep = 0; rep < REP_GLA; ++rep) gla_pre(lds, WSP(bf16, WS_P1), WSP(float, WS_G), ka->in[13] + (size_t)ji * 16 * 1024, ka->in[14] + ji * 1024, WSP(unsigned char, WS_ACT), tid, lane, wave, bx);
            }
            PH(base + 2) { TID(); KArgs ka = kargs();
                if constexpr (kind == 0) for (int rep = 0; rep < REP_MLSTM; ++rep) mlstm_scan2(lds, WSP(bf16, WS_P1), WSP(unsigned char, WS_ACT), WSP(bf16, WS_HM), WSP(long long, WS_HSS) + (size_t)HSLOT * MTOK * 8, tid, lane, wave, bx);
                else if constexpr (kind == 1) for (int rep = 0; rep < REP_FOX; ++rep) fox_attn2(lds, WSP(bf16, WS_P1), WSP(float, WS_CF), WSP(unsigned, WS_CTL) + CW_KMAX, WSP(bf16, WS_HM), tid, lane, wave, bx);
                else for (int rep = 0; rep < REP_GLA; ++rep) gla_scan2(lds, WSP(bf16, WS_P1), WSP(unsigned char, WS_ACT), WSP(bf16, WS_HM), WSP(long long, WS_HSS) + (size_t)HSLOT * MTOK * 8, tid, lane, wave, bx);
            }
        }
        PH(base + 4) { TID(); KArgs ka = kargs();
            pg8::Gemm gm; float scale;
            if constexpr (typ != 1) { const int mi = layer * 2 + (typ >> 1); gm = pg8::Gemm{WSP(bf16, WS_ACT), WSP(bf16, WS_WDN) + (size_t)mi * DM * DFF, MTOK, DM, DFF}; scale = 0.5f; }
            else { gm = pg8::Gemm{WSP(bf16, WS_HM), WSP(bf16, WS_WOUT) + (size_t)layer * DM * DM, MTOK, DM, DM}; scale = 1.0f; }
            pg8::StaticOrder S; S.init(MTOK, DM, gridDim.x, bx);
            constexpr int NHS = (typ != 1 || layer % 3 == 1) ? 0 : (layer % 3 == 0 ? 8 : 4);
            pg8::EpiResidT<NHS> E{WSP(bf16, WS_HB), WSP(long long, WS_SS) + (size_t)(j + 1) * MTOK, scale, WSP(long long, WS_HSS) + (size_t)((layer * 2 + 1) / 3) * MTOK * 8};
            pg8::gemm_phase<pg8::EpiResidT<NHS>, pg8::StaticOrder, PG8_ALIGN, PG8_SP2>(lds, gm, S, E);
        }
    }
}

__global__ void __launch_bounds__(NWAVES * 64, 2) trunk_fwd(Args args) {
    extern __shared__ __attribute__((aligned(16))) unsigned char lds_raw[];
    LAS unsigned char* lds = (LAS unsigned char*)lds_raw;
    volatile LAS unsigned* MISC = (volatile LAS unsigned*)(lds + MISC_OFF);
    for (int u = threadIdx.x; u < (LDS_BYTES - MISC_OFF) / 4; u += NWAVES * 64) ((LAS unsigned*)(lds + MISC_OFF))[u] = 0u;
    __syncthreads();
    XcdBarrier bar = xcd_barrier_post((unsigned*)(args.ws + WS_CTL) + CW_BAR, MISC + 8);
    const int lo = args.ph_lo, hi = args.ph_hi; bool ran = false;

    PH(0) { TID(); for (int rep = 0; rep < REP_PRO; ++rep) { prologue(lds, lane, wave, bx); __syncthreads(); } }

    subblock<0>(lds, bar, lo, hi, ran); subblock<1>(lds, bar, lo, hi, ran); subblock<2>(lds, bar, lo, hi, ran); subblock<3>(lds, bar, lo, hi, ran);
    subblock<4>(lds, bar, lo, hi, ran); subblock<5>(lds, bar, lo, hi, ran); subblock<6>(lds, bar, lo, hi, ran); subblock<7>(lds, bar, lo, hi, ran);
    subblock<8>(lds, bar, lo, hi, ran); subblock<9>(lds, bar, lo, hi, ran); subblock<10>(lds, bar, lo, hi, ran); subblock<11>(lds, bar, lo, hi, ran);
    PH(NPHASE - 1) { TID(); KArgs ka = kargs(); final_norm(ka->out, WSP(bf16, WS_HB), WSP(long long, WS_SS) + (size_t)NSUB * MTOK, ka->in[17], lane, wave, bx); }
#undef WSP
#undef PH
}

static bool phase_exists(int p) {
    if (p == 0 || p == NPHASE - 1) return true;
    const int j = (p - 1) / 5, k = (p - 1) % 5, typ = j % 3;
    if (k == 0 || k == 4) return true;
    if (typ != 1) return false;
    if (k == 3) return false;
    return true;
}
extern "C" void kernel_launch(void* const* d_in, const int* in_sizes, int n_in, void* d_out, int out_size, void* d_ws, size_t ws_size, hipStream_t stream) {
    static int grid = 0;
    if (grid == 0) {
        if (n_in != 18 || in_sizes[0] != MTOK * DM || out_size != MTOK * DM || ws_size < WS_END) { fprintf(stderr, "kernel_launch: unexpected shapes (n_in %d, in0 %d, out %d, ws %zu < %zu)\n", n_in, n_in > 0 ? in_sizes[0] : -1, out_size, ws_size, (size_t)WS_END); grid = -1; return; }
        int dev = 0, cus = 0, per_cu = 0;
        if (hipGetDevice(&dev) != hipSuccess || hipDeviceGetAttribute(&cus, hipDeviceAttributeMultiprocessorCount, dev) != hipSuccess) { grid = -1; return; }
        if (hipFuncSetAttribute((const void*)trunk_fwd, hipFuncAttributeMaxDynamicSharedMemorySize, LDS_BYTES) != hipSuccess) { fprintf(stderr, "kernel_launch: hipFuncSetAttribute failed\n"); grid = -1; return; }
        if (hipOccupancyMaxActiveBlocksPerMultiprocessor(&per_cu, (const void*)trunk_fwd, NWAVES * 64, LDS_BYTES) != hipSuccess || per_cu < 1) fprintf(stderr, "kernel_launch: occupancy query says %d\n", per_cu);
        (void)hipGetLastError();
        grid = cus;
    }
    if (grid < 0) return;
    if (hipMemsetAsync((char*)d_ws + WS_CTL, 0, CTL_ZERO_BYTES, stream) != hipSuccess) return;
    Args a{};
    for (int i = 0; i < 18; ++i) a.in[i] = (const float*)d_in[i];
    a.out = (float*)d_out; a.ws = (unsigned char*)d_ws;
#if MK_PER_PHASE
    for (int p = 0; p < NPHASE; ++p) { if (!phase_exists(p)) continue; a.ph_lo = p; a.ph_hi = p + 1; hipLaunchKernelGGL(trunk_fwd, dim3(grid), dim3(NWAVES * 64), LDS_BYTES, stream, a); }
#else
    a.ph_lo = 0; a.ph_hi = NPHASE; hipLaunchKernelGGL(trunk_fwd, dim3(grid), dim3(NWAVES * 64), LDS_BYTES, stream, a);
#endif
    (void)phase_exists;
}
```

```cpp
#include <hip/hip_runtime.h>
#include <cstdio>
#include <cstdint>
namespace pg8 {
#define PG8_LAS __attribute__((address_space(3)))
typedef unsigned short bf16_t;
typedef short bf16x8 __attribute__((ext_vector_type(8)));
typedef float f32x4 __attribute__((ext_vector_type(4)));
typedef unsigned u32x4 __attribute__((ext_vector_type(4)));
constexpr int BM = 256, BK = 64, HALF = 128, HTB = HALF * BK * 2  , STAGE_BYTES = 8 * HTB, NXCD = 8, WGM = 8;

__host__ __device__ __forceinline__ int lds_byte(int r, int c) { const int st = (r >> 4) * 2 + (c >> 5), rr = r & 15, cc = c & 31, ob = rr * 64 + cc * 2; return st * 1024 + (ob ^ (((ob >> 9) & 1) << 5)); }
__host__ __device__ __forceinline__ void stage_rc(int b, int& R, int& C) { const int st = b / 1024, sb = b % 1024, swz = sb ^ (((sb >> 9) & 1) << 5); R = (st >> 1) * 16 + swz / 64; C = (st & 1) * 32 + (swz % 64) / 2; }
__host__ __device__ __forceinline__ int perm32(int rho) { const int n = rho >> 4, i = rho & 15; return 8 * (i >> 2) + 4 * n + (i & 3); }

struct Unit { int pm, pn; };
struct Gemm { const bf16_t* A; const bf16_t* Bt; int M, N, K; };

struct StaticOrder {
    int nM, nN, nwg, G, c;
    __host__ __device__ void init(int M, int N, int G_, int c_) { nM = M / BM; nN = N / BM; nwg = nM * nN; G = G_; c = c_; }
    __host__ __device__ bool next(int i, Unit& u) const {
        const long L = (long)i * G + c; if (L >= nwg) return false;
        int wgid = (int)L; { const int q = nwg / NXCD, r = nwg % NXCD, xcd = wgid % NXCD, off = wgid / NXCD; wgid = (xcd < r ? xcd * (q + 1) : r * (q + 1) + (xcd - r) * q) + off; }
        const int nig = WGM * nN, gid = wgid / nig, fm = gid * WGM, gsz = (nM - fm) < WGM ? (nM - fm) : WGM;
        u.pm = fm + ((wgid % nig) % gsz); u.pn = (wgid % nig) / gsz; return true;
    }
    __device__ __forceinline__ void a_ready(const Unit&) const {}
    __device__ __forceinline__ void done(const Unit&) const {}
};

__device__ __forceinline__ unsigned cvt_pk_bf16(float lo, float hi) { unsigned r; asm volatile("v_cvt_pk_bf16_f32 %0, %1, %2" : "=v"(r) : "v"(lo), "v"(hi)); return r; }
constexpr float RMS_EPS_F = 1e-6f, SS_FIX = 1048576.0f, SS_UNFIX_D = 1.0f / (1048576.0f * 2048.0f);
typedef long long ss_t;
__device__ __forceinline__ float rstd_of(const ss_t* ss, int row) { return rsqrtf((float)ss[row] * SS_UNFIX_D + RMS_EPS_F); }
template <class Sched> __device__ __forceinline__ int rstd_table_fill(const Sched& S, const ss_t* ss, PG8_LAS unsigned char* ext, int tid) {
    PG8_LAS float* tab = (PG8_LAS float*)ext; int key0 = -1, key1 = -1, bad = 0; Unit u;
    for (int i = 0; S.next(i, u); ++i) { const int slot = (u.pm >> 3) & 1; const int key = slot ? key1 : key0;
        if (key == u.pm) continue;
        if (key >= 0) { bad = 1; continue; }
        if (slot) key1 = u.pm; else key0 = u.pm;
        if (tid < 256) tab[slot * 256 + tid] = rstd_of(ss, u.pm * BM + tid); }
    asm volatile("s_waitcnt lgkmcnt(0)" ::: "memory"); __builtin_amdgcn_s_barrier(); asm volatile("" ::: "memory");
    return bad;
}
__device__ __forceinline__ float rstd_get(const ss_t* ss, const Unit& u, int row, int pf, const PG8_LAS unsigned char* ext) {
    return pf ? rstd_of(ss, row) : ((const PG8_LAS float*)ext)[((u.pm >> 3) & 1) * 256 + (row - u.pm * BM)];
}
struct EpiSwiGLU {
    static constexpr bool PERM = true, AFTER_DRAIN = false, SEG = false;
    bf16_t* O; const ss_t* ss; int ldo;
    template <class Sched> __device__ __forceinline__ int prepare(const Sched& S, PG8_LAS unsigned char* ext, int tid) const { return rstd_table_fill(S, ss, ext, tid); }
    __device__ __forceinline__ void operator()(const f32x4 (&acc)[2][2][4][2], const Unit& u, int wr, int wc, int fr, int fq, int pf, const PG8_LAS unsigned char* ext) const {
        const int row0 = u.pm * BM + wr * 64 + fr, col0 = u.pn * HALF + wc * 32 + 8 * fq;
#pragma unroll
        for (int ai = 0; ai < 2; ++ai)
#pragma unroll
            for (int m = 0; m < 4; ++m) {
                const int row = row0 + ai * HALF + m * 16;
                const float rs = rstd_get(ss, u, row, pf, ext), c1 = -1.4426950408889634f * rs, rs2 = rs * rs;
                float o[8];
#pragma unroll
                for (int n = 0; n < 2; ++n) { const f32x4 p4 = acc[ai][0][m][n] * acc[ai][1][m][n] * rs2;
#pragma unroll
                    for (int j = 0; j < 4; ++j) o[4 * n + j] = p4[j] * __builtin_amdgcn_rcpf(1.0f + __builtin_amdgcn_exp2f(acc[ai][0][m][n][j] * c1)); }
                u32x4 w; w.x = cvt_pk_bf16(o[0], o[1]); w.y = cvt_pk_bf16(o[2], o[3]); w.z = cvt_pk_bf16(o[4], o[5]); w.w = cvt_pk_bf16(o[6], o[7]);
                *(u32x4*)(O + (size_t)row * ldo + col0) = w;
            }
    }
};
struct EpiMixIn {
    static constexpr bool PERM = true, AFTER_DRAIN = false, SEG = false;
    bf16_t* O; const ss_t* ss;
    template <class Sched> __device__ __forceinline__ int prepare(const Sched& S, PG8_LAS unsigned char* ext, int tid) const { return rstd_table_fill(S, ss, ext, tid); }
    __device__ __forceinline__ void operator()(const f32x4 (&acc)[2][2][4][2], const Unit& u, int wr, int wc, int fr, int fq, int pf, const PG8_LAS unsigned char* ext) const {
        const int row0 = u.pm * BM + wr * 64 + fr, col0 = u.pn * BM + wc * 32 + 8 * fq;
#pragma unroll
        for (int ai = 0; ai < 2; ++ai)
#pragma unroll
            for (int m = 0; m < 4; ++m) {
                const int row = row0 + ai * HALF + m * 16;
                const float rs = rstd_get(ss, u, row, pf, ext);
#pragma unroll
                for (int bj = 0; bj < 2; ++bj) { const f32x4 v0 = acc[ai][bj][m][0] * rs, v1 = acc[ai][bj][m][1] * rs;
                    u32x4 w; w.x = cvt_pk_bf16(v0[0], v0[1]); w.y = cvt_pk_bf16(v0[2], v0[3]); w.z = cvt_pk_bf16(v1[0], v1[1]); w.w = cvt_pk_bf16(v1[2], v1[3]);
                    *(u32x4*)(O + (size_t)row * 6144 + col0 + bj * HALF) = w; }
            }
    }
};
constexpr float HSS_FIX = 1073741824.0f;
template <int NH> struct EpiResidT {
    static constexpr bool PERM = true, AFTER_DRAIN = false, SEG = NH > 0; static constexpr int NHX = NH > 0 ? NH : 1, SEGT = (2048 / NHX) / BK;
    bf16_t* hb; ss_t* ssn; float scale; const ss_t* hss;
    __device__ __forceinline__ float hrstd(int row, int hh) const { return rsqrtf((float)hss[(size_t)row * NHX + hh] * (1.0f / (HSS_FIX * (2048 / NHX))) + RMS_EPS_F); }
    __device__ __forceinline__ static int slot_of(const Unit& u, int pf) { return pf ? (pf & 1) : ((u.pm >> 3) & 1); }
    __device__ __forceinline__ void fill(PG8_LAS float* tab, int slot, int pm, int tid) const {
        if (tid < 256) { const int row = pm * BM + tid; float prev = hrstd(row, 0);
#pragma unroll
            for (int hh = 1; hh < NHX; ++hh) { const float c = hrstd(row, hh); tab[(slot * NHX + hh) * 256 + tid] = prev / c; prev = c; }
            tab[(slot * NHX) * 256 + tid] = prev; }
    }
    __device__ __forceinline__ void fill_unit(const Unit& u, int ui, PG8_LAS unsigned char* ext, int tid) const { fill((PG8_LAS float*)ext, ui & 1, u.pm, tid); asm volatile("s_waitcnt lgkmcnt(0)" ::: "memory"); }
    template <class Sched> __device__ __forceinline__ int prepare(const Sched& S, PG8_LAS unsigned char* ext, int tid) const {
        if constexpr (NH == 0) return 0;
        else {
            PG8_LAS float* tab = (PG8_LAS float*)ext; int key0 = -1, key1 = -1, bad = 0; Unit u;
            for (int i = 0; S.next(i, u); ++i) { const int slot = (u.pm >> 3) & 1; const int key = slot ? key1 : key0;
                if (key == u.pm) continue;
                if (key >= 0) { bad = 1; continue; }
                if (slot) key1 = u.pm; else key0 = u.pm;
                fill(tab, slot, u.pm, tid); }
            if (bad) tab[((tid >> 8) & 1) * NH * 256 + (tid & 255)] = 1.0f;
            asm volatile("s_waitcnt lgkmcnt(0)" ::: "memory"); __builtin_amdgcn_s_barrier(); asm volatile("" ::: "memory");
            return bad;
        }
    }
    __device__ __forceinline__ void rescale(f32x4 (&acc)[2][2][4][2], const Unit& u, int hh, int wr, int fr, int pf, const PG8_LAS unsigned char* ext) const {
        int t_ = threadIdx.x; asm volatile("" : "+v"(t_));
        const PG8_LAS float* tab = (const PG8_LAS float*)ext + (slot_of(u, pf) * NHX + hh) * 256 + ((t_ >> 8) << 6) + (t_ & 15);
#pragma unroll
        for (int ai = 0; ai < 2; ++ai)
#pragma unroll
            for (int m = 0; m < 4; ++m) { const int lr = ai * HALF + m * 16; float r;
                r = tab[lr];
#pragma unroll
                for (int bj = 0; bj < 2; ++bj) { acc[ai][bj][m][0] = acc[ai][bj][m][0] * r; acc[ai][bj][m][1] = acc[ai][bj][m][1] * r; }
            }
    }
    __device__ __forceinline__ void operator()(const f32x4 (&acc)[2][2][4][2], const Unit& u, int wr, int wc, int fr, int fq, int pf, const PG8_LAS unsigned char* ext) const {
        const int row0 = u.pm * BM + wr * 64 + fr, col0 = u.pn * BM + wc * 32 + 8 * fq;
        u32x4 rb[3][2];
#define PG8_LDG(gi, buf) do { const size_t off_ = (size_t)(row0 + ((gi) >> 2) * HALF + ((gi) & 3) * 16) * 2048 + col0; \
            _Pragma("unroll") for (int q_ = 0; q_ < 2; ++q_) buf[q_] = *(const u32x4*)(hb + off_ + q_ * HALF); } while (0)
        PG8_LDG(0, rb[0]); PG8_LDG(1, rb[1]);
#pragma unroll
        for (int gi = 0; gi < 8; ++gi) {
            if (gi + 2 < 8) PG8_LDG(gi + 2, rb[(gi + 2) % 3]);
            const int ai = gi >> 2, m = gi & 3;
            const int row = row0 + ai * HALF + m * 16; const size_t off = (size_t)row * 2048 + col0; float sq = 0.f;
            float sc = scale;
            if constexpr (NH > 0) sc *= ((const PG8_LAS float*)ext)[(slot_of(u, pf) * NHX) * 256 + (row - u.pm * BM)];
#pragma unroll
            for (int bj = 0; bj < 2; ++bj) { const u32x4 hw = rb[gi % 3][bj];
                const f32x4 h0 = (f32x4){__uint_as_float(hw.x << 16), __uint_as_float(hw.x & 0xffff0000u), __uint_as_float(hw.y << 16), __uint_as_float(hw.y & 0xffff0000u)};
                const f32x4 h1 = (f32x4){__uint_as_float(hw.z << 16), __uint_as_float(hw.z & 0xffff0000u), __uint_as_float(hw.w << 16), __uint_as_float(hw.w & 0xffff0000u)};
                const f32x4 n0 = h0 + acc[ai][bj][m][0] * sc, n1 = h1 + acc[ai][bj][m][1] * sc;
                u32x4 w; w.x = cvt_pk_bf16(n0[0], n0[1]); w.y = cvt_pk_bf16(n0[2], n0[3]); w.z = cvt_pk_bf16(n1[0], n1[1]); w.w = cvt_pk_bf16(n1[2], n1[3]);
                *(u32x4*)(hb + off + bj * HALF) = w;
                const float r0 = __uint_as_float(w.x << 16), r1 = __uint_as_float(w.x & 0xffff0000u), r2 = __uint_as_float(w.y << 16), r3 = __uint_as_float(w.y & 0xffff0000u);
                const float r4 = __uint_as_float(w.z << 16), r5 = __uint_as_float(w.z & 0xffff0000u), r6 = __uint_as_float(w.w << 16), r7 = __uint_as_float(w.w & 0xffff0000u);
                sq += ((r0 * r0 + r1 * r1) + (r2 * r2 + r3 * r3)) + ((r4 * r4 + r5 * r5) + (r6 * r6 + r7 * r7)); }
            sq += __shfl_xor(sq, 16); sq += __shfl_xor(sq, 32);
            if (fq == 0) atomicAdd((unsigned long long*)(ssn + row), (unsigned long long)__float2ll_rn(sq * SS_FIX));
        }
#undef PG8_LDG
    }
};
typedef EpiResidT<0> EpiResid;

template <class Epi, class Sched, bool ALIGN_EPI = false, bool SP2 = false>
__device__ __forceinline__ void gemm_phase(PG8_LAS unsigned char* lds, const Gemm g, const Sched& S, const Epi& E) {
    int tid_ = threadIdx.x; asm volatile("" : "+v"(tid_));
    const int tid = tid_, wid = __builtin_amdgcn_readfirstlane(tid >> 6), lane = tid & 63, wr = wid >> 2, wc = wid & 3, fr = lane & 15, fq = lane >> 4;
    const int K = g.K, nt = K / BK;
    unsigned voffA[2], voffB[2];
#pragma unroll
    for (int i = 0; i < 2; ++i) { int R, C; stage_rc(tid * 16 + i * 8192, R, C); const int Rb = Epi::PERM ? ((R & ~31) + perm32(R & 31)) : R;
        voffA[i] = (unsigned)(R * K + C) * 2u; voffB[i] = (unsigned)(Rb * K + C) * 2u; }
    const size_t kstep = (size_t)(BK * 2);
    const size_t hstep = (size_t)HALF * K * 2;
    const size_t tstep = 2 * hstep;
    const unsigned ldsw = (unsigned)wid * 1024u;
    const int aoff = lds_byte(wr * 64 + fr, fq * 8), boff = lds_byte(wc * 32 + fr, fq * 8);
#define PG8_SA(b, h) (((b) * 2 + (h)) * HTB)
#define PG8_SB(b, h) ((4 + (b) * 2 + (h)) * HTB)
#define PG8_STAGE(bufoff, gbase, voff) do { _Pragma("unroll") for (int _i = 0; _i < 2; ++_i) \
        __builtin_amdgcn_global_load_lds((const unsigned*)((const char*)(gbase) + (voff)[_i]), (PG8_LAS unsigned*)(lds + (bufoff) + ldsw + _i * 8192), 16, 0, 0); } while (0)
#define PG8_LDA(dst, b, h) do { _Pragma("unroll") for (int m = 0; m < 4; ++m) _Pragma("unroll") for (int k = 0; k < 2; ++k) dst[m][k] = *(const PG8_LAS bf16x8*)(lds + PG8_SA(b, h) + aoff + m * 2048 + k * 1024); } while (0)
#define PG8_LDB(dst, b, h) do { _Pragma("unroll") for (int n = 0; n < 2; ++n) _Pragma("unroll") for (int k = 0; k < 2; ++k) dst[n][k] = *(const PG8_LAS bf16x8*)(lds + PG8_SB(b, h) + boff + n * 2048 + k * 1024); } while (0)
#define PG8_MMA(ai, bj, At, Bt) do { __builtin_amdgcn_s_setprio(1); _Pragma("unroll") for (int m = 0; m < 4; ++m) _Pragma("unroll") for (int n = 0; n < 2; ++n) _Pragma("unroll") for (int k = 0; k < 2; ++k) \
        acc[ai][bj][m][n] = __builtin_amdgcn_mfma_f32_16x16x32_bf16(Bt[n][k], At[m][k], acc[ai][bj][m][n], 0, 0, 0); __builtin_amdgcn_s_setprio(0); } while (0)
#define PG8_WAIT_V(n) asm volatile("s_waitcnt vmcnt(" #n ")" ::: "memory")
#define PG8_WAIT_L(n) asm volatile("s_waitcnt lgkmcnt(" #n ")" ::: "memory")
#define PG8_BAR __builtin_amdgcn_s_barrier()
#define PG8_SCHED __builtin_amdgcn_sched_barrier(0)
    const int pf0 = E.prepare(S, lds + STAGE_BYTES, tid); int pf = pf0;
    Unit cur, nxt; int ui = 0;
    if (!S.next(0, cur)) return;
    if constexpr (Epi::SEG) { if (pf0) { E.fill_unit(cur, 0, lds + STAGE_BYTES, tid); pf = 2; } }
    f32x4 acc[2][2][4][2];
#pragma unroll
    for (int a = 0; a < 2; ++a)
#pragma unroll
        for (int b = 0; b < 2; ++b)
#pragma unroll
            for (int m = 0; m < 4; ++m)
#pragma unroll
                for (int n = 0; n < 2; ++n) acc[a][b][m][n] = (f32x4){0.f, 0.f, 0.f, 0.f};
    bf16x8 At[4][2], B0[2][2], B1[2][2];
    const char* cA = (const char*)g.A + (size_t)cur.pm * tstep; const char* cB = (const char*)g.Bt + (size_t)cur.pn * tstep;
    S.a_ready(cur);
    if constexpr (SP2) {
        PG8_STAGE(PG8_SB(0, 0), cB, voffB); PG8_STAGE(PG8_SB(0, 1), cB + hstep, voffB); PG8_STAGE(PG8_SA(0, 0), cA, voffA); PG8_STAGE(PG8_SA(0, 1), cA + hstep, voffA);
        if (wr == 1) PG8_BAR;
        PG8_WAIT_V(2); PG8_BAR;
        PG8_STAGE(PG8_SB(1, 0), cB + kstep, voffB); PG8_STAGE(PG8_SA(1, 0), cA + kstep, voffA); PG8_STAGE(PG8_SB(1, 1), cB + hstep + kstep, voffB);
        PG8_WAIT_V(6); PG8_BAR;
    } else {
        PG8_STAGE(PG8_SB(0, 0), cB, voffB); PG8_STAGE(PG8_SA(0, 0), cA, voffA); PG8_STAGE(PG8_SB(0, 1), cB + hstep, voffB); PG8_STAGE(PG8_SA(0, 1), cA + hstep, voffA);
        if (wr == 1) PG8_BAR;
        PG8_WAIT_V(4); PG8_BAR;
        PG8_STAGE(PG8_SB(1, 0), cB + kstep, voffB); PG8_STAGE(PG8_SA(1, 0), cA + kstep, voffA); PG8_STAGE(PG8_SB(1, 1), cB + hstep + kstep, voffB);
        PG8_WAIT_V(6); PG8_BAR;
    }
    for (;;) {
        const bool has_next = S.next(ui + 1, nxt);
        const char* nA = has_next ? (const char*)g.A + (size_t)nxt.pm * tstep : cA; const char* nB = has_next ? (const char*)g.Bt + (size_t)nxt.pn * tstep : cB;
        for (int t = 0; t < nt; t += 2) {
            const bool last = (t == nt - 2);
            const char* a1 = cA + (size_t)(t + 1) * kstep;
            const char* a2 = last ? nA : cA + (size_t)(t + 2) * kstep; const char* b2 = last ? nB : cB + (size_t)(t + 2) * kstep;
            const char* a3 = a2 + kstep; const char* b3 = b2 + kstep;
            if (last && has_next) S.a_ready(nxt);
            if constexpr (Epi::SEG) { if ((t & (Epi::SEGT - 1)) == 0) E.rescale(acc, cur, t / Epi::SEGT, wr, fr, pf, lds + STAGE_BYTES); }
            if constexpr (SP2) {
            PG8_LDB(B0, 0, 0); PG8_LDB(B1, 0, 1); PG8_SCHED; PG8_LDA(At, 0, 0); PG8_STAGE(PG8_SA(1, 1), a1 + hstep, voffA);
            PG8_WAIT_V(8); PG8_WAIT_L(0); PG8_BAR; PG8_MMA(0, 0, At, B0); PG8_MMA(0, 1, At, B1); PG8_BAR; PG8_SCHED;
            PG8_LDA(At, 0, 1); PG8_STAGE(PG8_SB(0, 0), b2, voffB); PG8_STAGE(PG8_SB(0, 1), b2 + hstep, voffB); PG8_STAGE(PG8_SA(0, 0), a2, voffA);
            PG8_WAIT_V(8); PG8_WAIT_L(0); PG8_BAR; PG8_MMA(1, 0, At, B0); PG8_MMA(1, 1, At, B1); PG8_BAR; PG8_SCHED;
            PG8_LDB(B0, 1, 0); PG8_LDB(B1, 1, 1); PG8_SCHED; PG8_LDA(At, 1, 0); PG8_STAGE(PG8_SA(0, 1), a2 + hstep, voffA);
            PG8_WAIT_V(8); PG8_WAIT_L(0); PG8_BAR; PG8_MMA(0, 0, At, B0); PG8_MMA(0, 1, At, B1); PG8_BAR; PG8_SCHED;
            PG8_LDA(At, 1, 1); PG8_STAGE(PG8_SB(1, 0), b3, voffB); PG8_STAGE(PG8_SB(1, 1), b3 + hstep, voffB); PG8_STAGE(PG8_SA(1, 0), a3, voffA);
            PG8_WAIT_V(8); PG8_WAIT_L(0); PG8_BAR; PG8_MMA(1, 0, At, B0); PG8_MMA(1, 1, At, B1); PG8_BAR; PG8_SCHED;
            } else {
            PG8_LDB(B0, 0, 0); PG8_SCHED; PG8_LDA(At, 0, 0); PG8_STAGE(PG8_SA(1, 1), a1 + hstep, voffA);
            PG8_WAIT_L(8); PG8_BAR; PG8_WAIT_L(0); PG8_MMA(0, 0, At, B0); PG8_BAR; PG8_SCHED;
            PG8_LDB(B1, 0, 1); PG8_STAGE(PG8_SB(0, 0), b2, voffB);
            PG8_BAR; PG8_WAIT_L(0); PG8_MMA(0, 1, At, B1); PG8_BAR;
            PG8_LDA(At, 0, 1); PG8_STAGE(PG8_SA(0, 0), a2, voffA);
            PG8_BAR; PG8_WAIT_L(0); PG8_MMA(1, 0, At, B0); PG8_BAR; PG8_SCHED;
            PG8_STAGE(PG8_SB(0, 1), b2 + hstep, voffB);
            PG8_WAIT_V(6); PG8_BAR; PG8_MMA(1, 1, At, B1); PG8_BAR;
            PG8_LDB(B0, 1, 0); PG8_SCHED; PG8_LDA(At, 1, 0); PG8_STAGE(PG8_SA(0, 1), a2 + hstep, voffA);
            PG8_WAIT_L(8); PG8_BAR; PG8_WAIT_L(0); PG8_MMA(0, 0, At, B0); PG8_BAR; PG8_SCHED;
            PG8_LDB(B1, 1, 1); PG8_STAGE(PG8_SB(1, 0), b3, voffB);
            PG8_BAR; PG8_WAIT_L(0); PG8_MMA(0, 1, At, B1); PG8_BAR;
            PG8_LDA(At, 1, 1); PG8_STAGE(PG8_SA(1, 0), a3, voffA);
            PG8_BAR; PG8_WAIT_L(0); PG8_MMA(1, 0, At, B0); PG8_BAR; PG8_SCHED;
            PG8_STAGE(PG8_SB(1, 1), b3 + hstep, voffB);
            PG8_WAIT_V(6); PG8_BAR; PG8_MMA(1, 1, At, B1); PG8_BAR;
            }
        }
        if constexpr (ALIGN_EPI) { if (wr == 0) PG8_BAR; }
        if constexpr (!Epi::AFTER_DRAIN) { E(acc, cur, wr, wc, fr, fq, pf, lds + STAGE_BYTES); S.done(cur); }
        if (!has_next) break;
#pragma unroll
        for (int a = 0; a < 2; ++a)
#pragma unroll
            for (int b = 0; b < 2; ++b)
#pragma unroll
                for (int m = 0; m < 4; ++m)
#pragma unroll
                    for (int n = 0; n < 2; ++n) acc[a][b][m][n] = (f32x4){0.f, 0.f, 0.f, 0.f};
        cur = nxt; cA = nA; cB = nB; ++ui;
        if constexpr (Epi::SEG) { if (pf0) { E.fill_unit(cur, ui, lds + STAGE_BYTES, tid); pf = 2 + (ui & 1); } }
        if constexpr (ALIGN_EPI) { if (wr == 1) PG8_BAR; }
    }
    PG8_WAIT_V(0);
    if constexpr (!ALIGN_EPI) { if (wr == 0) PG8_BAR; }
    PG8_BAR;
    if constexpr (Epi::AFTER_DRAIN) { E.fused(acc, cur, wr, wc, fr, fq, lds, wid, lane); S.done(cur); }
#undef PG8_SA
#undef PG8_SB
#undef PG8_STAGE
#undef PG8_LDA
#undef PG8_LDB
#undef PG8_MMA
#undef PG8_WAIT_V
#undef PG8_WAIT_L
#undef PG8_BAR
#undef PG8_SCHED
}
}

#ifndef PG8_SP2
#define PG8_SP2 true
#endif
#ifndef PG8_ALIGN
#define PG8_ALIGN true
#endif
#ifndef REP_PRO
#define REP_PRO 1
#endif
#ifndef REP_MLSTM
#define REP_MLSTM 1
#endif
#ifndef REP_FOX
#define REP_FOX 1
#endif
#ifndef REP_GLA
#define REP_GLA 1
#endif
#ifndef MK_PER_PHASE
#define MK_PER_PHASE 0
#endif

constexpr int DM = 2048, BATCH = 8, SEQ = 4096, MTOK = BATCH * SEQ, DEPTH = 4, DFF = 5632, NUP = 2 * DFF, NIN = 6160, NINP = 6400, NQKV = 6144;
constexpr int NWAVES = 8;
constexpr int NSUB = 3 * DEPTH;
constexpr int NPHASE = 2 + 5 * NSUB;

constexpr size_t MiB = 1u << 20;
constexpr size_t WS_CTL = 0, CTL_ZERO_BYTES = 11 * MiB;
constexpr size_t WS_SS = 1 * MiB;
constexpr size_t WS_HSS = 5 * MiB;
constexpr size_t WS_WUP = 12 * MiB;
constexpr size_t WS_WDN = WS_WUP + 352 * MiB;
constexpr size_t WS_WIN = WS_WDN + 176 * MiB;
constexpr size_t WS_WOUT = WS_WIN + 100 * MiB;
constexpr size_t WS_HB = WS_WOUT + 32 * MiB;
constexpr size_t WS_ACT = WS_HB + 128 * MiB;
constexpr size_t WS_P1 = WS_ACT + 352 * MiB;
constexpr size_t WS_G = WS_P1 + 384 * MiB;
constexpr size_t WS_HRAW = WS_G + 2 * MiB;
constexpr size_t WS_HM = WS_HRAW + 256 * MiB;
constexpr size_t WS_CF = WS_HM + 128 * MiB;
constexpr size_t WS_END = WS_CF + 2 * MiB;
static_assert((size_t)8 * NUP * DM * 2 == 352 * MiB && (size_t)8 * DM * DFF * 2 == 176 * MiB && (size_t)4 * NINP * DM * 2 == 100 * MiB, "weight regions");
static_assert((size_t)MTOK * DFF * 2 == 352 * MiB && (size_t)MTOK * NQKV * 2 == 384 * MiB && WS_SS + 13 * (size_t)MTOK * 8 <= WS_HSS && WS_HSS + 3 * (size_t)MTOK * 64 <= CTL_ZERO_BYTES && CTL_ZERO_BYTES <= WS_WUP, "activation regions");
constexpr int CW_KMAX = 16384;
constexpr int CW_BAR = 4096;

constexpr int LDS_BYTES = 153600, MISC_OFF = 152576;

#define GAS __attribute__((address_space(1)))
#define LAS __attribute__((address_space(3)))
#define DI __device__ __forceinline__
typedef unsigned short bf16;
typedef unsigned v4u __attribute__((ext_vector_type(4)));
typedef unsigned v2u __attribute__((ext_vector_type(2)));
typedef float f32x4 __attribute__((ext_vector_type(4)));
typedef short bf16x8 __attribute__((ext_vector_type(8)));
typedef GAS unsigned gu32;
#define RLX_AGENT __ATOMIC_RELAXED, __HIP_MEMORY_SCOPE_AGENT
#define LDS_WAIT() asm volatile("s_waitcnt lgkmcnt(0)" ::: "memory")
DI unsigned f2bf(float f) { unsigned r; asm("v_cvt_pk_bf16_f32 %0, %1, %1" : "=v"(r) : "v"(f)); return r & 0xffffu; }
DI unsigned pk2(float lo, float hi) { unsigned r; asm("v_cvt_pk_bf16_f32 %0, %1, %2" : "=v"(r) : "v"(lo), "v"(hi)); return r; }
DI float bf2f(unsigned short v) { return __builtin_bit_cast(float, (unsigned)v << 16); }
DI float bflo(unsigned w) { return __builtin_bit_cast(float, w << 16); }
DI float bfhi(unsigned w) { return __builtin_bit_cast(float, w & 0xffff0000u); }
DI float logsig(float x) { return fminf(x, 0.f) - log1pf(expf(-fabsf(x))); }

#define XB_TMO      128
#define XB_XCNT(j)  (256  + 64 * (j))
#define XB_XSUB(j)  (1280 + 64 * (j))
#define XB_XGEN(j)  (2304 + 64 * (j))
#define XB_TOP      3328
#define XB_TOPGEN   3392
#define XCD_BAR_WORDS 3456
#define XB_SPIN_CAP (1u << 18)

__device__ __forceinline__ unsigned xb_ld(unsigned* p)              { return __hip_atomic_load(p, __ATOMIC_RELAXED, __HIP_MEMORY_SCOPE_AGENT); }
__device__ __forceinline__ unsigned xb_add(unsigned* p, unsigned v) { return __hip_atomic_fetch_add(p, v, __ATOMIC_RELAXED, __HIP_MEMORY_SCOPE_AGENT); }
__device__ __forceinline__ unsigned xb_xcc_id() { return (unsigned)__builtin_amdgcn_s_getreg((3 << 11) | 20) & 0xFu; }
#define XB_SPIN(cond, bar) do { unsigned _sp = 0; while (cond) { __builtin_amdgcn_s_sleep(1); \
    if ((++_sp & 255u) == 0u) { if (xb_ld(&(bar)[XB_TMO])) break; if (_sp > XB_SPIN_CAP) { atomicAdd(&(bar)[XB_TMO], 1u); break; } } } } while (0)

struct XcdBarrier {
    unsigned* bar; unsigned x;
    volatile LAS unsigned* st;
};

__device__ __forceinline__ XcdBarrier xcd_barrier_post(unsigned* bar, volatile LAS unsigned* st) {
    XcdBarrier b; b.bar = bar; b.x = xb_xcc_id(); b.st = st;
    if (threadIdx.x == 0) (void)xb_add(&bar[XB_XCNT(b.x)], 1u);
    return b;
}
__device__ __forceinline__ void xcd_barrier_complete(unsigned* bar, unsigned x, unsigned& nloc, unsigned& nx) {
    const unsigned G = gridDim.x * gridDim.y * gridDim.z;
    unsigned sum, cnt, mine, sp = 0u;
    for (;;) {
        sum = 0u; cnt = 0u; mine = 0u;
#pragma unroll
        for (unsigned j = 0; j < 16; ++j) { const unsigned c = xb_ld(&bar[XB_XCNT(j)]); sum += c; cnt += (c > 0u) ? 1u : 0u; mine = (j == x) ? c : mine; }
        if (sum == G) break;
        __builtin_amdgcn_s_sleep(1);
        if ((++sp & 255u) == 0u) { if (xb_ld(&bar[XB_TMO])) break; if (sp > XB_SPIN_CAP) { atomicAdd(&bar[XB_TMO], 1u); break; } }
    }
    nloc = mine > 0u ? mine : 1u; nx = cnt > 0u ? cnt : 1u;
}

__device__ __forceinline__ void xcd_barrier(const XcdBarrier& b) {
    asm volatile("s_waitcnt vmcnt(0)" ::: "memory");
    __syncthreads();
    if (threadIdx.x == 0) {
        unsigned* bar = b.bar;
        __builtin_amdgcn_s_waitcnt(0);
        unsigned nloc = b.st[0], nx = b.st[1];
        if (nloc == 0u) { xcd_barrier_complete(bar, b.x, nloc, nx); b.st[0] = nloc; b.st[1] = nx; }
        const unsigned old = xb_add(&bar[XB_XSUB(b.x)], 1u);
        const unsigned gen = old / nloc;
        if (old + 1u == (gen + 1u) * nloc) {
            __builtin_amdgcn_fence(__ATOMIC_RELEASE, "agent");
            asm volatile("s_waitcnt vmcnt(0)" ::: "memory");
            const unsigned og = xb_add(&bar[XB_TOP], 1u);
            const unsigned tg = og / nx;
            if (og + 1u == (tg + 1u) * nx) xb_add(&bar[XB_TOPGEN], 1u);
            else XB_SPIN(xb_ld(&bar[XB_TOPGEN]) == tg, bar);
            __builtin_amdgcn_fence(__ATOMIC_ACQUIRE, "agent");
            xb_add(&bar[XB_XGEN(b.x)], 1u);
            asm volatile("s_waitcnt vmcnt(0)" ::: "memory");
        } else {
            XB_SPIN(xb_ld(&bar[XB_XGEN(b.x)]) == gen, bar);
            __builtin_amdgcn_fence(__ATOMIC_ACQUIRE, "agent");
            asm volatile("s_waitcnt vmcnt(0)" ::: "memory");
        }
    }
    __syncthreads();
}


DI float wave_sum(float v) {
#pragma unroll
    for (int o = 1; o < 64; o <<= 1) v += __shfl_xor(v, o);
    return v;
}
DI float wave_max(float v) {
#pragma unroll
    for (int o = 1; o < 64; o <<= 1) v = fmaxf(v, __shfl_xor(v, o));
    return v;
}
DI float wave_incl_sum(float v, int lane) {
#pragma unroll
    for (int o = 1; o < 64; o <<= 1) { const float t = __shfl_up(v, o); if (lane >= o) v += t; }
    return v;
}
DI float wave_incl_max(float v, int lane) {
#pragma unroll
    for (int o = 1; o < 64; o <<= 1) { const float t = __shfl_up(v, o); if (lane >= o) v = fmaxf(v, t); }
    return v;
}

template <int L> DI int swx(int r) { return L == 64 ? ((r >> 1) & 7) : (r & 15); }
template <int L> DI int eoff(int r, int c) { return r * L + ((((c >> 3) ^ swx<L>(r)) << 3) | (c & 7)); }
template <int L> DI bf16x8 ldf(const LAS bf16* base, int r, int ch) { return *(const LAS bf16x8*)(base + r * L + ((ch ^ swx<L>(r)) << 3)); }
DI f32x4 mfma16(bf16x8 a, bf16x8 b, f32x4 c) { return __builtin_amdgcn_mfma_f32_16x16x32_bf16(a, b, c, 0, 0, 0); }
typedef short v4i16_t __attribute__((ext_vector_type(4)));
DI v4i16_t tr_read(const LAS unsigned char* p) { return __builtin_amdgcn_ds_read_tr16_b64_v4i16((LAS v4i16_t*)p); }
DI bf16x8 cat4(v4i16_t lo, v4i16_t hi) { bf16x8 r; r[0] = lo[0]; r[1] = lo[1]; r[2] = lo[2]; r[3] = lo[3]; r[4] = hi[0]; r[5] = hi[1]; r[6] = hi[2]; r[7] = hi[3]; return r; }
DI unsigned off_v64(unsigned row, unsigned ch) { return 128u * row + 16u * (ch ^ ((((row >> 1) & 1u) << 1) | (((row >> 3) & 1u) << 2))); }
DI bf16x8 vfrag64(const LAS unsigned char* vb, int c, int ks, int lane) { const unsigned g = lane >> 4, q = (lane & 15) >> 2, p = lane & 3;
    return cat4(tr_read(vb + off_v64(32 * ks + 8 * g + q, 2 * c + (p >> 1)) + 8 * (p & 1)), tr_read(vb + off_v64(32 * ks + 8 * g + 4 + q, 2 * c + (p >> 1)) + 8 * (p & 1))); }
template <int LA, int LB, int NK> DI void mma_tile(f32x4& acc, const LAS bf16* A, int ra0, const LAS bf16* B, int rb0, int lane) {
    const int r = lane & 15, g = lane >> 4;
#pragma unroll
    for (int kk = 0; kk < NK; ++kk) { const bf16x8 a = ldf<LA>(A, ra0 + r, 4 * kk + g), b = ldf<LB>(B, rb0 + r, 4 * kk + g); acc = mfma16(a, b, acc); }
}

struct ConvItem { const float* W; const float* gk; bf16* WT; int K, N, mode, r; };
DI void conv_load(const ConvItem& c, int lane, f32x4 (&v)[8], float (&gv)[8]) {
    const int nkb = c.K / 64, nb = c.r / nkb, kb = c.r - nb * nkb, k0 = 64 * kb, n0 = 32 * nb;
    const int n = n0 + 4 * (lane & 7); const bool ok = n < c.N;
#pragma unroll
    for (int i = 0; i < 8; ++i) { const int kk = 8 * i + (lane >> 3); v[i] = ok ? *(const f32x4*)(c.W + (size_t)(k0 + kk) * c.N + n) : (f32x4){0.f, 0.f, 0.f, 0.f}; gv[i] = c.gk ? c.gk[k0 + kk] : 1.0f; }
}
DI void conv_store(const ConvItem& c, int lane, const f32x4 (&v)[8], const float (&gv)[8], LAS float* scr) {
    const int nkb = c.K / 64, nb = c.r / nkb, kb = c.r - nb * nkb, k0 = 64 * kb, n0 = 32 * nb, nq = 4 * (lane & 7);
#pragma unroll
    for (int i = 0; i < 8; ++i) { const int kk = 8 * i + (lane >> 3); LAS float* d = scr + kk * 33 + nq; d[0] = v[i].x * gv[i]; d[1] = v[i].y * gv[i]; d[2] = v[i].z * gv[i]; d[3] = v[i].w * gv[i]; }
    LDS_WAIT(); asm volatile("" ::: "memory");
    int row_off = n0;
    if (c.mode == 1) { const int j = n0 < DFF ? n0 : n0 - DFF; row_off = 256 * (j >> 7) + (j & 127) + (n0 < DFF ? 0 : 128); }
    const int cc = lane & 7;
#pragma unroll
    for (int j = 0; j < 4; ++j) { const int nn = (lane >> 3) + 8 * j; const LAS float* s = scr + (8 * cc) * 33 + nn;
        v4u o; o.x = pk2(s[0 * 33], s[1 * 33]); o.y = pk2(s[2 * 33], s[3 * 33]); o.z = pk2(s[4 * 33], s[5 * 33]); o.w = pk2(s[6 * 33], s[7 * 33]);
        *(v4u*)(c.WT + (size_t)(row_off + nn) * c.K + k0 + 8 * cc) = o; }
    LDS_WAIT(); asm volatile("" ::: "memory");
}

struct Args { const float* in[18]; float* out; unsigned char* ws; int ph_lo, ph_hi; };

typedef const __attribute__((address_space(4))) Args* KArgs;
DI KArgs kargs() { KArgs p = (KArgs)__builtin_amdgcn_kernarg_segment_ptr(); asm volatile("" : "+s"(p)); return p; }
DI void prologue(LAS unsigned char* lds, int lane, int wave, int bx) {
    KArgs AP = kargs();
    LAS float* scr = (LAS float*)(lds + wave * 16384);
    const int gw = bx * NWAVES + wave, NGW = gridDim.x * NWAVES;
    unsigned char* ws = AP->ws;
    constexpr int I_UP = (DM / 64) * (NUP / 32), I_DN = (DFF / 64) * (DM / 32), I_IN = (DM / 64) * (NINP / 32), I_OUT = (DM / 64) * (DM / 32);
    constexpr int NITEMS = 8 * I_UP + 8 * I_DN + 4 * I_IN + 4 * I_OUT;
#define CONV_DECODE(it_, c_) do { int r = (it_); (c_).gk = nullptr; (c_).K = DM; (c_).mode = 0; \
        if (r < 8 * I_UP) { const int mi = r / I_UP; r -= mi * I_UP; (c_).W = AP->in[2] + (size_t)mi * DM * NUP; (c_).gk = AP->in[1] + (size_t)mi * DM; (c_).WT = (bf16*)(ws + WS_WUP) + (size_t)mi * NUP * DM; (c_).N = NUP; (c_).mode = 1; } \
        else if (r < 8 * I_UP + 8 * I_DN) { r -= 8 * I_UP; const int mi = r / I_DN; r -= mi * I_DN; (c_).W = AP->in[3] + (size_t)mi * DFF * DM; (c_).WT = (bf16*)(ws + WS_WDN) + (size_t)mi * DM * DFF; (c_).K = DFF; (c_).N = DM; } \
        else if (r < 8 * I_UP + 8 * I_DN + 4 * I_IN) { r -= 8 * I_UP + 8 * I_DN; const int l = r / I_IN; r -= l * I_IN; const int kind = l % 3, ji = l / 3; \
            (c_).W = AP->in[kind == 0 ? 5 : kind == 1 ? 9 : 12] + (size_t)ji * DM * NIN; (c_).gk = AP->in[4] + (size_t)l * DM; (c_).WT = (bf16*)(ws + WS_WIN) + (size_t)l * NINP * DM; (c_).N = NIN; } \
        else { r -= 8 * I_UP + 8 * I_DN + 4 * I_IN; const int l = r / I_OUT; r -= l * I_OUT; const int kind = l % 3, ji = l / 3; \
            (c_).W = AP->in[kind == 0 ? 8 : kind == 1 ? 11 : 16] + (size_t)ji * DM * DM; if (kind != 1) (c_).gk = AP->in[kind == 0 ? 7 : 15] + (size_t)ji * DM; (c_).WT = (bf16*)(ws + WS_WOUT) + (size_t)l * DM * DM; (c_).N = DM; } \
        (c_).r = r; } while (0)
    f32x4 va[8]; float ga[8]; ConvItem ca{}, cb{};
    if (gw < NITEMS) { CONV_DECODE(gw, ca); conv_load(ca, lane, va, ga); }
    for (int it = gw; it < NITEMS; it += NGW) {
        f32x4 vb[8]; float gb[8]; const int nx = it + NGW;
        if (nx < NITEMS) { CONV_DECODE(nx, cb); conv_load(cb, lane, vb, gb); }
        conv_store(ca, lane, va, ga, scr);
        ca = cb;
#pragma unroll
        for (int i = 0; i < 8; ++i) { va[i] = vb[i]; ga[i] = gb[i]; }
    }
#undef CONV_DECODE
    const float* x = AP->in[0]; bf16* hb = (bf16*)(ws + WS_HB); long long* ss0 = (long long*)(ws + WS_SS);
    for (int m = gw; m < MTOK; m += NGW) {
        const f32x4* xr = (const f32x4*)(x + (size_t)m * DM) + lane; f32x4 v[8]; float s = 0.f;
#pragma unroll
        for (int j = 0; j < 8; ++j) { v[j] = xr[64 * j]; s += (v[j].x * v[j].x + v[j].y * v[j].y) + (v[j].z * v[j].z + v[j].w * v[j].w); }
        s = wave_sum(s);
        v2u* o8 = (v2u*)(hb + (size_t)m * DM) + lane;
#pragma unroll
        for (int j = 0; j < 8; ++j) { v2u w; w.x = pk2(v[j].x, v[j].y); w.y = pk2(v[j].z, v[j].w); o8[64 * j] = w; }
        if (lane == 0) ss0[m] = __float2ll_rn(s * 1048576.0f);
    }
}

constexpr int IMGM_P = 0, IMGM_KT = 8192, IMGM_VT = IMGM_KT + 16384, IMGM_GS = IMGM_VT + 4 * 8192, IMGM_BYTES = IMGM_GS + 1024;
constexpr int IMGG_Q = 0, IMGG_KT = 32768, IMGG_P = 65536, IMGG_VT = IMGG_P + 8192, IMGG_EB = IMGG_VT + 8 * 8192, IMGG_BYTES = IMGG_EB + 1024;
static_assert((size_t)IMGM_BYTES * 4096 <= 352 * MiB && (size_t)IMGG_BYTES * 2048 <= 352 * MiB, "images overlay the (idle) FFN activation buffer");
DI unsigned pk2_sw(float lo, float hi) { unsigned a = __builtin_bit_cast(unsigned, lo), b = __builtin_bit_cast(unsigned, hi); a = (a + 0x7fffu + ((a >> 16) & 1u)) >> 16; b = (b + 0x7fffu + ((b >> 16) & 1u)) & 0xffff0000u; return a | b; }
DI float logsig_fast(float x) { return fminf(x, 0.f) - __logf(1.0f + __expf(-fabsf(x))); }

DI void mlstm_pre(LAS unsigned char* lds, const bf16* P1, const float* G, const float* b_if, unsigned char* img, int tid, int lane, int wave, int bx) {
    LAS bf16* Qs = (LAS bf16*)lds;
    LAS bf16* Ks = Qs + 64 * 128;
    LAS bf16* KTs = Ks + 64 * 128;
    LAS bf16* Ps = KTs + 128 * 64;
    LAS bf16* VT = Ps + 64 * 64;
    LAS float* fa = (LAS float*)(VT + 256 * 64);
    LAS float *bcum = fa, *ipre = fa + 64, *aloc = fa + 128, *wloc = fa + 192, *scal = fa + 256;
    const float KSCALE = 0.08838834764831845f;
    const int g = lane >> 4, r16 = lane & 15;
    v4u pq[2], pk[2]; float pgi = 0.f, pgf = 0.f;
#define MLP_LOAD(it_) do { const int b_ = (it_) >> 9, c_ = ((it_) >> 3) & 63, h_ = (it_) & 7; const int row0_ = b_ * SEQ + c_ * 64; \
        _Pragma("unroll") for (int p = 0; p < 2; ++p) { const int idx = tid + 512 * p, r = idx >> 4, c8 = idx & 15; const bf16* src = P1 + (size_t)(row0_ + r) * NQKV + h_ * 128 + c8 * 8; pq[p] = *(const v4u*)src; pk[p] = *(const v4u*)(src + 1024); } \
        if (tid < 64) { const float* gp = G + (size_t)(row0_ + tid) * 16; pgi = gp[h_]; pgf = gp[8 + h_]; } } while (0)
    if (bx < 4096) MLP_LOAD(bx);
    for (int item = bx; item < 4096; item += gridDim.x) {
        const int h = item & 7;
        unsigned char* im = img + (size_t)item * IMGM_BYTES;
        __syncthreads();
        if (tid < 64) { ipre[tid] = pgi + b_if[h]; bcum[tid] = logsig(pgf + b_if[8 + h]); }
#pragma unroll
        for (int p = 0; p < 2; ++p) { const int idx = tid + 512 * p, r = idx >> 4, c8 = idx & 15; *(LAS v4u*)(Qs + eoff<128>(r, c8 * 8)) = pq[p]; *(LAS v4u*)(Ks + eoff<128>(r, c8 * 8)) = pk[p]; }
        __syncthreads();
        if (wave == 0) {
            const float bt = wave_incl_sum(bcum[lane], lane), ip = ipre[lane];
            const float al = bt + wave_incl_max(ip - bt, lane);
            const float blast = __shfl(bt, 63);
            const float gg = blast - bt + ip;
            const float gmax = wave_max(gg);
            bcum[lane] = bt; aloc[lane] = al; wloc[lane] = __expf(gg - gmax);
            if (lane == 0) { scal[0] = blast; scal[1] = gmax; }
        }
        if (item + (int)gridDim.x < 4096) MLP_LOAD(item + (int)gridDim.x);
        __syncthreads();
#pragma unroll
        for (int p = 0; p < 2; ++p) { const int idx = tid + 512 * p, s = idx >> 4, c8 = idx & 15; const v4u kv = *(const LAS v4u*)(Ks + eoff<128>(s, c8 * 8)); const float w = wloc[s] * KSCALE;
#pragma unroll
            for (int j = 0; j < 4; ++j) { KTs[eoff<64>(c8 * 8 + 2 * j, s)] = (bf16)f2bf(bflo(kv[j]) * w); KTs[eoff<64>(c8 * 8 + 2 * j + 1, s)] = (bf16)f2bf(bfhi(kv[j]) * w); } }
        { const int tt = wave >> 1;
#pragma unroll
          for (int q2 = 0; q2 < 2; ++q2) { const int st = 2 * (wave & 1) + q2; f32x4 acc = (f32x4){0.f, 0.f, 0.f, 0.f};
            if (st <= tt) mma_tile<128, 128, 4>(acc, Qs, 16 * tt, Ks, 16 * st, lane);
            const int s = 16 * st + r16; const float cs = ipre[s] - bcum[s];
#pragma unroll
            for (int i = 0; i < 4; ++i) { const int t = 16 * tt + 4 * g + i; const float p = (s <= t) ? acc[i] * KSCALE * __expf(bcum[t] + cs - aloc[t]) : 0.f; Ps[eoff<64>(t, s)] = (bf16)f2bf(p); } } }
        __syncthreads();
        *(v4u*)(im + IMGM_P + tid * 16) = *(const LAS v4u*)((LAS unsigned char*)Ps + tid * 16);
#pragma unroll
        for (int p = 0; p < 2; ++p) *(v4u*)(im + IMGM_KT + (tid + 512 * p) * 16) = *(const LAS v4u*)((LAS unsigned char*)KTs + (tid + 512 * p) * 16);
        if (tid < 64) { float* gs = (float*)(im + IMGM_GS); gs[tid] = bcum[tid]; gs[64 + tid] = aloc[tid]; if (tid < 2) gs[128 + tid] = scal[tid]; }
    }
#undef MLP_LOAD
}

DI void mlstm_scan2(LAS unsigned char* lds, const bf16* P1, const unsigned char* img, bf16* hm, long long* hss, int tid, int lane, int wave, int bx) {
    constexpr int IB = 8192 + 16384 + 16384 + 10240 + 1024;
    LAS bf16* CT0 = (LAS bf16*)(lds + 2 * IB);
    const int g = lane >> 4, r16 = lane & 15, tt = wave >> 1, eh = wave & 1;
    for (int item0 = bx; item0 < 256; item0 += gridDim.x) {
        const int item = (gridDim.x == 256) ? (item0 & 7) * 32 + (item0 >> 3) : item0;
        const int b = item >> 5, h = (item >> 2) & 7, sl = item & 3;
        f32x4 Cacc[5];
#pragma unroll
        for (int e = 0; e < 5; ++e) Cacc[e] = (f32x4){0.f, 0.f, 0.f, 0.f};
        __syncthreads();
        for (int i = tid; i < 2 * 80 * 128 / 8; i += 512) ((LAS v4u*)CT0)[i] = (v4u){0u, 0u, 0u, 0u};
        float m_prev = 0.f;
        v4u rp, rq[2], rk[2], rv; float rg0 = 0.f, rbl, rgm;
#define MLS_PREFETCH(cc) do { const int item2 = (b * 64 + (cc)) * 8 + h; const unsigned char* im = img + (size_t)item2 * IMGM_BYTES; const int row0_ = b * SEQ + (cc) * 64; \
            rp = *(const v4u*)(im + IMGM_P + tid * 16); rk[0] = *(const v4u*)(im + IMGM_KT + tid * 16); rk[1] = *(const v4u*)(im + IMGM_KT + (tid + 512) * 16); \
            rv = *(const v4u*)(P1 + (size_t)(row0_ + (tid >> 3)) * NQKV + 2048 + h * 256 + sl * 64 + (tid & 7) * 8); \
            _Pragma("unroll") for (int p = 0; p < 2; ++p) { const int idx = tid + 512 * p, r = idx >> 4, c8 = idx & 15; rq[p] = *(const v4u*)(P1 + (size_t)(row0_ + r) * NQKV + h * 128 + c8 * 8); } \
            const float* gs = (const float*)(im + IMGM_GS); if (tid < 128) rg0 = gs[tid]; rbl = gs[128]; rgm = gs[129]; } while (0)
#define MLS_STORE(bi) do { LAS unsigned char* bb = lds + (bi) * IB; \
            *(LAS v4u*)(bb + tid * 16) = rp; *(LAS v4u*)(bb + 8192 + 16384 + tid * 16) = rk[0]; *(LAS v4u*)(bb + 8192 + 16384 + (tid + 512) * 16) = rk[1]; \
            *(LAS v4u*)(bb + 8192 + 16384 + 16384 + off_v64(tid >> 3, tid & 7)) = rv; \
            _Pragma("unroll") for (int p = 0; p < 2; ++p) { const int idx = tid + 512 * p, r = idx >> 4, c8 = idx & 15; *(LAS v4u*)((LAS bf16*)(bb + 8192) + eoff<128>(r, c8 * 8)) = rq[p]; } \
            if (tid < 128) ((LAS float*)(bb + 8192 + 16384 + 16384 + 10240))[tid] = rg0; } while (0)
        MLS_PREFETCH(0); MLS_STORE(0);
        float blast = rbl, gmax = rgm;
        const bf16* gbase = P1 + (size_t)(b * SEQ + 16 * tt + r16) * NQKV + 4096 + h * 256 + sl * 64 + 32 * eh + 4 * g;
        v2u gt[2];
#pragma unroll
        for (int q2 = 0; q2 < 2; ++q2) gt[q2] = *(const v2u*)(gbase + 16 * q2);
        MLS_PREFETCH(1);
        __syncthreads();
        for (int c = 0; c < 64; ++c) {
            const int row0 = b * SEQ + c * 64;
            const LAS unsigned char* bb = lds + (c & 1) * IB;
            const LAS bf16* Ps = (const LAS bf16*)bb; const LAS bf16* Qs = (const LAS bf16*)(bb + 8192); const LAS bf16* KTs = (const LAS bf16*)(bb + 8192 + 16384);
            const LAS bf16* VTs = (const LAS bf16*)(bb + 8192 + 16384 + 16384); const LAS float* gsl = (const LAS float*)(bb + 8192 + 16384 + 16384 + 10240);
            LAS bf16* CTc = CT0 + (c & 1) * 80 * 128; LAS bf16* CTn = CT0 + ((c + 1) & 1) * 80 * 128;
            const int t = 16 * tt + r16;
            v2u gtn[2];
#pragma unroll
            for (int q2 = 0; q2 < 2; ++q2) gtn[q2] = *(const v2u*)(gbase + (size_t)((c + 1 < 64 ? c + 1 : c) * 64) * NQKV + 16 * q2);
            float sq = 0.f;
            const float btv = gsl[t], alv = gsl[64 + t];
            const float mt = fmaxf(btv + m_prev, alv), al = __expf(alv - mt), be = __expf(btv + m_prev - mt), em = __expf(-mt);
            const float m_new = fmaxf(blast + m_prev, gmax), wcs = __expf(blast + m_prev - m_new), gam = __expf(gmax - m_new);
            m_prev = m_new;
            const LAS unsigned char* vb = (const LAS unsigned char*)VTs;
            bf16x8 onesf;
#pragma unroll
            for (int j = 0; j < 8; ++j) onesf[j] = (r16 == 0) ? (short)0x3f80 : (short)0;
            const bf16x8 pa0 = ldf<64>(Ps, 16 * tt + r16, g), pa1 = ldf<64>(Ps, 16 * tt + r16, 4 + g);
            f32x4 d1 = (f32x4){0.f, 0.f, 0.f, 0.f}, d2 = (f32x4){0.f, 0.f, 0.f, 0.f};
            d1 = mfma16(onesf, pa0, d1); d1 = mfma16(onesf, pa1, d1); mma_tile<128, 128, 4>(d2, CTc, 64, Qs, 16 * tt, lane);
            const float den = __shfl(al * d1[0] + be * d2[0], r16);
            const float dinv = __builtin_amdgcn_rcpf(fmaxf(fabsf(den), em));
#pragma unroll
            for (int q2 = 0; q2 < 2; ++q2) { const int et = 2 * eh + q2; f32x4 a1 = (f32x4){0.f, 0.f, 0.f, 0.f}, a2 = (f32x4){0.f, 0.f, 0.f, 0.f};
                a1 = mfma16(vfrag64(vb, et, 0, lane), pa0, a1); a1 = mfma16(vfrag64(vb, et, 1, lane), pa1, a1); mma_tile<128, 128, 4>(a2, CTc, 16 * et, Qs, 16 * tt, lane);
                const f32x4 o4 = (a1 * al + a2 * be) * dinv; sq += (o4[0] * o4[0] + o4[1] * o4[1]) + (o4[2] * o4[2] + o4[3] * o4[3]);
                const float s0 = __builtin_amdgcn_rcpf(1.0f + __expf(-bflo(gt[q2].x))), s1 = __builtin_amdgcn_rcpf(1.0f + __expf(-bfhi(gt[q2].x)));
                const float s2 = __builtin_amdgcn_rcpf(1.0f + __expf(-bflo(gt[q2].y))), s3 = __builtin_amdgcn_rcpf(1.0f + __expf(-bfhi(gt[q2].y)));
                v2u w; w.x = pk2(o4[0] * s0, o4[1] * s1); w.y = pk2(o4[2] * s2, o4[3] * s3);
                *(v2u*)(hm + (size_t)(row0 + t) * DM + h * 256 + sl * 64 + 16 * et + 4 * g) = w; }
            sq += __shfl_xor(sq, 16); sq += __shfl_xor(sq, 32);
            if (g == 0) atomicAdd((unsigned long long*)(hss + (size_t)(row0 + t) * 8 + h), (unsigned long long)__float2ll_rn(sq * pg8::HSS_FIX));
            const bf16x8 ka0 = ldf<64>(KTs, 16 * wave + r16, g), ka1 = ldf<64>(KTs, 16 * wave + r16, 4 + g);
#pragma unroll
            for (int et = 0; et < 5; ++et) { f32x4 tmp = (f32x4){0.f, 0.f, 0.f, 0.f};
                tmp = mfma16(ka0, et < 4 ? vfrag64(vb, et & 3, 0, lane) : onesf, tmp); tmp = mfma16(ka1, et < 4 ? vfrag64(vb, et & 3, 1, lane) : onesf, tmp);
                Cacc[et] = Cacc[et] * wcs + tmp * gam;
                v2u w; w.x = pk2(Cacc[et][0], Cacc[et][1]); w.y = pk2(Cacc[et][2], Cacc[et][3]);
                *(LAS v2u*)(CTn + eoff<128>(16 * et + r16, 16 * wave + 4 * g)) = w; }
            if (c + 1 < 64) { MLS_STORE((c + 1) & 1); blast = rbl; gmax = rgm; }
            if (c + 2 < 64) MLS_PREFETCH(c + 2);
            gt[0] = gtn[0]; gt[1] = gtn[1];
            __syncthreads();
        }
#undef MLS_PREFETCH
#undef MLS_STORE
    }
}

DI void gla_pre(LAS unsigned char* lds, const bf16* P1, const float* G, const float* w_alpha, const float* b_alpha, unsigned char* img, int tid, int lane, int wave, int bx) {
    LAS bf16* VT = (LAS bf16*)lds;
    LAS bf16* QTs = (LAS bf16*)lds;
    LAS bf16* KTl = QTs + 64 * 256;
    LAS bf16* KTT = KTl + 64 * 256;
    LAS bf16* Ps = KTT + 256 * 64;
    LAS float* alow = (LAS float*)(Ps + 64 * 64);
    LAS float* T0 = alow + 1024;
    const int g = lane >> 4, r16 = lane & 15, d = tid & 255, sh = tid >> 8;
    for (int item = bx; item < 2048; item += gridDim.x) {
        const int b = item >> 8, c = (item >> 2) & 63, h = item & 3;
        const int row0 = b * SEQ + c * 64;
        unsigned char* im = img + (size_t)item * IMGG_BYTES;
        __syncthreads();
        float wa[16];
#pragma unroll
        for (int i = 0; i < 16; ++i) wa[i] = w_alpha[i * 1024 + h * 256 + d];
        const float ba = b_alpha[h * 256 + d];
        f32x4 al4 = (f32x4){0.f, 0.f, 0.f, 0.f};
        if (tid < 256) al4 = *(const f32x4*)(G + (size_t)(row0 + (tid >> 2)) * 16 + (tid & 3) * 4);
        if (tid < 256) *(LAS f32x4*)(alow + tid * 4) = al4;
        __syncthreads();
        const bf16* qsrc = P1 + (size_t)(row0 + 32 * sh) * NQKV + h * 256 + d;
        float bs[32]; float run = 0.f;
#pragma unroll
        for (int j = 0; j < 32; ++j) { const int s = 32 * sh + j; float z = ba;
#pragma unroll
            for (int i = 0; i < 16; ++i) z += alow[s * 16 + i] * wa[i];
            run += logsig_fast(z) * (1.0f / 16.0f); bs[j] = run; }
        if (sh == 0) T0[d] = run;
        __syncthreads();
        const float add = sh ? T0[d] : 0.f;
        if (sh) ((float*)(im + IMGG_EB))[d] = __expf(run + add);
#pragma unroll
        for (int q8 = 0; q8 < 4; ++q8) { unsigned kk[8];
#pragma unroll
            for (int j = 0; j < 8; ++j) { const int jj = 8 * q8 + j, s = 32 * sh + jj; const float bsum = bs[jj] + add;
                const float qv = bf2f(qsrc[(size_t)jj * NQKV]) * 0.0625f * __expf(bsum), kv = bf2f(qsrc[(size_t)jj * NQKV + 1024]) * __expf(-bsum);
                QTs[eoff<256>(s, d)] = (bf16)f2bf(qv); kk[j] = f2bf(kv); KTl[eoff<256>(s, d)] = (bf16)kk[j]; }
            v4u w; w.x = kk[0] | (kk[1] << 16); w.y = kk[2] | (kk[3] << 16); w.z = kk[4] | (kk[5] << 16); w.w = kk[6] | (kk[7] << 16);
            *(LAS v4u*)(KTT + eoff<64>(d, 32 * sh + 8 * q8)) = w; }
        __syncthreads();
        { const int tt = wave >> 1;
#pragma unroll
          for (int q2 = 0; q2 < 2; ++q2) { const int st = 2 * (wave & 1) + q2; f32x4 acc = (f32x4){0.f, 0.f, 0.f, 0.f};
            if (st <= tt) mma_tile<256, 256, 8>(acc, QTs, 16 * tt, KTl, 16 * st, lane);
            const int s = 16 * st + r16;
#pragma unroll
            for (int i = 0; i < 4; ++i) { const int t = 16 * tt + 4 * g + i; Ps[eoff<64>(t, s)] = (bf16)f2bf((s <= t) ? acc[i] : 0.f); } } }
        __syncthreads();
#pragma unroll
        for (int p = 0; p < 4; ++p) { *(v4u*)(im + IMGG_Q + (tid + 512 * p) * 16) = *(const LAS v4u*)((LAS unsigned char*)QTs + (tid + 512 * p) * 16);
                                      *(v4u*)(im + IMGG_KT + (tid + 512 * p) * 16) = *(const LAS v4u*)((LAS unsigned char*)KTT + (tid + 512 * p) * 16); }
        *(v4u*)(im + IMGG_P + tid * 16) = *(const LAS v4u*)((LAS unsigned char*)Ps + tid * 16);
    }
}

DI void gla_scan2(LAS unsigned char* lds, const bf16* P1, const unsigned char* img, bf16* hm, long long* hss, int tid, int lane, int wave, int bx) {
    LAS bf16* QTs = (LAS bf16*)lds;
    LAS bf16* KTT = QTs + 64 * 256;
    LAS bf16* Ps = KTT + 256 * 64;
    LAS bf16* VTs = Ps + 64 * 64;
    LAS float* eb = (LAS float*)(VTs + 64 * 64);
    LAS bf16* ST0 = (LAS bf16*)(eb + 256);
    const int g = lane >> 4, r16 = lane & 15, tt = wave >> 1, eh = wave & 1;
    for (int item0 = bx; item0 < 256; item0 += gridDim.x) {
        const int item = (gridDim.x == 256) ? (item0 & 7) * 32 + (item0 >> 3) : item0;
        const int b = item >> 5, h = (item >> 3) & 3, sl = item & 7;
        f32x4 Sacc[2][4];
#pragma unroll
        for (int a = 0; a < 2; ++a)
#pragma unroll
            for (int e = 0; e < 4; ++e) Sacc[a][e] = (f32x4){0.f, 0.f, 0.f, 0.f};
        __syncthreads();
        for (int i = tid; i < 2 * 64 * 256 / 8; i += 512) ((LAS v4u*)ST0)[i] = (v4u){0u, 0u, 0u, 0u};
        v4u rq[4], rk[4], rp, rv; float re = 0.f;
#define GLS_PREFETCH(cc) do { const int item2 = (b * 64 + (cc)) * 4 + h; const unsigned char* im = img + (size_t)item2 * IMGG_BYTES; \
            _Pragma("unroll") for (int p = 0; p < 4; ++p) { rq[p] = *(const v4u*)(im + IMGG_Q + (tid + 512 * p) * 16); rk[p] = *(const v4u*)(im + IMGG_KT + (tid + 512 * p) * 16); } \
            rp = *(const v4u*)(im + IMGG_P + tid * 16); rv = *(const v4u*)(P1 + ((size_t)b * SEQ + (cc) * 64 + (tid >> 3)) * NQKV + 2048 + h * 512 + sl * 64 + (tid & 7) * 8); if (tid < 256) re = ((const float*)(im + IMGG_EB))[tid]; } while (0)
        const bf16* gbase = P1 + (size_t)(b * SEQ + 16 * tt + r16) * NQKV + 4096 + h * 512 + sl * 64 + 32 * eh + 4 * g;
        v2u gt[2];
#pragma unroll
        for (int q2 = 0; q2 < 2; ++q2) gt[q2] = *(const v2u*)(gbase + 16 * q2);
        GLS_PREFETCH(0);
        for (int c = 0; c < 64; ++c) {
            const int row0 = b * SEQ + c * 64;
            LAS bf16* STc = ST0 + (c & 1) * 64 * 256; LAS bf16* STn = ST0 + ((c + 1) & 1) * 64 * 256;
            __syncthreads();
#pragma unroll
            for (int p = 0; p < 4; ++p) { *(LAS v4u*)((LAS unsigned char*)QTs + (tid + 512 * p) * 16) = rq[p]; *(LAS v4u*)((LAS unsigned char*)KTT + (tid + 512 * p) * 16) = rk[p]; }
            *(LAS v4u*)((LAS unsigned char*)Ps + tid * 16) = rp; *(LAS v4u*)((LAS unsigned char*)VTs + off_v64(tid >> 3, tid & 7)) = rv;
            if (tid < 256) eb[tid] = re;
            __syncthreads();
            v2u gtn[2];
#pragma unroll
            for (int q2 = 0; q2 < 2; ++q2) gtn[q2] = *(const v2u*)(gbase + (size_t)((c + 1 < 64 ? c + 1 : c) * 64) * NQKV + 16 * q2);
            if (c + 1 < 64) GLS_PREFETCH(c + 1);
            float sq = 0.f;
            const LAS unsigned char* vb = (const LAS unsigned char*)VTs;
            const bf16x8 pa0 = ldf<64>(Ps, 16 * tt + r16, g), pa1 = ldf<64>(Ps, 16 * tt + r16, 4 + g);
#pragma unroll
            for (int q2 = 0; q2 < 2; ++q2) { const int et = 2 * eh + q2; f32x4 acc = (f32x4){0.f, 0.f, 0.f, 0.f};
                acc = mfma16(vfrag64(vb, et, 0, lane), pa0, acc); acc = mfma16(vfrag64(vb, et, 1, lane), pa1, acc); mma_tile<256, 256, 8>(acc, STc, 16 * et, QTs, 16 * tt, lane);
                sq += (acc[0] * acc[0] + acc[1] * acc[1]) + (acc[2] * acc[2] + acc[3] * acc[3]);
                const float g0 = bflo(gt[q2].x), g1 = bfhi(gt[q2].x), g2 = bflo(gt[q2].y), g3 = bfhi(gt[q2].y);
                const float o0 = acc[0] * (g0 * __builtin_amdgcn_rcpf(1.0f + __expf(-g0))), o1 = acc[1] * (g1 * __builtin_amdgcn_rcpf(1.0f + __expf(-g1)));
                const float o2 = acc[2] * (g2 * __builtin_amdgcn_rcpf(1.0f + __expf(-g2))), o3 = acc[3] * (g3 * __builtin_amdgcn_rcpf(1.0f + __expf(-g3)));
                v2u w; w.x = pk2_sw(o0, o1); w.y = pk2_sw(o2, o3);
                *(v2u*)(hm + (size_t)(row0 + 16 * tt + r16) * DM + h * 512 + sl * 64 + 16 * et + 4 * g) = w; }
            sq += __shfl_xor(sq, 16); sq += __shfl_xor(sq, 32);
            if (g == 0) atomicAdd((unsigned long long*)(hss + (size_t)(row0 + 16 * tt + r16) * 4 + h), (unsigned long long)__float2ll_rn(sq * pg8::HSS_FIX));
#pragma unroll
            for (int a = 0; a < 2; ++a) { const int dt = 2 * wave + a;
                const f32x4 ev = *(const LAS f32x4*)(eb + 16 * dt + 4 * g);
                const bf16x8 ka0 = ldf<64>(KTT, 16 * dt + r16, g), ka1 = ldf<64>(KTT, 16 * dt + r16, 4 + g);
#pragma unroll
                for (int et = 0; et < 4; ++et) { Sacc[a][et] = mfma16(ka0, vfrag64(vb, et, 0, lane), Sacc[a][et]); Sacc[a][et] = mfma16(ka1, vfrag64(vb, et, 1, lane), Sacc[a][et]); Sacc[a][et] = Sacc[a][et] * ev;
                    v2u w; w.x = pk2(Sacc[a][et][0], Sacc[a][et][1]); w.y = pk2(Sacc[a][et][2], Sacc[a][et][3]);
                    *(LAS v2u*)(STn + eoff<256>(16 * et + r16, 16 * dt + 4 * g)) = w; } }
            gt[0] = gtn[0]; gt[1] = gtn[1];
        }
#undef GLS_PREFETCH
    }
}


DI void mixer_gates(const bf16* hb, const bf16* wg, const long long* ss, float* G, int lane, int wave, int bx) {
    const int g = lane >> 4, r16 = lane & 15;
    for (int t = bx * NWAVES + wave; t < MTOK / 16; t += gridDim.x * NWAVES) {
        const bf16* ap = hb + (size_t)(16 * t + r16) * DM + 8 * g; const bf16* bp = wg + (size_t)r16 * DM + 8 * g;
        f32x4 acc = (f32x4){0.f, 0.f, 0.f, 0.f};
#pragma unroll 8
        for (int kk = 0; kk < DM / 32; ++kk) { const bf16x8 a = *(const bf16x8*)(ap + 32 * kk), b = *(const bf16x8*)(bp + 32 * kk); acc = mfma16(a, b, acc); }
#pragma unroll
        for (int i = 0; i < 4; ++i) { const int row = 16 * t + 4 * g + i; G[(size_t)row * 16 + r16] = acc[i] * pg8::rstd_of(ss, row); }
    }
}

template <int HS, int ACT> DI void headnorm_gate(const bf16* hraw, const bf16* P1, const float* gnorm, bf16* hm, int lane, int wave, int bx) {
    constexpr int NH = DM / HS, EPL = HS / 64;
    const int gw = bx * NWAVES + wave, NGW = gridDim.x * NWAVES;
    for (int row = gw; row < MTOK; row += NGW) {
#pragma unroll
        for (int hh = 0; hh < NH; ++hh) { const int col = hh * HS + lane * EPL;
            unsigned xw[EPL / 2], gwd[EPL / 2];
            if constexpr (EPL == 4) { const v2u a = *(const v2u*)(hraw + (size_t)row * DM + col), b2 = *(const v2u*)(P1 + (size_t)row * NQKV + 4096 + col); xw[0] = a.x; xw[1] = a.y; gwd[0] = b2.x; gwd[1] = b2.y; }
            else { const v4u a = *(const v4u*)(hraw + (size_t)row * DM + col), b2 = *(const v4u*)(P1 + (size_t)row * NQKV + 4096 + col); xw[0] = a.x; xw[1] = a.y; xw[2] = a.z; xw[3] = a.w; gwd[0] = b2.x; gwd[1] = b2.y; gwd[2] = b2.z; gwd[3] = b2.w; }
            float s = 0.f;
#pragma unroll
            for (int j = 0; j < EPL / 2; ++j) { const float x0 = bflo(xw[j]), x1 = bfhi(xw[j]); s += x0 * x0 + x1 * x1; }
            s = wave_sum(s); const float rs = rsqrtf(s * (1.0f / HS) + 1e-6f);
            unsigned outw[EPL / 2];
#pragma unroll
            for (int j = 0; j < EPL / 2; ++j) { const float g0 = bflo(gwd[j]), g1 = bfhi(gwd[j]);
                const float a0 = ACT == 0 ? __builtin_amdgcn_rcpf(1.0f + __expf(-g0)) : g0 * __builtin_amdgcn_rcpf(1.0f + __expf(-g0)), a1 = ACT == 0 ? __builtin_amdgcn_rcpf(1.0f + __expf(-g1)) : g1 * __builtin_amdgcn_rcpf(1.0f + __expf(-g1));
                outw[j] = pk2(bflo(xw[j]) * rs * gnorm[col + 2 * j] * a0, bfhi(xw[j]) * rs * gnorm[col + 2 * j + 1] * a1); }
            if constexpr (EPL == 4) { v2u w; w.x = outw[0]; w.y = outw[1]; *(v2u*)(hm + (size_t)row * DM + col) = w; }
            else { v4u w; w.x = outw[0]; w.y = outw[1]; w.z = outw[2]; w.w = outw[3]; *(v4u*)(hm + (size_t)row * DM + col) = w; }
        }
    }
}

DI void fox_cf(LAS unsigned char* lds, const float* G, const float* b_f, float* cf, const bf16* P1, unsigned* kmax2, int tid, int lane, int wave, int bx) {
    LAS float* wt = (LAS float*)lds;
    for (int item = bx; item < 256; item += gridDim.x) { const int seq = item >> 1, hf = item & 1, b = seq >> 4, h = seq & 15; const float bias = b_f[h];
        const float* gp = G + ((size_t)b * SEQ + hf * 2048 + tid * 4) * 16 + h;
        float ls[4]; float s = 0.f, s0 = 0.f;
#pragma unroll
        for (int p = 0; p < 4; ++p) { ls[p] = logsig(gp[p * 16] + bias); s += ls[p]; }
        if (hf) { const float* g0 = gp - (size_t)2048 * 16;
#pragma unroll
            for (int p = 0; p < 4; ++p) s0 += logsig(g0[p * 16] + bias); }
        const float incl = wave_incl_sum(s, lane), tot0 = wave_sum(s0);
        __syncthreads();
        if (lane == 63) wt[wave] = incl; if (lane == 0) wt[8 + wave] = tot0;
        __syncthreads();
        float base = 0.f;
#pragma unroll
        for (int w = 0; w < 8; ++w) { base += (w < wave) ? wt[w] : 0.f; base += wt[8 + w]; }
        float run = base + incl - s;
        float* o = cf + (size_t)seq * SEQ + hf * 2048 + tid * 4; f32x4 ov;
        run += ls[0]; ov.x = run; run += ls[1]; ov.y = run; run += ls[2]; ov.z = run; run += ls[3]; ov.w = run;
        *(f32x4*)o = ov;
        float km = 0.f; const bf16* kp = P1 + ((size_t)b * SEQ + hf * 2048) * NQKV + 2048 + h * 128;
#pragma unroll 8
        for (int i = 0; i < 64; ++i) { const int idx = tid + 512 * i, r = idx >> 4, c = idx & 15; const v4u kv = *(const v4u*)(kp + (size_t)r * NQKV + c * 8); float s2 = 0.f;
#pragma unroll
            for (int q = 0; q < 4; ++q) { const float x0 = bflo(kv[q]), x1 = bfhi(kv[q]); s2 += x0 * x0 + x1 * x1; }
            s2 += __shfl_xor(s2, 1); s2 += __shfl_xor(s2, 2); s2 += __shfl_xor(s2, 4); s2 += __shfl_xor(s2, 8); km = fmaxf(km, s2); }
        km = fmaxf(km, __shfl_xor(km, 16)); km = fmaxf(km, __shfl_xor(km, 32));
        if (lane == 0) atomicMax(kmax2 + seq, __float_as_uint(km));
    }
}

DI bf16x8 pack8_mfma(const f32x4& lo, const f32x4& hi) { v4u p;
    asm volatile("v_cvt_pk_bf16_f32 %0, %4, %5\n\tv_cvt_pk_bf16_f32 %1, %6, %7\n\tv_cvt_pk_bf16_f32 %2, %8, %9\n\tv_cvt_pk_bf16_f32 %3, %10, %11\n\ts_nop 1"
                 : "=&v"(p[0]), "=&v"(p[1]), "=&v"(p[2]), "=&v"(p[3]) : "v"(lo[0]), "v"(lo[1]), "v"(lo[2]), "v"(lo[3]), "v"(hi[0]), "v"(hi[1]), "v"(hi[2]), "v"(hi[3]));
    return __builtin_bit_cast(bf16x8, p); }
DI unsigned off_v(unsigned row, unsigned ch) { return 256u * row + 16u * (ch ^ (((row & 3u) << 2) | (((row >> 2) & 1u) << 1))); }

DI void fox_attn2(LAS unsigned char* lds, const bf16* P1, const float* cf, const unsigned* kmax2, bf16* hm, int tid, int lane, int wave, int bx) {
    constexpr int BUFB = 16384 + 16384 + 256;
    LAS float* xch = (LAS float*)(lds + 2 * BUFB);
    const float LOG2E = 1.4426950408889634f, QS = 0.08838834764831845f * 1.4426950408889634f, THR = 8.0f;
    const int g = lane >> 4, r16 = lane & 15;
    const int G_ = gridDim.x;
    const int nit = (2048 + G_ - 1) / G_;
    for (int it = 0; it < nit; ++it) {
        const int u = (it & 1) ? it * G_ + (G_ - 1 - bx) : it * G_ + bx;
        if (u >= 2048) continue;
        const int qb = 15 - (u >> 7), bh = u & 127, b = bh >> 4, h = bh & 15;
        const size_t rowb = (size_t)b * SEQ; const int q0 = qb * 256 + 32 * wave;
        bf16x8 qf[2][4]; float c0[2];
#pragma unroll
        for (int tt = 0; tt < 2; ++tt) { const int t = q0 + 16 * tt + r16; c0[tt] = cf[(size_t)bh * SEQ + t] * LOG2E;
#pragma unroll
            for (int kk = 0; kk < 4; ++kk) { const v4u raw = *(const v4u*)(P1 + (rowb + t) * NQKV + h * 128 + 32 * kk + 8 * g); v4u sc;
#pragma unroll
                for (int j = 0; j < 4; ++j) sc[j] = pk2(bflo(raw[j]) * QS, bfhi(raw[j]) * QS);
                qf[tt][kk] = __builtin_bit_cast(bf16x8, sc); } }
        f32x4 oacc[8][2];
#pragma unroll
        for (int et = 0; et < 8; ++et) { oacc[et][0] = (f32x4){0.f, 0.f, 0.f, 0.f}; oacc[et][1] = (f32x4){0.f, 0.f, 0.f, 0.f}; }
        float lrun[2] = {0.f, 0.f};
        const int ntiles = 4 * (qb + 1);
        v4u kreg[2], vreg[2]; float cfreg = 0.f;
        const bf16* kbase = P1 + rowb * NQKV + 2048 + h * 128;
#define FOX_LOAD(j) do { _Pragma("unroll") for (int p = 0; p < 2; ++p) { const int idx = tid + 512 * p, r = idx >> 4, c8 = idx & 15; \
            kreg[p] = *(const v4u*)(kbase + (size_t)(64 * (j) + r) * NQKV + c8 * 8); vreg[p] = *(const v4u*)(kbase + (size_t)(64 * (j) + r) * NQKV + 2048 + c8 * 8); } \
            if (tid < 64) cfreg = -cf[(size_t)bh * SEQ + 64 * (j) + tid] * LOG2E; } while (0)
#define FOX_STORE(bufi) do { LAS unsigned char* bb = lds + (bufi) * BUFB; _Pragma("unroll") for (int p = 0; p < 2; ++p) { const int idx = tid + 512 * p, r = idx >> 4, c8 = idx & 15; \
            *(LAS v4u*)((LAS bf16*)bb + eoff<128>(r, c8 * 8)) = kreg[p]; *(LAS v4u*)(bb + 16384 + off_v(r, c8)) = vreg[p]; } \
            if (tid < 64) ((LAS float*)(bb + 32768))[tid] = cfreg; } while (0)
        float qm = 0.f;
#pragma unroll
        for (int tt = 0; tt < 2; ++tt) { float s2 = 0.f;
#pragma unroll
            for (int kk = 0; kk < 4; ++kk)
#pragma unroll
                for (int jq = 0; jq < 8; ++jq) { const float v = bf2f((unsigned short)qf[tt][kk][jq]); s2 += v * v; }
            s2 += __shfl_xor(s2, 16); s2 += __shfl_xor(s2, 32); qm = fmaxf(qm, s2); }
        qm = fmaxf(qm, __shfl_xor(qm, 1)); qm = fmaxf(qm, __shfl_xor(qm, 2)); qm = fmaxf(qm, __shfl_xor(qm, 4)); qm = fmaxf(qm, __shfl_xor(qm, 8));
        __syncthreads();
        if (lane == 0) xch[16 + wave] = qm;
        FOX_LOAD(ntiles - 1); FOX_STORE(0);
        if (ntiles > 1) FOX_LOAD(ntiles - 2);
        __syncthreads();
        float q2 = xch[16];
#pragma unroll
        for (int w8 = 1; w8 < 8; ++w8) q2 = fmaxf(q2, xch[16 + w8]);
        const float QKB = sqrtf(q2 * __uint_as_float(kmax2[bh])) * 1.01f + 1e-3f;
        const float cfu0 = cf[(size_t)bh * SEQ + qb * 256] * LOG2E;
        float mref[2] = {0.f, 0.f}, rmaxlog[2] = {-__builtin_inff(), -__builtin_inff()};
        for (int k = 0; k < ntiles; ++k) { const int j = ntiles - 1 - k;
            if (k + 1 < ntiles) FOX_STORE((k + 1) & 1);
            if (k + 2 < ntiles) FOX_LOAD(ntiles - 3 - k);
            if (64 * j <= q0 + 31) {
                const LAS bf16* Ks = (const LAS bf16*)(lds + (k & 1) * BUFB); const LAS bf16* VTs = Ks + 64 * 128; const LAS float* cfs = (const LAS float*)(VTs + 128 * 64);
                f32x4 sacc[2][4];
#pragma unroll
                for (int st = 0; st < 4; ++st) { const f32x4 cv = *(const LAS f32x4*)(cfs + 16 * st + 4 * g);
#pragma unroll
                    for (int tt = 0; tt < 2; ++tt) sacc[tt][st] = cv + c0[tt]; }
#pragma unroll
                for (int st = 0; st < 4; ++st)
#pragma unroll
                    for (int kk = 0; kk < 4; ++kk) { const bf16x8 kf = ldf<128>(Ks, 16 * st + r16, 4 * kk + g);
                        sacc[0][st] = mfma16(kf, qf[0][kk], sacc[0][st]); sacc[1][st] = mfma16(kf, qf[1][kk], sacc[1][st]); if (kk == 3) asm volatile("" ::: "memory"); }
                if (64 * j + 63 > q0) {
#pragma unroll
                    for (int tt = 0; tt < 2; ++tt) { const int t = q0 + 16 * tt + r16;
#pragma unroll
                        for (int st = 0; st < 4; ++st)
#pragma unroll
                            for (int i = 0; i < 4; ++i) { const int s = 64 * j + 16 * st + 4 * g + i; if (s > t) sacc[tt][st][i] = -__builtin_inff(); } }
                }
                float mx[2];
#pragma unroll
                for (int tt = 0; tt < 2; ++tt) { float m = -__builtin_inff();
#pragma unroll
                    for (int st = 0; st < 4; ++st) m = fmaxf(m, fmaxf(fmaxf(sacc[tt][st][0], sacc[tt][st][1]), fmaxf(sacc[tt][st][2], sacc[tt][st][3])));
                    m = fmaxf(m, __shfl_xor(m, 16)); m = fmaxf(m, __shfl_xor(m, 32)); mx[tt] = m; }
                rmaxlog[0] = fmaxf(rmaxlog[0], mx[0] + mref[0]); rmaxlog[1] = fmaxf(rmaxlog[1], mx[1] + mref[1]);
                if (__any(mx[0] > THR || mx[1] > THR)) {
#pragma unroll
                    for (int tt = 0; tt < 2; ++tt) { const float sh = fmaxf(mx[tt], 0.f), f = __builtin_amdgcn_exp2f(-sh);
                        c0[tt] -= sh; mref[tt] += sh; lrun[tt] *= f;
#pragma unroll
                        for (int st = 0; st < 4; ++st) sacc[tt][st] = sacc[tt][st] - sh;
#pragma unroll
                        for (int et = 0; et < 8; ++et) oacc[et][tt] = oacc[et][tt] * f; }
                }
#pragma unroll
                for (int tt = 0; tt < 2; ++tt) { float ls = 0.f;
#pragma unroll
                    for (int st = 0; st < 4; ++st)
#pragma unroll
                        for (int i = 0; i < 4; ++i) { const float p = __builtin_amdgcn_exp2f(sacc[tt][st][i]); sacc[tt][st][i] = p; ls += p; }
                    lrun[tt] += ls; }
#pragma unroll
                for (int ks = 0; ks < 2; ++ks) { bf16x8 pb[2];
#pragma unroll
                    for (int tt = 0; tt < 2; ++tt) pb[tt] = pack8_mfma(sacc[tt][2 * ks], sacc[tt][2 * ks + 1]);
#pragma unroll
                    for (int et = 0; et < 8; ++et) {
                        const LAS unsigned char* vb = (const LAS unsigned char*)VTs;
                        const v4i16_t lo = tr_read(vb + off_v(32 * ks + 4 * g + (r16 >> 2), 2 * et + ((lane & 3) >> 1)) + 8 * (lane & 1));
                        const v4i16_t hi = tr_read(vb + off_v(32 * ks + 16 + 4 * g + (r16 >> 2), 2 * et + ((lane & 3) >> 1)) + 8 * (lane & 1));
                        bf16x8 va; va[0] = lo[0]; va[1] = lo[1]; va[2] = lo[2]; va[3] = lo[3]; va[4] = hi[0]; va[5] = hi[1]; va[6] = hi[2]; va[7] = hi[3];
                        oacc[et][0] = mfma16(va, pb[0], oacc[et][0]); oacc[et][1] = mfma16(va, pb[1], oacc[et][1]); if (et & 1) asm volatile("" ::: "memory"); } }
            }
            { float wm = fminf(rmaxlog[0], rmaxlog[1]);
              wm = fminf(wm, __shfl_xor(wm, 1)); wm = fminf(wm, __shfl_xor(wm, 2)); wm = fminf(wm, __shfl_xor(wm, 4)); wm = fminf(wm, __shfl_xor(wm, 8));
              if (lane == 0) xch[(k & 1) * 8 + wave] = wm; }
            __syncthreads();
            if (k + 1 < ntiles) { float mmin = xch[(k & 1) * 8];
#pragma unroll
                for (int w8 = 1; w8 < 8; ++w8) mmin = fminf(mmin, xch[(k & 1) * 8 + w8]);
                const float cfe = ((const LAS float*)(lds + ((k + 1) & 1) * BUFB + 32768))[63];
                if (QKB + cfu0 + cfe < mmin - 60.0f) break; }
        }
#undef FOX_LOAD
#undef FOX_STORE
#pragma unroll
        for (int tt = 0; tt < 2; ++tt) { float l = lrun[tt]; l += __shfl_xor(l, 16); l += __shfl_xor(l, 32); const float inv = 1.0f / l;
            bf16* orow = hm + (rowb + q0 + 16 * tt + r16) * DM + h * 128 + 4 * g;
#pragma unroll
            for (int et = 0; et < 8; ++et) { v2u w; w.x = pk2(oacc[et][tt][0] * inv, oacc[et][tt][1] * inv); w.y = pk2(oacc[et][tt][2] * inv, oacc[et][tt][3] * inv); *(v2u*)(orow + 16 * et) = w; } }
    }
}


DI void final_norm(float* out, const bf16* hb, const long long* ss, const float* gfin, int lane, int wave, int bx) {
    const int gw = bx * NWAVES + wave, NGW = gridDim.x * NWAVES;
    for (int m = gw; m < MTOK; m += NGW) { const float rs = pg8::rstd_of(ss, m);
        const v4u* hr = (const v4u*)(hb + (size_t)m * DM); f32x4* xr = (f32x4*)(out + (size_t)m * DM); const f32x4* gr = (const f32x4*)gfin;
#pragma unroll
        for (int j = 0; j < 4; ++j) { const v4u w = hr[lane + 64 * j]; const int c4 = 2 * (lane + 64 * j);
            const f32x4 g0 = gr[c4], g1 = gr[c4 + 1];
            xr[c4] = (f32x4){bflo(w.x) * rs * g0.x, bfhi(w.x) * rs * g0.y, bflo(w.y) * rs * g0.z, bfhi(w.y) * rs * g0.w};
            xr[c4 + 1] = (f32x4){bflo(w.z) * rs * g1.x, bfhi(w.z) * rs * g1.y, bflo(w.w) * rs * g1.z, bfhi(w.w) * rs * g1.w}; } }
}

#define PH(p) if (lo <= (p) && (p) < hi && (ran ? (xcd_barrier(bar), true) : (ran = true)))
#define TID() int tid = threadIdx.x; asm volatile("" : "+v"(tid)); const int lane = tid & 63, wave = __builtin_amdgcn_readfirstlane(tid >> 6); int bx = blockIdx.x; asm volatile("" : "+s"(bx)); (void)lane; (void)wave; (void)bx
#define WSP(T, off) ((T*)(ka->ws + (off)))
template <int j> DI void subblock(LAS unsigned char* lds, const XcdBarrier& bar, const int lo, const int hi, bool& ran) {
    {
        constexpr int layer = j / 3, typ = j - 3 * layer, base = 1 + 5 * j;
        if constexpr (typ != 1) {
            PH(base) { TID(); KArgs ka = kargs(); const int mi = layer * 2 + (typ >> 1);
                pg8::Gemm gm{WSP(bf16, WS_HB), WSP(bf16, WS_WUP) + (size_t)mi * NUP * DM, MTOK, NUP, DM}; pg8::StaticOrder S; S.init(MTOK, NUP, gridDim.x, bx);
                pg8::EpiSwiGLU E{WSP(bf16, WS_ACT), WSP(long long, WS_SS) + (size_t)j * MTOK, DFF};
                pg8::gemm_phase<pg8::EpiSwiGLU, pg8::StaticOrder, PG8_ALIGN, PG8_SP2>(lds, gm, S, E); }
        } else {
            constexpr int kind = layer % 3, ji = layer / 3, HSLOT = (layer * 2 + 1) / 3;
            (void)ji; (void)HSLOT;
            PH(base) { TID(); KArgs ka = kargs();
                mixer_gates(WSP(bf16, WS_HB), WSP(bf16, WS_WIN) + ((size_t)layer * NINP + NQKV) * DM, WSP(long long, WS_SS) + (size_t)j * MTOK, WSP(float, WS_G), lane, wave, bx);
                pg8::Gemm gm{WSP(bf16, WS_HB), WSP(bf16, WS_WIN) + (size_t)layer * NINP * DM, MTOK, NQKV, DM}; pg8::StaticOrder S; S.init(MTOK, NQKV, gridDim.x, bx);
                pg8::EpiMixIn E{WSP(bf16, WS_P1), WSP(long long, WS_SS) + (size_t)j * MTOK};
                pg8::gemm_phase<pg8::EpiMixIn, pg8::StaticOrder, PG8_ALIGN, PG8_SP2>(lds, gm, S, E); }
            PH(base + 1) { TID(); KArgs ka = kargs();
                if constexpr (kind == 0) for (int rep = 0; rep < REP_MLSTM; ++rep) mlstm_pre(lds, WSP(bf16, WS_P1), WSP(float, WS_G), ka->in[6] + ji * 16, WSP(unsigned char, WS_ACT), tid, lane, wave, bx);
                else if constexpr (kind == 1) { fox_cf(lds, WSP(float, WS_G), ka->in[10] + ji * 16, WSP(float, WS_CF), WSP(bf16, WS_P1), WSP(unsigned, WS_CTL) + CW_KMAX, tid, lane, wave, bx); }
                else for (int rep = 0; rep < REP_GLA; ++rep) gla_pre(lds, WSP(bf16, WS_P1), WSP(float, WS_G), ka->in[13] + (size_t)ji * 16 * 1024, ka->in[14] + ji * 1024, WSP(unsigned char, WS_ACT), tid, lane, wave, bx);
            }
            PH(base + 2) { TID(); KArgs ka = kargs();
                if constexpr (kind == 0) for (int rep = 0; rep < REP_MLSTM; ++rep) mlstm_scan2(lds, WSP(bf16, WS_P1), WSP(unsigned char, WS_ACT), WSP(bf16, WS_HM), WSP(long long, WS_HSS) + (size_t)HSLOT * MTOK * 8, tid, lane, wave, bx);
                else if constexpr (kind == 1) for (int rep = 0; rep < REP_FOX; ++rep) fox_attn2(lds, WSP(bf16, WS_P1), WSP(float, WS_CF), WSP(unsigned, WS_CTL) + CW_KMAX, WSP(bf16, WS_HM), tid, lane, wave, bx);
                else for (int rep = 0; rep < REP_GLA; ++rep) gla_scan2(lds, WSP(bf16, WS_P1), WSP(unsigned char, WS_ACT), WSP(bf16, WS_HM), WSP(long long, WS_HSS) + (size_t)HSLOT * MTOK * 8, tid, lane, wave, bx);
            }
        }
        PH(base + 4) { TID(); KArgs ka = kargs();
            pg8::Gemm gm; float scale;
            if constexpr (typ != 1) { const int mi = layer * 2 + (typ >> 1); gm = pg8::Gemm{WSP(bf16, WS_ACT), WSP(bf16, WS_WDN) + (size_t)mi * DM * DFF, MTOK, DM, DFF}; scale = 0.5f; }
            else { gm = pg8::Gemm{WSP(bf16, WS_HM), WSP(bf16, WS_WOUT) + (size_t)layer * DM * DM, MTOK, DM, DM}; scale = 1.0f; }
            pg8::StaticOrder S; S.init(MTOK, DM, gridDim.x, bx);
            constexpr int NHS = (typ != 1 || layer % 3 == 1) ? 0 : (layer % 3 == 0 ? 8 : 4);
            pg8::EpiResidT<NHS> E{WSP(bf16, WS_HB), WSP(long long, WS_SS) + (size_t)(j + 1) * MTOK, scale, WSP(long long, WS_HSS) + (size_t)((layer * 2 + 1) / 3) * MTOK * 8};
            pg8::gemm_phase<pg8::EpiResidT<NHS>, pg8::StaticOrder, PG8_ALIGN, PG8_SP2>(lds, gm, S, E);
        }
    }
}

__global__ void __launch_bounds__(NWAVES * 64, 2) trunk_fwd(Args args) {
    extern __shared__ __attribute__((aligned(16))) unsigned char lds_raw[];
    LAS unsigned char* lds = (LAS unsigned char*)lds_raw;
    volatile LAS unsigned* MISC = (volatile LAS unsigned*)(lds + MISC_OFF);
    for (int u = threadIdx.x; u < (LDS_BYTES - MISC_OFF) / 4; u += NWAVES * 64) ((LAS unsigned*)(lds + MISC_OFF))[u] = 0u;
    __syncthreads();
    XcdBarrier bar = xcd_barrier_post((unsigned*)(args.ws + WS_CTL) + CW_BAR, MISC + 8);
    const int lo = args.ph_lo, hi = args.ph_hi; bool ran = false;

    PH(0) { TID(); for (int rep = 0; rep < REP_PRO; ++rep) { prologue(lds, lane, wave, bx); __syncthreads(); } }

    subblock<0>(lds, bar, lo, hi, ran); subblock<1>(lds, bar, lo, hi, ran); subblock<2>(lds, bar, lo, hi, ran); subblock<3>(lds, bar, lo, hi, ran);
    subblock<4>(lds, bar, lo, hi, ran); subblock<5>(lds, bar, lo, hi, ran); subblock<6>(lds, bar, lo, hi, ran); subblock<7>(lds, bar, lo, hi, ran);
    subblock<8>(lds, bar, lo, hi, ran); subblock<9>(lds, bar, lo, hi, ran); subblock<10>(lds, bar, lo, hi, ran); subblock<11>(lds, bar, lo, hi, ran);
    PH(NPHASE - 1) { TID(); KArgs ka = kargs(); final_norm(ka->out, WSP(bf16, WS_HB), WSP(long long, WS_SS) + (size_t)NSUB * MTOK, ka->in[17], lane, wave, bx); }
#undef WSP
#undef PH
}

static bool phase_exists(int p) {
    if (p == 0 || p == NPHASE - 1) return true;
    const int j = (p - 1) / 5, k = (p - 1) % 5, typ = j % 3;
    if (k == 0 || k == 4) return true;
    if (typ != 1) return false;
    if (k == 3) return false;
    return true;
}
extern "C" void kernel_launch(void* const* d_in, const int* in_sizes, int n_in, void* d_out, int out_size, void* d_ws, size_t ws_size, hipStream_t stream) {
    static int grid = 0;
    if (grid == 0) {
        if (n_in != 18 || in_sizes[0] != MTOK * DM || out_size != MTOK * DM || ws_size < WS_END) { fprintf(stderr, "kernel_launch: unexpected shapes (n_in %d, in0 %d, out %d, ws %zu < %zu)\n", n_in, n_in > 0 ? in_sizes[0] : -1, out_size, ws_size, (size_t)WS_END); grid = -1; return; }
        int dev = 0, cus = 0, per_cu = 0;
        if (hipGetDevice(&dev) != hipSuccess || hipDeviceGetAttribute(&cus, hipDeviceAttributeMultiprocessorCount, dev) != hipSuccess) { grid = -1; return; }
        if (hipFuncSetAttribute((const void*)trunk_fwd, hipFuncAttributeMaxDynamicSharedMemorySize, LDS_BYTES) != hipSuccess) { fprintf(stderr, "kernel_launch: hipFuncSetAttribute failed\n"); grid = -1; return; }
        if (hipOccupancyMaxActiveBlocksPerMultiprocessor(&per_cu, (const void*)trunk_fwd, NWAVES * 64, LDS_BYTES) != hipSuccess || per_cu < 1) fprintf(stderr, "kernel_launch: occupancy query says %d\n", per_cu);
        (void)hipGetLastError();
        grid = cus;
    }
    if (grid < 0) return;
    if (hipMemsetAsync((char*)d_ws + WS_CTL, 0, CTL_ZERO_BYTES, stream) != hipSuccess) return;
    Args a{};
    for (int i = 0; i < 18; ++i) a.in[i] = (const float*)d_in[i];
    a.out = (float*)d_out; a.ws = (unsigned char*)d_ws;
#if MK_PER_PHASE
    for (int p = 0; p < NPHASE; ++p) { if (!phase_exists(p)) continue; a.ph_lo = p; a.ph_hi = p + 1; hipLaunchKernelGGL(trunk_fwd, dim3(grid), dim3(NWAVES * 64), LDS_BYTES, stream, a); }
#else
    a.ph_lo = 0; a.ph_hi = NPHASE; hipLaunchKernelGGL(trunk_fwd, dim3(grid), dim3(NWAVES * 64), LDS_BYTES, stream, a);
#endif
    (void)phase_exists;
}
```

```cpp
#include <hip/hip_runtime.h>
#include <cstdio>
#include <cstdint>
namespace pg8 {
#define PG8_LAS __attribute__((address_space(3)))
typedef unsigned short bf16_t;
typedef short bf16x8 __attribute__((ext_vector_type(8)));
typedef float f32x4 __attribute__((ext_vector_type(4)));
typedef unsigned u32x4 __attribute__((ext_vector_type(4)));
constexpr int BM = 256, BK = 64, HALF = 128, HTB = HALF * BK * 2  , STAGE_BYTES = 8 * HTB, NXCD = 8, WGM = 8;

__host__ __device__ __forceinline__ int lds_byte(int r, int c) { const int st = (r >> 4) * 2 + (c >> 5), rr = r & 15, cc = c & 31, ob = rr * 64 + cc * 2; return st * 1024 + (ob ^ (((ob >> 9) & 1) << 5)); }
__host__ __device__ __forceinline__ void stage_rc(int b, int& R, int& C) { const int st = b / 1024, sb = b % 1024, swz = sb ^ (((sb >> 9) & 1) << 5); R = (st >> 1) * 16 + swz / 64; C = (st & 1) * 32 + (swz % 64) / 2; }
__host__ __device__ __forceinline__ int perm32(int rho) { const int n = rho >> 4, i = rho & 15; return 8 * (i >> 2) + 4 * n + (i & 3); }

struct Unit { int pm, pn; };
struct Gemm { const bf16_t* A; const bf16_t* Bt; int M, N, K; };

struct StaticOrder {
    int nM, nN, nwg, G, c;
    __host__ __device__ void init(int M, int N, int G_, int c_) { nM = M / BM; nN = N / BM; nwg = nM * nN; G = G_; c = c_; }
    __host__ __device__ bool next(int i, Unit& u) const {
        const long L = (long)i * G + c; if (L >= nwg) return false;
        int wgid = (int)L; { const int q = nwg / NXCD, r = nwg % NXCD, xcd = wgid % NXCD, off = wgid / NXCD; wgid = (xcd < r ? xcd * (q + 1) : r * (q + 1) + (xcd - r) * q) + off; }
        const int nig = WGM * nN, gid = wgid / nig, fm = gid * WGM, gsz = (nM - fm) < WGM ? (nM - fm) : WGM;
        u.pm = fm + ((wgid % nig) % gsz); u.pn = (wgid % nig) / gsz; return true;
    }
    __device__ __forceinline__ void a_ready(const Unit&) const {}
    __device__ __forceinline__ void done(const Unit&) const {}
};

__device__ __forceinline__ unsigned cvt_pk_bf16(float lo, float hi) { unsigned r; asm volatile("v_cvt_pk_bf16_f32 %0, %1, %2" : "=v"(r) : "v"(lo), "v"(hi)); return r; }
constexpr float RMS_EPS_F = 1e-6f, SS_FIX = 1048576.0f, SS_UNFIX_D = 1.0f / (1048576.0f * 2048.0f);
typedef long long ss_t;
__device__ __forceinline__ float rstd_of(const ss_t* ss, int row) { return rsqrtf((float)ss[row] * SS_UNFIX_D + RMS_EPS_F); }
template <class Sched> __device__ __forceinline__ int rstd_table_fill(const Sched& S, const ss_t* ss, PG8_LAS unsigned char* ext, int tid) {
    PG8_LAS float* tab = (PG8_LAS float*)ext; int key0 = -1, key1 = -1, bad = 0; Unit u;
    for (int i = 0; S.next(i, u); ++i) { const int slot = (u.pm >> 3) & 1; const int key = slot ? key1 : key0;
        if (key == u.pm) continue;
        if (key >= 0) { bad = 1; continue; }
        if (slot) key1 = u.pm; else key0 = u.pm;
        if (tid < 256) tab[slot * 256 + tid] = rstd_of(ss, u.pm * BM + tid); }
    asm volatile("s_waitcnt lgkmcnt(0)" ::: "memory"); __builtin_amdgcn_s_barrier(); asm volatile("" ::: "memory");
    return bad;
}
__device__ __forceinline__ float rstd_get(const ss_t* ss, const Unit& u, int row, int pf, const PG8_LAS unsigned char* ext) {
    return pf ? rstd_of(ss, row) : ((const PG8_LAS float*)ext)[((u.pm >> 3) & 1) * 256 + (row - u.pm * BM)];
}
struct EpiSwiGLU {
    static constexpr bool PERM = true, AFTER_DRAIN = false, SEG = false;
    bf16_t* O; const ss_t* ss; int ldo;
    template <class Sched> __device__ __forceinline__ int prepare(const Sched& S, PG8_LAS unsigned char* ext, int tid) const { return rstd_table_fill(S, ss, ext, tid); }
    __device__ __forceinline__ void operator()(const f32x4 (&acc)[2][2][4][2], const Unit& u, int wr, int wc, int fr, int fq, int pf, const PG8_LAS unsigned char* ext) const {
        const int row0 = u.pm * BM + wr * 64 + fr, col0 = u.pn * HALF + wc * 32 + 8 * fq;
#pragma unroll
        for (int ai = 0; ai < 2; ++ai)
#pragma unroll
            for (int m = 0; m < 4; ++m) {
                const int row = row0 + ai * HALF + m * 16;
                const float rs = rstd_get(ss, u, row, pf, ext), c1 = -1.4426950408889634f * rs, rs2 = rs * rs;
                float o[8];
#pragma unroll
                for (int n = 0; n < 2; ++n) { const f32x4 p4 = acc[ai][0][m][n] * acc[ai][1][m][n] * rs2;
#pragma unroll
                    for (int j = 0; j < 4; ++j) o[4 * n + j] = p4[j] * __builtin_amdgcn_rcpf(1.0f + __builtin_amdgcn_exp2f(acc[ai][0][m][n][j] * c1)); }
                u32x4 w; w.x = cvt_pk_bf16(o[0], o[1]); w.y = cvt_pk_bf16(o[2], o[3]); w.z = cvt_pk_bf16(o[4], o[5]); w.w = cvt_pk_bf16(o[6], o[7]);
                *(u32x4*)(O + (size_t)row * ldo + col0) = w;
            }
    }
};
struct EpiMixIn {
    static constexpr bool PERM = true, AFTER_DRAIN = false, SEG = false;
    bf16_t* O; const ss_t* ss;
    template <class Sched> __device__ __forceinline__ int prepare(const Sched& S, PG8_LAS unsigned char* ext, int tid) const { return rstd_table_fill(S, ss, ext, tid); }
    __device__ __forceinline__ void operator()(const f32x4 (&acc)[2][2][4][2], const Unit& u, int wr, int wc, int fr, int fq, int pf, const PG8_LAS unsigned char* ext) const {
        const int row0 = u.pm * BM + wr * 64 + fr, col0 = u.pn * BM + wc * 32 + 8 * fq;
#pragma unroll
        for (int ai = 0; ai < 2; ++ai)
#pragma unroll
            for (int m = 0; m < 4; ++m) {
                const int row = row0 + ai * HALF + m * 16;
                const float rs = rstd_get(ss, u, row, pf, ext);
#pragma unroll
                for (int bj = 0; bj < 2; ++bj) { const f32x4 v0 = acc[ai][bj][m][0] * rs, v1 = acc[ai][bj][m][1] * rs;
                    u32x4 w; w.x = cvt_pk_bf16(v0[0], v0[1]); w.y = cvt_pk_bf16(v0[2], v0[3]); w.z = cvt_pk_bf16(v1[0], v1[1]); w.w = cvt_pk_bf16(v1[2], v1[3]);
                    *(u32x4*)(O + (size_t)row * 6144 + col0 + bj * HALF) = w; }
            }
    }
};
constexpr float HSS_FIX = 1073741824.0f;
template <int NH> struct EpiResidT {
    static constexpr bool PERM = true, AFTER_DRAIN = false, SEG = NH > 0; static constexpr int NHX = NH > 0 ? NH : 1, SEGT = (2048 / NHX) / BK;
    bf16_t* hb; ss_t* ssn; float scale; const ss_t* hss;
    __device__ __forceinline__ float hrstd(int row, int hh) const { return rsqrtf((float)hss[(size_t)row * NHX + hh] * (1.0f / (HSS_FIX * (2048 / NHX))) + RMS_EPS_F); }
    __device__ __forceinline__ static int slot_of(const Unit& u, int pf) { return pf ? (pf & 1) : ((u.pm >> 3) & 1); }
    __device__ __forceinline__ void fill(PG8_LAS float* tab, int slot, int pm, int tid) const {
        if (tid < 256) { const int row = pm * BM + tid; float prev = hrstd(row, 0);
#pragma unroll
            for (int hh = 1; hh < NHX; ++hh) { const float c = hrstd(row, hh); tab[(slot * NHX + hh) * 256 + tid] = prev / c; prev = c; }
            tab[(slot * NHX) * 256 + tid] = prev; }
    }
    __device__ __forceinline__ void fill_unit(const Unit& u, int ui, PG8_LAS unsigned char* ext, int tid) const { fill((PG8_LAS float*)ext, ui & 1, u.pm, tid); asm volatile("s_waitcnt lgkmcnt(0)" ::: "memory"); }
    template <class Sched> __device__ __forceinline__ int prepare(const Sched& S, PG8_LAS unsigned char* ext, int tid) const {
        if constexpr (NH == 0) return 0;
        else {
            PG8_LAS float* tab = (PG8_LAS float*)ext; int key0 = -1, key1 = -1, bad = 0; Unit u;
            for (int i = 0; S.next(i, u); ++i) { const int slot = (u.pm >> 3) & 1; const int key = slot ? key1 : key0;
                if (key == u.pm) continue;
                if (key >= 0) { bad = 1; continue; }
                if (slot) key1 = u.pm; else key0 = u.pm;
                fill(tab, slot, u.pm, tid); }
            if (bad) tab[((tid >> 8) & 1) * NH * 256 + (tid & 255)] = 1.0f;
            asm volatile("s_waitcnt lgkmcnt(0)" ::: "memory"); __builtin_amdgcn_s_barrier(); asm volatile("" ::: "memory");
            return bad;
        }
    }
    __device__ __forceinline__ void rescale(f32x4 (&acc)[2][2][4][2], const Unit& u, int hh, int wr, int fr, int pf, const PG8_LAS unsigned char* ext) const {
        int t_ = threadIdx.x; asm volatile("" : "+v"(t_));
        const PG8_LAS float* tab = (const PG8_LAS float*)ext + (slot_of(u, pf) * NHX + hh) * 256 + ((t_ >> 8) << 6) + (t_ & 15);
#pragma unroll
        for (int ai = 0; ai < 2; ++ai)
#pragma unroll
            for (int m = 0; m < 4; ++m) { const int lr = ai * HALF + m * 16; float r;
                r = tab[lr];
#pragma unroll
                for (int bj = 0; bj < 2; ++bj) { acc[ai][bj][m][0] = acc[ai][bj][m][0] * r; acc[ai][bj][m][1] = acc[ai][bj][m][1] * r; }
            }
    }
    __device__ __forceinline__ void operator()(const f32x4 (&acc)[2][2][4][2], const Unit& u, int wr, int wc, int fr, int fq, int pf, const PG8_LAS unsigned char* ext) const {
        const int row0 = u.pm * BM + wr * 64 + fr, col0 = u.pn * BM + wc * 32 + 8 * fq;
        u32x4 rb[3][2];
#define PG8_LDG(gi, buf) do { const size_t off_ = (size_t)(row0 + ((gi) >> 2) * HALF + ((gi) & 3) * 16) * 2048 + col0; \
            _Pragma("unroll") for (int q_ = 0; q_ < 2; ++q_) buf[q_] = *(const u32x4*)(hb + off_ + q_ * HALF); } while (0)
        PG8_LDG(0, rb[0]); PG8_LDG(1, rb[1]);
#pragma unroll
        for (int gi = 0; gi < 8; ++gi) {
            if (gi + 2 < 8) PG8_LDG(gi + 2, rb[(gi + 2) % 3]);
            const int ai = gi >> 2, m = gi & 3;
            const int row = row0 + ai * HALF + m * 16; const size_t off = (size_t)row * 2048 + col0; float sq = 0.f;
            float sc = scale;
            if constexpr (NH > 0) sc *= ((const PG8_LAS float*)ext)[(slot_of(u, pf) * NHX) * 256 + (row - u.pm * BM)];
#pragma unroll
            for (int bj = 0; bj < 2; ++bj) { const u32x4 hw = rb[gi % 3][bj];
                const f32x4 h0 = (f32x4){__uint_as_float(hw.x << 16), __uint_as_float(hw.x & 0xffff0000u), __uint_as_float(hw.y << 16), __uint_as_float(hw.y & 0xffff0000u)};
                const f32x4 h1 = (f32x4){__uint_as_float(hw.z << 16), __uint_as_float(hw.z & 0xffff0000u), __uint_as_float(hw.w << 16), __uint_as_float(hw.w & 0xffff0000u)};
                const f32x4 n0 = h0 + acc[ai][bj][m][0] * sc, n1 = h1 + acc[ai][bj][m][1] * sc;
                u32x4 w; w.x = cvt_pk_bf16(n0[0], n0[1]); w.y = cvt_pk_bf16(n0[2], n0[3]); w.z = cvt_pk_bf16(n1[0], n1[1]); w.w = cvt_pk_bf16(n1[2], n1[3]);
                *(u32x4*)(hb + off + bj * HALF) = w;
                const float r0 = __uint_as_float(w.x << 16), r1 = __uint_as_float(w.x & 0xffff0000u), r2 = __uint_as_float(w.y << 16), r3 = __uint_as_float(w.y & 0xffff0000u);
                const float r4 = __uint_as_float(w.z << 16), r5 = __uint_as_float(w.z & 0xffff0000u), r6 = __uint_as_float(w.w << 16), r7 = __uint_as_float(w.w & 0xffff0000u);
                sq += ((r0 * r0 + r1 * r1) + (r2 * r2 + r3 * r3)) + ((r4 * r4 + r5 * r5) + (r6 * r6 + r7 * r7)); }
            sq += __shfl_xor(sq, 16); sq += __shfl_xor(sq, 32);
            if (fq == 0) atomicAdd((unsigned long long*)(ssn + row), (unsigned long long)__float2ll_rn(sq * SS_FIX));
        }
#undef PG8_LDG
    }
};
typedef EpiResidT<0> EpiResid;

template <class Epi, class Sched, bool ALIGN_EPI = false, bool SP2 = false>
__device__ __forceinline__ void gemm_phase(PG8_LAS unsigned char* lds, const Gemm g, const Sched& S, const Epi& E) {
    int tid_ = threadIdx.x; asm volatile("" : "+v"(tid_));
    const int tid = tid_, wid = __builtin_amdgcn_readfirstlane(tid >> 6), lane = tid & 63, wr = wid >> 2, wc = wid & 3, fr = lane & 15, fq = lane >> 4;
    const int K = g.K, nt = K / BK;
    unsigned voffA[2], voffB[2];
#pragma unroll
    for (int i = 0; i < 2; ++i) { int R, C; stage_rc(tid * 16 + i * 8192, R, C); const int Rb = Epi::PERM ? ((R & ~31) + perm32(R & 31)) : R;
        voffA[i] = (unsigned)(R * K + C) * 2u; voffB[i] = (unsigned)(Rb * K + C) * 2u; }
    const size_t kstep = (size_t)(BK * 2);
    const size_t hstep = (size_t)HALF * K * 2;
    const size_t tstep = 2 * hstep;
    const unsigned ldsw = (unsigned)wid * 1024u;
    const int aoff = lds_byte(wr * 64 + fr, fq * 8), boff = lds_byte(wc * 32 + fr, fq * 8);
#define PG8_SA(b, h) (((b) * 2 + (h)) * HTB)
#define PG8_SB(b, h) ((4 + (b) * 2 + (h)) * HTB)
#define PG8_STAGE(bufoff, gbase, voff) do { _Pragma("unroll") for (int _i = 0; _i < 2; ++_i) \
        __builtin_amdgcn_global_load_lds((const unsigned*)((const char*)(gbase) + (voff)[_i]), (PG8_LAS unsigned*)(lds + (bufoff) + ldsw + _i * 8192), 16, 0, 0); } while (0)
#define PG8_LDA(dst, b, h) do { _Pragma("unroll") for (int m = 0; m < 4; ++m) _Pragma("unroll") for (int k = 0; k < 2; ++k) dst[m][k] = *(const PG8_LAS bf16x8*)(lds + PG8_SA(b, h) + aoff + m * 2048 + k * 1024); } while (0)
#define PG8_LDB(dst, b, h) do { _Pragma("unroll") for (int n = 0; n < 2; ++n) _Pragma("unroll") for (int k = 0; k < 2; ++k) dst[n][k] = *(const PG8_LAS bf16x8*)(lds + PG8_SB(b, h) + boff + n * 2048 + k * 1024); } while (0)
#define PG8_MMA(ai, bj, At, Bt) do { __builtin_amdgcn_s_setprio(1); _Pragma("unroll") for (int m = 0; m < 4; ++m) _Pragma("unroll") for (int n = 0; n < 2; ++n) _Pragma("unroll") for (int k = 0; k < 2; ++k) \
        acc[ai][bj][m][n] = __builtin_amdgcn_mfma_f32_16x16x32_bf16(Bt[n][k], At[m][k], acc[ai][bj][m][n], 0, 0, 0); __builtin_amdgcn_s_setprio(0); } while (0)
#define PG8_WAIT_V(n) asm volatile("s_waitcnt vmcnt(" #n ")" ::: "memory")
#define PG8_WAIT_L(n) asm volatile("s_waitcnt lgkmcnt(" #n ")" ::: "memory")
#define PG8_BAR __builtin_amdgcn_s_barrier()
#define PG8_SCHED __builtin_amdgcn_sched_barrier(0)
    const int pf0 = E.prepare(S, lds + STAGE_BYTES, tid); int pf = pf0;
    Unit cur, nxt; int ui = 0;
    if (!S.next(0, cur)) return;
    if constexpr (Epi::SEG) { if (pf0) { E.fill_unit(cur, 0, lds + STAGE_BYTES, tid); pf = 2; } }
    f32x4 acc[2][2][4][2];
#pragma unroll
    for (int a = 0; a < 2; ++a)
#pragma unroll
        for (int b = 0; b < 2; ++b)
#pragma unroll
            for (int m = 0; m < 4; ++m)
#pragma unroll
                for (int n = 0; n < 2; ++n) acc[a][b][m][n] = (f32x4){0.f, 0.f, 0.f, 0.f};
    bf16x8 At[4][2], B0[2][2], B1[2][2];
    const char* cA = (const char*)g.A + (size_t)cur.pm * tstep; const char* cB = (const char*)g.Bt + (size_t)cur.pn * tstep;
    S.a_ready(cur);
    if constexpr (SP2) {
        PG8_STAGE(PG8_SB(0, 0), cB, voffB); PG8_STAGE(PG8_SB(0, 1), cB + hstep, voffB); PG8_STAGE(PG8_SA(0, 0), cA, voffA); PG8_STAGE(PG8_SA(0, 1), cA + hstep, voffA);
        if (wr == 1) PG8_BAR;
        PG8_WAIT_V(2); PG8_BAR;
        PG8_STAGE(PG8_SB(1, 0), cB + kstep, voffB); PG8_STAGE(PG8_SA(1, 0), cA + kstep, voffA); PG8_STAGE(PG8_SB(1, 1), cB + hstep + kstep, voffB);
        PG8_WAIT_V(6); PG8_BAR;
    } else {
        PG8_STAGE(PG8_SB(0, 0), cB, voffB); PG8_STAGE(PG8_SA(0, 0), cA, voffA); PG8_STAGE(PG8_SB(0, 1), cB + hstep, voffB); PG8_STAGE(PG8_SA(0, 1), cA + hstep, voffA);
        if (wr == 1) PG8_BAR;
        PG8_WAIT_V(4); PG8_BAR;
        PG8_STAGE(PG8_SB(1, 0), cB + kstep, voffB); PG8_STAGE(PG8_SA(1, 0), cA + kstep, voffA); PG8_STAGE(PG8_SB(1, 1), cB + hstep + kstep, voffB);
        PG8_WAIT_V(6); PG8_BAR;
    }
    for (;;) {
        const bool has_next = S.next(ui + 1, nxt);
        const char* nA = has_next ? (const char*)g.A + (size_t)nxt.pm * tstep : cA; const char* nB = has_next ? (const char*)g.Bt + (size_t)nxt.pn * tstep : cB;
        for (int t = 0; t < nt; t += 2) {
            const bool last = (t == nt - 2);
            const char* a1 = cA + (size_t)(t + 1) * kstep;
            const char* a2 = last ? nA : cA + (size_t)(t + 2) * kstep; const char* b2 = last ? nB : cB + (size_t)(t + 2) * kstep;
            const char* a3 = a2 + kstep; const char* b3 = b2 + kstep;
            if (last && has_next) S.a_ready(nxt);
            if constexpr (Epi::SEG) { if ((t & (Epi::SEGT - 1)) == 0) E.rescale(acc, cur, t / Epi::SEGT, wr, fr, pf, lds + STAGE_BYTES); }
            if constexpr (SP2) {
            PG8_LDB(B0, 0, 0); PG8_LDB(B1, 0, 1); PG8_SCHED; PG8_LDA(At, 0, 0); PG8_STAGE(PG8_SA(1, 1), a1 + hstep, voffA);
            PG8_WAIT_V(8); PG8_WAIT_L(0); PG8_BAR; PG8_MMA(0, 0, At, B0); PG8_MMA(0, 1, At, B1); PG8_BAR; PG8_SCHED;
            PG8_LDA(At, 0, 1); PG8_STAGE(PG8_SB(0, 0), b2, voffB); PG8_STAGE(PG8_SB(0, 1), b2 + hstep, voffB); PG8_STAGE(PG8_SA(0, 0), a2, voffA);
            PG8_WAIT_V(8); PG8_WAIT_L(0); PG8_BAR; PG8_MMA(1, 0, At, B0); PG8_MMA(1, 1, At, B1); PG8_BAR; PG8_SCHED;
            PG8_LDB(B0, 1, 0); PG8_LDB(B1, 1, 1); PG8_SCHED; PG8_LDA(At, 1, 0); PG8_STAGE(PG8_SA(0, 1), a2 + hstep, voffA);
            PG8_WAIT_V(8); PG8_WAIT_L(0); PG8_BAR; PG8_MMA(0, 0, At, B0); PG8_MMA(0, 1, At, B1); PG8_BAR; PG8_SCHED;
            PG8_LDA(At, 1, 1); PG8_STAGE(PG8_SB(1, 0), b3, voffB); PG8_STAGE(PG8_SB(1, 1), b3 + hstep, voffB); PG8_STAGE(PG8_SA(1, 0), a3, voffA);
            PG8_WAIT_V(8); PG8_WAIT_L(0); PG8_BAR; PG8_MMA(1, 0, At, B0); PG8_MMA(1, 1, At, B1); PG8_BAR; PG8_SCHED;
            } else {
            PG8_LDB(B0, 0, 0); PG8_SCHED; PG8_LDA(At, 0, 0); PG8_STAGE(PG8_SA(1, 1), a1 + hstep, voffA);
            PG8_WAIT_L(8); PG8_BAR; PG8_WAIT_L(0); PG8_MMA(0, 0, At, B0); PG8_BAR; PG8_SCHED;
            PG8_LDB(B1, 0, 1); PG8_STAGE(PG8_SB(0, 0), b2, voffB);
            PG8_BAR; PG8_WAIT_L(0); PG8_MMA(0, 1, At, B1); PG8_BAR;
            PG8_LDA(At, 0, 1); PG8_STAGE(PG8_SA(0, 0), a2, voffA);
            PG8_BAR; PG8_WAIT_L(0); PG8_MMA(1, 0, At, B0); PG8_BAR; PG8_SCHED;
            PG8_STAGE(PG8_SB(0, 1), b2 + hstep, voffB);
            PG8_WAIT_V(6); PG8_BAR; PG8_MMA(1, 1, At, B1); PG8_BAR;
            PG8_LDB(B0, 1, 0); PG8_SCHED; PG8_LDA(At, 1, 0); PG8_STAGE(PG8_SA(0, 1), a2 + hstep, voffA);
            PG8_WAIT_L(8); PG8_BAR; PG8_WAIT_L(0); PG8_MMA(0, 0, At, B0); PG8_BAR; PG8_SCHED;
            PG8_LDB(B1, 1, 1); PG8_STAGE(PG8_SB(1, 0), b3, voffB);
            PG8_BAR; PG8_WAIT_L(0); PG8_MMA(0, 1, At, B1); PG8_BAR;
            PG8_LDA(At, 1, 1); PG8_STAGE(PG8_SA(1, 0), a3, voffA);
            PG8_BAR; PG8_WAIT_L(0); PG8_MMA(1, 0, At, B0); PG8_BAR; PG8_SCHED;
            PG8_STAGE(PG8_SB(1, 1), b3 + hstep, voffB);
            PG8_WAIT_V(6); PG8_BAR; PG8_MMA(1, 1, At, B1); PG8_BAR;
            }
        }
        if constexpr (ALIGN_EPI) { if (wr == 0) PG8_BAR; }
        if constexpr (!Epi::AFTER_DRAIN) { E(acc, cur, wr, wc, fr, fq, pf, lds + STAGE_BYTES); S.done(cur); }
        if (!has_next) break;
#pragma unroll
        for (int a = 0; a < 2; ++a)
#pragma unroll
            for (int b = 0; b < 2; ++b)
#pragma unroll
                for (int m = 0; m < 4; ++m)
#pragma unroll
                    for (int n = 0; n < 2; ++n) acc[a][b][m][n] = (f32x4){0.f, 0.f, 0.f, 0.f};
        cur = nxt; cA = nA; cB = nB; ++ui;
        if constexpr (Epi::SEG) { if (pf0) { E.fill_unit(cur, ui, lds + STAGE_BYTES, tid); pf = 2 + (ui & 1); } }
        if constexpr (ALIGN_EPI) { if (wr == 1) PG8_BAR; }
    }
    PG8_WAIT_V(0);
    if constexpr (!ALIGN_EPI) { if (wr == 0) PG8_BAR; }
    PG8_BAR;
    if constexpr (Epi::AFTER_DRAIN) { E.fused(acc, cur, wr, wc, fr, fq, lds, wid, lane); S.done(cur); }
#undef PG8_SA
#undef PG8_SB
#undef PG8_STAGE
#undef PG8_LDA
#undef PG8_LDB
#undef PG8_MMA
#undef PG8_WAIT_V
#undef PG8_WAIT_L
#undef PG8_BAR
#undef PG8_SCHED
}
}

#ifndef PG8_SP2
#define PG8_SP2 true
#endif
#ifndef PG8_ALIGN
#define PG8_ALIGN true
#endif
#ifndef REP_PRO
#define REP_PRO 1
#endif
#ifndef REP_MLSTM
#define REP_MLSTM 1
#endif
#ifndef REP_FOX
#define REP_FOX 1
#endif
#ifndef REP_GLA
#define REP_GLA 1
#endif
#ifndef MK_PER_PHASE
#define MK_PER_PHASE 0
#endif

constexpr int DM = 2048, BATCH = 8, SEQ = 4096, MTOK = BATCH * SEQ, DEPTH = 4, DFF = 5632, NUP = 2 * DFF, NIN = 6160, NINP = 6400, NQKV = 6144;
constexpr int NWAVES = 8;
constexpr int NSUB = 3 * DEPTH;
constexpr int NPHASE = 2 + 5 * NSUB;

constexpr size_t MiB = 1u << 20;
constexpr size_t WS_CTL = 0, CTL_ZERO_BYTES = 11 * MiB;
constexpr size_t WS_SS = 1 * MiB;
constexpr size_t WS_HSS = 5 * MiB;
constexpr size_t WS_WUP = 12 * MiB;
constexpr size_t WS_WDN = WS_WUP + 352 * MiB;
constexpr size_t WS_WIN = WS_WDN + 176 * MiB;
constexpr size_t WS_WOUT = WS_WIN + 100 * MiB;
constexpr size_t WS_HB = WS_WOUT + 32 * MiB;
constexpr size_t WS_ACT = WS_HB + 128 * MiB;
constexpr size_t WS_P1 = WS_ACT + 352 * MiB;
constexpr size_t WS_G = WS_P1 + 384 * MiB;
constexpr size_t WS_HRAW = WS_G + 2 * MiB;
constexpr size_t WS_HM = WS_HRAW + 256 * MiB;
constexpr size_t WS_CF = WS_HM + 128 * MiB;
constexpr size_t WS_END = WS_CF + 2 * MiB;
static_assert((size_t)8 * NUP * DM * 2 == 352 * MiB && (size_t)8 * DM * DFF * 2 == 176 * MiB && (size_t)4 * NINP * DM * 2 == 100 * MiB, "weight regions");
static_assert((size_t)MTOK * DFF * 2 == 352 * MiB && (size_t)MTOK * NQKV * 2 == 384 * MiB && WS_SS + 13 * (size_t)MTOK * 8 <= WS_HSS && WS_HSS + 3 * (size_t)MTOK * 64 <= CTL_ZERO_BYTES && CTL_ZERO_BYTES <= WS_WUP, "activation regions");
constexpr int CW_KMAX = 16384;
constexpr int CW_BAR = 4096;

constexpr int LDS_BYTES = 153600, MISC_OFF = 152576;

#define GAS __attribute__((address_space(1)))
#define LAS __attribute__((address_space(3)))
#define DI __device__ __forceinline__
typedef unsigned short bf16;
typedef unsigned v4u __attribute__((ext_vector_type(4)));
typedef unsigned v2u __attribute__((ext_vector_type(2)));
typedef float f32x4 __attribute__((ext_vector_type(4)));
typedef short bf16x8 __attribute__((ext_vector_type(8)));
typedef GAS unsigned gu32;
#define RLX_AGENT __ATOMIC_RELAXED, __HIP_MEMORY_SCOPE_AGENT
#define LDS_WAIT() asm volatile("s_waitcnt lgkmcnt(0)" ::: "memory")
DI unsigned f2bf(float f) { unsigned r; asm("v_cvt_pk_bf16_f32 %0, %1, %1" : "=v"(r) : "v"(f)); return r & 0xffffu; }
DI unsigned pk2(float lo, float hi) { unsigned r; asm("v_cvt_pk_bf16_f32 %0, %1, %2" : "=v"(r) : "v"(lo), "v"(hi)); return r; }
DI float bf2f(unsigned short v) { return __builtin_bit_cast(float, (unsigned)v << 16); }
DI float bflo(unsigned w) { return __builtin_bit_cast(float, w << 16); }
DI float bfhi(unsigned w) { return __builtin_bit_cast(float, w & 0xffff0000u); }
DI float logsig(float x) { return fminf(x, 0.f) - log1pf(expf(-fabsf(x))); }

#define XB_TMO      128
#define XB_XCNT(j)  (256  + 64 * (j))
#define XB_XSUB(j)  (1280 + 64 * (j))
#define XB_XGEN(j)  (2304 + 64 * (j))
#define XB_TOP      3328
#define XB_TOPGEN   3392
#define XCD_BAR_WORDS 3456
#define XB_SPIN_CAP (1u << 18)

__device__ __forceinline__ unsigned xb_ld(unsigned* p)              { return __hip_atomic_load(p, __ATOMIC_RELAXED, __HIP_MEMORY_SCOPE_AGENT); }
__device__ __forceinline__ unsigned xb_add(unsigned* p, unsigned v) { return __hip_atomic_fetch_add(p, v, __ATOMIC_RELAXED, __HIP_MEMORY_SCOPE_AGENT); }
__device__ __forceinline__ unsigned xb_xcc_id() { return (unsigned)__builtin_amdgcn_s_getreg((3 << 11) | 20) & 0xFu; }
#define XB_SPIN(cond, bar) do { unsigned _sp = 0; while (cond) { __builtin_amdgcn_s_sleep(1); \
    if ((++_sp & 255u) == 0u) { if (xb_ld(&(bar)[XB_TMO])) break; if (_sp > XB_SPIN_CAP) { atomicAdd(&(bar)[XB_TMO], 1u); break; } } } } while (0)

struct XcdBarrier {
    unsigned* bar; unsigned x;
    volatile LAS unsigned* st;
};

__device__ __forceinline__ XcdBarrier xcd_barrier_post(unsigned* bar, volatile LAS unsigned* st) {
    XcdBarrier b; b.bar = bar; b.x = xb_xcc_id(); b.st = st;
    if (threadIdx.x == 0) (void)xb_add(&bar[XB_XCNT(b.x)], 1u);
    return b;
}
__device__ __forceinline__ void xcd_barrier_complete(unsigned* bar, unsigned x, unsigned& nloc, unsigned& nx) {
    const unsigned G = gridDim.x * gridDim.y * gridDim.z;
    unsigned sum, cnt, mine, sp = 0u;
    for (;;) {
        sum = 0u; cnt = 0u; mine = 0u;
#pragma unroll
        for (unsigned j = 0; j < 16; ++j) { const unsigned c = xb_ld(&bar[XB_XCNT(j)]); sum += c; cnt += (c > 0u) ? 1u : 0u; mine = (j == x) ? c : mine; }
        if (sum == G) break;
        __builtin_amdgcn_s_sleep(1);
        if ((++sp & 255u) == 0u) { if (xb_ld(&bar[XB_TMO])) break; if (sp > XB_SPIN_CAP) { atomicAdd(&bar[XB_TMO], 1u); break; } }
    }
    nloc = mine > 0u ? mine : 1u; nx = cnt > 0u ? cnt : 1u;
}

__device__ __forceinline__ void xcd_barrier(const XcdBarrier& b) {
    asm volatile("s_waitcnt vmcnt(0)" ::: "memory");
    __syncthreads();
    if (threadIdx.x == 0) {
        unsigned* bar = b.bar;
        __builtin_amdgcn_s_waitcnt(0);
        unsigned nloc = b.st[0], nx = b.st[1];
        if (nloc == 0u) { xcd_barrier_complete(bar, b.x, nloc, nx); b.st[0] = nloc; b.st[1] = nx; }
        const unsigned old = xb_add(&bar[XB_XSUB(b.x)], 1u);
        const unsigned gen = old / nloc;
        if (old + 1u == (gen + 1u) * nloc) {
            __builtin_amdgcn_fence(__ATOMIC_RELEASE, "agent");
            asm volatile("s_waitcnt vmcnt(0)" ::: "memory");
            const unsigned og = xb_add(&bar[XB_TOP], 1u);
            const unsigned tg = og / nx;
            if (og + 1u == (tg + 1u) * nx) xb_add(&bar[XB_TOPGEN], 1u);
            else XB_SPIN(xb_ld(&bar[XB_TOPGEN]) == tg, bar);
            __builtin_amdgcn_fence(__ATOMIC_ACQUIRE, "agent");
            xb_add(&bar[XB_XGEN(b.x)], 1u);
            asm volatile("s_waitcnt vmcnt(0)" ::: "memory");
        } else {
            XB_SPIN(xb_ld(&bar[XB_XGEN(b.x)]) == gen, bar);
            __builtin_amdgcn_fence(__ATOMIC_ACQUIRE, "agent");
            asm volatile("s_waitcnt vmcnt(0)" ::: "memory");
        }
    }
    __syncthreads();
}


DI float wave_sum(float v) {
#pragma unroll
    for (int o = 1; o < 64; o <<= 1) v += __shfl_xor(v, o);
    return v;
}
DI float wave_max(float v) {
#pragma unroll
    for (int o = 1; o < 64; o <<= 1) v = fmaxf(v, __shfl_xor(v, o));
    return v;
}
DI float wave_incl_sum(float v, int lane) {
#pragma unroll
    for (int o = 1; o < 64; o <<= 1) { const float t = __shfl_up(v, o); if (lane >= o) v += t; }
    return v;
}
DI float wave_incl_max(float v, int lane) {
#pragma unroll
    for (int o = 1; o < 64; o <<= 1) { const float t = __shfl_up(v, o); if (lane >= o) v = fmaxf(v, t); }
    return v;
}

template <int L> DI int swx(int r) { return L == 64 ? ((r >> 1) & 7) : (r & 15); }
template <int L> DI int eoff(int r, int c) { return r * L + ((((c >> 3) ^ swx<L>(r)) << 3) | (c & 7)); }
template <int L> DI bf16x8 ldf(const LAS bf16* base, int r, int ch) { return *(const LAS bf16x8*)(base + r * L + ((ch ^ swx<L>(r)) << 3)); }
DI f32x4 mfma16(bf16x8 a, bf16x8 b, f32x4 c) { return __builtin_amdgcn_mfma_f32_16x16x32_bf16(a, b, c, 0, 0, 0); }
typedef short v4i16_t __attribute__((ext_vector_type(4)));
DI v4i16_t tr_read(const LAS unsigned char* p) { return __builtin_amdgcn_ds_read_tr16_b64_v4i16((LAS v4i16_t*)p); }
DI bf16x8 cat4(v4i16_t lo, v4i16_t hi) { bf16x8 r; r[0] = lo[0]; r[1] = lo[1]; r[2] = lo[2]; r[3] = lo[3]; r[4] = hi[0]; r[5] = hi[1]; r[6] = hi[2]; r[7] = hi[3]; return r; }
DI unsigned off_v64(unsigned row, unsigned ch) { return 128u * row + 16u * (ch ^ ((((row >> 1) & 1u) << 1) | (((row >> 3) & 1u) << 2))); }
DI bf16x8 vfrag64(const LAS unsigned char* vb, int c, int ks, int lane) { const unsigned g = lane >> 4, q = (lane & 15) >> 2, p = lane & 3;
    return cat4(tr_read(vb + off_v64(32 * ks + 8 * g + q, 2 * c + (p >> 1)) + 8 * (p & 1)), tr_read(vb + off_v64(32 * ks + 8 * g + 4 + q, 2 * c + (p >> 1)) + 8 * (p & 1))); }
template <int LA, int LB, int NK> DI void mma_tile(f32x4& acc, const LAS bf16* A, int ra0, const LAS bf16* B, int rb0, int lane) {
    const int r = lane & 15, g = lane >> 4;
#pragma unroll
    for (int kk = 0; kk < NK; ++kk) { const bf16x8 a = ldf<LA>(A, ra0 + r, 4 * kk + g), b = ldf<LB>(B, rb0 + r, 4 * kk + g); acc = mfma16(a, b, acc); }
}

struct ConvItem { const float* W; const float* gk; bf16* WT; int K, N, mode, r; };
DI void conv_load(const ConvItem& c, int lane, f32x4 (&v)[8], float (&gv)[8]) {
    const int nkb = c.K / 64, nb = c.r / nkb, kb = c.r - nb * nkb, k0 = 64 * kb, n0 = 32 * nb;
    const int n = n0 + 4 * (lane & 7); const bool ok = n < c.N;
#pragma unroll
    for (int i = 0; i < 8; ++i) { const int kk = 8 * i + (lane >> 3); v[i] = ok ? *(const f32x4*)(c.W + (size_t)(k0 + kk) * c.N + n) : (f32x4){0.f, 0.f, 0.f, 0.f}; gv[i] = c.gk ? c.gk[k0 + kk] : 1.0f; }
}
DI void conv_store(const ConvItem& c, int lane, const f32x4 (&v)[8], const float (&gv)[8], LAS float* scr) {
    const int nkb = c.K / 64, nb = c.r / nkb, kb = c.r - nb * nkb, k0 = 64 * kb, n0 = 32 * nb, nq = 4 * (lane & 7);
#pragma unroll
    for (int i = 0; i < 8; ++i) { const int kk = 8 * i + (lane >> 3); LAS float* d = scr + kk * 33 + nq; d[0] = v[i].x * gv[i]; d[1] = v[i].y * gv[i]; d[2] = v[i].z * gv[i]; d[3] = v[i].w * gv[i]; }
    LDS_WAIT(); asm volatile("" ::: "memory");
    int row_off = n0;
    if (c.mode == 1) { const int j = n0 < DFF ? n0 : n0 - DFF; row_off = 256 * (j >> 7) + (j & 127) + (n0 < DFF ? 0 : 128); }
    const int cc = lane & 7;
#pragma unroll
    for (int j = 0; j < 4; ++j) { const int nn = (lane >> 3) + 8 * j; const LAS float* s = scr + (8 * cc) * 33 + nn;
        v4u o; o.x = pk2(s[0 * 33], s[1 * 33]); o.y = pk2(s[2 * 33], s[3 * 33]); o.z = pk2(s[4 * 33], s[5 * 33]); o.w = pk2(s[6 * 33], s[7 * 33]);
        *(v4u*)(c.WT + (size_t)(row_off + nn) * c.K + k0 + 8 * cc) = o; }
    LDS_WAIT(); asm volatile("" ::: "memory");
}

struct Args { const float* in[18]; float* out; unsigned char* ws; int ph_lo, ph_hi; };

typedef const __attribute__((address_space(4))) Args* KArgs;
DI KArgs kargs() { KArgs p = (KArgs)__builtin_amdgcn_kernarg_segment_ptr(); asm volatile("" : "+s"(p)); return p; }
DI void prologue(LAS unsigned char* lds, int lane, int wave, int bx) {
    KArgs AP = kargs();
    LAS float* scr = (LAS float*)(lds + wave * 16384);
    const int gw = bx * NWAVES + wave, NGW = gridDim.x * NWAVES;
    unsigned char* ws = AP->ws;
    constexpr int I_UP = (DM / 64) * (NUP / 32), I_DN = (DFF / 64) * (DM / 32), I_IN = (DM / 64) * (NINP / 32), I_OUT = (DM / 64) * (DM / 32);
    constexpr int NITEMS = 8 * I_UP + 8 * I_DN + 4 * I_IN + 4 * I_OUT;
#define CONV_DECODE(it_, c_) do { int r = (it_); (c_).gk = nullptr; (c_).K = DM; (c_).mode = 0; \
        if (r < 8 * I_UP) { const int mi = r / I_UP; r -= mi * I_UP; (c_).W = AP->in[2] + (size_t)mi * DM * NUP; (c_).gk = AP->in[1] + (size_t)mi * DM; (c_).WT = (bf16*)(ws + WS_WUP) + (size_t)mi * NUP * DM; (c_).N = NUP; (c_).mode = 1; } \
        else if (r < 8 * I_UP + 8 * I_DN) { r -= 8 * I_UP; const int mi = r / I_DN; r -= mi * I_DN; (c_).W = AP->in[3] + (size_t)mi * DFF * DM; (c_).WT = (bf16*)(ws + WS_WDN) + (size_t)mi * DM * DFF; (c_).K = DFF; (c_).N = DM; } \
        else if (r < 8 * I_UP + 8 * I_DN + 4 * I_IN) { r -= 8 * I_UP + 8 * I_DN; const int l = r / I_IN; r -= l * I_IN; const int kind = l % 3, ji = l / 3; \
            (c_).W = AP->in[kind == 0 ? 5 : kind == 1 ? 9 : 12] + (size_t)ji * DM * NIN; (c_).gk = AP->in[4] + (size_t)l * DM; (c_).WT = (bf16*)(ws + WS_WIN) + (size_t)l * NINP * DM; (c_).N = NIN; } \
        else { r -= 8 * I_UP + 8 * I_DN + 4 * I_IN; const int l = r / I_OUT; r -= l * I_OUT; const int kind = l % 3, ji = l / 3; \
            (c_).W = AP->in[kind == 0 ? 8 : kind == 1 ? 11 : 16] + (size_t)ji * DM * DM; if (kind != 1) (c_).gk = AP->in[kind == 0 ? 7 : 15] + (size_t)ji * DM; (c_).WT = (bf16*)(ws + WS_WOUT) + (size_t)l * DM * DM; (c_).N = DM; } \
        (c_).r = r; } while (0)
    f32x4 va[8]; float ga[8]; ConvItem ca{}, cb{};
    if (gw < NITEMS) { CONV_DECODE(gw, ca); conv_load(ca, lane, va, ga); }
    for (int it = gw; it < NITEMS; it += NGW) {
        f32x4 vb[8]; float gb[8]; const int nx = it + NGW;
        if (nx < NITEMS) { CONV_DECODE(nx, cb); conv_load(cb, lane, vb, gb); }
        conv_store(ca, lane, va, ga, scr);
        ca = cb;
#pragma unroll
        for (int i = 0; i < 8; ++i) { va[i] = vb[i]; ga[i] = gb[i]; }
    }
#undef CONV_DECODE
    const float* x = AP->in[0]; bf16* hb = (bf16*)(ws + WS_HB); long long* ss0 = (long long*)(ws + WS_SS);
    for (int m = gw; m < MTOK; m += NGW) {
        const f32x4* xr = (const f32x4*)(x + (size_t)m * DM) + lane; f32x4 v[8]; float s = 0.f;
#pragma unroll
        for (int j = 0; j < 8; ++j) { v[j] = xr[64 * j]; s += (v[j].x * v[j].x + v[j].y * v[j].y) + (v[j].z * v[j].z + v[j].w * v[j].w); }
        s = wave_sum(s);
        v2u* o8 = (v2u*)(hb + (size_t)m * DM) + lane;
#pragma unroll
        for (int j = 0; j < 8; ++j) { v2u w; w.x = pk2(v[j].x, v[j].y); w.y = pk2(v[j].z, v[j].w); o8[64 * j] = w; }
        if (lane == 0) ss0[m] = __float2ll_rn(s * 1048576.0f);
    }
}

constexpr int IMGM_P = 0, IMGM_KT = 8192, IMGM_VT = IMGM_KT + 16384, IMGM_GS = IMGM_VT + 4 * 8192, IMGM_BYTES = IMGM_GS + 1024;
constexpr int IMGG_Q = 0, IMGG_KT = 32768, IMGG_P = 65536, IMGG_VT = IMGG_P + 8192, IMGG_EB = IMGG_VT + 8 * 8192, IMGG_BYTES = IMGG_EB + 1024;
static_assert((size_t)IMGM_BYTES * 4096 <= 352 * MiB && (size_t)IMGG_BYTES * 2048 <= 352 * MiB, "images overlay the (idle) FFN activation buffer");
DI unsigned pk2_sw(float lo, float hi) { unsigned a = __builtin_bit_cast(unsigned, lo), b = __builtin_bit_cast(unsigned, hi); a = (a + 0x7fffu + ((a >> 16) & 1u)) >> 16; b = (b + 0x7fffu + ((b >> 16) & 1u)) & 0xffff0000u; return a | b; }
DI bf16x8 vfrag64p(const LAS unsigned char* vb, int eh, int q2, int ks, int lane) { const unsigned g = lane >> 4, q = (lane & 15) >> 2, p = lane & 3;
    return cat4(tr_read(vb + off_v64(32 * ks + 8 * g + q, 4 * eh + p) + 8 * q2), tr_read(vb + off_v64(32 * ks + 8 * g + 4 + q, 4 * eh + p) + 8 * q2)); }
template <int LA, int LB, int NK> DI void mma_rows(f32x4& acc, const LAS bf16* A, int arow, const LAS bf16* B, int rb0, int lane) {
    const int r = lane & 15, g = lane >> 4;
#pragma unroll
    for (int kk = 0; kk < NK; ++kk) { const bf16x8 a = ldf<LA>(A, arow, 4 * kk + g), b = ldf<LB>(B, rb0 + r, 4 * kk + g); acc = mfma16(a, b, acc); }
}
DI float logsig_fast(float x) { return fminf(x, 0.f) - __logf(1.0f + __expf(-fabsf(x))); }

DI void mlstm_pre(LAS unsigned char* lds, const bf16* P1, const float* G, const float* b_if, unsigned char* img, int tid, int lane, int wave, int bx) {
    LAS bf16* Qs = (LAS bf16*)lds;
    LAS bf16* Ks = Qs + 64 * 128;
    LAS bf16* KTs = Ks + 64 * 128;
    LAS bf16* Ps = KTs + 128 * 64;
    LAS bf16* VT = Ps + 64 * 64;
    LAS float* fa = (LAS float*)(VT + 256 * 64);
    LAS float *bcum = fa, *ipre = fa + 64, *aloc = fa + 128, *wloc = fa + 192, *scal = fa + 256;
    const float KSCALE = 0.08838834764831845f;
    const int g = lane >> 4, r16 = lane & 15;
    v4u pq[2], pk[2]; float pgi = 0.f, pgf = 0.f;
#define MLP_LOAD(it_) do { const int b_ = (it_) >> 9, c_ = ((it_) >> 3) & 63, h_ = (it_) & 7; const int row0_ = b_ * SEQ + c_ * 64; \
        _Pragma("unroll") for (int p = 0; p < 2; ++p) { const int idx = tid + 512 * p, r = idx >> 4, c8 = idx & 15; const bf16* src = P1 + (size_t)(row0_ + r) * NQKV + h_ * 128 + c8 * 8; pq[p] = *(const v4u*)src; pk[p] = *(const v4u*)(src + 1024); } \
        if (tid < 64) { const float* gp = G + (size_t)(row0_ + tid) * 16; pgi = gp[h_]; pgf = gp[8 + h_]; } } while (0)
    if (bx < 4096) MLP_LOAD(bx);
    for (int item = bx; item < 4096; item += gridDim.x) {
        const int h = item & 7;
        unsigned char* im = img + (size_t)item * IMGM_BYTES;
        __syncthreads();
        if (tid < 64) { ipre[tid] = pgi + b_if[h]; bcum[tid] = logsig(pgf + b_if[8 + h]); }
#pragma unroll
        for (int p = 0; p < 2; ++p) { const int idx = tid + 512 * p, r = idx >> 4, c8 = idx & 15; *(LAS v4u*)(Qs + eoff<128>(r, c8 * 8)) = pq[p]; *(LAS v4u*)(Ks + eoff<128>(r, c8 * 8)) = pk[p]; }
        __syncthreads();
        if (wave == 0) {
            const float bt = wave_incl_sum(bcum[lane], lane), ip = ipre[lane];
            const float al = bt + wave_incl_max(ip - bt, lane);
            const float blast = __shfl(bt, 63);
            const float gg = blast - bt + ip;
            const float gmax = wave_max(gg);
            bcum[lane] = bt; aloc[lane] = al; wloc[lane] = __expf(gg - gmax);
            if (lane == 0) { scal[0] = blast; scal[1] = gmax; }
        }
        if (item + (int)gridDim.x < 4096) MLP_LOAD(item + (int)gridDim.x);
        __syncthreads();
#pragma unroll
        for (int p = 0; p < 2; ++p) { const int idx = tid + 512 * p, s = idx >> 4, c8 = idx & 15; const v4u kv = *(const LAS v4u*)(Ks + eoff<128>(s, c8 * 8)); const float w = wloc[s] * KSCALE;
#pragma unroll
            for (int j = 0; j < 4; ++j) { KTs[eoff<64>(c8 * 8 + 2 * j, s)] = (bf16)f2bf(bflo(kv[j]) * w); KTs[eoff<64>(c8 * 8 + 2 * j + 1, s)] = (bf16)f2bf(bfhi(kv[j]) * w); } }
        { const int tt = wave >> 1;
#pragma unroll
          for (int q2 = 0; q2 < 2; ++q2) { const int st = 2 * (wave & 1) + q2; f32x4 acc = (f32x4){0.f, 0.f, 0.f, 0.f};
            if (st <= tt) mma_tile<128, 128, 4>(acc, Qs, 16 * tt, Ks, 16 * st, lane);
            const int s = 16 * st + r16; const float cs = ipre[s] - bcum[s];
#pragma unroll
            for (int i = 0; i < 4; ++i) { const int t = 16 * tt + 4 * g + i; const float p = (s <= t) ? acc[i] * KSCALE * __expf(bcum[t] + cs - aloc[t]) : 0.f; Ps[eoff<64>(t, s)] = (bf16)f2bf(p); } } }
        __syncthreads();
        *(v4u*)(im + IMGM_P + tid * 16) = *(const LAS v4u*)((LAS unsigned char*)Ps + tid * 16);
#pragma unroll
        for (int p = 0; p < 2; ++p) *(v4u*)(im + IMGM_KT + (tid + 512 * p) * 16) = *(const LAS v4u*)((LAS unsigned char*)KTs + (tid + 512 * p) * 16);
        if (tid < 64) { float* gs = (float*)(im + IMGM_GS); gs[tid] = bcum[tid]; gs[64 + tid] = aloc[tid]; if (tid < 2) gs[128 + tid] = scal[tid]; }
    }
#undef MLP_LOAD
}

DI void mlstm_scan2(LAS unsigned char* lds, const bf16* P1, const unsigned char* img, bf16* hm, long long* hss, int tid, int lane, int wave, int bx) {
    constexpr int IB = 8192 + 16384 + 16384 + 10240 + 1024;
    LAS bf16* CT0 = (LAS bf16*)(lds + 2 * IB);
    const int g = lane >> 4, r16 = lane & 15, tt = wave >> 1, eh = wave & 1;
    for (int item0 = bx; item0 < 256; item0 += gridDim.x) {
        const int item = (gridDim.x == 256) ? (item0 & 7) * 32 + (item0 >> 3) : item0;
        const int b = item >> 5, h = (item >> 2) & 7, sl = item & 3;
        f32x4 Cacc[5];
#pragma unroll
        for (int e = 0; e < 5; ++e) Cacc[e] = (f32x4){0.f, 0.f, 0.f, 0.f};
        __syncthreads();
        for (int i = tid; i < 2 * 80 * 128 / 8; i += 512) ((LAS v4u*)CT0)[i] = (v4u){0u, 0u, 0u, 0u};
        float m_prev = 0.f;
        v4u rp, rq[2], rk[2], rv; float rg0 = 0.f, rbl, rgm;
#define MLS_PREFETCH(cc) do { const int item2 = (b * 64 + (cc)) * 8 + h; const unsigned char* im = img + (size_t)item2 * IMGM_BYTES; const int row0_ = b * SEQ + (cc) * 64; \
            rp = *(const v4u*)(im + IMGM_P + tid * 16); rk[0] = *(const v4u*)(im + IMGM_KT + tid * 16); rk[1] = *(const v4u*)(im + IMGM_KT + (tid + 512) * 16); \
            rv = *(const v4u*)(P1 + (size_t)(row0_ + (tid >> 3)) * NQKV + 2048 + h * 256 + sl * 64 + (tid & 7) * 8); \
            _Pragma("unroll") for (int p = 0; p < 2; ++p) { const int idx = tid + 512 * p, r = idx >> 4, c8 = idx & 15; rq[p] = *(const v4u*)(P1 + (size_t)(row0_ + r) * NQKV + h * 128 + c8 * 8); } \
            const float* gs = (const float*)(im + IMGM_GS); if (tid < 128) rg0 = gs[tid]; rbl = gs[128]; rgm = gs[129]; } while (0)
#define MLS_STORE(bi) do { LAS unsigned char* bb = lds + (bi) * IB; \
            *(LAS v4u*)(bb + tid * 16) = rp; *(LAS v4u*)(bb + 8192 + 16384 + tid * 16) = rk[0]; *(LAS v4u*)(bb + 8192 + 16384 + (tid + 512) * 16) = rk[1]; \
            *(LAS v4u*)(bb + 8192 + 16384 + 16384 + off_v64(tid >> 3, tid & 7)) = rv; \
            _Pragma("unroll") for (int p = 0; p < 2; ++p) { const int idx = tid + 512 * p, r = idx >> 4, c8 = idx & 15; *(LAS v4u*)((LAS bf16*)(bb + 8192) + eoff<128>(r, c8 * 8)) = rq[p]; } \
            if (tid < 128) ((LAS float*)(bb + 8192 + 16384 + 16384 + 10240))[tid] = rg0; } while (0)
        MLS_PREFETCH(0); MLS_STORE(0);
        float blast = rbl, gmax = rgm;
        const bf16* gbase = P1 + (size_t)(b * SEQ + 16 * tt + r16) * NQKV + 4096 + h * 256 + sl * 64 + 32 * eh + 8 * g;
        v4u gt = *(const v4u*)gbase;
        MLS_PREFETCH(1);
        __syncthreads();
        for (int c = 0; c < 64; ++c) {
            const int row0 = b * SEQ + c * 64;
            const LAS unsigned char* bb = lds + (c & 1) * IB;
            const LAS bf16* Ps = (const LAS bf16*)bb; const LAS bf16* Qs = (const LAS bf16*)(bb + 8192); const LAS bf16* KTs = (const LAS bf16*)(bb + 8192 + 16384);
            const LAS bf16* VTs = (const LAS bf16*)(bb + 8192 + 16384 + 16384); const LAS float* gsl = (const LAS float*)(bb + 8192 + 16384 + 16384 + 10240);
            LAS bf16* CTc = CT0 + (c & 1) * 80 * 128; LAS bf16* CTn = CT0 + ((c + 1) & 1) * 80 * 128;
            const int t = 16 * tt + r16;
            const v4u gtn = *(const v4u*)(gbase + (size_t)((c + 1 < 64 ? c + 1 : c) * 64) * NQKV);
            float sq = 0.f;
            float sg[2][4];
#pragma unroll
            for (int q2 = 0; q2 < 2; ++q2) { const unsigned wx = q2 ? gt.z : gt.x, wy = q2 ? gt.w : gt.y;
                sg[q2][0] = __builtin_amdgcn_rcpf(1.0f + __expf(-bflo(wx))); sg[q2][1] = __builtin_amdgcn_rcpf(1.0f + __expf(-bfhi(wx)));
                sg[q2][2] = __builtin_amdgcn_rcpf(1.0f + __expf(-bflo(wy))); sg[q2][3] = __builtin_amdgcn_rcpf(1.0f + __expf(-bfhi(wy))); }
            const float btv = gsl[t], alv = gsl[64 + t];
            const float mt = fmaxf(btv + m_prev, alv), al = __expf(alv - mt), be = __expf(btv + m_prev - mt), em = __expf(-mt);
            const float m_new = fmaxf(blast + m_prev, gmax), wcs = __expf(blast + m_prev - m_new), gam = __expf(gmax - m_new);
            m_prev = m_new;
            const LAS unsigned char* vb = (const LAS unsigned char*)VTs;
            bf16x8 onesf;
#pragma unroll
            for (int j = 0; j < 8; ++j) onesf[j] = (r16 == 0) ? (short)0x3f80 : (short)0;
            const bf16x8 pa0 = ldf<64>(Ps, 16 * tt + r16, g), pa1 = ldf<64>(Ps, 16 * tt + r16, 4 + g);
#pragma unroll
            for (int q2 = 0; q2 < 2; ++q2)
#pragma unroll
                for (int i = 0; i < 4; ++i) asm volatile("" : "+v"(sg[q2][i]));
            f32x4 d1 = (f32x4){0.f, 0.f, 0.f, 0.f}, d2 = (f32x4){0.f, 0.f, 0.f, 0.f};
            d1 = mfma16(onesf, pa0, d1); d1 = mfma16(onesf, pa1, d1); mma_tile<128, 128, 4>(d2, CTc, 64, Qs, 16 * tt, lane);
            const float den = __shfl(al * d1[0] + be * d2[0], r16);
            const float dinv = __builtin_amdgcn_rcpf(fmaxf(fabsf(den), em));
            unsigned wv[4];
#pragma unroll
            for (int q2 = 0; q2 < 2; ++q2) { f32x4 a1 = (f32x4){0.f, 0.f, 0.f, 0.f}, a2 = (f32x4){0.f, 0.f, 0.f, 0.f};
                a1 = mfma16(vfrag64p(vb, eh, q2, 0, lane), pa0, a1); a1 = mfma16(vfrag64p(vb, eh, q2, 1, lane), pa1, a1);
                mma_rows<128, 128, 4>(a2, CTc, 32 * eh + 8 * (r16 >> 2) + 4 * q2 + (r16 & 3), Qs, 16 * tt, lane);
                const f32x4 o4 = (a1 * al + a2 * be) * dinv; sq += (o4[0] * o4[0] + o4[1] * o4[1]) + (o4[2] * o4[2] + o4[3] * o4[3]);
                wv[2 * q2] = pk2(o4[0] * sg[q2][0], o4[1] * sg[q2][1]); wv[2 * q2 + 1] = pk2(o4[2] * sg[q2][2], o4[3] * sg[q2][3]); }
            { v4u w; w.x = wv[0]; w.y = wv[1]; w.z = wv[2]; w.w = wv[3]; *(v4u*)(hm + (size_t)(row0 + t) * DM + h * 256 + sl * 64 + 32 * eh + 8 * g) = w; }
            sq += __shfl_xor(sq, 16); sq += __shfl_xor(sq, 32);
            if (g == 0) atomicAdd((unsigned long long*)(hss + (size_t)(row0 + t) * 8 + h), (unsigned long long)__float2ll_rn(sq * pg8::HSS_FIX));
            const bf16x8 ka0 = ldf<64>(KTs, 16 * wave + r16, g), ka1 = ldf<64>(KTs, 16 * wave + r16, 4 + g);
#pragma unroll
            for (int et = 0; et < 5; ++et) { f32x4 tmp = (f32x4){0.f, 0.f, 0.f, 0.f};
                tmp = mfma16(ka0, et < 4 ? vfrag64(vb, et & 3, 0, lane) : onesf, tmp); tmp = mfma16(ka1, et < 4 ? vfrag64(vb, et & 3, 1, lane) : onesf, tmp);
                Cacc[et] = Cacc[et] * wcs + tmp * gam;
                v2u w; w.x = pk2(Cacc[et][0], Cacc[et][1]); w.y = pk2(Cacc[et][2], Cacc[et][3]);
                *(LAS v2u*)(CTn + eoff<128>(16 * et + r16, 16 * wave + 4 * g)) = w; }
            if (c + 1 < 64) { MLS_STORE((c + 1) & 1); blast = rbl; gmax = rgm; }
            if (c + 2 < 64) MLS_PREFETCH(c + 2);
            gt = gtn;
            __syncthreads();
        }
#undef MLS_PREFETCH
#undef MLS_STORE
    }
}

DI void gla_pre(LAS unsigned char* lds, const bf16* P1, const float* G, const float* w_alpha, const float* b_alpha, unsigned char* img, int tid, int lane, int wave, int bx) {
    LAS bf16* VT = (LAS bf16*)lds;
    LAS bf16* QTs = (LAS bf16*)lds;
    LAS bf16* KTl = QTs + 64 * 256;
    LAS bf16* KTT = KTl + 64 * 256;
    LAS bf16* Ps = KTT + 256 * 64;
    LAS float* alow = (LAS float*)(Ps + 64 * 64);
    LAS float* T0 = alow + 1024;
    const int g = lane >> 4, r16 = lane & 15, d = tid & 255, sh = tid >> 8;
    for (int item = bx; item < 2048; item += gridDim.x) {
        const int b = item >> 8, c = (item >> 2) & 63, h = item & 3;
        const int row0 = b * SEQ + c * 64;
        unsigned char* im = img + (size_t)item * IMGG_BYTES;
        __syncthreads();
        float wa[16];
#pragma unroll
        for (int i = 0; i < 16; ++i) wa[i] = w_alpha[i * 1024 + h * 256 + d];
        const float ba = b_alpha[h * 256 + d];
        f32x4 al4 = (f32x4){0.f, 0.f, 0.f, 0.f};
        if (tid < 256) al4 = *(const f32x4*)(G + (size_t)(row0 + (tid >> 2)) * 16 + (tid & 3) * 4);
        if (tid < 256) *(LAS f32x4*)(alow + tid * 4) = al4;
        __syncthreads();
        const bf16* qsrc = P1 + (size_t)(row0 + 32 * sh) * NQKV + h * 256 + d;
        float bs[32]; float run = 0.f;
#pragma unroll
        for (int j = 0; j < 32; ++j) { const int s = 32 * sh + j; float z = ba;
#pragma unroll
            for (int i = 0; i < 16; ++i) z += alow[s * 16 + i] * wa[i];
            run += logsig_fast(z) * (1.0f / 16.0f); bs[j] = run; }
        if (sh == 0) T0[d] = run;
        __syncthreads();
        const float add = sh ? T0[d] : 0.f;
        if (sh) ((float*)(im + IMGG_EB))[d] = __expf(run + add);
#pragma unroll
        for (int q8 = 0; q8 < 4; ++q8) { unsigned kk[8];
#pragma unroll
            for (int j = 0; j < 8; ++j) { const int jj = 8 * q8 + j, s = 32 * sh + jj; const float bsum = bs[jj] + add;
                const float qv = bf2f(qsrc[(size_t)jj * NQKV]) * 0.0625f * __expf(bsum), kv = bf2f(qsrc[(size_t)jj * NQKV + 1024]) * __expf(-bsum);
                QTs[eoff<256>(s, d)] = (bf16)f2bf(qv); kk[j] = f2bf(kv); KTl[eoff<256>(s, d)] = (bf16)kk[j]; }
            v4u w; w.x = kk[0] | (kk[1] << 16); w.y = kk[2] | (kk[3] << 16); w.z = kk[4] | (kk[5] << 16); w.w = kk[6] | (kk[7] << 16);
            *(LAS v4u*)(KTT + eoff<64>(d, 32 * sh + 8 * q8)) = w; }
        __syncthreads();
        { const int tt = wave >> 1;
#pragma unroll
          for (int q2 = 0; q2 < 2; ++q2) { const int st = 2 * (wave & 1) + q2; f32x4 acc = (f32x4){0.f, 0.f, 0.f, 0.f};
            if (st <= tt) mma_tile<256, 256, 8>(acc, QTs, 16 * tt, KTl, 16 * st, lane);
            const int s = 16 * st + r16;
#pragma unroll
            for (int i = 0; i < 4; ++i) { const int t = 16 * tt + 4 * g + i; Ps[eoff<64>(t, s)] = (bf16)f2bf((s <= t) ? acc[i] : 0.f); } } }
        __syncthreads();
#pragma unroll
        for (int p = 0; p < 4; ++p) { *(v4u*)(im + IMGG_Q + (tid + 512 * p) * 16) = *(const LAS v4u*)((LAS unsigned char*)QTs + (tid + 512 * p) * 16);
                                      *(v4u*)(im + IMGG_KT + (tid + 512 * p) * 16) = *(const LAS v4u*)((LAS unsigned char*)KTT + (tid + 512 * p) * 16); }
        *(v4u*)(im + IMGG_P + tid * 16) = *(const LAS v4u*)((LAS unsigned char*)Ps + tid * 16);
    }
}

DI void gla_scan2(LAS unsigned char* lds, const bf16* P1, const unsigned char* img, bf16* hm, long long* hss, int tid, int lane, int wave, int bx) {
    LAS bf16* QTs = (LAS bf16*)lds;
    LAS bf16* KTT = QTs + 64 * 256;
    LAS bf16* Ps = KTT + 256 * 64;
    LAS bf16* VTs = Ps + 64 * 64;
    LAS float* eb = (LAS float*)(VTs + 64 * 64);
    LAS bf16* ST0 = (LAS bf16*)(eb + 256);
    const int g = lane >> 4, r16 = lane & 15, tt = wave >> 1, eh = wave & 1;
    for (int item0 = bx; item0 < 256; item0 += gridDim.x) {
        const int item = (gridDim.x == 256) ? (item0 & 7) * 32 + (item0 >> 3) : item0;
        const int b = item >> 5, h = (item >> 3) & 3, sl = item & 7;
        f32x4 Sacc[2][4];
#pragma unroll
        for (int a = 0; a < 2; ++a)
#pragma unroll
            for (int e = 0; e < 4; ++e) Sacc[a][e] = (f32x4){0.f, 0.f, 0.f, 0.f};
        __syncthreads();
        for (int i = tid; i < 2 * 64 * 256 / 8; i += 512) ((LAS v4u*)ST0)[i] = (v4u){0u, 0u, 0u, 0u};
        v4u rq[4], rk[4], rp, rv; float re = 0.f;
#define GLS_PREFETCH(cc) do { const int item2 = (b * 64 + (cc)) * 4 + h; const unsigned char* im = img + (size_t)item2 * IMGG_BYTES; \
            _Pragma("unroll") for (int p = 0; p < 4; ++p) { rq[p] = *(const v4u*)(im + IMGG_Q + (tid + 512 * p) * 16); rk[p] = *(const v4u*)(im + IMGG_KT + (tid + 512 * p) * 16); } \
            rp = *(const v4u*)(im + IMGG_P + tid * 16); rv = *(const v4u*)(P1 + ((size_t)b * SEQ + (cc) * 64 + (tid >> 3)) * NQKV + 2048 + h * 512 + sl * 64 + (tid & 7) * 8); if (tid < 256) re = ((const float*)(im + IMGG_EB))[tid]; } while (0)
        const bf16* gbase = P1 + (size_t)(b * SEQ + 16 * tt + r16) * NQKV + 4096 + h * 512 + sl * 64 + 32 * eh + 8 * g;
        v4u gt = *(const v4u*)gbase;
        GLS_PREFETCH(0);
        for (int c = 0; c < 64; ++c) {
            const int row0 = b * SEQ + c * 64;
            LAS bf16* STc = ST0 + (c & 1) * 64 * 256; LAS bf16* STn = ST0 + ((c + 1) & 1) * 64 * 256;
            __syncthreads();
#pragma unroll
            for (int p = 0; p < 4; ++p) { *(LAS v4u*)((LAS unsigned char*)QTs + (tid + 512 * p) * 16) = rq[p]; *(LAS v4u*)((LAS unsigned char*)KTT + (tid + 512 * p) * 16) = rk[p]; }
            *(LAS v4u*)((LAS unsigned char*)Ps + tid * 16) = rp; *(LAS v4u*)((LAS unsigned char*)VTs + off_v64(tid >> 3, tid & 7)) = rv;
            if (tid < 256) eb[tid] = re;
            __syncthreads();
            const v4u gtn = *(const v4u*)(gbase + (size_t)((c + 1 < 64 ? c + 1 : c) * 64) * NQKV);
            if (c + 1 < 64) GLS_PREFETCH(c + 1);
            float sq = 0.f;
            const LAS unsigned char* vb = (const LAS unsigned char*)VTs;
            const bf16x8 pa0 = ldf<64>(Ps, 16 * tt + r16, g), pa1 = ldf<64>(Ps, 16 * tt + r16, 4 + g);
            float sg[2][4];
#pragma unroll
            for (int q2 = 0; q2 < 2; ++q2) { const unsigned wx = q2 ? gt.z : gt.x, wy = q2 ? gt.w : gt.y; const float g0 = bflo(wx), g1 = bfhi(wx), g2 = bflo(wy), g3 = bfhi(wy);
                sg[q2][0] = g0 * __builtin_amdgcn_rcpf(1.0f + __expf(-g0)); sg[q2][1] = g1 * __builtin_amdgcn_rcpf(1.0f + __expf(-g1));
                sg[q2][2] = g2 * __builtin_amdgcn_rcpf(1.0f + __expf(-g2)); sg[q2][3] = g3 * __builtin_amdgcn_rcpf(1.0f + __expf(-g3)); }
#pragma unroll
            for (int q2 = 0; q2 < 2; ++q2)
#pragma unroll
                for (int i = 0; i < 4; ++i) asm volatile("" : "+v"(sg[q2][i]));
            unsigned wv[4];
#pragma unroll
            for (int q2 = 0; q2 < 2; ++q2) { f32x4 acc = (f32x4){0.f, 0.f, 0.f, 0.f};
                acc = mfma16(vfrag64p(vb, eh, q2, 0, lane), pa0, acc); acc = mfma16(vfrag64p(vb, eh, q2, 1, lane), pa1, acc);
                mma_rows<256, 256, 8>(acc, STc, 32 * eh + 8 * (r16 >> 2) + 4 * q2 + (r16 & 3), QTs, 16 * tt, lane);
                sq += (acc[0] * acc[0] + acc[1] * acc[1]) + (acc[2] * acc[2] + acc[3] * acc[3]);
                const float o0 = acc[0] * sg[q2][0], o1 = acc[1] * sg[q2][1], o2 = acc[2] * sg[q2][2], o3 = acc[3] * sg[q2][3];
                wv[2 * q2] = pk2_sw(o0, o1); wv[2 * q2 + 1] = pk2_sw(o2, o3); }
            { v4u w; w.x = wv[0]; w.y = wv[1]; w.z = wv[2]; w.w = wv[3]; *(v4u*)(hm + (size_t)(row0 + 16 * tt + r16) * DM + h * 512 + sl * 64 + 32 * eh + 8 * g) = w; }
            sq += __shfl_xor(sq, 16); sq += __shfl_xor(sq, 32);
            if (g == 0) atomicAdd((unsigned long long*)(hss + (size_t)(row0 + 16 * tt + r16) * 4 + h), (unsigned long long)__float2ll_rn(sq * pg8::HSS_FIX));
#pragma unroll
            for (int a = 0; a < 2; ++a) { const int dt = 2 * wave + a;
                const f32x4 ev = *(const LAS f32x4*)(eb + 16 * dt + 4 * g);
                const bf16x8 ka0 = ldf<64>(KTT, 16 * dt + r16, g), ka1 = ldf<64>(KTT, 16 * dt + r16, 4 + g);
#pragma unroll
                for (int et = 0; et < 4; ++et) { Sacc[a][et] = mfma16(ka0, vfrag64(vb, et, 0, lane), Sacc[a][et]); Sacc[a][et] = mfma16(ka1, vfrag64(vb, et, 1, lane), Sacc[a][et]); Sacc[a][et] = Sacc[a][et] * ev;
                    v2u w; w.x = pk2(Sacc[a][et][0], Sacc[a][et][1]); w.y = pk2(Sacc[a][et][2], Sacc[a][et][3]);
                    *(LAS v2u*)(STn + eoff<256>(16 * et + r16, 16 * dt + 4 * g)) = w; } }
            gt = gtn;
        }
#undef GLS_PREFETCH
    }
}


DI void mixer_gates(const bf16* hb, const bf16* wg, const long long* ss, float* G, int lane, int wave, int bx) {
    const int g = lane >> 4, r16 = lane & 15;
    for (int t = bx * NWAVES + wave; t < MTOK / 16; t += gridDim.x * NWAVES) {
        const bf16* ap = hb + (size_t)(16 * t + r16) * DM + 8 * g; const bf16* bp = wg + (size_t)r16 * DM + 8 * g;
        f32x4 acc = (f32x4){0.f, 0.f, 0.f, 0.f};
#pragma unroll 8
        for (int kk = 0; kk < DM / 32; ++kk) { const bf16x8 a = *(const bf16x8*)(ap + 32 * kk), b = *(const bf16x8*)(bp + 32 * kk); acc = mfma16(a, b, acc); }
#pragma unroll
        for (int i = 0; i < 4; ++i) { const int row = 16 * t + 4 * g + i; G[(size_t)row * 16 + r16] = acc[i] * pg8::rstd_of(ss, row); }
    }
}

template <int HS, int ACT> DI void headnorm_gate(const bf16* hraw, const bf16* P1, const float* gnorm, bf16* hm, int lane, int wave, int bx) {
    constexpr int NH = DM / HS, EPL = HS / 64;
    const int gw = bx * NWAVES + wave, NGW = gridDim.x * NWAVES;
    for (int row = gw; row < MTOK; row += NGW) {
#pragma unroll
        for (int hh = 0; hh < NH; ++hh) { const int col = hh * HS + lane * EPL;
            unsigned xw[EPL / 2], gwd[EPL / 2];
            if constexpr (EPL == 4) { const v2u a = *(const v2u*)(hraw + (size_t)row * DM + col), b2 = *(const v2u*)(P1 + (size_t)row * NQKV + 4096 + col); xw[0] = a.x; xw[1] = a.y; gwd[0] = b2.x; gwd[1] = b2.y; }
            else { const v4u a = *(const v4u*)(hraw + (size_t)row * DM + col), b2 = *(const v4u*)(P1 + (size_t)row * NQKV + 4096 + col); xw[0] = a.x; xw[1] = a.y; xw[2] = a.z; xw[3] = a.w; gwd[0] = b2.x; gwd[1] = b2.y; gwd[2] = b2.z; gwd[3] = b2.w; }
            float s = 0.f;
#pragma unroll
            for (int j = 0; j < EPL / 2; ++j) { const float x0 = bflo(xw[j]), x1 = bfhi(xw[j]); s += x0 * x0 + x1 * x1; }
            s = wave_sum(s); const float rs = rsqrtf(s * (1.0f / HS) + 1e-6f);
            unsigned outw[EPL / 2];
#pragma unroll
            for (int j = 0; j < EPL / 2; ++j) { const float g0 = bflo(gwd[j]), g1 = bfhi(gwd[j]);
                const float a0 = ACT == 0 ? __builtin_amdgcn_rcpf(1.0f + __expf(-g0)) : g0 * __builtin_amdgcn_rcpf(1.0f + __expf(-g0)), a1 = ACT == 0 ? __builtin_amdgcn_rcpf(1.0f + __expf(-g1)) : g1 * __builtin_amdgcn_rcpf(1.0f + __expf(-g1));
                outw[j] = pk2(bflo(xw[j]) * rs * gnorm[col + 2 * j] * a0, bfhi(xw[j]) * rs * gnorm[col + 2 * j + 1] * a1); }
            if constexpr (EPL == 4) { v2u w; w.x = outw[0]; w.y = outw[1]; *(v2u*)(hm + (size_t)row * DM + col) = w; }
            else { v4u w; w.x = outw[0]; w.y = outw[1]; w.z = outw[2]; w.w = outw[3]; *(v4u*)(hm + (size_t)row * DM + col) = w; }
        }
    }
}

DI void fox_cf(LAS unsigned char* lds, const float* G, const float* b_f, float* cf, const bf16* P1, unsigned* kmax2, int tid, int lane, int wave, int bx) {
    LAS float* wt = (LAS float*)lds;
    for (int item = bx; item < 256; item += gridDim.x) { const int seq = item >> 1, hf = item & 1, b = seq >> 4, h = seq & 15; const float bias = b_f[h];
        const float* gp = G + ((size_t)b * SEQ + hf * 2048 + tid * 4) * 16 + h;
        float ls[4]; float s = 0.f, s0 = 0.f;
#pragma unroll
        for (int p = 0; p < 4; ++p) { ls[p] = logsig(gp[p * 16] + bias); s += ls[p]; }
        if (hf) { const float* g0 = gp - (size_t)2048 * 16;
#pragma unroll
            for (int p = 0; p < 4; ++p) s0 += logsig(g0[p * 16] + bias); }
        const float incl = wave_incl_sum(s, lane), tot0 = wave_sum(s0);
        __syncthreads();
        if (lane == 63) wt[wave] = incl; if (lane == 0) wt[8 + wave] = tot0;
        __syncthreads();
        float base = 0.f;
#pragma unroll
        for (int w = 0; w < 8; ++w) { base += (w < wave) ? wt[w] : 0.f; base += wt[8 + w]; }
        float run = base + incl - s;
        float* o = cf + (size_t)seq * SEQ + hf * 2048 + tid * 4; f32x4 ov;
        run += ls[0]; ov.x = run; run += ls[1]; ov.y = run; run += ls[2]; ov.z = run; run += ls[3]; ov.w = run;
        *(f32x4*)o = ov;
        float km = 0.f; const bf16* kp = P1 + ((size_t)b * SEQ + hf * 2048) * NQKV + 2048 + h * 128;
#pragma unroll 8
        for (int i = 0; i < 64; ++i) { const int idx = tid + 512 * i, r = idx >> 4, c = idx & 15; const v4u kv = *(const v4u*)(kp + (size_t)r * NQKV + c * 8); float s2 = 0.f;
#pragma unroll
            for (int q = 0; q < 4; ++q) { const float x0 = bflo(kv[q]), x1 = bfhi(kv[q]); s2 += x0 * x0 + x1 * x1; }
            s2 += __shfl_xor(s2, 1); s2 += __shfl_xor(s2, 2); s2 += __shfl_xor(s2, 4); s2 += __shfl_xor(s2, 8); km = fmaxf(km, s2); }
        km = fmaxf(km, __shfl_xor(km, 16)); km = fmaxf(km, __shfl_xor(km, 32));
        if (lane == 0) atomicMax(kmax2 + seq, __float_as_uint(km));
    }
}

DI bf16x8 pack8_mfma(const f32x4& lo, const f32x4& hi) { v4u p;
    asm volatile("v_cvt_pk_bf16_f32 %0, %4, %5\n\tv_cvt_pk_bf16_f32 %1, %6, %7\n\tv_cvt_pk_bf16_f32 %2, %8, %9\n\tv_cvt_pk_bf16_f32 %3, %10, %11\n\ts_nop 1"
                 : "=&v"(p[0]), "=&v"(p[1]), "=&v"(p[2]), "=&v"(p[3]) : "v"(lo[0]), "v"(lo[1]), "v"(lo[2]), "v"(lo[3]), "v"(hi[0]), "v"(hi[1]), "v"(hi[2]), "v"(hi[3]));
    return __builtin_bit_cast(bf16x8, p); }
DI unsigned off_v(unsigned row, unsigned ch) { return 256u * row + 16u * (ch ^ (((row & 3u) << 2) | (((row >> 2) & 1u) << 1))); }

DI void fox_attn2(LAS unsigned char* lds, const bf16* P1, const float* cf, const unsigned* kmax2, bf16* hm, int tid, int lane, int wave, int bx) {
    constexpr int BUFB = 16384 + 16384 + 256;
    LAS float* xch = (LAS float*)(lds + 2 * BUFB);
    const float LOG2E = 1.4426950408889634f, QS = 0.08838834764831845f * 1.4426950408889634f, THR = 8.0f;
    const int g = lane >> 4, r16 = lane & 15;
    const int G_ = gridDim.x;
    const int nit = (2048 + G_ - 1) / G_;
    for (int it = 0; it < nit; ++it) {
        const int u = (it & 1) ? it * G_ + (G_ - 1 - bx) : it * G_ + bx;
        if (u >= 2048) continue;
        const int qb = 15 - (u >> 7), bh = u & 127, b = bh >> 4, h = bh & 15;
        const size_t rowb = (size_t)b * SEQ; const int q0 = qb * 256 + 32 * wave;
        bf16x8 qf[2][4]; float c0[2];
#pragma unroll
        for (int tt = 0; tt < 2; ++tt) { const int t = q0 + 16 * tt + r16; c0[tt] = cf[(size_t)bh * SEQ + t] * LOG2E;
#pragma unroll
            for (int kk = 0; kk < 4; ++kk) { const v4u raw = *(const v4u*)(P1 + (rowb + t) * NQKV + h * 128 + 32 * kk + 8 * g); v4u sc;
#pragma unroll
                for (int j = 0; j < 4; ++j) sc[j] = pk2(bflo(raw[j]) * QS, bfhi(raw[j]) * QS);
                qf[tt][kk] = __builtin_bit_cast(bf16x8, sc); } }
        f32x4 oacc[8][2];
#pragma unroll
        for (int et = 0; et < 8; ++et) { oacc[et][0] = (f32x4){0.f, 0.f, 0.f, 0.f}; oacc[et][1] = (f32x4){0.f, 0.f, 0.f, 0.f}; }
        float lrun[2] = {0.f, 0.f};
        const int ntiles = 4 * (qb + 1);
        v4u kreg[2], vreg[2]; float cfreg = 0.f;
        const bf16* kbase = P1 + rowb * NQKV + 2048 + h * 128;
#define FOX_LOAD(j) do { _Pragma("unroll") for (int p = 0; p < 2; ++p) { const int idx = tid + 512 * p, r = idx >> 4, c8 = idx & 15; \
            kreg[p] = *(const v4u*)(kbase + (size_t)(64 * (j) + r) * NQKV + c8 * 8); vreg[p] = *(const v4u*)(kbase + (size_t)(64 * (j) + r) * NQKV + 2048 + c8 * 8); } \
            if (tid < 64) cfreg = -cf[(size_t)bh * SEQ + 64 * (j) + tid] * LOG2E; } while (0)
#define FOX_STORE(bufi) do { LAS unsigned char* bb = lds + (bufi) * BUFB; _Pragma("unroll") for (int p = 0; p < 2; ++p) { const int idx = tid + 512 * p, r = idx >> 4, c8 = idx & 15; \
            *(LAS v4u*)((LAS bf16*)bb + eoff<128>(r, c8 * 8)) = kreg[p]; *(LAS v4u*)(bb + 16384 + off_v(r, c8)) = vreg[p]; } \
            if (tid < 64) ((LAS float*)(bb + 32768))[tid] = cfreg; } while (0)
        float qm = 0.f;
#pragma unroll
        for (int tt = 0; tt < 2; ++tt) { float s2 = 0.f;
#pragma unroll
            for (int kk = 0; kk < 4; ++kk)
#pragma unroll
                for (int jq = 0; jq < 8; ++jq) { const float v = bf2f((unsigned short)qf[tt][kk][jq]); s2 += v * v; }
            s2 += __shfl_xor(s2, 16); s2 += __shfl_xor(s2, 32); qm = fmaxf(qm, s2); }
        qm = fmaxf(qm, __shfl_xor(qm, 1)); qm = fmaxf(qm, __shfl_xor(qm, 2)); qm = fmaxf(qm, __shfl_xor(qm, 4)); qm = fmaxf(qm, __shfl_xor(qm, 8));
        __syncthreads();
        if (lane == 0) xch[16 + wave] = qm;
        FOX_LOAD(ntiles - 1); FOX_STORE(0);
        if (ntiles > 1) FOX_LOAD(ntiles - 2);
        __syncthreads();
        float q2 = xch[16];
#pragma unroll
        for (int w8 = 1; w8 < 8; ++w8) q2 = fmaxf(q2, xch[16 + w8]);
        const float QKB = sqrtf(q2 * __uint_as_float(kmax2[bh])) * 1.01f + 1e-3f;
        const float cfu0 = cf[(size_t)bh * SEQ + qb * 256] * LOG2E;
        float mref[2] = {0.f, 0.f}, rmaxlog[2] = {-__builtin_inff(), -__builtin_inff()};
        for (int k = 0; k < ntiles; ++k) { const int j = ntiles - 1 - k;
            if (k + 1 < ntiles) FOX_STORE((k + 1) & 1);
            if (k + 2 < ntiles) FOX_LOAD(ntiles - 3 - k);
            if (64 * j <= q0 + 31) {
                const LAS bf16* Ks = (const LAS bf16*)(lds + (k & 1) * BUFB); const LAS bf16* VTs = Ks + 64 * 128; const LAS float* cfs = (const LAS float*)(VTs + 128 * 64);
                f32x4 sacc[2][4];
#pragma unroll
                for (int st = 0; st < 4; ++st) { const f32x4 cv = *(const LAS f32x4*)(cfs + 16 * st + 4 * g);
#pragma unroll
                    for (int tt = 0; tt < 2; ++tt) sacc[tt][st] = cv + c0[tt]; }
#pragma unroll
                for (int st = 0; st < 4; ++st)
#pragma unroll
                    for (int kk = 0; kk < 4; ++kk) { const bf16x8 kf = ldf<128>(Ks, 16 * st + r16, 4 * kk + g);
                        sacc[0][st] = mfma16(kf, qf[0][kk], sacc[0][st]); sacc[1][st] = mfma16(kf, qf[1][kk], sacc[1][st]); if (kk == 3) asm volatile("" ::: "memory"); }
                if (64 * j + 63 > q0) {
#pragma unroll
                    for (int tt = 0; tt < 2; ++tt) { const int t = q0 + 16 * tt + r16;
#pragma unroll
                        for (int st = 0; st < 4; ++st)
#pragma unroll
                            for (int i = 0; i < 4; ++i) { const int s = 64 * j + 16 * st + 4 * g + i; if (s > t) sacc[tt][st][i] = -__builtin_inff(); } }
                }
                float mx[2];
#pragma unroll
                for (int tt = 0; tt < 2; ++tt) { float m = -__builtin_inff();
#pragma unroll
                    for (int st = 0; st < 4; ++st) m = fmaxf(m, fmaxf(fmaxf(sacc[tt][st][0], sacc[tt][st][1]), fmaxf(sacc[tt][st][2], sacc[tt][st][3])));
                    m = fmaxf(m, __shfl_xor(m, 16)); m = fmaxf(m, __shfl_xor(m, 32)); mx[tt] = m; }
                rmaxlog[0] = fmaxf(rmaxlog[0], mx[0] + mref[0]); rmaxlog[1] = fmaxf(rmaxlog[1], mx[1] + mref[1]);
                if (__any(mx[0] > THR || mx[1] > THR)) {
#pragma unroll
                    for (int tt = 0; tt < 2; ++tt) { const float sh = fmaxf(mx[tt], 0.f), f = __builtin_amdgcn_exp2f(-sh);
                        c0[tt] -= sh; mref[tt] += sh; lrun[tt] *= f;
#pragma unroll
                        for (int st = 0; st < 4; ++st) sacc[tt][st] = sacc[tt][st] - sh;
#pragma unroll
                        for (int et = 0; et < 8; ++et) oacc[et][tt] = oacc[et][tt] * f; }
                }
#pragma unroll
                for (int tt = 0; tt < 2; ++tt) { float ls = 0.f;
#pragma unroll
                    for (int st = 0; st < 4; ++st)
#pragma unroll
                        for (int i = 0; i < 4; ++i) { const float p = __builtin_amdgcn_exp2f(sacc[tt][st][i]); sacc[tt][st][i] = p; ls += p; }
                    lrun[tt] += ls; }
#pragma unroll
                for (int ks = 0; ks < 2; ++ks) { bf16x8 pb[2];
#pragma unroll
                    for (int tt = 0; tt < 2; ++tt) pb[tt] = pack8_mfma(sacc[tt][2 * ks], sacc[tt][2 * ks + 1]);
#pragma unroll
                    for (int et = 0; et < 8; ++et) {
                        const LAS unsigned char* vb = (const LAS unsigned char*)VTs;
                        const v4i16_t lo = tr_read(vb + off_v(32 * ks + 4 * g + (r16 >> 2), 2 * et + ((lane & 3) >> 1)) + 8 * (lane & 1));
                        const v4i16_t hi = tr_read(vb + off_v(32 * ks + 16 + 4 * g + (r16 >> 2), 2 * et + ((lane & 3) >> 1)) + 8 * (lane & 1));
                        bf16x8 va; va[0] = lo[0]; va[1] = lo[1]; va[2] = lo[2]; va[3] = lo[3]; va[4] = hi[0]; va[5] = hi[1]; va[6] = hi[2]; va[7] = hi[3];
                        oacc[et][0] = mfma16(va, pb[0], oacc[et][0]); oacc[et][1] = mfma16(va, pb[1], oacc[et][1]); if (et & 1) asm volatile("" ::: "memory"); } }
            }
            { float wm = fminf(rmaxlog[0], rmaxlog[1]);
              wm = fminf(wm, __shfl_xor(wm, 1)); wm = fminf(wm, __shfl_xor(wm, 2)); wm = fminf(wm, __shfl_xor(wm, 4)); wm = fminf(wm, __shfl_xor(wm, 8));
              if (lane == 0) xch[(k & 1) * 8 + wave] = wm; }
            __syncthreads();
            if (k + 1 < ntiles) { float mmin = xch[(k & 1) * 8];
#pragma unroll
                for (int w8 = 1; w8 < 8; ++w8) mmin = fminf(mmin, xch[(k & 1) * 8 + w8]);
                const float cfe = ((const LAS float*)(lds + ((k + 1) & 1) * BUFB + 32768))[63];
                if (QKB + cfu0 + cfe < mmin - 60.0f) break; }
        }
#undef FOX_LOAD
#undef FOX_STORE
#pragma unroll
        for (int tt = 0; tt < 2; ++tt) { float l = lrun[tt]; l += __shfl_xor(l, 16); l += __shfl_xor(l, 32); const float inv = 1.0f / l;
            bf16* orow = hm + (rowb + q0 + 16 * tt + r16) * DM + h * 128 + 4 * g;
#pragma unroll
            for (int et = 0; et < 8; ++et) { v2u w; w.x = pk2(oacc[et][tt][0] * inv, oacc[et][tt][1] * inv); w.y = pk2(oacc[et][tt][2] * inv, oacc[et][tt][3] * inv); *(v2u*)(orow + 16 * et) = w; } }
    }
}


DI void final_norm(float* out, const bf16* hb, const long long* ss, const float* gfin, int lane, int wave, int bx) {
    const int gw = bx * NWAVES + wave, NGW = gridDim.x * NWAVES;
    for (int m = gw; m < MTOK; m += NGW) { const float rs = pg8::rstd_of(ss, m);
        const v4u* hr = (const v4u*)(hb + (size_t)m * DM); f32x4* xr = (f32x4*)(out + (size_t)m * DM); const f32x4* gr = (const f32x4*)gfin;
#pragma unroll
        for (int j = 0; j < 4; ++j) { const v4u w = hr[lane + 64 * j]; const int c4 = 2 * (lane + 64 * j);
            const f32x4 g0 = gr[c4], g1 = gr[c4 + 1];
            xr[c4] = (f32x4){bflo(w.x) * rs * g0.x, bfhi(w.x) * rs * g0.y, bflo(w.y) * rs * g0.z, bfhi(w.y) * rs * g0.w};
            xr[c4 + 1] = (f32x4){bflo(w.z) * rs * g1.x, bfhi(w.z) * rs * g1.y, bflo(w.w) * rs * g1.z, bfhi(w.w) * rs * g1.w}; } }
}

#define PH(p) if (lo <= (p) && (p) < hi && (ran ? (xcd_barrier(bar), true) : (ran = true)))
#define TID() int tid = threadIdx.x; asm volatile("" : "+v"(tid)); const int lane = tid & 63, wave = __builtin_amdgcn_readfirstlane(tid >> 6); int bx = blockIdx.x; asm volatile("" : "+s"(bx)); (void)lane; (void)wave; (void)bx
#define WSP(T, off) ((T*)(ka->ws + (off)))
template <int j> DI void subblock(LAS unsigned char* lds, const XcdBarrier& bar, const int lo, const int hi, bool& ran) {
    {
        constexpr int layer = j / 3, typ = j - 3 * layer, base = 1 + 5 * j;
        if constexpr (typ != 1) {
            PH(base) { TID(); KArgs ka = kargs(); const int mi = layer * 2 + (typ >> 1);
                pg8::Gemm gm{WSP(bf16, WS_HB), WSP(bf16, WS_WUP) + (size_t)mi * NUP * DM, MTOK, NUP, DM}; pg8::StaticOrder S; S.init(MTOK, NUP, gridDim.x, bx);
                pg8::EpiSwiGLU E{WSP(bf16, WS_ACT), WSP(long long, WS_SS) + (size_t)j * MTOK, DFF};
                pg8::gemm_phase<pg8::EpiSwiGLU, pg8::StaticOrder, PG8_ALIGN, PG8_SP2>(lds, gm, S, E); }
        } else {
            constexpr int kind = layer % 3, ji = layer / 3, HSLOT = (layer * 2 + 1) / 3;
            (void)ji; (void)HSLOT;
            PH(base) { TID(); KArgs ka = kargs();
                mixer_gates(WSP(bf16, WS_HB), WSP(bf16, WS_WIN) + ((size_t)layer * NINP + NQKV) * DM, WSP(long long, WS_SS) + (size_t)j * MTOK, WSP(float, WS_G), lane, wave, bx);
                pg8::Gemm gm{WSP(bf16, WS_HB), WSP(bf16, WS_WIN) + (size_t)layer * NINP * DM, MTOK, NQKV, DM}; pg8::StaticOrder S; S.init(MTOK, NQKV, gridDim.x, bx);
                pg8::EpiMixIn E{WSP(bf16, WS_P1), WSP(long long, WS_SS) + (size_t)j * MTOK};
                pg8::gemm_phase<pg8::EpiMixIn, pg8::StaticOrder, PG8_ALIGN, PG8_SP2>(lds, gm, S, E); }
            PH(base + 1) { TID(); KArgs ka = kargs();
                if constexpr (kind == 0) for (int rep = 0; rep < REP_MLSTM; ++rep) mlstm_pre(lds, WSP(bf16, WS_P1), WSP(float, WS_G), ka->in[6] + ji * 16, WSP(unsigned char, WS_ACT), tid, lane, wave, bx);
                else if constexpr (kind == 1) { fox_cf(lds, WSP(float, WS_G), ka->in[10] + ji * 16, WSP(float, WS_CF), WSP(bf16, WS_P1), WSP(unsigned, WS_CTL) + CW_KMAX, tid, lane, wave, bx); }
                else for (int rep = 0; rep < REP_GLA; ++rep) gla_pre(lds, WSP(bf16, WS_P1), WSP(float, WS_G), ka->in[13] + (size_t)ji * 16 * 1024, ka->in[14] + ji * 1024, WSP(unsigned char, WS_ACT), tid, lane, wave, bx);
            }
            PH(base + 2) { TID(); KArgs ka = kargs();
                if constexpr (kind == 0) for (int rep = 0; rep < REP_MLSTM; ++rep) mlstm_scan2(lds, WSP(bf16, WS_P1), WSP(unsigned char, WS_ACT), WSP(bf16, WS_HM), WSP(long long, WS_HSS) + (size_t)HSLOT * MTOK * 8, tid, lane, wave, bx);
                else if constexpr (kind == 1) for (int rep = 0; rep < REP_FOX; ++rep) fox_attn2(lds, WSP(bf16, WS_P1), WSP(float, WS_CF), WSP(unsigned, WS_CTL) + CW_KMAX, WSP(bf16, WS_HM), tid, lane, wave, bx);
                else for (int rep = 0; rep < REP_GLA; ++rep) gla_scan2(lds, WSP(bf16, WS_P1), WSP(unsigned char, WS_ACT), WSP(bf16, WS_HM), WSP(long long, WS_HSS) + (size_t)HSLOT * MTOK * 8, tid, lane, wave, bx);
            }
        }
        PH(base + 4) { TID(); KArgs ka = kargs();
            pg8::Gemm gm; float scale;
            if constexpr (typ != 1) { const int mi = layer * 2 + (typ >> 1); gm = pg8::Gemm{WSP(bf16, WS_ACT), WSP(bf16, WS_WDN) + (size_t)mi * DM * DFF, MTOK, DM, DFF}; scale = 0.5f; }
            else { gm = pg8::Gemm{WSP(bf16, WS_HM), WSP(bf16, WS_WOUT) + (size_t)layer * DM * DM, MTOK, DM, DM}; scale = 1.0f; }
            pg8::StaticOrder S; S.init(MTOK, DM, gridDim.x, bx);
            constexpr int NHS = (typ != 1 || layer % 3 == 1) ? 0 : (layer % 3 == 0 ? 8 : 4);
            pg8::EpiResidT<NHS> E{WSP(bf16, WS_HB), WSP(long long, WS_SS) + (size_t)(j + 1) * MTOK, scale, WSP(long long, WS_HSS) + (size_t)((layer * 2 + 1) / 3) * MTOK * 8};
            pg8::gemm_phase<pg8::EpiResidT<NHS>, pg8::StaticOrder, PG8_ALIGN, PG8_SP2>(lds, gm, S, E);
        }
    }
}

__global__ void __launch_bounds__(NWAVES * 64, 2) trunk_fwd(Args args) {
    extern __shared__ __attribute__((aligned(16))) unsigned char lds_raw[];
    LAS unsigned char* lds = (LAS unsigned char*)lds_raw;
    volatile LAS unsigned* MISC = (volatile LAS unsigned*)(lds + MISC_OFF);
    for (int u = threadIdx.x; u < (LDS_BYTES - MISC_OFF) / 4; u += NWAVES * 64) ((LAS unsigned*)(lds + MISC_OFF))[u] = 0u;
    __syncthreads();
    XcdBarrier bar = xcd_barrier_post((unsigned*)(args.ws + WS_CTL) + CW_BAR, MISC + 8);
    const int lo = args.ph_lo, hi = args.ph_hi; bool ran = false;

    PH(0) { TID(); for (int rep = 0; rep < REP_PRO; ++rep) { prologue(lds, lane, wave, bx); __syncthreads(); } }

    subblock<0>(lds, bar, lo, hi, ran); subblock<1>(lds, bar, lo, hi, ran); subblock<2>(lds, bar, lo, hi, ran); subblock<3>(lds, bar, lo, hi, ran);
    subblock<4>(lds, bar, lo, hi, ran); subblock<5>(lds, bar, lo, hi, ran); subblock<6>(lds, bar, lo, hi, ran); subblock<7>(lds, bar, lo, hi, ran);
    subblock<8>(lds, bar, lo, hi, ran); subblock<9>(lds, bar, lo, hi, ran); subblock<10>(lds, bar, lo, hi, ran); subblock<11>(lds, bar, lo, hi, ran);
    PH(NPHASE - 1) { TID(); KArgs ka = kargs(); final_norm(ka->out, WSP(bf16, WS_HB), WSP(long long, WS_SS) + (size_t)NSUB * MTOK, ka->in[17], lane, wave, bx); }
#undef WSP
#undef PH
}

static bool phase_exists(int p) {
    if (p == 0 || p == NPHASE - 1) return true;
    const int j = (p - 1) / 5, k = (p - 1) % 5, typ = j % 3;
    if (k == 0 || k == 4) return true;
    if (typ != 1) return false;
    if (k == 3) return false;
    return true;
}
extern "C" void kernel_launch(void* const* d_in, const int* in_sizes, int n_in, void* d_out, int out_size, void* d_ws, size_t ws_size, hipStream_t stream) {
    static int grid = 0;
    if (grid == 0) {
        if (n_in != 18 || in_sizes[0] != MTOK * DM || out_size != MTOK * DM || ws_size < WS_END) { fprintf(stderr, "kernel_launch: unexpected shapes (n_in %d, in0 %d, out %d, ws %zu < %zu)\n", n_in, n_in > 0 ? in_sizes[0] : -1, out_size, ws_size, (size_t)WS_END); grid = -1; return; }
        int dev = 0, cus = 0, per_cu = 0;
        if (hipGetDevice(&dev) != hipSuccess || hipDeviceGetAttribute(&cus, hipDeviceAttributeMultiprocessorCount, dev) != hipSuccess) { grid = -1; return; }
        if (hipFuncSetAttribute((const void*)trunk_fwd, hipFuncAttributeMaxDynamicSharedMemorySize, LDS_BYTES) != hipSuccess) { fprintf(stderr, "kernel_launch: hipFuncSetAttribute failed\n"); grid = -1; return; }
        if (hipOccupancyMaxActiveBlocksPerMultiprocessor(&per_cu, (const void*)trunk_fwd, NWAVES * 64, LDS_BYTES) != hipSuccess || per_cu < 1) fprintf(stderr, "kernel_launch: occupancy query says %d\n", per_cu);
        (void)hipGetLastError();
        grid = cus;
    }
    if (grid < 0) return;
    if (hipMemsetAsync((char*)d_ws + WS_CTL, 0, CTL_ZERO_BYTES, stream) != hipSuccess) return;
    Args a{};
    for (int i = 0; i < 18; ++i) a.in[i] = (const float*)d_in[i];
    a.out = (float*)d_out; a.ws = (unsigned char*)d_ws;
#if MK_PER_PHASE
    for (int p = 0; p < NPHASE; ++p) { if (!phase_exists(p)) continue; a.ph_lo = p; a.ph_hi = p + 1; hipLaunchKernelGGL(trunk_fwd, dim3(grid), dim3(NWAVES * 64), LDS_BYTES, stream, a); }
#else
    a.ph_lo = 0; a.ph_hi = NPHASE; hipLaunchKernelGGL(trunk_fwd, dim3(grid), dim3(NWAVES * 64), LDS_BYTES, stream, a);
#endif
    (void)phase_exists;
}
```

```cpp
#include <hip/hip_runtime.h>
#include <cstdio>
#include <cstdint>
namespace pg8 {
#define PG8_LAS __attribute__((address_space(3)))
typedef unsigned short bf16_t;
typedef short bf16x8 __attribute__((ext_vector_type(8)));
typedef float f32x4 __attribute__((ext_vector_type(4)));
typedef unsigned u32x4 __attribute__((ext_vector_type(4)));
constexpr int BM = 256, BK = 64, HALF = 128, HTB = HALF * BK * 2  , STAGE_BYTES = 8 * HTB, NXCD = 8, WGM = 8;

__host__ __device__ __forceinline__ int lds_byte(int r, int c) { const int st = (r >> 4) * 2 + (c >> 5), rr = r & 15, cc = c & 31, ob = rr * 64 + cc * 2; return st * 1024 + (ob ^ (((ob >> 9) & 1) << 5)); }
__host__ __device__ __forceinline__ void stage_rc(int b, int& R, int& C) { const int st = b / 1024, sb = b % 1024, swz = sb ^ (((sb >> 9) & 1) << 5); R = (st >> 1) * 16 + swz / 64; C = (st & 1) * 32 + (swz % 64) / 2; }
__host__ __device__ __forceinline__ int perm32(int rho) { const int n = rho >> 4, i = rho & 15; return 8 * (i >> 2) + 4 * n + (i & 3); }

struct Unit { int pm, pn; };
struct Gemm { const bf16_t* A; const bf16_t* Bt; int M, N, K; };

struct StaticOrder {
    int nM, nN, nwg, G, c;
    __host__ __device__ void init(int M, int N, int G_, int c_) { nM = M / BM; nN = N / BM; nwg = nM * nN; G = G_; c = c_; }
    __host__ __device__ bool next(int i, Unit& u) const {
        const long L = (long)i * G + c; if (L >= nwg) return false;
        int wgid = (int)L; { const int q = nwg / NXCD, r = nwg % NXCD, xcd = wgid % NXCD, off = wgid / NXCD; wgid = (xcd < r ? xcd * (q + 1) : r * (q + 1) + (xcd - r) * q) + off; }
        const int nig = WGM * nN, gid = wgid / nig, fm = gid * WGM, gsz = (nM - fm) < WGM ? (nM - fm) : WGM;
        u.pm = fm + ((wgid % nig) % gsz); u.pn = (wgid % nig) / gsz; return true;
    }
    __device__ __forceinline__ void a_ready(const Unit&) const {}
    __device__ __forceinline__ void done(const Unit&) const {}
};

__device__ __forceinline__ unsigned cvt_pk_bf16(float lo, float hi) { unsigned r; asm volatile("v_cvt_pk_bf16_f32 %0, %1, %2" : "=v"(r) : "v"(lo), "v"(hi)); return r; }
constexpr float RMS_EPS_F = 1e-6f, SS_FIX = 1048576.0f, SS_UNFIX_D = 1.0f / (1048576.0f * 2048.0f);
typedef long long ss_t;
__device__ __forceinline__ float rstd_of(const ss_t* ss, int row) { return rsqrtf((float)ss[row] * SS_UNFIX_D + RMS_EPS_F); }
template <class Sched> __device__ __forceinline__ int rstd_table_fill(const Sched& S, const ss_t* ss, PG8_LAS unsigned char* ext, int tid) {
    PG8_LAS float* tab = (PG8_LAS float*)ext; int key0 = -1, key1 = -1, bad = 0; Unit u;
    for (int i = 0; S.next(i, u); ++i) { const int slot = (u.pm >> 3) & 1; const int key = slot ? key1 : key0;
        if (key == u.pm) continue;
        if (key >= 0) { bad = 1; continue; }
        if (slot) key1 = u.pm; else key0 = u.pm;
        if (tid < 256) tab[slot * 256 + tid] = rstd_of(ss, u.pm * BM + tid); }
    asm volatile("s_waitcnt lgkmcnt(0)" ::: "memory"); __builtin_amdgcn_s_barrier(); asm volatile("" ::: "memory");
    return bad;
}
__device__ __forceinline__ float rstd_get(const ss_t* ss, const Unit& u, int row, int pf, const PG8_LAS unsigned char* ext) {
    return pf ? rstd_of(ss, row) : ((const PG8_LAS float*)ext)[((u.pm >> 3) & 1) * 256 + (row - u.pm * BM)];
}
struct EpiSwiGLU {
    static constexpr bool PERM = true, AFTER_DRAIN = false, SEG = false;
    bf16_t* O; const ss_t* ss; int ldo;
    template <class Sched> __device__ __forceinline__ int prepare(const Sched& S, PG8_LAS unsigned char* ext, int tid) const { return rstd_table_fill(S, ss, ext, tid); }
    __device__ __forceinline__ void operator()(const f32x4 (&acc)[2][2][4][2], const Unit& u, int wr, int wc, int fr, int fq, int pf, const PG8_LAS unsigned char* ext) const {
        const int row0 = u.pm * BM + wr * 64 + fr, col0 = u.pn * HALF + wc * 32 + 8 * fq;
#pragma unroll
        for (int ai = 0; ai < 2; ++ai)
#pragma unroll
            for (int m = 0; m < 4; ++m) {
                const int row = row0 + ai * HALF + m * 16;
                const float rs = rstd_get(ss, u, row, pf, ext), c1 = -1.4426950408889634f * rs, rs2 = rs * rs;
                float o[8];
#pragma unroll
                for (int n = 0; n < 2; ++n) { const f32x4 p4 = acc[ai][0][m][n] * acc[ai][1][m][n] * rs2;
#pragma unroll
                    for (int j = 0; j < 4; ++j) o[4 * n + j] = p4[j] * __builtin_amdgcn_rcpf(1.0f + __builtin_amdgcn_exp2f(acc[ai][0][m][n][j] * c1)); }
                u32x4 w; w.x = cvt_pk_bf16(o[0], o[1]); w.y = cvt_pk_bf16(o[2], o[3]); w.z = cvt_pk_bf16(o[4], o[5]); w.w = cvt_pk_bf16(o[6], o[7]);
                *(u32x4*)(O + (size_t)row * ldo + col0) = w;
            }
    }
};
struct EpiMixIn {
    static constexpr bool PERM = true, AFTER_DRAIN = false, SEG = false;
    bf16_t* O; const ss_t* ss;
    template <class Sched> __device__ __forceinline__ int prepare(const Sched& S, PG8_LAS unsigned char* ext, int tid) const { return rstd_table_fill(S, ss, ext, tid); }
    __device__ __forceinline__ void operator()(const f32x4 (&acc)[2][2][4][2], const Unit& u, int wr, int wc, int fr, int fq, int pf, const PG8_LAS unsigned char* ext) const {
        const int row0 = u.pm * BM + wr * 64 + fr, col0 = u.pn * BM + wc * 32 + 8 * fq;
#pragma unroll
        for (int ai = 0; ai < 2; ++ai)
#pragma unroll
            for (int m = 0; m < 4; ++m) {
                const int row = row0 + ai * HALF + m * 16;
                const float rs = rstd_get(ss, u, row, pf, ext);
#pragma unroll
                for (int bj = 0; bj < 2; ++bj) { const f32x4 v0 = acc[ai][bj][m][0] * rs, v1 = acc[ai][bj][m][1] * rs;
                    u32x4 w; w.x = cvt_pk_bf16(v0[0], v0[1]); w.y = cvt_pk_bf16(v0[2], v0[3]); w.z = cvt_pk_bf16(v1[0], v1[1]); w.w = cvt_pk_bf16(v1[2], v1[3]);
                    *(u32x4*)(O + (size_t)row * 6144 + col0 + bj * HALF) = w; }
            }
    }
};
constexpr float HSS_FIX = 1073741824.0f;
template <int NH> struct EpiResidT {
    static constexpr bool PERM = true, AFTER_DRAIN = false, SEG = NH > 0; static constexpr int NHX = NH > 0 ? NH : 1, SEGT = (2048 / NHX) / BK;
    bf16_t* hb; ss_t* ssn; float scale; const ss_t* hss;
    __device__ __forceinline__ float hrstd(int row, int hh) const { return rsqrtf((float)hss[(size_t)row * NHX + hh] * (1.0f / (HSS_FIX * (2048 / NHX))) + RMS_EPS_F); }
    __device__ __forceinline__ static int slot_of(const Unit& u, int pf) { return pf ? (pf & 1) : ((u.pm >> 3) & 1); }
    __device__ __forceinline__ void fill(PG8_LAS float* tab, int slot, int pm, int tid) const {
        if (tid < 256) { const int row = pm * BM + tid; float prev = hrstd(row, 0);
#pragma unroll
            for (int hh = 1; hh < NHX; ++hh) { const float c = hrstd(row, hh); tab[(slot * NHX + hh) * 256 + tid] = prev / c; prev = c; }
            tab[(slot * NHX) * 256 + tid] = prev; }
    }
    __device__ __forceinline__ void fill_unit(const Unit& u, int ui, PG8_LAS unsigned char* ext, int tid) const { fill((PG8_LAS float*)ext, ui & 1, u.pm, tid); asm volatile("s_waitcnt lgkmcnt(0)" ::: "memory"); }
    template <class Sched> __device__ __forceinline__ int prepare(const Sched& S, PG8_LAS unsigned char* ext, int tid) const {
        if constexpr (NH == 0) return 0;
        else {
            PG8_LAS float* tab = (PG8_LAS float*)ext; int key0 = -1, key1 = -1, bad = 0; Unit u;
            for (int i = 0; S.next(i, u); ++i) { const int slot = (u.pm >> 3) & 1; const int key = slot ? key1 : key0;
                if (key == u.pm) continue;
                if (key >= 0) { bad = 1; continue; }
                if (slot) key1 = u.pm; else key0 = u.pm;
                fill(tab, slot, u.pm, tid); }
            if (bad) tab[((tid >> 8) & 1) * NH * 256 + (tid & 255)] = 1.0f;
            asm volatile("s_waitcnt lgkmcnt(0)" ::: "memory"); __builtin_amdgcn_s_barrier(); asm volatile("" ::: "memory");
            return bad;
        }
    }
    __device__ __forceinline__ void rescale(f32x4 (&acc)[2][2][4][2], const Unit& u, int hh, int wr, int fr, int pf, const PG8_LAS unsigned char* ext) const {
        int t_ = threadIdx.x; asm volatile("" : "+v"(t_));
        const PG8_LAS float* tab = (const PG8_LAS float*)ext + (slot_of(u, pf) * NHX + hh) * 256 + ((t_ >> 8) << 6) + (t_ & 15);
#pragma unroll
        for (int ai = 0; ai < 2; ++ai)
#pragma unroll
            for (int m = 0; m < 4; ++m) { const int lr = ai * HALF + m * 16; float r;
                r = tab[lr];
#pragma unroll
                for (int bj = 0; bj < 2; ++bj) { acc[ai][bj][m][0] = acc[ai][bj][m][0] * r; acc[ai][bj][m][1] = acc[ai][bj][m][1] * r; }
            }
    }
    __device__ __forceinline__ void operator()(const f32x4 (&acc)[2][2][4][2], const Unit& u, int wr, int wc, int fr, int fq, int pf, const PG8_LAS unsigned char* ext) const {
        const int row0 = u.pm * BM + wr * 64 + fr, col0 = u.pn * BM + wc * 32 + 8 * fq;
        u32x4 rb[3][2];
#define PG8_LDG(gi, buf) do { const size_t off_ = (size_t)(row0 + ((gi) >> 2) * HALF + ((gi) & 3) * 16) * 2048 + col0; \
            _Pragma("unroll") for (int q_ = 0; q_ < 2; ++q_) buf[q_] = *(const u32x4*)(hb + off_ + q_ * HALF); } while (0)
        PG8_LDG(0, rb[0]); PG8_LDG(1, rb[1]);
#pragma unroll
        for (int gi = 0; gi < 8; ++gi) {
            if (gi + 2 < 8) PG8_LDG(gi + 2, rb[(gi + 2) % 3]);
            const int ai = gi >> 2, m = gi & 3;
            const int row = row0 + ai * HALF + m * 16; const size_t off = (size_t)row * 2048 + col0; float sq = 0.f;
            float sc = scale;
            if constexpr (NH > 0) sc *= ((const PG8_LAS float*)ext)[(slot_of(u, pf) * NHX) * 256 + (row - u.pm * BM)];
#pragma unroll
            for (int bj = 0; bj < 2; ++bj) { const u32x4 hw = rb[gi % 3][bj];
                const f32x4 h0 = (f32x4){__uint_as_float(hw.x << 16), __uint_as_float(hw.x & 0xffff0000u), __uint_as_float(hw.y << 16), __uint_as_float(hw.y & 0xffff0000u)};
                const f32x4 h1 = (f32x4){__uint_as_float(hw.z << 16), __uint_as_float(hw.z & 0xffff0000u), __uint_as_float(hw.w << 16), __uint_as_float(hw.w & 0xffff0000u)};
                const f32x4 n0 = h0 + acc[ai][bj][m][0] * sc, n1 = h1 + acc[ai][bj][m][1] * sc;
                u32x4 w; w.x = cvt_pk_bf16(n0[0], n0[1]); w.y = cvt_pk_bf16(n0[2], n0[3]); w.z = cvt_pk_bf16(n1[0], n1[1]); w.w = cvt_pk_bf16(n1[2], n1[3]);
                *(u32x4*)(hb + off + bj * HALF) = w;
                const float r0 = __uint_as_float(w.x << 16), r1 = __uint_as_float(w.x & 0xffff0000u), r2 = __uint_as_float(w.y << 16), r3 = __uint_as_float(w.y & 0xffff0000u);
                const float r4 = __uint_as_float(w.z << 16), r5 = __uint_as_float(w.z & 0xffff0000u), r6 = __uint_as_float(w.w << 16), r7 = __uint_as_float(w.w & 0xffff0000u);
                sq += ((r0 * r0 + r1 * r1) + (r2 * r2 + r3 * r3)) + ((r4 * r4 + r5 * r5) + (r6 * r6 + r7 * r7)); }
            sq += __shfl_xor(sq, 16); sq += __shfl_xor(sq, 32);
            if (fq == 0) atomicAdd((unsigned long long*)(ssn + row), (unsigned long long)__float2ll_rn(sq * SS_FIX));
        }
#undef PG8_LDG
    }
};
typedef EpiResidT<0> EpiResid;

template <class Epi, class Sched, bool ALIGN_EPI = false, bool SP2 = false>
__device__ __forceinline__ void gemm_phase(PG8_LAS unsigned char* lds, const Gemm g, const Sched& S, const Epi& E) {
    int tid_ = threadIdx.x; asm volatile("" : "+v"(tid_));
    const int tid = tid_, wid = __builtin_amdgcn_readfirstlane(tid >> 6), lane = tid & 63, wr = wid >> 2, wc = wid & 3, fr = lane & 15, fq = lane >> 4;
    const int K = g.K, nt = K / BK;
    unsigned voffA[2], voffB[2];
#pragma unroll
    for (int i = 0; i < 2; ++i) { int R, C; stage_rc(tid * 16 + i * 8192, R, C); const int Rb = Epi::PERM ? ((R & ~31) + perm32(R & 31)) : R;
        voffA[i] = (unsigned)(R * K + C) * 2u; voffB[i] = (unsigned)(Rb * K + C) * 2u; }
    const size_t kstep = (size_t)(BK * 2);
    const size_t hstep = (size_t)HALF * K * 2;
    const size_t tstep = 2 * hstep;
    const unsigned ldsw = (unsigned)wid * 1024u;
    const int aoff = lds_byte(wr * 64 + fr, fq * 8), boff = lds_byte(wc * 32 + fr, fq * 8);
#define PG8_SA(b, h) (((b) * 2 + (h)) * HTB)
#define PG8_SB(b, h) ((4 + (b) * 2 + (h)) * HTB)
#define PG8_STAGE(bufoff, gbase, voff) do { _Pragma("unroll") for (int _i = 0; _i < 2; ++_i) \
        __builtin_amdgcn_global_load_lds((const unsigned*)((const char*)(gbase) + (voff)[_i]), (PG8_LAS unsigned*)(lds + (bufoff) + ldsw + _i * 8192), 16, 0, 0); } while (0)
#define PG8_LDA(dst, b, h) do { _Pragma("unroll") for (int m = 0; m < 4; ++m) _Pragma("unroll") for (int k = 0; k < 2; ++k) dst[m][k] = *(const PG8_LAS bf16x8*)(lds + PG8_SA(b, h) + aoff + m * 2048 + k * 1024); } while (0)
#define PG8_LDB(dst, b, h) do { _Pragma("unroll") for (int n = 0; n < 2; ++n) _Pragma("unroll") for (int k = 0; k < 2; ++k) dst[n][k] = *(const PG8_LAS bf16x8*)(lds + PG8_SB(b, h) + boff + n * 2048 + k * 1024); } while (0)
#define PG8_MMA(ai, bj, At, Bt) do { __builtin_amdgcn_s_setprio(1); _Pragma("unroll") for (int m = 0; m < 4; ++m) _Pragma("unroll") for (int n = 0; n < 2; ++n) _Pragma("unroll") for (int k = 0; k < 2; ++k) \
        acc[ai][bj][m][n] = __builtin_amdgcn_mfma_f32_16x16x32_bf16(Bt[n][k], At[m][k], acc[ai][bj][m][n], 0, 0, 0); __builtin_amdgcn_s_setprio(0); } while (0)
#define PG8_WAIT_V(n) asm volatile("s_waitcnt vmcnt(" #n ")" ::: "memory")
#define PG8_WAIT_L(n) asm volatile("s_waitcnt lgkmcnt(" #n ")" ::: "memory")
#define PG8_BAR __builtin_amdgcn_s_barrier()
#define PG8_SCHED __builtin_amdgcn_sched_barrier(0)
    const int pf0 = E.prepare(S, lds + STAGE_BYTES, tid); int pf = pf0;
    Unit cur, nxt; int ui = 0;
    if (!S.next(0, cur)) return;
    if constexpr (Epi::SEG) { if (pf0) { E.fill_unit(cur, 0, lds + STAGE_BYTES, tid); pf = 2; } }
    f32x4 acc[2][2][4][2];
#pragma unroll
    for (int a = 0; a < 2; ++a)
#pragma unroll
        for (int b = 0; b < 2; ++b)
#pragma unroll
            for (int m = 0; m < 4; ++m)
#pragma unroll
                for (int n = 0; n < 2; ++n) acc[a][b][m][n] = (f32x4){0.f, 0.f, 0.f, 0.f};
    bf16x8 At[4][2], B0[2][2], B1[2][2];
    const char* cA = (const char*)g.A + (size_t)cur.pm * tstep; const char* cB = (const char*)g.Bt + (size_t)cur.pn * tstep;
    S.a_ready(cur);
    if constexpr (SP2) {
        PG8_STAGE(PG8_SB(0, 0), cB, voffB); PG8_STAGE(PG8_SB(0, 1), cB + hstep, voffB); PG8_STAGE(PG8_SA(0, 0), cA, voffA); PG8_STAGE(PG8_SA(0, 1), cA + hstep, voffA);
        if (wr == 1) PG8_BAR;
        PG8_WAIT_V(2); PG8_BAR;
        PG8_STAGE(PG8_SB(1, 0), cB + kstep, voffB); PG8_STAGE(PG8_SA(1, 0), cA + kstep, voffA); PG8_STAGE(PG8_SB(1, 1), cB + hstep + kstep, voffB);
        PG8_WAIT_V(6); PG8_BAR;
    } else {
        PG8_STAGE(PG8_SB(0, 0), cB, voffB); PG8_STAGE(PG8_SA(0, 0), cA, voffA); PG8_STAGE(PG8_SB(0, 1), cB + hstep, voffB); PG8_STAGE(PG8_SA(0, 1), cA + hstep, voffA);
        if (wr == 1) PG8_BAR;
        PG8_WAIT_V(4); PG8_BAR;
        PG8_STAGE(PG8_SB(1, 0), cB + kstep, voffB); PG8_STAGE(PG8_SA(1, 0), cA + kstep, voffA); PG8_STAGE(PG8_SB(1, 1), cB + hstep + kstep, voffB);
        PG8_WAIT_V(6); PG8_BAR;
    }
    for (;;) {
        const bool has_next = S.next(ui + 1, nxt);
        const char* nA = has_next ? (const char*)g.A + (size_t)nxt.pm * tstep : cA; const char* nB = has_next ? (const char*)g.Bt + (size_t)nxt.pn * tstep : cB;
        for (int t = 0; t < nt; t += 2) {
            const bool last = (t == nt - 2);
            const char* a1 = cA + (size_t)(t + 1) * kstep;
            const char* a2 = last ? nA : cA + (size_t)(t + 2) * kstep; const char* b2 = last ? nB : cB + (size_t)(t + 2) * kstep;
            const char* a3 = a2 + kstep; const char* b3 = b2 + kstep;
            if (last && has_next) S.a_ready(nxt);
            if constexpr (Epi::SEG) { if ((t & (Epi::SEGT - 1)) == 0) E.rescale(acc, cur, t / Epi::SEGT, wr, fr, pf, lds + STAGE_BYTES); }
            if constexpr (SP2) {
            PG8_LDB(B0, 0, 0); PG8_LDB(B1, 0, 1); PG8_SCHED; PG8_LDA(At, 0, 0); PG8_STAGE(PG8_SA(1, 1), a1 + hstep, voffA);
            PG8_WAIT_V(8); PG8_WAIT_L(0); PG8_BAR; PG8_MMA(0, 0, At, B0); PG8_MMA(0, 1, At, B1); PG8_BAR; PG8_SCHED;
            PG8_LDA(At, 0, 1); PG8_STAGE(PG8_SB(0, 0), b2, voffB); PG8_STAGE(PG8_SB(0, 1), b2 + hstep, voffB); PG8_STAGE(PG8_SA(0, 0), a2, voffA);
            PG8_WAIT_V(8); PG8_WAIT_L(0); PG8_BAR; PG8_MMA(1, 0, At, B0); PG8_MMA(1, 1, At, B1); PG8_BAR; PG8_SCHED;
            PG8_LDB(B0, 1, 0); PG8_LDB(B1, 1, 1); PG8_SCHED; PG8_LDA(At, 1, 0); PG8_STAGE(PG8_SA(0, 1), a2 + hstep, voffA);
            PG8_WAIT_V(8); PG8_WAIT_L(0); PG8_BAR; PG8_MMA(0, 0, At, B0); PG8_MMA(0, 1, At, B1); PG8_BAR; PG8_SCHED;
            PG8_LDA(At, 1, 1); PG8_STAGE(PG8_SB(1, 0), b3, voffB); PG8_STAGE(PG8_SB(1, 1), b3 + hstep, voffB); PG8_STAGE(PG8_SA(1, 0), a3, voffA);
            PG8_WAIT_V(8); PG8_WAIT_L(0); PG8_BAR; PG8_MMA(1, 0, At, B0); PG8_MMA(1, 1, At, B1); PG8_BAR; PG8_SCHED;
            } else {
            PG8_LDB(B0, 0, 0); PG8_SCHED; PG8_LDA(At, 0, 0); PG8_STAGE(PG8_SA(1, 1), a1 + hstep, voffA);
            PG8_WAIT_L(8); PG8_BAR; PG8_WAIT_L(0); PG8_MMA(0, 0, At, B0); PG8_BAR; PG8_SCHED;
            PG8_LDB(B1, 0, 1); PG8_STAGE(PG8_SB(0, 0), b2, voffB);
            PG8_BAR; PG8_WAIT_L(0); PG8_MMA(0, 1, At, B1); PG8_BAR;
            PG8_LDA(At, 0, 1); PG8_STAGE(PG8_SA(0, 0), a2, voffA);
            PG8_BAR; PG8_WAIT_L(0); PG8_MMA(1, 0, At, B0); PG8_BAR; PG8_SCHED;
            PG8_STAGE(PG8_SB(0, 1), b2 + hstep, voffB);
            PG8_WAIT_V(6); PG8_BAR; PG8_MMA(1, 1, At, B1); PG8_BAR;
            PG8_LDB(B0, 1, 0); PG8_SCHED; PG8_LDA(At, 1, 0); PG8_STAGE(PG8_SA(0, 1), a2 + hstep, voffA);
            PG8_WAIT_L(8); PG8_BAR; PG8_WAIT_L(0); PG8_MMA(0, 0, At, B0); PG8_BAR; PG8_SCHED;
            PG8_LDB(B1, 1, 1); PG8_STAGE(PG8_SB(1, 0), b3, voffB);
            PG8_BAR; PG8_WAIT_L(0); PG8_MMA(0, 1, At, B1); PG8_BAR;
            PG8_LDA(At, 1, 1); PG8_STAGE(PG8_SA(1, 0), a3, voffA);
            PG8_BAR; PG8_WAIT_L(0); PG8_MMA(1, 0, At, B0); PG8_BAR; PG8_SCHED;
            PG8_STAGE(PG8_SB(1, 1), b3 + hstep, voffB);
            PG8_WAIT_V(6); PG8_BAR; PG8_MMA(1, 1, At, B1); PG8_BAR;
            }
        }
        if constexpr (ALIGN_EPI) { if (wr == 0) PG8_BAR; }
        if constexpr (!Epi::AFTER_DRAIN) { E(acc, cur, wr, wc, fr, fq, pf, lds + STAGE_BYTES); S.done(cur); }
        if (!has_next) break;
#pragma unroll
        for (int a = 0; a < 2; ++a)
#pragma unroll
            for (int b = 0; b < 2; ++b)
#pragma unroll
                for (int m = 0; m < 4; ++m)
#pragma unroll
                    for (int n = 0; n < 2; ++n) acc[a][b][m][n] = (f32x4){0.f, 0.f, 0.f, 0.f};
        cur = nxt; cA = nA; cB = nB; ++ui;
        if constexpr (Epi::SEG) { if (pf0) { E.fill_unit(cur, ui, lds + STAGE_BYTES, tid); pf = 2 + (ui & 1); } }
        if constexpr (ALIGN_EPI) { if (wr == 1) PG8_BAR; }
    }
    PG8_WAIT_V(0);
    if constexpr (!ALIGN_EPI) { if (wr == 0) PG8_BAR; }
    PG8_BAR;
    if constexpr (Epi::AFTER_DRAIN) { E.fused(acc, cur, wr, wc, fr, fq, lds, wid, lane); S.done(cur); }
#undef PG8_SA
#undef PG8_SB
#undef PG8_STAGE
#undef PG8_LDA
#undef PG8_LDB
#undef PG8_MMA
#undef PG8_WAIT_V
#undef PG8_WAIT_L
#undef PG8_BAR
#undef PG8_SCHED
}
}

#ifndef PG8_SP2
#define PG8_SP2 true
#endif
#ifndef PG8_ALIGN
#define PG8_ALIGN true
#endif
#ifndef REP_PRO
#define REP_PRO 1
#endif
#ifndef REP_MLSTM
#define REP_MLSTM 1
#endif
#ifndef REP_FOX
#define REP_FOX 1
#endif
#ifndef REP_GLA
#define REP_GLA 1
#endif
#ifndef MK_PER_PHASE
#define MK_PER_PHASE 0
#endif

constexpr int DM = 2048, BATCH = 8, SEQ = 4096, MTOK = BATCH * SEQ, DEPTH = 4, DFF = 5632, NUP = 2 * DFF, NIN = 6160, NINP = 6400, NQKV = 6144;
constexpr int NWAVES = 8;
constexpr int NSUB = 3 * DEPTH;
constexpr int NPHASE = 2 + 5 * NSUB;

constexpr size_t MiB = 1u << 20;
constexpr size_t WS_CTL = 0, CTL_ZERO_BYTES = 11 * MiB;
constexpr size_t WS_SS = 1 * MiB;
constexpr size_t WS_HSS = 5 * MiB;
constexpr size_t WS_WUP = 12 * MiB;
constexpr size_t WS_WDN = WS_WUP + 352 * MiB;
constexpr size_t WS_WIN = WS_WDN + 176 * MiB;
constexpr size_t WS_WOUT = WS_WIN + 100 * MiB;
constexpr size_t WS_HB = WS_WOUT + 32 * MiB;
constexpr size_t WS_ACT = WS_HB + 128 * MiB;
constexpr size_t WS_P1 = WS_ACT + 352 * MiB;
constexpr size_t WS_G = WS_P1 + 384 * MiB;
constexpr size_t WS_HRAW = WS_G + 2 * MiB;
constexpr size_t WS_HM = WS_HRAW + 256 * MiB;
constexpr size_t WS_CF = WS_HM + 128 * MiB;
constexpr size_t WS_END = WS_CF + 2 * MiB;
static_assert((size_t)8 * NUP * DM * 2 == 352 * MiB && (size_t)8 * DM * DFF * 2 == 176 * MiB && (size_t)4 * NINP * DM * 2 == 100 * MiB, "weight regions");
static_assert((size_t)MTOK * DFF * 2 == 352 * MiB && (size_t)MTOK * NQKV * 2 == 384 * MiB && WS_SS + 13 * (size_t)MTOK * 8 <= WS_HSS && WS_HSS + 3 * (size_t)MTOK * 64 <= CTL_ZERO_BYTES && CTL_ZERO_BYTES <= WS_WUP, "activation regions");
constexpr int CW_KMAX = 16384;
constexpr int CW_BAR = 4096;

constexpr int LDS_BYTES = 153600, MISC_OFF = 152576;

#define GAS __attribute__((address_space(1)))
#define LAS __attribute__((address_space(3)))
#define DI __device__ __forceinline__
typedef unsigned short bf16;
typedef unsigned v4u __attribute__((ext_vector_type(4)));
typedef unsigned v2u __attribute__((ext_vector_type(2)));
typedef float f32x4 __attribute__((ext_vector_type(4)));
typedef short bf16x8 __attribute__((ext_vector_type(8)));
typedef GAS unsigned gu32;
#define RLX_AGENT __ATOMIC_RELAXED, __HIP_MEMORY_SCOPE_AGENT
#define LDS_WAIT() asm volatile("s_waitcnt lgkmcnt(0)" ::: "memory")
DI unsigned f2bf(float f) { unsigned r; asm("v_cvt_pk_bf16_f32 %0, %1, %1" : "=v"(r) : "v"(f)); return r & 0xffffu; }
DI unsigned pk2(float lo, float hi) { unsigned r; asm("v_cvt_pk_bf16_f32 %0, %1, %2" : "=v"(r) : "v"(lo), "v"(hi)); return r; }
DI float bf2f(unsigned short v) { return __builtin_bit_cast(float, (unsigned)v << 16); }
DI float bflo(unsigned w) { return __builtin_bit_cast(float, w << 16); }
DI float bfhi(unsigned w) { return __builtin_bit_cast(float, w & 0xffff0000u); }
DI float logsig(float x) { return fminf(x, 0.f) - log1pf(expf(-fabsf(x))); }

#define XB_TMO      128
#define XB_XCNT(j)  (256  + 64 * (j))
#define XB_XSUB(j)  (1280 + 64 * (j))
#define XB_XGEN(j)  (2304 + 64 * (j))
#define XB_TOP      3328
#define XB_TOPGEN   3392
#define XCD_BAR_WORDS 3456
#define XB_SPIN_CAP (1u << 18)

__device__ __forceinline__ unsigned xb_ld(unsigned* p)              { return __hip_atomic_load(p, __ATOMIC_RELAXED, __HIP_MEMORY_SCOPE_AGENT); }
__device__ __forceinline__ unsigned xb_add(unsigned* p, unsigned v) { return __hip_atomic_fetch_add(p, v, __ATOMIC_RELAXED, __HIP_MEMORY_SCOPE_AGENT); }
__device__ __forceinline__ unsigned xb_xcc_id() { return (unsigned)__builtin_amdgcn_s_getreg((3 << 11) | 20) & 0xFu; }
#define XB_SPIN(cond, bar) do { unsigned _sp = 0; while (cond) { __builtin_amdgcn_s_sleep(1); \
    if ((++_sp & 255u) == 0u) { if (xb_ld(&(bar)[XB_TMO])) break; if (_sp > XB_SPIN_CAP) { atomicAdd(&(bar)[XB_TMO], 1u); break; } } } } while (0)

struct XcdBarrier {
    unsigned* bar; unsigned x;
    volatile LAS unsigned* st;
};

__device__ __forceinline__ XcdBarrier xcd_barrier_post(unsigned* bar, volatile LAS unsigned* st) {
    XcdBarrier b; b.bar = bar; b.x = xb_xcc_id(); b.st = st;
    if (threadIdx.x == 0) (void)xb_add(&bar[XB_XCNT(b.x)], 1u);
    return b;
}
__device__ __forceinline__ void xcd_barrier_complete(unsigned* bar, unsigned x, unsigned& nloc, unsigned& nx) {
    const unsigned G = gridDim.x * gridDim.y * gridDim.z;
    unsigned sum, cnt, mine, sp = 0u;
    for (;;) {
        sum = 0u; cnt = 0u; mine = 0u;
#pragma unroll
        for (unsigned j = 0; j < 16; ++j) { const unsigned c = xb_ld(&bar[XB_XCNT(j)]); sum += c; cnt += (c > 0u) ? 1u : 0u; mine = (j == x) ? c : mine; }
        if (sum == G) break;
        __builtin_amdgcn_s_sleep(1);
        if ((++sp & 255u) == 0u) { if (xb_ld(&bar[XB_TMO])) break; if (sp > XB_SPIN_CAP) { atomicAdd(&bar[XB_TMO], 1u); break; } }
    }
    nloc = mine > 0u ? mine : 1u; nx = cnt > 0u ? cnt : 1u;
}

__device__ __forceinline__ void xcd_barrier(const XcdBarrier& b) {
    asm volatile("s_waitcnt vmcnt(0)" ::: "memory");
    __syncthreads();
    if (threadIdx.x == 0) {
        unsigned* bar = b.bar;
        __builtin_amdgcn_s_waitcnt(0);
        unsigned nloc = b.st[0], nx = b.st[1];
        if (nloc == 0u) { xcd_barrier_complete(bar, b.x, nloc, nx); b.st[0] = nloc; b.st[1] = nx; }
        const unsigned old = xb_add(&bar[XB_XSUB(b.x)], 1u);
        const unsigned gen = old / nloc;
        if (old + 1u == (gen + 1u) * nloc) {
            __builtin_amdgcn_fence(__ATOMIC_RELEASE, "agent");
            asm volatile("s_waitcnt vmcnt(0)" ::: "memory");
            const unsigned og = xb_add(&bar[XB_TOP], 1u);
            const unsigned tg = og / nx;
            if (og + 1u == (tg + 1u) * nx) xb_add(&bar[XB_TOPGEN], 1u);
            else XB_SPIN(xb_ld(&bar[XB_TOPGEN]) == tg, bar);
            __builtin_amdgcn_fence(__ATOMIC_ACQUIRE, "agent");
            xb_add(&bar[XB_XGEN(b.x)], 1u);
            asm volatile("s_waitcnt vmcnt(0)" ::: "memory");
        } else {
            XB_SPIN(xb_ld(&bar[XB_XGEN(b.x)]) == gen, bar);
            __builtin_amdgcn_fence(__ATOMIC_ACQUIRE, "agent");
            asm volatile("s_waitcnt vmcnt(0)" ::: "memory");
        }
    }
    __syncthreads();
}


DI float wave_sum(float v) {
#pragma unroll
    for (int o = 1; o < 64; o <<= 1) v += __shfl_xor(v, o);
    return v;
}
DI float wave_max(float v) {
#pragma unroll
    for (int o = 1; o < 64; o <<= 1) v = fmaxf(v, __shfl_xor(v, o));
    return v;
}
DI float wave_incl_sum(float v, int lane) {
#pragma unroll
    for (int o = 1; o < 64; o <<= 1) { const float t = __shfl_up(v, o); if (lane >= o) v += t; }
    return v;
}
DI float wave_incl_max(float v, int lane) {
#pragma unroll
    for (int o = 1; o < 64; o <<= 1) { const float t = __shfl_up(v, o); if (lane >= o) v = fmaxf(v, t); }
    return v;
}

template <int L> DI int swx(int r) { return L == 64 ? ((r >> 1) & 7) : (r & 15); }
template <int L> DI int eoff(int r, int c) { return r * L + ((((c >> 3) ^ swx<L>(r)) << 3) | (c & 7)); }
template <int L> DI bf16x8 ldf(const LAS bf16* base, int r, int ch) { return *(const LAS bf16x8*)(base + r * L + ((ch ^ swx<L>(r)) << 3)); }
DI f32x4 mfma16(bf16x8 a, bf16x8 b, f32x4 c) { return __builtin_amdgcn_mfma_f32_16x16x32_bf16(a, b, c, 0, 0, 0); }
typedef short v4i16_t __attribute__((ext_vector_type(4)));
DI v4i16_t tr_read(const LAS unsigned char* p) { return __builtin_amdgcn_ds_read_tr16_b64_v4i16((LAS v4i16_t*)p); }
DI bf16x8 cat4(v4i16_t lo, v4i16_t hi) { bf16x8 r; r[0] = lo[0]; r[1] = lo[1]; r[2] = lo[2]; r[3] = lo[3]; r[4] = hi[0]; r[5] = hi[1]; r[6] = hi[2]; r[7] = hi[3]; return r; }
DI unsigned off_v64(unsigned row, unsigned ch) { return 128u * row + 16u * (ch ^ ((((row >> 1) & 1u) << 1) | (((row >> 3) & 1u) << 2))); }
DI bf16x8 vfrag64(const LAS unsigned char* vb, int c, int ks, int lane) { const unsigned g = lane >> 4, q = (lane & 15) >> 2, p = lane & 3;
    return cat4(tr_read(vb + off_v64(32 * ks + 8 * g + q, 2 * c + (p >> 1)) + 8 * (p & 1)), tr_read(vb + off_v64(32 * ks + 8 * g + 4 + q, 2 * c + (p >> 1)) + 8 * (p & 1))); }
template <int LA, int LB, int NK> DI void mma_tile(f32x4& acc, const LAS bf16* A, int ra0, const LAS bf16* B, int rb0, int lane) {
    const int r = lane & 15, g = lane >> 4;
#pragma unroll
    for (int kk = 0; kk < NK; ++kk) { const bf16x8 a = ldf<LA>(A, ra0 + r, 4 * kk + g), b = ldf<LB>(B, rb0 + r, 4 * kk + g); acc = mfma16(a, b, acc); }
}

struct ConvItem { const float* W; const float* gk; bf16* WT; int K, N, mode, r; };
DI void conv_load(const ConvItem& c, int lane, f32x4 (&v)[8], float (&gv)[8]) {
    const int nkb = c.K / 64, nb = c.r / nkb, kb = c.r - nb * nkb, k0 = 64 * kb, n0 = 32 * nb;
    const int n = n0 + 4 * (lane & 7); const bool ok = n < c.N;
#pragma unroll
    for (int i = 0; i < 8; ++i) { const int kk = 8 * i + (lane >> 3); v[i] = ok ? *(const f32x4*)(c.W + (size_t)(k0 + kk) * c.N + n) : (f32x4){0.f, 0.f, 0.f, 0.f}; gv[i] = c.gk ? c.gk[k0 + kk] : 1.0f; }
}
DI void conv_store(const ConvItem& c, int lane, const f32x4 (&v)[8], const float (&gv)[8], LAS float* scr) {
    const int nkb = c.K / 64, nb = c.r / nkb, kb = c.r - nb * nkb, k0 = 64 * kb, n0 = 32 * nb, nq = 4 * (lane & 7);
#pragma unroll
    for (int i = 0; i < 8; ++i) { const int kk = 8 * i + (lane >> 3); LAS float* d = scr + kk * 33 + nq; d[0] = v[i].x * gv[i]; d[1] = v[i].y * gv[i]; d[2] = v[i].z * gv[i]; d[3] = v[i].w * gv[i]; }
    LDS_WAIT(); asm volatile("" ::: "memory");
    int row_off = n0;
    if (c.mode == 1) { const int j = n0 < DFF ? n0 : n0 - DFF; row_off = 256 * (j >> 7) + (j & 127) + (n0 < DFF ? 0 : 128); }
    const int cc = lane & 7;
#pragma unroll
    for (int j = 0; j < 4; ++j) { const int nn = (lane >> 3) + 8 * j; const LAS float* s = scr + (8 * cc) * 33 + nn;
        v4u o; o.x = pk2(s[0 * 33], s[1 * 33]); o.y = pk2(s[2 * 33], s[3 * 33]); o.z = pk2(s[4 * 33], s[5 * 33]); o.w = pk2(s[6 * 33], s[7 * 33]);
        *(v4u*)(c.WT + (size_t)(row_off + nn) * c.K + k0 + 8 * cc) = o; }
    LDS_WAIT(); asm volatile("" ::: "memory");
}

struct Args { const float* in[18]; float* out; unsigned char* ws; int ph_lo, ph_hi; };

typedef const __attribute__((address_space(4))) Args* KArgs;
DI KArgs kargs() { KArgs p = (KArgs)__builtin_amdgcn_kernarg_segment_ptr(); asm volatile("" : "+s"(p)); return p; }
DI void prologue(LAS unsigned char* lds, int lane, int wave, int bx) {
    KArgs AP = kargs();
    LAS float* scr = (LAS float*)(lds + wave * 16384);
    const int gw = bx * NWAVES + wave, NGW = gridDim.x * NWAVES;
    unsigned char* ws = AP->ws;
    constexpr int I_UP = (DM / 64) * (NUP / 32), I_DN = (DFF / 64) * (DM / 32), I_IN = (DM / 64) * (NINP / 32), I_OUT = (DM / 64) * (DM / 32);
    constexpr int NITEMS = 8 * I_UP + 8 * I_DN + 4 * I_IN + 4 * I_OUT;
#define CONV_DECODE(it_, c_) do { int r = (it_); (c_).gk = nullptr; (c_).K = DM; (c_).mode = 0; \
        if (r < 8 * I_UP) { const int mi = r / I_UP; r -= mi * I_UP; (c_).W = AP->in[2] + (size_t)mi * DM * NUP; (c_).gk = AP->in[1] + (size_t)mi * DM; (c_).WT = (bf16*)(ws + WS_WUP) + (size_t)mi * NUP * DM; (c_).N = NUP; (c_).mode = 1; } \
        else if (r < 8 * I_UP + 8 * I_DN) { r -= 8 * I_UP; const int mi = r / I_DN; r -= mi * I_DN; (c_).W = AP->in[3] + (size_t)mi * DFF * DM; (c_).WT = (bf16*)(ws + WS_WDN) + (size_t)mi * DM * DFF; (c_).K = DFF; (c_).N = DM; } \
        else if (r < 8 * I_UP + 8 * I_DN + 4 * I_IN) { r -= 8 * I_UP + 8 * I_DN; const int l = r / I_IN; r -= l * I_IN; const int kind = l % 3, ji = l / 3; \
            (c_).W = AP->in[kind == 0 ? 5 : kind == 1 ? 9 : 12] + (size_t)ji * DM * NIN; (c_).gk = AP->in[4] + (size_t)l * DM; (c_).WT = (bf16*)(ws + WS_WIN) + (size_t)l * NINP * DM; (c_).N = NIN; } \
        else { r -= 8 * I_UP + 8 * I_DN + 4 * I_IN; const int l = r / I_OUT; r -= l * I_OUT; const int kind = l % 3, ji = l / 3; \
            (c_).W = AP->in[kind == 0 ? 8 : kind == 1 ? 11 : 16] + (size_t)ji * DM * DM; if (kind != 1) (c_).gk = AP->in[kind == 0 ? 7 : 15] + (size_t)ji * DM; (c_).WT = (bf16*)(ws + WS_WOUT) + (size_t)l * DM * DM; (c_).N = DM; } \
        (c_).r = r; } while (0)
    f32x4 va[8]; float ga[8]; ConvItem ca{}, cb{};
    if (gw < NITEMS) { CONV_DECODE(gw, ca); conv_load(ca, lane, va, ga); }
    for (int it = gw; it < NITEMS; it += NGW) {
        f32x4 vb[8]; float gb[8]; const int nx = it + NGW;
        if (nx < NITEMS) { CONV_DECODE(nx, cb); conv_load(cb, lane, vb, gb); }
        conv_store(ca, lane, va, ga, scr);
        ca = cb;
#pragma unroll
        for (int i = 0; i < 8; ++i) { va[i] = vb[i]; ga[i] = gb[i]; }
    }
#undef CONV_DECODE
    const float* x = AP->in[0]; bf16* hb = (bf16*)(ws + WS_HB); long long* ss0 = (long long*)(ws + WS_SS);
    for (int m = gw; m < MTOK; m += NGW) {
        const f32x4* xr = (const f32x4*)(x + (size_t)m * DM) + lane; f32x4 v[8]; float s = 0.f;
#pragma unroll
        for (int j = 0; j < 8; ++j) { v[j] = xr[64 * j]; s += (v[j].x * v[j].x + v[j].y * v[j].y) + (v[j].z * v[j].z + v[j].w * v[j].w); }
        s = wave_sum(s);
        v2u* o8 = (v2u*)(hb + (size_t)m * DM) + lane;
#pragma unroll
        for (int j = 0; j < 8; ++j) { v2u w; w.x = pk2(v[j].x, v[j].y); w.y = pk2(v[j].z, v[j].w); o8[64 * j] = w; }
        if (lane == 0) ss0[m] = __float2ll_rn(s * 1048576.0f);
    }
}

constexpr int IMGM_P = 0, IMGM_KT = 8192, IMGM_VT = IMGM_KT + 16384, IMGM_GS = IMGM_VT + 4 * 8192, IMGM_BYTES = IMGM_GS + 1024;
constexpr int IMGG_Q = 0, IMGG_KT = 32768, IMGG_P = 65536, IMGG_VT = IMGG_P + 8192, IMGG_EB = IMGG_VT + 8 * 8192, IMGG_BYTES = IMGG_EB + 1024;
static_assert((size_t)IMGM_BYTES * 4096 <= 352 * MiB && (size_t)IMGG_BYTES * 2048 <= 352 * MiB, "images overlay the (idle) FFN activation buffer");
DI unsigned pk2_sw(float lo, float hi) { unsigned a = __builtin_bit_cast(unsigned, lo), b = __builtin_bit_cast(unsigned, hi); a = (a + 0x7fffu + ((a >> 16) & 1u)) >> 16; b = (b + 0x7fffu + ((b >> 16) & 1u)) & 0xffff0000u; return a | b; }
DI bf16x8 vfrag64p(const LAS unsigned char* vb, int eh, int q2, int ks, int lane) { const unsigned g = lane >> 4, q = (lane & 15) >> 2, p = lane & 3;
    return cat4(tr_read(vb + off_v64(32 * ks + 8 * g + q, 4 * eh + p) + 8 * q2), tr_read(vb + off_v64(32 * ks + 8 * g + 4 + q, 4 * eh + p) + 8 * q2)); }
template <int LA, int LB, int NK> DI void mma_rows(f32x4& acc, const LAS bf16* A, int arow, const LAS bf16* B, int rb0, int lane) {
    const int r = lane & 15, g = lane >> 4;
#pragma unroll
    for (int kk = 0; kk < NK; ++kk) { const bf16x8 a = ldf<LA>(A, arow, 4 * kk + g), b = ldf<LB>(B, rb0 + r, 4 * kk + g); acc = mfma16(a, b, acc); }
}
DI float logsig_fast(float x) { return fminf(x, 0.f) - __logf(1.0f + __expf(-fabsf(x))); }

DI void mlstm_pre(LAS unsigned char* lds, const bf16* P1, const float* G, const float* b_if, unsigned char* img, int tid, int lane, int wave, int bx) {
    LAS bf16* Qs = (LAS bf16*)lds;
    LAS bf16* Ks = Qs + 64 * 128;
    LAS bf16* KTs = Ks + 64 * 128;
    LAS bf16* Ps = KTs + 128 * 64;
    LAS bf16* VT = Ps + 64 * 64;
    LAS float* fa = (LAS float*)(VT + 256 * 64);
    LAS float *bcum = fa, *ipre = fa + 64, *aloc = fa + 128, *wloc = fa + 192, *scal = fa + 256;
    const float KSCALE = 0.08838834764831845f;
    const int g = lane >> 4, r16 = lane & 15;
    v4u pq[2], pk[2]; float pgi = 0.f, pgf = 0.f;
#define MLP_LOAD(it_) do { const int b_ = (it_) >> 9, c_ = ((it_) >> 3) & 63, h_ = (it_) & 7; const int row0_ = b_ * SEQ + c_ * 64; \
        _Pragma("unroll") for (int p = 0; p < 2; ++p) { const int idx = tid + 512 * p, r = idx >> 4, c8 = idx & 15; const bf16* src = P1 + (size_t)(row0_ + r) * NQKV + h_ * 128 + c8 * 8; pq[p] = *(const v4u*)src; pk[p] = *(const v4u*)(src + 1024); } \
        if (tid < 64) { const float* gp = G + (size_t)(row0_ + tid) * 16; pgi = gp[h_]; pgf = gp[8 + h_]; } } while (0)
    if (bx < 4096) MLP_LOAD(bx);
    for (int item = bx; item < 4096; item += gridDim.x) {
        const int h = item & 7;
        unsigned char* im = img + (size_t)item * IMGM_BYTES;
        __syncthreads();
        if (tid < 64) { ipre[tid] = pgi + b_if[h]; bcum[tid] = logsig(pgf + b_if[8 + h]); }
#pragma unroll
        for (int p = 0; p < 2; ++p) { const int idx = tid + 512 * p, r = idx >> 4, c8 = idx & 15; *(LAS v4u*)(Qs + eoff<128>(r, c8 * 8)) = pq[p]; *(LAS v4u*)(Ks + eoff<128>(r, c8 * 8)) = pk[p]; }
        __syncthreads();
        if (wave == 0) {
            const float bt = wave_incl_sum(bcum[lane], lane), ip = ipre[lane];
            const float al = bt + wave_incl_max(ip - bt, lane);
            const float blast = __shfl(bt, 63);
            const float gg = blast - bt + ip;
            const float gmax = wave_max(gg);
            bcum[lane] = bt; aloc[lane] = al; wloc[lane] = __expf(gg - gmax);
            if (lane == 0) { scal[0] = blast; scal[1] = gmax; }
        }
        if (item + (int)gridDim.x < 4096) MLP_LOAD(item + (int)gridDim.x);
        __syncthreads();
#pragma unroll
        for (int p = 0; p < 2; ++p) { const int idx = tid + 512 * p, s = idx >> 4, c8 = idx & 15; const v4u kv = *(const LAS v4u*)(Ks + eoff<128>(s, c8 * 8)); const float w = wloc[s] * KSCALE;
#pragma unroll
            for (int j = 0; j < 4; ++j) { KTs[eoff<64>(c8 * 8 + 2 * j, s)] = (bf16)f2bf(bflo(kv[j]) * w); KTs[eoff<64>(c8 * 8 + 2 * j + 1, s)] = (bf16)f2bf(bfhi(kv[j]) * w); } }
        { const int tt = wave >> 1;
#pragma unroll
          for (int q2 = 0; q2 < 2; ++q2) { const int st = 2 * (wave & 1) + q2; f32x4 acc = (f32x4){0.f, 0.f, 0.f, 0.f};
            if (st <= tt) mma_tile<128, 128, 4>(acc, Qs, 16 * tt, Ks, 16 * st, lane);
            const int s = 16 * st + r16; const float cs = ipre[s] - bcum[s];
#pragma unroll
            for (int i = 0; i < 4; ++i) { const int t = 16 * tt + 4 * g + i; const float p = (s <= t) ? acc[i] * KSCALE * __expf(bcum[t] + cs - aloc[t]) : 0.f; Ps[eoff<64>(t, s)] = (bf16)f2bf(p); } } }
        __syncthreads();
        *(v4u*)(im + IMGM_P + tid * 16) = *(const LAS v4u*)((LAS unsigned char*)Ps + tid * 16);
#pragma unroll
        for (int p = 0; p < 2; ++p) *(v4u*)(im + IMGM_KT + (tid + 512 * p) * 16) = *(const LAS v4u*)((LAS unsigned char*)KTs + (tid + 512 * p) * 16);
        if (tid < 64) { float* gs = (float*)(im + IMGM_GS); gs[tid] = bcum[tid]; gs[64 + tid] = aloc[tid]; if (tid < 2) gs[128 + tid] = scal[tid]; }
    }
#undef MLP_LOAD
}

DI void mlstm_scan2(LAS unsigned char* lds, const bf16* P1, const unsigned char* img, bf16* hm, long long* hss, int tid, int lane, int wave, int bx) {
    constexpr int IB = 8192 + 16384 + 16384 + 10240 + 1024;
    LAS bf16* CT0 = (LAS bf16*)(lds + 2 * IB);
    const int g = lane >> 4, r16 = lane & 15, tt = wave >> 1, eh = wave & 1;
    for (int item0 = bx; item0 < 256; item0 += gridDim.x) {
        const int item = (gridDim.x == 256) ? (item0 & 7) * 32 + (item0 >> 3) : item0;
        const int b = item >> 5, h = (item >> 2) & 7, sl = item & 3;
        f32x4 Cacc[5];
#pragma unroll
        for (int e = 0; e < 5; ++e) Cacc[e] = (f32x4){0.f, 0.f, 0.f, 0.f};
        __syncthreads();
        for (int i = tid; i < 2 * 80 * 128 / 8; i += 512) ((LAS v4u*)CT0)[i] = (v4u){0u, 0u, 0u, 0u};
        float m_prev = 0.f;
        v4u rp, rq[2], rk[2], rv; float rg0 = 0.f, rbl, rgm;
#define MLS_PREFETCH(cc) do { const int item2 = (b * 64 + (cc)) * 8 + h; const unsigned char* im = img + (size_t)item2 * IMGM_BYTES; const int row0_ = b * SEQ + (cc) * 64; \
            rp = *(const v4u*)(im + IMGM_P + tid * 16); rk[0] = *(const v4u*)(im + IMGM_KT + tid * 16); rk[1] = *(const v4u*)(im + IMGM_KT + (tid + 512) * 16); \
            rv = *(const v4u*)(P1 + (size_t)(row0_ + (tid >> 3)) * NQKV + 2048 + h * 256 + sl * 64 + (tid & 7) * 8); \
            _Pragma("unroll") for (int p = 0; p < 2; ++p) { const int idx = tid + 512 * p, r = idx >> 4, c8 = idx & 15; rq[p] = *(const v4u*)(P1 + (size_t)(row0_ + r) * NQKV + h * 128 + c8 * 8); } \
            const float* gs = (const float*)(im + IMGM_GS); if (tid < 128) rg0 = gs[tid]; rbl = gs[128]; rgm = gs[129]; } while (0)
#define MLS_STORE(bi) do { LAS unsigned char* bb = lds + (bi) * IB; \
            *(LAS v4u*)(bb + tid * 16) = rp; *(LAS v4u*)(bb + 8192 + 16384 + tid * 16) = rk[0]; *(LAS v4u*)(bb + 8192 + 16384 + (tid + 512) * 16) = rk[1]; \
            *(LAS v4u*)(bb + 8192 + 16384 + 16384 + off_v64(tid >> 3, tid & 7)) = rv; \
            _Pragma("unroll") for (int p = 0; p < 2; ++p) { const int idx = tid + 512 * p, r = idx >> 4, c8 = idx & 15; *(LAS v4u*)((LAS bf16*)(bb + 8192) + eoff<128>(r, c8 * 8)) = rq[p]; } \
            if (tid < 128) ((LAS float*)(bb + 8192 + 16384 + 16384 + 10240))[tid] = rg0; } while (0)
        MLS_PREFETCH(0); MLS_STORE(0);
        float blast = rbl, gmax = rgm;
        const bf16* gbase = P1 + (size_t)(b * SEQ + 16 * tt + r16) * NQKV + 4096 + h * 256 + sl * 64 + 32 * eh + 8 * g;
        v4u gt = *(const v4u*)gbase;
        MLS_PREFETCH(1);
        __syncthreads();
        for (int c = 0; c < 64; ++c) {
            const int row0 = b * SEQ + c * 64;
            const LAS unsigned char* bb = lds + (c & 1) * IB;
            const LAS bf16* Ps = (const LAS bf16*)bb; const LAS bf16* Qs = (const LAS bf16*)(bb + 8192); const LAS bf16* KTs = (const LAS bf16*)(bb + 8192 + 16384);
            const LAS bf16* VTs = (const LAS bf16*)(bb + 8192 + 16384 + 16384); const LAS float* gsl = (const LAS float*)(bb + 8192 + 16384 + 16384 + 10240);
            LAS bf16* CTc = CT0 + (c & 1) * 80 * 128; LAS bf16* CTn = CT0 + ((c + 1) & 1) * 80 * 128;
            const int t = 16 * tt + r16;
            const v4u gtn = *(const v4u*)(gbase + (size_t)((c + 1 < 64 ? c + 1 : c) * 64) * NQKV);
            float sq = 0.f;
            float sg[2][4];
#pragma unroll
            for (int q2 = 0; q2 < 2; ++q2) { const unsigned wx = q2 ? gt.z : gt.x, wy = q2 ? gt.w : gt.y;
                sg[q2][0] = __builtin_amdgcn_rcpf(1.0f + __expf(-bflo(wx))); sg[q2][1] = __builtin_amdgcn_rcpf(1.0f + __expf(-bfhi(wx)));
                sg[q2][2] = __builtin_amdgcn_rcpf(1.0f + __expf(-bflo(wy))); sg[q2][3] = __builtin_amdgcn_rcpf(1.0f + __expf(-bfhi(wy))); }
            const float btv = gsl[t], alv = gsl[64 + t];
            const float mt = fmaxf(btv + m_prev, alv), al = __expf(alv - mt), be = __expf(btv + m_prev - mt), em = __expf(-mt);
            const float m_new = fmaxf(blast + m_prev, gmax), wcs = __expf(blast + m_prev - m_new), gam = __expf(gmax - m_new);
            m_prev = m_new;
            const LAS unsigned char* vb = (const LAS unsigned char*)VTs;
            bf16x8 onesf;
#pragma unroll
            for (int j = 0; j < 8; ++j) onesf[j] = (r16 == 0) ? (short)0x3f80 : (short)0;
            const bf16x8 pa0 = ldf<64>(Ps, 16 * tt + r16, g), pa1 = ldf<64>(Ps, 16 * tt + r16, 4 + g);
#pragma unroll
            for (int q2 = 0; q2 < 2; ++q2)
#pragma unroll
                for (int i = 0; i < 4; ++i) asm volatile("" : "+v"(sg[q2][i]));
            f32x4 d1 = (f32x4){0.f, 0.f, 0.f, 0.f}, d2 = (f32x4){0.f, 0.f, 0.f, 0.f};
            d1 = mfma16(onesf, pa0, d1); d1 = mfma16(onesf, pa1, d1); mma_tile<128, 128, 4>(d2, CTc, 64, Qs, 16 * tt, lane);
            const float den = __shfl(al * d1[0] + be * d2[0], r16);
            const float dinv = __builtin_amdgcn_rcpf(fmaxf(fabsf(den), em));
            unsigned wv[4];
#pragma unroll
            for (int q2 = 0; q2 < 2; ++q2) { f32x4 a1 = (f32x4){0.f, 0.f, 0.f, 0.f}, a2 = (f32x4){0.f, 0.f, 0.f, 0.f};
                a1 = mfma16(vfrag64p(vb, eh, q2, 0, lane), pa0, a1); a1 = mfma16(vfrag64p(vb, eh, q2, 1, lane), pa1, a1);
                mma_rows<128, 128, 4>(a2, CTc, 32 * eh + 8 * (r16 >> 2) + 4 * q2 + (r16 & 3), Qs, 16 * tt, lane);
                const f32x4 o4 = (a1 * al + a2 * be) * dinv; sq += (o4[0] * o4[0] + o4[1] * o4[1]) + (o4[2] * o4[2] + o4[3] * o4[3]);
                wv[2 * q2] = pk2(o4[0] * sg[q2][0], o4[1] * sg[q2][1]); wv[2 * q2 + 1] = pk2(o4[2] * sg[q2][2], o4[3] * sg[q2][3]); }
            { v4u w; w.x = wv[0]; w.y = wv[1]; w.z = wv[2]; w.w = wv[3]; *(v4u*)(hm + (size_t)(row0 + t) * DM + h * 256 + sl * 64 + 32 * eh + 8 * g) = w; }
            sq += __shfl_xor(sq, 16); sq += __shfl_xor(sq, 32);
            if (g == 0) atomicAdd((unsigned long long*)(hss + (size_t)(row0 + t) * 8 + h), (unsigned long long)__float2ll_rn(sq * pg8::HSS_FIX));
            const bf16x8 ka0 = ldf<64>(KTs, 16 * wave + r16, g), ka1 = ldf<64>(KTs, 16 * wave + r16, 4 + g);
#pragma unroll
            for (int et = 0; et < 5; ++et) { f32x4 tmp = (f32x4){0.f, 0.f, 0.f, 0.f};
                tmp = mfma16(ka0, et < 4 ? vfrag64(vb, et & 3, 0, lane) : onesf, tmp); tmp = mfma16(ka1, et < 4 ? vfrag64(vb, et & 3, 1, lane) : onesf, tmp);
                Cacc[et] = Cacc[et] * wcs + tmp * gam;
                v2u w; w.x = pk2(Cacc[et][0], Cacc[et][1]); w.y = pk2(Cacc[et][2], Cacc[et][3]);
                *(LAS v2u*)(CTn + eoff<128>(16 * et + r16, 16 * wave + 4 * g)) = w; }
            if (c + 1 < 64) { MLS_STORE((c + 1) & 1); blast = rbl; gmax = rgm; }
            if (c + 2 < 64) MLS_PREFETCH(c + 2);
            gt = gtn;
            __syncthreads();
        }
#undef MLS_PREFETCH
#undef MLS_STORE
    }
}

DI void gla_pre(LAS unsigned char* lds, const bf16* P1, const float* G, const float* w_alpha, const float* b_alpha, unsigned char* img, int tid, int lane, int wave, int bx) {
    LAS bf16* VT = (LAS bf16*)lds;
    LAS bf16* QTs = (LAS bf16*)lds;
    LAS bf16* KTl = QTs + 64 * 256;
    LAS bf16* KTT = KTl + 64 * 256;
    LAS bf16* Ps = KTT + 256 * 64;
    LAS float* alow = (LAS float*)(Ps + 64 * 64);
    LAS float* T0 = alow + 1024;
    const int g = lane >> 4, r16 = lane & 15, d = tid & 255, sh = tid >> 8;
    for (int item = bx; item < 2048; item += gridDim.x) {
        const int b = item >> 8, c = (item >> 2) & 63, h = item & 3;
        const int row0 = b * SEQ + c * 64;
        unsigned char* im = img + (size_t)item * IMGG_BYTES;
        __syncthreads();
        float wa[16];
#pragma unroll
        for (int i = 0; i < 16; ++i) wa[i] = w_alpha[i * 1024 + h * 256 + d];
        const float ba = b_alpha[h * 256 + d];
        f32x4 al4 = (f32x4){0.f, 0.f, 0.f, 0.f};
        if (tid < 256) al4 = *(const f32x4*)(G + (size_t)(row0 + (tid >> 2)) * 16 + (tid & 3) * 4);
        if (tid < 256) *(LAS f32x4*)(alow + tid * 4) = al4;
        __syncthreads();
        const bf16* qsrc = P1 + (size_t)(row0 + 32 * sh) * NQKV + h * 256 + d;
        float bs[32]; float run = 0.f;
#pragma unroll
        for (int j = 0; j < 32; ++j) { const int s = 32 * sh + j; float z = ba;
#pragma unroll
            for (int i = 0; i < 16; ++i) z += alow[s * 16 + i] * wa[i];
            run += logsig_fast(z) * (1.0f / 16.0f); bs[j] = run; }
        if (sh == 0) T0[d] = run;
        __syncthreads();
        const float add = sh ? T0[d] : 0.f;
        if (sh) ((float*)(im + IMGG_EB))[d] = __expf(run + add);
#pragma unroll
        for (int q8 = 0; q8 < 4; ++q8) { unsigned kk[8];
#pragma unroll
            for (int j = 0; j < 8; ++j) { const int jj = 8 * q8 + j, s = 32 * sh + jj; const float bsum = bs[jj] + add;
                const float qv = bf2f(qsrc[(size_t)jj * NQKV]) * 0.0625f * __expf(bsum), kv = bf2f(qsrc[(size_t)jj * NQKV + 1024]) * __expf(-bsum);
                QTs[eoff<256>(s, d)] = (bf16)f2bf(qv); kk[j] = f2bf(kv); KTl[eoff<256>(s, d)] = (bf16)kk[j]; }
            v4u w; w.x = kk[0] | (kk[1] << 16); w.y = kk[2] | (kk[3] << 16); w.z = kk[4] | (kk[5] << 16); w.w = kk[6] | (kk[7] << 16);
            *(LAS v4u*)(KTT + eoff<64>(d, 32 * sh + 8 * q8)) = w; }
        __syncthreads();
        { const int tt = wave >> 1;
#pragma unroll
          for (int q2 = 0; q2 < 2; ++q2) { const int st = 2 * (wave & 1) + q2; f32x4 acc = (f32x4){0.f, 0.f, 0.f, 0.f};
            if (st <= tt) mma_tile<256, 256, 8>(acc, QTs, 16 * tt, KTl, 16 * st, lane);
            const int s = 16 * st + r16;
#pragma unroll
            for (int i = 0; i < 4; ++i) { const int t = 16 * tt + 4 * g + i; Ps[eoff<64>(t, s)] = (bf16)f2bf((s <= t) ? acc[i] : 0.f); } } }
        __syncthreads();
#pragma unroll
        for (int p = 0; p < 4; ++p) { *(v4u*)(im + IMGG_Q + (tid + 512 * p) * 16) = *(const LAS v4u*)((LAS unsigned char*)QTs + (tid + 512 * p) * 16);
                                      *(v4u*)(im + IMGG_KT + (tid + 512 * p) * 16) = *(const LAS v4u*)((LAS unsigned char*)KTT + (tid + 512 * p) * 16); }
        *(v4u*)(im + IMGG_P + tid * 16) = *(const LAS v4u*)((LAS unsigned char*)Ps + tid * 16);
    }
}

DI void gla_scan2(LAS unsigned char* lds, const bf16* P1, const unsigned char* img, bf16* hm, long long* hss, int tid, int lane, int wave, int bx) {
    LAS bf16* QTs = (LAS bf16*)lds;
    LAS bf16* KTT = QTs + 64 * 256;
    LAS bf16* Ps = KTT + 256 * 64;
    LAS bf16* VTs = Ps + 64 * 64;
    LAS float* eb = (LAS float*)(VTs + 64 * 64);
    LAS bf16* ST0 = (LAS bf16*)(eb + 256);
    const int g = lane >> 4, r16 = lane & 15, tt = wave >> 1, eh = wave & 1;
    for (int item0 = bx; item0 < 256; item0 += gridDim.x) {
        const int item = (gridDim.x == 256) ? (item0 & 7) * 32 + (item0 >> 3) : item0;
        const int b = item >> 5, h = (item >> 3) & 3, sl = item & 7;
        f32x4 Sacc[2][4];
#pragma unroll
        for (int a = 0; a < 2; ++a)
#pragma unroll
            for (int e = 0; e < 4; ++e) Sacc[a][e] = (f32x4){0.f, 0.f, 0.f, 0.f};
        __syncthreads();
        for (int i = tid; i < 2 * 64 * 256 / 8; i += 512) ((LAS v4u*)ST0)[i] = (v4u){0u, 0u, 0u, 0u};
        v4u rq[4], rk[4], rp, rv; float re = 0.f;
#define GLS_PREFETCH(cc) do { const int item2 = (b * 64 + (cc)) * 4 + h; const unsigned char* im = img + (size_t)item2 * IMGG_BYTES; \
            _Pragma("unroll") for (int p = 0; p < 4; ++p) { rq[p] = *(const v4u*)(im + IMGG_Q + (tid + 512 * p) * 16); rk[p] = *(const v4u*)(im + IMGG_KT + (tid + 512 * p) * 16); } \
            rp = *(const v4u*)(im + IMGG_P + tid * 16); rv = *(const v4u*)(P1 + ((size_t)b * SEQ + (cc) * 64 + (tid >> 3)) * NQKV + 2048 + h * 512 + sl * 64 + (tid & 7) * 8); if (tid < 256) re = ((const float*)(im + IMGG_EB))[tid]; } while (0)
        const bf16* gbase = P1 + (size_t)(b * SEQ + 16 * tt + r16) * NQKV + 4096 + h * 512 + sl * 64 + 32 * eh + 8 * g;
        v4u gt = *(const v4u*)gbase;
        GLS_PREFETCH(0);
        for (int c = 0; c < 64; ++c) {
            const int row0 = b * SEQ + c * 64;
            LAS bf16* STc = ST0 + (c & 1) * 64 * 256; LAS bf16* STn = ST0 + ((c + 1) & 1) * 64 * 256;
            __syncthreads();
#pragma unroll
            for (int p = 0; p < 4; ++p) { *(LAS v4u*)((LAS unsigned char*)QTs + (tid + 512 * p) * 16) = rq[p]; *(LAS v4u*)((LAS unsigned char*)KTT + (tid + 512 * p) * 16) = rk[p]; }
            *(LAS v4u*)((LAS unsigned char*)Ps + tid * 16) = rp; *(LAS v4u*)((LAS unsigned char*)VTs + off_v64(tid >> 3, tid & 7)) = rv;
            if (tid < 256) eb[tid] = re;
            __syncthreads();
            const v4u gtn = *(const v4u*)(gbase + (size_t)((c + 1 < 64 ? c + 1 : c) * 64) * NQKV);
            if (c + 1 < 64) GLS_PREFETCH(c + 1);
            float sq = 0.f;
            const LAS unsigned char* vb = (const LAS unsigned char*)VTs;
            const bf16x8 pa0 = ldf<64>(Ps, 16 * tt + r16, g), pa1 = ldf<64>(Ps, 16 * tt + r16, 4 + g);
            float sg[2][4];
#pragma unroll
            for (int q2 = 0; q2 < 2; ++q2) { const unsigned wx = q2 ? gt.z : gt.x, wy = q2 ? gt.w : gt.y; const float g0 = bflo(wx), g1 = bfhi(wx), g2 = bflo(wy), g3 = bfhi(wy);
                sg[q2][0] = g0 * __builtin_amdgcn_rcpf(1.0f + __expf(-g0)); sg[q2][1] = g1 * __builtin_amdgcn_rcpf(1.0f + __expf(-g1));
                sg[q2][2] = g2 * __builtin_amdgcn_rcpf(1.0f + __expf(-g2)); sg[q2][3] = g3 * __builtin_amdgcn_rcpf(1.0f + __expf(-g3)); }
#pragma unroll
            for (int q2 = 0; q2 < 2; ++q2)
#pragma unroll
                for (int i = 0; i < 4; ++i) asm volatile("" : "+v"(sg[q2][i]));
            unsigned wv[4];
#pragma unroll
            for (int q2 = 0; q2 < 2; ++q2) { f32x4 acc = (f32x4){0.f, 0.f, 0.f, 0.f};
                acc = mfma16(vfrag64p(vb, eh, q2, 0, lane), pa0, acc); acc = mfma16(vfrag64p(vb, eh, q2, 1, lane), pa1, acc);
                mma_rows<256, 256, 8>(acc, STc, 32 * eh + 8 * (r16 >> 2) + 4 * q2 + (r16 & 3), QTs, 16 * tt, lane);
                sq += (acc[0] * acc[0] + acc[1] * acc[1]) + (acc[2] * acc[2] + acc[3] * acc[3]);
                const float o0 = acc[0] * sg[q2][0], o1 = acc[1] * sg[q2][1], o2 = acc[2] * sg[q2][2], o3 = acc[3] * sg[q2][3];
                wv[2 * q2] = pk2_sw(o0, o1); wv[2 * q2 + 1] = pk2_sw(o2, o3); }
            { v4u w; w.x = wv[0]; w.y = wv[1]; w.z = wv[2]; w.w = wv[3]; *(v4u*)(hm + (size_t)(row0 + 16 * tt + r16) * DM + h * 512 + sl * 64 + 32 * eh + 8 * g) = w; }
            sq += __shfl_xor(sq, 16); sq += __shfl_xor(sq, 32);
            if (g == 0) atomicAdd((unsigned long long*)(hss + (size_t)(row0 + 16 * tt + r16) * 4 + h), (unsigned long long)__float2ll_rn(sq * pg8::HSS_FIX));
#pragma unroll
            for (int a = 0; a < 2; ++a) { const int dt = 2 * wave + a;
                const f32x4 ev = *(const LAS f32x4*)(eb + 16 * dt + 4 * g);
                const bf16x8 ka0 = ldf<64>(KTT, 16 * dt + r16, g), ka1 = ldf<64>(KTT, 16 * dt + r16, 4 + g);
#pragma unroll
                for (int et = 0; et < 4; ++et) { Sacc[a][et] = mfma16(ka0, vfrag64(vb, et, 0, lane), Sacc[a][et]); Sacc[a][et] = mfma16(ka1, vfrag64(vb, et, 1, lane), Sacc[a][et]); Sacc[a][et] = Sacc[a][et] * ev;
                    v2u w; w.x = pk2(Sacc[a][et][0], Sacc[a][et][1]); w.y = pk2(Sacc[a][et][2], Sacc[a][et][3]);
                    *(LAS v2u*)(STn + eoff<256>(16 * et + r16, 16 * dt + 4 * g)) = w; } }
            gt = gtn;
        }
#undef GLS_PREFETCH
    }
}


DI void mixer_gates(const bf16* hb, const bf16* wg, const long long* ss, float* G, int lane, int wave, int bx) {
    const int g = lane >> 4, r16 = lane & 15;
    for (int t = bx * NWAVES + wave; t < MTOK / 16; t += gridDim.x * NWAVES) {
        const bf16* ap = hb + (size_t)(16 * t + r16) * DM + 8 * g; const bf16* bp = wg + (size_t)r16 * DM + 8 * g;
        f32x4 acc = (f32x4){0.f, 0.f, 0.f, 0.f};
#pragma unroll 8
        for (int kk = 0; kk < DM / 32; ++kk) { const bf16x8 a = *(const bf16x8*)(ap + 32 * kk), b = *(const bf16x8*)(bp + 32 * kk); acc = mfma16(a, b, acc); }
#pragma unroll
        for (int i = 0; i < 4; ++i) { const int row = 16 * t + 4 * g + i; G[(size_t)row * 16 + r16] = acc[i] * pg8::rstd_of(ss, row); }
    }
}

template <int HS, int ACT> DI void headnorm_gate(const bf16* hraw, const bf16* P1, const float* gnorm, bf16* hm, int lane, int wave, int bx) {
    constexpr int NH = DM / HS, EPL = HS / 64;
    const int gw = bx * NWAVES + wave, NGW = gridDim.x * NWAVES;
    for (int row = gw; row < MTOK; row += NGW) {
#pragma unroll
        for (int hh = 0; hh < NH; ++hh) { const int col = hh * HS + lane * EPL;
            unsigned xw[EPL / 2], gwd[EPL / 2];
            if constexpr (EPL == 4) { const v2u a = *(const v2u*)(hraw + (size_t)row * DM + col), b2 = *(const v2u*)(P1 + (size_t)row * NQKV + 4096 + col); xw[0] = a.x; xw[1] = a.y; gwd[0] = b2.x; gwd[1] = b2.y; }
            else { const v4u a = *(const v4u*)(hraw + (size_t)row * DM + col), b2 = *(const v4u*)(P1 + (size_t)row * NQKV + 4096 + col); xw[0] = a.x; xw[1] = a.y; xw[2] = a.z; xw[3] = a.w; gwd[0] = b2.x; gwd[1] = b2.y; gwd[2] = b2.z; gwd[3] = b2.w; }
            float s = 0.f;
#pragma unroll
            for (int j = 0; j < EPL / 2; ++j) { const float x0 = bflo(xw[j]), x1 = bfhi(xw[j]); s += x0 * x0 + x1 * x1; }
            s = wave_sum(s); const float rs = rsqrtf(s * (1.0f / HS) + 1e-6f);
            unsigned outw[EPL / 2];
#pragma unroll
            for (int j = 0; j < EPL / 2; ++j) { const float g0 = bflo(gwd[j]), g1 = bfhi(gwd[j]);
                const float a0 = ACT == 0 ? __builtin_amdgcn_rcpf(1.0f + __expf(-g0)) : g0 * __builtin_amdgcn_rcpf(1.0f + __expf(-g0)), a1 = ACT == 0 ? __builtin_amdgcn_rcpf(1.0f + __expf(-g1)) : g1 * __builtin_amdgcn_rcpf(1.0f + __expf(-g1));
                outw[j] = pk2(bflo(xw[j]) * rs * gnorm[col + 2 * j] * a0, bfhi(xw[j]) * rs * gnorm[col + 2 * j + 1] * a1); }
            if constexpr (EPL == 4) { v2u w; w.x = outw[0]; w.y = outw[1]; *(v2u*)(hm + (size_t)row * DM + col) = w; }
            else { v4u w; w.x = outw[0]; w.y = outw[1]; w.z = outw[2]; w.w = outw[3]; *(v4u*)(hm + (size_t)row * DM + col) = w; }
        }
    }
}

DI void fox_cf(LAS unsigned char* lds, const float* G, const float* b_f, float* cf, const bf16* P1, unsigned* kmax2, int tid, int lane, int wave, int bx) {
    LAS float* wt = (LAS float*)lds;
    for (int item = bx; item < 256; item += gridDim.x) { const int seq = item >> 1, hf = item & 1, b = seq >> 4, h = seq & 15; const float bias = b_f[h];
        const float* gp = G + ((size_t)b * SEQ + hf * 2048 + tid * 4) * 16 + h;
        float ls[4]; float s = 0.f, s0 = 0.f;
#pragma unroll
        for (int p = 0; p < 4; ++p) { ls[p] = logsig(gp[p * 16] + bias); s += ls[p]; }
        if (hf) { const float* g0 = gp - (size_t)2048 * 16;
#pragma unroll
            for (int p = 0; p < 4; ++p) s0 += logsig(g0[p * 16] + bias); }
        const float incl = wave_incl_sum(s, lane), tot0 = wave_sum(s0);
        __syncthreads();
        if (lane == 63) wt[wave] = incl; if (lane == 0) wt[8 + wave] = tot0;
        __syncthreads();
        float base = 0.f;
#pragma unroll
        for (int w = 0; w < 8; ++w) { base += (w < wave) ? wt[w] : 0.f; base += wt[8 + w]; }
        float run = base + incl - s;
        float* o = cf + (size_t)seq * SEQ + hf * 2048 + tid * 4; f32x4 ov;
        run += ls[0]; ov.x = run; run += ls[1]; ov.y = run; run += ls[2]; ov.z = run; run += ls[3]; ov.w = run;
        *(f32x4*)o = ov;
        float km = 0.f; const bf16* kp = P1 + ((size_t)b * SEQ + hf * 2048) * NQKV + 2048 + h * 128;
#pragma unroll 8
        for (int i = 0; i < 64; ++i) { const int idx = tid + 512 * i, r = idx >> 4, c = idx & 15; const v4u kv = *(const v4u*)(kp + (size_t)r * NQKV + c * 8); float s2 = 0.f;
#pragma unroll
            for (int q = 0; q < 4; ++q) { const float x0 = bflo(kv[q]), x1 = bfhi(kv[q]); s2 += x0 * x0 + x1 * x1; }
            s2 += __shfl_xor(s2, 1); s2 += __shfl_xor(s2, 2); s2 += __shfl_xor(s2, 4); s2 += __shfl_xor(s2, 8); km = fmaxf(km, s2); }
        km = fmaxf(km, __shfl_xor(km, 16)); km = fmaxf(km, __shfl_xor(km, 32));
        if (lane == 0) atomicMax(kmax2 + seq, __float_as_uint(km));
    }
}

DI bf16x8 pack8_mfma(const f32x4& lo, const f32x4& hi) { v4u p;
    asm volatile("v_cvt_pk_bf16_f32 %0, %4, %5\n\tv_cvt_pk_bf16_f32 %1, %6, %7\n\tv_cvt_pk_bf16_f32 %2, %8, %9\n\tv_cvt_pk_bf16_f32 %3, %10, %11\n\ts_nop 1"
                 : "=&v"(p[0]), "=&v"(p[1]), "=&v"(p[2]), "=&v"(p[3]) : "v"(lo[0]), "v"(lo[1]), "v"(lo[2]), "v"(lo[3]), "v"(hi[0]), "v"(hi[1]), "v"(hi[2]), "v"(hi[3]));
    return __builtin_bit_cast(bf16x8, p); }
DI unsigned off_v(unsigned row, unsigned ch) { return 256u * row + 16u * (ch ^ (((row & 3u) << 2) | (((row >> 2) & 1u) << 1))); }

DI void fox_attn2(LAS unsigned char* lds, const bf16* P1, const float* cf, const unsigned* kmax2, bf16* hm, int tid, int lane, int wave, int bx) {
    constexpr int BUFB = 16384 + 16384 + 256;
    LAS float* xch = (LAS float*)(lds + 2 * BUFB);
    const float LOG2E = 1.4426950408889634f, QS = 0.08838834764831845f * 1.4426950408889634f, THR = 8.0f;
    const int g = lane >> 4, r16 = lane & 15;
    const int G_ = gridDim.x;
    const int nit = (2048 + G_ - 1) / G_;
    for (int it = 0; it < nit; ++it) {
        const int u = (it & 1) ? it * G_ + (G_ - 1 - bx) : it * G_ + bx;
        if (u >= 2048) continue;
        const int qb = 15 - (u >> 7), bh = u & 127, b = bh >> 4, h = bh & 15;
        const size_t rowb = (size_t)b * SEQ; const int q0 = qb * 256 + 32 * wave;
        bf16x8 qf[2][4]; float c0[2];
#pragma unroll
        for (int tt = 0; tt < 2; ++tt) { const int t = q0 + 16 * tt + r16; c0[tt] = cf[(size_t)bh * SEQ + t] * LOG2E;
#pragma unroll
            for (int kk = 0; kk < 4; ++kk) { const v4u raw = *(const v4u*)(P1 + (rowb + t) * NQKV + h * 128 + 32 * kk + 8 * g); v4u sc;
#pragma unroll
                for (int j = 0; j < 4; ++j) sc[j] = pk2(bflo(raw[j]) * QS, bfhi(raw[j]) * QS);
                qf[tt][kk] = __builtin_bit_cast(bf16x8, sc); } }
        f32x4 oacc[8][2];
#pragma unroll
        for (int et = 0; et < 8; ++et) { oacc[et][0] = (f32x4){0.f, 0.f, 0.f, 0.f}; oacc[et][1] = (f32x4){0.f, 0.f, 0.f, 0.f}; }
        float lrun[2] = {0.f, 0.f};
        const int ntiles = 4 * (qb + 1);
        v4u kreg[2], vreg[2]; float cfreg = 0.f;
        const bf16* kbase = P1 + rowb * NQKV + 2048 + h * 128;
#define FOX_LOAD(j) do { _Pragma("unroll") for (int p = 0; p < 2; ++p) { const int idx = tid + 512 * p, r = idx >> 4, c8 = idx & 15; \
            kreg[p] = *(const v4u*)(kbase + (size_t)(64 * (j) + r) * NQKV + c8 * 8); vreg[p] = *(const v4u*)(kbase + (size_t)(64 * (j) + r) * NQKV + 2048 + c8 * 8); } \
            if (tid < 64) cfreg = -cf[(size_t)bh * SEQ + 64 * (j) + tid] * LOG2E; } while (0)
#define FOX_STORE(bufi) do { LAS unsigned char* bb = lds + (bufi) * BUFB; _Pragma("unroll") for (int p = 0; p < 2; ++p) { const int idx = tid + 512 * p, r = idx >> 4, c8 = idx & 15; \
            *(LAS v4u*)((LAS bf16*)bb + eoff<128>(r, c8 * 8)) = kreg[p]; *(LAS v4u*)(bb + 16384 + off_v(r, c8)) = vreg[p]; } \
            if (tid < 64) ((LAS float*)(bb + 32768))[tid] = cfreg; } while (0)
        float qm = 0.f;
#pragma unroll
        for (int tt = 0; tt < 2; ++tt) { float s2 = 0.f;
#pragma unroll
            for (int kk = 0; kk < 4; ++kk)
#pragma unroll
                for (int jq = 0; jq < 8; ++jq) { const float v = bf2f((unsigned short)qf[tt][kk][jq]); s2 += v * v; }
            s2 += __shfl_xor(s2, 16); s2 += __shfl_xor(s2, 32); qm = fmaxf(qm, s2); }
        qm = fmaxf(qm, __shfl_xor(qm, 1)); qm = fmaxf(qm, __shfl_xor(qm, 2)); qm = fmaxf(qm, __shfl_xor(qm, 4)); qm = fmaxf(qm, __shfl_xor(qm, 8));
        __syncthreads();
        if (lane == 0) xch[16 + wave] = qm;
        FOX_LOAD(ntiles - 1); FOX_STORE(0);
        if (ntiles > 1) FOX_LOAD(ntiles - 2);
        __syncthreads();
        float q2 = xch[16];
#pragma unroll
        for (int w8 = 1; w8 < 8; ++w8) q2 = fmaxf(q2, xch[16 + w8]);
        const float QKB = sqrtf(q2 * __uint_as_float(kmax2[bh])) * 1.01f + 1e-3f;
        const float cfu0 = cf[(size_t)bh * SEQ + qb * 256] * LOG2E;
        float mref[2] = {0.f, 0.f}, rmaxlog[2] = {-__builtin_inff(), -__builtin_inff()};
        for (int k = 0; k < ntiles; ++k) { const int j = ntiles - 1 - k;
            if (k + 1 < ntiles) FOX_STORE((k + 1) & 1);
            if (k + 2 < ntiles) FOX_LOAD(ntiles - 3 - k);
            if (64 * j <= q0 + 31) {
                const LAS bf16* Ks = (const LAS bf16*)(lds + (k & 1) * BUFB); const LAS bf16* VTs = Ks + 64 * 128; const LAS float* cfs = (const LAS float*)(VTs + 128 * 64);
                f32x4 sacc[2][4];
#pragma unroll
                for (int st = 0; st < 4; ++st) { const f32x4 cv = *(const LAS f32x4*)(cfs + 16 * st + 4 * g);
#pragma unroll
                    for (int tt = 0; tt < 2; ++tt) sacc[tt][st] = cv + c0[tt]; }
#pragma unroll
                for (int st = 0; st < 4; ++st)
#pragma unroll
                    for (int kk = 0; kk < 4; ++kk) { const bf16x8 kf = ldf<128>(Ks, 16 * st + r16, 4 * kk + g);
                        sacc[0][st] = mfma16(kf, qf[0][kk], sacc[0][st]); sacc[1][st] = mfma16(kf, qf[1][kk], sacc[1][st]); if (kk == 3) asm volatile("" ::: "memory"); }
                if (64 * j + 63 > q0) {
#pragma unroll
                    for (int tt = 0; tt < 2; ++tt) { const int t = q0 + 16 * tt + r16;
#pragma unroll
                        for (int st = 0; st < 4; ++st)
#pragma unroll
                            for (int i = 0; i < 4; ++i) { const int s = 64 * j + 16 * st + 4 * g + i; if (s > t) sacc[tt][st][i] = -__builtin_inff(); } }
                }
                float mx[2];
#pragma unroll
                for (int tt = 0; tt < 2; ++tt) { float m = -__builtin_inff();
#pragma unroll
                    for (int st = 0; st < 4; ++st) m = fmaxf(m, fmaxf(fmaxf(sacc[tt][st][0], sacc[tt][st][1]), fmaxf(sacc[tt][st][2], sacc[tt][st][3])));
                    m = fmaxf(m, __shfl_xor(m, 16)); m = fmaxf(m, __shfl_xor(m, 32)); mx[tt] = m; }
                rmaxlog[0] = fmaxf(rmaxlog[0], mx[0] + mref[0]); rmaxlog[1] = fmaxf(rmaxlog[1], mx[1] + mref[1]);
                if (__any(mx[0] > THR || mx[1] > THR)) {
#pragma unroll
                    for (int tt = 0; tt < 2; ++tt) { const float sh = fmaxf(mx[tt], 0.f), f = __builtin_amdgcn_exp2f(-sh);
                        c0[tt] -= sh; mref[tt] += sh; lrun[tt] *= f;
#pragma unroll
                        for (int st = 0; st < 4; ++st) sacc[tt][st] = sacc[tt][st] - sh;
#pragma unroll
                        for (int et = 0; et < 8; ++et) oacc[et][tt] = oacc[et][tt] * f; }
                }
#pragma unroll
                for (int tt = 0; tt < 2; ++tt) { float ls = 0.f;
#pragma unroll
                    for (int st = 0; st < 4; ++st)
#pragma unroll
                        for (int i = 0; i < 4; ++i) { const float p = __builtin_amdgcn_exp2f(sacc[tt][st][i]); sacc[tt][st][i] = p; ls += p; }
                    lrun[tt] += ls; }
#pragma unroll
                for (int ks = 0; ks < 2; ++ks) { bf16x8 pb[2];
#pragma unroll
                    for (int tt = 0; tt < 2; ++tt) pb[tt] = pack8_mfma(sacc[tt][2 * ks], sacc[tt][2 * ks + 1]);
#pragma unroll
                    for (int et = 0; et < 8; ++et) {
                        const LAS unsigned char* vb = (const LAS unsigned char*)VTs;
                        const v4i16_t lo = tr_read(vb + off_v(32 * ks + 4 * g + (r16 >> 2), 2 * et + ((lane & 3) >> 1)) + 8 * (lane & 1));
                        const v4i16_t hi = tr_read(vb + off_v(32 * ks + 16 + 4 * g + (r16 >> 2), 2 * et + ((lane & 3) >> 1)) + 8 * (lane & 1));
                        bf16x8 va; va[0] = lo[0]; va[1] = lo[1]; va[2] = lo[2]; va[3] = lo[3]; va[4] = hi[0]; va[5] = hi[1]; va[6] = hi[2]; va[7] = hi[3];
                        oacc[et][0] = mfma16(va, pb[0], oacc[et][0]); oacc[et][1] = mfma16(va, pb[1], oacc[et][1]); if (et & 1) asm volatile("" ::: "memory"); } }
            }
            { float wm = fminf(rmaxlog[0], rmaxlog[1]);
              wm = fminf(wm, __shfl_xor(wm, 1)); wm = fminf(wm, __shfl_xor(wm, 2)); wm = fminf(wm, __shfl_xor(wm, 4)); wm = fminf(wm, __shfl_xor(wm, 8));
              if (lane == 0) xch[(k & 1) * 8 + wave] = wm; }
            __syncthreads();
            if (k + 1 < ntiles) { float mmin = xch[(k & 1) * 8];
#pragma unroll
                for (int w8 = 1; w8 < 8; ++w8) mmin = fminf(mmin, xch[(k & 1) * 8 + w8]);
                const float cfe = ((const LAS float*)(lds + ((k + 1) & 1) * BUFB + 32768))[63];
                if (QKB + cfu0 + cfe < mmin - 40.0f) break; }
        }
#undef FOX_LOAD
#undef FOX_STORE
#pragma unroll
        for (int tt = 0; tt < 2; ++tt) { float l = lrun[tt]; l += __shfl_xor(l, 16); l += __shfl_xor(l, 32); const float inv = 1.0f / l;
            bf16* orow = hm + (rowb + q0 + 16 * tt + r16) * DM + h * 128 + 4 * g;
#pragma unroll
            for (int et = 0; et < 8; ++et) { v2u w; w.x = pk2(oacc[et][tt][0] * inv, oacc[et][tt][1] * inv); w.y = pk2(oacc[et][tt][2] * inv, oacc[et][tt][3] * inv); *(v2u*)(orow + 16 * et) = w; } }
    }
}


DI void final_norm(float* out, const bf16* hb, const long long* ss, const float* gfin, int lane, int wave, int bx) {
    const int gw = bx * NWAVES + wave, NGW = gridDim.x * NWAVES;
    for (int m = gw; m < MTOK; m += NGW) { const float rs = pg8::rstd_of(ss, m);
        const v4u* hr = (const v4u*)(hb + (size_t)m * DM); f32x4* xr = (f32x4*)(out + (size_t)m * DM); const f32x4* gr = (const f32x4*)gfin;
#pragma unroll
        for (int j = 0; j < 4; ++j) { const v4u w = hr[lane + 64 * j]; const int c4 = 2 * (lane + 64 * j);
            const f32x4 g0 = gr[c4], g1 = gr[c4 + 1];
            xr[c4] = (f32x4){bflo(w.x) * rs * g0.x, bfhi(w.x) * rs * g0.y, bflo(w.y) * rs * g0.z, bfhi(w.y) * rs * g0.w};
            xr[c4 + 1] = (f32x4){bflo(w.z) * rs * g1.x, bfhi(w.z) * rs * g1.y, bflo(w.w) * rs * g1.z, bfhi(w.w) * rs * g1.w}; } }
}

#define PH(p) if (lo <= (p) && (p) < hi && (ran ? (xcd_barrier(bar), true) : (ran = true)))
#define TID() int tid = threadIdx.x; asm volatile("" : "+v"(tid)); const int lane = tid & 63, wave = __builtin_amdgcn_readfirstlane(tid >> 6); int bx = blockIdx.x; asm volatile("" : "+s"(bx)); (void)lane; (void)wave; (void)bx
#define WSP(T, off) ((T*)(ka->ws + (off)))
template <int j> DI void subblock(LAS unsigned char* lds, const XcdBarrier& bar, const int lo, const int hi, bool& ran) {
    {
        constexpr int layer = j / 3, typ = j - 3 * layer, base = 1 + 5 * j;
        if constexpr (typ != 1) {
            PH(base) { TID(); KArgs ka = kargs(); const int mi = layer * 2 + (typ >> 1);
                pg8::Gemm gm{WSP(bf16, WS_HB), WSP(bf16, WS_WUP) + (size_t)mi * NUP * DM, MTOK, NUP, DM}; pg8::StaticOrder S; S.init(MTOK, NUP, gridDim.x, bx);
                pg8::EpiSwiGLU E{WSP(bf16, WS_ACT), WSP(long long, WS_SS) + (size_t)j * MTOK, DFF};
                pg8::gemm_phase<pg8::EpiSwiGLU, pg8::StaticOrder, PG8_ALIGN, PG8_SP2>(lds, gm, S, E); }
        } else {
            constexpr int kind = layer % 3, ji = layer / 3, HSLOT = (layer * 2 + 1) / 3;
            (void)ji; (void)HSLOT;
            PH(base) { TID(); KArgs ka = kargs();
                mixer_gates(WSP(bf16, WS_HB), WSP(bf16, WS_WIN) + ((size_t)layer * NINP + NQKV) * DM, WSP(long long, WS_SS) + (size_t)j * MTOK, WSP(float, WS_G), lane, wave, bx);
                pg8::Gemm gm{WSP(bf16, WS_HB), WSP(bf16, WS_WIN) + (size_t)layer * NINP * DM, MTOK, NQKV, DM}; pg8::StaticOrder S; S.init(MTOK, NQKV, gridDim.x, bx);
                pg8::EpiMixIn E{WSP(bf16, WS_P1), WSP(long long, WS_SS) + (size_t)j * MTOK};
                pg8::gemm_phase<pg8::EpiMixIn, pg8::StaticOrder, PG8_ALIGN, PG8_SP2>(lds, gm, S, E); }
            PH(base + 1) { TID(); KArgs ka = kargs();
                if constexpr (kind == 0) for (int rep = 0; rep < REP_MLSTM; ++rep) mlstm_pre(lds, WSP(bf16, WS_P1), WSP(float, WS_G), ka->in[6] + ji * 16, WSP(unsigned char, WS_ACT), tid, lane, wave, bx);
                else if constexpr (kind == 1) { fox_cf(lds, WSP(float, WS_G), ka->in[10] + ji * 16, WSP(float, WS_CF), WSP(bf16, WS_P1), WSP(unsigned, WS_CTL) + CW_KMAX, tid, lane, wave, bx); }
                else for (int rep = 0; rep < REP_GLA; ++rep) gla_pre(lds, WSP(bf16, WS_P1), WSP(float, WS_G), ka->in[13] + (size_t)ji * 16 * 1024, ka->in[14] + ji * 1024, WSP(unsigned char, WS_ACT), tid, lane, wave, bx);
            }
            PH(base + 2) { TID(); KArgs ka = kargs();
                if constexpr (kind == 0) for (int rep = 0; rep < REP_MLSTM; ++rep) mlstm_scan2(lds, WSP(bf16, WS_P1), WSP(unsigned char, WS_ACT), WSP(bf16, WS_HM), WSP(long long, WS_HSS) + (size_t)HSLOT * MTOK * 8, tid, lane, wave, bx);
                else if constexpr (kind == 1) for (int rep = 0; rep < REP_FOX; ++rep) fox_attn2(lds, WSP(bf16, WS_P1), WSP(float, WS_CF), WSP(unsigned, WS_CTL) + CW_KMAX, WSP(bf16, WS_HM), tid, lane, wave, bx);
                else for (int rep = 0; rep < REP_GLA; ++rep) gla_scan2(lds, WSP(bf16, WS_P1), WSP(unsigned char, WS_ACT), WSP(bf16, WS_HM), WSP(long long, WS_HSS) + (size_t)HSLOT * MTOK * 8, tid, lane, wave, bx);
            }
        }
        PH(base + 4) { TID(); KArgs ka = kargs();
            pg8::Gemm gm; float scale;
            if constexpr (typ != 1) { const int mi = layer * 2 + (typ >> 1); gm = pg8::Gemm{WSP(bf16, WS_ACT), WSP(bf16, WS_WDN) + (size_t)mi * DM * DFF, MTOK, DM, DFF}; scale = 0.5f; }
            else { gm = pg8::Gemm{WSP(bf16, WS_HM), WSP(bf16, WS_WOUT) + (size_t)layer * DM * DM, MTOK, DM, DM}; scale = 1.0f; }
            pg8::StaticOrder S; S.init(MTOK, DM, gridDim.x, bx);
            constexpr int NHS = (typ != 1 || layer % 3 == 1) ? 0 : (layer % 3 == 0 ? 8 : 4);
            pg8::EpiResidT<NHS> E{WSP(bf16, WS_HB), WSP(long long, WS_SS) + (size_t)(j + 1) * MTOK, scale, WSP(long long, WS_HSS) + (size_t)((layer * 2 + 1) / 3) * MTOK * 8};
            pg8::gemm_phase<pg8::EpiResidT<NHS>, pg8::StaticOrder, PG8_ALIGN, PG8_SP2>(lds, gm, S, E);
        }
    }
}

__global__ void __launch_bounds__(NWAVES * 64, 2) trunk_fwd(Args args) {
    extern __shared__ __attribute__((aligned(16))) unsigned char lds_raw[];
    LAS unsigned char* lds = (LAS unsigned char*)lds_raw;
    volatile LAS unsigned* MISC = (volatile LAS unsigned*)(lds + MISC_OFF);
    for (int u = threadIdx.x; u < (LDS_BYTES - MISC_OFF) / 4; u += NWAVES * 64) ((LAS unsigned*)(lds + MISC_OFF))[u] = 0u;
    __syncthreads();
    XcdBarrier bar = xcd_barrier_post((unsigned*)(args.ws + WS_CTL) + CW_BAR, MISC + 8);
    const int lo = args.ph_lo, hi = args.ph_hi; bool ran = false;

    PH(0) { TID(); for (int rep = 0; rep < REP_PRO; ++rep) { prologue(lds, lane, wave, bx); __syncthreads(); } }

    subblock<0>(lds, bar, lo, hi, ran); subblock<1>(lds, bar, lo, hi, ran); subblock<2>(lds, bar, lo, hi, ran); subblock<3>(lds, bar, lo, hi, ran);
    subblock<4>(lds, bar, lo, hi, ran); subblock<5>(lds, bar, lo, hi, ran); subblock<6>(lds, bar, lo, hi, ran); subblock<7>(lds, bar, lo, hi, ran);
    subblock<8>(lds, bar, lo, hi, ran); subblock<9>(lds, bar, lo, hi, ran); subblock<10>(lds, bar, lo, hi, ran); subblock<11>(lds, bar, lo, hi, ran);
    PH(NPHASE - 1) { TID(); KArgs ka = kargs(); final_norm(ka->out, WSP(bf16, WS_HB), WSP(long long, WS_SS) + (size_t)NSUB * MTOK, ka->in[17], lane, wave, bx); }
#undef WSP
#undef PH
}

static bool phase_exists(int p) {
    if (p == 0 || p == NPHASE - 1) return true;
    const int j = (p - 1) / 5, k = (p - 1) % 5, typ = j % 3;
    if (k == 0 || k == 4) return true;
    if (typ != 1) return false;
    if (k == 3) return false;
    return true;
}
extern "C" void kernel_launch(void* const* d_in, const int* in_sizes, int n_in, void* d_out, int out_size, void* d_ws, size_t ws_size, hipStream_t stream) {
    static int grid = 0;
    if (grid == 0) {
        if (n_in != 18 || in_sizes[0] != MTOK * DM || out_size != MTOK * DM || ws_size < WS_END) { fprintf(stderr, "kernel_launch: unexpected shapes (n_in %d, in0 %d, out %d, ws %zu < %zu)\n", n_in, n_in > 0 ? in_sizes[0] : -1, out_size, ws_size, (size_t)WS_END); grid = -1; return; }
        int dev = 0, cus = 0, per_cu = 0;
        if (hipGetDevice(&dev) != hipSuccess || hipDeviceGetAttribute(&cus, hipDeviceAttributeMultiprocessorCount, dev) != hipSuccess) { grid = -1; return; }
        if (hipFuncSetAttribute((const void*)trunk_fwd, hipFuncAttributeMaxDynamicSharedMemorySize, LDS_BYTES) != hipSuccess) { fprintf(stderr, "kernel_launch: hipFuncSetAttribute failed\n"); grid = -1; return; }
        if (hipOccupancyMaxActiveBlocksPerMultiprocessor(&per_cu, (const void*)trunk_fwd, NWAVES * 64, LDS_BYTES) != hipSuccess || per_cu < 1) fprintf(stderr, "kernel_launch: occupancy query says %d\n", per_cu);
        (void)hipGetLastError();
        grid = cus;
    }
    if (grid < 0) return;
    if (hipMemsetAsync((char*)d_ws + WS_CTL, 0, CTL_ZERO_BYTES, stream) != hipSuccess) return;
    Args a{};
    for (int i = 0; i < 18; ++i) a.in[i] = (const float*)d_in[i];
    a.out = (float*)d_out; a.ws = (unsigned char*)d_ws;
#if MK_PER_PHASE
    for (int p = 0; p < NPHASE; ++p) { if (!phase_exists(p)) continue; a.ph_lo = p; a.ph_hi = p + 1; hipLaunchKernelGGL(trunk_fwd, dim3(grid), dim3(NWAVES * 64), LDS_BYTES, stream, a); }
#else
    a.ph_lo = 0; a.ph_hi = NPHASE; hipLaunchKernelGGL(trunk_fwd, dim3(grid), dim3(NWAVES * 64), LDS_BYTES, stream, a);
#endif
    (void)phase_exists;
}
```
